# Optimizing an MI355X kernel written in HIP

```python
import math
import jax
import jax.numpy as jnp
from jax import lax
import numpy as np

D_MODEL = 1024
BATCH = 8
SEQ = 4096
DEPTH = 4

GRID_W = 64
CTX_LEN = 256
N_MIXERS = 4
EPS = 1e-6
ROPE_BASE = 10000.0
Q_BLOCK = 128
NEG_INF = -1e30

NA_HEAD_DIM = 64
NA_HEADS = D_MODEL // NA_HEAD_DIM
NA_KH = 8
NA_KW = 16

SW_HEAD_DIM = 64
SW_HEADS = D_MODEL // SW_HEAD_DIM
SW_KV_HEADS = 4
SW_WINDOW = 128

MLA_HEADS = 16
MLA_Q_RANK = 384
MLA_KV_RANK = 256
MLA_NOPE = 64
MLA_ROPE = 32
MLA_V = 64

DIFF_HEAD_DIM = 64
DIFF_HEADS = D_MODEL // (2 * DIFF_HEAD_DIM)

N_GROUPS = 4
EXPERTS_PER_GROUP = 8
N_EXPERTS = N_GROUPS * EXPERTS_PER_GROUP
TOP_K = 2
D_EXPERT = 256
MOE_BLOCK = 128

kernel_name = 'hybrid_dit_na_swa_mla_diff_hmoe'


def _layers_of_kind(kind):
    return len(range(kind, DEPTH, N_MIXERS))


def rms_norm(x, g):
    xf = x.astype(jnp.float32)
    xf = xf * lax.rsqrt(jnp.mean(xf * xf, axis=-1, keepdims=True) + EPS)
    return (xf * g.astype(jnp.float32)).astype(x.dtype)


def modulate(x, g, shift, scale):
    return rms_norm(x, g) * (1.0 + scale) + shift


def split_heads(t, n_heads):
    b, n, _ = t.shape
    return t.reshape(b, n, n_heads, -1).transpose(0, 2, 1, 3)


def merge_heads(t):
    b, h, n, d = t.shape
    return t.transpose(0, 2, 1, 3).reshape(b, n, h * d)


def axial_rope(n_tokens, rot_dim):
    t = jnp.arange(n_tokens, dtype=jnp.int32)
    n_freq = rot_dim // 4
    inv_freq = ROPE_BASE ** (-jnp.arange(n_freq, dtype=jnp.float32) / n_freq)
    rows = (t // GRID_W).astype(jnp.float32)
    cols = (t % GRID_W).astype(jnp.float32)
    ang = jnp.concatenate([rows[:, None] * inv_freq, cols[:, None] * inv_freq], axis=-1)
    return jnp.cos(ang), jnp.sin(ang)


def apply_rope(x, cos, sin):
    x1, x2 = jnp.split(x.astype(jnp.float32), 2, axis=-1)
    return jnp.concatenate([x1 * cos - x2 * sin, x2 * cos + x1 * sin], axis=-1).astype(x.dtype)


def softmax_f32(logits, sink=None):
    if sink is None:
        return jax.nn.softmax(logits, axis=-1)
    sink_col = jnp.broadcast_to(sink, logits.shape[:-1] + (1,))
    return jax.nn.softmax(jnp.concatenate([logits, sink_col], axis=-1), axis=-1)[..., :-1]


def context_attention(q, k, v, scale, sink=None):
    b, h, n, dq = q.shape
    hk = k.shape[1]
    g = h // hk
    qg = q.reshape(b, hk, g, n, dq)
    logits = jnp.einsum('bkgqd,bkcd->bkgqc', qg, k).astype(jnp.float32) * scale
    sink_g = None if sink is None else sink.reshape(hk, g)[None, :, :, None, None].astype(jnp.float32)
    p = softmax_f32(logits, sink_g).astype(v.dtype)
    return jnp.einsum('bkgqc,bkcd->bkgqd', p, v).reshape(b, h, n, -1)


def dense_latent_attention(q, k, v, k_ctx, v_ctx, scale):
    b, h, s, dq = q.shape
    dv = v.shape[-1]
    nblk = s // Q_BLOCK
    qb = jnp.moveaxis(q.reshape(b, h, nblk, Q_BLOCK, dq), 2, 0)

    def one_block(qi):
        logits = jnp.concatenate([
            jnp.einsum('bhqd,bhkd->bhqk', qi, k),
            jnp.einsum('bhqd,bhcd->bhqc', qi, k_ctx)], axis=-1).astype(jnp.float32) * scale
        p = jax.nn.softmax(logits, axis=-1).astype(v.dtype)
        return (jnp.einsum('bhqk,bhkd->bhqd', p[..., :s], v)
                + jnp.einsum('bhqc,bhcd->bhqd', p[..., s:], v_ctx))

    o = lax.map(one_block, qb)
    return jnp.moveaxis(o, 0, 2).reshape(b, h, s, dv)


def window_latent_attention(q, k, v, k_ctx, v_ctx, sink, scale):
    b, h, s, d = q.shape
    hk = k.shape[1]
    g = h // hk
    nblk = s // Q_BLOCK
    span = Q_BLOCK + 2 * SW_WINDOW
    pad = ((0, 0), (0, 0), (SW_WINDOW, SW_WINDOW), (0, 0))
    kp, vp = jnp.pad(k, pad), jnp.pad(v, pad)
    qb = jnp.moveaxis(q.reshape(b, hk, g, nblk, Q_BLOCK, d), 3, 0)
    q_off = jnp.arange(Q_BLOCK)
    k_off = jnp.arange(span) - SW_WINDOW
    in_window = jnp.abs(k_off[None, :] - q_off[:, None]) <= SW_WINDOW
    sink_g = sink.reshape(hk, g)[None, :, :, None, None].astype(jnp.float32)

    def one_block(args):
        i, qi = args
        start = i * Q_BLOCK
        kb = lax.dynamic_slice_in_dim(kp, start, span, axis=2)
        vb = lax.dynamic_slice_in_dim(vp, start, span, axis=2)
        k_pos = start + k_off
        valid = in_window & ((k_pos >= 0) & (k_pos < s))[None, :]
        s_loc = jnp.einsum('bkgqd,bkcd->bkgqc', qi, kb).astype(jnp.float32) * scale
        s_loc = jnp.where(valid, s_loc, NEG_INF)
        s_ctx = jnp.einsum('bkgqd,bkcd->bkgqc', qi, k_ctx).astype(jnp.float32) * scale
        p = softmax_f32(jnp.concatenate([s_loc, s_ctx], axis=-1), sink_g).astype(v.dtype)
        return (jnp.einsum('bkgqc,bkcd->bkgqd', p[..., :span], vb)
                + jnp.einsum('bkgqc,bkcd->bkgqd', p[..., span:], v_ctx))

    o = lax.map(one_block, (jnp.arange(nblk), qb))
    return jnp.moveaxis(o, 0, 3).reshape(b, h, s, d)


def neighbourhood_latent_attention(q, k, v, k_ctx, v_ctx, rpb, scale):
    b, h, s, d = q.shape
    rows = s // GRID_W
    kh = min(NA_KH, rows)
    n_nb = kh * NA_KW
    q_col = jnp.arange(GRID_W)
    col0 = jnp.clip(q_col - NA_KW // 2, 0, GRID_W - NA_KW)
    key_col = col0[:, None] + jnp.arange(NA_KW)[None, :]
    col_off = key_col - q_col[:, None] + (NA_KW - 1)
    q_rows = jnp.moveaxis(q.reshape(b, h, rows, GRID_W, d), 2, 0)

    def one_row(args):
        r, qi = args
        row0 = jnp.clip(r - kh // 2, 0, rows - kh)
        key_row = row0 + jnp.arange(kh)
        row_off = key_row - r + (NA_KH - 1)
        key_idx = (key_row[None, :, None] * GRID_W + key_col[:, None, :]).reshape(GRID_W, n_nb)
        bias_idx = (row_off[None, :, None] * (2 * NA_KW - 1) + col_off[:, None, :]).reshape(GRID_W, n_nb)
        kg, vg = k[:, :, key_idx], v[:, :, key_idx]
        s_nb = (jnp.einsum('bhqd,bhqkd->bhqk', qi, kg).astype(jnp.float32) * scale
                + rpb[:, bias_idx].astype(jnp.float32)[None])
        s_ctx = jnp.einsum('bhqd,bhcd->bhqc', qi, k_ctx).astype(jnp.float32) * scale
        p = jax.nn.softmax(jnp.concatenate([s_nb, s_ctx], axis=-1), axis=-1).astype(v.dtype)
        return (jnp.einsum('bhqk,bhqkd->bhqd', p[..., :n_nb], vg)
                + jnp.einsum('bhqc,bhcd->bhqd', p[..., n_nb:], v_ctx))

    o = lax.map(one_row, (jnp.arange(rows), q_rows))
    return jnp.moveaxis(o, 0, 2).reshape(b, h, s, d)


def mixer_neighbourhood(h_lat, h_ctx, w_qkv, w_o, q_norm, k_norm, rpb, need_ctx):
    def project(h):
        q, k, v = jnp.split(h @ w_qkv, 3, axis=-1)
        return (rms_norm(split_heads(q, NA_HEADS), q_norm),
                rms_norm(split_heads(k, NA_HEADS), k_norm),
                split_heads(v, NA_HEADS))
    scale = NA_HEAD_DIM ** -0.5
    q, k, v = project(h_lat)
    qc, kc, vc = project(h_ctx)
    y_lat = merge_heads(neighbourhood_latent_attention(q, k, v, kc, vc, rpb, scale)) @ w_o
    y_ctx = merge_heads(context_attention(qc, kc, vc, scale)) @ w_o if need_ctx else None
    return y_lat, y_ctx


def mixer_window(h_lat, h_ctx, w_qkv, w_o, q_norm, k_norm, sink, rope, need_ctx):
    split_at = [SW_HEADS * SW_HEAD_DIM, (SW_HEADS + SW_KV_HEADS) * SW_HEAD_DIM]
    def project(h, rope_tab):
        q, k, v = jnp.split(h @ w_qkv, split_at, axis=-1)
        q = rms_norm(split_heads(q, SW_HEADS), q_norm)
        k = rms_norm(split_heads(k, SW_KV_HEADS), k_norm)
        if rope_tab is not None:
            q, k = apply_rope(q, *rope_tab), apply_rope(k, *rope_tab)
        return q, k, split_heads(v, SW_KV_HEADS)
    scale = SW_HEAD_DIM ** -0.5
    q, k, v = project(h_lat, rope)
    qc, kc, vc = project(h_ctx, None)
    y_lat = merge_heads(window_latent_attention(q, k, v, kc, vc, sink, scale)) @ w_o
    y_ctx = merge_heads(context_attention(qc, kc, vc, scale, sink)) @ w_o if need_ctx else None
    return y_lat, y_ctx


def mixer_mla(h_lat, h_ctx, w_dqkv, q_a_norm, kv_a_norm, w_uq, w_ukv, q_norm, k_norm, w_o, rope, need_ctx):
    def project(h, rope_tab):
        cq, ckv, k_rope = jnp.split(h @ w_dqkv, [MLA_Q_RANK, MLA_Q_RANK + MLA_KV_RANK], axis=-1)
        q = split_heads(rms_norm(cq, q_a_norm) @ w_uq, MLA_HEADS)
        kv = split_heads(rms_norm(ckv, kv_a_norm) @ w_ukv, MLA_HEADS)
        q_nope = rms_norm(q[..., :MLA_NOPE], q_norm[:MLA_NOPE])
        q_rope = rms_norm(q[..., MLA_NOPE:], q_norm[MLA_NOPE:])
        k_nope = rms_norm(kv[..., :MLA_NOPE], k_norm[:MLA_NOPE])
        v = kv[..., MLA_NOPE:]
        k_rope = rms_norm(k_rope, k_norm[MLA_NOPE:])[:, None]
        if rope_tab is not None:
            q_rope, k_rope = apply_rope(q_rope, *rope_tab), apply_rope(k_rope, *rope_tab)
        q = jnp.concatenate([q_nope, q_rope], axis=-1)
        k = jnp.concatenate([k_nope, jnp.broadcast_to(k_rope, k_nope.shape[:-1] + (MLA_ROPE,))], axis=-1)
        return q, k, v
    scale = (MLA_NOPE + MLA_ROPE) ** -0.5
    q, k, v = project(h_lat, rope)
    qc, kc, vc = project(h_ctx, None)
    y_lat = merge_heads(dense_latent_attention(q, k, v, kc, vc, scale)) @ w_o
    y_ctx = merge_heads(context_attention(qc, kc, vc, scale)) @ w_o if need_ctx else None
    return y_lat, y_ctx


def mixer_diff(h_lat, h_ctx, w_qkv, q_norm, k_norm, lam, subln, w_o, rope, lambda_init, need_ctx):
    qk_width = 2 * DIFF_HEADS * DIFF_HEAD_DIM
    def project(h, rope_tab):
        q, k, v = jnp.split(h @ w_qkv, [qk_width, 2 * qk_width], axis=-1)
        q = rms_norm(split_heads(q, 2 * DIFF_HEADS), q_norm)
        k = rms_norm(split_heads(k, 2 * DIFF_HEADS), k_norm)
        if rope_tab is not None:
            q, k = apply_rope(q, *rope_tab), apply_rope(k, *rope_tab)
        return q[:, 0::2], q[:, 1::2], k[:, 0::2], k[:, 1::2], split_heads(v, DIFF_HEADS)
    lf = lam.astype(jnp.float32)
    lam_full = jnp.exp(jnp.sum(lf[0] * lf[1])) - jnp.exp(jnp.sum(lf[2] * lf[3])) + lambda_init
    scale = DIFF_HEAD_DIM ** -0.5

    def combine(o1, o2):
        o = o1 - lam_full.astype(o1.dtype) * o2
        return merge_heads(rms_norm(o, subln) * (1.0 - lambda_init)) @ w_o

    q1, q2, k1, k2, v = project(h_lat, rope)
    q1c, q2c, k1c, k2c, vc = project(h_ctx, None)
    y_lat = combine(dense_latent_attention(q1, k1, v, k1c, vc, scale),
                    dense_latent_attention(q2, k2, v, k2c, vc, scale))
    y_ctx = (combine(context_attention(q1c, k1c, vc, scale), context_attention(q2c, k2c, vc, scale))
             if need_ctx else None)
    return y_lat, y_ctx


def hierarchical_moe(h, w_rg, b_rg, w_re, b_re, w_gu, w_down):
    t, d = h.shape
    hf = h.astype(jnp.float32)
    g_prob = jax.nn.softmax(hf @ w_rg.astype(jnp.float32) + b_rg.astype(jnp.float32), axis=-1)
    g_w, g_idx = lax.top_k(g_prob, 1)
    e_logits = (hf @ w_re.astype(jnp.float32) + b_re.astype(jnp.float32)).reshape(t, N_GROUPS, EXPERTS_PER_GROUP)
    e_logits = jnp.take_along_axis(e_logits, g_idx[:, :, None], axis=1)[:, 0]
    e_w, e_idx = lax.top_k(jax.nn.softmax(e_logits, axis=-1), TOP_K)
    gate = g_w * e_w / jnp.sum(e_w, axis=-1, keepdims=True)
    expert = (g_idx * EXPERTS_PER_GROUP + e_idx).astype(jnp.int32)
    n_rows = t * TOP_K
    flat_expert = expert.reshape(-1)
    order = jnp.argsort(flat_expert).astype(jnp.int32)
    sorted_expert = flat_expert[order]
    counts = jnp.zeros((N_EXPERTS,), jnp.int32).at[flat_expert].add(1)
    padded = (counts + MOE_BLOCK - 1) // MOE_BLOCK * MOE_BLOCK
    seg_end_p = jnp.cumsum(padded)
    seg_start_p = seg_end_p - padded
    seg_start = jnp.cumsum(counts) - counts
    dest = seg_start_p[sorted_expert] + jnp.arange(n_rows, dtype=jnp.int32) - seg_start[sorted_expert]
    n_pad_rows = -(-(n_rows + N_EXPERTS * (MOE_BLOCK - 1)) // MOE_BLOCK) * MOE_BLOCK
    n_blocks = n_pad_rows // MOE_BLOCK
    row_token = jnp.zeros((n_pad_rows,), jnp.int32).at[dest].set(order // TOP_K)
    row_gate = jnp.zeros((n_pad_rows,), jnp.float32).at[dest].set(gate.reshape(-1)[order])
    block_expert = jnp.minimum(
        jnp.searchsorted(seg_end_p, jnp.arange(n_blocks, dtype=jnp.int32) * MOE_BLOCK, side='right'),
        N_EXPERTS - 1)

    def one_block(args):
        e, tok, gw = args
        rows = h[tok]
        gte, up = jnp.split(rows @ w_gu[e], 2, axis=-1)
        return (jax.nn.silu(gte) * up * gw[:, None].astype(h.dtype)) @ w_down[e]

    out = lax.map(one_block, (block_expert,
                              row_token.reshape(n_blocks, MOE_BLOCK),
                              row_gate.reshape(n_blocks, MOE_BLOCK)))
    return jnp.zeros_like(h).at[row_token].add(out.reshape(n_pad_rows, d))


def setup_inputs(seed: int = 0) -> dict:
    keys = iter(jax.random.split(jax.random.key(seed), 40))

    def normal(shape, std):
        return std * jax.random.normal(next(keys), shape, jnp.float32)

    def gain(shape):
        return 1.0 + 0.1 * jax.random.normal(next(keys), shape, jnp.float32)

    d = D_MODEL
    n_a, n_b, n_c, n_d = (_layers_of_kind(kind) for kind in range(N_MIXERS))
    qk_diff = 2 * DIFF_HEADS * DIFF_HEAD_DIM
    return {
        'x': normal((BATCH, SEQ, d), 1.0),
        'c': normal((BATCH, d), 1.0),
        'ctx': normal((BATCH, CTX_LEN, d), 1.0),
        'c_ctx': normal((d,), 1.0),
        'ada_w': normal((DEPTH, d, 6 * d), 0.5 * d ** -0.5),
        'ada_b': normal((DEPTH, 6 * d), 0.02),
        'norm_g': gain((DEPTH, 2, d)),
        'moe_w_router_group': normal((DEPTH, d, N_GROUPS), d ** -0.5),
        'moe_b_router_group': normal((DEPTH, N_GROUPS), 0.01),
        'moe_w_router_expert': normal((DEPTH, d, N_EXPERTS), d ** -0.5),
        'moe_b_router_expert': normal((DEPTH, N_EXPERTS), 0.01),
        'moe_w_gate_up': normal((DEPTH, N_EXPERTS, d, 2 * D_EXPERT), d ** -0.5),
        'moe_w_down': normal((DEPTH, N_EXPERTS, D_EXPERT, d), D_EXPERT ** -0.5),
        'na_w_qkv': normal((n_a, d, 3 * NA_HEADS * NA_HEAD_DIM), d ** -0.5),
        'na_w_o': normal((n_a, NA_HEADS * NA_HEAD_DIM, d), (NA_HEADS * NA_HEAD_DIM) ** -0.5),
        'na_q_norm': gain((n_a, NA_HEAD_DIM)),
        'na_k_norm': gain((n_a, NA_HEAD_DIM)),
        'na_rpb': normal((n_a, NA_HEADS, (2 * NA_KH - 1) * (2 * NA_KW - 1)), 0.5),
        'sw_w_qkv': normal((n_b, d, (SW_HEADS + 2 * SW_KV_HEADS) * SW_HEAD_DIM), d ** -0.5),
        'sw_w_o': normal((n_b, SW_HEADS * SW_HEAD_DIM, d), (SW_HEADS * SW_HEAD_DIM) ** -0.5),
        'sw_q_norm': gain((n_b, SW_HEAD_DIM)),
        'sw_k_norm': gain((n_b, SW_HEAD_DIM)),
        'sw_sink': normal((n_b, SW_HEADS), 1.0),
        'mla_w_dqkv': normal((n_c, d, MLA_Q_RANK + MLA_KV_RANK + MLA_ROPE), d ** -0.5),
        'mla_q_a_norm': gain((n_c, MLA_Q_RANK)),
        'mla_kv_a_norm': gain((n_c, MLA_KV_RANK)),
        'mla_w_uq': normal((n_c, MLA_Q_RANK, MLA_HEADS * (MLA_NOPE + MLA_ROPE)), MLA_Q_RANK ** -0.5),
        'mla_w_ukv': normal((n_c, MLA_KV_RANK, MLA_HEADS * (MLA_NOPE + MLA_V)), MLA_KV_RANK ** -0.5),
        'mla_q_norm': gain((n_c, MLA_NOPE + MLA_ROPE)),
        'mla_k_norm': gain((n_c, MLA_NOPE + MLA_ROPE)),
        'mla_w_o': normal((n_c, MLA_HEADS * MLA_V, d), (MLA_HEADS * MLA_V) ** -0.5),
        'diff_w_qkv': normal((n_d, d, 2 * qk_diff + DIFF_HEADS * 2 * DIFF_HEAD_DIM), d ** -0.5),
        'diff_q_norm': gain((n_d, DIFF_HEAD_DIM)),
        'diff_k_norm': gain((n_d, DIFF_HEAD_DIM)),
        'diff_lambda': normal((n_d, 4, DIFF_HEAD_DIM), 0.1),
        'diff_subln': gain((n_d, 2 * DIFF_HEAD_DIM)),
        'diff_w_o': normal((n_d, DIFF_HEADS * 2 * DIFF_HEAD_DIM, d), (DIFF_HEADS * 2 * DIFF_HEAD_DIM) ** -0.5),
    }


def reference(x, c, ctx, c_ctx, ada_w, ada_b, norm_g,
              moe_w_router_group, moe_b_router_group, moe_w_router_expert, moe_b_router_expert,
              moe_w_gate_up, moe_w_down,
              na_w_qkv, na_w_o, na_q_norm, na_k_norm, na_rpb,
              sw_w_qkv, sw_w_o, sw_q_norm, sw_k_norm, sw_sink,
              mla_w_dqkv, mla_q_a_norm, mla_kv_a_norm, mla_w_uq, mla_w_ukv, mla_q_norm, mla_k_norm, mla_w_o,
              diff_w_qkv, diff_q_norm, diff_k_norm, diff_lambda, diff_subln, diff_w_o):
    b, s, d = x.shape
    n_ctx = ctx.shape[1]
    rope_head = axial_rope(s, SW_HEAD_DIM)
    rope_mla = axial_rope(s, MLA_ROPE)
    x_lat, x_ctx = x, ctx
    for l in range(DEPTH):
        kind, j = l % N_MIXERS, l // N_MIXERS
        need_ctx = l < DEPTH - 1
        mod_lat = (jax.nn.silu(c) @ ada_w[l] + ada_b[l])[:, None, :]
        mod_ctx = (jax.nn.silu(c_ctx) @ ada_w[l] + ada_b[l])[None, None, :]
        sh1, sc1, g1, sh2, sc2, g2 = jnp.split(mod_lat, 6, axis=-1)
        csh1, csc1, cg1, csh2, csc2, cg2 = jnp.split(mod_ctx, 6, axis=-1)
        h_lat = modulate(x_lat, norm_g[l, 0], sh1, sc1)
        h_ctx = modulate(x_ctx, norm_g[l, 0], csh1, csc1)
        if kind == 0:
            y_lat, y_ctx = mixer_neighbourhood(h_lat, h_ctx, na_w_qkv[j], na_w_o[j], na_q_norm[j],
                                               na_k_norm[j], na_rpb[j], need_ctx)
        elif kind == 1:
            y_lat, y_ctx = mixer_window(h_lat, h_ctx, sw_w_qkv[j], sw_w_o[j], sw_q_norm[j], sw_k_norm[j],
                                        sw_sink[j], rope_head, need_ctx)
        elif kind == 2:
            y_lat, y_ctx = mixer_mla(h_lat, h_ctx, mla_w_dqkv[j], mla_q_a_norm[j], mla_kv_a_norm[j],
                                     mla_w_uq[j], mla_w_ukv[j], mla_q_norm[j], mla_k_norm[j], mla_w_o[j],
                                     rope_mla, need_ctx)
        else:
            y_lat, y_ctx = mixer_diff(h_lat, h_ctx, diff_w_qkv[j], diff_q_norm[j], diff_k_norm[j],
                                      diff_lambda[j], diff_subln[j], diff_w_o[j], rope_head,
                                      0.8 - 0.6 * math.exp(-0.3 * l), need_ctx)
        x_lat = x_lat + g1 * y_lat
        h_lat = modulate(x_lat, norm_g[l, 1], sh2, sc2)
        moe_args = (moe_w_router_group[l], moe_b_router_group[l], moe_w_router_expert[l],
                    moe_b_router_expert[l], moe_w_gate_up[l], moe_w_down[l])
        if need_ctx:
            x_ctx = x_ctx + cg1 * y_ctx
            h_ctx = modulate(x_ctx, norm_g[l, 1], csh2, csc2)
            tokens = jnp.concatenate([h_lat.reshape(-1, d), h_ctx.reshape(-1, d)], axis=0)
            y = hierarchical_moe(tokens, *moe_args)
            x_lat = x_lat + g2 * y[:b * s].reshape(b, s, d)
            x_ctx = x_ctx + cg2 * y[b * s:].reshape(b, n_ctx, d)
        else:
            y = hierarchical_moe(h_lat.reshape(-1, d), *moe_args)
            x_lat = x_lat + g2 * y.reshape(b, s, d)
    return x_lat
```

```cpp
#include <hip/hip_runtime.h>
#include <stdint.h>
#include <stdio.h>

#ifndef ONE_LAUNCH
#define ONE_LAUNCH 1
#endif

#define DI __device__ __forceinline__
typedef unsigned short bf16_t;
typedef short bf16x8 __attribute__((ext_vector_type(8)));
typedef float f32x4 __attribute__((ext_vector_type(4)));
typedef float f32x16 __attribute__((ext_vector_type(16)));
typedef unsigned u32x4 __attribute__((ext_vector_type(4)));
typedef unsigned u32x2 __attribute__((ext_vector_type(2)));

constexpr int DM = 1024, NBATCH = 8, SEQ = 4096, CTXL = 256, PP = SEQ + CTXL, MROWS = NBATCH * PP;
constexpr int NEXP = 32, DEXP = 256;
constexpr float EPS = 1e-6f, LOG2E = 1.4426950408889634f;
constexpr int NTHREADS = 512, NW = NTHREADS / 64;

constexpr size_t MiB = 1ull << 20;
constexpr size_t WS_RAW_FWD = 380ull << 20;
constexpr size_t WS_CTL = 0, CTL_BYTES = 1 * MiB;
constexpr size_t WS_MOD = 1 * MiB;
constexpr size_t WS_MODP = WS_RAW_FWD;
constexpr size_t WS_XCTX = 9 * MiB;
constexpr size_t WS_LIST = 17 * MiB;
constexpr size_t WS_GATE = 22 * MiB;
constexpr size_t WS_W = 24 * MiB;
constexpr size_t W_QKV0 = WS_W + 0 * MiB, W_O0 = WS_W + 6 * MiB, W_QKV1 = WS_W + 8 * MiB, W_O1 = WS_W + 11 * MiB, W_DQKV = WS_W + 13 * MiB,
                 W_UQ = WS_W + 15 * MiB, W_UKV = WS_W + 17 * MiB, W_O2 = WS_W + 18 * MiB, W_QKV3 = WS_W + 20 * MiB, W_O3 = WS_W + 26 * MiB,
                 W_GU = WS_W + 28 * MiB, W_DN = WS_W + 156 * MiB;
constexpr size_t WS_H = 244 * MiB;
constexpr size_t WS_O = 312 * MiB;
constexpr size_t WS_RAW = 380 * MiB;
constexpr size_t WS_Q = 620 * MiB;
constexpr size_t WS_K = 722 * MiB;
constexpr size_t WS_XB = 824 * MiB;
constexpr size_t WS_END = 892 * MiB;
constexpr int CW_CNT = 4096;

constexpr size_t WS_RW = 2 * MiB;
struct Params { const float* in[37]; float* out; unsigned char* ws; };

DI unsigned f2bf(float f) { unsigned u = __float_as_uint(f); return (u + 0x7fffu + ((u >> 16) & 1u)) >> 16; }
DI float bf2f(unsigned h) { return __uint_as_float(h << 16); }
DI unsigned pk2(float lo, float hi) { return f2bf(lo) | (f2bf(hi) << 16); }
DI float bflo(unsigned w) { return __uint_as_float(w << 16); }
DI float bfhi(unsigned w) { return __uint_as_float(w & 0xffff0000u); }
DI int lane_now() { unsigned lane; asm volatile("v_mbcnt_lo_u32_b32 %0, -1, 0\n\tv_mbcnt_hi_u32_b32 %0, -1, %0" : "=v"(lane)); return (int)lane; }
DI float wave_sum(float v) {
#pragma unroll
    for (int o = 32; o > 0; o >>= 1) v += __shfl_xor(v, o);
    return v;
}
DI float silu_f(float x) { return x / (1.0f + __expf(-x)); }
DI void unpack8(const u32x4 w, float (&f)[8]) {
    f[0] = bflo(w.x); f[1] = bfhi(w.x); f[2] = bflo(w.y); f[3] = bfhi(w.y); f[4] = bflo(w.z); f[5] = bfhi(w.z); f[6] = bflo(w.w); f[7] = bfhi(w.w);
}
DI u32x4 pack8(const float (&f)[8]) { u32x4 w; w.x = pk2(f[0], f[1]); w.y = pk2(f[2], f[3]); w.z = pk2(f[4], f[5]); w.w = pk2(f[6], f[7]); return w; }
DI float* xrow_ptr(const Params& p, int r) {
    const int b = r / PP, pos = r - b * PP;
    return pos < SEQ ? p.out + ((size_t)b * SEQ + pos) * DM : (float*)(p.ws + WS_XCTX) + ((size_t)b * CTXL + (pos - SEQ)) * DM;
}
DI bf16_t* xb_row(const Params& p, int r) { return (bf16_t*)(p.ws + WS_XB) + (size_t)r * DM; }
DI int mod_row(int r) { const int b = r / PP, pos = r - b * PP; return pos < SEQ ? b : 8; }
__device__ const float ROPE64[2048] = {
  1.000000000e+00f, 0.000000000e+00f, 1.000000000e+00f, 0.000000000e+00f, 1.000000000e+00f, 0.000000000e+00f, 1.000000000e+00f, 0.000000000e+00f,
  1.000000000e+00f, 0.000000000e+00f, 1.000000000e+00f, 0.000000000e+00f, 1.000000000e+00f, 0.000000000e+00f, 1.000000000e+00f, 0.000000000e+00f,
  1.000000000e+00f, 0.000000000e+00f, 1.000000000e+00f, 0.000000000e+00f, 1.000000000e+00f, 0.000000000e+00f, 1.000000000e+00f, 0.000000000e+00f,
  1.000000000e+00f, 0.000000000e+00f, 1.000000000e+00f, 0.000000000e+00f, 1.000000000e+00f, 0.000000000e+00f, 1.000000000e+00f, 0.000000000e+00f,
  5.403022766e-01f, 8.414709568e-01f, 8.460091352e-01f, 5.331684351e-01f, 9.504152536e-01f, 3.109835982e-01f, 9.842302203e-01f, 1.768921912e-01f,
  9.950041771e-01f, 9.983342141e-02f, 9.984192848e-01f, 5.620449781e-02f, 9.995000362e-01f, 3.161750361e-02f, 9.998418689e-01f, 1.778185740e-02f,
  9.999499917e-01f, 9.999833070e-03f, 9.999842048e-01f, 5.623383448e-03f, 9.999949932e-01f, 3.162272274e-03f, 9.999983907e-01f, 1.778278500e-03f,
  9.999995232e-01f, 9.999999311e-04f, 9.999998212e-01f, 5.623412435e-04f, 9.999999404e-01f, 3.162277571e-04f, 1.000000000e+00f, 1.778279402e-04f,
  -4.161468446e-01f, 9.092974067e-01f, 4.314628243e-01f, 9.021307230e-01f, 8.065783978e-01f, 5.911270976e-01f, 9.374182820e-01f, 3.482052684e-01f,
  9.800665975e-01f, 1.986693293e-01f, 9.936820865e-01f, 1.122313142e-01f, 9.980006814e-01f, 6.320339441e-02f, 9.993675947e-01f, 3.555808961e-02f,
  9.998000264e-01f, 1.999866590e-02f, 9.999367595e-01f, 1.124658901e-02f, 9.999799728e-01f, 6.324512884e-03f, 9.999936819e-01f, 3.556551412e-03f,
  9.999979734e-01f, 1.999998698e-03f, 9.999993443e-01f, 1.124682371e-03f, 9.999998212e-01f, 6.324554561e-04f, 9.999999404e-01f, 3.556558804e-04f,
  -9.899924994e-01f, 1.411200017e-01f, -1.159661636e-01f, 9.932531714e-01f, 5.827536583e-01f, 8.126488924e-01f, 8.610406518e-01f, 5.085361004e-01f,
  9.553365111e-01f, 2.955202162e-01f, 9.858034849e-01f, 1.679033041e-01f, 9.955033660e-01f, 9.472608566e-02f, 9.985772967e-01f, 5.332308263e-02f,
  9.995500445e-01f, 2.999549918e-02f, 9.998577237e-01f, 1.686943881e-02f, 9.999549985e-01f, 9.486690164e-03f, 9.999857545e-01f, 5.334813148e-03f,
  9.999955297e-01f, 2.999995602e-03f, 9.999985695e-01f, 1.687023090e-03f, 9.999995232e-01f, 9.486831259e-04f, 9.999998808e-01f, 5.334838061e-04f,
  -6.536436081e-01f, -7.568024993e-01f, -6.276797056e-01f, 7.784717083e-01f, 3.011374772e-01f, 9.535807371e-01f, 7.575061917e-01f, 6.528279781e-01f,
  9.210609794e-01f, 3.894183338e-01f, 9.748082757e-01f, 2.230444849e-01f, 9.920106530e-01f, 1.261540651e-01f, 9.974712729e-01f, 7.107120752e-02f,
  9.992001057e-01f, 3.998933360e-02f, 9.997470379e-01f, 2.249175683e-02f, 9.999200106e-01f, 1.264877338e-02f, 9.999747276e-01f, 7.113057654e-03f,
  9.999920130e-01f, 3.999989480e-03f, 9.999974966e-01f, 2.249363344e-03f, 9.999992251e-01f, 1.264910679e-03f, 9.999997616e-01f, 7.113117026e-04f,
  2.836622000e-01f, -9.589242935e-01f, -9.460792542e-01f, 3.239352703e-01f, -1.034233812e-02f, 9.999465346e-01f, 6.300802827e-01f, 7.765299678e-01f,
  8.775825500e-01f, 4.794255495e-01f, 9.607312679e-01f, 2.774805427e-01f, 9.875259995e-01f, 1.574558765e-01f, 9.960497618e-01f, 8.879686147e-02f,
  9.987502694e-01f, 4.997916520e-02f, 9.996047616e-01f, 2.811336145e-02f, 9.998750091e-01f, 1.581072807e-02f, 9.999604821e-01f, 8.891279809e-03f,
  9.999874830e-01f, 4.999979399e-03f, 9.999960661e-01f, 2.811702900e-03f, 9.999987483e-01f, 1.581138116e-03f, 9.999995828e-01f, 8.891395992e-04f,
  9.601702690e-01f, -2.794154882e-01f, -9.731037021e-01f, -2.303675115e-01f, -3.207964003e-01f, 9.471482038e-01f, 4.827820361e-01f, 8.757405281e-01f,
  8.253356218e-01f, 5.646424890e-01f, 9.436169863e-01f, 3.310393095e-01f, 9.820539355e-01f, 1.886002719e-01f, 9.943132997e-01f, 1.064944416e-01f,
  9.982005358e-01f, 5.996400490e-02f, 9.994308352e-01f, 3.373407945e-02f, 9.998199940e-01f, 1.897252724e-02f, 9.999430776e-01f, 1.066947449e-02f,
  9.999819994e-01f, 5.999964196e-03f, 9.999943376e-01f, 3.374041524e-03f, 9.999982119e-01f, 1.897365320e-03f, 9.999994040e-01f, 1.066967379e-03f,
  7.539022565e-01f, 6.569865942e-01f, -7.004297972e-01f, -7.137212753e-01f, -5.994374752e-01f, 8.004215956e-01f, 3.202570081e-01f, 9.473307133e-01f,
  7.648422122e-01f, 6.442176700e-01f, 9.235194325e-01f, 3.835515678e-01f, 9.755998850e-01f, 2.195560932e-01f, 9.922624230e-01f, 1.241583377e-01f,
  9.975510240e-01f, 6.994284689e-02f, 9.992253184e-01f, 3.935372457e-02f, 9.997550249e-01f, 2.213413455e-02f, 9.999225140e-01f, 1.244763471e-02f,
  9.999755025e-01f, 6.999942940e-03f, 9.999922514e-01f, 3.936378751e-03f, 9.999975562e-01f, 2.213592408e-03f, 9.999992251e-01f, 1.244795276e-03f,
  -1.455000341e-01f, 9.893582463e-01f, -2.120364457e-01f, -9.772617817e-01f, -8.186324239e-01f, 5.743177533e-01f, 1.476312131e-01f, 9.890424609e-01f,
  6.967067122e-01f, 7.173560858e-01f, 9.005023241e-01f, 4.348512292e-01f, 9.681702852e-01f, 2.502923310e-01f, 9.898977876e-01f, 1.417829692e-01f,
  9.968017340e-01f, 7.991468906e-02f, 9.989882708e-01f, 4.497213289e-02f, 9.996800423e-01f, 2.529552206e-02f, 9.998987913e-01f, 1.422575582e-02f,
  9.999679923e-01f, 7.999914698e-03f, 9.999898672e-01f, 4.498715047e-03f, 9.999967813e-01f, 2.529819263e-03f, 9.999989867e-01f, 1.422623056e-03f,
  -9.111302495e-01f, 4.121184945e-01f, 3.416602612e-01f, -9.398235083e-01f, -9.566441774e-01f, 2.912592292e-01f, -2.965079620e-02f, 9.995602965e-01f,
  6.216099262e-01f, 7.833269238e-01f, 8.746382594e-01f, 4.847761393e-01f, 9.597726464e-01f, 2.807783186e-01f, 9.872201085e-01f, 1.593627781e-01f,
  9.959527254e-01f, 8.987854421e-02f, 9.987195730e-01f, 5.058911815e-02f, 9.995950460e-01f, 2.845665626e-02f, 9.998719096e-01f, 1.600383036e-02f,
  9.999595284e-01f, 8.999879472e-03f, 9.999871850e-01f, 5.061050411e-03f, 9.999959469e-01f, 2.846045885e-03f, 9.999987483e-01f, 1.600450720e-03f,
  -8.390715122e-01f, -5.440211296e-01f, 7.901318669e-01f, -6.129369140e-01f, -9.997860789e-01f, -2.068356983e-02f, -2.059976310e-01f, 9.785524607e-01f,
  5.403022766e-01f, 8.414709568e-01f, 8.460091352e-01f, 5.331684351e-01f, 9.504153132e-01f, 3.109835684e-01f, 9.842302203e-01f, 1.768921912e-01f,
  9.950041771e-01f, 9.983341396e-02f, 9.984192848e-01f, 5.620449781e-02f, 9.995000362e-01f, 3.161750361e-02f, 9.998418689e-01f, 1.778185740e-02f,
  9.999499917e-01f, 9.999834001e-03f, 9.999842048e-01f, 5.623383448e-03f, 9.999949932e-01f, 3.162272274e-03f, 9.999983907e-01f, 1.778278500e-03f,
  4.425697960e-03f, -9.999902248e-01f, 9.952573776e-01f, -9.727645665e-02f, -9.437797666e-01f, -3.305749595e-01f, -3.758473992e-01f, 9.266815782e-01f,
  4.535960853e-01f, 8.912073970e-01f, 8.147053123e-01f, 5.798751712e-01f, 9.401075840e-01f, 3.408778608e-01f, 9.809291363e-01f, 1.943656504e-01f,
  9.939560890e-01f, 1.097782999e-01f, 9.980874062e-01f, 6.181810424e-02f, 9.993950725e-01f, 3.477803990e-02f, 9.998086691e-01f, 1.955982670e-02f,
  9.999395013e-01f, 1.099977922e-02f, 9.999808669e-01f, 6.185714621e-03f, 9.999939203e-01f, 3.478498431e-03f, 9.999980927e-01f, 1.956106164e-03f,
  8.438539505e-01f, -5.365729332e-01f, 8.938615918e-01f, 4.483429790e-01f, -7.941793799e-01f, -6.076834202e-01f, -5.338430405e-01f, 8.455836177e-01f,
  3.623577058e-01f, 9.320390821e-01f, 7.808259130e-01f, 6.247486472e-01f, 9.288598895e-01f, 3.704313040e-01f, 9.773178697e-01f, 2.117776722e-01f,
  9.928086400e-01f, 1.197122037e-01f, 9.977239966e-01f, 6.742975861e-02f, 9.992800951e-01f, 3.793822229e-02f, 9.997723103e-01f, 2.133773454e-02f,
  9.999279976e-01f, 1.199971233e-02f, 9.999772310e-01f, 6.748044398e-03f, 9.999927878e-01f, 3.794723889e-03f, 9.999977350e-01f, 2.133933594e-03f,
  9.074468017e-01f, 4.201670289e-01f, 5.171728730e-01f, 8.558809757e-01f, -5.658205152e-01f, -8.245284557e-01f, -6.750016809e-01f, 7.378162146e-01f,
  2.674987614e-01f, 9.635581970e-01f, 7.444779873e-01f, 6.676470041e-01f, 9.166833758e-01f, 3.996143043e-01f, 9.733975530e-01f, 2.291227132e-01f,
  9.915618896e-01f, 1.296341419e-01f, 9.973290563e-01f, 7.303927839e-02f, 9.991551042e-01f, 4.109803215e-02f, 9.997327924e-01f, 2.311557345e-02f,
  9.999154806e-01f, 1.299963426e-02f, 9.999732971e-01f, 7.310371846e-03f, 9.999915361e-01f, 4.110949114e-03f, 9.999973178e-01f, 2.311761025e-03f,
  1.367372125e-01f, 9.906073809e-01f, -1.879615150e-02f, 9.998233318e-01f, -2.813494802e-01f, -9.596053958e-01f, -7.948709130e-01f, 6.067785621e-01f,
  1.699671596e-01f, 9.854497313e-01f, 7.057763934e-01f, 7.084347010e-01f, 9.035902619e-01f, 4.283977747e-01f, 9.691694379e-01f, 2.463953048e-01f,
  9.902160168e-01f, 1.395431161e-01f, 9.969025850e-01f, 7.864648104e-02f, 9.990201592e-01f, 4.425742477e-02f, 9.996901155e-01f, 2.489333972e-02f,
  9.999020100e-01f, 1.399954315e-02f, 9.999690056e-01f, 7.872696966e-03f, 9.999902248e-01f, 4.427174106e-03f, 9.999969006e-01f, 2.489588689e-03f,
  -7.596879005e-01f, 6.502878666e-01f, -5.489754677e-01f, 8.358384371e-01f, 3.102235124e-02f, -9.995186925e-01f, -8.896704316e-01f, 4.566032588e-01f,
  7.073719800e-02f, 9.974949956e-01f, 6.648434997e-01f, 7.469826341e-01f, 8.895936012e-01f, 4.567528665e-01f, 9.646348357e-01f, 2.635899782e-01f,
  9.887710810e-01f, 1.494381279e-01f, 9.964445233e-01f, 8.425120264e-02f, 9.988752007e-01f, 4.741638154e-02f, 9.996442795e-01f, 2.667102963e-02f,
  9.998875260e-01f, 1.499943808e-02f, 9.999644160e-01f, 8.435020223e-03f, 9.999887347e-01f, 4.743398633e-03f, 9.999964237e-01f, 2.667415887e-03f,
  -9.576594830e-01f, -2.879033089e-01f, -9.100810885e-01f, 4.144302309e-01f, 3.403181732e-01f, -9.403103590e-01f, -9.564100504e-01f, 2.920270860e-01f,
  -2.919954620e-02f, 9.995735884e-01f, 6.218088269e-01f, 7.831690907e-01f, 8.747074604e-01f, 4.846512377e-01f, 9.597951770e-01f, 2.807013094e-01f,
  9.872272611e-01f, 1.593182087e-01f, 9.959549904e-01f, 8.985326439e-02f, 9.987202883e-01f, 5.057485774e-02f, 9.995952845e-01f, 2.844863199e-02f,
  9.998720288e-01f, 1.599931903e-02f, 9.999595284e-01f, 8.997339755e-03f, 9.999871850e-01f, 5.059622694e-03f, 9.999959469e-01f, 2.845243318e-03f,
  -2.751633525e-01f, -9.613974690e-01f, -9.908979535e-01f, -1.346151382e-01f, 6.158648133e-01f, -7.878518701e-01f, -9.929850101e-01f, 1.182405204e-01f,
  -1.288445443e-01f, 9.916648269e-01f, 5.768082738e-01f, 8.168795705e-01f, 8.589466810e-01f, 5.120649934e-01f, 9.546520114e-01f, 2.977238595e-01f,
  9.855847955e-01f, 1.691823453e-01f, 9.954339862e-01f, 9.545248002e-02f, 9.985553622e-01f, 5.373282731e-02f, 9.995430708e-01f, 3.022614494e-02f,
  9.998555183e-01f, 1.699918136e-02f, 9.999542832e-01f, 9.559656493e-03f, 9.999855757e-01f, 5.375845823e-03f, 9.999954104e-01f, 3.023070283e-03f,
  6.603167057e-01f, -7.509872317e-01f, -7.665365338e-01f, -6.422007084e-01f, 8.303361535e-01f, -5.572628975e-01f, -9.982416630e-01f, -5.927551910e-02f,
  -2.272021621e-01f, 9.738476276e-01f, 5.299841762e-01f, 8.480075598e-01f, 8.423270583e-01f, 5.389667153e-01f, 9.492070079e-01f, 3.146522641e-01f,
  9.838436842e-01f, 1.790295690e-01f, 9.948815107e-01f, 1.010486856e-01f, 9.983804226e-01f, 5.689026415e-02f, 9.994877577e-01f, 3.200356290e-02f,
  9.998379946e-01f, 1.799902879e-02f, 9.999487996e-01f, 1.012197044e-02f, 9.999837875e-01f, 5.692068953e-03f, 9.999948740e-01f, 3.200897481e-03f,
  9.887046218e-01f, 1.498772055e-01f, -3.060953915e-01f, -9.520008564e-01f, 9.624637961e-01f, -2.714101076e-01f, -9.720142484e-01f, -2.349217981e-01f,
  -3.232895434e-01f, 9.463000894e-01f, 4.814845920e-01f, 8.764545321e-01f, 8.248651624e-01f, 5.653295517e-01f, 9.434618354e-01f, 3.314811885e-01f,
  9.820042253e-01f, 1.888588965e-01f, 9.942975044e-01f, 1.066416800e-01f, 9.981955290e-01f, 6.004713103e-02f, 9.994292855e-01f, 3.378088027e-02f,
  9.998195171e-01f, 1.899885759e-02f, 9.999428988e-01f, 1.068428159e-02f, 9.999819398e-01f, 6.008291151e-03f, 9.999942780e-01f, 3.378724447e-03f,
  4.080820680e-01f, 9.129452705e-01f, 2.486167252e-01f, -9.686019421e-01f, 9.991443753e-01f, 4.135828838e-02f, -9.151299596e-01f, -4.031589925e-01f,
  -4.161468446e-01f, 9.092974067e-01f, 4.314628243e-01f, 9.021307230e-01f, 8.065784574e-01f, 5.911270380e-01f, 9.374182820e-01f, 3.482052684e-01f,
  9.800665975e-01f, 1.986693144e-01f, 9.936820865e-01f, 1.122313142e-01f, 9.980006814e-01f, 6.320339441e-02f, 9.993675947e-01f, 3.555808961e-02f,
  9.998000264e-01f, 1.999866776e-02f, 9.999367595e-01f, 1.124658901e-02f, 9.999799728e-01f, 6.324512884e-03f, 9.999936819e-01f, 3.556551412e-03f,
  -5.477292538e-01f, 8.366556168e-01f, 7.267602682e-01f, -6.868911982e-01f, 9.367404580e-01f, 3.500247598e-01f, -8.293829560e-01f, -5.586805344e-01f,
  -5.048462152e-01f, 8.632093072e-01f, 3.800770044e-01f, 9.249548316e-01f, 7.874851823e-01f, 6.163335443e-01f, 9.310783744e-01f, 3.648192585e-01f,
  9.780309200e-01f, 2.084598988e-01f, 9.930352569e-01f, 1.178173944e-01f, 9.977958202e-01f, 6.635902822e-02f, 9.993028045e-01f, 3.733518720e-02f,
  9.997795224e-01f, 2.099845745e-02f, 9.999302626e-01f, 1.180889271e-02f, 9.999779463e-01f, 6.640734151e-03f, 9.999930263e-01f, 3.734378144e-03f,
  -9.999608397e-01f, -8.851309307e-03f, 9.810745716e-01f, -1.936302334e-01f, 7.814403772e-01f, 6.239799261e-01f, -7.174774408e-01f, -6.965817213e-01f,
  -5.885011554e-01f, 8.084963560e-01f, 3.274895847e-01f, 9.448547959e-01f, 7.676045895e-01f, 6.409237385e-01f, 9.244439602e-01f, 3.813178837e-01f,
  9.758974314e-01f, 2.182296216e-01f, 9.923570156e-01f, 1.233997419e-01f, 9.975810051e-01f, 6.951400638e-02f, 9.992348552e-01f, 3.911216930e-02f,
  9.997580051e-01f, 2.199822664e-02f, 9.999234676e-01f, 1.237119269e-02f, 9.999758005e-01f, 6.956954487e-03f, 9.999923706e-01f, 3.912204877e-03f,
  -5.328330398e-01f, -8.462204337e-01f, 9.332357645e-01f, 3.592645228e-01f, 5.486452579e-01f, 8.360552788e-01f, -5.829432607e-01f, -8.125128746e-01f,
  -6.662759781e-01f, 7.457052469e-01f, 2.738668323e-01f, 9.617676139e-01f, 7.469564080e-01f, 6.648730636e-01f, 9.175173044e-01f, 3.976959288e-01f,
  9.736663699e-01f, 2.279775143e-01f, 9.916474223e-01f, 1.289781928e-01f, 9.973561764e-01f, 7.266827673e-02f, 9.991636872e-01f, 4.088902473e-02f,
  9.997355342e-01f, 2.299797349e-02f, 9.999163747e-01f, 1.293348987e-02f, 9.999735355e-01f, 7.273174357e-03f, 9.999916553e-01f, 4.090031609e-03f,
  4.241790175e-01f, -9.055783749e-01f, 5.979771614e-01f, 8.015131354e-01f, 2.614416778e-01f, 9.652192593e-01f, -4.300232828e-01f, -9.028177857e-01f,
  -7.373937964e-01f, 6.754631400e-01f, 2.193782777e-01f, 9.756398797e-01f, 7.255613208e-01f, 6.881574988e-01f, 9.103004336e-01f, 4.139482081e-01f,
  9.713379741e-01f, 2.377026230e-01f, 9.909064770e-01f, 1.345525682e-01f, 9.971213937e-01f, 7.582182437e-02f, 9.990894198e-01f, 4.266574979e-02f,
  9.997119904e-01f, 2.399769612e-02f, 9.999089241e-01f, 1.349578146e-02f, 9.999712110e-01f, 7.589393295e-03f, 9.999908805e-01f, 4.267857410e-03f,
  9.912028313e-01f, -1.323517561e-01f, 7.855226099e-02f, 9.969099760e-01f, -5.168933049e-02f, 9.986631870e-01f, -2.635405958e-01f, -9.646483064e-01f,
  -8.011435866e-01f, 5.984721184e-01f, 1.641961634e-01f, 9.864277244e-01f, 7.034407258e-01f, 7.107539177e-01f, 9.027957320e-01f, 4.300695956e-01f,
  9.689124227e-01f, 2.474039644e-01f, 9.901341200e-01f, 1.401226968e-01f, 9.968766570e-01f, 7.897461206e-02f, 9.990119338e-01f, 4.444234073e-02f,
  9.996874928e-01f, 2.499739639e-02f, 9.999011755e-01f, 1.405806933e-02f, 9.999687672e-01f, 7.905611768e-03f, 9.999901056e-01f, 4.445684142e-03f,
  6.469193101e-01f, 7.625584602e-01f, -4.650644958e-01f, 8.852767944e-01f, -3.596943319e-01f, 9.330701828e-01f, -8.874550462e-02f, -9.960543513e-01f,
  -8.568888307e-01f, 5.155012608e-01f, 1.084949449e-01f, 9.940969944e-01f, 6.806167960e-01f, 7.326396108e-01f, 8.950055838e-01f, 4.460549951e-01f,
  9.663899541e-01f, 2.570805550e-01f, 9.893305302e-01f, 1.456883848e-01f, 9.966219068e-01f, 8.212661743e-02f, 9.989313483e-01f, 4.621879384e-02f,
  9.996620417e-01f, 2.599707060e-02f, 9.998931289e-01f, 1.462035347e-02f, 9.999662042e-01f, 8.221829310e-03f, 9.999893308e-01f, 4.623509943e-03f,
  -2.921388149e-01f, 9.563759565e-01f, -8.654506207e-01f, 5.009942055e-01f, -6.320286393e-01f, 7.749450207e-01f, 8.884811401e-02f, -9.960451722e-01f,
  -9.040721655e-01f, 4.273798466e-01f, 5.245061591e-02f, 9.986234903e-01f, 6.571123004e-01f, 7.537927032e-01f, 8.869323730e-01f, 4.618993104e-01f,
  9.637709260e-01f, 2.667314112e-01f, 9.884956479e-01f, 1.512494683e-01f, 9.963572025e-01f, 8.527779579e-02f, 9.988475442e-01f, 4.799510166e-02f,
  9.996355176e-01f, 2.699672058e-02f, 9.998847246e-01f, 1.518263202e-02f, 9.999635220e-01f, 8.538045920e-03f, 9.999884963e-01f, 4.801335745e-03f,
  -9.626058936e-01f, 2.709057927e-01f, -9.992933869e-01f, -3.758566082e-02f, -8.416849375e-01f, 5.399689674e-01f, 2.636395097e-01f, -9.646213055e-01f,
  -9.422222972e-01f, 3.349882066e-01f, -3.759419080e-03f, 9.999929070e-01f, 6.329506636e-01f, 7.741920948e-01f, 8.785787225e-01f, 4.775975943e-01f,
  9.610554576e-01f, 2.763556540e-01f, 9.876294732e-01f, 1.568057537e-01f, 9.960825443e-01f, 8.842811733e-02f, 9.987606406e-01f, 4.977125302e-02f,
  9.996080399e-01f, 2.799634263e-02f, 9.998760223e-01f, 1.574490592e-02f, 9.999607801e-01f, 8.854261599e-03f, 9.999876022e-01f, 4.979162011e-03f,
  -7.480575442e-01f, -6.636338830e-01f, -8.253716230e-01f, -5.645897985e-01f, -9.678714871e-01f, 2.514453232e-01f, 4.301158488e-01f, -9.027736783e-01f,
  -9.709581733e-01f, 2.392492294e-01f, -5.995756760e-02f, 9.982009530e-01f, 6.081562042e-01f, 7.938174009e-01f, 8.699471951e-01f, 4.931448400e-01f,
  9.582439065e-01f, 2.859522104e-01f, 9.867320657e-01f, 1.623570919e-01f, 9.957979321e-01f, 9.157756716e-02f, 9.986705780e-01f, 5.154724792e-02f,
  9.995795488e-01f, 2.899593674e-02f, 9.998670220e-01f, 1.630717516e-02f, 9.999579787e-01f, 9.170476347e-03f, 9.999867082e-01f, 5.156987347e-03f,
  1.542514563e-01f, -9.880316257e-01f, -3.972518742e-01f, -9.177096486e-01f, -9.980752468e-01f, -6.201484054e-02f, 5.830269456e-01f, -8.124528527e-01f,
  -9.899924994e-01f, 1.411200017e-01f, -1.159661636e-01f, 9.932531714e-01f, 5.827536583e-01f, 8.126488924e-01f, 8.610406518e-01f, 5.085361004e-01f,
  9.553365111e-01f, 2.955201864e-01f, 9.858034849e-01f, 1.679033041e-01f, 9.955033660e-01f, 9.472609311e-02f, 9.985772967e-01f, 5.332308263e-02f,
  9.995500445e-01f, 2.999550104e-02f, 9.998577237e-01f, 1.686943881e-02f, 9.999549985e-01f, 9.486690164e-03f, 9.999857545e-01f, 5.334813148e-03f,
  9.147423506e-01f, -4.040376544e-01f, 1.532154828e-01f, -9.881927967e-01f, -9.293003082e-01f, -3.693250120e-01f, 7.175492048e-01f, -6.965078115e-01f,
  -9.991351366e-01f, 4.158052057e-02f, -1.716081351e-01f, 9.851652980e-01f, 5.567683578e-01f, 8.306677938e-01f, 8.518617749e-01f, 5.237666368e-01f,
  9.523335695e-01f, 3.050586283e-01f, 9.848436713e-01f, 1.734442115e-01f, 9.951988459e-01f, 9.787366539e-02f, 9.984809160e-01f, 5.509874597e-02f,
  9.995195270e-01f, 3.099503554e-02f, 9.998480678e-01f, 1.743169688e-02f, 9.999519587e-01f, 9.802903049e-03f, 9.999848008e-01f, 5.512638018e-03f,
  8.342233896e-01f, 5.514267087e-01f, 6.564951539e-01f, -7.543302178e-01f, -7.683671117e-01f, -6.400094032e-01f, 8.294403553e-01f, -5.585952997e-01f,
  -9.982947707e-01f, -5.837419257e-02f, -2.267075777e-01f, 9.739628434e-01f, 5.302263498e-01f, 8.478561044e-01f, 8.424135447e-01f, 5.388315320e-01f,
  9.492354393e-01f, 3.145665526e-01f, 9.838528037e-01f, 1.789796203e-01f, 9.948843718e-01f, 1.010202691e-01f, 9.983813763e-01f, 5.687423423e-02f,
  9.994880557e-01f, 3.199454024e-02f, 9.998381138e-01f, 1.799395122e-02f, 9.999487996e-01f, 1.011911593e-02f, 9.999837875e-01f, 5.690463353e-03f,
  -1.327674743e-02f, 9.999118447e-01f, 9.575860500e-01f, -2.881473899e-01f, -5.312352777e-01f, -8.472243547e-01f, 9.151713848e-01f, -4.030649364e-01f,
  -9.874798059e-01f, -1.577456445e-01f, -2.810903192e-01f, 9.596813321e-01f, 5.031541586e-01f, 8.641966581e-01f, 8.326989412e-01f, 5.537260175e-01f,
  9.460423589e-01f, 3.240430057e-01f, 9.828307629e-01f, 1.845093668e-01f, 9.945599437e-01f, 1.041658595e-01f, 9.982786179e-01f, 5.864954367e-02f,
  9.994555712e-01f, 3.299400955e-02f, 9.998278022e-01f, 1.855619811e-02f, 9.999455214e-01f, 1.043532696e-02f, 9.999827743e-01f, 5.868288688e-03f,
  -8.485702872e-01f, 5.290827155e-01f, 9.637575150e-01f, 2.667797208e-01f, -2.414211184e-01f, -9.704204202e-01f, 9.720383286e-01f, -2.348221242e-01f,
  -9.667981863e-01f, -2.555412054e-01f, -3.345843852e-01f, 9.423658252e-01f, 4.755789042e-01f, 8.796730638e-01f, 8.227210045e-01f, 5.684453845e-01f,
  9.427546859e-01f, 3.334870934e-01f, 9.817776680e-01f, 1.900332868e-01f, 9.942255616e-01f, 1.073104069e-01f, 9.981727600e-01f, 6.042466685e-02f,
  9.994220734e-01f, 3.399345279e-02f, 9.998172522e-01f, 1.911843941e-02f, 9.999421835e-01f, 1.075153705e-02f, 9.999817014e-01f, 6.046113092e-03f,
  -9.036921859e-01f, -4.281826615e-01f, 6.731102467e-01f, 7.395421267e-01f, 7.233466953e-02f, -9.973804355e-01f, 9.982477427e-01f, -5.917267874e-02f,
  -9.364566803e-01f, -3.507832289e-01f, -3.870206773e-01f, 9.220710397e-01f, 4.475280643e-01f, 8.942698836e-01f, 8.124829531e-01f, 5.829849839e-01f,
  9.393727183e-01f, 3.428978026e-01f, 9.806935191e-01f, 1.955512017e-01f, 9.938812256e-01f, 1.104538813e-01f, 9.980637431e-01f, 6.219960377e-02f,
  9.993875623e-01f, 3.499285504e-02f, 9.998063445e-01f, 1.968067512e-02f, 9.999387264e-01f, 1.106774528e-02f, 9.999806285e-01f, 6.223937962e-03f,
  -1.279636919e-01f, -9.917788506e-01f, 1.751565337e-01f, 9.845405817e-01f, 3.789161742e-01f, -9.254310131e-01f, 9.929728508e-01f, 1.183425859e-01f,
  -8.967583776e-01f, -4.425205588e-01f, -4.382335544e-01f, 8.988611698e-01f, 4.190297425e-01f, 9.079725146e-01f, 8.019878864e-01f, 5.973402858e-01f,
  9.358968139e-01f, 3.522742093e-01f, 9.795783162e-01f, 2.010629177e-01f, 9.935269952e-01f, 1.135962531e-01f, 9.979515672e-01f, 6.397433579e-02f,
  9.993520975e-01f, 3.599222749e-02f, 9.997950792e-01f, 2.024290524e-02f, 9.999352098e-01f, 1.138395350e-02f, 9.999794960e-01f, 6.401761901e-03f,
  7.654140592e-01f, -6.435381174e-01f, -3.767423034e-01f, 9.263181090e-01f, 6.479216814e-01f, -7.617069483e-01f, 9.563800097e-01f, 2.921253741e-01f,
  -8.481000066e-01f, -5.298361778e-01f, -4.880608618e-01f, 8.728095889e-01f, 3.901124299e-01f, 9.207672477e-01f, 7.912392616e-01f, 6.115067005e-01f,
  9.323273301e-01f, 3.616154492e-01f, 9.784321785e-01f, 2.065682709e-01f, 9.931628108e-01f, 1.167374924e-01f, 9.978361726e-01f, 6.574887782e-02f,
  9.993155599e-01f, 3.699155897e-02f, 9.997835755e-01f, 2.080512606e-02f, 9.999315739e-01f, 1.170015987e-02f, 9.999783635e-01f, 6.579586305e-03f,
  9.550736547e-01f, 2.963685691e-01f, -8.126112223e-01f, 5.828061700e-01f, 8.526731133e-01f, -5.224447846e-01f, 8.896234632e-01f, 4.566946924e-01f,
  -7.909677625e-01f, -6.118578315e-01f, -5.363451838e-01f, 8.439987302e-01f, 3.608050346e-01f, 9.326412678e-01f, 7.802404165e-01f, 6.254796982e-01f,
  9.286646247e-01f, 3.709204793e-01f, 9.772551060e-01f, 2.120671123e-01f, 9.927886724e-01f, 1.198775545e-01f, 9.977176785e-01f, 6.752320379e-02f,
  9.992780685e-01f, 3.799085692e-02f, 9.997717142e-01f, 2.136734314e-02f, 9.999278188e-01f, 1.201636530e-02f, 9.999771714e-01f, 6.757410709e-03f,
  2.666429281e-01f, 9.637953639e-01f, -9.982103705e-01f, 5.980031565e-02f, 9.728653431e-01f, -2.313720137e-01f, 7.948083878e-01f, 6.068604589e-01f,
  -7.259322405e-01f, -6.877662539e-01f, -5.829339027e-01f, 8.125196099e-01f, 3.311368525e-01f, 9.435827136e-01f, 7.689949274e-01f, 6.392549276e-01f,
  9.249090552e-01f, 3.801884055e-01f, 9.760470986e-01f, 2.175592482e-01f, 9.924046397e-01f, 1.230164245e-01f, 9.975960255e-01f, 6.929731369e-02f,
  9.992396235e-01f, 3.899011388e-02f, 9.997594953e-01f, 2.192955278e-02f, 9.999239445e-01f, 1.233256981e-02f, 9.999759793e-01f, 6.935234182e-03f,
  -6.669380665e-01f, 7.451131344e-01f, -8.763794303e-01f, -4.816212952e-01f, 9.965789914e-01f, 8.264580369e-02f, 6.749256253e-01f, 7.378857136e-01f,
  -6.536436081e-01f, -7.568024993e-01f, -6.276797056e-01f, 7.784717083e-01f, 3.011375964e-01f, 9.535806775e-01f, 7.575061917e-01f, 6.528279781e-01f,
  9.210609794e-01f, 3.894183338e-01f, 9.748082757e-01f, 2.230444849e-01f, 9.920106530e-01f, 1.261540651e-01f, 9.974712729e-01f, 7.107120752e-02f,
  9.992001057e-01f, 3.998933733e-02f, 9.997470379e-01f, 2.249175683e-02f, 9.999200106e-01f, 1.264877338e-02f, 9.999747276e-01f, 7.113057654e-03f,
  -9.873392582e-01f, -1.586226672e-01f, -4.846394062e-01f, -8.747140169e-01f, 9.214623570e-01f, 3.884676993e-01f, 5.337560773e-01f, 8.456384540e-01f,
  -5.748240352e-01f, -8.182770610e-01f, -6.704410911e-01f, 7.419627905e-01f, 2.708370686e-01f, 9.626252055e-01f, 7.457779050e-01f, 6.661946774e-01f,
  9.171208143e-01f, 3.986093104e-01f, 9.735385776e-01f, 2.285226882e-01f, 9.916067719e-01f, 1.292904317e-01f, 9.973433018e-01f, 7.284487784e-02f,
  9.991596341e-01f, 4.098851606e-02f, 9.997342229e-01f, 2.305394970e-02f, 9.999159575e-01f, 1.296497509e-02f, 9.999734163e-01f, 7.290880661e-03f,
  -3.999853134e-01f, -9.165215492e-01f, 5.636094138e-02f, -9.984104633e-01f, 7.549653649e-01f, 6.557646990e-01f, 3.757521510e-01f, 9.267202020e-01f,
  -4.902605712e-01f, -8.715758920e-01f, -7.110829353e-01f, 7.031081319e-01f, 2.402658761e-01f, 9.707071185e-01f, 7.338138223e-01f, 6.793506742e-01f,
  9.130889177e-01f, 4.077604413e-01f, 9.722381234e-01f, 2.339936644e-01f, 9.911929369e-01f, 1.324255317e-01f, 9.972121716e-01f, 7.461831719e-02f,
  9.991181493e-01f, 4.198765755e-02f, 9.997211099e-01f, 2.361613885e-02f, 9.999117851e-01f, 1.328117587e-02f, 9.999721050e-01f, 7.468704134e-03f,
  5.551133156e-01f, -8.317747712e-01f, 5.800031424e-01f, -8.146142364e-01f, 5.135984421e-01f, 8.580306768e-01f, 2.058971673e-01f, 9.785736203e-01f,
  -4.007990062e-01f, -9.161660075e-01f, -7.494767308e-01f, 6.620306373e-01f, 2.094544172e-01f, 9.778184295e-01f, 7.216176391e-01f, 6.922917962e-01f,
  9.089657664e-01f, 4.168707728e-01f, 9.709069133e-01f, 2.394572198e-01f, 9.907692075e-01f, 1.355592906e-01f, 9.970778823e-01f, 7.639151812e-02f,
  9.990756512e-01f, 4.298675060e-02f, 9.997076392e-01f, 2.417832054e-02f, 9.999075532e-01f, 1.359737478e-02f, 9.999707937e-01f, 7.646527141e-03f,
  9.998432994e-01f, 1.770192571e-02f, 9.250146747e-01f, -3.799313903e-01f, 2.212981731e-01f, 9.752061963e-01f, 2.954781987e-02f, 9.995633960e-01f,
  -3.073327839e-01f, -9.516021013e-01f, -7.855011225e-01f, 6.188601851e-01f, 1.784335226e-01f, 9.839519858e-01f, 7.091933489e-01f, 7.050140500e-01f,
  9.047516584e-01f, 4.259394705e-01f, 9.695450068e-01f, 2.449132055e-01f, 9.903355837e-01f, 1.386916935e-01f, 9.969404936e-01f, 7.816448808e-02f,
  9.990321398e-01f, 4.398580641e-02f, 9.996939301e-01f, 2.474049293e-02f, 9.999032021e-01f, 1.391357277e-02f, 9.999693632e-01f, 7.824349217e-03f,
  5.253219604e-01f, 8.509035110e-01f, 9.851381779e-01f, 1.717635691e-01f, -9.294810891e-02f, 9.956709743e-01f, -1.477329880e-01f, 9.890272617e-01f,
  -2.107958049e-01f, -9.775301218e-01f, -8.190422058e-01f, 5.737332702e-01f, 1.472342163e-01f, 9.891016483e-01f, 6.965447664e-01f, 7.175133228e-01f,
  9.004471302e-01f, 4.349655211e-01f, 9.681524038e-01f, 2.503614724e-01f, 9.898920655e-01f, 1.418227106e-01f, 9.967998862e-01f, 7.993719727e-02f,
  9.989876747e-01f, 4.498481750e-02f, 9.996798635e-01f, 2.530265786e-02f, 9.998987317e-01f, 1.422976889e-02f, 9.999679923e-01f, 8.002171293e-03f,
  -4.321779311e-01f, 9.017883539e-01f, 7.418580055e-01f, 6.705570221e-01f, -3.979767561e-01f, 9.173954725e-01f, -3.203543723e-01f, 9.472977519e-01f,
  -1.121526212e-01f, -9.936909676e-01f, -8.499938846e-01f, 5.267925262e-01f, 1.158876941e-01f, 9.932623506e-01f, 6.836758852e-01f, 7.297857404e-01f,
  8.960524797e-01f, 4.439480901e-01f, 9.667292237e-01f, 2.558017969e-01f, 9.894386530e-01f, 1.449523121e-01f, 9.966561794e-01f, 8.170966059e-02f,
  9.989421964e-01f, 4.598378390e-02f, 9.996654391e-01f, 2.586481534e-02f, 9.998942018e-01f, 1.454596408e-02f, 9.999665618e-01f, 8.179994300e-03f,
  -9.923354983e-01f, 1.235731244e-01f, 2.700984478e-01f, 9.628326893e-01f, -6.635382771e-01f, 7.481423616e-01f, -4.828719497e-01f, 8.756909966e-01f,
  -1.238837745e-02f, -9.999232888e-01f, -8.782584071e-01f, 4.781863391e-01f, 8.442528546e-02f, 9.964298010e-01f, 6.705908775e-01f, 7.418274283e-01f,
  8.915683031e-01f, 4.528862834e-01f, 9.652754664e-01f, 2.612340748e-01f, 9.889753461e-01f, 1.480804533e-01f, 9.965093136e-01f, 8.348185569e-02f,
  9.988957047e-01f, 4.698270187e-02f, 9.996507764e-01f, 2.642696351e-02f, 9.998895526e-01f, 1.486215740e-02f, 9.999650717e-01f, 8.357816376e-03f,
  -6.401443481e-01f, -7.682546377e-01f, -2.848466039e-01f, 9.585731030e-01f, -8.632965088e-01f, 5.046970844e-01f, -6.301599741e-01f, 7.764653563e-01f,
  8.749917150e-02f, -9.961646199e-01f, -9.037463665e-01f, 4.280683994e-01f, 5.287845805e-02f, 9.986009598e-01f, 6.572937369e-01f, 7.536345124e-01f,
  8.869948983e-01f, 4.617791772e-01f, 9.637911916e-01f, 2.666580379e-01f, 9.885020852e-01f, 1.512071192e-01f, 9.963592887e-01f, 8.525379747e-02f,
  9.988481998e-01f, 4.798157141e-02f, 9.996357560e-01f, 2.698910423e-02f, 9.998847842e-01f, 1.517834887e-02f, 9.999635816e-01f, 8.535637520e-03f,
  3.005925417e-01f, -9.537526369e-01f, -7.520639896e-01f, 6.590901017e-01f, -9.774427414e-01f, 2.112006545e-01f, -7.575730681e-01f, 6.527503729e-01f,
  1.865124702e-01f, -9.824525714e-01f, -9.263771176e-01f, 3.765971363e-01f, 2.127875760e-02f, 9.997735620e-01f, 6.437888145e-01f, 7.652031779e-01f,
  8.823328614e-01f, 4.706258774e-01f, 9.622764587e-01f, 2.720735669e-01f, 9.880189896e-01f, 1.543322802e-01f, 9.962061048e-01f, 8.702547103e-02f,
  9.987997413e-01f, 4.898039624e-02f, 9.996203780e-01f, 2.755123749e-02f, 9.998799562e-01f, 1.549453940e-02f, 9.999620318e-01f, 8.713459596e-03f,
  9.649659991e-01f, -2.623748481e-01f, -9.876590967e-01f, 1.566190720e-01f, -9.946564436e-01f, -1.032404602e-01f, -8.610926867e-01f, 5.084479451e-01f,
  2.836622000e-01f, -9.589242935e-01f, -9.460792542e-01f, 3.239352703e-01f, -1.034221891e-02f, 9.999465346e-01f, 6.300802827e-01f, 7.765299678e-01f,
  8.775825500e-01f, 4.794255495e-01f, 9.607312679e-01f, 2.774805427e-01f, 9.875259995e-01f, 1.574558914e-01f, 9.960497618e-01f, 8.879686147e-02f,
  9.987502694e-01f, 4.997916892e-02f, 9.996047616e-01f, 2.811335959e-02f, 9.998750091e-01f, 1.581072807e-02f, 9.999604821e-01f, 8.891279809e-03f,
  7.421541810e-01f, 6.702291965e-01f, -9.190735221e-01f, -3.940860629e-01f, -9.132301211e-01f, -4.074441493e-01f, -9.374542236e-01f, 3.481085002e-01f,
  3.779776692e-01f, -9.258147478e-01f, -9.627903700e-01f, 2.702493370e-01f, -4.195285589e-02f, 9.991195798e-01f, 6.161724925e-01f, 7.876111865e-01f,
  8.727445006e-01f, 4.881772399e-01f, 9.591556787e-01f, 2.828786969e-01f, 9.870231748e-01f, 1.605779380e-01f, 9.958902597e-01f, 9.056797624e-02f,
  9.986997843e-01f, 5.097789690e-02f, 9.995887876e-01f, 2.867547423e-02f, 9.998699427e-01f, 1.612691768e-02f, 9.999588728e-01f, 9.069100954e-03f,
  -1.629907787e-01f, 9.866275787e-01f, -5.674300194e-01f, -8.234215975e-01f, -7.412399650e-01f, -6.712401509e-01f, -9.842484593e-01f, 1.767906845e-01f,
  4.685169160e-01f, -8.834545016e-01f, -9.764577150e-01f, 2.157090008e-01f, -7.352153957e-02f, 9.972936511e-01f, 6.020699143e-01f, 7.984433770e-01f,
  8.678191900e-01f, 4.968801141e-01f, 9.575498104e-01f, 2.882679403e-01f, 9.865104556e-01f, 1.636983752e-01f, 9.957276583e-01f, 9.233880043e-02f,
  9.986482859e-01f, 5.197656900e-02f, 9.995725155e-01f, 2.923758142e-02f, 9.998648167e-01f, 1.644310169e-02f, 9.999572635e-01f, 9.246920235e-03f,
  -9.182828069e-01f, 3.959251642e-01f, -4.102819040e-02f, -9.991579652e-01f, -4.957418144e-01f, -8.684699535e-01f, -1.000000000e+00f, -1.030206768e-04f,
  5.543745160e-01f, -8.322673440e-01f, -9.870380163e-01f, 1.604867280e-01f, -1.050167084e-01f, 9.944704771e-01f, 5.877769589e-01f, 8.090230227e-01f,
  8.628070951e-01f, 5.055333376e-01f, 9.559136033e-01f, 2.936480343e-01f, 9.859878421e-01f, 1.668171734e-01f, 9.955618382e-01f, 9.410934150e-02f,
  9.985958338e-01f, 5.297519267e-02f, 9.995558858e-01f, 2.979967557e-02f, 9.998595715e-01f, 1.675928757e-02f, 9.999555945e-01f, 9.424741380e-03f,
  -8.293098211e-01f, -5.587890744e-01f, 4.980095923e-01f, -8.671715260e-01f, -2.010796219e-01f, -9.795749187e-01f, -9.842120409e-01f, -1.769934744e-01f,
  6.346929669e-01f, -7.727644444e-01f, -9.944978952e-01f, 1.047568321e-01f, -1.364068687e-01f, 9.906529188e-01f, 5.732980371e-01f, 8.193469048e-01f,
  8.577086926e-01f, 5.141359568e-01f, 9.542471766e-01f, 2.990188897e-01f, 9.854553938e-01f, 1.699342877e-01f, 9.953929186e-01f, 9.587957710e-02f,
  9.985423684e-01f, 5.397376046e-02f, 9.995389581e-01f, 3.036176413e-02f, 9.998542070e-01f, 1.707546785e-02f, 9.999538660e-01f, 9.602561593e-03f,
  2.212675661e-02f, -9.997551441e-01f, 8.836693168e-01f, -4.681116641e-01f, 1.135217771e-01f, -9.935355186e-01f, -9.373825192e-01f, -3.483016491e-01f,
  7.086697817e-01f, -7.055402994e-01f, -9.988136292e-01f, 4.869600013e-02f, -1.676606387e-01f, 9.858447909e-01f, 5.586379170e-01f, 8.294116855e-01f,
  8.525245190e-01f, 5.226872563e-01f, 9.525505900e-01f, 3.043802381e-01f, 9.849131107e-01f, 1.730497181e-01f, 9.952208400e-01f, 9.764950722e-02f,
  9.984878898e-01f, 5.497227982e-02f, 9.995217323e-01f, 3.092384152e-02f, 9.998487830e-01f, 1.739165001e-02f, 9.999521971e-01f, 9.780380875e-03f,
  8.532201052e-01f, -5.215510130e-01f, 9.971746206e-01f, 7.511820644e-02f, 4.168670774e-01f, -9.089674354e-01f, -8.609884381e-01f, -5.086245537e-01f,
  7.755658031e-01f, -6.312667131e-01f, -9.999717474e-01f, -7.518785074e-03f, -1.987468749e-01f, 9.800508618e-01f, 5.438010693e-01f, 8.392141461e-01f,
  8.472551107e-01f, 5.311862230e-01f, 9.508239031e-01f, 3.097319603e-01f, 9.843609333e-01f, 1.761634201e-01f, 9.950456619e-01f, 9.941913933e-02f,
  9.984323978e-01f, 5.597073585e-02f, 9.995042086e-01f, 3.148590773e-02f, 9.998431802e-01f, 1.770782843e-02f, 9.999504089e-01f, 9.958200157e-03f,
  8.998668194e-01f, 4.361647666e-01f, 8.035690784e-01f, 5.952115059e-01f, 6.788702011e-01f, -7.342582941e-01f, -7.574391961e-01f, -6.529057026e-01f,
  8.347129226e-01f, -5.506852865e-01f, -9.979684949e-01f, -6.370979548e-02f, -2.296342701e-01f, 9.732769728e-01f, 5.287923217e-01f, 8.487512469e-01f,
  8.419010043e-01f, 5.396320224e-01f, 9.490671158e-01f, 3.150739372e-01f, 9.837989211e-01f, 1.792753637e-01f, 9.948672652e-01f, 1.011884511e-01f,
  9.983759522e-01f, 5.696914345e-02f, 9.994863272e-01f, 3.204796836e-02f, 9.998375773e-01f, 1.802400686e-02f, 9.999486208e-01f, 1.013601944e-02f,
  1.191801354e-01f, 9.928726554e-01f, 3.624766767e-01f, 9.319928288e-01f, 8.735505342e-01f, -4.867334962e-01f, -6.300007105e-01f, -7.765945792e-01f,
  8.855196238e-01f, -4.646020234e-01f, -9.928101897e-01f, -1.196993962e-01f, -2.602920532e-01f, 9.655299187e-01f, 5.136163235e-01f, 8.580200076e-01f,
  8.364626765e-01f, 5.480239391e-01f, 9.472803473e-01f, 3.204059005e-01f, 9.832270741e-01f, 1.823855042e-01f, 9.946857691e-01f, 1.029574350e-01f,
  9.983184934e-01f, 5.796748772e-02f, 9.994681478e-01f, 3.261001408e-02f, 9.998317957e-01f, 1.834018156e-02f, 9.999468327e-01f, 1.031383779e-02f,
  -7.710801959e-01f, 6.367380023e-01f, -1.902491003e-01f, 9.817358255e-01f, 9.816020727e-01f, -1.909380108e-01f, -4.826923311e-01f, -8.757900000e-01f,
  9.274784923e-01f, -3.738765717e-01f, -9.845131636e-01f, -1.753105819e-01f, -2.906895578e-01f, 9.568174481e-01f, 4.982779026e-01f, 8.670173883e-01f,
  8.309407234e-01f, 5.563610196e-01f, 9.454635978e-01f, 3.257277906e-01f, 9.826454520e-01f, 1.854938269e-01f, 9.945011139e-01f, 1.047261059e-01f,
  9.982600212e-01f, 5.896577984e-02f, 9.994496703e-01f, 3.317204863e-02f, 9.998259544e-01f, 1.865635626e-02f, 9.999449849e-01f, 1.049165614e-02f,
  -9.524129629e-01f, -3.048106134e-01f, -6.843819022e-01f, 7.291237116e-01f, 9.923083186e-01f, 1.237909496e-01f, -3.201591671e-01f, -9.473637342e-01f,
  9.601702690e-01f, -2.794154882e-01f, -9.731037021e-01f, -2.303675115e-01f, -3.207964003e-01f, 9.471482038e-01f, 4.827820361e-01f, 8.757405281e-01f,
  8.253356218e-01f, 5.646424294e-01f, 9.436169863e-01f, 3.310393095e-01f, 9.820539355e-01f, 1.886002868e-01f, 9.943132997e-01f, 1.064944416e-01f,
  9.982005358e-01f, 5.996400863e-02f, 9.994308352e-01f, 3.373407945e-02f, 9.998199940e-01f, 1.897252724e-02f, 9.999430776e-01f, 1.066947449e-02f,
  -2.581016421e-01f, -9.661177993e-01f, -9.677396417e-01f, 2.519522607e-01f, 9.046075940e-01f, 4.262454212e-01f, -1.475291997e-01f, -9.890577197e-01f,
  9.832684398e-01f, -1.821625978e-01f, -9.586178064e-01f, -2.846961617e-01f, -3.505824506e-01f, 9.365318418e-01f, 4.671334028e-01f, 8.841868639e-01f,
  8.196480274e-01f, 5.728674531e-01f, 9.417404532e-01f, 3.363404274e-01f, 9.814526439e-01f, 1.917048544e-01f, 9.941223264e-01f, 1.082624346e-01f,
  9.981400967e-01f, 6.096218154e-02f, 9.994117022e-01f, 3.429609165e-02f, 9.998139739e-01f, 1.928869821e-02f, 9.999411702e-01f, 1.084729191e-02f,
  6.735071540e-01f, -7.391806841e-01f, -9.530500174e-01f, -3.028128743e-01f, 7.271980643e-01f, 6.864276528e-01f, 2.975377068e-02f, -9.995572567e-01f,
  9.965420961e-01f, -8.308912069e-02f, -9.411013126e-01f, -3.381247520e-01f, -3.800179660e-01f, 9.249790907e-01f, 4.513370395e-01f, 8.923535347e-01f,
  8.138784766e-01f, 5.810351372e-01f, 9.398342371e-01f, 3.416308761e-01f, 9.808415174e-01f, 1.948075294e-01f, 9.939282537e-01f, 1.100300923e-01f,
  9.980786443e-01f, 6.196028739e-02f, 9.993922710e-01f, 3.485809639e-02f, 9.998078346e-01f, 1.960486546e-02f, 9.999392033e-01f, 1.102510840e-02f,
  9.858965874e-01f, 1.673557013e-01f, -6.448370218e-01f, -7.643200755e-01f, 4.776714444e-01f, 8.785385489e-01f, 2.060983330e-01f, -9.785313010e-01f,
  9.998586178e-01f, 1.681409031e-02f, -9.206095338e-01f, -3.904843926e-01f, -4.090735018e-01f, 9.125014544e-01f, 4.353979528e-01f, 9.002380967e-01f,
  8.080275059e-01f, 5.891447663e-01f, 9.378982186e-01f, 3.469105363e-01f, 9.802205563e-01f, 1.979082376e-01f, 9.937310219e-01f, 1.117973924e-01f,
  9.980161786e-01f, 6.295833737e-02f, 9.993724823e-01f, 3.542009369e-02f, 9.998015761e-01f, 1.992103085e-02f, 9.999372363e-01f, 1.120292582e-02f,
};
__device__ const float ROPE32[1024] = {
  1.000000000e+00f, 0.000000000e+00f, 1.000000000e+00f, 0.000000000e+00f, 1.000000000e+00f, 0.000000000e+00f, 1.000000000e+00f, 0.000000000e+00f,
  1.000000000e+00f, 0.000000000e+00f, 1.000000000e+00f, 0.000000000e+00f, 1.000000000e+00f, 0.000000000e+00f, 1.000000000e+00f, 0.000000000e+00f,
  5.403022766e-01f, 8.414709568e-01f, 9.504152536e-01f, 3.109835982e-01f, 9.950041771e-01f, 9.983342141e-02f, 9.995000362e-01f, 3.161750361e-02f,
  9.999499917e-01f, 9.999833070e-03f, 9.999949932e-01f, 3.162272274e-03f, 9.999995232e-01f, 9.999999311e-04f, 9.999999404e-01f, 3.162277571e-04f,
  -4.161468446e-01f, 9.092974067e-01f, 8.065783978e-01f, 5.911270976e-01f, 9.800665975e-01f, 1.986693293e-01f, 9.980006814e-01f, 6.320339441e-02f,
  9.998000264e-01f, 1.999866590e-02f, 9.999799728e-01f, 6.324512884e-03f, 9.999979734e-01f, 1.999998698e-03f, 9.999998212e-01f, 6.324554561e-04f,
  -9.899924994e-01f, 1.411200017e-01f, 5.827536583e-01f, 8.126488924e-01f, 9.553365111e-01f, 2.955202162e-01f, 9.955033660e-01f, 9.472608566e-02f,
  9.995500445e-01f, 2.999549918e-02f, 9.999549985e-01f, 9.486690164e-03f, 9.999955297e-01f, 2.999995602e-03f, 9.999995232e-01f, 9.486831259e-04f,
  -6.536436081e-01f, -7.568024993e-01f, 3.011374772e-01f, 9.535807371e-01f, 9.210609794e-01f, 3.894183338e-01f, 9.920106530e-01f, 1.261540651e-01f,
  9.992001057e-01f, 3.998933360e-02f, 9.999200106e-01f, 1.264877338e-02f, 9.999920130e-01f, 3.999989480e-03f, 9.999992251e-01f, 1.264910679e-03f,
  2.836622000e-01f, -9.589242935e-01f, -1.034233812e-02f, 9.999465346e-01f, 8.775825500e-01f, 4.794255495e-01f, 9.875259995e-01f, 1.574558765e-01f,
  9.987502694e-01f, 4.997916520e-02f, 9.998750091e-01f, 1.581072807e-02f, 9.999874830e-01f, 4.999979399e-03f, 9.999987483e-01f, 1.581138116e-03f,
  9.601702690e-01f, -2.794154882e-01f, -3.207964003e-01f, 9.471482038e-01f, 8.253356218e-01f, 5.646424890e-01f, 9.820539355e-01f, 1.886002719e-01f,
  9.982005358e-01f, 5.996400490e-02f, 9.998199940e-01f, 1.897252724e-02f, 9.999819994e-01f, 5.999964196e-03f, 9.999982119e-01f, 1.897365320e-03f,
  7.539022565e-01f, 6.569865942e-01f, -5.994374752e-01f, 8.004215956e-01f, 7.648422122e-01f, 6.442176700e-01f, 9.755998850e-01f, 2.195560932e-01f,
  9.975510240e-01f, 6.994284689e-02f, 9.997550249e-01f, 2.213413455e-02f, 9.999755025e-01f, 6.999942940e-03f, 9.999975562e-01f, 2.213592408e-03f,
  -1.455000341e-01f, 9.893582463e-01f, -8.186324239e-01f, 5.743177533e-01f, 6.967067122e-01f, 7.173560858e-01f, 9.681702852e-01f, 2.502923310e-01f,
  9.968017340e-01f, 7.991468906e-02f, 9.996800423e-01f, 2.529552206e-02f, 9.999679923e-01f, 7.999914698e-03f, 9.999967813e-01f, 2.529819263e-03f,
  -9.111302495e-01f, 4.121184945e-01f, -9.566441774e-01f, 2.912592292e-01f, 6.216099262e-01f, 7.833269238e-01f, 9.597726464e-01f, 2.807783186e-01f,
  9.959527254e-01f, 8.987854421e-02f, 9.995950460e-01f, 2.845665626e-02f, 9.999595284e-01f, 8.999879472e-03f, 9.999959469e-01f, 2.846045885e-03f,
  -8.390715122e-01f, -5.440211296e-01f, -9.997860789e-01f, -2.068356983e-02f, 5.403022766e-01f, 8.414709568e-01f, 9.504153132e-01f, 3.109835684e-01f,
  9.950041771e-01f, 9.983341396e-02f, 9.995000362e-01f, 3.161750361e-02f, 9.999499917e-01f, 9.999834001e-03f, 9.999949932e-01f, 3.162272274e-03f,
  4.425697960e-03f, -9.999902248e-01f, -9.437797666e-01f, -3.305749595e-01f, 4.535960853e-01f, 8.912073970e-01f, 9.401075840e-01f, 3.408778608e-01f,
  9.939560890e-01f, 1.097782999e-01f, 9.993950725e-01f, 3.477803990e-02f, 9.999395013e-01f, 1.099977922e-02f, 9.999939203e-01f, 3.478498431e-03f,
  8.438539505e-01f, -5.365729332e-01f, -7.941793799e-01f, -6.076834202e-01f, 3.623577058e-01f, 9.320390821e-01f, 9.288598895e-01f, 3.704313040e-01f,
  9.928086400e-01f, 1.197122037e-01f, 9.992800951e-01f, 3.793822229e-02f, 9.999279976e-01f, 1.199971233e-02f, 9.999927878e-01f, 3.794723889e-03f,
  9.074468017e-01f, 4.201670289e-01f, -5.658205152e-01f, -8.245284557e-01f, 2.674987614e-01f, 9.635581970e-01f, 9.166833758e-01f, 3.996143043e-01f,
  9.915618896e-01f, 1.296341419e-01f, 9.991551042e-01f, 4.109803215e-02f, 9.999154806e-01f, 1.299963426e-02f, 9.999915361e-01f, 4.110949114e-03f,
  1.367372125e-01f, 9.906073809e-01f, -2.813494802e-01f, -9.596053958e-01f, 1.699671596e-01f, 9.854497313e-01f, 9.035902619e-01f, 4.283977747e-01f,
  9.902160168e-01f, 1.395431161e-01f, 9.990201592e-01f, 4.425742477e-02f, 9.999020100e-01f, 1.399954315e-02f, 9.999902248e-01f, 4.427174106e-03f,
  -7.596879005e-01f, 6.502878666e-01f, 3.102235124e-02f, -9.995186925e-01f, 7.073719800e-02f, 9.974949956e-01f, 8.895936012e-01f, 4.567528665e-01f,
  9.887710810e-01f, 1.494381279e-01f, 9.988752007e-01f, 4.741638154e-02f, 9.998875260e-01f, 1.499943808e-02f, 9.999887347e-01f, 4.743398633e-03f,
  -9.576594830e-01f, -2.879033089e-01f, 3.403181732e-01f, -9.403103590e-01f, -2.919954620e-02f, 9.995735884e-01f, 8.747074604e-01f, 4.846512377e-01f,
  9.872272611e-01f, 1.593182087e-01f, 9.987202883e-01f, 5.057485774e-02f, 9.998720288e-01f, 1.599931903e-02f, 9.999871850e-01f, 5.059622694e-03f,
  -2.751633525e-01f, -9.613974690e-01f, 6.158648133e-01f, -7.878518701e-01f, -1.288445443e-01f, 9.916648269e-01f, 8.589466810e-01f, 5.120649934e-01f,
  9.855847955e-01f, 1.691823453e-01f, 9.985553622e-01f, 5.373282731e-02f, 9.998555183e-01f, 1.699918136e-02f, 9.999855757e-01f, 5.375845823e-03f,
  6.603167057e-01f, -7.509872317e-01f, 8.303361535e-01f, -5.572628975e-01f, -2.272021621e-01f, 9.738476276e-01f, 8.423270583e-01f, 5.389667153e-01f,
  9.838436842e-01f, 1.790295690e-01f, 9.983804226e-01f, 5.689026415e-02f, 9.998379946e-01f, 1.799902879e-02f, 9.999837875e-01f, 5.692068953e-03f,
  9.887046218e-01f, 1.498772055e-01f, 9.624637961e-01f, -2.714101076e-01f, -3.232895434e-01f, 9.463000894e-01f, 8.248651624e-01f, 5.653295517e-01f,
  9.820042253e-01f, 1.888588965e-01f, 9.981955290e-01f, 6.004713103e-02f, 9.998195171e-01f, 1.899885759e-02f, 9.999819398e-01f, 6.008291151e-03f,
  4.080820680e-01f, 9.129452705e-01f, 9.991443753e-01f, 4.135828838e-02f, -4.161468446e-01f, 9.092974067e-01f, 8.065784574e-01f, 5.911270380e-01f,
  9.800665975e-01f, 1.986693144e-01f, 9.980006814e-01f, 6.320339441e-02f, 9.998000264e-01f, 1.999866776e-02f, 9.999799728e-01f, 6.324512884e-03f,
  -5.477292538e-01f, 8.366556168e-01f, 9.367404580e-01f, 3.500247598e-01f, -5.048462152e-01f, 8.632093072e-01f, 7.874851823e-01f, 6.163335443e-01f,
  9.780309200e-01f, 2.084598988e-01f, 9.977958202e-01f, 6.635902822e-02f, 9.997795224e-01f, 2.099845745e-02f, 9.999779463e-01f, 6.640734151e-03f,
  -9.999608397e-01f, -8.851309307e-03f, 7.814403772e-01f, 6.239799261e-01f, -5.885011554e-01f, 8.084963560e-01f, 7.676045895e-01f, 6.409237385e-01f,
  9.758974314e-01f, 2.182296216e-01f, 9.975810051e-01f, 6.951400638e-02f, 9.997580051e-01f, 2.199822664e-02f, 9.999758005e-01f, 6.956954487e-03f,
  -5.328330398e-01f, -8.462204337e-01f, 5.486452579e-01f, 8.360552788e-01f, -6.662759781e-01f, 7.457052469e-01f, 7.469564080e-01f, 6.648730636e-01f,
  9.736663699e-01f, 2.279775143e-01f, 9.973561764e-01f, 7.266827673e-02f, 9.997355342e-01f, 2.299797349e-02f, 9.999735355e-01f, 7.273174357e-03f,
  4.241790175e-01f, -9.055783749e-01f, 2.614416778e-01f, 9.652192593e-01f, -7.373937964e-01f, 6.754631400e-01f, 7.255613208e-01f, 6.881574988e-01f,
  9.713379741e-01f, 2.377026230e-01f, 9.971213937e-01f, 7.582182437e-02f, 9.997119904e-01f, 2.399769612e-02f, 9.999712110e-01f, 7.589393295e-03f,
  9.912028313e-01f, -1.323517561e-01f, -5.168933049e-02f, 9.986631870e-01f, -8.011435866e-01f, 5.984721184e-01f, 7.034407258e-01f, 7.107539177e-01f,
  9.689124227e-01f, 2.474039644e-01f, 9.968766570e-01f, 7.897461206e-02f, 9.996874928e-01f, 2.499739639e-02f, 9.999687672e-01f, 7.905611768e-03f,
  6.469193101e-01f, 7.625584602e-01f, -3.596943319e-01f, 9.330701828e-01f, -8.568888307e-01f, 5.155012608e-01f, 6.806167960e-01f, 7.326396108e-01f,
  9.663899541e-01f, 2.570805550e-01f, 9.966219068e-01f, 8.212661743e-02f, 9.996620417e-01f, 2.599707060e-02f, 9.999662042e-01f, 8.221829310e-03f,
  -2.921388149e-01f, 9.563759565e-01f, -6.320286393e-01f, 7.749450207e-01f, -9.040721655e-01f, 4.273798466e-01f, 6.571123004e-01f, 7.537927032e-01f,
  9.637709260e-01f, 2.667314112e-01f, 9.963572025e-01f, 8.527779579e-02f, 9.996355176e-01f, 2.699672058e-02f, 9.999635220e-01f, 8.538045920e-03f,
  -9.626058936e-01f, 2.709057927e-01f, -8.416849375e-01f, 5.399689674e-01f, -9.422222972e-01f, 3.349882066e-01f, 6.329506636e-01f, 7.741920948e-01f,
  9.610554576e-01f, 2.763556540e-01f, 9.960825443e-01f, 8.842811733e-02f, 9.996080399e-01f, 2.799634263e-02f, 9.999607801e-01f, 8.854261599e-03f,
  -7.480575442e-01f, -6.636338830e-01f, -9.678714871e-01f, 2.514453232e-01f, -9.709581733e-01f, 2.392492294e-01f, 6.081562042e-01f, 7.938174009e-01f,
  9.582439065e-01f, 2.859522104e-01f, 9.957979321e-01f, 9.157756716e-02f, 9.995795488e-01f, 2.899593674e-02f, 9.999579787e-01f, 9.170476347e-03f,
  1.542514563e-01f, -9.880316257e-01f, -9.980752468e-01f, -6.201484054e-02f, -9.899924994e-01f, 1.411200017e-01f, 5.827536583e-01f, 8.126488924e-01f,
  9.553365111e-01f, 2.955201864e-01f, 9.955033660e-01f, 9.472609311e-02f, 9.995500445e-01f, 2.999550104e-02f, 9.999549985e-01f, 9.486690164e-03f,
  9.147423506e-01f, -4.040376544e-01f, -9.293003082e-01f, -3.693250120e-01f, -9.991351366e-01f, 4.158052057e-02f, 5.567683578e-01f, 8.306677938e-01f,
  9.523335695e-01f, 3.050586283e-01f, 9.951988459e-01f, 9.787366539e-02f, 9.995195270e-01f, 3.099503554e-02f, 9.999519587e-01f, 9.802903049e-03f,
  8.342233896e-01f, 5.514267087e-01f, -7.683671117e-01f, -6.400094032e-01f, -9.982947707e-01f, -5.837419257e-02f, 5.302263498e-01f, 8.478561044e-01f,
  9.492354393e-01f, 3.145665526e-01f, 9.948843718e-01f, 1.010202691e-01f, 9.994880557e-01f, 3.199454024e-02f, 9.999487996e-01f, 1.011911593e-02f,
  -1.327674743e-02f, 9.999118447e-01f, -5.312352777e-01f, -8.472243547e-01f, -9.874798059e-01f, -1.577456445e-01f, 5.031541586e-01f, 8.641966581e-01f,
  9.460423589e-01f, 3.240430057e-01f, 9.945599437e-01f, 1.041658595e-01f, 9.994555712e-01f, 3.299400955e-02f, 9.999455214e-01f, 1.043532696e-02f,
  -8.485702872e-01f, 5.290827155e-01f, -2.414211184e-01f, -9.704204202e-01f, -9.667981863e-01f, -2.555412054e-01f, 4.755789042e-01f, 8.796730638e-01f,
  9.427546859e-01f, 3.334870934e-01f, 9.942255616e-01f, 1.073104069e-01f, 9.994220734e-01f, 3.399345279e-02f, 9.999421835e-01f, 1.075153705e-02f,
  -9.036921859e-01f, -4.281826615e-01f, 7.233466953e-02f, -9.973804355e-01f, -9.364566803e-01f, -3.507832289e-01f, 4.475280643e-01f, 8.942698836e-01f,
  9.393727183e-01f, 3.428978026e-01f, 9.938812256e-01f, 1.104538813e-01f, 9.993875623e-01f, 3.499285504e-02f, 9.999387264e-01f, 1.106774528e-02f,
  -1.279636919e-01f, -9.917788506e-01f, 3.789161742e-01f, -9.254310131e-01f, -8.967583776e-01f, -4.425205588e-01f, 4.190297425e-01f, 9.079725146e-01f,
  9.358968139e-01f, 3.522742093e-01f, 9.935269952e-01f, 1.135962531e-01f, 9.993520975e-01f, 3.599222749e-02f, 9.999352098e-01f, 1.138395350e-02f,
  7.654140592e-01f, -6.435381174e-01f, 6.479216814e-01f, -7.617069483e-01f, -8.481000066e-01f, -5.298361778e-01f, 3.901124299e-01f, 9.207672477e-01f,
  9.323273301e-01f, 3.616154492e-01f, 9.931628108e-01f, 1.167374924e-01f, 9.993155599e-01f, 3.699155897e-02f, 9.999315739e-01f, 1.170015987e-02f,
  9.550736547e-01f, 2.963685691e-01f, 8.526731133e-01f, -5.224447846e-01f, -7.909677625e-01f, -6.118578315e-01f, 3.608050346e-01f, 9.326412678e-01f,
  9.286646247e-01f, 3.709204793e-01f, 9.927886724e-01f, 1.198775545e-01f, 9.992780685e-01f, 3.799085692e-02f, 9.999278188e-01f, 1.201636530e-02f,
  2.666429281e-01f, 9.637953639e-01f, 9.728653431e-01f, -2.313720137e-01f, -7.259322405e-01f, -6.877662539e-01f, 3.311368525e-01f, 9.435827136e-01f,
  9.249090552e-01f, 3.801884055e-01f, 9.924046397e-01f, 1.230164245e-01f, 9.992396235e-01f, 3.899011388e-02f, 9.999239445e-01f, 1.233256981e-02f,
  -6.669380665e-01f, 7.451131344e-01f, 9.965789914e-01f, 8.264580369e-02f, -6.536436081e-01f, -7.568024993e-01f, 3.011375964e-01f, 9.535806775e-01f,
  9.210609794e-01f, 3.894183338e-01f, 9.920106530e-01f, 1.261540651e-01f, 9.992001057e-01f, 3.998933733e-02f, 9.999200106e-01f, 1.264877338e-02f,
  -9.873392582e-01f, -1.586226672e-01f, 9.214623570e-01f, 3.884676993e-01f, -5.748240352e-01f, -8.182770610e-01f, 2.708370686e-01f, 9.626252055e-01f,
  9.171208143e-01f, 3.986093104e-01f, 9.916067719e-01f, 1.292904317e-01f, 9.991596341e-01f, 4.098851606e-02f, 9.999159575e-01f, 1.296497509e-02f,
  -3.999853134e-01f, -9.165215492e-01f, 7.549653649e-01f, 6.557646990e-01f, -4.902605712e-01f, -8.715758920e-01f, 2.402658761e-01f, 9.707071185e-01f,
  9.130889177e-01f, 4.077604413e-01f, 9.911929369e-01f, 1.324255317e-01f, 9.991181493e-01f, 4.198765755e-02f, 9.999117851e-01f, 1.328117587e-02f,
  5.551133156e-01f, -8.317747712e-01f, 5.135984421e-01f, 8.580306768e-01f, -4.007990062e-01f, -9.161660075e-01f, 2.094544172e-01f, 9.778184295e-01f,
  9.089657664e-01f, 4.168707728e-01f, 9.907692075e-01f, 1.355592906e-01f, 9.990756512e-01f, 4.298675060e-02f, 9.999075532e-01f, 1.359737478e-02f,
  9.998432994e-01f, 1.770192571e-02f, 2.212981731e-01f, 9.752061963e-01f, -3.073327839e-01f, -9.516021013e-01f, 1.784335226e-01f, 9.839519858e-01f,
  9.047516584e-01f, 4.259394705e-01f, 9.903355837e-01f, 1.386916935e-01f, 9.990321398e-01f, 4.398580641e-02f, 9.999032021e-01f, 1.391357277e-02f,
  5.253219604e-01f, 8.509035110e-01f, -9.294810891e-02f, 9.956709743e-01f, -2.107958049e-01f, -9.775301218e-01f, 1.472342163e-01f, 9.891016483e-01f,
  9.004471302e-01f, 4.349655211e-01f, 9.898920655e-01f, 1.418227106e-01f, 9.989876747e-01f, 4.498481750e-02f, 9.998987317e-01f, 1.422976889e-02f,
  -4.321779311e-01f, 9.017883539e-01f, -3.979767561e-01f, 9.173954725e-01f, -1.121526212e-01f, -9.936909676e-01f, 1.158876941e-01f, 9.932623506e-01f,
  8.960524797e-01f, 4.439480901e-01f, 9.894386530e-01f, 1.449523121e-01f, 9.989421964e-01f, 4.598378390e-02f, 9.998942018e-01f, 1.454596408e-02f,
  -9.923354983e-01f, 1.235731244e-01f, -6.635382771e-01f, 7.481423616e-01f, -1.238837745e-02f, -9.999232888e-01f, 8.442528546e-02f, 9.964298010e-01f,
  8.915683031e-01f, 4.528862834e-01f, 9.889753461e-01f, 1.480804533e-01f, 9.988957047e-01f, 4.698270187e-02f, 9.998895526e-01f, 1.486215740e-02f,
  -6.401443481e-01f, -7.682546377e-01f, -8.632965088e-01f, 5.046970844e-01f, 8.749917150e-02f, -9.961646199e-01f, 5.287845805e-02f, 9.986009598e-01f,
  8.869948983e-01f, 4.617791772e-01f, 9.885020852e-01f, 1.512071192e-01f, 9.988481998e-01f, 4.798157141e-02f, 9.998847842e-01f, 1.517834887e-02f,
  3.005925417e-01f, -9.537526369e-01f, -9.774427414e-01f, 2.112006545e-01f, 1.865124702e-01f, -9.824525714e-01f, 2.127875760e-02f, 9.997735620e-01f,
  8.823328614e-01f, 4.706258774e-01f, 9.880189896e-01f, 1.543322802e-01f, 9.987997413e-01f, 4.898039624e-02f, 9.998799562e-01f, 1.549453940e-02f,
  9.649659991e-01f, -2.623748481e-01f, -9.946564436e-01f, -1.032404602e-01f, 2.836622000e-01f, -9.589242935e-01f, -1.034221891e-02f, 9.999465346e-01f,
  8.775825500e-01f, 4.794255495e-01f, 9.875259995e-01f, 1.574558914e-01f, 9.987502694e-01f, 4.997916892e-02f, 9.998750091e-01f, 1.581072807e-02f,
  7.421541810e-01f, 6.702291965e-01f, -9.132301211e-01f, -4.074441493e-01f, 3.779776692e-01f, -9.258147478e-01f, -4.195285589e-02f, 9.991195798e-01f,
  8.727445006e-01f, 4.881772399e-01f, 9.870231748e-01f, 1.605779380e-01f, 9.986997843e-01f, 5.097789690e-02f, 9.998699427e-01f, 1.612691768e-02f,
  -1.629907787e-01f, 9.866275787e-01f, -7.412399650e-01f, -6.712401509e-01f, 4.685169160e-01f, -8.834545016e-01f, -7.352153957e-02f, 9.972936511e-01f,
  8.678191900e-01f, 4.968801141e-01f, 9.865104556e-01f, 1.636983752e-01f, 9.986482859e-01f, 5.197656900e-02f, 9.998648167e-01f, 1.644310169e-02f,
  -9.182828069e-01f, 3.959251642e-01f, -4.957418144e-01f, -8.684699535e-01f, 5.543745160e-01f, -8.322673440e-01f, -1.050167084e-01f, 9.944704771e-01f,
  8.628070951e-01f, 5.055333376e-01f, 9.859878421e-01f, 1.668171734e-01f, 9.985958338e-01f, 5.297519267e-02f, 9.998595715e-01f, 1.675928757e-02f,
  -8.293098211e-01f, -5.587890744e-01f, -2.010796219e-01f, -9.795749187e-01f, 6.346929669e-01f, -7.727644444e-01f, -1.364068687e-01f, 9.906529188e-01f,
  8.577086926e-01f, 5.141359568e-01f, 9.854553938e-01f, 1.699342877e-01f, 9.985423684e-01f, 5.397376046e-02f, 9.998542070e-01f, 1.707546785e-02f,
  2.212675661e-02f, -9.997551441e-01f, 1.135217771e-01f, -9.935355186e-01f, 7.086697817e-01f, -7.055402994e-01f, -1.676606387e-01f, 9.858447909e-01f,
  8.525245190e-01f, 5.226872563e-01f, 9.849131107e-01f, 1.730497181e-01f, 9.984878898e-01f, 5.497227982e-02f, 9.998487830e-01f, 1.739165001e-02f,
  8.532201052e-01f, -5.215510130e-01f, 4.168670774e-01f, -9.089674354e-01f, 7.755658031e-01f, -6.312667131e-01f, -1.987468749e-01f, 9.800508618e-01f,
  8.472551107e-01f, 5.311862230e-01f, 9.843609333e-01f, 1.761634201e-01f, 9.984323978e-01f, 5.597073585e-02f, 9.998431802e-01f, 1.770782843e-02f,
  8.998668194e-01f, 4.361647666e-01f, 6.788702011e-01f, -7.342582941e-01f, 8.347129226e-01f, -5.506852865e-01f, -2.296342701e-01f, 9.732769728e-01f,
  8.419010043e-01f, 5.396320224e-01f, 9.837989211e-01f, 1.792753637e-01f, 9.983759522e-01f, 5.696914345e-02f, 9.998375773e-01f, 1.802400686e-02f,
  1.191801354e-01f, 9.928726554e-01f, 8.735505342e-01f, -4.867334962e-01f, 8.855196238e-01f, -4.646020234e-01f, -2.602920532e-01f, 9.655299187e-01f,
  8.364626765e-01f, 5.480239391e-01f, 9.832270741e-01f, 1.823855042e-01f, 9.983184934e-01f, 5.796748772e-02f, 9.998317957e-01f, 1.834018156e-02f,
  -7.710801959e-01f, 6.367380023e-01f, 9.816020727e-01f, -1.909380108e-01f, 9.274784923e-01f, -3.738765717e-01f, -2.906895578e-01f, 9.568174481e-01f,
  8.309407234e-01f, 5.563610196e-01f, 9.826454520e-01f, 1.854938269e-01f, 9.982600212e-01f, 5.896577984e-02f, 9.998259544e-01f, 1.865635626e-02f,
  -9.524129629e-01f, -3.048106134e-01f, 9.923083186e-01f, 1.237909496e-01f, 9.601702690e-01f, -2.794154882e-01f, -3.207964003e-01f, 9.471482038e-01f,
  8.253356218e-01f, 5.646424294e-01f, 9.820539355e-01f, 1.886002868e-01f, 9.982005358e-01f, 5.996400863e-02f, 9.998199940e-01f, 1.897252724e-02f,
  -2.581016421e-01f, -9.661177993e-01f, 9.046075940e-01f, 4.262454212e-01f, 9.832684398e-01f, -1.821625978e-01f, -3.505824506e-01f, 9.365318418e-01f,
  8.196480274e-01f, 5.728674531e-01f, 9.814526439e-01f, 1.917048544e-01f, 9.981400967e-01f, 6.096218154e-02f, 9.998139739e-01f, 1.928869821e-02f,
  6.735071540e-01f, -7.391806841e-01f, 7.271980643e-01f, 6.864276528e-01f, 9.965420961e-01f, -8.308912069e-02f, -3.800179660e-01f, 9.249790907e-01f,
  8.138784766e-01f, 5.810351372e-01f, 9.808415174e-01f, 1.948075294e-01f, 9.980786443e-01f, 6.196028739e-02f, 9.998078346e-01f, 1.960486546e-02f,
  9.858965874e-01f, 1.673557013e-01f, 4.776714444e-01f, 8.785385489e-01f, 9.998586178e-01f, 1.681409031e-02f, -4.090735018e-01f, 9.125014544e-01f,
  8.080275059e-01f, 5.891447663e-01f, 9.802205563e-01f, 1.979082376e-01f, 9.980161786e-01f, 6.295833737e-02f, 9.998015761e-01f, 1.992103085e-02f,
};
#define XB_TMO      128
#define XB_XCNT(j)  (256  + 64 * (j))
#define XB_XSUB(j)  (1280 + 64 * (j))
#define XB_XGEN(j)  (2304 + 64 * (j))
#define XB_TOP      3328
#define XB_TOPGEN   3392
#define XCD_BAR_WORDS 3456
#define XB_SPIN_CAP (1u << 18)
#define LAS __attribute__((address_space(3)))

__device__ __forceinline__ unsigned xb_ld(unsigned* p)              { return __hip_atomic_load(p, __ATOMIC_RELAXED, __HIP_MEMORY_SCOPE_AGENT); }
__device__ __forceinline__ unsigned xb_add(unsigned* p, unsigned v) { return __hip_atomic_fetch_add(p, v, __ATOMIC_RELAXED, __HIP_MEMORY_SCOPE_AGENT); }
__device__ __forceinline__ unsigned xb_xcc_id() { return (unsigned)__builtin_amdgcn_s_getreg((3 << 11) | 20) & 0xFu; }
#define XB_SPIN(cond, bar) do { unsigned _sp = 0; while (cond) { __builtin_amdgcn_s_sleep(1); \
    if ((++_sp & 255u) == 0u) { if (xb_ld(&(bar)[XB_TMO])) break; if (_sp > XB_SPIN_CAP) { atomicAdd(&(bar)[XB_TMO], 1u); break; } } } } while (0)

struct XcdBarrier {
    unsigned* bar; unsigned x;
    volatile LAS unsigned* st;
};

__device__ __forceinline__ XcdBarrier xcd_barrier_post(unsigned* bar, volatile LAS unsigned* st) {
    XcdBarrier b; b.bar = bar; b.x = xb_xcc_id(); b.st = st;
    if (threadIdx.x == 0) (void)xb_add(&bar[XB_XCNT(b.x)], 1u);
    return b;
}
__device__ __forceinline__ void xcd_barrier_complete(unsigned* bar, unsigned x, unsigned& nloc, unsigned& nx) {
    const unsigned G = gridDim.x * gridDim.y * gridDim.z;
    unsigned sum, cnt, mine, sp = 0u;
    for (;;) {
        sum = 0u; cnt = 0u; mine = 0u;
#pragma unroll
        for (unsigned j = 0; j < 16; ++j) { const unsigned c = xb_ld(&bar[XB_XCNT(j)]); sum += c; cnt += (c > 0u) ? 1u : 0u; mine = (j == x) ? c : mine; }
        if (sum == G) break;
        __builtin_amdgcn_s_sleep(1);
        if ((++sp & 255u) == 0u) { if (xb_ld(&bar[XB_TMO])) break; if (sp > XB_SPIN_CAP) { atomicAdd(&bar[XB_TMO], 1u); break; } }
    }
    nloc = mine > 0u ? mine : 1u; nx = cnt > 0u ? cnt : 1u;
}

__device__ __forceinline__ void xcd_barrier(const XcdBarrier& b, const bool t0  ) {
    asm volatile("s_waitcnt vmcnt(0)" ::: "memory");
    __syncthreads();
    if (t0) {
        unsigned* bar = b.bar;
        __builtin_amdgcn_s_waitcnt(0);
        unsigned nloc = b.st[0], nx = b.st[1];
        if (nloc == 0u) { xcd_barrier_complete(bar, b.x, nloc, nx); b.st[0] = nloc; b.st[1] = nx; }
        const unsigned old = xb_add(&bar[XB_XSUB(b.x)], 1u);
        const unsigned gen = old / nloc;
        if (old + 1u == (gen + 1u) * nloc) {
            __builtin_amdgcn_fence(__ATOMIC_RELEASE, "agent");
            asm volatile("s_waitcnt vmcnt(0)" ::: "memory");
            const unsigned og = xb_add(&bar[XB_TOP], 1u);
            const unsigned tg = og / nx;
            if (og + 1u == (tg + 1u) * nx) xb_add(&bar[XB_TOPGEN], 1u);
            else XB_SPIN(xb_ld(&bar[XB_TOPGEN]) == tg, bar);
            __builtin_amdgcn_fence(__ATOMIC_ACQUIRE, "agent");
            xb_add(&bar[XB_XGEN(b.x)], 1u);
            asm volatile("s_waitcnt vmcnt(0)" ::: "memory");
        } else {
            XB_SPIN(xb_ld(&bar[XB_XGEN(b.x)]) == gen, bar);
            __builtin_amdgcn_fence(__ATOMIC_ACQUIRE, "agent");
            asm volatile("s_waitcnt vmcnt(0)" ::: "memory");
        }
    }
    __syncthreads();
}

DI void conv_fetch(const float* __restrict__ src, int K, int N, int k0, int n0, f32x4 (&v)[2], int tid) {
#pragma unroll
    for (int i = 0; i < 2; ++i) {
        const int idx = tid + NTHREADS * i, kr = idx >> 4, c4 = (idx & 15) * 4;
        v[i] = (f32x4){0.f, 0.f, 0.f, 0.f};
        if (n0 + c4 < N) v[i] = __builtin_nontemporal_load((const f32x4*)(src + (size_t)(k0 + kr) * N + n0 + c4));
    }
}
DI void conv_put(const f32x4 (&v)[2], float* lds, int tid) {
#pragma unroll
    for (int i = 0; i < 2; ++i) {
        const int idx = tid + NTHREADS * i, kr = idx >> 4, c4 = (idx & 15) * 4;
        float* d = lds + kr * 65 + c4;
        d[0] = v[i].x; d[1] = v[i].y; d[2] = v[i].z; d[3] = v[i].w;
    }
}
template <bool NT>
DI void conv_store(int K, bf16_t* __restrict__ dst, int k0, int ndst0, int nstep, const float* lds, int tid) {
    const int idx = tid, n = idx >> 3, kc = idx & 7;
    float f[8];
#pragma unroll
    for (int j = 0; j < 8; ++j) f[j] = lds[(kc * 8 + j) * 65 + n];
    u32x4* d = (u32x4*)(dst + (size_t)(ndst0 + (n & 31) + (n >> 5) * nstep) * K + k0 + kc * 8);
    if (NT) __builtin_nontemporal_store(pack8(f), d); else *d = pack8(f);
}
template <bool NT = true>
DI void conv_job(const float* src, int count, int K, int N, int Npad, bf16_t* dst, int perm  , int& base, float* lds, int bid, int nb, int tid) {
    const int tk = K / 64, tn = Npad / 64, per = tk * tn, total = count * per;
    int t = (bid - (base % nb) + nb) % nb;
    f32x4 rg[4][2];
    auto fetch4 = [&](int tt) {
#pragma unroll
        for (int q = 0; q < 4; ++q) {
            const int tq = tt + q * nb;
            if (tq < total) { const int mi = tq / per, rem = tq - mi * per, nt = rem / tk, kt = rem - nt * tk;
                conv_fetch(src + (size_t)mi * K * N, K, N, kt * 64, nt * 64, rg[q], tid); }
        }
    };
    if (t < total) fetch4(t);
    for (; t < total; t += 4 * nb) {
#pragma unroll
        for (int q = 0; q < 4; ++q) if (t + q * nb < total) conv_put(rg[q], lds + q * 4160, tid);
        __syncthreads();
        if (t + 4 * nb < total) fetch4(t + 4 * nb);
#pragma unroll
        for (int q = 0; q < 4; ++q) {
            const int tq = t + q * nb;
            if (tq < total) { const int mi = tq / per, rem = tq - mi * per, nt = rem / tk, kt = rem - nt * tk, n0 = nt * 64;
                int nd0 = n0, nstep = 32;
                if (perm == 1) nd0 = ((n0 & 255) >> 7) * 256 + (n0 >> 8) * 128 + (n0 & 127);
                else if (n0 < perm) { const int hg = n0 >> 6; nd0 = (hg >> 2) * 256 + (hg & 3) * 32; nstep = 128; }
                conv_store<NT>(K, dst + (size_t)mi * Npad * K, kt * 64, nd0, nstep, lds + q * 4160, tid); }
        }
        __syncthreads();
    }
    base += total;
}

DI int mla_col(bool uq, int r) {
    const int hw = uq ? 96 : 128;
    if (r < 1024) { const int pn = r >> 8, bj = (r >> 7) & 1, wc = (r >> 5) & 3, d = r & 31; return (4 * pn + wc) * hw + 32 * bj + d; }
    const int rr = r - 1024;
    if (uq) { const int head = rr >> 5, c = rr & 31, dim = (c >> 3) * 4 + (c & 3) + 16 * ((c >> 2) & 1); return head * 96 + 64 + dim; }
    return (rr >> 6) * 128 + 64 + (rr & 63);
}
DI void phase_prologue(const Params& p, float* lds, int bid, int nb, int tid) {
    bf16_t* ws16 = (bf16_t*)p.ws;
    int base = 0;
    conv_job(p.in[13], 1, 1024, 3072, 3072, (bf16_t*)(p.ws + W_QKV0), 2048, base, lds, bid, nb, tid);
    conv_job(p.in[14], 1, 1024, 1024, 1024, (bf16_t*)(p.ws + W_O0), 0, base, lds, bid, nb, tid);
    conv_job(p.in[18], 1, 1024, 1536, 1536, (bf16_t*)(p.ws + W_QKV1), 1280, base, lds, bid, nb, tid);
    conv_job(p.in[19], 1, 1024, 1024, 1024, (bf16_t*)(p.ws + W_O1), 0, base, lds, bid, nb, tid);
    conv_job(p.in[23], 1, 1024, 672, 768, (bf16_t*)(p.ws + W_DQKV), 0, base, lds, bid, nb, tid);
    for (int i = bid * NTHREADS + tid; i < 1536 * 48 + 2048 * 32; i += nb * NTHREADS) {
        const bool uq = i < 1536 * 48;
        const int K = uq ? 384 : 256, kc = K / 8, ii = uq ? i : i - 1536 * 48, r = ii / kc, k0 = (ii - r * kc) * 8, nsrc = uq ? 1536 : 2048;
        const int col = mla_col(uq, r);
        const float* src = p.in[uq ? 26 : 27] + (size_t)k0 * nsrc + col;
        float f[8];
#pragma unroll
        for (int j = 0; j < 8; ++j) f[j] = src[(size_t)j * nsrc];
        *(u32x4*)((bf16_t*)(p.ws + (uq ? W_UQ : W_UKV)) + (size_t)r * K + k0) = pack8(f);
    }
    conv_job(p.in[30], 1, 1024, 1024, 1024, (bf16_t*)(p.ws + W_O2), 0, base, lds, bid, nb, tid);
    conv_job(p.in[31], 1, 1024, 3072, 3072, (bf16_t*)(p.ws + W_QKV3), 2048, base, lds, bid, nb, tid);
    conv_job(p.in[36], 1, 1024, 1024, 1024, (bf16_t*)(p.ws + W_O3), 0, base, lds, bid, nb, tid);
    conv_job(p.in[11], 32, 1024, 512, 512, (bf16_t*)(p.ws + W_GU), 1, base, lds, bid, nb, tid);
    conv_job(p.in[12], 32, 256, 1024, 1024, (bf16_t*)(p.ws + W_DN), 0, base, lds, bid, nb, tid);
    (void)ws16;
    float* sc = lds;
    for (int i = tid; i < 9 * 1024; i += NTHREADS) {
        const int r = i >> 10, k = i & 1023;
        const float v = r < 8 ? p.in[1][r * 1024 + k] : p.in[3][k];
        sc[i] = silu_f(v);
    }
    __syncthreads();
    float* part = (float*)(p.ws + WS_MODP);
    for (int it = bid; it < 768; it += nb) {
        const int kc = it / 48, rem = it - kc * 48, l = rem / 12, nch = rem - l * 12;
        const int n = nch * 512 + tid;
        const float* w = p.in[4] + ((size_t)l * 1024 + kc * 64) * 6144 + n;
        float acc[9];
#pragma unroll
        for (int r = 0; r < 9; ++r) acc[r] = 0.f;
#pragma unroll 8
        for (int k = 0; k < 64; ++k) {
            const float wv = __builtin_nontemporal_load(w + (size_t)k * 6144);
#pragma unroll
            for (int r = 0; r < 9; ++r) acc[r] += sc[r * 1024 + kc * 64 + k] * wv;
        }
#pragma unroll
        for (int r = 0; r < 9; ++r) part[(((size_t)kc * 4 + l) * 9 + r) * 6144 + n] = acc[r];
    }
    __syncthreads();
}
DI void phase_mod_reduce(const Params& p, int bid, int nb, int tid) {
    const float* part = (const float*)(p.ws + WS_MODP);
    float* mod = (float*)(p.ws + WS_MOD);
    const int total = 4 * 9 * 6144;
    for (int i = bid * NTHREADS + tid; i < total; i += nb * NTHREADS) {
        const int l = i / (9 * 6144), n = i % 6144;
        float s = p.in[5][l * 6144 + n];
#pragma unroll
        for (int kc = 0; kc < 16; ++kc) s += part[(size_t)kc * total + i];
        mod[i] = s;
    }
}

template <int MODE>
DI void phase_rows(const Params& p, int layer  , int which  , int bid, int nb, int tid) {
    const int wid = __builtin_amdgcn_readfirstlane(tid >> 6), lane = tid & 63;
    const float* modall = (const float*)(p.ws + WS_MOD);
    const bf16_t* eo = (const bf16_t*)(p.ws + WS_RAW);
    bf16_t* H = (bf16_t*)(p.ws + WS_H);
    for (int r = bid * NW + wid; r < MROWS; r += nb * NW) {
        const int b = r / PP, pos = r - b * PP;
        if ((MODE & 16) && pos >= SEQ) continue;
        const int mr = pos < SEQ ? b : 8;
        bf16_t* xb = xb_row(p, r);
        float x[16];
        if (MODE & 8) {
            const float* xr = pos < SEQ ? p.in[0] + ((size_t)b * SEQ + pos) * DM : p.in[2] + ((size_t)b * CTXL + (pos - SEQ)) * DM;
#pragma unroll
            for (int j = 0; j < 4; ++j) { const f32x4 v = *(const f32x4*)(xr + lane * 4 + 256 * j); x[4 * j] = v.x; x[4 * j + 1] = v.y; x[4 * j + 2] = v.z; x[4 * j + 3] = v.w; }
        } else {
#pragma unroll
            for (int j = 0; j < 4; ++j) { const u32x2 v = *(const u32x2*)(xb + lane * 4 + 256 * j); x[4 * j] = bflo(v.x); x[4 * j + 1] = bfhi(v.x); x[4 * j + 2] = bflo(v.y); x[4 * j + 3] = bfhi(v.y); }
        }
        if (MODE & 1) {
            const float* g2 = modall + ((size_t)(layer - ((MODE & 2) ? 1 : 0)) * 9 + mr) * 6144 + 5120;
            const bf16_t* y0 = eo + (size_t)(2 * r) * 1024, *y1 = y0 + 1024;
#pragma unroll
            for (int j = 0; j < 4; ++j) {
                const u32x2 a = *(const u32x2*)(y0 + lane * 4 + 256 * j), bb = *(const u32x2*)(y1 + lane * 4 + 256 * j);
                const f32x4 g = *(const f32x4*)(g2 + lane * 4 + 256 * j);
                x[4 * j] += g.x * (bflo(a.x) + bflo(bb.x)); x[4 * j + 1] += g.y * (bfhi(a.x) + bfhi(bb.x));
                x[4 * j + 2] += g.z * (bflo(a.y) + bflo(bb.y)); x[4 * j + 3] += g.w * (bfhi(a.y) + bfhi(bb.y));
            }
        }
        if (MODE & 16) {
            float* orow = p.out + ((size_t)b * SEQ + pos) * DM;
#pragma unroll
            for (int j = 0; j < 4; ++j) *(f32x4*)(orow + lane * 4 + 256 * j) = (f32x4){x[4 * j], x[4 * j + 1], x[4 * j + 2], x[4 * j + 3]};
        } else if (MODE & (1 | 8)) {
#pragma unroll
            for (int j = 0; j < 4; ++j) {
                u32x2 w; w.x = pk2(x[4 * j], x[4 * j + 1]); w.y = pk2(x[4 * j + 2], x[4 * j + 3]);
                *(u32x2*)(xb + lane * 4 + 256 * j) = w;
                x[4 * j] = bflo(w.x); x[4 * j + 1] = bfhi(w.x); x[4 * j + 2] = bflo(w.y); x[4 * j + 3] = bfhi(w.y);
            }
        }
        if (MODE & 2) {
            float ss = 0.f;
#pragma unroll
            for (int i = 0; i < 16; ++i) ss += x[i] * x[i];
            ss = wave_sum(ss);
            const float rs = rsqrtf(ss * (1.0f / 1024.0f) + EPS);
            const float* ng = p.in[6] + ((size_t)layer * 2 + which) * 1024;
            const float* md = modall + ((size_t)layer * 9 + mr) * 6144 + which * 3072;
#pragma unroll
            for (int j = 0; j < 4; ++j) {
                const f32x4 g = *(const f32x4*)(ng + lane * 4 + 256 * j), sh = *(const f32x4*)(md + lane * 4 + 256 * j), sc = *(const f32x4*)(md + 1024 + lane * 4 + 256 * j);
                u32x2 w;
                w.x = pk2(x[4 * j] * rs * g.x * (1.0f + sc.x) + sh.x, x[4 * j + 1] * rs * g.y * (1.0f + sc.y) + sh.y);
                w.y = pk2(x[4 * j + 2] * rs * g.z * (1.0f + sc.z) + sh.z, x[4 * j + 3] * rs * g.w * (1.0f + sc.w) + sh.w);
                *(u32x2*)(H + (size_t)r * 1024 + lane * 4 + 256 * j) = w;
            }
        }
    }
}

constexpr size_t WS_RC = WS_MOD + 917504;
DI void phase_router_prep(const Params& p, int bid, int nb, int tid) {
    const float* modall = (const float*)(p.ws + WS_MOD);
    bf16_t* wth = (bf16_t*)(p.ws + WS_RW); bf16_t* wtl = wth + 4 * 9 * 48 * 1024;
    const int total = 4 * 9 * 48 * 1024;
    for (int i = bid * NTHREADS + tid; i < total; i += nb * NTHREADS) {
        const int k = i & 1023, c = (i >> 10) % 48, lb = i / (48 * 1024), l = lb / 9, b = lb - l * 9;
        float v = 0.f;
        if (c < 36) {
            const float w = c < 32 ? p.in[9][((size_t)l * 1024 + k) * 32 + c] : p.in[7][((size_t)l * 1024 + k) * 4 + (c - 32)];
            v = p.in[6][((size_t)l * 2 + 1) * 1024 + k] * (1.0f + modall[((size_t)l * 9 + b) * 6144 + 4096 + k]) * w;
        }
        const unsigned hb = f2bf(v); wth[i] = (bf16_t)hb; wtl[i] = (bf16_t)f2bf(v - bf2f(hb));
    }
    float* cst = (float*)(p.ws + WS_RC);
    const int wid = __builtin_amdgcn_readfirstlane(tid >> 6), lane = tid & 63;
    for (int j = bid * NW + wid; j < 4 * 9 * 48; j += nb * NW) {
        const int c = j % 48, lb = j / 48, l = lb / 9, b = lb - l * 9;
        float acc = 0.f;
        if (c < 36) {
            for (int k = lane; k < 1024; k += 64) {
                const float w = c < 32 ? p.in[9][((size_t)l * 1024 + k) * 32 + c] : p.in[7][((size_t)l * 1024 + k) * 4 + (c - 32)];
                acc += modall[((size_t)l * 9 + b) * 6144 + 3072 + k] * w;
            }
            acc = wave_sum(acc) + (c < 32 ? p.in[10][l * 32 + c] : p.in[8][l * 4 + (c - 32)]);
        }
        if (lane == 0) cst[j] = acc;
    }
}
typedef float f32x2_3 __attribute__((ext_vector_type(2)));
typedef __bf16 bf16x2_3 __attribute__((ext_vector_type(2)));
DI unsigned cvtpk3(float lo, float hi) { f32x2_3 v = {lo, hi}; bf16x2_3 b = __builtin_convertvector(v, bf16x2_3); return __builtin_bit_cast(unsigned, b); }
DI void phase_router(const Params& p, unsigned char* smem, int layer, bool skip_ctx, int bid, int nb, int tid) {
    const int lane = tid & 63, wid = __builtin_amdgcn_readfirstlane(tid >> 6), li = lane & 15, kq = lane >> 4;
    LAS float* tile = (LAS float*)smem + wid * (32 * 49);
    const bf16_t* wth_all = (const bf16_t*)(p.ws + WS_RW) + (size_t)layer * 9 * 48 * 1024;
    const bf16_t* wtl_all = wth_all + 4 * 9 * 48 * 1024;
    const float* cst_all = (const float*)(p.ws + WS_RC) + layer * 9 * 48;
    unsigned* cnt = (unsigned*)(p.ws + WS_CTL) + CW_CNT + layer * 32;
    unsigned* list = (unsigned*)(p.ws + WS_LIST);
    float* gates = (float*)(p.ws + WS_GATE);
    if (layer > 0) {
        int base = 0;
        conv_job<false>(p.in[11] + (size_t)layer * 32 * 1024 * 512, 32, 1024, 512, 512, (bf16_t*)(p.ws + W_GU) + (size_t)layer * 32 * 512 * 1024, 1, base, (float*)smem, bid, nb, tid);
        conv_job<false>(p.in[12] + (size_t)layer * 32 * 256 * 1024, 32, 256, 1024, 1024, (bf16_t*)(p.ws + W_DN) + (size_t)layer * 32 * 1024 * 256, 0, base, (float*)smem, bid, nb, tid);
    }
    for (int u = bid * NW + wid; u < MROWS / 32; u += nb * NW) {
        const int r0 = u * 32, b = r0 / PP, pos = r0 - b * PP;
        const bool isctx = pos >= SEQ;
        if (skip_ctx && isctx) continue;
        const int mr = isctx ? 8 : b;
        const bf16_t* xr = xb_row(p, r0 + li) + 8 * kq;
        const bf16_t* wh = wth_all + ((size_t)mr * 48 + li) * 1024 + 8 * kq;
        const bf16_t* wl = wtl_all + ((size_t)mr * 48 + li) * 1024 + 8 * kq;
        f32x4 acc[2][3];
#pragma unroll
        for (int m = 0; m < 2; ++m)
#pragma unroll
            for (int n = 0; n < 3; ++n) acc[m][n] = (f32x4){0.f, 0.f, 0.f, 0.f};
        float ss[2] = {0.f, 0.f};
#pragma unroll 2
        for (int s = 0; s < 32; ++s) {
            bf16x8 xa[2], bh[3], bl[3];
#pragma unroll
            for (int m = 0; m < 2; ++m) xa[m] = *(const bf16x8*)(xr + (size_t)m * 16 * DM + 32 * s);
#pragma unroll
            for (int n = 0; n < 3; ++n) { bh[n] = *(const bf16x8*)(wh + (size_t)n * 16 * 1024 + 32 * s); bl[n] = *(const bf16x8*)(wl + (size_t)n * 16 * 1024 + 32 * s); }
#pragma unroll
            for (int m = 0; m < 2; ++m) {
                const u32x4 w = __builtin_bit_cast(u32x4, xa[m]);
                ss[m] += bflo(w.x) * bflo(w.x) + bfhi(w.x) * bfhi(w.x) + bflo(w.y) * bflo(w.y) + bfhi(w.y) * bfhi(w.y) + bflo(w.z) * bflo(w.z) + bfhi(w.z) * bfhi(w.z) + bflo(w.w) * bflo(w.w) + bfhi(w.w) * bfhi(w.w);
#pragma unroll
                for (int n = 0; n < 3; ++n) {
                    acc[m][n] = __builtin_amdgcn_mfma_f32_16x16x32_bf16(xa[m], bl[n], acc[m][n], 0, 0, 0);
                    acc[m][n] = __builtin_amdgcn_mfma_f32_16x16x32_bf16(xa[m], bh[n], acc[m][n], 0, 0, 0);
                }
            }
        }
#pragma unroll
        for (int m = 0; m < 2; ++m) { ss[m] += __shfl_xor(ss[m], 16); ss[m] += __shfl_xor(ss[m], 32); }
#pragma unroll
        for (int m = 0; m < 2; ++m)
#pragma unroll
            for (int n = 0; n < 3; ++n)
#pragma unroll
                for (int i = 0; i < 4; ++i) tile[(16 * m + 4 * kq + i) * 49 + n * 16 + li] = acc[m][n][i];
        __builtin_amdgcn_s_waitcnt(0xc07f);
        const float ssr = (lane & 16) ? ss[1] : ss[0];
        const float rs = rsqrtf(ssr * (1.0f / 1024.0f) + EPS);
        if (lane < 32) {
            const float* cst = cst_all + mr * 48;
            const LAS float* tr = tile + lane * 49;
            float lg[4];
#pragma unroll
            for (int c = 0; c < 4; ++c) lg[c] = tr[32 + c] * rs + cst[32 + c];
            int gi = 0; float gm = lg[0];
#pragma unroll
            for (int c = 1; c < 4; ++c) if (lg[c] > gm) { gm = lg[c]; gi = c; }
            float gden = 0.f;
#pragma unroll
            for (int c = 0; c < 4; ++c) gden += __expf(lg[c] - gm);
            const float gw = 1.0f / gden;
            float le[8];
#pragma unroll
            for (int c = 0; c < 8; ++c) le[c] = tr[gi * 8 + c] * rs + cst[gi * 8 + c];
            int e0 = 0; float m0 = le[0];
#pragma unroll
            for (int c = 1; c < 8; ++c) if (le[c] > m0) { m0 = le[c]; e0 = c; }
            int e1 = -1; float m1 = -INFINITY;
#pragma unroll
            for (int c = 0; c < 8; ++c) if (c != e0 && le[c] > m1) { m1 = le[c]; e1 = c; }
            const float q1 = __expf(m1 - m0), inv = 1.0f / (1.0f + q1);
            const int r = r0 + lane, ex0 = gi * 8 + e0, ex1 = gi * 8 + e1;
            const unsigned s0 = atomicAdd(cnt + ex0, 1u), s1 = atomicAdd(cnt + ex1, 1u);
            list[(size_t)ex0 * MROWS + s0] = 2u * r; list[(size_t)ex1 * MROWS + s1] = 2u * r + 1u;
            gates[2 * r] = gw * inv; gates[2 * r + 1] = gw * q1 * inv;
        }
        {
            const float* ng = p.in[6] + ((size_t)layer * 2 + 1) * 1024;
            const float* md = (const float*)(p.ws + WS_MOD) + ((size_t)layer * 9 + mr) * 6144 + 3072;
            f32x4 gm[4], sh[4];
#pragma unroll
            for (int j = 0; j < 4; ++j) {
                const f32x4 g = *(const f32x4*)(ng + lane * 4 + 256 * j), sc = *(const f32x4*)(md + 1024 + lane * 4 + 256 * j);
                sh[j] = *(const f32x4*)(md + lane * 4 + 256 * j);
                gm[j] = (f32x4){g.x * (1.0f + sc.x), g.y * (1.0f + sc.y), g.z * (1.0f + sc.z), g.w * (1.0f + sc.w)};
            }
            bf16_t* H = (bf16_t*)(p.ws + WS_H);
#pragma unroll 4
            for (int i = 0; i < 32; ++i) {
                const float rsi = __shfl(rs, i);
                const bf16_t* xb = xb_row(p, r0 + i);
#pragma unroll
                for (int j = 0; j < 4; ++j) {
                    const u32x2 v = *(const u32x2*)(xb + lane * 4 + 256 * j);
                    u32x2 w;
                    w.x = pk2(bflo(v.x) * rsi * gm[j].x + sh[j].x, bfhi(v.x) * rsi * gm[j].y + sh[j].y);
                    w.y = pk2(bflo(v.y) * rsi * gm[j].z + sh[j].z, bfhi(v.y) * rsi * gm[j].w + sh[j].w);
                    *(u32x2*)(H + (size_t)(r0 + i) * 1024 + lane * 4 + 256 * j) = w;
                }
            }
        }
    }
}

#define MFMA32(a, b, c) __builtin_amdgcn_mfma_f32_32x32x16_bf16((a), (b), (c), 0, 0, 0)
typedef LAS unsigned char* lds_ptr;
constexpr int GEMM_TM = 256, GEMM_TN = 256;
constexpr int GEMM_STAGE = 65536;
constexpr int GEMM_LDS = 2 * GEMM_STAGE;
constexpr int GEMM_MT = 4;

struct RowDense { static constexpr bool DENSE = true; const bf16_t* A; int lda; int m0; DI unsigned row(int i) const { return (unsigned)(m0 + i) * (unsigned)lda; } };
struct RowGather { static constexpr bool DENSE = false; const bf16_t* A; int lda; const unsigned* ent; int valid; int shift;
    DI unsigned row(int i) const { const unsigned e = ent[i < valid ? i : valid - 1]; return (e >> shift) * (unsigned)lda; } };

struct EpiStore { bf16_t* C; int ldc; int m0;
    DI void wave_tile(const f32x16 (&acc)[2][GEMM_MT], int mloc, int ncol, int lane) const {
        const int r = lane & 31, h = lane >> 5;
#pragma unroll
        for (int mt = 0; mt < GEMM_MT; ++mt) {
            bf16_t* c = C + (size_t)(m0 + mloc + mt * 32 + r) * ldc + ncol + 4 * h;
#pragma unroll
            for (int nt = 0; nt < 2; ++nt)
#pragma unroll
                for (int g = 0; g < 4; ++g) {
                    u32x2 w; w.x = pk2(acc[nt][mt][4 * g], acc[nt][mt][4 * g + 1]); w.y = pk2(acc[nt][mt][4 * g + 2], acc[nt][mt][4 * g + 3]);
                    *(u32x2*)(c + nt * 32 + 8 * g) = w;
                }
        }
    } };
struct EpiResid { const Params* p; const float* mod; int m0;
    DI void wave_tile(const f32x16 (&acc)[2][GEMM_MT], int mloc, int ncol, int lane) const {
        const int r = lane & 31, h = lane >> 5;
#pragma unroll
        for (int mt = 0; mt < GEMM_MT; ++mt) {
            const int row = m0 + mloc + mt * 32 + r;
            float* xr = xrow_ptr(*p, row) + ncol + 4 * h;
            const float* gp = mod + (size_t)mod_row(row) * 6144 + 2048 + ncol + 4 * h;
#pragma unroll
            for (int nt = 0; nt < 2; ++nt)
#pragma unroll
                for (int g = 0; g < 4; ++g) {
                    f32x4 x = *(f32x4*)(xr + nt * 32 + 8 * g);
                    const f32x4 gg = *(const f32x4*)(gp + nt * 32 + 8 * g);
                    x.x += gg.x * acc[nt][mt][4 * g]; x.y += gg.y * acc[nt][mt][4 * g + 1]; x.z += gg.z * acc[nt][mt][4 * g + 2]; x.w += gg.w * acc[nt][mt][4 * g + 3];
                    *(f32x4*)(xr + nt * 32 + 8 * g) = x;
                }
        }
    } };
struct EpiGlu { bf16_t* act; const unsigned* ent; const float* gates; int valid;
    DI void wave_tile(const f32x16 (&acc)[2][GEMM_MT], int mloc, int ncol, int lane) const {
        const int r = lane & 31, h = lane >> 5;
#pragma unroll
        for (int mt = 0; mt < GEMM_MT; ++mt) {
            const int i = mloc + mt * 32 + r;
            if (i < valid) {
                const unsigned a = ent[i];
                const float gw = gates[a];
                bf16_t* o = act + (size_t)a * DEXP + (ncol >> 6) * 32 + 4 * h;
#pragma unroll
                for (int g = 0; g < 4; ++g) {
                    float v[4];
#pragma unroll
                    for (int j = 0; j < 4; ++j) v[j] = silu_f(acc[0][mt][4 * g + j]) * acc[1][mt][4 * g + j] * gw;
                    u32x2 w; w.x = pk2(v[0], v[1]); w.y = pk2(v[2], v[3]);
                    *(u32x2*)(o + 8 * g) = w;
                }
            }
        }
    } };
struct EpiScatter { bf16_t* outp; const unsigned* ent; int valid;
    DI void wave_tile(const f32x16 (&acc)[2][GEMM_MT], int mloc, int ncol, int lane) const {
        const int r = lane & 31, h = lane >> 5;
#pragma unroll
        for (int mt = 0; mt < GEMM_MT; ++mt) {
            const int i = mloc + mt * 32 + r;
            if (i < valid) {
                bf16_t* c = outp + (size_t)ent[i] * 1024 + ncol + 4 * h;
#pragma unroll
                for (int nt = 0; nt < 2; ++nt)
#pragma unroll
                    for (int g = 0; g < 4; ++g) {
                        u32x2 w; w.x = pk2(acc[nt][mt][4 * g], acc[nt][mt][4 * g + 1]); w.y = pk2(acc[nt][mt][4 * g + 2], acc[nt][mt][4 * g + 3]);
                        *(u32x2*)(c + nt * 32 + 8 * g) = w;
                    }
            }
        }
    } };

#define SCHED_FENCE() __builtin_amdgcn_sched_barrier(0)
DI void glds16(const bf16_t* g, lds_ptr l) { __builtin_amdgcn_global_load_lds((const unsigned*)g, (LAS unsigned*)l, 16, 0, 0); }
template <int PROBE, int NAG>
DI void gemm_kstep(f32x16 (&acc)[2][GEMM_MT], const lds_ptr st, const unsigned (&arow)[GEMM_MT], const unsigned (&wrow)[2], const unsigned (&aswz)[GEMM_MT], const unsigned (&wswz)[2], int h,
                   bool issue, const bf16_t* __restrict__ An, const bf16_t* __restrict__ Wn, const unsigned (&ag)[NAG], unsigned astep, const unsigned (&bg)[2], unsigned bstep, const lds_ptr sn) {
    if (PROBE != 2 && issue) {
#pragma unroll
        for (int j = 0; j < 8; ++j) { glds16(An + (NAG == 2 ? ag[j & 1] + (j >> 1) * astep : ag[j % NAG]), sn + j * 1024); glds16(Wn + bg[j & 1] + (j >> 1) * bstep, sn + 32768 + j * 1024); }
    }
    if (PROBE == 1) return;
    bf16x8 af[2][GEMM_MT], wf[2][2];
#pragma unroll
    for (int t = 0; t < 2; ++t) wf[0][t] = *(const LAS bf16x8*)(st + wrow[t] + ((((unsigned)h) ^ wswz[t]) << 4));
#pragma unroll
    for (int t = 0; t < GEMM_MT; ++t) af[0][t] = *(const LAS bf16x8*)(st + arow[t] + ((((unsigned)h) ^ aswz[t]) << 4));
#pragma unroll
    for (int kk = 0; kk < 4; ++kk) {
        if (kk < 3) {
#pragma unroll
            for (int t = 0; t < 2; ++t) wf[(kk + 1) & 1][t] = *(const LAS bf16x8*)(st + wrow[t] + ((((unsigned)((kk + 1) * 2 + h)) ^ wswz[t]) << 4));
#pragma unroll
            for (int t = 0; t < GEMM_MT; ++t) af[(kk + 1) & 1][t] = *(const LAS bf16x8*)(st + arow[t] + ((((unsigned)((kk + 1) * 2 + h)) ^ aswz[t]) << 4));
        }
        SCHED_FENCE();
        __builtin_amdgcn_s_setprio(1);
#pragma unroll
        for (int mt = 0; mt < GEMM_MT; ++mt)
#pragma unroll
            for (int nt = 0; nt < 2; ++nt) acc[nt][mt] = MFMA32(wf[kk & 1][nt], af[kk & 1][mt], acc[nt][mt]);
        __builtin_amdgcn_s_setprio(0);
        SCHED_FENCE();
    }
}
template <class RowSrc, class Epi, int PROBE = 0>
DI void gemm_tile_mfma(unsigned char* smem, const RowSrc& rs, const bf16_t* __restrict__ Wt, int K, int n0, const Epi& epi, int tid) {
    const lds_ptr lds = (lds_ptr)smem;
    const int lane = tid & 63, wid = __builtin_amdgcn_readfirstlane(tid >> 6), wm = wid & 1, wn = wid >> 1, r = lane & 31, h = lane >> 5;
    const bool loader = wid < 4;
    const int lw = wid & 3;
    constexpr int NAG = RowSrc::DENSE ? 2 : 8;
    unsigned ag[NAG], bg[2];
    const bf16_t* __restrict__ Ab = rs.A;
#pragma unroll
    for (int j = 0; j < NAG; ++j) {
        const int row = (lw * 8 + j) * 8 + (lane >> 3), c = (lane & 7) ^ ((row >> 1) & 7);
        ag[j] = rs.row(row) + c * 8;
    }
#pragma unroll
    for (int j = 0; j < 2; ++j) {
        const int row = (lw * 8 + j) * 8 + (lane >> 3), c = (lane & 7) ^ ((row >> 1) & 7);
        bg[j] = (unsigned)(n0 + row) * (unsigned)K + c * 8;
    }
    const unsigned astep = 16u * (unsigned)rs.lda, bstep = 16u * (unsigned)K;
    const unsigned dmaoff = (unsigned)lw * 8192u;
    unsigned arow[GEMM_MT], wrow[2], aswz[GEMM_MT], wswz[2];
#pragma unroll
    for (int t = 0; t < GEMM_MT; ++t) { const int ra = wm * 128 + t * 32 + r; arow[t] = ra * 128; aswz[t] = (ra >> 1) & 7; }
#pragma unroll
    for (int t = 0; t < 2; ++t) { const int rw = wn * 64 + t * 32 + r; wrow[t] = 32768 + rw * 128; wswz[t] = (rw >> 1) & 7; }
    f32x16 acc[2][GEMM_MT];
#pragma unroll
    for (int a = 0; a < 2; ++a)
#pragma unroll
        for (int b = 0; b < GEMM_MT; ++b)
#pragma unroll
            for (int i = 0; i < 16; ++i) acc[a][b][i] = 0.f;
    if (loader) {
#pragma unroll
        for (int j = 0; j < 8; ++j) { glds16(Ab + (NAG == 2 ? ag[j & 1] + (j >> 1) * astep : ag[j % NAG]), lds + dmaoff + j * 1024); glds16(Wt + bg[j & 1] + (j >> 1) * bstep, lds + 32768 + dmaoff + j * 1024); }
    }
    asm volatile("s_waitcnt vmcnt(0)" ::: "memory");
    __syncthreads();
    const int KT = K >> 6;
    for (int kt = 0; kt < KT; ++kt) {
        gemm_kstep<PROBE, NAG>(acc, lds + (kt & 1) * GEMM_STAGE, arow, wrow, aswz, wswz, h, loader && kt + 1 < KT, Ab + (kt + 1) * 64, Wt + (kt + 1) * 64, ag, astep, bg, bstep, lds + ((kt + 1) & 1) * GEMM_STAGE + dmaoff);
        asm volatile("s_waitcnt vmcnt(0)" ::: "memory");
        __syncthreads();
    }
    if (PROBE == 0 || acc[0][0][0] == 12345.678f) epi.wave_tile(acc, wm * 128, n0 + wn * 64, lane);
}

template <int EPIK, int PROBE = 0>
DI void gemm_dense(const Params& p, unsigned char* smem, const bf16_t* A, int lda, const bf16_t* Wt, int K, int N, bf16_t* C, int ldc, const float* mod, int bid, int nb, int tid) {
    const int tn = N / GEMM_TN, total = (MROWS / GEMM_TM) * tn;
    for (int t = bid; t < total; t += nb) {
        const int mt = t / tn, nt = t - mt * tn;
        RowDense rs{A, lda, mt * GEMM_TM};
        if (EPIK == 0) { EpiStore e{C, ldc, mt * GEMM_TM}; gemm_tile_mfma<RowDense, EpiStore, PROBE>(smem, rs, Wt, K, nt * GEMM_TN, e, tid); }
        else { EpiResid e{&p, mod, mt * GEMM_TM}; gemm_tile_mfma(smem, rs, Wt, K, nt * GEMM_TN, e, tid); }
    }
}
template <int WHICH>
DI void gemm_moe(const Params& p, unsigned char* smem, int layer, int bid, int nb, int tid) {
    const unsigned* cnt = (const unsigned*)(p.ws + WS_CTL) + CW_CNT + layer * 32;
    const unsigned* list = (const unsigned*)(p.ws + WS_LIST);
    const float* gates = (const float*)(p.ws + WS_GATE);
    const bf16_t* H = (const bf16_t*)(p.ws + WS_H);
    bf16_t* act = (bf16_t*)(p.ws + WS_Q);
    bf16_t* eo = (bf16_t*)(p.ws + WS_RAW);
    constexpr int TN = WHICH == 0 ? 2 : 4;
    int total = 0;
    for (int e = 0; e < NEXP; ++e) total += (int)((cnt[e] + 255u) >> 8) * TN;
    for (int t = bid; t < total; t += nb) {
        int e = 0, rem = t;
        for (; e < NEXP; ++e) { const int te = (int)((cnt[e] + 255u) >> 8) * TN; if (rem < te) break; rem -= te; }
        const int rt = rem / TN, ct = rem - rt * TN;
        const unsigned* ent = list + (size_t)e * MROWS + rt * GEMM_TM;
        const int valid = min(GEMM_TM, (int)cnt[e] - rt * GEMM_TM);
        if (WHICH == 0) {
            RowGather rs{H, 1024, ent, valid, 1};
            EpiGlu ep{act, ent, gates, valid};
            gemm_tile_mfma(smem, rs, (const bf16_t*)(p.ws + W_GU) + ((size_t)layer * 32 + e) * 512 * 1024, 1024, ct * GEMM_TN, ep, tid);
        } else {
            RowGather rs{act, DEXP, ent, valid, 0};
            EpiScatter ep{eo, ent, valid};
            gemm_tile_mfma(smem, rs, (const bf16_t*)(p.ws + W_DN) + ((size_t)layer * 32 + e) * 1024 * 256, 256, ct * GEMM_TN, ep, tid);
        }
    }
}

DI float quad_sum(float v) { v += __shfl_xor(v, 1); v += __shfl_xor(v, 2); return v; }
DI void head64_norm_rope(const bf16_t* src, bf16_t* dst, const float* gain, int sub, bool rope, int prow, int pcol, float scale) {
    float a[8], b[8];
    unpack8(*(const u32x4*)(src + sub * 8), a); unpack8(*(const u32x4*)(src + 32 + sub * 8), b);
    float ss = 0.f;
#pragma unroll
    for (int e = 0; e < 8; ++e) ss += a[e] * a[e] + b[e] * b[e];
    ss = quad_sum(ss);
    const float rs = rsqrtf(ss * (1.0f / 64.0f) + EPS);
#pragma unroll
    for (int e = 0; e < 8; ++e) { a[e] *= rs * gain[sub * 8 + e]; b[e] *= rs * gain[32 + sub * 8 + e]; }
    if (rope) {
#pragma unroll
        for (int e = 0; e < 8; ++e) {
            const int i = sub * 8 + e;
            const float* cs = ROPE64 + ((i < 16 ? prow : pcol) * 16 + (i & 15)) * 2;
            const float c = cs[0], s = cs[1], x1 = a[e], x2 = b[e];
            a[e] = x1 * c - x2 * s; b[e] = x2 * c + x1 * s;
        }
    }
#pragma unroll
    for (int e = 0; e < 8; ++e) { a[e] *= scale; b[e] *= scale; }
    *(u32x4*)(dst + sub * 8) = pack8(a); *(u32x4*)(dst + 32 + sub * 8) = pack8(b);
}
template <int KIND>
DI void phase_post_qk(const Params& p, int bid, int nb, int tid) {
    const int wid = __builtin_amdgcn_readfirstlane(tid >> 6), lane = tid & 63, hd = lane >> 2, sub = lane & 3;
    constexpr int NRAW = KIND == 1 ? 1536 : 3072, KH = KIND == 1 ? 4 : 16;
    const bf16_t* raw = (const bf16_t*)(p.ws + WS_RAW);
    bf16_t* Q = (bf16_t*)(p.ws + WS_Q); bf16_t* Kb = (bf16_t*)(p.ws + WS_K);
    const float* qn = p.in[KIND == 0 ? 15 : KIND == 1 ? 20 : 32];
    const float* kn = p.in[KIND == 0 ? 16 : KIND == 1 ? 21 : 33];
    const float qscale = 0.125f * LOG2E;
    for (int r = bid * NW + wid; r < MROWS; r += nb * NW) {
        const int b = r / PP, pos = r - b * PP;
        const bool rope = (KIND != 0) && pos < SEQ;
        const int prow = (pos >> 6) & 63, pcol = pos & 63;
        const bf16_t* rr = raw + (size_t)r * NRAW;
        head64_norm_rope(rr + hd * 64, Q + (size_t)r * 1024 + hd * 64, qn, sub, rope, prow, pcol, qscale);
        if (hd < KH) head64_norm_rope(rr + 1024 + hd * 64, Kb + (size_t)r * (KH * 64) + hd * 64, kn, sub, rope, prow, pcol, 1.0f);
    }
}
DI void phase_post_mla1(const Params& p, int bid, int nb, int tid) {
    const int wid = __builtin_amdgcn_readfirstlane(tid >> 6), lane = tid & 63;
    const bf16_t* raw = (const bf16_t*)(p.ws + WS_Q);
    bf16_t* cqn = (bf16_t*)(p.ws + WS_O);
    bf16_t* ckvn = cqn + (size_t)MROWS * 384;
    bf16_t* krope = ckvn + (size_t)MROWS * 256;
    const float* qa = p.in[24]; const float* kva = p.in[25]; const float* kn = p.in[29];
    for (int r = bid * NW + wid; r < MROWS; r += nb * NW) {
        const int b = r / PP, pos = r - b * PP;
        const bf16_t* rr = raw + (size_t)r * 768;
        {
            float v[6];
#pragma unroll
            for (int j = 0; j < 3; ++j) { const unsigned w = *(const unsigned*)(rr + lane * 6 + 2 * j); v[2 * j] = bflo(w); v[2 * j + 1] = bfhi(w); }
            float ss = 0.f;
#pragma unroll
            for (int j = 0; j < 6; ++j) ss += v[j] * v[j];
            ss = wave_sum(ss);
            const float rs = rsqrtf(ss * (1.0f / 384.0f) + EPS);
#pragma unroll
            for (int j = 0; j < 3; ++j) *(unsigned*)(cqn + (size_t)r * 384 + lane * 6 + 2 * j) = pk2(v[2 * j] * rs * qa[lane * 6 + 2 * j], v[2 * j + 1] * rs * qa[lane * 6 + 2 * j + 1]);
        }
        {
            const u32x2 w = *(const u32x2*)(rr + 384 + lane * 4);
            float v[4] = {bflo(w.x), bfhi(w.x), bflo(w.y), bfhi(w.y)};
            float ss = v[0] * v[0] + v[1] * v[1] + v[2] * v[2] + v[3] * v[3];
            ss = wave_sum(ss);
            const float rs = rsqrtf(ss * (1.0f / 256.0f) + EPS);
            u32x2 o; o.x = pk2(v[0] * rs * kva[lane * 4], v[1] * rs * kva[lane * 4 + 1]); o.y = pk2(v[2] * rs * kva[lane * 4 + 2], v[3] * rs * kva[lane * 4 + 3]);
            *(u32x2*)(ckvn + (size_t)r * 256 + lane * 4) = o;
        }
        {
            float x1 = 0.f, x2 = 0.f;
            if (lane < 16) { x1 = bf2f(rr[640 + lane]); x2 = bf2f(rr[640 + 16 + lane]); }
            float ss = wave_sum(x1 * x1 + x2 * x2);
            const float rs = rsqrtf(ss * (1.0f / 32.0f) + EPS);
            if (lane < 16) {
                x1 *= rs * kn[64 + lane]; x2 *= rs * kn[64 + 16 + lane];
                if (pos < SEQ) {
                    const int prow = (pos >> 6) & 63, pcol = pos & 63;
                    const float* cs = ROPE32 + ((lane < 8 ? prow : pcol) * 8 + (lane & 7)) * 2;
                    const float c = cs[0], s = cs[1], a = x1, bb = x2;
                    x1 = a * c - bb * s; x2 = bb * c + a * s;
                }
                bf16_t* kr = (bf16_t*)(p.ws + WS_K) + (size_t)r * 1536 + 64;
                const bf16_t b1 = (bf16_t)f2bf(x1), b2 = (bf16_t)f2bf(x2);
#pragma unroll
                for (int hh = 0; hh < 16; ++hh) { kr[hh * 96 + lane] = b1; kr[hh * 96 + 16 + lane] = b2; }
            }
        }
    }
}
DI void phase_post_mla2(const Params& p, int bid, int nb, int tid) {
    const int wid = __builtin_amdgcn_readfirstlane(tid >> 6), lane = tid & 63, hd = lane >> 2, sub = lane & 3;
    const bf16_t* qraw = (const bf16_t*)(p.ws + WS_RAW);
    const bf16_t* kvraw = qraw + (size_t)MROWS * 1536;
    const bf16_t* krope = (const bf16_t*)(p.ws + WS_O) + (size_t)MROWS * 640;
    bf16_t* Q = (bf16_t*)(p.ws + WS_Q); bf16_t* Kb = (bf16_t*)(p.ws + WS_K);
    const float* qn = p.in[28]; const float* kn = p.in[29];
    const float qscale = 0.10206207261596577f * LOG2E;
    for (int r = bid * NW + wid; r < MROWS; r += nb * NW) {
        const int b = r / PP, pos = r - b * PP;
        const bf16_t* qr = qraw + (size_t)r * 1536 + hd * 96;
        bf16_t* qo = Q + (size_t)r * 1536 + hd * 96;
        {
            float a[8], c[8];
            unpack8(*(const u32x4*)(qr + sub * 16), a); unpack8(*(const u32x4*)(qr + sub * 16 + 8), c);
            float ss = 0.f;
#pragma unroll
            for (int e = 0; e < 8; ++e) ss += a[e] * a[e] + c[e] * c[e];
            ss = quad_sum(ss);
            const float rs = rsqrtf(ss * (1.0f / 64.0f) + EPS) * qscale;
#pragma unroll
            for (int e = 0; e < 8; ++e) { a[e] *= rs * qn[sub * 16 + e]; c[e] *= rs * qn[sub * 16 + 8 + e]; }
            *(u32x4*)(qo + sub * 16) = pack8(a); *(u32x4*)(qo + sub * 16 + 8) = pack8(c);
        }
        {
            const u32x2 w1 = *(const u32x2*)(qr + 64 + sub * 4), w2 = *(const u32x2*)(qr + 64 + 16 + sub * 4);
            float x1[4] = {bflo(w1.x), bfhi(w1.x), bflo(w1.y), bfhi(w1.y)}, x2[4] = {bflo(w2.x), bfhi(w2.x), bflo(w2.y), bfhi(w2.y)};
            float ss = 0.f;
#pragma unroll
            for (int e = 0; e < 4; ++e) ss += x1[e] * x1[e] + x2[e] * x2[e];
            ss = quad_sum(ss);
            const float rs = rsqrtf(ss * (1.0f / 32.0f) + EPS);
#pragma unroll
            for (int e = 0; e < 4; ++e) {
                const int i = sub * 4 + e;
                float a = x1[e] * rs * qn[64 + i], bb = x2[e] * rs * qn[64 + 16 + i];
                if (pos < SEQ) {
                    const int prow = (pos >> 6) & 63, pcol = pos & 63;
                    const float* cs = ROPE32 + ((i < 8 ? prow : pcol) * 8 + (i & 7)) * 2;
                    const float c = cs[0], s = cs[1], t1 = a, t2 = bb;
                    a = t1 * c - t2 * s; bb = t2 * c + t1 * s;
                }
                x1[e] = a * qscale; x2[e] = bb * qscale;
            }
            u32x2 o1, o2; o1.x = pk2(x1[0], x1[1]); o1.y = pk2(x1[2], x1[3]); o2.x = pk2(x2[0], x2[1]); o2.y = pk2(x2[2], x2[3]);
            *(u32x2*)(qo + 64 + sub * 4) = o1; *(u32x2*)(qo + 64 + 16 + sub * 4) = o2;
        }
        {
            const bf16_t* kr = kvraw + (size_t)r * 2048 + hd * 128;
            bf16_t* ko = Kb + (size_t)r * 1536 + hd * 96;
            float a[8], c[8];
            unpack8(*(const u32x4*)(kr + sub * 16), a); unpack8(*(const u32x4*)(kr + sub * 16 + 8), c);
            float ss = 0.f;
#pragma unroll
            for (int e = 0; e < 8; ++e) ss += a[e] * a[e] + c[e] * c[e];
            ss = quad_sum(ss);
            const float rs = rsqrtf(ss * (1.0f / 64.0f) + EPS);
#pragma unroll
            for (int e = 0; e < 8; ++e) { a[e] *= rs * kn[sub * 16 + e]; c[e] *= rs * kn[sub * 16 + 8 + e]; }
            *(u32x4*)(ko + sub * 16) = pack8(a); *(u32x4*)(ko + sub * 16 + 8) = pack8(c);
            *(u32x4*)(ko + 64 + sub * 8) = *(const u32x4*)(krope + (size_t)r * 32 + sub * 8);
        }
    }
}
DI void phase_diff_combine(const Params& p, int bid, int nb, int tid) {
    const int wid = __builtin_amdgcn_readfirstlane(tid >> 6), lane = tid & 63, hd = lane >> 3, sub = lane & 7;
    const bf16_t* O12 = (const bf16_t*)(p.ws + WS_H);
    bf16_t* Oc = (bf16_t*)(p.ws + WS_Q);
    const float* lam = p.in[34]; const float* subln = p.in[35];
    const float lambda_init = 0.8f - 0.6f * 0.40656965974059917f;
    const float s1 = wave_sum(lam[lane] * lam[64 + lane]), s2 = wave_sum(lam[128 + lane] * lam[192 + lane]);
    const float lam_full = expf(s1) - expf(s2) + lambda_init;
    for (int r = bid * NW + wid; r < MROWS; r += nb * NW) {
        const bf16_t* o1 = O12 + (size_t)r * 2048 + (2 * hd) * 128 + sub * 16, *o2 = o1 + 128;
        float a[16], c[16];
        unpack8(*(const u32x4*)o1, *(float(*)[8])a); unpack8(*(const u32x4*)(o1 + 8), *(float(*)[8])(a + 8));
        unpack8(*(const u32x4*)o2, *(float(*)[8])c); unpack8(*(const u32x4*)(o2 + 8), *(float(*)[8])(c + 8));
        float ss = 0.f;
#pragma unroll
        for (int e = 0; e < 16; ++e) { a[e] -= lam_full * c[e]; ss += a[e] * a[e]; }
        ss += __shfl_xor(ss, 1); ss += __shfl_xor(ss, 2); ss += __shfl_xor(ss, 4);
        const float rs = rsqrtf(ss * (1.0f / 128.0f) + EPS) * (1.0f - lambda_init);
#pragma unroll
        for (int e = 0; e < 16; ++e) a[e] *= rs * subln[sub * 16 + e];
        bf16_t* o = Oc + (size_t)r * 1024 + hd * 128 + sub * 16;
        *(u32x4*)o = pack8(*(float(*)[8])a); *(u32x4*)(o + 8) = pack8(*(float(*)[8])(a + 8));
    }
}


typedef short s16x4 __attribute__((ext_vector_type(4)));
typedef float f32x2_t __attribute__((ext_vector_type(2)));
typedef __bf16 bf16x2_t __attribute__((ext_vector_type(2)));
DI unsigned cvtpk(float lo, float hi) { f32x2_t v = {lo, hi}; bf16x2_t b = __builtin_convertvector(v, bf16x2_t); return __builtin_bit_cast(unsigned, b); }
DI float xhalf_max(float v) { auto rr = __builtin_amdgcn_permlane32_swap(__float_as_uint(v), __float_as_uint(v), false, false); return fmaxf(__uint_as_float(rr[0]), __uint_as_float(rr[1])); }
DI float xhalf_sum(float v) { auto rr = __builtin_amdgcn_permlane32_swap(__float_as_uint(v), __float_as_uint(v), false, false); return __uint_as_float(rr[0]) + __uint_as_float(rr[1]); }
typedef short v4i16_t __attribute__((__vector_size__(4 * sizeof(short))));
DI s16x4 lds_tr(lds_ptr p) { return __builtin_bit_cast(s16x4, __builtin_amdgcn_ds_read_tr16_b64_v4i16((LAS v4i16_t*)p)); }
constexpr float ATT_BIG = 40.0f, ATT_BIGF = 1.0995116e12f;
DI int crow(int i, int hf) { return (i & 3) + 8 * (i >> 2) + 4 * hf; }

struct AttnP { const bf16_t* Q; int ldq; const bf16_t* K; int ldk; const bf16_t* V; int ldv; bf16_t* O; int ldo; int HQ; int gk; int gv; int vhs  ; const float* bias; const float* sink; int need_ctx; const float* kgain  ; const float* lam; const float* subln; bf16_t* Oc;   };

template <int DQ, int DV, int MODE, int ABL = 0>
DI void attn_mfma(const AttnP& a, unsigned char* smem, int bid, int nb, int tid) {
    constexpr int KSTR = DQ * 2 + 16, KTB = 64 * KSTR, VTB = 64 * DV * 2, NDB = DV / 32, NKK = DQ / 16;
    constexpr int KCH = DQ / 8, VCH = DV / 8, NKI = (64 * KCH + NTHREADS - 1) / NTHREADS, NVI = (64 * VCH + NTHREADS - 1) / NTHREADS;
    static_assert(2 * KTB + 2 * VTB + 2048 <= GEMM_LDS, "attention LDS");
    const lds_ptr lds = (lds_ptr)smem;
    LAS float* biasl = (LAS float*)(lds + 2 * KTB + 2 * VTB);
    const int lane = tid & 63, wid = __builtin_amdgcn_readfirstlane(tid >> 6), r = lane & 31, hf = lane >> 5;
    const int nq = a.need_ctx ? 17 : 16;
    const int xcd = bid & 7, slot = bid >> 3, nslots = nb >> 3, per_xcd = (NBATCH * a.HQ / 8) * nq;
    int koff[NKI], kdst[NKI], voff[NVI], vdst[NVI];
#pragma unroll
    for (int i = 0; i < NKI; ++i) { const int c = min(tid + NTHREADS * i, 64 * KCH - 1), row = c / KCH, kc = c - row * KCH; koff[i] = row * a.ldk + kc * 8; kdst[i] = row * KSTR + kc * 16; }
#pragma unroll
    for (int i = 0; i < NVI; ++i) { const int c = tid + NTHREADS * i, row = c / VCH, vc = c - row * VCH; voff[i] = row * a.ldv + vc * 8; vdst[i] = ((row >> 3) * NDB + (vc >> 2)) * 512 + (row & 7) * 64 + (vc & 3) * 16; }
    const int i16 = lane & 15, trq = i16 >> 2, trp = i16 & 3, grp = (lane >> 4) & 1;
    const int vtr0 = (4 * hf + trq) * 64 + 32 * grp + 8 * trp;
    constexpr bool PAIRED = (MODE == 2 && DV == 128);
    float lam_full = 0.f;
    if (PAIRED) { const float s1 = wave_sum(a.lam[lane] * a.lam[64 + lane]), s2 = wave_sum(a.lam[128 + lane] * a.lam[192 + lane]); lam_full = expf(s1) - expf(s2) + (0.8f - 0.6f * 0.40656965974059917f); }
    int it_i = 0;
    for (int j = slot; j < per_xcd; j += nslots, ++it_i) {
        const int nbh = NBATCH * a.HQ / 8;
        const int bhl = j < nbh * 16 ? j >> 4 : j - nbh * 16;
        int qt = j < nbh * 16 ? j & 15 : 16;
        int bh = bhl * 8 + xcd;
        if (MODE == 1) { const int P = (bhl >> 2) * 8 + xcd; bh = (P >> 2) * a.HQ + (P & 3) * 4 + (bhl & 3); }
        if (PAIRED) { const int pu = slot + nslots * (it_i >> 1); qt = pu & 15; bh = (pu >> 4) * a.HQ + 2 * xcd + (it_i & 1); }
        const int h = bh % a.HQ, b = bh / a.HQ;
        const bool is_ctx = qt >= 16;
        const int q0 = is_ctx ? SEQ : qt * 256;
        int t_lo = 0, n_lat = 0;
        if (!is_ctx) {
            if (MODE == 2) { t_lo = 0; n_lat = 64; }
            else if (MODE == 1) { t_lo = max(0, 4 * qt - 2); n_lat = min(63, 4 * qt + 5) - t_lo + 1; }
            else { const int r0 = 4 * qt; t_lo = min(max(r0 - 4, 0), 56); n_lat = min(max(r0 - 1, 0), 56) + 7 - t_lo + 1; }
        }
        const int ntiles = n_lat + 4;
        const int qw0 = q0 + wid * 32, qpos = qw0 + r;
        const size_t qrow = (size_t)b * PP + qpos;
        bf16x8 qf[NKK];
#pragma unroll
        for (int kk = 0; kk < NKK; ++kk) qf[kk] = *(const bf16x8*)(a.Q + qrow * a.ldq + h * DQ + kk * 16 + hf * 8);
        if (MODE == 0 && !is_ctx) { for (int i = tid; i < 465; i += NTHREADS) biasl[i] = a.bias[h * 465 + i] * LOG2E; }
        const bf16_t* Kg = a.K + (size_t)b * PP * a.ldk + (h >> a.gk) * DQ;
        const bf16_t* Vg = a.V + (size_t)b * PP * a.ldv + (h >> a.gv) * a.vhs;
        f32x16 o[NDB];
#pragma unroll
        for (int d = 0; d < NDB; ++d)
#pragma unroll
            for (int i = 0; i < 16; ++i) o[d][i] = 0.f;
        float mref = 0.f, l = 0.f;
        f32x16 negm;
#pragma unroll
        for (int i = 0; i < 16; ++i) negm[i] = 0.f;
        bool first = true;
        float lbig = 0.f;
        float one = 1.0f; asm volatile("" : "+v"(one));
#define ATT_TILE(IT) ((IT) < n_lat ? t_lo + (IT) : 64 + ((IT) - n_lat))
        auto tile_active = [&](int t) -> bool {
            if (t >= 64) return true;
            if (MODE == 1) return (t * 64 + 63 >= qw0 - 128) && (t * 64 <= qw0 + 31 + 128);
            if (MODE == 0) { const int rw = qw0 >> 6, row0 = min(max(rw - 4, 0), 56); return t >= row0 && t < row0 + 8; }
            return true;
        };
        auto qk = [&](f32x16 (&s)[2], const lds_ptr Kb) {
#pragma unroll
            for (int kk = 0; kk < NKK; ++kk)
#pragma unroll
                for (int kb = 0; kb < 2; ++kb) {
                    if (ABL & 4) { if (kk == 0) s[kb] = negm; }
                    else {
                    const bf16x8 kf = *(const LAS bf16x8*)(Kb + (kb * 32 + r) * KSTR + (kk * 2 + hf) * 16);
                    s[kb] = MFMA32(kf, qf[kk], kk == 0 ? negm : s[kb]);
                    }
                }
        };
        u32x4 kr[NKI], vr[NVI];
        {
            const int t0 = ATT_TILE(0), t1 = ATT_TILE(1);
            u32x4 k1[NKI];
#pragma unroll
            for (int i = 0; i < NKI; ++i) kr[i] = *(const u32x4*)(Kg + (size_t)t0 * 64 * a.ldk + koff[i]);
#pragma unroll
            for (int i = 0; i < NVI; ++i) vr[i] = *(const u32x4*)(Vg + (size_t)t0 * 64 * a.ldv + voff[i]);
#pragma unroll
            for (int i = 0; i < NKI; ++i) k1[i] = *(const u32x4*)(Kg + (size_t)t1 * 64 * a.ldk + koff[i]);
#pragma unroll
            for (int i = 0; i < NKI; ++i) { *(LAS u32x4*)(lds + kdst[i]) = kr[i]; *(LAS u32x4*)(lds + KTB + kdst[i]) = k1[i]; }
#pragma unroll
            for (int i = 0; i < NVI; ++i) *(LAS u32x4*)(lds + 2 * KTB + vdst[i]) = vr[i];
        }
        __syncthreads();
        f32x16 sc[2], sn[2];
        bool act_cur = tile_active(ATT_TILE(0)), act_nxt = false;
        if (act_cur) qk(sc, lds);
        __syncthreads();
        auto step = [&](const int it, const int e, const bool N2, const bool N1) {
            const int t = ATT_TILE(it);
            if (N2 && !(ABL & 8) && (!(ABL & 128) || e)) {
                const int tn = ATT_TILE(it + 2);
#pragma unroll
                for (int i = 0; i < NKI; ++i) kr[i] = *(const u32x4*)(Kg + (size_t)tn * 64 * a.ldk + koff[i]);
            }
            if (N1 && !(ABL & 8) && (!(ABL & 128) || e)) {
                const int tn = ATT_TILE(it + 1);
#pragma unroll
                for (int i = 0; i < NVI; ++i) vr[i] = *(const u32x4*)(Vg + (size_t)tn * 64 * a.ldv + voff[i]);
            }
            SCHED_FENCE();
            act_nxt = N1 && (MODE == 2 || tile_active(ATT_TILE(it + 1)));
            const lds_ptr Vb = lds + 2 * KTB + e * VTB;
            const bool do_cur = MODE == 2 || act_cur;
            if (do_cur) {
                if (t < 64 && MODE == 1 && !((t * 64 + 63 - qw0 <= 128) && (qw0 + 31 - t * 64 <= 128))) {
                    const int dbase = t * 64 + 4 * hf - qpos;
#pragma unroll
                    for (int kb = 0; kb < 2; ++kb)
#pragma unroll
                        for (int i = 0; i < 16; ++i) { const int c = kb * 32 + (i & 3) + 8 * (i >> 2); sc[kb][i] = (dbase > 128 - c || dbase < -128 - c) ? -INFINITY : sc[kb][i]; }
                }
                if (t < 64 && MODE == 0) {
                    const int qc = qpos & 63, rw = qpos >> 6, col0 = min(max(qc - 8, 0), 48);
                    const int brow = (t - rw + 7) * 31 + 15 - qc;
#pragma unroll
                    for (int kb = 0; kb < 2; ++kb)
#pragma unroll
                        for (int i = 0; i < 16; ++i) {
                            const int kc = kb * 32 + crow(i, hf);
                            const bool ok = kc >= col0 && kc < col0 + 16;
                            const float bv = biasl[ok ? brow + kc : 0];
                            sc[kb][i] = ok ? sc[kb][i] + bv : -INFINITY;
                        }
                }
                if (first || __builtin_amdgcn_ballot_w64(lbig > ATT_BIGF) != 0ull) {
                    float delta = lbig > ATT_BIGF ? ATT_BIG : 0.f;
                    if (first) {
                        float mx = sc[0][0];
#pragma unroll
                        for (int i = 1; i < 16; ++i) mx = fmaxf(mx, sc[0][i]);
#pragma unroll
                        for (int i = 0; i < 16; ++i) mx = fmaxf(mx, sc[1][i]);
                        mx = xhalf_max(mx);
                        delta = mx > -INFINITY ? mx : 0.f;
                    }
                    const float alpha = __builtin_amdgcn_exp2f(-delta);
                    l *= alpha; mref += delta;
#pragma unroll
                    for (int d = 0; d < NDB; ++d)
#pragma unroll
                        for (int i = 0; i < 16; ++i) o[d][i] *= alpha;
#pragma unroll
                    for (int kb = 0; kb < 2; ++kb)
#pragma unroll
                        for (int i = 0; i < 16; ++i) sc[kb][i] -= delta;
#pragma unroll
                    for (int i = 0; i < 16; ++i) negm[i] = -mref;
                    first = false;
                }
            }
            if (N1) qk(sn, lds + (e ^ 1) * KTB);
            if (do_cur) {
                float ls0 = 0.f, ls1 = 0.f;
#pragma unroll
                for (int kb = 0; kb < 2; ++kb)
#pragma unroll
                    for (int i = 0; i < 16; i += 2) {
                        const float p0 = (ABL & 1) ? sc[kb][i] : __builtin_amdgcn_exp2f(sc[kb][i]), p1 = (ABL & 1) ? sc[kb][i + 1] : __builtin_amdgcn_exp2f(sc[kb][i + 1]);
                        sc[kb][i] = p0; sc[kb][i + 1] = p1;
                        if (!(ABL & 16)) { ls0 += p0; ls1 = __builtin_fmaf(p1, one, ls1); }
                    }
                lbig = ls0 + ls1;
                l += lbig;
                bf16x8 pf[4];
#pragma unroll
                for (int kb = 0; kb < 2; ++kb)
#pragma unroll
                    for (int sp = 0; sp < 2; ++sp) {
                        u32x4 w;
                        w.x = cvtpk(sc[kb][8 * sp], sc[kb][8 * sp + 1]); w.y = cvtpk(sc[kb][8 * sp + 2], sc[kb][8 * sp + 3]);
                        w.z = cvtpk(sc[kb][8 * sp + 4], sc[kb][8 * sp + 5]); w.w = cvtpk(sc[kb][8 * sp + 6], sc[kb][8 * sp + 7]);
                        pf[kb * 2 + sp] = __builtin_bit_cast(bf16x8, w);
                    }
#pragma unroll
                for (int ks = 0; ks < 4; ++ks)
#pragma unroll
                    for (int d = 0; d < NDB; ++d) {
                        const lds_ptr vp = Vb + ((2 * ks) * NDB + d) * 512 + vtr0;
                        const s16x4 lo = lds_tr(vp), hi = lds_tr(vp + NDB * 512);
                        const bf16x8 vf = __builtin_shufflevector(lo, hi, 0, 1, 2, 3, 4, 5, 6, 7);
                        if (ABL & 2) { if (d == 0 && ks == 0) o[0][0] += __builtin_bit_cast(float, pf[0][0] | pf[1][0] | pf[2][0] | pf[3][0]) + __builtin_bit_cast(float, (int)vf[0]); } else
                        o[d] = MFMA32(vf, pf[ks], o[d]);
                    }
            }
            SCHED_FENCE();
            if (N2 && !(ABL & 8) && (!(ABL & 128) || e)) {
#pragma unroll
                for (int i = 0; i < NKI; ++i) *(LAS u32x4*)(lds + e * KTB + kdst[i]) = kr[i];
            }
            if (N1 && !(ABL & 8) && (!(ABL & 128) || e)) {
#pragma unroll
                for (int i = 0; i < NVI; ++i) *(LAS u32x4*)(lds + 2 * KTB + (e ^ 1) * VTB + vdst[i]) = vr[i];
            }
            if (!(ABL & 64) && (!(ABL & 128) || e)) __syncthreads();
#pragma unroll
            for (int kb = 0; kb < 2; ++kb) sc[kb] = sn[kb];
            act_cur = act_nxt;
        };
        int it = 0;
        for (; it + 3 < ntiles; it += 2) { step(it, 0, true, true); step(it + 1, 1, true, true); }
        if (ntiles - it == 3) { step(it, 0, true, true); step(it + 1, 1, false, true); step(it + 2, 0, false, false); }
        else { step(it, 0, false, true); step(it + 1, 1, false, false); }
#undef ATT_TILE
        l = xhalf_sum(l);
        if (a.sink) {
            l += __builtin_amdgcn_exp2f(a.sink[h] * LOG2E - mref);
        }
        const float inv = 1.0f / l;
        bf16_t* orow = a.O + qrow * a.ldo + h * DV + 4 * hf;
#pragma unroll
        for (int d = 0; d < NDB; ++d)
#pragma unroll
            for (int g = 0; g < 4; ++g) {
                u32x2 w; w.x = cvtpk(o[d][4 * g] * inv, o[d][4 * g + 1] * inv); w.y = cvtpk(o[d][4 * g + 2] * inv, o[d][4 * g + 3] * inv);
                *(u32x2*)(orow + d * 32 + 8 * g) = w;
            }
        if (PAIRED && (it_i & 1)) {
            asm volatile("s_waitcnt vmcnt(0)" ::: "memory");
            const float lambda_init = 0.8f - 0.6f * 0.40656965974059917f;
            const int sub = lane & 7, pair = h >> 1;
#pragma unroll
            for (int i4 = 0; i4 < 4; ++i4) {
                const size_t row = (size_t)b * PP + qw0 + i4 * 8 + (lane >> 3);
                const bf16_t* o1 = a.O + row * a.ldo + (2 * pair) * 128 + sub * 16, *o2 = o1 + 128;
                float av[16], cv[16];
                unpack8(*(const u32x4*)o1, *(float(*)[8])av); unpack8(*(const u32x4*)(o1 + 8), *(float(*)[8])(av + 8));
                unpack8(*(const u32x4*)o2, *(float(*)[8])cv); unpack8(*(const u32x4*)(o2 + 8), *(float(*)[8])(cv + 8));
                float ss = 0.f;
#pragma unroll
                for (int e = 0; e < 16; ++e) { av[e] -= lam_full * cv[e]; ss += av[e] * av[e]; }
                ss += __shfl_xor(ss, 1); ss += __shfl_xor(ss, 2); ss += __shfl_xor(ss, 4);
                const float rs = rsqrtf(ss * (1.0f / 128.0f) + EPS) * (1.0f - lambda_init);
#pragma unroll
                for (int e = 0; e < 16; ++e) av[e] *= rs * a.subln[sub * 16 + e];
                bf16_t* oc = a.Oc + row * 1024 + pair * 128 + sub * 16;
                *(u32x4*)oc = pack8(*(float(*)[8])av); *(u32x4*)(oc + 8) = pack8(*(float(*)[8])(av + 8));
            }
        }
    }
}

DI void attn_na(const AttnP& a, unsigned char* smem, int bid, int nb, int tid) {
    constexpr int DQ = 64, DV = 64, KSTR = DQ * 2 + 16, KTB = 64 * KSTR, VTB = 64 * DV * 2, NDB = 2, NKK = 4;
    const lds_ptr lds = (lds_ptr)smem;
    constexpr int BZ_TAB = 32, BZ_HEAD = 560, BZ_NINF = 16 * BZ_HEAD, BZ_N = BZ_NINF + 64;
    static_assert(4 * KTB + 4 * VTB + (BZ_N + 16) * 4 <= GEMM_LDS, "NA LDS");
    LAS float* biasl = (LAS float*)(lds + 4 * KTB + 4 * VTB);
    for (int i = tid; i < BZ_N; i += NTHREADS) {
        const int hh = i / BZ_HEAD, o = i - hh * BZ_HEAD;
        biasl[i] = i >= BZ_NINF ? -INFINITY : (o >= BZ_TAB && o < BZ_TAB + 465) ? a.bias[hh * 465 + o - BZ_TAB] * LOG2E : 0.f;
    }
    __syncthreads();
    {
        const int wv = __builtin_amdgcn_readfirstlane(tid >> 6), ln = tid & 63;
#pragma unroll
        for (int hh2 = 0; hh2 < 2; ++hh2) {
            const int hh = 2 * wv + hh2;
            float m = 0.f;
            for (int i = ln; i < 465; i += 64) m = fmaxf(m, biasl[hh * BZ_HEAD + BZ_TAB + i]);
#pragma unroll
            for (int d = 32; d >= 1; d >>= 1) m = fmaxf(m, __shfl_xor(m, d));
            if (ln == 0) biasl[BZ_N + hh] = m;
        }
    }
    float kmax = fabsf(a.kgain[tid & 63]);
#pragma unroll
    for (int d = 32; d >= 1; d >>= 1) kmax = fmaxf(kmax, __shfl_xor(kmax, d));
    kmax *= 8.0f * 1.01f;
    const int lane = tid & 63, wid = __builtin_amdgcn_readfirstlane(tid >> 6), r = lane & 31, hf = lane >> 5;
    const int nq = a.need_ctx ? 17 : 16;
    const int xcd = bid & 7, slot = bid >> 3, nslots = nb >> 3, per_xcd = (NBATCH * a.HQ / 8) * nq;
    const int krow_s = tid >> 3, kc_s = tid & 7;
    const int koff = krow_s * a.ldk + kc_s * 8, kdst = krow_s * KSTR + kc_s * 16, voff = krow_s * a.ldv + kc_s * 8;
    const int vdst = ((krow_s >> 3) * NDB + (kc_s >> 2)) * 512 + (krow_s & 7) * 64 + (kc_s & 3) * 16;
    const int i16 = lane & 15, trq = i16 >> 2, trp = i16 & 3, grp = (lane >> 4) & 1;
    const int vtr0 = (4 * hf + trq) * 64 + 32 * grp + 8 * trp;
    const int rp = wid >> 2, cq = wid & 3, k0 = cq == 0 ? 0 : cq == 1 ? 8 : cq == 2 ? 24 : 32;
    float one = 1.0f; asm volatile("" : "+v"(one));
    auto unit_of = [&](int j, int& b, int& h, int& qt, int& t_lo, int& n_lat) {
        const int nbh = NBATCH * a.HQ / 8;
        const int bhl = j < nbh * 16 ? j >> 4 : j - nbh * 16; qt = j < nbh * 16 ? j & 15 : 16;
        const int bh = bhl * 8 + xcd; h = bh % a.HQ; b = bh / a.HQ;
        t_lo = 0; n_lat = 0;
        if (qt < 16) { const int r0 = 4 * qt; t_lo = min(max(r0 - 4, 0), 56); n_lat = min(max(r0 - 1, 0), 56) + 7 - t_lo + 1; n_lat += n_lat & 1; }
    };
#define NA_TILE_OF(IT, TLO, NLAT) ((IT) < (NLAT) ? (TLO) + (IT) : 64 + ((IT) - (NLAT)))
    bf16x8 qf[NKK];
    u32x4 krA[2], vrA[2], krB[2], vrB[2];
    auto load_pair = [&](u32x4 (&kr)[2], u32x4 (&vr)[2], const bf16_t* Kg, const bf16_t* Vg, int t_lo, int n_lat, int pr) {
#pragma unroll
        for (int jj = 0; jj < 2; ++jj) {
            const int tn = NA_TILE_OF(2 * pr + jj, t_lo, n_lat);
            kr[jj] = *(const u32x4*)(Kg + (size_t)tn * 64 * a.ldk + koff); vr[jj] = *(const u32x4*)(Vg + (size_t)tn * 64 * a.ldv + voff);
        }
    };
    auto store_pair = [&](const u32x4 (&kr)[2], const u32x4 (&vr)[2], int e) {
#pragma unroll
        for (int jj = 0; jj < 2; ++jj) { *(LAS u32x4*)(lds + (2 * e + jj) * KTB + kdst) = kr[jj]; *(LAS u32x4*)(lds + 4 * KTB + (2 * e + jj) * VTB + vdst) = vr[jj]; }
    };
    auto qrow_of = [&](int b, int qt) -> size_t { const int qpos = qt >= 16 ? SEQ + wid * 32 + r : (4 * qt + 2 * rp + (r >> 4)) * 64 + 16 * cq + (r & 15); return (size_t)b * PP + qpos; };
    auto load_q = [&](int b, int h, int qt) {
        const size_t qrow = qrow_of(b, qt);
#pragma unroll
        for (int kk = 0; kk < NKK; ++kk) qf[kk] = *(const bf16x8*)(a.Q + qrow * a.ldq + h * DQ + kk * 16 + hf * 8);
    };
    if (slot >= per_xcd) return;
    int b, h, qt, t_lo, n_lat;
    unit_of(slot, b, h, qt, t_lo, n_lat);
    {
        load_q(b, h, qt);
        const bf16_t* Kg = a.K + (size_t)b * PP * a.ldk + h * DQ; const bf16_t* Vg = a.V + (size_t)b * PP * a.ldv + h * a.vhs;
        load_pair(krA, vrA, Kg, Vg, t_lo, n_lat, 0); store_pair(krA, vrA, 0); load_pair(krB, vrB, Kg, Vg, t_lo, n_lat, 1);
    }
    __syncthreads();
    for (int j = slot;;) {
        const int jn = j + nslots; const bool has_next = jn < per_xcd;
        int nb_, nh, nqt, nt_lo, nn_lat;
        unit_of(has_next ? jn : j, nb_, nh, nqt, nt_lo, nn_lat);
        const bf16_t* nKg = a.K + (size_t)nb_ * PP * a.ldk + nh * DQ; const bf16_t* nVg = a.V + (size_t)nb_ * PP * a.ldv + nh * a.vhs;
        const bool is_ctx = qt >= 16;
        const int r0 = 4 * qt;
        const int npair = (n_lat + 4) >> 1;
        const int qrw = r0 + 2 * rp + (r >> 4), qc = 16 * cq + (r & 15);
        const size_t qrow = qrow_of(b, qt);
        const bf16_t* Kg = a.K + (size_t)b * PP * a.ldk + h * DQ;
        const bf16_t* Vg = a.V + (size_t)b * PP * a.ldv + h * a.vhs;
        const int rwA = r0 + 2 * rp, wlo = min(max(rwA - 4, 0), 56), whi = min(max(rwA - 3, 0), 56) + 7;
        const int col0 = min(max(qc - 8, 0), 48), row0q = min(max(qrw - 4, 0), 56);
        const int lanebase = h * BZ_HEAD + BZ_TAB + (7 - qrw) * 31 + 15 - qc + k0 + 4 * hf;
        f32x16 o[NDB];
#pragma unroll
        for (int d = 0; d < NDB; ++d)
#pragma unroll
            for (int i = 0; i < 16; ++i) o[d][i] = 0.f;
        float l = 0.f;
        float qn2 = 0.f;
#pragma unroll
        for (int kk = 0; kk < NKK; ++kk)
#pragma unroll
            for (int jj = 0; jj < 8; ++jj) { const float qv = bf2f((bf16_t)qf[kk][jj]); qn2 = __builtin_fmaf(qv, qv, qn2); }
        qn2 = xhalf_sum(qn2);
        const float mref = __builtin_sqrtf(qn2) * kmax + biasl[BZ_N + h];
        f32x16 negmL;
#pragma unroll
        for (int i = 0; i < 16; ++i) { const int kc = k0 + crow(i, hf); negmL[i] = (kc >= col0 && kc < col0 + 16) ? -mref : -INFINITY; }
#define NA_TILE(IT) NA_TILE_OF(IT, t_lo, n_lat)
        auto ctx_tile = [&](const lds_ptr Kb, const lds_ptr Vb) {
            {
                f32x16 s[2], negm;
#pragma unroll
                for (int i = 0; i < 16; ++i) negm[i] = -mref;
#pragma unroll
                for (int kk = 0; kk < NKK; ++kk)
#pragma unroll
                    for (int kb = 0; kb < 2; ++kb) {
                        const bf16x8 kf = *(const LAS bf16x8*)(Kb + (kb * 32 + r) * KSTR + (kk * 2 + hf) * 16);
                        s[kb] = MFMA32(kf, qf[kk], kk == 0 ? negm : s[kb]);
                    }
                float ls0 = 0.f, ls1 = 0.f;
                bf16x8 pf[4];
#pragma unroll
                for (int kb = 0; kb < 2; ++kb) {
#pragma unroll
                    for (int i = 0; i < 16; i += 2) {
                        const float p0 = __builtin_amdgcn_exp2f(s[kb][i]), p1 = __builtin_amdgcn_exp2f(s[kb][i + 1]);
                        s[kb][i] = p0; s[kb][i + 1] = p1; ls0 += p0; ls1 = __builtin_fmaf(p1, one, ls1);
                    }
#pragma unroll
                    for (int sp = 0; sp < 2; ++sp) {
                        u32x4 w;
                        w.x = cvtpk(s[kb][8 * sp], s[kb][8 * sp + 1]); w.y = cvtpk(s[kb][8 * sp + 2], s[kb][8 * sp + 3]);
                        w.z = cvtpk(s[kb][8 * sp + 4], s[kb][8 * sp + 5]); w.w = cvtpk(s[kb][8 * sp + 6], s[kb][8 * sp + 7]);
                        pf[kb * 2 + sp] = __builtin_bit_cast(bf16x8, w);
                    }
                }
                l += ls0 + ls1;
#pragma unroll
                for (int ks = 0; ks < 4; ++ks)
#pragma unroll
                    for (int d = 0; d < NDB; ++d) {
                        const lds_ptr vp = Vb + ((2 * ks) * NDB + d) * 512 + vtr0;
                        const s16x4 lo = lds_tr(vp), hi = lds_tr(vp + NDB * 512);
                        o[d] = MFMA32(__builtin_shufflevector(lo, hi, 0, 1, 2, 3, 4, 5, 6, 7), pf[ks], o[d]);
                    }
            }
        };
        auto lat_tile = [&](const int t, const lds_ptr Kb, const lds_ptr Vb) {
            bf16x8 pf[2];
#pragma unroll
            for (int sp = 0; sp < 2; ++sp)
#pragma unroll
                for (int jj = 0; jj < 8; ++jj) pf[sp][jj] = 0;
            if (t >= wlo && t <= whi) {
                f32x16 s;
#pragma unroll
                for (int kk = 0; kk < NKK; ++kk) {
                    const bf16x8 kf = *(const LAS bf16x8*)(Kb + (k0 + r) * KSTR + (kk * 2 + hf) * 16);
                    s = MFMA32(kf, qf[kk], kk == 0 ? negmL : s);
                }
                const LAS float* bp = biasl + (((unsigned)(t - row0q) < 8u) ? lanebase + 31 * t : BZ_NINF);
#pragma unroll
                for (int i = 0; i < 16; ++i) s[i] += bp[crow(i, 0)];
                float ls0 = 0.f, ls1 = 0.f;
#pragma unroll
                for (int i = 0; i < 16; i += 2) {
                    const float p0 = __builtin_amdgcn_exp2f(s[i]), p1 = __builtin_amdgcn_exp2f(s[i + 1]);
                    s[i] = p0; s[i + 1] = p1; ls0 += p0; ls1 = __builtin_fmaf(p1, one, ls1);
                }
#pragma unroll
                for (int sp = 0; sp < 2; ++sp) {
                    u32x4 w;
                    w.x = cvtpk(s[8 * sp], s[8 * sp + 1]); w.y = cvtpk(s[8 * sp + 2], s[8 * sp + 3]);
                    w.z = cvtpk(s[8 * sp + 4], s[8 * sp + 5]); w.w = cvtpk(s[8 * sp + 6], s[8 * sp + 7]);
                    pf[sp] = __builtin_bit_cast(bf16x8, w);
                }
                l += ls0 + ls1;
            }
#pragma unroll
            for (int ks = 0; ks < 2; ++ks)
#pragma unroll
                for (int d = 0; d < NDB; ++d) {
                    const lds_ptr vp = Vb + (((k0 >> 3) + 2 * ks) * NDB + d) * 512 + vtr0;
                    const s16x4 lo = lds_tr(vp), hi = lds_tr(vp + NDB * 512);
                    o[d] = MFMA32(__builtin_shufflevector(lo, hi, 0, 1, 2, 3, 4, 5, 6, 7), pf[ks], o[d]);
                }
        };
#define NA_ITER(IP, E, KL, VL, KS, VS, LAT) do { \
            if ((IP) + 2 < npair) load_pair(KL, VL, Kg, Vg, t_lo, n_lat, (IP) + 2); \
            else if (has_next) load_pair(KL, VL, nKg, nVg, nt_lo, nn_lat, (IP) + 2 - npair); \
            SCHED_FENCE(); \
            if (LAT) { lat_tile(t_lo + 2 * (IP), lds + (2 * (E)) * KTB, lds + 4 * KTB + (2 * (E)) * VTB); lat_tile(t_lo + 2 * (IP) + 1, lds + (2 * (E) + 1) * KTB, lds + 4 * KTB + (2 * (E) + 1) * VTB); } \
            else { ctx_tile(lds + (2 * (E)) * KTB, lds + 4 * KTB + (2 * (E)) * VTB); ctx_tile(lds + (2 * (E) + 1) * KTB, lds + 4 * KTB + (2 * (E) + 1) * VTB); } \
            SCHED_FENCE(); \
            if ((IP) + 1 < npair || has_next) store_pair(KS, VS, (E) ^ 1); \
            __syncthreads(); } while (0)
        int ip = 0;
        for (; ip < (n_lat >> 1); ip += 2) { NA_ITER(ip, 0, krA, vrA, krB, vrB, true); NA_ITER(ip + 1, 1, krB, vrB, krA, vrA, true); }
        NA_ITER(ip, 0, krA, vrA, krB, vrB, false); NA_ITER(ip + 1, 1, krB, vrB, krA, vrA, false);
#undef NA_ITER
        if (has_next) load_q(nb_, nh, nqt);
#undef NA_TILE
        l = xhalf_sum(l);
        const float inv = 1.0f / l;
        bf16_t* orow = a.O + qrow * a.ldo + h * DV + 4 * hf;
#pragma unroll
        for (int d = 0; d < NDB; ++d)
#pragma unroll
            for (int g = 0; g < 4; ++g) {
                u32x2 w; w.x = cvtpk(o[d][4 * g] * inv, o[d][4 * g + 1] * inv); w.y = cvtpk(o[d][4 * g + 2] * inv, o[d][4 * g + 3] * inv);
                *(u32x2*)(orow + d * 32 + 8 * g) = w;
            }
        if (!has_next) break;
        j = jn; b = nb_; h = nh; qt = nqt; t_lo = nt_lo; n_lat = nn_lat;
    }
#undef NA_TILE_OF
}

namespace pg8 {
constexpr int BM = 256, BK = 64, HALF = 128, HTB = HALF * BK * 2  ;
DI int lds_byte(int r, int c) { const int st = (r >> 4) * 2 + (c >> 5), rr = r & 15, cc = c & 31, ob = rr * 64 + cc * 2; return st * 1024 + (ob ^ (((ob >> 9) & 1) << 5)); }
DI void stage_rc(int b, int& R, int& C) { const int st = b / 1024, sb = b % 1024, swz = sb ^ (((sb >> 9) & 1) << 5); R = (st >> 1) * 16 + swz / 64; C = (st & 1) * 32 + (swz % 64) / 2; }
DI int perm32(int rho) { const int n = rho >> 4, i = rho & 15; return 8 * (i >> 2) + 4 * n + (i & 3); }

template <class Epi, class Sched>
DI void gemm_phase(lds_ptr lds, const bf16_t* __restrict__ Aop, const int K, const Sched& S, const Epi& E, const int tid) {
    const int wid = __builtin_amdgcn_readfirstlane(tid >> 6), lane = tid & 63, wr = wid >> 2, wc = wid & 3, fr = lane & 15, fq = lane >> 4;
    const int nt = K / BK;
    int Ra[2], Ca[2]; unsigned voffB[2];
#pragma unroll
    for (int i = 0; i < 2; ++i) { int R, C; stage_rc(tid * 16 + i * 8192, R, C); const int Rb = Epi::PERM ? ((R & ~31) + perm32(R & 31)) : R;
        Ra[i] = R; Ca[i] = C; voffB[i] = (unsigned)(Rb * K + C) * 2u; }
    const size_t kstep = (size_t)(BK * 2);
    const size_t hstep = (size_t)HALF * K * 2;
    const unsigned ldsw = (unsigned)wid * 1024u;
    const int aoff = lds_byte(wr * 64 + fr, fq * 8), boff = lds_byte(wc * 32 + fr, fq * 8);
#define PG8_SA(b, h) (((b) * 2 + (h)) * HTB)
#define PG8_SB(b, h) ((4 + (b) * 2 + (h)) * HTB)
#define PG8_STAGE(bufoff, gbase, voff) do { const char* _gb = (const char*)(gbase); asm volatile("" : "+s"(_gb)); _Pragma("unroll") for (int _i = 0; _i < 2; ++_i) { \
        unsigned _o = (voff)[_i]; asm volatile("" : "+v"(_o)); \
        __builtin_amdgcn_global_load_lds((const unsigned*)(_gb + _o), (LAS unsigned*)(lds + (bufoff) + ldsw + _i * 8192), 16, 0, 0); } } while (0)
#define PG8_LDA(dst, b, h) do { _Pragma("unroll") for (int m = 0; m < 4; ++m) _Pragma("unroll") for (int k = 0; k < 2; ++k) dst[m][k] = *(const LAS bf16x8*)(lds + PG8_SA(b, h) + aoff + m * 2048 + k * 1024); } while (0)
#define PG8_LDB(dst, b, h) do { _Pragma("unroll") for (int n = 0; n < 2; ++n) _Pragma("unroll") for (int k = 0; k < 2; ++k) dst[n][k] = *(const LAS bf16x8*)(lds + PG8_SB(b, h) + boff + n * 2048 + k * 1024); } while (0)
#define PG8_MMA(ai, bj, At, Bt) do { __builtin_amdgcn_s_setprio(1); _Pragma("unroll") for (int m = 0; m < 4; ++m) _Pragma("unroll") for (int n = 0; n < 2; ++n) _Pragma("unroll") for (int k = 0; k < 2; ++k) \
        acc[ai][bj][m][n] = __builtin_amdgcn_mfma_f32_16x16x32_bf16(Bt[n][k], At[m][k], acc[ai][bj][m][n], 0, 0, 0); __builtin_amdgcn_s_setprio(0); } while (0)
#define PG8_WAIT_V(n) asm volatile("s_waitcnt vmcnt(" #n ")" ::: "memory")
#define PG8_WAIT_L(n) asm volatile("s_waitcnt lgkmcnt(" #n ")" ::: "memory")
#define PG8_BAR __builtin_amdgcn_s_barrier()
#define PG8_SCHED __builtin_amdgcn_sched_barrier(0)
    typename Sched::Unit cur, nxt; int ui = 0;
    if (!S.next(0, cur)) return;
    f32x4 acc[2][2][4][2];
#pragma unroll
    for (int a = 0; a < 2; ++a)
#pragma unroll
        for (int b = 0; b < 2; ++b)
#pragma unroll
            for (int m = 0; m < 4; ++m)
#pragma unroll
                for (int n = 0; n < 2; ++n) acc[a][b][m][n] = (f32x4){0.f, 0.f, 0.f, 0.f};
    bf16x8 At[4][2], B0[2][2], B1[2][2];
    constexpr bool GATHER = Sched::GATHER;
    unsigned oc[2][2], on[2][2] = {{0u, 0u}, {0u, 0u}};
    size_t ubc[2] = {0, 0}, ubn[2] = {0, 0};
#pragma unroll
    for (int h = 0; h < 2; ++h) {
        if (!GATHER) ubc[h] = (size_t)S.a_off(cur, h * HALF) * 2u;
#pragma unroll
        for (int i = 0; i < 2; ++i) oc[h][i] = GATHER ? (S.a_off(cur, h * HALF + Ra[i]) + (unsigned)Ca[i]) * 2u : (unsigned)(Ra[i] * S.lda + Ca[i]) * 2u;
    }
    const char* gA = (const char*)Aop;
    const char* cB = (const char*)S.b_base(cur);
    PG8_STAGE(PG8_SB(0, 0), cB, voffB); PG8_STAGE(PG8_SB(0, 1), cB + hstep, voffB); PG8_STAGE(PG8_SA(0, 0), gA + ubc[0], oc[0]); PG8_STAGE(PG8_SA(0, 1), gA + ubc[1], oc[1]);
    if (wr == 1) PG8_BAR;
    PG8_WAIT_V(2); PG8_BAR;
    PG8_STAGE(PG8_SB(1, 0), cB + kstep, voffB); PG8_STAGE(PG8_SA(1, 0), gA + ubc[0] + kstep, oc[0]); PG8_STAGE(PG8_SB(1, 1), cB + hstep + kstep, voffB);
    PG8_WAIT_V(6); PG8_BAR;
    for (;;) {
        const bool has_next = S.next(ui + 1, nxt);
        const char* nB = has_next ? (const char*)S.b_base(nxt) : cB;
#pragma unroll
        for (int h = 0; h < 2; ++h) {
            if (!GATHER) ubn[h] = has_next ? (size_t)S.a_off(nxt, h * HALF) * 2u : ubc[h];
#pragma unroll
            for (int i = 0; i < 2; ++i) if (GATHER) { int R, C; stage_rc(((wid << 6) | lane_now()) * 16 + i * 8192, R, C);
                const unsigned* ip = S.a_ptr(nxt, h * HALF + R); asm volatile("global_load_dword %0, %1, off" : "=v"(on[h][i]) : "v"(ip) : "memory"); }
        }
        const bool full = cur.half < 0;
        for (int t = 0; t < nt; t += 2) {
            const bool last = (t == nt - 2);
            const char* a1 = gA + (size_t)(t + 1) * kstep;
            const char* a2 = last ? gA : gA + (size_t)(t + 2) * kstep; const char* b2 = last ? nB : cB + (size_t)(t + 2) * kstep;
            const char* a3 = a2 + kstep; const char* b3 = b2 + kstep;
            size_t u2[2];
            if (GATHER && last) {
                asm volatile("" : "+v"(on[0][0]), "+v"(on[0][1]), "+v"(on[1][0]), "+v"(on[1][1]));
#pragma unroll
                for (int i = 0; i < 2; ++i) { int R, C; stage_rc(((wid << 6) | lane_now()) * 16 + i * 8192, R, C);
                    oc[0][i] = (S.a_cvt(on[0][i]) + (unsigned)C) * 2u; on[1][i] = (S.a_cvt(on[1][i]) + (unsigned)C) * 2u; }
            }
#pragma unroll
            for (int h = 0; h < 2; ++h) u2[h] = last ? ubn[h] : ubc[h];
            PG8_LDB(B0, 0, 0); PG8_LDB(B1, 0, 1); PG8_SCHED; PG8_LDA(At, 0, 0); PG8_STAGE(PG8_SA(1, 1), a1 + ubc[1], oc[1]);
            if (GATHER && last) { oc[1][0] = on[1][0]; oc[1][1] = on[1][1]; }
            PG8_WAIT_V(8); PG8_WAIT_L(0); PG8_BAR; PG8_MMA(0, 0, At, B0); PG8_MMA(0, 1, At, B1); PG8_BAR; PG8_SCHED;
            PG8_LDA(At, 0, 1); PG8_STAGE(PG8_SB(0, 0), b2, voffB); PG8_STAGE(PG8_SB(0, 1), b2 + hstep, voffB); PG8_STAGE(PG8_SA(0, 0), a2 + u2[0], oc[0]);
            PG8_WAIT_V(8); PG8_WAIT_L(0); PG8_BAR; if (full) { PG8_MMA(1, 0, At, B0); PG8_MMA(1, 1, At, B1); } PG8_BAR; PG8_SCHED;
            PG8_LDB(B0, 1, 0); PG8_LDB(B1, 1, 1); PG8_SCHED; PG8_LDA(At, 1, 0); PG8_STAGE(PG8_SA(0, 1), a2 + u2[1], oc[1]);
            PG8_WAIT_V(8); PG8_WAIT_L(0); PG8_BAR; PG8_MMA(0, 0, At, B0); PG8_MMA(0, 1, At, B1); PG8_BAR; PG8_SCHED;
            PG8_LDA(At, 1, 1); PG8_STAGE(PG8_SB(1, 0), b3, voffB); PG8_STAGE(PG8_SB(1, 1), b3 + hstep, voffB); PG8_STAGE(PG8_SA(1, 0), a3 + u2[0], oc[0]);
            PG8_WAIT_V(8); PG8_WAIT_L(0); PG8_BAR; if (full) { PG8_MMA(1, 0, At, B0); PG8_MMA(1, 1, At, B1); } PG8_BAR; PG8_SCHED;
        }
        if (wr == 0) PG8_BAR;
        { const int ln = lane_now(); E(acc, cur, wr, wc, ln & 15, ln >> 4); }
        if (!has_next) break;
#pragma unroll
        for (int a = 0; a < 2; ++a)
#pragma unroll
            for (int b = 0; b < 2; ++b)
#pragma unroll
                for (int m = 0; m < 4; ++m)
#pragma unroll
                    for (int n = 0; n < 2; ++n) acc[a][b][m][n] = (f32x4){0.f, 0.f, 0.f, 0.f};
        cur = nxt; cB = nB; ++ui;
#pragma unroll
        for (int h = 0; h < 2; ++h) ubc[h] = ubn[h];
        if (wr == 1) PG8_BAR;
    }
    PG8_WAIT_V(0);
    PG8_BAR;
#undef PG8_SA
#undef PG8_SB
#undef PG8_STAGE
#undef PG8_LDA
#undef PG8_LDB
#undef PG8_MMA
#undef PG8_WAIT_V
#undef PG8_WAIT_L
#undef PG8_BAR
#undef PG8_SCHED
}
}

struct DenseSched {
    static constexpr bool GATHER = false;
    struct Unit { int pm, pn, half; };
    int nM, nN, nwg, G, c; const bf16_t* Bt; int K, lda; bool skip_ctx;
    DI void unit_of(int L, Unit& u) const {
        int wgid = L; { const int q = nwg / 8, r = nwg % 8, xcd = wgid % 8, off = wgid / 8; wgid = (xcd < r ? xcd * (q + 1) : r * (q + 1) + (xcd - r) * q) + off; }
        const int nig = 8 * nN, gid = wgid / nig, fm = gid * 8, gsz = (nM - fm) < 8 ? (nM - fm) : 8;
        u.pm = fm + ((wgid % nig) % gsz); u.pn = (wgid % nig) / gsz;
        if (skip_ctx) u.pm += u.pm >> 4;
    }
    DI bool next(int i, Unit& u) const {
        const int rounds = nwg / G, rem = nwg - rounds * G;
        if (i < rounds) { unit_of(i * G + c, u); u.half = -1; return true; }
        if (i > rounds || rem == 0) return false;
        if (2 * rem <= G) { if (c >= 2 * rem) return false; unit_of(rounds * G + (c >> 1), u); u.half = c & 1; return true; }
        if (c >= rem) return false;
        unit_of(rounds * G + c, u); u.half = -1; return true;
    }
    DI unsigned a_off(const Unit& u, int row) const { const int rr = u.half < 0 ? row : u.half * 128 + (row & 127); return (unsigned)(u.pm * 256 + rr) * (unsigned)lda; }
    DI const unsigned* a_ptr(const Unit&, int) const { return nullptr; }
    DI unsigned a_cvt(unsigned raw) const { return raw; }
    DI const bf16_t* b_base(const Unit& u) const { return Bt + (size_t)u.pn * 256 * K; }
};
struct MoeUnit { int e, pn, valid, half; const unsigned* ent; };
template <bool TAIL>
struct MoeSched {
    static constexpr bool GATHER = true;
    typedef MoeUnit Unit;
    const LAS int* tab; const unsigned* list; const unsigned* zero  ; const bf16_t* W; int K, N, TN, lda, shift, G, c, nwg;
    DI bool unit_of(int L, Unit& u) const {
        const int v = tab[1 + (lane_now() & 31)];
        const int e = __builtin_popcount((unsigned)__ballot(v <= L));
        if (e >= NEXP) return false;
        const int rem = L - __builtin_amdgcn_readfirstlane(tab[e]), cn = __builtin_amdgcn_readfirstlane(tab[40 + e]);
        const int rt = rem / TN; u.e = e; u.pn = rem - rt * TN; u.ent = list + (size_t)e * MROWS + rt * 256; u.valid = min(256, cn - rt * 256); return true;
    }
    int lo, n, GX, j;
    DI void place() { GX = G >> 3; j = c >> 3; const int per = ((((nwg + 7) >> 3) + TN - 1) / TN) * TN; lo = (c & 7) * per; n = max(0, min(per, nwg - lo)); }
    DI bool next(int i, Unit& u) const {
        u.ent = zero; u.valid = 1;
        const int rounds = n / GX, rem = n - rounds * GX;
        if (!TAIL) { u.half = -1; if (i >= rounds) return false; return unit_of(lo + i * GX + j, u); }
        if (i > 0 || rem == 0) return false;
        if (2 * rem <= GX) {
            if (j >= 2 * rem) return false;
            if (!unit_of(lo + rounds * GX + (j >> 1), u)) return false;
            u.half = j & 1; u.ent += u.half * 128; u.valid = min(128, u.valid - u.half * 128);
            return u.valid > 0;
        }
        u.half = -1; if (j >= rem) return false;
        return unit_of(lo + rounds * GX + j, u);
    }
    DI unsigned a_off(const Unit& u, int row) const { const int rr = (TAIL && u.half >= 0) ? (row & 127) : row; return (u.ent[rr < u.valid ? rr : u.valid - 1] >> shift) * (unsigned)lda; }
    DI const unsigned* a_ptr(const Unit& u, int row) const { const int rr = (TAIL && u.half >= 0) ? (row & 127) : row; return u.ent + (rr < u.valid ? rr : u.valid - 1); }
    DI unsigned a_cvt(unsigned raw) const { return (raw >> shift) * (unsigned)lda; }
    DI const bf16_t* b_base(const Unit& u) const { return W + ((size_t)u.e * N + (size_t)u.pn * 256) * K; }
};
typedef float f32x4_t __attribute__((ext_vector_type(4)));
struct XEpiStore {
    static constexpr bool PERM = true;
    bf16_t* C; int ldc;
    DI void operator()(const f32x4 (&acc)[2][2][4][2], const DenseSched::Unit& u, int wr, int wc, int fr, int fq) const {
        const int row0 = u.pm * 256 + (u.half > 0 ? 128 : 0) + wr * 64 + fr, col0 = u.pn * 256 + wc * 32 + 8 * fq;
#pragma unroll
        for (int ai = 0; ai < 2; ++ai) if (ai == 0 || u.half < 0)
#pragma unroll
            for (int m = 0; m < 4; ++m) { bf16_t* rowp = C + (size_t)(row0 + ai * 128 + m * 16) * ldc + col0;
#pragma unroll
                for (int bj = 0; bj < 2; ++bj) { const f32x4 v0 = acc[ai][bj][m][0], v1 = acc[ai][bj][m][1];
                    u32x4 w; w.x = cvtpk(v0[0], v0[1]); w.y = cvtpk(v0[2], v0[3]); w.z = cvtpk(v1[0], v1[1]); w.w = cvtpk(v1[2], v1[3]);
                    *(u32x4*)(rowp + bj * 128) = w; } }
    } };
struct XEpiResid {
    static constexpr bool PERM = true;
    const Params* p; const float* mod;
    DI void operator()(const f32x4 (&acc)[2][2][4][2], const DenseSched::Unit& u, int wr, int wc, int fr, int fq) const {
        const int row0 = u.pm * 256 + (u.half > 0 ? 128 : 0) + wr * 64 + fr, col0 = u.pn * 256 + wc * 32 + 8 * fq;
#pragma unroll
        for (int ai = 0; ai < 2; ++ai) if (ai == 0 || u.half < 0)
#pragma unroll
            for (int m = 0; m < 4; ++m) { const int row = row0 + ai * 128 + m * 16;
                bf16_t* xr = xb_row(*p, row) + col0; const float* gp = mod + (size_t)mod_row(row) * 6144 + 2048 + col0;
#pragma unroll
                for (int bj = 0; bj < 2; ++bj) {
                    const u32x4 xw = *(const u32x4*)(xr + bj * 128); const f32x4 g0 = *(const f32x4*)(gp + bj * 128), g1 = *(const f32x4*)(gp + bj * 128 + 4);
                    const f32x4 a0 = acc[ai][bj][m][0], a1 = acc[ai][bj][m][1];
                    u32x4 w;
                    w.x = cvtpk(bflo(xw.x) + g0[0] * a0[0], bfhi(xw.x) + g0[1] * a0[1]); w.y = cvtpk(bflo(xw.y) + g0[2] * a0[2], bfhi(xw.y) + g0[3] * a0[3]);
                    w.z = cvtpk(bflo(xw.z) + g1[0] * a1[0], bfhi(xw.z) + g1[1] * a1[1]); w.w = cvtpk(bflo(xw.w) + g1[2] * a1[2], bfhi(xw.w) + g1[3] * a1[3]);
                    *(u32x4*)(xr + bj * 128) = w; } }
    } };
struct XEpiGlu {
    static constexpr bool PERM = true;
    bf16_t* act; const float* gates;
    DI void operator()(const f32x4 (&acc)[2][2][4][2], const MoeUnit& u, int wr, int wc, int fr, int fq) const {
#pragma unroll
        for (int ai = 0; ai < 2; ++ai)
#pragma unroll
            for (int m = 0; m < 4; ++m) { const int i = ai * 128 + wr * 64 + m * 16 + fr;
                if (i < u.valid) { const unsigned a = u.ent[i]; const float gw = gates[a];
                    const f32x4 g0 = acc[ai][0][m][0], g1 = acc[ai][0][m][1], u0 = acc[ai][1][m][0], u1 = acc[ai][1][m][1];
                    float v[8];
#pragma unroll
                    for (int j = 0; j < 4; ++j) { v[j] = silu_f(g0[j]) * u0[j] * gw; v[4 + j] = silu_f(g1[j]) * u1[j] * gw; }
                    u32x4 w; w.x = cvtpk(v[0], v[1]); w.y = cvtpk(v[2], v[3]); w.z = cvtpk(v[4], v[5]); w.w = cvtpk(v[6], v[7]);
                    *(u32x4*)(act + (size_t)a * DEXP + u.pn * 128 + wc * 32 + 8 * fq) = w; } }
    } };
struct XEpiScatter {
    static constexpr bool PERM = true;
    bf16_t* outp;
    DI void operator()(const f32x4 (&acc)[2][2][4][2], const MoeUnit& u, int wr, int wc, int fr, int fq) const {
#pragma unroll
        for (int ai = 0; ai < 2; ++ai)
#pragma unroll
            for (int m = 0; m < 4; ++m) { const int i = ai * 128 + wr * 64 + m * 16 + fr;
                if (i < u.valid) { bf16_t* rowp = outp + (size_t)u.ent[i] * 1024 + u.pn * 256 + wc * 32 + 8 * fq;
#pragma unroll
                    for (int bj = 0; bj < 2; ++bj) { const f32x4 v0 = acc[ai][bj][m][0], v1 = acc[ai][bj][m][1];
                        u32x4 w; w.x = cvtpk(v0[0], v0[1]); w.y = cvtpk(v0[2], v0[3]); w.z = cvtpk(v1[0], v1[1]); w.w = cvtpk(v1[2], v1[3]);
                        *(u32x4*)(rowp + bj * 128) = w; } } }
    } };

template <int KIND>
struct XEpiQKV {
    static constexpr bool PERM = true;
    static constexpr int KW = KIND == 1 ? 256 : 1024, LDRAW = KIND == 1 ? 1536 : 3072;
    bf16_t* Q; bf16_t* Kb; bf16_t* RAW; const float* qn; const float* kn;
    DI void operator()(const f32x4 (&acc)[2][2][4][2], const DenseSched::Unit& u, int wr, int wc, int fr, int fq) const {
        const int col0 = u.pn * 256, row0 = u.pm * 256 + (u.half > 0 ? 128 : 0) + wr * 64 + fr;
        if (col0 >= 1024 + KW) {
#pragma unroll
            for (int ai = 0; ai < 2; ++ai) if (ai == 0 || u.half < 0)
#pragma unroll
                for (int m = 0; m < 4; ++m) { bf16_t* rowp = RAW + (size_t)(row0 + ai * 128 + m * 16) * LDRAW + col0 + wc * 32 + 8 * fq;
#pragma unroll
                    for (int bj = 0; bj < 2; ++bj) { const f32x4 v0 = acc[ai][bj][m][0], v1 = acc[ai][bj][m][1];
                        u32x4 w; w.x = cvtpk(v0[0], v0[1]); w.y = cvtpk(v0[2], v0[3]); w.z = cvtpk(v1[0], v1[1]); w.w = cvtpk(v1[2], v1[3]);
                        *(u32x4*)(rowp + bj * 128) = w; } }
            return;
        }
        const bool isq = col0 < 1024;
        const int head = isq ? 4 * u.pn + wc : ((col0 - 1024) >> 6) + wc;
        const float* gain = (isq ? qn : kn) + 8 * fq;
        const float scale = isq ? 0.125f * LOG2E : 1.0f;
        bf16_t* dstb = isq ? Q + head * 64 + 8 * fq : Kb + head * 64 + 8 * fq;
        const int ldd = isq ? 1024 : KW;
        f32x4 g[2][2];
#pragma unroll
        for (int bj = 0; bj < 2; ++bj)
#pragma unroll
            for (int n = 0; n < 2; ++n) g[bj][n] = *(const f32x4*)(gain + 32 * bj + 4 * n);
#pragma unroll
        for (int ai = 0; ai < 2; ++ai) if (ai == 0 || u.half < 0)
#pragma unroll
            for (int m = 0; m < 4; ++m) {
                const int row = row0 + ai * 128 + m * 16, b = row / PP, pos = row - b * PP;
                f32x4 v[2][2];
                float ss = 0.f;
#pragma unroll
                for (int bj = 0; bj < 2; ++bj)
#pragma unroll
                    for (int n = 0; n < 2; ++n) { v[bj][n] = acc[ai][bj][m][n]; ss += v[bj][n][0] * v[bj][n][0] + v[bj][n][1] * v[bj][n][1] + v[bj][n][2] * v[bj][n][2] + v[bj][n][3] * v[bj][n][3]; }
                ss += __shfl_xor(ss, 16); ss += __shfl_xor(ss, 32);
                const float rs = rsqrtf(ss * (1.0f / 64.0f) + EPS);
#pragma unroll
                for (int bj = 0; bj < 2; ++bj)
#pragma unroll
                    for (int n = 0; n < 2; ++n) v[bj][n] = v[bj][n] * rs * g[bj][n];
                if (KIND != 0 && pos < SEQ) {
                    const int prow = (pos >> 6) & 63, pcol = pos & 63;
                    const float* cs = ROPE64 + ((fq < 2 ? prow : pcol) * 16 + ((8 * fq) & 15)) * 2;
#pragma unroll
                    for (int n = 0; n < 2; ++n)
#pragma unroll
                        for (int j = 0; j < 4; ++j) {
                            const float c = cs[(4 * n + j) * 2], sn = cs[(4 * n + j) * 2 + 1], x1 = v[0][n][j], x2 = v[1][n][j];
                            v[0][n][j] = x1 * c - x2 * sn; v[1][n][j] = x2 * c + x1 * sn;
                        }
                }
                bf16_t* rowp = dstb + (size_t)row * ldd;
#pragma unroll
                for (int bj = 0; bj < 2; ++bj) { const f32x4 v0 = v[bj][0] * scale, v1 = v[bj][1] * scale;
                    u32x4 w; w.x = cvtpk(v0[0], v0[1]); w.y = cvtpk(v0[2], v0[3]); w.z = cvtpk(v1[0], v1[1]); w.w = cvtpk(v1[2], v1[3]);
                    *(u32x4*)(rowp + bj * 32) = w; }
            }
    } };
template <int KIND>
DI void gemm_qkv_x(const Params& p, unsigned char* smem, const bf16_t* Wt, int N, const float* qn, const float* kn, int bid, int nb, int tid) {
    DenseSched S; S.nM = MROWS / 256; S.nN = N / 256; S.nwg = S.nM * S.nN; S.G = nb; S.c = bid; S.Bt = Wt; S.K = 1024; S.lda = 1024; S.skip_ctx = false;
    XEpiQKV<KIND> e{(bf16_t*)(p.ws + WS_Q), (bf16_t*)(p.ws + WS_K), (bf16_t*)(p.ws + WS_RAW), qn, kn};
    pg8::gemm_phase((lds_ptr)smem, (const bf16_t*)(p.ws + WS_H), 1024, S, e, tid);
}
template <bool UQ>
struct XEpiMla {
    static constexpr bool PERM = true;
    bf16_t* Q; bf16_t* Kb; bf16_t* V; const float* qn; const float* kn;
    DI void operator()(const f32x4 (&acc)[2][2][4][2], const DenseSched::Unit& u, int wr, int wc, int fr, int fq) const {
        const int row0 = u.pm * 256 + (u.half > 0 ? 128 : 0) + wr * 64 + fr;
        if (u.pn < 4) {
            const int head = 4 * u.pn + wc;
            const float* gain = (UQ ? qn : kn) + 8 * fq;
            const float scale = UQ ? 0.10206207261596577f * LOG2E : 1.0f;
            bf16_t* dstb = (UQ ? Q : Kb) + head * 96 + 8 * fq;
            f32x4 g[2][2];
#pragma unroll
            for (int bj = 0; bj < 2; ++bj)
#pragma unroll
                for (int n = 0; n < 2; ++n) g[bj][n] = *(const f32x4*)(gain + 32 * bj + 4 * n);
#pragma unroll
            for (int ai = 0; ai < 2; ++ai) if (ai == 0 || u.half < 0)
#pragma unroll
                for (int m = 0; m < 4; ++m) {
                    const int row = row0 + ai * 128 + m * 16;
                    float ss = 0.f;
#pragma unroll
                    for (int bj = 0; bj < 2; ++bj)
#pragma unroll
                        for (int n = 0; n < 2; ++n) { const f32x4 v = acc[ai][bj][m][n]; ss += v[0] * v[0] + v[1] * v[1] + v[2] * v[2] + v[3] * v[3]; }
                    ss += __shfl_xor(ss, 16); ss += __shfl_xor(ss, 32);
                    const float rs = rsqrtf(ss * (1.0f / 64.0f) + EPS) * scale;
                    bf16_t* rowp = dstb + (size_t)row * 1536;
#pragma unroll
                    for (int bj = 0; bj < 2; ++bj) { const f32x4 v0 = acc[ai][bj][m][0] * rs * g[bj][0], v1 = acc[ai][bj][m][1] * rs * g[bj][1];
                        u32x4 w; w.x = cvtpk(v0[0], v0[1]); w.y = cvtpk(v0[2], v0[3]); w.z = cvtpk(v1[0], v1[1]); w.w = cvtpk(v1[2], v1[3]);
                        *(u32x4*)(rowp + bj * 32) = w; }
                }
        } else if (UQ) {
            const float scale = 0.10206207261596577f * LOG2E;
            const f32x4 g1 = *(const f32x4*)(qn + 64 + 4 * fq), g2 = *(const f32x4*)(qn + 64 + 16 + 4 * fq);
#pragma unroll
            for (int ai = 0; ai < 2; ++ai) if (ai == 0 || u.half < 0)
#pragma unroll
                for (int m = 0; m < 4; ++m) {
                    const int row = row0 + ai * 128 + m * 16, b = row / PP, pos = row - b * PP;
                    const int prow = (pos >> 6) & 63, pcol = pos & 63;
                    const float* cs = ROPE32 + ((fq < 2 ? prow : pcol) * 8 + ((4 * fq) & 7)) * 2;
#pragma unroll
                    for (int bj = 0; bj < 2; ++bj) {
                        f32x4 x1 = acc[ai][bj][m][0], x2 = acc[ai][bj][m][1];
                        float ss = x1[0] * x1[0] + x1[1] * x1[1] + x1[2] * x1[2] + x1[3] * x1[3] + x2[0] * x2[0] + x2[1] * x2[1] + x2[2] * x2[2] + x2[3] * x2[3];
                        ss += __shfl_xor(ss, 16); ss += __shfl_xor(ss, 32);
                        const float rs = rsqrtf(ss * (1.0f / 32.0f) + EPS);
                        x1 = x1 * rs * g1; x2 = x2 * rs * g2;
                        if (pos < SEQ) {
#pragma unroll
                            for (int j = 0; j < 4; ++j) { const float c = cs[2 * j], sn = cs[2 * j + 1], a1 = x1[j], a2 = x2[j]; x1[j] = a1 * c - a2 * sn; x2[j] = a2 * c + a1 * sn; }
                        }
                        x1 = x1 * scale; x2 = x2 * scale;
                        bf16_t* rowp = Q + (size_t)row * 1536 + (8 * (u.pn - 4) + 4 * bj + wc) * 96 + 64 + 4 * fq;
                        u32x2 w1, w2; w1.x = cvtpk(x1[0], x1[1]); w1.y = cvtpk(x1[2], x1[3]); w2.x = cvtpk(x2[0], x2[1]); w2.y = cvtpk(x2[2], x2[3]);
                        *(u32x2*)rowp = w1; *(u32x2*)(rowp + 16) = w2;
                    }
                }
        } else {
#pragma unroll
            for (int ai = 0; ai < 2; ++ai) if (ai == 0 || u.half < 0)
#pragma unroll
                for (int m = 0; m < 4; ++m) { bf16_t* rowp = V + (size_t)(row0 + ai * 128 + m * 16) * 1024 + (u.pn - 4) * 256 + wc * 32 + 8 * fq;
#pragma unroll
                    for (int bj = 0; bj < 2; ++bj) { const f32x4 v0 = acc[ai][bj][m][0], v1 = acc[ai][bj][m][1];
                        u32x4 w; w.x = cvtpk(v0[0], v0[1]); w.y = cvtpk(v0[2], v0[3]); w.z = cvtpk(v1[0], v1[1]); w.w = cvtpk(v1[2], v1[3]);
                        *(u32x4*)(rowp + bj * 128) = w; } }
        }
    } };
template <bool UQ>
DI void gemm_mla_x(const Params& p, unsigned char* smem, int bid, int nb, int tid) {
    bf16_t* O = (bf16_t*)(p.ws + WS_O);
    DenseSched S; S.nM = MROWS / 256; S.nN = (UQ ? 1536 : 2048) / 256; S.nwg = S.nM * S.nN; S.G = nb; S.c = bid; S.Bt = (const bf16_t*)(p.ws + (UQ ? W_UQ : W_UKV)); S.K = UQ ? 384 : 256; S.lda = S.K; S.skip_ctx = false;
    XEpiMla<UQ> e{(bf16_t*)(p.ws + WS_Q), (bf16_t*)(p.ws + WS_K), (bf16_t*)(p.ws + WS_RAW), p.in[28], p.in[29]};
    pg8::gemm_phase((lds_ptr)smem, UQ ? O : O + (size_t)MROWS * 384, S.K, S, e, tid);
}
template <int EPIK>
DI void gemm_dense_x(const Params& p, unsigned char* smem, const bf16_t* A, int lda, const bf16_t* Wt, int K, int N, bf16_t* C, int ldc, const float* mod, int bid, int nb, int tid, bool skip_ctx = false) {
    DenseSched S; S.nM = skip_ctx ? NBATCH * 16 : MROWS / 256; S.nN = N / 256; S.nwg = S.nM * S.nN; S.G = nb; S.c = bid; S.Bt = Wt; S.K = K; S.lda = lda; S.skip_ctx = skip_ctx;
    if (EPIK == 0) { XEpiStore e{C, ldc}; pg8::gemm_phase((lds_ptr)smem, A, K, S, e, tid); }
    else { XEpiResid e{&p, mod}; pg8::gemm_phase((lds_ptr)smem, A, K, S, e, tid); }
}
template <int WHICH, bool TAIL>
DI void gemm_moe_call(const Params& p, unsigned char* smem, int layer, int bid, int nb, int tid) {
    MoeSched<TAIL> S; S.list = (const unsigned*)(p.ws + WS_LIST); S.zero = (const unsigned*)(p.ws + WS_CTL) + 8192; S.G = nb; S.c = bid;
    {
        LAS int* tab = (LAS int*)(smem + GEMM_LDS);
        constexpr int TNc = WHICH == 0 ? 2 : 4;
        if (tid < 64) {
            const unsigned cv = tid < 32 ? ((const unsigned*)(p.ws + WS_CTL) + CW_CNT + layer * 32)[tid] : 0u;
            int incl = (int)((cv + 255u) >> 8) * TNc;
#pragma unroll
            for (int d = 1; d < 32; d <<= 1) { const int o = __shfl_up(incl, d); if (tid >= d) incl += o; }
            if (tid < 32) { tab[1 + tid] = incl; tab[40 + tid] = (int)cv; }
            if (tid == 0) tab[0] = 0;
        }
        __syncthreads();
        S.tab = tab; S.nwg = __builtin_amdgcn_readfirstlane(tab[32]);
    }
    if (WHICH == 0) { S.W = (const bf16_t*)(p.ws + W_GU) + (size_t)layer * 32 * 512 * 1024; S.K = 1024; S.N = 512; S.TN = 2; S.lda = 1024; S.shift = 1;
        S.place(); XEpiGlu e{(bf16_t*)(p.ws + WS_Q), (const float*)(p.ws + WS_GATE)}; pg8::gemm_phase((lds_ptr)smem, (const bf16_t*)(p.ws + WS_H), 1024, S, e, tid); }
    else { S.W = (const bf16_t*)(p.ws + W_DN) + (size_t)layer * 32 * 1024 * 256; S.K = 256; S.N = 1024; S.TN = 4; S.lda = DEXP; S.shift = 0;
        S.place(); XEpiScatter e{(bf16_t*)(p.ws + WS_RAW)}; pg8::gemm_phase((lds_ptr)smem, (const bf16_t*)(p.ws + WS_Q), 256, S, e, tid); }
}
template <int WHICH>
DI void gemm_moe_x(const Params& p, unsigned char* smem, int layer, int bid, int nb, int tid) {
    const int wv = __builtin_amdgcn_readfirstlane(tid >> 6);
    gemm_moe_call<WHICH, false>(p, smem, layer, bid, nb, (wv << 6) | lane_now());
    gemm_moe_call<WHICH, true>(p, smem, layer, bid, nb, (wv << 6) | lane_now());
}

constexpr int NPHASES = 2 + (7 + 7 + 9 + 7) + 1;
constexpr int SMEM_BYTES = GEMM_LDS + 512;

template <int KIND>
DI void layer_phases(const Params& p, int& ph, const int lo, const int hi, const XcdBarrier& bar, unsigned char* smem, int bid, int nb, int wid_u) {
    constexpr int L = KIND;
    const float* mod = (const float*)(p.ws + WS_MOD) + (size_t)L * 9 * 6144;
    bf16_t* H = (bf16_t*)(p.ws + WS_H); bf16_t* O = (bf16_t*)(p.ws + WS_O); bf16_t* RAW = (bf16_t*)(p.ws + WS_RAW);
    bf16_t* Q = (bf16_t*)(p.ws + WS_Q); bf16_t* Kb = (bf16_t*)(p.ws + WS_K);
#ifndef AABL
#define AABL 0
#endif
#ifndef GPROBE
#define GPROBE 0
#endif
#ifndef DUP_MASK
#define DUP_MASK 0ull
#endif
#define PHASE2(BODY, DUPBODY) do { if (lo <= ph && ph < hi) { const int tid = (wid_u << 6) | lane_now(); if ((DUP_MASK >> ph) & 1ull) { DUPBODY; xcd_barrier(bar, tid == 0); } BODY; } if (lo <= ph && ph + 1 < hi) xcd_barrier(bar, ((wid_u << 6) | lane_now()) == 0); ++ph; } while (0)
#define PHASE(...) PHASE2((__VA_ARGS__), (__VA_ARGS__))
    if (L == 0) PHASE(phase_rows<2 | 8>(p, L, 0, bid, nb, tid), phase_router_prep(p, bid, nb, tid));
    else PHASE2((phase_rows<3>(p, L, 0, bid, nb, tid)), (phase_rows<2>(p, L, 0, bid, nb, tid)));
    AttnP a{};
    if (KIND == 0) {
        PHASE(gemm_qkv_x<0>(p, smem, (const bf16_t*)(p.ws + W_QKV0), 3072, p.in[15], p.in[16], bid, nb, tid));
        a = AttnP{Q, 1024, Kb, 1024, RAW + 2048, 3072, O, 1024, 16, 0, 0, 64, p.in[17], nullptr, 1, p.in[16]};
        PHASE(attn_na(a, smem, bid, nb, tid));
        PHASE2((gemm_dense_x<1>(p, smem, O, 1024, (const bf16_t*)(p.ws + W_O0), 1024, 1024, nullptr, 0, mod, bid, nb, tid)), (gemm_dense_x<0>(p, smem, O, 1024, (const bf16_t*)(p.ws + W_O0), 1024, 1024, RAW, 1024, nullptr, bid, nb, tid)));
    } else if (KIND == 1) {
        PHASE(gemm_qkv_x<1>(p, smem, (const bf16_t*)(p.ws + W_QKV1), 1536, p.in[20], p.in[21], bid, nb, tid));
        a = AttnP{Q, 1024, Kb, 256, RAW + 1280, 1536, O, 1024, 16, 2, 2, 64, nullptr, p.in[22], 1};
        PHASE(attn_mfma<64, 64, 1>(a, smem, bid, nb, tid));
        PHASE2((gemm_dense_x<1>(p, smem, O, 1024, (const bf16_t*)(p.ws + W_O1), 1024, 1024, nullptr, 0, mod, bid, nb, tid)), (gemm_dense_x<0>(p, smem, O, 1024, (const bf16_t*)(p.ws + W_O1), 1024, 1024, RAW, 1024, nullptr, bid, nb, tid)));
    } else if (KIND == 2) {
        bf16_t* cqn = O; bf16_t* ckvn = O + (size_t)MROWS * 384;
        PHASE(gemm_dense_x<0>(p, smem, H, 1024, (const bf16_t*)(p.ws + W_DQKV), 1024, 768, Q, 768, nullptr, bid, nb, tid));
        PHASE(phase_post_mla1(p, bid, nb, tid));
        PHASE(gemm_mla_x<true>(p, smem, bid, nb, tid), gemm_mla_x<false>(p, smem, bid, nb, (wid_u << 6) | lane_now()));
        a = AttnP{Q, 1536, Kb, 1536, RAW, 1024, O, 1024, 16, 0, 0, 64, nullptr, nullptr, 1};
        PHASE(attn_mfma<96, 64, 2>(a, smem, bid, nb, tid));
        PHASE2((gemm_dense_x<1>(p, smem, O, 1024, (const bf16_t*)(p.ws + W_O2), 1024, 1024, nullptr, 0, mod, bid, nb, tid)), (gemm_dense_x<0>(p, smem, O, 1024, (const bf16_t*)(p.ws + W_O2), 1024, 1024, RAW, 1024, nullptr, bid, nb, tid)));
    } else {
        PHASE(gemm_qkv_x<3>(p, smem, (const bf16_t*)(p.ws + W_QKV3), 3072, p.in[32], p.in[33], bid, nb, tid));
        a = AttnP{Q, 1024, Kb, 1024, RAW + 2048, 3072, H  , 2048, 16, 0, 1, 128, nullptr, nullptr, 0, nullptr, p.in[34], p.in[35], Q  };
        PHASE(attn_mfma<64, 128, 2>(a, smem, bid, nb, tid));
        PHASE(gemm_dense_x<1>(p, smem, Q, 1024, (const bf16_t*)(p.ws + W_O3), 1024, 1024, nullptr, 0, mod, bid, nb, tid, true));
    }
    PHASE(phase_router(p, smem, L, L == 3, bid, nb, tid));
    PHASE(gemm_moe_x<0>(p, smem, L, bid, nb, tid));
    PHASE(gemm_moe_x<1>(p, smem, L, bid, nb, tid));
}

__global__ void __launch_bounds__(NTHREADS, 2) mega(Params p, int lo, int hi) {
    extern __shared__ __attribute__((aligned(16))) unsigned char smem[];
    const int bid = blockIdx.x, nb = gridDim.x, wid_u = __builtin_amdgcn_readfirstlane(threadIdx.x >> 6);
    float* lds = (float*)smem;
    volatile LAS unsigned* xbw = (volatile LAS unsigned*)(smem + SMEM_BYTES - 16);
    if (threadIdx.x == 0) { xbw[0] = 0u; xbw[1] = 0u; }
    __syncthreads();
    XcdBarrier bar = xcd_barrier_post((unsigned*)(p.ws + WS_CTL), xbw);
    int ph = 0;
    PHASE(phase_prologue(p, lds, bid, nb, tid));
    PHASE(phase_mod_reduce(p, bid, nb, tid));
    layer_phases<0>(p, ph, lo, hi, bar, smem, bid, nb, wid_u);
    layer_phases<1>(p, ph, lo, hi, bar, smem, bid, nb, wid_u);
    layer_phases<2>(p, ph, lo, hi, bar, smem, bid, nb, wid_u);
    layer_phases<3>(p, ph, lo, hi, bar, smem, bid, nb, wid_u);
    PHASE2((phase_rows<1 | 16>(p, 3, 0, bid, nb, tid)), (void)0);
}

extern "C" void kernel_launch(void* const* d_in, const int* in_sizes, int n_in, void* d_out, int out_size, void* d_ws, size_t ws_size, hipStream_t stream) {
    (void)in_sizes; (void)out_size;
    if (n_in < 37 || ws_size < WS_END) { fprintf(stderr, "kernel_launch: unexpected inputs (n_in %d, ws %zu)\n", n_in, ws_size); return; }
    static int grid = 0;
    if (!grid) {
        int dev = 0, cus = 0, per_cu = 0;
        hipGetDevice(&dev);
        hipDeviceGetAttribute(&cus, hipDeviceAttributeMultiprocessorCount, dev);
        hipFuncSetAttribute((const void*)mega, hipFuncAttributeMaxDynamicSharedMemorySize, SMEM_BYTES);
        hipOccupancyMaxActiveBlocksPerMultiprocessor(&per_cu, mega, NTHREADS, SMEM_BYTES);
        if (per_cu < 1) per_cu = 1;
        grid = cus * (per_cu < 1 ? per_cu : 1);
    }
    Params p{};
    for (int i = 0; i < 37; ++i) p.in[i] = (const float*)d_in[i];
    p.out = (float*)d_out; p.ws = (unsigned char*)d_ws;
    hipMemsetAsync(p.ws + WS_CTL, 0, 65536, stream);
#if ONE_LAUNCH
    hipLaunchKernelGGL(mega, dim3(grid), dim3(NTHREADS), SMEM_BYTES, stream, p, 0, NPHASES);
#else
    for (int k = 0; k < NPHASES; ++k) hipLaunchKernelGGL(mega, dim3(grid), dim3(NTHREADS), SMEM_BYTES, stream, p, k, k + 1);
#endif
}
```

```cpp
#include <hip/hip_runtime.h>
#include <stdint.h>
#include <stdio.h>

#ifndef ONE_LAUNCH
#define ONE_LAUNCH 1
#endif

#define DI __device__ __forceinline__
typedef unsigned short bf16_t;
typedef short bf16x8 __attribute__((ext_vector_type(8)));
typedef float f32x4 __attribute__((ext_vector_type(4)));
typedef float f32x16 __attribute__((ext_vector_type(16)));
typedef unsigned u32x4 __attribute__((ext_vector_type(4)));
typedef unsigned u32x2 __attribute__((ext_vector_type(2)));

constexpr int DM = 1024, NBATCH = 8, SEQ = 4096, CTXL = 256, PP = SEQ + CTXL, MROWS = NBATCH * PP;
constexpr int NEXP = 32, DEXP = 256;
constexpr float EPS = 1e-6f, LOG2E = 1.4426950408889634f;
constexpr int NTHREADS = 512, NW = NTHREADS / 64;

constexpr size_t MiB = 1ull << 20;
constexpr size_t WS_RAW_FWD = 380ull << 20;
constexpr size_t WS_CTL = 0, CTL_BYTES = 1 * MiB;
constexpr size_t WS_MOD = 1 * MiB;
constexpr size_t WS_MODP = WS_RAW_FWD;
constexpr size_t WS_XCTX = 9 * MiB;
constexpr size_t WS_LIST = 17 * MiB;
constexpr size_t WS_GATE = 22 * MiB;
constexpr size_t WS_W = 24 * MiB;
constexpr size_t W_QKV0 = WS_W + 0 * MiB, W_O0 = WS_W + 6 * MiB, W_QKV1 = WS_W + 8 * MiB, W_O1 = WS_W + 11 * MiB, W_DQKV = WS_W + 13 * MiB,
                 W_UQ = WS_W + 15 * MiB, W_UKV = WS_W + 17 * MiB, W_O2 = WS_W + 18 * MiB, W_QKV3 = WS_W + 20 * MiB, W_O3 = WS_W + 26 * MiB,
                 W_GU = WS_W + 28 * MiB, W_DN = WS_W + 156 * MiB;
constexpr size_t WS_H = 244 * MiB;
constexpr size_t WS_O = 312 * MiB;
constexpr size_t WS_RAW = 380 * MiB;
constexpr size_t WS_Q = 620 * MiB;
constexpr size_t WS_K = 722 * MiB;
constexpr size_t WS_XB = 824 * MiB;
constexpr size_t WS_END = 892 * MiB;
constexpr int CW_CNT = 4096;

constexpr size_t WS_RW = 2 * MiB;
struct Params { const float* in[37]; float* out; unsigned char* ws; };

DI unsigned f2bf(float f) { unsigned u = __float_as_uint(f); return (u + 0x7fffu + ((u >> 16) & 1u)) >> 16; }
DI float bf2f(unsigned h) { return __uint_as_float(h << 16); }
DI unsigned pk2(float lo, float hi) { return f2bf(lo) | (f2bf(hi) << 16); }
DI float bflo(unsigned w) { return __uint_as_float(w << 16); }
DI float bfhi(unsigned w) { return __uint_as_float(w & 0xffff0000u); }
DI int lane_now() { unsigned lane; asm volatile("v_mbcnt_lo_u32_b32 %0, -1, 0\n\tv_mbcnt_hi_u32_b32 %0, -1, %0" : "=v"(lane)); return (int)lane; }
DI float wave_sum(float v) {
#pragma unroll
    for (int o = 32; o > 0; o >>= 1) v += __shfl_xor(v, o);
    return v;
}
DI float silu_f(float x) { return x / (1.0f + __expf(-x)); }
DI void unpack8(const u32x4 w, float (&f)[8]) {
    f[0] = bflo(w.x); f[1] = bfhi(w.x); f[2] = bflo(w.y); f[3] = bfhi(w.y); f[4] = bflo(w.z); f[5] = bfhi(w.z); f[6] = bflo(w.w); f[7] = bfhi(w.w);
}
DI u32x4 pack8(const float (&f)[8]) { u32x4 w; w.x = pk2(f[0], f[1]); w.y = pk2(f[2], f[3]); w.z = pk2(f[4], f[5]); w.w = pk2(f[6], f[7]); return w; }
DI float* xrow_ptr(const Params& p, int r) {
    const int b = r / PP, pos = r - b * PP;
    return pos < SEQ ? p.out + ((size_t)b * SEQ + pos) * DM : (float*)(p.ws + WS_XCTX) + ((size_t)b * CTXL + (pos - SEQ)) * DM;
}
DI bf16_t* xb_row(const Params& p, int r) { return (bf16_t*)(p.ws + WS_XB) + (size_t)r * DM; }
DI int mod_row(int r) { const int b = r / PP, pos = r - b * PP; return pos < SEQ ? b : 8; }
__device__ const float ROPE64[2048] = {
  1.000000000e+00f, 0.000000000e+00f, 1.000000000e+00f, 0.000000000e+00f, 1.000000000e+00f, 0.000000000e+00f, 1.000000000e+00f, 0.000000000e+00f,
  1.000000000e+00f, 0.000000000e+00f, 1.000000000e+00f, 0.000000000e+00f, 1.000000000e+00f, 0.000000000e+00f, 1.000000000e+00f, 0.000000000e+00f,
  1.000000000e+00f, 0.000000000e+00f, 1.000000000e+00f, 0.000000000e+00f, 1.000000000e+00f, 0.000000000e+00f, 1.000000000e+00f, 0.000000000e+00f,
  1.000000000e+00f, 0.000000000e+00f, 1.000000000e+00f, 0.000000000e+00f, 1.000000000e+00f, 0.000000000e+00f, 1.000000000e+00f, 0.000000000e+00f,
  5.403022766e-01f, 8.414709568e-01f, 8.460091352e-01f, 5.331684351e-01f, 9.504152536e-01f, 3.109835982e-01f, 9.842302203e-01f, 1.768921912e-01f,
  9.950041771e-01f, 9.983342141e-02f, 9.984192848e-01f, 5.620449781e-02f, 9.995000362e-01f, 3.161750361e-02f, 9.998418689e-01f, 1.778185740e-02f,
  9.999499917e-01f, 9.999833070e-03f, 9.999842048e-01f, 5.623383448e-03f, 9.999949932e-01f, 3.162272274e-03f, 9.999983907e-01f, 1.778278500e-03f,
  9.999995232e-01f, 9.999999311e-04f, 9.999998212e-01f, 5.623412435e-04f, 9.999999404e-01f, 3.162277571e-04f, 1.000000000e+00f, 1.778279402e-04f,
  -4.161468446e-01f, 9.092974067e-01f, 4.314628243e-01f, 9.021307230e-01f, 8.065783978e-01f, 5.911270976e-01f, 9.374182820e-01f, 3.482052684e-01f,
  9.800665975e-01f, 1.986693293e-01f, 9.936820865e-01f, 1.122313142e-01f, 9.980006814e-01f, 6.320339441e-02f, 9.993675947e-01f, 3.555808961e-02f,
  9.998000264e-01f, 1.999866590e-02f, 9.999367595e-01f, 1.124658901e-02f, 9.999799728e-01f, 6.324512884e-03f, 9.999936819e-01f, 3.556551412e-03f,
  9.999979734e-01f, 1.999998698e-03f, 9.999993443e-01f, 1.124682371e-03f, 9.999998212e-01f, 6.324554561e-04f, 9.999999404e-01f, 3.556558804e-04f,
  -9.899924994e-01f, 1.411200017e-01f, -1.159661636e-01f, 9.932531714e-01f, 5.827536583e-01f, 8.126488924e-01f, 8.610406518e-01f, 5.085361004e-01f,
  9.553365111e-01f, 2.955202162e-01f, 9.858034849e-01f, 1.679033041e-01f, 9.955033660e-01f, 9.472608566e-02f, 9.985772967e-01f, 5.332308263e-02f,
  9.995500445e-01f, 2.999549918e-02f, 9.998577237e-01f, 1.686943881e-02f, 9.999549985e-01f, 9.486690164e-03f, 9.999857545e-01f, 5.334813148e-03f,
  9.999955297e-01f, 2.999995602e-03f, 9.999985695e-01f, 1.687023090e-03f, 9.999995232e-01f, 9.486831259e-04f, 9.999998808e-01f, 5.334838061e-04f,
  -6.536436081e-01f, -7.568024993e-01f, -6.276797056e-01f, 7.784717083e-01f, 3.011374772e-01f, 9.535807371e-01f, 7.575061917e-01f, 6.528279781e-01f,
  9.210609794e-01f, 3.894183338e-01f, 9.748082757e-01f, 2.230444849e-01f, 9.920106530e-01f, 1.261540651e-01f, 9.974712729e-01f, 7.107120752e-02f,
  9.992001057e-01f, 3.998933360e-02f, 9.997470379e-01f, 2.249175683e-02f, 9.999200106e-01f, 1.264877338e-02f, 9.999747276e-01f, 7.113057654e-03f,
  9.999920130e-01f, 3.999989480e-03f, 9.999974966e-01f, 2.249363344e-03f, 9.999992251e-01f, 1.264910679e-03f, 9.999997616e-01f, 7.113117026e-04f,
  2.836622000e-01f, -9.589242935e-01f, -9.460792542e-01f, 3.239352703e-01f, -1.034233812e-02f, 9.999465346e-01f, 6.300802827e-01f, 7.765299678e-01f,
  8.775825500e-01f, 4.794255495e-01f, 9.607312679e-01f, 2.774805427e-01f, 9.875259995e-01f, 1.574558765e-01f, 9.960497618e-01f, 8.879686147e-02f,
  9.987502694e-01f, 4.997916520e-02f, 9.996047616e-01f, 2.811336145e-02f, 9.998750091e-01f, 1.581072807e-02f, 9.999604821e-01f, 8.891279809e-03f,
  9.999874830e-01f, 4.999979399e-03f, 9.999960661e-01f, 2.811702900e-03f, 9.999987483e-01f, 1.581138116e-03f, 9.999995828e-01f, 8.891395992e-04f,
  9.601702690e-01f, -2.794154882e-01f, -9.731037021e-01f, -2.303675115e-01f, -3.207964003e-01f, 9.471482038e-01f, 4.827820361e-01f, 8.757405281e-01f,
  8.253356218e-01f, 5.646424890e-01f, 9.436169863e-01f, 3.310393095e-01f, 9.820539355e-01f, 1.886002719e-01f, 9.943132997e-01f, 1.064944416e-01f,
  9.982005358e-01f, 5.996400490e-02f, 9.994308352e-01f, 3.373407945e-02f, 9.998199940e-01f, 1.897252724e-02f, 9.999430776e-01f, 1.066947449e-02f,
  9.999819994e-01f, 5.999964196e-03f, 9.999943376e-01f, 3.374041524e-03f, 9.999982119e-01f, 1.897365320e-03f, 9.999994040e-01f, 1.066967379e-03f,
  7.539022565e-01f, 6.569865942e-01f, -7.004297972e-01f, -7.137212753e-01f, -5.994374752e-01f, 8.004215956e-01f, 3.202570081e-01f, 9.473307133e-01f,
  7.648422122e-01f, 6.442176700e-01f, 9.235194325e-01f, 3.835515678e-01f, 9.755998850e-01f, 2.195560932e-01f, 9.922624230e-01f, 1.241583377e-01f,
  9.975510240e-01f, 6.994284689e-02f, 9.992253184e-01f, 3.935372457e-02f, 9.997550249e-01f, 2.213413455e-02f, 9.999225140e-01f, 1.244763471e-02f,
  9.999755025e-01f, 6.999942940e-03f, 9.999922514e-01f, 3.936378751e-03f, 9.999975562e-01f, 2.213592408e-03f, 9.999992251e-01f, 1.244795276e-03f,
  -1.455000341e-01f, 9.893582463e-01f, -2.120364457e-01f, -9.772617817e-01f, -8.186324239e-01f, 5.743177533e-01f, 1.476312131e-01f, 9.890424609e-01f,
  6.967067122e-01f, 7.173560858e-01f, 9.005023241e-01f, 4.348512292e-01f, 9.681702852e-01f, 2.502923310e-01f, 9.898977876e-01f, 1.417829692e-01f,
  9.968017340e-01f, 7.991468906e-02f, 9.989882708e-01f, 4.497213289e-02f, 9.996800423e-01f, 2.529552206e-02f, 9.998987913e-01f, 1.422575582e-02f,
  9.999679923e-01f, 7.999914698e-03f, 9.999898672e-01f, 4.498715047e-03f, 9.999967813e-01f, 2.529819263e-03f, 9.999989867e-01f, 1.422623056e-03f,
  -9.111302495e-01f, 4.121184945e-01f, 3.416602612e-01f, -9.398235083e-01f, -9.566441774e-01f, 2.912592292e-01f, -2.965079620e-02f, 9.995602965e-01f,
  6.216099262e-01f, 7.833269238e-01f, 8.746382594e-01f, 4.847761393e-01f, 9.597726464e-01f, 2.807783186e-01f, 9.872201085e-01f, 1.593627781e-01f,
  9.959527254e-01f, 8.987854421e-02f, 9.987195730e-01f, 5.058911815e-02f, 9.995950460e-01f, 2.845665626e-02f, 9.998719096e-01f, 1.600383036e-02f,
  9.999595284e-01f, 8.999879472e-03f, 9.999871850e-01f, 5.061050411e-03f, 9.999959469e-01f, 2.846045885e-03f, 9.999987483e-01f, 1.600450720e-03f,
  -8.390715122e-01f, -5.440211296e-01f, 7.901318669e-01f, -6.129369140e-01f, -9.997860789e-01f, -2.068356983e-02f, -2.059976310e-01f, 9.785524607e-01f,
  5.403022766e-01f, 8.414709568e-01f, 8.460091352e-01f, 5.331684351e-01f, 9.504153132e-01f, 3.109835684e-01f, 9.842302203e-01f, 1.768921912e-01f,
  9.950041771e-01f, 9.983341396e-02f, 9.984192848e-01f, 5.620449781e-02f, 9.995000362e-01f, 3.161750361e-02f, 9.998418689e-01f, 1.778185740e-02f,
  9.999499917e-01f, 9.999834001e-03f, 9.999842048e-01f, 5.623383448e-03f, 9.999949932e-01f, 3.162272274e-03f, 9.999983907e-01f, 1.778278500e-03f,
  4.425697960e-03f, -9.999902248e-01f, 9.952573776e-01f, -9.727645665e-02f, -9.437797666e-01f, -3.305749595e-01f, -3.758473992e-01f, 9.266815782e-01f,
  4.535960853e-01f, 8.912073970e-01f, 8.147053123e-01f, 5.798751712e-01f, 9.401075840e-01f, 3.408778608e-01f, 9.809291363e-01f, 1.943656504e-01f,
  9.939560890e-01f, 1.097782999e-01f, 9.980874062e-01f, 6.181810424e-02f, 9.993950725e-01f, 3.477803990e-02f, 9.998086691e-01f, 1.955982670e-02f,
  9.999395013e-01f, 1.099977922e-02f, 9.999808669e-01f, 6.185714621e-03f, 9.999939203e-01f, 3.478498431e-03f, 9.999980927e-01f, 1.956106164e-03f,
  8.438539505e-01f, -5.365729332e-01f, 8.938615918e-01f, 4.483429790e-01f, -7.941793799e-01f, -6.076834202e-01f, -5.338430405e-01f, 8.455836177e-01f,
  3.623577058e-01f, 9.320390821e-01f, 7.808259130e-01f, 6.247486472e-01f, 9.288598895e-01f, 3.704313040e-01f, 9.773178697e-01f, 2.117776722e-01f,
  9.928086400e-01f, 1.197122037e-01f, 9.977239966e-01f, 6.742975861e-02f, 9.992800951e-01f, 3.793822229e-02f, 9.997723103e-01f, 2.133773454e-02f,
  9.999279976e-01f, 1.199971233e-02f, 9.999772310e-01f, 6.748044398e-03f, 9.999927878e-01f, 3.794723889e-03f, 9.999977350e-01f, 2.133933594e-03f,
  9.074468017e-01f, 4.201670289e-01f, 5.171728730e-01f, 8.558809757e-01f, -5.658205152e-01f, -8.245284557e-01f, -6.750016809e-01f, 7.378162146e-01f,
  2.674987614e-01f, 9.635581970e-01f, 7.444779873e-01f, 6.676470041e-01f, 9.166833758e-01f, 3.996143043e-01f, 9.733975530e-01f, 2.291227132e-01f,
  9.915618896e-01f, 1.296341419e-01f, 9.973290563e-01f, 7.303927839e-02f, 9.991551042e-01f, 4.109803215e-02f, 9.997327924e-01f, 2.311557345e-02f,
  9.999154806e-01f, 1.299963426e-02f, 9.999732971e-01f, 7.310371846e-03f, 9.999915361e-01f, 4.110949114e-03f, 9.999973178e-01f, 2.311761025e-03f,
  1.367372125e-01f, 9.906073809e-01f, -1.879615150e-02f, 9.998233318e-01f, -2.813494802e-01f, -9.596053958e-01f, -7.948709130e-01f, 6.067785621e-01f,
  1.699671596e-01f, 9.854497313e-01f, 7.057763934e-01f, 7.084347010e-01f, 9.035902619e-01f, 4.283977747e-01f, 9.691694379e-01f, 2.463953048e-01f,
  9.902160168e-01f, 1.395431161e-01f, 9.969025850e-01f, 7.864648104e-02f, 9.990201592e-01f, 4.425742477e-02f, 9.996901155e-01f, 2.489333972e-02f,
  9.999020100e-01f, 1.399954315e-02f, 9.999690056e-01f, 7.872696966e-03f, 9.999902248e-01f, 4.427174106e-03f, 9.999969006e-01f, 2.489588689e-03f,
  -7.596879005e-01f, 6.502878666e-01f, -5.489754677e-01f, 8.358384371e-01f, 3.102235124e-02f, -9.995186925e-01f, -8.896704316e-01f, 4.566032588e-01f,
  7.073719800e-02f, 9.974949956e-01f, 6.648434997e-01f, 7.469826341e-01f, 8.895936012e-01f, 4.567528665e-01f, 9.646348357e-01f, 2.635899782e-01f,
  9.887710810e-01f, 1.494381279e-01f, 9.964445233e-01f, 8.425120264e-02f, 9.988752007e-01f, 4.741638154e-02f, 9.996442795e-01f, 2.667102963e-02f,
  9.998875260e-01f, 1.499943808e-02f, 9.999644160e-01f, 8.435020223e-03f, 9.999887347e-01f, 4.743398633e-03f, 9.999964237e-01f, 2.667415887e-03f,
  -9.576594830e-01f, -2.879033089e-01f, -9.100810885e-01f, 4.144302309e-01f, 3.403181732e-01f, -9.403103590e-01f, -9.564100504e-01f, 2.920270860e-01f,
  -2.919954620e-02f, 9.995735884e-01f, 6.218088269e-01f, 7.831690907e-01f, 8.747074604e-01f, 4.846512377e-01f, 9.597951770e-01f, 2.807013094e-01f,
  9.872272611e-01f, 1.593182087e-01f, 9.959549904e-01f, 8.985326439e-02f, 9.987202883e-01f, 5.057485774e-02f, 9.995952845e-01f, 2.844863199e-02f,
  9.998720288e-01f, 1.599931903e-02f, 9.999595284e-01f, 8.997339755e-03f, 9.999871850e-01f, 5.059622694e-03f, 9.999959469e-01f, 2.845243318e-03f,
  -2.751633525e-01f, -9.613974690e-01f, -9.908979535e-01f, -1.346151382e-01f, 6.158648133e-01f, -7.878518701e-01f, -9.929850101e-01f, 1.182405204e-01f,
  -1.288445443e-01f, 9.916648269e-01f, 5.768082738e-01f, 8.168795705e-01f, 8.589466810e-01f, 5.120649934e-01f, 9.546520114e-01f, 2.977238595e-01f,
  9.855847955e-01f, 1.691823453e-01f, 9.954339862e-01f, 9.545248002e-02f, 9.985553622e-01f, 5.373282731e-02f, 9.995430708e-01f, 3.022614494e-02f,
  9.998555183e-01f, 1.699918136e-02f, 9.999542832e-01f, 9.559656493e-03f, 9.999855757e-01f, 5.375845823e-03f, 9.999954104e-01f, 3.023070283e-03f,
  6.603167057e-01f, -7.509872317e-01f, -7.665365338e-01f, -6.422007084e-01f, 8.303361535e-01f, -5.572628975e-01f, -9.982416630e-01f, -5.927551910e-02f,
  -2.272021621e-01f, 9.738476276e-01f, 5.299841762e-01f, 8.480075598e-01f, 8.423270583e-01f, 5.389667153e-01f, 9.492070079e-01f, 3.146522641e-01f,
  9.838436842e-01f, 1.790295690e-01f, 9.948815107e-01f, 1.010486856e-01f, 9.983804226e-01f, 5.689026415e-02f, 9.994877577e-01f, 3.200356290e-02f,
  9.998379946e-01f, 1.799902879e-02f, 9.999487996e-01f, 1.012197044e-02f, 9.999837875e-01f, 5.692068953e-03f, 9.999948740e-01f, 3.200897481e-03f,
  9.887046218e-01f, 1.498772055e-01f, -3.060953915e-01f, -9.520008564e-01f, 9.624637961e-01f, -2.714101076e-01f, -9.720142484e-01f, -2.349217981e-01f,
  -3.232895434e-01f, 9.463000894e-01f, 4.814845920e-01f, 8.764545321e-01f, 8.248651624e-01f, 5.653295517e-01f, 9.434618354e-01f, 3.314811885e-01f,
  9.820042253e-01f, 1.888588965e-01f, 9.942975044e-01f, 1.066416800e-01f, 9.981955290e-01f, 6.004713103e-02f, 9.994292855e-01f, 3.378088027e-02f,
  9.998195171e-01f, 1.899885759e-02f, 9.999428988e-01f, 1.068428159e-02f, 9.999819398e-01f, 6.008291151e-03f, 9.999942780e-01f, 3.378724447e-03f,
  4.080820680e-01f, 9.129452705e-01f, 2.486167252e-01f, -9.686019421e-01f, 9.991443753e-01f, 4.135828838e-02f, -9.151299596e-01f, -4.031589925e-01f,
  -4.161468446e-01f, 9.092974067e-01f, 4.314628243e-01f, 9.021307230e-01f, 8.065784574e-01f, 5.911270380e-01f, 9.374182820e-01f, 3.482052684e-01f,
  9.800665975e-01f, 1.986693144e-01f, 9.936820865e-01f, 1.122313142e-01f, 9.980006814e-01f, 6.320339441e-02f, 9.993675947e-01f, 3.555808961e-02f,
  9.998000264e-01f, 1.999866776e-02f, 9.999367595e-01f, 1.124658901e-02f, 9.999799728e-01f, 6.324512884e-03f, 9.999936819e-01f, 3.556551412e-03f,
  -5.477292538e-01f, 8.366556168e-01f, 7.267602682e-01f, -6.868911982e-01f, 9.367404580e-01f, 3.500247598e-01f, -8.293829560e-01f, -5.586805344e-01f,
  -5.048462152e-01f, 8.632093072e-01f, 3.800770044e-01f, 9.249548316e-01f, 7.874851823e-01f, 6.163335443e-01f, 9.310783744e-01f, 3.648192585e-01f,
  9.780309200e-01f, 2.084598988e-01f, 9.930352569e-01f, 1.178173944e-01f, 9.977958202e-01f, 6.635902822e-02f, 9.993028045e-01f, 3.733518720e-02f,
  9.997795224e-01f, 2.099845745e-02f, 9.999302626e-01f, 1.180889271e-02f, 9.999779463e-01f, 6.640734151e-03f, 9.999930263e-01f, 3.734378144e-03f,
  -9.999608397e-01f, -8.851309307e-03f, 9.810745716e-01f, -1.936302334e-01f, 7.814403772e-01f, 6.239799261e-01f, -7.174774408e-01f, -6.965817213e-01f,
  -5.885011554e-01f, 8.084963560e-01f, 3.274895847e-01f, 9.448547959e-01f, 7.676045895e-01f, 6.409237385e-01f, 9.244439602e-01f, 3.813178837e-01f,
  9.758974314e-01f, 2.182296216e-01f, 9.923570156e-01f, 1.233997419e-01f, 9.975810051e-01f, 6.951400638e-02f, 9.992348552e-01f, 3.911216930e-02f,
  9.997580051e-01f, 2.199822664e-02f, 9.999234676e-01f, 1.237119269e-02f, 9.999758005e-01f, 6.956954487e-03f, 9.999923706e-01f, 3.912204877e-03f,
  -5.328330398e-01f, -8.462204337e-01f, 9.332357645e-01f, 3.592645228e-01f, 5.486452579e-01f, 8.360552788e-01f, -5.829432607e-01f, -8.125128746e-01f,
  -6.662759781e-01f, 7.457052469e-01f, 2.738668323e-01f, 9.617676139e-01f, 7.469564080e-01f, 6.648730636e-01f, 9.175173044e-01f, 3.976959288e-01f,
  9.736663699e-01f, 2.279775143e-01f, 9.916474223e-01f, 1.289781928e-01f, 9.973561764e-01f, 7.266827673e-02f, 9.991636872e-01f, 4.088902473e-02f,
  9.997355342e-01f, 2.299797349e-02f, 9.999163747e-01f, 1.293348987e-02f, 9.999735355e-01f, 7.273174357e-03f, 9.999916553e-01f, 4.090031609e-03f,
  4.241790175e-01f, -9.055783749e-01f, 5.979771614e-01f, 8.015131354e-01f, 2.614416778e-01f, 9.652192593e-01f, -4.300232828e-01f, -9.028177857e-01f,
  -7.373937964e-01f, 6.754631400e-01f, 2.193782777e-01f, 9.756398797e-01f, 7.255613208e-01f, 6.881574988e-01f, 9.103004336e-01f, 4.139482081e-01f,
  9.713379741e-01f, 2.377026230e-01f, 9.909064770e-01f, 1.345525682e-01f, 9.971213937e-01f, 7.582182437e-02f, 9.990894198e-01f, 4.266574979e-02f,
  9.997119904e-01f, 2.399769612e-02f, 9.999089241e-01f, 1.349578146e-02f, 9.999712110e-01f, 7.589393295e-03f, 9.999908805e-01f, 4.267857410e-03f,
  9.912028313e-01f, -1.323517561e-01f, 7.855226099e-02f, 9.969099760e-01f, -5.168933049e-02f, 9.986631870e-01f, -2.635405958e-01f, -9.646483064e-01f,
  -8.011435866e-01f, 5.984721184e-01f, 1.641961634e-01f, 9.864277244e-01f, 7.034407258e-01f, 7.107539177e-01f, 9.027957320e-01f, 4.300695956e-01f,
  9.689124227e-01f, 2.474039644e-01f, 9.901341200e-01f, 1.401226968e-01f, 9.968766570e-01f, 7.897461206e-02f, 9.990119338e-01f, 4.444234073e-02f,
  9.996874928e-01f, 2.499739639e-02f, 9.999011755e-01f, 1.405806933e-02f, 9.999687672e-01f, 7.905611768e-03f, 9.999901056e-01f, 4.445684142e-03f,
  6.469193101e-01f, 7.625584602e-01f, -4.650644958e-01f, 8.852767944e-01f, -3.596943319e-01f, 9.330701828e-01f, -8.874550462e-02f, -9.960543513e-01f,
  -8.568888307e-01f, 5.155012608e-01f, 1.084949449e-01f, 9.940969944e-01f, 6.806167960e-01f, 7.326396108e-01f, 8.950055838e-01f, 4.460549951e-01f,
  9.663899541e-01f, 2.570805550e-01f, 9.893305302e-01f, 1.456883848e-01f, 9.966219068e-01f, 8.212661743e-02f, 9.989313483e-01f, 4.621879384e-02f,
  9.996620417e-01f, 2.599707060e-02f, 9.998931289e-01f, 1.462035347e-02f, 9.999662042e-01f, 8.221829310e-03f, 9.999893308e-01f, 4.623509943e-03f,
  -2.921388149e-01f, 9.563759565e-01f, -8.654506207e-01f, 5.009942055e-01f, -6.320286393e-01f, 7.749450207e-01f, 8.884811401e-02f, -9.960451722e-01f,
  -9.040721655e-01f, 4.273798466e-01f, 5.245061591e-02f, 9.986234903e-01f, 6.571123004e-01f, 7.537927032e-01f, 8.869323730e-01f, 4.618993104e-01f,
  9.637709260e-01f, 2.667314112e-01f, 9.884956479e-01f, 1.512494683e-01f, 9.963572025e-01f, 8.527779579e-02f, 9.988475442e-01f, 4.799510166e-02f,
  9.996355176e-01f, 2.699672058e-02f, 9.998847246e-01f, 1.518263202e-02f, 9.999635220e-01f, 8.538045920e-03f, 9.999884963e-01f, 4.801335745e-03f,
  -9.626058936e-01f, 2.709057927e-01f, -9.992933869e-01f, -3.758566082e-02f, -8.416849375e-01f, 5.399689674e-01f, 2.636395097e-01f, -9.646213055e-01f,
  -9.422222972e-01f, 3.349882066e-01f, -3.759419080e-03f, 9.999929070e-01f, 6.329506636e-01f, 7.741920948e-01f, 8.785787225e-01f, 4.775975943e-01f,
  9.610554576e-01f, 2.763556540e-01f, 9.876294732e-01f, 1.568057537e-01f, 9.960825443e-01f, 8.842811733e-02f, 9.987606406e-01f, 4.977125302e-02f,
  9.996080399e-01f, 2.799634263e-02f, 9.998760223e-01f, 1.574490592e-02f, 9.999607801e-01f, 8.854261599e-03f, 9.999876022e-01f, 4.979162011e-03f,
  -7.480575442e-01f, -6.636338830e-01f, -8.253716230e-01f, -5.645897985e-01f, -9.678714871e-01f, 2.514453232e-01f, 4.301158488e-01f, -9.027736783e-01f,
  -9.709581733e-01f, 2.392492294e-01f, -5.995756760e-02f, 9.982009530e-01f, 6.081562042e-01f, 7.938174009e-01f, 8.699471951e-01f, 4.931448400e-01f,
  9.582439065e-01f, 2.859522104e-01f, 9.867320657e-01f, 1.623570919e-01f, 9.957979321e-01f, 9.157756716e-02f, 9.986705780e-01f, 5.154724792e-02f,
  9.995795488e-01f, 2.899593674e-02f, 9.998670220e-01f, 1.630717516e-02f, 9.999579787e-01f, 9.170476347e-03f, 9.999867082e-01f, 5.156987347e-03f,
  1.542514563e-01f, -9.880316257e-01f, -3.972518742e-01f, -9.177096486e-01f, -9.980752468e-01f, -6.201484054e-02f, 5.830269456e-01f, -8.124528527e-01f,
  -9.899924994e-01f, 1.411200017e-01f, -1.159661636e-01f, 9.932531714e-01f, 5.827536583e-01f, 8.126488924e-01f, 8.610406518e-01f, 5.085361004e-01f,
  9.553365111e-01f, 2.955201864e-01f, 9.858034849e-01f, 1.679033041e-01f, 9.955033660e-01f, 9.472609311e-02f, 9.985772967e-01f, 5.332308263e-02f,
  9.995500445e-01f, 2.999550104e-02f, 9.998577237e-01f, 1.686943881e-02f, 9.999549985e-01f, 9.486690164e-03f, 9.999857545e-01f, 5.334813148e-03f,
  9.147423506e-01f, -4.040376544e-01f, 1.532154828e-01f, -9.881927967e-01f, -9.293003082e-01f, -3.693250120e-01f, 7.175492048e-01f, -6.965078115e-01f,
  -9.991351366e-01f, 4.158052057e-02f, -1.716081351e-01f, 9.851652980e-01f, 5.567683578e-01f, 8.306677938e-01f, 8.518617749e-01f, 5.237666368e-01f,
  9.523335695e-01f, 3.050586283e-01f, 9.848436713e-01f, 1.734442115e-01f, 9.951988459e-01f, 9.787366539e-02f, 9.984809160e-01f, 5.509874597e-02f,
  9.995195270e-01f, 3.099503554e-02f, 9.998480678e-01f, 1.743169688e-02f, 9.999519587e-01f, 9.802903049e-03f, 9.999848008e-01f, 5.512638018e-03f,
  8.342233896e-01f, 5.514267087e-01f, 6.564951539e-01f, -7.543302178e-01f, -7.683671117e-01f, -6.400094032e-01f, 8.294403553e-01f, -5.585952997e-01f,
  -9.982947707e-01f, -5.837419257e-02f, -2.267075777e-01f, 9.739628434e-01f, 5.302263498e-01f, 8.478561044e-01f, 8.424135447e-01f, 5.388315320e-01f,
  9.492354393e-01f, 3.145665526e-01f, 9.838528037e-01f, 1.789796203e-01f, 9.948843718e-01f, 1.010202691e-01f, 9.983813763e-01f, 5.687423423e-02f,
  9.994880557e-01f, 3.199454024e-02f, 9.998381138e-01f, 1.799395122e-02f, 9.999487996e-01f, 1.011911593e-02f, 9.999837875e-01f, 5.690463353e-03f,
  -1.327674743e-02f, 9.999118447e-01f, 9.575860500e-01f, -2.881473899e-01f, -5.312352777e-01f, -8.472243547e-01f, 9.151713848e-01f, -4.030649364e-01f,
  -9.874798059e-01f, -1.577456445e-01f, -2.810903192e-01f, 9.596813321e-01f, 5.031541586e-01f, 8.641966581e-01f, 8.326989412e-01f, 5.537260175e-01f,
  9.460423589e-01f, 3.240430057e-01f, 9.828307629e-01f, 1.845093668e-01f, 9.945599437e-01f, 1.041658595e-01f, 9.982786179e-01f, 5.864954367e-02f,
  9.994555712e-01f, 3.299400955e-02f, 9.998278022e-01f, 1.855619811e-02f, 9.999455214e-01f, 1.043532696e-02f, 9.999827743e-01f, 5.868288688e-03f,
  -8.485702872e-01f, 5.290827155e-01f, 9.637575150e-01f, 2.667797208e-01f, -2.414211184e-01f, -9.704204202e-01f, 9.720383286e-01f, -2.348221242e-01f,
  -9.667981863e-01f, -2.555412054e-01f, -3.345843852e-01f, 9.423658252e-01f, 4.755789042e-01f, 8.796730638e-01f, 8.227210045e-01f, 5.684453845e-01f,
  9.427546859e-01f, 3.334870934e-01f, 9.817776680e-01f, 1.900332868e-01f, 9.942255616e-01f, 1.073104069e-01f, 9.981727600e-01f, 6.042466685e-02f,
  9.994220734e-01f, 3.399345279e-02f, 9.998172522e-01f, 1.911843941e-02f, 9.999421835e-01f, 1.075153705e-02f, 9.999817014e-01f, 6.046113092e-03f,
  -9.036921859e-01f, -4.281826615e-01f, 6.731102467e-01f, 7.395421267e-01f, 7.233466953e-02f, -9.973804355e-01f, 9.982477427e-01f, -5.917267874e-02f,
  -9.364566803e-01f, -3.507832289e-01f, -3.870206773e-01f, 9.220710397e-01f, 4.475280643e-01f, 8.942698836e-01f, 8.124829531e-01f, 5.829849839e-01f,
  9.393727183e-01f, 3.428978026e-01f, 9.806935191e-01f, 1.955512017e-01f, 9.938812256e-01f, 1.104538813e-01f, 9.980637431e-01f, 6.219960377e-02f,
  9.993875623e-01f, 3.499285504e-02f, 9.998063445e-01f, 1.968067512e-02f, 9.999387264e-01f, 1.106774528e-02f, 9.999806285e-01f, 6.223937962e-03f,
  -1.279636919e-01f, -9.917788506e-01f, 1.751565337e-01f, 9.845405817e-01f, 3.789161742e-01f, -9.254310131e-01f, 9.929728508e-01f, 1.183425859e-01f,
  -8.967583776e-01f, -4.425205588e-01f, -4.382335544e-01f, 8.988611698e-01f, 4.190297425e-01f, 9.079725146e-01f, 8.019878864e-01f, 5.973402858e-01f,
  9.358968139e-01f, 3.522742093e-01f, 9.795783162e-01f, 2.010629177e-01f, 9.935269952e-01f, 1.135962531e-01f, 9.979515672e-01f, 6.397433579e-02f,
  9.993520975e-01f, 3.599222749e-02f, 9.997950792e-01f, 2.024290524e-02f, 9.999352098e-01f, 1.138395350e-02f, 9.999794960e-01f, 6.401761901e-03f,
  7.654140592e-01f, -6.435381174e-01f, -3.767423034e-01f, 9.263181090e-01f, 6.479216814e-01f, -7.617069483e-01f, 9.563800097e-01f, 2.921253741e-01f,
  -8.481000066e-01f, -5.298361778e-01f, -4.880608618e-01f, 8.728095889e-01f, 3.901124299e-01f, 9.207672477e-01f, 7.912392616e-01f, 6.115067005e-01f,
  9.323273301e-01f, 3.616154492e-01f, 9.784321785e-01f, 2.065682709e-01f, 9.931628108e-01f, 1.167374924e-01f, 9.978361726e-01f, 6.574887782e-02f,
  9.993155599e-01f, 3.699155897e-02f, 9.997835755e-01f, 2.080512606e-02f, 9.999315739e-01f, 1.170015987e-02f, 9.999783635e-01f, 6.579586305e-03f,
  9.550736547e-01f, 2.963685691e-01f, -8.126112223e-01f, 5.828061700e-01f, 8.526731133e-01f, -5.224447846e-01f, 8.896234632e-01f, 4.566946924e-01f,
  -7.909677625e-01f, -6.118578315e-01f, -5.363451838e-01f, 8.439987302e-01f, 3.608050346e-01f, 9.326412678e-01f, 7.802404165e-01f, 6.254796982e-01f,
  9.286646247e-01f, 3.709204793e-01f, 9.772551060e-01f, 2.120671123e-01f, 9.927886724e-01f, 1.198775545e-01f, 9.977176785e-01f, 6.752320379e-02f,
  9.992780685e-01f, 3.799085692e-02f, 9.997717142e-01f, 2.136734314e-02f, 9.999278188e-01f, 1.201636530e-02f, 9.999771714e-01f, 6.757410709e-03f,
  2.666429281e-01f, 9.637953639e-01f, -9.982103705e-01f, 5.980031565e-02f, 9.728653431e-01f, -2.313720137e-01f, 7.948083878e-01f, 6.068604589e-01f,
  -7.259322405e-01f, -6.877662539e-01f, -5.829339027e-01f, 8.125196099e-01f, 3.311368525e-01f, 9.435827136e-01f, 7.689949274e-01f, 6.392549276e-01f,
  9.249090552e-01f, 3.801884055e-01f, 9.760470986e-01f, 2.175592482e-01f, 9.924046397e-01f, 1.230164245e-01f, 9.975960255e-01f, 6.929731369e-02f,
  9.992396235e-01f, 3.899011388e-02f, 9.997594953e-01f, 2.192955278e-02f, 9.999239445e-01f, 1.233256981e-02f, 9.999759793e-01f, 6.935234182e-03f,
  -6.669380665e-01f, 7.451131344e-01f, -8.763794303e-01f, -4.816212952e-01f, 9.965789914e-01f, 8.264580369e-02f, 6.749256253e-01f, 7.378857136e-01f,
  -6.536436081e-01f, -7.568024993e-01f, -6.276797056e-01f, 7.784717083e-01f, 3.011375964e-01f, 9.535806775e-01f, 7.575061917e-01f, 6.528279781e-01f,
  9.210609794e-01f, 3.894183338e-01f, 9.748082757e-01f, 2.230444849e-01f, 9.920106530e-01f, 1.261540651e-01f, 9.974712729e-01f, 7.107120752e-02f,
  9.992001057e-01f, 3.998933733e-02f, 9.997470379e-01f, 2.249175683e-02f, 9.999200106e-01f, 1.264877338e-02f, 9.999747276e-01f, 7.113057654e-03f,
  -9.873392582e-01f, -1.586226672e-01f, -4.846394062e-01f, -8.747140169e-01f, 9.214623570e-01f, 3.884676993e-01f, 5.337560773e-01f, 8.456384540e-01f,
  -5.748240352e-01f, -8.182770610e-01f, -6.704410911e-01f, 7.419627905e-01f, 2.708370686e-01f, 9.626252055e-01f, 7.457779050e-01f, 6.661946774e-01f,
  9.171208143e-01f, 3.986093104e-01f, 9.735385776e-01f, 2.285226882e-01f, 9.916067719e-01f, 1.292904317e-01f, 9.973433018e-01f, 7.284487784e-02f,
  9.991596341e-01f, 4.098851606e-02f, 9.997342229e-01f, 2.305394970e-02f, 9.999159575e-01f, 1.296497509e-02f, 9.999734163e-01f, 7.290880661e-03f,
  -3.999853134e-01f, -9.165215492e-01f, 5.636094138e-02f, -9.984104633e-01f, 7.549653649e-01f, 6.557646990e-01f, 3.757521510e-01f, 9.267202020e-01f,
  -4.902605712e-01f, -8.715758920e-01f, -7.110829353e-01f, 7.031081319e-01f, 2.402658761e-01f, 9.707071185e-01f, 7.338138223e-01f, 6.793506742e-01f,
  9.130889177e-01f, 4.077604413e-01f, 9.722381234e-01f, 2.339936644e-01f, 9.911929369e-01f, 1.324255317e-01f, 9.972121716e-01f, 7.461831719e-02f,
  9.991181493e-01f, 4.198765755e-02f, 9.997211099e-01f, 2.361613885e-02f, 9.999117851e-01f, 1.328117587e-02f, 9.999721050e-01f, 7.468704134e-03f,
  5.551133156e-01f, -8.317747712e-01f, 5.800031424e-01f, -8.146142364e-01f, 5.135984421e-01f, 8.580306768e-01f, 2.058971673e-01f, 9.785736203e-01f,
  -4.007990062e-01f, -9.161660075e-01f, -7.494767308e-01f, 6.620306373e-01f, 2.094544172e-01f, 9.778184295e-01f, 7.216176391e-01f, 6.922917962e-01f,
  9.089657664e-01f, 4.168707728e-01f, 9.709069133e-01f, 2.394572198e-01f, 9.907692075e-01f, 1.355592906e-01f, 9.970778823e-01f, 7.639151812e-02f,
  9.990756512e-01f, 4.298675060e-02f, 9.997076392e-01f, 2.417832054e-02f, 9.999075532e-01f, 1.359737478e-02f, 9.999707937e-01f, 7.646527141e-03f,
  9.998432994e-01f, 1.770192571e-02f, 9.250146747e-01f, -3.799313903e-01f, 2.212981731e-01f, 9.752061963e-01f, 2.954781987e-02f, 9.995633960e-01f,
  -3.073327839e-01f, -9.516021013e-01f, -7.855011225e-01f, 6.188601851e-01f, 1.784335226e-01f, 9.839519858e-01f, 7.091933489e-01f, 7.050140500e-01f,
  9.047516584e-01f, 4.259394705e-01f, 9.695450068e-01f, 2.449132055e-01f, 9.903355837e-01f, 1.386916935e-01f, 9.969404936e-01f, 7.816448808e-02f,
  9.990321398e-01f, 4.398580641e-02f, 9.996939301e-01f, 2.474049293e-02f, 9.999032021e-01f, 1.391357277e-02f, 9.999693632e-01f, 7.824349217e-03f,
  5.253219604e-01f, 8.509035110e-01f, 9.851381779e-01f, 1.717635691e-01f, -9.294810891e-02f, 9.956709743e-01f, -1.477329880e-01f, 9.890272617e-01f,
  -2.107958049e-01f, -9.775301218e-01f, -8.190422058e-01f, 5.737332702e-01f, 1.472342163e-01f, 9.891016483e-01f, 6.965447664e-01f, 7.175133228e-01f,
  9.004471302e-01f, 4.349655211e-01f, 9.681524038e-01f, 2.503614724e-01f, 9.898920655e-01f, 1.418227106e-01f, 9.967998862e-01f, 7.993719727e-02f,
  9.989876747e-01f, 4.498481750e-02f, 9.996798635e-01f, 2.530265786e-02f, 9.998987317e-01f, 1.422976889e-02f, 9.999679923e-01f, 8.002171293e-03f,
  -4.321779311e-01f, 9.017883539e-01f, 7.418580055e-01f, 6.705570221e-01f, -3.979767561e-01f, 9.173954725e-01f, -3.203543723e-01f, 9.472977519e-01f,
  -1.121526212e-01f, -9.936909676e-01f, -8.499938846e-01f, 5.267925262e-01f, 1.158876941e-01f, 9.932623506e-01f, 6.836758852e-01f, 7.297857404e-01f,
  8.960524797e-01f, 4.439480901e-01f, 9.667292237e-01f, 2.558017969e-01f, 9.894386530e-01f, 1.449523121e-01f, 9.966561794e-01f, 8.170966059e-02f,
  9.989421964e-01f, 4.598378390e-02f, 9.996654391e-01f, 2.586481534e-02f, 9.998942018e-01f, 1.454596408e-02f, 9.999665618e-01f, 8.179994300e-03f,
  -9.923354983e-01f, 1.235731244e-01f, 2.700984478e-01f, 9.628326893e-01f, -6.635382771e-01f, 7.481423616e-01f, -4.828719497e-01f, 8.756909966e-01f,
  -1.238837745e-02f, -9.999232888e-01f, -8.782584071e-01f, 4.781863391e-01f, 8.442528546e-02f, 9.964298010e-01f, 6.705908775e-01f, 7.418274283e-01f,
  8.915683031e-01f, 4.528862834e-01f, 9.652754664e-01f, 2.612340748e-01f, 9.889753461e-01f, 1.480804533e-01f, 9.965093136e-01f, 8.348185569e-02f,
  9.988957047e-01f, 4.698270187e-02f, 9.996507764e-01f, 2.642696351e-02f, 9.998895526e-01f, 1.486215740e-02f, 9.999650717e-01f, 8.357816376e-03f,
  -6.401443481e-01f, -7.682546377e-01f, -2.848466039e-01f, 9.585731030e-01f, -8.632965088e-01f, 5.046970844e-01f, -6.301599741e-01f, 7.764653563e-01f,
  8.749917150e-02f, -9.961646199e-01f, -9.037463665e-01f, 4.280683994e-01f, 5.287845805e-02f, 9.986009598e-01f, 6.572937369e-01f, 7.536345124e-01f,
  8.869948983e-01f, 4.617791772e-01f, 9.637911916e-01f, 2.666580379e-01f, 9.885020852e-01f, 1.512071192e-01f, 9.963592887e-01f, 8.525379747e-02f,
  9.988481998e-01f, 4.798157141e-02f, 9.996357560e-01f, 2.698910423e-02f, 9.998847842e-01f, 1.517834887e-02f, 9.999635816e-01f, 8.535637520e-03f,
  3.005925417e-01f, -9.537526369e-01f, -7.520639896e-01f, 6.590901017e-01f, -9.774427414e-01f, 2.112006545e-01f, -7.575730681e-01f, 6.527503729e-01f,
  1.865124702e-01f, -9.824525714e-01f, -9.263771176e-01f, 3.765971363e-01f, 2.127875760e-02f, 9.997735620e-01f, 6.437888145e-01f, 7.652031779e-01f,
  8.823328614e-01f, 4.706258774e-01f, 9.622764587e-01f, 2.720735669e-01f, 9.880189896e-01f, 1.543322802e-01f, 9.962061048e-01f, 8.702547103e-02f,
  9.987997413e-01f, 4.898039624e-02f, 9.996203780e-01f, 2.755123749e-02f, 9.998799562e-01f, 1.549453940e-02f, 9.999620318e-01f, 8.713459596e-03f,
  9.649659991e-01f, -2.623748481e-01f, -9.876590967e-01f, 1.566190720e-01f, -9.946564436e-01f, -1.032404602e-01f, -8.610926867e-01f, 5.084479451e-01f,
  2.836622000e-01f, -9.589242935e-01f, -9.460792542e-01f, 3.239352703e-01f, -1.034221891e-02f, 9.999465346e-01f, 6.300802827e-01f, 7.765299678e-01f,
  8.775825500e-01f, 4.794255495e-01f, 9.607312679e-01f, 2.774805427e-01f, 9.875259995e-01f, 1.574558914e-01f, 9.960497618e-01f, 8.879686147e-02f,
  9.987502694e-01f, 4.997916892e-02f, 9.996047616e-01f, 2.811335959e-02f, 9.998750091e-01f, 1.581072807e-02f, 9.999604821e-01f, 8.891279809e-03f,
  7.421541810e-01f, 6.702291965e-01f, -9.190735221e-01f, -3.940860629e-01f, -9.132301211e-01f, -4.074441493e-01f, -9.374542236e-01f, 3.481085002e-01f,
  3.779776692e-01f, -9.258147478e-01f, -9.627903700e-01f, 2.702493370e-01f, -4.195285589e-02f, 9.991195798e-01f, 6.161724925e-01f, 7.876111865e-01f,
  8.727445006e-01f, 4.881772399e-01f, 9.591556787e-01f, 2.828786969e-01f, 9.870231748e-01f, 1.605779380e-01f, 9.958902597e-01f, 9.056797624e-02f,
  9.986997843e-01f, 5.097789690e-02f, 9.995887876e-01f, 2.867547423e-02f, 9.998699427e-01f, 1.612691768e-02f, 9.999588728e-01f, 9.069100954e-03f,
  -1.629907787e-01f, 9.866275787e-01f, -5.674300194e-01f, -8.234215975e-01f, -7.412399650e-01f, -6.712401509e-01f, -9.842484593e-01f, 1.767906845e-01f,
  4.685169160e-01f, -8.834545016e-01f, -9.764577150e-01f, 2.157090008e-01f, -7.352153957e-02f, 9.972936511e-01f, 6.020699143e-01f, 7.984433770e-01f,
  8.678191900e-01f, 4.968801141e-01f, 9.575498104e-01f, 2.882679403e-01f, 9.865104556e-01f, 1.636983752e-01f, 9.957276583e-01f, 9.233880043e-02f,
  9.986482859e-01f, 5.197656900e-02f, 9.995725155e-01f, 2.923758142e-02f, 9.998648167e-01f, 1.644310169e-02f, 9.999572635e-01f, 9.246920235e-03f,
  -9.182828069e-01f, 3.959251642e-01f, -4.102819040e-02f, -9.991579652e-01f, -4.957418144e-01f, -8.684699535e-01f, -1.000000000e+00f, -1.030206768e-04f,
  5.543745160e-01f, -8.322673440e-01f, -9.870380163e-01f, 1.604867280e-01f, -1.050167084e-01f, 9.944704771e-01f, 5.877769589e-01f, 8.090230227e-01f,
  8.628070951e-01f, 5.055333376e-01f, 9.559136033e-01f, 2.936480343e-01f, 9.859878421e-01f, 1.668171734e-01f, 9.955618382e-01f, 9.410934150e-02f,
  9.985958338e-01f, 5.297519267e-02f, 9.995558858e-01f, 2.979967557e-02f, 9.998595715e-01f, 1.675928757e-02f, 9.999555945e-01f, 9.424741380e-03f,
  -8.293098211e-01f, -5.587890744e-01f, 4.980095923e-01f, -8.671715260e-01f, -2.010796219e-01f, -9.795749187e-01f, -9.842120409e-01f, -1.769934744e-01f,
  6.346929669e-01f, -7.727644444e-01f, -9.944978952e-01f, 1.047568321e-01f, -1.364068687e-01f, 9.906529188e-01f, 5.732980371e-01f, 8.193469048e-01f,
  8.577086926e-01f, 5.141359568e-01f, 9.542471766e-01f, 2.990188897e-01f, 9.854553938e-01f, 1.699342877e-01f, 9.953929186e-01f, 9.587957710e-02f,
  9.985423684e-01f, 5.397376046e-02f, 9.995389581e-01f, 3.036176413e-02f, 9.998542070e-01f, 1.707546785e-02f, 9.999538660e-01f, 9.602561593e-03f,
  2.212675661e-02f, -9.997551441e-01f, 8.836693168e-01f, -4.681116641e-01f, 1.135217771e-01f, -9.935355186e-01f, -9.373825192e-01f, -3.483016491e-01f,
  7.086697817e-01f, -7.055402994e-01f, -9.988136292e-01f, 4.869600013e-02f, -1.676606387e-01f, 9.858447909e-01f, 5.586379170e-01f, 8.294116855e-01f,
  8.525245190e-01f, 5.226872563e-01f, 9.525505900e-01f, 3.043802381e-01f, 9.849131107e-01f, 1.730497181e-01f, 9.952208400e-01f, 9.764950722e-02f,
  9.984878898e-01f, 5.497227982e-02f, 9.995217323e-01f, 3.092384152e-02f, 9.998487830e-01f, 1.739165001e-02f, 9.999521971e-01f, 9.780380875e-03f,
  8.532201052e-01f, -5.215510130e-01f, 9.971746206e-01f, 7.511820644e-02f, 4.168670774e-01f, -9.089674354e-01f, -8.609884381e-01f, -5.086245537e-01f,
  7.755658031e-01f, -6.312667131e-01f, -9.999717474e-01f, -7.518785074e-03f, -1.987468749e-01f, 9.800508618e-01f, 5.438010693e-01f, 8.392141461e-01f,
  8.472551107e-01f, 5.311862230e-01f, 9.508239031e-01f, 3.097319603e-01f, 9.843609333e-01f, 1.761634201e-01f, 9.950456619e-01f, 9.941913933e-02f,
  9.984323978e-01f, 5.597073585e-02f, 9.995042086e-01f, 3.148590773e-02f, 9.998431802e-01f, 1.770782843e-02f, 9.999504089e-01f, 9.958200157e-03f,
  8.998668194e-01f, 4.361647666e-01f, 8.035690784e-01f, 5.952115059e-01f, 6.788702011e-01f, -7.342582941e-01f, -7.574391961e-01f, -6.529057026e-01f,
  8.347129226e-01f, -5.506852865e-01f, -9.979684949e-01f, -6.370979548e-02f, -2.296342701e-01f, 9.732769728e-01f, 5.287923217e-01f, 8.487512469e-01f,
  8.419010043e-01f, 5.396320224e-01f, 9.490671158e-01f, 3.150739372e-01f, 9.837989211e-01f, 1.792753637e-01f, 9.948672652e-01f, 1.011884511e-01f,
  9.983759522e-01f, 5.696914345e-02f, 9.994863272e-01f, 3.204796836e-02f, 9.998375773e-01f, 1.802400686e-02f, 9.999486208e-01f, 1.013601944e-02f,
  1.191801354e-01f, 9.928726554e-01f, 3.624766767e-01f, 9.319928288e-01f, 8.735505342e-01f, -4.867334962e-01f, -6.300007105e-01f, -7.765945792e-01f,
  8.855196238e-01f, -4.646020234e-01f, -9.928101897e-01f, -1.196993962e-01f, -2.602920532e-01f, 9.655299187e-01f, 5.136163235e-01f, 8.580200076e-01f,
  8.364626765e-01f, 5.480239391e-01f, 9.472803473e-01f, 3.204059005e-01f, 9.832270741e-01f, 1.823855042e-01f, 9.946857691e-01f, 1.029574350e-01f,
  9.983184934e-01f, 5.796748772e-02f, 9.994681478e-01f, 3.261001408e-02f, 9.998317957e-01f, 1.834018156e-02f, 9.999468327e-01f, 1.031383779e-02f,
  -7.710801959e-01f, 6.367380023e-01f, -1.902491003e-01f, 9.817358255e-01f, 9.816020727e-01f, -1.909380108e-01f, -4.826923311e-01f, -8.757900000e-01f,
  9.274784923e-01f, -3.738765717e-01f, -9.845131636e-01f, -1.753105819e-01f, -2.906895578e-01f, 9.568174481e-01f, 4.982779026e-01f, 8.670173883e-01f,
  8.309407234e-01f, 5.563610196e-01f, 9.454635978e-01f, 3.257277906e-01f, 9.826454520e-01f, 1.854938269e-01f, 9.945011139e-01f, 1.047261059e-01f,
  9.982600212e-01f, 5.896577984e-02f, 9.994496703e-01f, 3.317204863e-02f, 9.998259544e-01f, 1.865635626e-02f, 9.999449849e-01f, 1.049165614e-02f,
  -9.524129629e-01f, -3.048106134e-01f, -6.843819022e-01f, 7.291237116e-01f, 9.923083186e-01f, 1.237909496e-01f, -3.201591671e-01f, -9.473637342e-01f,
  9.601702690e-01f, -2.794154882e-01f, -9.731037021e-01f, -2.303675115e-01f, -3.207964003e-01f, 9.471482038e-01f, 4.827820361e-01f, 8.757405281e-01f,
  8.253356218e-01f, 5.646424294e-01f, 9.436169863e-01f, 3.310393095e-01f, 9.820539355e-01f, 1.886002868e-01f, 9.943132997e-01f, 1.064944416e-01f,
  9.982005358e-01f, 5.996400863e-02f, 9.994308352e-01f, 3.373407945e-02f, 9.998199940e-01f, 1.897252724e-02f, 9.999430776e-01f, 1.066947449e-02f,
  -2.581016421e-01f, -9.661177993e-01f, -9.677396417e-01f, 2.519522607e-01f, 9.046075940e-01f, 4.262454212e-01f, -1.475291997e-01f, -9.890577197e-01f,
  9.832684398e-01f, -1.821625978e-01f, -9.586178064e-01f, -2.846961617e-01f, -3.505824506e-01f, 9.365318418e-01f, 4.671334028e-01f, 8.841868639e-01f,
  8.196480274e-01f, 5.728674531e-01f, 9.417404532e-01f, 3.363404274e-01f, 9.814526439e-01f, 1.917048544e-01f, 9.941223264e-01f, 1.082624346e-01f,
  9.981400967e-01f, 6.096218154e-02f, 9.994117022e-01f, 3.429609165e-02f, 9.998139739e-01f, 1.928869821e-02f, 9.999411702e-01f, 1.084729191e-02f,
  6.735071540e-01f, -7.391806841e-01f, -9.530500174e-01f, -3.028128743e-01f, 7.271980643e-01f, 6.864276528e-01f, 2.975377068e-02f, -9.995572567e-01f,
  9.965420961e-01f, -8.308912069e-02f, -9.411013126e-01f, -3.381247520e-01f, -3.800179660e-01f, 9.249790907e-01f, 4.513370395e-01f, 8.923535347e-01f,
  8.138784766e-01f, 5.810351372e-01f, 9.398342371e-01f, 3.416308761e-01f, 9.808415174e-01f, 1.948075294e-01f, 9.939282537e-01f, 1.100300923e-01f,
  9.980786443e-01f, 6.196028739e-02f, 9.993922710e-01f, 3.485809639e-02f, 9.998078346e-01f, 1.960486546e-02f, 9.999392033e-01f, 1.102510840e-02f,
  9.858965874e-01f, 1.673557013e-01f, -6.448370218e-01f, -7.643200755e-01f, 4.776714444e-01f, 8.785385489e-01f, 2.060983330e-01f, -9.785313010e-01f,
  9.998586178e-01f, 1.681409031e-02f, -9.206095338e-01f, -3.904843926e-01f, -4.090735018e-01f, 9.125014544e-01f, 4.353979528e-01f, 9.002380967e-01f,
  8.080275059e-01f, 5.891447663e-01f, 9.378982186e-01f, 3.469105363e-01f, 9.802205563e-01f, 1.979082376e-01f, 9.937310219e-01f, 1.117973924e-01f,
  9.980161786e-01f, 6.295833737e-02f, 9.993724823e-01f, 3.542009369e-02f, 9.998015761e-01f, 1.992103085e-02f, 9.999372363e-01f, 1.120292582e-02f,
};
__device__ const float ROPE32[1024] = {
  1.000000000e+00f, 0.000000000e+00f, 1.000000000e+00f, 0.000000000e+00f, 1.000000000e+00f, 0.000000000e+00f, 1.000000000e+00f, 0.000000000e+00f,
  1.000000000e+00f, 0.000000000e+00f, 1.000000000e+00f, 0.000000000e+00f, 1.000000000e+00f, 0.000000000e+00f, 1.000000000e+00f, 0.000000000e+00f,
  5.403022766e-01f, 8.414709568e-01f, 9.504152536e-01f, 3.109835982e-01f, 9.950041771e-01f, 9.983342141e-02f, 9.995000362e-01f, 3.161750361e-02f,
  9.999499917e-01f, 9.999833070e-03f, 9.999949932e-01f, 3.162272274e-03f, 9.999995232e-01f, 9.999999311e-04f, 9.999999404e-01f, 3.162277571e-04f,
  -4.161468446e-01f, 9.092974067e-01f, 8.065783978e-01f, 5.911270976e-01f, 9.800665975e-01f, 1.986693293e-01f, 9.980006814e-01f, 6.320339441e-02f,
  9.998000264e-01f, 1.999866590e-02f, 9.999799728e-01f, 6.324512884e-03f, 9.999979734e-01f, 1.999998698e-03f, 9.999998212e-01f, 6.324554561e-04f,
  -9.899924994e-01f, 1.411200017e-01f, 5.827536583e-01f, 8.126488924e-01f, 9.553365111e-01f, 2.955202162e-01f, 9.955033660e-01f, 9.472608566e-02f,
  9.995500445e-01f, 2.999549918e-02f, 9.999549985e-01f, 9.486690164e-03f, 9.999955297e-01f, 2.999995602e-03f, 9.999995232e-01f, 9.486831259e-04f,
  -6.536436081e-01f, -7.568024993e-01f, 3.011374772e-01f, 9.535807371e-01f, 9.210609794e-01f, 3.894183338e-01f, 9.920106530e-01f, 1.261540651e-01f,
  9.992001057e-01f, 3.998933360e-02f, 9.999200106e-01f, 1.264877338e-02f, 9.999920130e-01f, 3.999989480e-03f, 9.999992251e-01f, 1.264910679e-03f,
  2.836622000e-01f, -9.589242935e-01f, -1.034233812e-02f, 9.999465346e-01f, 8.775825500e-01f, 4.794255495e-01f, 9.875259995e-01f, 1.574558765e-01f,
  9.987502694e-01f, 4.997916520e-02f, 9.998750091e-01f, 1.581072807e-02f, 9.999874830e-01f, 4.999979399e-03f, 9.999987483e-01f, 1.581138116e-03f,
  9.601702690e-01f, -2.794154882e-01f, -3.207964003e-01f, 9.471482038e-01f, 8.253356218e-01f, 5.646424890e-01f, 9.820539355e-01f, 1.886002719e-01f,
  9.982005358e-01f, 5.996400490e-02f, 9.998199940e-01f, 1.897252724e-02f, 9.999819994e-01f, 5.999964196e-03f, 9.999982119e-01f, 1.897365320e-03f,
  7.539022565e-01f, 6.569865942e-01f, -5.994374752e-01f, 8.004215956e-01f, 7.648422122e-01f, 6.442176700e-01f, 9.755998850e-01f, 2.195560932e-01f,
  9.975510240e-01f, 6.994284689e-02f, 9.997550249e-01f, 2.213413455e-02f, 9.999755025e-01f, 6.999942940e-03f, 9.999975562e-01f, 2.213592408e-03f,
  -1.455000341e-01f, 9.893582463e-01f, -8.186324239e-01f, 5.743177533e-01f, 6.967067122e-01f, 7.173560858e-01f, 9.681702852e-01f, 2.502923310e-01f,
  9.968017340e-01f, 7.991468906e-02f, 9.996800423e-01f, 2.529552206e-02f, 9.999679923e-01f, 7.999914698e-03f, 9.999967813e-01f, 2.529819263e-03f,
  -9.111302495e-01f, 4.121184945e-01f, -9.566441774e-01f, 2.912592292e-01f, 6.216099262e-01f, 7.833269238e-01f, 9.597726464e-01f, 2.807783186e-01f,
  9.959527254e-01f, 8.987854421e-02f, 9.995950460e-01f, 2.845665626e-02f, 9.999595284e-01f, 8.999879472e-03f, 9.999959469e-01f, 2.846045885e-03f,
  -8.390715122e-01f, -5.440211296e-01f, -9.997860789e-01f, -2.068356983e-02f, 5.403022766e-01f, 8.414709568e-01f, 9.504153132e-01f, 3.109835684e-01f,
  9.950041771e-01f, 9.983341396e-02f, 9.995000362e-01f, 3.161750361e-02f, 9.999499917e-01f, 9.999834001e-03f, 9.999949932e-01f, 3.162272274e-03f,
  4.425697960e-03f, -9.999902248e-01f, -9.437797666e-01f, -3.305749595e-01f, 4.535960853e-01f, 8.912073970e-01f, 9.401075840e-01f, 3.408778608e-01f,
  9.939560890e-01f, 1.097782999e-01f, 9.993950725e-01f, 3.477803990e-02f, 9.999395013e-01f, 1.099977922e-02f, 9.999939203e-01f, 3.478498431e-03f,
  8.438539505e-01f, -5.365729332e-01f, -7.941793799e-01f, -6.076834202e-01f, 3.623577058e-01f, 9.320390821e-01f, 9.288598895e-01f, 3.704313040e-01f,
  9.928086400e-01f, 1.197122037e-01f, 9.992800951e-01f, 3.793822229e-02f, 9.999279976e-01f, 1.199971233e-02f, 9.999927878e-01f, 3.794723889e-03f,
  9.074468017e-01f, 4.201670289e-01f, -5.658205152e-01f, -8.245284557e-01f, 2.674987614e-01f, 9.635581970e-01f, 9.166833758e-01f, 3.996143043e-01f,
  9.915618896e-01f, 1.296341419e-01f, 9.991551042e-01f, 4.109803215e-02f, 9.999154806e-01f, 1.299963426e-02f, 9.999915361e-01f, 4.110949114e-03f,
  1.367372125e-01f, 9.906073809e-01f, -2.813494802e-01f, -9.596053958e-01f, 1.699671596e-01f, 9.854497313e-01f, 9.035902619e-01f, 4.283977747e-01f,
  9.902160168e-01f, 1.395431161e-01f, 9.990201592e-01f, 4.425742477e-02f, 9.999020100e-01f, 1.399954315e-02f, 9.999902248e-01f, 4.427174106e-03f,
  -7.596879005e-01f, 6.502878666e-01f, 3.102235124e-02f, -9.995186925e-01f, 7.073719800e-02f, 9.974949956e-01f, 8.895936012e-01f, 4.567528665e-01f,
  9.887710810e-01f, 1.494381279e-01f, 9.988752007e-01f, 4.741638154e-02f, 9.998875260e-01f, 1.499943808e-02f, 9.999887347e-01f, 4.743398633e-03f,
  -9.576594830e-01f, -2.879033089e-01f, 3.403181732e-01f, -9.403103590e-01f, -2.919954620e-02f, 9.995735884e-01f, 8.747074604e-01f, 4.846512377e-01f,
  9.872272611e-01f, 1.593182087e-01f, 9.987202883e-01f, 5.057485774e-02f, 9.998720288e-01f, 1.599931903e-02f, 9.999871850e-01f, 5.059622694e-03f,
  -2.751633525e-01f, -9.613974690e-01f, 6.158648133e-01f, -7.878518701e-01f, -1.288445443e-01f, 9.916648269e-01f, 8.589466810e-01f, 5.120649934e-01f,
  9.855847955e-01f, 1.691823453e-01f, 9.985553622e-01f, 5.373282731e-02f, 9.998555183e-01f, 1.699918136e-02f, 9.999855757e-01f, 5.375845823e-03f,
  6.603167057e-01f, -7.509872317e-01f, 8.303361535e-01f, -5.572628975e-01f, -2.272021621e-01f, 9.738476276e-01f, 8.423270583e-01f, 5.389667153e-01f,
  9.838436842e-01f, 1.790295690e-01f, 9.983804226e-01f, 5.689026415e-02f, 9.998379946e-01f, 1.799902879e-02f, 9.999837875e-01f, 5.692068953e-03f,
  9.887046218e-01f, 1.498772055e-01f, 9.624637961e-01f, -2.714101076e-01f, -3.232895434e-01f, 9.463000894e-01f, 8.248651624e-01f, 5.653295517e-01f,
  9.820042253e-01f, 1.888588965e-01f, 9.981955290e-01f, 6.004713103e-02f, 9.998195171e-01f, 1.899885759e-02f, 9.999819398e-01f, 6.008291151e-03f,
  4.080820680e-01f, 9.129452705e-01f, 9.991443753e-01f, 4.135828838e-02f, -4.161468446e-01f, 9.092974067e-01f, 8.065784574e-01f, 5.911270380e-01f,
  9.800665975e-01f, 1.986693144e-01f, 9.980006814e-01f, 6.320339441e-02f, 9.998000264e-01f, 1.999866776e-02f, 9.999799728e-01f, 6.324512884e-03f,
  -5.477292538e-01f, 8.366556168e-01f, 9.367404580e-01f, 3.500247598e-01f, -5.048462152e-01f, 8.632093072e-01f, 7.874851823e-01f, 6.163335443e-01f,
  9.780309200e-01f, 2.084598988e-01f, 9.977958202e-01f, 6.635902822e-02f, 9.997795224e-01f, 2.099845745e-02f, 9.999779463e-01f, 6.640734151e-03f,
  -9.999608397e-01f, -8.851309307e-03f, 7.814403772e-01f, 6.239799261e-01f, -5.885011554e-01f, 8.084963560e-01f, 7.676045895e-01f, 6.409237385e-01f,
  9.758974314e-01f, 2.182296216e-01f, 9.975810051e-01f, 6.951400638e-02f, 9.997580051e-01f, 2.199822664e-02f, 9.999758005e-01f, 6.956954487e-03f,
  -5.328330398e-01f, -8.462204337e-01f, 5.486452579e-01f, 8.360552788e-01f, -6.662759781e-01f, 7.457052469e-01f, 7.469564080e-01f, 6.648730636e-01f,
  9.736663699e-01f, 2.279775143e-01f, 9.973561764e-01f, 7.266827673e-02f, 9.997355342e-01f, 2.299797349e-02f, 9.999735355e-01f, 7.273174357e-03f,
  4.241790175e-01f, -9.055783749e-01f, 2.614416778e-01f, 9.652192593e-01f, -7.373937964e-01f, 6.754631400e-01f, 7.255613208e-01f, 6.881574988e-01f,
  9.713379741e-01f, 2.377026230e-01f, 9.971213937e-01f, 7.582182437e-02f, 9.997119904e-01f, 2.399769612e-02f, 9.999712110e-01f, 7.589393295e-03f,
  9.912028313e-01f, -1.323517561e-01f, -5.168933049e-02f, 9.986631870e-01f, -8.011435866e-01f, 5.984721184e-01f, 7.034407258e-01f, 7.107539177e-01f,
  9.689124227e-01f, 2.474039644e-01f, 9.968766570e-01f, 7.897461206e-02f, 9.996874928e-01f, 2.499739639e-02f, 9.999687672e-01f, 7.905611768e-03f,
  6.469193101e-01f, 7.625584602e-01f, -3.596943319e-01f, 9.330701828e-01f, -8.568888307e-01f, 5.155012608e-01f, 6.806167960e-01f, 7.326396108e-01f,
  9.663899541e-01f, 2.570805550e-01f, 9.966219068e-01f, 8.212661743e-02f, 9.996620417e-01f, 2.599707060e-02f, 9.999662042e-01f, 8.221829310e-03f,
  -2.921388149e-01f, 9.563759565e-01f, -6.320286393e-01f, 7.749450207e-01f, -9.040721655e-01f, 4.273798466e-01f, 6.571123004e-01f, 7.537927032e-01f,
  9.637709260e-01f, 2.667314112e-01f, 9.963572025e-01f, 8.527779579e-02f, 9.996355176e-01f, 2.699672058e-02f, 9.999635220e-01f, 8.538045920e-03f,
  -9.626058936e-01f, 2.709057927e-01f, -8.416849375e-01f, 5.399689674e-01f, -9.422222972e-01f, 3.349882066e-01f, 6.329506636e-01f, 7.741920948e-01f,
  9.610554576e-01f, 2.763556540e-01f, 9.960825443e-01f, 8.842811733e-02f, 9.996080399e-01f, 2.799634263e-02f, 9.999607801e-01f, 8.854261599e-03f,
  -7.480575442e-01f, -6.636338830e-01f, -9.678714871e-01f, 2.514453232e-01f, -9.709581733e-01f, 2.392492294e-01f, 6.081562042e-01f, 7.938174009e-01f,
  9.582439065e-01f, 2.859522104e-01f, 9.957979321e-01f, 9.157756716e-02f, 9.995795488e-01f, 2.899593674e-02f, 9.999579787e-01f, 9.170476347e-03f,
  1.542514563e-01f, -9.880316257e-01f, -9.980752468e-01f, -6.201484054e-02f, -9.899924994e-01f, 1.411200017e-01f, 5.827536583e-01f, 8.126488924e-01f,
  9.553365111e-01f, 2.955201864e-01f, 9.955033660e-01f, 9.472609311e-02f, 9.995500445e-01f, 2.999550104e-02f, 9.999549985e-01f, 9.486690164e-03f,
  9.147423506e-01f, -4.040376544e-01f, -9.293003082e-01f, -3.693250120e-01f, -9.991351366e-01f, 4.158052057e-02f, 5.567683578e-01f, 8.306677938e-01f,
  9.523335695e-01f, 3.050586283e-01f, 9.951988459e-01f, 9.787366539e-02f, 9.995195270e-01f, 3.099503554e-02f, 9.999519587e-01f, 9.802903049e-03f,
  8.342233896e-01f, 5.514267087e-01f, -7.683671117e-01f, -6.400094032e-01f, -9.982947707e-01f, -5.837419257e-02f, 5.302263498e-01f, 8.478561044e-01f,
  9.492354393e-01f, 3.145665526e-01f, 9.948843718e-01f, 1.010202691e-01f, 9.994880557e-01f, 3.199454024e-02f, 9.999487996e-01f, 1.011911593e-02f,
  -1.327674743e-02f, 9.999118447e-01f, -5.312352777e-01f, -8.472243547e-01f, -9.874798059e-01f, -1.577456445e-01f, 5.031541586e-01f, 8.641966581e-01f,
  9.460423589e-01f, 3.240430057e-01f, 9.945599437e-01f, 1.041658595e-01f, 9.994555712e-01f, 3.299400955e-02f, 9.999455214e-01f, 1.043532696e-02f,
  -8.485702872e-01f, 5.290827155e-01f, -2.414211184e-01f, -9.704204202e-01f, -9.667981863e-01f, -2.555412054e-01f, 4.755789042e-01f, 8.796730638e-01f,
  9.427546859e-01f, 3.334870934e-01f, 9.942255616e-01f, 1.073104069e-01f, 9.994220734e-01f, 3.399345279e-02f, 9.999421835e-01f, 1.075153705e-02f,
  -9.036921859e-01f, -4.281826615e-01f, 7.233466953e-02f, -9.973804355e-01f, -9.364566803e-01f, -3.507832289e-01f, 4.475280643e-01f, 8.942698836e-01f,
  9.393727183e-01f, 3.428978026e-01f, 9.938812256e-01f, 1.104538813e-01f, 9.993875623e-01f, 3.499285504e-02f, 9.999387264e-01f, 1.106774528e-02f,
  -1.279636919e-01f, -9.917788506e-01f, 3.789161742e-01f, -9.254310131e-01f, -8.967583776e-01f, -4.425205588e-01f, 4.190297425e-01f, 9.079725146e-01f,
  9.358968139e-01f, 3.522742093e-01f, 9.935269952e-01f, 1.135962531e-01f, 9.993520975e-01f, 3.599222749e-02f, 9.999352098e-01f, 1.138395350e-02f,
  7.654140592e-01f, -6.435381174e-01f, 6.479216814e-01f, -7.617069483e-01f, -8.481000066e-01f, -5.298361778e-01f, 3.901124299e-01f, 9.207672477e-01f,
  9.323273301e-01f, 3.616154492e-01f, 9.931628108e-01f, 1.167374924e-01f, 9.993155599e-01f, 3.699155897e-02f, 9.999315739e-01f, 1.170015987e-02f,
  9.550736547e-01f, 2.963685691e-01f, 8.526731133e-01f, -5.224447846e-01f, -7.909677625e-01f, -6.118578315e-01f, 3.608050346e-01f, 9.326412678e-01f,
  9.286646247e-01f, 3.709204793e-01f, 9.927886724e-01f, 1.198775545e-01f, 9.992780685e-01f, 3.799085692e-02f, 9.999278188e-01f, 1.201636530e-02f,
  2.666429281e-01f, 9.637953639e-01f, 9.728653431e-01f, -2.313720137e-01f, -7.259322405e-01f, -6.877662539e-01f, 3.311368525e-01f, 9.435827136e-01f,
  9.249090552e-01f, 3.801884055e-01f, 9.924046397e-01f, 1.230164245e-01f, 9.992396235e-01f, 3.899011388e-02f, 9.999239445e-01f, 1.233256981e-02f,
  -6.669380665e-01f, 7.451131344e-01f, 9.965789914e-01f, 8.264580369e-02f, -6.536436081e-01f, -7.568024993e-01f, 3.011375964e-01f, 9.535806775e-01f,
  9.210609794e-01f, 3.894183338e-01f, 9.920106530e-01f, 1.261540651e-01f, 9.992001057e-01f, 3.998933733e-02f, 9.999200106e-01f, 1.264877338e-02f,
  -9.873392582e-01f, -1.586226672e-01f, 9.214623570e-01f, 3.884676993e-01f, -5.748240352e-01f, -8.182770610e-01f, 2.708370686e-01f, 9.626252055e-01f,
  9.171208143e-01f, 3.986093104e-01f, 9.916067719e-01f, 1.292904317e-01f, 9.991596341e-01f, 4.098851606e-02f, 9.999159575e-01f, 1.296497509e-02f,
  -3.999853134e-01f, -9.165215492e-01f, 7.549653649e-01f, 6.557646990e-01f, -4.902605712e-01f, -8.715758920e-01f, 2.402658761e-01f, 9.707071185e-01f,
  9.130889177e-01f, 4.077604413e-01f, 9.911929369e-01f, 1.324255317e-01f, 9.991181493e-01f, 4.198765755e-02f, 9.999117851e-01f, 1.328117587e-02f,
  5.551133156e-01f, -8.317747712e-01f, 5.135984421e-01f, 8.580306768e-01f, -4.007990062e-01f, -9.161660075e-01f, 2.094544172e-01f, 9.778184295e-01f,
  9.089657664e-01f, 4.168707728e-01f, 9.907692075e-01f, 1.355592906e-01f, 9.990756512e-01f, 4.298675060e-02f, 9.999075532e-01f, 1.359737478e-02f,
  9.998432994e-01f, 1.770192571e-02f, 2.212981731e-01f, 9.752061963e-01f, -3.073327839e-01f, -9.516021013e-01f, 1.784335226e-01f, 9.839519858e-01f,
  9.047516584e-01f, 4.259394705e-01f, 9.903355837e-01f, 1.386916935e-01f, 9.990321398e-01f, 4.398580641e-02f, 9.999032021e-01f, 1.391357277e-02f,
  5.253219604e-01f, 8.509035110e-01f, -9.294810891e-02f, 9.956709743e-01f, -2.107958049e-01f, -9.775301218e-01f, 1.472342163e-01f, 9.891016483e-01f,
  9.004471302e-01f, 4.349655211e-01f, 9.898920655e-01f, 1.418227106e-01f, 9.989876747e-01f, 4.498481750e-02f, 9.998987317e-01f, 1.422976889e-02f,
  -4.321779311e-01f, 9.017883539e-01f, -3.979767561e-01f, 9.173954725e-01f, -1.121526212e-01f, -9.936909676e-01f, 1.158876941e-01f, 9.932623506e-01f,
  8.960524797e-01f, 4.439480901e-01f, 9.894386530e-01f, 1.449523121e-01f, 9.989421964e-01f, 4.598378390e-02f, 9.998942018e-01f, 1.454596408e-02f,
  -9.923354983e-01f, 1.235731244e-01f, -6.635382771e-01f, 7.481423616e-01f, -1.238837745e-02f, -9.999232888e-01f, 8.442528546e-02f, 9.964298010e-01f,
  8.915683031e-01f, 4.528862834e-01f, 9.889753461e-01f, 1.480804533e-01f, 9.988957047e-01f, 4.698270187e-02f, 9.998895526e-01f, 1.486215740e-02f,
  -6.401443481e-01f, -7.682546377e-01f, -8.632965088e-01f, 5.046970844e-01f, 8.749917150e-02f, -9.961646199e-01f, 5.287845805e-02f, 9.986009598e-01f,
  8.869948983e-01f, 4.617791772e-01f, 9.885020852e-01f, 1.512071192e-01f, 9.988481998e-01f, 4.798157141e-02f, 9.998847842e-01f, 1.517834887e-02f,
  3.005925417e-01f, -9.537526369e-01f, -9.774427414e-01f, 2.112006545e-01f, 1.865124702e-01f, -9.824525714e-01f, 2.127875760e-02f, 9.997735620e-01f,
  8.823328614e-01f, 4.706258774e-01f, 9.880189896e-01f, 1.543322802e-01f, 9.987997413e-01f, 4.898039624e-02f, 9.998799562e-01f, 1.549453940e-02f,
  9.649659991e-01f, -2.623748481e-01f, -9.946564436e-01f, -1.032404602e-01f, 2.836622000e-01f, -9.589242935e-01f, -1.034221891e-02f, 9.999465346e-01f,
  8.775825500e-01f, 4.794255495e-01f, 9.875259995e-01f, 1.574558914e-01f, 9.987502694e-01f, 4.997916892e-02f, 9.998750091e-01f, 1.581072807e-02f,
  7.421541810e-01f, 6.702291965e-01f, -9.132301211e-01f, -4.074441493e-01f, 3.779776692e-01f, -9.258147478e-01f, -4.195285589e-02f, 9.991195798e-01f,
  8.727445006e-01f, 4.881772399e-01f, 9.870231748e-01f, 1.605779380e-01f, 9.986997843e-01f, 5.097789690e-02f, 9.998699427e-01f, 1.612691768e-02f,
  -1.629907787e-01f, 9.866275787e-01f, -7.412399650e-01f, -6.712401509e-01f, 4.685169160e-01f, -8.834545016e-01f, -7.352153957e-02f, 9.972936511e-01f,
  8.678191900e-01f, 4.968801141e-01f, 9.865104556e-01f, 1.636983752e-01f, 9.986482859e-01f, 5.197656900e-02f, 9.998648167e-01f, 1.644310169e-02f,
  -9.182828069e-01f, 3.959251642e-01f, -4.957418144e-01f, -8.684699535e-01f, 5.543745160e-01f, -8.322673440e-01f, -1.050167084e-01f, 9.944704771e-01f,
  8.628070951e-01f, 5.055333376e-01f, 9.859878421e-01f, 1.668171734e-01f, 9.985958338e-01f, 5.297519267e-02f, 9.998595715e-01f, 1.675928757e-02f,
  -8.293098211e-01f, -5.587890744e-01f, -2.010796219e-01f, -9.795749187e-01f, 6.346929669e-01f, -7.727644444e-01f, -1.364068687e-01f, 9.906529188e-01f,
  8.577086926e-01f, 5.141359568e-01f, 9.854553938e-01f, 1.699342877e-01f, 9.985423684e-01f, 5.397376046e-02f, 9.998542070e-01f, 1.707546785e-02f,
  2.212675661e-02f, -9.997551441e-01f, 1.135217771e-01f, -9.935355186e-01f, 7.086697817e-01f, -7.055402994e-01f, -1.676606387e-01f, 9.858447909e-01f,
  8.525245190e-01f, 5.226872563e-01f, 9.849131107e-01f, 1.730497181e-01f, 9.984878898e-01f, 5.497227982e-02f, 9.998487830e-01f, 1.739165001e-02f,
  8.532201052e-01f, -5.215510130e-01f, 4.168670774e-01f, -9.089674354e-01f, 7.755658031e-01f, -6.312667131e-01f, -1.987468749e-01f, 9.800508618e-01f,
  8.472551107e-01f, 5.311862230e-01f, 9.843609333e-01f, 1.761634201e-01f, 9.984323978e-01f, 5.597073585e-02f, 9.998431802e-01f, 1.770782843e-02f,
  8.998668194e-01f, 4.361647666e-01f, 6.788702011e-01f, -7.342582941e-01f, 8.347129226e-01f, -5.506852865e-01f, -2.296342701e-01f, 9.732769728e-01f,
  8.419010043e-01f, 5.396320224e-01f, 9.837989211e-01f, 1.792753637e-01f, 9.983759522e-01f, 5.696914345e-02f, 9.998375773e-01f, 1.802400686e-02f,
  1.191801354e-01f, 9.928726554e-01f, 8.735505342e-01f, -4.867334962e-01f, 8.855196238e-01f, -4.646020234e-01f, -2.602920532e-01f, 9.655299187e-01f,
  8.364626765e-01f, 5.480239391e-01f, 9.832270741e-01f, 1.823855042e-01f, 9.983184934e-01f, 5.796748772e-02f, 9.998317957e-01f, 1.834018156e-02f,
  -7.710801959e-01f, 6.367380023e-01f, 9.816020727e-01f, -1.909380108e-01f, 9.274784923e-01f, -3.738765717e-01f, -2.906895578e-01f, 9.568174481e-01f,
  8.309407234e-01f, 5.563610196e-01f, 9.826454520e-01f, 1.854938269e-01f, 9.982600212e-01f, 5.896577984e-02f, 9.998259544e-01f, 1.865635626e-02f,
  -9.524129629e-01f, -3.048106134e-01f, 9.923083186e-01f, 1.237909496e-01f, 9.601702690e-01f, -2.794154882e-01f, -3.207964003e-01f, 9.471482038e-01f,
  8.253356218e-01f, 5.646424294e-01f, 9.820539355e-01f, 1.886002868e-01f, 9.982005358e-01f, 5.996400863e-02f, 9.998199940e-01f, 1.897252724e-02f,
  -2.581016421e-01f, -9.661177993e-01f, 9.046075940e-01f, 4.262454212e-01f, 9.832684398e-01f, -1.821625978e-01f, -3.505824506e-01f, 9.365318418e-01f,
  8.196480274e-01f, 5.728674531e-01f, 9.814526439e-01f, 1.917048544e-01f, 9.981400967e-01f, 6.096218154e-02f, 9.998139739e-01f, 1.928869821e-02f,
  6.735071540e-01f, -7.391806841e-01f, 7.271980643e-01f, 6.864276528e-01f, 9.965420961e-01f, -8.308912069e-02f, -3.800179660e-01f, 9.249790907e-01f,
  8.138784766e-01f, 5.810351372e-01f, 9.808415174e-01f, 1.948075294e-01f, 9.980786443e-01f, 6.196028739e-02f, 9.998078346e-01f, 1.960486546e-02f,
  9.858965874e-01f, 1.673557013e-01f, 4.776714444e-01f, 8.785385489e-01f, 9.998586178e-01f, 1.681409031e-02f, -4.090735018e-01f, 9.125014544e-01f,
  8.080275059e-01f, 5.891447663e-01f, 9.802205563e-01f, 1.979082376e-01f, 9.980161786e-01f, 6.295833737e-02f, 9.998015761e-01f, 1.992103085e-02f,
};
#define XB_TMO      128
#define XB_XCNT(j)  (256  + 64 * (j))
#define XB_XSUB(j)  (1280 + 64 * (j))
#define XB_XGEN(j)  (2304 + 64 * (j))
#define XB_TOP      3328
#define XB_TOPGEN   3392
#define XCD_BAR_WORDS 3456
#define XB_SPIN_CAP (1u << 18)
#define LAS __attribute__((address_space(3)))

__device__ __forceinline__ unsigned xb_ld(unsigned* p)              { return __hip_atomic_load(p, __ATOMIC_RELAXED, __HIP_MEMORY_SCOPE_AGENT); }
__device__ __forceinline__ unsigned xb_add(unsigned* p, unsigned v) { return __hip_atomic_fetch_add(p, v, __ATOMIC_RELAXED, __HIP_MEMORY_SCOPE_AGENT); }
__device__ __forceinline__ unsigned xb_xcc_id() { return (unsigned)__builtin_amdgcn_s_getreg((3 << 11) | 20) & 0xFu; }
#define XB_SPIN(cond, bar) do { unsigned _sp = 0; while (cond) { __builtin_amdgcn_s_sleep(1); \
    if ((++_sp & 255u) == 0u) { if (xb_ld(&(bar)[XB_TMO])) break; if (_sp > XB_SPIN_CAP) { atomicAdd(&(bar)[XB_TMO], 1u); break; } } } } while (0)

struct XcdBarrier {
    unsigned* bar; unsigned x;
    volatile LAS unsigned* st;
};

__device__ __forceinline__ XcdBarrier xcd_barrier_post(unsigned* bar, volatile LAS unsigned* st) {
    XcdBarrier b; b.bar = bar; b.x = xb_xcc_id(); b.st = st;
    if (threadIdx.x == 0) (void)xb_add(&bar[XB_XCNT(b.x)], 1u);
    return b;
}
__device__ __forceinline__ void xcd_barrier_complete(unsigned* bar, unsigned x, unsigned& nloc, unsigned& nx) {
    const unsigned G = gridDim.x * gridDim.y * gridDim.z;
    unsigned sum, cnt, mine, sp = 0u;
    for (;;) {
        sum = 0u; cnt = 0u; mine = 0u;
#pragma unroll
        for (unsigned j = 0; j < 16; ++j) { const unsigned c = xb_ld(&bar[XB_XCNT(j)]); sum += c; cnt += (c > 0u) ? 1u : 0u; mine = (j == x) ? c : mine; }
        if (sum == G) break;
        __builtin_amdgcn_s_sleep(1);
        if ((++sp & 255u) == 0u) { if (xb_ld(&bar[XB_TMO])) break; if (sp > XB_SPIN_CAP) { atomicAdd(&bar[XB_TMO], 1u); break; } }
    }
    nloc = mine > 0u ? mine : 1u; nx = cnt > 0u ? cnt : 1u;
}

__device__ __forceinline__ void xcd_barrier(const XcdBarrier& b, const bool t0  ) {
    asm volatile("s_waitcnt vmcnt(0)" ::: "memory");
    __syncthreads();
    if (t0) {
        unsigned* bar = b.bar;
        __builtin_amdgcn_s_waitcnt(0);
        unsigned nloc = b.st[0], nx = b.st[1];
        if (nloc == 0u) { xcd_barrier_complete(bar, b.x, nloc, nx); b.st[0] = nloc; b.st[1] = nx; }
        const unsigned old = xb_add(&bar[XB_XSUB(b.x)], 1u);
        const unsigned gen = old / nloc;
        if (old + 1u == (gen + 1u) * nloc) {
            __builtin_amdgcn_fence(__ATOMIC_RELEASE, "agent");
            asm volatile("s_waitcnt vmcnt(0)" ::: "memory");
            const unsigned og = xb_add(&bar[XB_TOP], 1u);
            const unsigned tg = og / nx;
            if (og + 1u == (tg + 1u) * nx) xb_add(&bar[XB_TOPGEN], 1u);
            else XB_SPIN(xb_ld(&bar[XB_TOPGEN]) == tg, bar);
            __builtin_amdgcn_fence(__ATOMIC_ACQUIRE, "agent");
            xb_add(&bar[XB_XGEN(b.x)], 1u);
            asm volatile("s_waitcnt vmcnt(0)" ::: "memory");
        } else {
            XB_SPIN(xb_ld(&bar[XB_XGEN(b.x)]) == gen, bar);
            __builtin_amdgcn_fence(__ATOMIC_ACQUIRE, "agent");
            asm volatile("s_waitcnt vmcnt(0)" ::: "memory");
        }
    }
    __syncthreads();
}

DI void conv_fetch(const float* __restrict__ src, int K, int N, int k0, int n0, f32x4 (&v)[2], int tid) {
#pragma unroll
    for (int i = 0; i < 2; ++i) {
        const int idx = tid + NTHREADS * i, kr = idx >> 4, c4 = (idx & 15) * 4;
        v[i] = (f32x4){0.f, 0.f, 0.f, 0.f};
        if (n0 + c4 < N) v[i] = __builtin_nontemporal_load((const f32x4*)(src + (size_t)(k0 + kr) * N + n0 + c4));
    }
}
DI void conv_put(const f32x4 (&v)[2], float* lds, int tid) {
#pragma unroll
    for (int i = 0; i < 2; ++i) {
        const int idx = tid + NTHREADS * i, kr = idx >> 4, c4 = (idx & 15) * 4;
        float* d = lds + kr * 65 + c4;
        d[0] = v[i].x; d[1] = v[i].y; d[2] = v[i].z; d[3] = v[i].w;
    }
}
DI unsigned cvt_fp8x4(float a, float b, float c, float d) { int w = __builtin_amdgcn_cvt_pk_fp8_f32(a, b, 0, false); w = __builtin_amdgcn_cvt_pk_fp8_f32(c, d, w, true); return (unsigned)w; }
template <bool NT, bool FP8>
DI void conv_store(int K, bf16_t* __restrict__ dst, int k0, int ndst0, int nstep, const float* lds, int tid) {
    const int idx = tid, n = idx >> 3, kc = idx & 7;
    float f[8];
#pragma unroll
    for (int j = 0; j < 8; ++j) f[j] = lds[(kc * 8 + j) * 65 + n];
    const size_t e = (size_t)(ndst0 + (n & 31) + (n >> 5) * nstep) * K + k0 + kc * 8;
    if (FP8) {
        u32x2 w; w.x = cvt_fp8x4(f[0] * 32.f, f[1] * 32.f, f[2] * 32.f, f[3] * 32.f); w.y = cvt_fp8x4(f[4] * 32.f, f[5] * 32.f, f[6] * 32.f, f[7] * 32.f);
        u32x2* d = (u32x2*)((unsigned char*)dst + e);
        if (NT) __builtin_nontemporal_store(w, d); else *d = w;
    } else {
        u32x4* d = (u32x4*)(dst + e);
        if (NT) __builtin_nontemporal_store(pack8(f), d); else *d = pack8(f);
    }
}
template <bool NT = true, bool FP8 = false>
DI void conv_job(const float* src, int count, int K, int N, int Npad, bf16_t* dst, int perm  , int& base, float* lds, int bid, int nb, int tid) {
    const int tk = K / 64, tn = Npad / 64, per = tk * tn, total = count * per;
    int t = (bid - (base % nb) + nb) % nb;
    f32x4 rg[4][2];
    auto fetch4 = [&](int tt) {
#pragma unroll
        for (int q = 0; q < 4; ++q) {
            const int tq = tt + q * nb;
            if (tq < total) { const int mi = tq / per, rem = tq - mi * per, nt = rem / tk, kt = rem - nt * tk;
                conv_fetch(src + (size_t)mi * K * N, K, N, kt * 64, nt * 64, rg[q], tid); }
        }
    };
    if (t < total) fetch4(t);
    for (; t < total; t += 4 * nb) {
#pragma unroll
        for (int q = 0; q < 4; ++q) if (t + q * nb < total) conv_put(rg[q], lds + q * 4160, tid);
        __syncthreads();
        if (t + 4 * nb < total) fetch4(t + 4 * nb);
#pragma unroll
        for (int q = 0; q < 4; ++q) {
            const int tq = t + q * nb;
            if (tq < total) { const int mi = tq / per, rem = tq - mi * per, nt = rem / tk, kt = rem - nt * tk, n0 = nt * 64;
                int nd0 = n0, nstep = 32;
                if (perm == 1) nd0 = ((n0 & 255) >> 7) * 256 + (n0 >> 8) * 128 + (n0 & 127);
                else if (n0 < perm) { const int hg = n0 >> 6; nd0 = (hg >> 2) * 256 + (hg & 3) * 32; nstep = 128; }
                conv_store<NT, FP8>(K, FP8 ? (bf16_t*)((unsigned char*)dst + (size_t)mi * Npad * K) : dst + (size_t)mi * Npad * K, kt * 64, nd0, nstep, lds + q * 4160, tid); }
        }
        __syncthreads();
    }
    base += total;
}

DI int mla_col(bool uq, int r) {
    const int hw = uq ? 96 : 128;
    if (r < 1024) { const int pn = r >> 8, bj = (r >> 7) & 1, wc = (r >> 5) & 3, d = r & 31; return (4 * pn + wc) * hw + 32 * bj + d; }
    const int rr = r - 1024;
    if (uq) { const int head = rr >> 5, c = rr & 31, dim = (c >> 3) * 4 + (c & 3) + 16 * ((c >> 2) & 1); return head * 96 + 64 + dim; }
    return (rr >> 6) * 128 + 64 + (rr & 63);
}
DI void phase_prologue(const Params& p, float* lds, int bid, int nb, int tid) {
    bf16_t* ws16 = (bf16_t*)p.ws;
    int base = 0;
    conv_job(p.in[13], 1, 1024, 3072, 3072, (bf16_t*)(p.ws + W_QKV0), 2048, base, lds, bid, nb, tid);
    conv_job(p.in[14], 1, 1024, 1024, 1024, (bf16_t*)(p.ws + W_O0), 0, base, lds, bid, nb, tid);
    conv_job(p.in[18], 1, 1024, 1536, 1536, (bf16_t*)(p.ws + W_QKV1), 1280, base, lds, bid, nb, tid);
    conv_job(p.in[19], 1, 1024, 1024, 1024, (bf16_t*)(p.ws + W_O1), 0, base, lds, bid, nb, tid);
    conv_job(p.in[23], 1, 1024, 672, 768, (bf16_t*)(p.ws + W_DQKV), 0, base, lds, bid, nb, tid);
    for (int i = bid * NTHREADS + tid; i < 1536 * 48 + 2048 * 32; i += nb * NTHREADS) {
        const bool uq = i < 1536 * 48;
        const int K = uq ? 384 : 256, kc = K / 8, ii = uq ? i : i - 1536 * 48, r = ii / kc, k0 = (ii - r * kc) * 8, nsrc = uq ? 1536 : 2048;
        const int col = mla_col(uq, r);
        const float* src = p.in[uq ? 26 : 27] + (size_t)k0 * nsrc + col;
        float f[8];
#pragma unroll
        for (int j = 0; j < 8; ++j) f[j] = src[(size_t)j * nsrc];
        *(u32x4*)((bf16_t*)(p.ws + (uq ? W_UQ : W_UKV)) + (size_t)r * K + k0) = pack8(f);
    }
    conv_job(p.in[30], 1, 1024, 1024, 1024, (bf16_t*)(p.ws + W_O2), 0, base, lds, bid, nb, tid);
    conv_job(p.in[31], 1, 1024, 3072, 3072, (bf16_t*)(p.ws + W_QKV3), 2048, base, lds, bid, nb, tid);
    conv_job(p.in[36], 1, 1024, 1024, 1024, (bf16_t*)(p.ws + W_O3), 0, base, lds, bid, nb, tid);
    conv_job<true, true>(p.in[11], 32, 1024, 512, 512, (bf16_t*)(p.ws + W_GU), 1, base, lds, bid, nb, tid);
    conv_job(p.in[12], 32, 256, 1024, 1024, (bf16_t*)(p.ws + W_DN), 0, base, lds, bid, nb, tid);
    (void)ws16;
    float* sc = lds;
    for (int i = tid; i < 9 * 1024; i += NTHREADS) {
        const int r = i >> 10, k = i & 1023;
        const float v = r < 8 ? p.in[1][r * 1024 + k] : p.in[3][k];
        sc[i] = silu_f(v);
    }
    __syncthreads();
    float* part = (float*)(p.ws + WS_MODP);
    for (int it = bid; it < 768; it += nb) {
        const int kc = it / 48, rem = it - kc * 48, l = rem / 12, nch = rem - l * 12;
        const int n = nch * 512 + tid;
        const float* w = p.in[4] + ((size_t)l * 1024 + kc * 64) * 6144 + n;
        float acc[9];
#pragma unroll
        for (int r = 0; r < 9; ++r) acc[r] = 0.f;
#pragma unroll 8
        for (int k = 0; k < 64; ++k) {
            const float wv = __builtin_nontemporal_load(w + (size_t)k * 6144);
#pragma unroll
            for (int r = 0; r < 9; ++r) acc[r] += sc[r * 1024 + kc * 64 + k] * wv;
        }
#pragma unroll
        for (int r = 0; r < 9; ++r) part[(((size_t)kc * 4 + l) * 9 + r) * 6144 + n] = acc[r];
    }
    __syncthreads();
}
DI void phase_mod_reduce(const Params& p, int bid, int nb, int tid) {
    const float* part = (const float*)(p.ws + WS_MODP);
    float* mod = (float*)(p.ws + WS_MOD);
    const int total = 4 * 9 * 6144;
    for (int i = bid * NTHREADS + tid; i < total; i += nb * NTHREADS) {
        const int l = i / (9 * 6144), n = i % 6144;
        float s = p.in[5][l * 6144 + n];
#pragma unroll
        for (int kc = 0; kc < 16; ++kc) s += part[(size_t)kc * total + i];
        mod[i] = s;
    }
}

template <int MODE>
DI void phase_rows(const Params& p, int layer  , int which  , int bid, int nb, int tid) {
    const int wid = __builtin_amdgcn_readfirstlane(tid >> 6), lane = tid & 63;
    const float* modall = (const float*)(p.ws + WS_MOD);
    const bf16_t* eo = (const bf16_t*)(p.ws + WS_RAW);
    bf16_t* H = (bf16_t*)(p.ws + WS_H);
    for (int r = bid * NW + wid; r < MROWS; r += nb * NW) {
        const int b = r / PP, pos = r - b * PP;
        if ((MODE & 16) && pos >= SEQ) continue;
        const int mr = pos < SEQ ? b : 8;
        bf16_t* xb = xb_row(p, r);
        float x[16];
        if (MODE & 8) {
            const float* xr = pos < SEQ ? p.in[0] + ((size_t)b * SEQ + pos) * DM : p.in[2] + ((size_t)b * CTXL + (pos - SEQ)) * DM;
#pragma unroll
            for (int j = 0; j < 4; ++j) { const f32x4 v = *(const f32x4*)(xr + lane * 4 + 256 * j); x[4 * j] = v.x; x[4 * j + 1] = v.y; x[4 * j + 2] = v.z; x[4 * j + 3] = v.w; }
        } else {
#pragma unroll
            for (int j = 0; j < 4; ++j) { const u32x2 v = *(const u32x2*)(xb + lane * 4 + 256 * j); x[4 * j] = bflo(v.x); x[4 * j + 1] = bfhi(v.x); x[4 * j + 2] = bflo(v.y); x[4 * j + 3] = bfhi(v.y); }
        }
        if (MODE & 1) {
            const float* g2 = modall + ((size_t)(layer - ((MODE & 2) ? 1 : 0)) * 9 + mr) * 6144 + 5120;
            const bf16_t* y0 = eo + (size_t)(2 * r) * 1024, *y1 = y0 + 1024;
#pragma unroll
            for (int j = 0; j < 4; ++j) {
                const u32x2 a = *(const u32x2*)(y0 + lane * 4 + 256 * j), bb = *(const u32x2*)(y1 + lane * 4 + 256 * j);
                const f32x4 g = *(const f32x4*)(g2 + lane * 4 + 256 * j);
                x[4 * j] += g.x * (bflo(a.x) + bflo(bb.x)); x[4 * j + 1] += g.y * (bfhi(a.x) + bfhi(bb.x));
                x[4 * j + 2] += g.z * (bflo(a.y) + bflo(bb.y)); x[4 * j + 3] += g.w * (bfhi(a.y) + bfhi(bb.y));
            }
        }
        if (MODE & 16) {
            float* orow = p.out + ((size_t)b * SEQ + pos) * DM;
#pragma unroll
            for (int j = 0; j < 4; ++j) *(f32x4*)(orow + lane * 4 + 256 * j) = (f32x4){x[4 * j], x[4 * j + 1], x[4 * j + 2], x[4 * j + 3]};
        } else if (MODE & (1 | 8)) {
#pragma unroll
            for (int j = 0; j < 4; ++j) {
                u32x2 w; w.x = pk2(x[4 * j], x[4 * j + 1]); w.y = pk2(x[4 * j + 2], x[4 * j + 3]);
                *(u32x2*)(xb + lane * 4 + 256 * j) = w;
                x[4 * j] = bflo(w.x); x[4 * j + 1] = bfhi(w.x); x[4 * j + 2] = bflo(w.y); x[4 * j + 3] = bfhi(w.y);
            }
        }
        if (MODE & 2) {
            float ss = 0.f;
#pragma unroll
            for (int i = 0; i < 16; ++i) ss += x[i] * x[i];
            ss = wave_sum(ss);
            const float rs = rsqrtf(ss * (1.0f / 1024.0f) + EPS);
            const float* ng = p.in[6] + ((size_t)layer * 2 + which) * 1024;
            const float* md = modall + ((size_t)layer * 9 + mr) * 6144 + which * 3072;
#pragma unroll
            for (int j = 0; j < 4; ++j) {
                const f32x4 g = *(const f32x4*)(ng + lane * 4 + 256 * j), sh = *(const f32x4*)(md + lane * 4 + 256 * j), sc = *(const f32x4*)(md + 1024 + lane * 4 + 256 * j);
                u32x2 w;
                w.x = pk2(x[4 * j] * rs * g.x * (1.0f + sc.x) + sh.x, x[4 * j + 1] * rs * g.y * (1.0f + sc.y) + sh.y);
                w.y = pk2(x[4 * j + 2] * rs * g.z * (1.0f + sc.z) + sh.z, x[4 * j + 3] * rs * g.w * (1.0f + sc.w) + sh.w);
                *(u32x2*)(H + (size_t)r * 1024 + lane * 4 + 256 * j) = w;
            }
        }
    }
}

constexpr size_t WS_RC = WS_MOD + 917504;
DI void phase_router_prep(const Params& p, int bid, int nb, int tid) {
    const float* modall = (const float*)(p.ws + WS_MOD);
    bf16_t* wth = (bf16_t*)(p.ws + WS_RW); bf16_t* wtl = wth + 4 * 9 * 48 * 1024;
    const int total = 4 * 9 * 48 * 1024;
    for (int i = bid * NTHREADS + tid; i < total; i += nb * NTHREADS) {
        const int k = i & 1023, c = (i >> 10) % 48, lb = i / (48 * 1024), l = lb / 9, b = lb - l * 9;
        float v = 0.f;
        if (c < 36) {
            const float w = c < 32 ? p.in[9][((size_t)l * 1024 + k) * 32 + c] : p.in[7][((size_t)l * 1024 + k) * 4 + (c - 32)];
            v = p.in[6][((size_t)l * 2 + 1) * 1024 + k] * (1.0f + modall[((size_t)l * 9 + b) * 6144 + 4096 + k]) * w;
        }
        const unsigned hb = f2bf(v); wth[i] = (bf16_t)hb; wtl[i] = (bf16_t)f2bf(v - bf2f(hb));
    }
    float* cst = (float*)(p.ws + WS_RC);
    const int wid = __builtin_amdgcn_readfirstlane(tid >> 6), lane = tid & 63;
    for (int j = bid * NW + wid; j < 4 * 9 * 48; j += nb * NW) {
        const int c = j % 48, lb = j / 48, l = lb / 9, b = lb - l * 9;
        float acc = 0.f;
        if (c < 36) {
            for (int k = lane; k < 1024; k += 64) {
                const float w = c < 32 ? p.in[9][((size_t)l * 1024 + k) * 32 + c] : p.in[7][((size_t)l * 1024 + k) * 4 + (c - 32)];
                acc += modall[((size_t)l * 9 + b) * 6144 + 3072 + k] * w;
            }
            acc = wave_sum(acc) + (c < 32 ? p.in[10][l * 32 + c] : p.in[8][l * 4 + (c - 32)]);
        }
        if (lane == 0) cst[j] = acc;
    }
}
typedef float f32x2_3 __attribute__((ext_vector_type(2)));
typedef __bf16 bf16x2_3 __attribute__((ext_vector_type(2)));
DI unsigned cvtpk3(float lo, float hi) { f32x2_3 v = {lo, hi}; bf16x2_3 b = __builtin_convertvector(v, bf16x2_3); return __builtin_bit_cast(unsigned, b); }
DI void phase_router(const Params& p, unsigned char* smem, int layer, bool skip_ctx, int bid, int nb, int tid) {
    const int lane = tid & 63, wid = __builtin_amdgcn_readfirstlane(tid >> 6), li = lane & 15, kq = lane >> 4;
    LAS float* tile = (LAS float*)smem + wid * (32 * 49);
    const bf16_t* wth_all = (const bf16_t*)(p.ws + WS_RW) + (size_t)layer * 9 * 48 * 1024;
    const bf16_t* wtl_all = wth_all + 4 * 9 * 48 * 1024;
    const float* cst_all = (const float*)(p.ws + WS_RC) + layer * 9 * 48;
    unsigned* cnt = (unsigned*)(p.ws + WS_CTL) + CW_CNT + layer * 32;
    unsigned* list = (unsigned*)(p.ws + WS_LIST);
    float* gates = (float*)(p.ws + WS_GATE);
    if (layer > 0) {
        int base = 0;
        conv_job<false, true>(p.in[11] + (size_t)layer * 32 * 1024 * 512, 32, 1024, 512, 512, (bf16_t*)(p.ws + W_GU + (size_t)layer * 32 * 512 * 1024), 1, base, (float*)smem, bid, nb, tid);
        conv_job<false>(p.in[12] + (size_t)layer * 32 * 256 * 1024, 32, 256, 1024, 1024, (bf16_t*)(p.ws + W_DN) + (size_t)layer * 32 * 1024 * 256, 0, base, (float*)smem, bid, nb, tid);
    }
    for (int u = bid * NW + wid; u < MROWS / 32; u += nb * NW) {
        const int r0 = u * 32, b = r0 / PP, pos = r0 - b * PP;
        const bool isctx = pos >= SEQ;
        if (skip_ctx && isctx) continue;
        const int mr = isctx ? 8 : b;
        const bf16_t* xr = xb_row(p, r0 + li) + 8 * kq;
        const bf16_t* wh = wth_all + ((size_t)mr * 48 + li) * 1024 + 8 * kq;
        const bf16_t* wl = wtl_all + ((size_t)mr * 48 + li) * 1024 + 8 * kq;
        f32x4 acc[2][3];
#pragma unroll
        for (int m = 0; m < 2; ++m)
#pragma unroll
            for (int n = 0; n < 3; ++n) acc[m][n] = (f32x4){0.f, 0.f, 0.f, 0.f};
        float ss[2] = {0.f, 0.f};
#pragma unroll 2
        for (int s = 0; s < 32; ++s) {
            bf16x8 xa[2], bh[3], bl[3];
#pragma unroll
            for (int m = 0; m < 2; ++m) xa[m] = *(const bf16x8*)(xr + (size_t)m * 16 * DM + 32 * s);
#pragma unroll
            for (int n = 0; n < 3; ++n) { bh[n] = *(const bf16x8*)(wh + (size_t)n * 16 * 1024 + 32 * s); bl[n] = *(const bf16x8*)(wl + (size_t)n * 16 * 1024 + 32 * s); }
#pragma unroll
            for (int m = 0; m < 2; ++m) {
                const u32x4 w = __builtin_bit_cast(u32x4, xa[m]);
                ss[m] += bflo(w.x) * bflo(w.x) + bfhi(w.x) * bfhi(w.x) + bflo(w.y) * bflo(w.y) + bfhi(w.y) * bfhi(w.y) + bflo(w.z) * bflo(w.z) + bfhi(w.z) * bfhi(w.z) + bflo(w.w) * bflo(w.w) + bfhi(w.w) * bfhi(w.w);
#pragma unroll
                for (int n = 0; n < 3; ++n) {
                    acc[m][n] = __builtin_amdgcn_mfma_f32_16x16x32_bf16(xa[m], bl[n], acc[m][n], 0, 0, 0);
                    acc[m][n] = __builtin_amdgcn_mfma_f32_16x16x32_bf16(xa[m], bh[n], acc[m][n], 0, 0, 0);
                }
            }
        }
#pragma unroll
        for (int m = 0; m < 2; ++m) { ss[m] += __shfl_xor(ss[m], 16); ss[m] += __shfl_xor(ss[m], 32); }
#pragma unroll
        for (int m = 0; m < 2; ++m)
#pragma unroll
            for (int n = 0; n < 3; ++n)
#pragma unroll
                for (int i = 0; i < 4; ++i) tile[(16 * m + 4 * kq + i) * 49 + n * 16 + li] = acc[m][n][i];
        __builtin_amdgcn_s_waitcnt(0xc07f);
        const float ssr = (lane & 16) ? ss[1] : ss[0];
        const float rs = rsqrtf(ssr * (1.0f / 1024.0f) + EPS);
        if (lane < 32) {
            const float* cst = cst_all + mr * 48;
            const LAS float* tr = tile + lane * 49;
            float lg[4];
#pragma unroll
            for (int c = 0; c < 4; ++c) lg[c] = tr[32 + c] * rs + cst[32 + c];
            int gi = 0; float gm = lg[0];
#pragma unroll
            for (int c = 1; c < 4; ++c) if (lg[c] > gm) { gm = lg[c]; gi = c; }
            float gden = 0.f;
#pragma unroll
            for (int c = 0; c < 4; ++c) gden += __expf(lg[c] - gm);
            const float gw = 1.0f / gden;
            float le[8];
#pragma unroll
            for (int c = 0; c < 8; ++c) le[c] = tr[gi * 8 + c] * rs + cst[gi * 8 + c];
            int e0 = 0; float m0 = le[0];
#pragma unroll
            for (int c = 1; c < 8; ++c) if (le[c] > m0) { m0 = le[c]; e0 = c; }
            int e1 = -1; float m1 = -INFINITY;
#pragma unroll
            for (int c = 0; c < 8; ++c) if (c != e0 && le[c] > m1) { m1 = le[c]; e1 = c; }
            const float q1 = __expf(m1 - m0), inv = 1.0f / (1.0f + q1);
            const int r = r0 + lane, ex0 = gi * 8 + e0, ex1 = gi * 8 + e1;
            const unsigned s0 = atomicAdd(cnt + ex0, 1u), s1 = atomicAdd(cnt + ex1, 1u);
            list[(size_t)ex0 * MROWS + s0] = 2u * r; list[(size_t)ex1 * MROWS + s1] = 2u * r + 1u;
            gates[2 * r] = gw * inv; gates[2 * r + 1] = gw * q1 * inv;
        }
        {
            const float* ng = p.in[6] + ((size_t)layer * 2 + 1) * 1024;
            const float* md = (const float*)(p.ws + WS_MOD) + ((size_t)layer * 9 + mr) * 6144 + 3072;
            f32x4 gm[4], sh[4];
#pragma unroll
            for (int j = 0; j < 4; ++j) {
                const f32x4 g = *(const f32x4*)(ng + lane * 4 + 256 * j), sc = *(const f32x4*)(md + 1024 + lane * 4 + 256 * j);
                sh[j] = *(const f32x4*)(md + lane * 4 + 256 * j);
                gm[j] = (f32x4){g.x * (1.0f + sc.x), g.y * (1.0f + sc.y), g.z * (1.0f + sc.z), g.w * (1.0f + sc.w)};
            }
            unsigned char* H8 = p.ws + WS_H;
#pragma unroll 4
            for (int i = 0; i < 32; ++i) {
                const float rsi = __shfl(rs, i);
                const bf16_t* xb = xb_row(p, r0 + i);
#pragma unroll
                for (int j = 0; j < 4; ++j) {
                    const u32x2 v = *(const u32x2*)(xb + lane * 4 + 256 * j);
                    *(unsigned*)(H8 + (size_t)(r0 + i) * 1024 + lane * 4 + 256 * j) =
                        cvt_fp8x4(bflo(v.x) * rsi * gm[j].x + sh[j].x, bfhi(v.x) * rsi * gm[j].y + sh[j].y, bflo(v.y) * rsi * gm[j].z + sh[j].z, bfhi(v.y) * rsi * gm[j].w + sh[j].w);
                }
            }
        }
    }
}

#define MFMA32(a, b, c) __builtin_amdgcn_mfma_f32_32x32x16_bf16((a), (b), (c), 0, 0, 0)
typedef LAS unsigned char* lds_ptr;
constexpr int GEMM_TM = 256, GEMM_TN = 256;
constexpr int GEMM_STAGE = 65536;
constexpr int GEMM_LDS = 2 * GEMM_STAGE;
constexpr int GEMM_MT = 4;

struct RowDense { static constexpr bool DENSE = true; const bf16_t* A; int lda; int m0; DI unsigned row(int i) const { return (unsigned)(m0 + i) * (unsigned)lda; } };
struct RowGather { static constexpr bool DENSE = false; const bf16_t* A; int lda; const unsigned* ent; int valid; int shift;
    DI unsigned row(int i) const { const unsigned e = ent[i < valid ? i : valid - 1]; return (e >> shift) * (unsigned)lda; } };

struct EpiStore { bf16_t* C; int ldc; int m0;
    DI void wave_tile(const f32x16 (&acc)[2][GEMM_MT], int mloc, int ncol, int lane) const {
        const int r = lane & 31, h = lane >> 5;
#pragma unroll
        for (int mt = 0; mt < GEMM_MT; ++mt) {
            bf16_t* c = C + (size_t)(m0 + mloc + mt * 32 + r) * ldc + ncol + 4 * h;
#pragma unroll
            for (int nt = 0; nt < 2; ++nt)
#pragma unroll
                for (int g = 0; g < 4; ++g) {
                    u32x2 w; w.x = pk2(acc[nt][mt][4 * g], acc[nt][mt][4 * g + 1]); w.y = pk2(acc[nt][mt][4 * g + 2], acc[nt][mt][4 * g + 3]);
                    *(u32x2*)(c + nt * 32 + 8 * g) = w;
                }
        }
    } };
struct EpiResid { const Params* p; const float* mod; int m0;
    DI void wave_tile(const f32x16 (&acc)[2][GEMM_MT], int mloc, int ncol, int lane) const {
        const int r = lane & 31, h = lane >> 5;
#pragma unroll
        for (int mt = 0; mt < GEMM_MT; ++mt) {
            const int row = m0 + mloc + mt * 32 + r;
            float* xr = xrow_ptr(*p, row) + ncol + 4 * h;
            const float* gp = mod + (size_t)mod_row(row) * 6144 + 2048 + ncol + 4 * h;
#pragma unroll
            for (int nt = 0; nt < 2; ++nt)
#pragma unroll
                for (int g = 0; g < 4; ++g) {
                    f32x4 x = *(f32x4*)(xr + nt * 32 + 8 * g);
                    const f32x4 gg = *(const f32x4*)(gp + nt * 32 + 8 * g);
                    x.x += gg.x * acc[nt][mt][4 * g]; x.y += gg.y * acc[nt][mt][4 * g + 1]; x.z += gg.z * acc[nt][mt][4 * g + 2]; x.w += gg.w * acc[nt][mt][4 * g + 3];
                    *(f32x4*)(xr + nt * 32 + 8 * g) = x;
                }
        }
    } };
struct EpiGlu { bf16_t* act; const unsigned* ent; const float* gates; int valid;
    DI void wave_tile(const f32x16 (&acc)[2][GEMM_MT], int mloc, int ncol, int lane) const {
        const int r = lane & 31, h = lane >> 5;
#pragma unroll
        for (int mt = 0; mt < GEMM_MT; ++mt) {
            const int i = mloc + mt * 32 + r;
            if (i < valid) {
                const unsigned a = ent[i];
                const float gw = gates[a];
                bf16_t* o = act + (size_t)a * DEXP + (ncol >> 6) * 32 + 4 * h;
#pragma unroll
                for (int g = 0; g < 4; ++g) {
                    float v[4];
#pragma unroll
                    for (int j = 0; j < 4; ++j) v[j] = silu_f(acc[0][mt][4 * g + j]) * acc[1][mt][4 * g + j] * gw;
                    u32x2 w; w.x = pk2(v[0], v[1]); w.y = pk2(v[2], v[3]);
                    *(u32x2*)(o + 8 * g) = w;
                }
            }
        }
    } };
struct EpiScatter { bf16_t* outp; const unsigned* ent; int valid;
    DI void wave_tile(const f32x16 (&acc)[2][GEMM_MT], int mloc, int ncol, int lane) const {
        const int r = lane & 31, h = lane >> 5;
#pragma unroll
        for (int mt = 0; mt < GEMM_MT; ++mt) {
            const int i = mloc + mt * 32 + r;
            if (i < valid) {
                bf16_t* c = outp + (size_t)ent[i] * 1024 + ncol + 4 * h;
#pragma unroll
                for (int nt = 0; nt < 2; ++nt)
#pragma unroll
                    for (int g = 0; g < 4; ++g) {
                        u32x2 w; w.x = pk2(acc[nt][mt][4 * g], acc[nt][mt][4 * g + 1]); w.y = pk2(acc[nt][mt][4 * g + 2], acc[nt][mt][4 * g + 3]);
                        *(u32x2*)(c + nt * 32 + 8 * g) = w;
                    }
            }
        }
    } };

#define SCHED_FENCE() __builtin_amdgcn_sched_barrier(0)
DI void glds16(const bf16_t* g, lds_ptr l) { __builtin_amdgcn_global_load_lds((const unsigned*)g, (LAS unsigned*)l, 16, 0, 0); }
template <int PROBE, int NAG>
DI void gemm_kstep(f32x16 (&acc)[2][GEMM_MT], const lds_ptr st, const unsigned (&arow)[GEMM_MT], const unsigned (&wrow)[2], const unsigned (&aswz)[GEMM_MT], const unsigned (&wswz)[2], int h,
                   bool issue, const bf16_t* __restrict__ An, const bf16_t* __restrict__ Wn, const unsigned (&ag)[NAG], unsigned astep, const unsigned (&bg)[2], unsigned bstep, const lds_ptr sn) {
    if (PROBE != 2 && issue) {
#pragma unroll
        for (int j = 0; j < 8; ++j) { glds16(An + (NAG == 2 ? ag[j & 1] + (j >> 1) * astep : ag[j % NAG]), sn + j * 1024); glds16(Wn + bg[j & 1] + (j >> 1) * bstep, sn + 32768 + j * 1024); }
    }
    if (PROBE == 1) return;
    bf16x8 af[2][GEMM_MT], wf[2][2];
#pragma unroll
    for (int t = 0; t < 2; ++t) wf[0][t] = *(const LAS bf16x8*)(st + wrow[t] + ((((unsigned)h) ^ wswz[t]) << 4));
#pragma unroll
    for (int t = 0; t < GEMM_MT; ++t) af[0][t] = *(const LAS bf16x8*)(st + arow[t] + ((((unsigned)h) ^ aswz[t]) << 4));
#pragma unroll
    for (int kk = 0; kk < 4; ++kk) {
        if (kk < 3) {
#pragma unroll
            for (int t = 0; t < 2; ++t) wf[(kk + 1) & 1][t] = *(const LAS bf16x8*)(st + wrow[t] + ((((unsigned)((kk + 1) * 2 + h)) ^ wswz[t]) << 4));
#pragma unroll
            for (int t = 0; t < GEMM_MT; ++t) af[(kk + 1) & 1][t] = *(const LAS bf16x8*)(st + arow[t] + ((((unsigned)((kk + 1) * 2 + h)) ^ aswz[t]) << 4));
        }
        SCHED_FENCE();
        __builtin_amdgcn_s_setprio(1);
#pragma unroll
        for (int mt = 0; mt < GEMM_MT; ++mt)
#pragma unroll
            for (int nt = 0; nt < 2; ++nt) acc[nt][mt] = MFMA32(wf[kk & 1][nt], af[kk & 1][mt], acc[nt][mt]);
        __builtin_amdgcn_s_setprio(0);
        SCHED_FENCE();
    }
}
template <class RowSrc, class Epi, int PROBE = 0>
DI void gemm_tile_mfma(unsigned char* smem, const RowSrc& rs, const bf16_t* __restrict__ Wt, int K, int n0, const Epi& epi, int tid) {
    const lds_ptr lds = (lds_ptr)smem;
    const int lane = tid & 63, wid = __builtin_amdgcn_readfirstlane(tid >> 6), wm = wid & 1, wn = wid >> 1, r = lane & 31, h = lane >> 5;
    const bool loader = wid < 4;
    const int lw = wid & 3;
    constexpr int NAG = RowSrc::DENSE ? 2 : 8;
    unsigned ag[NAG], bg[2];
    const bf16_t* __restrict__ Ab = rs.A;
#pragma unroll
    for (int j = 0; j < NAG; ++j) {
        const int row = (lw * 8 + j) * 8 + (lane >> 3), c = (lane & 7) ^ ((row >> 1) & 7);
        ag[j] = rs.row(row) + c * 8;
    }
#pragma unroll
    for (int j = 0; j < 2; ++j) {
        const int row = (lw * 8 + j) * 8 + (lane >> 3), c = (lane & 7) ^ ((row >> 1) & 7);
        bg[j] = (unsigned)(n0 + row) * (unsigned)K + c * 8;
    }
    const unsigned astep = 16u * (unsigned)rs.lda, bstep = 16u * (unsigned)K;
    const unsigned dmaoff = (unsigned)lw * 8192u;
    unsigned arow[GEMM_MT], wrow[2], aswz[GEMM_MT], wswz[2];
#pragma unroll
    for (int t = 0; t < GEMM_MT; ++t) { const int ra = wm * 128 + t * 32 + r; arow[t] = ra * 128; aswz[t] = (ra >> 1) & 7; }
#pragma unroll
    for (int t = 0; t < 2; ++t) { const int rw = wn * 64 + t * 32 + r; wrow[t] = 32768 + rw * 128; wswz[t] = (rw >> 1) & 7; }
    f32x16 acc[2][GEMM_MT];
#pragma unroll
    for (int a = 0; a < 2; ++a)
#pragma unroll
        for (int b = 0; b < GEMM_MT; ++b)
#pragma unroll
            for (int i = 0; i < 16; ++i) acc[a][b][i] = 0.f;
    if (loader) {
#pragma unroll
        for (int j = 0; j < 8; ++j) { glds16(Ab + (NAG == 2 ? ag[j & 1] + (j >> 1) * astep : ag[j % NAG]), lds + dmaoff + j * 1024); glds16(Wt + bg[j & 1] + (j >> 1) * bstep, lds + 32768 + dmaoff + j * 1024); }
    }
    asm volatile("s_waitcnt vmcnt(0)" ::: "memory");
    __syncthreads();
    const int KT = K >> 6;
    for (int kt = 0; kt < KT; ++kt) {
        gemm_kstep<PROBE, NAG>(acc, lds + (kt & 1) * GEMM_STAGE, arow, wrow, aswz, wswz, h, loader && kt + 1 < KT, Ab + (kt + 1) * 64, Wt + (kt + 1) * 64, ag, astep, bg, bstep, lds + ((kt + 1) & 1) * GEMM_STAGE + dmaoff);
        asm volatile("s_waitcnt vmcnt(0)" ::: "memory");
        __syncthreads();
    }
    if (PROBE == 0 || acc[0][0][0] == 12345.678f) epi.wave_tile(acc, wm * 128, n0 + wn * 64, lane);
}

template <int EPIK, int PROBE = 0>
DI void gemm_dense(const Params& p, unsigned char* smem, const bf16_t* A, int lda, const bf16_t* Wt, int K, int N, bf16_t* C, int ldc, const float* mod, int bid, int nb, int tid) {
    const int tn = N / GEMM_TN, total = (MROWS / GEMM_TM) * tn;
    for (int t = bid; t < total; t += nb) {
        const int mt = t / tn, nt = t - mt * tn;
        RowDense rs{A, lda, mt * GEMM_TM};
        if (EPIK == 0) { EpiStore e{C, ldc, mt * GEMM_TM}; gemm_tile_mfma<RowDense, EpiStore, PROBE>(smem, rs, Wt, K, nt * GEMM_TN, e, tid); }
        else { EpiResid e{&p, mod, mt * GEMM_TM}; gemm_tile_mfma(smem, rs, Wt, K, nt * GEMM_TN, e, tid); }
    }
}
template <int WHICH>
DI void gemm_moe(const Params& p, unsigned char* smem, int layer, int bid, int nb, int tid) {
    const unsigned* cnt = (const unsigned*)(p.ws + WS_CTL) + CW_CNT + layer * 32;
    const unsigned* list = (const unsigned*)(p.ws + WS_LIST);
    const float* gates = (const float*)(p.ws + WS_GATE);
    const bf16_t* H = (const bf16_t*)(p.ws + WS_H);
    bf16_t* act = (bf16_t*)(p.ws + WS_Q);
    bf16_t* eo = (bf16_t*)(p.ws + WS_RAW);
    constexpr int TN = WHICH == 0 ? 2 : 4;
    int total = 0;
    for (int e = 0; e < NEXP; ++e) total += (int)((cnt[e] + 255u) >> 8) * TN;
    for (int t = bid; t < total; t += nb) {
        int e = 0, rem = t;
        for (; e < NEXP; ++e) { const int te = (int)((cnt[e] + 255u) >> 8) * TN; if (rem < te) break; rem -= te; }
        const int rt = rem / TN, ct = rem - rt * TN;
        const unsigned* ent = list + (size_t)e * MROWS + rt * GEMM_TM;
        const int valid = min(GEMM_TM, (int)cnt[e] - rt * GEMM_TM);
        if (WHICH == 0) {
            RowGather rs{H, 1024, ent, valid, 1};
            EpiGlu ep{act, ent, gates, valid};
            gemm_tile_mfma(smem, rs, (const bf16_t*)(p.ws + W_GU) + ((size_t)layer * 32 + e) * 512 * 1024, 1024, ct * GEMM_TN, ep, tid);
        } else {
            RowGather rs{act, DEXP, ent, valid, 0};
            EpiScatter ep{eo, ent, valid};
            gemm_tile_mfma(smem, rs, (const bf16_t*)(p.ws + W_DN) + ((size_t)layer * 32 + e) * 1024 * 256, 256, ct * GEMM_TN, ep, tid);
        }
    }
}

DI float quad_sum(float v) { v += __shfl_xor(v, 1); v += __shfl_xor(v, 2); return v; }
DI void head64_norm_rope(const bf16_t* src, bf16_t* dst, const float* gain, int sub, bool rope, int prow, int pcol, float scale) {
    float a[8], b[8];
    unpack8(*(const u32x4*)(src + sub * 8), a); unpack8(*(const u32x4*)(src + 32 + sub * 8), b);
    float ss = 0.f;
#pragma unroll
    for (int e = 0; e < 8; ++e) ss += a[e] * a[e] + b[e] * b[e];
    ss = quad_sum(ss);
    const float rs = rsqrtf(ss * (1.0f / 64.0f) + EPS);
#pragma unroll
    for (int e = 0; e < 8; ++e) { a[e] *= rs * gain[sub * 8 + e]; b[e] *= rs * gain[32 + sub * 8 + e]; }
    if (rope) {
#pragma unroll
        for (int e = 0; e < 8; ++e) {
            const int i = sub * 8 + e;
            const float* cs = ROPE64 + ((i < 16 ? prow : pcol) * 16 + (i & 15)) * 2;
            const float c = cs[0], s = cs[1], x1 = a[e], x2 = b[e];
            a[e] = x1 * c - x2 * s; b[e] = x2 * c + x1 * s;
        }
    }
#pragma unroll
    for (int e = 0; e < 8; ++e) { a[e] *= scale; b[e] *= scale; }
    *(u32x4*)(dst + sub * 8) = pack8(a); *(u32x4*)(dst + 32 + sub * 8) = pack8(b);
}
template <int KIND>
DI void phase_post_qk(const Params& p, int bid, int nb, int tid) {
    const int wid = __builtin_amdgcn_readfirstlane(tid >> 6), lane = tid & 63, hd = lane >> 2, sub = lane & 3;
    constexpr int NRAW = KIND == 1 ? 1536 : 3072, KH = KIND == 1 ? 4 : 16;
    const bf16_t* raw = (const bf16_t*)(p.ws + WS_RAW);
    bf16_t* Q = (bf16_t*)(p.ws + WS_Q); bf16_t* Kb = (bf16_t*)(p.ws + WS_K);
    const float* qn = p.in[KIND == 0 ? 15 : KIND == 1 ? 20 : 32];
    const float* kn = p.in[KIND == 0 ? 16 : KIND == 1 ? 21 : 33];
    const float qscale = 0.125f * LOG2E;
    for (int r = bid * NW + wid; r < MROWS; r += nb * NW) {
        const int b = r / PP, pos = r - b * PP;
        const bool rope = (KIND != 0) && pos < SEQ;
        const int prow = (pos >> 6) & 63, pcol = pos & 63;
        const bf16_t* rr = raw + (size_t)r * NRAW;
        head64_norm_rope(rr + hd * 64, Q + (size_t)r * 1024 + hd * 64, qn, sub, rope, prow, pcol, qscale);
        if (hd < KH) head64_norm_rope(rr + 1024 + hd * 64, Kb + (size_t)r * (KH * 64) + hd * 64, kn, sub, rope, prow, pcol, 1.0f);
    }
}
DI void phase_post_mla1(const Params& p, int bid, int nb, int tid) {
    const int wid = __builtin_amdgcn_readfirstlane(tid >> 6), lane = tid & 63;
    const bf16_t* raw = (const bf16_t*)(p.ws + WS_Q);
    bf16_t* cqn = (bf16_t*)(p.ws + WS_O);
    bf16_t* ckvn = cqn + (size_t)MROWS * 384;
    bf16_t* krope = ckvn + (size_t)MROWS * 256;
    const float* qa = p.in[24]; const float* kva = p.in[25]; const float* kn = p.in[29];
    for (int r = bid * NW + wid; r < MROWS; r += nb * NW) {
        const int b = r / PP, pos = r - b * PP;
        const bf16_t* rr = raw + (size_t)r * 768;
        {
            float v[6];
#pragma unroll
            for (int j = 0; j < 3; ++j) { const unsigned w = *(const unsigned*)(rr + lane * 6 + 2 * j); v[2 * j] = bflo(w); v[2 * j + 1] = bfhi(w); }
            float ss = 0.f;
#pragma unroll
            for (int j = 0; j < 6; ++j) ss += v[j] * v[j];
            ss = wave_sum(ss);
            const float rs = rsqrtf(ss * (1.0f / 384.0f) + EPS);
#pragma unroll
            for (int j = 0; j < 3; ++j) *(unsigned*)(cqn + (size_t)r * 384 + lane * 6 + 2 * j) = pk2(v[2 * j] * rs * qa[lane * 6 + 2 * j], v[2 * j + 1] * rs * qa[lane * 6 + 2 * j + 1]);
        }
        {
            const u32x2 w = *(const u32x2*)(rr + 384 + lane * 4);
            float v[4] = {bflo(w.x), bfhi(w.x), bflo(w.y), bfhi(w.y)};
            float ss = v[0] * v[0] + v[1] * v[1] + v[2] * v[2] + v[3] * v[3];
            ss = wave_sum(ss);
            const float rs = rsqrtf(ss * (1.0f / 256.0f) + EPS);
            u32x2 o; o.x = pk2(v[0] * rs * kva[lane * 4], v[1] * rs * kva[lane * 4 + 1]); o.y = pk2(v[2] * rs * kva[lane * 4 + 2], v[3] * rs * kva[lane * 4 + 3]);
            *(u32x2*)(ckvn + (size_t)r * 256 + lane * 4) = o;
        }
        {
            float x1 = 0.f, x2 = 0.f;
            if (lane < 16) { x1 = bf2f(rr[640 + lane]); x2 = bf2f(rr[640 + 16 + lane]); }
            float ss = wave_sum(x1 * x1 + x2 * x2);
            const float rs = rsqrtf(ss * (1.0f / 32.0f) + EPS);
            if (lane < 16) {
                x1 *= rs * kn[64 + lane]; x2 *= rs * kn[64 + 16 + lane];
                if (pos < SEQ) {
                    const int prow = (pos >> 6) & 63, pcol = pos & 63;
                    const float* cs = ROPE32 + ((lane < 8 ? prow : pcol) * 8 + (lane & 7)) * 2;
                    const float c = cs[0], s = cs[1], a = x1, bb = x2;
                    x1 = a * c - bb * s; x2 = bb * c + a * s;
                }
                bf16_t* kr = (bf16_t*)(p.ws + WS_K) + (size_t)r * 1536 + 64;
                const bf16_t b1 = (bf16_t)f2bf(x1), b2 = (bf16_t)f2bf(x2);
#pragma unroll
                for (int hh = 0; hh < 16; ++hh) { kr[hh * 96 + lane] = b1; kr[hh * 96 + 16 + lane] = b2; }
            }
        }
    }
}
DI void phase_post_mla2(const Params& p, int bid, int nb, int tid) {
    const int wid = __builtin_amdgcn_readfirstlane(tid >> 6), lane = tid & 63, hd = lane >> 2, sub = lane & 3;
    const bf16_t* qraw = (const bf16_t*)(p.ws + WS_RAW);
    const bf16_t* kvraw = qraw + (size_t)MROWS * 1536;
    const bf16_t* krope = (const bf16_t*)(p.ws + WS_O) + (size_t)MROWS * 640;
    bf16_t* Q = (bf16_t*)(p.ws + WS_Q); bf16_t* Kb = (bf16_t*)(p.ws + WS_K);
    const float* qn = p.in[28]; const float* kn = p.in[29];
    const float qscale = 0.10206207261596577f * LOG2E;
    for (int r = bid * NW + wid; r < MROWS; r += nb * NW) {
        const int b = r / PP, pos = r - b * PP;
        const bf16_t* qr = qraw + (size_t)r * 1536 + hd * 96;
        bf16_t* qo = Q + (size_t)r * 1536 + hd * 96;
        {
            float a[8], c[8];
            unpack8(*(const u32x4*)(qr + sub * 16), a); unpack8(*(const u32x4*)(qr + sub * 16 + 8), c);
            float ss = 0.f;
#pragma unroll
            for (int e = 0; e < 8; ++e) ss += a[e] * a[e] + c[e] * c[e];
            ss = quad_sum(ss);
            const float rs = rsqrtf(ss * (1.0f / 64.0f) + EPS) * qscale;
#pragma unroll
            for (int e = 0; e < 8; ++e) { a[e] *= rs * qn[sub * 16 + e]; c[e] *= rs * qn[sub * 16 + 8 + e]; }
            *(u32x4*)(qo + sub * 16) = pack8(a); *(u32x4*)(qo + sub * 16 + 8) = pack8(c);
        }
        {
            const u32x2 w1 = *(const u32x2*)(qr + 64 + sub * 4), w2 = *(const u32x2*)(qr + 64 + 16 + sub * 4);
            float x1[4] = {bflo(w1.x), bfhi(w1.x), bflo(w1.y), bfhi(w1.y)}, x2[4] = {bflo(w2.x), bfhi(w2.x), bflo(w2.y), bfhi(w2.y)};
            float ss = 0.f;
#pragma unroll
            for (int e = 0; e < 4; ++e) ss += x1[e] * x1[e] + x2[e] * x2[e];
            ss = quad_sum(ss);
            const float rs = rsqrtf(ss * (1.0f / 32.0f) + EPS);
#pragma unroll
            for (int e = 0; e < 4; ++e) {
                const int i = sub * 4 + e;
                float a = x1[e] * rs * qn[64 + i], bb = x2[e] * rs * qn[64 + 16 + i];
                if (pos < SEQ) {
                    const int prow = (pos >> 6) & 63, pcol = pos & 63;
                    const float* cs = ROPE32 + ((i < 8 ? prow : pcol) * 8 + (i & 7)) * 2;
                    const float c = cs[0], s = cs[1], t1 = a, t2 = bb;
                    a = t1 * c - t2 * s; bb = t2 * c + t1 * s;
                }
                x1[e] = a * qscale; x2[e] = bb * qscale;
            }
            u32x2 o1, o2; o1.x = pk2(x1[0], x1[1]); o1.y = pk2(x1[2], x1[3]); o2.x = pk2(x2[0], x2[1]); o2.y = pk2(x2[2], x2[3]);
            *(u32x2*)(qo + 64 + sub * 4) = o1; *(u32x2*)(qo + 64 + 16 + sub * 4) = o2;
        }
        {
            const bf16_t* kr = kvraw + (size_t)r * 2048 + hd * 128;
            bf16_t* ko = Kb + (size_t)r * 1536 + hd * 96;
            float a[8], c[8];
            unpack8(*(const u32x4*)(kr + sub * 16), a); unpack8(*(const u32x4*)(kr + sub * 16 + 8), c);
            float ss = 0.f;
#pragma unroll
            for (int e = 0; e < 8; ++e) ss += a[e] * a[e] + c[e] * c[e];
            ss = quad_sum(ss);
            const float rs = rsqrtf(ss * (1.0f / 64.0f) + EPS);
#pragma unroll
            for (int e = 0; e < 8; ++e) { a[e] *= rs * kn[sub * 16 + e]; c[e] *= rs * kn[sub * 16 + 8 + e]; }
            *(u32x4*)(ko + sub * 16) = pack8(a); *(u32x4*)(ko + sub * 16 + 8) = pack8(c);
            *(u32x4*)(ko + 64 + sub * 8) = *(const u32x4*)(krope + (size_t)r * 32 + sub * 8);
        }
    }
}
DI void phase_diff_combine(const Params& p, int bid, int nb, int tid) {
    const int wid = __builtin_amdgcn_readfirstlane(tid >> 6), lane = tid & 63, hd = lane >> 3, sub = lane & 7;
    const bf16_t* O12 = (const bf16_t*)(p.ws + WS_H);
    bf16_t* Oc = (bf16_t*)(p.ws + WS_Q);
    const float* lam = p.in[34]; const float* subln = p.in[35];
    const float lambda_init = 0.8f - 0.6f * 0.40656965974059917f;
    const float s1 = wave_sum(lam[lane] * lam[64 + lane]), s2 = wave_sum(lam[128 + lane] * lam[192 + lane]);
    const float lam_full = expf(s1) - expf(s2) + lambda_init;
    for (int r = bid * NW + wid; r < MROWS; r += nb * NW) {
        const bf16_t* o1 = O12 + (size_t)r * 2048 + (2 * hd) * 128 + sub * 16, *o2 = o1 + 128;
        float a[16], c[16];
        unpack8(*(const u32x4*)o1, *(float(*)[8])a); unpack8(*(const u32x4*)(o1 + 8), *(float(*)[8])(a + 8));
        unpack8(*(const u32x4*)o2, *(float(*)[8])c); unpack8(*(const u32x4*)(o2 + 8), *(float(*)[8])(c + 8));
        float ss = 0.f;
#pragma unroll
        for (int e = 0; e < 16; ++e) { a[e] -= lam_full * c[e]; ss += a[e] * a[e]; }
        ss += __shfl_xor(ss, 1); ss += __shfl_xor(ss, 2); ss += __shfl_xor(ss, 4);
        const float rs = rsqrtf(ss * (1.0f / 128.0f) + EPS) * (1.0f - lambda_init);
#pragma unroll
        for (int e = 0; e < 16; ++e) a[e] *= rs * subln[sub * 16 + e];
        bf16_t* o = Oc + (size_t)r * 1024 + hd * 128 + sub * 16;
        *(u32x4*)o = pack8(*(float(*)[8])a); *(u32x4*)(o + 8) = pack8(*(float(*)[8])(a + 8));
    }
}


typedef short s16x4 __attribute__((ext_vector_type(4)));
typedef float f32x2_t __attribute__((ext_vector_type(2)));
typedef __bf16 bf16x2_t __attribute__((ext_vector_type(2)));
DI unsigned cvtpk(float lo, float hi) { f32x2_t v = {lo, hi}; bf16x2_t b = __builtin_convertvector(v, bf16x2_t); return __builtin_bit_cast(unsigned, b); }
DI float xhalf_max(float v) { auto rr = __builtin_amdgcn_permlane32_swap(__float_as_uint(v), __float_as_uint(v), false, false); return fmaxf(__uint_as_float(rr[0]), __uint_as_float(rr[1])); }
DI float xhalf_sum(float v) { auto rr = __builtin_amdgcn_permlane32_swap(__float_as_uint(v), __float_as_uint(v), false, false); return __uint_as_float(rr[0]) + __uint_as_float(rr[1]); }
typedef short v4i16_t __attribute__((__vector_size__(4 * sizeof(short))));
DI s16x4 lds_tr(lds_ptr p) { return __builtin_bit_cast(s16x4, __builtin_amdgcn_ds_read_tr16_b64_v4i16((LAS v4i16_t*)p)); }
constexpr float ATT_BIG = 40.0f, ATT_BIGF = 1.0995116e12f;
DI int crow(int i, int hf) { return (i & 3) + 8 * (i >> 2) + 4 * hf; }

struct AttnP { const bf16_t* Q; int ldq; const bf16_t* K; int ldk; const bf16_t* V; int ldv; bf16_t* O; int ldo; int HQ; int gk; int gv; int vhs  ; const float* bias; const float* sink; int need_ctx; const float* kgain  ; const float* lam; const float* subln; bf16_t* Oc;   };

template <int DQ, int DV, int MODE, int ABL = 0>
DI void attn_mfma(const AttnP& a, unsigned char* smem, int bid, int nb, int tid) {
    constexpr int KSTR = DQ * 2 + 16, KTB = 64 * KSTR, VTB = 64 * DV * 2, NDB = DV / 32, NKK = DQ / 16;
    constexpr int KCH = DQ / 8, VCH = DV / 8, NKI = (64 * KCH + NTHREADS - 1) / NTHREADS, NVI = (64 * VCH + NTHREADS - 1) / NTHREADS;
    static_assert(2 * KTB + 2 * VTB + 2048 <= GEMM_LDS, "attention LDS");
    const lds_ptr lds = (lds_ptr)smem;
    LAS float* biasl = (LAS float*)(lds + 2 * KTB + 2 * VTB);
    const int lane = tid & 63, wid = __builtin_amdgcn_readfirstlane(tid >> 6), r = lane & 31, hf = lane >> 5;
    const int nq = a.need_ctx ? 17 : 16;
    const int xcd = bid & 7, slot = bid >> 3, nslots = nb >> 3, per_xcd = (NBATCH * a.HQ / 8) * nq;
    int koff[NKI], kdst[NKI], voff[NVI], vdst[NVI];
#pragma unroll
    for (int i = 0; i < NKI; ++i) { const int c = min(tid + NTHREADS * i, 64 * KCH - 1), row = c / KCH, kc = c - row * KCH; koff[i] = row * a.ldk + kc * 8; kdst[i] = row * KSTR + kc * 16; }
#pragma unroll
    for (int i = 0; i < NVI; ++i) { const int c = tid + NTHREADS * i, row = c / VCH, vc = c - row * VCH; voff[i] = row * a.ldv + vc * 8; vdst[i] = ((row >> 3) * NDB + (vc >> 2)) * 512 + (row & 7) * 64 + (vc & 3) * 16; }
    const int i16 = lane & 15, trq = i16 >> 2, trp = i16 & 3, grp = (lane >> 4) & 1;
    const int vtr0 = (4 * hf + trq) * 64 + 32 * grp + 8 * trp;
    constexpr bool PAIRED = (MODE == 2 && DV == 128);
    float lam_full = 0.f;
    if (PAIRED) { const float s1 = wave_sum(a.lam[lane] * a.lam[64 + lane]), s2 = wave_sum(a.lam[128 + lane] * a.lam[192 + lane]); lam_full = expf(s1) - expf(s2) + (0.8f - 0.6f * 0.40656965974059917f); }
    int it_i = 0;
    for (int j = slot; j < per_xcd; j += nslots, ++it_i) {
        const int nbh = NBATCH * a.HQ / 8;
        const int bhl = j < nbh * 16 ? j >> 4 : j - nbh * 16;
        int qt = j < nbh * 16 ? j & 15 : 16;
        int bh = bhl * 8 + xcd;
        if (MODE == 1) { const int P = (bhl >> 2) * 8 + xcd; bh = (P >> 2) * a.HQ + (P & 3) * 4 + (bhl & 3); }
        if (PAIRED) { const int pu = slot + nslots * (it_i >> 1); qt = pu & 15; bh = (pu >> 4) * a.HQ + 2 * xcd + (it_i & 1); }
        const int h = bh % a.HQ, b = bh / a.HQ;
        const bool is_ctx = qt >= 16;
        const int q0 = is_ctx ? SEQ : qt * 256;
        int t_lo = 0, n_lat = 0;
        if (!is_ctx) {
            if (MODE == 2) { t_lo = 0; n_lat = 64; }
            else if (MODE == 1) { t_lo = max(0, 4 * qt - 2); n_lat = min(63, 4 * qt + 5) - t_lo + 1; }
            else { const int r0 = 4 * qt; t_lo = min(max(r0 - 4, 0), 56); n_lat = min(max(r0 - 1, 0), 56) + 7 - t_lo + 1; }
        }
        const int ntiles = n_lat + 4;
        const int qw0 = q0 + wid * 32, qpos = qw0 + r;
        const size_t qrow = (size_t)b * PP + qpos;
        bf16x8 qf[NKK];
#pragma unroll
        for (int kk = 0; kk < NKK; ++kk) qf[kk] = *(const bf16x8*)(a.Q + qrow * a.ldq + h * DQ + kk * 16 + hf * 8);
        if (MODE == 0 && !is_ctx) { for (int i = tid; i < 465; i += NTHREADS) biasl[i] = a.bias[h * 465 + i] * LOG2E; }
        const bf16_t* Kg = a.K + (size_t)b * PP * a.ldk + (h >> a.gk) * DQ;
        const bf16_t* Vg = a.V + (size_t)b * PP * a.ldv + (h >> a.gv) * a.vhs;
        f32x16 o[NDB];
#pragma unroll
        for (int d = 0; d < NDB; ++d)
#pragma unroll
            for (int i = 0; i < 16; ++i) o[d][i] = 0.f;
        float mref = 0.f, l = 0.f;
        f32x16 negm;
#pragma unroll
        for (int i = 0; i < 16; ++i) negm[i] = 0.f;
        bool first = true;
        float lbig = 0.f;
        float one = 1.0f; asm volatile("" : "+v"(one));
#define ATT_TILE(IT) ((IT) < n_lat ? t_lo + (IT) : 64 + ((IT) - n_lat))
        auto tile_active = [&](int t) -> bool {
            if (t >= 64) return true;
            if (MODE == 1) return (t * 64 + 63 >= qw0 - 128) && (t * 64 <= qw0 + 31 + 128);
            if (MODE == 0) { const int rw = qw0 >> 6, row0 = min(max(rw - 4, 0), 56); return t >= row0 && t < row0 + 8; }
            return true;
        };
        auto qk = [&](f32x16 (&s)[2], const lds_ptr Kb) {
#pragma unroll
            for (int kk = 0; kk < NKK; ++kk)
#pragma unroll
                for (int kb = 0; kb < 2; ++kb) {
                    if (ABL & 4) { if (kk == 0) s[kb] = negm; }
                    else {
                    const bf16x8 kf = *(const LAS bf16x8*)(Kb + (kb * 32 + r) * KSTR + (kk * 2 + hf) * 16);
                    s[kb] = MFMA32(kf, qf[kk], kk == 0 ? negm : s[kb]);
                    }
                }
        };
        u32x4 kr[NKI], vr[NVI];
        {
            const int t0 = ATT_TILE(0), t1 = ATT_TILE(1);
            u32x4 k1[NKI];
#pragma unroll
            for (int i = 0; i < NKI; ++i) kr[i] = *(const u32x4*)(Kg + (size_t)t0 * 64 * a.ldk + koff[i]);
#pragma unroll
            for (int i = 0; i < NVI; ++i) vr[i] = *(const u32x4*)(Vg + (size_t)t0 * 64 * a.ldv + voff[i]);
#pragma unroll
            for (int i = 0; i < NKI; ++i) k1[i] = *(const u32x4*)(Kg + (size_t)t1 * 64 * a.ldk + koff[i]);
#pragma unroll
            for (int i = 0; i < NKI; ++i) { *(LAS u32x4*)(lds + kdst[i]) = kr[i]; *(LAS u32x4*)(lds + KTB + kdst[i]) = k1[i]; }
#pragma unroll
            for (int i = 0; i < NVI; ++i) *(LAS u32x4*)(lds + 2 * KTB + vdst[i]) = vr[i];
        }
        __syncthreads();
        f32x16 sc[2], sn[2];
        bool act_cur = tile_active(ATT_TILE(0)), act_nxt = false;
        if (act_cur) qk(sc, lds);
        __syncthreads();
        auto step = [&](const int it, const int e, const bool N2, const bool N1) {
            const int t = ATT_TILE(it);
            if (N2 && !(ABL & 8) && (!(ABL & 128) || e)) {
                const int tn = ATT_TILE(it + 2);
#pragma unroll
                for (int i = 0; i < NKI; ++i) kr[i] = *(const u32x4*)(Kg + (size_t)tn * 64 * a.ldk + koff[i]);
            }
            if (N1 && !(ABL & 8) && (!(ABL & 128) || e)) {
                const int tn = ATT_TILE(it + 1);
#pragma unroll
                for (int i = 0; i < NVI; ++i) vr[i] = *(const u32x4*)(Vg + (size_t)tn * 64 * a.ldv + voff[i]);
            }
            SCHED_FENCE();
            act_nxt = N1 && (MODE == 2 || tile_active(ATT_TILE(it + 1)));
            const lds_ptr Vb = lds + 2 * KTB + e * VTB;
            const bool do_cur = MODE == 2 || act_cur;
            if (do_cur) {
                if (t < 64 && MODE == 1 && !((t * 64 + 63 - qw0 <= 128) && (qw0 + 31 - t * 64 <= 128))) {
                    const int dbase = t * 64 + 4 * hf - qpos;
#pragma unroll
                    for (int kb = 0; kb < 2; ++kb)
#pragma unroll
                        for (int i = 0; i < 16; ++i) { const int c = kb * 32 + (i & 3) + 8 * (i >> 2); sc[kb][i] = (dbase > 128 - c || dbase < -128 - c) ? -INFINITY : sc[kb][i]; }
                }
                if (t < 64 && MODE == 0) {
                    const int qc = qpos & 63, rw = qpos >> 6, col0 = min(max(qc - 8, 0), 48);
                    const int brow = (t - rw + 7) * 31 + 15 - qc;
#pragma unroll
                    for (int kb = 0; kb < 2; ++kb)
#pragma unroll
                        for (int i = 0; i < 16; ++i) {
                            const int kc = kb * 32 + crow(i, hf);
                            const bool ok = kc >= col0 && kc < col0 + 16;
                            const float bv = biasl[ok ? brow + kc : 0];
                            sc[kb][i] = ok ? sc[kb][i] + bv : -INFINITY;
                        }
                }
                if (first || __builtin_amdgcn_ballot_w64(lbig > ATT_BIGF) != 0ull) {
                    float delta = lbig > ATT_BIGF ? ATT_BIG : 0.f;
                    if (first) {
                        float mx = sc[0][0];
#pragma unroll
                        for (int i = 1; i < 16; ++i) mx = fmaxf(mx, sc[0][i]);
#pragma unroll
                        for (int i = 0; i < 16; ++i) mx = fmaxf(mx, sc[1][i]);
                        mx = xhalf_max(mx);
                        delta = mx > -INFINITY ? mx : 0.f;
                    }
                    const float alpha = __builtin_amdgcn_exp2f(-delta);
                    l *= alpha; mref += delta;
#pragma unroll
                    for (int d = 0; d < NDB; ++d)
#pragma unroll
                        for (int i = 0; i < 16; ++i) o[d][i] *= alpha;
#pragma unroll
                    for (int kb = 0; kb < 2; ++kb)
#pragma unroll
                        for (int i = 0; i < 16; ++i) sc[kb][i] -= delta;
#pragma unroll
                    for (int i = 0; i < 16; ++i) negm[i] = -mref;
                    first = false;
                }
            }
            if (N1) qk(sn, lds + (e ^ 1) * KTB);
            if (do_cur) {
                float ls0 = 0.f, ls1 = 0.f;
#pragma unroll
                for (int kb = 0; kb < 2; ++kb)
#pragma unroll
                    for (int i = 0; i < 16; i += 2) {
                        const float p0 = (ABL & 1) ? sc[kb][i] : __builtin_amdgcn_exp2f(sc[kb][i]), p1 = (ABL & 1) ? sc[kb][i + 1] : __builtin_amdgcn_exp2f(sc[kb][i + 1]);
                        sc[kb][i] = p0; sc[kb][i + 1] = p1;
                        if (!(ABL & 16)) { ls0 += p0; ls1 = __builtin_fmaf(p1, one, ls1); }
                    }
                lbig = ls0 + ls1;
                l += lbig;
                bf16x8 pf[4];
#pragma unroll
                for (int kb = 0; kb < 2; ++kb)
#pragma unroll
                    for (int sp = 0; sp < 2; ++sp) {
                        u32x4 w;
                        w.x = cvtpk(sc[kb][8 * sp], sc[kb][8 * sp + 1]); w.y = cvtpk(sc[kb][8 * sp + 2], sc[kb][8 * sp + 3]);
                        w.z = cvtpk(sc[kb][8 * sp + 4], sc[kb][8 * sp + 5]); w.w = cvtpk(sc[kb][8 * sp + 6], sc[kb][8 * sp + 7]);
                        pf[kb * 2 + sp] = __builtin_bit_cast(bf16x8, w);
                    }
#pragma unroll
                for (int ks = 0; ks < 4; ++ks)
#pragma unroll
                    for (int d = 0; d < NDB; ++d) {
                        const lds_ptr vp = Vb + ((2 * ks) * NDB + d) * 512 + vtr0;
                        const s16x4 lo = lds_tr(vp), hi = lds_tr(vp + NDB * 512);
                        const bf16x8 vf = __builtin_shufflevector(lo, hi, 0, 1, 2, 3, 4, 5, 6, 7);
                        if (ABL & 2) { if (d == 0 && ks == 0) o[0][0] += __builtin_bit_cast(float, pf[0][0] | pf[1][0] | pf[2][0] | pf[3][0]) + __builtin_bit_cast(float, (int)vf[0]); } else
                        o[d] = MFMA32(vf, pf[ks], o[d]);
                    }
            }
            SCHED_FENCE();
            if (N2 && !(ABL & 8) && (!(ABL & 128) || e)) {
#pragma unroll
                for (int i = 0; i < NKI; ++i) *(LAS u32x4*)(lds + e * KTB + kdst[i]) = kr[i];
            }
            if (N1 && !(ABL & 8) && (!(ABL & 128) || e)) {
#pragma unroll
                for (int i = 0; i < NVI; ++i) *(LAS u32x4*)(lds + 2 * KTB + (e ^ 1) * VTB + vdst[i]) = vr[i];
            }
            if (!(ABL & 64) && (!(ABL & 128) || e)) __syncthreads();
#pragma unroll
            for (int kb = 0; kb < 2; ++kb) sc[kb] = sn[kb];
            act_cur = act_nxt;
        };
        int it = 0;
        for (; it + 3 < ntiles; it += 2) { step(it, 0, true, true); step(it + 1, 1, true, true); }
        if (ntiles - it == 3) { step(it, 0, true, true); step(it + 1, 1, false, true); step(it + 2, 0, false, false); }
        else { step(it, 0, false, true); step(it + 1, 1, false, false); }
#undef ATT_TILE
        l = xhalf_sum(l);
        if (a.sink) {
            l += __builtin_amdgcn_exp2f(a.sink[h] * LOG2E - mref);
        }
        const float inv = 1.0f / l;
        bf16_t* orow = a.O + qrow * a.ldo + h * DV + 4 * hf;
#pragma unroll
        for (int d = 0; d < NDB; ++d)
#pragma unroll
            for (int g = 0; g < 4; ++g) {
                u32x2 w; w.x = cvtpk(o[d][4 * g] * inv, o[d][4 * g + 1] * inv); w.y = cvtpk(o[d][4 * g + 2] * inv, o[d][4 * g + 3] * inv);
                *(u32x2*)(orow + d * 32 + 8 * g) = w;
            }
        if (PAIRED && (it_i & 1)) {
            asm volatile("s_waitcnt vmcnt(0)" ::: "memory");
            const float lambda_init = 0.8f - 0.6f * 0.40656965974059917f;
            const int sub = lane & 7, pair = h >> 1;
#pragma unroll
            for (int i4 = 0; i4 < 4; ++i4) {
                const size_t row = (size_t)b * PP + qw0 + i4 * 8 + (lane >> 3);
                const bf16_t* o1 = a.O + row * a.ldo + (2 * pair) * 128 + sub * 16, *o2 = o1 + 128;
                float av[16], cv[16];
                unpack8(*(const u32x4*)o1, *(float(*)[8])av); unpack8(*(const u32x4*)(o1 + 8), *(float(*)[8])(av + 8));
                unpack8(*(const u32x4*)o2, *(float(*)[8])cv); unpack8(*(const u32x4*)(o2 + 8), *(float(*)[8])(cv + 8));
                float ss = 0.f;
#pragma unroll
                for (int e = 0; e < 16; ++e) { av[e] -= lam_full * cv[e]; ss += av[e] * av[e]; }
                ss += __shfl_xor(ss, 1); ss += __shfl_xor(ss, 2); ss += __shfl_xor(ss, 4);
                const float rs = rsqrtf(ss * (1.0f / 128.0f) + EPS) * (1.0f - lambda_init);
#pragma unroll
                for (int e = 0; e < 16; ++e) av[e] *= rs * a.subln[sub * 16 + e];
                bf16_t* oc = a.Oc + row * 1024 + pair * 128 + sub * 16;
                *(u32x4*)oc = pack8(*(float(*)[8])av); *(u32x4*)(oc + 8) = pack8(*(float(*)[8])(av + 8));
            }
        }
    }
}

DI void attn_na(const AttnP& a, unsigned char* smem, int bid, int nb, int tid) {
    constexpr int DQ = 64, DV = 64, KSTR = DQ * 2 + 16, KTB = 64 * KSTR, VTB = 64 * DV * 2, NDB = 2, NKK = 4;
    const lds_ptr lds = (lds_ptr)smem;
    constexpr int BZ_TAB = 32, BZ_HEAD = 560, BZ_NINF = 16 * BZ_HEAD, BZ_N = BZ_NINF + 64;
    static_assert(4 * KTB + 4 * VTB + (BZ_N + 16) * 4 <= GEMM_LDS, "NA LDS");
    LAS float* biasl = (LAS float*)(lds + 4 * KTB + 4 * VTB);
    for (int i = tid; i < BZ_N; i += NTHREADS) {
        const int hh = i / BZ_HEAD, o = i - hh * BZ_HEAD;
        biasl[i] = i >= BZ_NINF ? -INFINITY : (o >= BZ_TAB && o < BZ_TAB + 465) ? a.bias[hh * 465 + o - BZ_TAB] * LOG2E : 0.f;
    }
    __syncthreads();
    {
        const int wv = __builtin_amdgcn_readfirstlane(tid >> 6), ln = tid & 63;
#pragma unroll
        for (int hh2 = 0; hh2 < 2; ++hh2) {
            const int hh = 2 * wv + hh2;
            float m = 0.f;
            for (int i = ln; i < 465; i += 64) m = fmaxf(m, biasl[hh * BZ_HEAD + BZ_TAB + i]);
#pragma unroll
            for (int d = 32; d >= 1; d >>= 1) m = fmaxf(m, __shfl_xor(m, d));
            if (ln == 0) biasl[BZ_N + hh] = m;
        }
    }
    float kmax = fabsf(a.kgain[tid & 63]);
#pragma unroll
    for (int d = 32; d >= 1; d >>= 1) kmax = fmaxf(kmax, __shfl_xor(kmax, d));
    kmax *= 8.0f * 1.01f;
    const int lane = tid & 63, wid = __builtin_amdgcn_readfirstlane(tid >> 6), r = lane & 31, hf = lane >> 5;
    const int nq = a.need_ctx ? 17 : 16;
    const int xcd = bid & 7, slot = bid >> 3, nslots = nb >> 3, per_xcd = (NBATCH * a.HQ / 8) * nq;
    const int krow_s = tid >> 3, kc_s = tid & 7;
    const int koff = krow_s * a.ldk + kc_s * 8, kdst = krow_s * KSTR + kc_s * 16, voff = krow_s * a.ldv + kc_s * 8;
    const int vdst = ((krow_s >> 3) * NDB + (kc_s >> 2)) * 512 + (krow_s & 7) * 64 + (kc_s & 3) * 16;
    const int i16 = lane & 15, trq = i16 >> 2, trp = i16 & 3, grp = (lane >> 4) & 1;
    const int vtr0 = (4 * hf + trq) * 64 + 32 * grp + 8 * trp;
    const int rp = wid >> 2, cq = wid & 3, k0 = cq == 0 ? 0 : cq == 1 ? 8 : cq == 2 ? 24 : 32;
    float one = 1.0f; asm volatile("" : "+v"(one));
    auto unit_of = [&](int j, int& b, int& h, int& qt, int& t_lo, int& n_lat) {
        const int nbh = NBATCH * a.HQ / 8;
        const int bhl = j < nbh * 16 ? j >> 4 : j - nbh * 16; qt = j < nbh * 16 ? j & 15 : 16;
        const int bh = bhl * 8 + xcd; h = bh % a.HQ; b = bh / a.HQ;
        t_lo = 0; n_lat = 0;
        if (qt < 16) { const int r0 = 4 * qt; t_lo = min(max(r0 - 4, 0), 56); n_lat = min(max(r0 - 1, 0), 56) + 7 - t_lo + 1; n_lat += n_lat & 1; }
    };
#define NA_TILE_OF(IT, TLO, NLAT) ((IT) < (NLAT) ? (TLO) + (IT) : 64 + ((IT) - (NLAT)))
    bf16x8 qf[NKK];
    u32x4 krA[2], vrA[2], krB[2], vrB[2];
    auto load_pair = [&](u32x4 (&kr)[2], u32x4 (&vr)[2], const bf16_t* Kg, const bf16_t* Vg, int t_lo, int n_lat, int pr) {
#pragma unroll
        for (int jj = 0; jj < 2; ++jj) {
            const int tn = NA_TILE_OF(2 * pr + jj, t_lo, n_lat);
            kr[jj] = *(const u32x4*)(Kg + (size_t)tn * 64 * a.ldk + koff); vr[jj] = *(const u32x4*)(Vg + (size_t)tn * 64 * a.ldv + voff);
        }
    };
    auto store_pair = [&](const u32x4 (&kr)[2], const u32x4 (&vr)[2], int e) {
#pragma unroll
        for (int jj = 0; jj < 2; ++jj) { *(LAS u32x4*)(lds + (2 * e + jj) * KTB + kdst) = kr[jj]; *(LAS u32x4*)(lds + 4 * KTB + (2 * e + jj) * VTB + vdst) = vr[jj]; }
    };
    auto qrow_of = [&](int b, int qt) -> size_t { const int qpos = qt >= 16 ? SEQ + wid * 32 + r : (4 * qt + 2 * rp + (r >> 4)) * 64 + 16 * cq + (r & 15); return (size_t)b * PP + qpos; };
    auto load_q = [&](int b, int h, int qt) {
        const size_t qrow = qrow_of(b, qt);
#pragma unroll
        for (int kk = 0; kk < NKK; ++kk) qf[kk] = *(const bf16x8*)(a.Q + qrow * a.ldq + h * DQ + kk * 16 + hf * 8);
    };
    if (slot >= per_xcd) return;
    int b, h, qt, t_lo, n_lat;
    unit_of(slot, b, h, qt, t_lo, n_lat);
    {
        load_q(b, h, qt);
        const bf16_t* Kg = a.K + (size_t)b * PP * a.ldk + h * DQ; const bf16_t* Vg = a.V + (size_t)b * PP * a.ldv + h * a.vhs;
        load_pair(krA, vrA, Kg, Vg, t_lo, n_lat, 0); store_pair(krA, vrA, 0); load_pair(krB, vrB, Kg, Vg, t_lo, n_lat, 1);
    }
    __syncthreads();
    for (int j = slot;;) {
        const int jn = j + nslots; const bool has_next = jn < per_xcd;
        int nb_, nh, nqt, nt_lo, nn_lat;
        unit_of(has_next ? jn : j, nb_, nh, nqt, nt_lo, nn_lat);
        const bf16_t* nKg = a.K + (size_t)nb_ * PP * a.ldk + nh * DQ; const bf16_t* nVg = a.V + (size_t)nb_ * PP * a.ldv + nh * a.vhs;
        const bool is_ctx = qt >= 16;
        const int r0 = 4 * qt;
        const int npair = (n_lat + 4) >> 1;
        const int qrw = r0 + 2 * rp + (r >> 4), qc = 16 * cq + (r & 15);
        const size_t qrow = qrow_of(b, qt);
        const bf16_t* Kg = a.K + (size_t)b * PP * a.ldk + h * DQ;
        const bf16_t* Vg = a.V + (size_t)b * PP * a.ldv + h * a.vhs;
        const int rwA = r0 + 2 * rp, wlo = min(max(rwA - 4, 0), 56), whi = min(max(rwA - 3, 0), 56) + 7;
        const int col0 = min(max(qc - 8, 0), 48), row0q = min(max(qrw - 4, 0), 56);
        const int lanebase = h * BZ_HEAD + BZ_TAB + (7 - qrw) * 31 + 15 - qc + k0 + 4 * hf;
        f32x16 o[NDB];
#pragma unroll
        for (int d = 0; d < NDB; ++d)
#pragma unroll
            for (int i = 0; i < 16; ++i) o[d][i] = 0.f;
        float l = 0.f;
        float qn2 = 0.f;
#pragma unroll
        for (int kk = 0; kk < NKK; ++kk)
#pragma unroll
            for (int jj = 0; jj < 8; ++jj) { const float qv = bf2f((bf16_t)qf[kk][jj]); qn2 = __builtin_fmaf(qv, qv, qn2); }
        qn2 = xhalf_sum(qn2);
        const float mref = __builtin_sqrtf(qn2) * kmax + biasl[BZ_N + h];
        f32x16 negmL;
#pragma unroll
        for (int i = 0; i < 16; ++i) { const int kc = k0 + crow(i, hf); negmL[i] = (kc >= col0 && kc < col0 + 16) ? -mref : -INFINITY; }
#define NA_TILE(IT) NA_TILE_OF(IT, t_lo, n_lat)
        auto ctx_tile = [&](const lds_ptr Kb, const lds_ptr Vb) {
            {
                f32x16 s[2], negm;
#pragma unroll
                for (int i = 0; i < 16; ++i) negm[i] = -mref;
#pragma unroll
                for (int kk = 0; kk < NKK; ++kk)
#pragma unroll
                    for (int kb = 0; kb < 2; ++kb) {
                        const bf16x8 kf = *(const LAS bf16x8*)(Kb + (kb * 32 + r) * KSTR + (kk * 2 + hf) * 16);
                        s[kb] = MFMA32(kf, qf[kk], kk == 0 ? negm : s[kb]);
                    }
                float ls0 = 0.f, ls1 = 0.f;
                bf16x8 pf[4];
#pragma unroll
                for (int kb = 0; kb < 2; ++kb) {
#pragma unroll
                    for (int i = 0; i < 16; i += 2) {
                        const float p0 = __builtin_amdgcn_exp2f(s[kb][i]), p1 = __builtin_amdgcn_exp2f(s[kb][i + 1]);
                        s[kb][i] = p0; s[kb][i + 1] = p1; ls0 += p0; ls1 = __builtin_fmaf(p1, one, ls1);
                    }
#pragma unroll
                    for (int sp = 0; sp < 2; ++sp) {
                        u32x4 w;
                        w.x = cvtpk(s[kb][8 * sp], s[kb][8 * sp + 1]); w.y = cvtpk(s[kb][8 * sp + 2], s[kb][8 * sp + 3]);
                        w.z = cvtpk(s[kb][8 * sp + 4], s[kb][8 * sp + 5]); w.w = cvtpk(s[kb][8 * sp + 6], s[kb][8 * sp + 7]);
                        pf[kb * 2 + sp] = __builtin_bit_cast(bf16x8, w);
                    }
                }
                l += ls0 + ls1;
#pragma unroll
                for (int ks = 0; ks < 4; ++ks)
#pragma unroll
                    for (int d = 0; d < NDB; ++d) {
                        const lds_ptr vp = Vb + ((2 * ks) * NDB + d) * 512 + vtr0;
                        const s16x4 lo = lds_tr(vp), hi = lds_tr(vp + NDB * 512);
                        o[d] = MFMA32(__builtin_shufflevector(lo, hi, 0, 1, 2, 3, 4, 5, 6, 7), pf[ks], o[d]);
                    }
            }
        };
        auto lat_tile = [&](const int t, const lds_ptr Kb, const lds_ptr Vb) {
            bf16x8 pf[2];
#pragma unroll
            for (int sp = 0; sp < 2; ++sp)
#pragma unroll
                for (int jj = 0; jj < 8; ++jj) pf[sp][jj] = 0;
            if (t >= wlo && t <= whi) {
                f32x16 s;
#pragma unroll
                for (int kk = 0; kk < NKK; ++kk) {
                    const bf16x8 kf = *(const LAS bf16x8*)(Kb + (k0 + r) * KSTR + (kk * 2 + hf) * 16);
                    s = MFMA32(kf, qf[kk], kk == 0 ? negmL : s);
                }
                const LAS float* bp = biasl + (((unsigned)(t - row0q) < 8u) ? lanebase + 31 * t : BZ_NINF);
#pragma unroll
                for (int i = 0; i < 16; ++i) s[i] += bp[crow(i, 0)];
                float ls0 = 0.f, ls1 = 0.f;
#pragma unroll
                for (int i = 0; i < 16; i += 2) {
                    const float p0 = __builtin_amdgcn_exp2f(s[i]), p1 = __builtin_amdgcn_exp2f(s[i + 1]);
                    s[i] = p0; s[i + 1] = p1; ls0 += p0; ls1 = __builtin_fmaf(p1, one, ls1);
                }
#pragma unroll
                for (int sp = 0; sp < 2; ++sp) {
                    u32x4 w;
                    w.x = cvtpk(s[8 * sp], s[8 * sp + 1]); w.y = cvtpk(s[8 * sp + 2], s[8 * sp + 3]);
                    w.z = cvtpk(s[8 * sp + 4], s[8 * sp + 5]); w.w = cvtpk(s[8 * sp + 6], s[8 * sp + 7]);
                    pf[sp] = __builtin_bit_cast(bf16x8, w);
                }
                l += ls0 + ls1;
            }
#pragma unroll
            for (int ks = 0; ks < 2; ++ks)
#pragma unroll
                for (int d = 0; d < NDB; ++d) {
                    const lds_ptr vp = Vb + (((k0 >> 3) + 2 * ks) * NDB + d) * 512 + vtr0;
                    const s16x4 lo = lds_tr(vp), hi = lds_tr(vp + NDB * 512);
                    o[d] = MFMA32(__builtin_shufflevector(lo, hi, 0, 1, 2, 3, 4, 5, 6, 7), pf[ks], o[d]);
                }
        };
#define NA_ITER(IP, E, KL, VL, KS, VS, LAT) do { \
            if ((IP) + 2 < npair) load_pair(KL, VL, Kg, Vg, t_lo, n_lat, (IP) + 2); \
            else if (has_next) load_pair(KL, VL, nKg, nVg, nt_lo, nn_lat, (IP) + 2 - npair); \
            SCHED_FENCE(); \
            if (LAT) { lat_tile(t_lo + 2 * (IP), lds + (2 * (E)) * KTB, lds + 4 * KTB + (2 * (E)) * VTB); lat_tile(t_lo + 2 * (IP) + 1, lds + (2 * (E) + 1) * KTB, lds + 4 * KTB + (2 * (E) + 1) * VTB); } \
            else { ctx_tile(lds + (2 * (E)) * KTB, lds + 4 * KTB + (2 * (E)) * VTB); ctx_tile(lds + (2 * (E) + 1) * KTB, lds + 4 * KTB + (2 * (E) + 1) * VTB); } \
            SCHED_FENCE(); \
            if ((IP) + 1 < npair || has_next) store_pair(KS, VS, (E) ^ 1); \
            __syncthreads(); } while (0)
        int ip = 0;
        for (; ip < (n_lat >> 1); ip += 2) { NA_ITER(ip, 0, krA, vrA, krB, vrB, true); NA_ITER(ip + 1, 1, krB, vrB, krA, vrA, true); }
        NA_ITER(ip, 0, krA, vrA, krB, vrB, false); NA_ITER(ip + 1, 1, krB, vrB, krA, vrA, false);
#undef NA_ITER
        if (has_next) load_q(nb_, nh, nqt);
#undef NA_TILE
        l = xhalf_sum(l);
        const float inv = 1.0f / l;
        bf16_t* orow = a.O + qrow * a.ldo + h * DV + 4 * hf;
#pragma unroll
        for (int d = 0; d < NDB; ++d)
#pragma unroll
            for (int g = 0; g < 4; ++g) {
                u32x2 w; w.x = cvtpk(o[d][4 * g] * inv, o[d][4 * g + 1] * inv); w.y = cvtpk(o[d][4 * g + 2] * inv, o[d][4 * g + 3] * inv);
                *(u32x2*)(orow + d * 32 + 8 * g) = w;
            }
        if (!has_next) break;
        j = jn; b = nb_; h = nh; qt = nqt; t_lo = nt_lo; n_lat = nn_lat;
    }
#undef NA_TILE_OF
}

template <class E> struct epi_fp8 { static constexpr bool value = false; };
typedef int v8i_t __attribute__((ext_vector_type(8)));
typedef int v4i_t __attribute__((ext_vector_type(4)));
namespace pg8 {
constexpr int BM = 256, BK = 64, HALF = 128, HTB = HALF * BK * 2  ;
DI int lds_byte(int r, int c) { const int st = (r >> 4) * 2 + (c >> 5), rr = r & 15, cc = c & 31, ob = rr * 64 + cc * 2; return st * 1024 + (ob ^ (((ob >> 9) & 1) << 5)); }
DI void stage_rc(int b, int& R, int& C) { const int st = b / 1024, sb = b % 1024, swz = sb ^ (((sb >> 9) & 1) << 5); R = (st >> 1) * 16 + swz / 64; C = (st & 1) * 32 + (swz % 64) / 2; }
DI int perm32(int rho) { const int n = rho >> 4, i = rho & 15; return 8 * (i >> 2) + 4 * n + (i & 3); }

template <class Epi, class Sched>
DI void gemm_phase(lds_ptr lds, const bf16_t* __restrict__ Aop, const int K, const Sched& S, const Epi& E, const int tid) {
    const int wid = __builtin_amdgcn_readfirstlane(tid >> 6), lane = tid & 63, wr = wid >> 2, wc = wid & 3, fr = lane & 15, fq = lane >> 4;
    const int nt = K / BK;
    int Ra[2], Ca[2]; unsigned voffB[2];
#pragma unroll
    for (int i = 0; i < 2; ++i) { int R, C; stage_rc(tid * 16 + i * 8192, R, C); const int Rb = Epi::PERM ? ((R & ~31) + perm32(R & 31)) : R;
        Ra[i] = R; Ca[i] = C; voffB[i] = (unsigned)(Rb * K + C) * 2u; }
    const size_t kstep = (size_t)(BK * 2);
    const size_t hstep = (size_t)HALF * K * 2;
    const unsigned ldsw = (unsigned)wid * 1024u;
    const int aoff = lds_byte(wr * 64 + fr, fq * 8), boff = lds_byte(wc * 32 + fr, fq * 8);
#define PG8_SA(b, h) (((b) * 2 + (h)) * HTB)
#define PG8_SB(b, h) ((4 + (b) * 2 + (h)) * HTB)
#define PG8_STAGE(bufoff, gbase, voff) do { const char* _gb = (const char*)(gbase); asm volatile("" : "+s"(_gb)); _Pragma("unroll") for (int _i = 0; _i < 2; ++_i) { \
        unsigned _o = (voff)[_i]; asm volatile("" : "+v"(_o)); \
        __builtin_amdgcn_global_load_lds((const unsigned*)(_gb + _o), (LAS unsigned*)(lds + (bufoff) + ldsw + _i * 8192), 16, 0, 0); } } while (0)
#define PG8_LDA(dst, b, h) do { _Pragma("unroll") for (int m = 0; m < 4; ++m) _Pragma("unroll") for (int k = 0; k < 2; ++k) dst[m][k] = *(const LAS bf16x8*)(lds + PG8_SA(b, h) + aoff + m * 2048 + k * 1024); } while (0)
#define PG8_LDB(dst, b, h) do { _Pragma("unroll") for (int n = 0; n < 2; ++n) _Pragma("unroll") for (int k = 0; k < 2; ++k) dst[n][k] = *(const LAS bf16x8*)(lds + PG8_SB(b, h) + boff + n * 2048 + k * 1024); } while (0)
typedef long i64x2_t __attribute__((ext_vector_type(2)));
#define PG8_MMA(ai, bj, At, Bt) do { __builtin_amdgcn_s_setprio(1); _Pragma("unroll") for (int m = 0; m < 4; ++m) _Pragma("unroll") for (int n = 0; n < 2; ++n) _Pragma("unroll") for (int k = 0; k < 2; ++k) { \
        if (epi_fp8<Epi>::value) { const i64x2_t _b = __builtin_bit_cast(i64x2_t, Bt[n][k]), _a = __builtin_bit_cast(i64x2_t, At[m][k]); \
            acc[ai][bj][m][n] = __builtin_amdgcn_mfma_f32_16x16x32_fp8_fp8(_b[0], _a[0], acc[ai][bj][m][n], 0, 0, 0); \
            acc[ai][bj][m][n] = __builtin_amdgcn_mfma_f32_16x16x32_fp8_fp8(_b[1], _a[1], acc[ai][bj][m][n], 0, 0, 0); } \
        else acc[ai][bj][m][n] = __builtin_amdgcn_mfma_f32_16x16x32_bf16(Bt[n][k], At[m][k], acc[ai][bj][m][n], 0, 0, 0); } \
        __builtin_amdgcn_s_setprio(0); } while (0)
#define PG8_WAIT_V(n) asm volatile("s_waitcnt vmcnt(" #n ")" ::: "memory")
#define PG8_WAIT_L(n) asm volatile("s_waitcnt lgkmcnt(" #n ")" ::: "memory")
#define PG8_BAR __builtin_amdgcn_s_barrier()
#define PG8_SCHED __builtin_amdgcn_sched_barrier(0)
    typename Sched::Unit cur, nxt; int ui = 0;
    if (!S.next(0, cur)) return;
    f32x4 acc[2][2][4][2];
#pragma unroll
    for (int a = 0; a < 2; ++a)
#pragma unroll
        for (int b = 0; b < 2; ++b)
#pragma unroll
            for (int m = 0; m < 4; ++m)
#pragma unroll
                for (int n = 0; n < 2; ++n) acc[a][b][m][n] = (f32x4){0.f, 0.f, 0.f, 0.f};
    bf16x8 At[4][2], B0[2][2], B1[2][2];
    constexpr bool GATHER = Sched::GATHER;
    unsigned oc[2][2], on[2][2] = {{0u, 0u}, {0u, 0u}};
    size_t ubc[2] = {0, 0}, ubn[2] = {0, 0};
#pragma unroll
    for (int h = 0; h < 2; ++h) {
        if (!GATHER) ubc[h] = (size_t)S.a_off(cur, h * HALF) * 2u;
#pragma unroll
        for (int i = 0; i < 2; ++i) oc[h][i] = GATHER ? (S.a_off(cur, h * HALF + Ra[i]) + (unsigned)Ca[i]) * 2u : (unsigned)(Ra[i] * S.lda + Ca[i]) * 2u;
    }
    const char* gA = (const char*)Aop;
    const char* cB = (const char*)S.b_base(cur);
    PG8_STAGE(PG8_SB(0, 0), cB, voffB); PG8_STAGE(PG8_SB(0, 1), cB + hstep, voffB); PG8_STAGE(PG8_SA(0, 0), gA + ubc[0], oc[0]); PG8_STAGE(PG8_SA(0, 1), gA + ubc[1], oc[1]);
    if (wr == 1) PG8_BAR;
    PG8_WAIT_V(2); PG8_BAR;
    PG8_STAGE(PG8_SB(1, 0), cB + kstep, voffB); PG8_STAGE(PG8_SA(1, 0), gA + ubc[0] + kstep, oc[0]); PG8_STAGE(PG8_SB(1, 1), cB + hstep + kstep, voffB);
    PG8_WAIT_V(6); PG8_BAR;
    for (;;) {
        const bool has_next = S.next(ui + 1, nxt);
        const char* nB = has_next ? (const char*)S.b_base(nxt) : cB;
#pragma unroll
        for (int h = 0; h < 2; ++h) {
            if (!GATHER) ubn[h] = has_next ? (size_t)S.a_off(nxt, h * HALF) * 2u : ubc[h];
#pragma unroll
            for (int i = 0; i < 2; ++i) if (GATHER) { int R, C; stage_rc(((wid << 6) | lane_now()) * 16 + i * 8192, R, C);
                const unsigned* ip = S.a_ptr(nxt, h * HALF + R); asm volatile("global_load_dword %0, %1, off" : "=v"(on[h][i]) : "v"(ip) : "memory"); }
        }
        const bool full = cur.half < 0;
        for (int t = 0; t < nt; t += 2) {
            const bool last = (t == nt - 2);
            const char* a1 = gA + (size_t)(t + 1) * kstep;
            const char* a2 = last ? gA : gA + (size_t)(t + 2) * kstep; const char* b2 = last ? nB : cB + (size_t)(t + 2) * kstep;
            const char* a3 = a2 + kstep; const char* b3 = b2 + kstep;
            size_t u2[2];
            if (GATHER && last) {
                asm volatile("" : "+v"(on[0][0]), "+v"(on[0][1]), "+v"(on[1][0]), "+v"(on[1][1]));
#pragma unroll
                for (int i = 0; i < 2; ++i) { int R, C; stage_rc(((wid << 6) | lane_now()) * 16 + i * 8192, R, C);
                    oc[0][i] = (S.a_cvt(on[0][i]) + (unsigned)C) * 2u; on[1][i] = (S.a_cvt(on[1][i]) + (unsigned)C) * 2u; }
            }
#pragma unroll
            for (int h = 0; h < 2; ++h) u2[h] = last ? ubn[h] : ubc[h];
            PG8_LDB(B0, 0, 0); PG8_LDB(B1, 0, 1); PG8_SCHED; PG8_LDA(At, 0, 0); PG8_STAGE(PG8_SA(1, 1), a1 + ubc[1], oc[1]);
            if (GATHER && last) { oc[1][0] = on[1][0]; oc[1][1] = on[1][1]; }
            PG8_WAIT_V(8); PG8_WAIT_L(0); PG8_BAR; PG8_MMA(0, 0, At, B0); PG8_MMA(0, 1, At, B1); PG8_BAR; PG8_SCHED;
            PG8_LDA(At, 0, 1); PG8_STAGE(PG8_SB(0, 0), b2, voffB); PG8_STAGE(PG8_SB(0, 1), b2 + hstep, voffB); PG8_STAGE(PG8_SA(0, 0), a2 + u2[0], oc[0]);
            PG8_WAIT_V(8); PG8_WAIT_L(0); PG8_BAR; if (full) { PG8_MMA(1, 0, At, B0); PG8_MMA(1, 1, At, B1); } PG8_BAR; PG8_SCHED;
            PG8_LDB(B0, 1, 0); PG8_LDB(B1, 1, 1); PG8_SCHED; PG8_LDA(At, 1, 0); PG8_STAGE(PG8_SA(0, 1), a2 + u2[1], oc[1]);
            PG8_WAIT_V(8); PG8_WAIT_L(0); PG8_BAR; PG8_MMA(0, 0, At, B0); PG8_MMA(0, 1, At, B1); PG8_BAR; PG8_SCHED;
            PG8_LDA(At, 1, 1); PG8_STAGE(PG8_SB(1, 0), b3, voffB); PG8_STAGE(PG8_SB(1, 1), b3 + hstep, voffB); PG8_STAGE(PG8_SA(1, 0), a3 + u2[0], oc[0]);
            PG8_WAIT_V(8); PG8_WAIT_L(0); PG8_BAR; if (full) { PG8_MMA(1, 0, At, B0); PG8_MMA(1, 1, At, B1); } PG8_BAR; PG8_SCHED;
        }
        if (wr == 0) PG8_BAR;
        { const int ln = lane_now(); E(acc, cur, wr, wc, ln & 15, ln >> 4); }
        if (!has_next) break;
#pragma unroll
        for (int a = 0; a < 2; ++a)
#pragma unroll
            for (int b = 0; b < 2; ++b)
#pragma unroll
                for (int m = 0; m < 4; ++m)
#pragma unroll
                    for (int n = 0; n < 2; ++n) acc[a][b][m][n] = (f32x4){0.f, 0.f, 0.f, 0.f};
        cur = nxt; cB = nB; ++ui;
#pragma unroll
        for (int h = 0; h < 2; ++h) ubc[h] = ubn[h];
        if (wr == 1) PG8_BAR;
    }
    PG8_WAIT_V(0);
    PG8_BAR;
#undef PG8_SA
#undef PG8_SB
#undef PG8_STAGE
#undef PG8_LDA
#undef PG8_LDB
#undef PG8_MMA
#undef PG8_WAIT_V
#undef PG8_WAIT_L
#undef PG8_BAR
#undef PG8_SCHED
}
}

struct DenseSched {
    static constexpr bool GATHER = false;
    struct Unit { int pm, pn, half; };
    int nM, nN, nwg, G, c; const bf16_t* Bt; int K, lda; bool skip_ctx;
    DI void unit_of(int L, Unit& u) const {
        int wgid = L; { const int q = nwg / 8, r = nwg % 8, xcd = wgid % 8, off = wgid / 8; wgid = (xcd < r ? xcd * (q + 1) : r * (q + 1) + (xcd - r) * q) + off; }
        const int nig = 8 * nN, gid = wgid / nig, fm = gid * 8, gsz = (nM - fm) < 8 ? (nM - fm) : 8;
        u.pm = fm + ((wgid % nig) % gsz); u.pn = (wgid % nig) / gsz;
        if (skip_ctx) u.pm += u.pm >> 4;
    }
    DI bool next(int i, Unit& u) const {
        const int rounds = nwg / G, rem = nwg - rounds * G;
        if (i < rounds) { unit_of(i * G + c, u); u.half = -1; return true; }
        if (i > rounds || rem == 0) return false;
        if (2 * rem <= G) { if (c >= 2 * rem) return false; unit_of(rounds * G + (c >> 1), u); u.half = c & 1; return true; }
        if (c >= rem) return false;
        unit_of(rounds * G + c, u); u.half = -1; return true;
    }
    DI unsigned a_off(const Unit& u, int row) const { const int rr = u.half < 0 ? row : u.half * 128 + (row & 127); return (unsigned)(u.pm * 256 + rr) * (unsigned)lda; }
    DI const unsigned* a_ptr(const Unit&, int) const { return nullptr; }
    DI unsigned a_cvt(unsigned raw) const { return raw; }
    DI const bf16_t* b_base(const Unit& u) const { return Bt + (size_t)u.pn * 256 * K; }
};
struct MoeUnit { int e, pn, valid, half; const unsigned* ent; };
template <bool TAIL>
struct MoeSched {
    static constexpr bool GATHER = true;
    typedef MoeUnit Unit;
    const LAS int* tab; const unsigned* list; const unsigned* zero  ; const bf16_t* W; int K, N, TN, lda, shift, G, c, nwg;
    DI bool unit_of(int L, Unit& u) const {
        const int v = tab[1 + (lane_now() & 31)];
        const int e = __builtin_popcount((unsigned)__ballot(v <= L));
        if (e >= NEXP) return false;
        const int rem = L - __builtin_amdgcn_readfirstlane(tab[e]), cn = __builtin_amdgcn_readfirstlane(tab[40 + e]);
        const int rt = rem / TN; u.e = e; u.pn = rem - rt * TN; u.ent = list + (size_t)e * MROWS + rt * 256; u.valid = min(256, cn - rt * 256); return true;
    }
    int lo, n, GX, j;
    DI void place() { GX = G >> 3; j = c >> 3; const int per = ((((nwg + 7) >> 3) + TN - 1) / TN) * TN; lo = (c & 7) * per; n = max(0, min(per, nwg - lo)); }
    DI bool next(int i, Unit& u) const {
        u.ent = zero; u.valid = 1;
        const int rounds = n / GX, rem = n - rounds * GX;
        if (!TAIL) { u.half = -1; if (i >= rounds) return false; return unit_of(lo + i * GX + j, u); }
        if (i > 0 || rem == 0) return false;
        if (2 * rem <= GX) {
            if (j >= 2 * rem) return false;
            if (!unit_of(lo + rounds * GX + (j >> 1), u)) return false;
            u.half = j & 1; u.ent += u.half * 128; u.valid = min(128, u.valid - u.half * 128);
            return u.valid > 0;
        }
        u.half = -1; if (j >= rem) return false;
        return unit_of(lo + rounds * GX + j, u);
    }
    DI unsigned a_off(const Unit& u, int row) const { const int rr = (TAIL && u.half >= 0) ? (row & 127) : row; return (u.ent[rr < u.valid ? rr : u.valid - 1] >> shift) * (unsigned)lda; }
    DI const unsigned* a_ptr(const Unit& u, int row) const { const int rr = (TAIL && u.half >= 0) ? (row & 127) : row; return u.ent + (rr < u.valid ? rr : u.valid - 1); }
    DI unsigned a_cvt(unsigned raw) const { return (raw >> shift) * (unsigned)lda; }
    DI const bf16_t* b_base(const Unit& u) const { return W + ((size_t)u.e * N + (size_t)u.pn * 256) * K; }
};
typedef float f32x4_t __attribute__((ext_vector_type(4)));
struct XEpiStore {
    static constexpr bool PERM = true;
    bf16_t* C; int ldc;
    DI void operator()(const f32x4 (&acc)[2][2][4][2], const DenseSched::Unit& u, int wr, int wc, int fr, int fq) const {
        const int row0 = u.pm * 256 + (u.half > 0 ? 128 : 0) + wr * 64 + fr, col0 = u.pn * 256 + wc * 32 + 8 * fq;
#pragma unroll
        for (int ai = 0; ai < 2; ++ai) if (ai == 0 || u.half < 0)
#pragma unroll
            for (int m = 0; m < 4; ++m) { bf16_t* rowp = C + (size_t)(row0 + ai * 128 + m * 16) * ldc + col0;
#pragma unroll
                for (int bj = 0; bj < 2; ++bj) { const f32x4 v0 = acc[ai][bj][m][0], v1 = acc[ai][bj][m][1];
                    u32x4 w; w.x = cvtpk(v0[0], v0[1]); w.y = cvtpk(v0[2], v0[3]); w.z = cvtpk(v1[0], v1[1]); w.w = cvtpk(v1[2], v1[3]);
                    *(u32x4*)(rowp + bj * 128) = w; } }
    } };
struct XEpiResid {
    static constexpr bool PERM = true;
    const Params* p; const float* mod;
    DI void operator()(const f32x4 (&acc)[2][2][4][2], const DenseSched::Unit& u, int wr, int wc, int fr, int fq) const {
        const int row0 = u.pm * 256 + (u.half > 0 ? 128 : 0) + wr * 64 + fr, col0 = u.pn * 256 + wc * 32 + 8 * fq;
#pragma unroll
        for (int ai = 0; ai < 2; ++ai) if (ai == 0 || u.half < 0)
#pragma unroll
            for (int m = 0; m < 4; ++m) { const int row = row0 + ai * 128 + m * 16;
                bf16_t* xr = xb_row(*p, row) + col0; const float* gp = mod + (size_t)mod_row(row) * 6144 + 2048 + col0;
#pragma unroll
                for (int bj = 0; bj < 2; ++bj) {
                    const u32x4 xw = *(const u32x4*)(xr + bj * 128); const f32x4 g0 = *(const f32x4*)(gp + bj * 128), g1 = *(const f32x4*)(gp + bj * 128 + 4);
                    const f32x4 a0 = acc[ai][bj][m][0], a1 = acc[ai][bj][m][1];
                    u32x4 w;
                    w.x = cvtpk(bflo(xw.x) + g0[0] * a0[0], bfhi(xw.x) + g0[1] * a0[1]); w.y = cvtpk(bflo(xw.y) + g0[2] * a0[2], bfhi(xw.y) + g0[3] * a0[3]);
                    w.z = cvtpk(bflo(xw.z) + g1[0] * a1[0], bfhi(xw.z) + g1[1] * a1[1]); w.w = cvtpk(bflo(xw.w) + g1[2] * a1[2], bfhi(xw.w) + g1[3] * a1[3]);
                    *(u32x4*)(xr + bj * 128) = w; } }
    } };
struct XEpiGlu {
    static constexpr bool PERM = true;
    bf16_t* act; const float* gates;
    DI void operator()(const f32x4 (&acc)[2][2][4][2], const MoeUnit& u, int wr, int wc, int fr, int fq) const {
#pragma unroll
        for (int ai = 0; ai < 2; ++ai)
#pragma unroll
            for (int m = 0; m < 4; ++m) { const int i = ai * 128 + wr * 64 + m * 16 + fr;
                if (i < u.valid) { const unsigned a = u.ent[i]; const float gw = gates[a];
                    const f32x4 g0 = acc[ai][0][m][0], g1 = acc[ai][0][m][1], u0 = acc[ai][1][m][0], u1 = acc[ai][1][m][1];
                    float v[8];
#pragma unroll
                    for (int j = 0; j < 4; ++j) { v[j] = silu_f(g0[j]) * u0[j] * gw; v[4 + j] = silu_f(g1[j]) * u1[j] * gw; }
                    u32x4 w; w.x = cvtpk(v[0], v[1]); w.y = cvtpk(v[2], v[3]); w.z = cvtpk(v[4], v[5]); w.w = cvtpk(v[6], v[7]);
                    *(u32x4*)(act + (size_t)a * DEXP + u.pn * 128 + wc * 32 + 8 * fq) = w; } }
    } };
struct XEpiGlu8 : XEpiGlu {
    DI void operator()(const f32x4 (&acc)[2][2][4][2], const MoeUnit& u, int wr, int wc, int fr, int fq) const {
#pragma unroll
        for (int ai = 0; ai < 2; ++ai)
#pragma unroll
            for (int m = 0; m < 4; ++m) { const int i = ai * 128 + wr * 64 + m * 16 + fr;
                if (i < u.valid) { const unsigned a = u.ent[i]; const float gw = gates[a] * (1.0f / 32.0f);
                    const f32x4 g0 = acc[ai][0][m][0] * (1.0f / 32.0f), g1 = acc[ai][0][m][1] * (1.0f / 32.0f), u0 = acc[ai][1][m][0], u1 = acc[ai][1][m][1];
                    float v[8];
#pragma unroll
                    for (int j = 0; j < 4; ++j) { v[j] = silu_f(g0[j]) * u0[j] * gw; v[4 + j] = silu_f(g1[j]) * u1[j] * gw; }
                    u32x4 w; w.x = cvtpk(v[0], v[1]); w.y = cvtpk(v[2], v[3]); w.z = cvtpk(v[4], v[5]); w.w = cvtpk(v[6], v[7]);
                    *(u32x4*)(act + (size_t)a * DEXP + u.pn * 128 + wc * 32 + 8 * fq) = w; } }
    } };
template <> struct epi_fp8<XEpiGlu8> { static constexpr bool value = true; };
struct XEpiScatter {
    static constexpr bool PERM = true;
    bf16_t* outp;
    DI void operator()(const f32x4 (&acc)[2][2][4][2], const MoeUnit& u, int wr, int wc, int fr, int fq) const {
#pragma unroll
        for (int ai = 0; ai < 2; ++ai)
#pragma unroll
            for (int m = 0; m < 4; ++m) { const int i = ai * 128 + wr * 64 + m * 16 + fr;
                if (i < u.valid) { bf16_t* rowp = outp + (size_t)u.ent[i] * 1024 + u.pn * 256 + wc * 32 + 8 * fq;
#pragma unroll
                    for (int bj = 0; bj < 2; ++bj) { const f32x4 v0 = acc[ai][bj][m][0], v1 = acc[ai][bj][m][1];
                        u32x4 w; w.x = cvtpk(v0[0], v0[1]); w.y = cvtpk(v0[2], v0[3]); w.z = cvtpk(v1[0], v1[1]); w.w = cvtpk(v1[2], v1[3]);
                        *(u32x4*)(rowp + bj * 128) = w; } } }
    } };

template <int KIND>
struct XEpiQKV {
    static constexpr bool PERM = true;
    static constexpr int KW = KIND == 1 ? 256 : 1024, LDRAW = KIND == 1 ? 1536 : 3072;
    bf16_t* Q; bf16_t* Kb; bf16_t* RAW; const float* qn; const float* kn;
    DI void operator()(const f32x4 (&acc)[2][2][4][2], const DenseSched::Unit& u, int wr, int wc, int fr, int fq) const {
        const int col0 = u.pn * 256, row0 = u.pm * 256 + (u.half > 0 ? 128 : 0) + wr * 64 + fr;
        if (col0 >= 1024 + KW) {
#pragma unroll
            for (int ai = 0; ai < 2; ++ai) if (ai == 0 || u.half < 0)
#pragma unroll
                for (int m = 0; m < 4; ++m) { bf16_t* rowp = RAW + (size_t)(row0 + ai * 128 + m * 16) * LDRAW + col0 + wc * 32 + 8 * fq;
#pragma unroll
                    for (int bj = 0; bj < 2; ++bj) { const f32x4 v0 = acc[ai][bj][m][0], v1 = acc[ai][bj][m][1];
                        u32x4 w; w.x = cvtpk(v0[0], v0[1]); w.y = cvtpk(v0[2], v0[3]); w.z = cvtpk(v1[0], v1[1]); w.w = cvtpk(v1[2], v1[3]);
                        *(u32x4*)(rowp + bj * 128) = w; } }
            return;
        }
        const bool isq = col0 < 1024;
        const int head = isq ? 4 * u.pn + wc : ((col0 - 1024) >> 6) + wc;
        const float* gain = (isq ? qn : kn) + 8 * fq;
        const float scale = isq ? 0.125f * LOG2E : 1.0f;
        bf16_t* dstb = isq ? Q + head * 64 + 8 * fq : Kb + head * 64 + 8 * fq;
        const int ldd = isq ? 1024 : KW;
        f32x4 g[2][2];
#pragma unroll
        for (int bj = 0; bj < 2; ++bj)
#pragma unroll
            for (int n = 0; n < 2; ++n) g[bj][n] = *(const f32x4*)(gain + 32 * bj + 4 * n);
#pragma unroll
        for (int ai = 0; ai < 2; ++ai) if (ai == 0 || u.half < 0)
#pragma unroll
            for (int m = 0; m < 4; ++m) {
                const int row = row0 + ai * 128 + m * 16, b = row / PP, pos = row - b * PP;
                f32x4 v[2][2];
                float ss = 0.f;
#pragma unroll
                for (int bj = 0; bj < 2; ++bj)
#pragma unroll
                    for (int n = 0; n < 2; ++n) { v[bj][n] = acc[ai][bj][m][n]; ss += v[bj][n][0] * v[bj][n][0] + v[bj][n][1] * v[bj][n][1] + v[bj][n][2] * v[bj][n][2] + v[bj][n][3] * v[bj][n][3]; }
                ss += __shfl_xor(ss, 16); ss += __shfl_xor(ss, 32);
                const float rs = rsqrtf(ss * (1.0f / 64.0f) + EPS);
#pragma unroll
                for (int bj = 0; bj < 2; ++bj)
#pragma unroll
                    for (int n = 0; n < 2; ++n) v[bj][n] = v[bj][n] * rs * g[bj][n];
                if (KIND != 0 && pos < SEQ) {
                    const int prow = (pos >> 6) & 63, pcol = pos & 63;
                    const float* cs = ROPE64 + ((fq < 2 ? prow : pcol) * 16 + ((8 * fq) & 15)) * 2;
#pragma unroll
                    for (int n = 0; n < 2; ++n)
#pragma unroll
                        for (int j = 0; j < 4; ++j) {
                            const float c = cs[(4 * n + j) * 2], sn = cs[(4 * n + j) * 2 + 1], x1 = v[0][n][j], x2 = v[1][n][j];
                            v[0][n][j] = x1 * c - x2 * sn; v[1][n][j] = x2 * c + x1 * sn;
                        }
                }
                bf16_t* rowp = dstb + (size_t)row * ldd;
#pragma unroll
                for (int bj = 0; bj < 2; ++bj) { const f32x4 v0 = v[bj][0] * scale, v1 = v[bj][1] * scale;
                    u32x4 w; w.x = cvtpk(v0[0], v0[1]); w.y = cvtpk(v0[2], v0[3]); w.z = cvtpk(v1[0], v1[1]); w.w = cvtpk(v1[2], v1[3]);
                    *(u32x4*)(rowp + bj * 32) = w; }
            }
    } };
template <int KIND>
DI void gemm_qkv_x(const Params& p, unsigned char* smem, const bf16_t* Wt, int N, const float* qn, const float* kn, int bid, int nb, int tid) {
    DenseSched S; S.nM = MROWS / 256; S.nN = N / 256; S.nwg = S.nM * S.nN; S.G = nb; S.c = bid; S.Bt = Wt; S.K = 1024; S.lda = 1024; S.skip_ctx = false;
    XEpiQKV<KIND> e{(bf16_t*)(p.ws + WS_Q), (bf16_t*)(p.ws + WS_K), (bf16_t*)(p.ws + WS_RAW), qn, kn};
    pg8::gemm_phase((lds_ptr)smem, (const bf16_t*)(p.ws + WS_H), 1024, S, e, tid);
}
template <bool UQ>
struct XEpiMla {
    static constexpr bool PERM = true;
    bf16_t* Q; bf16_t* Kb; bf16_t* V; const float* qn; const float* kn;
    DI void operator()(const f32x4 (&acc)[2][2][4][2], const DenseSched::Unit& u, int wr, int wc, int fr, int fq) const {
        const int row0 = u.pm * 256 + (u.half > 0 ? 128 : 0) + wr * 64 + fr;
        if (u.pn < 4) {
            const int head = 4 * u.pn + wc;
            const float* gain = (UQ ? qn : kn) + 8 * fq;
            const float scale = UQ ? 0.10206207261596577f * LOG2E : 1.0f;
            bf16_t* dstb = (UQ ? Q : Kb) + head * 96 + 8 * fq;
            f32x4 g[2][2];
#pragma unroll
            for (int bj = 0; bj < 2; ++bj)
#pragma unroll
                for (int n = 0; n < 2; ++n) g[bj][n] = *(const f32x4*)(gain + 32 * bj + 4 * n);
#pragma unroll
            for (int ai = 0; ai < 2; ++ai) if (ai == 0 || u.half < 0)
#pragma unroll
                for (int m = 0; m < 4; ++m) {
                    const int row = row0 + ai * 128 + m * 16;
                    float ss = 0.f;
#pragma unroll
                    for (int bj = 0; bj < 2; ++bj)
#pragma unroll
                        for (int n = 0; n < 2; ++n) { const f32x4 v = acc[ai][bj][m][n]; ss += v[0] * v[0] + v[1] * v[1] + v[2] * v[2] + v[3] * v[3]; }
                    ss += __shfl_xor(ss, 16); ss += __shfl_xor(ss, 32);
                    const float rs = rsqrtf(ss * (1.0f / 64.0f) + EPS) * scale;
                    bf16_t* rowp = dstb + (size_t)row * 1536;
#pragma unroll
                    for (int bj = 0; bj < 2; ++bj) { const f32x4 v0 = acc[ai][bj][m][0] * rs * g[bj][0], v1 = acc[ai][bj][m][1] * rs * g[bj][1];
                        u32x4 w; w.x = cvtpk(v0[0], v0[1]); w.y = cvtpk(v0[2], v0[3]); w.z = cvtpk(v1[0], v1[1]); w.w = cvtpk(v1[2], v1[3]);
                        *(u32x4*)(rowp + bj * 32) = w; }
                }
        } else if (UQ) {
            const float scale = 0.10206207261596577f * LOG2E;
            const f32x4 g1 = *(const f32x4*)(qn + 64 + 4 * fq), g2 = *(const f32x4*)(qn + 64 + 16 + 4 * fq);
#pragma unroll
            for (int ai = 0; ai < 2; ++ai) if (ai == 0 || u.half < 0)
#pragma unroll
                for (int m = 0; m < 4; ++m) {
                    const int row = row0 + ai * 128 + m * 16, b = row / PP, pos = row - b * PP;
                    const int prow = (pos >> 6) & 63, pcol = pos & 63;
                    const float* cs = ROPE32 + ((fq < 2 ? prow : pcol) * 8 + ((4 * fq) & 7)) * 2;
#pragma unroll
                    for (int bj = 0; bj < 2; ++bj) {
                        f32x4 x1 = acc[ai][bj][m][0], x2 = acc[ai][bj][m][1];
                        float ss = x1[0] * x1[0] + x1[1] * x1[1] + x1[2] * x1[2] + x1[3] * x1[3] + x2[0] * x2[0] + x2[1] * x2[1] + x2[2] * x2[2] + x2[3] * x2[3];
                        ss += __shfl_xor(ss, 16); ss += __shfl_xor(ss, 32);
                        const float rs = rsqrtf(ss * (1.0f / 32.0f) + EPS);
                        x1 = x1 * rs * g1; x2 = x2 * rs * g2;
                        if (pos < SEQ) {
#pragma unroll
                            for (int j = 0; j < 4; ++j) { const float c = cs[2 * j], sn = cs[2 * j + 1], a1 = x1[j], a2 = x2[j]; x1[j] = a1 * c - a2 * sn; x2[j] = a2 * c + a1 * sn; }
                        }
                        x1 = x1 * scale; x2 = x2 * scale;
                        bf16_t* rowp = Q + (size_t)row * 1536 + (8 * (u.pn - 4) + 4 * bj + wc) * 96 + 64 + 4 * fq;
                        u32x2 w1, w2; w1.x = cvtpk(x1[0], x1[1]); w1.y = cvtpk(x1[2], x1[3]); w2.x = cvtpk(x2[0], x2[1]); w2.y = cvtpk(x2[2], x2[3]);
                        *(u32x2*)rowp = w1; *(u32x2*)(rowp + 16) = w2;
                    }
                }
        } else {
#pragma unroll
            for (int ai = 0; ai < 2; ++ai) if (ai == 0 || u.half < 0)
#pragma unroll
                for (int m = 0; m < 4; ++m) { bf16_t* rowp = V + (size_t)(row0 + ai * 128 + m * 16) * 1024 + (u.pn - 4) * 256 + wc * 32 + 8 * fq;
#pragma unroll
                    for (int bj = 0; bj < 2; ++bj) { const f32x4 v0 = acc[ai][bj][m][0], v1 = acc[ai][bj][m][1];
                        u32x4 w; w.x = cvtpk(v0[0], v0[1]); w.y = cvtpk(v0[2], v0[3]); w.z = cvtpk(v1[0], v1[1]); w.w = cvtpk(v1[2], v1[3]);
                        *(u32x4*)(rowp + bj * 128) = w; } }
        }
    } };
template <bool UQ>
DI void gemm_mla_x(const Params& p, unsigned char* smem, int bid, int nb, int tid) {
    bf16_t* O = (bf16_t*)(p.ws + WS_O);
    DenseSched S; S.nM = MROWS / 256; S.nN = (UQ ? 1536 : 2048) / 256; S.nwg = S.nM * S.nN; S.G = nb; S.c = bid; S.Bt = (const bf16_t*)(p.ws + (UQ ? W_UQ : W_UKV)); S.K = UQ ? 384 : 256; S.lda = S.K; S.skip_ctx = false;
    XEpiMla<UQ> e{(bf16_t*)(p.ws + WS_Q), (bf16_t*)(p.ws + WS_K), (bf16_t*)(p.ws + WS_RAW), p.in[28], p.in[29]};
    pg8::gemm_phase((lds_ptr)smem, UQ ? O : O + (size_t)MROWS * 384, S.K, S, e, tid);
}
template <int EPIK>
DI void gemm_dense_x(const Params& p, unsigned char* smem, const bf16_t* A, int lda, const bf16_t* Wt, int K, int N, bf16_t* C, int ldc, const float* mod, int bid, int nb, int tid, bool skip_ctx = false) {
    DenseSched S; S.nM = skip_ctx ? NBATCH * 16 : MROWS / 256; S.nN = N / 256; S.nwg = S.nM * S.nN; S.G = nb; S.c = bid; S.Bt = Wt; S.K = K; S.lda = lda; S.skip_ctx = skip_ctx;
    if (EPIK == 0) { XEpiStore e{C, ldc}; pg8::gemm_phase((lds_ptr)smem, A, K, S, e, tid); }
    else { XEpiResid e{&p, mod}; pg8::gemm_phase((lds_ptr)smem, A, K, S, e, tid); }
}
template <int WHICH, bool TAIL>
DI void gemm_moe_call(const Params& p, unsigned char* smem, int layer, int bid, int nb, int tid) {
    MoeSched<TAIL> S; S.list = (const unsigned*)(p.ws + WS_LIST); S.zero = (const unsigned*)(p.ws + WS_CTL) + 8192; S.G = nb; S.c = bid;
    {
        LAS int* tab = (LAS int*)(smem + GEMM_LDS);
        constexpr int TNc = WHICH == 0 ? 2 : 4;
        if (tid < 64) {
            const unsigned cv = tid < 32 ? ((const unsigned*)(p.ws + WS_CTL) + CW_CNT + layer * 32)[tid] : 0u;
            int incl = (int)((cv + 255u) >> 8) * TNc;
#pragma unroll
            for (int d = 1; d < 32; d <<= 1) { const int o = __shfl_up(incl, d); if (tid >= d) incl += o; }
            if (tid < 32) { tab[1 + tid] = incl; tab[40 + tid] = (int)cv; }
            if (tid == 0) tab[0] = 0;
        }
        __syncthreads();
        S.tab = tab; S.nwg = __builtin_amdgcn_readfirstlane(tab[32]);
    }
    if (WHICH == 0) { S.W = (const bf16_t*)(p.ws + W_GU + (size_t)layer * 32 * 512 * 1024); S.K = 512; S.N = 512; S.TN = 2; S.lda = 512; S.shift = 1;
        S.place(); XEpiGlu8 e{{(bf16_t*)(p.ws + WS_Q), (const float*)(p.ws + WS_GATE)}}; pg8::gemm_phase((lds_ptr)smem, (const bf16_t*)(p.ws + WS_H), 512, S, e, tid); }
    else { S.W = (const bf16_t*)(p.ws + W_DN) + (size_t)layer * 32 * 1024 * 256; S.K = 256; S.N = 1024; S.TN = 4; S.lda = DEXP; S.shift = 0;
        S.place(); XEpiScatter e{(bf16_t*)(p.ws + WS_RAW)}; pg8::gemm_phase((lds_ptr)smem, (const bf16_t*)(p.ws + WS_Q), 256, S, e, tid); }
}
template <int WHICH>
DI void gemm_moe_x(const Params& p, unsigned char* smem, int layer, int bid, int nb, int tid) {
    const int wv = __builtin_amdgcn_readfirstlane(tid >> 6);
    gemm_moe_call<WHICH, false>(p, smem, layer, bid, nb, (wv << 6) | lane_now());
    gemm_moe_call<WHICH, true>(p, smem, layer, bid, nb, (wv << 6) | lane_now());
}

constexpr int NPHASES = 2 + (7 + 7 + 9 + 7) + 1;
constexpr int SMEM_BYTES = GEMM_LDS + 512;

template <int KIND>
DI void layer_phases(const Params& p, int& ph, const int lo, const int hi, const XcdBarrier& bar, unsigned char* smem, int bid, int nb, int wid_u) {
    constexpr int L = KIND;
    const float* mod = (const float*)(p.ws + WS_MOD) + (size_t)L * 9 * 6144;
    bf16_t* H = (bf16_t*)(p.ws + WS_H); bf16_t* O = (bf16_t*)(p.ws + WS_O); bf16_t* RAW = (bf16_t*)(p.ws + WS_RAW);
    bf16_t* Q = (bf16_t*)(p.ws + WS_Q); bf16_t* Kb = (bf16_t*)(p.ws + WS_K);
#ifndef AABL
#define AABL 0
#endif
#ifndef GPROBE
#define GPROBE 0
#endif
#ifndef DUP_MASK
#define DUP_MASK 0ull
#endif
#define PHASE2(BODY, DUPBODY) do { if (lo <= ph && ph < hi) { const int tid = (wid_u << 6) | lane_now(); if ((DUP_MASK >> ph) & 1ull) { DUPBODY; xcd_barrier(bar, tid == 0); } BODY; } if (lo <= ph && ph + 1 < hi) xcd_barrier(bar, ((wid_u << 6) | lane_now()) == 0); ++ph; } while (0)
#define PHASE(...) PHASE2((__VA_ARGS__), (__VA_ARGS__))
    if (L == 0) PHASE(phase_rows<2 | 8>(p, L, 0, bid, nb, tid), phase_router_prep(p, bid, nb, tid));
    else PHASE2((phase_rows<3>(p, L, 0, bid, nb, tid)), (phase_rows<2>(p, L, 0, bid, nb, tid)));
    AttnP a{};
    if (KIND == 0) {
        PHASE(gemm_qkv_x<0>(p, smem, (const bf16_t*)(p.ws + W_QKV0), 3072, p.in[15], p.in[16], bid, nb, tid));
        a = AttnP{Q, 1024, Kb, 1024, RAW + 2048, 3072, O, 1024, 16, 0, 0, 64, p.in[17], nullptr, 1, p.in[16]};
        PHASE(attn_na(a, smem, bid, nb, tid));
        PHASE2((gemm_dense_x<1>(p, smem, O, 1024, (const bf16_t*)(p.ws + W_O0), 1024, 1024, nullptr, 0, mod, bid, nb, tid)), (gemm_dense_x<0>(p, smem, O, 1024, (const bf16_t*)(p.ws + W_O0), 1024, 1024, RAW, 1024, nullptr, bid, nb, tid)));
    } else if (KIND == 1) {
        PHASE(gemm_qkv_x<1>(p, smem, (const bf16_t*)(p.ws + W_QKV1), 1536, p.in[20], p.in[21], bid, nb, tid));
        a = AttnP{Q, 1024, Kb, 256, RAW + 1280, 1536, O, 1024, 16, 2, 2, 64, nullptr, p.in[22], 1};
        PHASE(attn_mfma<64, 64, 1>(a, smem, bid, nb, tid));
        PHASE2((gemm_dense_x<1>(p, smem, O, 1024, (const bf16_t*)(p.ws + W_O1), 1024, 1024, nullptr, 0, mod, bid, nb, tid)), (gemm_dense_x<0>(p, smem, O, 1024, (const bf16_t*)(p.ws + W_O1), 1024, 1024, RAW, 1024, nullptr, bid, nb, tid)));
    } else if (KIND == 2) {
        bf16_t* cqn = O; bf16_t* ckvn = O + (size_t)MROWS * 384;
        PHASE(gemm_dense_x<0>(p, smem, H, 1024, (const bf16_t*)(p.ws + W_DQKV), 1024, 768, Q, 768, nullptr, bid, nb, tid));
        PHASE(phase_post_mla1(p, bid, nb, tid));
        PHASE(gemm_mla_x<true>(p, smem, bid, nb, tid), gemm_mla_x<false>(p, smem, bid, nb, (wid_u << 6) | lane_now()));
        a = AttnP{Q, 1536, Kb, 1536, RAW, 1024, O, 1024, 16, 0, 0, 64, nullptr, nullptr, 1};
        PHASE(attn_mfma<96, 64, 2>(a, smem, bid, nb, tid));
        PHASE2((gemm_dense_x<1>(p, smem, O, 1024, (const bf16_t*)(p.ws + W_O2), 1024, 1024, nullptr, 0, mod, bid, nb, tid)), (gemm_dense_x<0>(p, smem, O, 1024, (const bf16_t*)(p.ws + W_O2), 1024, 1024, RAW, 1024, nullptr, bid, nb, tid)));
    } else {
        PHASE(gemm_qkv_x<3>(p, smem, (const bf16_t*)(p.ws + W_QKV3), 3072, p.in[32], p.in[33], bid, nb, tid));
        a = AttnP{Q, 1024, Kb, 1024, RAW + 2048, 3072, H  , 2048, 16, 0, 1, 128, nullptr, nullptr, 0, nullptr, p.in[34], p.in[35], Q  };
        PHASE(attn_mfma<64, 128, 2>(a, smem, bid, nb, tid));
        PHASE(gemm_dense_x<1>(p, smem, Q, 1024, (const bf16_t*)(p.ws + W_O3), 1024, 1024, nullptr, 0, mod, bid, nb, tid, true));
    }
    PHASE(phase_router(p, smem, L, L == 3, bid, nb, tid));
    PHASE(gemm_moe_x<0>(p, smem, L, bid, nb, tid));
    PHASE(gemm_moe_x<1>(p, smem, L, bid, nb, tid));
}

__global__ void __launch_bounds__(NTHREADS, 2) mega(Params p, int lo, int hi) {
    extern __shared__ __attribute__((aligned(16))) unsigned char smem[];
    const int bid = blockIdx.x, nb = gridDim.x, wid_u = __builtin_amdgcn_readfirstlane(threadIdx.x >> 6);
    float* lds = (float*)smem;
    volatile LAS unsigned* xbw = (volatile LAS unsigned*)(smem + SMEM_BYTES - 16);
    if (threadIdx.x == 0) { xbw[0] = 0u; xbw[1] = 0u; }
    __syncthreads();
    XcdBarrier bar = xcd_barrier_post((unsigned*)(p.ws + WS_CTL), xbw);
    int ph = 0;
    PHASE(phase_prologue(p, lds, bid, nb, tid));
    PHASE(phase_mod_reduce(p, bid, nb, tid));
    layer_phases<0>(p, ph, lo, hi, bar, smem, bid, nb, wid_u);
    layer_phases<1>(p, ph, lo, hi, bar, smem, bid, nb, wid_u);
    layer_phases<2>(p, ph, lo, hi, bar, smem, bid, nb, wid_u);
    layer_phases<3>(p, ph, lo, hi, bar, smem, bid, nb, wid_u);
    PHASE2((phase_rows<1 | 16>(p, 3, 0, bid, nb, tid)), (void)0);
}

extern "C" void kernel_launch(void* const* d_in, const int* in_sizes, int n_in, void* d_out, int out_size, void* d_ws, size_t ws_size, hipStream_t stream) {
    (void)in_sizes; (void)out_size;
    if (n_in < 37 || ws_size < WS_END) { fprintf(stderr, "kernel_launch: unexpected inputs (n_in %d, ws %zu)\n", n_in, ws_size); return; }
    static int grid = 0;
    if (!grid) {
        int dev = 0, cus = 0, per_cu = 0;
        hipGetDevice(&dev);
        hipDeviceGetAttribute(&cus, hipDeviceAttributeMultiprocessorCount, dev);
        hipFuncSetAttribute((const void*)mega, hipFuncAttributeMaxDynamicSharedMemorySize, SMEM_BYTES);
        hipOccupancyMaxActiveBlocksPerMultiprocessor(&per_cu, mega, NTHREADS, SMEM_BYTES);
        if (per_cu < 1) per_cu = 1;
        grid = cus * (per_cu < 1 ? per_cu : 1);
    }
    Params p{};
    for (int i = 0; i < 37; ++i) p.in[i] = (const float*)d_in[i];
    p.out = (float*)d_out; p.ws = (unsigned char*)d_ws;
    hipMemsetAsync(p.ws + WS_CTL, 0, 65536, stream);
#if ONE_LAUNCH
    hipLaunchKernelGGL(mega, dim3(grid), dim3(NTHREADS), SMEM_BYTES, stream, p, 0, NPHASES);
#else
    for (int k = 0; k < NPHASES; ++k) hipLaunchKernelGGL(mega, dim3(grid), dim3(NTHREADS), SMEM_BYTES, stream, p, k, k + 1);
#endif
}
```

```cpp
#include <hip/hip_runtime.h>
#include <stdint.h>
#include <stdio.h>

#ifndef ONE_LAUNCH
#define ONE_LAUNCH 1
#endif

#define DI __device__ __forceinline__
typedef unsigned short bf16_t;
typedef short bf16x8 __attribute__((ext_vector_type(8)));
typedef float f32x4 __attribute__((ext_vector_type(4)));
typedef float f32x16 __attribute__((ext_vector_type(16)));
typedef unsigned u32x4 __attribute__((ext_vector_type(4)));
typedef unsigned u32x2 __attribute__((ext_vector_type(2)));

constexpr int DM = 1024, NBATCH = 8, SEQ = 4096, CTXL = 256, PP = SEQ + CTXL, MROWS = NBATCH * PP;
constexpr int NEXP = 32, DEXP = 256;
constexpr float EPS = 1e-6f, LOG2E = 1.4426950408889634f;
constexpr int NTHREADS = 512, NW = NTHREADS / 64;

constexpr size_t MiB = 1ull << 20;
constexpr size_t WS_RAW_FWD = 380ull << 20;
constexpr size_t WS_CTL = 0, CTL_BYTES = 1 * MiB;
constexpr size_t WS_MOD = 1 * MiB;
constexpr size_t WS_MODP = WS_RAW_FWD;
constexpr size_t WS_XCTX = 9 * MiB;
constexpr size_t WS_LIST = 17 * MiB;
constexpr size_t WS_GATE = 22 * MiB;
constexpr size_t WS_W = 24 * MiB;
constexpr size_t W_QKV0 = WS_W + 0 * MiB, W_O0 = WS_W + 6 * MiB, W_QKV1 = WS_W + 8 * MiB, W_O1 = WS_W + 11 * MiB, W_DQKV = WS_W + 13 * MiB,
                 W_UQ = WS_W + 15 * MiB, W_UKV = WS_W + 17 * MiB, W_O2 = WS_W + 18 * MiB, W_QKV3 = WS_W + 20 * MiB, W_O3 = WS_W + 26 * MiB,
                 W_GU = WS_W + 28 * MiB, W_DN = WS_W + 156 * MiB;
constexpr size_t WS_H = 244 * MiB;
constexpr size_t WS_O = 312 * MiB;
constexpr size_t WS_RAW = 380 * MiB;
constexpr size_t WS_Q = 620 * MiB;
constexpr size_t WS_K = 722 * MiB;
constexpr size_t WS_XB = 824 * MiB;
constexpr size_t WS_END = 892 * MiB;
constexpr int CW_CNT = 4096;

constexpr size_t WS_RW = 2 * MiB;
struct Params { const float* in[37]; float* out; unsigned char* ws; };

DI unsigned f2bf(float f) { unsigned u = __float_as_uint(f); return (u + 0x7fffu + ((u >> 16) & 1u)) >> 16; }
DI float bf2f(unsigned h) { return __uint_as_float(h << 16); }
DI unsigned pk2(float lo, float hi) { return f2bf(lo) | (f2bf(hi) << 16); }
DI float bflo(unsigned w) { return __uint_as_float(w << 16); }
DI float bfhi(unsigned w) { return __uint_as_float(w & 0xffff0000u); }
DI int lane_now() { unsigned lane; asm volatile("v_mbcnt_lo_u32_b32 %0, -1, 0\n\tv_mbcnt_hi_u32_b32 %0, -1, %0" : "=v"(lane)); return (int)lane; }
DI float wave_sum(float v) {
#pragma unroll
    for (int o = 32; o > 0; o >>= 1) v += __shfl_xor(v, o);
    return v;
}
DI float silu_f(float x) { return x / (1.0f + __expf(-x)); }
DI void unpack8(const u32x4 w, float (&f)[8]) {
    f[0] = bflo(w.x); f[1] = bfhi(w.x); f[2] = bflo(w.y); f[3] = bfhi(w.y); f[4] = bflo(w.z); f[5] = bfhi(w.z); f[6] = bflo(w.w); f[7] = bfhi(w.w);
}
DI u32x4 pack8(const float (&f)[8]) { u32x4 w; w.x = pk2(f[0], f[1]); w.y = pk2(f[2], f[3]); w.z = pk2(f[4], f[5]); w.w = pk2(f[6], f[7]); return w; }
DI float* xrow_ptr(const Params& p, int r) {
    const int b = r / PP, pos = r - b * PP;
    return pos < SEQ ? p.out + ((size_t)b * SEQ + pos) * DM : (float*)(p.ws + WS_XCTX) + ((size_t)b * CTXL + (pos - SEQ)) * DM;
}
DI bf16_t* xb_row(const Params& p, int r) { return (bf16_t*)(p.ws + WS_XB) + (size_t)r * DM; }
DI int mod_row(int r) { const int b = r / PP, pos = r - b * PP; return pos < SEQ ? b : 8; }
__device__ const float ROPE64[2048] = {
  1.000000000e+00f, 0.000000000e+00f, 1.000000000e+00f, 0.000000000e+00f, 1.000000000e+00f, 0.000000000e+00f, 1.000000000e+00f, 0.000000000e+00f,
  1.000000000e+00f, 0.000000000e+00f, 1.000000000e+00f, 0.000000000e+00f, 1.000000000e+00f, 0.000000000e+00f, 1.000000000e+00f, 0.000000000e+00f,
  1.000000000e+00f, 0.000000000e+00f, 1.000000000e+00f, 0.000000000e+00f, 1.000000000e+00f, 0.000000000e+00f, 1.000000000e+00f, 0.000000000e+00f,
  1.000000000e+00f, 0.000000000e+00f, 1.000000000e+00f, 0.000000000e+00f, 1.000000000e+00f, 0.000000000e+00f, 1.000000000e+00f, 0.000000000e+00f,
  5.403022766e-01f, 8.414709568e-01f, 8.460091352e-01f, 5.331684351e-01f, 9.504152536e-01f, 3.109835982e-01f, 9.842302203e-01f, 1.768921912e-01f,
  9.950041771e-01f, 9.983342141e-02f, 9.984192848e-01f, 5.620449781e-02f, 9.995000362e-01f, 3.161750361e-02f, 9.998418689e-01f, 1.778185740e-02f,
  9.999499917e-01f, 9.999833070e-03f, 9.999842048e-01f, 5.623383448e-03f, 9.999949932e-01f, 3.162272274e-03f, 9.999983907e-01f, 1.778278500e-03f,
  9.999995232e-01f, 9.999999311e-04f, 9.999998212e-01f, 5.623412435e-04f, 9.999999404e-01f, 3.162277571e-04f, 1.000000000e+00f, 1.778279402e-04f,
  -4.161468446e-01f, 9.092974067e-01f, 4.314628243e-01f, 9.021307230e-01f, 8.065783978e-01f, 5.911270976e-01f, 9.374182820e-01f, 3.482052684e-01f,
  9.800665975e-01f, 1.986693293e-01f, 9.936820865e-01f, 1.122313142e-01f, 9.980006814e-01f, 6.320339441e-02f, 9.993675947e-01f, 3.555808961e-02f,
  9.998000264e-01f, 1.999866590e-02f, 9.999367595e-01f, 1.124658901e-02f, 9.999799728e-01f, 6.324512884e-03f, 9.999936819e-01f, 3.556551412e-03f,
  9.999979734e-01f, 1.999998698e-03f, 9.999993443e-01f, 1.124682371e-03f, 9.999998212e-01f, 6.324554561e-04f, 9.999999404e-01f, 3.556558804e-04f,
  -9.899924994e-01f, 1.411200017e-01f, -1.159661636e-01f, 9.932531714e-01f, 5.827536583e-01f, 8.126488924e-01f, 8.610406518e-01f, 5.085361004e-01f,
  9.553365111e-01f, 2.955202162e-01f, 9.858034849e-01f, 1.679033041e-01f, 9.955033660e-01f, 9.472608566e-02f, 9.985772967e-01f, 5.332308263e-02f,
  9.995500445e-01f, 2.999549918e-02f, 9.998577237e-01f, 1.686943881e-02f, 9.999549985e-01f, 9.486690164e-03f, 9.999857545e-01f, 5.334813148e-03f,
  9.999955297e-01f, 2.999995602e-03f, 9.999985695e-01f, 1.687023090e-03f, 9.999995232e-01f, 9.486831259e-04f, 9.999998808e-01f, 5.334838061e-04f,
  -6.536436081e-01f, -7.568024993e-01f, -6.276797056e-01f, 7.784717083e-01f, 3.011374772e-01f, 9.535807371e-01f, 7.575061917e-01f, 6.528279781e-01f,
  9.210609794e-01f, 3.894183338e-01f, 9.748082757e-01f, 2.230444849e-01f, 9.920106530e-01f, 1.261540651e-01f, 9.974712729e-01f, 7.107120752e-02f,
  9.992001057e-01f, 3.998933360e-02f, 9.997470379e-01f, 2.249175683e-02f, 9.999200106e-01f, 1.264877338e-02f, 9.999747276e-01f, 7.113057654e-03f,
  9.999920130e-01f, 3.999989480e-03f, 9.999974966e-01f, 2.249363344e-03f, 9.999992251e-01f, 1.264910679e-03f, 9.999997616e-01f, 7.113117026e-04f,
  2.836622000e-01f, -9.589242935e-01f, -9.460792542e-01f, 3.239352703e-01f, -1.034233812e-02f, 9.999465346e-01f, 6.300802827e-01f, 7.765299678e-01f,
  8.775825500e-01f, 4.794255495e-01f, 9.607312679e-01f, 2.774805427e-01f, 9.875259995e-01f, 1.574558765e-01f, 9.960497618e-01f, 8.879686147e-02f,
  9.987502694e-01f, 4.997916520e-02f, 9.996047616e-01f, 2.811336145e-02f, 9.998750091e-01f, 1.581072807e-02f, 9.999604821e-01f, 8.891279809e-03f,
  9.999874830e-01f, 4.999979399e-03f, 9.999960661e-01f, 2.811702900e-03f, 9.999987483e-01f, 1.581138116e-03f, 9.999995828e-01f, 8.891395992e-04f,
  9.601702690e-01f, -2.794154882e-01f, -9.731037021e-01f, -2.303675115e-01f, -3.207964003e-01f, 9.471482038e-01f, 4.827820361e-01f, 8.757405281e-01f,
  8.253356218e-01f, 5.646424890e-01f, 9.436169863e-01f, 3.310393095e-01f, 9.820539355e-01f, 1.886002719e-01f, 9.943132997e-01f, 1.064944416e-01f,
  9.982005358e-01f, 5.996400490e-02f, 9.994308352e-01f, 3.373407945e-02f, 9.998199940e-01f, 1.897252724e-02f, 9.999430776e-01f, 1.066947449e-02f,
  9.999819994e-01f, 5.999964196e-03f, 9.999943376e-01f, 3.374041524e-03f, 9.999982119e-01f, 1.897365320e-03f, 9.999994040e-01f, 1.066967379e-03f,
  7.539022565e-01f, 6.569865942e-01f, -7.004297972e-01f, -7.137212753e-01f, -5.994374752e-01f, 8.004215956e-01f, 3.202570081e-01f, 9.473307133e-01f,
  7.648422122e-01f, 6.442176700e-01f, 9.235194325e-01f, 3.835515678e-01f, 9.755998850e-01f, 2.195560932e-01f, 9.922624230e-01f, 1.241583377e-01f,
  9.975510240e-01f, 6.994284689e-02f, 9.992253184e-01f, 3.935372457e-02f, 9.997550249e-01f, 2.213413455e-02f, 9.999225140e-01f, 1.244763471e-02f,
  9.999755025e-01f, 6.999942940e-03f, 9.999922514e-01f, 3.936378751e-03f, 9.999975562e-01f, 2.213592408e-03f, 9.999992251e-01f, 1.244795276e-03f,
  -1.455000341e-01f, 9.893582463e-01f, -2.120364457e-01f, -9.772617817e-01f, -8.186324239e-01f, 5.743177533e-01f, 1.476312131e-01f, 9.890424609e-01f,
  6.967067122e-01f, 7.173560858e-01f, 9.005023241e-01f, 4.348512292e-01f, 9.681702852e-01f, 2.502923310e-01f, 9.898977876e-01f, 1.417829692e-01f,
  9.968017340e-01f, 7.991468906e-02f, 9.989882708e-01f, 4.497213289e-02f, 9.996800423e-01f, 2.529552206e-02f, 9.998987913e-01f, 1.422575582e-02f,
  9.999679923e-01f, 7.999914698e-03f, 9.999898672e-01f, 4.498715047e-03f, 9.999967813e-01f, 2.529819263e-03f, 9.999989867e-01f, 1.422623056e-03f,
  -9.111302495e-01f, 4.121184945e-01f, 3.416602612e-01f, -9.398235083e-01f, -9.566441774e-01f, 2.912592292e-01f, -2.965079620e-02f, 9.995602965e-01f,
  6.216099262e-01f, 7.833269238e-01f, 8.746382594e-01f, 4.847761393e-01f, 9.597726464e-01f, 2.807783186e-01f, 9.872201085e-01f, 1.593627781e-01f,
  9.959527254e-01f, 8.987854421e-02f, 9.987195730e-01f, 5.058911815e-02f, 9.995950460e-01f, 2.845665626e-02f, 9.998719096e-01f, 1.600383036e-02f,
  9.999595284e-01f, 8.999879472e-03f, 9.999871850e-01f, 5.061050411e-03f, 9.999959469e-01f, 2.846045885e-03f, 9.999987483e-01f, 1.600450720e-03f,
  -8.390715122e-01f, -5.440211296e-01f, 7.901318669e-01f, -6.129369140e-01f, -9.997860789e-01f, -2.068356983e-02f, -2.059976310e-01f, 9.785524607e-01f,
  5.403022766e-01f, 8.414709568e-01f, 8.460091352e-01f, 5.331684351e-01f, 9.504153132e-01f, 3.109835684e-01f, 9.842302203e-01f, 1.768921912e-01f,
  9.950041771e-01f, 9.983341396e-02f, 9.984192848e-01f, 5.620449781e-02f, 9.995000362e-01f, 3.161750361e-02f, 9.998418689e-01f, 1.778185740e-02f,
  9.999499917e-01f, 9.999834001e-03f, 9.999842048e-01f, 5.623383448e-03f, 9.999949932e-01f, 3.162272274e-03f, 9.999983907e-01f, 1.778278500e-03f,
  4.425697960e-03f, -9.999902248e-01f, 9.952573776e-01f, -9.727645665e-02f, -9.437797666e-01f, -3.305749595e-01f, -3.758473992e-01f, 9.266815782e-01f,
  4.535960853e-01f, 8.912073970e-01f, 8.147053123e-01f, 5.798751712e-01f, 9.401075840e-01f, 3.408778608e-01f, 9.809291363e-01f, 1.943656504e-01f,
  9.939560890e-01f, 1.097782999e-01f, 9.980874062e-01f, 6.181810424e-02f, 9.993950725e-01f, 3.477803990e-02f, 9.998086691e-01f, 1.955982670e-02f,
  9.999395013e-01f, 1.099977922e-02f, 9.999808669e-01f, 6.185714621e-03f, 9.999939203e-01f, 3.478498431e-03f, 9.999980927e-01f, 1.956106164e-03f,
  8.438539505e-01f, -5.365729332e-01f, 8.938615918e-01f, 4.483429790e-01f, -7.941793799e-01f, -6.076834202e-01f, -5.338430405e-01f, 8.455836177e-01f,
  3.623577058e-01f, 9.320390821e-01f, 7.808259130e-01f, 6.247486472e-01f, 9.288598895e-01f, 3.704313040e-01f, 9.773178697e-01f, 2.117776722e-01f,
  9.928086400e-01f, 1.197122037e-01f, 9.977239966e-01f, 6.742975861e-02f, 9.992800951e-01f, 3.793822229e-02f, 9.997723103e-01f, 2.133773454e-02f,
  9.999279976e-01f, 1.199971233e-02f, 9.999772310e-01f, 6.748044398e-03f, 9.999927878e-01f, 3.794723889e-03f, 9.999977350e-01f, 2.133933594e-03f,
  9.074468017e-01f, 4.201670289e-01f, 5.171728730e-01f, 8.558809757e-01f, -5.658205152e-01f, -8.245284557e-01f, -6.750016809e-01f, 7.378162146e-01f,
  2.674987614e-01f, 9.635581970e-01f, 7.444779873e-01f, 6.676470041e-01f, 9.166833758e-01f, 3.996143043e-01f, 9.733975530e-01f, 2.291227132e-01f,
  9.915618896e-01f, 1.296341419e-01f, 9.973290563e-01f, 7.303927839e-02f, 9.991551042e-01f, 4.109803215e-02f, 9.997327924e-01f, 2.311557345e-02f,
  9.999154806e-01f, 1.299963426e-02f, 9.999732971e-01f, 7.310371846e-03f, 9.999915361e-01f, 4.110949114e-03f, 9.999973178e-01f, 2.311761025e-03f,
  1.367372125e-01f, 9.906073809e-01f, -1.879615150e-02f, 9.998233318e-01f, -2.813494802e-01f, -9.596053958e-01f, -7.948709130e-01f, 6.067785621e-01f,
  1.699671596e-01f, 9.854497313e-01f, 7.057763934e-01f, 7.084347010e-01f, 9.035902619e-01f, 4.283977747e-01f, 9.691694379e-01f, 2.463953048e-01f,
  9.902160168e-01f, 1.395431161e-01f, 9.969025850e-01f, 7.864648104e-02f, 9.990201592e-01f, 4.425742477e-02f, 9.996901155e-01f, 2.489333972e-02f,
  9.999020100e-01f, 1.399954315e-02f, 9.999690056e-01f, 7.872696966e-03f, 9.999902248e-01f, 4.427174106e-03f, 9.999969006e-01f, 2.489588689e-03f,
  -7.596879005e-01f, 6.502878666e-01f, -5.489754677e-01f, 8.358384371e-01f, 3.102235124e-02f, -9.995186925e-01f, -8.896704316e-01f, 4.566032588e-01f,
  7.073719800e-02f, 9.974949956e-01f, 6.648434997e-01f, 7.469826341e-01f, 8.895936012e-01f, 4.567528665e-01f, 9.646348357e-01f, 2.635899782e-01f,
  9.887710810e-01f, 1.494381279e-01f, 9.964445233e-01f, 8.425120264e-02f, 9.988752007e-01f, 4.741638154e-02f, 9.996442795e-01f, 2.667102963e-02f,
  9.998875260e-01f, 1.499943808e-02f, 9.999644160e-01f, 8.435020223e-03f, 9.999887347e-01f, 4.743398633e-03f, 9.999964237e-01f, 2.667415887e-03f,
  -9.576594830e-01f, -2.879033089e-01f, -9.100810885e-01f, 4.144302309e-01f, 3.403181732e-01f, -9.403103590e-01f, -9.564100504e-01f, 2.920270860e-01f,
  -2.919954620e-02f, 9.995735884e-01f, 6.218088269e-01f, 7.831690907e-01f, 8.747074604e-01f, 4.846512377e-01f, 9.597951770e-01f, 2.807013094e-01f,
  9.872272611e-01f, 1.593182087e-01f, 9.959549904e-01f, 8.985326439e-02f, 9.987202883e-01f, 5.057485774e-02f, 9.995952845e-01f, 2.844863199e-02f,
  9.998720288e-01f, 1.599931903e-02f, 9.999595284e-01f, 8.997339755e-03f, 9.999871850e-01f, 5.059622694e-03f, 9.999959469e-01f, 2.845243318e-03f,
  -2.751633525e-01f, -9.613974690e-01f, -9.908979535e-01f, -1.346151382e-01f, 6.158648133e-01f, -7.878518701e-01f, -9.929850101e-01f, 1.182405204e-01f,
  -1.288445443e-01f, 9.916648269e-01f, 5.768082738e-01f, 8.168795705e-01f, 8.589466810e-01f, 5.120649934e-01f, 9.546520114e-01f, 2.977238595e-01f,
  9.855847955e-01f, 1.691823453e-01f, 9.954339862e-01f, 9.545248002e-02f, 9.985553622e-01f, 5.373282731e-02f, 9.995430708e-01f, 3.022614494e-02f,
  9.998555183e-01f, 1.699918136e-02f, 9.999542832e-01f, 9.559656493e-03f, 9.999855757e-01f, 5.375845823e-03f, 9.999954104e-01f, 3.023070283e-03f,
  6.603167057e-01f, -7.509872317e-01f, -7.665365338e-01f, -6.422007084e-01f, 8.303361535e-01f, -5.572628975e-01f, -9.982416630e-01f, -5.927551910e-02f,
  -2.272021621e-01f, 9.738476276e-01f, 5.299841762e-01f, 8.480075598e-01f, 8.423270583e-01f, 5.389667153e-01f, 9.492070079e-01f, 3.146522641e-01f,
  9.838436842e-01f, 1.790295690e-01f, 9.948815107e-01f, 1.010486856e-01f, 9.983804226e-01f, 5.689026415e-02f, 9.994877577e-01f, 3.200356290e-02f,
  9.998379946e-01f, 1.799902879e-02f, 9.999487996e-01f, 1.012197044e-02f, 9.999837875e-01f, 5.692068953e-03f, 9.999948740e-01f, 3.200897481e-03f,
  9.887046218e-01f, 1.498772055e-01f, -3.060953915e-01f, -9.520008564e-01f, 9.624637961e-01f, -2.714101076e-01f, -9.720142484e-01f, -2.349217981e-01f,
  -3.232895434e-01f, 9.463000894e-01f, 4.814845920e-01f, 8.764545321e-01f, 8.248651624e-01f, 5.653295517e-01f, 9.434618354e-01f, 3.314811885e-01f,
  9.820042253e-01f, 1.888588965e-01f, 9.942975044e-01f, 1.066416800e-01f, 9.981955290e-01f, 6.004713103e-02f, 9.994292855e-01f, 3.378088027e-02f,
  9.998195171e-01f, 1.899885759e-02f, 9.999428988e-01f, 1.068428159e-02f, 9.999819398e-01f, 6.008291151e-03f, 9.999942780e-01f, 3.378724447e-03f,
  4.080820680e-01f, 9.129452705e-01f, 2.486167252e-01f, -9.686019421e-01f, 9.991443753e-01f, 4.135828838e-02f, -9.151299596e-01f, -4.031589925e-01f,
  -4.161468446e-01f, 9.092974067e-01f, 4.314628243e-01f, 9.021307230e-01f, 8.065784574e-01f, 5.911270380e-01f, 9.374182820e-01f, 3.482052684e-01f,
  9.800665975e-01f, 1.986693144e-01f, 9.936820865e-01f, 1.122313142e-01f, 9.980006814e-01f, 6.320339441e-02f, 9.993675947e-01f, 3.555808961e-02f,
  9.998000264e-01f, 1.999866776e-02f, 9.999367595e-01f, 1.124658901e-02f, 9.999799728e-01f, 6.324512884e-03f, 9.999936819e-01f, 3.556551412e-03f,
  -5.477292538e-01f, 8.366556168e-01f, 7.267602682e-01f, -6.868911982e-01f, 9.367404580e-01f, 3.500247598e-01f, -8.293829560e-01f, -5.586805344e-01f,
  -5.048462152e-01f, 8.632093072e-01f, 3.800770044e-01f, 9.249548316e-01f, 7.874851823e-01f, 6.163335443e-01f, 9.310783744e-01f, 3.648192585e-01f,
  9.780309200e-01f, 2.084598988e-01f, 9.930352569e-01f, 1.178173944e-01f, 9.977958202e-01f, 6.635902822e-02f, 9.993028045e-01f, 3.733518720e-02f,
  9.997795224e-01f, 2.099845745e-02f, 9.999302626e-01f, 1.180889271e-02f, 9.999779463e-01f, 6.640734151e-03f, 9.999930263e-01f, 3.734378144e-03f,
  -9.999608397e-01f, -8.851309307e-03f, 9.810745716e-01f, -1.936302334e-01f, 7.814403772e-01f, 6.239799261e-01f, -7.174774408e-01f, -6.965817213e-01f,
  -5.885011554e-01f, 8.084963560e-01f, 3.274895847e-01f, 9.448547959e-01f, 7.676045895e-01f, 6.409237385e-01f, 9.244439602e-01f, 3.813178837e-01f,
  9.758974314e-01f, 2.182296216e-01f, 9.923570156e-01f, 1.233997419e-01f, 9.975810051e-01f, 6.951400638e-02f, 9.992348552e-01f, 3.911216930e-02f,
  9.997580051e-01f, 2.199822664e-02f, 9.999234676e-01f, 1.237119269e-02f, 9.999758005e-01f, 6.956954487e-03f, 9.999923706e-01f, 3.912204877e-03f,
  -5.328330398e-01f, -8.462204337e-01f, 9.332357645e-01f, 3.592645228e-01f, 5.486452579e-01f, 8.360552788e-01f, -5.829432607e-01f, -8.125128746e-01f,
  -6.662759781e-01f, 7.457052469e-01f, 2.738668323e-01f, 9.617676139e-01f, 7.469564080e-01f, 6.648730636e-01f, 9.175173044e-01f, 3.976959288e-01f,
  9.736663699e-01f, 2.279775143e-01f, 9.916474223e-01f, 1.289781928e-01f, 9.973561764e-01f, 7.266827673e-02f, 9.991636872e-01f, 4.088902473e-02f,
  9.997355342e-01f, 2.299797349e-02f, 9.999163747e-01f, 1.293348987e-02f, 9.999735355e-01f, 7.273174357e-03f, 9.999916553e-01f, 4.090031609e-03f,
  4.241790175e-01f, -9.055783749e-01f, 5.979771614e-01f, 8.015131354e-01f, 2.614416778e-01f, 9.652192593e-01f, -4.300232828e-01f, -9.028177857e-01f,
  -7.373937964e-01f, 6.754631400e-01f, 2.193782777e-01f, 9.756398797e-01f, 7.255613208e-01f, 6.881574988e-01f, 9.103004336e-01f, 4.139482081e-01f,
  9.713379741e-01f, 2.377026230e-01f, 9.909064770e-01f, 1.345525682e-01f, 9.971213937e-01f, 7.582182437e-02f, 9.990894198e-01f, 4.266574979e-02f,
  9.997119904e-01f, 2.399769612e-02f, 9.999089241e-01f, 1.349578146e-02f, 9.999712110e-01f, 7.589393295e-03f, 9.999908805e-01f, 4.267857410e-03f,
  9.912028313e-01f, -1.323517561e-01f, 7.855226099e-02f, 9.969099760e-01f, -5.168933049e-02f, 9.986631870e-01f, -2.635405958e-01f, -9.646483064e-01f,
  -8.011435866e-01f, 5.984721184e-01f, 1.641961634e-01f, 9.864277244e-01f, 7.034407258e-01f, 7.107539177e-01f, 9.027957320e-01f, 4.300695956e-01f,
  9.689124227e-01f, 2.474039644e-01f, 9.901341200e-01f, 1.401226968e-01f, 9.968766570e-01f, 7.897461206e-02f, 9.990119338e-01f, 4.444234073e-02f,
  9.996874928e-01f, 2.499739639e-02f, 9.999011755e-01f, 1.405806933e-02f, 9.999687672e-01f, 7.905611768e-03f, 9.999901056e-01f, 4.445684142e-03f,
  6.469193101e-01f, 7.625584602e-01f, -4.650644958e-01f, 8.852767944e-01f, -3.596943319e-01f, 9.330701828e-01f, -8.874550462e-02f, -9.960543513e-01f,
  -8.568888307e-01f, 5.155012608e-01f, 1.084949449e-01f, 9.940969944e-01f, 6.806167960e-01f, 7.326396108e-01f, 8.950055838e-01f, 4.460549951e-01f,
  9.663899541e-01f, 2.570805550e-01f, 9.893305302e-01f, 1.456883848e-01f, 9.966219068e-01f, 8.212661743e-02f, 9.989313483e-01f, 4.621879384e-02f,
  9.996620417e-01f, 2.599707060e-02f, 9.998931289e-01f, 1.462035347e-02f, 9.999662042e-01f, 8.221829310e-03f, 9.999893308e-01f, 4.623509943e-03f,
  -2.921388149e-01f, 9.563759565e-01f, -8.654506207e-01f, 5.009942055e-01f, -6.320286393e-01f, 7.749450207e-01f, 8.884811401e-02f, -9.960451722e-01f,
  -9.040721655e-01f, 4.273798466e-01f, 5.245061591e-02f, 9.986234903e-01f, 6.571123004e-01f, 7.537927032e-01f, 8.869323730e-01f, 4.618993104e-01f,
  9.637709260e-01f, 2.667314112e-01f, 9.884956479e-01f, 1.512494683e-01f, 9.963572025e-01f, 8.527779579e-02f, 9.988475442e-01f, 4.799510166e-02f,
  9.996355176e-01f, 2.699672058e-02f, 9.998847246e-01f, 1.518263202e-02f, 9.999635220e-01f, 8.538045920e-03f, 9.999884963e-01f, 4.801335745e-03f,
  -9.626058936e-01f, 2.709057927e-01f, -9.992933869e-01f, -3.758566082e-02f, -8.416849375e-01f, 5.399689674e-01f, 2.636395097e-01f, -9.646213055e-01f,
  -9.422222972e-01f, 3.349882066e-01f, -3.759419080e-03f, 9.999929070e-01f, 6.329506636e-01f, 7.741920948e-01f, 8.785787225e-01f, 4.775975943e-01f,
  9.610554576e-01f, 2.763556540e-01f, 9.876294732e-01f, 1.568057537e-01f, 9.960825443e-01f, 8.842811733e-02f, 9.987606406e-01f, 4.977125302e-02f,
  9.996080399e-01f, 2.799634263e-02f, 9.998760223e-01f, 1.574490592e-02f, 9.999607801e-01f, 8.854261599e-03f, 9.999876022e-01f, 4.979162011e-03f,
  -7.480575442e-01f, -6.636338830e-01f, -8.253716230e-01f, -5.645897985e-01f, -9.678714871e-01f, 2.514453232e-01f, 4.301158488e-01f, -9.027736783e-01f,
  -9.709581733e-01f, 2.392492294e-01f, -5.995756760e-02f, 9.982009530e-01f, 6.081562042e-01f, 7.938174009e-01f, 8.699471951e-01f, 4.931448400e-01f,
  9.582439065e-01f, 2.859522104e-01f, 9.867320657e-01f, 1.623570919e-01f, 9.957979321e-01f, 9.157756716e-02f, 9.986705780e-01f, 5.154724792e-02f,
  9.995795488e-01f, 2.899593674e-02f, 9.998670220e-01f, 1.630717516e-02f, 9.999579787e-01f, 9.170476347e-03f, 9.999867082e-01f, 5.156987347e-03f,
  1.542514563e-01f, -9.880316257e-01f, -3.972518742e-01f, -9.177096486e-01f, -9.980752468e-01f, -6.201484054e-02f, 5.830269456e-01f, -8.124528527e-01f,
  -9.899924994e-01f, 1.411200017e-01f, -1.159661636e-01f, 9.932531714e-01f, 5.827536583e-01f, 8.126488924e-01f, 8.610406518e-01f, 5.085361004e-01f,
  9.553365111e-01f, 2.955201864e-01f, 9.858034849e-01f, 1.679033041e-01f, 9.955033660e-01f, 9.472609311e-02f, 9.985772967e-01f, 5.332308263e-02f,
  9.995500445e-01f, 2.999550104e-02f, 9.998577237e-01f, 1.686943881e-02f, 9.999549985e-01f, 9.486690164e-03f, 9.999857545e-01f, 5.334813148e-03f,
  9.147423506e-01f, -4.040376544e-01f, 1.532154828e-01f, -9.881927967e-01f, -9.293003082e-01f, -3.693250120e-01f, 7.175492048e-01f, -6.965078115e-01f,
  -9.991351366e-01f, 4.158052057e-02f, -1.716081351e-01f, 9.851652980e-01f, 5.567683578e-01f, 8.306677938e-01f, 8.518617749e-01f, 5.237666368e-01f,
  9.523335695e-01f, 3.050586283e-01f, 9.848436713e-01f, 1.734442115e-01f, 9.951988459e-01f, 9.787366539e-02f, 9.984809160e-01f, 5.509874597e-02f,
  9.995195270e-01f, 3.099503554e-02f, 9.998480678e-01f, 1.743169688e-02f, 9.999519587e-01f, 9.802903049e-03f, 9.999848008e-01f, 5.512638018e-03f,
  8.342233896e-01f, 5.514267087e-01f, 6.564951539e-01f, -7.543302178e-01f, -7.683671117e-01f, -6.400094032e-01f, 8.294403553e-01f, -5.585952997e-01f,
  -9.982947707e-01f, -5.837419257e-02f, -2.267075777e-01f, 9.739628434e-01f, 5.302263498e-01f, 8.478561044e-01f, 8.424135447e-01f, 5.388315320e-01f,
  9.492354393e-01f, 3.145665526e-01f, 9.838528037e-01f, 1.789796203e-01f, 9.948843718e-01f, 1.010202691e-01f, 9.983813763e-01f, 5.687423423e-02f,
  9.994880557e-01f, 3.199454024e-02f, 9.998381138e-01f, 1.799395122e-02f, 9.999487996e-01f, 1.011911593e-02f, 9.999837875e-01f, 5.690463353e-03f,
  -1.327674743e-02f, 9.999118447e-01f, 9.575860500e-01f, -2.881473899e-01f, -5.312352777e-01f, -8.472243547e-01f, 9.151713848e-01f, -4.030649364e-01f,
  -9.874798059e-01f, -1.577456445e-01f, -2.810903192e-01f, 9.596813321e-01f, 5.031541586e-01f, 8.641966581e-01f, 8.326989412e-01f, 5.537260175e-01f,
  9.460423589e-01f, 3.240430057e-01f, 9.828307629e-01f, 1.845093668e-01f, 9.945599437e-01f, 1.041658595e-01f, 9.982786179e-01f, 5.864954367e-02f,
  9.994555712e-01f, 3.299400955e-02f, 9.998278022e-01f, 1.855619811e-02f, 9.999455214e-01f, 1.043532696e-02f, 9.999827743e-01f, 5.868288688e-03f,
  -8.485702872e-01f, 5.290827155e-01f, 9.637575150e-01f, 2.667797208e-01f, -2.414211184e-01f, -9.704204202e-01f, 9.720383286e-01f, -2.348221242e-01f,
  -9.667981863e-01f, -2.555412054e-01f, -3.345843852e-01f, 9.423658252e-01f, 4.755789042e-01f, 8.796730638e-01f, 8.227210045e-01f, 5.684453845e-01f,
  9.427546859e-01f, 3.334870934e-01f, 9.817776680e-01f, 1.900332868e-01f, 9.942255616e-01f, 1.073104069e-01f, 9.981727600e-01f, 6.042466685e-02f,
  9.994220734e-01f, 3.399345279e-02f, 9.998172522e-01f, 1.911843941e-02f, 9.999421835e-01f, 1.075153705e-02f, 9.999817014e-01f, 6.046113092e-03f,
  -9.036921859e-01f, -4.281826615e-01f, 6.731102467e-01f, 7.395421267e-01f, 7.233466953e-02f, -9.973804355e-01f, 9.982477427e-01f, -5.917267874e-02f,
  -9.364566803e-01f, -3.507832289e-01f, -3.870206773e-01f, 9.220710397e-01f, 4.475280643e-01f, 8.942698836e-01f, 8.124829531e-01f, 5.829849839e-01f,
  9.393727183e-01f, 3.428978026e-01f, 9.806935191e-01f, 1.955512017e-01f, 9.938812256e-01f, 1.104538813e-01f, 9.980637431e-01f, 6.219960377e-02f,
  9.993875623e-01f, 3.499285504e-02f, 9.998063445e-01f, 1.968067512e-02f, 9.999387264e-01f, 1.106774528e-02f, 9.999806285e-01f, 6.223937962e-03f,
  -1.279636919e-01f, -9.917788506e-01f, 1.751565337e-01f, 9.845405817e-01f, 3.789161742e-01f, -9.254310131e-01f, 9.929728508e-01f, 1.183425859e-01f,
  -8.967583776e-01f, -4.425205588e-01f, -4.382335544e-01f, 8.988611698e-01f, 4.190297425e-01f, 9.079725146e-01f, 8.019878864e-01f, 5.973402858e-01f,
  9.358968139e-01f, 3.522742093e-01f, 9.795783162e-01f, 2.010629177e-01f, 9.935269952e-01f, 1.135962531e-01f, 9.979515672e-01f, 6.397433579e-02f,
  9.993520975e-01f, 3.599222749e-02f, 9.997950792e-01f, 2.024290524e-02f, 9.999352098e-01f, 1.138395350e-02f, 9.999794960e-01f, 6.401761901e-03f,
  7.654140592e-01f, -6.435381174e-01f, -3.767423034e-01f, 9.263181090e-01f, 6.479216814e-01f, -7.617069483e-01f, 9.563800097e-01f, 2.921253741e-01f,
  -8.481000066e-01f, -5.298361778e-01f, -4.880608618e-01f, 8.728095889e-01f, 3.901124299e-01f, 9.207672477e-01f, 7.912392616e-01f, 6.115067005e-01f,
  9.323273301e-01f, 3.616154492e-01f, 9.784321785e-01f, 2.065682709e-01f, 9.931628108e-01f, 1.167374924e-01f, 9.978361726e-01f, 6.574887782e-02f,
  9.993155599e-01f, 3.699155897e-02f, 9.997835755e-01f, 2.080512606e-02f, 9.999315739e-01f, 1.170015987e-02f, 9.999783635e-01f, 6.579586305e-03f,
  9.550736547e-01f, 2.963685691e-01f, -8.126112223e-01f, 5.828061700e-01f, 8.526731133e-01f, -5.224447846e-01f, 8.896234632e-01f, 4.566946924e-01f,
  -7.909677625e-01f, -6.118578315e-01f, -5.363451838e-01f, 8.439987302e-01f, 3.608050346e-01f, 9.326412678e-01f, 7.802404165e-01f, 6.254796982e-01f,
  9.286646247e-01f, 3.709204793e-01f, 9.772551060e-01f, 2.120671123e-01f, 9.927886724e-01f, 1.198775545e-01f, 9.977176785e-01f, 6.752320379e-02f,
  9.992780685e-01f, 3.799085692e-02f, 9.997717142e-01f, 2.136734314e-02f, 9.999278188e-01f, 1.201636530e-02f, 9.999771714e-01f, 6.757410709e-03f,
  2.666429281e-01f, 9.637953639e-01f, -9.982103705e-01f, 5.980031565e-02f, 9.728653431e-01f, -2.313720137e-01f, 7.948083878e-01f, 6.068604589e-01f,
  -7.259322405e-01f, -6.877662539e-01f, -5.829339027e-01f, 8.125196099e-01f, 3.311368525e-01f, 9.435827136e-01f, 7.689949274e-01f, 6.392549276e-01f,
  9.249090552e-01f, 3.801884055e-01f, 9.760470986e-01f, 2.175592482e-01f, 9.924046397e-01f, 1.230164245e-01f, 9.975960255e-01f, 6.929731369e-02f,
  9.992396235e-01f, 3.899011388e-02f, 9.997594953e-01f, 2.192955278e-02f, 9.999239445e-01f, 1.233256981e-02f, 9.999759793e-01f, 6.935234182e-03f,
  -6.669380665e-01f, 7.451131344e-01f, -8.763794303e-01f, -4.816212952e-01f, 9.965789914e-01f, 8.264580369e-02f, 6.749256253e-01f, 7.378857136e-01f,
  -6.536436081e-01f, -7.568024993e-01f, -6.276797056e-01f, 7.784717083e-01f, 3.011375964e-01f, 9.535806775e-01f, 7.575061917e-01f, 6.528279781e-01f,
  9.210609794e-01f, 3.894183338e-01f, 9.748082757e-01f, 2.230444849e-01f, 9.920106530e-01f, 1.261540651e-01f, 9.974712729e-01f, 7.107120752e-02f,
  9.992001057e-01f, 3.998933733e-02f, 9.997470379e-01f, 2.249175683e-02f, 9.999200106e-01f, 1.264877338e-02f, 9.999747276e-01f, 7.113057654e-03f,
  -9.873392582e-01f, -1.586226672e-01f, -4.846394062e-01f, -8.747140169e-01f, 9.214623570e-01f, 3.884676993e-01f, 5.337560773e-01f, 8.456384540e-01f,
  -5.748240352e-01f, -8.182770610e-01f, -6.704410911e-01f, 7.419627905e-01f, 2.708370686e-01f, 9.626252055e-01f, 7.457779050e-01f, 6.661946774e-01f,
  9.171208143e-01f, 3.986093104e-01f, 9.735385776e-01f, 2.285226882e-01f, 9.916067719e-01f, 1.292904317e-01f, 9.973433018e-01f, 7.284487784e-02f,
  9.991596341e-01f, 4.098851606e-02f, 9.997342229e-01f, 2.305394970e-02f, 9.999159575e-01f, 1.296497509e-02f, 9.999734163e-01f, 7.290880661e-03f,
  -3.999853134e-01f, -9.165215492e-01f, 5.636094138e-02f, -9.984104633e-01f, 7.549653649e-01f, 6.557646990e-01f, 3.757521510e-01f, 9.267202020e-01f,
  -4.902605712e-01f, -8.715758920e-01f, -7.110829353e-01f, 7.031081319e-01f, 2.402658761e-01f, 9.707071185e-01f, 7.338138223e-01f, 6.793506742e-01f,
  9.130889177e-01f, 4.077604413e-01f, 9.722381234e-01f, 2.339936644e-01f, 9.911929369e-01f, 1.324255317e-01f, 9.972121716e-01f, 7.461831719e-02f,
  9.991181493e-01f, 4.198765755e-02f, 9.997211099e-01f, 2.361613885e-02f, 9.999117851e-01f, 1.328117587e-02f, 9.999721050e-01f, 7.468704134e-03f,
  5.551133156e-01f, -8.317747712e-01f, 5.800031424e-01f, -8.146142364e-01f, 5.135984421e-01f, 8.580306768e-01f, 2.058971673e-01f, 9.785736203e-01f,
  -4.007990062e-01f, -9.161660075e-01f, -7.494767308e-01f, 6.620306373e-01f, 2.094544172e-01f, 9.778184295e-01f, 7.216176391e-01f, 6.922917962e-01f,
  9.089657664e-01f, 4.168707728e-01f, 9.709069133e-01f, 2.394572198e-01f, 9.907692075e-01f, 1.355592906e-01f, 9.970778823e-01f, 7.639151812e-02f,
  9.990756512e-01f, 4.298675060e-02f, 9.997076392e-01f, 2.417832054e-02f, 9.999075532e-01f, 1.359737478e-02f, 9.999707937e-01f, 7.646527141e-03f,
  9.998432994e-01f, 1.770192571e-02f, 9.250146747e-01f, -3.799313903e-01f, 2.212981731e-01f, 9.752061963e-01f, 2.954781987e-02f, 9.995633960e-01f,
  -3.073327839e-01f, -9.516021013e-01f, -7.855011225e-01f, 6.188601851e-01f, 1.784335226e-01f, 9.839519858e-01f, 7.091933489e-01f, 7.050140500e-01f,
  9.047516584e-01f, 4.259394705e-01f, 9.695450068e-01f, 2.449132055e-01f, 9.903355837e-01f, 1.386916935e-01f, 9.969404936e-01f, 7.816448808e-02f,
  9.990321398e-01f, 4.398580641e-02f, 9.996939301e-01f, 2.474049293e-02f, 9.999032021e-01f, 1.391357277e-02f, 9.999693632e-01f, 7.824349217e-03f,
  5.253219604e-01f, 8.509035110e-01f, 9.851381779e-01f, 1.717635691e-01f, -9.294810891e-02f, 9.956709743e-01f, -1.477329880e-01f, 9.890272617e-01f,
  -2.107958049e-01f, -9.775301218e-01f, -8.190422058e-01f, 5.737332702e-01f, 1.472342163e-01f, 9.891016483e-01f, 6.965447664e-01f, 7.175133228e-01f,
  9.004471302e-01f, 4.349655211e-01f, 9.681524038e-01f, 2.503614724e-01f, 9.898920655e-01f, 1.418227106e-01f, 9.967998862e-01f, 7.993719727e-02f,
  9.989876747e-01f, 4.498481750e-02f, 9.996798635e-01f, 2.530265786e-02f, 9.998987317e-01f, 1.422976889e-02f, 9.999679923e-01f, 8.002171293e-03f,
  -4.321779311e-01f, 9.017883539e-01f, 7.418580055e-01f, 6.705570221e-01f, -3.979767561e-01f, 9.173954725e-01f, -3.203543723e-01f, 9.472977519e-01f,
  -1.121526212e-01f, -9.936909676e-01f, -8.499938846e-01f, 5.267925262e-01f, 1.158876941e-01f, 9.932623506e-01f, 6.836758852e-01f, 7.297857404e-01f,
  8.960524797e-01f, 4.439480901e-01f, 9.667292237e-01f, 2.558017969e-01f, 9.894386530e-01f, 1.449523121e-01f, 9.966561794e-01f, 8.170966059e-02f,
  9.989421964e-01f, 4.598378390e-02f, 9.996654391e-01f, 2.586481534e-02f, 9.998942018e-01f, 1.454596408e-02f, 9.999665618e-01f, 8.179994300e-03f,
  -9.923354983e-01f, 1.235731244e-01f, 2.700984478e-01f, 9.628326893e-01f, -6.635382771e-01f, 7.481423616e-01f, -4.828719497e-01f, 8.756909966e-01f,
  -1.238837745e-02f, -9.999232888e-01f, -8.782584071e-01f, 4.781863391e-01f, 8.442528546e-02f, 9.964298010e-01f, 6.705908775e-01f, 7.418274283e-01f,
  8.915683031e-01f, 4.528862834e-01f, 9.652754664e-01f, 2.612340748e-01f, 9.889753461e-01f, 1.480804533e-01f, 9.965093136e-01f, 8.348185569e-02f,
  9.988957047e-01f, 4.698270187e-02f, 9.996507764e-01f, 2.642696351e-02f, 9.998895526e-01f, 1.486215740e-02f, 9.999650717e-01f, 8.357816376e-03f,
  -6.401443481e-01f, -7.682546377e-01f, -2.848466039e-01f, 9.585731030e-01f, -8.632965088e-01f, 5.046970844e-01f, -6.301599741e-01f, 7.764653563e-01f,
  8.749917150e-02f, -9.961646199e-01f, -9.037463665e-01f, 4.280683994e-01f, 5.287845805e-02f, 9.986009598e-01f, 6.572937369e-01f, 7.536345124e-01f,
  8.869948983e-01f, 4.617791772e-01f, 9.637911916e-01f, 2.666580379e-01f, 9.885020852e-01f, 1.512071192e-01f, 9.963592887e-01f, 8.525379747e-02f,
  9.988481998e-01f, 4.798157141e-02f, 9.996357560e-01f, 2.698910423e-02f, 9.998847842e-01f, 1.517834887e-02f, 9.999635816e-01f, 8.535637520e-03f,
  3.005925417e-01f, -9.537526369e-01f, -7.520639896e-01f, 6.590901017e-01f, -9.774427414e-01f, 2.112006545e-01f, -7.575730681e-01f, 6.527503729e-01f,
  1.865124702e-01f, -9.824525714e-01f, -9.263771176e-01f, 3.765971363e-01f, 2.127875760e-02f, 9.997735620e-01f, 6.437888145e-01f, 7.652031779e-01f,
  8.823328614e-01f, 4.706258774e-01f, 9.622764587e-01f, 2.720735669e-01f, 9.880189896e-01f, 1.543322802e-01f, 9.962061048e-01f, 8.702547103e-02f,
  9.987997413e-01f, 4.898039624e-02f, 9.996203780e-01f, 2.755123749e-02f, 9.998799562e-01f, 1.549453940e-02f, 9.999620318e-01f, 8.713459596e-03f,
  9.649659991e-01f, -2.623748481e-01f, -9.876590967e-01f, 1.566190720e-01f, -9.946564436e-01f, -1.032404602e-01f, -8.610926867e-01f, 5.084479451e-01f,
  2.836622000e-01f, -9.589242935e-01f, -9.460792542e-01f, 3.239352703e-01f, -1.034221891e-02f, 9.999465346e-01f, 6.300802827e-01f, 7.765299678e-01f,
  8.775825500e-01f, 4.794255495e-01f, 9.607312679e-01f, 2.774805427e-01f, 9.875259995e-01f, 1.574558914e-01f, 9.960497618e-01f, 8.879686147e-02f,
  9.987502694e-01f, 4.997916892e-02f, 9.996047616e-01f, 2.811335959e-02f, 9.998750091e-01f, 1.581072807e-02f, 9.999604821e-01f, 8.891279809e-03f,
  7.421541810e-01f, 6.702291965e-01f, -9.190735221e-01f, -3.940860629e-01f, -9.132301211e-01f, -4.074441493e-01f, -9.374542236e-01f, 3.481085002e-01f,
  3.779776692e-01f, -9.258147478e-01f, -9.627903700e-01f, 2.702493370e-01f, -4.195285589e-02f, 9.991195798e-01f, 6.161724925e-01f, 7.876111865e-01f,
  8.727445006e-01f, 4.881772399e-01f, 9.591556787e-01f, 2.828786969e-01f, 9.870231748e-01f, 1.605779380e-01f, 9.958902597e-01f, 9.056797624e-02f,
  9.986997843e-01f, 5.097789690e-02f, 9.995887876e-01f, 2.867547423e-02f, 9.998699427e-01f, 1.612691768e-02f, 9.999588728e-01f, 9.069100954e-03f,
  -1.629907787e-01f, 9.866275787e-01f, -5.674300194e-01f, -8.234215975e-01f, -7.412399650e-01f, -6.712401509e-01f, -9.842484593e-01f, 1.767906845e-01f,
  4.685169160e-01f, -8.834545016e-01f, -9.764577150e-01f, 2.157090008e-01f, -7.352153957e-02f, 9.972936511e-01f, 6.020699143e-01f, 7.984433770e-01f,
  8.678191900e-01f, 4.968801141e-01f, 9.575498104e-01f, 2.882679403e-01f, 9.865104556e-01f, 1.636983752e-01f, 9.957276583e-01f, 9.233880043e-02f,
  9.986482859e-01f, 5.197656900e-02f, 9.995725155e-01f, 2.923758142e-02f, 9.998648167e-01f, 1.644310169e-02f, 9.999572635e-01f, 9.246920235e-03f,
  -9.182828069e-01f, 3.959251642e-01f, -4.102819040e-02f, -9.991579652e-01f, -4.957418144e-01f, -8.684699535e-01f, -1.000000000e+00f, -1.030206768e-04f,
  5.543745160e-01f, -8.322673440e-01f, -9.870380163e-01f, 1.604867280e-01f, -1.050167084e-01f, 9.944704771e-01f, 5.877769589e-01f, 8.090230227e-01f,
  8.628070951e-01f, 5.055333376e-01f, 9.559136033e-01f, 2.936480343e-01f, 9.859878421e-01f, 1.668171734e-01f, 9.955618382e-01f, 9.410934150e-02f,
  9.985958338e-01f, 5.297519267e-02f, 9.995558858e-01f, 2.979967557e-02f, 9.998595715e-01f, 1.675928757e-02f, 9.999555945e-01f, 9.424741380e-03f,
  -8.293098211e-01f, -5.587890744e-01f, 4.980095923e-01f, -8.671715260e-01f, -2.010796219e-01f, -9.795749187e-01f, -9.842120409e-01f, -1.769934744e-01f,
  6.346929669e-01f, -7.727644444e-01f, -9.944978952e-01f, 1.047568321e-01f, -1.364068687e-01f, 9.906529188e-01f, 5.732980371e-01f, 8.193469048e-01f,
  8.577086926e-01f, 5.141359568e-01f, 9.542471766e-01f, 2.990188897e-01f, 9.854553938e-01f, 1.699342877e-01f, 9.953929186e-01f, 9.587957710e-02f,
  9.985423684e-01f, 5.397376046e-02f, 9.995389581e-01f, 3.036176413e-02f, 9.998542070e-01f, 1.707546785e-02f, 9.999538660e-01f, 9.602561593e-03f,
  2.212675661e-02f, -9.997551441e-01f, 8.836693168e-01f, -4.681116641e-01f, 1.135217771e-01f, -9.935355186e-01f, -9.373825192e-01f, -3.483016491e-01f,
  7.086697817e-01f, -7.055402994e-01f, -9.988136292e-01f, 4.869600013e-02f, -1.676606387e-01f, 9.858447909e-01f, 5.586379170e-01f, 8.294116855e-01f,
  8.525245190e-01f, 5.226872563e-01f, 9.525505900e-01f, 3.043802381e-01f, 9.849131107e-01f, 1.730497181e-01f, 9.952208400e-01f, 9.764950722e-02f,
  9.984878898e-01f, 5.497227982e-02f, 9.995217323e-01f, 3.092384152e-02f, 9.998487830e-01f, 1.739165001e-02f, 9.999521971e-01f, 9.780380875e-03f,
  8.532201052e-01f, -5.215510130e-01f, 9.971746206e-01f, 7.511820644e-02f, 4.168670774e-01f, -9.089674354e-01f, -8.609884381e-01f, -5.086245537e-01f,
  7.755658031e-01f, -6.312667131e-01f, -9.999717474e-01f, -7.518785074e-03f, -1.987468749e-01f, 9.800508618e-01f, 5.438010693e-01f, 8.392141461e-01f,
  8.472551107e-01f, 5.311862230e-01f, 9.508239031e-01f, 3.097319603e-01f, 9.843609333e-01f, 1.761634201e-01f, 9.950456619e-01f, 9.941913933e-02f,
  9.984323978e-01f, 5.597073585e-02f, 9.995042086e-01f, 3.148590773e-02f, 9.998431802e-01f, 1.770782843e-02f, 9.999504089e-01f, 9.958200157e-03f,
  8.998668194e-01f, 4.361647666e-01f, 8.035690784e-01f, 5.952115059e-01f, 6.788702011e-01f, -7.342582941e-01f, -7.574391961e-01f, -6.529057026e-01f,
  8.347129226e-01f, -5.506852865e-01f, -9.979684949e-01f, -6.370979548e-02f, -2.296342701e-01f, 9.732769728e-01f, 5.287923217e-01f, 8.487512469e-01f,
  8.419010043e-01f, 5.396320224e-01f, 9.490671158e-01f, 3.150739372e-01f, 9.837989211e-01f, 1.792753637e-01f, 9.948672652e-01f, 1.011884511e-01f,
  9.983759522e-01f, 5.696914345e-02f, 9.994863272e-01f, 3.204796836e-02f, 9.998375773e-01f, 1.802400686e-02f, 9.999486208e-01f, 1.013601944e-02f,
  1.191801354e-01f, 9.928726554e-01f, 3.624766767e-01f, 9.319928288e-01f, 8.735505342e-01f, -4.867334962e-01f, -6.300007105e-01f, -7.765945792e-01f,
  8.855196238e-01f, -4.646020234e-01f, -9.928101897e-01f, -1.196993962e-01f, -2.602920532e-01f, 9.655299187e-01f, 5.136163235e-01f, 8.580200076e-01f,
  8.364626765e-01f, 5.480239391e-01f, 9.472803473e-01f, 3.204059005e-01f, 9.832270741e-01f, 1.823855042e-01f, 9.946857691e-01f, 1.029574350e-01f,
  9.983184934e-01f, 5.796748772e-02f, 9.994681478e-01f, 3.261001408e-02f, 9.998317957e-01f, 1.834018156e-02f, 9.999468327e-01f, 1.031383779e-02f,
  -7.710801959e-01f, 6.367380023e-01f, -1.902491003e-01f, 9.817358255e-01f, 9.816020727e-01f, -1.909380108e-01f, -4.826923311e-01f, -8.757900000e-01f,
  9.274784923e-01f, -3.738765717e-01f, -9.845131636e-01f, -1.753105819e-01f, -2.906895578e-01f, 9.568174481e-01f, 4.982779026e-01f, 8.670173883e-01f,
  8.309407234e-01f, 5.563610196e-01f, 9.454635978e-01f, 3.257277906e-01f, 9.826454520e-01f, 1.854938269e-01f, 9.945011139e-01f, 1.047261059e-01f,
  9.982600212e-01f, 5.896577984e-02f, 9.994496703e-01f, 3.317204863e-02f, 9.998259544e-01f, 1.865635626e-02f, 9.999449849e-01f, 1.049165614e-02f,
  -9.524129629e-01f, -3.048106134e-01f, -6.843819022e-01f, 7.291237116e-01f, 9.923083186e-01f, 1.237909496e-01f, -3.201591671e-01f, -9.473637342e-01f,
  9.601702690e-01f, -2.794154882e-01f, -9.731037021e-01f, -2.303675115e-01f, -3.207964003e-01f, 9.471482038e-01f, 4.827820361e-01f, 8.757405281e-01f,
  8.253356218e-01f, 5.646424294e-01f, 9.436169863e-01f, 3.310393095e-01f, 9.820539355e-01f, 1.886002868e-01f, 9.943132997e-01f, 1.064944416e-01f,
  9.982005358e-01f, 5.996400863e-02f, 9.994308352e-01f, 3.373407945e-02f, 9.998199940e-01f, 1.897252724e-02f, 9.999430776e-01f, 1.066947449e-02f,
  -2.581016421e-01f, -9.661177993e-01f, -9.677396417e-01f, 2.519522607e-01f, 9.046075940e-01f, 4.262454212e-01f, -1.475291997e-01f, -9.890577197e-01f,
  9.832684398e-01f, -1.821625978e-01f, -9.586178064e-01f, -2.846961617e-01f, -3.505824506e-01f, 9.365318418e-01f, 4.671334028e-01f, 8.841868639e-01f,
  8.196480274e-01f, 5.728674531e-01f, 9.417404532e-01f, 3.363404274e-01f, 9.814526439e-01f, 1.917048544e-01f, 9.941223264e-01f, 1.082624346e-01f,
  9.981400967e-01f, 6.096218154e-02f, 9.994117022e-01f, 3.429609165e-02f, 9.998139739e-01f, 1.928869821e-02f, 9.999411702e-01f, 1.084729191e-02f,
  6.735071540e-01f, -7.391806841e-01f, -9.530500174e-01f, -3.028128743e-01f, 7.271980643e-01f, 6.864276528e-01f, 2.975377068e-02f, -9.995572567e-01f,
  9.965420961e-01f, -8.308912069e-02f, -9.411013126e-01f, -3.381247520e-01f, -3.800179660e-01f, 9.249790907e-01f, 4.513370395e-01f, 8.923535347e-01f,
  8.138784766e-01f, 5.810351372e-01f, 9.398342371e-01f, 3.416308761e-01f, 9.808415174e-01f, 1.948075294e-01f, 9.939282537e-01f, 1.100300923e-01f,
  9.980786443e-01f, 6.196028739e-02f, 9.993922710e-01f, 3.485809639e-02f, 9.998078346e-01f, 1.960486546e-02f, 9.999392033e-01f, 1.102510840e-02f,
  9.858965874e-01f, 1.673557013e-01f, -6.448370218e-01f, -7.643200755e-01f, 4.776714444e-01f, 8.785385489e-01f, 2.060983330e-01f, -9.785313010e-01f,
  9.998586178e-01f, 1.681409031e-02f, -9.206095338e-01f, -3.904843926e-01f, -4.090735018e-01f, 9.125014544e-01f, 4.353979528e-01f, 9.002380967e-01f,
  8.080275059e-01f, 5.891447663e-01f, 9.378982186e-01f, 3.469105363e-01f, 9.802205563e-01f, 1.979082376e-01f, 9.937310219e-01f, 1.117973924e-01f,
  9.980161786e-01f, 6.295833737e-02f, 9.993724823e-01f, 3.542009369e-02f, 9.998015761e-01f, 1.992103085e-02f, 9.999372363e-01f, 1.120292582e-02f,
};
__device__ const float ROPE32[1024] = {
  1.000000000e+00f, 0.000000000e+00f, 1.000000000e+00f, 0.000000000e+00f, 1.000000000e+00f, 0.000000000e+00f, 1.000000000e+00f, 0.000000000e+00f,
  1.000000000e+00f, 0.000000000e+00f, 1.000000000e+00f, 0.000000000e+00f, 1.000000000e+00f, 0.000000000e+00f, 1.000000000e+00f, 0.000000000e+00f,
  5.403022766e-01f, 8.414709568e-01f, 9.504152536e-01f, 3.109835982e-01f, 9.950041771e-01f, 9.983342141e-02f, 9.995000362e-01f, 3.161750361e-02f,
  9.999499917e-01f, 9.999833070e-03f, 9.999949932e-01f, 3.162272274e-03f, 9.999995232e-01f, 9.999999311e-04f, 9.999999404e-01f, 3.162277571e-04f,
  -4.161468446e-01f, 9.092974067e-01f, 8.065783978e-01f, 5.911270976e-01f, 9.800665975e-01f, 1.986693293e-01f, 9.980006814e-01f, 6.320339441e-02f,
  9.998000264e-01f, 1.999866590e-02f, 9.999799728e-01f, 6.324512884e-03f, 9.999979734e-01f, 1.999998698e-03f, 9.999998212e-01f, 6.324554561e-04f,
  -9.899924994e-01f, 1.411200017e-01f, 5.827536583e-01f, 8.126488924e-01f, 9.553365111e-01f, 2.955202162e-01f, 9.955033660e-01f, 9.472608566e-02f,
  9.995500445e-01f, 2.999549918e-02f, 9.999549985e-01f, 9.486690164e-03f, 9.999955297e-01f, 2.999995602e-03f, 9.999995232e-01f, 9.486831259e-04f,
  -6.536436081e-01f, -7.568024993e-01f, 3.011374772e-01f, 9.535807371e-01f, 9.210609794e-01f, 3.894183338e-01f, 9.920106530e-01f, 1.261540651e-01f,
  9.992001057e-01f, 3.998933360e-02f, 9.999200106e-01f, 1.264877338e-02f, 9.999920130e-01f, 3.999989480e-03f, 9.999992251e-01f, 1.264910679e-03f,
  2.836622000e-01f, -9.589242935e-01f, -1.034233812e-02f, 9.999465346e-01f, 8.775825500e-01f, 4.794255495e-01f, 9.875259995e-01f, 1.574558765e-01f,
  9.987502694e-01f, 4.997916520e-02f, 9.998750091e-01f, 1.581072807e-02f, 9.999874830e-01f, 4.999979399e-03f, 9.999987483e-01f, 1.581138116e-03f,
  9.601702690e-01f, -2.794154882e-01f, -3.207964003e-01f, 9.471482038e-01f, 8.253356218e-01f, 5.646424890e-01f, 9.820539355e-01f, 1.886002719e-01f,
  9.982005358e-01f, 5.996400490e-02f, 9.998199940e-01f, 1.897252724e-02f, 9.999819994e-01f, 5.999964196e-03f, 9.999982119e-01f, 1.897365320e-03f,
  7.539022565e-01f, 6.569865942e-01f, -5.994374752e-01f, 8.004215956e-01f, 7.648422122e-01f, 6.442176700e-01f, 9.755998850e-01f, 2.195560932e-01f,
  9.975510240e-01f, 6.994284689e-02f, 9.997550249e-01f, 2.213413455e-02f, 9.999755025e-01f, 6.999942940e-03f, 9.999975562e-01f, 2.213592408e-03f,
  -1.455000341e-01f, 9.893582463e-01f, -8.186324239e-01f, 5.743177533e-01f, 6.967067122e-01f, 7.173560858e-01f, 9.681702852e-01f, 2.502923310e-01f,
  9.968017340e-01f, 7.991468906e-02f, 9.996800423e-01f, 2.529552206e-02f, 9.999679923e-01f, 7.999914698e-03f, 9.999967813e-01f, 2.529819263e-03f,
  -9.111302495e-01f, 4.121184945e-01f, -9.566441774e-01f, 2.912592292e-01f, 6.216099262e-01f, 7.833269238e-01f, 9.597726464e-01f, 2.807783186e-01f,
  9.959527254e-01f, 8.987854421e-02f, 9.995950460e-01f, 2.845665626e-02f, 9.999595284e-01f, 8.999879472e-03f, 9.999959469e-01f, 2.846045885e-03f,
  -8.390715122e-01f, -5.440211296e-01f, -9.997860789e-01f, -2.068356983e-02f, 5.403022766e-01f, 8.414709568e-01f, 9.504153132e-01f, 3.109835684e-01f,
  9.950041771e-01f, 9.983341396e-02f, 9.995000362e-01f, 3.161750361e-02f, 9.999499917e-01f, 9.999834001e-03f, 9.999949932e-01f, 3.162272274e-03f,
  4.425697960e-03f, -9.999902248e-01f, -9.437797666e-01f, -3.305749595e-01f, 4.535960853e-01f, 8.912073970e-01f, 9.401075840e-01f, 3.408778608e-01f,
  9.939560890e-01f, 1.097782999e-01f, 9.993950725e-01f, 3.477803990e-02f, 9.999395013e-01f, 1.099977922e-02f, 9.999939203e-01f, 3.478498431e-03f,
  8.438539505e-01f, -5.365729332e-01f, -7.941793799e-01f, -6.076834202e-01f, 3.623577058e-01f, 9.320390821e-01f, 9.288598895e-01f, 3.704313040e-01f,
  9.928086400e-01f, 1.197122037e-01f, 9.992800951e-01f, 3.793822229e-02f, 9.999279976e-01f, 1.199971233e-02f, 9.999927878e-01f, 3.794723889e-03f,
  9.074468017e-01f, 4.201670289e-01f, -5.658205152e-01f, -8.245284557e-01f, 2.674987614e-01f, 9.635581970e-01f, 9.166833758e-01f, 3.996143043e-01f,
  9.915618896e-01f, 1.296341419e-01f, 9.991551042e-01f, 4.109803215e-02f, 9.999154806e-01f, 1.299963426e-02f, 9.999915361e-01f, 4.110949114e-03f,
  1.367372125e-01f, 9.906073809e-01f, -2.813494802e-01f, -9.596053958e-01f, 1.699671596e-01f, 9.854497313e-01f, 9.035902619e-01f, 4.283977747e-01f,
  9.902160168e-01f, 1.395431161e-01f, 9.990201592e-01f, 4.425742477e-02f, 9.999020100e-01f, 1.399954315e-02f, 9.999902248e-01f, 4.427174106e-03f,
  -7.596879005e-01f, 6.502878666e-01f, 3.102235124e-02f, -9.995186925e-01f, 7.073719800e-02f, 9.974949956e-01f, 8.895936012e-01f, 4.567528665e-01f,
  9.887710810e-01f, 1.494381279e-01f, 9.988752007e-01f, 4.741638154e-02f, 9.998875260e-01f, 1.499943808e-02f, 9.999887347e-01f, 4.743398633e-03f,
  -9.576594830e-01f, -2.879033089e-01f, 3.403181732e-01f, -9.403103590e-01f, -2.919954620e-02f, 9.995735884e-01f, 8.747074604e-01f, 4.846512377e-01f,
  9.872272611e-01f, 1.593182087e-01f, 9.987202883e-01f, 5.057485774e-02f, 9.998720288e-01f, 1.599931903e-02f, 9.999871850e-01f, 5.059622694e-03f,
  -2.751633525e-01f, -9.613974690e-01f, 6.158648133e-01f, -7.878518701e-01f, -1.288445443e-01f, 9.916648269e-01f, 8.589466810e-01f, 5.120649934e-01f,
  9.855847955e-01f, 1.691823453e-01f, 9.985553622e-01f, 5.373282731e-02f, 9.998555183e-01f, 1.699918136e-02f, 9.999855757e-01f, 5.375845823e-03f,
  6.603167057e-01f, -7.509872317e-01f, 8.303361535e-01f, -5.572628975e-01f, -2.272021621e-01f, 9.738476276e-01f, 8.423270583e-01f, 5.389667153e-01f,
  9.838436842e-01f, 1.790295690e-01f, 9.983804226e-01f, 5.689026415e-02f, 9.998379946e-01f, 1.799902879e-02f, 9.999837875e-01f, 5.692068953e-03f,
  9.887046218e-01f, 1.498772055e-01f, 9.624637961e-01f, -2.714101076e-01f, -3.232895434e-01f, 9.463000894e-01f, 8.248651624e-01f, 5.653295517e-01f,
  9.820042253e-01f, 1.888588965e-01f, 9.981955290e-01f, 6.004713103e-02f, 9.998195171e-01f, 1.899885759e-02f, 9.999819398e-01f, 6.008291151e-03f,
  4.080820680e-01f, 9.129452705e-01f, 9.991443753e-01f, 4.135828838e-02f, -4.161468446e-01f, 9.092974067e-01f, 8.065784574e-01f, 5.911270380e-01f,
  9.800665975e-01f, 1.986693144e-01f, 9.980006814e-01f, 6.320339441e-02f, 9.998000264e-01f, 1.999866776e-02f, 9.999799728e-01f, 6.324512884e-03f,
  -5.477292538e-01f, 8.366556168e-01f, 9.367404580e-01f, 3.500247598e-01f, -5.048462152e-01f, 8.632093072e-01f, 7.874851823e-01f, 6.163335443e-01f,
  9.780309200e-01f, 2.084598988e-01f, 9.977958202e-01f, 6.635902822e-02f, 9.997795224e-01f, 2.099845745e-02f, 9.999779463e-01f, 6.640734151e-03f,
  -9.999608397e-01f, -8.851309307e-03f, 7.814403772e-01f, 6.239799261e-01f, -5.885011554e-01f, 8.084963560e-01f, 7.676045895e-01f, 6.409237385e-01f,
  9.758974314e-01f, 2.182296216e-01f, 9.975810051e-01f, 6.951400638e-02f, 9.997580051e-01f, 2.199822664e-02f, 9.999758005e-01f, 6.956954487e-03f,
  -5.328330398e-01f, -8.462204337e-01f, 5.486452579e-01f, 8.360552788e-01f, -6.662759781e-01f, 7.457052469e-01f, 7.469564080e-01f, 6.648730636e-01f,
  9.736663699e-01f, 2.279775143e-01f, 9.973561764e-01f, 7.266827673e-02f, 9.997355342e-01f, 2.299797349e-02f, 9.999735355e-01f, 7.273174357e-03f,
  4.241790175e-01f, -9.055783749e-01f, 2.614416778e-01f, 9.652192593e-01f, -7.373937964e-01f, 6.754631400e-01f, 7.255613208e-01f, 6.881574988e-01f,
  9.713379741e-01f, 2.377026230e-01f, 9.971213937e-01f, 7.582182437e-02f, 9.997119904e-01f, 2.399769612e-02f, 9.999712110e-01f, 7.589393295e-03f,
  9.912028313e-01f, -1.323517561e-01f, -5.168933049e-02f, 9.986631870e-01f, -8.011435866e-01f, 5.984721184e-01f, 7.034407258e-01f, 7.107539177e-01f,
  9.689124227e-01f, 2.474039644e-01f, 9.968766570e-01f, 7.897461206e-02f, 9.996874928e-01f, 2.499739639e-02f, 9.999687672e-01f, 7.905611768e-03f,
  6.469193101e-01f, 7.625584602e-01f, -3.596943319e-01f, 9.330701828e-01f, -8.568888307e-01f, 5.155012608e-01f, 6.806167960e-01f, 7.326396108e-01f,
  9.663899541e-01f, 2.570805550e-01f, 9.966219068e-01f, 8.212661743e-02f, 9.996620417e-01f, 2.599707060e-02f, 9.999662042e-01f, 8.221829310e-03f,
  -2.921388149e-01f, 9.563759565e-01f, -6.320286393e-01f, 7.749450207e-01f, -9.040721655e-01f, 4.273798466e-01f, 6.571123004e-01f, 7.537927032e-01f,
  9.637709260e-01f, 2.667314112e-01f, 9.963572025e-01f, 8.527779579e-02f, 9.996355176e-01f, 2.699672058e-02f, 9.999635220e-01f, 8.538045920e-03f,
  -9.626058936e-01f, 2.709057927e-01f, -8.416849375e-01f, 5.399689674e-01f, -9.422222972e-01f, 3.349882066e-01f, 6.329506636e-01f, 7.741920948e-01f,
  9.610554576e-01f, 2.763556540e-01f, 9.960825443e-01f, 8.842811733e-02f, 9.996080399e-01f, 2.799634263e-02f, 9.999607801e-01f, 8.854261599e-03f,
  -7.480575442e-01f, -6.636338830e-01f, -9.678714871e-01f, 2.514453232e-01f, -9.709581733e-01f, 2.392492294e-01f, 6.081562042e-01f, 7.938174009e-01f,
  9.582439065e-01f, 2.859522104e-01f, 9.957979321e-01f, 9.157756716e-02f, 9.995795488e-01f, 2.899593674e-02f, 9.999579787e-01f, 9.170476347e-03f,
  1.542514563e-01f, -9.880316257e-01f, -9.980752468e-01f, -6.201484054e-02f, -9.899924994e-01f, 1.411200017e-01f, 5.827536583e-01f, 8.126488924e-01f,
  9.553365111e-01f, 2.955201864e-01f, 9.955033660e-01f, 9.472609311e-02f, 9.995500445e-01f, 2.999550104e-02f, 9.999549985e-01f, 9.486690164e-03f,
  9.147423506e-01f, -4.040376544e-01f, -9.293003082e-01f, -3.693250120e-01f, -9.991351366e-01f, 4.158052057e-02f, 5.567683578e-01f, 8.306677938e-01f,
  9.523335695e-01f, 3.050586283e-01f, 9.951988459e-01f, 9.787366539e-02f, 9.995195270e-01f, 3.099503554e-02f, 9.999519587e-01f, 9.802903049e-03f,
  8.342233896e-01f, 5.514267087e-01f, -7.683671117e-01f, -6.400094032e-01f, -9.982947707e-01f, -5.837419257e-02f, 5.302263498e-01f, 8.478561044e-01f,
  9.492354393e-01f, 3.145665526e-01f, 9.948843718e-01f, 1.010202691e-01f, 9.994880557e-01f, 3.199454024e-02f, 9.999487996e-01f, 1.011911593e-02f,
  -1.327674743e-02f, 9.999118447e-01f, -5.312352777e-01f, -8.472243547e-01f, -9.874798059e-01f, -1.577456445e-01f, 5.031541586e-01f, 8.641966581e-01f,
  9.460423589e-01f, 3.240430057e-01f, 9.945599437e-01f, 1.041658595e-01f, 9.994555712e-01f, 3.299400955e-02f, 9.999455214e-01f, 1.043532696e-02f,
  -8.485702872e-01f, 5.290827155e-01f, -2.414211184e-01f, -9.704204202e-01f, -9.667981863e-01f, -2.555412054e-01f, 4.755789042e-01f, 8.796730638e-01f,
  9.427546859e-01f, 3.334870934e-01f, 9.942255616e-01f, 1.073104069e-01f, 9.994220734e-01f, 3.399345279e-02f, 9.999421835e-01f, 1.075153705e-02f,
  -9.036921859e-01f, -4.281826615e-01f, 7.233466953e-02f, -9.973804355e-01f, -9.364566803e-01f, -3.507832289e-01f, 4.475280643e-01f, 8.942698836e-01f,
  9.393727183e-01f, 3.428978026e-01f, 9.938812256e-01f, 1.104538813e-01f, 9.993875623e-01f, 3.499285504e-02f, 9.999387264e-01f, 1.106774528e-02f,
  -1.279636919e-01f, -9.917788506e-01f, 3.789161742e-01f, -9.254310131e-01f, -8.967583776e-01f, -4.425205588e-01f, 4.190297425e-01f, 9.079725146e-01f,
  9.358968139e-01f, 3.522742093e-01f, 9.935269952e-01f, 1.135962531e-01f, 9.993520975e-01f, 3.599222749e-02f, 9.999352098e-01f, 1.138395350e-02f,
  7.654140592e-01f, -6.435381174e-01f, 6.479216814e-01f, -7.617069483e-01f, -8.481000066e-01f, -5.298361778e-01f, 3.901124299e-01f, 9.207672477e-01f,
  9.323273301e-01f, 3.616154492e-01f, 9.931628108e-01f, 1.167374924e-01f, 9.993155599e-01f, 3.699155897e-02f, 9.999315739e-01f, 1.170015987e-02f,
  9.550736547e-01f, 2.963685691e-01f, 8.526731133e-01f, -5.224447846e-01f, -7.909677625e-01f, -6.118578315e-01f, 3.608050346e-01f, 9.326412678e-01f,
  9.286646247e-01f, 3.709204793e-01f, 9.927886724e-01f, 1.198775545e-01f, 9.992780685e-01f, 3.799085692e-02f, 9.999278188e-01f, 1.201636530e-02f,
  2.666429281e-01f, 9.637953639e-01f, 9.728653431e-01f, -2.313720137e-01f, -7.259322405e-01f, -6.877662539e-01f, 3.311368525e-01f, 9.435827136e-01f,
  9.249090552e-01f, 3.801884055e-01f, 9.924046397e-01f, 1.230164245e-01f, 9.992396235e-01f, 3.899011388e-02f, 9.999239445e-01f, 1.233256981e-02f,
  -6.669380665e-01f, 7.451131344e-01f, 9.965789914e-01f, 8.264580369e-02f, -6.536436081e-01f, -7.568024993e-01f, 3.011375964e-01f, 9.535806775e-01f,
  9.210609794e-01f, 3.894183338e-01f, 9.920106530e-01f, 1.261540651e-01f, 9.992001057e-01f, 3.998933733e-02f, 9.999200106e-01f, 1.264877338e-02f,
  -9.873392582e-01f, -1.586226672e-01f, 9.214623570e-01f, 3.884676993e-01f, -5.748240352e-01f, -8.182770610e-01f, 2.708370686e-01f, 9.626252055e-01f,
  9.171208143e-01f, 3.986093104e-01f, 9.916067719e-01f, 1.292904317e-01f, 9.991596341e-01f, 4.098851606e-02f, 9.999159575e-01f, 1.296497509e-02f,
  -3.999853134e-01f, -9.165215492e-01f, 7.549653649e-01f, 6.557646990e-01f, -4.902605712e-01f, -8.715758920e-01f, 2.402658761e-01f, 9.707071185e-01f,
  9.130889177e-01f, 4.077604413e-01f, 9.911929369e-01f, 1.324255317e-01f, 9.991181493e-01f, 4.198765755e-02f, 9.999117851e-01f, 1.328117587e-02f,
  5.551133156e-01f, -8.317747712e-01f, 5.135984421e-01f, 8.580306768e-01f, -4.007990062e-01f, -9.161660075e-01f, 2.094544172e-01f, 9.778184295e-01f,
  9.089657664e-01f, 4.168707728e-01f, 9.907692075e-01f, 1.355592906e-01f, 9.990756512e-01f, 4.298675060e-02f, 9.999075532e-01f, 1.359737478e-02f,
  9.998432994e-01f, 1.770192571e-02f, 2.212981731e-01f, 9.752061963e-01f, -3.073327839e-01f, -9.516021013e-01f, 1.784335226e-01f, 9.839519858e-01f,
  9.047516584e-01f, 4.259394705e-01f, 9.903355837e-01f, 1.386916935e-01f, 9.990321398e-01f, 4.398580641e-02f, 9.999032021e-01f, 1.391357277e-02f,
  5.253219604e-01f, 8.509035110e-01f, -9.294810891e-02f, 9.956709743e-01f, -2.107958049e-01f, -9.775301218e-01f, 1.472342163e-01f, 9.891016483e-01f,
  9.004471302e-01f, 4.349655211e-01f, 9.898920655e-01f, 1.418227106e-01f, 9.989876747e-01f, 4.498481750e-02f, 9.998987317e-01f, 1.422976889e-02f,
  -4.321779311e-01f, 9.017883539e-01f, -3.979767561e-01f, 9.173954725e-01f, -1.121526212e-01f, -9.936909676e-01f, 1.158876941e-01f, 9.932623506e-01f,
  8.960524797e-01f, 4.439480901e-01f, 9.894386530e-01f, 1.449523121e-01f, 9.989421964e-01f, 4.598378390e-02f, 9.998942018e-01f, 1.454596408e-02f,
  -9.923354983e-01f, 1.235731244e-01f, -6.635382771e-01f, 7.481423616e-01f, -1.238837745e-02f, -9.999232888e-01f, 8.442528546e-02f, 9.964298010e-01f,
  8.915683031e-01f, 4.528862834e-01f, 9.889753461e-01f, 1.480804533e-01f, 9.988957047e-01f, 4.698270187e-02f, 9.998895526e-01f, 1.486215740e-02f,
  -6.401443481e-01f, -7.682546377e-01f, -8.632965088e-01f, 5.046970844e-01f, 8.749917150e-02f, -9.961646199e-01f, 5.287845805e-02f, 9.986009598e-01f,
  8.869948983e-01f, 4.617791772e-01f, 9.885020852e-01f, 1.512071192e-01f, 9.988481998e-01f, 4.798157141e-02f, 9.998847842e-01f, 1.517834887e-02f,
  3.005925417e-01f, -9.537526369e-01f, -9.774427414e-01f, 2.112006545e-01f, 1.865124702e-01f, -9.824525714e-01f, 2.127875760e-02f, 9.997735620e-01f,
  8.823328614e-01f, 4.706258774e-01f, 9.880189896e-01f, 1.543322802e-01f, 9.987997413e-01f, 4.898039624e-02f, 9.998799562e-01f, 1.549453940e-02f,
  9.649659991e-01f, -2.623748481e-01f, -9.946564436e-01f, -1.032404602e-01f, 2.836622000e-01f, -9.589242935e-01f, -1.034221891e-02f, 9.999465346e-01f,
  8.775825500e-01f, 4.794255495e-01f, 9.875259995e-01f, 1.574558914e-01f, 9.987502694e-01f, 4.997916892e-02f, 9.998750091e-01f, 1.581072807e-02f,
  7.421541810e-01f, 6.702291965e-01f, -9.132301211e-01f, -4.074441493e-01f, 3.779776692e-01f, -9.258147478e-01f, -4.195285589e-02f, 9.991195798e-01f,
  8.727445006e-01f, 4.881772399e-01f, 9.870231748e-01f, 1.605779380e-01f, 9.986997843e-01f, 5.097789690e-02f, 9.998699427e-01f, 1.612691768e-02f,
  -1.629907787e-01f, 9.866275787e-01f, -7.412399650e-01f, -6.712401509e-01f, 4.685169160e-01f, -8.834545016e-01f, -7.352153957e-02f, 9.972936511e-01f,
  8.678191900e-01f, 4.968801141e-01f, 9.865104556e-01f, 1.636983752e-01f, 9.986482859e-01f, 5.197656900e-02f, 9.998648167e-01f, 1.644310169e-02f,
  -9.182828069e-01f, 3.959251642e-01f, -4.957418144e-01f, -8.684699535e-01f, 5.543745160e-01f, -8.322673440e-01f, -1.050167084e-01f, 9.944704771e-01f,
  8.628070951e-01f, 5.055333376e-01f, 9.859878421e-01f, 1.668171734e-01f, 9.985958338e-01f, 5.297519267e-02f, 9.998595715e-01f, 1.675928757e-02f,
  -8.293098211e-01f, -5.587890744e-01f, -2.010796219e-01f, -9.795749187e-01f, 6.346929669e-01f, -7.727644444e-01f, -1.364068687e-01f, 9.906529188e-01f,
  8.577086926e-01f, 5.141359568e-01f, 9.854553938e-01f, 1.699342877e-01f, 9.985423684e-01f, 5.397376046e-02f, 9.998542070e-01f, 1.707546785e-02f,
  2.212675661e-02f, -9.997551441e-01f, 1.135217771e-01f, -9.935355186e-01f, 7.086697817e-01f, -7.055402994e-01f, -1.676606387e-01f, 9.858447909e-01f,
  8.525245190e-01f, 5.226872563e-01f, 9.849131107e-01f, 1.730497181e-01f, 9.984878898e-01f, 5.497227982e-02f, 9.998487830e-01f, 1.739165001e-02f,
  8.532201052e-01f, -5.215510130e-01f, 4.168670774e-01f, -9.089674354e-01f, 7.755658031e-01f, -6.312667131e-01f, -1.987468749e-01f, 9.800508618e-01f,
  8.472551107e-01f, 5.311862230e-01f, 9.843609333e-01f, 1.761634201e-01f, 9.984323978e-01f, 5.597073585e-02f, 9.998431802e-01f, 1.770782843e-02f,
  8.998668194e-01f, 4.361647666e-01f, 6.788702011e-01f, -7.342582941e-01f, 8.347129226e-01f, -5.506852865e-01f, -2.296342701e-01f, 9.732769728e-01f,
  8.419010043e-01f, 5.396320224e-01f, 9.837989211e-01f, 1.792753637e-01f, 9.983759522e-01f, 5.696914345e-02f, 9.998375773e-01f, 1.802400686e-02f,
  1.191801354e-01f, 9.928726554e-01f, 8.735505342e-01f, -4.867334962e-01f, 8.855196238e-01f, -4.646020234e-01f, -2.602920532e-01f, 9.655299187e-01f,
  8.364626765e-01f, 5.480239391e-01f, 9.832270741e-01f, 1.823855042e-01f, 9.983184934e-01f, 5.796748772e-02f, 9.998317957e-01f, 1.834018156e-02f,
  -7.710801959e-01f, 6.367380023e-01f, 9.816020727e-01f, -1.909380108e-01f, 9.274784923e-01f, -3.738765717e-01f, -2.906895578e-01f, 9.568174481e-01f,
  8.309407234e-01f, 5.563610196e-01f, 9.826454520e-01f, 1.854938269e-01f, 9.982600212e-01f, 5.896577984e-02f, 9.998259544e-01f, 1.865635626e-02f,
  -9.524129629e-01f, -3.048106134e-01f, 9.923083186e-01f, 1.237909496e-01f, 9.601702690e-01f, -2.794154882e-01f, -3.207964003e-01f, 9.471482038e-01f,
  8.253356218e-01f, 5.646424294e-01f, 9.820539355e-01f, 1.886002868e-01f, 9.982005358e-01f, 5.996400863e-02f, 9.998199940e-01f, 1.897252724e-02f,
  -2.581016421e-01f, -9.661177993e-01f, 9.046075940e-01f, 4.262454212e-01f, 9.832684398e-01f, -1.821625978e-01f, -3.505824506e-01f, 9.365318418e-01f,
  8.196480274e-01f, 5.728674531e-01f, 9.814526439e-01f, 1.917048544e-01f, 9.981400967e-01f, 6.096218154e-02f, 9.998139739e-01f, 1.928869821e-02f,
  6.735071540e-01f, -7.391806841e-01f, 7.271980643e-01f, 6.864276528e-01f, 9.965420961e-01f, -8.308912069e-02f, -3.800179660e-01f, 9.249790907e-01f,
  8.138784766e-01f, 5.810351372e-01f, 9.808415174e-01f, 1.948075294e-01f, 9.980786443e-01f, 6.196028739e-02f, 9.998078346e-01f, 1.960486546e-02f,
  9.858965874e-01f, 1.673557013e-01f, 4.776714444e-01f, 8.785385489e-01f, 9.998586178e-01f, 1.681409031e-02f, -4.090735018e-01f, 9.125014544e-01f,
  8.080275059e-01f, 5.891447663e-01f, 9.802205563e-01f, 1.979082376e-01f, 9.980161786e-01f, 6.295833737e-02f, 9.998015761e-01f, 1.992103085e-02f,
};
#define XB_TMO      128
#define XB_XCNT(j)  (256  + 64 * (j))
#define XB_XSUB(j)  (1280 + 64 * (j))
#define XB_XGEN(j)  (2304 + 64 * (j))
#define XB_TOP      3328
#define XB_TOPGEN   3392
#define XCD_BAR_WORDS 3456
#define XB_SPIN_CAP (1u << 18)
#define LAS __attribute__((address_space(3)))

__device__ __forceinline__ unsigned xb_ld(unsigned* p)              { return __hip_atomic_load(p, __ATOMIC_RELAXED, __HIP_MEMORY_SCOPE_AGENT); }
__device__ __forceinline__ unsigned xb_add(unsigned* p, unsigned v) { return __hip_atomic_fetch_add(p, v, __ATOMIC_RELAXED, __HIP_MEMORY_SCOPE_AGENT); }
__device__ __forceinline__ unsigned xb_xcc_id() { return (unsigned)__builtin_amdgcn_s_getreg((3 << 11) | 20) & 0xFu; }
#define XB_SPIN(cond, bar) do { unsigned _sp = 0; while (cond) { __builtin_amdgcn_s_sleep(1); \
    if ((++_sp & 255u) == 0u) { if (xb_ld(&(bar)[XB_TMO])) break; if (_sp > XB_SPIN_CAP) { atomicAdd(&(bar)[XB_TMO], 1u); break; } } } } while (0)

struct XcdBarrier {
    unsigned* bar; unsigned x;
    volatile LAS unsigned* st;
};

__device__ __forceinline__ XcdBarrier xcd_barrier_post(unsigned* bar, volatile LAS unsigned* st) {
    XcdBarrier b; b.bar = bar; b.x = xb_xcc_id(); b.st = st;
    if (threadIdx.x == 0) (void)xb_add(&bar[XB_XCNT(b.x)], 1u);
    return b;
}
__device__ __forceinline__ void xcd_barrier_complete(unsigned* bar, unsigned x, unsigned& nloc, unsigned& nx) {
    const unsigned G = gridDim.x * gridDim.y * gridDim.z;
    unsigned sum, cnt, mine, sp = 0u;
    for (;;) {
        sum = 0u; cnt = 0u; mine = 0u;
#pragma unroll
        for (unsigned j = 0; j < 16; ++j) { const unsigned c = xb_ld(&bar[XB_XCNT(j)]); sum += c; cnt += (c > 0u) ? 1u : 0u; mine = (j == x) ? c : mine; }
        if (sum == G) break;
        __builtin_amdgcn_s_sleep(1);
        if ((++sp & 255u) == 0u) { if (xb_ld(&bar[XB_TMO])) break; if (sp > XB_SPIN_CAP) { atomicAdd(&bar[XB_TMO], 1u); break; } }
    }
    nloc = mine > 0u ? mine : 1u; nx = cnt > 0u ? cnt : 1u;
}

__device__ __forceinline__ void xcd_barrier(const XcdBarrier& b, const bool t0  ) {
    asm volatile("s_waitcnt vmcnt(0)" ::: "memory");
    __syncthreads();
    if (t0) {
        unsigned* bar = b.bar;
        __builtin_amdgcn_s_waitcnt(0);
        unsigned nloc = b.st[0], nx = b.st[1];
        if (nloc == 0u) { xcd_barrier_complete(bar, b.x, nloc, nx); b.st[0] = nloc; b.st[1] = nx; }
        const unsigned old = xb_add(&bar[XB_XSUB(b.x)], 1u);
        const unsigned gen = old / nloc;
        if (old + 1u == (gen + 1u) * nloc) {
            __builtin_amdgcn_fence(__ATOMIC_RELEASE, "agent");
            asm volatile("s_waitcnt vmcnt(0)" ::: "memory");
            const unsigned og = xb_add(&bar[XB_TOP], 1u);
            const unsigned tg = og / nx;
            if (og + 1u == (tg + 1u) * nx) xb_add(&bar[XB_TOPGEN], 1u);
            else XB_SPIN(xb_ld(&bar[XB_TOPGEN]) == tg, bar);
            __builtin_amdgcn_fence(__ATOMIC_ACQUIRE, "agent");
            xb_add(&bar[XB_XGEN(b.x)], 1u);
            asm volatile("s_waitcnt vmcnt(0)" ::: "memory");
        } else {
            XB_SPIN(xb_ld(&bar[XB_XGEN(b.x)]) == gen, bar);
            __builtin_amdgcn_fence(__ATOMIC_ACQUIRE, "agent");
            asm volatile("s_waitcnt vmcnt(0)" ::: "memory");
        }
    }
    __syncthreads();
}

DI void conv_fetch(const float* __restrict__ src, int K, int N, int k0, int n0, f32x4 (&v)[2], int tid) {
#pragma unroll
    for (int i = 0; i < 2; ++i) {
        const int idx = tid + NTHREADS * i, kr = idx >> 4, c4 = (idx & 15) * 4;
        v[i] = (f32x4){0.f, 0.f, 0.f, 0.f};
        if (n0 + c4 < N) v[i] = __builtin_nontemporal_load((const f32x4*)(src + (size_t)(k0 + kr) * N + n0 + c4));
    }
}
DI void conv_put(const f32x4 (&v)[2], float* lds, int tid) {
#pragma unroll
    for (int i = 0; i < 2; ++i) {
        const int idx = tid + NTHREADS * i, kr = idx >> 4, c4 = (idx & 15) * 4;
        float* d = lds + kr * 65 + c4;
        d[0] = v[i].x; d[1] = v[i].y; d[2] = v[i].z; d[3] = v[i].w;
    }
}
DI unsigned cvt_fp8x4(float a, float b, float c, float d) { int w = __builtin_amdgcn_cvt_pk_fp8_f32(a, b, 0, false); w = __builtin_amdgcn_cvt_pk_fp8_f32(c, d, w, true); return (unsigned)w; }
template <bool NT, bool FP8>
DI void conv_store(int K, bf16_t* __restrict__ dst, int k0, int ndst0, int nstep, const float* lds, int tid) {
    const int idx = tid, n = idx >> 3, kc = idx & 7;
    float f[8];
#pragma unroll
    for (int j = 0; j < 8; ++j) f[j] = lds[(kc * 8 + j) * 65 + n];
    const size_t e = (size_t)(ndst0 + (n & 31) + (n >> 5) * nstep) * K + k0 + kc * 8;
    if (FP8) {
        u32x2 w; w.x = cvt_fp8x4(f[0] * 32.f, f[1] * 32.f, f[2] * 32.f, f[3] * 32.f); w.y = cvt_fp8x4(f[4] * 32.f, f[5] * 32.f, f[6] * 32.f, f[7] * 32.f);
        u32x2* d = (u32x2*)((unsigned char*)dst + e);
        if (NT) __builtin_nontemporal_store(w, d); else *d = w;
    } else {
        u32x4* d = (u32x4*)(dst + e);
        if (NT) __builtin_nontemporal_store(pack8(f), d); else *d = pack8(f);
    }
}
template <bool NT = true, bool FP8 = false>
DI void conv_job(const float* src, int count, int K, int N, int Npad, bf16_t* dst, int perm  , int& base, float* lds, int bid, int nb, int tid) {
    const int tk = K / 64, tn = Npad / 64, per = tk * tn, total = count * per;
    int t = (bid - (base % nb) + nb) % nb;
    f32x4 rg[4][2];
    auto fetch4 = [&](int tt) {
#pragma unroll
        for (int q = 0; q < 4; ++q) {
            const int tq = tt + q * nb;
            if (tq < total) { const int mi = tq / per, rem = tq - mi * per, nt = rem / tk, kt = rem - nt * tk;
                conv_fetch(src + (size_t)mi * K * N, K, N, kt * 64, nt * 64, rg[q], tid); }
        }
    };
    if (t < total) fetch4(t);
    for (; t < total; t += 4 * nb) {
#pragma unroll
        for (int q = 0; q < 4; ++q) if (t + q * nb < total) conv_put(rg[q], lds + q * 4160, tid);
        __syncthreads();
        if (t + 4 * nb < total) fetch4(t + 4 * nb);
#pragma unroll
        for (int q = 0; q < 4; ++q) {
            const int tq = t + q * nb;
            if (tq < total) { const int mi = tq / per, rem = tq - mi * per, nt = rem / tk, kt = rem - nt * tk, n0 = nt * 64;
                int nd0 = n0, nstep = 32;
                if (perm == 1) nd0 = ((n0 & 255) >> 7) * 256 + (n0 >> 8) * 128 + (n0 & 127);
                else if (n0 < perm) { const int hg = n0 >> 6; nd0 = (hg >> 2) * 256 + (hg & 3) * 32; nstep = 128; }
                conv_store<NT, FP8>(K, FP8 ? (bf16_t*)((unsigned char*)dst + (size_t)mi * Npad * K) : dst + (size_t)mi * Npad * K, kt * 64, nd0, nstep, lds + q * 4160, tid); }
        }
        __syncthreads();
    }
    base += total;
}

DI int mla_col(bool uq, int r) {
    const int hw = uq ? 96 : 128;
    if (r < 1024) { const int pn = r >> 8, bj = (r >> 7) & 1, wc = (r >> 5) & 3, d = r & 31; return (4 * pn + wc) * hw + 32 * bj + d; }
    const int rr = r - 1024;
    if (uq) { const int head = rr >> 5, c = rr & 31, dim = (c >> 3) * 4 + (c & 3) + 16 * ((c >> 2) & 1); return head * 96 + 64 + dim; }
    return (rr >> 6) * 128 + 64 + (rr & 63);
}
DI void phase_prologue(const Params& p, float* lds, int bid, int nb, int tid) {
    bf16_t* ws16 = (bf16_t*)p.ws;
    int base = 0;
    conv_job<true, true>(p.in[13], 1, 1024, 3072, 3072, (bf16_t*)(p.ws + W_QKV0), 2048, base, lds, bid, nb, tid);
    conv_job(p.in[14], 1, 1024, 1024, 1024, (bf16_t*)(p.ws + W_O0), 0, base, lds, bid, nb, tid);
    conv_job<true, true>(p.in[18], 1, 1024, 1536, 1536, (bf16_t*)(p.ws + W_QKV1), 1280, base, lds, bid, nb, tid);
    conv_job(p.in[19], 1, 1024, 1024, 1024, (bf16_t*)(p.ws + W_O1), 0, base, lds, bid, nb, tid);
    conv_job<true, true>(p.in[23], 1, 1024, 672, 768, (bf16_t*)(p.ws + W_DQKV), 0, base, lds, bid, nb, tid);
    for (int i = bid * NTHREADS + tid; i < 1536 * 48 + 2048 * 32; i += nb * NTHREADS) {
        const bool uq = i < 1536 * 48;
        const int K = uq ? 384 : 256, kc = K / 8, ii = uq ? i : i - 1536 * 48, r = ii / kc, k0 = (ii - r * kc) * 8, nsrc = uq ? 1536 : 2048;
        const int col = mla_col(uq, r);
        const float* src = p.in[uq ? 26 : 27] + (size_t)k0 * nsrc + col;
        float f[8];
#pragma unroll
        for (int j = 0; j < 8; ++j) f[j] = src[(size_t)j * nsrc];
        *(u32x4*)((bf16_t*)(p.ws + (uq ? W_UQ : W_UKV)) + (size_t)r * K + k0) = pack8(f);
    }
    conv_job(p.in[30], 1, 1024, 1024, 1024, (bf16_t*)(p.ws + W_O2), 0, base, lds, bid, nb, tid);
    conv_job<true, true>(p.in[31], 1, 1024, 3072, 3072, (bf16_t*)(p.ws + W_QKV3), 2048, base, lds, bid, nb, tid);
    conv_job(p.in[36], 1, 1024, 1024, 1024, (bf16_t*)(p.ws + W_O3), 0, base, lds, bid, nb, tid);
    conv_job<true, true>(p.in[11], 32, 1024, 512, 512, (bf16_t*)(p.ws + W_GU), 1, base, lds, bid, nb, tid);
    conv_job(p.in[12], 32, 256, 1024, 1024, (bf16_t*)(p.ws + W_DN), 0, base, lds, bid, nb, tid);
    (void)ws16;
    float* sc = lds;
    for (int i = tid; i < 9 * 1024; i += NTHREADS) {
        const int r = i >> 10, k = i & 1023;
        const float v = r < 8 ? p.in[1][r * 1024 + k] : p.in[3][k];
        sc[i] = silu_f(v);
    }
    __syncthreads();
    float* part = (float*)(p.ws + WS_MODP);
    for (int it = bid; it < 768; it += nb) {
        const int kc = it / 48, rem = it - kc * 48, l = rem / 12, nch = rem - l * 12;
        const int n = nch * 512 + tid;
        const float* w = p.in[4] + ((size_t)l * 1024 + kc * 64) * 6144 + n;
        float acc[9];
#pragma unroll
        for (int r = 0; r < 9; ++r) acc[r] = 0.f;
#pragma unroll 8
        for (int k = 0; k < 64; ++k) {
            const float wv = __builtin_nontemporal_load(w + (size_t)k * 6144);
#pragma unroll
            for (int r = 0; r < 9; ++r) acc[r] += sc[r * 1024 + kc * 64 + k] * wv;
        }
#pragma unroll
        for (int r = 0; r < 9; ++r) part[(((size_t)kc * 4 + l) * 9 + r) * 6144 + n] = acc[r];
    }
    __syncthreads();
}
DI void phase_mod_reduce(const Params& p, int bid, int nb, int tid) {
    const float* part = (const float*)(p.ws + WS_MODP);
    float* mod = (float*)(p.ws + WS_MOD);
    const int total = 4 * 9 * 6144;
    for (int i = bid * NTHREADS + tid; i < total; i += nb * NTHREADS) {
        const int l = i / (9 * 6144), n = i % 6144;
        float s = p.in[5][l * 6144 + n];
#pragma unroll
        for (int kc = 0; kc < 16; ++kc) s += part[(size_t)kc * total + i];
        mod[i] = s;
    }
}

template <int MODE>
DI void phase_rows(const Params& p, int layer  , int which  , int bid, int nb, int tid) {
    const int wid = __builtin_amdgcn_readfirstlane(tid >> 6), lane = tid & 63;
    const float* modall = (const float*)(p.ws + WS_MOD);
    const bf16_t* eo = (const bf16_t*)(p.ws + WS_RAW);
    bf16_t* H = (bf16_t*)(p.ws + WS_H);
    for (int r = bid * NW + wid; r < MROWS; r += nb * NW) {
        const int b = r / PP, pos = r - b * PP;
        if ((MODE & 16) && pos >= SEQ) continue;
        const int mr = pos < SEQ ? b : 8;
        bf16_t* xb = xb_row(p, r);
        float x[16];
        if (MODE & 8) {
            const float* xr = pos < SEQ ? p.in[0] + ((size_t)b * SEQ + pos) * DM : p.in[2] + ((size_t)b * CTXL + (pos - SEQ)) * DM;
#pragma unroll
            for (int j = 0; j < 4; ++j) { const f32x4 v = *(const f32x4*)(xr + lane * 4 + 256 * j); x[4 * j] = v.x; x[4 * j + 1] = v.y; x[4 * j + 2] = v.z; x[4 * j + 3] = v.w; }
        } else {
#pragma unroll
            for (int j = 0; j < 4; ++j) { const u32x2 v = *(const u32x2*)(xb + lane * 4 + 256 * j); x[4 * j] = bflo(v.x); x[4 * j + 1] = bfhi(v.x); x[4 * j + 2] = bflo(v.y); x[4 * j + 3] = bfhi(v.y); }
        }
        if (MODE & 1) {
            const float* g2 = modall + ((size_t)(layer - ((MODE & 2) ? 1 : 0)) * 9 + mr) * 6144 + 5120;
            const bf16_t* y0 = eo + (size_t)(2 * r) * 1024, *y1 = y0 + 1024;
#pragma unroll
            for (int j = 0; j < 4; ++j) {
                const u32x2 a = *(const u32x2*)(y0 + lane * 4 + 256 * j), bb = *(const u32x2*)(y1 + lane * 4 + 256 * j);
                const f32x4 g = *(const f32x4*)(g2 + lane * 4 + 256 * j);
                x[4 * j] += g.x * (bflo(a.x) + bflo(bb.x)); x[4 * j + 1] += g.y * (bfhi(a.x) + bfhi(bb.x));
                x[4 * j + 2] += g.z * (bflo(a.y) + bflo(bb.y)); x[4 * j + 3] += g.w * (bfhi(a.y) + bfhi(bb.y));
            }
        }
        if (MODE & 16) {
            float* orow = p.out + ((size_t)b * SEQ + pos) * DM;
#pragma unroll
            for (int j = 0; j < 4; ++j) *(f32x4*)(orow + lane * 4 + 256 * j) = (f32x4){x[4 * j], x[4 * j + 1], x[4 * j + 2], x[4 * j + 3]};
        } else if (MODE & (1 | 8)) {
#pragma unroll
            for (int j = 0; j < 4; ++j) {
                u32x2 w; w.x = pk2(x[4 * j], x[4 * j + 1]); w.y = pk2(x[4 * j + 2], x[4 * j + 3]);
                *(u32x2*)(xb + lane * 4 + 256 * j) = w;
                x[4 * j] = bflo(w.x); x[4 * j + 1] = bfhi(w.x); x[4 * j + 2] = bflo(w.y); x[4 * j + 3] = bfhi(w.y);
            }
        }
        if (MODE & 2) {
            float ss = 0.f;
#pragma unroll
            for (int i = 0; i < 16; ++i) ss += x[i] * x[i];
            ss = wave_sum(ss);
            const float rs = rsqrtf(ss * (1.0f / 1024.0f) + EPS);
            const float* ng = p.in[6] + ((size_t)layer * 2 + which) * 1024;
            const float* md = modall + ((size_t)layer * 9 + mr) * 6144 + which * 3072;
#pragma unroll
            for (int j = 0; j < 4; ++j) {
                const f32x4 g = *(const f32x4*)(ng + lane * 4 + 256 * j), sh = *(const f32x4*)(md + lane * 4 + 256 * j), sc = *(const f32x4*)(md + 1024 + lane * 4 + 256 * j);
                const float h0 = x[4 * j] * rs * g.x * (1.0f + sc.x) + sh.x, h1 = x[4 * j + 1] * rs * g.y * (1.0f + sc.y) + sh.y;
                const float h2 = x[4 * j + 2] * rs * g.z * (1.0f + sc.z) + sh.z, h3 = x[4 * j + 3] * rs * g.w * (1.0f + sc.w) + sh.w;
                if (MODE & 32) *(unsigned*)((unsigned char*)H + (size_t)r * 1024 + lane * 4 + 256 * j) = cvt_fp8x4(h0, h1, h2, h3);
                else { u32x2 w; w.x = pk2(h0, h1); w.y = pk2(h2, h3); *(u32x2*)(H + (size_t)r * 1024 + lane * 4 + 256 * j) = w; }
            }
        }
    }
}

constexpr size_t WS_RC = WS_MOD + 917504;
DI void phase_router_prep(const Params& p, int bid, int nb, int tid) {
    const float* modall = (const float*)(p.ws + WS_MOD);
    bf16_t* wth = (bf16_t*)(p.ws + WS_RW); bf16_t* wtl = wth + 4 * 9 * 48 * 1024;
    const int total = 4 * 9 * 48 * 1024;
    for (int i = bid * NTHREADS + tid; i < total; i += nb * NTHREADS) {
        const int k = i & 1023, c = (i >> 10) % 48, lb = i / (48 * 1024), l = lb / 9, b = lb - l * 9;
        float v = 0.f;
        if (c < 36) {
            const float w = c < 32 ? p.in[9][((size_t)l * 1024 + k) * 32 + c] : p.in[7][((size_t)l * 1024 + k) * 4 + (c - 32)];
            v = p.in[6][((size_t)l * 2 + 1) * 1024 + k] * (1.0f + modall[((size_t)l * 9 + b) * 6144 + 4096 + k]) * w;
        }
        const unsigned hb = f2bf(v); wth[i] = (bf16_t)hb; wtl[i] = (bf16_t)f2bf(v - bf2f(hb));
    }
    float* cst = (float*)(p.ws + WS_RC);
    const int wid = __builtin_amdgcn_readfirstlane(tid >> 6), lane = tid & 63;
    for (int j = bid * NW + wid; j < 4 * 9 * 48; j += nb * NW) {
        const int c = j % 48, lb = j / 48, l = lb / 9, b = lb - l * 9;
        float acc = 0.f;
        if (c < 36) {
            for (int k = lane; k < 1024; k += 64) {
                const float w = c < 32 ? p.in[9][((size_t)l * 1024 + k) * 32 + c] : p.in[7][((size_t)l * 1024 + k) * 4 + (c - 32)];
                acc += modall[((size_t)l * 9 + b) * 6144 + 3072 + k] * w;
            }
            acc = wave_sum(acc) + (c < 32 ? p.in[10][l * 32 + c] : p.in[8][l * 4 + (c - 32)]);
        }
        if (lane == 0) cst[j] = acc;
    }
}
typedef float f32x2_3 __attribute__((ext_vector_type(2)));
typedef __bf16 bf16x2_3 __attribute__((ext_vector_type(2)));
DI unsigned cvtpk3(float lo, float hi) { f32x2_3 v = {lo, hi}; bf16x2_3 b = __builtin_convertvector(v, bf16x2_3); return __builtin_bit_cast(unsigned, b); }
DI void phase_router(const Params& p, unsigned char* smem, int layer, bool skip_ctx, int bid, int nb, int tid) {
    const int lane = tid & 63, wid = __builtin_amdgcn_readfirstlane(tid >> 6), li = lane & 15, kq = lane >> 4;
    LAS float* tile = (LAS float*)smem + wid * (32 * 49);
    const bf16_t* wth_all = (const bf16_t*)(p.ws + WS_RW) + (size_t)layer * 9 * 48 * 1024;
    const bf16_t* wtl_all = wth_all + 4 * 9 * 48 * 1024;
    const float* cst_all = (const float*)(p.ws + WS_RC) + layer * 9 * 48;
    unsigned* cnt = (unsigned*)(p.ws + WS_CTL) + CW_CNT + layer * 32;
    unsigned* list = (unsigned*)(p.ws + WS_LIST);
    float* gates = (float*)(p.ws + WS_GATE);
    if (layer > 0) {
        int base = 0;
        conv_job<false, true>(p.in[11] + (size_t)layer * 32 * 1024 * 512, 32, 1024, 512, 512, (bf16_t*)(p.ws + W_GU + (size_t)layer * 32 * 512 * 1024), 1, base, (float*)smem, bid, nb, tid);
        conv_job<false>(p.in[12] + (size_t)layer * 32 * 256 * 1024, 32, 256, 1024, 1024, (bf16_t*)(p.ws + W_DN) + (size_t)layer * 32 * 1024 * 256, 0, base, (float*)smem, bid, nb, tid);
    }
    for (int u = bid * NW + wid; u < MROWS / 32; u += nb * NW) {
        const int r0 = u * 32, b = r0 / PP, pos = r0 - b * PP;
        const bool isctx = pos >= SEQ;
        if (skip_ctx && isctx) continue;
        const int mr = isctx ? 8 : b;
        const bf16_t* xr = xb_row(p, r0 + li) + 8 * kq;
        const bf16_t* wh = wth_all + ((size_t)mr * 48 + li) * 1024 + 8 * kq;
        const bf16_t* wl = wtl_all + ((size_t)mr * 48 + li) * 1024 + 8 * kq;
        f32x4 acc[2][3];
#pragma unroll
        for (int m = 0; m < 2; ++m)
#pragma unroll
            for (int n = 0; n < 3; ++n) acc[m][n] = (f32x4){0.f, 0.f, 0.f, 0.f};
        float ss[2] = {0.f, 0.f};
#pragma unroll 2
        for (int s = 0; s < 32; ++s) {
            bf16x8 xa[2], bh[3], bl[3];
#pragma unroll
            for (int m = 0; m < 2; ++m) xa[m] = *(const bf16x8*)(xr + (size_t)m * 16 * DM + 32 * s);
#pragma unroll
            for (int n = 0; n < 3; ++n) { bh[n] = *(const bf16x8*)(wh + (size_t)n * 16 * 1024 + 32 * s); bl[n] = *(const bf16x8*)(wl + (size_t)n * 16 * 1024 + 32 * s); }
#pragma unroll
            for (int m = 0; m < 2; ++m) {
                const u32x4 w = __builtin_bit_cast(u32x4, xa[m]);
                ss[m] += bflo(w.x) * bflo(w.x) + bfhi(w.x) * bfhi(w.x) + bflo(w.y) * bflo(w.y) + bfhi(w.y) * bfhi(w.y) + bflo(w.z) * bflo(w.z) + bfhi(w.z) * bfhi(w.z) + bflo(w.w) * bflo(w.w) + bfhi(w.w) * bfhi(w.w);
#pragma unroll
                for (int n = 0; n < 3; ++n) {
                    acc[m][n] = __builtin_amdgcn_mfma_f32_16x16x32_bf16(xa[m], bl[n], acc[m][n], 0, 0, 0);
                    acc[m][n] = __builtin_amdgcn_mfma_f32_16x16x32_bf16(xa[m], bh[n], acc[m][n], 0, 0, 0);
                }
            }
        }
#pragma unroll
        for (int m = 0; m < 2; ++m) { ss[m] += __shfl_xor(ss[m], 16); ss[m] += __shfl_xor(ss[m], 32); }
#pragma unroll
        for (int m = 0; m < 2; ++m)
#pragma unroll
            for (int n = 0; n < 3; ++n)
#pragma unroll
                for (int i = 0; i < 4; ++i) tile[(16 * m + 4 * kq + i) * 49 + n * 16 + li] = acc[m][n][i];
        __builtin_amdgcn_s_waitcnt(0xc07f);
        const float ssr = (lane & 16) ? ss[1] : ss[0];
        const float rs = rsqrtf(ssr * (1.0f / 1024.0f) + EPS);
        if (lane < 32) {
            const float* cst = cst_all + mr * 48;
            const LAS float* tr = tile + lane * 49;
            float lg[4];
#pragma unroll
            for (int c = 0; c < 4; ++c) lg[c] = tr[32 + c] * rs + cst[32 + c];
            int gi = 0; float gm = lg[0];
#pragma unroll
            for (int c = 1; c < 4; ++c) if (lg[c] > gm) { gm = lg[c]; gi = c; }
            float gden = 0.f;
#pragma unroll
            for (int c = 0; c < 4; ++c) gden += __expf(lg[c] - gm);
            const float gw = 1.0f / gden;
            float le[8];
#pragma unroll
            for (int c = 0; c < 8; ++c) le[c] = tr[gi * 8 + c] * rs + cst[gi * 8 + c];
            int e0 = 0; float m0 = le[0];
#pragma unroll
            for (int c = 1; c < 8; ++c) if (le[c] > m0) { m0 = le[c]; e0 = c; }
            int e1 = -1; float m1 = -INFINITY;
#pragma unroll
            for (int c = 0; c < 8; ++c) if (c != e0 && le[c] > m1) { m1 = le[c]; e1 = c; }
            const float q1 = __expf(m1 - m0), inv = 1.0f / (1.0f + q1);
            const int r = r0 + lane, ex0 = gi * 8 + e0, ex1 = gi * 8 + e1;
            const unsigned s0 = atomicAdd(cnt + ex0, 1u), s1 = atomicAdd(cnt + ex1, 1u);
            list[(size_t)ex0 * MROWS + s0] = 2u * r; list[(size_t)ex1 * MROWS + s1] = 2u * r + 1u;
            gates[2 * r] = gw * inv; gates[2 * r + 1] = gw * q1 * inv;
        }
        {
            const float* ng = p.in[6] + ((size_t)layer * 2 + 1) * 1024;
            const float* md = (const float*)(p.ws + WS_MOD) + ((size_t)layer * 9 + mr) * 6144 + 3072;
            f32x4 gm[4], sh[4];
#pragma unroll
            for (int j = 0; j < 4; ++j) {
                const f32x4 g = *(const f32x4*)(ng + lane * 4 + 256 * j), sc = *(const f32x4*)(md + 1024 + lane * 4 + 256 * j);
                sh[j] = *(const f32x4*)(md + lane * 4 + 256 * j);
                gm[j] = (f32x4){g.x * (1.0f + sc.x), g.y * (1.0f + sc.y), g.z * (1.0f + sc.z), g.w * (1.0f + sc.w)};
            }
            unsigned char* H8 = p.ws + WS_H;
#pragma unroll 4
            for (int i = 0; i < 32; ++i) {
                const float rsi = __shfl(rs, i);
                const bf16_t* xb = xb_row(p, r0 + i);
#pragma unroll
                for (int j = 0; j < 4; ++j) {
                    const u32x2 v = *(const u32x2*)(xb + lane * 4 + 256 * j);
                    *(unsigned*)(H8 + (size_t)(r0 + i) * 1024 + lane * 4 + 256 * j) =
                        cvt_fp8x4(bflo(v.x) * rsi * gm[j].x + sh[j].x, bfhi(v.x) * rsi * gm[j].y + sh[j].y, bflo(v.y) * rsi * gm[j].z + sh[j].z, bfhi(v.y) * rsi * gm[j].w + sh[j].w);
                }
            }
        }
    }
}

#define MFMA32(a, b, c) __builtin_amdgcn_mfma_f32_32x32x16_bf16((a), (b), (c), 0, 0, 0)
typedef LAS unsigned char* lds_ptr;
constexpr int GEMM_TM = 256, GEMM_TN = 256;
constexpr int GEMM_STAGE = 65536;
constexpr int GEMM_LDS = 2 * GEMM_STAGE;
constexpr int GEMM_MT = 4;

struct RowDense { static constexpr bool DENSE = true; const bf16_t* A; int lda; int m0; DI unsigned row(int i) const { return (unsigned)(m0 + i) * (unsigned)lda; } };
struct RowGather { static constexpr bool DENSE = false; const bf16_t* A; int lda; const unsigned* ent; int valid; int shift;
    DI unsigned row(int i) const { const unsigned e = ent[i < valid ? i : valid - 1]; return (e >> shift) * (unsigned)lda; } };

struct EpiStore { bf16_t* C; int ldc; int m0;
    DI void wave_tile(const f32x16 (&acc)[2][GEMM_MT], int mloc, int ncol, int lane) const {
        const int r = lane & 31, h = lane >> 5;
#pragma unroll
        for (int mt = 0; mt < GEMM_MT; ++mt) {
            bf16_t* c = C + (size_t)(m0 + mloc + mt * 32 + r) * ldc + ncol + 4 * h;
#pragma unroll
            for (int nt = 0; nt < 2; ++nt)
#pragma unroll
                for (int g = 0; g < 4; ++g) {
                    u32x2 w; w.x = pk2(acc[nt][mt][4 * g], acc[nt][mt][4 * g + 1]); w.y = pk2(acc[nt][mt][4 * g + 2], acc[nt][mt][4 * g + 3]);
                    *(u32x2*)(c + nt * 32 + 8 * g) = w;
                }
        }
    } };
struct EpiResid { const Params* p; const float* mod; int m0;
    DI void wave_tile(const f32x16 (&acc)[2][GEMM_MT], int mloc, int ncol, int lane) const {
        const int r = lane & 31, h = lane >> 5;
#pragma unroll
        for (int mt = 0; mt < GEMM_MT; ++mt) {
            const int row = m0 + mloc + mt * 32 + r;
            float* xr = xrow_ptr(*p, row) + ncol + 4 * h;
            const float* gp = mod + (size_t)mod_row(row) * 6144 + 2048 + ncol + 4 * h;
#pragma unroll
            for (int nt = 0; nt < 2; ++nt)
#pragma unroll
                for (int g = 0; g < 4; ++g) {
                    f32x4 x = *(f32x4*)(xr + nt * 32 + 8 * g);
                    const f32x4 gg = *(const f32x4*)(gp + nt * 32 + 8 * g);
                    x.x += gg.x * acc[nt][mt][4 * g]; x.y += gg.y * acc[nt][mt][4 * g + 1]; x.z += gg.z * acc[nt][mt][4 * g + 2]; x.w += gg.w * acc[nt][mt][4 * g + 3];
                    *(f32x4*)(xr + nt * 32 + 8 * g) = x;
                }
        }
    } };
struct EpiGlu { bf16_t* act; const unsigned* ent; const float* gates; int valid;
    DI void wave_tile(const f32x16 (&acc)[2][GEMM_MT], int mloc, int ncol, int lane) const {
        const int r = lane & 31, h = lane >> 5;
#pragma unroll
        for (int mt = 0; mt < GEMM_MT; ++mt) {
            const int i = mloc + mt * 32 + r;
            if (i < valid) {
                const unsigned a = ent[i];
                const float gw = gates[a];
                bf16_t* o = act + (size_t)a * DEXP + (ncol >> 6) * 32 + 4 * h;
#pragma unroll
                for (int g = 0; g < 4; ++g) {
                    float v[4];
#pragma unroll
                    for (int j = 0; j < 4; ++j) v[j] = silu_f(acc[0][mt][4 * g + j]) * acc[1][mt][4 * g + j] * gw;
                    u32x2 w; w.x = pk2(v[0], v[1]); w.y = pk2(v[2], v[3]);
                    *(u32x2*)(o + 8 * g) = w;
                }
            }
        }
    } };
struct EpiScatter { bf16_t* outp; const unsigned* ent; int valid;
    DI void wave_tile(const f32x16 (&acc)[2][GEMM_MT], int mloc, int ncol, int lane) const {
        const int r = lane & 31, h = lane >> 5;
#pragma unroll
        for (int mt = 0; mt < GEMM_MT; ++mt) {
            const int i = mloc + mt * 32 + r;
            if (i < valid) {
                bf16_t* c = outp + (size_t)ent[i] * 1024 + ncol + 4 * h;
#pragma unroll
                for (int nt = 0; nt < 2; ++nt)
#pragma unroll
                    for (int g = 0; g < 4; ++g) {
                        u32x2 w; w.x = pk2(acc[nt][mt][4 * g], acc[nt][mt][4 * g + 1]); w.y = pk2(acc[nt][mt][4 * g + 2], acc[nt][mt][4 * g + 3]);
                        *(u32x2*)(c + nt * 32 + 8 * g) = w;
                    }
            }
        }
    } };

#define SCHED_FENCE() __builtin_amdgcn_sched_barrier(0)
DI void glds16(const bf16_t* g, lds_ptr l) { __builtin_amdgcn_global_load_lds((const unsigned*)g, (LAS unsigned*)l, 16, 0, 0); }
template <int PROBE, int NAG>
DI void gemm_kstep(f32x16 (&acc)[2][GEMM_MT], const lds_ptr st, const unsigned (&arow)[GEMM_MT], const unsigned (&wrow)[2], const unsigned (&aswz)[GEMM_MT], const unsigned (&wswz)[2], int h,
                   bool issue, const bf16_t* __restrict__ An, const bf16_t* __restrict__ Wn, const unsigned (&ag)[NAG], unsigned astep, const unsigned (&bg)[2], unsigned bstep, const lds_ptr sn) {
    if (PROBE != 2 && issue) {
#pragma unroll
        for (int j = 0; j < 8; ++j) { glds16(An + (NAG == 2 ? ag[j & 1] + (j >> 1) * astep : ag[j % NAG]), sn + j * 1024); glds16(Wn + bg[j & 1] + (j >> 1) * bstep, sn + 32768 + j * 1024); }
    }
    if (PROBE == 1) return;
    bf16x8 af[2][GEMM_MT], wf[2][2];
#pragma unroll
    for (int t = 0; t < 2; ++t) wf[0][t] = *(const LAS bf16x8*)(st + wrow[t] + ((((unsigned)h) ^ wswz[t]) << 4));
#pragma unroll
    for (int t = 0; t < GEMM_MT; ++t) af[0][t] = *(const LAS bf16x8*)(st + arow[t] + ((((unsigned)h) ^ aswz[t]) << 4));
#pragma unroll
    for (int kk = 0; kk < 4; ++kk) {
        if (kk < 3) {
#pragma unroll
            for (int t = 0; t < 2; ++t) wf[(kk + 1) & 1][t] = *(const LAS bf16x8*)(st + wrow[t] + ((((unsigned)((kk + 1) * 2 + h)) ^ wswz[t]) << 4));
#pragma unroll
            for (int t = 0; t < GEMM_MT; ++t) af[(kk + 1) & 1][t] = *(const LAS bf16x8*)(st + arow[t] + ((((unsigned)((kk + 1) * 2 + h)) ^ aswz[t]) << 4));
        }
        SCHED_FENCE();
        __builtin_amdgcn_s_setprio(1);
#pragma unroll
        for (int mt = 0; mt < GEMM_MT; ++mt)
#pragma unroll
            for (int nt = 0; nt < 2; ++nt) acc[nt][mt] = MFMA32(wf[kk & 1][nt], af[kk & 1][mt], acc[nt][mt]);
        __builtin_amdgcn_s_setprio(0);
        SCHED_FENCE();
    }
}
template <class RowSrc, class Epi, int PROBE = 0>
DI void gemm_tile_mfma(unsigned char* smem, const RowSrc& rs, const bf16_t* __restrict__ Wt, int K, int n0, const Epi& epi, int tid) {
    const lds_ptr lds = (lds_ptr)smem;
    const int lane = tid & 63, wid = __builtin_amdgcn_readfirstlane(tid >> 6), wm = wid & 1, wn = wid >> 1, r = lane & 31, h = lane >> 5;
    const bool loader = wid < 4;
    const int lw = wid & 3;
    constexpr int NAG = RowSrc::DENSE ? 2 : 8;
    unsigned ag[NAG], bg[2];
    const bf16_t* __restrict__ Ab = rs.A;
#pragma unroll
    for (int j = 0; j < NAG; ++j) {
        const int row = (lw * 8 + j) * 8 + (lane >> 3), c = (lane & 7) ^ ((row >> 1) & 7);
        ag[j] = rs.row(row) + c * 8;
    }
#pragma unroll
    for (int j = 0; j < 2; ++j) {
        const int row = (lw * 8 + j) * 8 + (lane >> 3), c = (lane & 7) ^ ((row >> 1) & 7);
        bg[j] = (unsigned)(n0 + row) * (unsigned)K + c * 8;
    }
    const unsigned astep = 16u * (unsigned)rs.lda, bstep = 16u * (unsigned)K;
    const unsigned dmaoff = (unsigned)lw * 8192u;
    unsigned arow[GEMM_MT], wrow[2], aswz[GEMM_MT], wswz[2];
#pragma unroll
    for (int t = 0; t < GEMM_MT; ++t) { const int ra = wm * 128 + t * 32 + r; arow[t] = ra * 128; aswz[t] = (ra >> 1) & 7; }
#pragma unroll
    for (int t = 0; t < 2; ++t) { const int rw = wn * 64 + t * 32 + r; wrow[t] = 32768 + rw * 128; wswz[t] = (rw >> 1) & 7; }
    f32x16 acc[2][GEMM_MT];
#pragma unroll
    for (int a = 0; a < 2; ++a)
#pragma unroll
        for (int b = 0; b < GEMM_MT; ++b)
#pragma unroll
            for (int i = 0; i < 16; ++i) acc[a][b][i] = 0.f;
    if (loader) {
#pragma unroll
        for (int j = 0; j < 8; ++j) { glds16(Ab + (NAG == 2 ? ag[j & 1] + (j >> 1) * astep : ag[j % NAG]), lds + dmaoff + j * 1024); glds16(Wt + bg[j & 1] + (j >> 1) * bstep, lds + 32768 + dmaoff + j * 1024); }
    }
    asm volatile("s_waitcnt vmcnt(0)" ::: "memory");
    __syncthreads();
    const int KT = K >> 6;
    for (int kt = 0; kt < KT; ++kt) {
        gemm_kstep<PROBE, NAG>(acc, lds + (kt & 1) * GEMM_STAGE, arow, wrow, aswz, wswz, h, loader && kt + 1 < KT, Ab + (kt + 1) * 64, Wt + (kt + 1) * 64, ag, astep, bg, bstep, lds + ((kt + 1) & 1) * GEMM_STAGE + dmaoff);
        asm volatile("s_waitcnt vmcnt(0)" ::: "memory");
        __syncthreads();
    }
    if (PROBE == 0 || acc[0][0][0] == 12345.678f) epi.wave_tile(acc, wm * 128, n0 + wn * 64, lane);
}

template <int EPIK, int PROBE = 0>
DI void gemm_dense(const Params& p, unsigned char* smem, const bf16_t* A, int lda, const bf16_t* Wt, int K, int N, bf16_t* C, int ldc, const float* mod, int bid, int nb, int tid) {
    const int tn = N / GEMM_TN, total = (MROWS / GEMM_TM) * tn;
    for (int t = bid; t < total; t += nb) {
        const int mt = t / tn, nt = t - mt * tn;
        RowDense rs{A, lda, mt * GEMM_TM};
        if (EPIK == 0) { EpiStore e{C, ldc, mt * GEMM_TM}; gemm_tile_mfma<RowDense, EpiStore, PROBE>(smem, rs, Wt, K, nt * GEMM_TN, e, tid); }
        else { EpiResid e{&p, mod, mt * GEMM_TM}; gemm_tile_mfma(smem, rs, Wt, K, nt * GEMM_TN, e, tid); }
    }
}
template <int WHICH>
DI void gemm_moe(const Params& p, unsigned char* smem, int layer, int bid, int nb, int tid) {
    const unsigned* cnt = (const unsigned*)(p.ws + WS_CTL) + CW_CNT + layer * 32;
    const unsigned* list = (const unsigned*)(p.ws + WS_LIST);
    const float* gates = (const float*)(p.ws + WS_GATE);
    const bf16_t* H = (const bf16_t*)(p.ws + WS_H);
    bf16_t* act = (bf16_t*)(p.ws + WS_Q);
    bf16_t* eo = (bf16_t*)(p.ws + WS_RAW);
    constexpr int TN = WHICH == 0 ? 2 : 4;
    int total = 0;
    for (int e = 0; e < NEXP; ++e) total += (int)((cnt[e] + 255u) >> 8) * TN;
    for (int t = bid; t < total; t += nb) {
        int e = 0, rem = t;
        for (; e < NEXP; ++e) { const int te = (int)((cnt[e] + 255u) >> 8) * TN; if (rem < te) break; rem -= te; }
        const int rt = rem / TN, ct = rem - rt * TN;
        const unsigned* ent = list + (size_t)e * MROWS + rt * GEMM_TM;
        const int valid = min(GEMM_TM, (int)cnt[e] - rt * GEMM_TM);
        if (WHICH == 0) {
            RowGather rs{H, 1024, ent, valid, 1};
            EpiGlu ep{act, ent, gates, valid};
            gemm_tile_mfma(smem, rs, (const bf16_t*)(p.ws + W_GU) + ((size_t)layer * 32 + e) * 512 * 1024, 1024, ct * GEMM_TN, ep, tid);
        } else {
            RowGather rs{act, DEXP, ent, valid, 0};
            EpiScatter ep{eo, ent, valid};
            gemm_tile_mfma(smem, rs, (const bf16_t*)(p.ws + W_DN) + ((size_t)layer * 32 + e) * 1024 * 256, 256, ct * GEMM_TN, ep, tid);
        }
    }
}

DI float quad_sum(float v) { v += __shfl_xor(v, 1); v += __shfl_xor(v, 2); return v; }
DI void head64_norm_rope(const bf16_t* src, bf16_t* dst, const float* gain, int sub, bool rope, int prow, int pcol, float scale) {
    float a[8], b[8];
    unpack8(*(const u32x4*)(src + sub * 8), a); unpack8(*(const u32x4*)(src + 32 + sub * 8), b);
    float ss = 0.f;
#pragma unroll
    for (int e = 0; e < 8; ++e) ss += a[e] * a[e] + b[e] * b[e];
    ss = quad_sum(ss);
    const float rs = rsqrtf(ss * (1.0f / 64.0f) + EPS);
#pragma unroll
    for (int e = 0; e < 8; ++e) { a[e] *= rs * gain[sub * 8 + e]; b[e] *= rs * gain[32 + sub * 8 + e]; }
    if (rope) {
#pragma unroll
        for (int e = 0; e < 8; ++e) {
            const int i = sub * 8 + e;
            const float* cs = ROPE64 + ((i < 16 ? prow : pcol) * 16 + (i & 15)) * 2;
            const float c = cs[0], s = cs[1], x1 = a[e], x2 = b[e];
            a[e] = x1 * c - x2 * s; b[e] = x2 * c + x1 * s;
        }
    }
#pragma unroll
    for (int e = 0; e < 8; ++e) { a[e] *= scale; b[e] *= scale; }
    *(u32x4*)(dst + sub * 8) = pack8(a); *(u32x4*)(dst + 32 + sub * 8) = pack8(b);
}
template <int KIND>
DI void phase_post_qk(const Params& p, int bid, int nb, int tid) {
    const int wid = __builtin_amdgcn_readfirstlane(tid >> 6), lane = tid & 63, hd = lane >> 2, sub = lane & 3;
    constexpr int NRAW = KIND == 1 ? 1536 : 3072, KH = KIND == 1 ? 4 : 16;
    const bf16_t* raw = (const bf16_t*)(p.ws + WS_RAW);
    bf16_t* Q = (bf16_t*)(p.ws + WS_Q); bf16_t* Kb = (bf16_t*)(p.ws + WS_K);
    const float* qn = p.in[KIND == 0 ? 15 : KIND == 1 ? 20 : 32];
    const float* kn = p.in[KIND == 0 ? 16 : KIND == 1 ? 21 : 33];
    const float qscale = 0.125f * LOG2E;
    for (int r = bid * NW + wid; r < MROWS; r += nb * NW) {
        const int b = r / PP, pos = r - b * PP;
        const bool rope = (KIND != 0) && pos < SEQ;
        const int prow = (pos >> 6) & 63, pcol = pos & 63;
        const bf16_t* rr = raw + (size_t)r * NRAW;
        head64_norm_rope(rr + hd * 64, Q + (size_t)r * 1024 + hd * 64, qn, sub, rope, prow, pcol, qscale);
        if (hd < KH) head64_norm_rope(rr + 1024 + hd * 64, Kb + (size_t)r * (KH * 64) + hd * 64, kn, sub, rope, prow, pcol, 1.0f);
    }
}
DI void phase_post_mla1(const Params& p, int bid, int nb, int tid) {
    const int wid = __builtin_amdgcn_readfirstlane(tid >> 6), lane = tid & 63;
    const bf16_t* raw = (const bf16_t*)(p.ws + WS_Q);
    bf16_t* cqn = (bf16_t*)(p.ws + WS_O);
    bf16_t* ckvn = cqn + (size_t)MROWS * 384;
    bf16_t* krope = ckvn + (size_t)MROWS * 256;
    const float* qa = p.in[24]; const float* kva = p.in[25]; const float* kn = p.in[29];
    for (int r = bid * NW + wid; r < MROWS; r += nb * NW) {
        const int b = r / PP, pos = r - b * PP;
        const bf16_t* rr = raw + (size_t)r * 768;
        {
            float v[6];
#pragma unroll
            for (int j = 0; j < 3; ++j) { const unsigned w = *(const unsigned*)(rr + lane * 6 + 2 * j); v[2 * j] = bflo(w); v[2 * j + 1] = bfhi(w); }
            float ss = 0.f;
#pragma unroll
            for (int j = 0; j < 6; ++j) ss += v[j] * v[j];
            ss = wave_sum(ss);
            const float rs = rsqrtf(ss * (1.0f / 384.0f) + EPS);
#pragma unroll
            for (int j = 0; j < 3; ++j) *(unsigned*)(cqn + (size_t)r * 384 + lane * 6 + 2 * j) = pk2(v[2 * j] * rs * qa[lane * 6 + 2 * j], v[2 * j + 1] * rs * qa[lane * 6 + 2 * j + 1]);
        }
        {
            const u32x2 w = *(const u32x2*)(rr + 384 + lane * 4);
            float v[4] = {bflo(w.x), bfhi(w.x), bflo(w.y), bfhi(w.y)};
            float ss = v[0] * v[0] + v[1] * v[1] + v[2] * v[2] + v[3] * v[3];
            ss = wave_sum(ss);
            const float rs = rsqrtf(ss * (1.0f / 256.0f) + EPS);
            u32x2 o; o.x = pk2(v[0] * rs * kva[lane * 4], v[1] * rs * kva[lane * 4 + 1]); o.y = pk2(v[2] * rs * kva[lane * 4 + 2], v[3] * rs * kva[lane * 4 + 3]);
            *(u32x2*)(ckvn + (size_t)r * 256 + lane * 4) = o;
        }
        {
            float x1 = 0.f, x2 = 0.f;
            if (lane < 16) { x1 = bf2f(rr[640 + lane]); x2 = bf2f(rr[640 + 16 + lane]); }
            float ss = wave_sum(x1 * x1 + x2 * x2);
            const float rs = rsqrtf(ss * (1.0f / 32.0f) + EPS);
            if (lane < 16) {
                x1 *= rs * kn[64 + lane]; x2 *= rs * kn[64 + 16 + lane];
                if (pos < SEQ) {
                    const int prow = (pos >> 6) & 63, pcol = pos & 63;
                    const float* cs = ROPE32 + ((lane < 8 ? prow : pcol) * 8 + (lane & 7)) * 2;
                    const float c = cs[0], s = cs[1], a = x1, bb = x2;
                    x1 = a * c - bb * s; x2 = bb * c + a * s;
                }
                bf16_t* kr = (bf16_t*)(p.ws + WS_K) + (size_t)r * 1536 + 64;
                const bf16_t b1 = (bf16_t)f2bf(x1), b2 = (bf16_t)f2bf(x2);
#pragma unroll
                for (int hh = 0; hh < 16; ++hh) { kr[hh * 96 + lane] = b1; kr[hh * 96 + 16 + lane] = b2; }
            }
        }
    }
}
DI void phase_post_mla2(const Params& p, int bid, int nb, int tid) {
    const int wid = __builtin_amdgcn_readfirstlane(tid >> 6), lane = tid & 63, hd = lane >> 2, sub = lane & 3;
    const bf16_t* qraw = (const bf16_t*)(p.ws + WS_RAW);
    const bf16_t* kvraw = qraw + (size_t)MROWS * 1536;
    const bf16_t* krope = (const bf16_t*)(p.ws + WS_O) + (size_t)MROWS * 640;
    bf16_t* Q = (bf16_t*)(p.ws + WS_Q); bf16_t* Kb = (bf16_t*)(p.ws + WS_K);
    const float* qn = p.in[28]; const float* kn = p.in[29];
    const float qscale = 0.10206207261596577f * LOG2E;
    for (int r = bid * NW + wid; r < MROWS; r += nb * NW) {
        const int b = r / PP, pos = r - b * PP;
        const bf16_t* qr = qraw + (size_t)r * 1536 + hd * 96;
        bf16_t* qo = Q + (size_t)r * 1536 + hd * 96;
        {
            float a[8], c[8];
            unpack8(*(const u32x4*)(qr + sub * 16), a); unpack8(*(const u32x4*)(qr + sub * 16 + 8), c);
            float ss = 0.f;
#pragma unroll
            for (int e = 0; e < 8; ++e) ss += a[e] * a[e] + c[e] * c[e];
            ss = quad_sum(ss);
            const float rs = rsqrtf(ss * (1.0f / 64.0f) + EPS) * qscale;
#pragma unroll
            for (int e = 0; e < 8; ++e) { a[e] *= rs * qn[sub * 16 + e]; c[e] *= rs * qn[sub * 16 + 8 + e]; }
            *(u32x4*)(qo + sub * 16) = pack8(a); *(u32x4*)(qo + sub * 16 + 8) = pack8(c);
        }
        {
            const u32x2 w1 = *(const u32x2*)(qr + 64 + sub * 4), w2 = *(const u32x2*)(qr + 64 + 16 + sub * 4);
            float x1[4] = {bflo(w1.x), bfhi(w1.x), bflo(w1.y), bfhi(w1.y)}, x2[4] = {bflo(w2.x), bfhi(w2.x), bflo(w2.y), bfhi(w2.y)};
            float ss = 0.f;
#pragma unroll
            for (int e = 0; e < 4; ++e) ss += x1[e] * x1[e] + x2[e] * x2[e];
            ss = quad_sum(ss);
            const float rs = rsqrtf(ss * (1.0f / 32.0f) + EPS);
#pragma unroll
            for (int e = 0; e < 4; ++e) {
                const int i = sub * 4 + e;
                float a = x1[e] * rs * qn[64 + i], bb = x2[e] * rs * qn[64 + 16 + i];
                if (pos < SEQ) {
                    const int prow = (pos >> 6) & 63, pcol = pos & 63;
                    const float* cs = ROPE32 + ((i < 8 ? prow : pcol) * 8 + (i & 7)) * 2;
                    const float c = cs[0], s = cs[1], t1 = a, t2 = bb;
                    a = t1 * c - t2 * s; bb = t2 * c + t1 * s;
                }
                x1[e] = a * qscale; x2[e] = bb * qscale;
            }
            u32x2 o1, o2; o1.x = pk2(x1[0], x1[1]); o1.y = pk2(x1[2], x1[3]); o2.x = pk2(x2[0], x2[1]); o2.y = pk2(x2[2], x2[3]);
            *(u32x2*)(qo + 64 + sub * 4) = o1; *(u32x2*)(qo + 64 + 16 + sub * 4) = o2;
        }
        {
            const bf16_t* kr = kvraw + (size_t)r * 2048 + hd * 128;
            bf16_t* ko = Kb + (size_t)r * 1536 + hd * 96;
            float a[8], c[8];
            unpack8(*(const u32x4*)(kr + sub * 16), a); unpack8(*(const u32x4*)(kr + sub * 16 + 8), c);
            float ss = 0.f;
#pragma unroll
            for (int e = 0; e < 8; ++e) ss += a[e] * a[e] + c[e] * c[e];
            ss = quad_sum(ss);
            const float rs = rsqrtf(ss * (1.0f / 64.0f) + EPS);
#pragma unroll
            for (int e = 0; e < 8; ++e) { a[e] *= rs * kn[sub * 16 + e]; c[e] *= rs * kn[sub * 16 + 8 + e]; }
            *(u32x4*)(ko + sub * 16) = pack8(a); *(u32x4*)(ko + sub * 16 + 8) = pack8(c);
            *(u32x4*)(ko + 64 + sub * 8) = *(const u32x4*)(krope + (size_t)r * 32 + sub * 8);
        }
    }
}
DI void phase_diff_combine(const Params& p, int bid, int nb, int tid) {
    const int wid = __builtin_amdgcn_readfirstlane(tid >> 6), lane = tid & 63, hd = lane >> 3, sub = lane & 7;
    const bf16_t* O12 = (const bf16_t*)(p.ws + WS_H);
    bf16_t* Oc = (bf16_t*)(p.ws + WS_Q);
    const float* lam = p.in[34]; const float* subln = p.in[35];
    const float lambda_init = 0.8f - 0.6f * 0.40656965974059917f;
    const float s1 = wave_sum(lam[lane] * lam[64 + lane]), s2 = wave_sum(lam[128 + lane] * lam[192 + lane]);
    const float lam_full = expf(s1) - expf(s2) + lambda_init;
    for (int r = bid * NW + wid; r < MROWS; r += nb * NW) {
        const bf16_t* o1 = O12 + (size_t)r * 2048 + (2 * hd) * 128 + sub * 16, *o2 = o1 + 128;
        float a[16], c[16];
        unpack8(*(const u32x4*)o1, *(float(*)[8])a); unpack8(*(const u32x4*)(o1 + 8), *(float(*)[8])(a + 8));
        unpack8(*(const u32x4*)o2, *(float(*)[8])c); unpack8(*(const u32x4*)(o2 + 8), *(float(*)[8])(c + 8));
        float ss = 0.f;
#pragma unroll
        for (int e = 0; e < 16; ++e) { a[e] -= lam_full * c[e]; ss += a[e] * a[e]; }
        ss += __shfl_xor(ss, 1); ss += __shfl_xor(ss, 2); ss += __shfl_xor(ss, 4);
        const float rs = rsqrtf(ss * (1.0f / 128.0f) + EPS) * (1.0f - lambda_init);
#pragma unroll
        for (int e = 0; e < 16; ++e) a[e] *= rs * subln[sub * 16 + e];
        bf16_t* o = Oc + (size_t)r * 1024 + hd * 128 + sub * 16;
        *(u32x4*)o = pack8(*(float(*)[8])a); *(u32x4*)(o + 8) = pack8(*(float(*)[8])(a + 8));
    }
}


typedef short s16x4 __attribute__((ext_vector_type(4)));
typedef float f32x2_t __attribute__((ext_vector_type(2)));
typedef __bf16 bf16x2_t __attribute__((ext_vector_type(2)));
DI unsigned cvtpk(float lo, float hi) { f32x2_t v = {lo, hi}; bf16x2_t b = __builtin_convertvector(v, bf16x2_t); return __builtin_bit_cast(unsigned, b); }
DI float xhalf_max(float v) { auto rr = __builtin_amdgcn_permlane32_swap(__float_as_uint(v), __float_as_uint(v), false, false); return fmaxf(__uint_as_float(rr[0]), __uint_as_float(rr[1])); }
DI float xhalf_sum(float v) { auto rr = __builtin_amdgcn_permlane32_swap(__float_as_uint(v), __float_as_uint(v), false, false); return __uint_as_float(rr[0]) + __uint_as_float(rr[1]); }
typedef short v4i16_t __attribute__((__vector_size__(4 * sizeof(short))));
DI s16x4 lds_tr(lds_ptr p) { return __builtin_bit_cast(s16x4, __builtin_amdgcn_ds_read_tr16_b64_v4i16((LAS v4i16_t*)p)); }
constexpr float ATT_BIG = 40.0f, ATT_BIGF = 1.0995116e12f;
DI int crow(int i, int hf) { return (i & 3) + 8 * (i >> 2) + 4 * hf; }

struct AttnP { const bf16_t* Q; int ldq; const bf16_t* K; int ldk; const bf16_t* V; int ldv; bf16_t* O; int ldo; int HQ; int gk; int gv; int vhs  ; const float* bias; const float* sink; int need_ctx; const float* kgain  ; const float* lam; const float* subln; bf16_t* Oc;   };

template <int DQ, int DV, int MODE, int ABL = 0>
DI void attn_mfma(const AttnP& a, unsigned char* smem, int bid, int nb, int tid) {
    constexpr int KSTR = DQ * 2 + 16, KTB = 64 * KSTR, VTB = 64 * DV * 2, NDB = DV / 32, NKK = DQ / 16;
    constexpr int KCH = DQ / 8, VCH = DV / 8, NKI = (64 * KCH + NTHREADS - 1) / NTHREADS, NVI = (64 * VCH + NTHREADS - 1) / NTHREADS;
    static_assert(2 * KTB + 2 * VTB + 2048 <= GEMM_LDS, "attention LDS");
    const lds_ptr lds = (lds_ptr)smem;
    LAS float* biasl = (LAS float*)(lds + 2 * KTB + 2 * VTB);
    const int lane = tid & 63, wid = __builtin_amdgcn_readfirstlane(tid >> 6), r = lane & 31, hf = lane >> 5;
    const int nq = a.need_ctx ? 17 : 16;
    const int xcd = bid & 7, slot = bid >> 3, nslots = nb >> 3, per_xcd = (NBATCH * a.HQ / 8) * nq;
    int koff[NKI], kdst[NKI], voff[NVI], vdst[NVI];
#pragma unroll
    for (int i = 0; i < NKI; ++i) { const int c = min(tid + NTHREADS * i, 64 * KCH - 1), row = c / KCH, kc = c - row * KCH; koff[i] = row * a.ldk + kc * 8; kdst[i] = row * KSTR + kc * 16; }
#pragma unroll
    for (int i = 0; i < NVI; ++i) { const int c = tid + NTHREADS * i, row = c / VCH, vc = c - row * VCH; voff[i] = row * a.ldv + vc * 8; vdst[i] = ((row >> 3) * NDB + (vc >> 2)) * 512 + (row & 7) * 64 + (vc & 3) * 16; }
    const int i16 = lane & 15, trq = i16 >> 2, trp = i16 & 3, grp = (lane >> 4) & 1;
    const int vtr0 = (4 * hf + trq) * 64 + 32 * grp + 8 * trp;
    constexpr bool PAIRED = (MODE == 2 && DV == 128);
    float lam_full = 0.f;
    if (PAIRED) { const float s1 = wave_sum(a.lam[lane] * a.lam[64 + lane]), s2 = wave_sum(a.lam[128 + lane] * a.lam[192 + lane]); lam_full = expf(s1) - expf(s2) + (0.8f - 0.6f * 0.40656965974059917f); }
    int it_i = 0;
    for (int j = slot; j < per_xcd; j += nslots, ++it_i) {
        const int nbh = NBATCH * a.HQ / 8;
        const int bhl = j < nbh * 16 ? j >> 4 : j - nbh * 16;
        int qt = j < nbh * 16 ? j & 15 : 16;
        int bh = bhl * 8 + xcd;
        if (MODE == 1) { const int P = (bhl >> 2) * 8 + xcd; bh = (P >> 2) * a.HQ + (P & 3) * 4 + (bhl & 3); }
        if (PAIRED) { const int pu = slot + nslots * (it_i >> 1); qt = pu & 15; bh = (pu >> 4) * a.HQ + 2 * xcd + (it_i & 1); }
        const int h = bh % a.HQ, b = bh / a.HQ;
        const bool is_ctx = qt >= 16;
        const int q0 = is_ctx ? SEQ : qt * 256;
        int t_lo = 0, n_lat = 0;
        if (!is_ctx) {
            if (MODE == 2) { t_lo = 0; n_lat = 64; }
            else if (MODE == 1) { t_lo = max(0, 4 * qt - 2); n_lat = min(63, 4 * qt + 5) - t_lo + 1; }
            else { const int r0 = 4 * qt; t_lo = min(max(r0 - 4, 0), 56); n_lat = min(max(r0 - 1, 0), 56) + 7 - t_lo + 1; }
        }
        const int ntiles = n_lat + 4;
        const int qw0 = q0 + wid * 32, qpos = qw0 + r;
        const size_t qrow = (size_t)b * PP + qpos;
        bf16x8 qf[NKK];
#pragma unroll
        for (int kk = 0; kk < NKK; ++kk) qf[kk] = *(const bf16x8*)(a.Q + qrow * a.ldq + h * DQ + kk * 16 + hf * 8);
        if (MODE == 0 && !is_ctx) { for (int i = tid; i < 465; i += NTHREADS) biasl[i] = a.bias[h * 465 + i] * LOG2E; }
        const bf16_t* Kg = a.K + (size_t)b * PP * a.ldk + (h >> a.gk) * DQ;
        const bf16_t* Vg = a.V + (size_t)b * PP * a.ldv + (h >> a.gv) * a.vhs;
        f32x16 o[NDB];
#pragma unroll
        for (int d = 0; d < NDB; ++d)
#pragma unroll
            for (int i = 0; i < 16; ++i) o[d][i] = 0.f;
        float mref = 0.f, l = 0.f;
        f32x16 negm;
#pragma unroll
        for (int i = 0; i < 16; ++i) negm[i] = 0.f;
        bool first = true;
        float lbig = 0.f;
        float one = 1.0f; asm volatile("" : "+v"(one));
#define ATT_TILE(IT) ((IT) < n_lat ? t_lo + (IT) : 64 + ((IT) - n_lat))
        auto tile_active = [&](int t) -> bool {
            if (t >= 64) return true;
            if (MODE == 1) return (t * 64 + 63 >= qw0 - 128) && (t * 64 <= qw0 + 31 + 128);
            if (MODE == 0) { const int rw = qw0 >> 6, row0 = min(max(rw - 4, 0), 56); return t >= row0 && t < row0 + 8; }
            return true;
        };
        auto qk = [&](f32x16 (&s)[2], const lds_ptr Kb) {
#pragma unroll
            for (int kk = 0; kk < NKK; ++kk)
#pragma unroll
                for (int kb = 0; kb < 2; ++kb) {
                    if (ABL & 4) { if (kk == 0) s[kb] = negm; }
                    else {
                    const bf16x8 kf = *(const LAS bf16x8*)(Kb + (kb * 32 + r) * KSTR + (kk * 2 + hf) * 16);
                    s[kb] = MFMA32(kf, qf[kk], kk == 0 ? negm : s[kb]);
                    }
                }
        };
        u32x4 kr[NKI], vr[NVI];
        {
            const int t0 = ATT_TILE(0), t1 = ATT_TILE(1);
            u32x4 k1[NKI];
#pragma unroll
            for (int i = 0; i < NKI; ++i) kr[i] = *(const u32x4*)(Kg + (size_t)t0 * 64 * a.ldk + koff[i]);
#pragma unroll
            for (int i = 0; i < NVI; ++i) vr[i] = *(const u32x4*)(Vg + (size_t)t0 * 64 * a.ldv + voff[i]);
#pragma unroll
            for (int i = 0; i < NKI; ++i) k1[i] = *(const u32x4*)(Kg + (size_t)t1 * 64 * a.ldk + koff[i]);
#pragma unroll
            for (int i = 0; i < NKI; ++i) { *(LAS u32x4*)(lds + kdst[i]) = kr[i]; *(LAS u32x4*)(lds + KTB + kdst[i]) = k1[i]; }
#pragma unroll
            for (int i = 0; i < NVI; ++i) *(LAS u32x4*)(lds + 2 * KTB + vdst[i]) = vr[i];
        }
        __syncthreads();
        f32x16 sc[2], sn[2];
        bool act_cur = tile_active(ATT_TILE(0)), act_nxt = false;
        if (act_cur) qk(sc, lds);
        __syncthreads();
        auto step = [&](const int it, const int e, const bool N2, const bool N1) {
            const int t = ATT_TILE(it);
            if (N2 && !(ABL & 8) && (!(ABL & 128) || e)) {
                const int tn = ATT_TILE(it + 2);
#pragma unroll
                for (int i = 0; i < NKI; ++i) kr[i] = *(const u32x4*)(Kg + (size_t)tn * 64 * a.ldk + koff[i]);
            }
            if (N1 && !(ABL & 8) && (!(ABL & 128) || e)) {
                const int tn = ATT_TILE(it + 1);
#pragma unroll
                for (int i = 0; i < NVI; ++i) vr[i] = *(const u32x4*)(Vg + (size_t)tn * 64 * a.ldv + voff[i]);
            }
            SCHED_FENCE();
            act_nxt = N1 && (MODE == 2 || tile_active(ATT_TILE(it + 1)));
            const lds_ptr Vb = lds + 2 * KTB + e * VTB;
            const bool do_cur = MODE == 2 || act_cur;
            if (do_cur) {
                if (t < 64 && MODE == 1 && !((t * 64 + 63 - qw0 <= 128) && (qw0 + 31 - t * 64 <= 128))) {
                    const int dbase = t * 64 + 4 * hf - qpos;
#pragma unroll
                    for (int kb = 0; kb < 2; ++kb)
#pragma unroll
                        for (int i = 0; i < 16; ++i) { const int c = kb * 32 + (i & 3) + 8 * (i >> 2); sc[kb][i] = (dbase > 128 - c || dbase < -128 - c) ? -INFINITY : sc[kb][i]; }
                }
                if (t < 64 && MODE == 0) {
                    const int qc = qpos & 63, rw = qpos >> 6, col0 = min(max(qc - 8, 0), 48);
                    const int brow = (t - rw + 7) * 31 + 15 - qc;
#pragma unroll
                    for (int kb = 0; kb < 2; ++kb)
#pragma unroll
                        for (int i = 0; i < 16; ++i) {
                            const int kc = kb * 32 + crow(i, hf);
                            const bool ok = kc >= col0 && kc < col0 + 16;
                            const float bv = biasl[ok ? brow + kc : 0];
                            sc[kb][i] = ok ? sc[kb][i] + bv : -INFINITY;
                        }
                }
                if (first || __builtin_amdgcn_ballot_w64(lbig > ATT_BIGF) != 0ull) {
                    float delta = lbig > ATT_BIGF ? ATT_BIG : 0.f;
                    if (first) {
                        float mx = sc[0][0];
#pragma unroll
                        for (int i = 1; i < 16; ++i) mx = fmaxf(mx, sc[0][i]);
#pragma unroll
                        for (int i = 0; i < 16; ++i) mx = fmaxf(mx, sc[1][i]);
                        mx = xhalf_max(mx);
                        delta = mx > -INFINITY ? mx : 0.f;
                    }
                    const float alpha = __builtin_amdgcn_exp2f(-delta);
                    l *= alpha; mref += delta;
#pragma unroll
                    for (int d = 0; d < NDB; ++d)
#pragma unroll
                        for (int i = 0; i < 16; ++i) o[d][i] *= alpha;
#pragma unroll
                    for (int kb = 0; kb < 2; ++kb)
#pragma unroll
                        for (int i = 0; i < 16; ++i) sc[kb][i] -= delta;
#pragma unroll
                    for (int i = 0; i < 16; ++i) negm[i] = -mref;
                    first = false;
                }
            }
            if (N1) qk(sn, lds + (e ^ 1) * KTB);
            if (do_cur) {
                float ls0 = 0.f, ls1 = 0.f;
#pragma unroll
                for (int kb = 0; kb < 2; ++kb)
#pragma unroll
                    for (int i = 0; i < 16; i += 2) {
                        const float p0 = (ABL & 1) ? sc[kb][i] : __builtin_amdgcn_exp2f(sc[kb][i]), p1 = (ABL & 1) ? sc[kb][i + 1] : __builtin_amdgcn_exp2f(sc[kb][i + 1]);
                        sc[kb][i] = p0; sc[kb][i + 1] = p1;
                        if (!(ABL & 16)) { ls0 += p0; ls1 = __builtin_fmaf(p1, one, ls1); }
                    }
                lbig = ls0 + ls1;
                l += lbig;
                bf16x8 pf[4];
#pragma unroll
                for (int kb = 0; kb < 2; ++kb)
#pragma unroll
                    for (int sp = 0; sp < 2; ++sp) {
                        u32x4 w;
                        w.x = cvtpk(sc[kb][8 * sp], sc[kb][8 * sp + 1]); w.y = cvtpk(sc[kb][8 * sp + 2], sc[kb][8 * sp + 3]);
                        w.z = cvtpk(sc[kb][8 * sp + 4], sc[kb][8 * sp + 5]); w.w = cvtpk(sc[kb][8 * sp + 6], sc[kb][8 * sp + 7]);
                        pf[kb * 2 + sp] = __builtin_bit_cast(bf16x8, w);
                    }
#pragma unroll
                for (int ks = 0; ks < 4; ++ks)
#pragma unroll
                    for (int d = 0; d < NDB; ++d) {
                        const lds_ptr vp = Vb + ((2 * ks) * NDB + d) * 512 + vtr0;
                        const s16x4 lo = lds_tr(vp), hi = lds_tr(vp + NDB * 512);
                        const bf16x8 vf = __builtin_shufflevector(lo, hi, 0, 1, 2, 3, 4, 5, 6, 7);
                        if (ABL & 2) { if (d == 0 && ks == 0) o[0][0] += __builtin_bit_cast(float, pf[0][0] | pf[1][0] | pf[2][0] | pf[3][0]) + __builtin_bit_cast(float, (int)vf[0]); } else
                        o[d] = MFMA32(vf, pf[ks], o[d]);
                    }
            }
            SCHED_FENCE();
            if (N2 && !(ABL & 8) && (!(ABL & 128) || e)) {
#pragma unroll
                for (int i = 0; i < NKI; ++i) *(LAS u32x4*)(lds + e * KTB + kdst[i]) = kr[i];
            }
            if (N1 && !(ABL & 8) && (!(ABL & 128) || e)) {
#pragma unroll
                for (int i = 0; i < NVI; ++i) *(LAS u32x4*)(lds + 2 * KTB + (e ^ 1) * VTB + vdst[i]) = vr[i];
            }
            if (!(ABL & 64) && (!(ABL & 128) || e)) __syncthreads();
#pragma unroll
            for (int kb = 0; kb < 2; ++kb) sc[kb] = sn[kb];
            act_cur = act_nxt;
        };
        int it = 0;
        for (; it + 3 < ntiles; it += 2) { step(it, 0, true, true); step(it + 1, 1, true, true); }
        if (ntiles - it == 3) { step(it, 0, true, true); step(it + 1, 1, false, true); step(it + 2, 0, false, false); }
        else { step(it, 0, false, true); step(it + 1, 1, false, false); }
#undef ATT_TILE
        l = xhalf_sum(l);
        if (a.sink) {
            l += __builtin_amdgcn_exp2f(a.sink[h] * LOG2E - mref);
        }
        const float inv = 1.0f / l;
        bf16_t* orow = a.O + qrow * a.ldo + h * DV + 4 * hf;
#pragma unroll
        for (int d = 0; d < NDB; ++d)
#pragma unroll
            for (int g = 0; g < 4; ++g) {
                u32x2 w; w.x = cvtpk(o[d][4 * g] * inv, o[d][4 * g + 1] * inv); w.y = cvtpk(o[d][4 * g + 2] * inv, o[d][4 * g + 3] * inv);
                *(u32x2*)(orow + d * 32 + 8 * g) = w;
            }
        if (PAIRED && (it_i & 1)) {
            asm volatile("s_waitcnt vmcnt(0)" ::: "memory");
            const float lambda_init = 0.8f - 0.6f * 0.40656965974059917f;
            const int sub = lane & 7, pair = h >> 1;
#pragma unroll
            for (int i4 = 0; i4 < 4; ++i4) {
                const size_t row = (size_t)b * PP + qw0 + i4 * 8 + (lane >> 3);
                const bf16_t* o1 = a.O + row * a.ldo + (2 * pair) * 128 + sub * 16, *o2 = o1 + 128;
                float av[16], cv[16];
                unpack8(*(const u32x4*)o1, *(float(*)[8])av); unpack8(*(const u32x4*)(o1 + 8), *(float(*)[8])(av + 8));
                unpack8(*(const u32x4*)o2, *(float(*)[8])cv); unpack8(*(const u32x4*)(o2 + 8), *(float(*)[8])(cv + 8));
                float ss = 0.f;
#pragma unroll
                for (int e = 0; e < 16; ++e) { av[e] -= lam_full * cv[e]; ss += av[e] * av[e]; }
                ss += __shfl_xor(ss, 1); ss += __shfl_xor(ss, 2); ss += __shfl_xor(ss, 4);
                const float rs = rsqrtf(ss * (1.0f / 128.0f) + EPS) * (1.0f - lambda_init);
#pragma unroll
                for (int e = 0; e < 16; ++e) av[e] *= rs * a.subln[sub * 16 + e];
                bf16_t* oc = a.Oc + row * 1024 + pair * 128 + sub * 16;
                *(u32x4*)oc = pack8(*(float(*)[8])av); *(u32x4*)(oc + 8) = pack8(*(float(*)[8])(av + 8));
            }
        }
    }
}

DI void attn_na(const AttnP& a, unsigned char* smem, int bid, int nb, int tid) {
    constexpr int DQ = 64, DV = 64, KSTR = DQ * 2 + 16, KTB = 64 * KSTR, VTB = 64 * DV * 2, NDB = 2, NKK = 4;
    const lds_ptr lds = (lds_ptr)smem;
    constexpr int BZ_TAB = 32, BZ_HEAD = 560, BZ_NINF = 16 * BZ_HEAD, BZ_N = BZ_NINF + 64;
    static_assert(4 * KTB + 4 * VTB + (BZ_N + 16) * 4 <= GEMM_LDS, "NA LDS");
    LAS float* biasl = (LAS float*)(lds + 4 * KTB + 4 * VTB);
    for (int i = tid; i < BZ_N; i += NTHREADS) {
        const int hh = i / BZ_HEAD, o = i - hh * BZ_HEAD;
        biasl[i] = i >= BZ_NINF ? -INFINITY : (o >= BZ_TAB && o < BZ_TAB + 465) ? a.bias[hh * 465 + o - BZ_TAB] * LOG2E : 0.f;
    }
    __syncthreads();
    {
        const int wv = __builtin_amdgcn_readfirstlane(tid >> 6), ln = tid & 63;
#pragma unroll
        for (int hh2 = 0; hh2 < 2; ++hh2) {
            const int hh = 2 * wv + hh2;
            float m = 0.f;
            for (int i = ln; i < 465; i += 64) m = fmaxf(m, biasl[hh * BZ_HEAD + BZ_TAB + i]);
#pragma unroll
            for (int d = 32; d >= 1; d >>= 1) m = fmaxf(m, __shfl_xor(m, d));
            if (ln == 0) biasl[BZ_N + hh] = m;
        }
    }
    float kmax = fabsf(a.kgain[tid & 63]);
#pragma unroll
    for (int d = 32; d >= 1; d >>= 1) kmax = fmaxf(kmax, __shfl_xor(kmax, d));
    kmax *= 8.0f * 1.01f;
    const int lane = tid & 63, wid = __builtin_amdgcn_readfirstlane(tid >> 6), r = lane & 31, hf = lane >> 5;
    const int nq = a.need_ctx ? 17 : 16;
    const int xcd = bid & 7, slot = bid >> 3, nslots = nb >> 3, per_xcd = (NBATCH * a.HQ / 8) * nq;
    const int krow_s = tid >> 3, kc_s = tid & 7;
    const int koff = krow_s * a.ldk + kc_s * 8, kdst = krow_s * KSTR + kc_s * 16, voff = krow_s * a.ldv + kc_s * 8;
    const int vdst = ((krow_s >> 3) * NDB + (kc_s >> 2)) * 512 + (krow_s & 7) * 64 + (kc_s & 3) * 16;
    const int i16 = lane & 15, trq = i16 >> 2, trp = i16 & 3, grp = (lane >> 4) & 1;
    const int vtr0 = (4 * hf + trq) * 64 + 32 * grp + 8 * trp;
    const int rp = wid >> 2, cq = wid & 3, k0 = cq == 0 ? 0 : cq == 1 ? 8 : cq == 2 ? 24 : 32;
    float one = 1.0f; asm volatile("" : "+v"(one));
    auto unit_of = [&](int j, int& b, int& h, int& qt, int& t_lo, int& n_lat) {
        const int nbh = NBATCH * a.HQ / 8;
        const int bhl = j < nbh * 16 ? j >> 4 : j - nbh * 16; qt = j < nbh * 16 ? j & 15 : 16;
        const int bh = bhl * 8 + xcd; h = bh % a.HQ; b = bh / a.HQ;
        t_lo = 0; n_lat = 0;
        if (qt < 16) { const int r0 = 4 * qt; t_lo = min(max(r0 - 4, 0), 56); n_lat = min(max(r0 - 1, 0), 56) + 7 - t_lo + 1; n_lat += n_lat & 1; }
    };
#define NA_TILE_OF(IT, TLO, NLAT) ((IT) < (NLAT) ? (TLO) + (IT) : 64 + ((IT) - (NLAT)))
    bf16x8 qf[NKK];
    u32x4 krA[2], vrA[2], krB[2], vrB[2];
    auto load_pair = [&](u32x4 (&kr)[2], u32x4 (&vr)[2], const bf16_t* Kg, const bf16_t* Vg, int t_lo, int n_lat, int pr) {
#pragma unroll
        for (int jj = 0; jj < 2; ++jj) {
            const int tn = NA_TILE_OF(2 * pr + jj, t_lo, n_lat);
            kr[jj] = *(const u32x4*)(Kg + (size_t)tn * 64 * a.ldk + koff); vr[jj] = *(const u32x4*)(Vg + (size_t)tn * 64 * a.ldv + voff);
        }
    };
    auto store_pair = [&](const u32x4 (&kr)[2], const u32x4 (&vr)[2], int e) {
#pragma unroll
        for (int jj = 0; jj < 2; ++jj) { *(LAS u32x4*)(lds + (2 * e + jj) * KTB + kdst) = kr[jj]; *(LAS u32x4*)(lds + 4 * KTB + (2 * e + jj) * VTB + vdst) = vr[jj]; }
    };
    auto qrow_of = [&](int b, int qt) -> size_t { const int qpos = qt >= 16 ? SEQ + wid * 32 + r : (4 * qt + 2 * rp + (r >> 4)) * 64 + 16 * cq + (r & 15); return (size_t)b * PP + qpos; };
    auto load_q = [&](int b, int h, int qt) {
        const size_t qrow = qrow_of(b, qt);
#pragma unroll
        for (int kk = 0; kk < NKK; ++kk) qf[kk] = *(const bf16x8*)(a.Q + qrow * a.ldq + h * DQ + kk * 16 + hf * 8);
    };
    if (slot >= per_xcd) return;
    int b, h, qt, t_lo, n_lat;
    unit_of(slot, b, h, qt, t_lo, n_lat);
    {
        load_q(b, h, qt);
        const bf16_t* Kg = a.K + (size_t)b * PP * a.ldk + h * DQ; const bf16_t* Vg = a.V + (size_t)b * PP * a.ldv + h * a.vhs;
        load_pair(krA, vrA, Kg, Vg, t_lo, n_lat, 0); store_pair(krA, vrA, 0); load_pair(krB, vrB, Kg, Vg, t_lo, n_lat, 1);
    }
    __syncthreads();
    for (int j = slot;;) {
        const int jn = j + nslots; const bool has_next = jn < per_xcd;
        int nb_, nh, nqt, nt_lo, nn_lat;
        unit_of(has_next ? jn : j, nb_, nh, nqt, nt_lo, nn_lat);
        const bf16_t* nKg = a.K + (size_t)nb_ * PP * a.ldk + nh * DQ; const bf16_t* nVg = a.V + (size_t)nb_ * PP * a.ldv + nh * a.vhs;
        const bool is_ctx = qt >= 16;
        const int r0 = 4 * qt;
        const int npair = (n_lat + 4) >> 1;
        const int qrw = r0 + 2 * rp + (r >> 4), qc = 16 * cq + (r & 15);
        const size_t qrow = qrow_of(b, qt);
        const bf16_t* Kg = a.K + (size_t)b * PP * a.ldk + h * DQ;
        const bf16_t* Vg = a.V + (size_t)b * PP * a.ldv + h * a.vhs;
        const int rwA = r0 + 2 * rp, wlo = min(max(rwA - 4, 0), 56), whi = min(max(rwA - 3, 0), 56) + 7;
        const int col0 = min(max(qc - 8, 0), 48), row0q = min(max(qrw - 4, 0), 56);
        const int lanebase = h * BZ_HEAD + BZ_TAB + (7 - qrw) * 31 + 15 - qc + k0 + 4 * hf;
        f32x16 o[NDB];
#pragma unroll
        for (int d = 0; d < NDB; ++d)
#pragma unroll
            for (int i = 0; i < 16; ++i) o[d][i] = 0.f;
        float l = 0.f;
        float qn2 = 0.f;
#pragma unroll
        for (int kk = 0; kk < NKK; ++kk)
#pragma unroll
            for (int jj = 0; jj < 8; ++jj) { const float qv = bf2f((bf16_t)qf[kk][jj]); qn2 = __builtin_fmaf(qv, qv, qn2); }
        qn2 = xhalf_sum(qn2);
        const float mref = __builtin_sqrtf(qn2) * kmax + biasl[BZ_N + h];
        f32x16 negmL;
#pragma unroll
        for (int i = 0; i < 16; ++i) { const int kc = k0 + crow(i, hf); negmL[i] = (kc >= col0 && kc < col0 + 16) ? -mref : -INFINITY; }
#define NA_TILE(IT) NA_TILE_OF(IT, t_lo, n_lat)
        auto ctx_tile = [&](const lds_ptr Kb, const lds_ptr Vb) {
            {
                f32x16 s[2], negm;
#pragma unroll
                for (int i = 0; i < 16; ++i) negm[i] = -mref;
#pragma unroll
                for (int kk = 0; kk < NKK; ++kk)
#pragma unroll
                    for (int kb = 0; kb < 2; ++kb) {
                        const bf16x8 kf = *(const LAS bf16x8*)(Kb + (kb * 32 + r) * KSTR + (kk * 2 + hf) * 16);
                        s[kb] = MFMA32(kf, qf[kk], kk == 0 ? negm : s[kb]);
                    }
                float ls0 = 0.f, ls1 = 0.f;
                bf16x8 pf[4];
#pragma unroll
                for (int kb = 0; kb < 2; ++kb) {
#pragma unroll
                    for (int i = 0; i < 16; i += 2) {
                        const float p0 = __builtin_amdgcn_exp2f(s[kb][i]), p1 = __builtin_amdgcn_exp2f(s[kb][i + 1]);
                        s[kb][i] = p0; s[kb][i + 1] = p1; ls0 += p0; ls1 = __builtin_fmaf(p1, one, ls1);
                    }
#pragma unroll
                    for (int sp = 0; sp < 2; ++sp) {
                        u32x4 w;
                        w.x = cvtpk(s[kb][8 * sp], s[kb][8 * sp + 1]); w.y = cvtpk(s[kb][8 * sp + 2], s[kb][8 * sp + 3]);
                        w.z = cvtpk(s[kb][8 * sp + 4], s[kb][8 * sp + 5]); w.w = cvtpk(s[kb][8 * sp + 6], s[kb][8 * sp + 7]);
                        pf[kb * 2 + sp] = __builtin_bit_cast(bf16x8, w);
                    }
                }
                l += ls0 + ls1;
#pragma unroll
                for (int ks = 0; ks < 4; ++ks)
#pragma unroll
                    for (int d = 0; d < NDB; ++d) {
                        const lds_ptr vp = Vb + ((2 * ks) * NDB + d) * 512 + vtr0;
                        const s16x4 lo = lds_tr(vp), hi = lds_tr(vp + NDB * 512);
                        o[d] = MFMA32(__builtin_shufflevector(lo, hi, 0, 1, 2, 3, 4, 5, 6, 7), pf[ks], o[d]);
                    }
            }
        };
        auto lat_tile = [&](const int t, const lds_ptr Kb, const lds_ptr Vb) {
            bf16x8 pf[2];
#pragma unroll
            for (int sp = 0; sp < 2; ++sp)
#pragma unroll
                for (int jj = 0; jj < 8; ++jj) pf[sp][jj] = 0;
            if (t >= wlo && t <= whi) {
                f32x16 s;
#pragma unroll
                for (int kk = 0; kk < NKK; ++kk) {
                    const bf16x8 kf = *(const LAS bf16x8*)(Kb + (k0 + r) * KSTR + (kk * 2 + hf) * 16);
                    s = MFMA32(kf, qf[kk], kk == 0 ? negmL : s);
                }
                const LAS float* bp = biasl + (((unsigned)(t - row0q) < 8u) ? lanebase + 31 * t : BZ_NINF);
#pragma unroll
                for (int i = 0; i < 16; ++i) s[i] += bp[crow(i, 0)];
                float ls0 = 0.f, ls1 = 0.f;
#pragma unroll
                for (int i = 0; i < 16; i += 2) {
                    const float p0 = __builtin_amdgcn_exp2f(s[i]), p1 = __builtin_amdgcn_exp2f(s[i + 1]);
                    s[i] = p0; s[i + 1] = p1; ls0 += p0; ls1 = __builtin_fmaf(p1, one, ls1);
                }
#pragma unroll
                for (int sp = 0; sp < 2; ++sp) {
                    u32x4 w;
                    w.x = cvtpk(s[8 * sp], s[8 * sp + 1]); w.y = cvtpk(s[8 * sp + 2], s[8 * sp + 3]);
                    w.z = cvtpk(s[8 * sp + 4], s[8 * sp + 5]); w.w = cvtpk(s[8 * sp + 6], s[8 * sp + 7]);
                    pf[sp] = __builtin_bit_cast(bf16x8, w);
                }
                l += ls0 + ls1;
            }
#pragma unroll
            for (int ks = 0; ks < 2; ++ks)
#pragma unroll
                for (int d = 0; d < NDB; ++d) {
                    const lds_ptr vp = Vb + (((k0 >> 3) + 2 * ks) * NDB + d) * 512 + vtr0;
                    const s16x4 lo = lds_tr(vp), hi = lds_tr(vp + NDB * 512);
                    o[d] = MFMA32(__builtin_shufflevector(lo, hi, 0, 1, 2, 3, 4, 5, 6, 7), pf[ks], o[d]);
                }
        };
#define NA_ITER(IP, E, KL, VL, KS, VS, LAT) do { \
            if ((IP) + 2 < npair) load_pair(KL, VL, Kg, Vg, t_lo, n_lat, (IP) + 2); \
            else if (has_next) load_pair(KL, VL, nKg, nVg, nt_lo, nn_lat, (IP) + 2 - npair); \
            SCHED_FENCE(); \
            if (LAT) { lat_tile(t_lo + 2 * (IP), lds + (2 * (E)) * KTB, lds + 4 * KTB + (2 * (E)) * VTB); lat_tile(t_lo + 2 * (IP) + 1, lds + (2 * (E) + 1) * KTB, lds + 4 * KTB + (2 * (E) + 1) * VTB); } \
            else { ctx_tile(lds + (2 * (E)) * KTB, lds + 4 * KTB + (2 * (E)) * VTB); ctx_tile(lds + (2 * (E) + 1) * KTB, lds + 4 * KTB + (2 * (E) + 1) * VTB); } \
            SCHED_FENCE(); \
            if ((IP) + 1 < npair || has_next) store_pair(KS, VS, (E) ^ 1); \
            __syncthreads(); } while (0)
        int ip = 0;
        for (; ip < (n_lat >> 1); ip += 2) { NA_ITER(ip, 0, krA, vrA, krB, vrB, true); NA_ITER(ip + 1, 1, krB, vrB, krA, vrA, true); }
        NA_ITER(ip, 0, krA, vrA, krB, vrB, false); NA_ITER(ip + 1, 1, krB, vrB, krA, vrA, false);
#undef NA_ITER
        if (has_next) load_q(nb_, nh, nqt);
#undef NA_TILE
        l = xhalf_sum(l);
        const float inv = 1.0f / l;
        bf16_t* orow = a.O + qrow * a.ldo + h * DV + 4 * hf;
#pragma unroll
        for (int d = 0; d < NDB; ++d)
#pragma unroll
            for (int g = 0; g < 4; ++g) {
                u32x2 w; w.x = cvtpk(o[d][4 * g] * inv, o[d][4 * g + 1] * inv); w.y = cvtpk(o[d][4 * g + 2] * inv, o[d][4 * g + 3] * inv);
                *(u32x2*)(orow + d * 32 + 8 * g) = w;
            }
        if (!has_next) break;
        j = jn; b = nb_; h = nh; qt = nqt; t_lo = nt_lo; n_lat = nn_lat;
    }
#undef NA_TILE_OF
}

template <class E> struct epi_fp8 { static constexpr int value = 0; };
typedef int v8i_t __attribute__((ext_vector_type(8)));
typedef int v4i_t __attribute__((ext_vector_type(4)));
namespace pg8 {
constexpr int BM = 256, BK = 64, HALF = 128, HTB = HALF * BK * 2  ;
DI int lds_byte(int r, int c) { const int st = (r >> 4) * 2 + (c >> 5), rr = r & 15, cc = c & 31, ob = rr * 64 + cc * 2; return st * 1024 + (ob ^ (((ob >> 9) & 1) << 5)); }
DI void stage_rc(int b, int& R, int& C) { const int st = b / 1024, sb = b % 1024, swz = sb ^ (((sb >> 9) & 1) << 5); R = (st >> 1) * 16 + swz / 64; C = (st & 1) * 32 + (swz % 64) / 2; }
DI int perm32(int rho) { const int n = rho >> 4, i = rho & 15; return 8 * (i >> 2) + 4 * n + (i & 3); }

template <class Epi, class Sched>
DI void gemm_phase(lds_ptr lds, const bf16_t* __restrict__ Aop, const int K, const Sched& S, const Epi& E, const int tid) {
    const int wid = __builtin_amdgcn_readfirstlane(tid >> 6), lane = tid & 63, wr = wid >> 2, wc = wid & 3, fr = lane & 15, fq = lane >> 4;
    const int nt = K / BK;
    int Ra[2], Ca[2]; unsigned voffB[2];
#pragma unroll
    for (int i = 0; i < 2; ++i) { int R, C; stage_rc(tid * 16 + i * 8192, R, C); const int Rb = Epi::PERM ? ((R & ~31) + perm32(R & 31)) : R;
        Ra[i] = R; Ca[i] = C; voffB[i] = (unsigned)(Rb * K + C) * 2u; }
    const size_t kstep = (size_t)(BK * 2);
    const size_t hstep = (size_t)HALF * K * 2;
    const unsigned ldsw = (unsigned)wid * 1024u;
    const int aoff = lds_byte(wr * 64 + fr, fq * 8), boff = lds_byte(wc * 32 + fr, fq * 8);
#define PG8_SA(b, h) (((b) * 2 + (h)) * HTB)
#define PG8_SB(b, h) ((4 + (b) * 2 + (h)) * HTB)
#define PG8_STAGE(bufoff, gbase, voff) do { const char* _gb = (const char*)(gbase); asm volatile("" : "+s"(_gb)); _Pragma("unroll") for (int _i = 0; _i < 2; ++_i) { \
        unsigned _o = (voff)[_i]; asm volatile("" : "+v"(_o)); \
        __builtin_amdgcn_global_load_lds((const unsigned*)(_gb + _o), (LAS unsigned*)(lds + (bufoff) + ldsw + _i * 8192), 16, 0, 0); } } while (0)
#define PG8_LDA(dst, b, h) do { _Pragma("unroll") for (int m = 0; m < 4; ++m) _Pragma("unroll") for (int k = 0; k < 2; ++k) dst[m][k] = *(const LAS bf16x8*)(lds + PG8_SA(b, h) + aoff + m * 2048 + k * 1024); } while (0)
#define PG8_LDB(dst, b, h) do { _Pragma("unroll") for (int n = 0; n < 2; ++n) _Pragma("unroll") for (int k = 0; k < 2; ++k) dst[n][k] = *(const LAS bf16x8*)(lds + PG8_SB(b, h) + boff + n * 2048 + k * 1024); } while (0)
typedef long i64x2_t __attribute__((ext_vector_type(2)));
#define PG8_MMA(ai, bj, At, Bt) do { __builtin_amdgcn_s_setprio(1); _Pragma("unroll") for (int m = 0; m < 4; ++m) _Pragma("unroll") for (int n = 0; n < 2; ++n) { \
        if (epi_fp8<Epi>::value == 2) { \
            const v8i_t _b = __builtin_shufflevector(__builtin_bit_cast(v4i_t, Bt[n][0]), __builtin_bit_cast(v4i_t, Bt[n][1]), 0, 1, 2, 3, 4, 5, 6, 7); \
            const v8i_t _a = __builtin_shufflevector(__builtin_bit_cast(v4i_t, At[m][0]), __builtin_bit_cast(v4i_t, At[m][1]), 0, 1, 2, 3, 4, 5, 6, 7); \
            acc[ai][bj][m][n] = __builtin_amdgcn_mfma_scale_f32_16x16x128_f8f6f4(_b, _a, acc[ai][bj][m][n], 0, 0, 0, 0, 0, 0); \
        } else { _Pragma("unroll") for (int k = 0; k < 2; ++k) { \
        if (epi_fp8<Epi>::value == 1) { const i64x2_t _b = __builtin_bit_cast(i64x2_t, Bt[n][k]), _a = __builtin_bit_cast(i64x2_t, At[m][k]); \
            acc[ai][bj][m][n] = __builtin_amdgcn_mfma_f32_16x16x32_fp8_fp8(_b[0], _a[0], acc[ai][bj][m][n], 0, 0, 0); \
            acc[ai][bj][m][n] = __builtin_amdgcn_mfma_f32_16x16x32_fp8_fp8(_b[1], _a[1], acc[ai][bj][m][n], 0, 0, 0); } \
        else acc[ai][bj][m][n] = __builtin_amdgcn_mfma_f32_16x16x32_bf16(Bt[n][k], At[m][k], acc[ai][bj][m][n], 0, 0, 0); } } } \
        __builtin_amdgcn_s_setprio(0); } while (0)
#define PG8_WAIT_V(n) asm volatile("s_waitcnt vmcnt(" #n ")" ::: "memory")
#define PG8_WAIT_L(n) asm volatile("s_waitcnt lgkmcnt(" #n ")" ::: "memory")
#define PG8_BAR __builtin_amdgcn_s_barrier()
#define PG8_SCHED __builtin_amdgcn_sched_barrier(0)
    typename Sched::Unit cur, nxt; int ui = 0;
    if (!S.next(0, cur)) return;
    f32x4 acc[2][2][4][2];
#pragma unroll
    for (int a = 0; a < 2; ++a)
#pragma unroll
        for (int b = 0; b < 2; ++b)
#pragma unroll
            for (int m = 0; m < 4; ++m)
#pragma unroll
                for (int n = 0; n < 2; ++n) acc[a][b][m][n] = (f32x4){0.f, 0.f, 0.f, 0.f};
    bf16x8 At[4][2], B0[2][2], B1[2][2];
    constexpr bool GATHER = Sched::GATHER;
    unsigned oc[2][2], on[2][2] = {{0u, 0u}, {0u, 0u}};
    size_t ubc[2] = {0, 0}, ubn[2] = {0, 0};
#pragma unroll
    for (int h = 0; h < 2; ++h) {
        if (!GATHER) ubc[h] = (size_t)S.a_off(cur, h * HALF) * 2u;
#pragma unroll
        for (int i = 0; i < 2; ++i) oc[h][i] = GATHER ? (S.a_off(cur, h * HALF + Ra[i]) + (unsigned)Ca[i]) * 2u : (unsigned)(Ra[i] * S.lda + Ca[i]) * 2u;
    }
    const char* gA = (const char*)Aop;
    const char* cB = (const char*)S.b_base(cur);
    PG8_STAGE(PG8_SB(0, 0), cB, voffB); PG8_STAGE(PG8_SB(0, 1), cB + hstep, voffB); PG8_STAGE(PG8_SA(0, 0), gA + ubc[0], oc[0]); PG8_STAGE(PG8_SA(0, 1), gA + ubc[1], oc[1]);
    if (wr == 1) PG8_BAR;
    PG8_WAIT_V(2); PG8_BAR;
    PG8_STAGE(PG8_SB(1, 0), cB + kstep, voffB); PG8_STAGE(PG8_SA(1, 0), gA + ubc[0] + kstep, oc[0]); PG8_STAGE(PG8_SB(1, 1), cB + hstep + kstep, voffB);
    PG8_WAIT_V(6); PG8_BAR;
    for (;;) {
        const bool has_next = S.next(ui + 1, nxt);
        const char* nB = has_next ? (const char*)S.b_base(nxt) : cB;
#pragma unroll
        for (int h = 0; h < 2; ++h) {
            if (!GATHER) ubn[h] = has_next ? (size_t)S.a_off(nxt, h * HALF) * 2u : ubc[h];
#pragma unroll
            for (int i = 0; i < 2; ++i) if (GATHER) { int R, C; stage_rc(((wid << 6) | lane_now()) * 16 + i * 8192, R, C);
                const unsigned* ip = S.a_ptr(nxt, h * HALF + R); asm volatile("global_load_dword %0, %1, off" : "=v"(on[h][i]) : "v"(ip) : "memory"); }
        }
        const bool full = cur.half < 0;
        for (int t = 0; t < nt; t += 2) {
            const bool last = (t == nt - 2);
            const char* a1 = gA + (size_t)(t + 1) * kstep;
            const char* a2 = last ? gA : gA + (size_t)(t + 2) * kstep; const char* b2 = last ? nB : cB + (size_t)(t + 2) * kstep;
            const char* a3 = a2 + kstep; const char* b3 = b2 + kstep;
            size_t u2[2];
            if (GATHER && last) {
                asm volatile("" : "+v"(on[0][0]), "+v"(on[0][1]), "+v"(on[1][0]), "+v"(on[1][1]));
#pragma unroll
                for (int i = 0; i < 2; ++i) { int R, C; stage_rc(((wid << 6) | lane_now()) * 16 + i * 8192, R, C);
                    oc[0][i] = (S.a_cvt(on[0][i]) + (unsigned)C) * 2u; on[1][i] = (S.a_cvt(on[1][i]) + (unsigned)C) * 2u; }
            }
#pragma unroll
            for (int h = 0; h < 2; ++h) u2[h] = last ? ubn[h] : ubc[h];
            PG8_LDB(B0, 0, 0); PG8_LDB(B1, 0, 1); PG8_SCHED; PG8_LDA(At, 0, 0); PG8_STAGE(PG8_SA(1, 1), a1 + ubc[1], oc[1]);
            if (GATHER && last) { oc[1][0] = on[1][0]; oc[1][1] = on[1][1]; }
            PG8_WAIT_V(8); PG8_WAIT_L(0); PG8_BAR; PG8_MMA(0, 0, At, B0); PG8_MMA(0, 1, At, B1); PG8_BAR; PG8_SCHED;
            PG8_LDA(At, 0, 1); PG8_STAGE(PG8_SB(0, 0), b2, voffB); PG8_STAGE(PG8_SB(0, 1), b2 + hstep, voffB); PG8_STAGE(PG8_SA(0, 0), a2 + u2[0], oc[0]);
            PG8_WAIT_V(8); PG8_WAIT_L(0); PG8_BAR; if (full) { PG8_MMA(1, 0, At, B0); PG8_MMA(1, 1, At, B1); } PG8_BAR; PG8_SCHED;
            PG8_LDB(B0, 1, 0); PG8_LDB(B1, 1, 1); PG8_SCHED; PG8_LDA(At, 1, 0); PG8_STAGE(PG8_SA(0, 1), a2 + u2[1], oc[1]);
            PG8_WAIT_V(8); PG8_WAIT_L(0); PG8_BAR; PG8_MMA(0, 0, At, B0); PG8_MMA(0, 1, At, B1); PG8_BAR; PG8_SCHED;
            PG8_LDA(At, 1, 1); PG8_STAGE(PG8_SB(1, 0), b3, voffB); PG8_STAGE(PG8_SB(1, 1), b3 + hstep, voffB); PG8_STAGE(PG8_SA(1, 0), a3 + u2[0], oc[0]);
            PG8_WAIT_V(8); PG8_WAIT_L(0); PG8_BAR; if (full) { PG8_MMA(1, 0, At, B0); PG8_MMA(1, 1, At, B1); } PG8_BAR; PG8_SCHED;
        }
        if (wr == 0) PG8_BAR;
        { const int ln = lane_now(); E(acc, cur, wr, wc, ln & 15, ln >> 4); }
        if (!has_next) break;
#pragma unroll
        for (int a = 0; a < 2; ++a)
#pragma unroll
            for (int b = 0; b < 2; ++b)
#pragma unroll
                for (int m = 0; m < 4; ++m)
#pragma unroll
                    for (int n = 0; n < 2; ++n) acc[a][b][m][n] = (f32x4){0.f, 0.f, 0.f, 0.f};
        cur = nxt; cB = nB; ++ui;
#pragma unroll
        for (int h = 0; h < 2; ++h) ubc[h] = ubn[h];
        if (wr == 1) PG8_BAR;
    }
    PG8_WAIT_V(0);
    PG8_BAR;
#undef PG8_SA
#undef PG8_SB
#undef PG8_STAGE
#undef PG8_LDA
#undef PG8_LDB
#undef PG8_MMA
#undef PG8_WAIT_V
#undef PG8_WAIT_L
#undef PG8_BAR
#undef PG8_SCHED
}
}

struct DenseSched {
    static constexpr bool GATHER = false;
    struct Unit { int pm, pn, half; };
    int nM, nN, nwg, G, c; const bf16_t* Bt; int K, lda; bool skip_ctx;
    DI void unit_of(int L, Unit& u) const {
        int wgid = L; { const int q = nwg / 8, r = nwg % 8, xcd = wgid % 8, off = wgid / 8; wgid = (xcd < r ? xcd * (q + 1) : r * (q + 1) + (xcd - r) * q) + off; }
        const int nig = 8 * nN, gid = wgid / nig, fm = gid * 8, gsz = (nM - fm) < 8 ? (nM - fm) : 8;
        u.pm = fm + ((wgid % nig) % gsz); u.pn = (wgid % nig) / gsz;
        if (skip_ctx) u.pm += u.pm >> 4;
    }
    DI bool next(int i, Unit& u) const {
        const int rounds = nwg / G, rem = nwg - rounds * G;
        if (i < rounds) { unit_of(i * G + c, u); u.half = -1; return true; }
        if (i > rounds || rem == 0) return false;
        if (2 * rem <= G) { if (c >= 2 * rem) return false; unit_of(rounds * G + (c >> 1), u); u.half = c & 1; return true; }
        if (c >= rem) return false;
        unit_of(rounds * G + c, u); u.half = -1; return true;
    }
    DI unsigned a_off(const Unit& u, int row) const { const int rr = u.half < 0 ? row : u.half * 128 + (row & 127); return (unsigned)(u.pm * 256 + rr) * (unsigned)lda; }
    DI const unsigned* a_ptr(const Unit&, int) const { return nullptr; }
    DI unsigned a_cvt(unsigned raw) const { return raw; }
    DI const bf16_t* b_base(const Unit& u) const { return Bt + (size_t)u.pn * 256 * K; }
};
struct MoeUnit { int e, pn, valid, half; const unsigned* ent; };
template <bool TAIL>
struct MoeSched {
    static constexpr bool GATHER = true;
    typedef MoeUnit Unit;
    const LAS int* tab; const unsigned* list; const unsigned* zero  ; const bf16_t* W; int K, N, TN, lda, shift, G, c, nwg;
    DI bool unit_of(int L, Unit& u) const {
        const int v = tab[1 + (lane_now() & 31)];
        const int e = __builtin_popcount((unsigned)__ballot(v <= L));
        if (e >= NEXP) return false;
        const int rem = L - __builtin_amdgcn_readfirstlane(tab[e]), cn = __builtin_amdgcn_readfirstlane(tab[40 + e]);
        const int rt = rem / TN; u.e = e; u.pn = rem - rt * TN; u.ent = list + (size_t)e * MROWS + rt * 256; u.valid = min(256, cn - rt * 256); return true;
    }
    int lo, n, GX, j;
    DI void place() { GX = G >> 3; j = c >> 3; const int per = ((((nwg + 7) >> 3) + TN - 1) / TN) * TN; lo = (c & 7) * per; n = max(0, min(per, nwg - lo)); }
    DI bool next(int i, Unit& u) const {
        u.ent = zero; u.valid = 1;
        const int rounds = n / GX, rem = n - rounds * GX;
        if (!TAIL) { u.half = -1; if (i >= rounds) return false; return unit_of(lo + i * GX + j, u); }
        if (i > 0 || rem == 0) return false;
        if (2 * rem <= GX) {
            if (j >= 2 * rem) return false;
            if (!unit_of(lo + rounds * GX + (j >> 1), u)) return false;
            u.half = j & 1; u.ent += u.half * 128; u.valid = min(128, u.valid - u.half * 128);
            return u.valid > 0;
        }
        u.half = -1; if (j >= rem) return false;
        return unit_of(lo + rounds * GX + j, u);
    }
    DI unsigned a_off(const Unit& u, int row) const { const int rr = (TAIL && u.half >= 0) ? (row & 127) : row; return (u.ent[rr < u.valid ? rr : u.valid - 1] >> shift) * (unsigned)lda; }
    DI const unsigned* a_ptr(const Unit& u, int row) const { const int rr = (TAIL && u.half >= 0) ? (row & 127) : row; return u.ent + (rr < u.valid ? rr : u.valid - 1); }
    DI unsigned a_cvt(unsigned raw) const { return (raw >> shift) * (unsigned)lda; }
    DI const bf16_t* b_base(const Unit& u) const { return W + ((size_t)u.e * N + (size_t)u.pn * 256) * K; }
};
typedef float f32x4_t __attribute__((ext_vector_type(4)));
struct XEpiStore {
    static constexpr bool PERM = true;
    bf16_t* C; int ldc;
    DI void operator()(const f32x4 (&acc)[2][2][4][2], const DenseSched::Unit& u, int wr, int wc, int fr, int fq) const {
        const int row0 = u.pm * 256 + (u.half > 0 ? 128 : 0) + wr * 64 + fr, col0 = u.pn * 256 + wc * 32 + 8 * fq;
#pragma unroll
        for (int ai = 0; ai < 2; ++ai) if (ai == 0 || u.half < 0)
#pragma unroll
            for (int m = 0; m < 4; ++m) { bf16_t* rowp = C + (size_t)(row0 + ai * 128 + m * 16) * ldc + col0;
#pragma unroll
                for (int bj = 0; bj < 2; ++bj) { const f32x4 v0 = acc[ai][bj][m][0], v1 = acc[ai][bj][m][1];
                    u32x4 w; w.x = cvtpk(v0[0], v0[1]); w.y = cvtpk(v0[2], v0[3]); w.z = cvtpk(v1[0], v1[1]); w.w = cvtpk(v1[2], v1[3]);
                    *(u32x4*)(rowp + bj * 128) = w; } }
    } };
struct XEpiStore8 {
    static constexpr bool PERM = true;
    bf16_t* C; int ldc;
    DI void operator()(const f32x4 (&acc)[2][2][4][2], const DenseSched::Unit& u, int wr, int wc, int fr, int fq) const {
        const int row0 = u.pm * 256 + (u.half > 0 ? 128 : 0) + wr * 64 + fr, col0 = u.pn * 256 + wc * 32 + 8 * fq;
#pragma unroll
        for (int ai = 0; ai < 2; ++ai) if (ai == 0 || u.half < 0)
#pragma unroll
            for (int m = 0; m < 4; ++m) { bf16_t* rowp = C + (size_t)(row0 + ai * 128 + m * 16) * ldc + col0;
#pragma unroll
                for (int bj = 0; bj < 2; ++bj) { const f32x4 v0 = acc[ai][bj][m][0] * (1.0f / 32.0f), v1 = acc[ai][bj][m][1] * (1.0f / 32.0f);
                    u32x4 w; w.x = cvtpk(v0[0], v0[1]); w.y = cvtpk(v0[2], v0[3]); w.z = cvtpk(v1[0], v1[1]); w.w = cvtpk(v1[2], v1[3]);
                    *(u32x4*)(rowp + bj * 128) = w; } }
    } };
template <> struct epi_fp8<XEpiStore8> { static constexpr int value = 2; };
struct XEpiResid {
    static constexpr bool PERM = true;
    const Params* p; const float* mod;
    DI void operator()(const f32x4 (&acc)[2][2][4][2], const DenseSched::Unit& u, int wr, int wc, int fr, int fq) const {
        const int row0 = u.pm * 256 + (u.half > 0 ? 128 : 0) + wr * 64 + fr, col0 = u.pn * 256 + wc * 32 + 8 * fq;
#pragma unroll
        for (int ai = 0; ai < 2; ++ai) if (ai == 0 || u.half < 0)
#pragma unroll
            for (int m = 0; m < 4; ++m) { const int row = row0 + ai * 128 + m * 16;
                bf16_t* xr = xb_row(*p, row) + col0; const float* gp = mod + (size_t)mod_row(row) * 6144 + 2048 + col0;
#pragma unroll
                for (int bj = 0; bj < 2; ++bj) {
                    const u32x4 xw = *(const u32x4*)(xr + bj * 128); const f32x4 g0 = *(const f32x4*)(gp + bj * 128), g1 = *(const f32x4*)(gp + bj * 128 + 4);
                    const f32x4 a0 = acc[ai][bj][m][0], a1 = acc[ai][bj][m][1];
                    u32x4 w;
                    w.x = cvtpk(bflo(xw.x) + g0[0] * a0[0], bfhi(xw.x) + g0[1] * a0[1]); w.y = cvtpk(bflo(xw.y) + g0[2] * a0[2], bfhi(xw.y) + g0[3] * a0[3]);
                    w.z = cvtpk(bflo(xw.z) + g1[0] * a1[0], bfhi(xw.z) + g1[1] * a1[1]); w.w = cvtpk(bflo(xw.w) + g1[2] * a1[2], bfhi(xw.w) + g1[3] * a1[3]);
                    *(u32x4*)(xr + bj * 128) = w; } }
    } };
struct XEpiGlu {
    static constexpr bool PERM = true;
    bf16_t* act; const float* gates;
    DI void operator()(const f32x4 (&acc)[2][2][4][2], const MoeUnit& u, int wr, int wc, int fr, int fq) const {
#pragma unroll
        for (int ai = 0; ai < 2; ++ai)
#pragma unroll
            for (int m = 0; m < 4; ++m) { const int i = ai * 128 + wr * 64 + m * 16 + fr;
                if (i < u.valid) { const unsigned a = u.ent[i]; const float gw = gates[a];
                    const f32x4 g0 = acc[ai][0][m][0], g1 = acc[ai][0][m][1], u0 = acc[ai][1][m][0], u1 = acc[ai][1][m][1];
                    float v[8];
#pragma unroll
                    for (int j = 0; j < 4; ++j) { v[j] = silu_f(g0[j]) * u0[j] * gw; v[4 + j] = silu_f(g1[j]) * u1[j] * gw; }
                    u32x4 w; w.x = cvtpk(v[0], v[1]); w.y = cvtpk(v[2], v[3]); w.z = cvtpk(v[4], v[5]); w.w = cvtpk(v[6], v[7]);
                    *(u32x4*)(act + (size_t)a * DEXP + u.pn * 128 + wc * 32 + 8 * fq) = w; } }
    } };
struct XEpiGlu8 : XEpiGlu {
    DI void operator()(const f32x4 (&acc)[2][2][4][2], const MoeUnit& u, int wr, int wc, int fr, int fq) const {
#pragma unroll
        for (int ai = 0; ai < 2; ++ai)
#pragma unroll
            for (int m = 0; m < 4; ++m) { const int i = ai * 128 + wr * 64 + m * 16 + fr;
                if (i < u.valid) { const unsigned a = u.ent[i]; const float gw = gates[a] * (1.0f / 32.0f);
                    const f32x4 g0 = acc[ai][0][m][0] * (1.0f / 32.0f), g1 = acc[ai][0][m][1] * (1.0f / 32.0f), u0 = acc[ai][1][m][0], u1 = acc[ai][1][m][1];
                    float v[8];
#pragma unroll
                    for (int j = 0; j < 4; ++j) { v[j] = silu_f(g0[j]) * u0[j] * gw; v[4 + j] = silu_f(g1[j]) * u1[j] * gw; }
                    u32x4 w; w.x = cvtpk(v[0], v[1]); w.y = cvtpk(v[2], v[3]); w.z = cvtpk(v[4], v[5]); w.w = cvtpk(v[6], v[7]);
                    *(u32x4*)(act + (size_t)a * DEXP + u.pn * 128 + wc * 32 + 8 * fq) = w; } }
    } };
template <> struct epi_fp8<XEpiGlu8> { static constexpr int value = 1; };
struct XEpiScatter {
    static constexpr bool PERM = true;
    bf16_t* outp;
    DI void operator()(const f32x4 (&acc)[2][2][4][2], const MoeUnit& u, int wr, int wc, int fr, int fq) const {
#pragma unroll
        for (int ai = 0; ai < 2; ++ai)
#pragma unroll
            for (int m = 0; m < 4; ++m) { const int i = ai * 128 + wr * 64 + m * 16 + fr;
                if (i < u.valid) { bf16_t* rowp = outp + (size_t)u.ent[i] * 1024 + u.pn * 256 + wc * 32 + 8 * fq;
#pragma unroll
                    for (int bj = 0; bj < 2; ++bj) { const f32x4 v0 = acc[ai][bj][m][0], v1 = acc[ai][bj][m][1];
                        u32x4 w; w.x = cvtpk(v0[0], v0[1]); w.y = cvtpk(v0[2], v0[3]); w.z = cvtpk(v1[0], v1[1]); w.w = cvtpk(v1[2], v1[3]);
                        *(u32x4*)(rowp + bj * 128) = w; } } }
    } };

template <int KIND>
struct XEpiQKV {
    static constexpr bool PERM = true;
    static constexpr int KW = KIND == 1 ? 256 : 1024, LDRAW = KIND == 1 ? 1536 : 3072;
    static constexpr float ASC = 1.0f / 32.0f;
    bf16_t* Q; bf16_t* Kb; bf16_t* RAW; const float* qn; const float* kn;
    DI void operator()(const f32x4 (&acc)[2][2][4][2], const DenseSched::Unit& u, int wr, int wc, int fr, int fq) const {
        const int col0 = u.pn * 256, row0 = u.pm * 256 + (u.half > 0 ? 128 : 0) + wr * 64 + fr;
        if (col0 >= 1024 + KW) {
#pragma unroll
            for (int ai = 0; ai < 2; ++ai) if (ai == 0 || u.half < 0)
#pragma unroll
                for (int m = 0; m < 4; ++m) { bf16_t* rowp = RAW + (size_t)(row0 + ai * 128 + m * 16) * LDRAW + col0 + wc * 32 + 8 * fq;
#pragma unroll
                    for (int bj = 0; bj < 2; ++bj) { const f32x4 v0 = acc[ai][bj][m][0] * ASC, v1 = acc[ai][bj][m][1] * ASC;
                        u32x4 w; w.x = cvtpk(v0[0], v0[1]); w.y = cvtpk(v0[2], v0[3]); w.z = cvtpk(v1[0], v1[1]); w.w = cvtpk(v1[2], v1[3]);
                        *(u32x4*)(rowp + bj * 128) = w; } }
            return;
        }
        const bool isq = col0 < 1024;
        const int head = isq ? 4 * u.pn + wc : ((col0 - 1024) >> 6) + wc;
        const float* gain = (isq ? qn : kn) + 8 * fq;
        const float scale = isq ? 0.125f * LOG2E : 1.0f;
        bf16_t* dstb = isq ? Q + head * 64 + 8 * fq : Kb + head * 64 + 8 * fq;
        const int ldd = isq ? 1024 : KW;
        f32x4 g[2][2];
#pragma unroll
        for (int bj = 0; bj < 2; ++bj)
#pragma unroll
            for (int n = 0; n < 2; ++n) g[bj][n] = *(const f32x4*)(gain + 32 * bj + 4 * n);
#pragma unroll
        for (int ai = 0; ai < 2; ++ai) if (ai == 0 || u.half < 0)
#pragma unroll
            for (int m = 0; m < 4; ++m) {
                const int row = row0 + ai * 128 + m * 16, b = row / PP, pos = row - b * PP;
                f32x4 v[2][2];
                float ss = 0.f;
#pragma unroll
                for (int bj = 0; bj < 2; ++bj)
#pragma unroll
                    for (int n = 0; n < 2; ++n) { v[bj][n] = acc[ai][bj][m][n] * ASC; ss += v[bj][n][0] * v[bj][n][0] + v[bj][n][1] * v[bj][n][1] + v[bj][n][2] * v[bj][n][2] + v[bj][n][3] * v[bj][n][3]; }
                ss += __shfl_xor(ss, 16); ss += __shfl_xor(ss, 32);
                const float rs = rsqrtf(ss * (1.0f / 64.0f) + EPS);
#pragma unroll
                for (int bj = 0; bj < 2; ++bj)
#pragma unroll
                    for (int n = 0; n < 2; ++n) v[bj][n] = v[bj][n] * rs * g[bj][n];
                if (KIND != 0 && pos < SEQ) {
                    const int prow = (pos >> 6) & 63, pcol = pos & 63;
                    const float* cs = ROPE64 + ((fq < 2 ? prow : pcol) * 16 + ((8 * fq) & 15)) * 2;
#pragma unroll
                    for (int n = 0; n < 2; ++n)
#pragma unroll
                        for (int j = 0; j < 4; ++j) {
                            const float c = cs[(4 * n + j) * 2], sn = cs[(4 * n + j) * 2 + 1], x1 = v[0][n][j], x2 = v[1][n][j];
                            v[0][n][j] = x1 * c - x2 * sn; v[1][n][j] = x2 * c + x1 * sn;
                        }
                }
                bf16_t* rowp = dstb + (size_t)row * ldd;
#pragma unroll
                for (int bj = 0; bj < 2; ++bj) { const f32x4 v0 = v[bj][0] * scale, v1 = v[bj][1] * scale;
                    u32x4 w; w.x = cvtpk(v0[0], v0[1]); w.y = cvtpk(v0[2], v0[3]); w.z = cvtpk(v1[0], v1[1]); w.w = cvtpk(v1[2], v1[3]);
                    *(u32x4*)(rowp + bj * 32) = w; }
            }
    } };
constexpr bool qkv_fp8(int kind) { return true; }
template <int KIND> struct epi_fp8<XEpiQKV<KIND>> { static constexpr int value = 2; };
template <int KIND>
DI void gemm_qkv_x(const Params& p, unsigned char* smem, const bf16_t* Wt, int N, const float* qn, const float* kn, int bid, int nb, int tid) {
    constexpr int KU = qkv_fp8(KIND) ? 512 : 1024;
    DenseSched S; S.nM = MROWS / 256; S.nN = N / 256; S.nwg = S.nM * S.nN; S.G = nb; S.c = bid; S.Bt = Wt; S.K = KU; S.lda = KU; S.skip_ctx = false;
    XEpiQKV<KIND> e{(bf16_t*)(p.ws + WS_Q), (bf16_t*)(p.ws + WS_K), (bf16_t*)(p.ws + WS_RAW), qn, kn};
    pg8::gemm_phase((lds_ptr)smem, (const bf16_t*)(p.ws + WS_H), KU, S, e, tid);
}
template <bool UQ>
struct XEpiMla {
    static constexpr bool PERM = true;
    bf16_t* Q; bf16_t* Kb; bf16_t* V; const float* qn; const float* kn;
    DI void operator()(const f32x4 (&acc)[2][2][4][2], const DenseSched::Unit& u, int wr, int wc, int fr, int fq) const {
        const int row0 = u.pm * 256 + (u.half > 0 ? 128 : 0) + wr * 64 + fr;
        if (u.pn < 4) {
            const int head = 4 * u.pn + wc;
            const float* gain = (UQ ? qn : kn) + 8 * fq;
            const float scale = UQ ? 0.10206207261596577f * LOG2E : 1.0f;
            bf16_t* dstb = (UQ ? Q : Kb) + head * 96 + 8 * fq;
            f32x4 g[2][2];
#pragma unroll
            for (int bj = 0; bj < 2; ++bj)
#pragma unroll
                for (int n = 0; n < 2; ++n) g[bj][n] = *(const f32x4*)(gain + 32 * bj + 4 * n);
#pragma unroll
            for (int ai = 0; ai < 2; ++ai) if (ai == 0 || u.half < 0)
#pragma unroll
                for (int m = 0; m < 4; ++m) {
                    const int row = row0 + ai * 128 + m * 16;
                    float ss = 0.f;
#pragma unroll
                    for (int bj = 0; bj < 2; ++bj)
#pragma unroll
                        for (int n = 0; n < 2; ++n) { const f32x4 v = acc[ai][bj][m][n]; ss += v[0] * v[0] + v[1] * v[1] + v[2] * v[2] + v[3] * v[3]; }
                    ss += __shfl_xor(ss, 16); ss += __shfl_xor(ss, 32);
                    const float rs = rsqrtf(ss * (1.0f / 64.0f) + EPS) * scale;
                    bf16_t* rowp = dstb + (size_t)row * 1536;
#pragma unroll
                    for (int bj = 0; bj < 2; ++bj) { const f32x4 v0 = acc[ai][bj][m][0] * rs * g[bj][0], v1 = acc[ai][bj][m][1] * rs * g[bj][1];
                        u32x4 w; w.x = cvtpk(v0[0], v0[1]); w.y = cvtpk(v0[2], v0[3]); w.z = cvtpk(v1[0], v1[1]); w.w = cvtpk(v1[2], v1[3]);
                        *(u32x4*)(rowp + bj * 32) = w; }
                }
        } else if (UQ) {
            const float scale = 0.10206207261596577f * LOG2E;
            const f32x4 g1 = *(const f32x4*)(qn + 64 + 4 * fq), g2 = *(const f32x4*)(qn + 64 + 16 + 4 * fq);
#pragma unroll
            for (int ai = 0; ai < 2; ++ai) if (ai == 0 || u.half < 0)
#pragma unroll
                for (int m = 0; m < 4; ++m) {
                    const int row = row0 + ai * 128 + m * 16, b = row / PP, pos = row - b * PP;
                    const int prow = (pos >> 6) & 63, pcol = pos & 63;
                    const float* cs = ROPE32 + ((fq < 2 ? prow : pcol) * 8 + ((4 * fq) & 7)) * 2;
#pragma unroll
                    for (int bj = 0; bj < 2; ++bj) {
                        f32x4 x1 = acc[ai][bj][m][0], x2 = acc[ai][bj][m][1];
                        float ss = x1[0] * x1[0] + x1[1] * x1[1] + x1[2] * x1[2] + x1[3] * x1[3] + x2[0] * x2[0] + x2[1] * x2[1] + x2[2] * x2[2] + x2[3] * x2[3];
                        ss += __shfl_xor(ss, 16); ss += __shfl_xor(ss, 32);
                        const float rs = rsqrtf(ss * (1.0f / 32.0f) + EPS);
                        x1 = x1 * rs * g1; x2 = x2 * rs * g2;
                        if (pos < SEQ) {
#pragma unroll
                            for (int j = 0; j < 4; ++j) { const float c = cs[2 * j], sn = cs[2 * j + 1], a1 = x1[j], a2 = x2[j]; x1[j] = a1 * c - a2 * sn; x2[j] = a2 * c + a1 * sn; }
                        }
                        x1 = x1 * scale; x2 = x2 * scale;
                        bf16_t* rowp = Q + (size_t)row * 1536 + (8 * (u.pn - 4) + 4 * bj + wc) * 96 + 64 + 4 * fq;
                        u32x2 w1, w2; w1.x = cvtpk(x1[0], x1[1]); w1.y = cvtpk(x1[2], x1[3]); w2.x = cvtpk(x2[0], x2[1]); w2.y = cvtpk(x2[2], x2[3]);
                        *(u32x2*)rowp = w1; *(u32x2*)(rowp + 16) = w2;
                    }
                }
        } else {
#pragma unroll
            for (int ai = 0; ai < 2; ++ai) if (ai == 0 || u.half < 0)
#pragma unroll
                for (int m = 0; m < 4; ++m) { bf16_t* rowp = V + (size_t)(row0 + ai * 128 + m * 16) * 1024 + (u.pn - 4) * 256 + wc * 32 + 8 * fq;
#pragma unroll
                    for (int bj = 0; bj < 2; ++bj) { const f32x4 v0 = acc[ai][bj][m][0], v1 = acc[ai][bj][m][1];
                        u32x4 w; w.x = cvtpk(v0[0], v0[1]); w.y = cvtpk(v0[2], v0[3]); w.z = cvtpk(v1[0], v1[1]); w.w = cvtpk(v1[2], v1[3]);
                        *(u32x4*)(rowp + bj * 128) = w; } }
        }
    } };
template <bool UQ>
DI void gemm_mla_x(const Params& p, unsigned char* smem, int bid, int nb, int tid) {
    bf16_t* O = (bf16_t*)(p.ws + WS_O);
    DenseSched S; S.nM = MROWS / 256; S.nN = (UQ ? 1536 : 2048) / 256; S.nwg = S.nM * S.nN; S.G = nb; S.c = bid; S.Bt = (const bf16_t*)(p.ws + (UQ ? W_UQ : W_UKV)); S.K = UQ ? 384 : 256; S.lda = S.K; S.skip_ctx = false;
    XEpiMla<UQ> e{(bf16_t*)(p.ws + WS_Q), (bf16_t*)(p.ws + WS_K), (bf16_t*)(p.ws + WS_RAW), p.in[28], p.in[29]};
    pg8::gemm_phase((lds_ptr)smem, UQ ? O : O + (size_t)MROWS * 384, S.K, S, e, tid);
}
template <int EPIK>
DI void gemm_dense_x(const Params& p, unsigned char* smem, const bf16_t* A, int lda, const bf16_t* Wt, int K, int N, bf16_t* C, int ldc, const float* mod, int bid, int nb, int tid, bool skip_ctx = false) {
    DenseSched S; S.nM = skip_ctx ? NBATCH * 16 : MROWS / 256; S.nN = N / 256; S.nwg = S.nM * S.nN; S.G = nb; S.c = bid; S.Bt = Wt; S.K = K; S.lda = lda; S.skip_ctx = skip_ctx;
    if (EPIK == 0) { XEpiStore e{C, ldc}; pg8::gemm_phase((lds_ptr)smem, A, K, S, e, tid); }
    else if (EPIK == 2) { XEpiStore8 e{C, ldc}; pg8::gemm_phase((lds_ptr)smem, A, K, S, e, tid); }
    else { XEpiResid e{&p, mod}; pg8::gemm_phase((lds_ptr)smem, A, K, S, e, tid); }
}
template <int WHICH, bool TAIL>
DI void gemm_moe_call(const Params& p, unsigned char* smem, int layer, int bid, int nb, int tid) {
    MoeSched<TAIL> S; S.list = (const unsigned*)(p.ws + WS_LIST); S.zero = (const unsigned*)(p.ws + WS_CTL) + 8192; S.G = nb; S.c = bid;
    {
        LAS int* tab = (LAS int*)(smem + GEMM_LDS);
        constexpr int TNc = WHICH == 0 ? 2 : 4;
        if (tid < 64) {
            const unsigned cv = tid < 32 ? ((const unsigned*)(p.ws + WS_CTL) + CW_CNT + layer * 32)[tid] : 0u;
            int incl = (int)((cv + 255u) >> 8) * TNc;
#pragma unroll
            for (int d = 1; d < 32; d <<= 1) { const int o = __shfl_up(incl, d); if (tid >= d) incl += o; }
            if (tid < 32) { tab[1 + tid] = incl; tab[40 + tid] = (int)cv; }
            if (tid == 0) tab[0] = 0;
        }
        __syncthreads();
        S.tab = tab; S.nwg = __builtin_amdgcn_readfirstlane(tab[32]);
    }
    if (WHICH == 0) { S.W = (const bf16_t*)(p.ws + W_GU + (size_t)layer * 32 * 512 * 1024); S.K = 512; S.N = 512; S.TN = 2; S.lda = 512; S.shift = 1;
        S.place(); XEpiGlu8 e{{(bf16_t*)(p.ws + WS_Q), (const float*)(p.ws + WS_GATE)}}; pg8::gemm_phase((lds_ptr)smem, (const bf16_t*)(p.ws + WS_H), 512, S, e, tid); }
    else { S.W = (const bf16_t*)(p.ws + W_DN) + (size_t)layer * 32 * 1024 * 256; S.K = 256; S.N = 1024; S.TN = 4; S.lda = DEXP; S.shift = 0;
        S.place(); XEpiScatter e{(bf16_t*)(p.ws + WS_RAW)}; pg8::gemm_phase((lds_ptr)smem, (const bf16_t*)(p.ws + WS_Q), 256, S, e, tid); }
}
template <int WHICH>
DI void gemm_moe_x(const Params& p, unsigned char* smem, int layer, int bid, int nb, int tid) {
    const int wv = __builtin_amdgcn_readfirstlane(tid >> 6);
    gemm_moe_call<WHICH, false>(p, smem, layer, bid, nb, (wv << 6) | lane_now());
    gemm_moe_call<WHICH, true>(p, smem, layer, bid, nb, (wv << 6) | lane_now());
}

constexpr int NPHASES = 2 + (7 + 7 + 9 + 7) + 1;
constexpr int SMEM_BYTES = GEMM_LDS + 512;

template <int KIND>
DI void layer_phases(const Params& p, int& ph, const int lo, const int hi, const XcdBarrier& bar, unsigned char* smem, int bid, int nb, int wid_u) {
    constexpr int L = KIND;
    const float* mod = (const float*)(p.ws + WS_MOD) + (size_t)L * 9 * 6144;
    bf16_t* H = (bf16_t*)(p.ws + WS_H); bf16_t* O = (bf16_t*)(p.ws + WS_O); bf16_t* RAW = (bf16_t*)(p.ws + WS_RAW);
    bf16_t* Q = (bf16_t*)(p.ws + WS_Q); bf16_t* Kb = (bf16_t*)(p.ws + WS_K);
#ifndef AABL
#define AABL 0
#endif
#ifndef GPROBE
#define GPROBE 0
#endif
#ifndef DUP_MASK
#define DUP_MASK 0ull
#endif
#define PHASE2(BODY, DUPBODY) do { if (lo <= ph && ph < hi) { const int tid = (wid_u << 6) | lane_now(); if ((DUP_MASK >> ph) & 1ull) { DUPBODY; xcd_barrier(bar, tid == 0); } BODY; } if (lo <= ph && ph + 1 < hi) xcd_barrier(bar, ((wid_u << 6) | lane_now()) == 0); ++ph; } while (0)
#define PHASE(...) PHASE2((__VA_ARGS__), (__VA_ARGS__))
    if (L == 0) PHASE(phase_rows<2 | 8 | 32>(p, L, 0, bid, nb, tid), phase_router_prep(p, bid, nb, tid));
    else PHASE2((phase_rows<3 | 32>(p, L, 0, bid, nb, tid)), (phase_rows<2 | 32>(p, L, 0, bid, nb, tid)));
    AttnP a{};
    if (KIND == 0) {
        PHASE(gemm_qkv_x<0>(p, smem, (const bf16_t*)(p.ws + W_QKV0), 3072, p.in[15], p.in[16], bid, nb, tid));
        a = AttnP{Q, 1024, Kb, 1024, RAW + 2048, 3072, O, 1024, 16, 0, 0, 64, p.in[17], nullptr, 1, p.in[16]};
        PHASE(attn_na(a, smem, bid, nb, tid));
        PHASE2((gemm_dense_x<1>(p, smem, O, 1024, (const bf16_t*)(p.ws + W_O0), 1024, 1024, nullptr, 0, mod, bid, nb, tid)), (gemm_dense_x<0>(p, smem, O, 1024, (const bf16_t*)(p.ws + W_O0), 1024, 1024, RAW, 1024, nullptr, bid, nb, tid)));
    } else if (KIND == 1) {
        PHASE(gemm_qkv_x<1>(p, smem, (const bf16_t*)(p.ws + W_QKV1), 1536, p.in[20], p.in[21], bid, nb, tid));
        a = AttnP{Q, 1024, Kb, 256, RAW + 1280, 1536, O, 1024, 16, 2, 2, 64, nullptr, p.in[22], 1};
        PHASE(attn_mfma<64, 64, 1>(a, smem, bid, nb, tid));
        PHASE2((gemm_dense_x<1>(p, smem, O, 1024, (const bf16_t*)(p.ws + W_O1), 1024, 1024, nullptr, 0, mod, bid, nb, tid)), (gemm_dense_x<0>(p, smem, O, 1024, (const bf16_t*)(p.ws + W_O1), 1024, 1024, RAW, 1024, nullptr, bid, nb, tid)));
    } else if (KIND == 2) {
        bf16_t* cqn = O; bf16_t* ckvn = O + (size_t)MROWS * 384;
        PHASE(gemm_dense_x<2>(p, smem, H, 512, (const bf16_t*)(p.ws + W_DQKV), 512, 768, Q, 768, nullptr, bid, nb, tid));
        PHASE(phase_post_mla1(p, bid, nb, tid));
        PHASE(gemm_mla_x<true>(p, smem, bid, nb, tid), gemm_mla_x<false>(p, smem, bid, nb, (wid_u << 6) | lane_now()));
        a = AttnP{Q, 1536, Kb, 1536, RAW, 1024, O, 1024, 16, 0, 0, 64, nullptr, nullptr, 1};
        PHASE(attn_mfma<96, 64, 2>(a, smem, bid, nb, tid));
        PHASE2((gemm_dense_x<1>(p, smem, O, 1024, (const bf16_t*)(p.ws + W_O2), 1024, 1024, nullptr, 0, mod, bid, nb, tid)), (gemm_dense_x<0>(p, smem, O, 1024, (const bf16_t*)(p.ws + W_O2), 1024, 1024, RAW, 1024, nullptr, bid, nb, tid)));
    } else {
        PHASE(gemm_qkv_x<3>(p, smem, (const bf16_t*)(p.ws + W_QKV3), 3072, p.in[32], p.in[33], bid, nb, tid));
        a = AttnP{Q, 1024, Kb, 1024, RAW + 2048, 3072, H  , 2048, 16, 0, 1, 128, nullptr, nullptr, 0, nullptr, p.in[34], p.in[35], Q  };
        PHASE(attn_mfma<64, 128, 2>(a, smem, bid, nb, tid));
        PHASE(gemm_dense_x<1>(p, smem, Q, 1024, (const bf16_t*)(p.ws + W_O3), 1024, 1024, nullptr, 0, mod, bid, nb, tid, true));
    }
    PHASE(phase_router(p, smem, L, L == 3, bid, nb, tid));
    PHASE(gemm_moe_x<0>(p, smem, L, bid, nb, tid));
    PHASE(gemm_moe_x<1>(p, smem, L, bid, nb, tid));
}

__global__ void __launch_bounds__(NTHREADS, 2) mega(Params p, int lo, int hi) {
    extern __shared__ __attribute__((aligned(16))) unsigned char smem[];
    const int bid = blockIdx.x, nb = gridDim.x, wid_u = __builtin_amdgcn_readfirstlane(threadIdx.x >> 6);
    float* lds = (float*)smem;
    volatile LAS unsigned* xbw = (volatile LAS unsigned*)(smem + SMEM_BYTES - 16);
    if (threadIdx.x == 0) { xbw[0] = 0u; xbw[1] = 0u; }
    __syncthreads();
    XcdBarrier bar = xcd_barrier_post((unsigned*)(p.ws + WS_CTL), xbw);
    int ph = 0;
    PHASE(phase_prologue(p, lds, bid, nb, tid));
    PHASE(phase_mod_reduce(p, bid, nb, tid));
    layer_phases<0>(p, ph, lo, hi, bar, smem, bid, nb, wid_u);
    layer_phases<1>(p, ph, lo, hi, bar, smem, bid, nb, wid_u);
    layer_phases<2>(p, ph, lo, hi, bar, smem, bid, nb, wid_u);
    layer_phases<3>(p, ph, lo, hi, bar, smem, bid, nb, wid_u);
    PHASE2((phase_rows<1 | 16>(p, 3, 0, bid, nb, tid)), (void)0);
}

extern "C" void kernel_launch(void* const* d_in, const int* in_sizes, int n_in, void* d_out, int out_size, void* d_ws, size_t ws_size, hipStream_t stream) {
    (void)in_sizes; (void)out_size;
    if (n_in < 37 || ws_size < WS_END) { fprintf(stderr, "kernel_launch: unexpected inputs (n_in %d, ws %zu)\n", n_in, ws_size); return; }
    static int grid = 0;
    if (!grid) {
        int dev = 0, cus = 0, per_cu = 0;
        hipGetDevice(&dev);
        hipDeviceGetAttribute(&cus, hipDeviceAttributeMultiprocessorCount, dev);
        hipFuncSetAttribute((const void*)mega, hipFuncAttributeMaxDynamicSharedMemorySize, SMEM_BYTES);
        hipOccupancyMaxActiveBlocksPerMultiprocessor(&per_cu, mega, NTHREADS, SMEM_BYTES);
        if (per_cu < 1) per_cu = 1;
        grid = cus * (per_cu < 1 ? per_cu : 1);
    }
    Params p{};
    for (int i = 0; i < 37; ++i) p.in[i] = (const float*)d_in[i];
    p.out = (float*)d_out; p.ws = (unsigned char*)d_ws;
    hipMemsetAsync(p.ws + WS_CTL, 0, 65536, stream);
#if ONE_LAUNCH
    hipLaunchKernelGGL(mega, dim3(grid), dim3(NTHREADS), SMEM_BYTES, stream, p, 0, NPHASES);
#else
    for (int k = 0; k < NPHASES; ++k) hipLaunchKernelGGL(mega, dim3(grid), dim3(NTHREADS), SMEM_BYTES, stream, p, k, k + 1);
#endif
}
```

```cpp
#include <hip/hip_runtime.h>
#include <stdint.h>
#include <stdio.h>

#ifndef ONE_LAUNCH
#define ONE_LAUNCH 1
#endif

#define DI __device__ __forceinline__
typedef unsigned short bf16_t;
typedef short bf16x8 __attribute__((ext_vector_type(8)));
typedef float f32x4 __attribute__((ext_vector_type(4)));
typedef float f32x16 __attribute__((ext_vector_type(16)));
typedef unsigned u32x4 __attribute__((ext_vector_type(4)));
typedef unsigned u32x2 __attribute__((ext_vector_type(2)));

constexpr int DM = 1024, NBATCH = 8, SEQ = 4096, CTXL = 256, PP = SEQ + CTXL, MROWS = NBATCH * PP;
constexpr int NEXP = 32, DEXP = 256;
constexpr float EPS = 1e-6f, LOG2E = 1.4426950408889634f;
constexpr int NTHREADS = 512, NW = NTHREADS / 64;

constexpr size_t MiB = 1ull << 20;
constexpr size_t WS_RAW_FWD = 380ull << 20;
constexpr size_t WS_CTL = 0, CTL_BYTES = 1 * MiB;
constexpr size_t WS_MOD = 1 * MiB;
constexpr size_t WS_MODP = WS_RAW_FWD;
constexpr size_t WS_XCTX = 9 * MiB;
constexpr size_t WS_LIST = 17 * MiB;
constexpr size_t WS_GATE = 22 * MiB;
constexpr size_t WS_W = 24 * MiB;
constexpr size_t W_QKV0 = WS_W + 0 * MiB, W_O0 = WS_W + 6 * MiB, W_QKV1 = WS_W + 8 * MiB, W_O1 = WS_W + 11 * MiB, W_DQKV = WS_W + 13 * MiB,
                 W_UQ = WS_W + 15 * MiB, W_UKV = WS_W + 17 * MiB, W_O2 = WS_W + 18 * MiB, W_QKV3 = WS_W + 20 * MiB, W_O3 = WS_W + 26 * MiB,
                 W_GU = WS_W + 28 * MiB, W_DN = WS_W + 156 * MiB;
constexpr size_t WS_H = 244 * MiB;
constexpr size_t WS_O = 312 * MiB;
constexpr size_t WS_RAW = 380 * MiB;
constexpr size_t WS_Q = 620 * MiB;
constexpr size_t WS_K = 722 * MiB;
constexpr size_t WS_XB = 824 * MiB;
constexpr size_t WS_END = 892 * MiB;
constexpr int CW_CNT = 4096;

constexpr size_t WS_RW = 2 * MiB;
struct Params { const float* in[37]; float* out; unsigned char* ws; };

DI unsigned f2bf(float f) { unsigned u = __float_as_uint(f); return (u + 0x7fffu + ((u >> 16) & 1u)) >> 16; }
DI float bf2f(unsigned h) { return __uint_as_float(h << 16); }
DI unsigned pk2(float lo, float hi) { return f2bf(lo) | (f2bf(hi) << 16); }
DI float bflo(unsigned w) { return __uint_as_float(w << 16); }
DI float bfhi(unsigned w) { return __uint_as_float(w & 0xffff0000u); }
DI int lane_now() { unsigned lane; asm volatile("v_mbcnt_lo_u32_b32 %0, -1, 0\n\tv_mbcnt_hi_u32_b32 %0, -1, %0" : "=v"(lane)); return (int)lane; }
DI float wave_sum(float v) {
#pragma unroll
    for (int o = 32; o > 0; o >>= 1) v += __shfl_xor(v, o);
    return v;
}
DI float silu_f(float x) { return x / (1.0f + __expf(-x)); }
DI void unpack8(const u32x4 w, float (&f)[8]) {
    f[0] = bflo(w.x); f[1] = bfhi(w.x); f[2] = bflo(w.y); f[3] = bfhi(w.y); f[4] = bflo(w.z); f[5] = bfhi(w.z); f[6] = bflo(w.w); f[7] = bfhi(w.w);
}
DI u32x4 pack8(const float (&f)[8]) { u32x4 w; w.x = pk2(f[0], f[1]); w.y = pk2(f[2], f[3]); w.z = pk2(f[4], f[5]); w.w = pk2(f[6], f[7]); return w; }
DI float* xrow_ptr(const Params& p, int r) {
    const int b = r / PP, pos = r - b * PP;
    return pos < SEQ ? p.out + ((size_t)b * SEQ + pos) * DM : (float*)(p.ws + WS_XCTX) + ((size_t)b * CTXL + (pos - SEQ)) * DM;
}
DI bf16_t* xb_row(const Params& p, int r) { return (bf16_t*)(p.ws + WS_XB) + (size_t)r * DM; }
DI int mod_row(int r) { const int b = r / PP, pos = r - b * PP; return pos < SEQ ? b : 8; }
__device__ const float ROPE64[2048] = {
  1.000000000e+00f, 0.000000000e+00f, 1.000000000e+00f, 0.000000000e+00f, 1.000000000e+00f, 0.000000000e+00f, 1.000000000e+00f, 0.000000000e+00f,
  1.000000000e+00f, 0.000000000e+00f, 1.000000000e+00f, 0.000000000e+00f, 1.000000000e+00f, 0.000000000e+00f, 1.000000000e+00f, 0.000000000e+00f,
  1.000000000e+00f, 0.000000000e+00f, 1.000000000e+00f, 0.000000000e+00f, 1.000000000e+00f, 0.000000000e+00f, 1.000000000e+00f, 0.000000000e+00f,
  1.000000000e+00f, 0.000000000e+00f, 1.000000000e+00f, 0.000000000e+00f, 1.000000000e+00f, 0.000000000e+00f, 1.000000000e+00f, 0.000000000e+00f,
  5.403022766e-01f, 8.414709568e-01f, 8.460091352e-01f, 5.331684351e-01f, 9.504152536e-01f, 3.109835982e-01f, 9.842302203e-01f, 1.768921912e-01f,
  9.950041771e-01f, 9.983342141e-02f, 9.984192848e-01f, 5.620449781e-02f, 9.995000362e-01f, 3.161750361e-02f, 9.998418689e-01f, 1.778185740e-02f,
  9.999499917e-01f, 9.999833070e-03f, 9.999842048e-01f, 5.623383448e-03f, 9.999949932e-01f, 3.162272274e-03f, 9.999983907e-01f, 1.778278500e-03f,
  9.999995232e-01f, 9.999999311e-04f, 9.999998212e-01f, 5.623412435e-04f, 9.999999404e-01f, 3.162277571e-04f, 1.000000000e+00f, 1.778279402e-04f,
  -4.161468446e-01f, 9.092974067e-01f, 4.314628243e-01f, 9.021307230e-01f, 8.065783978e-01f, 5.911270976e-01f, 9.374182820e-01f, 3.482052684e-01f,
  9.800665975e-01f, 1.986693293e-01f, 9.936820865e-01f, 1.122313142e-01f, 9.980006814e-01f, 6.320339441e-02f, 9.993675947e-01f, 3.555808961e-02f,
  9.998000264e-01f, 1.999866590e-02f, 9.999367595e-01f, 1.124658901e-02f, 9.999799728e-01f, 6.324512884e-03f, 9.999936819e-01f, 3.556551412e-03f,
  9.999979734e-01f, 1.999998698e-03f, 9.999993443e-01f, 1.124682371e-03f, 9.999998212e-01f, 6.324554561e-04f, 9.999999404e-01f, 3.556558804e-04f,
  -9.899924994e-01f, 1.411200017e-01f, -1.159661636e-01f, 9.932531714e-01f, 5.827536583e-01f, 8.126488924e-01f, 8.610406518e-01f, 5.085361004e-01f,
  9.553365111e-01f, 2.955202162e-01f, 9.858034849e-01f, 1.679033041e-01f, 9.955033660e-01f, 9.472608566e-02f, 9.985772967e-01f, 5.332308263e-02f,
  9.995500445e-01f, 2.999549918e-02f, 9.998577237e-01f, 1.686943881e-02f, 9.999549985e-01f, 9.486690164e-03f, 9.999857545e-01f, 5.334813148e-03f,
  9.999955297e-01f, 2.999995602e-03f, 9.999985695e-01f, 1.687023090e-03f, 9.999995232e-01f, 9.486831259e-04f, 9.999998808e-01f, 5.334838061e-04f,
  -6.536436081e-01f, -7.568024993e-01f, -6.276797056e-01f, 7.784717083e-01f, 3.011374772e-01f, 9.535807371e-01f, 7.575061917e-01f, 6.528279781e-01f,
  9.210609794e-01f, 3.894183338e-01f, 9.748082757e-01f, 2.230444849e-01f, 9.920106530e-01f, 1.261540651e-01f, 9.974712729e-01f, 7.107120752e-02f,
  9.992001057e-01f, 3.998933360e-02f, 9.997470379e-01f, 2.249175683e-02f, 9.999200106e-01f, 1.264877338e-02f, 9.999747276e-01f, 7.113057654e-03f,
  9.999920130e-01f, 3.999989480e-03f, 9.999974966e-01f, 2.249363344e-03f, 9.999992251e-01f, 1.264910679e-03f, 9.999997616e-01f, 7.113117026e-04f,
  2.836622000e-01f, -9.589242935e-01f, -9.460792542e-01f, 3.239352703e-01f, -1.034233812e-02f, 9.999465346e-01f, 6.300802827e-01f, 7.765299678e-01f,
  8.775825500e-01f, 4.794255495e-01f, 9.607312679e-01f, 2.774805427e-01f, 9.875259995e-01f, 1.574558765e-01f, 9.960497618e-01f, 8.879686147e-02f,
  9.987502694e-01f, 4.997916520e-02f, 9.996047616e-01f, 2.811336145e-02f, 9.998750091e-01f, 1.581072807e-02f, 9.999604821e-01f, 8.891279809e-03f,
  9.999874830e-01f, 4.999979399e-03f, 9.999960661e-01f, 2.811702900e-03f, 9.999987483e-01f, 1.581138116e-03f, 9.999995828e-01f, 8.891395992e-04f,
  9.601702690e-01f, -2.794154882e-01f, -9.731037021e-01f, -2.303675115e-01f, -3.207964003e-01f, 9.471482038e-01f, 4.827820361e-01f, 8.757405281e-01f,
  8.253356218e-01f, 5.646424890e-01f, 9.436169863e-01f, 3.310393095e-01f, 9.820539355e-01f, 1.886002719e-01f, 9.943132997e-01f, 1.064944416e-01f,
  9.982005358e-01f, 5.996400490e-02f, 9.994308352e-01f, 3.373407945e-02f, 9.998199940e-01f, 1.897252724e-02f, 9.999430776e-01f, 1.066947449e-02f,
  9.999819994e-01f, 5.999964196e-03f, 9.999943376e-01f, 3.374041524e-03f, 9.999982119e-01f, 1.897365320e-03f, 9.999994040e-01f, 1.066967379e-03f,
  7.539022565e-01f, 6.569865942e-01f, -7.004297972e-01f, -7.137212753e-01f, -5.994374752e-01f, 8.004215956e-01f, 3.202570081e-01f, 9.473307133e-01f,
  7.648422122e-01f, 6.442176700e-01f, 9.235194325e-01f, 3.835515678e-01f, 9.755998850e-01f, 2.195560932e-01f, 9.922624230e-01f, 1.241583377e-01f,
  9.975510240e-01f, 6.994284689e-02f, 9.992253184e-01f, 3.935372457e-02f, 9.997550249e-01f, 2.213413455e-02f, 9.999225140e-01f, 1.244763471e-02f,
  9.999755025e-01f, 6.999942940e-03f, 9.999922514e-01f, 3.936378751e-03f, 9.999975562e-01f, 2.213592408e-03f, 9.999992251e-01f, 1.244795276e-03f,
  -1.455000341e-01f, 9.893582463e-01f, -2.120364457e-01f, -9.772617817e-01f, -8.186324239e-01f, 5.743177533e-01f, 1.476312131e-01f, 9.890424609e-01f,
  6.967067122e-01f, 7.173560858e-01f, 9.005023241e-01f, 4.348512292e-01f, 9.681702852e-01f, 2.502923310e-01f, 9.898977876e-01f, 1.417829692e-01f,
  9.968017340e-01f, 7.991468906e-02f, 9.989882708e-01f, 4.497213289e-02f, 9.996800423e-01f, 2.529552206e-02f, 9.998987913e-01f, 1.422575582e-02f,
  9.999679923e-01f, 7.999914698e-03f, 9.999898672e-01f, 4.498715047e-03f, 9.999967813e-01f, 2.529819263e-03f, 9.999989867e-01f, 1.422623056e-03f,
  -9.111302495e-01f, 4.121184945e-01f, 3.416602612e-01f, -9.398235083e-01f, -9.566441774e-01f, 2.912592292e-01f, -2.965079620e-02f, 9.995602965e-01f,
  6.216099262e-01f, 7.833269238e-01f, 8.746382594e-01f, 4.847761393e-01f, 9.597726464e-01f, 2.807783186e-01f, 9.872201085e-01f, 1.593627781e-01f,
  9.959527254e-01f, 8.987854421e-02f, 9.987195730e-01f, 5.058911815e-02f, 9.995950460e-01f, 2.845665626e-02f, 9.998719096e-01f, 1.600383036e-02f,
  9.999595284e-01f, 8.999879472e-03f, 9.999871850e-01f, 5.061050411e-03f, 9.999959469e-01f, 2.846045885e-03f, 9.999987483e-01f, 1.600450720e-03f,
  -8.390715122e-01f, -5.440211296e-01f, 7.901318669e-01f, -6.129369140e-01f, -9.997860789e-01f, -2.068356983e-02f, -2.059976310e-01f, 9.785524607e-01f,
  5.403022766e-01f, 8.414709568e-01f, 8.460091352e-01f, 5.331684351e-01f, 9.504153132e-01f, 3.109835684e-01f, 9.842302203e-01f, 1.768921912e-01f,
  9.950041771e-01f, 9.983341396e-02f, 9.984192848e-01f, 5.620449781e-02f, 9.995000362e-01f, 3.161750361e-02f, 9.998418689e-01f, 1.778185740e-02f,
  9.999499917e-01f, 9.999834001e-03f, 9.999842048e-01f, 5.623383448e-03f, 9.999949932e-01f, 3.162272274e-03f, 9.999983907e-01f, 1.778278500e-03f,
  4.425697960e-03f, -9.999902248e-01f, 9.952573776e-01f, -9.727645665e-02f, -9.437797666e-01f, -3.305749595e-01f, -3.758473992e-01f, 9.266815782e-01f,
  4.535960853e-01f, 8.912073970e-01f, 8.147053123e-01f, 5.798751712e-01f, 9.401075840e-01f, 3.408778608e-01f, 9.809291363e-01f, 1.943656504e-01f,
  9.939560890e-01f, 1.097782999e-01f, 9.980874062e-01f, 6.181810424e-02f, 9.993950725e-01f, 3.477803990e-02f, 9.998086691e-01f, 1.955982670e-02f,
  9.999395013e-01f, 1.099977922e-02f, 9.999808669e-01f, 6.185714621e-03f, 9.999939203e-01f, 3.478498431e-03f, 9.999980927e-01f, 1.956106164e-03f,
  8.438539505e-01f, -5.365729332e-01f, 8.938615918e-01f, 4.483429790e-01f, -7.941793799e-01f, -6.076834202e-01f, -5.338430405e-01f, 8.455836177e-01f,
  3.623577058e-01f, 9.320390821e-01f, 7.808259130e-01f, 6.247486472e-01f, 9.288598895e-01f, 3.704313040e-01f, 9.773178697e-01f, 2.117776722e-01f,
  9.928086400e-01f, 1.197122037e-01f, 9.977239966e-01f, 6.742975861e-02f, 9.992800951e-01f, 3.793822229e-02f, 9.997723103e-01f, 2.133773454e-02f,
  9.999279976e-01f, 1.199971233e-02f, 9.999772310e-01f, 6.748044398e-03f, 9.999927878e-01f, 3.794723889e-03f, 9.999977350e-01f, 2.133933594e-03f,
  9.074468017e-01f, 4.201670289e-01f, 5.171728730e-01f, 8.558809757e-01f, -5.658205152e-01f, -8.245284557e-01f, -6.750016809e-01f, 7.378162146e-01f,
  2.674987614e-01f, 9.635581970e-01f, 7.444779873e-01f, 6.676470041e-01f, 9.166833758e-01f, 3.996143043e-01f, 9.733975530e-01f, 2.291227132e-01f,
  9.915618896e-01f, 1.296341419e-01f, 9.973290563e-01f, 7.303927839e-02f, 9.991551042e-01f, 4.109803215e-02f, 9.997327924e-01f, 2.311557345e-02f,
  9.999154806e-01f, 1.299963426e-02f, 9.999732971e-01f, 7.310371846e-03f, 9.999915361e-01f, 4.110949114e-03f, 9.999973178e-01f, 2.311761025e-03f,
  1.367372125e-01f, 9.906073809e-01f, -1.879615150e-02f, 9.998233318e-01f, -2.813494802e-01f, -9.596053958e-01f, -7.948709130e-01f, 6.067785621e-01f,
  1.699671596e-01f, 9.854497313e-01f, 7.057763934e-01f, 7.084347010e-01f, 9.035902619e-01f, 4.283977747e-01f, 9.691694379e-01f, 2.463953048e-01f,
  9.902160168e-01f, 1.395431161e-01f, 9.969025850e-01f, 7.864648104e-02f, 9.990201592e-01f, 4.425742477e-02f, 9.996901155e-01f, 2.489333972e-02f,
  9.999020100e-01f, 1.399954315e-02f, 9.999690056e-01f, 7.872696966e-03f, 9.999902248e-01f, 4.427174106e-03f, 9.999969006e-01f, 2.489588689e-03f,
  -7.596879005e-01f, 6.502878666e-01f, -5.489754677e-01f, 8.358384371e-01f, 3.102235124e-02f, -9.995186925e-01f, -8.896704316e-01f, 4.566032588e-01f,
  7.073719800e-02f, 9.974949956e-01f, 6.648434997e-01f, 7.469826341e-01f, 8.895936012e-01f, 4.567528665e-01f, 9.646348357e-01f, 2.635899782e-01f,
  9.887710810e-01f, 1.494381279e-01f, 9.964445233e-01f, 8.425120264e-02f, 9.988752007e-01f, 4.741638154e-02f, 9.996442795e-01f, 2.667102963e-02f,
  9.998875260e-01f, 1.499943808e-02f, 9.999644160e-01f, 8.435020223e-03f, 9.999887347e-01f, 4.743398633e-03f, 9.999964237e-01f, 2.667415887e-03f,
  -9.576594830e-01f, -2.879033089e-01f, -9.100810885e-01f, 4.144302309e-01f, 3.403181732e-01f, -9.403103590e-01f, -9.564100504e-01f, 2.920270860e-01f,
  -2.919954620e-02f, 9.995735884e-01f, 6.218088269e-01f, 7.831690907e-01f, 8.747074604e-01f, 4.846512377e-01f, 9.597951770e-01f, 2.807013094e-01f,
  9.872272611e-01f, 1.593182087e-01f, 9.959549904e-01f, 8.985326439e-02f, 9.987202883e-01f, 5.057485774e-02f, 9.995952845e-01f, 2.844863199e-02f,
  9.998720288e-01f, 1.599931903e-02f, 9.999595284e-01f, 8.997339755e-03f, 9.999871850e-01f, 5.059622694e-03f, 9.999959469e-01f, 2.845243318e-03f,
  -2.751633525e-01f, -9.613974690e-01f, -9.908979535e-01f, -1.346151382e-01f, 6.158648133e-01f, -7.878518701e-01f, -9.929850101e-01f, 1.182405204e-01f,
  -1.288445443e-01f, 9.916648269e-01f, 5.768082738e-01f, 8.168795705e-01f, 8.589466810e-01f, 5.120649934e-01f, 9.546520114e-01f, 2.977238595e-01f,
  9.855847955e-01f, 1.691823453e-01f, 9.954339862e-01f, 9.545248002e-02f, 9.985553622e-01f, 5.373282731e-02f, 9.995430708e-01f, 3.022614494e-02f,
  9.998555183e-01f, 1.699918136e-02f, 9.999542832e-01f, 9.559656493e-03f, 9.999855757e-01f, 5.375845823e-03f, 9.999954104e-01f, 3.023070283e-03f,
  6.603167057e-01f, -7.509872317e-01f, -7.665365338e-01f, -6.422007084e-01f, 8.303361535e-01f, -5.572628975e-01f, -9.982416630e-01f, -5.927551910e-02f,
  -2.272021621e-01f, 9.738476276e-01f, 5.299841762e-01f, 8.480075598e-01f, 8.423270583e-01f, 5.389667153e-01f, 9.492070079e-01f, 3.146522641e-01f,
  9.838436842e-01f, 1.790295690e-01f, 9.948815107e-01f, 1.010486856e-01f, 9.983804226e-01f, 5.689026415e-02f, 9.994877577e-01f, 3.200356290e-02f,
  9.998379946e-01f, 1.799902879e-02f, 9.999487996e-01f, 1.012197044e-02f, 9.999837875e-01f, 5.692068953e-03f, 9.999948740e-01f, 3.200897481e-03f,
  9.887046218e-01f, 1.498772055e-01f, -3.060953915e-01f, -9.520008564e-01f, 9.624637961e-01f, -2.714101076e-01f, -9.720142484e-01f, -2.349217981e-01f,
  -3.232895434e-01f, 9.463000894e-01f, 4.814845920e-01f, 8.764545321e-01f, 8.248651624e-01f, 5.653295517e-01f, 9.434618354e-01f, 3.314811885e-01f,
  9.820042253e-01f, 1.888588965e-01f, 9.942975044e-01f, 1.066416800e-01f, 9.981955290e-01f, 6.004713103e-02f, 9.994292855e-01f, 3.378088027e-02f,
  9.998195171e-01f, 1.899885759e-02f, 9.999428988e-01f, 1.068428159e-02f, 9.999819398e-01f, 6.008291151e-03f, 9.999942780e-01f, 3.378724447e-03f,
  4.080820680e-01f, 9.129452705e-01f, 2.486167252e-01f, -9.686019421e-01f, 9.991443753e-01f, 4.135828838e-02f, -9.151299596e-01f, -4.031589925e-01f,
  -4.161468446e-01f, 9.092974067e-01f, 4.314628243e-01f, 9.021307230e-01f, 8.065784574e-01f, 5.911270380e-01f, 9.374182820e-01f, 3.482052684e-01f,
  9.800665975e-01f, 1.986693144e-01f, 9.936820865e-01f, 1.122313142e-01f, 9.980006814e-01f, 6.320339441e-02f, 9.993675947e-01f, 3.555808961e-02f,
  9.998000264e-01f, 1.999866776e-02f, 9.999367595e-01f, 1.124658901e-02f, 9.999799728e-01f, 6.324512884e-03f, 9.999936819e-01f, 3.556551412e-03f,
  -5.477292538e-01f, 8.366556168e-01f, 7.267602682e-01f, -6.868911982e-01f, 9.367404580e-01f, 3.500247598e-01f, -8.293829560e-01f, -5.586805344e-01f,
  -5.048462152e-01f, 8.632093072e-01f, 3.800770044e-01f, 9.249548316e-01f, 7.874851823e-01f, 6.163335443e-01f, 9.310783744e-01f, 3.648192585e-01f,
  9.780309200e-01f, 2.084598988e-01f, 9.930352569e-01f, 1.178173944e-01f, 9.977958202e-01f, 6.635902822e-02f, 9.993028045e-01f, 3.733518720e-02f,
  9.997795224e-01f, 2.099845745e-02f, 9.999302626e-01f, 1.180889271e-02f, 9.999779463e-01f, 6.640734151e-03f, 9.999930263e-01f, 3.734378144e-03f,
  -9.999608397e-01f, -8.851309307e-03f, 9.810745716e-01f, -1.936302334e-01f, 7.814403772e-01f, 6.239799261e-01f, -7.174774408e-01f, -6.965817213e-01f,
  -5.885011554e-01f, 8.084963560e-01f, 3.274895847e-01f, 9.448547959e-01f, 7.676045895e-01f, 6.409237385e-01f, 9.244439602e-01f, 3.813178837e-01f,
  9.758974314e-01f, 2.182296216e-01f, 9.923570156e-01f, 1.233997419e-01f, 9.975810051e-01f, 6.951400638e-02f, 9.992348552e-01f, 3.911216930e-02f,
  9.997580051e-01f, 2.199822664e-02f, 9.999234676e-01f, 1.237119269e-02f, 9.999758005e-01f, 6.956954487e-03f, 9.999923706e-01f, 3.912204877e-03f,
  -5.328330398e-01f, -8.462204337e-01f, 9.332357645e-01f, 3.592645228e-01f, 5.486452579e-01f, 8.360552788e-01f, -5.829432607e-01f, -8.125128746e-01f,
  -6.662759781e-01f, 7.457052469e-01f, 2.738668323e-01f, 9.617676139e-01f, 7.469564080e-01f, 6.648730636e-01f, 9.175173044e-01f, 3.976959288e-01f,
  9.736663699e-01f, 2.279775143e-01f, 9.916474223e-01f, 1.289781928e-01f, 9.973561764e-01f, 7.266827673e-02f, 9.991636872e-01f, 4.088902473e-02f,
  9.997355342e-01f, 2.299797349e-02f, 9.999163747e-01f, 1.293348987e-02f, 9.999735355e-01f, 7.273174357e-03f, 9.999916553e-01f, 4.090031609e-03f,
  4.241790175e-01f, -9.055783749e-01f, 5.979771614e-01f, 8.015131354e-01f, 2.614416778e-01f, 9.652192593e-01f, -4.300232828e-01f, -9.028177857e-01f,
  -7.373937964e-01f, 6.754631400e-01f, 2.193782777e-01f, 9.756398797e-01f, 7.255613208e-01f, 6.881574988e-01f, 9.103004336e-01f, 4.139482081e-01f,
  9.713379741e-01f, 2.377026230e-01f, 9.909064770e-01f, 1.345525682e-01f, 9.971213937e-01f, 7.582182437e-02f, 9.990894198e-01f, 4.266574979e-02f,
  9.997119904e-01f, 2.399769612e-02f, 9.999089241e-01f, 1.349578146e-02f, 9.999712110e-01f, 7.589393295e-03f, 9.999908805e-01f, 4.267857410e-03f,
  9.912028313e-01f, -1.323517561e-01f, 7.855226099e-02f, 9.969099760e-01f, -5.168933049e-02f, 9.986631870e-01f, -2.635405958e-01f, -9.646483064e-01f,
  -8.011435866e-01f, 5.984721184e-01f, 1.641961634e-01f, 9.864277244e-01f, 7.034407258e-01f, 7.107539177e-01f, 9.027957320e-01f, 4.300695956e-01f,
  9.689124227e-01f, 2.474039644e-01f, 9.901341200e-01f, 1.401226968e-01f, 9.968766570e-01f, 7.897461206e-02f, 9.990119338e-01f, 4.444234073e-02f,
  9.996874928e-01f, 2.499739639e-02f, 9.999011755e-01f, 1.405806933e-02f, 9.999687672e-01f, 7.905611768e-03f, 9.999901056e-01f, 4.445684142e-03f,
  6.469193101e-01f, 7.625584602e-01f, -4.650644958e-01f, 8.852767944e-01f, -3.596943319e-01f, 9.330701828e-01f, -8.874550462e-02f, -9.960543513e-01f,
  -8.568888307e-01f, 5.155012608e-01f, 1.084949449e-01f, 9.940969944e-01f, 6.806167960e-01f, 7.326396108e-01f, 8.950055838e-01f, 4.460549951e-01f,
  9.663899541e-01f, 2.570805550e-01f, 9.893305302e-01f, 1.456883848e-01f, 9.966219068e-01f, 8.212661743e-02f, 9.989313483e-01f, 4.621879384e-02f,
  9.996620417e-01f, 2.599707060e-02f, 9.998931289e-01f, 1.462035347e-02f, 9.999662042e-01f, 8.221829310e-03f, 9.999893308e-01f, 4.623509943e-03f,
  -2.921388149e-01f, 9.563759565e-01f, -8.654506207e-01f, 5.009942055e-01f, -6.320286393e-01f, 7.749450207e-01f, 8.884811401e-02f, -9.960451722e-01f,
  -9.040721655e-01f, 4.273798466e-01f, 5.245061591e-02f, 9.986234903e-01f, 6.571123004e-01f, 7.537927032e-01f, 8.869323730e-01f, 4.618993104e-01f,
  9.637709260e-01f, 2.667314112e-01f, 9.884956479e-01f, 1.512494683e-01f, 9.963572025e-01f, 8.527779579e-02f, 9.988475442e-01f, 4.799510166e-02f,
  9.996355176e-01f, 2.699672058e-02f, 9.998847246e-01f, 1.518263202e-02f, 9.999635220e-01f, 8.538045920e-03f, 9.999884963e-01f, 4.801335745e-03f,
  -9.626058936e-01f, 2.709057927e-01f, -9.992933869e-01f, -3.758566082e-02f, -8.416849375e-01f, 5.399689674e-01f, 2.636395097e-01f, -9.646213055e-01f,
  -9.422222972e-01f, 3.349882066e-01f, -3.759419080e-03f, 9.999929070e-01f, 6.329506636e-01f, 7.741920948e-01f, 8.785787225e-01f, 4.775975943e-01f,
  9.610554576e-01f, 2.763556540e-01f, 9.876294732e-01f, 1.568057537e-01f, 9.960825443e-01f, 8.842811733e-02f, 9.987606406e-01f, 4.977125302e-02f,
  9.996080399e-01f, 2.799634263e-02f, 9.998760223e-01f, 1.574490592e-02f, 9.999607801e-01f, 8.854261599e-03f, 9.999876022e-01f, 4.979162011e-03f,
  -7.480575442e-01f, -6.636338830e-01f, -8.253716230e-01f, -5.645897985e-01f, -9.678714871e-01f, 2.514453232e-01f, 4.301158488e-01f, -9.027736783e-01f,
  -9.709581733e-01f, 2.392492294e-01f, -5.995756760e-02f, 9.982009530e-01f, 6.081562042e-01f, 7.938174009e-01f, 8.699471951e-01f, 4.931448400e-01f,
  9.582439065e-01f, 2.859522104e-01f, 9.867320657e-01f, 1.623570919e-01f, 9.957979321e-01f, 9.157756716e-02f, 9.986705780e-01f, 5.154724792e-02f,
  9.995795488e-01f, 2.899593674e-02f, 9.998670220e-01f, 1.630717516e-02f, 9.999579787e-01f, 9.170476347e-03f, 9.999867082e-01f, 5.156987347e-03f,
  1.542514563e-01f, -9.880316257e-01f, -3.972518742e-01f, -9.177096486e-01f, -9.980752468e-01f, -6.201484054e-02f, 5.830269456e-01f, -8.124528527e-01f,
  -9.899924994e-01f, 1.411200017e-01f, -1.159661636e-01f, 9.932531714e-01f, 5.827536583e-01f, 8.126488924e-01f, 8.610406518e-01f, 5.085361004e-01f,
  9.553365111e-01f, 2.955201864e-01f, 9.858034849e-01f, 1.679033041e-01f, 9.955033660e-01f, 9.472609311e-02f, 9.985772967e-01f, 5.332308263e-02f,
  9.995500445e-01f, 2.999550104e-02f, 9.998577237e-01f, 1.686943881e-02f, 9.999549985e-01f, 9.486690164e-03f, 9.999857545e-01f, 5.334813148e-03f,
  9.147423506e-01f, -4.040376544e-01f, 1.532154828e-01f, -9.881927967e-01f, -9.293003082e-01f, -3.693250120e-01f, 7.175492048e-01f, -6.965078115e-01f,
  -9.991351366e-01f, 4.158052057e-02f, -1.716081351e-01f, 9.851652980e-01f, 5.567683578e-01f, 8.306677938e-01f, 8.518617749e-01f, 5.237666368e-01f,
  9.523335695e-01f, 3.050586283e-01f, 9.848436713e-01f, 1.734442115e-01f, 9.951988459e-01f, 9.787366539e-02f, 9.984809160e-01f, 5.509874597e-02f,
  9.995195270e-01f, 3.099503554e-02f, 9.998480678e-01f, 1.743169688e-02f, 9.999519587e-01f, 9.802903049e-03f, 9.999848008e-01f, 5.512638018e-03f,
  8.342233896e-01f, 5.514267087e-01f, 6.564951539e-01f, -7.543302178e-01f, -7.683671117e-01f, -6.400094032e-01f, 8.294403553e-01f, -5.585952997e-01f,
  -9.982947707e-01f, -5.837419257e-02f, -2.267075777e-01f, 9.739628434e-01f, 5.302263498e-01f, 8.478561044e-01f, 8.424135447e-01f, 5.388315320e-01f,
  9.492354393e-01f, 3.145665526e-01f, 9.838528037e-01f, 1.789796203e-01f, 9.948843718e-01f, 1.010202691e-01f, 9.983813763e-01f, 5.687423423e-02f,
  9.994880557e-01f, 3.199454024e-02f, 9.998381138e-01f, 1.799395122e-02f, 9.999487996e-01f, 1.011911593e-02f, 9.999837875e-01f, 5.690463353e-03f,
  -1.327674743e-02f, 9.999118447e-01f, 9.575860500e-01f, -2.881473899e-01f, -5.312352777e-01f, -8.472243547e-01f, 9.151713848e-01f, -4.030649364e-01f,
  -9.874798059e-01f, -1.577456445e-01f, -2.810903192e-01f, 9.596813321e-01f, 5.031541586e-01f, 8.641966581e-01f, 8.326989412e-01f, 5.537260175e-01f,
  9.460423589e-01f, 3.240430057e-01f, 9.828307629e-01f, 1.845093668e-01f, 9.945599437e-01f, 1.041658595e-01f, 9.982786179e-01f, 5.864954367e-02f,
  9.994555712e-01f, 3.299400955e-02f, 9.998278022e-01f, 1.855619811e-02f, 9.999455214e-01f, 1.043532696e-02f, 9.999827743e-01f, 5.868288688e-03f,
  -8.485702872e-01f, 5.290827155e-01f, 9.637575150e-01f, 2.667797208e-01f, -2.414211184e-01f, -9.704204202e-01f, 9.720383286e-01f, -2.348221242e-01f,
  -9.667981863e-01f, -2.555412054e-01f, -3.345843852e-01f, 9.423658252e-01f, 4.755789042e-01f, 8.796730638e-01f, 8.227210045e-01f, 5.684453845e-01f,
  9.427546859e-01f, 3.334870934e-01f, 9.817776680e-01f, 1.900332868e-01f, 9.942255616e-01f, 1.073104069e-01f, 9.981727600e-01f, 6.042466685e-02f,
  9.994220734e-01f, 3.399345279e-02f, 9.998172522e-01f, 1.911843941e-02f, 9.999421835e-01f, 1.075153705e-02f, 9.999817014e-01f, 6.046113092e-03f,
  -9.036921859e-01f, -4.281826615e-01f, 6.731102467e-01f, 7.395421267e-01f, 7.233466953e-02f, -9.973804355e-01f, 9.982477427e-01f, -5.917267874e-02f,
  -9.364566803e-01f, -3.507832289e-01f, -3.870206773e-01f, 9.220710397e-01f, 4.475280643e-01f, 8.942698836e-01f, 8.124829531e-01f, 5.829849839e-01f,
  9.393727183e-01f, 3.428978026e-01f, 9.806935191e-01f, 1.955512017e-01f, 9.938812256e-01f, 1.104538813e-01f, 9.980637431e-01f, 6.219960377e-02f,
  9.993875623e-01f, 3.499285504e-02f, 9.998063445e-01f, 1.968067512e-02f, 9.999387264e-01f, 1.106774528e-02f, 9.999806285e-01f, 6.223937962e-03f,
  -1.279636919e-01f, -9.917788506e-01f, 1.751565337e-01f, 9.845405817e-01f, 3.789161742e-01f, -9.254310131e-01f, 9.929728508e-01f, 1.183425859e-01f,
  -8.967583776e-01f, -4.425205588e-01f, -4.382335544e-01f, 8.988611698e-01f, 4.190297425e-01f, 9.079725146e-01f, 8.019878864e-01f, 5.973402858e-01f,
  9.358968139e-01f, 3.522742093e-01f, 9.795783162e-01f, 2.010629177e-01f, 9.935269952e-01f, 1.135962531e-01f, 9.979515672e-01f, 6.397433579e-02f,
  9.993520975e-01f, 3.599222749e-02f, 9.997950792e-01f, 2.024290524e-02f, 9.999352098e-01f, 1.138395350e-02f, 9.999794960e-01f, 6.401761901e-03f,
  7.654140592e-01f, -6.435381174e-01f, -3.767423034e-01f, 9.263181090e-01f, 6.479216814e-01f, -7.617069483e-01f, 9.563800097e-01f, 2.921253741e-01f,
  -8.481000066e-01f, -5.298361778e-01f, -4.880608618e-01f, 8.728095889e-01f, 3.901124299e-01f, 9.207672477e-01f, 7.912392616e-01f, 6.115067005e-01f,
  9.323273301e-01f, 3.616154492e-01f, 9.784321785e-01f, 2.065682709e-01f, 9.931628108e-01f, 1.167374924e-01f, 9.978361726e-01f, 6.574887782e-02f,
  9.993155599e-01f, 3.699155897e-02f, 9.997835755e-01f, 2.080512606e-02f, 9.999315739e-01f, 1.170015987e-02f, 9.999783635e-01f, 6.579586305e-03f,
  9.550736547e-01f, 2.963685691e-01f, -8.126112223e-01f, 5.828061700e-01f, 8.526731133e-01f, -5.224447846e-01f, 8.896234632e-01f, 4.566946924e-01f,
  -7.909677625e-01f, -6.118578315e-01f, -5.363451838e-01f, 8.439987302e-01f, 3.608050346e-01f, 9.326412678e-01f, 7.802404165e-01f, 6.254796982e-01f,
  9.286646247e-01f, 3.709204793e-01f, 9.772551060e-01f, 2.120671123e-01f, 9.927886724e-01f, 1.198775545e-01f, 9.977176785e-01f, 6.752320379e-02f,
  9.992780685e-01f, 3.799085692e-02f, 9.997717142e-01f, 2.136734314e-02f, 9.999278188e-01f, 1.201636530e-02f, 9.999771714e-01f, 6.757410709e-03f,
  2.666429281e-01f, 9.637953639e-01f, -9.982103705e-01f, 5.980031565e-02f, 9.728653431e-01f, -2.313720137e-01f, 7.948083878e-01f, 6.068604589e-01f,
  -7.259322405e-01f, -6.877662539e-01f, -5.829339027e-01f, 8.125196099e-01f, 3.311368525e-01f, 9.435827136e-01f, 7.689949274e-01f, 6.392549276e-01f,
  9.249090552e-01f, 3.801884055e-01f, 9.760470986e-01f, 2.175592482e-01f, 9.924046397e-01f, 1.230164245e-01f, 9.975960255e-01f, 6.929731369e-02f,
  9.992396235e-01f, 3.899011388e-02f, 9.997594953e-01f, 2.192955278e-02f, 9.999239445e-01f, 1.233256981e-02f, 9.999759793e-01f, 6.935234182e-03f,
  -6.669380665e-01f, 7.451131344e-01f, -8.763794303e-01f, -4.816212952e-01f, 9.965789914e-01f, 8.264580369e-02f, 6.749256253e-01f, 7.378857136e-01f,
  -6.536436081e-01f, -7.568024993e-01f, -6.276797056e-01f, 7.784717083e-01f, 3.011375964e-01f, 9.535806775e-01f, 7.575061917e-01f, 6.528279781e-01f,
  9.210609794e-01f, 3.894183338e-01f, 9.748082757e-01f, 2.230444849e-01f, 9.920106530e-01f, 1.261540651e-01f, 9.974712729e-01f, 7.107120752e-02f,
  9.992001057e-01f, 3.998933733e-02f, 9.997470379e-01f, 2.249175683e-02f, 9.999200106e-01f, 1.264877338e-02f, 9.999747276e-01f, 7.113057654e-03f,
  -9.873392582e-01f, -1.586226672e-01f, -4.846394062e-01f, -8.747140169e-01f, 9.214623570e-01f, 3.884676993e-01f, 5.337560773e-01f, 8.456384540e-01f,
  -5.748240352e-01f, -8.182770610e-01f, -6.704410911e-01f, 7.419627905e-01f, 2.708370686e-01f, 9.626252055e-01f, 7.457779050e-01f, 6.661946774e-01f,
  9.171208143e-01f, 3.986093104e-01f, 9.735385776e-01f, 2.285226882e-01f, 9.916067719e-01f, 1.292904317e-01f, 9.973433018e-01f, 7.284487784e-02f,
  9.991596341e-01f, 4.098851606e-02f, 9.997342229e-01f, 2.305394970e-02f, 9.999159575e-01f, 1.296497509e-02f, 9.999734163e-01f, 7.290880661e-03f,
  -3.999853134e-01f, -9.165215492e-01f, 5.636094138e-02f, -9.984104633e-01f, 7.549653649e-01f, 6.557646990e-01f, 3.757521510e-01f, 9.267202020e-01f,
  -4.902605712e-01f, -8.715758920e-01f, -7.110829353e-01f, 7.031081319e-01f, 2.402658761e-01f, 9.707071185e-01f, 7.338138223e-01f, 6.793506742e-01f,
  9.130889177e-01f, 4.077604413e-01f, 9.722381234e-01f, 2.339936644e-01f, 9.911929369e-01f, 1.324255317e-01f, 9.972121716e-01f, 7.461831719e-02f,
  9.991181493e-01f, 4.198765755e-02f, 9.997211099e-01f, 2.361613885e-02f, 9.999117851e-01f, 1.328117587e-02f, 9.999721050e-01f, 7.468704134e-03f,
  5.551133156e-01f, -8.317747712e-01f, 5.800031424e-01f, -8.146142364e-01f, 5.135984421e-01f, 8.580306768e-01f, 2.058971673e-01f, 9.785736203e-01f,
  -4.007990062e-01f, -9.161660075e-01f, -7.494767308e-01f, 6.620306373e-01f, 2.094544172e-01f, 9.778184295e-01f, 7.216176391e-01f, 6.922917962e-01f,
  9.089657664e-01f, 4.168707728e-01f, 9.709069133e-01f, 2.394572198e-01f, 9.907692075e-01f, 1.355592906e-01f, 9.970778823e-01f, 7.639151812e-02f,
  9.990756512e-01f, 4.298675060e-02f, 9.997076392e-01f, 2.417832054e-02f, 9.999075532e-01f, 1.359737478e-02f, 9.999707937e-01f, 7.646527141e-03f,
  9.998432994e-01f, 1.770192571e-02f, 9.250146747e-01f, -3.799313903e-01f, 2.212981731e-01f, 9.752061963e-01f, 2.954781987e-02f, 9.995633960e-01f,
  -3.073327839e-01f, -9.516021013e-01f, -7.855011225e-01f, 6.188601851e-01f, 1.784335226e-01f, 9.839519858e-01f, 7.091933489e-01f, 7.050140500e-01f,
  9.047516584e-01f, 4.259394705e-01f, 9.695450068e-01f, 2.449132055e-01f, 9.903355837e-01f, 1.386916935e-01f, 9.969404936e-01f, 7.816448808e-02f,
  9.990321398e-01f, 4.398580641e-02f, 9.996939301e-01f, 2.474049293e-02f, 9.999032021e-01f, 1.391357277e-02f, 9.999693632e-01f, 7.824349217e-03f,
  5.253219604e-01f, 8.509035110e-01f, 9.851381779e-01f, 1.717635691e-01f, -9.294810891e-02f, 9.956709743e-01f, -1.477329880e-01f, 9.890272617e-01f,
  -2.107958049e-01f, -9.775301218e-01f, -8.190422058e-01f, 5.737332702e-01f, 1.472342163e-01f, 9.891016483e-01f, 6.965447664e-01f, 7.175133228e-01f,
  9.004471302e-01f, 4.349655211e-01f, 9.681524038e-01f, 2.503614724e-01f, 9.898920655e-01f, 1.418227106e-01f, 9.967998862e-01f, 7.993719727e-02f,
  9.989876747e-01f, 4.498481750e-02f, 9.996798635e-01f, 2.530265786e-02f, 9.998987317e-01f, 1.422976889e-02f, 9.999679923e-01f, 8.002171293e-03f,
  -4.321779311e-01f, 9.017883539e-01f, 7.418580055e-01f, 6.705570221e-01f, -3.979767561e-01f, 9.173954725e-01f, -3.203543723e-01f, 9.472977519e-01f,
  -1.121526212e-01f, -9.936909676e-01f, -8.499938846e-01f, 5.267925262e-01f, 1.158876941e-01f, 9.932623506e-01f, 6.836758852e-01f, 7.297857404e-01f,
  8.960524797e-01f, 4.439480901e-01f, 9.667292237e-01f, 2.558017969e-01f, 9.894386530e-01f, 1.449523121e-01f, 9.966561794e-01f, 8.170966059e-02f,
  9.989421964e-01f, 4.598378390e-02f, 9.996654391e-01f, 2.586481534e-02f, 9.998942018e-01f, 1.454596408e-02f, 9.999665618e-01f, 8.179994300e-03f,
  -9.923354983e-01f, 1.235731244e-01f, 2.700984478e-01f, 9.628326893e-01f, -6.635382771e-01f, 7.481423616e-01f, -4.828719497e-01f, 8.756909966e-01f,
  -1.238837745e-02f, -9.999232888e-01f, -8.782584071e-01f, 4.781863391e-01f, 8.442528546e-02f, 9.964298010e-01f, 6.705908775e-01f, 7.418274283e-01f,
  8.915683031e-01f, 4.528862834e-01f, 9.652754664e-01f, 2.612340748e-01f, 9.889753461e-01f, 1.480804533e-01f, 9.965093136e-01f, 8.348185569e-02f,
  9.988957047e-01f, 4.698270187e-02f, 9.996507764e-01f, 2.642696351e-02f, 9.998895526e-01f, 1.486215740e-02f, 9.999650717e-01f, 8.357816376e-03f,
  -6.401443481e-01f, -7.682546377e-01f, -2.848466039e-01f, 9.585731030e-01f, -8.632965088e-01f, 5.046970844e-01f, -6.301599741e-01f, 7.764653563e-01f,
  8.749917150e-02f, -9.961646199e-01f, -9.037463665e-01f, 4.280683994e-01f, 5.287845805e-02f, 9.986009598e-01f, 6.572937369e-01f, 7.536345124e-01f,
  8.869948983e-01f, 4.617791772e-01f, 9.637911916e-01f, 2.666580379e-01f, 9.885020852e-01f, 1.512071192e-01f, 9.963592887e-01f, 8.525379747e-02f,
  9.988481998e-01f, 4.798157141e-02f, 9.996357560e-01f, 2.698910423e-02f, 9.998847842e-01f, 1.517834887e-02f, 9.999635816e-01f, 8.535637520e-03f,
  3.005925417e-01f, -9.537526369e-01f, -7.520639896e-01f, 6.590901017e-01f, -9.774427414e-01f, 2.112006545e-01f, -7.575730681e-01f, 6.527503729e-01f,
  1.865124702e-01f, -9.824525714e-01f, -9.263771176e-01f, 3.765971363e-01f, 2.127875760e-02f, 9.997735620e-01f, 6.437888145e-01f, 7.652031779e-01f,
  8.823328614e-01f, 4.706258774e-01f, 9.622764587e-01f, 2.720735669e-01f, 9.880189896e-01f, 1.543322802e-01f, 9.962061048e-01f, 8.702547103e-02f,
  9.987997413e-01f, 4.898039624e-02f, 9.996203780e-01f, 2.755123749e-02f, 9.998799562e-01f, 1.549453940e-02f, 9.999620318e-01f, 8.713459596e-03f,
  9.649659991e-01f, -2.623748481e-01f, -9.876590967e-01f, 1.566190720e-01f, -9.946564436e-01f, -1.032404602e-01f, -8.610926867e-01f, 5.084479451e-01f,
  2.836622000e-01f, -9.589242935e-01f, -9.460792542e-01f, 3.239352703e-01f, -1.034221891e-02f, 9.999465346e-01f, 6.300802827e-01f, 7.765299678e-01f,
  8.775825500e-01f, 4.794255495e-01f, 9.607312679e-01f, 2.774805427e-01f, 9.875259995e-01f, 1.574558914e-01f, 9.960497618e-01f, 8.879686147e-02f,
  9.987502694e-01f, 4.997916892e-02f, 9.996047616e-01f, 2.811335959e-02f, 9.998750091e-01f, 1.581072807e-02f, 9.999604821e-01f, 8.891279809e-03f,
  7.421541810e-01f, 6.702291965e-01f, -9.190735221e-01f, -3.940860629e-01f, -9.132301211e-01f, -4.074441493e-01f, -9.374542236e-01f, 3.481085002e-01f,
  3.779776692e-01f, -9.258147478e-01f, -9.627903700e-01f, 2.702493370e-01f, -4.195285589e-02f, 9.991195798e-01f, 6.161724925e-01f, 7.876111865e-01f,
  8.727445006e-01f, 4.881772399e-01f, 9.591556787e-01f, 2.828786969e-01f, 9.870231748e-01f, 1.605779380e-01f, 9.958902597e-01f, 9.056797624e-02f,
  9.986997843e-01f, 5.097789690e-02f, 9.995887876e-01f, 2.867547423e-02f, 9.998699427e-01f, 1.612691768e-02f, 9.999588728e-01f, 9.069100954e-03f,
  -1.629907787e-01f, 9.866275787e-01f, -5.674300194e-01f, -8.234215975e-01f, -7.412399650e-01f, -6.712401509e-01f, -9.842484593e-01f, 1.767906845e-01f,
  4.685169160e-01f, -8.834545016e-01f, -9.764577150e-01f, 2.157090008e-01f, -7.352153957e-02f, 9.972936511e-01f, 6.020699143e-01f, 7.984433770e-01f,
  8.678191900e-01f, 4.968801141e-01f, 9.575498104e-01f, 2.882679403e-01f, 9.865104556e-01f, 1.636983752e-01f, 9.957276583e-01f, 9.233880043e-02f,
  9.986482859e-01f, 5.197656900e-02f, 9.995725155e-01f, 2.923758142e-02f, 9.998648167e-01f, 1.644310169e-02f, 9.999572635e-01f, 9.246920235e-03f,
  -9.182828069e-01f, 3.959251642e-01f, -4.102819040e-02f, -9.991579652e-01f, -4.957418144e-01f, -8.684699535e-01f, -1.000000000e+00f, -1.030206768e-04f,
  5.543745160e-01f, -8.322673440e-01f, -9.870380163e-01f, 1.604867280e-01f, -1.050167084e-01f, 9.944704771e-01f, 5.877769589e-01f, 8.090230227e-01f,
  8.628070951e-01f, 5.055333376e-01f, 9.559136033e-01f, 2.936480343e-01f, 9.859878421e-01f, 1.668171734e-01f, 9.955618382e-01f, 9.410934150e-02f,
  9.985958338e-01f, 5.297519267e-02f, 9.995558858e-01f, 2.979967557e-02f, 9.998595715e-01f, 1.675928757e-02f, 9.999555945e-01f, 9.424741380e-03f,
  -8.293098211e-01f, -5.587890744e-01f, 4.980095923e-01f, -8.671715260e-01f, -2.010796219e-01f, -9.795749187e-01f, -9.842120409e-01f, -1.769934744e-01f,
  6.346929669e-01f, -7.727644444e-01f, -9.944978952e-01f, 1.047568321e-01f, -1.364068687e-01f, 9.906529188e-01f, 5.732980371e-01f, 8.193469048e-01f,
  8.577086926e-01f, 5.141359568e-01f, 9.542471766e-01f, 2.990188897e-01f, 9.854553938e-01f, 1.699342877e-01f, 9.953929186e-01f, 9.587957710e-02f,
  9.985423684e-01f, 5.397376046e-02f, 9.995389581e-01f, 3.036176413e-02f, 9.998542070e-01f, 1.707546785e-02f, 9.999538660e-01f, 9.602561593e-03f,
  2.212675661e-02f, -9.997551441e-01f, 8.836693168e-01f, -4.681116641e-01f, 1.135217771e-01f, -9.935355186e-01f, -9.373825192e-01f, -3.483016491e-01f,
  7.086697817e-01f, -7.055402994e-01f, -9.988136292e-01f, 4.869600013e-02f, -1.676606387e-01f, 9.858447909e-01f, 5.586379170e-01f, 8.294116855e-01f,
  8.525245190e-01f, 5.226872563e-01f, 9.525505900e-01f, 3.043802381e-01f, 9.849131107e-01f, 1.730497181e-01f, 9.952208400e-01f, 9.764950722e-02f,
  9.984878898e-01f, 5.497227982e-02f, 9.995217323e-01f, 3.092384152e-02f, 9.998487830e-01f, 1.739165001e-02f, 9.999521971e-01f, 9.780380875e-03f,
  8.532201052e-01f, -5.215510130e-01f, 9.971746206e-01f, 7.511820644e-02f, 4.168670774e-01f, -9.089674354e-01f, -8.609884381e-01f, -5.086245537e-01f,
  7.755658031e-01f, -6.312667131e-01f, -9.999717474e-01f, -7.518785074e-03f, -1.987468749e-01f, 9.800508618e-01f, 5.438010693e-01f, 8.392141461e-01f,
  8.472551107e-01f, 5.311862230e-01f, 9.508239031e-01f, 3.097319603e-01f, 9.843609333e-01f, 1.761634201e-01f, 9.950456619e-01f, 9.941913933e-02f,
  9.984323978e-01f, 5.597073585e-02f, 9.995042086e-01f, 3.148590773e-02f, 9.998431802e-01f, 1.770782843e-02f, 9.999504089e-01f, 9.958200157e-03f,
  8.998668194e-01f, 4.361647666e-01f, 8.035690784e-01f, 5.952115059e-01f, 6.788702011e-01f, -7.342582941e-01f, -7.574391961e-01f, -6.529057026e-01f,
  8.347129226e-01f, -5.506852865e-01f, -9.979684949e-01f, -6.370979548e-02f, -2.296342701e-01f, 9.732769728e-01f, 5.287923217e-01f, 8.487512469e-01f,
  8.419010043e-01f, 5.396320224e-01f, 9.490671158e-01f, 3.150739372e-01f, 9.837989211e-01f, 1.792753637e-01f, 9.948672652e-01f, 1.011884511e-01f,
  9.983759522e-01f, 5.696914345e-02f, 9.994863272e-01f, 3.204796836e-02f, 9.998375773e-01f, 1.802400686e-02f, 9.999486208e-01f, 1.013601944e-02f,
  1.191801354e-01f, 9.928726554e-01f, 3.624766767e-01f, 9.319928288e-01f, 8.735505342e-01f, -4.867334962e-01f, -6.300007105e-01f, -7.765945792e-01f,
  8.855196238e-01f, -4.646020234e-01f, -9.928101897e-01f, -1.196993962e-01f, -2.602920532e-01f, 9.655299187e-01f, 5.136163235e-01f, 8.580200076e-01f,
  8.364626765e-01f, 5.480239391e-01f, 9.472803473e-01f, 3.204059005e-01f, 9.832270741e-01f, 1.823855042e-01f, 9.946857691e-01f, 1.029574350e-01f,
  9.983184934e-01f, 5.796748772e-02f, 9.994681478e-01f, 3.261001408e-02f, 9.998317957e-01f, 1.834018156e-02f, 9.999468327e-01f, 1.031383779e-02f,
  -7.710801959e-01f, 6.367380023e-01f, -1.902491003e-01f, 9.817358255e-01f, 9.816020727e-01f, -1.909380108e-01f, -4.826923311e-01f, -8.757900000e-01f,
  9.274784923e-01f, -3.738765717e-01f, -9.845131636e-01f, -1.753105819e-01f, -2.906895578e-01f, 9.568174481e-01f, 4.982779026e-01f, 8.670173883e-01f,
  8.309407234e-01f, 5.563610196e-01f, 9.454635978e-01f, 3.257277906e-01f, 9.826454520e-01f, 1.854938269e-01f, 9.945011139e-01f, 1.047261059e-01f,
  9.982600212e-01f, 5.896577984e-02f, 9.994496703e-01f, 3.317204863e-02f, 9.998259544e-01f, 1.865635626e-02f, 9.999449849e-01f, 1.049165614e-02f,
  -9.524129629e-01f, -3.048106134e-01f, -6.843819022e-01f, 7.291237116e-01f, 9.923083186e-01f, 1.237909496e-01f, -3.201591671e-01f, -9.473637342e-01f,
  9.601702690e-01f, -2.794154882e-01f, -9.731037021e-01f, -2.303675115e-01f, -3.207964003e-01f, 9.471482038e-01f, 4.827820361e-01f, 8.757405281e-01f,
  8.253356218e-01f, 5.646424294e-01f, 9.436169863e-01f, 3.310393095e-01f, 9.820539355e-01f, 1.886002868e-01f, 9.943132997e-01f, 1.064944416e-01f,
  9.982005358e-01f, 5.996400863e-02f, 9.994308352e-01f, 3.373407945e-02f, 9.998199940e-01f, 1.897252724e-02f, 9.999430776e-01f, 1.066947449e-02f,
  -2.581016421e-01f, -9.661177993e-01f, -9.677396417e-01f, 2.519522607e-01f, 9.046075940e-01f, 4.262454212e-01f, -1.475291997e-01f, -9.890577197e-01f,
  9.832684398e-01f, -1.821625978e-01f, -9.586178064e-01f, -2.846961617e-01f, -3.505824506e-01f, 9.365318418e-01f, 4.671334028e-01f, 8.841868639e-01f,
  8.196480274e-01f, 5.728674531e-01f, 9.417404532e-01f, 3.363404274e-01f, 9.814526439e-01f, 1.917048544e-01f, 9.941223264e-01f, 1.082624346e-01f,
  9.981400967e-01f, 6.096218154e-02f, 9.994117022e-01f, 3.429609165e-02f, 9.998139739e-01f, 1.928869821e-02f, 9.999411702e-01f, 1.084729191e-02f,
  6.735071540e-01f, -7.391806841e-01f, -9.530500174e-01f, -3.028128743e-01f, 7.271980643e-01f, 6.864276528e-01f, 2.975377068e-02f, -9.995572567e-01f,
  9.965420961e-01f, -8.308912069e-02f, -9.411013126e-01f, -3.381247520e-01f, -3.800179660e-01f, 9.249790907e-01f, 4.513370395e-01f, 8.923535347e-01f,
  8.138784766e-01f, 5.810351372e-01f, 9.398342371e-01f, 3.416308761e-01f, 9.808415174e-01f, 1.948075294e-01f, 9.939282537e-01f, 1.100300923e-01f,
  9.980786443e-01f, 6.196028739e-02f, 9.993922710e-01f, 3.485809639e-02f, 9.998078346e-01f, 1.960486546e-02f, 9.999392033e-01f, 1.102510840e-02f,
  9.858965874e-01f, 1.673557013e-01f, -6.448370218e-01f, -7.643200755e-01f, 4.776714444e-01f, 8.785385489e-01f, 2.060983330e-01f, -9.785313010e-01f,
  9.998586178e-01f, 1.681409031e-02f, -9.206095338e-01f, -3.904843926e-01f, -4.090735018e-01f, 9.125014544e-01f, 4.353979528e-01f, 9.002380967e-01f,
  8.080275059e-01f, 5.891447663e-01f, 9.378982186e-01f, 3.469105363e-01f, 9.802205563e-01f, 1.979082376e-01f, 9.937310219e-01f, 1.117973924e-01f,
  9.980161786e-01f, 6.295833737e-02f, 9.993724823e-01f, 3.542009369e-02f, 9.998015761e-01f, 1.992103085e-02f, 9.999372363e-01f, 1.120292582e-02f,
};
__device__ const float ROPE32[1024] = {
  1.000000000e+00f, 0.000000000e+00f, 1.000000000e+00f, 0.000000000e+00f, 1.000000000e+00f, 0.000000000e+00f, 1.000000000e+00f, 0.000000000e+00f,
  1.000000000e+00f, 0.000000000e+00f, 1.000000000e+00f, 0.000000000e+00f, 1.000000000e+00f, 0.000000000e+00f, 1.000000000e+00f, 0.000000000e+00f,
  5.403022766e-01f, 8.414709568e-01f, 9.504152536e-01f, 3.109835982e-01f, 9.950041771e-01f, 9.983342141e-02f, 9.995000362e-01f, 3.161750361e-02f,
  9.999499917e-01f, 9.999833070e-03f, 9.999949932e-01f, 3.162272274e-03f, 9.999995232e-01f, 9.999999311e-04f, 9.999999404e-01f, 3.162277571e-04f,
  -4.161468446e-01f, 9.092974067e-01f, 8.065783978e-01f, 5.911270976e-01f, 9.800665975e-01f, 1.986693293e-01f, 9.980006814e-01f, 6.320339441e-02f,
  9.998000264e-01f, 1.999866590e-02f, 9.999799728e-01f, 6.324512884e-03f, 9.999979734e-01f, 1.999998698e-03f, 9.999998212e-01f, 6.324554561e-04f,
  -9.899924994e-01f, 1.411200017e-01f, 5.827536583e-01f, 8.126488924e-01f, 9.553365111e-01f, 2.955202162e-01f, 9.955033660e-01f, 9.472608566e-02f,
  9.995500445e-01f, 2.999549918e-02f, 9.999549985e-01f, 9.486690164e-03f, 9.999955297e-01f, 2.999995602e-03f, 9.999995232e-01f, 9.486831259e-04f,
  -6.536436081e-01f, -7.568024993e-01f, 3.011374772e-01f, 9.535807371e-01f, 9.210609794e-01f, 3.894183338e-01f, 9.920106530e-01f, 1.261540651e-01f,
  9.992001057e-01f, 3.998933360e-02f, 9.999200106e-01f, 1.264877338e-02f, 9.999920130e-01f, 3.999989480e-03f, 9.999992251e-01f, 1.264910679e-03f,
  2.836622000e-01f, -9.589242935e-01f, -1.034233812e-02f, 9.999465346e-01f, 8.775825500e-01f, 4.794255495e-01f, 9.875259995e-01f, 1.574558765e-01f,
  9.987502694e-01f, 4.997916520e-02f, 9.998750091e-01f, 1.581072807e-02f, 9.999874830e-01f, 4.999979399e-03f, 9.999987483e-01f, 1.581138116e-03f,
  9.601702690e-01f, -2.794154882e-01f, -3.207964003e-01f, 9.471482038e-01f, 8.253356218e-01f, 5.646424890e-01f, 9.820539355e-01f, 1.886002719e-01f,
  9.982005358e-01f, 5.996400490e-02f, 9.998199940e-01f, 1.897252724e-02f, 9.999819994e-01f, 5.999964196e-03f, 9.999982119e-01f, 1.897365320e-03f,
  7.539022565e-01f, 6.569865942e-01f, -5.994374752e-01f, 8.004215956e-01f, 7.648422122e-01f, 6.442176700e-01f, 9.755998850e-01f, 2.195560932e-01f,
  9.975510240e-01f, 6.994284689e-02f, 9.997550249e-01f, 2.213413455e-02f, 9.999755025e-01f, 6.999942940e-03f, 9.999975562e-01f, 2.213592408e-03f,
  -1.455000341e-01f, 9.893582463e-01f, -8.186324239e-01f, 5.743177533e-01f, 6.967067122e-01f, 7.173560858e-01f, 9.681702852e-01f, 2.502923310e-01f,
  9.968017340e-01f, 7.991468906e-02f, 9.996800423e-01f, 2.529552206e-02f, 9.999679923e-01f, 7.999914698e-03f, 9.999967813e-01f, 2.529819263e-03f,
  -9.111302495e-01f, 4.121184945e-01f, -9.566441774e-01f, 2.912592292e-01f, 6.216099262e-01f, 7.833269238e-01f, 9.597726464e-01f, 2.807783186e-01f,
  9.959527254e-01f, 8.987854421e-02f, 9.995950460e-01f, 2.845665626e-02f, 9.999595284e-01f, 8.999879472e-03f, 9.999959469e-01f, 2.846045885e-03f,
  -8.390715122e-01f, -5.440211296e-01f, -9.997860789e-01f, -2.068356983e-02f, 5.403022766e-01f, 8.414709568e-01f, 9.504153132e-01f, 3.109835684e-01f,
  9.950041771e-01f, 9.983341396e-02f, 9.995000362e-01f, 3.161750361e-02f, 9.999499917e-01f, 9.999834001e-03f, 9.999949932e-01f, 3.162272274e-03f,
  4.425697960e-03f, -9.999902248e-01f, -9.437797666e-01f, -3.305749595e-01f, 4.535960853e-01f, 8.912073970e-01f, 9.401075840e-01f, 3.408778608e-01f,
  9.939560890e-01f, 1.097782999e-01f, 9.993950725e-01f, 3.477803990e-02f, 9.999395013e-01f, 1.099977922e-02f, 9.999939203e-01f, 3.478498431e-03f,
  8.438539505e-01f, -5.365729332e-01f, -7.941793799e-01f, -6.076834202e-01f, 3.623577058e-01f, 9.320390821e-01f, 9.288598895e-01f, 3.704313040e-01f,
  9.928086400e-01f, 1.197122037e-01f, 9.992800951e-01f, 3.793822229e-02f, 9.999279976e-01f, 1.199971233e-02f, 9.999927878e-01f, 3.794723889e-03f,
  9.074468017e-01f, 4.201670289e-01f, -5.658205152e-01f, -8.245284557e-01f, 2.674987614e-01f, 9.635581970e-01f, 9.166833758e-01f, 3.996143043e-01f,
  9.915618896e-01f, 1.296341419e-01f, 9.991551042e-01f, 4.109803215e-02f, 9.999154806e-01f, 1.299963426e-02f, 9.999915361e-01f, 4.110949114e-03f,
  1.367372125e-01f, 9.906073809e-01f, -2.813494802e-01f, -9.596053958e-01f, 1.699671596e-01f, 9.854497313e-01f, 9.035902619e-01f, 4.283977747e-01f,
  9.902160168e-01f, 1.395431161e-01f, 9.990201592e-01f, 4.425742477e-02f, 9.999020100e-01f, 1.399954315e-02f, 9.999902248e-01f, 4.427174106e-03f,
  -7.596879005e-01f, 6.502878666e-01f, 3.102235124e-02f, -9.995186925e-01f, 7.073719800e-02f, 9.974949956e-01f, 8.895936012e-01f, 4.567528665e-01f,
  9.887710810e-01f, 1.494381279e-01f, 9.988752007e-01f, 4.741638154e-02f, 9.998875260e-01f, 1.499943808e-02f, 9.999887347e-01f, 4.743398633e-03f,
  -9.576594830e-01f, -2.879033089e-01f, 3.403181732e-01f, -9.403103590e-01f, -2.919954620e-02f, 9.995735884e-01f, 8.747074604e-01f, 4.846512377e-01f,
  9.872272611e-01f, 1.593182087e-01f, 9.987202883e-01f, 5.057485774e-02f, 9.998720288e-01f, 1.599931903e-02f, 9.999871850e-01f, 5.059622694e-03f,
  -2.751633525e-01f, -9.613974690e-01f, 6.158648133e-01f, -7.878518701e-01f, -1.288445443e-01f, 9.916648269e-01f, 8.589466810e-01f, 5.120649934e-01f,
  9.855847955e-01f, 1.691823453e-01f, 9.985553622e-01f, 5.373282731e-02f, 9.998555183e-01f, 1.699918136e-02f, 9.999855757e-01f, 5.375845823e-03f,
  6.603167057e-01f, -7.509872317e-01f, 8.303361535e-01f, -5.572628975e-01f, -2.272021621e-01f, 9.738476276e-01f, 8.423270583e-01f, 5.389667153e-01f,
  9.838436842e-01f, 1.790295690e-01f, 9.983804226e-01f, 5.689026415e-02f, 9.998379946e-01f, 1.799902879e-02f, 9.999837875e-01f, 5.692068953e-03f,
  9.887046218e-01f, 1.498772055e-01f, 9.624637961e-01f, -2.714101076e-01f, -3.232895434e-01f, 9.463000894e-01f, 8.248651624e-01f, 5.653295517e-01f,
  9.820042253e-01f, 1.888588965e-01f, 9.981955290e-01f, 6.004713103e-02f, 9.998195171e-01f, 1.899885759e-02f, 9.999819398e-01f, 6.008291151e-03f,
  4.080820680e-01f, 9.129452705e-01f, 9.991443753e-01f, 4.135828838e-02f, -4.161468446e-01f, 9.092974067e-01f, 8.065784574e-01f, 5.911270380e-01f,
  9.800665975e-01f, 1.986693144e-01f, 9.980006814e-01f, 6.320339441e-02f, 9.998000264e-01f, 1.999866776e-02f, 9.999799728e-01f, 6.324512884e-03f,
  -5.477292538e-01f, 8.366556168e-01f, 9.367404580e-01f, 3.500247598e-01f, -5.048462152e-01f, 8.632093072e-01f, 7.874851823e-01f, 6.163335443e-01f,
  9.780309200e-01f, 2.084598988e-01f, 9.977958202e-01f, 6.635902822e-02f, 9.997795224e-01f, 2.099845745e-02f, 9.999779463e-01f, 6.640734151e-03f,
  -9.999608397e-01f, -8.851309307e-03f, 7.814403772e-01f, 6.239799261e-01f, -5.885011554e-01f, 8.084963560e-01f, 7.676045895e-01f, 6.409237385e-01f,
  9.758974314e-01f, 2.182296216e-01f, 9.975810051e-01f, 6.951400638e-02f, 9.997580051e-01f, 2.199822664e-02f, 9.999758005e-01f, 6.956954487e-03f,
  -5.328330398e-01f, -8.462204337e-01f, 5.486452579e-01f, 8.360552788e-01f, -6.662759781e-01f, 7.457052469e-01f, 7.469564080e-01f, 6.648730636e-01f,
  9.736663699e-01f, 2.279775143e-01f, 9.973561764e-01f, 7.266827673e-02f, 9.997355342e-01f, 2.299797349e-02f, 9.999735355e-01f, 7.273174357e-03f,
  4.241790175e-01f, -9.055783749e-01f, 2.614416778e-01f, 9.652192593e-01f, -7.373937964e-01f, 6.754631400e-01f, 7.255613208e-01f, 6.881574988e-01f,
  9.713379741e-01f, 2.377026230e-01f, 9.971213937e-01f, 7.582182437e-02f, 9.997119904e-01f, 2.399769612e-02f, 9.999712110e-01f, 7.589393295e-03f,
  9.912028313e-01f, -1.323517561e-01f, -5.168933049e-02f, 9.986631870e-01f, -8.011435866e-01f, 5.984721184e-01f, 7.034407258e-01f, 7.107539177e-01f,
  9.689124227e-01f, 2.474039644e-01f, 9.968766570e-01f, 7.897461206e-02f, 9.996874928e-01f, 2.499739639e-02f, 9.999687672e-01f, 7.905611768e-03f,
  6.469193101e-01f, 7.625584602e-01f, -3.596943319e-01f, 9.330701828e-01f, -8.568888307e-01f, 5.155012608e-01f, 6.806167960e-01f, 7.326396108e-01f,
  9.663899541e-01f, 2.570805550e-01f, 9.966219068e-01f, 8.212661743e-02f, 9.996620417e-01f, 2.599707060e-02f, 9.999662042e-01f, 8.221829310e-03f,
  -2.921388149e-01f, 9.563759565e-01f, -6.320286393e-01f, 7.749450207e-01f, -9.040721655e-01f, 4.273798466e-01f, 6.571123004e-01f, 7.537927032e-01f,
  9.637709260e-01f, 2.667314112e-01f, 9.963572025e-01f, 8.527779579e-02f, 9.996355176e-01f, 2.699672058e-02f, 9.999635220e-01f, 8.538045920e-03f,
  -9.626058936e-01f, 2.709057927e-01f, -8.416849375e-01f, 5.399689674e-01f, -9.422222972e-01f, 3.349882066e-01f, 6.329506636e-01f, 7.741920948e-01f,
  9.610554576e-01f, 2.763556540e-01f, 9.960825443e-01f, 8.842811733e-02f, 9.996080399e-01f, 2.799634263e-02f, 9.999607801e-01f, 8.854261599e-03f,
  -7.480575442e-01f, -6.636338830e-01f, -9.678714871e-01f, 2.514453232e-01f, -9.709581733e-01f, 2.392492294e-01f, 6.081562042e-01f, 7.938174009e-01f,
  9.582439065e-01f, 2.859522104e-01f, 9.957979321e-01f, 9.157756716e-02f, 9.995795488e-01f, 2.899593674e-02f, 9.999579787e-01f, 9.170476347e-03f,
  1.542514563e-01f, -9.880316257e-01f, -9.980752468e-01f, -6.201484054e-02f, -9.899924994e-01f, 1.411200017e-01f, 5.827536583e-01f, 8.126488924e-01f,
  9.553365111e-01f, 2.955201864e-01f, 9.955033660e-01f, 9.472609311e-02f, 9.995500445e-01f, 2.999550104e-02f, 9.999549985e-01f, 9.486690164e-03f,
  9.147423506e-01f, -4.040376544e-01f, -9.293003082e-01f, -3.693250120e-01f, -9.991351366e-01f, 4.158052057e-02f, 5.567683578e-01f, 8.306677938e-01f,
  9.523335695e-01f, 3.050586283e-01f, 9.951988459e-01f, 9.787366539e-02f, 9.995195270e-01f, 3.099503554e-02f, 9.999519587e-01f, 9.802903049e-03f,
  8.342233896e-01f, 5.514267087e-01f, -7.683671117e-01f, -6.400094032e-01f, -9.982947707e-01f, -5.837419257e-02f, 5.302263498e-01f, 8.478561044e-01f,
  9.492354393e-01f, 3.145665526e-01f, 9.948843718e-01f, 1.010202691e-01f, 9.994880557e-01f, 3.199454024e-02f, 9.999487996e-01f, 1.011911593e-02f,
  -1.327674743e-02f, 9.999118447e-01f, -5.312352777e-01f, -8.472243547e-01f, -9.874798059e-01f, -1.577456445e-01f, 5.031541586e-01f, 8.641966581e-01f,
  9.460423589e-01f, 3.240430057e-01f, 9.945599437e-01f, 1.041658595e-01f, 9.994555712e-01f, 3.299400955e-02f, 9.999455214e-01f, 1.043532696e-02f,
  -8.485702872e-01f, 5.290827155e-01f, -2.414211184e-01f, -9.704204202e-01f, -9.667981863e-01f, -2.555412054e-01f, 4.755789042e-01f, 8.796730638e-01f,
  9.427546859e-01f, 3.334870934e-01f, 9.942255616e-01f, 1.073104069e-01f, 9.994220734e-01f, 3.399345279e-02f, 9.999421835e-01f, 1.075153705e-02f,
  -9.036921859e-01f, -4.281826615e-01f, 7.233466953e-02f, -9.973804355e-01f, -9.364566803e-01f, -3.507832289e-01f, 4.475280643e-01f, 8.942698836e-01f,
  9.393727183e-01f, 3.428978026e-01f, 9.938812256e-01f, 1.104538813e-01f, 9.993875623e-01f, 3.499285504e-02f, 9.999387264e-01f, 1.106774528e-02f,
  -1.279636919e-01f, -9.917788506e-01f, 3.789161742e-01f, -9.254310131e-01f, -8.967583776e-01f, -4.425205588e-01f, 4.190297425e-01f, 9.079725146e-01f,
  9.358968139e-01f, 3.522742093e-01f, 9.935269952e-01f, 1.135962531e-01f, 9.993520975e-01f, 3.599222749e-02f, 9.999352098e-01f, 1.138395350e-02f,
  7.654140592e-01f, -6.435381174e-01f, 6.479216814e-01f, -7.617069483e-01f, -8.481000066e-01f, -5.298361778e-01f, 3.901124299e-01f, 9.207672477e-01f,
  9.323273301e-01f, 3.616154492e-01f, 9.931628108e-01f, 1.167374924e-01f, 9.993155599e-01f, 3.699155897e-02f, 9.999315739e-01f, 1.170015987e-02f,
  9.550736547e-01f, 2.963685691e-01f, 8.526731133e-01f, -5.224447846e-01f, -7.909677625e-01f, -6.118578315e-01f, 3.608050346e-01f, 9.326412678e-01f,
  9.286646247e-01f, 3.709204793e-01f, 9.927886724e-01f, 1.198775545e-01f, 9.992780685e-01f, 3.799085692e-02f, 9.999278188e-01f, 1.201636530e-02f,
  2.666429281e-01f, 9.637953639e-01f, 9.728653431e-01f, -2.313720137e-01f, -7.259322405e-01f, -6.877662539e-01f, 3.311368525e-01f, 9.435827136e-01f,
  9.249090552e-01f, 3.801884055e-01f, 9.924046397e-01f, 1.230164245e-01f, 9.992396235e-01f, 3.899011388e-02f, 9.999239445e-01f, 1.233256981e-02f,
  -6.669380665e-01f, 7.451131344e-01f, 9.965789914e-01f, 8.264580369e-02f, -6.536436081e-01f, -7.568024993e-01f, 3.011375964e-01f, 9.535806775e-01f,
  9.210609794e-01f, 3.894183338e-01f, 9.920106530e-01f, 1.261540651e-01f, 9.992001057e-01f, 3.998933733e-02f, 9.999200106e-01f, 1.264877338e-02f,
  -9.873392582e-01f, -1.586226672e-01f, 9.214623570e-01f, 3.884676993e-01f, -5.748240352e-01f, -8.182770610e-01f, 2.708370686e-01f, 9.626252055e-01f,
  9.171208143e-01f, 3.986093104e-01f, 9.916067719e-01f, 1.292904317e-01f, 9.991596341e-01f, 4.098851606e-02f, 9.999159575e-01f, 1.296497509e-02f,
  -3.999853134e-01f, -9.165215492e-01f, 7.549653649e-01f, 6.557646990e-01f, -4.902605712e-01f, -8.715758920e-01f, 2.402658761e-01f, 9.707071185e-01f,
  9.130889177e-01f, 4.077604413e-01f, 9.911929369e-01f, 1.324255317e-01f, 9.991181493e-01f, 4.198765755e-02f, 9.999117851e-01f, 1.328117587e-02f,
  5.551133156e-01f, -8.317747712e-01f, 5.135984421e-01f, 8.580306768e-01f, -4.007990062e-01f, -9.161660075e-01f, 2.094544172e-01f, 9.778184295e-01f,
  9.089657664e-01f, 4.168707728e-01f, 9.907692075e-01f, 1.355592906e-01f, 9.990756512e-01f, 4.298675060e-02f, 9.999075532e-01f, 1.359737478e-02f,
  9.998432994e-01f, 1.770192571e-02f, 2.212981731e-01f, 9.752061963e-01f, -3.073327839e-01f, -9.516021013e-01f, 1.784335226e-01f, 9.839519858e-01f,
  9.047516584e-01f, 4.259394705e-01f, 9.903355837e-01f, 1.386916935e-01f, 9.990321398e-01f, 4.398580641e-02f, 9.999032021e-01f, 1.391357277e-02f,
  5.253219604e-01f, 8.509035110e-01f, -9.294810891e-02f, 9.956709743e-01f, -2.107958049e-01f, -9.775301218e-01f, 1.472342163e-01f, 9.891016483e-01f,
  9.004471302e-01f, 4.349655211e-01f, 9.898920655e-01f, 1.418227106e-01f, 9.989876747e-01f, 4.498481750e-02f, 9.998987317e-01f, 1.422976889e-02f,
  -4.321779311e-01f, 9.017883539e-01f, -3.979767561e-01f, 9.173954725e-01f, -1.121526212e-01f, -9.936909676e-01f, 1.158876941e-01f, 9.932623506e-01f,
  8.960524797e-01f, 4.439480901e-01f, 9.894386530e-01f, 1.449523121e-01f, 9.989421964e-01f, 4.598378390e-02f, 9.998942018e-01f, 1.454596408e-02f,
  -9.923354983e-01f, 1.235731244e-01f, -6.635382771e-01f, 7.481423616e-01f, -1.238837745e-02f, -9.999232888e-01f, 8.442528546e-02f, 9.964298010e-01f,
  8.915683031e-01f, 4.528862834e-01f, 9.889753461e-01f, 1.480804533e-01f, 9.988957047e-01f, 4.698270187e-02f, 9.998895526e-01f, 1.486215740e-02f,
  -6.401443481e-01f, -7.682546377e-01f, -8.632965088e-01f, 5.046970844e-01f, 8.749917150e-02f, -9.961646199e-01f, 5.287845805e-02f, 9.986009598e-01f,
  8.869948983e-01f, 4.617791772e-01f, 9.885020852e-01f, 1.512071192e-01f, 9.988481998e-01f, 4.798157141e-02f, 9.998847842e-01f, 1.517834887e-02f,
  3.005925417e-01f, -9.537526369e-01f, -9.774427414e-01f, 2.112006545e-01f, 1.865124702e-01f, -9.824525714e-01f, 2.127875760e-02f, 9.997735620e-01f,
  8.823328614e-01f, 4.706258774e-01f, 9.880189896e-01f, 1.543322802e-01f, 9.987997413e-01f, 4.898039624e-02f, 9.998799562e-01f, 1.549453940e-02f,
  9.649659991e-01f, -2.623748481e-01f, -9.946564436e-01f, -1.032404602e-01f, 2.836622000e-01f, -9.589242935e-01f, -1.034221891e-02f, 9.999465346e-01f,
  8.775825500e-01f, 4.794255495e-01f, 9.875259995e-01f, 1.574558914e-01f, 9.987502694e-01f, 4.997916892e-02f, 9.998750091e-01f, 1.581072807e-02f,
  7.421541810e-01f, 6.702291965e-01f, -9.132301211e-01f, -4.074441493e-01f, 3.779776692e-01f, -9.258147478e-01f, -4.195285589e-02f, 9.991195798e-01f,
  8.727445006e-01f, 4.881772399e-01f, 9.870231748e-01f, 1.605779380e-01f, 9.986997843e-01f, 5.097789690e-02f, 9.998699427e-01f, 1.612691768e-02f,
  -1.629907787e-01f, 9.866275787e-01f, -7.412399650e-01f, -6.712401509e-01f, 4.685169160e-01f, -8.834545016e-01f, -7.352153957e-02f, 9.972936511e-01f,
  8.678191900e-01f, 4.968801141e-01f, 9.865104556e-01f, 1.636983752e-01f, 9.986482859e-01f, 5.197656900e-02f, 9.998648167e-01f, 1.644310169e-02f,
  -9.182828069e-01f, 3.959251642e-01f, -4.957418144e-01f, -8.684699535e-01f, 5.543745160e-01f, -8.322673440e-01f, -1.050167084e-01f, 9.944704771e-01f,
  8.628070951e-01f, 5.055333376e-01f, 9.859878421e-01f, 1.668171734e-01f, 9.985958338e-01f, 5.297519267e-02f, 9.998595715e-01f, 1.675928757e-02f,
  -8.293098211e-01f, -5.587890744e-01f, -2.010796219e-01f, -9.795749187e-01f, 6.346929669e-01f, -7.727644444e-01f, -1.364068687e-01f, 9.906529188e-01f,
  8.577086926e-01f, 5.141359568e-01f, 9.854553938e-01f, 1.699342877e-01f, 9.985423684e-01f, 5.397376046e-02f, 9.998542070e-01f, 1.707546785e-02f,
  2.212675661e-02f, -9.997551441e-01f, 1.135217771e-01f, -9.935355186e-01f, 7.086697817e-01f, -7.055402994e-01f, -1.676606387e-01f, 9.858447909e-01f,
  8.525245190e-01f, 5.226872563e-01f, 9.849131107e-01f, 1.730497181e-01f, 9.984878898e-01f, 5.497227982e-02f, 9.998487830e-01f, 1.739165001e-02f,
  8.532201052e-01f, -5.215510130e-01f, 4.168670774e-01f, -9.089674354e-01f, 7.755658031e-01f, -6.312667131e-01f, -1.987468749e-01f, 9.800508618e-01f,
  8.472551107e-01f, 5.311862230e-01f, 9.843609333e-01f, 1.761634201e-01f, 9.984323978e-01f, 5.597073585e-02f, 9.998431802e-01f, 1.770782843e-02f,
  8.998668194e-01f, 4.361647666e-01f, 6.788702011e-01f, -7.342582941e-01f, 8.347129226e-01f, -5.506852865e-01f, -2.296342701e-01f, 9.732769728e-01f,
  8.419010043e-01f, 5.396320224e-01f, 9.837989211e-01f, 1.792753637e-01f, 9.983759522e-01f, 5.696914345e-02f, 9.998375773e-01f, 1.802400686e-02f,
  1.191801354e-01f, 9.928726554e-01f, 8.735505342e-01f, -4.867334962e-01f, 8.855196238e-01f, -4.646020234e-01f, -2.602920532e-01f, 9.655299187e-01f,
  8.364626765e-01f, 5.480239391e-01f, 9.832270741e-01f, 1.823855042e-01f, 9.983184934e-01f, 5.796748772e-02f, 9.998317957e-01f, 1.834018156e-02f,
  -7.710801959e-01f, 6.367380023e-01f, 9.816020727e-01f, -1.909380108e-01f, 9.274784923e-01f, -3.738765717e-01f, -2.906895578e-01f, 9.568174481e-01f,
  8.309407234e-01f, 5.563610196e-01f, 9.826454520e-01f, 1.854938269e-01f, 9.982600212e-01f, 5.896577984e-02f, 9.998259544e-01f, 1.865635626e-02f,
  -9.524129629e-01f, -3.048106134e-01f, 9.923083186e-01f, 1.237909496e-01f, 9.601702690e-01f, -2.794154882e-01f, -3.207964003e-01f, 9.471482038e-01f,
  8.253356218e-01f, 5.646424294e-01f, 9.820539355e-01f, 1.886002868e-01f, 9.982005358e-01f, 5.996400863e-02f, 9.998199940e-01f, 1.897252724e-02f,
  -2.581016421e-01f, -9.661177993e-01f, 9.046075940e-01f, 4.262454212e-01f, 9.832684398e-01f, -1.821625978e-01f, -3.505824506e-01f, 9.365318418e-01f,
  8.196480274e-01f, 5.728674531e-01f, 9.814526439e-01f, 1.917048544e-01f, 9.981400967e-01f, 6.096218154e-02f, 9.998139739e-01f, 1.928869821e-02f,
  6.735071540e-01f, -7.391806841e-01f, 7.271980643e-01f, 6.864276528e-01f, 9.965420961e-01f, -8.308912069e-02f, -3.800179660e-01f, 9.249790907e-01f,
  8.138784766e-01f, 5.810351372e-01f, 9.808415174e-01f, 1.948075294e-01f, 9.980786443e-01f, 6.196028739e-02f, 9.998078346e-01f, 1.960486546e-02f,
  9.858965874e-01f, 1.673557013e-01f, 4.776714444e-01f, 8.785385489e-01f, 9.998586178e-01f, 1.681409031e-02f, -4.090735018e-01f, 9.125014544e-01f,
  8.080275059e-01f, 5.891447663e-01f, 9.802205563e-01f, 1.979082376e-01f, 9.980161786e-01f, 6.295833737e-02f, 9.998015761e-01f, 1.992103085e-02f,
};
#define XB_TMO      128
#define XB_XCNT(j)  (256  + 64 * (j))
#define XB_XSUB(j)  (1280 + 64 * (j))
#define XB_XGEN(j)  (2304 + 64 * (j))
#define XB_TOP      3328
#define XB_TOPGEN   3392
#define XCD_BAR_WORDS 3456
#define XB_SPIN_CAP (1u << 18)
#define LAS __attribute__((address_space(3)))

__device__ __forceinline__ unsigned xb_ld(unsigned* p)              { return __hip_atomic_load(p, __ATOMIC_RELAXED, __HIP_MEMORY_SCOPE_AGENT); }
__device__ __forceinline__ unsigned xb_add(unsigned* p, unsigned v) { return __hip_atomic_fetch_add(p, v, __ATOMIC_RELAXED, __HIP_MEMORY_SCOPE_AGENT); }
__device__ __forceinline__ unsigned xb_xcc_id() { return (unsigned)__builtin_amdgcn_s_getreg((3 << 11) | 20) & 0xFu; }
#define XB_SPIN(cond, bar) do { unsigned _sp = 0; while (cond) { __builtin_amdgcn_s_sleep(1); \
    if ((++_sp & 255u) == 0u) { if (xb_ld(&(bar)[XB_TMO])) break; if (_sp > XB_SPIN_CAP) { atomicAdd(&(bar)[XB_TMO], 1u); break; } } } } while (0)

struct XcdBarrier {
    unsigned* bar; unsigned x;
    volatile LAS unsigned* st;
};

__device__ __forceinline__ XcdBarrier xcd_barrier_post(unsigned* bar, volatile LAS unsigned* st) {
    XcdBarrier b; b.bar = bar; b.x = xb_xcc_id(); b.st = st;
    if (threadIdx.x == 0) (void)xb_add(&bar[XB_XCNT(b.x)], 1u);
    return b;
}
__device__ __forceinline__ void xcd_barrier_complete(unsigned* bar, unsigned x, unsigned& nloc, unsigned& nx) {
    const unsigned G = gridDim.x * gridDim.y * gridDim.z;
    unsigned sum, cnt, mine, sp = 0u;
    for (;;) {
        sum = 0u; cnt = 0u; mine = 0u;
#pragma unroll
        for (unsigned j = 0; j < 16; ++j) { const unsigned c = xb_ld(&bar[XB_XCNT(j)]); sum += c; cnt += (c > 0u) ? 1u : 0u; mine = (j == x) ? c : mine; }
        if (sum == G) break;
        __builtin_amdgcn_s_sleep(1);
        if ((++sp & 255u) == 0u) { if (xb_ld(&bar[XB_TMO])) break; if (sp > XB_SPIN_CAP) { atomicAdd(&bar[XB_TMO], 1u); break; } }
    }
    nloc = mine > 0u ? mine : 1u; nx = cnt > 0u ? cnt : 1u;
}

__device__ __forceinline__ void xcd_barrier(const XcdBarrier& b, const bool t0  ) {
    asm volatile("s_waitcnt vmcnt(0)" ::: "memory");
    __syncthreads();
    if (t0) {
        unsigned* bar = b.bar;
        __builtin_amdgcn_s_waitcnt(0);
        unsigned nloc = b.st[0], nx = b.st[1];
        if (nloc == 0u) { xcd_barrier_complete(bar, b.x, nloc, nx); b.st[0] = nloc; b.st[1] = nx; }
        const unsigned old = xb_add(&bar[XB_XSUB(b.x)], 1u);
        const unsigned gen = old / nloc;
        if (old + 1u == (gen + 1u) * nloc) {
            __builtin_amdgcn_fence(__ATOMIC_RELEASE, "agent");
            asm volatile("s_waitcnt vmcnt(0)" ::: "memory");
            const unsigned og = xb_add(&bar[XB_TOP], 1u);
            const unsigned tg = og / nx;
            if (og + 1u == (tg + 1u) * nx) xb_add(&bar[XB_TOPGEN], 1u);
            else XB_SPIN(xb_ld(&bar[XB_TOPGEN]) == tg, bar);
            __builtin_amdgcn_fence(__ATOMIC_ACQUIRE, "agent");
            xb_add(&bar[XB_XGEN(b.x)], 1u);
            asm volatile("s_waitcnt vmcnt(0)" ::: "memory");
        } else {
            XB_SPIN(xb_ld(&bar[XB_XGEN(b.x)]) == gen, bar);
            __builtin_amdgcn_fence(__ATOMIC_ACQUIRE, "agent");
            asm volatile("s_waitcnt vmcnt(0)" ::: "memory");
        }
    }
    __syncthreads();
}

DI void conv_fetch(const float* __restrict__ src, int K, int N, int k0, int n0, f32x4 (&v)[2], int tid) {
#pragma unroll
    for (int i = 0; i < 2; ++i) {
        const int idx = tid + NTHREADS * i, kr = idx >> 4, c4 = (idx & 15) * 4;
        v[i] = (f32x4){0.f, 0.f, 0.f, 0.f};
        if (n0 + c4 < N) v[i] = __builtin_nontemporal_load((const f32x4*)(src + (size_t)(k0 + kr) * N + n0 + c4));
    }
}
DI void conv_put(const f32x4 (&v)[2], float* lds, int tid) {
#pragma unroll
    for (int i = 0; i < 2; ++i) {
        const int idx = tid + NTHREADS * i, kr = idx >> 4, c4 = (idx & 15) * 4;
        float* d = lds + kr * 65 + c4;
        d[0] = v[i].x; d[1] = v[i].y; d[2] = v[i].z; d[3] = v[i].w;
    }
}
DI unsigned cvt_fp8x4(float a, float b, float c, float d) { int w = __builtin_amdgcn_cvt_pk_fp8_f32(a, b, 0, false); w = __builtin_amdgcn_cvt_pk_fp8_f32(c, d, w, true); return (unsigned)w; }
template <bool NT, bool FP8>
DI void conv_store(int K, bf16_t* __restrict__ dst, int k0, int ndst0, int nstep, const float* lds, int tid) {
    const int idx = tid, n = idx >> 3, kc = idx & 7;
    float f[8];
#pragma unroll
    for (int j = 0; j < 8; ++j) f[j] = lds[(kc * 8 + j) * 65 + n];
    const size_t e = (size_t)(ndst0 + (n & 31) + (n >> 5) * nstep) * K + k0 + kc * 8;
    if (FP8) {
        u32x2 w; w.x = cvt_fp8x4(f[0] * 32.f, f[1] * 32.f, f[2] * 32.f, f[3] * 32.f); w.y = cvt_fp8x4(f[4] * 32.f, f[5] * 32.f, f[6] * 32.f, f[7] * 32.f);
        u32x2* d = (u32x2*)((unsigned char*)dst + e);
        if (NT) __builtin_nontemporal_store(w, d); else *d = w;
    } else {
        u32x4* d = (u32x4*)(dst + e);
        if (NT) __builtin_nontemporal_store(pack8(f), d); else *d = pack8(f);
    }
}
template <bool NT = true, bool FP8 = false>
DI void conv_job(const float* src, int count, int K, int N, int Npad, bf16_t* dst, int perm  , int& base, float* lds, int bid, int nb, int tid) {
    const int tk = K / 64, tn = Npad / 64, per = tk * tn, total = count * per;
    int t = (bid - (base % nb) + nb) % nb;
    f32x4 rg[4][2];
    auto fetch4 = [&](int tt) {
#pragma unroll
        for (int q = 0; q < 4; ++q) {
            const int tq = tt + q * nb;
            if (tq < total) { const int mi = tq / per, rem = tq - mi * per, nt = rem / tk, kt = rem - nt * tk;
                conv_fetch(src + (size_t)mi * K * N, K, N, kt * 64, nt * 64, rg[q], tid); }
        }
    };
    if (t < total) fetch4(t);
    for (; t < total; t += 4 * nb) {
#pragma unroll
        for (int q = 0; q < 4; ++q) if (t + q * nb < total) conv_put(rg[q], lds + q * 4160, tid);
        __syncthreads();
        if (t + 4 * nb < total) fetch4(t + 4 * nb);
#pragma unroll
        for (int q = 0; q < 4; ++q) {
            const int tq = t + q * nb;
            if (tq < total) { const int mi = tq / per, rem = tq - mi * per, nt = rem / tk, kt = rem - nt * tk, n0 = nt * 64;
                int nd0 = n0, nstep = 32;
                if (perm == 1) nd0 = ((n0 & 255) >> 7) * 256 + (n0 >> 8) * 128 + (n0 & 127);
                else if (n0 < perm) { const int hg = n0 >> 6; nd0 = (hg >> 2) * 256 + (hg & 3) * 32; nstep = 128; }
                conv_store<NT, FP8>(K, FP8 ? (bf16_t*)((unsigned char*)dst + (size_t)mi * Npad * K) : dst + (size_t)mi * Npad * K, kt * 64, nd0, nstep, lds + q * 4160, tid); }
        }
        __syncthreads();
    }
    base += total;
}

DI int mla_col(bool uq, int r) {
    const int hw = uq ? 96 : 128;
    if (r < 1024) { const int pn = r >> 8, bj = (r >> 7) & 1, wc = (r >> 5) & 3, d = r & 31; return (4 * pn + wc) * hw + 32 * bj + d; }
    const int rr = r - 1024;
    if (uq) { const int head = rr >> 5, c = rr & 31, dim = (c >> 3) * 4 + (c & 3) + 16 * ((c >> 2) & 1); return head * 96 + 64 + dim; }
    return (rr >> 6) * 128 + 64 + (rr & 63);
}
DI void phase_prologue(const Params& p, float* lds, int bid, int nb, int tid) {
    bf16_t* ws16 = (bf16_t*)p.ws;
    int base = 0;
    conv_job<true, true>(p.in[13], 1, 1024, 3072, 3072, (bf16_t*)(p.ws + W_QKV0), 2048, base, lds, bid, nb, tid);
    conv_job<true, true>(p.in[14], 1, 1024, 1024, 1024, (bf16_t*)(p.ws + W_O0), 0, base, lds, bid, nb, tid);
    conv_job<true, true>(p.in[18], 1, 1024, 1536, 1536, (bf16_t*)(p.ws + W_QKV1), 1280, base, lds, bid, nb, tid);
    conv_job<true, true>(p.in[19], 1, 1024, 1024, 1024, (bf16_t*)(p.ws + W_O1), 0, base, lds, bid, nb, tid);
    conv_job<true, true>(p.in[23], 1, 1024, 672, 768, (bf16_t*)(p.ws + W_DQKV), 0, base, lds, bid, nb, tid);
    for (int i = bid * NTHREADS + tid; i < 1536 * 48 + 2048 * 32; i += nb * NTHREADS) {
        const bool uq = i < 1536 * 48;
        const int K = uq ? 384 : 256, kc = K / 8, ii = uq ? i : i - 1536 * 48, r = ii / kc, k0 = (ii - r * kc) * 8, nsrc = uq ? 1536 : 2048;
        const int col = mla_col(uq, r);
        const float* src = p.in[uq ? 26 : 27] + (size_t)k0 * nsrc + col;
        float f[8];
#pragma unroll
        for (int j = 0; j < 8; ++j) f[j] = src[(size_t)j * nsrc];
        *(u32x4*)((bf16_t*)(p.ws + (uq ? W_UQ : W_UKV)) + (size_t)r * K + k0) = pack8(f);
    }
    conv_job<true, true>(p.in[30], 1, 1024, 1024, 1024, (bf16_t*)(p.ws + W_O2), 0, base, lds, bid, nb, tid);
    conv_job<true, true>(p.in[31], 1, 1024, 3072, 3072, (bf16_t*)(p.ws + W_QKV3), 2048, base, lds, bid, nb, tid);
    conv_job<true, true>(p.in[36], 1, 1024, 1024, 1024, (bf16_t*)(p.ws + W_O3), 0, base, lds, bid, nb, tid);
    conv_job<true, true>(p.in[11], 32, 1024, 512, 512, (bf16_t*)(p.ws + W_GU), 1, base, lds, bid, nb, tid);
    conv_job(p.in[12], 32, 256, 1024, 1024, (bf16_t*)(p.ws + W_DN), 0, base, lds, bid, nb, tid);
    (void)ws16;
    float* sc = lds;
    for (int i = tid; i < 9 * 1024; i += NTHREADS) {
        const int r = i >> 10, k = i & 1023;
        const float v = r < 8 ? p.in[1][r * 1024 + k] : p.in[3][k];
        sc[i] = silu_f(v);
    }
    __syncthreads();
    float* part = (float*)(p.ws + WS_MODP);
    for (int it = bid; it < 768; it += nb) {
        const int kc = it / 48, rem = it - kc * 48, l = rem / 12, nch = rem - l * 12;
        const int n = nch * 512 + tid;
        const float* w = p.in[4] + ((size_t)l * 1024 + kc * 64) * 6144 + n;
        float acc[9];
#pragma unroll
        for (int r = 0; r < 9; ++r) acc[r] = 0.f;
#pragma unroll 8
        for (int k = 0; k < 64; ++k) {
            const float wv = __builtin_nontemporal_load(w + (size_t)k * 6144);
#pragma unroll
            for (int r = 0; r < 9; ++r) acc[r] += sc[r * 1024 + kc * 64 + k] * wv;
        }
#pragma unroll
        for (int r = 0; r < 9; ++r) part[(((size_t)kc * 4 + l) * 9 + r) * 6144 + n] = acc[r];
    }
    __syncthreads();
}
DI void phase_mod_reduce(const Params& p, int bid, int nb, int tid) {
    const float* part = (const float*)(p.ws + WS_MODP);
    float* mod = (float*)(p.ws + WS_MOD);
    const int total = 4 * 9 * 6144;
    for (int i = bid * NTHREADS + tid; i < total; i += nb * NTHREADS) {
        const int l = i / (9 * 6144), n = i % 6144;
        float s = p.in[5][l * 6144 + n];
#pragma unroll
        for (int kc = 0; kc < 16; ++kc) s += part[(size_t)kc * total + i];
        mod[i] = s;
    }
}

template <int MODE>
DI void phase_rows(const Params& p, int layer  , int which  , int bid, int nb, int tid) {
    const int wid = __builtin_amdgcn_readfirstlane(tid >> 6), lane = tid & 63;
    const float* modall = (const float*)(p.ws + WS_MOD);
    const bf16_t* eo = (const bf16_t*)(p.ws + WS_RAW);
    bf16_t* H = (bf16_t*)(p.ws + WS_H);
    for (int r = bid * NW + wid; r < MROWS; r += nb * NW) {
        const int b = r / PP, pos = r - b * PP;
        if ((MODE & 16) && pos >= SEQ) continue;
        const int mr = pos < SEQ ? b : 8;
        bf16_t* xb = xb_row(p, r);
        float x[16];
        if (MODE & 8) {
            const float* xr = pos < SEQ ? p.in[0] + ((size_t)b * SEQ + pos) * DM : p.in[2] + ((size_t)b * CTXL + (pos - SEQ)) * DM;
#pragma unroll
            for (int j = 0; j < 4; ++j) { const f32x4 v = *(const f32x4*)(xr + lane * 4 + 256 * j); x[4 * j] = v.x; x[4 * j + 1] = v.y; x[4 * j + 2] = v.z; x[4 * j + 3] = v.w; }
        } else {
#pragma unroll
            for (int j = 0; j < 4; ++j) { const u32x2 v = *(const u32x2*)(xb + lane * 4 + 256 * j); x[4 * j] = bflo(v.x); x[4 * j + 1] = bfhi(v.x); x[4 * j + 2] = bflo(v.y); x[4 * j + 3] = bfhi(v.y); }
        }
        if (MODE & 1) {
            const float* g2 = modall + ((size_t)(layer - ((MODE & 2) ? 1 : 0)) * 9 + mr) * 6144 + 5120;
            const bf16_t* y0 = eo + (size_t)(2 * r) * 1024, *y1 = y0 + 1024;
#pragma unroll
            for (int j = 0; j < 4; ++j) {
                const u32x2 a = *(const u32x2*)(y0 + lane * 4 + 256 * j), bb = *(const u32x2*)(y1 + lane * 4 + 256 * j);
                const f32x4 g = *(const f32x4*)(g2 + lane * 4 + 256 * j);
                x[4 * j] += g.x * (bflo(a.x) + bflo(bb.x)); x[4 * j + 1] += g.y * (bfhi(a.x) + bfhi(bb.x));
                x[4 * j + 2] += g.z * (bflo(a.y) + bflo(bb.y)); x[4 * j + 3] += g.w * (bfhi(a.y) + bfhi(bb.y));
            }
        }
        if (MODE & 16) {
            float* orow = p.out + ((size_t)b * SEQ + pos) * DM;
#pragma unroll
            for (int j = 0; j < 4; ++j) *(f32x4*)(orow + lane * 4 + 256 * j) = (f32x4){x[4 * j], x[4 * j + 1], x[4 * j + 2], x[4 * j + 3]};
        } else if (MODE & (1 | 8)) {
#pragma unroll
            for (int j = 0; j < 4; ++j) {
                u32x2 w; w.x = pk2(x[4 * j], x[4 * j + 1]); w.y = pk2(x[4 * j + 2], x[4 * j + 3]);
                *(u32x2*)(xb + lane * 4 + 256 * j) = w;
                x[4 * j] = bflo(w.x); x[4 * j + 1] = bfhi(w.x); x[4 * j + 2] = bflo(w.y); x[4 * j + 3] = bfhi(w.y);
            }
        }
        if (MODE & 2) {
            float ss = 0.f;
#pragma unroll
            for (int i = 0; i < 16; ++i) ss += x[i] * x[i];
            ss = wave_sum(ss);
            const float rs = rsqrtf(ss * (1.0f / 1024.0f) + EPS);
            const float* ng = p.in[6] + ((size_t)layer * 2 + which) * 1024;
            const float* md = modall + ((size_t)layer * 9 + mr) * 6144 + which * 3072;
#pragma unroll
            for (int j = 0; j < 4; ++j) {
                const f32x4 g = *(const f32x4*)(ng + lane * 4 + 256 * j), sh = *(const f32x4*)(md + lane * 4 + 256 * j), sc = *(const f32x4*)(md + 1024 + lane * 4 + 256 * j);
                const float h0 = x[4 * j] * rs * g.x * (1.0f + sc.x) + sh.x, h1 = x[4 * j + 1] * rs * g.y * (1.0f + sc.y) + sh.y;
                const float h2 = x[4 * j + 2] * rs * g.z * (1.0f + sc.z) + sh.z, h3 = x[4 * j + 3] * rs * g.w * (1.0f + sc.w) + sh.w;
                if (MODE & 32) *(unsigned*)((unsigned char*)H + (size_t)r * 1024 + lane * 4 + 256 * j) = cvt_fp8x4(h0, h1, h2, h3);
                else { u32x2 w; w.x = pk2(h0, h1); w.y = pk2(h2, h3); *(u32x2*)(H + (size_t)r * 1024 + lane * 4 + 256 * j) = w; }
            }
        }
    }
}

constexpr size_t WS_RC = WS_MOD + 917504;
DI void phase_router_prep(const Params& p, int bid, int nb, int tid) {
    const float* modall = (const float*)(p.ws + WS_MOD);
    bf16_t* wth = (bf16_t*)(p.ws + WS_RW); bf16_t* wtl = wth + 4 * 9 * 48 * 1024;
    const int total = 4 * 9 * 48 * 1024;
    for (int i = bid * NTHREADS + tid; i < total; i += nb * NTHREADS) {
        const int k = i & 1023, c = (i >> 10) % 48, lb = i / (48 * 1024), l = lb / 9, b = lb - l * 9;
        float v = 0.f;
        if (c < 36) {
            const float w = c < 32 ? p.in[9][((size_t)l * 1024 + k) * 32 + c] : p.in[7][((size_t)l * 1024 + k) * 4 + (c - 32)];
            v = p.in[6][((size_t)l * 2 + 1) * 1024 + k] * (1.0f + modall[((size_t)l * 9 + b) * 6144 + 4096 + k]) * w;
        }
        const unsigned hb = f2bf(v); wth[i] = (bf16_t)hb; wtl[i] = (bf16_t)f2bf(v - bf2f(hb));
    }
    float* cst = (float*)(p.ws + WS_RC);
    const int wid = __builtin_amdgcn_readfirstlane(tid >> 6), lane = tid & 63;
    for (int j = bid * NW + wid; j < 4 * 9 * 48; j += nb * NW) {
        const int c = j % 48, lb = j / 48, l = lb / 9, b = lb - l * 9;
        float acc = 0.f;
        if (c < 36) {
            for (int k = lane; k < 1024; k += 64) {
                const float w = c < 32 ? p.in[9][((size_t)l * 1024 + k) * 32 + c] : p.in[7][((size_t)l * 1024 + k) * 4 + (c - 32)];
                acc += modall[((size_t)l * 9 + b) * 6144 + 3072 + k] * w;
            }
            acc = wave_sum(acc) + (c < 32 ? p.in[10][l * 32 + c] : p.in[8][l * 4 + (c - 32)]);
        }
        if (lane == 0) cst[j] = acc;
    }
}
typedef float f32x2_3 __attribute__((ext_vector_type(2)));
typedef __bf16 bf16x2_3 __attribute__((ext_vector_type(2)));
DI unsigned cvtpk3(float lo, float hi) { f32x2_3 v = {lo, hi}; bf16x2_3 b = __builtin_convertvector(v, bf16x2_3); return __builtin_bit_cast(unsigned, b); }
DI void phase_router(const Params& p, unsigned char* smem, int layer, bool skip_ctx, int bid, int nb, int tid) {
    const int lane = tid & 63, wid = __builtin_amdgcn_readfirstlane(tid >> 6), li = lane & 15, kq = lane >> 4;
    LAS float* tile = (LAS float*)smem + wid * (32 * 49);
    const bf16_t* wth_all = (const bf16_t*)(p.ws + WS_RW) + (size_t)layer * 9 * 48 * 1024;
    const bf16_t* wtl_all = wth_all + 4 * 9 * 48 * 1024;
    const float* cst_all = (const float*)(p.ws + WS_RC) + layer * 9 * 48;
    unsigned* cnt = (unsigned*)(p.ws + WS_CTL) + CW_CNT + layer * 32;
    unsigned* list = (unsigned*)(p.ws + WS_LIST);
    float* gates = (float*)(p.ws + WS_GATE);
    if (layer > 0) {
        int base = 0;
        conv_job<false, true>(p.in[11] + (size_t)layer * 32 * 1024 * 512, 32, 1024, 512, 512, (bf16_t*)(p.ws + W_GU + (size_t)layer * 32 * 512 * 1024), 1, base, (float*)smem, bid, nb, tid);
        conv_job<false>(p.in[12] + (size_t)layer * 32 * 256 * 1024, 32, 256, 1024, 1024, (bf16_t*)(p.ws + W_DN) + (size_t)layer * 32 * 1024 * 256, 0, base, (float*)smem, bid, nb, tid);
    }
    for (int u = bid * NW + wid; u < MROWS / 32; u += nb * NW) {
        const int r0 = u * 32, b = r0 / PP, pos = r0 - b * PP;
        const bool isctx = pos >= SEQ;
        if (skip_ctx && isctx) continue;
        const int mr = isctx ? 8 : b;
        const bf16_t* xr = xb_row(p, r0 + li) + 8 * kq;
        const bf16_t* wh = wth_all + ((size_t)mr * 48 + li) * 1024 + 8 * kq;
        const bf16_t* wl = wtl_all + ((size_t)mr * 48 + li) * 1024 + 8 * kq;
        f32x4 acc[2][3];
#pragma unroll
        for (int m = 0; m < 2; ++m)
#pragma unroll
            for (int n = 0; n < 3; ++n) acc[m][n] = (f32x4){0.f, 0.f, 0.f, 0.f};
        float ss[2] = {0.f, 0.f};
#pragma unroll 2
        for (int s = 0; s < 32; ++s) {
            bf16x8 xa[2], bh[3], bl[3];
#pragma unroll
            for (int m = 0; m < 2; ++m) xa[m] = *(const bf16x8*)(xr + (size_t)m * 16 * DM + 32 * s);
#pragma unroll
            for (int n = 0; n < 3; ++n) { bh[n] = *(const bf16x8*)(wh + (size_t)n * 16 * 1024 + 32 * s); bl[n] = *(const bf16x8*)(wl + (size_t)n * 16 * 1024 + 32 * s); }
#pragma unroll
            for (int m = 0; m < 2; ++m) {
                const u32x4 w = __builtin_bit_cast(u32x4, xa[m]);
                ss[m] += bflo(w.x) * bflo(w.x) + bfhi(w.x) * bfhi(w.x) + bflo(w.y) * bflo(w.y) + bfhi(w.y) * bfhi(w.y) + bflo(w.z) * bflo(w.z) + bfhi(w.z) * bfhi(w.z) + bflo(w.w) * bflo(w.w) + bfhi(w.w) * bfhi(w.w);
#pragma unroll
                for (int n = 0; n < 3; ++n) {
                    acc[m][n] = __builtin_amdgcn_mfma_f32_16x16x32_bf16(xa[m], bl[n], acc[m][n], 0, 0, 0);
                    acc[m][n] = __builtin_amdgcn_mfma_f32_16x16x32_bf16(xa[m], bh[n], acc[m][n], 0, 0, 0);
                }
            }
        }
#pragma unroll
        for (int m = 0; m < 2; ++m) { ss[m] += __shfl_xor(ss[m], 16); ss[m] += __shfl_xor(ss[m], 32); }
#pragma unroll
        for (int m = 0; m < 2; ++m)
#pragma unroll
            for (int n = 0; n < 3; ++n)
#pragma unroll
                for (int i = 0; i < 4; ++i) tile[(16 * m + 4 * kq + i) * 49 + n * 16 + li] = acc[m][n][i];
        __builtin_amdgcn_s_waitcnt(0xc07f);
        const float ssr = (lane & 16) ? ss[1] : ss[0];
        const float rs = rsqrtf(ssr * (1.0f / 1024.0f) + EPS);
        if (lane < 32) {
            const float* cst = cst_all + mr * 48;
            const LAS float* tr = tile + lane * 49;
            float lg[4];
#pragma unroll
            for (int c = 0; c < 4; ++c) lg[c] = tr[32 + c] * rs + cst[32 + c];
            int gi = 0; float gm = lg[0];
#pragma unroll
            for (int c = 1; c < 4; ++c) if (lg[c] > gm) { gm = lg[c]; gi = c; }
            float gden = 0.f;
#pragma unroll
            for (int c = 0; c < 4; ++c) gden += __expf(lg[c] - gm);
            const float gw = 1.0f / gden;
            float le[8];
#pragma unroll
            for (int c = 0; c < 8; ++c) le[c] = tr[gi * 8 + c] * rs + cst[gi * 8 + c];
            int e0 = 0; float m0 = le[0];
#pragma unroll
            for (int c = 1; c < 8; ++c) if (le[c] > m0) { m0 = le[c]; e0 = c; }
            int e1 = -1; float m1 = -INFINITY;
#pragma unroll
            for (int c = 0; c < 8; ++c) if (c != e0 && le[c] > m1) { m1 = le[c]; e1 = c; }
            const float q1 = __expf(m1 - m0), inv = 1.0f / (1.0f + q1);
            const int r = r0 + lane, ex0 = gi * 8 + e0, ex1 = gi * 8 + e1;
            const unsigned s0 = atomicAdd(cnt + ex0, 1u), s1 = atomicAdd(cnt + ex1, 1u);
            list[(size_t)ex0 * MROWS + s0] = 2u * r; list[(size_t)ex1 * MROWS + s1] = 2u * r + 1u;
            gates[2 * r] = gw * inv; gates[2 * r + 1] = gw * q1 * inv;
        }
        {
            const float* ng = p.in[6] + ((size_t)layer * 2 + 1) * 1024;
            const float* md = (const float*)(p.ws + WS_MOD) + ((size_t)layer * 9 + mr) * 6144 + 3072;
            f32x4 gm[4], sh[4];
#pragma unroll
            for (int j = 0; j < 4; ++j) {
                const f32x4 g = *(const f32x4*)(ng + lane * 4 + 256 * j), sc = *(const f32x4*)(md + 1024 + lane * 4 + 256 * j);
                sh[j] = *(const f32x4*)(md + lane * 4 + 256 * j);
                gm[j] = (f32x4){g.x * (1.0f + sc.x), g.y * (1.0f + sc.y), g.z * (1.0f + sc.z), g.w * (1.0f + sc.w)};
            }
            unsigned char* H8 = p.ws + WS_H;
#pragma unroll 4
            for (int i = 0; i < 32; ++i) {
                const float rsi = __shfl(rs, i);
                const bf16_t* xb = xb_row(p, r0 + i);
#pragma unroll
                for (int j = 0; j < 4; ++j) {
                    const u32x2 v = *(const u32x2*)(xb + lane * 4 + 256 * j);
                    *(unsigned*)(H8 + (size_t)(r0 + i) * 1024 + lane * 4 + 256 * j) =
                        cvt_fp8x4(bflo(v.x) * rsi * gm[j].x + sh[j].x, bfhi(v.x) * rsi * gm[j].y + sh[j].y, bflo(v.y) * rsi * gm[j].z + sh[j].z, bfhi(v.y) * rsi * gm[j].w + sh[j].w);
                }
            }
        }
    }
}

#define MFMA32(a, b, c) __builtin_amdgcn_mfma_f32_32x32x16_bf16((a), (b), (c), 0, 0, 0)
typedef LAS unsigned char* lds_ptr;
constexpr int GEMM_TM = 256, GEMM_TN = 256;
constexpr int GEMM_STAGE = 65536;
constexpr int GEMM_LDS = 2 * GEMM_STAGE;
constexpr int GEMM_MT = 4;

struct RowDense { static constexpr bool DENSE = true; const bf16_t* A; int lda; int m0; DI unsigned row(int i) const { return (unsigned)(m0 + i) * (unsigned)lda; } };
struct RowGather { static constexpr bool DENSE = false; const bf16_t* A; int lda; const unsigned* ent; int valid; int shift;
    DI unsigned row(int i) const { const unsigned e = ent[i < valid ? i : valid - 1]; return (e >> shift) * (unsigned)lda; } };

struct EpiStore { bf16_t* C; int ldc; int m0;
    DI void wave_tile(const f32x16 (&acc)[2][GEMM_MT], int mloc, int ncol, int lane) const {
        const int r = lane & 31, h = lane >> 5;
#pragma unroll
        for (int mt = 0; mt < GEMM_MT; ++mt) {
            bf16_t* c = C + (size_t)(m0 + mloc + mt * 32 + r) * ldc + ncol + 4 * h;
#pragma unroll
            for (int nt = 0; nt < 2; ++nt)
#pragma unroll
                for (int g = 0; g < 4; ++g) {
                    u32x2 w; w.x = pk2(acc[nt][mt][4 * g], acc[nt][mt][4 * g + 1]); w.y = pk2(acc[nt][mt][4 * g + 2], acc[nt][mt][4 * g + 3]);
                    *(u32x2*)(c + nt * 32 + 8 * g) = w;
                }
        }
    } };
struct EpiResid { const Params* p; const float* mod; int m0;
    DI void wave_tile(const f32x16 (&acc)[2][GEMM_MT], int mloc, int ncol, int lane) const {
        const int r = lane & 31, h = lane >> 5;
#pragma unroll
        for (int mt = 0; mt < GEMM_MT; ++mt) {
            const int row = m0 + mloc + mt * 32 + r;
            float* xr = xrow_ptr(*p, row) + ncol + 4 * h;
            const float* gp = mod + (size_t)mod_row(row) * 6144 + 2048 + ncol + 4 * h;
#pragma unroll
            for (int nt = 0; nt < 2; ++nt)
#pragma unroll
                for (int g = 0; g < 4; ++g) {
                    f32x4 x = *(f32x4*)(xr + nt * 32 + 8 * g);
                    const f32x4 gg = *(const f32x4*)(gp + nt * 32 + 8 * g);
                    x.x += gg.x * acc[nt][mt][4 * g]; x.y += gg.y * acc[nt][mt][4 * g + 1]; x.z += gg.z * acc[nt][mt][4 * g + 2]; x.w += gg.w * acc[nt][mt][4 * g + 3];
                    *(f32x4*)(xr + nt * 32 + 8 * g) = x;
                }
        }
    } };
struct EpiGlu { bf16_t* act; const unsigned* ent; const float* gates; int valid;
    DI void wave_tile(const f32x16 (&acc)[2][GEMM_MT], int mloc, int ncol, int lane) const {
        const int r = lane & 31, h = lane >> 5;
#pragma unroll
        for (int mt = 0; mt < GEMM_MT; ++mt) {
            const int i = mloc + mt * 32 + r;
            if (i < valid) {
                const unsigned a = ent[i];
                const float gw = gates[a];
                bf16_t* o = act + (size_t)a * DEXP + (ncol >> 6) * 32 + 4 * h;
#pragma unroll
                for (int g = 0; g < 4; ++g) {
                    float v[4];
#pragma unroll
                    for (int j = 0; j < 4; ++j) v[j] = silu_f(acc[0][mt][4 * g + j]) * acc[1][mt][4 * g + j] * gw;
                    u32x2 w; w.x = pk2(v[0], v[1]); w.y = pk2(v[2], v[3]);
                    *(u32x2*)(o + 8 * g) = w;
                }
            }
        }
    } };
struct EpiScatter { bf16_t* outp; const unsigned* ent; int valid;
    DI void wave_tile(const f32x16 (&acc)[2][GEMM_MT], int mloc, int ncol, int lane) const {
        const int r = lane & 31, h = lane >> 5;
#pragma unroll
        for (int mt = 0; mt < GEMM_MT; ++mt) {
            const int i = mloc + mt * 32 + r;
            if (i < valid) {
                bf16_t* c = outp + (size_t)ent[i] * 1024 + ncol + 4 * h;
#pragma unroll
                for (int nt = 0; nt < 2; ++nt)
#pragma unroll
                    for (int g = 0; g < 4; ++g) {
                        u32x2 w; w.x = pk2(acc[nt][mt][4 * g], acc[nt][mt][4 * g + 1]); w.y = pk2(acc[nt][mt][4 * g + 2], acc[nt][mt][4 * g + 3]);
                        *(u32x2*)(c + nt * 32 + 8 * g) = w;
                    }
            }
        }
    } };

#define SCHED_FENCE() __builtin_amdgcn_sched_barrier(0)
DI void glds16(const bf16_t* g, lds_ptr l) { __builtin_amdgcn_global_load_lds((const unsigned*)g, (LAS unsigned*)l, 16, 0, 0); }
template <int PROBE, int NAG>
DI void gemm_kstep(f32x16 (&acc)[2][GEMM_MT], const lds_ptr st, const unsigned (&arow)[GEMM_MT], const unsigned (&wrow)[2], const unsigned (&aswz)[GEMM_MT], const unsigned (&wswz)[2], int h,
                   bool issue, const bf16_t* __restrict__ An, const bf16_t* __restrict__ Wn, const unsigned (&ag)[NAG], unsigned astep, const unsigned (&bg)[2], unsigned bstep, const lds_ptr sn) {
    if (PROBE != 2 && issue) {
#pragma unroll
        for (int j = 0; j < 8; ++j) { glds16(An + (NAG == 2 ? ag[j & 1] + (j >> 1) * astep : ag[j % NAG]), sn + j * 1024); glds16(Wn + bg[j & 1] + (j >> 1) * bstep, sn + 32768 + j * 1024); }
    }
    if (PROBE == 1) return;
    bf16x8 af[2][GEMM_MT], wf[2][2];
#pragma unroll
    for (int t = 0; t < 2; ++t) wf[0][t] = *(const LAS bf16x8*)(st + wrow[t] + ((((unsigned)h) ^ wswz[t]) << 4));
#pragma unroll
    for (int t = 0; t < GEMM_MT; ++t) af[0][t] = *(const LAS bf16x8*)(st + arow[t] + ((((unsigned)h) ^ aswz[t]) << 4));
#pragma unroll
    for (int kk = 0; kk < 4; ++kk) {
        if (kk < 3) {
#pragma unroll
            for (int t = 0; t < 2; ++t) wf[(kk + 1) & 1][t] = *(const LAS bf16x8*)(st + wrow[t] + ((((unsigned)((kk + 1) * 2 + h)) ^ wswz[t]) << 4));
#pragma unroll
            for (int t = 0; t < GEMM_MT; ++t) af[(kk + 1) & 1][t] = *(const LAS bf16x8*)(st + arow[t] + ((((unsigned)((kk + 1) * 2 + h)) ^ aswz[t]) << 4));
        }
        SCHED_FENCE();
        __builtin_amdgcn_s_setprio(1);
#pragma unroll
        for (int mt = 0; mt < GEMM_MT; ++mt)
#pragma unroll
            for (int nt = 0; nt < 2; ++nt) acc[nt][mt] = MFMA32(wf[kk & 1][nt], af[kk & 1][mt], acc[nt][mt]);
        __builtin_amdgcn_s_setprio(0);
        SCHED_FENCE();
    }
}
template <class RowSrc, class Epi, int PROBE = 0>
DI void gemm_tile_mfma(unsigned char* smem, const RowSrc& rs, const bf16_t* __restrict__ Wt, int K, int n0, const Epi& epi, int tid) {
    const lds_ptr lds = (lds_ptr)smem;
    const int lane = tid & 63, wid = __builtin_amdgcn_readfirstlane(tid >> 6), wm = wid & 1, wn = wid >> 1, r = lane & 31, h = lane >> 5;
    const bool loader = wid < 4;
    const int lw = wid & 3;
    constexpr int NAG = RowSrc::DENSE ? 2 : 8;
    unsigned ag[NAG], bg[2];
    const bf16_t* __restrict__ Ab = rs.A;
#pragma unroll
    for (int j = 0; j < NAG; ++j) {
        const int row = (lw * 8 + j) * 8 + (lane >> 3), c = (lane & 7) ^ ((row >> 1) & 7);
        ag[j] = rs.row(row) + c * 8;
    }
#pragma unroll
    for (int j = 0; j < 2; ++j) {
        const int row = (lw * 8 + j) * 8 + (lane >> 3), c = (lane & 7) ^ ((row >> 1) & 7);
        bg[j] = (unsigned)(n0 + row) * (unsigned)K + c * 8;
    }
    const unsigned astep = 16u * (unsigned)rs.lda, bstep = 16u * (unsigned)K;
    const unsigned dmaoff = (unsigned)lw * 8192u;
    unsigned arow[GEMM_MT], wrow[2], aswz[GEMM_MT], wswz[2];
#pragma unroll
    for (int t = 0; t < GEMM_MT; ++t) { const int ra = wm * 128 + t * 32 + r; arow[t] = ra * 128; aswz[t] = (ra >> 1) & 7; }
#pragma unroll
    for (int t = 0; t < 2; ++t) { const int rw = wn * 64 + t * 32 + r; wrow[t] = 32768 + rw * 128; wswz[t] = (rw >> 1) & 7; }
    f32x16 acc[2][GEMM_MT];
#pragma unroll
    for (int a = 0; a < 2; ++a)
#pragma unroll
        for (int b = 0; b < GEMM_MT; ++b)
#pragma unroll
            for (int i = 0; i < 16; ++i) acc[a][b][i] = 0.f;
    if (loader) {
#pragma unroll
        for (int j = 0; j < 8; ++j) { glds16(Ab + (NAG == 2 ? ag[j & 1] + (j >> 1) * astep : ag[j % NAG]), lds + dmaoff + j * 1024); glds16(Wt + bg[j & 1] + (j >> 1) * bstep, lds + 32768 + dmaoff + j * 1024); }
    }
    asm volatile("s_waitcnt vmcnt(0)" ::: "memory");
    __syncthreads();
    const int KT = K >> 6;
    for (int kt = 0; kt < KT; ++kt) {
        gemm_kstep<PROBE, NAG>(acc, lds + (kt & 1) * GEMM_STAGE, arow, wrow, aswz, wswz, h, loader && kt + 1 < KT, Ab + (kt + 1) * 64, Wt + (kt + 1) * 64, ag, astep, bg, bstep, lds + ((kt + 1) & 1) * GEMM_STAGE + dmaoff);
        asm volatile("s_waitcnt vmcnt(0)" ::: "memory");
        __syncthreads();
    }
    if (PROBE == 0 || acc[0][0][0] == 12345.678f) epi.wave_tile(acc, wm * 128, n0 + wn * 64, lane);
}

template <int EPIK, int PROBE = 0>
DI void gemm_dense(const Params& p, unsigned char* smem, const bf16_t* A, int lda, const bf16_t* Wt, int K, int N, bf16_t* C, int ldc, const float* mod, int bid, int nb, int tid) {
    const int tn = N / GEMM_TN, total = (MROWS / GEMM_TM) * tn;
    for (int t = bid; t < total; t += nb) {
        const int mt = t / tn, nt = t - mt * tn;
        RowDense rs{A, lda, mt * GEMM_TM};
        if (EPIK == 0) { EpiStore e{C, ldc, mt * GEMM_TM}; gemm_tile_mfma<RowDense, EpiStore, PROBE>(smem, rs, Wt, K, nt * GEMM_TN, e, tid); }
        else { EpiResid e{&p, mod, mt * GEMM_TM}; gemm_tile_mfma(smem, rs, Wt, K, nt * GEMM_TN, e, tid); }
    }
}
template <int WHICH>
DI void gemm_moe(const Params& p, unsigned char* smem, int layer, int bid, int nb, int tid) {
    const unsigned* cnt = (const unsigned*)(p.ws + WS_CTL) + CW_CNT + layer * 32;
    const unsigned* list = (const unsigned*)(p.ws + WS_LIST);
    const float* gates = (const float*)(p.ws + WS_GATE);
    const bf16_t* H = (const bf16_t*)(p.ws + WS_H);
    bf16_t* act = (bf16_t*)(p.ws + WS_Q);
    bf16_t* eo = (bf16_t*)(p.ws + WS_RAW);
    constexpr int TN = WHICH == 0 ? 2 : 4;
    int total = 0;
    for (int e = 0; e < NEXP; ++e) total += (int)((cnt[e] + 255u) >> 8) * TN;
    for (int t = bid; t < total; t += nb) {
        int e = 0, rem = t;
        for (; e < NEXP; ++e) { const int te = (int)((cnt[e] + 255u) >> 8) * TN; if (rem < te) break; rem -= te; }
        const int rt = rem / TN, ct = rem - rt * TN;
        const unsigned* ent = list + (size_t)e * MROWS + rt * GEMM_TM;
        const int valid = min(GEMM_TM, (int)cnt[e] - rt * GEMM_TM);
        if (WHICH == 0) {
            RowGather rs{H, 1024, ent, valid, 1};
            EpiGlu ep{act, ent, gates, valid};
            gemm_tile_mfma(smem, rs, (const bf16_t*)(p.ws + W_GU) + ((size_t)layer * 32 + e) * 512 * 1024, 1024, ct * GEMM_TN, ep, tid);
        } else {
            RowGather rs{act, DEXP, ent, valid, 0};
            EpiScatter ep{eo, ent, valid};
            gemm_tile_mfma(smem, rs, (const bf16_t*)(p.ws + W_DN) + ((size_t)layer * 32 + e) * 1024 * 256, 256, ct * GEMM_TN, ep, tid);
        }
    }
}

DI float quad_sum(float v) { v += __shfl_xor(v, 1); v += __shfl_xor(v, 2); return v; }
DI void head64_norm_rope(const bf16_t* src, bf16_t* dst, const float* gain, int sub, bool rope, int prow, int pcol, float scale) {
    float a[8], b[8];
    unpack8(*(const u32x4*)(src + sub * 8), a); unpack8(*(const u32x4*)(src + 32 + sub * 8), b);
    float ss = 0.f;
#pragma unroll
    for (int e = 0; e < 8; ++e) ss += a[e] * a[e] + b[e] * b[e];
    ss = quad_sum(ss);
    const float rs = rsqrtf(ss * (1.0f / 64.0f) + EPS);
#pragma unroll
    for (int e = 0; e < 8; ++e) { a[e] *= rs * gain[sub * 8 + e]; b[e] *= rs * gain[32 + sub * 8 + e]; }
    if (rope) {
#pragma unroll
        for (int e = 0; e < 8; ++e) {
            const int i = sub * 8 + e;
            const float* cs = ROPE64 + ((i < 16 ? prow : pcol) * 16 + (i & 15)) * 2;
            const float c = cs[0], s = cs[1], x1 = a[e], x2 = b[e];
            a[e] = x1 * c - x2 * s; b[e] = x2 * c + x1 * s;
        }
    }
#pragma unroll
    for (int e = 0; e < 8; ++e) { a[e] *= scale; b[e] *= scale; }
    *(u32x4*)(dst + sub * 8) = pack8(a); *(u32x4*)(dst + 32 + sub * 8) = pack8(b);
}
template <int KIND>
DI void phase_post_qk(const Params& p, int bid, int nb, int tid) {
    const int wid = __builtin_amdgcn_readfirstlane(tid >> 6), lane = tid & 63, hd = lane >> 2, sub = lane & 3;
    constexpr int NRAW = KIND == 1 ? 1536 : 3072, KH = KIND == 1 ? 4 : 16;
    const bf16_t* raw = (const bf16_t*)(p.ws + WS_RAW);
    bf16_t* Q = (bf16_t*)(p.ws + WS_Q); bf16_t* Kb = (bf16_t*)(p.ws + WS_K);
    const float* qn = p.in[KIND == 0 ? 15 : KIND == 1 ? 20 : 32];
    const float* kn = p.in[KIND == 0 ? 16 : KIND == 1 ? 21 : 33];
    const float qscale = 0.125f * LOG2E;
    for (int r = bid * NW + wid; r < MROWS; r += nb * NW) {
        const int b = r / PP, pos = r - b * PP;
        const bool rope = (KIND != 0) && pos < SEQ;
        const int prow = (pos >> 6) & 63, pcol = pos & 63;
        const bf16_t* rr = raw + (size_t)r * NRAW;
        head64_norm_rope(rr + hd * 64, Q + (size_t)r * 1024 + hd * 64, qn, sub, rope, prow, pcol, qscale);
        if (hd < KH) head64_norm_rope(rr + 1024 + hd * 64, Kb + (size_t)r * (KH * 64) + hd * 64, kn, sub, rope, prow, pcol, 1.0f);
    }
}
DI void phase_post_mla1(const Params& p, int bid, int nb, int tid) {
    const int wid = __builtin_amdgcn_readfirstlane(tid >> 6), lane = tid & 63;
    const bf16_t* raw = (const bf16_t*)(p.ws + WS_Q);
    bf16_t* cqn = (bf16_t*)(p.ws + WS_O);
    bf16_t* ckvn = cqn + (size_t)MROWS * 384;
    bf16_t* krope = ckvn + (size_t)MROWS * 256;
    const float* qa = p.in[24]; const float* kva = p.in[25]; const float* kn = p.in[29];
    for (int r = bid * NW + wid; r < MROWS; r += nb * NW) {
        const int b = r / PP, pos = r - b * PP;
        const bf16_t* rr = raw + (size_t)r * 768;
        {
            float v[6];
#pragma unroll
            for (int j = 0; j < 3; ++j) { const unsigned w = *(const unsigned*)(rr + lane * 6 + 2 * j); v[2 * j] = bflo(w); v[2 * j + 1] = bfhi(w); }
            float ss = 0.f;
#pragma unroll
            for (int j = 0; j < 6; ++j) ss += v[j] * v[j];
            ss = wave_sum(ss);
            const float rs = rsqrtf(ss * (1.0f / 384.0f) + EPS);
#pragma unroll
            for (int j = 0; j < 3; ++j) *(unsigned*)(cqn + (size_t)r * 384 + lane * 6 + 2 * j) = pk2(v[2 * j] * rs * qa[lane * 6 + 2 * j], v[2 * j + 1] * rs * qa[lane * 6 + 2 * j + 1]);
        }
        {
            const u32x2 w = *(const u32x2*)(rr + 384 + lane * 4);
            float v[4] = {bflo(w.x), bfhi(w.x), bflo(w.y), bfhi(w.y)};
            float ss = v[0] * v[0] + v[1] * v[1] + v[2] * v[2] + v[3] * v[3];
            ss = wave_sum(ss);
            const float rs = rsqrtf(ss * (1.0f / 256.0f) + EPS);
            u32x2 o; o.x = pk2(v[0] * rs * kva[lane * 4], v[1] * rs * kva[lane * 4 + 1]); o.y = pk2(v[2] * rs * kva[lane * 4 + 2], v[3] * rs * kva[lane * 4 + 3]);
            *(u32x2*)(ckvn + (size_t)r * 256 + lane * 4) = o;
        }
        {
            float x1 = 0.f, x2 = 0.f;
            if (lane < 16) { x1 = bf2f(rr[640 + lane]); x2 = bf2f(rr[640 + 16 + lane]); }
            float ss = wave_sum(x1 * x1 + x2 * x2);
            const float rs = rsqrtf(ss * (1.0f / 32.0f) + EPS);
            if (lane < 16) {
                x1 *= rs * kn[64 + lane]; x2 *= rs * kn[64 + 16 + lane];
                if (pos < SEQ) {
                    const int prow = (pos >> 6) & 63, pcol = pos & 63;
                    const float* cs = ROPE32 + ((lane < 8 ? prow : pcol) * 8 + (lane & 7)) * 2;
                    const float c = cs[0], s = cs[1], a = x1, bb = x2;
                    x1 = a * c - bb * s; x2 = bb * c + a * s;
                }
                bf16_t* kr = (bf16_t*)(p.ws + WS_K) + (size_t)r * 1536 + 64;
                const bf16_t b1 = (bf16_t)f2bf(x1), b2 = (bf16_t)f2bf(x2);
#pragma unroll
                for (int hh = 0; hh < 16; ++hh) { kr[hh * 96 + lane] = b1; kr[hh * 96 + 16 + lane] = b2; }
            }
        }
    }
}
DI void phase_post_mla2(const Params& p, int bid, int nb, int tid) {
    const int wid = __builtin_amdgcn_readfirstlane(tid >> 6), lane = tid & 63, hd = lane >> 2, sub = lane & 3;
    const bf16_t* qraw = (const bf16_t*)(p.ws + WS_RAW);
    const bf16_t* kvraw = qraw + (size_t)MROWS * 1536;
    const bf16_t* krope = (const bf16_t*)(p.ws + WS_O) + (size_t)MROWS * 640;
    bf16_t* Q = (bf16_t*)(p.ws + WS_Q); bf16_t* Kb = (bf16_t*)(p.ws + WS_K);
    const float* qn = p.in[28]; const float* kn = p.in[29];
    const float qscale = 0.10206207261596577f * LOG2E;
    for (int r = bid * NW + wid; r < MROWS; r += nb * NW) {
        const int b = r / PP, pos = r - b * PP;
        const bf16_t* qr = qraw + (size_t)r * 1536 + hd * 96;
        bf16_t* qo = Q + (size_t)r * 1536 + hd * 96;
        {
            float a[8], c[8];
            unpack8(*(const u32x4*)(qr + sub * 16), a); unpack8(*(const u32x4*)(qr + sub * 16 + 8), c);
            float ss = 0.f;
#pragma unroll
            for (int e = 0; e < 8; ++e) ss += a[e] * a[e] + c[e] * c[e];
            ss = quad_sum(ss);
            const float rs = rsqrtf(ss * (1.0f / 64.0f) + EPS) * qscale;
#pragma unroll
            for (int e = 0; e < 8; ++e) { a[e] *= rs * qn[sub * 16 + e]; c[e] *= rs * qn[sub * 16 + 8 + e]; }
            *(u32x4*)(qo + sub * 16) = pack8(a); *(u32x4*)(qo + sub * 16 + 8) = pack8(c);
        }
        {
            const u32x2 w1 = *(const u32x2*)(qr + 64 + sub * 4), w2 = *(const u32x2*)(qr + 64 + 16 + sub * 4);
            float x1[4] = {bflo(w1.x), bfhi(w1.x), bflo(w1.y), bfhi(w1.y)}, x2[4] = {bflo(w2.x), bfhi(w2.x), bflo(w2.y), bfhi(w2.y)};
            float ss = 0.f;
#pragma unroll
            for (int e = 0; e < 4; ++e) ss += x1[e] * x1[e] + x2[e] * x2[e];
            ss = quad_sum(ss);
            const float rs = rsqrtf(ss * (1.0f / 32.0f) + EPS);
#pragma unroll
            for (int e = 0; e < 4; ++e) {
                const int i = sub * 4 + e;
                float a = x1[e] * rs * qn[64 + i], bb = x2[e] * rs * qn[64 + 16 + i];
                if (pos < SEQ) {
                    const int prow = (pos >> 6) & 63, pcol = pos & 63;
                    const float* cs = ROPE32 + ((i < 8 ? prow : pcol) * 8 + (i & 7)) * 2;
                    const float c = cs[0], s = cs[1], t1 = a, t2 = bb;
                    a = t1 * c - t2 * s; bb = t2 * c + t1 * s;
                }
                x1[e] = a * qscale; x2[e] = bb * qscale;
            }
            u32x2 o1, o2; o1.x = pk2(x1[0], x1[1]); o1.y = pk2(x1[2], x1[3]); o2.x = pk2(x2[0], x2[1]); o2.y = pk2(x2[2], x2[3]);
            *(u32x2*)(qo + 64 + sub * 4) = o1; *(u32x2*)(qo + 64 + 16 + sub * 4) = o2;
        }
        {
            const bf16_t* kr = kvraw + (size_t)r * 2048 + hd * 128;
            bf16_t* ko = Kb + (size_t)r * 1536 + hd * 96;
            float a[8], c[8];
            unpack8(*(const u32x4*)(kr + sub * 16), a); unpack8(*(const u32x4*)(kr + sub * 16 + 8), c);
            float ss = 0.f;
#pragma unroll
            for (int e = 0; e < 8; ++e) ss += a[e] * a[e] + c[e] * c[e];
            ss = quad_sum(ss);
            const float rs = rsqrtf(ss * (1.0f / 64.0f) + EPS);
#pragma unroll
            for (int e = 0; e < 8; ++e) { a[e] *= rs * kn[sub * 16 + e]; c[e] *= rs * kn[sub * 16 + 8 + e]; }
            *(u32x4*)(ko + sub * 16) = pack8(a); *(u32x4*)(ko + sub * 16 + 8) = pack8(c);
            *(u32x4*)(ko + 64 + sub * 8) = *(const u32x4*)(krope + (size_t)r * 32 + sub * 8);
        }
    }
}
DI void phase_diff_combine(const Params& p, int bid, int nb, int tid) {
    const int wid = __builtin_amdgcn_readfirstlane(tid >> 6), lane = tid & 63, hd = lane >> 3, sub = lane & 7;
    const bf16_t* O12 = (const bf16_t*)(p.ws + WS_H);
    bf16_t* Oc = (bf16_t*)(p.ws + WS_Q);
    const float* lam = p.in[34]; const float* subln = p.in[35];
    const float lambda_init = 0.8f - 0.6f * 0.40656965974059917f;
    const float s1 = wave_sum(lam[lane] * lam[64 + lane]), s2 = wave_sum(lam[128 + lane] * lam[192 + lane]);
    const float lam_full = expf(s1) - expf(s2) + lambda_init;
    for (int r = bid * NW + wid; r < MROWS; r += nb * NW) {
        const bf16_t* o1 = O12 + (size_t)r * 2048 + (2 * hd) * 128 + sub * 16, *o2 = o1 + 128;
        float a[16], c[16];
        unpack8(*(const u32x4*)o1, *(float(*)[8])a); unpack8(*(const u32x4*)(o1 + 8), *(float(*)[8])(a + 8));
        unpack8(*(const u32x4*)o2, *(float(*)[8])c); unpack8(*(const u32x4*)(o2 + 8), *(float(*)[8])(c + 8));
        float ss = 0.f;
#pragma unroll
        for (int e = 0; e < 16; ++e) { a[e] -= lam_full * c[e]; ss += a[e] * a[e]; }
        ss += __shfl_xor(ss, 1); ss += __shfl_xor(ss, 2); ss += __shfl_xor(ss, 4);
        const float rs = rsqrtf(ss * (1.0f / 128.0f) + EPS) * (1.0f - lambda_init);
#pragma unroll
        for (int e = 0; e < 16; ++e) a[e] *= rs * subln[sub * 16 + e];
        bf16_t* o = Oc + (size_t)r * 1024 + hd * 128 + sub * 16;
        *(u32x4*)o = pack8(*(float(*)[8])a); *(u32x4*)(o + 8) = pack8(*(float(*)[8])(a + 8));
    }
}


typedef short s16x4 __attribute__((ext_vector_type(4)));
typedef float f32x2_t __attribute__((ext_vector_type(2)));
typedef __bf16 bf16x2_t __attribute__((ext_vector_type(2)));
DI unsigned cvtpk(float lo, float hi) { f32x2_t v = {lo, hi}; bf16x2_t b = __builtin_convertvector(v, bf16x2_t); return __builtin_bit_cast(unsigned, b); }
DI float xhalf_max(float v) { auto rr = __builtin_amdgcn_permlane32_swap(__float_as_uint(v), __float_as_uint(v), false, false); return fmaxf(__uint_as_float(rr[0]), __uint_as_float(rr[1])); }
DI float xhalf_sum(float v) { auto rr = __builtin_amdgcn_permlane32_swap(__float_as_uint(v), __float_as_uint(v), false, false); return __uint_as_float(rr[0]) + __uint_as_float(rr[1]); }
typedef short v4i16_t __attribute__((__vector_size__(4 * sizeof(short))));
DI s16x4 lds_tr(lds_ptr p) { return __builtin_bit_cast(s16x4, __builtin_amdgcn_ds_read_tr16_b64_v4i16((LAS v4i16_t*)p)); }
constexpr float ATT_BIG = 40.0f, ATT_BIGF = 1.0995116e12f;
DI int crow(int i, int hf) { return (i & 3) + 8 * (i >> 2) + 4 * hf; }

struct AttnP { const bf16_t* Q; int ldq; const bf16_t* K; int ldk; const bf16_t* V; int ldv; bf16_t* O; int ldo; int HQ; int gk; int gv; int vhs  ; const float* bias; const float* sink; int need_ctx; const float* kgain  ; const float* lam; const float* subln; unsigned char* Oc; int ldoc;   };

template <int DQ, int DV, int MODE, int ABL = 0>
DI void attn_mfma(const AttnP& a, unsigned char* smem, int bid, int nb, int tid) {
    constexpr int KSTR = DQ * 2 + 16, KTB = 64 * KSTR, VTB = 64 * DV * 2, NDB = DV / 32, NKK = DQ / 16;
    constexpr int KCH = DQ / 8, VCH = DV / 8, NKI = (64 * KCH + NTHREADS - 1) / NTHREADS, NVI = (64 * VCH + NTHREADS - 1) / NTHREADS;
    static_assert(2 * KTB + 2 * VTB + 2048 <= GEMM_LDS, "attention LDS");
    const lds_ptr lds = (lds_ptr)smem;
    LAS float* biasl = (LAS float*)(lds + 2 * KTB + 2 * VTB);
    const int lane = tid & 63, wid = __builtin_amdgcn_readfirstlane(tid >> 6), r = lane & 31, hf = lane >> 5;
    const int nq = a.need_ctx ? 17 : 16;
    const int xcd = bid & 7, slot = bid >> 3, nslots = nb >> 3, per_xcd = (NBATCH * a.HQ / 8) * nq;
    int koff[NKI], kdst[NKI], voff[NVI], vdst[NVI];
#pragma unroll
    for (int i = 0; i < NKI; ++i) { const int c = min(tid + NTHREADS * i, 64 * KCH - 1), row = c / KCH, kc = c - row * KCH; koff[i] = row * a.ldk + kc * 8; kdst[i] = row * KSTR + kc * 16; }
#pragma unroll
    for (int i = 0; i < NVI; ++i) { const int c = tid + NTHREADS * i, row = c / VCH, vc = c - row * VCH; voff[i] = row * a.ldv + vc * 8; vdst[i] = ((row >> 3) * NDB + (vc >> 2)) * 512 + (row & 7) * 64 + (vc & 3) * 16; }
    const int i16 = lane & 15, trq = i16 >> 2, trp = i16 & 3, grp = (lane >> 4) & 1;
    const int vtr0 = (4 * hf + trq) * 64 + 32 * grp + 8 * trp;
    constexpr bool PAIRED = (MODE == 2 && DV == 128);
    float lam_full = 0.f;
    if (PAIRED) { const float s1 = wave_sum(a.lam[lane] * a.lam[64 + lane]), s2 = wave_sum(a.lam[128 + lane] * a.lam[192 + lane]); lam_full = expf(s1) - expf(s2) + (0.8f - 0.6f * 0.40656965974059917f); }
    int it_i = 0;
    for (int j = slot; j < per_xcd; j += nslots, ++it_i) {
        const int nbh = NBATCH * a.HQ / 8;
        const int bhl = j < nbh * 16 ? j >> 4 : j - nbh * 16;
        int qt = j < nbh * 16 ? j & 15 : 16;
        int bh = bhl * 8 + xcd;
        if (MODE == 1) { const int P = (bhl >> 2) * 8 + xcd; bh = (P >> 2) * a.HQ + (P & 3) * 4 + (bhl & 3); }
        if (PAIRED) { const int pu = slot + nslots * (it_i >> 1); qt = pu & 15; bh = (pu >> 4) * a.HQ + 2 * xcd + (it_i & 1); }
        const int h = bh % a.HQ, b = bh / a.HQ;
        const bool is_ctx = qt >= 16;
        const int q0 = is_ctx ? SEQ : qt * 256;
        int t_lo = 0, n_lat = 0;
        if (!is_ctx) {
            if (MODE == 2) { t_lo = 0; n_lat = 64; }
            else if (MODE == 1) { t_lo = max(0, 4 * qt - 2); n_lat = min(63, 4 * qt + 5) - t_lo + 1; }
            else { const int r0 = 4 * qt; t_lo = min(max(r0 - 4, 0), 56); n_lat = min(max(r0 - 1, 0), 56) + 7 - t_lo + 1; }
        }
        const int ntiles = n_lat + 4;
        const int qw0 = q0 + wid * 32, qpos = qw0 + r;
        const size_t qrow = (size_t)b * PP + qpos;
        bf16x8 qf[NKK];
#pragma unroll
        for (int kk = 0; kk < NKK; ++kk) qf[kk] = *(const bf16x8*)(a.Q + qrow * a.ldq + h * DQ + kk * 16 + hf * 8);
        if (MODE == 0 && !is_ctx) { for (int i = tid; i < 465; i += NTHREADS) biasl[i] = a.bias[h * 465 + i] * LOG2E; }
        const bf16_t* Kg = a.K + (size_t)b * PP * a.ldk + (h >> a.gk) * DQ;
        const bf16_t* Vg = a.V + (size_t)b * PP * a.ldv + (h >> a.gv) * a.vhs;
        f32x16 o[NDB];
#pragma unroll
        for (int d = 0; d < NDB; ++d)
#pragma unroll
            for (int i = 0; i < 16; ++i) o[d][i] = 0.f;
        float mref = 0.f, l = 0.f;
        f32x16 negm;
#pragma unroll
        for (int i = 0; i < 16; ++i) negm[i] = 0.f;
        bool first = true;
        float lbig = 0.f;
        float one = 1.0f; asm volatile("" : "+v"(one));
#define ATT_TILE(IT) ((IT) < n_lat ? t_lo + (IT) : 64 + ((IT) - n_lat))
        auto tile_active = [&](int t) -> bool {
            if (t >= 64) return true;
            if (MODE == 1) return (t * 64 + 63 >= qw0 - 128) && (t * 64 <= qw0 + 31 + 128);
            if (MODE == 0) { const int rw = qw0 >> 6, row0 = min(max(rw - 4, 0), 56); return t >= row0 && t < row0 + 8; }
            return true;
        };
        auto qk = [&](f32x16 (&s)[2], const lds_ptr Kb) {
#pragma unroll
            for (int kk = 0; kk < NKK; ++kk)
#pragma unroll
                for (int kb = 0; kb < 2; ++kb) {
                    if (ABL & 4) { if (kk == 0) s[kb] = negm; }
                    else {
                    const bf16x8 kf = *(const LAS bf16x8*)(Kb + (kb * 32 + r) * KSTR + (kk * 2 + hf) * 16);
                    s[kb] = MFMA32(kf, qf[kk], kk == 0 ? negm : s[kb]);
                    }
                }
        };
        u32x4 kr[NKI], vr[NVI];
        {
            const int t0 = ATT_TILE(0), t1 = ATT_TILE(1);
            u32x4 k1[NKI];
#pragma unroll
            for (int i = 0; i < NKI; ++i) kr[i] = *(const u32x4*)(Kg + (size_t)t0 * 64 * a.ldk + koff[i]);
#pragma unroll
            for (int i = 0; i < NVI; ++i) vr[i] = *(const u32x4*)(Vg + (size_t)t0 * 64 * a.ldv + voff[i]);
#pragma unroll
            for (int i = 0; i < NKI; ++i) k1[i] = *(const u32x4*)(Kg + (size_t)t1 * 64 * a.ldk + koff[i]);
#pragma unroll
            for (int i = 0; i < NKI; ++i) { *(LAS u32x4*)(lds + kdst[i]) = kr[i]; *(LAS u32x4*)(lds + KTB + kdst[i]) = k1[i]; }
#pragma unroll
            for (int i = 0; i < NVI; ++i) *(LAS u32x4*)(lds + 2 * KTB + vdst[i]) = vr[i];
        }
        __syncthreads();
        f32x16 sc[2], sn[2];
        bool act_cur = tile_active(ATT_TILE(0)), act_nxt = false;
        if (act_cur) qk(sc, lds);
        __syncthreads();
        auto step = [&](const int it, const int e, const bool N2, const bool N1) {
            const int t = ATT_TILE(it);
            if (N2 && !(ABL & 8) && (!(ABL & 128) || e)) {
                const int tn = ATT_TILE(it + 2);
#pragma unroll
                for (int i = 0; i < NKI; ++i) kr[i] = *(const u32x4*)(Kg + (size_t)tn * 64 * a.ldk + koff[i]);
            }
            if (N1 && !(ABL & 8) && (!(ABL & 128) || e)) {
                const int tn = ATT_TILE(it + 1);
#pragma unroll
                for (int i = 0; i < NVI; ++i) vr[i] = *(const u32x4*)(Vg + (size_t)tn * 64 * a.ldv + voff[i]);
            }
            SCHED_FENCE();
            act_nxt = N1 && (MODE == 2 || tile_active(ATT_TILE(it + 1)));
            const lds_ptr Vb = lds + 2 * KTB + e * VTB;
            const bool do_cur = MODE == 2 || act_cur;
            if (do_cur) {
                if (t < 64 && MODE == 1 && !((t * 64 + 63 - qw0 <= 128) && (qw0 + 31 - t * 64 <= 128))) {
                    const int dbase = t * 64 + 4 * hf - qpos;
#pragma unroll
                    for (int kb = 0; kb < 2; ++kb)
#pragma unroll
                        for (int i = 0; i < 16; ++i) { const int c = kb * 32 + (i & 3) + 8 * (i >> 2); sc[kb][i] = (dbase > 128 - c || dbase < -128 - c) ? -INFINITY : sc[kb][i]; }
                }
                if (t < 64 && MODE == 0) {
                    const int qc = qpos & 63, rw = qpos >> 6, col0 = min(max(qc - 8, 0), 48);
                    const int brow = (t - rw + 7) * 31 + 15 - qc;
#pragma unroll
                    for (int kb = 0; kb < 2; ++kb)
#pragma unroll
                        for (int i = 0; i < 16; ++i) {
                            const int kc = kb * 32 + crow(i, hf);
                            const bool ok = kc >= col0 && kc < col0 + 16;
                            const float bv = biasl[ok ? brow + kc : 0];
                            sc[kb][i] = ok ? sc[kb][i] + bv : -INFINITY;
                        }
                }
                if (first || __builtin_amdgcn_ballot_w64(lbig > ATT_BIGF) != 0ull) {
                    float delta = lbig > ATT_BIGF ? ATT_BIG : 0.f;
                    if (first) {
                        float mx = sc[0][0];
#pragma unroll
                        for (int i = 1; i < 16; ++i) mx = fmaxf(mx, sc[0][i]);
#pragma unroll
                        for (int i = 0; i < 16; ++i) mx = fmaxf(mx, sc[1][i]);
                        mx = xhalf_max(mx);
                        delta = mx > -INFINITY ? mx : 0.f;
                    }
                    const float alpha = __builtin_amdgcn_exp2f(-delta);
                    l *= alpha; mref += delta;
#pragma unroll
                    for (int d = 0; d < NDB; ++d)
#pragma unroll
                        for (int i = 0; i < 16; ++i) o[d][i] *= alpha;
#pragma unroll
                    for (int kb = 0; kb < 2; ++kb)
#pragma unroll
                        for (int i = 0; i < 16; ++i) sc[kb][i] -= delta;
#pragma unroll
                    for (int i = 0; i < 16; ++i) negm[i] = -mref;
                    first = false;
                }
            }
            if (N1) qk(sn, lds + (e ^ 1) * KTB);
            if (do_cur) {
                float ls0 = 0.f, ls1 = 0.f;
#pragma unroll
                for (int kb = 0; kb < 2; ++kb)
#pragma unroll
                    for (int i = 0; i < 16; i += 2) {
                        const float p0 = (ABL & 1) ? sc[kb][i] : __builtin_amdgcn_exp2f(sc[kb][i]), p1 = (ABL & 1) ? sc[kb][i + 1] : __builtin_amdgcn_exp2f(sc[kb][i + 1]);
                        sc[kb][i] = p0; sc[kb][i + 1] = p1;
                        if (!(ABL & 16)) { ls0 += p0; ls1 = __builtin_fmaf(p1, one, ls1); }
                    }
                lbig = ls0 + ls1;
                l += lbig;
                bf16x8 pf[4];
#pragma unroll
                for (int kb = 0; kb < 2; ++kb)
#pragma unroll
                    for (int sp = 0; sp < 2; ++sp) {
                        u32x4 w;
                        w.x = cvtpk(sc[kb][8 * sp], sc[kb][8 * sp + 1]); w.y = cvtpk(sc[kb][8 * sp + 2], sc[kb][8 * sp + 3]);
                        w.z = cvtpk(sc[kb][8 * sp + 4], sc[kb][8 * sp + 5]); w.w = cvtpk(sc[kb][8 * sp + 6], sc[kb][8 * sp + 7]);
                        pf[kb * 2 + sp] = __builtin_bit_cast(bf16x8, w);
                    }
#pragma unroll
                for (int ks = 0; ks < 4; ++ks)
#pragma unroll
                    for (int d = 0; d < NDB; ++d) {
                        const lds_ptr vp = Vb + ((2 * ks) * NDB + d) * 512 + vtr0;
                        const s16x4 lo = lds_tr(vp), hi = lds_tr(vp + NDB * 512);
                        const bf16x8 vf = __builtin_shufflevector(lo, hi, 0, 1, 2, 3, 4, 5, 6, 7);
                        if (ABL & 2) { if (d == 0 && ks == 0) o[0][0] += __builtin_bit_cast(float, pf[0][0] | pf[1][0] | pf[2][0] | pf[3][0]) + __builtin_bit_cast(float, (int)vf[0]); } else
                        o[d] = MFMA32(vf, pf[ks], o[d]);
                    }
            }
            SCHED_FENCE();
            if (N2 && !(ABL & 8) && (!(ABL & 128) || e)) {
#pragma unroll
                for (int i = 0; i < NKI; ++i) *(LAS u32x4*)(lds + e * KTB + kdst[i]) = kr[i];
            }
            if (N1 && !(ABL & 8) && (!(ABL & 128) || e)) {
#pragma unroll
                for (int i = 0; i < NVI; ++i) *(LAS u32x4*)(lds + 2 * KTB + (e ^ 1) * VTB + vdst[i]) = vr[i];
            }
            if (!(ABL & 64) && (!(ABL & 128) || e)) __syncthreads();
#pragma unroll
            for (int kb = 0; kb < 2; ++kb) sc[kb] = sn[kb];
            act_cur = act_nxt;
        };
        int it = 0;
        for (; it + 3 < ntiles; it += 2) { step(it, 0, true, true); step(it + 1, 1, true, true); }
        if (ntiles - it == 3) { step(it, 0, true, true); step(it + 1, 1, false, true); step(it + 2, 0, false, false); }
        else { step(it, 0, false, true); step(it + 1, 1, false, false); }
#undef ATT_TILE
        l = xhalf_sum(l);
        if (a.sink) {
            l += __builtin_amdgcn_exp2f(a.sink[h] * LOG2E - mref);
        }
        const float inv = 1.0f / l;
        bf16_t* orow = a.O + qrow * a.ldo + h * DV + 4 * hf;
#pragma unroll
        for (int d = 0; d < NDB; ++d)
#pragma unroll
            for (int g = 0; g < 4; ++g) {
                if (DV == 64) {
                    *(unsigned*)((unsigned char*)a.O + qrow * a.ldo + h * DV + 4 * hf + d * 32 + 8 * g) = cvt_fp8x4(o[d][4 * g] * inv, o[d][4 * g + 1] * inv, o[d][4 * g + 2] * inv, o[d][4 * g + 3] * inv);
                } else {
                    u32x2 w; w.x = cvtpk(o[d][4 * g] * inv, o[d][4 * g + 1] * inv); w.y = cvtpk(o[d][4 * g + 2] * inv, o[d][4 * g + 3] * inv);
                    *(u32x2*)(orow + d * 32 + 8 * g) = w;
                }
            }
        if (PAIRED && (it_i & 1)) {
            asm volatile("s_waitcnt vmcnt(0)" ::: "memory");
            const float lambda_init = 0.8f - 0.6f * 0.40656965974059917f;
            const int sub = lane & 7, pair = h >> 1;
#pragma unroll
            for (int i4 = 0; i4 < 4; ++i4) {
                const size_t row = (size_t)b * PP + qw0 + i4 * 8 + (lane >> 3);
                const bf16_t* o1 = a.O + row * a.ldo + (2 * pair) * 128 + sub * 16, *o2 = o1 + 128;
                float av[16], cv[16];
                unpack8(*(const u32x4*)o1, *(float(*)[8])av); unpack8(*(const u32x4*)(o1 + 8), *(float(*)[8])(av + 8));
                unpack8(*(const u32x4*)o2, *(float(*)[8])cv); unpack8(*(const u32x4*)(o2 + 8), *(float(*)[8])(cv + 8));
                float ss = 0.f;
#pragma unroll
                for (int e = 0; e < 16; ++e) { av[e] -= lam_full * cv[e]; ss += av[e] * av[e]; }
                ss += __shfl_xor(ss, 1); ss += __shfl_xor(ss, 2); ss += __shfl_xor(ss, 4);
                const float rs = rsqrtf(ss * (1.0f / 128.0f) + EPS) * (1.0f - lambda_init);
#pragma unroll
                for (int e = 0; e < 16; ++e) av[e] *= rs * a.subln[sub * 16 + e];
                u32x4 w8; w8.x = cvt_fp8x4(av[0], av[1], av[2], av[3]); w8.y = cvt_fp8x4(av[4], av[5], av[6], av[7]); w8.z = cvt_fp8x4(av[8], av[9], av[10], av[11]); w8.w = cvt_fp8x4(av[12], av[13], av[14], av[15]);
                *(u32x4*)(a.Oc + row * (size_t)a.ldoc + pair * 128 + sub * 16) = w8;
            }
        }
    }
}

DI void attn_na(const AttnP& a, unsigned char* smem, int bid, int nb, int tid) {
    constexpr int DQ = 64, DV = 64, KSTR = DQ * 2 + 16, KTB = 64 * KSTR, VTB = 64 * DV * 2, NDB = 2, NKK = 4;
    const lds_ptr lds = (lds_ptr)smem;
    constexpr int BZ_TAB = 32, BZ_HEAD = 560, BZ_NINF = 16 * BZ_HEAD, BZ_N = BZ_NINF + 64;
    static_assert(4 * KTB + 4 * VTB + (BZ_N + 16) * 4 <= GEMM_LDS, "NA LDS");
    LAS float* biasl = (LAS float*)(lds + 4 * KTB + 4 * VTB);
    for (int i = tid; i < BZ_N; i += NTHREADS) {
        const int hh = i / BZ_HEAD, o = i - hh * BZ_HEAD;
        biasl[i] = i >= BZ_NINF ? -INFINITY : (o >= BZ_TAB && o < BZ_TAB + 465) ? a.bias[hh * 465 + o - BZ_TAB] * LOG2E : 0.f;
    }
    __syncthreads();
    {
        const int wv = __builtin_amdgcn_readfirstlane(tid >> 6), ln = tid & 63;
#pragma unroll
        for (int hh2 = 0; hh2 < 2; ++hh2) {
            const int hh = 2 * wv + hh2;
            float m = 0.f;
            for (int i = ln; i < 465; i += 64) m = fmaxf(m, biasl[hh * BZ_HEAD + BZ_TAB + i]);
#pragma unroll
            for (int d = 32; d >= 1; d >>= 1) m = fmaxf(m, __shfl_xor(m, d));
            if (ln == 0) biasl[BZ_N + hh] = m;
        }
    }
    float kmax = fabsf(a.kgain[tid & 63]);
#pragma unroll
    for (int d = 32; d >= 1; d >>= 1) kmax = fmaxf(kmax, __shfl_xor(kmax, d));
    kmax *= 8.0f * 1.01f;
    const int lane = tid & 63, wid = __builtin_amdgcn_readfirstlane(tid >> 6), r = lane & 31, hf = lane >> 5;
    const int nq = a.need_ctx ? 17 : 16;
    const int xcd = bid & 7, slot = bid >> 3, nslots = nb >> 3, per_xcd = (NBATCH * a.HQ / 8) * nq;
    const int krow_s = tid >> 3, kc_s = tid & 7;
    const int koff = krow_s * a.ldk + kc_s * 8, kdst = krow_s * KSTR + kc_s * 16, voff = krow_s * a.ldv + kc_s * 8;
    const int vdst = ((krow_s >> 3) * NDB + (kc_s >> 2)) * 512 + (krow_s & 7) * 64 + (kc_s & 3) * 16;
    const int i16 = lane & 15, trq = i16 >> 2, trp = i16 & 3, grp = (lane >> 4) & 1;
    const int vtr0 = (4 * hf + trq) * 64 + 32 * grp + 8 * trp;
    const int rp = wid >> 2, cq = wid & 3, k0 = cq == 0 ? 0 : cq == 1 ? 8 : cq == 2 ? 24 : 32;
    float one = 1.0f; asm volatile("" : "+v"(one));
    auto unit_of = [&](int j, int& b, int& h, int& qt, int& t_lo, int& n_lat) {
        const int nbh = NBATCH * a.HQ / 8;
        const int bhl = j < nbh * 16 ? j >> 4 : j - nbh * 16; qt = j < nbh * 16 ? j & 15 : 16;
        const int bh = bhl * 8 + xcd; h = bh % a.HQ; b = bh / a.HQ;
        t_lo = 0; n_lat = 0;
        if (qt < 16) { const int r0 = 4 * qt; t_lo = min(max(r0 - 4, 0), 56); n_lat = min(max(r0 - 1, 0), 56) + 7 - t_lo + 1; n_lat += n_lat & 1; }
    };
#define NA_TILE_OF(IT, TLO, NLAT) ((IT) < (NLAT) ? (TLO) + (IT) : 64 + ((IT) - (NLAT)))
    bf16x8 qf[NKK];
    u32x4 krA[2], vrA[2], krB[2], vrB[2];
    auto load_pair = [&](u32x4 (&kr)[2], u32x4 (&vr)[2], const bf16_t* Kg, const bf16_t* Vg, int t_lo, int n_lat, int pr) {
#pragma unroll
        for (int jj = 0; jj < 2; ++jj) {
            const int tn = NA_TILE_OF(2 * pr + jj, t_lo, n_lat);
            kr[jj] = *(const u32x4*)(Kg + (size_t)tn * 64 * a.ldk + koff); vr[jj] = *(const u32x4*)(Vg + (size_t)tn * 64 * a.ldv + voff);
        }
    };
    auto store_pair = [&](const u32x4 (&kr)[2], const u32x4 (&vr)[2], int e) {
#pragma unroll
        for (int jj = 0; jj < 2; ++jj) { *(LAS u32x4*)(lds + (2 * e + jj) * KTB + kdst) = kr[jj]; *(LAS u32x4*)(lds + 4 * KTB + (2 * e + jj) * VTB + vdst) = vr[jj]; }
    };
    auto qrow_of = [&](int b, int qt) -> size_t { const int qpos = qt >= 16 ? SEQ + wid * 32 + r : (4 * qt + 2 * rp + (r >> 4)) * 64 + 16 * cq + (r & 15); return (size_t)b * PP + qpos; };
    auto load_q = [&](int b, int h, int qt) {
        const size_t qrow = qrow_of(b, qt);
#pragma unroll
        for (int kk = 0; kk < NKK; ++kk) qf[kk] = *(const bf16x8*)(a.Q + qrow * a.ldq + h * DQ + kk * 16 + hf * 8);
    };
    if (slot >= per_xcd) return;
    int b, h, qt, t_lo, n_lat;
    unit_of(slot, b, h, qt, t_lo, n_lat);
    {
        load_q(b, h, qt);
        const bf16_t* Kg = a.K + (size_t)b * PP * a.ldk + h * DQ; const bf16_t* Vg = a.V + (size_t)b * PP * a.ldv + h * a.vhs;
        load_pair(krA, vrA, Kg, Vg, t_lo, n_lat, 0); store_pair(krA, vrA, 0); load_pair(krB, vrB, Kg, Vg, t_lo, n_lat, 1);
    }
    __syncthreads();
    for (int j = slot;;) {
        const int jn = j + nslots; const bool has_next = jn < per_xcd;
        int nb_, nh, nqt, nt_lo, nn_lat;
        unit_of(has_next ? jn : j, nb_, nh, nqt, nt_lo, nn_lat);
        const bf16_t* nKg = a.K + (size_t)nb_ * PP * a.ldk + nh * DQ; const bf16_t* nVg = a.V + (size_t)nb_ * PP * a.ldv + nh * a.vhs;
        const bool is_ctx = qt >= 16;
        const int r0 = 4 * qt;
        const int npair = (n_lat + 4) >> 1;
        const int qrw = r0 + 2 * rp + (r >> 4), qc = 16 * cq + (r & 15);
        const size_t qrow = qrow_of(b, qt);
        const bf16_t* Kg = a.K + (size_t)b * PP * a.ldk + h * DQ;
        const bf16_t* Vg = a.V + (size_t)b * PP * a.ldv + h * a.vhs;
        const int rwA = r0 + 2 * rp, wlo = min(max(rwA - 4, 0), 56), whi = min(max(rwA - 3, 0), 56) + 7;
        const int col0 = min(max(qc - 8, 0), 48), row0q = min(max(qrw - 4, 0), 56);
        const int lanebase = h * BZ_HEAD + BZ_TAB + (7 - qrw) * 31 + 15 - qc + k0 + 4 * hf;
        f32x16 o[NDB];
#pragma unroll
        for (int d = 0; d < NDB; ++d)
#pragma unroll
            for (int i = 0; i < 16; ++i) o[d][i] = 0.f;
        float l = 0.f;
        float qn2 = 0.f;
#pragma unroll
        for (int kk = 0; kk < NKK; ++kk)
#pragma unroll
            for (int jj = 0; jj < 8; ++jj) { const float qv = bf2f((bf16_t)qf[kk][jj]); qn2 = __builtin_fmaf(qv, qv, qn2); }
        qn2 = xhalf_sum(qn2);
        const float mref = __builtin_sqrtf(qn2) * kmax + biasl[BZ_N + h];
        f32x16 negmL;
#pragma unroll
        for (int i = 0; i < 16; ++i) { const int kc = k0 + crow(i, hf); negmL[i] = (kc >= col0 && kc < col0 + 16) ? -mref : -INFINITY; }
#define NA_TILE(IT) NA_TILE_OF(IT, t_lo, n_lat)
        auto ctx_tile = [&](const lds_ptr Kb, const lds_ptr Vb) {
            {
                f32x16 s[2], negm;
#pragma unroll
                for (int i = 0; i < 16; ++i) negm[i] = -mref;
#pragma unroll
                for (int kk = 0; kk < NKK; ++kk)
#pragma unroll
                    for (int kb = 0; kb < 2; ++kb) {
                        const bf16x8 kf = *(const LAS bf16x8*)(Kb + (kb * 32 + r) * KSTR + (kk * 2 + hf) * 16);
                        s[kb] = MFMA32(kf, qf[kk], kk == 0 ? negm : s[kb]);
                    }
                float ls0 = 0.f, ls1 = 0.f;
                bf16x8 pf[4];
#pragma unroll
                for (int kb = 0; kb < 2; ++kb) {
#pragma unroll
                    for (int i = 0; i < 16; i += 2) {
                        const float p0 = __builtin_amdgcn_exp2f(s[kb][i]), p1 = __builtin_amdgcn_exp2f(s[kb][i + 1]);
                        s[kb][i] = p0; s[kb][i + 1] = p1; ls0 += p0; ls1 = __builtin_fmaf(p1, one, ls1);
                    }
#pragma unroll
                    for (int sp = 0; sp < 2; ++sp) {
                        u32x4 w;
                        w.x = cvtpk(s[kb][8 * sp], s[kb][8 * sp + 1]); w.y = cvtpk(s[kb][8 * sp + 2], s[kb][8 * sp + 3]);
                        w.z = cvtpk(s[kb][8 * sp + 4], s[kb][8 * sp + 5]); w.w = cvtpk(s[kb][8 * sp + 6], s[kb][8 * sp + 7]);
                        pf[kb * 2 + sp] = __builtin_bit_cast(bf16x8, w);
                    }
                }
                l += ls0 + ls1;
#pragma unroll
                for (int ks = 0; ks < 4; ++ks)
#pragma unroll
                    for (int d = 0; d < NDB; ++d) {
                        const lds_ptr vp = Vb + ((2 * ks) * NDB + d) * 512 + vtr0;
                        const s16x4 lo = lds_tr(vp), hi = lds_tr(vp + NDB * 512);
                        o[d] = MFMA32(__builtin_shufflevector(lo, hi, 0, 1, 2, 3, 4, 5, 6, 7), pf[ks], o[d]);
                    }
            }
        };
        auto lat_tile = [&](const int t, const lds_ptr Kb, const lds_ptr Vb) {
            bf16x8 pf[2];
#pragma unroll
            for (int sp = 0; sp < 2; ++sp)
#pragma unroll
                for (int jj = 0; jj < 8; ++jj) pf[sp][jj] = 0;
            if (t >= wlo && t <= whi) {
                f32x16 s;
#pragma unroll
                for (int kk = 0; kk < NKK; ++kk) {
                    const bf16x8 kf = *(const LAS bf16x8*)(Kb + (k0 + r) * KSTR + (kk * 2 + hf) * 16);
                    s = MFMA32(kf, qf[kk], kk == 0 ? negmL : s);
                }
                const LAS float* bp = biasl + (((unsigned)(t - row0q) < 8u) ? lanebase + 31 * t : BZ_NINF);
#pragma unroll
                for (int i = 0; i < 16; ++i) s[i] += bp[crow(i, 0)];
                float ls0 = 0.f, ls1 = 0.f;
#pragma unroll
                for (int i = 0; i < 16; i += 2) {
                    const float p0 = __builtin_amdgcn_exp2f(s[i]), p1 = __builtin_amdgcn_exp2f(s[i + 1]);
                    s[i] = p0; s[i + 1] = p1; ls0 += p0; ls1 = __builtin_fmaf(p1, one, ls1);
                }
#pragma unroll
                for (int sp = 0; sp < 2; ++sp) {
                    u32x4 w;
                    w.x = cvtpk(s[8 * sp], s[8 * sp + 1]); w.y = cvtpk(s[8 * sp + 2], s[8 * sp + 3]);
                    w.z = cvtpk(s[8 * sp + 4], s[8 * sp + 5]); w.w = cvtpk(s[8 * sp + 6], s[8 * sp + 7]);
                    pf[sp] = __builtin_bit_cast(bf16x8, w);
                }
                l += ls0 + ls1;
            }
#pragma unroll
            for (int ks = 0; ks < 2; ++ks)
#pragma unroll
                for (int d = 0; d < NDB; ++d) {
                    const lds_ptr vp = Vb + (((k0 >> 3) + 2 * ks) * NDB + d) * 512 + vtr0;
                    const s16x4 lo = lds_tr(vp), hi = lds_tr(vp + NDB * 512);
                    o[d] = MFMA32(__builtin_shufflevector(lo, hi, 0, 1, 2, 3, 4, 5, 6, 7), pf[ks], o[d]);
                }
        };
#define NA_ITER(IP, E, KL, VL, KS, VS, LAT) do { \
            if ((IP) + 2 < npair) load_pair(KL, VL, Kg, Vg, t_lo, n_lat, (IP) + 2); \
            else if (has_next) load_pair(KL, VL, nKg, nVg, nt_lo, nn_lat, (IP) + 2 - npair); \
            SCHED_FENCE(); \
            if (LAT) { lat_tile(t_lo + 2 * (IP), lds + (2 * (E)) * KTB, lds + 4 * KTB + (2 * (E)) * VTB); lat_tile(t_lo + 2 * (IP) + 1, lds + (2 * (E) + 1) * KTB, lds + 4 * KTB + (2 * (E) + 1) * VTB); } \
            else { ctx_tile(lds + (2 * (E)) * KTB, lds + 4 * KTB + (2 * (E)) * VTB); ctx_tile(lds + (2 * (E) + 1) * KTB, lds + 4 * KTB + (2 * (E) + 1) * VTB); } \
            SCHED_FENCE(); \
            if ((IP) + 1 < npair || has_next) store_pair(KS, VS, (E) ^ 1); \
            __syncthreads(); } while (0)
        int ip = 0;
        for (; ip < (n_lat >> 1); ip += 2) { NA_ITER(ip, 0, krA, vrA, krB, vrB, true); NA_ITER(ip + 1, 1, krB, vrB, krA, vrA, true); }
        NA_ITER(ip, 0, krA, vrA, krB, vrB, false); NA_ITER(ip + 1, 1, krB, vrB, krA, vrA, false);
#undef NA_ITER
        if (has_next) load_q(nb_, nh, nqt);
#undef NA_TILE
        l = xhalf_sum(l);
        const float inv = 1.0f / l;
#pragma unroll
        for (int d = 0; d < NDB; ++d)
#pragma unroll
            for (int g = 0; g < 4; ++g)
                *(unsigned*)((unsigned char*)a.O + qrow * a.ldo + h * DV + 4 * hf + d * 32 + 8 * g) = cvt_fp8x4(o[d][4 * g] * inv, o[d][4 * g + 1] * inv, o[d][4 * g + 2] * inv, o[d][4 * g + 3] * inv);
        if (!has_next) break;
        j = jn; b = nb_; h = nh; qt = nqt; t_lo = nt_lo; n_lat = nn_lat;
    }
#undef NA_TILE_OF
}

template <class E> struct epi_fp8 { static constexpr int value = 0; };
typedef int v8i_t __attribute__((ext_vector_type(8)));
typedef int v4i_t __attribute__((ext_vector_type(4)));
namespace pg8 {
constexpr int BM = 256, BK = 64, HALF = 128, HTB = HALF * BK * 2  ;
DI int lds_byte(int r, int c) { const int st = (r >> 4) * 2 + (c >> 5), rr = r & 15, cc = c & 31, ob = rr * 64 + cc * 2; return st * 1024 + (ob ^ (((ob >> 9) & 1) << 5)); }
DI void stage_rc(int b, int& R, int& C) { const int st = b / 1024, sb = b % 1024, swz = sb ^ (((sb >> 9) & 1) << 5); R = (st >> 1) * 16 + swz / 64; C = (st & 1) * 32 + (swz % 64) / 2; }
DI int perm32(int rho) { const int n = rho >> 4, i = rho & 15; return 8 * (i >> 2) + 4 * n + (i & 3); }

template <class Epi, class Sched>
DI void gemm_phase(lds_ptr lds, const bf16_t* __restrict__ Aop, const int K, const Sched& S, const Epi& E, const int tid) {
    const int wid = __builtin_amdgcn_readfirstlane(tid >> 6), lane = tid & 63, wr = wid >> 2, wc = wid & 3, fr = lane & 15, fq = lane >> 4;
    const int nt = K / BK;
    int Ra[2], Ca[2]; unsigned voffB[2];
#pragma unroll
    for (int i = 0; i < 2; ++i) { int R, C; stage_rc(tid * 16 + i * 8192, R, C); const int Rb = Epi::PERM ? ((R & ~31) + perm32(R & 31)) : R;
        Ra[i] = R; Ca[i] = C; voffB[i] = (unsigned)(Rb * K + C) * 2u; }
    const size_t kstep = (size_t)(BK * 2);
    const size_t hstep = (size_t)HALF * K * 2;
    const unsigned ldsw = (unsigned)wid * 1024u;
    const int aoff = lds_byte(wr * 64 + fr, fq * 8), boff = lds_byte(wc * 32 + fr, fq * 8);
#define PG8_SA(b, h) (((b) * 2 + (h)) * HTB)
#define PG8_SB(b, h) ((4 + (b) * 2 + (h)) * HTB)
#define PG8_STAGE(bufoff, gbase, voff) do { const char* _gb = (const char*)(gbase); asm volatile("" : "+s"(_gb)); _Pragma("unroll") for (int _i = 0; _i < 2; ++_i) { \
        unsigned _o = (voff)[_i]; asm volatile("" : "+v"(_o)); \
        __builtin_amdgcn_global_load_lds((const unsigned*)(_gb + _o), (LAS unsigned*)(lds + (bufoff) + ldsw + _i * 8192), 16, 0, 0); } } while (0)
#define PG8_LDA(dst, b, h) do { _Pragma("unroll") for (int m = 0; m < 4; ++m) _Pragma("unroll") for (int k = 0; k < 2; ++k) dst[m][k] = *(const LAS bf16x8*)(lds + PG8_SA(b, h) + aoff + m * 2048 + k * 1024); } while (0)
#define PG8_LDB(dst, b, h) do { _Pragma("unroll") for (int n = 0; n < 2; ++n) _Pragma("unroll") for (int k = 0; k < 2; ++k) dst[n][k] = *(const LAS bf16x8*)(lds + PG8_SB(b, h) + boff + n * 2048 + k * 1024); } while (0)
typedef long i64x2_t __attribute__((ext_vector_type(2)));
#define PG8_MMA(ai, bj, At, Bt) do { __builtin_amdgcn_s_setprio(1); _Pragma("unroll") for (int m = 0; m < 4; ++m) _Pragma("unroll") for (int n = 0; n < 2; ++n) { \
        if (epi_fp8<Epi>::value == 2) { \
            const v8i_t _b = __builtin_shufflevector(__builtin_bit_cast(v4i_t, Bt[n][0]), __builtin_bit_cast(v4i_t, Bt[n][1]), 0, 1, 2, 3, 4, 5, 6, 7); \
            const v8i_t _a = __builtin_shufflevector(__builtin_bit_cast(v4i_t, At[m][0]), __builtin_bit_cast(v4i_t, At[m][1]), 0, 1, 2, 3, 4, 5, 6, 7); \
            acc[ai][bj][m][n] = __builtin_amdgcn_mfma_scale_f32_16x16x128_f8f6f4(_b, _a, acc[ai][bj][m][n], 0, 0, 0, 0, 0, 0); \
        } else { _Pragma("unroll") for (int k = 0; k < 2; ++k) { \
        if (epi_fp8<Epi>::value == 1) { const i64x2_t _b = __builtin_bit_cast(i64x2_t, Bt[n][k]), _a = __builtin_bit_cast(i64x2_t, At[m][k]); \
            acc[ai][bj][m][n] = __builtin_amdgcn_mfma_f32_16x16x32_fp8_fp8(_b[0], _a[0], acc[ai][bj][m][n], 0, 0, 0); \
            acc[ai][bj][m][n] = __builtin_amdgcn_mfma_f32_16x16x32_fp8_fp8(_b[1], _a[1], acc[ai][bj][m][n], 0, 0, 0); } \
        else acc[ai][bj][m][n] = __builtin_amdgcn_mfma_f32_16x16x32_bf16(Bt[n][k], At[m][k], acc[ai][bj][m][n], 0, 0, 0); } } } \
        __builtin_amdgcn_s_setprio(0); } while (0)
#define PG8_WAIT_V(n) asm volatile("s_waitcnt vmcnt(" #n ")" ::: "memory")
#define PG8_WAIT_L(n) asm volatile("s_waitcnt lgkmcnt(" #n ")" ::: "memory")
#define PG8_BAR __builtin_amdgcn_s_barrier()
#define PG8_SCHED __builtin_amdgcn_sched_barrier(0)
    typename Sched::Unit cur, nxt; int ui = 0;
    if (!S.next(0, cur)) return;
    f32x4 acc[2][2][4][2];
#pragma unroll
    for (int a = 0; a < 2; ++a)
#pragma unroll
        for (int b = 0; b < 2; ++b)
#pragma unroll
            for (int m = 0; m < 4; ++m)
#pragma unroll
                for (int n = 0; n < 2; ++n) acc[a][b][m][n] = (f32x4){0.f, 0.f, 0.f, 0.f};
    bf16x8 At[4][2], B0[2][2], B1[2][2];
    constexpr bool GATHER = Sched::GATHER;
    unsigned oc[2][2], on[2][2] = {{0u, 0u}, {0u, 0u}};
    size_t ubc[2] = {0, 0}, ubn[2] = {0, 0};
#pragma unroll
    for (int h = 0; h < 2; ++h) {
        if (!GATHER) ubc[h] = (size_t)S.a_off(cur, h * HALF) * 2u;
#pragma unroll
        for (int i = 0; i < 2; ++i) oc[h][i] = GATHER ? (S.a_off(cur, h * HALF + Ra[i]) + (unsigned)Ca[i]) * 2u : (unsigned)(Ra[i] * S.lda + Ca[i]) * 2u;
    }
    const char* gA = (const char*)Aop;
    const char* cB = (const char*)S.b_base(cur);
    PG8_STAGE(PG8_SB(0, 0), cB, voffB); PG8_STAGE(PG8_SB(0, 1), cB + hstep, voffB); PG8_STAGE(PG8_SA(0, 0), gA + ubc[0], oc[0]); PG8_STAGE(PG8_SA(0, 1), gA + ubc[1], oc[1]);
    if (wr == 1) PG8_BAR;
    PG8_WAIT_V(2); PG8_BAR;
    PG8_STAGE(PG8_SB(1, 0), cB + kstep, voffB); PG8_STAGE(PG8_SA(1, 0), gA + ubc[0] + kstep, oc[0]); PG8_STAGE(PG8_SB(1, 1), cB + hstep + kstep, voffB);
    PG8_WAIT_V(6); PG8_BAR;
    for (;;) {
        const bool has_next = S.next(ui + 1, nxt);
        const char* nB = has_next ? (const char*)S.b_base(nxt) : cB;
#pragma unroll
        for (int h = 0; h < 2; ++h) {
            if (!GATHER) ubn[h] = has_next ? (size_t)S.a_off(nxt, h * HALF) * 2u : ubc[h];
#pragma unroll
            for (int i = 0; i < 2; ++i) if (GATHER) { int R, C; stage_rc(((wid << 6) | lane_now()) * 16 + i * 8192, R, C);
                const unsigned* ip = S.a_ptr(nxt, h * HALF + R); asm volatile("global_load_dword %0, %1, off" : "=v"(on[h][i]) : "v"(ip) : "memory"); }
        }
        const bool full = cur.half < 0;
        for (int t = 0; t < nt; t += 2) {
            const bool last = (t == nt - 2);
            const char* a1 = gA + (size_t)(t + 1) * kstep;
            const char* a2 = last ? gA : gA + (size_t)(t + 2) * kstep; const char* b2 = last ? nB : cB + (size_t)(t + 2) * kstep;
            const char* a3 = a2 + kstep; const char* b3 = b2 + kstep;
            size_t u2[2];
            if (GATHER && last) {
                asm volatile("" : "+v"(on[0][0]), "+v"(on[0][1]), "+v"(on[1][0]), "+v"(on[1][1]));
#pragma unroll
                for (int i = 0; i < 2; ++i) { int R, C; stage_rc(((wid << 6) | lane_now()) * 16 + i * 8192, R, C);
                    oc[0][i] = (S.a_cvt(on[0][i]) + (unsigned)C) * 2u; on[1][i] = (S.a_cvt(on[1][i]) + (unsigned)C) * 2u; }
            }
#pragma unroll
            for (int h = 0; h < 2; ++h) u2[h] = last ? ubn[h] : ubc[h];
            PG8_LDB(B0, 0, 0); PG8_LDB(B1, 0, 1); PG8_SCHED; PG8_LDA(At, 0, 0); PG8_STAGE(PG8_SA(1, 1), a1 + ubc[1], oc[1]);
            if (GATHER && last) { oc[1][0] = on[1][0]; oc[1][1] = on[1][1]; }
            PG8_WAIT_V(8); PG8_WAIT_L(0); PG8_BAR; PG8_MMA(0, 0, At, B0); PG8_MMA(0, 1, At, B1); PG8_BAR; PG8_SCHED;
            PG8_LDA(At, 0, 1); PG8_STAGE(PG8_SB(0, 0), b2, voffB); PG8_STAGE(PG8_SB(0, 1), b2 + hstep, voffB); PG8_STAGE(PG8_SA(0, 0), a2 + u2[0], oc[0]);
            PG8_WAIT_V(8); PG8_WAIT_L(0); PG8_BAR; if (full) { PG8_MMA(1, 0, At, B0); PG8_MMA(1, 1, At, B1); } PG8_BAR; PG8_SCHED;
            PG8_LDB(B0, 1, 0); PG8_LDB(B1, 1, 1); PG8_SCHED; PG8_LDA(At, 1, 0); PG8_STAGE(PG8_SA(0, 1), a2 + u2[1], oc[1]);
            PG8_WAIT_V(8); PG8_WAIT_L(0); PG8_BAR; PG8_MMA(0, 0, At, B0); PG8_MMA(0, 1, At, B1); PG8_BAR; PG8_SCHED;
            PG8_LDA(At, 1, 1); PG8_STAGE(PG8_SB(1, 0), b3, voffB); PG8_STAGE(PG8_SB(1, 1), b3 + hstep, voffB); PG8_STAGE(PG8_SA(1, 0), a3 + u2[0], oc[0]);
            PG8_WAIT_V(8); PG8_WAIT_L(0); PG8_BAR; if (full) { PG8_MMA(1, 0, At, B0); PG8_MMA(1, 1, At, B1); } PG8_BAR; PG8_SCHED;
        }
        if (wr == 0) PG8_BAR;
        { const int ln = lane_now(); E(acc, cur, wr, wc, ln & 15, ln >> 4); }
        if (!has_next) break;
#pragma unroll
        for (int a = 0; a < 2; ++a)
#pragma unroll
            for (int b = 0; b < 2; ++b)
#pragma unroll
                for (int m = 0; m < 4; ++m)
#pragma unroll
                    for (int n = 0; n < 2; ++n) acc[a][b][m][n] = (f32x4){0.f, 0.f, 0.f, 0.f};
        cur = nxt; cB = nB; ++ui;
#pragma unroll
        for (int h = 0; h < 2; ++h) ubc[h] = ubn[h];
        if (wr == 1) PG8_BAR;
    }
    PG8_WAIT_V(0);
    PG8_BAR;
#undef PG8_SA
#undef PG8_SB
#undef PG8_STAGE
#undef PG8_LDA
#undef PG8_LDB
#undef PG8_MMA
#undef PG8_WAIT_V
#undef PG8_WAIT_L
#undef PG8_BAR
#undef PG8_SCHED
}
}

struct DenseSched {
    static constexpr bool GATHER = false;
    struct Unit { int pm, pn, half; };
    int nM, nN, nwg, G, c; const bf16_t* Bt; int K, lda; bool skip_ctx;
    DI void unit_of(int L, Unit& u) const {
        int wgid = L; { const int q = nwg / 8, r = nwg % 8, xcd = wgid % 8, off = wgid / 8; wgid = (xcd < r ? xcd * (q + 1) : r * (q + 1) + (xcd - r) * q) + off; }
        const int nig = 8 * nN, gid = wgid / nig, fm = gid * 8, gsz = (nM - fm) < 8 ? (nM - fm) : 8;
        u.pm = fm + ((wgid % nig) % gsz); u.pn = (wgid % nig) / gsz;
        if (skip_ctx) u.pm += u.pm >> 4;
    }
    DI bool next(int i, Unit& u) const {
        const int rounds = nwg / G, rem = nwg - rounds * G;
        if (i < rounds) { unit_of(i * G + c, u); u.half = -1; return true; }
        if (i > rounds || rem == 0) return false;
        if (2 * rem <= G) { if (c >= 2 * rem) return false; unit_of(rounds * G + (c >> 1), u); u.half = c & 1; return true; }
        if (c >= rem) return false;
        unit_of(rounds * G + c, u); u.half = -1; return true;
    }
    DI unsigned a_off(const Unit& u, int row) const { const int rr = u.half < 0 ? row : u.half * 128 + (row & 127); return (unsigned)(u.pm * 256 + rr) * (unsigned)lda; }
    DI const unsigned* a_ptr(const Unit&, int) const { return nullptr; }
    DI unsigned a_cvt(unsigned raw) const { return raw; }
    DI const bf16_t* b_base(const Unit& u) const { return Bt + (size_t)u.pn * 256 * K; }
};
struct MoeUnit { int e, pn, valid, half; const unsigned* ent; };
template <bool TAIL>
struct MoeSched {
    static constexpr bool GATHER = true;
    typedef MoeUnit Unit;
    const LAS int* tab; const unsigned* list; const unsigned* zero  ; const bf16_t* W; int K, N, TN, lda, shift, G, c, nwg;
    DI bool unit_of(int L, Unit& u) const {
        const int v = tab[1 + (lane_now() & 31)];
        const int e = __builtin_popcount((unsigned)__ballot(v <= L));
        if (e >= NEXP) return false;
        const int rem = L - __builtin_amdgcn_readfirstlane(tab[e]), cn = __builtin_amdgcn_readfirstlane(tab[40 + e]);
        const int rt = rem / TN; u.e = e; u.pn = rem - rt * TN; u.ent = list + (size_t)e * MROWS + rt * 256; u.valid = min(256, cn - rt * 256); return true;
    }
    int lo, n, GX, j;
    DI void place() { GX = G >> 3; j = c >> 3; const int per = ((((nwg + 7) >> 3) + TN - 1) / TN) * TN; lo = (c & 7) * per; n = max(0, min(per, nwg - lo)); }
    DI bool next(int i, Unit& u) const {
        u.ent = zero; u.valid = 1;
        const int rounds = n / GX, rem = n - rounds * GX;
        if (!TAIL) { u.half = -1; if (i >= rounds) return false; return unit_of(lo + i * GX + j, u); }
        if (i > 0 || rem == 0) return false;
        if (2 * rem <= GX) {
            if (j >= 2 * rem) return false;
            if (!unit_of(lo + rounds * GX + (j >> 1), u)) return false;
            u.half = j & 1; u.ent += u.half * 128; u.valid = min(128, u.valid - u.half * 128);
            return u.valid > 0;
        }
        u.half = -1; if (j >= rem) return false;
        return unit_of(lo + rounds * GX + j, u);
    }
    DI unsigned a_off(const Unit& u, int row) const { const int rr = (TAIL && u.half >= 0) ? (row & 127) : row; return (u.ent[rr < u.valid ? rr : u.valid - 1] >> shift) * (unsigned)lda; }
    DI const unsigned* a_ptr(const Unit& u, int row) const { const int rr = (TAIL && u.half >= 0) ? (row & 127) : row; return u.ent + (rr < u.valid ? rr : u.valid - 1); }
    DI unsigned a_cvt(unsigned raw) const { return (raw >> shift) * (unsigned)lda; }
    DI const bf16_t* b_base(const Unit& u) const { return W + ((size_t)u.e * N + (size_t)u.pn * 256) * K; }
};
typedef float f32x4_t __attribute__((ext_vector_type(4)));
struct XEpiStore {
    static constexpr bool PERM = true;
    bf16_t* C; int ldc;
    DI void operator()(const f32x4 (&acc)[2][2][4][2], const DenseSched::Unit& u, int wr, int wc, int fr, int fq) const {
        const int row0 = u.pm * 256 + (u.half > 0 ? 128 : 0) + wr * 64 + fr, col0 = u.pn * 256 + wc * 32 + 8 * fq;
#pragma unroll
        for (int ai = 0; ai < 2; ++ai) if (ai == 0 || u.half < 0)
#pragma unroll
            for (int m = 0; m < 4; ++m) { bf16_t* rowp = C + (size_t)(row0 + ai * 128 + m * 16) * ldc + col0;
#pragma unroll
                for (int bj = 0; bj < 2; ++bj) { const f32x4 v0 = acc[ai][bj][m][0], v1 = acc[ai][bj][m][1];
                    u32x4 w; w.x = cvtpk(v0[0], v0[1]); w.y = cvtpk(v0[2], v0[3]); w.z = cvtpk(v1[0], v1[1]); w.w = cvtpk(v1[2], v1[3]);
                    *(u32x4*)(rowp + bj * 128) = w; } }
    } };
struct XEpiStore8 {
    static constexpr bool PERM = true;
    bf16_t* C; int ldc;
    DI void operator()(const f32x4 (&acc)[2][2][4][2], const DenseSched::Unit& u, int wr, int wc, int fr, int fq) const {
        const int row0 = u.pm * 256 + (u.half > 0 ? 128 : 0) + wr * 64 + fr, col0 = u.pn * 256 + wc * 32 + 8 * fq;
#pragma unroll
        for (int ai = 0; ai < 2; ++ai) if (ai == 0 || u.half < 0)
#pragma unroll
            for (int m = 0; m < 4; ++m) { bf16_t* rowp = C + (size_t)(row0 + ai * 128 + m * 16) * ldc + col0;
#pragma unroll
                for (int bj = 0; bj < 2; ++bj) { const f32x4 v0 = acc[ai][bj][m][0] * (1.0f / 32.0f), v1 = acc[ai][bj][m][1] * (1.0f / 32.0f);
                    u32x4 w; w.x = cvtpk(v0[0], v0[1]); w.y = cvtpk(v0[2], v0[3]); w.z = cvtpk(v1[0], v1[1]); w.w = cvtpk(v1[2], v1[3]);
                    *(u32x4*)(rowp + bj * 128) = w; } }
    } };
template <> struct epi_fp8<XEpiStore8> { static constexpr int value = 2; };
struct XEpiResid {
    static constexpr bool PERM = true;
    const Params* p; const float* mod;
    DI void operator()(const f32x4 (&acc)[2][2][4][2], const DenseSched::Unit& u, int wr, int wc, int fr, int fq) const {
        const int row0 = u.pm * 256 + (u.half > 0 ? 128 : 0) + wr * 64 + fr, col0 = u.pn * 256 + wc * 32 + 8 * fq;
#pragma unroll
        for (int ai = 0; ai < 2; ++ai) if (ai == 0 || u.half < 0)
#pragma unroll
            for (int m = 0; m < 4; ++m) { const int row = row0 + ai * 128 + m * 16;
                bf16_t* xr = xb_row(*p, row) + col0; const float* gp = mod + (size_t)mod_row(row) * 6144 + 2048 + col0;
#pragma unroll
                for (int bj = 0; bj < 2; ++bj) {
                    const u32x4 xw = *(const u32x4*)(xr + bj * 128); const f32x4 g0 = *(const f32x4*)(gp + bj * 128), g1 = *(const f32x4*)(gp + bj * 128 + 4);
                    const f32x4 a0 = acc[ai][bj][m][0], a1 = acc[ai][bj][m][1];
                    u32x4 w;
                    w.x = cvtpk(bflo(xw.x) + g0[0] * a0[0], bfhi(xw.x) + g0[1] * a0[1]); w.y = cvtpk(bflo(xw.y) + g0[2] * a0[2], bfhi(xw.y) + g0[3] * a0[3]);
                    w.z = cvtpk(bflo(xw.z) + g1[0] * a1[0], bfhi(xw.z) + g1[1] * a1[1]); w.w = cvtpk(bflo(xw.w) + g1[2] * a1[2], bfhi(xw.w) + g1[3] * a1[3]);
                    *(u32x4*)(xr + bj * 128) = w; } }
    } };
struct XEpiResid8 {
    static constexpr bool PERM = true;
    const Params* p; const float* mod;
    DI void operator()(const f32x4 (&acc)[2][2][4][2], const DenseSched::Unit& u, int wr, int wc, int fr, int fq) const {
        const int row0 = u.pm * 256 + (u.half > 0 ? 128 : 0) + wr * 64 + fr, col0 = u.pn * 256 + wc * 32 + 8 * fq;
#pragma unroll
        for (int ai = 0; ai < 2; ++ai) if (ai == 0 || u.half < 0)
#pragma unroll
            for (int m = 0; m < 4; ++m) { const int row = row0 + ai * 128 + m * 16;
                bf16_t* xr = xb_row(*p, row) + col0; const float* gp = mod + (size_t)mod_row(row) * 6144 + 2048 + col0;
#pragma unroll
                for (int bj = 0; bj < 2; ++bj) {
                    const u32x4 xw = *(const u32x4*)(xr + bj * 128); const f32x4 g0 = *(const f32x4*)(gp + bj * 128) * (1.0f / 32.0f), g1 = *(const f32x4*)(gp + bj * 128 + 4) * (1.0f / 32.0f);
                    const f32x4 a0 = acc[ai][bj][m][0], a1 = acc[ai][bj][m][1];
                    u32x4 w;
                    w.x = cvtpk(bflo(xw.x) + g0[0] * a0[0], bfhi(xw.x) + g0[1] * a0[1]); w.y = cvtpk(bflo(xw.y) + g0[2] * a0[2], bfhi(xw.y) + g0[3] * a0[3]);
                    w.z = cvtpk(bflo(xw.z) + g1[0] * a1[0], bfhi(xw.z) + g1[1] * a1[1]); w.w = cvtpk(bflo(xw.w) + g1[2] * a1[2], bfhi(xw.w) + g1[3] * a1[3]);
                    *(u32x4*)(xr + bj * 128) = w; } }
    } };
template <> struct epi_fp8<XEpiResid8> { static constexpr int value = 2; };
struct XEpiGlu {
    static constexpr bool PERM = true;
    bf16_t* act; const float* gates;
    DI void operator()(const f32x4 (&acc)[2][2][4][2], const MoeUnit& u, int wr, int wc, int fr, int fq) const {
#pragma unroll
        for (int ai = 0; ai < 2; ++ai)
#pragma unroll
            for (int m = 0; m < 4; ++m) { const int i = ai * 128 + wr * 64 + m * 16 + fr;
                if (i < u.valid) { const unsigned a = u.ent[i]; const float gw = gates[a];
                    const f32x4 g0 = acc[ai][0][m][0], g1 = acc[ai][0][m][1], u0 = acc[ai][1][m][0], u1 = acc[ai][1][m][1];
                    float v[8];
#pragma unroll
                    for (int j = 0; j < 4; ++j) { v[j] = silu_f(g0[j]) * u0[j] * gw; v[4 + j] = silu_f(g1[j]) * u1[j] * gw; }
                    u32x4 w; w.x = cvtpk(v[0], v[1]); w.y = cvtpk(v[2], v[3]); w.z = cvtpk(v[4], v[5]); w.w = cvtpk(v[6], v[7]);
                    *(u32x4*)(act + (size_t)a * DEXP + u.pn * 128 + wc * 32 + 8 * fq) = w; } }
    } };
struct XEpiGlu8 : XEpiGlu {
    DI void operator()(const f32x4 (&acc)[2][2][4][2], const MoeUnit& u, int wr, int wc, int fr, int fq) const {
#pragma unroll
        for (int ai = 0; ai < 2; ++ai)
#pragma unroll
            for (int m = 0; m < 4; ++m) { const int i = ai * 128 + wr * 64 + m * 16 + fr;
                if (i < u.valid) { const unsigned a = u.ent[i]; const float gw = gates[a] * (1.0f / 32.0f);
                    const f32x4 g0 = acc[ai][0][m][0] * (1.0f / 32.0f), g1 = acc[ai][0][m][1] * (1.0f / 32.0f), u0 = acc[ai][1][m][0], u1 = acc[ai][1][m][1];
                    float v[8];
#pragma unroll
                    for (int j = 0; j < 4; ++j) { v[j] = silu_f(g0[j]) * u0[j] * gw; v[4 + j] = silu_f(g1[j]) * u1[j] * gw; }
                    u32x4 w; w.x = cvtpk(v[0], v[1]); w.y = cvtpk(v[2], v[3]); w.z = cvtpk(v[4], v[5]); w.w = cvtpk(v[6], v[7]);
                    *(u32x4*)(act + (size_t)a * DEXP + u.pn * 128 + wc * 32 + 8 * fq) = w; } }
    } };
template <> struct epi_fp8<XEpiGlu8> { static constexpr int value = 1; };
struct XEpiScatter {
    static constexpr bool PERM = true;
    bf16_t* outp;
    DI void operator()(const f32x4 (&acc)[2][2][4][2], const MoeUnit& u, int wr, int wc, int fr, int fq) const {
#pragma unroll
        for (int ai = 0; ai < 2; ++ai)
#pragma unroll
            for (int m = 0; m < 4; ++m) { const int i = ai * 128 + wr * 64 + m * 16 + fr;
                if (i < u.valid) { bf16_t* rowp = outp + (size_t)u.ent[i] * 1024 + u.pn * 256 + wc * 32 + 8 * fq;
#pragma unroll
                    for (int bj = 0; bj < 2; ++bj) { const f32x4 v0 = acc[ai][bj][m][0], v1 = acc[ai][bj][m][1];
                        u32x4 w; w.x = cvtpk(v0[0], v0[1]); w.y = cvtpk(v0[2], v0[3]); w.z = cvtpk(v1[0], v1[1]); w.w = cvtpk(v1[2], v1[3]);
                        *(u32x4*)(rowp + bj * 128) = w; } } }
    } };

template <int KIND>
struct XEpiQKV {
    static constexpr bool PERM = true;
    static constexpr int KW = KIND == 1 ? 256 : 1024, LDRAW = KIND == 1 ? 1536 : 3072;
    static constexpr float ASC = 1.0f / 32.0f;
    bf16_t* Q; bf16_t* Kb; bf16_t* RAW; const float* qn; const float* kn;
    DI void operator()(const f32x4 (&acc)[2][2][4][2], const DenseSched::Unit& u, int wr, int wc, int fr, int fq) const {
        const int col0 = u.pn * 256, row0 = u.pm * 256 + (u.half > 0 ? 128 : 0) + wr * 64 + fr;
        if (col0 >= 1024 + KW) {
#pragma unroll
            for (int ai = 0; ai < 2; ++ai) if (ai == 0 || u.half < 0)
#pragma unroll
                for (int m = 0; m < 4; ++m) { bf16_t* rowp = RAW + (size_t)(row0 + ai * 128 + m * 16) * LDRAW + col0 + wc * 32 + 8 * fq;
#pragma unroll
                    for (int bj = 0; bj < 2; ++bj) { const f32x4 v0 = acc[ai][bj][m][0] * ASC, v1 = acc[ai][bj][m][1] * ASC;
                        u32x4 w; w.x = cvtpk(v0[0], v0[1]); w.y = cvtpk(v0[2], v0[3]); w.z = cvtpk(v1[0], v1[1]); w.w = cvtpk(v1[2], v1[3]);
                        *(u32x4*)(rowp + bj * 128) = w; } }
            return;
        }
        const bool isq = col0 < 1024;
        const int head = isq ? 4 * u.pn + wc : ((col0 - 1024) >> 6) + wc;
        const float* gain = (isq ? qn : kn) + 8 * fq;
        const float scale = isq ? 0.125f * LOG2E : 1.0f;
        bf16_t* dstb = isq ? Q + head * 64 + 8 * fq : Kb + head * 64 + 8 * fq;
        const int ldd = isq ? 1024 : KW;
        f32x4 g[2][2];
#pragma unroll
        for (int bj = 0; bj < 2; ++bj)
#pragma unroll
            for (int n = 0; n < 2; ++n) g[bj][n] = *(const f32x4*)(gain + 32 * bj + 4 * n);
#pragma unroll
        for (int ai = 0; ai < 2; ++ai) if (ai == 0 || u.half < 0)
#pragma unroll
            for (int m = 0; m < 4; ++m) {
                const int row = row0 + ai * 128 + m * 16, b = row / PP, pos = row - b * PP;
                f32x4 v[2][2];
                float ss = 0.f;
#pragma unroll
                for (int bj = 0; bj < 2; ++bj)
#pragma unroll
                    for (int n = 0; n < 2; ++n) { v[bj][n] = acc[ai][bj][m][n] * ASC; ss += v[bj][n][0] * v[bj][n][0] + v[bj][n][1] * v[bj][n][1] + v[bj][n][2] * v[bj][n][2] + v[bj][n][3] * v[bj][n][3]; }
                ss += __shfl_xor(ss, 16); ss += __shfl_xor(ss, 32);
                const float rs = rsqrtf(ss * (1.0f / 64.0f) + EPS);
#pragma unroll
                for (int bj = 0; bj < 2; ++bj)
#pragma unroll
                    for (int n = 0; n < 2; ++n) v[bj][n] = v[bj][n] * rs * g[bj][n];
                if (KIND != 0 && pos < SEQ) {
                    const int prow = (pos >> 6) & 63, pcol = pos & 63;
                    const float* cs = ROPE64 + ((fq < 2 ? prow : pcol) * 16 + ((8 * fq) & 15)) * 2;
#pragma unroll
                    for (int n = 0; n < 2; ++n)
#pragma unroll
                        for (int j = 0; j < 4; ++j) {
                            const float c = cs[(4 * n + j) * 2], sn = cs[(4 * n + j) * 2 + 1], x1 = v[0][n][j], x2 = v[1][n][j];
                            v[0][n][j] = x1 * c - x2 * sn; v[1][n][j] = x2 * c + x1 * sn;
                        }
                }
                bf16_t* rowp = dstb + (size_t)row * ldd;
#pragma unroll
                for (int bj = 0; bj < 2; ++bj) { const f32x4 v0 = v[bj][0] * scale, v1 = v[bj][1] * scale;
                    u32x4 w; w.x = cvtpk(v0[0], v0[1]); w.y = cvtpk(v0[2], v0[3]); w.z = cvtpk(v1[0], v1[1]); w.w = cvtpk(v1[2], v1[3]);
                    *(u32x4*)(rowp + bj * 32) = w; }
            }
    } };
constexpr bool qkv_fp8(int kind) { return true; }
template <int KIND> struct epi_fp8<XEpiQKV<KIND>> { static constexpr int value = 2; };
template <int KIND>
DI void gemm_qkv_x(const Params& p, unsigned char* smem, const bf16_t* Wt, int N, const float* qn, const float* kn, int bid, int nb, int tid) {
    constexpr int KU = qkv_fp8(KIND) ? 512 : 1024;
    DenseSched S; S.nM = MROWS / 256; S.nN = N / 256; S.nwg = S.nM * S.nN; S.G = nb; S.c = bid; S.Bt = Wt; S.K = KU; S.lda = KU; S.skip_ctx = false;
    XEpiQKV<KIND> e{(bf16_t*)(p.ws + WS_Q), (bf16_t*)(p.ws + WS_K), (bf16_t*)(p.ws + WS_RAW), qn, kn};
    pg8::gemm_phase((lds_ptr)smem, (const bf16_t*)(p.ws + WS_H), KU, S, e, tid);
}
template <bool UQ>
struct XEpiMla {
    static constexpr bool PERM = true;
    bf16_t* Q; bf16_t* Kb; bf16_t* V; const float* qn; const float* kn;
    DI void operator()(const f32x4 (&acc)[2][2][4][2], const DenseSched::Unit& u, int wr, int wc, int fr, int fq) const {
        const int row0 = u.pm * 256 + (u.half > 0 ? 128 : 0) + wr * 64 + fr;
        if (u.pn < 4) {
            const int head = 4 * u.pn + wc;
            const float* gain = (UQ ? qn : kn) + 8 * fq;
            const float scale = UQ ? 0.10206207261596577f * LOG2E : 1.0f;
            bf16_t* dstb = (UQ ? Q : Kb) + head * 96 + 8 * fq;
            f32x4 g[2][2];
#pragma unroll
            for (int bj = 0; bj < 2; ++bj)
#pragma unroll
                for (int n = 0; n < 2; ++n) g[bj][n] = *(const f32x4*)(gain + 32 * bj + 4 * n);
#pragma unroll
            for (int ai = 0; ai < 2; ++ai) if (ai == 0 || u.half < 0)
#pragma unroll
                for (int m = 0; m < 4; ++m) {
                    const int row = row0 + ai * 128 + m * 16;
                    float ss = 0.f;
#pragma unroll
                    for (int bj = 0; bj < 2; ++bj)
#pragma unroll
                        for (int n = 0; n < 2; ++n) { const f32x4 v = acc[ai][bj][m][n]; ss += v[0] * v[0] + v[1] * v[1] + v[2] * v[2] + v[3] * v[3]; }
                    ss += __shfl_xor(ss, 16); ss += __shfl_xor(ss, 32);
                    const float rs = rsqrtf(ss * (1.0f / 64.0f) + EPS) * scale;
                    bf16_t* rowp = dstb + (size_t)row * 1536;
#pragma unroll
                    for (int bj = 0; bj < 2; ++bj) { const f32x4 v0 = acc[ai][bj][m][0] * rs * g[bj][0], v1 = acc[ai][bj][m][1] * rs * g[bj][1];
                        u32x4 w; w.x = cvtpk(v0[0], v0[1]); w.y = cvtpk(v0[2], v0[3]); w.z = cvtpk(v1[0], v1[1]); w.w = cvtpk(v1[2], v1[3]);
                        *(u32x4*)(rowp + bj * 32) = w; }
                }
        } else if (UQ) {
            const float scale = 0.10206207261596577f * LOG2E;
            const f32x4 g1 = *(const f32x4*)(qn + 64 + 4 * fq), g2 = *(const f32x4*)(qn + 64 + 16 + 4 * fq);
#pragma unroll
            for (int ai = 0; ai < 2; ++ai) if (ai == 0 || u.half < 0)
#pragma unroll
                for (int m = 0; m < 4; ++m) {
                    const int row = row0 + ai * 128 + m * 16, b = row / PP, pos = row - b * PP;
                    const int prow = (pos >> 6) & 63, pcol = pos & 63;
                    const float* cs = ROPE32 + ((fq < 2 ? prow : pcol) * 8 + ((4 * fq) & 7)) * 2;
#pragma unroll
                    for (int bj = 0; bj < 2; ++bj) {
                        f32x4 x1 = acc[ai][bj][m][0], x2 = acc[ai][bj][m][1];
                        float ss = x1[0] * x1[0] + x1[1] * x1[1] + x1[2] * x1[2] + x1[3] * x1[3] + x2[0] * x2[0] + x2[1] * x2[1] + x2[2] * x2[2] + x2[3] * x2[3];
                        ss += __shfl_xor(ss, 16); ss += __shfl_xor(ss, 32);
                        const float rs = rsqrtf(ss * (1.0f / 32.0f) + EPS);
                        x1 = x1 * rs * g1; x2 = x2 * rs * g2;
                        if (pos < SEQ) {
#pragma unroll
                            for (int j = 0; j < 4; ++j) { const float c = cs[2 * j], sn = cs[2 * j + 1], a1 = x1[j], a2 = x2[j]; x1[j] = a1 * c - a2 * sn; x2[j] = a2 * c + a1 * sn; }
                        }
                        x1 = x1 * scale; x2 = x2 * scale;
                        bf16_t* rowp = Q + (size_t)row * 1536 + (8 * (u.pn - 4) + 4 * bj + wc) * 96 + 64 + 4 * fq;
                        u32x2 w1, w2; w1.x = cvtpk(x1[0], x1[1]); w1.y = cvtpk(x1[2], x1[3]); w2.x = cvtpk(x2[0], x2[1]); w2.y = cvtpk(x2[2], x2[3]);
                        *(u32x2*)rowp = w1; *(u32x2*)(rowp + 16) = w2;
                    }
                }
        } else {
#pragma unroll
            for (int ai = 0; ai < 2; ++ai) if (ai == 0 || u.half < 0)
#pragma unroll
                for (int m = 0; m < 4; ++m) { bf16_t* rowp = V + (size_t)(row0 + ai * 128 + m * 16) * 1024 + (u.pn - 4) * 256 + wc * 32 + 8 * fq;
#pragma unroll
                    for (int bj = 0; bj < 2; ++bj) { const f32x4 v0 = acc[ai][bj][m][0], v1 = acc[ai][bj][m][1];
                        u32x4 w; w.x = cvtpk(v0[0], v0[1]); w.y = cvtpk(v0[2], v0[3]); w.z = cvtpk(v1[0], v1[1]); w.w = cvtpk(v1[2], v1[3]);
                        *(u32x4*)(rowp + bj * 128) = w; } }
        }
    } };
template <bool UQ>
DI void gemm_mla_x(const Params& p, unsigned char* smem, int bid, int nb, int tid) {
    bf16_t* O = (bf16_t*)(p.ws + WS_O);
    DenseSched S; S.nM = MROWS / 256; S.nN = (UQ ? 1536 : 2048) / 256; S.nwg = S.nM * S.nN; S.G = nb; S.c = bid; S.Bt = (const bf16_t*)(p.ws + (UQ ? W_UQ : W_UKV)); S.K = UQ ? 384 : 256; S.lda = S.K; S.skip_ctx = false;
    XEpiMla<UQ> e{(bf16_t*)(p.ws + WS_Q), (bf16_t*)(p.ws + WS_K), (bf16_t*)(p.ws + WS_RAW), p.in[28], p.in[29]};
    pg8::gemm_phase((lds_ptr)smem, UQ ? O : O + (size_t)MROWS * 384, S.K, S, e, tid);
}
template <int EPIK>
DI void gemm_dense_x(const Params& p, unsigned char* smem, const bf16_t* A, int lda, const bf16_t* Wt, int K, int N, bf16_t* C, int ldc, const float* mod, int bid, int nb, int tid, bool skip_ctx = false) {
    DenseSched S; S.nM = skip_ctx ? NBATCH * 16 : MROWS / 256; S.nN = N / 256; S.nwg = S.nM * S.nN; S.G = nb; S.c = bid; S.Bt = Wt; S.K = K; S.lda = lda; S.skip_ctx = skip_ctx;
    if (EPIK == 0) { XEpiStore e{C, ldc}; pg8::gemm_phase((lds_ptr)smem, A, K, S, e, tid); }
    else if (EPIK == 2) { XEpiStore8 e{C, ldc}; pg8::gemm_phase((lds_ptr)smem, A, K, S, e, tid); }
    else if (EPIK == 3) { XEpiResid8 e{&p, mod}; pg8::gemm_phase((lds_ptr)smem, A, K, S, e, tid); }
    else { XEpiResid e{&p, mod}; pg8::gemm_phase((lds_ptr)smem, A, K, S, e, tid); }
}
template <int WHICH, bool TAIL>
DI void gemm_moe_call(const Params& p, unsigned char* smem, int layer, int bid, int nb, int tid) {
    MoeSched<TAIL> S; S.list = (const unsigned*)(p.ws + WS_LIST); S.zero = (const unsigned*)(p.ws + WS_CTL) + 8192; S.G = nb; S.c = bid;
    {
        LAS int* tab = (LAS int*)(smem + GEMM_LDS);
        constexpr int TNc = WHICH == 0 ? 2 : 4;
        if (tid < 64) {
            const unsigned cv = tid < 32 ? ((const unsigned*)(p.ws + WS_CTL) + CW_CNT + layer * 32)[tid] : 0u;
            int incl = (int)((cv + 255u) >> 8) * TNc;
#pragma unroll
            for (int d = 1; d < 32; d <<= 1) { const int o = __shfl_up(incl, d); if (tid >= d) incl += o; }
            if (tid < 32) { tab[1 + tid] = incl; tab[40 + tid] = (int)cv; }
            if (tid == 0) tab[0] = 0;
        }
        __syncthreads();
        S.tab = tab; S.nwg = __builtin_amdgcn_readfirstlane(tab[32]);
    }
    if (WHICH == 0) { S.W = (const bf16_t*)(p.ws + W_GU + (size_t)layer * 32 * 512 * 1024); S.K = 512; S.N = 512; S.TN = 2; S.lda = 512; S.shift = 1;
        S.place(); XEpiGlu8 e{{(bf16_t*)(p.ws + WS_Q), (const float*)(p.ws + WS_GATE)}}; pg8::gemm_phase((lds_ptr)smem, (const bf16_t*)(p.ws + WS_H), 512, S, e, tid); }
    else { S.W = (const bf16_t*)(p.ws + W_DN) + (size_t)layer * 32 * 1024 * 256; S.K = 256; S.N = 1024; S.TN = 4; S.lda = DEXP; S.shift = 0;
        S.place(); XEpiScatter e{(bf16_t*)(p.ws + WS_RAW)}; pg8::gemm_phase((lds_ptr)smem, (const bf16_t*)(p.ws + WS_Q), 256, S, e, tid); }
}
template <int WHICH>
DI void gemm_moe_x(const Params& p, unsigned char* smem, int layer, int bid, int nb, int tid) {
    const int wv = __builtin_amdgcn_readfirstlane(tid >> 6);
    gemm_moe_call<WHICH, false>(p, smem, layer, bid, nb, (wv << 6) | lane_now());
    gemm_moe_call<WHICH, true>(p, smem, layer, bid, nb, (wv << 6) | lane_now());
}

constexpr int NPHASES = 2 + (7 + 7 + 9 + 7) + 1;
constexpr int SMEM_BYTES = GEMM_LDS + 512;

template <int KIND>
DI void layer_phases(const Params& p, int& ph, const int lo, const int hi, const XcdBarrier& bar, unsigned char* smem, int bid, int nb, int wid_u) {
    constexpr int L = KIND;
    const float* mod = (const float*)(p.ws + WS_MOD) + (size_t)L * 9 * 6144;
    bf16_t* H = (bf16_t*)(p.ws + WS_H); bf16_t* O = (bf16_t*)(p.ws + WS_O); bf16_t* RAW = (bf16_t*)(p.ws + WS_RAW);
    bf16_t* Q = (bf16_t*)(p.ws + WS_Q); bf16_t* Kb = (bf16_t*)(p.ws + WS_K);
#ifndef AABL
#define AABL 0
#endif
#ifndef GPROBE
#define GPROBE 0
#endif
#ifndef DUP_MASK
#define DUP_MASK 0ull
#endif
#define PHASE2(BODY, DUPBODY) do { if (lo <= ph && ph < hi) { const int tid = (wid_u << 6) | lane_now(); if ((DUP_MASK >> ph) & 1ull) { DUPBODY; xcd_barrier(bar, tid == 0); } BODY; } if (lo <= ph && ph + 1 < hi) xcd_barrier(bar, ((wid_u << 6) | lane_now()) == 0); ++ph; } while (0)
#define PHASE(...) PHASE2((__VA_ARGS__), (__VA_ARGS__))
    if (L == 0) PHASE(phase_rows<2 | 8 | 32>(p, L, 0, bid, nb, tid), phase_router_prep(p, bid, nb, tid));
    else PHASE2((phase_rows<3 | 32>(p, L, 0, bid, nb, tid)), (phase_rows<2 | 32>(p, L, 0, bid, nb, tid)));
    AttnP a{};
    if (KIND == 0) {
        PHASE(gemm_qkv_x<0>(p, smem, (const bf16_t*)(p.ws + W_QKV0), 3072, p.in[15], p.in[16], bid, nb, tid));
        a = AttnP{Q, 1024, Kb, 1024, RAW + 2048, 3072, O, 1024, 16, 0, 0, 64, p.in[17], nullptr, 1, p.in[16]};
        PHASE(attn_na(a, smem, bid, nb, tid));
        PHASE2((gemm_dense_x<3>(p, smem, O, 512, (const bf16_t*)(p.ws + W_O0), 512, 1024, nullptr, 0, mod, bid, nb, tid)), (gemm_dense_x<0>(p, smem, O, 1024, (const bf16_t*)(p.ws + W_O0), 1024, 1024, RAW, 1024, nullptr, bid, nb, tid)));
    } else if (KIND == 1) {
        PHASE(gemm_qkv_x<1>(p, smem, (const bf16_t*)(p.ws + W_QKV1), 1536, p.in[20], p.in[21], bid, nb, tid));
        a = AttnP{Q, 1024, Kb, 256, RAW + 1280, 1536, O, 1024, 16, 2, 2, 64, nullptr, p.in[22], 1};
        PHASE(attn_mfma<64, 64, 1>(a, smem, bid, nb, tid));
        PHASE2((gemm_dense_x<3>(p, smem, O, 512, (const bf16_t*)(p.ws + W_O1), 512, 1024, nullptr, 0, mod, bid, nb, tid)), (gemm_dense_x<0>(p, smem, O, 1024, (const bf16_t*)(p.ws + W_O1), 1024, 1024, RAW, 1024, nullptr, bid, nb, tid)));
    } else if (KIND == 2) {
        bf16_t* cqn = O; bf16_t* ckvn = O + (size_t)MROWS * 384;
        PHASE(gemm_dense_x<2>(p, smem, H, 512, (const bf16_t*)(p.ws + W_DQKV), 512, 768, Q, 768, nullptr, bid, nb, tid));
        PHASE(phase_post_mla1(p, bid, nb, tid));
        PHASE(gemm_mla_x<true>(p, smem, bid, nb, tid), gemm_mla_x<false>(p, smem, bid, nb, (wid_u << 6) | lane_now()));
        a = AttnP{Q, 1536, Kb, 1536, RAW, 1024, O, 1024, 16, 0, 0, 64, nullptr, nullptr, 1};
        PHASE(attn_mfma<96, 64, 2>(a, smem, bid, nb, tid));
        PHASE2((gemm_dense_x<3>(p, smem, O, 512, (const bf16_t*)(p.ws + W_O2), 512, 1024, nullptr, 0, mod, bid, nb, tid)), (gemm_dense_x<0>(p, smem, O, 1024, (const bf16_t*)(p.ws + W_O2), 1024, 1024, RAW, 1024, nullptr, bid, nb, tid)));
    } else {
        PHASE(gemm_qkv_x<3>(p, smem, (const bf16_t*)(p.ws + W_QKV3), 3072, p.in[32], p.in[33], bid, nb, tid));
        a = AttnP{Q, 1024, Kb, 1024, RAW + 2048, 3072, H  , 2048, 16, 0, 1, 128, nullptr, nullptr, 0, nullptr, p.in[34], p.in[35], (unsigned char*)RAW  , 6144};
        PHASE(attn_mfma<64, 128, 2>(a, smem, bid, nb, tid));
        PHASE(gemm_dense_x<3>(p, smem, RAW, 3072, (const bf16_t*)(p.ws + W_O3), 512, 1024, nullptr, 0, mod, bid, nb, tid, true));
    }
    PHASE(phase_router(p, smem, L, L == 3, bid, nb, tid));
    PHASE(gemm_moe_x<0>(p, smem, L, bid, nb, tid));
    PHASE(gemm_moe_x<1>(p, smem, L, bid, nb, tid));
}

__global__ void __launch_bounds__(NTHREADS, 2) mega(Params p, int lo, int hi) {
    extern __shared__ __attribute__((aligned(16))) unsigned char smem[];
    const int bid = blockIdx.x, nb = gridDim.x, wid_u = __builtin_amdgcn_readfirstlane(threadIdx.x >> 6);
    float* lds = (float*)smem;
    volatile LAS unsigned* xbw = (volatile LAS unsigned*)(smem + SMEM_BYTES - 16);
    if (threadIdx.x == 0) { xbw[0] = 0u; xbw[1] = 0u; }
    __syncthreads();
    XcdBarrier bar = xcd_barrier_post((unsigned*)(p.ws + WS_CTL), xbw);
    int ph = 0;
    PHASE(phase_prologue(p, lds, bid, nb, tid));
    PHASE(phase_mod_reduce(p, bid, nb, tid));
    layer_phases<0>(p, ph, lo, hi, bar, smem, bid, nb, wid_u);
    layer_phases<1>(p, ph, lo, hi, bar, smem, bid, nb, wid_u);
    layer_phases<2>(p, ph, lo, hi, bar, smem, bid, nb, wid_u);
    layer_phases<3>(p, ph, lo, hi, bar, smem, bid, nb, wid_u);
    PHASE2((phase_rows<1 | 16>(p, 3, 0, bid, nb, tid)), (void)0);
}

extern "C" void kernel_launch(void* const* d_in, const int* in_sizes, int n_in, void* d_out, int out_size, void* d_ws, size_t ws_size, hipStream_t stream) {
    (void)in_sizes; (void)out_size;
    if (n_in < 37 || ws_size < WS_END) { fprintf(stderr, "kernel_launch: unexpected inputs (n_in %d, ws %zu)\n", n_in, ws_size); return; }
    static int grid = 0;
    if (!grid) {
        int dev = 0, cus = 0, per_cu = 0;
        hipGetDevice(&dev);
        hipDeviceGetAttribute(&cus, hipDeviceAttributeMultiprocessorCount, dev);
        hipFuncSetAttribute((const void*)mega, hipFuncAttributeMaxDynamicSharedMemorySize, SMEM_BYTES);
        hipOccupancyMaxActiveBlocksPerMultiprocessor(&per_cu, mega, NTHREADS, SMEM_BYTES);
        if (per_cu < 1) per_cu = 1;
        grid = cus * (per_cu < 1 ? per_cu : 1);
    }
    Params p{};
    for (int i = 0; i < 37; ++i) p.in[i] = (const float*)d_in[i];
    p.out = (float*)d_out; p.ws = (unsigned char*)d_ws;
    hipMemsetAsync(p.ws + WS_CTL, 0, 65536, stream);
#if ONE_LAUNCH
    hipLaunchKernelGGL(mega, dim3(grid), dim3(NTHREADS), SMEM_BYTES, stream, p, 0, NPHASES);
#else
    for (int k = 0; k < NPHASES; ++k) hipLaunchKernelGGL(mega, dim3(grid), dim3(NTHREADS), SMEM_BYTES, stream, p, k, k + 1);
#endif
}
```

```cpp
#include <hip/hip_runtime.h>
#include <stdint.h>
#include <stdio.h>

#ifndef ONE_LAUNCH
#define ONE_LAUNCH 1
#endif

#define DI __device__ __forceinline__
typedef unsigned short bf16_t;
typedef short bf16x8 __attribute__((ext_vector_type(8)));
typedef float f32x4 __attribute__((ext_vector_type(4)));
typedef float f32x16 __attribute__((ext_vector_type(16)));
typedef unsigned u32x4 __attribute__((ext_vector_type(4)));
typedef unsigned u32x2 __attribute__((ext_vector_type(2)));

constexpr int DM = 1024, NBATCH = 8, SEQ = 4096, CTXL = 256, PP = SEQ + CTXL, MROWS = NBATCH * PP;
constexpr int NEXP = 32, DEXP = 256;
constexpr float EPS = 1e-6f, LOG2E = 1.4426950408889634f;
constexpr int NTHREADS = 512, NW = NTHREADS / 64;

constexpr size_t MiB = 1ull << 20;
constexpr size_t WS_RAW_FWD = 380ull << 20;
constexpr size_t WS_CTL = 0, CTL_BYTES = 1 * MiB;
constexpr size_t WS_MOD = 1 * MiB;
constexpr size_t WS_MODP = WS_RAW_FWD;
constexpr size_t WS_XCTX = 9 * MiB;
constexpr size_t WS_LIST = 17 * MiB;
constexpr size_t WS_GATE = 22 * MiB;
constexpr size_t WS_W = 24 * MiB;
constexpr size_t W_QKV0 = WS_W + 0 * MiB, W_O0 = WS_W + 6 * MiB, W_QKV1 = WS_W + 8 * MiB, W_O1 = WS_W + 11 * MiB, W_DQKV = WS_W + 13 * MiB,
                 W_UQ = WS_W + 15 * MiB, W_UKV = WS_W + 17 * MiB, W_O2 = WS_W + 18 * MiB, W_QKV3 = WS_W + 20 * MiB, W_O3 = WS_W + 26 * MiB,
                 W_GU = WS_W + 28 * MiB, W_DN = WS_W + 156 * MiB;
constexpr size_t WS_H = 244 * MiB;
constexpr size_t WS_O = 312 * MiB;
constexpr size_t WS_RAW = 380 * MiB;
constexpr size_t WS_Q = 620 * MiB;
constexpr size_t WS_K = 722 * MiB;
constexpr size_t WS_XB = 824 * MiB;
constexpr size_t WS_END = 892 * MiB;
constexpr int CW_CNT = 4096;

constexpr size_t WS_RW = 2 * MiB;
struct Params { const float* in[37]; float* out; unsigned char* ws; };

DI unsigned f2bf(float f) { unsigned u = __float_as_uint(f); return (u + 0x7fffu + ((u >> 16) & 1u)) >> 16; }
DI float bf2f(unsigned h) { return __uint_as_float(h << 16); }
DI unsigned pk2(float lo, float hi) { return f2bf(lo) | (f2bf(hi) << 16); }
DI float bflo(unsigned w) { return __uint_as_float(w << 16); }
DI float bfhi(unsigned w) { return __uint_as_float(w & 0xffff0000u); }
DI int lane_now() { unsigned lane; asm volatile("v_mbcnt_lo_u32_b32 %0, -1, 0\n\tv_mbcnt_hi_u32_b32 %0, -1, %0" : "=v"(lane)); return (int)lane; }
DI float wave_sum(float v) {
#pragma unroll
    for (int o = 32; o > 0; o >>= 1) v += __shfl_xor(v, o);
    return v;
}
DI float silu_f(float x) { return x / (1.0f + __expf(-x)); }
DI void unpack8(const u32x4 w, float (&f)[8]) {
    f[0] = bflo(w.x); f[1] = bfhi(w.x); f[2] = bflo(w.y); f[3] = bfhi(w.y); f[4] = bflo(w.z); f[5] = bfhi(w.z); f[6] = bflo(w.w); f[7] = bfhi(w.w);
}
DI u32x4 pack8(const float (&f)[8]) { u32x4 w; w.x = pk2(f[0], f[1]); w.y = pk2(f[2], f[3]); w.z = pk2(f[4], f[5]); w.w = pk2(f[6], f[7]); return w; }
DI float* xrow_ptr(const Params& p, int r) {
    const int b = r / PP, pos = r - b * PP;
    return pos < SEQ ? p.out + ((size_t)b * SEQ + pos) * DM : (float*)(p.ws + WS_XCTX) + ((size_t)b * CTXL + (pos - SEQ)) * DM;
}
DI bf16_t* xb_row(const Params& p, int r) { return (bf16_t*)(p.ws + WS_XB) + (size_t)r * DM; }
DI int mod_row(int r) { const int b = r / PP, pos = r - b * PP; return pos < SEQ ? b : 8; }
__device__ const float ROPE64[2048] = {
  1.000000000e+00f, 0.000000000e+00f, 1.000000000e+00f, 0.000000000e+00f, 1.000000000e+00f, 0.000000000e+00f, 1.000000000e+00f, 0.000000000e+00f,
  1.000000000e+00f, 0.000000000e+00f, 1.000000000e+00f, 0.000000000e+00f, 1.000000000e+00f, 0.000000000e+00f, 1.000000000e+00f, 0.000000000e+00f,
  1.000000000e+00f, 0.000000000e+00f, 1.000000000e+00f, 0.000000000e+00f, 1.000000000e+00f, 0.000000000e+00f, 1.000000000e+00f, 0.000000000e+00f,
  1.000000000e+00f, 0.000000000e+00f, 1.000000000e+00f, 0.000000000e+00f, 1.000000000e+00f, 0.000000000e+00f, 1.000000000e+00f, 0.000000000e+00f,
  5.403022766e-01f, 8.414709568e-01f, 8.460091352e-01f, 5.331684351e-01f, 9.504152536e-01f, 3.109835982e-01f, 9.842302203e-01f, 1.768921912e-01f,
  9.950041771e-01f, 9.983342141e-02f, 9.984192848e-01f, 5.620449781e-02f, 9.995000362e-01f, 3.161750361e-02f, 9.998418689e-01f, 1.778185740e-02f,
  9.999499917e-01f, 9.999833070e-03f, 9.999842048e-01f, 5.623383448e-03f, 9.999949932e-01f, 3.162272274e-03f, 9.999983907e-01f, 1.778278500e-03f,
  9.999995232e-01f, 9.999999311e-04f, 9.999998212e-01f, 5.623412435e-04f, 9.999999404e-01f, 3.162277571e-04f, 1.000000000e+00f, 1.778279402e-04f,
  -4.161468446e-01f, 9.092974067e-01f, 4.314628243e-01f, 9.021307230e-01f, 8.065783978e-01f, 5.911270976e-01f, 9.374182820e-01f, 3.482052684e-01f,
  9.800665975e-01f, 1.986693293e-01f, 9.936820865e-01f, 1.122313142e-01f, 9.980006814e-01f, 6.320339441e-02f, 9.993675947e-01f, 3.555808961e-02f,
  9.998000264e-01f, 1.999866590e-02f, 9.999367595e-01f, 1.124658901e-02f, 9.999799728e-01f, 6.324512884e-03f, 9.999936819e-01f, 3.556551412e-03f,
  9.999979734e-01f, 1.999998698e-03f, 9.999993443e-01f, 1.124682371e-03f, 9.999998212e-01f, 6.324554561e-04f, 9.999999404e-01f, 3.556558804e-04f,
  -9.899924994e-01f, 1.411200017e-01f, -1.159661636e-01f, 9.932531714e-01f, 5.827536583e-01f, 8.126488924e-01f, 8.610406518e-01f, 5.085361004e-01f,
  9.553365111e-01f, 2.955202162e-01f, 9.858034849e-01f, 1.679033041e-01f, 9.955033660e-01f, 9.472608566e-02f, 9.985772967e-01f, 5.332308263e-02f,
  9.995500445e-01f, 2.999549918e-02f, 9.998577237e-01f, 1.686943881e-02f, 9.999549985e-01f, 9.486690164e-03f, 9.999857545e-01f, 5.334813148e-03f,
  9.999955297e-01f, 2.999995602e-03f, 9.999985695e-01f, 1.687023090e-03f, 9.999995232e-01f, 9.486831259e-04f, 9.999998808e-01f, 5.334838061e-04f,
  -6.536436081e-01f, -7.568024993e-01f, -6.276797056e-01f, 7.784717083e-01f, 3.011374772e-01f, 9.535807371e-01f, 7.575061917e-01f, 6.528279781e-01f,
  9.210609794e-01f, 3.894183338e-01f, 9.748082757e-01f, 2.230444849e-01f, 9.920106530e-01f, 1.261540651e-01f, 9.974712729e-01f, 7.107120752e-02f,
  9.992001057e-01f, 3.998933360e-02f, 9.997470379e-01f, 2.249175683e-02f, 9.999200106e-01f, 1.264877338e-02f, 9.999747276e-01f, 7.113057654e-03f,
  9.999920130e-01f, 3.999989480e-03f, 9.999974966e-01f, 2.249363344e-03f, 9.999992251e-01f, 1.264910679e-03f, 9.999997616e-01f, 7.113117026e-04f,
  2.836622000e-01f, -9.589242935e-01f, -9.460792542e-01f, 3.239352703e-01f, -1.034233812e-02f, 9.999465346e-01f, 6.300802827e-01f, 7.765299678e-01f,
  8.775825500e-01f, 4.794255495e-01f, 9.607312679e-01f, 2.774805427e-01f, 9.875259995e-01f, 1.574558765e-01f, 9.960497618e-01f, 8.879686147e-02f,
  9.987502694e-01f, 4.997916520e-02f, 9.996047616e-01f, 2.811336145e-02f, 9.998750091e-01f, 1.581072807e-02f, 9.999604821e-01f, 8.891279809e-03f,
  9.999874830e-01f, 4.999979399e-03f, 9.999960661e-01f, 2.811702900e-03f, 9.999987483e-01f, 1.581138116e-03f, 9.999995828e-01f, 8.891395992e-04f,
  9.601702690e-01f, -2.794154882e-01f, -9.731037021e-01f, -2.303675115e-01f, -3.207964003e-01f, 9.471482038e-01f, 4.827820361e-01f, 8.757405281e-01f,
  8.253356218e-01f, 5.646424890e-01f, 9.436169863e-01f, 3.310393095e-01f, 9.820539355e-01f, 1.886002719e-01f, 9.943132997e-01f, 1.064944416e-01f,
  9.982005358e-01f, 5.996400490e-02f, 9.994308352e-01f, 3.373407945e-02f, 9.998199940e-01f, 1.897252724e-02f, 9.999430776e-01f, 1.066947449e-02f,
  9.999819994e-01f, 5.999964196e-03f, 9.999943376e-01f, 3.374041524e-03f, 9.999982119e-01f, 1.897365320e-03f, 9.999994040e-01f, 1.066967379e-03f,
  7.539022565e-01f, 6.569865942e-01f, -7.004297972e-01f, -7.137212753e-01f, -5.994374752e-01f, 8.004215956e-01f, 3.202570081e-01f, 9.473307133e-01f,
  7.648422122e-01f, 6.442176700e-01f, 9.235194325e-01f, 3.835515678e-01f, 9.755998850e-01f, 2.195560932e-01f, 9.922624230e-01f, 1.241583377e-01f,
  9.975510240e-01f, 6.994284689e-02f, 9.992253184e-01f, 3.935372457e-02f, 9.997550249e-01f, 2.213413455e-02f, 9.999225140e-01f, 1.244763471e-02f,
  9.999755025e-01f, 6.999942940e-03f, 9.999922514e-01f, 3.936378751e-03f, 9.999975562e-01f, 2.213592408e-03f, 9.999992251e-01f, 1.244795276e-03f,
  -1.455000341e-01f, 9.893582463e-01f, -2.120364457e-01f, -9.772617817e-01f, -8.186324239e-01f, 5.743177533e-01f, 1.476312131e-01f, 9.890424609e-01f,
  6.967067122e-01f, 7.173560858e-01f, 9.005023241e-01f, 4.348512292e-01f, 9.681702852e-01f, 2.502923310e-01f, 9.898977876e-01f, 1.417829692e-01f,
  9.968017340e-01f, 7.991468906e-02f, 9.989882708e-01f, 4.497213289e-02f, 9.996800423e-01f, 2.529552206e-02f, 9.998987913e-01f, 1.422575582e-02f,
  9.999679923e-01f, 7.999914698e-03f, 9.999898672e-01f, 4.498715047e-03f, 9.999967813e-01f, 2.529819263e-03f, 9.999989867e-01f, 1.422623056e-03f,
  -9.111302495e-01f, 4.121184945e-01f, 3.416602612e-01f, -9.398235083e-01f, -9.566441774e-01f, 2.912592292e-01f, -2.965079620e-02f, 9.995602965e-01f,
  6.216099262e-01f, 7.833269238e-01f, 8.746382594e-01f, 4.847761393e-01f, 9.597726464e-01f, 2.807783186e-01f, 9.872201085e-01f, 1.593627781e-01f,
  9.959527254e-01f, 8.987854421e-02f, 9.987195730e-01f, 5.058911815e-02f, 9.995950460e-01f, 2.845665626e-02f, 9.998719096e-01f, 1.600383036e-02f,
  9.999595284e-01f, 8.999879472e-03f, 9.999871850e-01f, 5.061050411e-03f, 9.999959469e-01f, 2.846045885e-03f, 9.999987483e-01f, 1.600450720e-03f,
  -8.390715122e-01f, -5.440211296e-01f, 7.901318669e-01f, -6.129369140e-01f, -9.997860789e-01f, -2.068356983e-02f, -2.059976310e-01f, 9.785524607e-01f,
  5.403022766e-01f, 8.414709568e-01f, 8.460091352e-01f, 5.331684351e-01f, 9.504153132e-01f, 3.109835684e-01f, 9.842302203e-01f, 1.768921912e-01f,
  9.950041771e-01f, 9.983341396e-02f, 9.984192848e-01f, 5.620449781e-02f, 9.995000362e-01f, 3.161750361e-02f, 9.998418689e-01f, 1.778185740e-02f,
  9.999499917e-01f, 9.999834001e-03f, 9.999842048e-01f, 5.623383448e-03f, 9.999949932e-01f, 3.162272274e-03f, 9.999983907e-01f, 1.778278500e-03f,
  4.425697960e-03f, -9.999902248e-01f, 9.952573776e-01f, -9.727645665e-02f, -9.437797666e-01f, -3.305749595e-01f, -3.758473992e-01f, 9.266815782e-01f,
  4.535960853e-01f, 8.912073970e-01f, 8.147053123e-01f, 5.798751712e-01f, 9.401075840e-01f, 3.408778608e-01f, 9.809291363e-01f, 1.943656504e-01f,
  9.939560890e-01f, 1.097782999e-01f, 9.980874062e-01f, 6.181810424e-02f, 9.993950725e-01f, 3.477803990e-02f, 9.998086691e-01f, 1.955982670e-02f,
  9.999395013e-01f, 1.099977922e-02f, 9.999808669e-01f, 6.185714621e-03f, 9.999939203e-01f, 3.478498431e-03f, 9.999980927e-01f, 1.956106164e-03f,
  8.438539505e-01f, -5.365729332e-01f, 8.938615918e-01f, 4.483429790e-01f, -7.941793799e-01f, -6.076834202e-01f, -5.338430405e-01f, 8.455836177e-01f,
  3.623577058e-01f, 9.320390821e-01f, 7.808259130e-01f, 6.247486472e-01f, 9.288598895e-01f, 3.704313040e-01f, 9.773178697e-01f, 2.117776722e-01f,
  9.928086400e-01f, 1.197122037e-01f, 9.977239966e-01f, 6.742975861e-02f, 9.992800951e-01f, 3.793822229e-02f, 9.997723103e-01f, 2.133773454e-02f,
  9.999279976e-01f, 1.199971233e-02f, 9.999772310e-01f, 6.748044398e-03f, 9.999927878e-01f, 3.794723889e-03f, 9.999977350e-01f, 2.133933594e-03f,
  9.074468017e-01f, 4.201670289e-01f, 5.171728730e-01f, 8.558809757e-01f, -5.658205152e-01f, -8.245284557e-01f, -6.750016809e-01f, 7.378162146e-01f,
  2.674987614e-01f, 9.635581970e-01f, 7.444779873e-01f, 6.676470041e-01f, 9.166833758e-01f, 3.996143043e-01f, 9.733975530e-01f, 2.291227132e-01f,
  9.915618896e-01f, 1.296341419e-01f, 9.973290563e-01f, 7.303927839e-02f, 9.991551042e-01f, 4.109803215e-02f, 9.997327924e-01f, 2.311557345e-02f,
  9.999154806e-01f, 1.299963426e-02f, 9.999732971e-01f, 7.310371846e-03f, 9.999915361e-01f, 4.110949114e-03f, 9.999973178e-01f, 2.311761025e-03f,
  1.367372125e-01f, 9.906073809e-01f, -1.879615150e-02f, 9.998233318e-01f, -2.813494802e-01f, -9.596053958e-01f, -7.948709130e-01f, 6.067785621e-01f,
  1.699671596e-01f, 9.854497313e-01f, 7.057763934e-01f, 7.084347010e-01f, 9.035902619e-01f, 4.283977747e-01f, 9.691694379e-01f, 2.463953048e-01f,
  9.902160168e-01f, 1.395431161e-01f, 9.969025850e-01f, 7.864648104e-02f, 9.990201592e-01f, 4.425742477e-02f, 9.996901155e-01f, 2.489333972e-02f,
  9.999020100e-01f, 1.399954315e-02f, 9.999690056e-01f, 7.872696966e-03f, 9.999902248e-01f, 4.427174106e-03f, 9.999969006e-01f, 2.489588689e-03f,
  -7.596879005e-01f, 6.502878666e-01f, -5.489754677e-01f, 8.358384371e-01f, 3.102235124e-02f, -9.995186925e-01f, -8.896704316e-01f, 4.566032588e-01f,
  7.073719800e-02f, 9.974949956e-01f, 6.648434997e-01f, 7.469826341e-01f, 8.895936012e-01f, 4.567528665e-01f, 9.646348357e-01f, 2.635899782e-01f,
  9.887710810e-01f, 1.494381279e-01f, 9.964445233e-01f, 8.425120264e-02f, 9.988752007e-01f, 4.741638154e-02f, 9.996442795e-01f, 2.667102963e-02f,
  9.998875260e-01f, 1.499943808e-02f, 9.999644160e-01f, 8.435020223e-03f, 9.999887347e-01f, 4.743398633e-03f, 9.999964237e-01f, 2.667415887e-03f,
  -9.576594830e-01f, -2.879033089e-01f, -9.100810885e-01f, 4.144302309e-01f, 3.403181732e-01f, -9.403103590e-01f, -9.564100504e-01f, 2.920270860e-01f,
  -2.919954620e-02f, 9.995735884e-01f, 6.218088269e-01f, 7.831690907e-01f, 8.747074604e-01f, 4.846512377e-01f, 9.597951770e-01f, 2.807013094e-01f,
  9.872272611e-01f, 1.593182087e-01f, 9.959549904e-01f, 8.985326439e-02f, 9.987202883e-01f, 5.057485774e-02f, 9.995952845e-01f, 2.844863199e-02f,
  9.998720288e-01f, 1.599931903e-02f, 9.999595284e-01f, 8.997339755e-03f, 9.999871850e-01f, 5.059622694e-03f, 9.999959469e-01f, 2.845243318e-03f,
  -2.751633525e-01f, -9.613974690e-01f, -9.908979535e-01f, -1.346151382e-01f, 6.158648133e-01f, -7.878518701e-01f, -9.929850101e-01f, 1.182405204e-01f,
  -1.288445443e-01f, 9.916648269e-01f, 5.768082738e-01f, 8.168795705e-01f, 8.589466810e-01f, 5.120649934e-01f, 9.546520114e-01f, 2.977238595e-01f,
  9.855847955e-01f, 1.691823453e-01f, 9.954339862e-01f, 9.545248002e-02f, 9.985553622e-01f, 5.373282731e-02f, 9.995430708e-01f, 3.022614494e-02f,
  9.998555183e-01f, 1.699918136e-02f, 9.999542832e-01f, 9.559656493e-03f, 9.999855757e-01f, 5.375845823e-03f, 9.999954104e-01f, 3.023070283e-03f,
  6.603167057e-01f, -7.509872317e-01f, -7.665365338e-01f, -6.422007084e-01f, 8.303361535e-01f, -5.572628975e-01f, -9.982416630e-01f, -5.927551910e-02f,
  -2.272021621e-01f, 9.738476276e-01f, 5.299841762e-01f, 8.480075598e-01f, 8.423270583e-01f, 5.389667153e-01f, 9.492070079e-01f, 3.146522641e-01f,
  9.838436842e-01f, 1.790295690e-01f, 9.948815107e-01f, 1.010486856e-01f, 9.983804226e-01f, 5.689026415e-02f, 9.994877577e-01f, 3.200356290e-02f,
  9.998379946e-01f, 1.799902879e-02f, 9.999487996e-01f, 1.012197044e-02f, 9.999837875e-01f, 5.692068953e-03f, 9.999948740e-01f, 3.200897481e-03f,
  9.887046218e-01f, 1.498772055e-01f, -3.060953915e-01f, -9.520008564e-01f, 9.624637961e-01f, -2.714101076e-01f, -9.720142484e-01f, -2.349217981e-01f,
  -3.232895434e-01f, 9.463000894e-01f, 4.814845920e-01f, 8.764545321e-01f, 8.248651624e-01f, 5.653295517e-01f, 9.434618354e-01f, 3.314811885e-01f,
  9.820042253e-01f, 1.888588965e-01f, 9.942975044e-01f, 1.066416800e-01f, 9.981955290e-01f, 6.004713103e-02f, 9.994292855e-01f, 3.378088027e-02f,
  9.998195171e-01f, 1.899885759e-02f, 9.999428988e-01f, 1.068428159e-02f, 9.999819398e-01f, 6.008291151e-03f, 9.999942780e-01f, 3.378724447e-03f,
  4.080820680e-01f, 9.129452705e-01f, 2.486167252e-01f, -9.686019421e-01f, 9.991443753e-01f, 4.135828838e-02f, -9.151299596e-01f, -4.031589925e-01f,
  -4.161468446e-01f, 9.092974067e-01f, 4.314628243e-01f, 9.021307230e-01f, 8.065784574e-01f, 5.911270380e-01f, 9.374182820e-01f, 3.482052684e-01f,
  9.800665975e-01f, 1.986693144e-01f, 9.936820865e-01f, 1.122313142e-01f, 9.980006814e-01f, 6.320339441e-02f, 9.993675947e-01f, 3.555808961e-02f,
  9.998000264e-01f, 1.999866776e-02f, 9.999367595e-01f, 1.124658901e-02f, 9.999799728e-01f, 6.324512884e-03f, 9.999936819e-01f, 3.556551412e-03f,
  -5.477292538e-01f, 8.366556168e-01f, 7.267602682e-01f, -6.868911982e-01f, 9.367404580e-01f, 3.500247598e-01f, -8.293829560e-01f, -5.586805344e-01f,
  -5.048462152e-01f, 8.632093072e-01f, 3.800770044e-01f, 9.249548316e-01f, 7.874851823e-01f, 6.163335443e-01f, 9.310783744e-01f, 3.648192585e-01f,
  9.780309200e-01f, 2.084598988e-01f, 9.930352569e-01f, 1.178173944e-01f, 9.977958202e-01f, 6.635902822e-02f, 9.993028045e-01f, 3.733518720e-02f,
  9.997795224e-01f, 2.099845745e-02f, 9.999302626e-01f, 1.180889271e-02f, 9.999779463e-01f, 6.640734151e-03f, 9.999930263e-01f, 3.734378144e-03f,
  -9.999608397e-01f, -8.851309307e-03f, 9.810745716e-01f, -1.936302334e-01f, 7.814403772e-01f, 6.239799261e-01f, -7.174774408e-01f, -6.965817213e-01f,
  -5.885011554e-01f, 8.084963560e-01f, 3.274895847e-01f, 9.448547959e-01f, 7.676045895e-01f, 6.409237385e-01f, 9.244439602e-01f, 3.813178837e-01f,
  9.758974314e-01f, 2.182296216e-01f, 9.923570156e-01f, 1.233997419e-01f, 9.975810051e-01f, 6.951400638e-02f, 9.992348552e-01f, 3.911216930e-02f,
  9.997580051e-01f, 2.199822664e-02f, 9.999234676e-01f, 1.237119269e-02f, 9.999758005e-01f, 6.956954487e-03f, 9.999923706e-01f, 3.912204877e-03f,
  -5.328330398e-01f, -8.462204337e-01f, 9.332357645e-01f, 3.592645228e-01f, 5.486452579e-01f, 8.360552788e-01f, -5.829432607e-01f, -8.125128746e-01f,
  -6.662759781e-01f, 7.457052469e-01f, 2.738668323e-01f, 9.617676139e-01f, 7.469564080e-01f, 6.648730636e-01f, 9.175173044e-01f, 3.976959288e-01f,
  9.736663699e-01f, 2.279775143e-01f, 9.916474223e-01f, 1.289781928e-01f, 9.973561764e-01f, 7.266827673e-02f, 9.991636872e-01f, 4.088902473e-02f,
  9.997355342e-01f, 2.299797349e-02f, 9.999163747e-01f, 1.293348987e-02f, 9.999735355e-01f, 7.273174357e-03f, 9.999916553e-01f, 4.090031609e-03f,
  4.241790175e-01f, -9.055783749e-01f, 5.979771614e-01f, 8.015131354e-01f, 2.614416778e-01f, 9.652192593e-01f, -4.300232828e-01f, -9.028177857e-01f,
  -7.373937964e-01f, 6.754631400e-01f, 2.193782777e-01f, 9.756398797e-01f, 7.255613208e-01f, 6.881574988e-01f, 9.103004336e-01f, 4.139482081e-01f,
  9.713379741e-01f, 2.377026230e-01f, 9.909064770e-01f, 1.345525682e-01f, 9.971213937e-01f, 7.582182437e-02f, 9.990894198e-01f, 4.266574979e-02f,
  9.997119904e-01f, 2.399769612e-02f, 9.999089241e-01f, 1.349578146e-02f, 9.999712110e-01f, 7.589393295e-03f, 9.999908805e-01f, 4.267857410e-03f,
  9.912028313e-01f, -1.323517561e-01f, 7.855226099e-02f, 9.969099760e-01f, -5.168933049e-02f, 9.986631870e-01f, -2.635405958e-01f, -9.646483064e-01f,
  -8.011435866e-01f, 5.984721184e-01f, 1.641961634e-01f, 9.864277244e-01f, 7.034407258e-01f, 7.107539177e-01f, 9.027957320e-01f, 4.300695956e-01f,
  9.689124227e-01f, 2.474039644e-01f, 9.901341200e-01f, 1.401226968e-01f, 9.968766570e-01f, 7.897461206e-02f, 9.990119338e-01f, 4.444234073e-02f,
  9.996874928e-01f, 2.499739639e-02f, 9.999011755e-01f, 1.405806933e-02f, 9.999687672e-01f, 7.905611768e-03f, 9.999901056e-01f, 4.445684142e-03f,
  6.469193101e-01f, 7.625584602e-01f, -4.650644958e-01f, 8.852767944e-01f, -3.596943319e-01f, 9.330701828e-01f, -8.874550462e-02f, -9.960543513e-01f,
  -8.568888307e-01f, 5.155012608e-01f, 1.084949449e-01f, 9.940969944e-01f, 6.806167960e-01f, 7.326396108e-01f, 8.950055838e-01f, 4.460549951e-01f,
  9.663899541e-01f, 2.570805550e-01f, 9.893305302e-01f, 1.456883848e-01f, 9.966219068e-01f, 8.212661743e-02f, 9.989313483e-01f, 4.621879384e-02f,
  9.996620417e-01f, 2.599707060e-02f, 9.998931289e-01f, 1.462035347e-02f, 9.999662042e-01f, 8.221829310e-03f, 9.999893308e-01f, 4.623509943e-03f,
  -2.921388149e-01f, 9.563759565e-01f, -8.654506207e-01f, 5.009942055e-01f, -6.320286393e-01f, 7.749450207e-01f, 8.884811401e-02f, -9.960451722e-01f,
  -9.040721655e-01f, 4.273798466e-01f, 5.245061591e-02f, 9.986234903e-01f, 6.571123004e-01f, 7.537927032e-01f, 8.869323730e-01f, 4.618993104e-01f,
  9.637709260e-01f, 2.667314112e-01f, 9.884956479e-01f, 1.512494683e-01f, 9.963572025e-01f, 8.527779579e-02f, 9.988475442e-01f, 4.799510166e-02f,
  9.996355176e-01f, 2.699672058e-02f, 9.998847246e-01f, 1.518263202e-02f, 9.999635220e-01f, 8.538045920e-03f, 9.999884963e-01f, 4.801335745e-03f,
  -9.626058936e-01f, 2.709057927e-01f, -9.992933869e-01f, -3.758566082e-02f, -8.416849375e-01f, 5.399689674e-01f, 2.636395097e-01f, -9.646213055e-01f,
  -9.422222972e-01f, 3.349882066e-01f, -3.759419080e-03f, 9.999929070e-01f, 6.329506636e-01f, 7.741920948e-01f, 8.785787225e-01f, 4.775975943e-01f,
  9.610554576e-01f, 2.763556540e-01f, 9.876294732e-01f, 1.568057537e-01f, 9.960825443e-01f, 8.842811733e-02f, 9.987606406e-01f, 4.977125302e-02f,
  9.996080399e-01f, 2.799634263e-02f, 9.998760223e-01f, 1.574490592e-02f, 9.999607801e-01f, 8.854261599e-03f, 9.999876022e-01f, 4.979162011e-03f,
  -7.480575442e-01f, -6.636338830e-01f, -8.253716230e-01f, -5.645897985e-01f, -9.678714871e-01f, 2.514453232e-01f, 4.301158488e-01f, -9.027736783e-01f,
  -9.709581733e-01f, 2.392492294e-01f, -5.995756760e-02f, 9.982009530e-01f, 6.081562042e-01f, 7.938174009e-01f, 8.699471951e-01f, 4.931448400e-01f,
  9.582439065e-01f, 2.859522104e-01f, 9.867320657e-01f, 1.623570919e-01f, 9.957979321e-01f, 9.157756716e-02f, 9.986705780e-01f, 5.154724792e-02f,
  9.995795488e-01f, 2.899593674e-02f, 9.998670220e-01f, 1.630717516e-02f, 9.999579787e-01f, 9.170476347e-03f, 9.999867082e-01f, 5.156987347e-03f,
  1.542514563e-01f, -9.880316257e-01f, -3.972518742e-01f, -9.177096486e-01f, -9.980752468e-01f, -6.201484054e-02f, 5.830269456e-01f, -8.124528527e-01f,
  -9.899924994e-01f, 1.411200017e-01f, -1.159661636e-01f, 9.932531714e-01f, 5.827536583e-01f, 8.126488924e-01f, 8.610406518e-01f, 5.085361004e-01f,
  9.553365111e-01f, 2.955201864e-01f, 9.858034849e-01f, 1.679033041e-01f, 9.955033660e-01f, 9.472609311e-02f, 9.985772967e-01f, 5.332308263e-02f,
  9.995500445e-01f, 2.999550104e-02f, 9.998577237e-01f, 1.686943881e-02f, 9.999549985e-01f, 9.486690164e-03f, 9.999857545e-01f, 5.334813148e-03f,
  9.147423506e-01f, -4.040376544e-01f, 1.532154828e-01f, -9.881927967e-01f, -9.293003082e-01f, -3.693250120e-01f, 7.175492048e-01f, -6.965078115e-01f,
  -9.991351366e-01f, 4.158052057e-02f, -1.716081351e-01f, 9.851652980e-01f, 5.567683578e-01f, 8.306677938e-01f, 8.518617749e-01f, 5.237666368e-01f,
  9.523335695e-01f, 3.050586283e-01f, 9.848436713e-01f, 1.734442115e-01f, 9.951988459e-01f, 9.787366539e-02f, 9.984809160e-01f, 5.509874597e-02f,
  9.995195270e-01f, 3.099503554e-02f, 9.998480678e-01f, 1.743169688e-02f, 9.999519587e-01f, 9.802903049e-03f, 9.999848008e-01f, 5.512638018e-03f,
  8.342233896e-01f, 5.514267087e-01f, 6.564951539e-01f, -7.543302178e-01f, -7.683671117e-01f, -6.400094032e-01f, 8.294403553e-01f, -5.585952997e-01f,
  -9.982947707e-01f, -5.837419257e-02f, -2.267075777e-01f, 9.739628434e-01f, 5.302263498e-01f, 8.478561044e-01f, 8.424135447e-01f, 5.388315320e-01f,
  9.492354393e-01f, 3.145665526e-01f, 9.838528037e-01f, 1.789796203e-01f, 9.948843718e-01f, 1.010202691e-01f, 9.983813763e-01f, 5.687423423e-02f,
  9.994880557e-01f, 3.199454024e-02f, 9.998381138e-01f, 1.799395122e-02f, 9.999487996e-01f, 1.011911593e-02f, 9.999837875e-01f, 5.690463353e-03f,
  -1.327674743e-02f, 9.999118447e-01f, 9.575860500e-01f, -2.881473899e-01f, -5.312352777e-01f, -8.472243547e-01f, 9.151713848e-01f, -4.030649364e-01f,
  -9.874798059e-01f, -1.577456445e-01f, -2.810903192e-01f, 9.596813321e-01f, 5.031541586e-01f, 8.641966581e-01f, 8.326989412e-01f, 5.537260175e-01f,
  9.460423589e-01f, 3.240430057e-01f, 9.828307629e-01f, 1.845093668e-01f, 9.945599437e-01f, 1.041658595e-01f, 9.982786179e-01f, 5.864954367e-02f,
  9.994555712e-01f, 3.299400955e-02f, 9.998278022e-01f, 1.855619811e-02f, 9.999455214e-01f, 1.043532696e-02f, 9.999827743e-01f, 5.868288688e-03f,
  -8.485702872e-01f, 5.290827155e-01f, 9.637575150e-01f, 2.667797208e-01f, -2.414211184e-01f, -9.704204202e-01f, 9.720383286e-01f, -2.348221242e-01f,
  -9.667981863e-01f, -2.555412054e-01f, -3.345843852e-01f, 9.423658252e-01f, 4.755789042e-01f, 8.796730638e-01f, 8.227210045e-01f, 5.684453845e-01f,
  9.427546859e-01f, 3.334870934e-01f, 9.817776680e-01f, 1.900332868e-01f, 9.942255616e-01f, 1.073104069e-01f, 9.981727600e-01f, 6.042466685e-02f,
  9.994220734e-01f, 3.399345279e-02f, 9.998172522e-01f, 1.911843941e-02f, 9.999421835e-01f, 1.075153705e-02f, 9.999817014e-01f, 6.046113092e-03f,
  -9.036921859e-01f, -4.281826615e-01f, 6.731102467e-01f, 7.395421267e-01f, 7.233466953e-02f, -9.973804355e-01f, 9.982477427e-01f, -5.917267874e-02f,
  -9.364566803e-01f, -3.507832289e-01f, -3.870206773e-01f, 9.220710397e-01f, 4.475280643e-01f, 8.942698836e-01f, 8.124829531e-01f, 5.829849839e-01f,
  9.393727183e-01f, 3.428978026e-01f, 9.806935191e-01f, 1.955512017e-01f, 9.938812256e-01f, 1.104538813e-01f, 9.980637431e-01f, 6.219960377e-02f,
  9.993875623e-01f, 3.499285504e-02f, 9.998063445e-01f, 1.968067512e-02f, 9.999387264e-01f, 1.106774528e-02f, 9.999806285e-01f, 6.223937962e-03f,
  -1.279636919e-01f, -9.917788506e-01f, 1.751565337e-01f, 9.845405817e-01f, 3.789161742e-01f, -9.254310131e-01f, 9.929728508e-01f, 1.183425859e-01f,
  -8.967583776e-01f, -4.425205588e-01f, -4.382335544e-01f, 8.988611698e-01f, 4.190297425e-01f, 9.079725146e-01f, 8.019878864e-01f, 5.973402858e-01f,
  9.358968139e-01f, 3.522742093e-01f, 9.795783162e-01f, 2.010629177e-01f, 9.935269952e-01f, 1.135962531e-01f, 9.979515672e-01f, 6.397433579e-02f,
  9.993520975e-01f, 3.599222749e-02f, 9.997950792e-01f, 2.024290524e-02f, 9.999352098e-01f, 1.138395350e-02f, 9.999794960e-01f, 6.401761901e-03f,
  7.654140592e-01f, -6.435381174e-01f, -3.767423034e-01f, 9.263181090e-01f, 6.479216814e-01f, -7.617069483e-01f, 9.563800097e-01f, 2.921253741e-01f,
  -8.481000066e-01f, -5.298361778e-01f, -4.880608618e-01f, 8.728095889e-01f, 3.901124299e-01f, 9.207672477e-01f, 7.912392616e-01f, 6.115067005e-01f,
  9.323273301e-01f, 3.616154492e-01f, 9.784321785e-01f, 2.065682709e-01f, 9.931628108e-01f, 1.167374924e-01f, 9.978361726e-01f, 6.574887782e-02f,
  9.993155599e-01f, 3.699155897e-02f, 9.997835755e-01f, 2.080512606e-02f, 9.999315739e-01f, 1.170015987e-02f, 9.999783635e-01f, 6.579586305e-03f,
  9.550736547e-01f, 2.963685691e-01f, -8.126112223e-01f, 5.828061700e-01f, 8.526731133e-01f, -5.224447846e-01f, 8.896234632e-01f, 4.566946924e-01f,
  -7.909677625e-01f, -6.118578315e-01f, -5.363451838e-01f, 8.439987302e-01f, 3.608050346e-01f, 9.326412678e-01f, 7.802404165e-01f, 6.254796982e-01f,
  9.286646247e-01f, 3.709204793e-01f, 9.772551060e-01f, 2.120671123e-01f, 9.927886724e-01f, 1.198775545e-01f, 9.977176785e-01f, 6.752320379e-02f,
  9.992780685e-01f, 3.799085692e-02f, 9.997717142e-01f, 2.136734314e-02f, 9.999278188e-01f, 1.201636530e-02f, 9.999771714e-01f, 6.757410709e-03f,
  2.666429281e-01f, 9.637953639e-01f, -9.982103705e-01f, 5.980031565e-02f, 9.728653431e-01f, -2.313720137e-01f, 7.948083878e-01f, 6.068604589e-01f,
  -7.259322405e-01f, -6.877662539e-01f, -5.829339027e-01f, 8.125196099e-01f, 3.311368525e-01f, 9.435827136e-01f, 7.689949274e-01f, 6.392549276e-01f,
  9.249090552e-01f, 3.801884055e-01f, 9.760470986e-01f, 2.175592482e-01f, 9.924046397e-01f, 1.230164245e-01f, 9.975960255e-01f, 6.929731369e-02f,
  9.992396235e-01f, 3.899011388e-02f, 9.997594953e-01f, 2.192955278e-02f, 9.999239445e-01f, 1.233256981e-02f, 9.999759793e-01f, 6.935234182e-03f,
  -6.669380665e-01f, 7.451131344e-01f, -8.763794303e-01f, -4.816212952e-01f, 9.965789914e-01f, 8.264580369e-02f, 6.749256253e-01f, 7.378857136e-01f,
  -6.536436081e-01f, -7.568024993e-01f, -6.276797056e-01f, 7.784717083e-01f, 3.011375964e-01f, 9.535806775e-01f, 7.575061917e-01f, 6.528279781e-01f,
  9.210609794e-01f, 3.894183338e-01f, 9.748082757e-01f, 2.230444849e-01f, 9.920106530e-01f, 1.261540651e-01f, 9.974712729e-01f, 7.107120752e-02f,
  9.992001057e-01f, 3.998933733e-02f, 9.997470379e-01f, 2.249175683e-02f, 9.999200106e-01f, 1.264877338e-02f, 9.999747276e-01f, 7.113057654e-03f,
  -9.873392582e-01f, -1.586226672e-01f, -4.846394062e-01f, -8.747140169e-01f, 9.214623570e-01f, 3.884676993e-01f, 5.337560773e-01f, 8.456384540e-01f,
  -5.748240352e-01f, -8.182770610e-01f, -6.704410911e-01f, 7.419627905e-01f, 2.708370686e-01f, 9.626252055e-01f, 7.457779050e-01f, 6.661946774e-01f,
  9.171208143e-01f, 3.986093104e-01f, 9.735385776e-01f, 2.285226882e-01f, 9.916067719e-01f, 1.292904317e-01f, 9.973433018e-01f, 7.284487784e-02f,
  9.991596341e-01f, 4.098851606e-02f, 9.997342229e-01f, 2.305394970e-02f, 9.999159575e-01f, 1.296497509e-02f, 9.999734163e-01f, 7.290880661e-03f,
  -3.999853134e-01f, -9.165215492e-01f, 5.636094138e-02f, -9.984104633e-01f, 7.549653649e-01f, 6.557646990e-01f, 3.757521510e-01f, 9.267202020e-01f,
  -4.902605712e-01f, -8.715758920e-01f, -7.110829353e-01f, 7.031081319e-01f, 2.402658761e-01f, 9.707071185e-01f, 7.338138223e-01f, 6.793506742e-01f,
  9.130889177e-01f, 4.077604413e-01f, 9.722381234e-01f, 2.339936644e-01f, 9.911929369e-01f, 1.324255317e-01f, 9.972121716e-01f, 7.461831719e-02f,
  9.991181493e-01f, 4.198765755e-02f, 9.997211099e-01f, 2.361613885e-02f, 9.999117851e-01f, 1.328117587e-02f, 9.999721050e-01f, 7.468704134e-03f,
  5.551133156e-01f, -8.317747712e-01f, 5.800031424e-01f, -8.146142364e-01f, 5.135984421e-01f, 8.580306768e-01f, 2.058971673e-01f, 9.785736203e-01f,
  -4.007990062e-01f, -9.161660075e-01f, -7.494767308e-01f, 6.620306373e-01f, 2.094544172e-01f, 9.778184295e-01f, 7.216176391e-01f, 6.922917962e-01f,
  9.089657664e-01f, 4.168707728e-01f, 9.709069133e-01f, 2.394572198e-01f, 9.907692075e-01f, 1.355592906e-01f, 9.970778823e-01f, 7.639151812e-02f,
  9.990756512e-01f, 4.298675060e-02f, 9.997076392e-01f, 2.417832054e-02f, 9.999075532e-01f, 1.359737478e-02f, 9.999707937e-01f, 7.646527141e-03f,
  9.998432994e-01f, 1.770192571e-02f, 9.250146747e-01f, -3.799313903e-01f, 2.212981731e-01f, 9.752061963e-01f, 2.954781987e-02f, 9.995633960e-01f,
  -3.073327839e-01f, -9.516021013e-01f, -7.855011225e-01f, 6.188601851e-01f, 1.784335226e-01f, 9.839519858e-01f, 7.091933489e-01f, 7.050140500e-01f,
  9.047516584e-01f, 4.259394705e-01f, 9.695450068e-01f, 2.449132055e-01f, 9.903355837e-01f, 1.386916935e-01f, 9.969404936e-01f, 7.816448808e-02f,
  9.990321398e-01f, 4.398580641e-02f, 9.996939301e-01f, 2.474049293e-02f, 9.999032021e-01f, 1.391357277e-02f, 9.999693632e-01f, 7.824349217e-03f,
  5.253219604e-01f, 8.509035110e-01f, 9.851381779e-01f, 1.717635691e-01f, -9.294810891e-02f, 9.956709743e-01f, -1.477329880e-01f, 9.890272617e-01f,
  -2.107958049e-01f, -9.775301218e-01f, -8.190422058e-01f, 5.737332702e-01f, 1.472342163e-01f, 9.891016483e-01f, 6.965447664e-01f, 7.175133228e-01f,
  9.004471302e-01f, 4.349655211e-01f, 9.681524038e-01f, 2.503614724e-01f, 9.898920655e-01f, 1.418227106e-01f, 9.967998862e-01f, 7.993719727e-02f,
  9.989876747e-01f, 4.498481750e-02f, 9.996798635e-01f, 2.530265786e-02f, 9.998987317e-01f, 1.422976889e-02f, 9.999679923e-01f, 8.002171293e-03f,
  -4.321779311e-01f, 9.017883539e-01f, 7.418580055e-01f, 6.705570221e-01f, -3.979767561e-01f, 9.173954725e-01f, -3.203543723e-01f, 9.472977519e-01f,
  -1.121526212e-01f, -9.936909676e-01f, -8.499938846e-01f, 5.267925262e-01f, 1.158876941e-01f, 9.932623506e-01f, 6.836758852e-01f, 7.297857404e-01f,
  8.960524797e-01f, 4.439480901e-01f, 9.667292237e-01f, 2.558017969e-01f, 9.894386530e-01f, 1.449523121e-01f, 9.966561794e-01f, 8.170966059e-02f,
  9.989421964e-01f, 4.598378390e-02f, 9.996654391e-01f, 2.586481534e-02f, 9.998942018e-01f, 1.454596408e-02f, 9.999665618e-01f, 8.179994300e-03f,
  -9.923354983e-01f, 1.235731244e-01f, 2.700984478e-01f, 9.628326893e-01f, -6.635382771e-01f, 7.481423616e-01f, -4.828719497e-01f, 8.756909966e-01f,
  -1.238837745e-02f, -9.999232888e-01f, -8.782584071e-01f, 4.781863391e-01f, 8.442528546e-02f, 9.964298010e-01f, 6.705908775e-01f, 7.418274283e-01f,
  8.915683031e-01f, 4.528862834e-01f, 9.652754664e-01f, 2.612340748e-01f, 9.889753461e-01f, 1.480804533e-01f, 9.965093136e-01f, 8.348185569e-02f,
  9.988957047e-01f, 4.698270187e-02f, 9.996507764e-01f, 2.642696351e-02f, 9.998895526e-01f, 1.486215740e-02f, 9.999650717e-01f, 8.357816376e-03f,
  -6.401443481e-01f, -7.682546377e-01f, -2.848466039e-01f, 9.585731030e-01f, -8.632965088e-01f, 5.046970844e-01f, -6.301599741e-01f, 7.764653563e-01f,
  8.749917150e-02f, -9.961646199e-01f, -9.037463665e-01f, 4.280683994e-01f, 5.287845805e-02f, 9.986009598e-01f, 6.572937369e-01f, 7.536345124e-01f,
  8.869948983e-01f, 4.617791772e-01f, 9.637911916e-01f, 2.666580379e-01f, 9.885020852e-01f, 1.512071192e-01f, 9.963592887e-01f, 8.525379747e-02f,
  9.988481998e-01f, 4.798157141e-02f, 9.996357560e-01f, 2.698910423e-02f, 9.998847842e-01f, 1.517834887e-02f, 9.999635816e-01f, 8.535637520e-03f,
  3.005925417e-01f, -9.537526369e-01f, -7.520639896e-01f, 6.590901017e-01f, -9.774427414e-01f, 2.112006545e-01f, -7.575730681e-01f, 6.527503729e-01f,
  1.865124702e-01f, -9.824525714e-01f, -9.263771176e-01f, 3.765971363e-01f, 2.127875760e-02f, 9.997735620e-01f, 6.437888145e-01f, 7.652031779e-01f,
  8.823328614e-01f, 4.706258774e-01f, 9.622764587e-01f, 2.720735669e-01f, 9.880189896e-01f, 1.543322802e-01f, 9.962061048e-01f, 8.702547103e-02f,
  9.987997413e-01f, 4.898039624e-02f, 9.996203780e-01f, 2.755123749e-02f, 9.998799562e-01f, 1.549453940e-02f, 9.999620318e-01f, 8.713459596e-03f,
  9.649659991e-01f, -2.623748481e-01f, -9.876590967e-01f, 1.566190720e-01f, -9.946564436e-01f, -1.032404602e-01f, -8.610926867e-01f, 5.084479451e-01f,
  2.836622000e-01f, -9.589242935e-01f, -9.460792542e-01f, 3.239352703e-01f, -1.034221891e-02f, 9.999465346e-01f, 6.300802827e-01f, 7.765299678e-01f,
  8.775825500e-01f, 4.794255495e-01f, 9.607312679e-01f, 2.774805427e-01f, 9.875259995e-01f, 1.574558914e-01f, 9.960497618e-01f, 8.879686147e-02f,
  9.987502694e-01f, 4.997916892e-02f, 9.996047616e-01f, 2.811335959e-02f, 9.998750091e-01f, 1.581072807e-02f, 9.999604821e-01f, 8.891279809e-03f,
  7.421541810e-01f, 6.702291965e-01f, -9.190735221e-01f, -3.940860629e-01f, -9.132301211e-01f, -4.074441493e-01f, -9.374542236e-01f, 3.481085002e-01f,
  3.779776692e-01f, -9.258147478e-01f, -9.627903700e-01f, 2.702493370e-01f, -4.195285589e-02f, 9.991195798e-01f, 6.161724925e-01f, 7.876111865e-01f,
  8.727445006e-01f, 4.881772399e-01f, 9.591556787e-01f, 2.828786969e-01f, 9.870231748e-01f, 1.605779380e-01f, 9.958902597e-01f, 9.056797624e-02f,
  9.986997843e-01f, 5.097789690e-02f, 9.995887876e-01f, 2.867547423e-02f, 9.998699427e-01f, 1.612691768e-02f, 9.999588728e-01f, 9.069100954e-03f,
  -1.629907787e-01f, 9.866275787e-01f, -5.674300194e-01f, -8.234215975e-01f, -7.412399650e-01f, -6.712401509e-01f, -9.842484593e-01f, 1.767906845e-01f,
  4.685169160e-01f, -8.834545016e-01f, -9.764577150e-01f, 2.157090008e-01f, -7.352153957e-02f, 9.972936511e-01f, 6.020699143e-01f, 7.984433770e-01f,
  8.678191900e-01f, 4.968801141e-01f, 9.575498104e-01f, 2.882679403e-01f, 9.865104556e-01f, 1.636983752e-01f, 9.957276583e-01f, 9.233880043e-02f,
  9.986482859e-01f, 5.197656900e-02f, 9.995725155e-01f, 2.923758142e-02f, 9.998648167e-01f, 1.644310169e-02f, 9.999572635e-01f, 9.246920235e-03f,
  -9.182828069e-01f, 3.959251642e-01f, -4.102819040e-02f, -9.991579652e-01f, -4.957418144e-01f, -8.684699535e-01f, -1.000000000e+00f, -1.030206768e-04f,
  5.543745160e-01f, -8.322673440e-01f, -9.870380163e-01f, 1.604867280e-01f, -1.050167084e-01f, 9.944704771e-01f, 5.877769589e-01f, 8.090230227e-01f,
  8.628070951e-01f, 5.055333376e-01f, 9.559136033e-01f, 2.936480343e-01f, 9.859878421e-01f, 1.668171734e-01f, 9.955618382e-01f, 9.410934150e-02f,
  9.985958338e-01f, 5.297519267e-02f, 9.995558858e-01f, 2.979967557e-02f, 9.998595715e-01f, 1.675928757e-02f, 9.999555945e-01f, 9.424741380e-03f,
  -8.293098211e-01f, -5.587890744e-01f, 4.980095923e-01f, -8.671715260e-01f, -2.010796219e-01f, -9.795749187e-01f, -9.842120409e-01f, -1.769934744e-01f,
  6.346929669e-01f, -7.727644444e-01f, -9.944978952e-01f, 1.047568321e-01f, -1.364068687e-01f, 9.906529188e-01f, 5.732980371e-01f, 8.193469048e-01f,
  8.577086926e-01f, 5.141359568e-01f, 9.542471766e-01f, 2.990188897e-01f, 9.854553938e-01f, 1.699342877e-01f, 9.953929186e-01f, 9.587957710e-02f,
  9.985423684e-01f, 5.397376046e-02f, 9.995389581e-01f, 3.036176413e-02f, 9.998542070e-01f, 1.707546785e-02f, 9.999538660e-01f, 9.602561593e-03f,
  2.212675661e-02f, -9.997551441e-01f, 8.836693168e-01f, -4.681116641e-01f, 1.135217771e-01f, -9.935355186e-01f, -9.373825192e-01f, -3.483016491e-01f,
  7.086697817e-01f, -7.055402994e-01f, -9.988136292e-01f, 4.869600013e-02f, -1.676606387e-01f, 9.858447909e-01f, 5.586379170e-01f, 8.294116855e-01f,
  8.525245190e-01f, 5.226872563e-01f, 9.525505900e-01f, 3.043802381e-01f, 9.849131107e-01f, 1.730497181e-01f, 9.952208400e-01f, 9.764950722e-02f,
  9.984878898e-01f, 5.497227982e-02f, 9.995217323e-01f, 3.092384152e-02f, 9.998487830e-01f, 1.739165001e-02f, 9.999521971e-01f, 9.780380875e-03f,
  8.532201052e-01f, -5.215510130e-01f, 9.971746206e-01f, 7.511820644e-02f, 4.168670774e-01f, -9.089674354e-01f, -8.609884381e-01f, -5.086245537e-01f,
  7.755658031e-01f, -6.312667131e-01f, -9.999717474e-01f, -7.518785074e-03f, -1.987468749e-01f, 9.800508618e-01f, 5.438010693e-01f, 8.392141461e-01f,
  8.472551107e-01f, 5.311862230e-01f, 9.508239031e-01f, 3.097319603e-01f, 9.843609333e-01f, 1.761634201e-01f, 9.950456619e-01f, 9.941913933e-02f,
  9.984323978e-01f, 5.597073585e-02f, 9.995042086e-01f, 3.148590773e-02f, 9.998431802e-01f, 1.770782843e-02f, 9.999504089e-01f, 9.958200157e-03f,
  8.998668194e-01f, 4.361647666e-01f, 8.035690784e-01f, 5.952115059e-01f, 6.788702011e-01f, -7.342582941e-01f, -7.574391961e-01f, -6.529057026e-01f,
  8.347129226e-01f, -5.506852865e-01f, -9.979684949e-01f, -6.370979548e-02f, -2.296342701e-01f, 9.732769728e-01f, 5.287923217e-01f, 8.487512469e-01f,
  8.419010043e-01f, 5.396320224e-01f, 9.490671158e-01f, 3.150739372e-01f, 9.837989211e-01f, 1.792753637e-01f, 9.948672652e-01f, 1.011884511e-01f,
  9.983759522e-01f, 5.696914345e-02f, 9.994863272e-01f, 3.204796836e-02f, 9.998375773e-01f, 1.802400686e-02f, 9.999486208e-01f, 1.013601944e-02f,
  1.191801354e-01f, 9.928726554e-01f, 3.624766767e-01f, 9.319928288e-01f, 8.735505342e-01f, -4.867334962e-01f, -6.300007105e-01f, -7.765945792e-01f,
  8.855196238e-01f, -4.646020234e-01f, -9.928101897e-01f, -1.196993962e-01f, -2.602920532e-01f, 9.655299187e-01f, 5.136163235e-01f, 8.580200076e-01f,
  8.364626765e-01f, 5.480239391e-01f, 9.472803473e-01f, 3.204059005e-01f, 9.832270741e-01f, 1.823855042e-01f, 9.946857691e-01f, 1.029574350e-01f,
  9.983184934e-01f, 5.796748772e-02f, 9.994681478e-01f, 3.261001408e-02f, 9.998317957e-01f, 1.834018156e-02f, 9.999468327e-01f, 1.031383779e-02f,
  -7.710801959e-01f, 6.367380023e-01f, -1.902491003e-01f, 9.817358255e-01f, 9.816020727e-01f, -1.909380108e-01f, -4.826923311e-01f, -8.757900000e-01f,
  9.274784923e-01f, -3.738765717e-01f, -9.845131636e-01f, -1.753105819e-01f, -2.906895578e-01f, 9.568174481e-01f, 4.982779026e-01f, 8.670173883e-01f,
  8.309407234e-01f, 5.563610196e-01f, 9.454635978e-01f, 3.257277906e-01f, 9.826454520e-01f, 1.854938269e-01f, 9.945011139e-01f, 1.047261059e-01f,
  9.982600212e-01f, 5.896577984e-02f, 9.994496703e-01f, 3.317204863e-02f, 9.998259544e-01f, 1.865635626e-02f, 9.999449849e-01f, 1.049165614e-02f,
  -9.524129629e-01f, -3.048106134e-01f, -6.843819022e-01f, 7.291237116e-01f, 9.923083186e-01f, 1.237909496e-01f, -3.201591671e-01f, -9.473637342e-01f,
  9.601702690e-01f, -2.794154882e-01f, -9.731037021e-01f, -2.303675115e-01f, -3.207964003e-01f, 9.471482038e-01f, 4.827820361e-01f, 8.757405281e-01f,
  8.253356218e-01f, 5.646424294e-01f, 9.436169863e-01f, 3.310393095e-01f, 9.820539355e-01f, 1.886002868e-01f, 9.943132997e-01f, 1.064944416e-01f,
  9.982005358e-01f, 5.996400863e-02f, 9.994308352e-01f, 3.373407945e-02f, 9.998199940e-01f, 1.897252724e-02f, 9.999430776e-01f, 1.066947449e-02f,
  -2.581016421e-01f, -9.661177993e-01f, -9.677396417e-01f, 2.519522607e-01f, 9.046075940e-01f, 4.262454212e-01f, -1.475291997e-01f, -9.890577197e-01f,
  9.832684398e-01f, -1.821625978e-01f, -9.586178064e-01f, -2.846961617e-01f, -3.505824506e-01f, 9.365318418e-01f, 4.671334028e-01f, 8.841868639e-01f,
  8.196480274e-01f, 5.728674531e-01f, 9.417404532e-01f, 3.363404274e-01f, 9.814526439e-01f, 1.917048544e-01f, 9.941223264e-01f, 1.082624346e-01f,
  9.981400967e-01f, 6.096218154e-02f, 9.994117022e-01f, 3.429609165e-02f, 9.998139739e-01f, 1.928869821e-02f, 9.999411702e-01f, 1.084729191e-02f,
  6.735071540e-01f, -7.391806841e-01f, -9.530500174e-01f, -3.028128743e-01f, 7.271980643e-01f, 6.864276528e-01f, 2.975377068e-02f, -9.995572567e-01f,
  9.965420961e-01f, -8.308912069e-02f, -9.411013126e-01f, -3.381247520e-01f, -3.800179660e-01f, 9.249790907e-01f, 4.513370395e-01f, 8.923535347e-01f,
  8.138784766e-01f, 5.810351372e-01f, 9.398342371e-01f, 3.416308761e-01f, 9.808415174e-01f, 1.948075294e-01f, 9.939282537e-01f, 1.100300923e-01f,
  9.980786443e-01f, 6.196028739e-02f, 9.993922710e-01f, 3.485809639e-02f, 9.998078346e-01f, 1.960486546e-02f, 9.999392033e-01f, 1.102510840e-02f,
  9.858965874e-01f, 1.673557013e-01f, -6.448370218e-01f, -7.643200755e-01f, 4.776714444e-01f, 8.785385489e-01f, 2.060983330e-01f, -9.785313010e-01f,
  9.998586178e-01f, 1.681409031e-02f, -9.206095338e-01f, -3.904843926e-01f, -4.090735018e-01f, 9.125014544e-01f, 4.353979528e-01f, 9.002380967e-01f,
  8.080275059e-01f, 5.891447663e-01f, 9.378982186e-01f, 3.469105363e-01f, 9.802205563e-01f, 1.979082376e-01f, 9.937310219e-01f, 1.117973924e-01f,
  9.980161786e-01f, 6.295833737e-02f, 9.993724823e-01f, 3.542009369e-02f, 9.998015761e-01f, 1.992103085e-02f, 9.999372363e-01f, 1.120292582e-02f,
};
__device__ const float ROPE32[1024] = {
  1.000000000e+00f, 0.000000000e+00f, 1.000000000e+00f, 0.000000000e+00f, 1.000000000e+00f, 0.000000000e+00f, 1.000000000e+00f, 0.000000000e+00f,
  1.000000000e+00f, 0.000000000e+00f, 1.000000000e+00f, 0.000000000e+00f, 1.000000000e+00f, 0.000000000e+00f, 1.000000000e+00f, 0.000000000e+00f,
  5.403022766e-01f, 8.414709568e-01f, 9.504152536e-01f, 3.109835982e-01f, 9.950041771e-01f, 9.983342141e-02f, 9.995000362e-01f, 3.161750361e-02f,
  9.999499917e-01f, 9.999833070e-03f, 9.999949932e-01f, 3.162272274e-03f, 9.999995232e-01f, 9.999999311e-04f, 9.999999404e-01f, 3.162277571e-04f,
  -4.161468446e-01f, 9.092974067e-01f, 8.065783978e-01f, 5.911270976e-01f, 9.800665975e-01f, 1.986693293e-01f, 9.980006814e-01f, 6.320339441e-02f,
  9.998000264e-01f, 1.999866590e-02f, 9.999799728e-01f, 6.324512884e-03f, 9.999979734e-01f, 1.999998698e-03f, 9.999998212e-01f, 6.324554561e-04f,
  -9.899924994e-01f, 1.411200017e-01f, 5.827536583e-01f, 8.126488924e-01f, 9.553365111e-01f, 2.955202162e-01f, 9.955033660e-01f, 9.472608566e-02f,
  9.995500445e-01f, 2.999549918e-02f, 9.999549985e-01f, 9.486690164e-03f, 9.999955297e-01f, 2.999995602e-03f, 9.999995232e-01f, 9.486831259e-04f,
  -6.536436081e-01f, -7.568024993e-01f, 3.011374772e-01f, 9.535807371e-01f, 9.210609794e-01f, 3.894183338e-01f, 9.920106530e-01f, 1.261540651e-01f,
  9.992001057e-01f, 3.998933360e-02f, 9.999200106e-01f, 1.264877338e-02f, 9.999920130e-01f, 3.999989480e-03f, 9.999992251e-01f, 1.264910679e-03f,
  2.836622000e-01f, -9.589242935e-01f, -1.034233812e-02f, 9.999465346e-01f, 8.775825500e-01f, 4.794255495e-01f, 9.875259995e-01f, 1.574558765e-01f,
  9.987502694e-01f, 4.997916520e-02f, 9.998750091e-01f, 1.581072807e-02f, 9.999874830e-01f, 4.999979399e-03f, 9.999987483e-01f, 1.581138116e-03f,
  9.601702690e-01f, -2.794154882e-01f, -3.207964003e-01f, 9.471482038e-01f, 8.253356218e-01f, 5.646424890e-01f, 9.820539355e-01f, 1.886002719e-01f,
  9.982005358e-01f, 5.996400490e-02f, 9.998199940e-01f, 1.897252724e-02f, 9.999819994e-01f, 5.999964196e-03f, 9.999982119e-01f, 1.897365320e-03f,
  7.539022565e-01f, 6.569865942e-01f, -5.994374752e-01f, 8.004215956e-01f, 7.648422122e-01f, 6.442176700e-01f, 9.755998850e-01f, 2.195560932e-01f,
  9.975510240e-01f, 6.994284689e-02f, 9.997550249e-01f, 2.213413455e-02f, 9.999755025e-01f, 6.999942940e-03f, 9.999975562e-01f, 2.213592408e-03f,
  -1.455000341e-01f, 9.893582463e-01f, -8.186324239e-01f, 5.743177533e-01f, 6.967067122e-01f, 7.173560858e-01f, 9.681702852e-01f, 2.502923310e-01f,
  9.968017340e-01f, 7.991468906e-02f, 9.996800423e-01f, 2.529552206e-02f, 9.999679923e-01f, 7.999914698e-03f, 9.999967813e-01f, 2.529819263e-03f,
  -9.111302495e-01f, 4.121184945e-01f, -9.566441774e-01f, 2.912592292e-01f, 6.216099262e-01f, 7.833269238e-01f, 9.597726464e-01f, 2.807783186e-01f,
  9.959527254e-01f, 8.987854421e-02f, 9.995950460e-01f, 2.845665626e-02f, 9.999595284e-01f, 8.999879472e-03f, 9.999959469e-01f, 2.846045885e-03f,
  -8.390715122e-01f, -5.440211296e-01f, -9.997860789e-01f, -2.068356983e-02f, 5.403022766e-01f, 8.414709568e-01f, 9.504153132e-01f, 3.109835684e-01f,
  9.950041771e-01f, 9.983341396e-02f, 9.995000362e-01f, 3.161750361e-02f, 9.999499917e-01f, 9.999834001e-03f, 9.999949932e-01f, 3.162272274e-03f,
  4.425697960e-03f, -9.999902248e-01f, -9.437797666e-01f, -3.305749595e-01f, 4.535960853e-01f, 8.912073970e-01f, 9.401075840e-01f, 3.408778608e-01f,
  9.939560890e-01f, 1.097782999e-01f, 9.993950725e-01f, 3.477803990e-02f, 9.999395013e-01f, 1.099977922e-02f, 9.999939203e-01f, 3.478498431e-03f,
  8.438539505e-01f, -5.365729332e-01f, -7.941793799e-01f, -6.076834202e-01f, 3.623577058e-01f, 9.320390821e-01f, 9.288598895e-01f, 3.704313040e-01f,
  9.928086400e-01f, 1.197122037e-01f, 9.992800951e-01f, 3.793822229e-02f, 9.999279976e-01f, 1.199971233e-02f, 9.999927878e-01f, 3.794723889e-03f,
  9.074468017e-01f, 4.201670289e-01f, -5.658205152e-01f, -8.245284557e-01f, 2.674987614e-01f, 9.635581970e-01f, 9.166833758e-01f, 3.996143043e-01f,
  9.915618896e-01f, 1.296341419e-01f, 9.991551042e-01f, 4.109803215e-02f, 9.999154806e-01f, 1.299963426e-02f, 9.999915361e-01f, 4.110949114e-03f,
  1.367372125e-01f, 9.906073809e-01f, -2.813494802e-01f, -9.596053958e-01f, 1.699671596e-01f, 9.854497313e-01f, 9.035902619e-01f, 4.283977747e-01f,
  9.902160168e-01f, 1.395431161e-01f, 9.990201592e-01f, 4.425742477e-02f, 9.999020100e-01f, 1.399954315e-02f, 9.999902248e-01f, 4.427174106e-03f,
  -7.596879005e-01f, 6.502878666e-01f, 3.102235124e-02f, -9.995186925e-01f, 7.073719800e-02f, 9.974949956e-01f, 8.895936012e-01f, 4.567528665e-01f,
  9.887710810e-01f, 1.494381279e-01f, 9.988752007e-01f, 4.741638154e-02f, 9.998875260e-01f, 1.499943808e-02f, 9.999887347e-01f, 4.743398633e-03f,
  -9.576594830e-01f, -2.879033089e-01f, 3.403181732e-01f, -9.403103590e-01f, -2.919954620e-02f, 9.995735884e-01f, 8.747074604e-01f, 4.846512377e-01f,
  9.872272611e-01f, 1.593182087e-01f, 9.987202883e-01f, 5.057485774e-02f, 9.998720288e-01f, 1.599931903e-02f, 9.999871850e-01f, 5.059622694e-03f,
  -2.751633525e-01f, -9.613974690e-01f, 6.158648133e-01f, -7.878518701e-01f, -1.288445443e-01f, 9.916648269e-01f, 8.589466810e-01f, 5.120649934e-01f,
  9.855847955e-01f, 1.691823453e-01f, 9.985553622e-01f, 5.373282731e-02f, 9.998555183e-01f, 1.699918136e-02f, 9.999855757e-01f, 5.375845823e-03f,
  6.603167057e-01f, -7.509872317e-01f, 8.303361535e-01f, -5.572628975e-01f, -2.272021621e-01f, 9.738476276e-01f, 8.423270583e-01f, 5.389667153e-01f,
  9.838436842e-01f, 1.790295690e-01f, 9.983804226e-01f, 5.689026415e-02f, 9.998379946e-01f, 1.799902879e-02f, 9.999837875e-01f, 5.692068953e-03f,
  9.887046218e-01f, 1.498772055e-01f, 9.624637961e-01f, -2.714101076e-01f, -3.232895434e-01f, 9.463000894e-01f, 8.248651624e-01f, 5.653295517e-01f,
  9.820042253e-01f, 1.888588965e-01f, 9.981955290e-01f, 6.004713103e-02f, 9.998195171e-01f, 1.899885759e-02f, 9.999819398e-01f, 6.008291151e-03f,
  4.080820680e-01f, 9.129452705e-01f, 9.991443753e-01f, 4.135828838e-02f, -4.161468446e-01f, 9.092974067e-01f, 8.065784574e-01f, 5.911270380e-01f,
  9.800665975e-01f, 1.986693144e-01f, 9.980006814e-01f, 6.320339441e-02f, 9.998000264e-01f, 1.999866776e-02f, 9.999799728e-01f, 6.324512884e-03f,
  -5.477292538e-01f, 8.366556168e-01f, 9.367404580e-01f, 3.500247598e-01f, -5.048462152e-01f, 8.632093072e-01f, 7.874851823e-01f, 6.163335443e-01f,
  9.780309200e-01f, 2.084598988e-01f, 9.977958202e-01f, 6.635902822e-02f, 9.997795224e-01f, 2.099845745e-02f, 9.999779463e-01f, 6.640734151e-03f,
  -9.999608397e-01f, -8.851309307e-03f, 7.814403772e-01f, 6.239799261e-01f, -5.885011554e-01f, 8.084963560e-01f, 7.676045895e-01f, 6.409237385e-01f,
  9.758974314e-01f, 2.182296216e-01f, 9.975810051e-01f, 6.951400638e-02f, 9.997580051e-01f, 2.199822664e-02f, 9.999758005e-01f, 6.956954487e-03f,
  -5.328330398e-01f, -8.462204337e-01f, 5.486452579e-01f, 8.360552788e-01f, -6.662759781e-01f, 7.457052469e-01f, 7.469564080e-01f, 6.648730636e-01f,
  9.736663699e-01f, 2.279775143e-01f, 9.973561764e-01f, 7.266827673e-02f, 9.997355342e-01f, 2.299797349e-02f, 9.999735355e-01f, 7.273174357e-03f,
  4.241790175e-01f, -9.055783749e-01f, 2.614416778e-01f, 9.652192593e-01f, -7.373937964e-01f, 6.754631400e-01f, 7.255613208e-01f, 6.881574988e-01f,
  9.713379741e-01f, 2.377026230e-01f, 9.971213937e-01f, 7.582182437e-02f, 9.997119904e-01f, 2.399769612e-02f, 9.999712110e-01f, 7.589393295e-03f,
  9.912028313e-01f, -1.323517561e-01f, -5.168933049e-02f, 9.986631870e-01f, -8.011435866e-01f, 5.984721184e-01f, 7.034407258e-01f, 7.107539177e-01f,
  9.689124227e-01f, 2.474039644e-01f, 9.968766570e-01f, 7.897461206e-02f, 9.996874928e-01f, 2.499739639e-02f, 9.999687672e-01f, 7.905611768e-03f,
  6.469193101e-01f, 7.625584602e-01f, -3.596943319e-01f, 9.330701828e-01f, -8.568888307e-01f, 5.155012608e-01f, 6.806167960e-01f, 7.326396108e-01f,
  9.663899541e-01f, 2.570805550e-01f, 9.966219068e-01f, 8.212661743e-02f, 9.996620417e-01f, 2.599707060e-02f, 9.999662042e-01f, 8.221829310e-03f,
  -2.921388149e-01f, 9.563759565e-01f, -6.320286393e-01f, 7.749450207e-01f, -9.040721655e-01f, 4.273798466e-01f, 6.571123004e-01f, 7.537927032e-01f,
  9.637709260e-01f, 2.667314112e-01f, 9.963572025e-01f, 8.527779579e-02f, 9.996355176e-01f, 2.699672058e-02f, 9.999635220e-01f, 8.538045920e-03f,
  -9.626058936e-01f, 2.709057927e-01f, -8.416849375e-01f, 5.399689674e-01f, -9.422222972e-01f, 3.349882066e-01f, 6.329506636e-01f, 7.741920948e-01f,
  9.610554576e-01f, 2.763556540e-01f, 9.960825443e-01f, 8.842811733e-02f, 9.996080399e-01f, 2.799634263e-02f, 9.999607801e-01f, 8.854261599e-03f,
  -7.480575442e-01f, -6.636338830e-01f, -9.678714871e-01f, 2.514453232e-01f, -9.709581733e-01f, 2.392492294e-01f, 6.081562042e-01f, 7.938174009e-01f,
  9.582439065e-01f, 2.859522104e-01f, 9.957979321e-01f, 9.157756716e-02f, 9.995795488e-01f, 2.899593674e-02f, 9.999579787e-01f, 9.170476347e-03f,
  1.542514563e-01f, -9.880316257e-01f, -9.980752468e-01f, -6.201484054e-02f, -9.899924994e-01f, 1.411200017e-01f, 5.827536583e-01f, 8.126488924e-01f,
  9.553365111e-01f, 2.955201864e-01f, 9.955033660e-01f, 9.472609311e-02f, 9.995500445e-01f, 2.999550104e-02f, 9.999549985e-01f, 9.486690164e-03f,
  9.147423506e-01f, -4.040376544e-01f, -9.293003082e-01f, -3.693250120e-01f, -9.991351366e-01f, 4.158052057e-02f, 5.567683578e-01f, 8.306677938e-01f,
  9.523335695e-01f, 3.050586283e-01f, 9.951988459e-01f, 9.787366539e-02f, 9.995195270e-01f, 3.099503554e-02f, 9.999519587e-01f, 9.802903049e-03f,
  8.342233896e-01f, 5.514267087e-01f, -7.683671117e-01f, -6.400094032e-01f, -9.982947707e-01f, -5.837419257e-02f, 5.302263498e-01f, 8.478561044e-01f,
  9.492354393e-01f, 3.145665526e-01f, 9.948843718e-01f, 1.010202691e-01f, 9.994880557e-01f, 3.199454024e-02f, 9.999487996e-01f, 1.011911593e-02f,
  -1.327674743e-02f, 9.999118447e-01f, -5.312352777e-01f, -8.472243547e-01f, -9.874798059e-01f, -1.577456445e-01f, 5.031541586e-01f, 8.641966581e-01f,
  9.460423589e-01f, 3.240430057e-01f, 9.945599437e-01f, 1.041658595e-01f, 9.994555712e-01f, 3.299400955e-02f, 9.999455214e-01f, 1.043532696e-02f,
  -8.485702872e-01f, 5.290827155e-01f, -2.414211184e-01f, -9.704204202e-01f, -9.667981863e-01f, -2.555412054e-01f, 4.755789042e-01f, 8.796730638e-01f,
  9.427546859e-01f, 3.334870934e-01f, 9.942255616e-01f, 1.073104069e-01f, 9.994220734e-01f, 3.399345279e-02f, 9.999421835e-01f, 1.075153705e-02f,
  -9.036921859e-01f, -4.281826615e-01f, 7.233466953e-02f, -9.973804355e-01f, -9.364566803e-01f, -3.507832289e-01f, 4.475280643e-01f, 8.942698836e-01f,
  9.393727183e-01f, 3.428978026e-01f, 9.938812256e-01f, 1.104538813e-01f, 9.993875623e-01f, 3.499285504e-02f, 9.999387264e-01f, 1.106774528e-02f,
  -1.279636919e-01f, -9.917788506e-01f, 3.789161742e-01f, -9.254310131e-01f, -8.967583776e-01f, -4.425205588e-01f, 4.190297425e-01f, 9.079725146e-01f,
  9.358968139e-01f, 3.522742093e-01f, 9.935269952e-01f, 1.135962531e-01f, 9.993520975e-01f, 3.599222749e-02f, 9.999352098e-01f, 1.138395350e-02f,
  7.654140592e-01f, -6.435381174e-01f, 6.479216814e-01f, -7.617069483e-01f, -8.481000066e-01f, -5.298361778e-01f, 3.901124299e-01f, 9.207672477e-01f,
  9.323273301e-01f, 3.616154492e-01f, 9.931628108e-01f, 1.167374924e-01f, 9.993155599e-01f, 3.699155897e-02f, 9.999315739e-01f, 1.170015987e-02f,
  9.550736547e-01f, 2.963685691e-01f, 8.526731133e-01f, -5.224447846e-01f, -7.909677625e-01f, -6.118578315e-01f, 3.608050346e-01f, 9.326412678e-01f,
  9.286646247e-01f, 3.709204793e-01f, 9.927886724e-01f, 1.198775545e-01f, 9.992780685e-01f, 3.799085692e-02f, 9.999278188e-01f, 1.201636530e-02f,
  2.666429281e-01f, 9.637953639e-01f, 9.728653431e-01f, -2.313720137e-01f, -7.259322405e-01f, -6.877662539e-01f, 3.311368525e-01f, 9.435827136e-01f,
  9.249090552e-01f, 3.801884055e-01f, 9.924046397e-01f, 1.230164245e-01f, 9.992396235e-01f, 3.899011388e-02f, 9.999239445e-01f, 1.233256981e-02f,
  -6.669380665e-01f, 7.451131344e-01f, 9.965789914e-01f, 8.264580369e-02f, -6.536436081e-01f, -7.568024993e-01f, 3.011375964e-01f, 9.535806775e-01f,
  9.210609794e-01f, 3.894183338e-01f, 9.920106530e-01f, 1.261540651e-01f, 9.992001057e-01f, 3.998933733e-02f, 9.999200106e-01f, 1.264877338e-02f,
  -9.873392582e-01f, -1.586226672e-01f, 9.214623570e-01f, 3.884676993e-01f, -5.748240352e-01f, -8.182770610e-01f, 2.708370686e-01f, 9.626252055e-01f,
  9.171208143e-01f, 3.986093104e-01f, 9.916067719e-01f, 1.292904317e-01f, 9.991596341e-01f, 4.098851606e-02f, 9.999159575e-01f, 1.296497509e-02f,
  -3.999853134e-01f, -9.165215492e-01f, 7.549653649e-01f, 6.557646990e-01f, -4.902605712e-01f, -8.715758920e-01f, 2.402658761e-01f, 9.707071185e-01f,
  9.130889177e-01f, 4.077604413e-01f, 9.911929369e-01f, 1.324255317e-01f, 9.991181493e-01f, 4.198765755e-02f, 9.999117851e-01f, 1.328117587e-02f,
  5.551133156e-01f, -8.317747712e-01f, 5.135984421e-01f, 8.580306768e-01f, -4.007990062e-01f, -9.161660075e-01f, 2.094544172e-01f, 9.778184295e-01f,
  9.089657664e-01f, 4.168707728e-01f, 9.907692075e-01f, 1.355592906e-01f, 9.990756512e-01f, 4.298675060e-02f, 9.999075532e-01f, 1.359737478e-02f,
  9.998432994e-01f, 1.770192571e-02f, 2.212981731e-01f, 9.752061963e-01f, -3.073327839e-01f, -9.516021013e-01f, 1.784335226e-01f, 9.839519858e-01f,
  9.047516584e-01f, 4.259394705e-01f, 9.903355837e-01f, 1.386916935e-01f, 9.990321398e-01f, 4.398580641e-02f, 9.999032021e-01f, 1.391357277e-02f,
  5.253219604e-01f, 8.509035110e-01f, -9.294810891e-02f, 9.956709743e-01f, -2.107958049e-01f, -9.775301218e-01f, 1.472342163e-01f, 9.891016483e-01f,
  9.004471302e-01f, 4.349655211e-01f, 9.898920655e-01f, 1.418227106e-01f, 9.989876747e-01f, 4.498481750e-02f, 9.998987317e-01f, 1.422976889e-02f,
  -4.321779311e-01f, 9.017883539e-01f, -3.979767561e-01f, 9.173954725e-01f, -1.121526212e-01f, -9.936909676e-01f, 1.158876941e-01f, 9.932623506e-01f,
  8.960524797e-01f, 4.439480901e-01f, 9.894386530e-01f, 1.449523121e-01f, 9.989421964e-01f, 4.598378390e-02f, 9.998942018e-01f, 1.454596408e-02f,
  -9.923354983e-01f, 1.235731244e-01f, -6.635382771e-01f, 7.481423616e-01f, -1.238837745e-02f, -9.999232888e-01f, 8.442528546e-02f, 9.964298010e-01f,
  8.915683031e-01f, 4.528862834e-01f, 9.889753461e-01f, 1.480804533e-01f, 9.988957047e-01f, 4.698270187e-02f, 9.998895526e-01f, 1.486215740e-02f,
  -6.401443481e-01f, -7.682546377e-01f, -8.632965088e-01f, 5.046970844e-01f, 8.749917150e-02f, -9.961646199e-01f, 5.287845805e-02f, 9.986009598e-01f,
  8.869948983e-01f, 4.617791772e-01f, 9.885020852e-01f, 1.512071192e-01f, 9.988481998e-01f, 4.798157141e-02f, 9.998847842e-01f, 1.517834887e-02f,
  3.005925417e-01f, -9.537526369e-01f, -9.774427414e-01f, 2.112006545e-01f, 1.865124702e-01f, -9.824525714e-01f, 2.127875760e-02f, 9.997735620e-01f,
  8.823328614e-01f, 4.706258774e-01f, 9.880189896e-01f, 1.543322802e-01f, 9.987997413e-01f, 4.898039624e-02f, 9.998799562e-01f, 1.549453940e-02f,
  9.649659991e-01f, -2.623748481e-01f, -9.946564436e-01f, -1.032404602e-01f, 2.836622000e-01f, -9.589242935e-01f, -1.034221891e-02f, 9.999465346e-01f,
  8.775825500e-01f, 4.794255495e-01f, 9.875259995e-01f, 1.574558914e-01f, 9.987502694e-01f, 4.997916892e-02f, 9.998750091e-01f, 1.581072807e-02f,
  7.421541810e-01f, 6.702291965e-01f, -9.132301211e-01f, -4.074441493e-01f, 3.779776692e-01f, -9.258147478e-01f, -4.195285589e-02f, 9.991195798e-01f,
  8.727445006e-01f, 4.881772399e-01f, 9.870231748e-01f, 1.605779380e-01f, 9.986997843e-01f, 5.097789690e-02f, 9.998699427e-01f, 1.612691768e-02f,
  -1.629907787e-01f, 9.866275787e-01f, -7.412399650e-01f, -6.712401509e-01f, 4.685169160e-01f, -8.834545016e-01f, -7.352153957e-02f, 9.972936511e-01f,
  8.678191900e-01f, 4.968801141e-01f, 9.865104556e-01f, 1.636983752e-01f, 9.986482859e-01f, 5.197656900e-02f, 9.998648167e-01f, 1.644310169e-02f,
  -9.182828069e-01f, 3.959251642e-01f, -4.957418144e-01f, -8.684699535e-01f, 5.543745160e-01f, -8.322673440e-01f, -1.050167084e-01f, 9.944704771e-01f,
  8.628070951e-01f, 5.055333376e-01f, 9.859878421e-01f, 1.668171734e-01f, 9.985958338e-01f, 5.297519267e-02f, 9.998595715e-01f, 1.675928757e-02f,
  -8.293098211e-01f, -5.587890744e-01f, -2.010796219e-01f, -9.795749187e-01f, 6.346929669e-01f, -7.727644444e-01f, -1.364068687e-01f, 9.906529188e-01f,
  8.577086926e-01f, 5.141359568e-01f, 9.854553938e-01f, 1.699342877e-01f, 9.985423684e-01f, 5.397376046e-02f, 9.998542070e-01f, 1.707546785e-02f,
  2.212675661e-02f, -9.997551441e-01f, 1.135217771e-01f, -9.935355186e-01f, 7.086697817e-01f, -7.055402994e-01f, -1.676606387e-01f, 9.858447909e-01f,
  8.525245190e-01f, 5.226872563e-01f, 9.849131107e-01f, 1.730497181e-01f, 9.984878898e-01f, 5.497227982e-02f, 9.998487830e-01f, 1.739165001e-02f,
  8.532201052e-01f, -5.215510130e-01f, 4.168670774e-01f, -9.089674354e-01f, 7.755658031e-01f, -6.312667131e-01f, -1.987468749e-01f, 9.800508618e-01f,
  8.472551107e-01f, 5.311862230e-01f, 9.843609333e-01f, 1.761634201e-01f, 9.984323978e-01f, 5.597073585e-02f, 9.998431802e-01f, 1.770782843e-02f,
  8.998668194e-01f, 4.361647666e-01f, 6.788702011e-01f, -7.342582941e-01f, 8.347129226e-01f, -5.506852865e-01f, -2.296342701e-01f, 9.732769728e-01f,
  8.419010043e-01f, 5.396320224e-01f, 9.837989211e-01f, 1.792753637e-01f, 9.983759522e-01f, 5.696914345e-02f, 9.998375773e-01f, 1.802400686e-02f,
  1.191801354e-01f, 9.928726554e-01f, 8.735505342e-01f, -4.867334962e-01f, 8.855196238e-01f, -4.646020234e-01f, -2.602920532e-01f, 9.655299187e-01f,
  8.364626765e-01f, 5.480239391e-01f, 9.832270741e-01f, 1.823855042e-01f, 9.983184934e-01f, 5.796748772e-02f, 9.998317957e-01f, 1.834018156e-02f,
  -7.710801959e-01f, 6.367380023e-01f, 9.816020727e-01f, -1.909380108e-01f, 9.274784923e-01f, -3.738765717e-01f, -2.906895578e-01f, 9.568174481e-01f,
  8.309407234e-01f, 5.563610196e-01f, 9.826454520e-01f, 1.854938269e-01f, 9.982600212e-01f, 5.896577984e-02f, 9.998259544e-01f, 1.865635626e-02f,
  -9.524129629e-01f, -3.048106134e-01f, 9.923083186e-01f, 1.237909496e-01f, 9.601702690e-01f, -2.794154882e-01f, -3.207964003e-01f, 9.471482038e-01f,
  8.253356218e-01f, 5.646424294e-01f, 9.820539355e-01f, 1.886002868e-01f, 9.982005358e-01f, 5.996400863e-02f, 9.998199940e-01f, 1.897252724e-02f,
  -2.581016421e-01f, -9.661177993e-01f, 9.046075940e-01f, 4.262454212e-01f, 9.832684398e-01f, -1.821625978e-01f, -3.505824506e-01f, 9.365318418e-01f,
  8.196480274e-01f, 5.728674531e-01f, 9.814526439e-01f, 1.917048544e-01f, 9.981400967e-01f, 6.096218154e-02f, 9.998139739e-01f, 1.928869821e-02f,
  6.735071540e-01f, -7.391806841e-01f, 7.271980643e-01f, 6.864276528e-01f, 9.965420961e-01f, -8.308912069e-02f, -3.800179660e-01f, 9.249790907e-01f,
  8.138784766e-01f, 5.810351372e-01f, 9.808415174e-01f, 1.948075294e-01f, 9.980786443e-01f, 6.196028739e-02f, 9.998078346e-01f, 1.960486546e-02f,
  9.858965874e-01f, 1.673557013e-01f, 4.776714444e-01f, 8.785385489e-01f, 9.998586178e-01f, 1.681409031e-02f, -4.090735018e-01f, 9.125014544e-01f,
  8.080275059e-01f, 5.891447663e-01f, 9.802205563e-01f, 1.979082376e-01f, 9.980161786e-01f, 6.295833737e-02f, 9.998015761e-01f, 1.992103085e-02f,
};
#define XB_TMO      128
#define XB_XCNT(j)  (256  + 64 * (j))
#define XB_XSUB(j)  (1280 + 64 * (j))
#define XB_XGEN(j)  (2304 + 64 * (j))
#define XB_TOP      3328
#define XB_TOPGEN   3392
#define XCD_BAR_WORDS 3456
#define XB_SPIN_CAP (1u << 18)
#define LAS __attribute__((address_space(3)))

__device__ __forceinline__ unsigned xb_ld(unsigned* p)              { return __hip_atomic_load(p, __ATOMIC_RELAXED, __HIP_MEMORY_SCOPE_AGENT); }
__device__ __forceinline__ unsigned xb_add(unsigned* p, unsigned v) { return __hip_atomic_fetch_add(p, v, __ATOMIC_RELAXED, __HIP_MEMORY_SCOPE_AGENT); }
__device__ __forceinline__ unsigned xb_xcc_id() { return (unsigned)__builtin_amdgcn_s_getreg((3 << 11) | 20) & 0xFu; }
#define XB_SPIN(cond, bar) do { unsigned _sp = 0; while (cond) { __builtin_amdgcn_s_sleep(1); \
    if ((++_sp & 255u) == 0u) { if (xb_ld(&(bar)[XB_TMO])) break; if (_sp > XB_SPIN_CAP) { atomicAdd(&(bar)[XB_TMO], 1u); break; } } } } while (0)

struct XcdBarrier {
    unsigned* bar; unsigned x;
    volatile LAS unsigned* st;
};

__device__ __forceinline__ XcdBarrier xcd_barrier_post(unsigned* bar, volatile LAS unsigned* st) {
    XcdBarrier b; b.bar = bar; b.x = xb_xcc_id(); b.st = st;
    if (threadIdx.x == 0) (void)xb_add(&bar[XB_XCNT(b.x)], 1u);
    return b;
}
__device__ __forceinline__ void xcd_barrier_complete(unsigned* bar, unsigned x, unsigned& nloc, unsigned& nx) {
    const unsigned G = gridDim.x * gridDim.y * gridDim.z;
    unsigned sum, cnt, mine, sp = 0u;
    for (;;) {
        sum = 0u; cnt = 0u; mine = 0u;
#pragma unroll
        for (unsigned j = 0; j < 16; ++j) { const unsigned c = xb_ld(&bar[XB_XCNT(j)]); sum += c; cnt += (c > 0u) ? 1u : 0u; mine = (j == x) ? c : mine; }
        if (sum == G) break;
        __builtin_amdgcn_s_sleep(1);
        if ((++sp & 255u) == 0u) { if (xb_ld(&bar[XB_TMO])) break; if (sp > XB_SPIN_CAP) { atomicAdd(&bar[XB_TMO], 1u); break; } }
    }
    nloc = mine > 0u ? mine : 1u; nx = cnt > 0u ? cnt : 1u;
}

__device__ __forceinline__ void xcd_barrier(const XcdBarrier& b, const bool t0  ) {
    asm volatile("s_waitcnt vmcnt(0)" ::: "memory");
    __syncthreads();
    if (t0) {
        unsigned* bar = b.bar;
        __builtin_amdgcn_s_waitcnt(0);
        unsigned nloc = b.st[0], nx = b.st[1];
        if (nloc == 0u) { xcd_barrier_complete(bar, b.x, nloc, nx); b.st[0] = nloc; b.st[1] = nx; }
        const unsigned old = xb_add(&bar[XB_XSUB(b.x)], 1u);
        const unsigned gen = old / nloc;
        if (old + 1u == (gen + 1u) * nloc) {
            __builtin_amdgcn_fence(__ATOMIC_RELEASE, "agent");
            asm volatile("s_waitcnt vmcnt(0)" ::: "memory");
            const unsigned og = xb_add(&bar[XB_TOP], 1u);
            const unsigned tg = og / nx;
            if (og + 1u == (tg + 1u) * nx) xb_add(&bar[XB_TOPGEN], 1u);
            else XB_SPIN(xb_ld(&bar[XB_TOPGEN]) == tg, bar);
            __builtin_amdgcn_fence(__ATOMIC_ACQUIRE, "agent");
            xb_add(&bar[XB_XGEN(b.x)], 1u);
            asm volatile("s_waitcnt vmcnt(0)" ::: "memory");
        } else {
            XB_SPIN(xb_ld(&bar[XB_XGEN(b.x)]) == gen, bar);
            __builtin_amdgcn_fence(__ATOMIC_ACQUIRE, "agent");
            asm volatile("s_waitcnt vmcnt(0)" ::: "memory");
        }
    }
    __syncthreads();
}

DI void conv_fetch(const float* __restrict__ src, int K, int N, int k0, int n0, f32x4 (&v)[2], int tid) {
#pragma unroll
    for (int i = 0; i < 2; ++i) {
        const int idx = tid + NTHREADS * i, kr = idx >> 4, c4 = (idx & 15) * 4;
        v[i] = (f32x4){0.f, 0.f, 0.f, 0.f};
        if (n0 + c4 < N) v[i] = __builtin_nontemporal_load((const f32x4*)(src + (size_t)(k0 + kr) * N + n0 + c4));
    }
}
DI void conv_put(const f32x4 (&v)[2], float* lds, int tid) {
#pragma unroll
    for (int i = 0; i < 2; ++i) {
        const int idx = tid + NTHREADS * i, kr = idx >> 4, c4 = (idx & 15) * 4;
        float* d = lds + kr * 65 + c4;
        d[0] = v[i].x; d[1] = v[i].y; d[2] = v[i].z; d[3] = v[i].w;
    }
}
DI unsigned cvt_fp8x4(float a, float b, float c, float d) { int w = __builtin_amdgcn_cvt_pk_fp8_f32(a, b, 0, false); w = __builtin_amdgcn_cvt_pk_fp8_f32(c, d, w, true); return (unsigned)w; }
template <bool NT, bool FP8>
DI void conv_store(int K, bf16_t* __restrict__ dst, int k0, int ndst0, int nstep, const float* lds, int tid) {
    const int idx = tid, n = idx >> 3, kc = idx & 7;
    float f[8];
#pragma unroll
    for (int j = 0; j < 8; ++j) f[j] = lds[(kc * 8 + j) * 65 + n];
    const size_t e = (size_t)(ndst0 + (n & 31) + (n >> 5) * nstep) * K + k0 + kc * 8;
    if (FP8) {
        u32x2 w; w.x = cvt_fp8x4(f[0] * 32.f, f[1] * 32.f, f[2] * 32.f, f[3] * 32.f); w.y = cvt_fp8x4(f[4] * 32.f, f[5] * 32.f, f[6] * 32.f, f[7] * 32.f);
        u32x2* d = (u32x2*)((unsigned char*)dst + e);
        if (NT) __builtin_nontemporal_store(w, d); else *d = w;
    } else {
        u32x4* d = (u32x4*)(dst + e);
        if (NT) __builtin_nontemporal_store(pack8(f), d); else *d = pack8(f);
    }
}
template <bool NT = true, bool FP8 = false>
DI void conv_job(const float* src, int count, int K, int N, int Npad, bf16_t* dst, int perm  , int& base, float* lds, int bid, int nb, int tid) {
    const int tk = K / 64, tn = Npad / 64, per = tk * tn, total = count * per;
    int t = (bid - (base % nb) + nb) % nb;
    f32x4 rg[4][2];
    auto fetch4 = [&](int tt) {
#pragma unroll
        for (int q = 0; q < 4; ++q) {
            const int tq = tt + q * nb;
            if (tq < total) { const int mi = tq / per, rem = tq - mi * per, nt = rem / tk, kt = rem - nt * tk;
                conv_fetch(src + (size_t)mi * K * N, K, N, kt * 64, nt * 64, rg[q], tid); }
        }
    };
    if (t < total) fetch4(t);
    for (; t < total; t += 4 * nb) {
#pragma unroll
        for (int q = 0; q < 4; ++q) if (t + q * nb < total) conv_put(rg[q], lds + q * 4160, tid);
        __syncthreads();
        if (t + 4 * nb < total) fetch4(t + 4 * nb);
#pragma unroll
        for (int q = 0; q < 4; ++q) {
            const int tq = t + q * nb;
            if (tq < total) { const int mi = tq / per, rem = tq - mi * per, nt = rem / tk, kt = rem - nt * tk, n0 = nt * 64;
                int nd0 = n0, nstep = 32;
                if (perm == 1) nd0 = ((n0 & 255) >> 7) * 256 + (n0 >> 8) * 128 + (n0 & 127);
                else if (n0 < perm) { const int hg = n0 >> 6; nd0 = (hg >> 2) * 256 + (hg & 3) * 32; nstep = 128; }
                conv_store<NT, FP8>(K, FP8 ? (bf16_t*)((unsigned char*)dst + (size_t)mi * Npad * K) : dst + (size_t)mi * Npad * K, kt * 64, nd0, nstep, lds + q * 4160, tid); }
        }
        __syncthreads();
    }
    base += total;
}

DI int mla_col(bool uq, int r) {
    const int hw = uq ? 96 : 128;
    if (r < 1024) { const int pn = r >> 8, bj = (r >> 7) & 1, wc = (r >> 5) & 3, d = r & 31; return (4 * pn + wc) * hw + 32 * bj + d; }
    const int rr = r - 1024;
    if (uq) { const int head = rr >> 5, c = rr & 31, dim = (c >> 3) * 4 + (c & 3) + 16 * ((c >> 2) & 1); return head * 96 + 64 + dim; }
    return (rr >> 6) * 128 + 64 + (rr & 63);
}
DI void phase_prologue(const Params& p, float* lds, int bid, int nb, int tid) {
    bf16_t* ws16 = (bf16_t*)p.ws;
    int base = 0;
    conv_job<true, true>(p.in[13], 1, 1024, 3072, 3072, (bf16_t*)(p.ws + W_QKV0), 2048, base, lds, bid, nb, tid);
    conv_job<true, true>(p.in[14], 1, 1024, 1024, 1024, (bf16_t*)(p.ws + W_O0), 0, base, lds, bid, nb, tid);
    conv_job<true, true>(p.in[18], 1, 1024, 1536, 1536, (bf16_t*)(p.ws + W_QKV1), 1280, base, lds, bid, nb, tid);
    conv_job<true, true>(p.in[19], 1, 1024, 1024, 1024, (bf16_t*)(p.ws + W_O1), 0, base, lds, bid, nb, tid);
    conv_job<true, true>(p.in[23], 1, 1024, 672, 768, (bf16_t*)(p.ws + W_DQKV), 0, base, lds, bid, nb, tid);
    for (int i = bid * NTHREADS + tid; i < 1536 * 48 + 2048 * 32; i += nb * NTHREADS) {
        const bool uq = i < 1536 * 48;
        const int K = uq ? 384 : 256, kc = K / 8, ii = uq ? i : i - 1536 * 48, r = ii / kc, k0 = (ii - r * kc) * 8, nsrc = uq ? 1536 : 2048;
        const int col = mla_col(uq, r);
        const float* src = p.in[uq ? 26 : 27] + (size_t)k0 * nsrc + col;
        float f[8];
#pragma unroll
        for (int j = 0; j < 8; ++j) f[j] = src[(size_t)j * nsrc];
        *(u32x4*)((bf16_t*)(p.ws + (uq ? W_UQ : W_UKV)) + (size_t)r * K + k0) = pack8(f);
    }
    conv_job<true, true>(p.in[30], 1, 1024, 1024, 1024, (bf16_t*)(p.ws + W_O2), 0, base, lds, bid, nb, tid);
    conv_job<true, true>(p.in[31], 1, 1024, 3072, 3072, (bf16_t*)(p.ws + W_QKV3), 2048, base, lds, bid, nb, tid);
    conv_job<true, true>(p.in[36], 1, 1024, 1024, 1024, (bf16_t*)(p.ws + W_O3), 0, base, lds, bid, nb, tid);
    conv_job<true, true>(p.in[11], 32, 1024, 512, 512, (bf16_t*)(p.ws + W_GU), 1, base, lds, bid, nb, tid);
    conv_job(p.in[12], 32, 256, 1024, 1024, (bf16_t*)(p.ws + W_DN), 0, base, lds, bid, nb, tid);
    (void)ws16;
    float* sc = lds;
    for (int i = tid; i < 9 * 1024; i += NTHREADS) {
        const int r = i >> 10, k = i & 1023;
        const float v = r < 8 ? p.in[1][r * 1024 + k] : p.in[3][k];
        sc[i] = silu_f(v);
    }
    __syncthreads();
    float* part = (float*)(p.ws + WS_MODP);
    for (int it = bid; it < 768; it += nb) {
        const int kc = it / 48, rem = it - kc * 48, l = rem / 12, nch = rem - l * 12;
        const int n = nch * 512 + tid;
        const float* w = p.in[4] + ((size_t)l * 1024 + kc * 64) * 6144 + n;
        float acc[9];
#pragma unroll
        for (int r = 0; r < 9; ++r) acc[r] = 0.f;
#pragma unroll 8
        for (int k = 0; k < 64; ++k) {
            const float wv = __builtin_nontemporal_load(w + (size_t)k * 6144);
#pragma unroll
            for (int r = 0; r < 9; ++r) acc[r] += sc[r * 1024 + kc * 64 + k] * wv;
        }
#pragma unroll
        for (int r = 0; r < 9; ++r) part[(((size_t)kc * 4 + l) * 9 + r) * 6144 + n] = acc[r];
    }
    __syncthreads();
}
DI void phase_mod_reduce(const Params& p, int bid, int nb, int tid) {
    const float* part = (const float*)(p.ws + WS_MODP);
    float* mod = (float*)(p.ws + WS_MOD);
    const int total = 4 * 9 * 6144;
    for (int i = bid * NTHREADS + tid; i < total; i += nb * NTHREADS) {
        const int l = i / (9 * 6144), n = i % 6144;
        float s = p.in[5][l * 6144 + n];
#pragma unroll
        for (int kc = 0; kc < 16; ++kc) s += part[(size_t)kc * total + i];
        mod[i] = s;
    }
}

template <int MODE>
DI void phase_rows(const Params& p, int layer  , int which  , int bid, int nb, int tid) {
    const int wid = __builtin_amdgcn_readfirstlane(tid >> 6), lane = tid & 63;
    const float* modall = (const float*)(p.ws + WS_MOD);
    const bf16_t* eo = (const bf16_t*)(p.ws + WS_RAW);
    bf16_t* H = (bf16_t*)(p.ws + WS_H);
    for (int r = bid * NW + wid; r < MROWS; r += nb * NW) {
        const int b = r / PP, pos = r - b * PP;
        if ((MODE & 16) && pos >= SEQ) continue;
        const int mr = pos < SEQ ? b : 8;
        bf16_t* xb = xb_row(p, r);
        float x[16];
        if (MODE & 8) {
            const float* xr = pos < SEQ ? p.in[0] + ((size_t)b * SEQ + pos) * DM : p.in[2] + ((size_t)b * CTXL + (pos - SEQ)) * DM;
#pragma unroll
            for (int j = 0; j < 4; ++j) { const f32x4 v = *(const f32x4*)(xr + lane * 4 + 256 * j); x[4 * j] = v.x; x[4 * j + 1] = v.y; x[4 * j + 2] = v.z; x[4 * j + 3] = v.w; }
        } else {
#pragma unroll
            for (int j = 0; j < 4; ++j) { const u32x2 v = *(const u32x2*)(xb + lane * 4 + 256 * j); x[4 * j] = bflo(v.x); x[4 * j + 1] = bfhi(v.x); x[4 * j + 2] = bflo(v.y); x[4 * j + 3] = bfhi(v.y); }
        }
        if (MODE & 1) {
            const float* g2 = modall + ((size_t)(layer - ((MODE & 2) ? 1 : 0)) * 9 + mr) * 6144 + 5120;
            const bf16_t* y0 = eo + (size_t)(2 * r) * 1024, *y1 = y0 + 1024;
#pragma unroll
            for (int j = 0; j < 4; ++j) {
                const u32x2 a = *(const u32x2*)(y0 + lane * 4 + 256 * j), bb = *(const u32x2*)(y1 + lane * 4 + 256 * j);
                const f32x4 g = *(const f32x4*)(g2 + lane * 4 + 256 * j);
                x[4 * j] += g.x * (bflo(a.x) + bflo(bb.x)); x[4 * j + 1] += g.y * (bfhi(a.x) + bfhi(bb.x));
                x[4 * j + 2] += g.z * (bflo(a.y) + bflo(bb.y)); x[4 * j + 3] += g.w * (bfhi(a.y) + bfhi(bb.y));
            }
        }
        if (MODE & 16) {
            float* orow = p.out + ((size_t)b * SEQ + pos) * DM;
#pragma unroll
            for (int j = 0; j < 4; ++j) *(f32x4*)(orow + lane * 4 + 256 * j) = (f32x4){x[4 * j], x[4 * j + 1], x[4 * j + 2], x[4 * j + 3]};
        } else if (MODE & (1 | 8)) {
#pragma unroll
            for (int j = 0; j < 4; ++j) {
                u32x2 w; w.x = pk2(x[4 * j], x[4 * j + 1]); w.y = pk2(x[4 * j + 2], x[4 * j + 3]);
                *(u32x2*)(xb + lane * 4 + 256 * j) = w;
                x[4 * j] = bflo(w.x); x[4 * j + 1] = bfhi(w.x); x[4 * j + 2] = bflo(w.y); x[4 * j + 3] = bfhi(w.y);
            }
        }
        if (MODE & 2) {
            float ss = 0.f;
#pragma unroll
            for (int i = 0; i < 16; ++i) ss += x[i] * x[i];
            ss = wave_sum(ss);
            const float rs = rsqrtf(ss * (1.0f / 1024.0f) + EPS);
            const float* ng = p.in[6] + ((size_t)layer * 2 + which) * 1024;
            const float* md = modall + ((size_t)layer * 9 + mr) * 6144 + which * 3072;
#pragma unroll
            for (int j = 0; j < 4; ++j) {
                const f32x4 g = *(const f32x4*)(ng + lane * 4 + 256 * j), sh = *(const f32x4*)(md + lane * 4 + 256 * j), sc = *(const f32x4*)(md + 1024 + lane * 4 + 256 * j);
                const float h0 = x[4 * j] * rs * g.x * (1.0f + sc.x) + sh.x, h1 = x[4 * j + 1] * rs * g.y * (1.0f + sc.y) + sh.y;
                const float h2 = x[4 * j + 2] * rs * g.z * (1.0f + sc.z) + sh.z, h3 = x[4 * j + 3] * rs * g.w * (1.0f + sc.w) + sh.w;
                if (MODE & 32) *(unsigned*)((unsigned char*)H + (size_t)r * 1024 + lane * 4 + 256 * j) = cvt_fp8x4(h0, h1, h2, h3);
                else { u32x2 w; w.x = pk2(h0, h1); w.y = pk2(h2, h3); *(u32x2*)(H + (size_t)r * 1024 + lane * 4 + 256 * j) = w; }
            }
        }
    }
}

constexpr size_t WS_RC = WS_MOD + 917504;
DI void phase_router_prep(const Params& p, int bid, int nb, int tid) {
    const float* modall = (const float*)(p.ws + WS_MOD);
    bf16_t* wth = (bf16_t*)(p.ws + WS_RW); bf16_t* wtl = wth + 4 * 9 * 48 * 1024;
    const int total = 4 * 9 * 48 * 1024;
    for (int i = bid * NTHREADS + tid; i < total; i += nb * NTHREADS) {
        const int k = i & 1023, c = (i >> 10) % 48, lb = i / (48 * 1024), l = lb / 9, b = lb - l * 9;
        float v = 0.f;
        if (c < 36) {
            const float w = c < 32 ? p.in[9][((size_t)l * 1024 + k) * 32 + c] : p.in[7][((size_t)l * 1024 + k) * 4 + (c - 32)];
            v = p.in[6][((size_t)l * 2 + 1) * 1024 + k] * (1.0f + modall[((size_t)l * 9 + b) * 6144 + 4096 + k]) * w;
        }
        const unsigned hb = f2bf(v); wth[i] = (bf16_t)hb; wtl[i] = (bf16_t)f2bf(v - bf2f(hb));
    }
    float* cst = (float*)(p.ws + WS_RC);
    const int wid = __builtin_amdgcn_readfirstlane(tid >> 6), lane = tid & 63;
    for (int j = bid * NW + wid; j < 4 * 9 * 48; j += nb * NW) {
        const int c = j % 48, lb = j / 48, l = lb / 9, b = lb - l * 9;
        float acc = 0.f;
        if (c < 36) {
            for (int k = lane; k < 1024; k += 64) {
                const float w = c < 32 ? p.in[9][((size_t)l * 1024 + k) * 32 + c] : p.in[7][((size_t)l * 1024 + k) * 4 + (c - 32)];
                acc += modall[((size_t)l * 9 + b) * 6144 + 3072 + k] * w;
            }
            acc = wave_sum(acc) + (c < 32 ? p.in[10][l * 32 + c] : p.in[8][l * 4 + (c - 32)]);
        }
        if (lane == 0) cst[j] = acc;
    }
}
typedef float f32x2_3 __attribute__((ext_vector_type(2)));
typedef __bf16 bf16x2_3 __attribute__((ext_vector_type(2)));
DI unsigned cvtpk3(float lo, float hi) { f32x2_3 v = {lo, hi}; bf16x2_3 b = __builtin_convertvector(v, bf16x2_3); return __builtin_bit_cast(unsigned, b); }
DI void phase_router(const Params& p, unsigned char* smem, int layer, bool skip_ctx, int bid, int nb, int tid) {
    const int lane = tid & 63, wid = __builtin_amdgcn_readfirstlane(tid >> 6), li = lane & 15, kq = lane >> 4;
    LAS float* tile = (LAS float*)smem + wid * (32 * 49);
    const bf16_t* wth_all = (const bf16_t*)(p.ws + WS_RW) + (size_t)layer * 9 * 48 * 1024;
    const bf16_t* wtl_all = wth_all + 4 * 9 * 48 * 1024;
    const float* cst_all = (const float*)(p.ws + WS_RC) + layer * 9 * 48;
    unsigned* cnt = (unsigned*)(p.ws + WS_CTL) + CW_CNT + layer * 32;
    unsigned* list = (unsigned*)(p.ws + WS_LIST);
    float* gates = (float*)(p.ws + WS_GATE);
    if (layer > 0) {
        int base = 0;
        conv_job<false, true>(p.in[11] + (size_t)layer * 32 * 1024 * 512, 32, 1024, 512, 512, (bf16_t*)(p.ws + W_GU + (size_t)layer * 32 * 512 * 1024), 1, base, (float*)smem, bid, nb, tid);
        conv_job<false>(p.in[12] + (size_t)layer * 32 * 256 * 1024, 32, 256, 1024, 1024, (bf16_t*)(p.ws + W_DN) + (size_t)layer * 32 * 1024 * 256, 0, base, (float*)smem, bid, nb, tid);
    }
    for (int u = bid * NW + wid; u < MROWS / 32; u += nb * NW) {
        const int r0 = u * 32, b = r0 / PP, pos = r0 - b * PP;
        const bool isctx = pos >= SEQ;
        if (skip_ctx && isctx) continue;
        const int mr = isctx ? 8 : b;
        const bf16_t* xr = xb_row(p, r0 + li) + 8 * kq;
        const bf16_t* wh = wth_all + ((size_t)mr * 48 + li) * 1024 + 8 * kq;
        const bf16_t* wl = wtl_all + ((size_t)mr * 48 + li) * 1024 + 8 * kq;
        f32x4 acc[2][3];
#pragma unroll
        for (int m = 0; m < 2; ++m)
#pragma unroll
            for (int n = 0; n < 3; ++n) acc[m][n] = (f32x4){0.f, 0.f, 0.f, 0.f};
        float ss[2] = {0.f, 0.f};
#pragma unroll 2
        for (int s = 0; s < 32; ++s) {
            bf16x8 xa[2], bh[3], bl[3];
#pragma unroll
            for (int m = 0; m < 2; ++m) xa[m] = *(const bf16x8*)(xr + (size_t)m * 16 * DM + 32 * s);
#pragma unroll
            for (int n = 0; n < 3; ++n) { bh[n] = *(const bf16x8*)(wh + (size_t)n * 16 * 1024 + 32 * s); bl[n] = *(const bf16x8*)(wl + (size_t)n * 16 * 1024 + 32 * s); }
#pragma unroll
            for (int m = 0; m < 2; ++m) {
                const u32x4 w = __builtin_bit_cast(u32x4, xa[m]);
                ss[m] += bflo(w.x) * bflo(w.x) + bfhi(w.x) * bfhi(w.x) + bflo(w.y) * bflo(w.y) + bfhi(w.y) * bfhi(w.y) + bflo(w.z) * bflo(w.z) + bfhi(w.z) * bfhi(w.z) + bflo(w.w) * bflo(w.w) + bfhi(w.w) * bfhi(w.w);
#pragma unroll
                for (int n = 0; n < 3; ++n) {
                    acc[m][n] = __builtin_amdgcn_mfma_f32_16x16x32_bf16(xa[m], bl[n], acc[m][n], 0, 0, 0);
                    acc[m][n] = __builtin_amdgcn_mfma_f32_16x16x32_bf16(xa[m], bh[n], acc[m][n], 0, 0, 0);
                }
            }
        }
#pragma unroll
        for (int m = 0; m < 2; ++m) { ss[m] += __shfl_xor(ss[m], 16); ss[m] += __shfl_xor(ss[m], 32); }
#pragma unroll
        for (int m = 0; m < 2; ++m)
#pragma unroll
            for (int n = 0; n < 3; ++n)
#pragma unroll
                for (int i = 0; i < 4; ++i) tile[(16 * m + 4 * kq + i) * 49 + n * 16 + li] = acc[m][n][i];
        __builtin_amdgcn_s_waitcnt(0xc07f);
        const float ssr = (lane & 16) ? ss[1] : ss[0];
        const float rs = rsqrtf(ssr * (1.0f / 1024.0f) + EPS);
        if (lane < 32) {
            const float* cst = cst_all + mr * 48;
            const LAS float* tr = tile + lane * 49;
            float lg[4];
#pragma unroll
            for (int c = 0; c < 4; ++c) lg[c] = tr[32 + c] * rs + cst[32 + c];
            int gi = 0; float gm = lg[0];
#pragma unroll
            for (int c = 1; c < 4; ++c) if (lg[c] > gm) { gm = lg[c]; gi = c; }
            float gden = 0.f;
#pragma unroll
            for (int c = 0; c < 4; ++c) gden += __expf(lg[c] - gm);
            const float gw = 1.0f / gden;
            float le[8];
#pragma unroll
            for (int c = 0; c < 8; ++c) le[c] = tr[gi * 8 + c] * rs + cst[gi * 8 + c];
            int e0 = 0; float m0 = le[0];
#pragma unroll
            for (int c = 1; c < 8; ++c) if (le[c] > m0) { m0 = le[c]; e0 = c; }
            int e1 = -1; float m1 = -INFINITY;
#pragma unroll
            for (int c = 0; c < 8; ++c) if (c != e0 && le[c] > m1) { m1 = le[c]; e1 = c; }
            const float q1 = __expf(m1 - m0), inv = 1.0f / (1.0f + q1);
            const int r = r0 + lane, ex0 = gi * 8 + e0, ex1 = gi * 8 + e1;
            const unsigned s0 = atomicAdd(cnt + ex0, 1u), s1 = atomicAdd(cnt + ex1, 1u);
            list[(size_t)ex0 * MROWS + s0] = 2u * r; list[(size_t)ex1 * MROWS + s1] = 2u * r + 1u;
            gates[2 * r] = gw * inv; gates[2 * r + 1] = gw * q1 * inv;
        }
        {
            const float* ng = p.in[6] + ((size_t)layer * 2 + 1) * 1024;
            const float* md = (const float*)(p.ws + WS_MOD) + ((size_t)layer * 9 + mr) * 6144 + 3072;
            f32x4 gm[4], sh[4];
#pragma unroll
            for (int j = 0; j < 4; ++j) {
                const f32x4 g = *(const f32x4*)(ng + lane * 4 + 256 * j), sc = *(const f32x4*)(md + 1024 + lane * 4 + 256 * j);
                sh[j] = *(const f32x4*)(md + lane * 4 + 256 * j);
                gm[j] = (f32x4){g.x * (1.0f + sc.x), g.y * (1.0f + sc.y), g.z * (1.0f + sc.z), g.w * (1.0f + sc.w)};
            }
            unsigned char* H8 = p.ws + WS_H;
#pragma unroll 4
            for (int i = 0; i < 32; ++i) {
                const float rsi = __shfl(rs, i);
                const bf16_t* xb = xb_row(p, r0 + i);
#pragma unroll
                for (int j = 0; j < 4; ++j) {
                    const u32x2 v = *(const u32x2*)(xb + lane * 4 + 256 * j);
                    *(unsigned*)(H8 + (size_t)(r0 + i) * 1024 + lane * 4 + 256 * j) =
                        cvt_fp8x4(bflo(v.x) * rsi * gm[j].x + sh[j].x, bfhi(v.x) * rsi * gm[j].y + sh[j].y, bflo(v.y) * rsi * gm[j].z + sh[j].z, bfhi(v.y) * rsi * gm[j].w + sh[j].w);
                }
            }
        }
    }
}

#define MFMA32(a, b, c) __builtin_amdgcn_mfma_f32_32x32x16_bf16((a), (b), (c), 0, 0, 0)
typedef LAS unsigned char* lds_ptr;
constexpr int GEMM_TM = 256, GEMM_TN = 256;
constexpr int GEMM_STAGE = 65536;
constexpr int GEMM_LDS = 2 * GEMM_STAGE;
constexpr int GEMM_MT = 4;

struct RowDense { static constexpr bool DENSE = true; const bf16_t* A; int lda; int m0; DI unsigned row(int i) const { return (unsigned)(m0 + i) * (unsigned)lda; } };
struct RowGather { static constexpr bool DENSE = false; const bf16_t* A; int lda; const unsigned* ent; int valid; int shift;
    DI unsigned row(int i) const { const unsigned e = ent[i < valid ? i : valid - 1]; return (e >> shift) * (unsigned)lda; } };

struct EpiStore { bf16_t* C; int ldc; int m0;
    DI void wave_tile(const f32x16 (&acc)[2][GEMM_MT], int mloc, int ncol, int lane) const {
        const int r = lane & 31, h = lane >> 5;
#pragma unroll
        for (int mt = 0; mt < GEMM_MT; ++mt) {
            bf16_t* c = C + (size_t)(m0 + mloc + mt * 32 + r) * ldc + ncol + 4 * h;
#pragma unroll
            for (int nt = 0; nt < 2; ++nt)
#pragma unroll
                for (int g = 0; g < 4; ++g) {
                    u32x2 w; w.x = pk2(acc[nt][mt][4 * g], acc[nt][mt][4 * g + 1]); w.y = pk2(acc[nt][mt][4 * g + 2], acc[nt][mt][4 * g + 3]);
                    *(u32x2*)(c + nt * 32 + 8 * g) = w;
                }
        }
    } };
struct EpiResid { const Params* p; const float* mod; int m0;
    DI void wave_tile(const f32x16 (&acc)[2][GEMM_MT], int mloc, int ncol, int lane) const {
        const int r = lane & 31, h = lane >> 5;
#pragma unroll
        for (int mt = 0; mt < GEMM_MT; ++mt) {
            const int row = m0 + mloc + mt * 32 + r;
            float* xr = xrow_ptr(*p, row) + ncol + 4 * h;
            const float* gp = mod + (size_t)mod_row(row) * 6144 + 2048 + ncol + 4 * h;
#pragma unroll
            for (int nt = 0; nt < 2; ++nt)
#pragma unroll
                for (int g = 0; g < 4; ++g) {
                    f32x4 x = *(f32x4*)(xr + nt * 32 + 8 * g);
                    const f32x4 gg = *(const f32x4*)(gp + nt * 32 + 8 * g);
                    x.x += gg.x * acc[nt][mt][4 * g]; x.y += gg.y * acc[nt][mt][4 * g + 1]; x.z += gg.z * acc[nt][mt][4 * g + 2]; x.w += gg.w * acc[nt][mt][4 * g + 3];
                    *(f32x4*)(xr + nt * 32 + 8 * g) = x;
                }
        }
    } };
struct EpiGlu { bf16_t* act; const unsigned* ent; const float* gates; int valid;
    DI void wave_tile(const f32x16 (&acc)[2][GEMM_MT], int mloc, int ncol, int lane) const {
        const int r = lane & 31, h = lane >> 5;
#pragma unroll
        for (int mt = 0; mt < GEMM_MT; ++mt) {
            const int i = mloc + mt * 32 + r;
            if (i < valid) {
                const unsigned a = ent[i];
                const float gw = gates[a];
                bf16_t* o = act + (size_t)a * DEXP + (ncol >> 6) * 32 + 4 * h;
#pragma unroll
                for (int g = 0; g < 4; ++g) {
                    float v[4];
#pragma unroll
                    for (int j = 0; j < 4; ++j) v[j] = silu_f(acc[0][mt][4 * g + j]) * acc[1][mt][4 * g + j] * gw;
                    u32x2 w; w.x = pk2(v[0], v[1]); w.y = pk2(v[2], v[3]);
                    *(u32x2*)(o + 8 * g) = w;
                }
            }
        }
    } };
struct EpiScatter { bf16_t* outp; const unsigned* ent; int valid;
    DI void wave_tile(const f32x16 (&acc)[2][GEMM_MT], int mloc, int ncol, int lane) const {
        const int r = lane & 31, h = lane >> 5;
#pragma unroll
        for (int mt = 0; mt < GEMM_MT; ++mt) {
            const int i = mloc + mt * 32 + r;
            if (i < valid) {
                bf16_t* c = outp + (size_t)ent[i] * 1024 + ncol + 4 * h;
#pragma unroll
                for (int nt = 0; nt < 2; ++nt)
#pragma unroll
                    for (int g = 0; g < 4; ++g) {
                        u32x2 w; w.x = pk2(acc[nt][mt][4 * g], acc[nt][mt][4 * g + 1]); w.y = pk2(acc[nt][mt][4 * g + 2], acc[nt][mt][4 * g + 3]);
                        *(u32x2*)(c + nt * 32 + 8 * g) = w;
                    }
            }
        }
    } };

#define SCHED_FENCE() __builtin_amdgcn_sched_barrier(0)
DI void glds16(const bf16_t* g, lds_ptr l) { __builtin_amdgcn_global_load_lds((const unsigned*)g, (LAS unsigned*)l, 16, 0, 0); }
template <int PROBE, int NAG>
DI void gemm_kstep(f32x16 (&acc)[2][GEMM_MT], const lds_ptr st, const unsigned (&arow)[GEMM_MT], const unsigned (&wrow)[2], const unsigned (&aswz)[GEMM_MT], const unsigned (&wswz)[2], int h,
                   bool issue, const bf16_t* __restrict__ An, const bf16_t* __restrict__ Wn, const unsigned (&ag)[NAG], unsigned astep, const unsigned (&bg)[2], unsigned bstep, const lds_ptr sn) {
    if (PROBE != 2 && issue) {
#pragma unroll
        for (int j = 0; j < 8; ++j) { glds16(An + (NAG == 2 ? ag[j & 1] + (j >> 1) * astep : ag[j % NAG]), sn + j * 1024); glds16(Wn + bg[j & 1] + (j >> 1) * bstep, sn + 32768 + j * 1024); }
    }
    if (PROBE == 1) return;
    bf16x8 af[2][GEMM_MT], wf[2][2];
#pragma unroll
    for (int t = 0; t < 2; ++t) wf[0][t] = *(const LAS bf16x8*)(st + wrow[t] + ((((unsigned)h) ^ wswz[t]) << 4));
#pragma unroll
    for (int t = 0; t < GEMM_MT; ++t) af[0][t] = *(const LAS bf16x8*)(st + arow[t] + ((((unsigned)h) ^ aswz[t]) << 4));
#pragma unroll
    for (int kk = 0; kk < 4; ++kk) {
        if (kk < 3) {
#pragma unroll
            for (int t = 0; t < 2; ++t) wf[(kk + 1) & 1][t] = *(const LAS bf16x8*)(st + wrow[t] + ((((unsigned)((kk + 1) * 2 + h)) ^ wswz[t]) << 4));
#pragma unroll
            for (int t = 0; t < GEMM_MT; ++t) af[(kk + 1) & 1][t] = *(const LAS bf16x8*)(st + arow[t] + ((((unsigned)((kk + 1) * 2 + h)) ^ aswz[t]) << 4));
        }
        SCHED_FENCE();
        __builtin_amdgcn_s_setprio(1);
#pragma unroll
        for (int mt = 0; mt < GEMM_MT; ++mt)
#pragma unroll
            for (int nt = 0; nt < 2; ++nt) acc[nt][mt] = MFMA32(wf[kk & 1][nt], af[kk & 1][mt], acc[nt][mt]);
        __builtin_amdgcn_s_setprio(0);
        SCHED_FENCE();
    }
}
template <class RowSrc, class Epi, int PROBE = 0>
DI void gemm_tile_mfma(unsigned char* smem, const RowSrc& rs, const bf16_t* __restrict__ Wt, int K, int n0, const Epi& epi, int tid) {
    const lds_ptr lds = (lds_ptr)smem;
    const int lane = tid & 63, wid = __builtin_amdgcn_readfirstlane(tid >> 6), wm = wid & 1, wn = wid >> 1, r = lane & 31, h = lane >> 5;
    const bool loader = wid < 4;
    const int lw = wid & 3;
    constexpr int NAG = RowSrc::DENSE ? 2 : 8;
    unsigned ag[NAG], bg[2];
    const bf16_t* __restrict__ Ab = rs.A;
#pragma unroll
    for (int j = 0; j < NAG; ++j) {
        const int row = (lw * 8 + j) * 8 + (lane >> 3), c = (lane & 7) ^ ((row >> 1) & 7);
        ag[j] = rs.row(row) + c * 8;
    }
#pragma unroll
    for (int j = 0; j < 2; ++j) {
        const int row = (lw * 8 + j) * 8 + (lane >> 3), c = (lane & 7) ^ ((row >> 1) & 7);
        bg[j] = (unsigned)(n0 + row) * (unsigned)K + c * 8;
    }
    const unsigned astep = 16u * (unsigned)rs.lda, bstep = 16u * (unsigned)K;
    const unsigned dmaoff = (unsigned)lw * 8192u;
    unsigned arow[GEMM_MT], wrow[2], aswz[GEMM_MT], wswz[2];
#pragma unroll
    for (int t = 0; t < GEMM_MT; ++t) { const int ra = wm * 128 + t * 32 + r; arow[t] = ra * 128; aswz[t] = (ra >> 1) & 7; }
#pragma unroll
    for (int t = 0; t < 2; ++t) { const int rw = wn * 64 + t * 32 + r; wrow[t] = 32768 + rw * 128; wswz[t] = (rw >> 1) & 7; }
    f32x16 acc[2][GEMM_MT];
#pragma unroll
    for (int a = 0; a < 2; ++a)
#pragma unroll
        for (int b = 0; b < GEMM_MT; ++b)
#pragma unroll
            for (int i = 0; i < 16; ++i) acc[a][b][i] = 0.f;
    if (loader) {
#pragma unroll
        for (int j = 0; j < 8; ++j) { glds16(Ab + (NAG == 2 ? ag[j & 1] + (j >> 1) * astep : ag[j % NAG]), lds + dmaoff + j * 1024); glds16(Wt + bg[j & 1] + (j >> 1) * bstep, lds + 32768 + dmaoff + j * 1024); }
    }
    asm volatile("s_waitcnt vmcnt(0)" ::: "memory");
    __syncthreads();
    const int KT = K >> 6;
    for (int kt = 0; kt < KT; ++kt) {
        gemm_kstep<PROBE, NAG>(acc, lds + (kt & 1) * GEMM_STAGE, arow, wrow, aswz, wswz, h, loader && kt + 1 < KT, Ab + (kt + 1) * 64, Wt + (kt + 1) * 64, ag, astep, bg, bstep, lds + ((kt + 1) & 1) * GEMM_STAGE + dmaoff);
        asm volatile("s_waitcnt vmcnt(0)" ::: "memory");
        __syncthreads();
    }
    if (PROBE == 0 || acc[0][0][0] == 12345.678f) epi.wave_tile(acc, wm * 128, n0 + wn * 64, lane);
}

template <int EPIK, int PROBE = 0>
DI void gemm_dense(const Params& p, unsigned char* smem, const bf16_t* A, int lda, const bf16_t* Wt, int K, int N, bf16_t* C, int ldc, const float* mod, int bid, int nb, int tid) {
    const int tn = N / GEMM_TN, total = (MROWS / GEMM_TM) * tn;
    for (int t = bid; t < total; t += nb) {
        const int mt = t / tn, nt = t - mt * tn;
        RowDense rs{A, lda, mt * GEMM_TM};
        if (EPIK == 0) { EpiStore e{C, ldc, mt * GEMM_TM}; gemm_tile_mfma<RowDense, EpiStore, PROBE>(smem, rs, Wt, K, nt * GEMM_TN, e, tid); }
        else { EpiResid e{&p, mod, mt * GEMM_TM}; gemm_tile_mfma(smem, rs, Wt, K, nt * GEMM_TN, e, tid); }
    }
}
template <int WHICH>
DI void gemm_moe(const Params& p, unsigned char* smem, int layer, int bid, int nb, int tid) {
    const unsigned* cnt = (const unsigned*)(p.ws + WS_CTL) + CW_CNT + layer * 32;
    const unsigned* list = (const unsigned*)(p.ws + WS_LIST);
    const float* gates = (const float*)(p.ws + WS_GATE);
    const bf16_t* H = (const bf16_t*)(p.ws + WS_H);
    bf16_t* act = (bf16_t*)(p.ws + WS_Q);
    bf16_t* eo = (bf16_t*)(p.ws + WS_RAW);
    constexpr int TN = WHICH == 0 ? 2 : 4;
    int total = 0;
    for (int e = 0; e < NEXP; ++e) total += (int)((cnt[e] + 255u) >> 8) * TN;
    for (int t = bid; t < total; t += nb) {
        int e = 0, rem = t;
        for (; e < NEXP; ++e) { const int te = (int)((cnt[e] + 255u) >> 8) * TN; if (rem < te) break; rem -= te; }
        const int rt = rem / TN, ct = rem - rt * TN;
        const unsigned* ent = list + (size_t)e * MROWS + rt * GEMM_TM;
        const int valid = min(GEMM_TM, (int)cnt[e] - rt * GEMM_TM);
        if (WHICH == 0) {
            RowGather rs{H, 1024, ent, valid, 1};
            EpiGlu ep{act, ent, gates, valid};
            gemm_tile_mfma(smem, rs, (const bf16_t*)(p.ws + W_GU) + ((size_t)layer * 32 + e) * 512 * 1024, 1024, ct * GEMM_TN, ep, tid);
        } else {
            RowGather rs{act, DEXP, ent, valid, 0};
            EpiScatter ep{eo, ent, valid};
            gemm_tile_mfma(smem, rs, (const bf16_t*)(p.ws + W_DN) + ((size_t)layer * 32 + e) * 1024 * 256, 256, ct * GEMM_TN, ep, tid);
        }
    }
}

DI float quad_sum(float v) { v += __shfl_xor(v, 1); v += __shfl_xor(v, 2); return v; }
DI void head64_norm_rope(const bf16_t* src, bf16_t* dst, const float* gain, int sub, bool rope, int prow, int pcol, float scale) {
    float a[8], b[8];
    unpack8(*(const u32x4*)(src + sub * 8), a); unpack8(*(const u32x4*)(src + 32 + sub * 8), b);
    float ss = 0.f;
#pragma unroll
    for (int e = 0; e < 8; ++e) ss += a[e] * a[e] + b[e] * b[e];
    ss = quad_sum(ss);
    const float rs = rsqrtf(ss * (1.0f / 64.0f) + EPS);
#pragma unroll
    for (int e = 0; e < 8; ++e) { a[e] *= rs * gain[sub * 8 + e]; b[e] *= rs * gain[32 + sub * 8 + e]; }
    if (rope) {
#pragma unroll
        for (int e = 0; e < 8; ++e) {
            const int i = sub * 8 + e;
            const float* cs = ROPE64 + ((i < 16 ? prow : pcol) * 16 + (i & 15)) * 2;
            const float c = cs[0], s = cs[1], x1 = a[e], x2 = b[e];
            a[e] = x1 * c - x2 * s; b[e] = x2 * c + x1 * s;
        }
    }
#pragma unroll
    for (int e = 0; e < 8; ++e) { a[e] *= scale; b[e] *= scale; }
    *(u32x4*)(dst + sub * 8) = pack8(a); *(u32x4*)(dst + 32 + sub * 8) = pack8(b);
}
template <int KIND>
DI void phase_post_qk(const Params& p, int bid, int nb, int tid) {
    const int wid = __builtin_amdgcn_readfirstlane(tid >> 6), lane = tid & 63, hd = lane >> 2, sub = lane & 3;
    constexpr int NRAW = KIND == 1 ? 1536 : 3072, KH = KIND == 1 ? 4 : 16;
    const bf16_t* raw = (const bf16_t*)(p.ws + WS_RAW);
    bf16_t* Q = (bf16_t*)(p.ws + WS_Q); bf16_t* Kb = (bf16_t*)(p.ws + WS_K);
    const float* qn = p.in[KIND == 0 ? 15 : KIND == 1 ? 20 : 32];
    const float* kn = p.in[KIND == 0 ? 16 : KIND == 1 ? 21 : 33];
    const float qscale = 0.125f * LOG2E;
    for (int r = bid * NW + wid; r < MROWS; r += nb * NW) {
        const int b = r / PP, pos = r - b * PP;
        const bool rope = (KIND != 0) && pos < SEQ;
        const int prow = (pos >> 6) & 63, pcol = pos & 63;
        const bf16_t* rr = raw + (size_t)r * NRAW;
        head64_norm_rope(rr + hd * 64, Q + (size_t)r * 1024 + hd * 64, qn, sub, rope, prow, pcol, qscale);
        if (hd < KH) head64_norm_rope(rr + 1024 + hd * 64, Kb + (size_t)r * (KH * 64) + hd * 64, kn, sub, rope, prow, pcol, 1.0f);
    }
}
DI void phase_post_mla1(const Params& p, int bid, int nb, int tid) {
    const int wid = __builtin_amdgcn_readfirstlane(tid >> 6), lane = tid & 63;
    const bf16_t* raw = (const bf16_t*)(p.ws + WS_Q);
    bf16_t* cqn = (bf16_t*)(p.ws + WS_O);
    bf16_t* ckvn = cqn + (size_t)MROWS * 384;
    bf16_t* krope = ckvn + (size_t)MROWS * 256;
    const float* qa = p.in[24]; const float* kva = p.in[25]; const float* kn = p.in[29];
    for (int r = bid * NW + wid; r < MROWS; r += nb * NW) {
        const int b = r / PP, pos = r - b * PP;
        const bf16_t* rr = raw + (size_t)r * 768;
        {
            float v[6];
#pragma unroll
            for (int j = 0; j < 3; ++j) { const unsigned w = *(const unsigned*)(rr + lane * 6 + 2 * j); v[2 * j] = bflo(w); v[2 * j + 1] = bfhi(w); }
            float ss = 0.f;
#pragma unroll
            for (int j = 0; j < 6; ++j) ss += v[j] * v[j];
            ss = wave_sum(ss);
            const float rs = rsqrtf(ss * (1.0f / 384.0f) + EPS);
#pragma unroll
            for (int j = 0; j < 3; ++j) *(unsigned*)(cqn + (size_t)r * 384 + lane * 6 + 2 * j) = pk2(v[2 * j] * rs * qa[lane * 6 + 2 * j], v[2 * j + 1] * rs * qa[lane * 6 + 2 * j + 1]);
        }
        {
            const u32x2 w = *(const u32x2*)(rr + 384 + lane * 4);
            float v[4] = {bflo(w.x), bfhi(w.x), bflo(w.y), bfhi(w.y)};
            float ss = v[0] * v[0] + v[1] * v[1] + v[2] * v[2] + v[3] * v[3];
            ss = wave_sum(ss);
            const float rs = rsqrtf(ss * (1.0f / 256.0f) + EPS);
            u32x2 o; o.x = pk2(v[0] * rs * kva[lane * 4], v[1] * rs * kva[lane * 4 + 1]); o.y = pk2(v[2] * rs * kva[lane * 4 + 2], v[3] * rs * kva[lane * 4 + 3]);
            *(u32x2*)(ckvn + (size_t)r * 256 + lane * 4) = o;
        }
        {
            float x1 = 0.f, x2 = 0.f;
            if (lane < 16) { x1 = bf2f(rr[640 + lane]); x2 = bf2f(rr[640 + 16 + lane]); }
            float ss = wave_sum(x1 * x1 + x2 * x2);
            const float rs = rsqrtf(ss * (1.0f / 32.0f) + EPS);
            if (lane < 16) {
                x1 *= rs * kn[64 + lane]; x2 *= rs * kn[64 + 16 + lane];
                if (pos < SEQ) {
                    const int prow = (pos >> 6) & 63, pcol = pos & 63;
                    const float* cs = ROPE32 + ((lane < 8 ? prow : pcol) * 8 + (lane & 7)) * 2;
                    const float c = cs[0], s = cs[1], a = x1, bb = x2;
                    x1 = a * c - bb * s; x2 = bb * c + a * s;
                }
                bf16_t* kr = (bf16_t*)(p.ws + WS_K) + (size_t)r * 1536 + 64;
                const bf16_t b1 = (bf16_t)f2bf(x1), b2 = (bf16_t)f2bf(x2);
#pragma unroll
                for (int hh = 0; hh < 16; ++hh) { kr[hh * 96 + lane] = b1; kr[hh * 96 + 16 + lane] = b2; }
            }
        }
    }
}
DI void phase_post_mla2(const Params& p, int bid, int nb, int tid) {
    const int wid = __builtin_amdgcn_readfirstlane(tid >> 6), lane = tid & 63, hd = lane >> 2, sub = lane & 3;
    const bf16_t* qraw = (const bf16_t*)(p.ws + WS_RAW);
    const bf16_t* kvraw = qraw + (size_t)MROWS * 1536;
    const bf16_t* krope = (const bf16_t*)(p.ws + WS_O) + (size_t)MROWS * 640;
    bf16_t* Q = (bf16_t*)(p.ws + WS_Q); bf16_t* Kb = (bf16_t*)(p.ws + WS_K);
    const float* qn = p.in[28]; const float* kn = p.in[29];
    const float qscale = 0.10206207261596577f * LOG2E;
    for (int r = bid * NW + wid; r < MROWS; r += nb * NW) {
        const int b = r / PP, pos = r - b * PP;
        const bf16_t* qr = qraw + (size_t)r * 1536 + hd * 96;
        bf16_t* qo = Q + (size_t)r * 1536 + hd * 96;
        {
            float a[8], c[8];
            unpack8(*(const u32x4*)(qr + sub * 16), a); unpack8(*(const u32x4*)(qr + sub * 16 + 8), c);
            float ss = 0.f;
#pragma unroll
            for (int e = 0; e < 8; ++e) ss += a[e] * a[e] + c[e] * c[e];
            ss = quad_sum(ss);
            const float rs = rsqrtf(ss * (1.0f / 64.0f) + EPS) * qscale;
#pragma unroll
            for (int e = 0; e < 8; ++e) { a[e] *= rs * qn[sub * 16 + e]; c[e] *= rs * qn[sub * 16 + 8 + e]; }
            *(u32x4*)(qo + sub * 16) = pack8(a); *(u32x4*)(qo + sub * 16 + 8) = pack8(c);
        }
        {
            const u32x2 w1 = *(const u32x2*)(qr + 64 + sub * 4), w2 = *(const u32x2*)(qr + 64 + 16 + sub * 4);
            float x1[4] = {bflo(w1.x), bfhi(w1.x), bflo(w1.y), bfhi(w1.y)}, x2[4] = {bflo(w2.x), bfhi(w2.x), bflo(w2.y), bfhi(w2.y)};
            float ss = 0.f;
#pragma unroll
            for (int e = 0; e < 4; ++e) ss += x1[e] * x1[e] + x2[e] * x2[e];
            ss = quad_sum(ss);
            const float rs = rsqrtf(ss * (1.0f / 32.0f) + EPS);
#pragma unroll
            for (int e = 0; e < 4; ++e) {
                const int i = sub * 4 + e;
                float a = x1[e] * rs * qn[64 + i], bb = x2[e] * rs * qn[64 + 16 + i];
                if (pos < SEQ) {
                    const int prow = (pos >> 6) & 63, pcol = pos & 63;
                    const float* cs = ROPE32 + ((i < 8 ? prow : pcol) * 8 + (i & 7)) * 2;
                    const float c = cs[0], s = cs[1], t1 = a, t2 = bb;
                    a = t1 * c - t2 * s; bb = t2 * c + t1 * s;
                }
                x1[e] = a * qscale; x2[e] = bb * qscale;
            }
            u32x2 o1, o2; o1.x = pk2(x1[0], x1[1]); o1.y = pk2(x1[2], x1[3]); o2.x = pk2(x2[0], x2[1]); o2.y = pk2(x2[2], x2[3]);
            *(u32x2*)(qo + 64 + sub * 4) = o1; *(u32x2*)(qo + 64 + 16 + sub * 4) = o2;
        }
        {
            const bf16_t* kr = kvraw + (size_t)r * 2048 + hd * 128;
            bf16_t* ko = Kb + (size_t)r * 1536 + hd * 96;
            float a[8], c[8];
            unpack8(*(const u32x4*)(kr + sub * 16), a); unpack8(*(const u32x4*)(kr + sub * 16 + 8), c);
            float ss = 0.f;
#pragma unroll
            for (int e = 0; e < 8; ++e) ss += a[e] * a[e] + c[e] * c[e];
            ss = quad_sum(ss);
            const float rs = rsqrtf(ss * (1.0f / 64.0f) + EPS);
#pragma unroll
            for (int e = 0; e < 8; ++e) { a[e] *= rs * kn[sub * 16 + e]; c[e] *= rs * kn[sub * 16 + 8 + e]; }
            *(u32x4*)(ko + sub * 16) = pack8(a); *(u32x4*)(ko + sub * 16 + 8) = pack8(c);
            *(u32x4*)(ko + 64 + sub * 8) = *(const u32x4*)(krope + (size_t)r * 32 + sub * 8);
        }
    }
}
DI void phase_diff_combine(const Params& p, int bid, int nb, int tid) {
    const int wid = __builtin_amdgcn_readfirstlane(tid >> 6), lane = tid & 63, hd = lane >> 3, sub = lane & 7;
    const bf16_t* O12 = (const bf16_t*)(p.ws + WS_H);
    bf16_t* Oc = (bf16_t*)(p.ws + WS_Q);
    const float* lam = p.in[34]; const float* subln = p.in[35];
    const float lambda_init = 0.8f - 0.6f * 0.40656965974059917f;
    const float s1 = wave_sum(lam[lane] * lam[64 + lane]), s2 = wave_sum(lam[128 + lane] * lam[192 + lane]);
    const float lam_full = expf(s1) - expf(s2) + lambda_init;
    for (int r = bid * NW + wid; r < MROWS; r += nb * NW) {
        const bf16_t* o1 = O12 + (size_t)r * 2048 + (2 * hd) * 128 + sub * 16, *o2 = o1 + 128;
        float a[16], c[16];
        unpack8(*(const u32x4*)o1, *(float(*)[8])a); unpack8(*(const u32x4*)(o1 + 8), *(float(*)[8])(a + 8));
        unpack8(*(const u32x4*)o2, *(float(*)[8])c); unpack8(*(const u32x4*)(o2 + 8), *(float(*)[8])(c + 8));
        float ss = 0.f;
#pragma unroll
        for (int e = 0; e < 16; ++e) { a[e] -= lam_full * c[e]; ss += a[e] * a[e]; }
        ss += __shfl_xor(ss, 1); ss += __shfl_xor(ss, 2); ss += __shfl_xor(ss, 4);
        const float rs = rsqrtf(ss * (1.0f / 128.0f) + EPS) * (1.0f - lambda_init);
#pragma unroll
        for (int e = 0; e < 16; ++e) a[e] *= rs * subln[sub * 16 + e];
        bf16_t* o = Oc + (size_t)r * 1024 + hd * 128 + sub * 16;
        *(u32x4*)o = pack8(*(float(*)[8])a); *(u32x4*)(o + 8) = pack8(*(float(*)[8])(a + 8));
    }
}


typedef short s16x4 __attribute__((ext_vector_type(4)));
typedef float f32x2_t __attribute__((ext_vector_type(2)));
typedef __bf16 bf16x2_t __attribute__((ext_vector_type(2)));
DI unsigned cvtpk(float lo, float hi) { f32x2_t v = {lo, hi}; bf16x2_t b = __builtin_convertvector(v, bf16x2_t); return __builtin_bit_cast(unsigned, b); }
DI float xhalf_max(float v) { auto rr = __builtin_amdgcn_permlane32_swap(__float_as_uint(v), __float_as_uint(v), false, false); return fmaxf(__uint_as_float(rr[0]), __uint_as_float(rr[1])); }
DI float xhalf_sum(float v) { auto rr = __builtin_amdgcn_permlane32_swap(__float_as_uint(v), __float_as_uint(v), false, false); return __uint_as_float(rr[0]) + __uint_as_float(rr[1]); }
typedef short v4i16_t __attribute__((__vector_size__(4 * sizeof(short))));
DI s16x4 lds_tr(lds_ptr p) { return __builtin_bit_cast(s16x4, __builtin_amdgcn_ds_read_tr16_b64_v4i16((LAS v4i16_t*)p)); }
constexpr float ATT_BIG = 40.0f, ATT_BIGF = 1.0995116e12f;
DI int crow(int i, int hf) { return (i & 3) + 8 * (i >> 2) + 4 * hf; }

struct AttnP { const bf16_t* Q; int ldq; const bf16_t* K; int ldk; const bf16_t* V; int ldv; bf16_t* O; int ldo; int HQ; int gk; int gv; int vhs  ; const float* bias; const float* sink; int need_ctx; const float* kgain  ; const float* lam; const float* subln; unsigned char* Oc; int ldoc;   };

template <int DQ, int DV, int MODE, int ABL = 0>
DI void attn_mfma(const AttnP& a, unsigned char* smem, int bid, int nb, int tid) {
    constexpr int KSTR = DQ * 2 + 16, KTB = 64 * KSTR, VTB = 64 * DV * 2, NDB = DV / 32, NKK = DQ / 16;
    constexpr int KCH = DQ / 8, VCH = DV / 8, NKI = (64 * KCH + NTHREADS - 1) / NTHREADS, NVI = (64 * VCH + NTHREADS - 1) / NTHREADS;
    static_assert(2 * KTB + 2 * VTB + 2048 <= GEMM_LDS, "attention LDS");
    const lds_ptr lds = (lds_ptr)smem;
    LAS float* biasl = (LAS float*)(lds + 2 * KTB + 2 * VTB);
    const int lane = tid & 63, wid = __builtin_amdgcn_readfirstlane(tid >> 6), r = lane & 31, hf = lane >> 5;
    const int nq = a.need_ctx ? 17 : 16;
    const int xcd = bid & 7, slot = bid >> 3, nslots = nb >> 3, per_xcd = (NBATCH * a.HQ / 8) * nq;
    int koff[NKI], kdst[NKI], voff[NVI], vdst[NVI];
#pragma unroll
    for (int i = 0; i < NKI; ++i) { const int c = min(tid + NTHREADS * i, 64 * KCH - 1), row = c / KCH, kc = c - row * KCH; koff[i] = row * a.ldk + kc * 8; kdst[i] = row * KSTR + kc * 16; }
#pragma unroll
    for (int i = 0; i < NVI; ++i) { const int c = tid + NTHREADS * i, row = c / VCH, vc = c - row * VCH; voff[i] = row * a.ldv + vc * 8; vdst[i] = ((row >> 3) * NDB + (vc >> 2)) * 512 + (row & 7) * 64 + (vc & 3) * 16; }
    const int i16 = lane & 15, trq = i16 >> 2, trp = i16 & 3, grp = (lane >> 4) & 1;
    const int vtr0 = (4 * hf + trq) * 64 + 32 * grp + 8 * trp;
    constexpr bool PAIRED = (MODE == 2 && DV == 128);
    float lam_full = 0.f;
    if (PAIRED) { const float s1 = wave_sum(a.lam[lane] * a.lam[64 + lane]), s2 = wave_sum(a.lam[128 + lane] * a.lam[192 + lane]); lam_full = expf(s1) - expf(s2) + (0.8f - 0.6f * 0.40656965974059917f); }
    int it_i = 0;
    for (int j = slot; j < per_xcd; j += nslots, ++it_i) {
        const int nbh = NBATCH * a.HQ / 8;
        const int bhl = j < nbh * 16 ? j >> 4 : j - nbh * 16;
        int qt = j < nbh * 16 ? j & 15 : 16;
        int bh = bhl * 8 + xcd;
        if (MODE == 1) { const int P = (bhl >> 2) * 8 + xcd; bh = (P >> 2) * a.HQ + (P & 3) * 4 + (bhl & 3); }
        if (PAIRED) { const int pu = slot + nslots * (it_i >> 1); qt = pu & 15; bh = (pu >> 4) * a.HQ + 2 * xcd + (it_i & 1); }
        const int h = bh % a.HQ, b = bh / a.HQ;
        const bool is_ctx = qt >= 16;
        const int q0 = is_ctx ? SEQ : qt * 256;
        int t_lo = 0, n_lat = 0;
        if (!is_ctx) {
            if (MODE == 2) { t_lo = 0; n_lat = 64; }
            else if (MODE == 1) { t_lo = max(0, 4 * qt - 2); n_lat = min(63, 4 * qt + 5) - t_lo + 1; }
            else { const int r0 = 4 * qt; t_lo = min(max(r0 - 4, 0), 56); n_lat = min(max(r0 - 1, 0), 56) + 7 - t_lo + 1; }
        }
        const int ntiles = n_lat + 4;
        const int qw0 = q0 + wid * 32, qpos = qw0 + r;
        const size_t qrow = (size_t)b * PP + qpos;
        bf16x8 qf[NKK];
#pragma unroll
        for (int kk = 0; kk < NKK; ++kk) qf[kk] = *(const bf16x8*)(a.Q + qrow * a.ldq + h * DQ + kk * 16 + hf * 8);
        if (MODE == 0 && !is_ctx) { for (int i = tid; i < 465; i += NTHREADS) biasl[i] = a.bias[h * 465 + i] * LOG2E; }
        const bf16_t* Kg = a.K + (size_t)b * PP * a.ldk + (h >> a.gk) * DQ;
        const bf16_t* Vg = a.V + (size_t)b * PP * a.ldv + (h >> a.gv) * a.vhs;
        f32x16 o[NDB];
#pragma unroll
        for (int d = 0; d < NDB; ++d)
#pragma unroll
            for (int i = 0; i < 16; ++i) o[d][i] = 0.f;
        float mref = 0.f, l = 0.f;
        f32x16 negm;
#pragma unroll
        for (int i = 0; i < 16; ++i) negm[i] = 0.f;
        bool first = true;
        float lbig = 0.f;
        float one = 1.0f; asm volatile("" : "+v"(one));
#define ATT_TILE(IT) ((IT) < n_lat ? t_lo + (IT) : 64 + ((IT) - n_lat))
        auto tile_active = [&](int t) -> bool {
            if (t >= 64) return true;
            if (MODE == 1) return (t * 64 + 63 >= qw0 - 128) && (t * 64 <= qw0 + 31 + 128);
            if (MODE == 0) { const int rw = qw0 >> 6, row0 = min(max(rw - 4, 0), 56); return t >= row0 && t < row0 + 8; }
            return true;
        };
        auto qk = [&](f32x16 (&s)[2], const lds_ptr Kb) {
#pragma unroll
            for (int kk = 0; kk < NKK; ++kk)
#pragma unroll
                for (int kb = 0; kb < 2; ++kb) {
                    if (ABL & 4) { if (kk == 0) s[kb] = negm; }
                    else {
                    const bf16x8 kf = *(const LAS bf16x8*)(Kb + (kb * 32 + r) * KSTR + (kk * 2 + hf) * 16);
                    s[kb] = MFMA32(kf, qf[kk], kk == 0 ? negm : s[kb]);
                    }
                }
        };
        u32x4 kr[NKI], vr[NVI];
        {
            const int t0 = ATT_TILE(0), t1 = ATT_TILE(1);
            u32x4 k1[NKI];
#pragma unroll
            for (int i = 0; i < NKI; ++i) kr[i] = *(const u32x4*)(Kg + (size_t)t0 * 64 * a.ldk + koff[i]);
#pragma unroll
            for (int i = 0; i < NVI; ++i) vr[i] = *(const u32x4*)(Vg + (size_t)t0 * 64 * a.ldv + voff[i]);
#pragma unroll
            for (int i = 0; i < NKI; ++i) k1[i] = *(const u32x4*)(Kg + (size_t)t1 * 64 * a.ldk + koff[i]);
#pragma unroll
            for (int i = 0; i < NKI; ++i) { *(LAS u32x4*)(lds + kdst[i]) = kr[i]; *(LAS u32x4*)(lds + KTB + kdst[i]) = k1[i]; }
#pragma unroll
            for (int i = 0; i < NVI; ++i) *(LAS u32x4*)(lds + 2 * KTB + vdst[i]) = vr[i];
        }
        __syncthreads();
        f32x16 sc[2], sn[2];
        bool act_cur = tile_active(ATT_TILE(0)), act_nxt = false;
        if (act_cur) qk(sc, lds);
        __syncthreads();
        auto step = [&](const int it, const int e, const bool N2, const bool N1) {
            const int t = ATT_TILE(it);
            if (N2 && !(ABL & 8) && (!(ABL & 128) || e)) {
                const int tn = ATT_TILE(it + 2);
#pragma unroll
                for (int i = 0; i < NKI; ++i) kr[i] = *(const u32x4*)(Kg + (size_t)tn * 64 * a.ldk + koff[i]);
            }
            if (N1 && !(ABL & 8) && (!(ABL & 128) || e)) {
                const int tn = ATT_TILE(it + 1);
#pragma unroll
                for (int i = 0; i < NVI; ++i) vr[i] = *(const u32x4*)(Vg + (size_t)tn * 64 * a.ldv + voff[i]);
            }
            SCHED_FENCE();
            act_nxt = N1 && (MODE == 2 || tile_active(ATT_TILE(it + 1)));
            const lds_ptr Vb = lds + 2 * KTB + e * VTB;
            const bool do_cur = MODE == 2 || act_cur;
            if (do_cur) {
                if (t < 64 && MODE == 1 && !((t * 64 + 63 - qw0 <= 128) && (qw0 + 31 - t * 64 <= 128))) {
                    const int dbase = t * 64 + 4 * hf - qpos;
#pragma unroll
                    for (int kb = 0; kb < 2; ++kb)
#pragma unroll
                        for (int i = 0; i < 16; ++i) { const int c = kb * 32 + (i & 3) + 8 * (i >> 2); sc[kb][i] = (dbase > 128 - c || dbase < -128 - c) ? -INFINITY : sc[kb][i]; }
                }
                if (t < 64 && MODE == 0) {
                    const int qc = qpos & 63, rw = qpos >> 6, col0 = min(max(qc - 8, 0), 48);
                    const int brow = (t - rw + 7) * 31 + 15 - qc;
#pragma unroll
                    for (int kb = 0; kb < 2; ++kb)
#pragma unroll
                        for (int i = 0; i < 16; ++i) {
                            const int kc = kb * 32 + crow(i, hf);
                            const bool ok = kc >= col0 && kc < col0 + 16;
                            const float bv = biasl[ok ? brow + kc : 0];
                            sc[kb][i] = ok ? sc[kb][i] + bv : -INFINITY;
                        }
                }
                if (first || __builtin_amdgcn_ballot_w64(lbig > ATT_BIGF) != 0ull) {
                    float delta = lbig > ATT_BIGF ? ATT_BIG : 0.f;
                    if (first) {
                        float mx = sc[0][0];
#pragma unroll
                        for (int i = 1; i < 16; ++i) mx = fmaxf(mx, sc[0][i]);
#pragma unroll
                        for (int i = 0; i < 16; ++i) mx = fmaxf(mx, sc[1][i]);
                        mx = xhalf_max(mx);
                        delta = mx > -INFINITY ? mx : 0.f;
                    }
                    const float alpha = __builtin_amdgcn_exp2f(-delta);
                    l *= alpha; mref += delta;
#pragma unroll
                    for (int d = 0; d < NDB; ++d)
#pragma unroll
                        for (int i = 0; i < 16; ++i) o[d][i] *= alpha;
#pragma unroll
                    for (int kb = 0; kb < 2; ++kb)
#pragma unroll
                        for (int i = 0; i < 16; ++i) sc[kb][i] -= delta;
#pragma unroll
                    for (int i = 0; i < 16; ++i) negm[i] = -mref;
                    first = false;
                }
            }
            if (N1) qk(sn, lds + (e ^ 1) * KTB);
            if (do_cur) {
                float ls0 = 0.f, ls1 = 0.f;
#pragma unroll
                for (int kb = 0; kb < 2; ++kb)
#pragma unroll
                    for (int i = 0; i < 16; i += 2) {
                        const float p0 = (ABL & 1) ? sc[kb][i] : __builtin_amdgcn_exp2f(sc[kb][i]), p1 = (ABL & 1) ? sc[kb][i + 1] : __builtin_amdgcn_exp2f(sc[kb][i + 1]);
                        sc[kb][i] = p0; sc[kb][i + 1] = p1;
                        if (!(ABL & 16)) { ls0 += p0; ls1 = __builtin_fmaf(p1, one, ls1); }
                    }
                lbig = ls0 + ls1;
                l += lbig;
                bf16x8 pf[4];
#pragma unroll
                for (int kb = 0; kb < 2; ++kb)
#pragma unroll
                    for (int sp = 0; sp < 2; ++sp) {
                        u32x4 w;
                        w.x = cvtpk(sc[kb][8 * sp], sc[kb][8 * sp + 1]); w.y = cvtpk(sc[kb][8 * sp + 2], sc[kb][8 * sp + 3]);
                        w.z = cvtpk(sc[kb][8 * sp + 4], sc[kb][8 * sp + 5]); w.w = cvtpk(sc[kb][8 * sp + 6], sc[kb][8 * sp + 7]);
                        pf[kb * 2 + sp] = __builtin_bit_cast(bf16x8, w);
                    }
#pragma unroll
                for (int ks = 0; ks < 4; ++ks)
#pragma unroll
                    for (int d = 0; d < NDB; ++d) {
                        const lds_ptr vp = Vb + ((2 * ks) * NDB + d) * 512 + vtr0;
                        const s16x4 lo = lds_tr(vp), hi = lds_tr(vp + NDB * 512);
                        const bf16x8 vf = __builtin_shufflevector(lo, hi, 0, 1, 2, 3, 4, 5, 6, 7);
                        if (ABL & 2) { if (d == 0 && ks == 0) o[0][0] += __builtin_bit_cast(float, pf[0][0] | pf[1][0] | pf[2][0] | pf[3][0]) + __builtin_bit_cast(float, (int)vf[0]); } else
                        o[d] = MFMA32(vf, pf[ks], o[d]);
                    }
            }
            SCHED_FENCE();
            if (N2 && !(ABL & 8) && (!(ABL & 128) || e)) {
#pragma unroll
                for (int i = 0; i < NKI; ++i) *(LAS u32x4*)(lds + e * KTB + kdst[i]) = kr[i];
            }
            if (N1 && !(ABL & 8) && (!(ABL & 128) || e)) {
#pragma unroll
                for (int i = 0; i < NVI; ++i) *(LAS u32x4*)(lds + 2 * KTB + (e ^ 1) * VTB + vdst[i]) = vr[i];
            }
            if (!(ABL & 64) && (!(ABL & 128) || e)) __syncthreads();
#pragma unroll
            for (int kb = 0; kb < 2; ++kb) sc[kb] = sn[kb];
            act_cur = act_nxt;
        };
        int it = 0;
        for (; it + 3 < ntiles; it += 2) { step(it, 0, true, true); step(it + 1, 1, true, true); }
        if (ntiles - it == 3) { step(it, 0, true, true); step(it + 1, 1, false, true); step(it + 2, 0, false, false); }
        else { step(it, 0, false, true); step(it + 1, 1, false, false); }
#undef ATT_TILE
        l = xhalf_sum(l);
        if (a.sink) {
            l += __builtin_amdgcn_exp2f(a.sink[h] * LOG2E - mref);
        }
        const float inv = 1.0f / l;
        bf16_t* orow = a.O + qrow * a.ldo + h * DV + 4 * hf;
#pragma unroll
        for (int d = 0; d < NDB; ++d)
#pragma unroll
            for (int g = 0; g < 4; ++g) {
                if (DV == 64) {
                    *(unsigned*)((unsigned char*)a.O + qrow * a.ldo + h * DV + 4 * hf + d * 32 + 8 * g) = cvt_fp8x4(o[d][4 * g] * inv, o[d][4 * g + 1] * inv, o[d][4 * g + 2] * inv, o[d][4 * g + 3] * inv);
                } else {
                    u32x2 w; w.x = cvtpk(o[d][4 * g] * inv, o[d][4 * g + 1] * inv); w.y = cvtpk(o[d][4 * g + 2] * inv, o[d][4 * g + 3] * inv);
                    *(u32x2*)(orow + d * 32 + 8 * g) = w;
                }
            }
        if (PAIRED && (it_i & 1)) {
            asm volatile("s_waitcnt vmcnt(0)" ::: "memory");
            const float lambda_init = 0.8f - 0.6f * 0.40656965974059917f;
            const int sub = lane & 7, pair = h >> 1;
#pragma unroll
            for (int i4 = 0; i4 < 4; ++i4) {
                const size_t row = (size_t)b * PP + qw0 + i4 * 8 + (lane >> 3);
                const bf16_t* o1 = a.O + row * a.ldo + (2 * pair) * 128 + sub * 16, *o2 = o1 + 128;
                float av[16], cv[16];
                unpack8(*(const u32x4*)o1, *(float(*)[8])av); unpack8(*(const u32x4*)(o1 + 8), *(float(*)[8])(av + 8));
                unpack8(*(const u32x4*)o2, *(float(*)[8])cv); unpack8(*(const u32x4*)(o2 + 8), *(float(*)[8])(cv + 8));
                float ss = 0.f;
#pragma unroll
                for (int e = 0; e < 16; ++e) { av[e] -= lam_full * cv[e]; ss += av[e] * av[e]; }
                ss += __shfl_xor(ss, 1); ss += __shfl_xor(ss, 2); ss += __shfl_xor(ss, 4);
                const float rs = rsqrtf(ss * (1.0f / 128.0f) + EPS) * (1.0f - lambda_init);
#pragma unroll
                for (int e = 0; e < 16; ++e) av[e] *= rs * a.subln[sub * 16 + e];
                u32x4 w8; w8.x = cvt_fp8x4(av[0], av[1], av[2], av[3]); w8.y = cvt_fp8x4(av[4], av[5], av[6], av[7]); w8.z = cvt_fp8x4(av[8], av[9], av[10], av[11]); w8.w = cvt_fp8x4(av[12], av[13], av[14], av[15]);
                *(u32x4*)(a.Oc + row * (size_t)a.ldoc + pair * 128 + sub * 16) = w8;
            }
        }
    }
}

DI void attn_na(const AttnP& a, unsigned char* smem, int bid, int nb, int tid) {
    constexpr int DQ = 64, DV = 64, KSTR = DQ * 2 + 16, KTB = 64 * KSTR, VTB = 64 * DV * 2, NDB = 2, NKK = 4;
    const lds_ptr lds = (lds_ptr)smem;
    constexpr int BZ_TAB = 32, BZ_HEAD = 560, BZ_NINF = 16 * BZ_HEAD, BZ_N = BZ_NINF + 64;
    static_assert(4 * KTB + 4 * VTB + (BZ_N + 16) * 4 <= GEMM_LDS, "NA LDS");
    LAS float* biasl = (LAS float*)(lds + 4 * KTB + 4 * VTB);
    for (int i = tid; i < BZ_N; i += NTHREADS) {
        const int hh = i / BZ_HEAD, o = i - hh * BZ_HEAD;
        biasl[i] = i >= BZ_NINF ? -INFINITY : (o >= BZ_TAB && o < BZ_TAB + 465) ? a.bias[hh * 465 + o - BZ_TAB] * LOG2E : 0.f;
    }
    __syncthreads();
    {
        const int wv = __builtin_amdgcn_readfirstlane(tid >> 6), ln = tid & 63;
#pragma unroll
        for (int hh2 = 0; hh2 < 2; ++hh2) {
            const int hh = 2 * wv + hh2;
            float m = 0.f;
            for (int i = ln; i < 465; i += 64) m = fmaxf(m, biasl[hh * BZ_HEAD + BZ_TAB + i]);
#pragma unroll
            for (int d = 32; d >= 1; d >>= 1) m = fmaxf(m, __shfl_xor(m, d));
            if (ln == 0) biasl[BZ_N + hh] = m;
        }
    }
    float kmax = fabsf(a.kgain[tid & 63]);
#pragma unroll
    for (int d = 32; d >= 1; d >>= 1) kmax = fmaxf(kmax, __shfl_xor(kmax, d));
    kmax *= 8.0f * 1.01f;
    const int lane = tid & 63, wid = __builtin_amdgcn_readfirstlane(tid >> 6), r = lane & 31, hf = lane >> 5;
    const int nq = a.need_ctx ? 17 : 16;
    const int xcd = bid & 7, slot = bid >> 3, nslots = nb >> 3, per_xcd = (NBATCH * a.HQ / 8) * nq;
    const int krow_s = tid >> 3, kc_s = tid & 7;
    const int koff = krow_s * a.ldk + kc_s * 8, kdst = krow_s * KSTR + kc_s * 16, voff = krow_s * a.ldv + kc_s * 8;
    const int vdst = ((krow_s >> 3) * NDB + (kc_s >> 2)) * 512 + (krow_s & 7) * 64 + (kc_s & 3) * 16;
    const int i16 = lane & 15, trq = i16 >> 2, trp = i16 & 3, grp = (lane >> 4) & 1;
    const int vtr0 = (4 * hf + trq) * 64 + 32 * grp + 8 * trp;
    const int rp = wid >> 2, cq = wid & 3, k0 = cq == 0 ? 0 : cq == 1 ? 8 : cq == 2 ? 24 : 32;
    float one = 1.0f; asm volatile("" : "+v"(one));
    auto unit_of = [&](int j, int& b, int& h, int& qt, int& t_lo, int& n_lat) {
        const int nbh = NBATCH * a.HQ / 8;
        const int bhl = j < nbh * 16 ? j >> 4 : j - nbh * 16; qt = j < nbh * 16 ? j & 15 : 16;
        const int bh = bhl * 8 + xcd; h = bh % a.HQ; b = bh / a.HQ;
        t_lo = 0; n_lat = 0;
        if (qt < 16) { const int r0 = 4 * qt; t_lo = min(max(r0 - 4, 0), 56); n_lat = min(max(r0 - 1, 0), 56) + 7 - t_lo + 1; n_lat += n_lat & 1; }
    };
#define NA_TILE_OF(IT, TLO, NLAT) ((IT) < (NLAT) ? (TLO) + (IT) : 64 + ((IT) - (NLAT)))
    bf16x8 qf[NKK];
    u32x4 krA[2], vrA[2], krB[2], vrB[2];
    auto load_pair = [&](u32x4 (&kr)[2], u32x4 (&vr)[2], const bf16_t* Kg, const bf16_t* Vg, int t_lo, int n_lat, int pr) {
#pragma unroll
        for (int jj = 0; jj < 2; ++jj) {
            const int tn = NA_TILE_OF(2 * pr + jj, t_lo, n_lat);
            kr[jj] = *(const u32x4*)(Kg + (size_t)tn * 64 * a.ldk + koff); vr[jj] = *(const u32x4*)(Vg + (size_t)tn * 64 * a.ldv + voff);
        }
    };
    auto store_pair = [&](const u32x4 (&kr)[2], const u32x4 (&vr)[2], int e) {
#pragma unroll
        for (int jj = 0; jj < 2; ++jj) { *(LAS u32x4*)(lds + (2 * e + jj) * KTB + kdst) = kr[jj]; *(LAS u32x4*)(lds + 4 * KTB + (2 * e + jj) * VTB + vdst) = vr[jj]; }
    };
    auto qrow_of = [&](int b, int qt) -> size_t { const int qpos = qt >= 16 ? SEQ + wid * 32 + r : (4 * qt + 2 * rp + (r >> 4)) * 64 + 16 * cq + (r & 15); return (size_t)b * PP + qpos; };
    auto load_q = [&](int b, int h, int qt) {
        const size_t qrow = qrow_of(b, qt);
#pragma unroll
        for (int kk = 0; kk < NKK; ++kk) qf[kk] = *(const bf16x8*)(a.Q + qrow * a.ldq + h * DQ + kk * 16 + hf * 8);
    };
    if (slot >= per_xcd) return;
    int b, h, qt, t_lo, n_lat;
    unit_of(slot, b, h, qt, t_lo, n_lat);
    {
        load_q(b, h, qt);
        const bf16_t* Kg = a.K + (size_t)b * PP * a.ldk + h * DQ; const bf16_t* Vg = a.V + (size_t)b * PP * a.ldv + h * a.vhs;
        load_pair(krA, vrA, Kg, Vg, t_lo, n_lat, 0); store_pair(krA, vrA, 0); load_pair(krB, vrB, Kg, Vg, t_lo, n_lat, 1);
    }
    __syncthreads();
    for (int j = slot;;) {
        const int jn = j + nslots; const bool has_next = jn < per_xcd;
        int nb_, nh, nqt, nt_lo, nn_lat;
        unit_of(has_next ? jn : j, nb_, nh, nqt, nt_lo, nn_lat);
        const bf16_t* nKg = a.K + (size_t)nb_ * PP * a.ldk + nh * DQ; const bf16_t* nVg = a.V + (size_t)nb_ * PP * a.ldv + nh * a.vhs;
        const bool is_ctx = qt >= 16;
        const int r0 = 4 * qt;
        const int npair = (n_lat + 4) >> 1;
        const int qrw = r0 + 2 * rp + (r >> 4), qc = 16 * cq + (r & 15);
        const size_t qrow = qrow_of(b, qt);
        const bf16_t* Kg = a.K + (size_t)b * PP * a.ldk + h * DQ;
        const bf16_t* Vg = a.V + (size_t)b * PP * a.ldv + h * a.vhs;
        const int rwA = r0 + 2 * rp, wlo = min(max(rwA - 4, 0), 56), whi = min(max(rwA - 3, 0), 56) + 7;
        const int col0 = min(max(qc - 8, 0), 48), row0q = min(max(qrw - 4, 0), 56);
        const int lanebase = h * BZ_HEAD + BZ_TAB + (7 - qrw) * 31 + 15 - qc + k0 + 4 * hf;
        f32x16 o[NDB];
#pragma unroll
        for (int d = 0; d < NDB; ++d)
#pragma unroll
            for (int i = 0; i < 16; ++i) o[d][i] = 0.f;
        float l = 0.f;
        float qn2 = 0.f;
#pragma unroll
        for (int kk = 0; kk < NKK; ++kk)
#pragma unroll
            for (int jj = 0; jj < 8; ++jj) { const float qv = bf2f((bf16_t)qf[kk][jj]); qn2 = __builtin_fmaf(qv, qv, qn2); }
        qn2 = xhalf_sum(qn2);
        const float mref = __builtin_sqrtf(qn2) * kmax + biasl[BZ_N + h];
        f32x16 negmL;
#pragma unroll
        for (int i = 0; i < 16; ++i) { const int kc = k0 + crow(i, hf); negmL[i] = (kc >= col0 && kc < col0 + 16) ? -mref : -INFINITY; }
#define NA_TILE(IT) NA_TILE_OF(IT, t_lo, n_lat)
        auto ctx_tile = [&](const lds_ptr Kb, const lds_ptr Vb) {
            {
                f32x16 s[2], negm;
#pragma unroll
                for (int i = 0; i < 16; ++i) negm[i] = -mref;
#pragma unroll
                for (int kk = 0; kk < NKK; ++kk)
#pragma unroll
                    for (int kb = 0; kb < 2; ++kb) {
                        const bf16x8 kf = *(const LAS bf16x8*)(Kb + (kb * 32 + r) * KSTR + (kk * 2 + hf) * 16);
                        s[kb] = MFMA32(kf, qf[kk], kk == 0 ? negm : s[kb]);
                    }
                float ls0 = 0.f, ls1 = 0.f;
                bf16x8 pf[4];
#pragma unroll
                for (int kb = 0; kb < 2; ++kb) {
#pragma unroll
                    for (int i = 0; i < 16; i += 2) {
                        const float p0 = __builtin_amdgcn_exp2f(s[kb][i]), p1 = __builtin_amdgcn_exp2f(s[kb][i + 1]);
                        s[kb][i] = p0; s[kb][i + 1] = p1; ls0 += p0; ls1 = __builtin_fmaf(p1, one, ls1);
                    }
#pragma unroll
                    for (int sp = 0; sp < 2; ++sp) {
                        u32x4 w;
                        w.x = cvtpk(s[kb][8 * sp], s[kb][8 * sp + 1]); w.y = cvtpk(s[kb][8 * sp + 2], s[kb][8 * sp + 3]);
                        w.z = cvtpk(s[kb][8 * sp + 4], s[kb][8 * sp + 5]); w.w = cvtpk(s[kb][8 * sp + 6], s[kb][8 * sp + 7]);
                        pf[kb * 2 + sp] = __builtin_bit_cast(bf16x8, w);
                    }
                }
                l += ls0 + ls1;
#pragma unroll
                for (int ks = 0; ks < 4; ++ks)
#pragma unroll
                    for (int d = 0; d < NDB; ++d) {
                        const lds_ptr vp = Vb + ((2 * ks) * NDB + d) * 512 + vtr0;
                        const s16x4 lo = lds_tr(vp), hi = lds_tr(vp + NDB * 512);
                        o[d] = MFMA32(__builtin_shufflevector(lo, hi, 0, 1, 2, 3, 4, 5, 6, 7), pf[ks], o[d]);
                    }
            }
        };
        auto lat_tile = [&](const int t, const lds_ptr Kb, const lds_ptr Vb) {
            bf16x8 pf[2];
#pragma unroll
            for (int sp = 0; sp < 2; ++sp)
#pragma unroll
                for (int jj = 0; jj < 8; ++jj) pf[sp][jj] = 0;
            if (t >= wlo && t <= whi) {
                f32x16 s;
#pragma unroll
                for (int kk = 0; kk < NKK; ++kk) {
                    const bf16x8 kf = *(const LAS bf16x8*)(Kb + (k0 + r) * KSTR + (kk * 2 + hf) * 16);
                    s = MFMA32(kf, qf[kk], kk == 0 ? negmL : s);
                }
                const LAS float* bp = biasl + (((unsigned)(t - row0q) < 8u) ? lanebase + 31 * t : BZ_NINF);
#pragma unroll
                for (int i = 0; i < 16; ++i) s[i] += bp[crow(i, 0)];
                float ls0 = 0.f, ls1 = 0.f;
#pragma unroll
                for (int i = 0; i < 16; i += 2) {
                    const float p0 = __builtin_amdgcn_exp2f(s[i]), p1 = __builtin_amdgcn_exp2f(s[i + 1]);
                    s[i] = p0; s[i + 1] = p1; ls0 += p0; ls1 = __builtin_fmaf(p1, one, ls1);
                }
#pragma unroll
                for (int sp = 0; sp < 2; ++sp) {
                    u32x4 w;
                    w.x = cvtpk(s[8 * sp], s[8 * sp + 1]); w.y = cvtpk(s[8 * sp + 2], s[8 * sp + 3]);
                    w.z = cvtpk(s[8 * sp + 4], s[8 * sp + 5]); w.w = cvtpk(s[8 * sp + 6], s[8 * sp + 7]);
                    pf[sp] = __builtin_bit_cast(bf16x8, w);
                }
                l += ls0 + ls1;
            }
#pragma unroll
            for (int ks = 0; ks < 2; ++ks)
#pragma unroll
                for (int d = 0; d < NDB; ++d) {
                    const lds_ptr vp = Vb + (((k0 >> 3) + 2 * ks) * NDB + d) * 512 + vtr0;
                    const s16x4 lo = lds_tr(vp), hi = lds_tr(vp + NDB * 512);
                    o[d] = MFMA32(__builtin_shufflevector(lo, hi, 0, 1, 2, 3, 4, 5, 6, 7), pf[ks], o[d]);
                }
        };
#define NA_ITER(IP, E, KL, VL, KS, VS, LAT) do { \
            if ((IP) + 2 < npair) load_pair(KL, VL, Kg, Vg, t_lo, n_lat, (IP) + 2); \
            else if (has_next) load_pair(KL, VL, nKg, nVg, nt_lo, nn_lat, (IP) + 2 - npair); \
            SCHED_FENCE(); \
            if (LAT) { lat_tile(t_lo + 2 * (IP), lds + (2 * (E)) * KTB, lds + 4 * KTB + (2 * (E)) * VTB); lat_tile(t_lo + 2 * (IP) + 1, lds + (2 * (E) + 1) * KTB, lds + 4 * KTB + (2 * (E) + 1) * VTB); } \
            else { ctx_tile(lds + (2 * (E)) * KTB, lds + 4 * KTB + (2 * (E)) * VTB); ctx_tile(lds + (2 * (E) + 1) * KTB, lds + 4 * KTB + (2 * (E) + 1) * VTB); } \
            SCHED_FENCE(); \
            if ((IP) + 1 < npair || has_next) store_pair(KS, VS, (E) ^ 1); \
            __syncthreads(); } while (0)
        int ip = 0;
        for (; ip < (n_lat >> 1); ip += 2) { NA_ITER(ip, 0, krA, vrA, krB, vrB, true); NA_ITER(ip + 1, 1, krB, vrB, krA, vrA, true); }
        NA_ITER(ip, 0, krA, vrA, krB, vrB, false); NA_ITER(ip + 1, 1, krB, vrB, krA, vrA, false);
#undef NA_ITER
        if (has_next) load_q(nb_, nh, nqt);
#undef NA_TILE
        l = xhalf_sum(l);
        const float inv = 1.0f / l;
#pragma unroll
        for (int d = 0; d < NDB; ++d)
#pragma unroll
            for (int g = 0; g < 4; ++g)
                *(unsigned*)((unsigned char*)a.O + qrow * a.ldo + h * DV + 4 * hf + d * 32 + 8 * g) = cvt_fp8x4(o[d][4 * g] * inv, o[d][4 * g + 1] * inv, o[d][4 * g + 2] * inv, o[d][4 * g + 3] * inv);
        if (!has_next) break;
        j = jn; b = nb_; h = nh; qt = nqt; t_lo = nt_lo; n_lat = nn_lat;
    }
#undef NA_TILE_OF
}

template <class E> struct epi_fp8 { static constexpr int value = 0; };
typedef int v8i_t __attribute__((ext_vector_type(8)));
typedef int v4i_t __attribute__((ext_vector_type(4)));
namespace pg8 {
constexpr int BM = 256, BK = 64, HALF = 128, HTB = HALF * BK * 2  ;
DI int lds_byte(int r, int c) { const int st = (r >> 4) * 2 + (c >> 5), rr = r & 15, cc = c & 31, ob = rr * 64 + cc * 2; return st * 1024 + (ob ^ (((ob >> 9) & 1) << 5)); }
DI void stage_rc(int b, int& R, int& C) { const int st = b / 1024, sb = b % 1024, swz = sb ^ (((sb >> 9) & 1) << 5); R = (st >> 1) * 16 + swz / 64; C = (st & 1) * 32 + (swz % 64) / 2; }
DI int perm32(int rho) { const int n = rho >> 4, i = rho & 15; return 8 * (i >> 2) + 4 * n + (i & 3); }

template <class Epi, class Sched>
DI void gemm_phase(lds_ptr lds, const bf16_t* __restrict__ Aop, const int K, const Sched& S, const Epi& E, const int tid) {
    const int wid = __builtin_amdgcn_readfirstlane(tid >> 6), lane = tid & 63, wr = wid >> 2, wc = wid & 3, fr = lane & 15, fq = lane >> 4;
    const int nt = K / BK;
    int Ra[2], Ca[2]; unsigned voffB[2];
#pragma unroll
    for (int i = 0; i < 2; ++i) { int R, C; stage_rc(tid * 16 + i * 8192, R, C); const int Rb = Epi::PERM ? ((R & ~31) + perm32(R & 31)) : R;
        Ra[i] = R; Ca[i] = C; voffB[i] = (unsigned)(Rb * K + C) * 2u; }
    const size_t kstep = (size_t)(BK * 2);
    const size_t hstep = (size_t)HALF * K * 2;
    const unsigned ldsw = (unsigned)wid * 1024u;
    const int aoff = lds_byte(wr * 64 + fr, fq * 8), boff = lds_byte(wc * 32 + fr, fq * 8);
#define PG8_SA(b, h) (((b) * 2 + (h)) * HTB)
#define PG8_SB(b, h) ((4 + (b) * 2 + (h)) * HTB)
#define PG8_STAGE(bufoff, gbase, voff) do { const char* _gb = (const char*)(gbase); asm volatile("" : "+s"(_gb)); _Pragma("unroll") for (int _i = 0; _i < 2; ++_i) { \
        unsigned _o = (voff)[_i]; asm volatile("" : "+v"(_o)); \
        __builtin_amdgcn_global_load_lds((const unsigned*)(_gb + _o), (LAS unsigned*)(lds + (bufoff) + ldsw + _i * 8192), 16, 0, 0); } } while (0)
#define PG8_LDA(dst, b, h) do { _Pragma("unroll") for (int m = 0; m < 4; ++m) _Pragma("unroll") for (int k = 0; k < 2; ++k) dst[m][k] = *(const LAS bf16x8*)(lds + PG8_SA(b, h) + aoff + m * 2048 + k * 1024); } while (0)
#define PG8_LDB(dst, b, h) do { _Pragma("unroll") for (int n = 0; n < 2; ++n) _Pragma("unroll") for (int k = 0; k < 2; ++k) dst[n][k] = *(const LAS bf16x8*)(lds + PG8_SB(b, h) + boff + n * 2048 + k * 1024); } while (0)
typedef long i64x2_t __attribute__((ext_vector_type(2)));
#define PG8_MMA(ai, bj, At, Bt) do { __builtin_amdgcn_s_setprio(1); _Pragma("unroll") for (int m = 0; m < 4; ++m) _Pragma("unroll") for (int n = 0; n < 2; ++n) { \
        if (epi_fp8<Epi>::value == 2) { \
            const v8i_t _b = __builtin_shufflevector(__builtin_bit_cast(v4i_t, Bt[n][0]), __builtin_bit_cast(v4i_t, Bt[n][1]), 0, 1, 2, 3, 4, 5, 6, 7); \
            const v8i_t _a = __builtin_shufflevector(__builtin_bit_cast(v4i_t, At[m][0]), __builtin_bit_cast(v4i_t, At[m][1]), 0, 1, 2, 3, 4, 5, 6, 7); \
            acc[ai][bj][m][n] = __builtin_amdgcn_mfma_scale_f32_16x16x128_f8f6f4(_b, _a, acc[ai][bj][m][n], 0, 0, 0, 0, 0, 0); \
        } else { _Pragma("unroll") for (int k = 0; k < 2; ++k) { \
        if (epi_fp8<Epi>::value == 1) { const i64x2_t _b = __builtin_bit_cast(i64x2_t, Bt[n][k]), _a = __builtin_bit_cast(i64x2_t, At[m][k]); \
            acc[ai][bj][m][n] = __builtin_amdgcn_mfma_f32_16x16x32_fp8_fp8(_b[0], _a[0], acc[ai][bj][m][n], 0, 0, 0); \
            acc[ai][bj][m][n] = __builtin_amdgcn_mfma_f32_16x16x32_fp8_fp8(_b[1], _a[1], acc[ai][bj][m][n], 0, 0, 0); } \
        else acc[ai][bj][m][n] = __builtin_amdgcn_mfma_f32_16x16x32_bf16(Bt[n][k], At[m][k], acc[ai][bj][m][n], 0, 0, 0); } } } \
        __builtin_amdgcn_s_setprio(0); } while (0)
#define PG8_WAIT_V(n) asm volatile("s_waitcnt vmcnt(" #n ")" ::: "memory")
#define PG8_WAIT_L(n) asm volatile("s_waitcnt lgkmcnt(" #n ")" ::: "memory")
#define PG8_BAR __builtin_amdgcn_s_barrier()
#define PG8_SCHED __builtin_amdgcn_sched_barrier(0)
    typename Sched::Unit cur, nxt; int ui = 0;
    if (!S.next(0, cur)) return;
    f32x4 acc[2][2][4][2];
#pragma unroll
    for (int a = 0; a < 2; ++a)
#pragma unroll
        for (int b = 0; b < 2; ++b)
#pragma unroll
            for (int m = 0; m < 4; ++m)
#pragma unroll
                for (int n = 0; n < 2; ++n) acc[a][b][m][n] = (f32x4){0.f, 0.f, 0.f, 0.f};
    bf16x8 At[4][2], B0[2][2], B1[2][2];
    constexpr bool GATHER = Sched::GATHER;
    unsigned oc[2][2], on[2][2] = {{0u, 0u}, {0u, 0u}};
    size_t ubc[2] = {0, 0}, ubn[2] = {0, 0};
#pragma unroll
    for (int h = 0; h < 2; ++h) {
        if (!GATHER) ubc[h] = (size_t)S.a_off(cur, h * HALF) * 2u;
#pragma unroll
        for (int i = 0; i < 2; ++i) oc[h][i] = GATHER ? (S.a_off(cur, h * HALF + Ra[i]) + (unsigned)Ca[i]) * 2u : (unsigned)(Ra[i] * S.lda + Ca[i]) * 2u;
    }
    const char* gA = (const char*)Aop;
    const char* cB = (const char*)S.b_base(cur);
    PG8_STAGE(PG8_SB(0, 0), cB, voffB); PG8_STAGE(PG8_SB(0, 1), cB + hstep, voffB); PG8_STAGE(PG8_SA(0, 0), gA + ubc[0], oc[0]); PG8_STAGE(PG8_SA(0, 1), gA + ubc[1], oc[1]);
    if (wr == 1) PG8_BAR;
    PG8_WAIT_V(2); PG8_BAR;
    PG8_STAGE(PG8_SB(1, 0), cB + kstep, voffB); PG8_STAGE(PG8_SA(1, 0), gA + ubc[0] + kstep, oc[0]); PG8_STAGE(PG8_SB(1, 1), cB + hstep + kstep, voffB);
    PG8_WAIT_V(6); PG8_BAR;
    for (;;) {
        const bool has_next = S.next(ui + 1, nxt);
        const char* nB = has_next ? (const char*)S.b_base(nxt) : cB;
#pragma unroll
        for (int h = 0; h < 2; ++h) {
            if (!GATHER) ubn[h] = has_next ? (size_t)S.a_off(nxt, h * HALF) * 2u : ubc[h];
#pragma unroll
            for (int i = 0; i < 2; ++i) if (GATHER) { int R, C; stage_rc(((wid << 6) | lane_now()) * 16 + i * 8192, R, C);
                const unsigned* ip = S.a_ptr(nxt, h * HALF + R); if (epi_fp8<Epi>::value != 2) asm volatile("global_load_dword %0, %1, off" : "=v"(on[h][i]) : "v"(ip) : "memory"); }
        }
        const bool full = cur.half < 0;
        for (int t = 0; t < nt; t += 2) {
            const bool last = (t == nt - 2);
            const char* a1 = gA + (size_t)(t + 1) * kstep;
            const char* a2 = last ? gA : gA + (size_t)(t + 2) * kstep; const char* b2 = last ? nB : cB + (size_t)(t + 2) * kstep;
            const char* a3 = a2 + kstep; const char* b3 = b2 + kstep;
            size_t u2[2];
            if (GATHER && last) {
                if (epi_fp8<Epi>::value != 2) asm volatile("" : "+v"(on[0][0]), "+v"(on[0][1]), "+v"(on[1][0]), "+v"(on[1][1]));
#pragma unroll
                for (int i = 0; i < 2; ++i) { int R, C; stage_rc(((wid << 6) | lane_now()) * 16 + i * 8192, R, C);
                    if (epi_fp8<Epi>::value == 2) { on[0][i] = *S.a_ptr(nxt, R); on[1][i] = *S.a_ptr(nxt, HALF + R); }
                    oc[0][i] = (S.a_cvt(on[0][i]) + (unsigned)C) * 2u; on[1][i] = (S.a_cvt(on[1][i]) + (unsigned)C) * 2u; }
            }
#pragma unroll
            for (int h = 0; h < 2; ++h) u2[h] = last ? ubn[h] : ubc[h];
            PG8_LDB(B0, 0, 0); PG8_LDB(B1, 0, 1); PG8_SCHED; PG8_LDA(At, 0, 0); PG8_STAGE(PG8_SA(1, 1), a1 + ubc[1], oc[1]);
            if (GATHER && last) { oc[1][0] = on[1][0]; oc[1][1] = on[1][1]; }
            PG8_WAIT_V(8); PG8_WAIT_L(0); PG8_BAR; PG8_MMA(0, 0, At, B0); PG8_MMA(0, 1, At, B1); PG8_BAR; PG8_SCHED;
            PG8_LDA(At, 0, 1); PG8_STAGE(PG8_SB(0, 0), b2, voffB); PG8_STAGE(PG8_SB(0, 1), b2 + hstep, voffB); PG8_STAGE(PG8_SA(0, 0), a2 + u2[0], oc[0]);
            PG8_WAIT_V(8); PG8_WAIT_L(0); PG8_BAR; if (full) { PG8_MMA(1, 0, At, B0); PG8_MMA(1, 1, At, B1); } PG8_BAR; PG8_SCHED;
            PG8_LDB(B0, 1, 0); PG8_LDB(B1, 1, 1); PG8_SCHED; PG8_LDA(At, 1, 0); PG8_STAGE(PG8_SA(0, 1), a2 + u2[1], oc[1]);
            PG8_WAIT_V(8); PG8_WAIT_L(0); PG8_BAR; PG8_MMA(0, 0, At, B0); PG8_MMA(0, 1, At, B1); PG8_BAR; PG8_SCHED;
            PG8_LDA(At, 1, 1); PG8_STAGE(PG8_SB(1, 0), b3, voffB); PG8_STAGE(PG8_SB(1, 1), b3 + hstep, voffB); PG8_STAGE(PG8_SA(1, 0), a3 + u2[0], oc[0]);
            PG8_WAIT_V(8); PG8_WAIT_L(0); PG8_BAR; if (full) { PG8_MMA(1, 0, At, B0); PG8_MMA(1, 1, At, B1); } PG8_BAR; PG8_SCHED;
        }
        if (wr == 0) PG8_BAR;
        { const int ln = lane_now(); E(acc, cur, wr, wc, ln & 15, ln >> 4); }
        if (!has_next) break;
#pragma unroll
        for (int a = 0; a < 2; ++a)
#pragma unroll
            for (int b = 0; b < 2; ++b)
#pragma unroll
                for (int m = 0; m < 4; ++m)
#pragma unroll
                    for (int n = 0; n < 2; ++n) acc[a][b][m][n] = (f32x4){0.f, 0.f, 0.f, 0.f};
        cur = nxt; cB = nB; ++ui;
#pragma unroll
        for (int h = 0; h < 2; ++h) ubc[h] = ubn[h];
        if (wr == 1) PG8_BAR;
    }
    PG8_WAIT_V(0);
    PG8_BAR;
#undef PG8_SA
#undef PG8_SB
#undef PG8_STAGE
#undef PG8_LDA
#undef PG8_LDB
#undef PG8_MMA
#undef PG8_WAIT_V
#undef PG8_WAIT_L
#undef PG8_BAR
#undef PG8_SCHED
}
}

struct DenseSched {
    static constexpr bool GATHER = false;
    struct Unit { int pm, pn, half; };
    int nM, nN, nwg, G, c; const bf16_t* Bt; int K, lda; bool skip_ctx;
    DI void unit_of(int L, Unit& u) const {
        int wgid = L; { const int q = nwg / 8, r = nwg % 8, xcd = wgid % 8, off = wgid / 8; wgid = (xcd < r ? xcd * (q + 1) : r * (q + 1) + (xcd - r) * q) + off; }
        const int nig = 8 * nN, gid = wgid / nig, fm = gid * 8, gsz = (nM - fm) < 8 ? (nM - fm) : 8;
        u.pm = fm + ((wgid % nig) % gsz); u.pn = (wgid % nig) / gsz;
        if (skip_ctx) u.pm += u.pm >> 4;
    }
    DI bool next(int i, Unit& u) const {
        const int rounds = nwg / G, rem = nwg - rounds * G;
        if (i < rounds) { unit_of(i * G + c, u); u.half = -1; return true; }
        if (i > rounds || rem == 0) return false;
        if (2 * rem <= G) { if (c >= 2 * rem) return false; unit_of(rounds * G + (c >> 1), u); u.half = c & 1; return true; }
        if (c >= rem) return false;
        unit_of(rounds * G + c, u); u.half = -1; return true;
    }
    DI unsigned a_off(const Unit& u, int row) const { const int rr = u.half < 0 ? row : u.half * 128 + (row & 127); return (unsigned)(u.pm * 256 + rr) * (unsigned)lda; }
    DI const unsigned* a_ptr(const Unit&, int) const { return nullptr; }
    DI unsigned a_cvt(unsigned raw) const { return raw; }
    DI const bf16_t* b_base(const Unit& u) const { return Bt + (size_t)u.pn * 256 * K; }
};
struct MoeUnit { int e, pn, valid, half; const unsigned* ent; };
template <bool TAIL>
struct MoeSched {
    static constexpr bool GATHER = true;
    typedef MoeUnit Unit;
    const LAS int* tab; const unsigned* list; const unsigned* zero  ; const bf16_t* W; int K, N, TN, lda, shift, G, c, nwg;
    DI bool unit_of(int L, Unit& u) const {
        const int v = tab[1 + (lane_now() & 31)];
        const int e = __builtin_popcount((unsigned)__ballot(v <= L));
        if (e >= NEXP) return false;
        const int rem = L - __builtin_amdgcn_readfirstlane(tab[e]), cn = __builtin_amdgcn_readfirstlane(tab[40 + e]);
        const int rt = rem / TN; u.e = e; u.pn = rem - rt * TN; u.ent = list + (size_t)e * MROWS + rt * 256; u.valid = min(256, cn - rt * 256); return true;
    }
    int lo, n, GX, j;
    DI void place() { GX = G >> 3; j = c >> 3; const int per = ((((nwg + 7) >> 3) + TN - 1) / TN) * TN; lo = (c & 7) * per; n = max(0, min(per, nwg - lo)); }
    DI bool next(int i, Unit& u) const {
        u.ent = zero; u.valid = 1;
        const int rounds = n / GX, rem = n - rounds * GX;
        if (!TAIL) { u.half = -1; if (i >= rounds) return false; return unit_of(lo + i * GX + j, u); }
        if (i > 0 || rem == 0) return false;
        if (2 * rem <= GX) {
            if (j >= 2 * rem) return false;
            if (!unit_of(lo + rounds * GX + (j >> 1), u)) return false;
            u.half = j & 1; u.ent += u.half * 128; u.valid = min(128, u.valid - u.half * 128);
            return u.valid > 0;
        }
        u.half = -1; if (j >= rem) return false;
        return unit_of(lo + rounds * GX + j, u);
    }
    DI unsigned a_off(const Unit& u, int row) const { const int rr = (TAIL && u.half >= 0) ? (row & 127) : row; return (u.ent[rr < u.valid ? rr : u.valid - 1] >> shift) * (unsigned)lda; }
    DI const unsigned* a_ptr(const Unit& u, int row) const { const int rr = (TAIL && u.half >= 0) ? (row & 127) : row; return u.ent + (rr < u.valid ? rr : u.valid - 1); }
    DI unsigned a_cvt(unsigned raw) const { return (raw >> shift) * (unsigned)lda; }
    DI const bf16_t* b_base(const Unit& u) const { return W + ((size_t)u.e * N + (size_t)u.pn * 256) * K; }
};
typedef float f32x4_t __attribute__((ext_vector_type(4)));
struct XEpiStore {
    static constexpr bool PERM = true;
    bf16_t* C; int ldc;
    DI void operator()(const f32x4 (&acc)[2][2][4][2], const DenseSched::Unit& u, int wr, int wc, int fr, int fq) const {
        const int row0 = u.pm * 256 + (u.half > 0 ? 128 : 0) + wr * 64 + fr, col0 = u.pn * 256 + wc * 32 + 8 * fq;
#pragma unroll
        for (int ai = 0; ai < 2; ++ai) if (ai == 0 || u.half < 0)
#pragma unroll
            for (int m = 0; m < 4; ++m) { bf16_t* rowp = C + (size_t)(row0 + ai * 128 + m * 16) * ldc + col0;
#pragma unroll
                for (int bj = 0; bj < 2; ++bj) { const f32x4 v0 = acc[ai][bj][m][0], v1 = acc[ai][bj][m][1];
                    u32x4 w; w.x = cvtpk(v0[0], v0[1]); w.y = cvtpk(v0[2], v0[3]); w.z = cvtpk(v1[0], v1[1]); w.w = cvtpk(v1[2], v1[3]);
                    *(u32x4*)(rowp + bj * 128) = w; } }
    } };
struct XEpiStore8 {
    static constexpr bool PERM = true;
    bf16_t* C; int ldc;
    DI void operator()(const f32x4 (&acc)[2][2][4][2], const DenseSched::Unit& u, int wr, int wc, int fr, int fq) const {
        const int row0 = u.pm * 256 + (u.half > 0 ? 128 : 0) + wr * 64 + fr, col0 = u.pn * 256 + wc * 32 + 8 * fq;
#pragma unroll
        for (int ai = 0; ai < 2; ++ai) if (ai == 0 || u.half < 0)
#pragma unroll
            for (int m = 0; m < 4; ++m) { bf16_t* rowp = C + (size_t)(row0 + ai * 128 + m * 16) * ldc + col0;
#pragma unroll
                for (int bj = 0; bj < 2; ++bj) { const f32x4 v0 = acc[ai][bj][m][0] * (1.0f / 32.0f), v1 = acc[ai][bj][m][1] * (1.0f / 32.0f);
                    u32x4 w; w.x = cvtpk(v0[0], v0[1]); w.y = cvtpk(v0[2], v0[3]); w.z = cvtpk(v1[0], v1[1]); w.w = cvtpk(v1[2], v1[3]);
                    *(u32x4*)(rowp + bj * 128) = w; } }
    } };
template <> struct epi_fp8<XEpiStore8> { static constexpr int value = 2; };
struct XEpiResid {
    static constexpr bool PERM = true;
    const Params* p; const float* mod;
    DI void operator()(const f32x4 (&acc)[2][2][4][2], const DenseSched::Unit& u, int wr, int wc, int fr, int fq) const {
        const int row0 = u.pm * 256 + (u.half > 0 ? 128 : 0) + wr * 64 + fr, col0 = u.pn * 256 + wc * 32 + 8 * fq;
#pragma unroll
        for (int ai = 0; ai < 2; ++ai) if (ai == 0 || u.half < 0)
#pragma unroll
            for (int m = 0; m < 4; ++m) { const int row = row0 + ai * 128 + m * 16;
                bf16_t* xr = xb_row(*p, row) + col0; const float* gp = mod + (size_t)mod_row(row) * 6144 + 2048 + col0;
#pragma unroll
                for (int bj = 0; bj < 2; ++bj) {
                    const u32x4 xw = *(const u32x4*)(xr + bj * 128); const f32x4 g0 = *(const f32x4*)(gp + bj * 128), g1 = *(const f32x4*)(gp + bj * 128 + 4);
                    const f32x4 a0 = acc[ai][bj][m][0], a1 = acc[ai][bj][m][1];
                    u32x4 w;
                    w.x = cvtpk(bflo(xw.x) + g0[0] * a0[0], bfhi(xw.x) + g0[1] * a0[1]); w.y = cvtpk(bflo(xw.y) + g0[2] * a0[2], bfhi(xw.y) + g0[3] * a0[3]);
                    w.z = cvtpk(bflo(xw.z) + g1[0] * a1[0], bfhi(xw.z) + g1[1] * a1[1]); w.w = cvtpk(bflo(xw.w) + g1[2] * a1[2], bfhi(xw.w) + g1[3] * a1[3]);
                    *(u32x4*)(xr + bj * 128) = w; } }
    } };
struct XEpiResid8 {
    static constexpr bool PERM = true;
    const Params* p; const float* mod;
    DI void operator()(const f32x4 (&acc)[2][2][4][2], const DenseSched::Unit& u, int wr, int wc, int fr, int fq) const {
        const int row0 = u.pm * 256 + (u.half > 0 ? 128 : 0) + wr * 64 + fr, col0 = u.pn * 256 + wc * 32 + 8 * fq;
#pragma unroll
        for (int ai = 0; ai < 2; ++ai) if (ai == 0 || u.half < 0)
#pragma unroll
            for (int m = 0; m < 4; ++m) { const int row = row0 + ai * 128 + m * 16;
                bf16_t* xr = xb_row(*p, row) + col0; const float* gp = mod + (size_t)mod_row(row) * 6144 + 2048 + col0;
#pragma unroll
                for (int bj = 0; bj < 2; ++bj) {
                    const u32x4 xw = *(const u32x4*)(xr + bj * 128); const f32x4 g0 = *(const f32x4*)(gp + bj * 128) * (1.0f / 32.0f), g1 = *(const f32x4*)(gp + bj * 128 + 4) * (1.0f / 32.0f);
                    const f32x4 a0 = acc[ai][bj][m][0], a1 = acc[ai][bj][m][1];
                    u32x4 w;
                    w.x = cvtpk(bflo(xw.x) + g0[0] * a0[0], bfhi(xw.x) + g0[1] * a0[1]); w.y = cvtpk(bflo(xw.y) + g0[2] * a0[2], bfhi(xw.y) + g0[3] * a0[3]);
                    w.z = cvtpk(bflo(xw.z) + g1[0] * a1[0], bfhi(xw.z) + g1[1] * a1[1]); w.w = cvtpk(bflo(xw.w) + g1[2] * a1[2], bfhi(xw.w) + g1[3] * a1[3]);
                    *(u32x4*)(xr + bj * 128) = w; } }
    } };
template <> struct epi_fp8<XEpiResid8> { static constexpr int value = 2; };
struct XEpiGlu {
    static constexpr bool PERM = true;
    bf16_t* act; const float* gates;
    DI void operator()(const f32x4 (&acc)[2][2][4][2], const MoeUnit& u, int wr, int wc, int fr, int fq) const {
#pragma unroll
        for (int ai = 0; ai < 2; ++ai)
#pragma unroll
            for (int m = 0; m < 4; ++m) { const int i = ai * 128 + wr * 64 + m * 16 + fr;
                if (i < u.valid) { const unsigned a = u.ent[i]; const float gw = gates[a];
                    const f32x4 g0 = acc[ai][0][m][0], g1 = acc[ai][0][m][1], u0 = acc[ai][1][m][0], u1 = acc[ai][1][m][1];
                    float v[8];
#pragma unroll
                    for (int j = 0; j < 4; ++j) { v[j] = silu_f(g0[j]) * u0[j] * gw; v[4 + j] = silu_f(g1[j]) * u1[j] * gw; }
                    u32x4 w; w.x = cvtpk(v[0], v[1]); w.y = cvtpk(v[2], v[3]); w.z = cvtpk(v[4], v[5]); w.w = cvtpk(v[6], v[7]);
                    *(u32x4*)(act + (size_t)a * DEXP + u.pn * 128 + wc * 32 + 8 * fq) = w; } }
    } };
struct XEpiGlu8 : XEpiGlu {
    DI void operator()(const f32x4 (&acc)[2][2][4][2], const MoeUnit& u, int wr, int wc, int fr, int fq) const {
#pragma unroll
        for (int ai = 0; ai < 2; ++ai)
#pragma unroll
            for (int m = 0; m < 4; ++m) { const int i = ai * 128 + wr * 64 + m * 16 + fr;
                if (i < u.valid) { const unsigned a = u.ent[i]; const float gw = gates[a] * (1.0f / 32.0f);
                    const f32x4 g0 = acc[ai][0][m][0] * (1.0f / 32.0f), g1 = acc[ai][0][m][1] * (1.0f / 32.0f), u0 = acc[ai][1][m][0], u1 = acc[ai][1][m][1];
                    float v[8];
#pragma unroll
                    for (int j = 0; j < 4; ++j) { v[j] = silu_f(g0[j]) * u0[j] * gw; v[4 + j] = silu_f(g1[j]) * u1[j] * gw; }
                    u32x4 w; w.x = cvtpk(v[0], v[1]); w.y = cvtpk(v[2], v[3]); w.z = cvtpk(v[4], v[5]); w.w = cvtpk(v[6], v[7]);
                    *(u32x4*)(act + (size_t)a * DEXP + u.pn * 128 + wc * 32 + 8 * fq) = w; } }
    } };
template <> struct epi_fp8<XEpiGlu8> { static constexpr int value = 2; };
struct XEpiScatter {
    static constexpr bool PERM = true;
    bf16_t* outp;
    DI void operator()(const f32x4 (&acc)[2][2][4][2], const MoeUnit& u, int wr, int wc, int fr, int fq) const {
#pragma unroll
        for (int ai = 0; ai < 2; ++ai)
#pragma unroll
            for (int m = 0; m < 4; ++m) { const int i = ai * 128 + wr * 64 + m * 16 + fr;
                if (i < u.valid) { bf16_t* rowp = outp + (size_t)u.ent[i] * 1024 + u.pn * 256 + wc * 32 + 8 * fq;
#pragma unroll
                    for (int bj = 0; bj < 2; ++bj) { const f32x4 v0 = acc[ai][bj][m][0], v1 = acc[ai][bj][m][1];
                        u32x4 w; w.x = cvtpk(v0[0], v0[1]); w.y = cvtpk(v0[2], v0[3]); w.z = cvtpk(v1[0], v1[1]); w.w = cvtpk(v1[2], v1[3]);
                        *(u32x4*)(rowp + bj * 128) = w; } } }
    } };

template <int KIND>
struct XEpiQKV {
    static constexpr bool PERM = true;
    static constexpr int KW = KIND == 1 ? 256 : 1024, LDRAW = KIND == 1 ? 1536 : 3072;
    static constexpr float ASC = 1.0f / 32.0f;
    bf16_t* Q; bf16_t* Kb; bf16_t* RAW; const float* qn; const float* kn;
    DI void operator()(const f32x4 (&acc)[2][2][4][2], const DenseSched::Unit& u, int wr, int wc, int fr, int fq) const {
        const int col0 = u.pn * 256, row0 = u.pm * 256 + (u.half > 0 ? 128 : 0) + wr * 64 + fr;
        if (col0 >= 1024 + KW) {
#pragma unroll
            for (int ai = 0; ai < 2; ++ai) if (ai == 0 || u.half < 0)
#pragma unroll
                for (int m = 0; m < 4; ++m) { bf16_t* rowp = RAW + (size_t)(row0 + ai * 128 + m * 16) * LDRAW + col0 + wc * 32 + 8 * fq;
#pragma unroll
                    for (int bj = 0; bj < 2; ++bj) { const f32x4 v0 = acc[ai][bj][m][0] * ASC, v1 = acc[ai][bj][m][1] * ASC;
                        u32x4 w; w.x = cvtpk(v0[0], v0[1]); w.y = cvtpk(v0[2], v0[3]); w.z = cvtpk(v1[0], v1[1]); w.w = cvtpk(v1[2], v1[3]);
                        *(u32x4*)(rowp + bj * 128) = w; } }
            return;
        }
        const bool isq = col0 < 1024;
        const int head = isq ? 4 * u.pn + wc : ((col0 - 1024) >> 6) + wc;
        const float* gain = (isq ? qn : kn) + 8 * fq;
        const float scale = isq ? 0.125f * LOG2E : 1.0f;
        bf16_t* dstb = isq ? Q + head * 64 + 8 * fq : Kb + head * 64 + 8 * fq;
        const int ldd = isq ? 1024 : KW;
        f32x4 g[2][2];
#pragma unroll
        for (int bj = 0; bj < 2; ++bj)
#pragma unroll
            for (int n = 0; n < 2; ++n) g[bj][n] = *(const f32x4*)(gain + 32 * bj + 4 * n);
#pragma unroll
        for (int ai = 0; ai < 2; ++ai) if (ai == 0 || u.half < 0)
#pragma unroll
            for (int m = 0; m < 4; ++m) {
                const int row = row0 + ai * 128 + m * 16, b = row / PP, pos = row - b * PP;
                f32x4 v[2][2];
                float ss = 0.f;
#pragma unroll
                for (int bj = 0; bj < 2; ++bj)
#pragma unroll
                    for (int n = 0; n < 2; ++n) { v[bj][n] = acc[ai][bj][m][n] * ASC; ss += v[bj][n][0] * v[bj][n][0] + v[bj][n][1] * v[bj][n][1] + v[bj][n][2] * v[bj][n][2] + v[bj][n][3] * v[bj][n][3]; }
                ss += __shfl_xor(ss, 16); ss += __shfl_xor(ss, 32);
                const float rs = rsqrtf(ss * (1.0f / 64.0f) + EPS);
#pragma unroll
                for (int bj = 0; bj < 2; ++bj)
#pragma unroll
                    for (int n = 0; n < 2; ++n) v[bj][n] = v[bj][n] * rs * g[bj][n];
                if (KIND != 0 && pos < SEQ) {
                    const int prow = (pos >> 6) & 63, pcol = pos & 63;
                    const float* cs = ROPE64 + ((fq < 2 ? prow : pcol) * 16 + ((8 * fq) & 15)) * 2;
#pragma unroll
                    for (int n = 0; n < 2; ++n)
#pragma unroll
                        for (int j = 0; j < 4; ++j) {
                            const float c = cs[(4 * n + j) * 2], sn = cs[(4 * n + j) * 2 + 1], x1 = v[0][n][j], x2 = v[1][n][j];
                            v[0][n][j] = x1 * c - x2 * sn; v[1][n][j] = x2 * c + x1 * sn;
                        }
                }
                bf16_t* rowp = dstb + (size_t)row * ldd;
#pragma unroll
                for (int bj = 0; bj < 2; ++bj) { const f32x4 v0 = v[bj][0] * scale, v1 = v[bj][1] * scale;
                    u32x4 w; w.x = cvtpk(v0[0], v0[1]); w.y = cvtpk(v0[2], v0[3]); w.z = cvtpk(v1[0], v1[1]); w.w = cvtpk(v1[2], v1[3]);
                    *(u32x4*)(rowp + bj * 32) = w; }
            }
    } };
constexpr bool qkv_fp8(int kind) { return true; }
template <int KIND> struct epi_fp8<XEpiQKV<KIND>> { static constexpr int value = 2; };
template <int KIND>
DI void gemm_qkv_x(const Params& p, unsigned char* smem, const bf16_t* Wt, int N, const float* qn, const float* kn, int bid, int nb, int tid) {
    constexpr int KU = qkv_fp8(KIND) ? 512 : 1024;
    DenseSched S; S.nM = MROWS / 256; S.nN = N / 256; S.nwg = S.nM * S.nN; S.G = nb; S.c = bid; S.Bt = Wt; S.K = KU; S.lda = KU; S.skip_ctx = false;
    XEpiQKV<KIND> e{(bf16_t*)(p.ws + WS_Q), (bf16_t*)(p.ws + WS_K), (bf16_t*)(p.ws + WS_RAW), qn, kn};
    pg8::gemm_phase((lds_ptr)smem, (const bf16_t*)(p.ws + WS_H), KU, S, e, tid);
}
template <bool UQ>
struct XEpiMla {
    static constexpr bool PERM = true;
    bf16_t* Q; bf16_t* Kb; bf16_t* V; const float* qn; const float* kn;
    DI void operator()(const f32x4 (&acc)[2][2][4][2], const DenseSched::Unit& u, int wr, int wc, int fr, int fq) const {
        const int row0 = u.pm * 256 + (u.half > 0 ? 128 : 0) + wr * 64 + fr;
        if (u.pn < 4) {
            const int head = 4 * u.pn + wc;
            const float* gain = (UQ ? qn : kn) + 8 * fq;
            const float scale = UQ ? 0.10206207261596577f * LOG2E : 1.0f;
            bf16_t* dstb = (UQ ? Q : Kb) + head * 96 + 8 * fq;
            f32x4 g[2][2];
#pragma unroll
            for (int bj = 0; bj < 2; ++bj)
#pragma unroll
                for (int n = 0; n < 2; ++n) g[bj][n] = *(const f32x4*)(gain + 32 * bj + 4 * n);
#pragma unroll
            for (int ai = 0; ai < 2; ++ai) if (ai == 0 || u.half < 0)
#pragma unroll
                for (int m = 0; m < 4; ++m) {
                    const int row = row0 + ai * 128 + m * 16;
                    float ss = 0.f;
#pragma unroll
                    for (int bj = 0; bj < 2; ++bj)
#pragma unroll
                        for (int n = 0; n < 2; ++n) { const f32x4 v = acc[ai][bj][m][n]; ss += v[0] * v[0] + v[1] * v[1] + v[2] * v[2] + v[3] * v[3]; }
                    ss += __shfl_xor(ss, 16); ss += __shfl_xor(ss, 32);
                    const float rs = rsqrtf(ss * (1.0f / 64.0f) + EPS) * scale;
                    bf16_t* rowp = dstb + (size_t)row * 1536;
#pragma unroll
                    for (int bj = 0; bj < 2; ++bj) { const f32x4 v0 = acc[ai][bj][m][0] * rs * g[bj][0], v1 = acc[ai][bj][m][1] * rs * g[bj][1];
                        u32x4 w; w.x = cvtpk(v0[0], v0[1]); w.y = cvtpk(v0[2], v0[3]); w.z = cvtpk(v1[0], v1[1]); w.w = cvtpk(v1[2], v1[3]);
                        *(u32x4*)(rowp + bj * 32) = w; }
                }
        } else if (UQ) {
            const float scale = 0.10206207261596577f * LOG2E;
            const f32x4 g1 = *(const f32x4*)(qn + 64 + 4 * fq), g2 = *(const f32x4*)(qn + 64 + 16 + 4 * fq);
#pragma unroll
            for (int ai = 0; ai < 2; ++ai) if (ai == 0 || u.half < 0)
#pragma unroll
                for (int m = 0; m < 4; ++m) {
                    const int row = row0 + ai * 128 + m * 16, b = row / PP, pos = row - b * PP;
                    const int prow = (pos >> 6) & 63, pcol = pos & 63;
                    const float* cs = ROPE32 + ((fq < 2 ? prow : pcol) * 8 + ((4 * fq) & 7)) * 2;
#pragma unroll
                    for (int bj = 0; bj < 2; ++bj) {
                        f32x4 x1 = acc[ai][bj][m][0], x2 = acc[ai][bj][m][1];
                        float ss = x1[0] * x1[0] + x1[1] * x1[1] + x1[2] * x1[2] + x1[3] * x1[3] + x2[0] * x2[0] + x2[1] * x2[1] + x2[2] * x2[2] + x2[3] * x2[3];
                        ss += __shfl_xor(ss, 16); ss += __shfl_xor(ss, 32);
                        const float rs = rsqrtf(ss * (1.0f / 32.0f) + EPS);
                        x1 = x1 * rs * g1; x2 = x2 * rs * g2;
                        if (pos < SEQ) {
#pragma unroll
                            for (int j = 0; j < 4; ++j) { const float c = cs[2 * j], sn = cs[2 * j + 1], a1 = x1[j], a2 = x2[j]; x1[j] = a1 * c - a2 * sn; x2[j] = a2 * c + a1 * sn; }
                        }
                        x1 = x1 * scale; x2 = x2 * scale;
                        bf16_t* rowp = Q + (size_t)row * 1536 + (8 * (u.pn - 4) + 4 * bj + wc) * 96 + 64 + 4 * fq;
                        u32x2 w1, w2; w1.x = cvtpk(x1[0], x1[1]); w1.y = cvtpk(x1[2], x1[3]); w2.x = cvtpk(x2[0], x2[1]); w2.y = cvtpk(x2[2], x2[3]);
                        *(u32x2*)rowp = w1; *(u32x2*)(rowp + 16) = w2;
                    }
                }
        } else {
#pragma unroll
            for (int ai = 0; ai < 2; ++ai) if (ai == 0 || u.half < 0)
#pragma unroll
                for (int m = 0; m < 4; ++m) { bf16_t* rowp = V + (size_t)(row0 + ai * 128 + m * 16) * 1024 + (u.pn - 4) * 256 + wc * 32 + 8 * fq;
#pragma unroll
                    for (int bj = 0; bj < 2; ++bj) { const f32x4 v0 = acc[ai][bj][m][0], v1 = acc[ai][bj][m][1];
                        u32x4 w; w.x = cvtpk(v0[0], v0[1]); w.y = cvtpk(v0[2], v0[3]); w.z = cvtpk(v1[0], v1[1]); w.w = cvtpk(v1[2], v1[3]);
                        *(u32x4*)(rowp + bj * 128) = w; } }
        }
    } };
template <bool UQ>
DI void gemm_mla_x(const Params& p, unsigned char* smem, int bid, int nb, int tid) {
    bf16_t* O = (bf16_t*)(p.ws + WS_O);
    DenseSched S; S.nM = MROWS / 256; S.nN = (UQ ? 1536 : 2048) / 256; S.nwg = S.nM * S.nN; S.G = nb; S.c = bid; S.Bt = (const bf16_t*)(p.ws + (UQ ? W_UQ : W_UKV)); S.K = UQ ? 384 : 256; S.lda = S.K; S.skip_ctx = false;
    XEpiMla<UQ> e{(bf16_t*)(p.ws + WS_Q), (bf16_t*)(p.ws + WS_K), (bf16_t*)(p.ws + WS_RAW), p.in[28], p.in[29]};
    pg8::gemm_phase((lds_ptr)smem, UQ ? O : O + (size_t)MROWS * 384, S.K, S, e, tid);
}
template <int EPIK>
DI void gemm_dense_x(const Params& p, unsigned char* smem, const bf16_t* A, int lda, const bf16_t* Wt, int K, int N, bf16_t* C, int ldc, const float* mod, int bid, int nb, int tid, bool skip_ctx = false) {
    DenseSched S; S.nM = skip_ctx ? NBATCH * 16 : MROWS / 256; S.nN = N / 256; S.nwg = S.nM * S.nN; S.G = nb; S.c = bid; S.Bt = Wt; S.K = K; S.lda = lda; S.skip_ctx = skip_ctx;
    if (EPIK == 0) { XEpiStore e{C, ldc}; pg8::gemm_phase((lds_ptr)smem, A, K, S, e, tid); }
    else if (EPIK == 2) { XEpiStore8 e{C, ldc}; pg8::gemm_phase((lds_ptr)smem, A, K, S, e, tid); }
    else if (EPIK == 3) { XEpiResid8 e{&p, mod}; pg8::gemm_phase((lds_ptr)smem, A, K, S, e, tid); }
    else { XEpiResid e{&p, mod}; pg8::gemm_phase((lds_ptr)smem, A, K, S, e, tid); }
}
template <int WHICH, bool TAIL>
DI void gemm_moe_call(const Params& p, unsigned char* smem, int layer, int bid, int nb, int tid) {
    MoeSched<TAIL> S; S.list = (const unsigned*)(p.ws + WS_LIST); S.zero = (const unsigned*)(p.ws + WS_CTL) + 8192; S.G = nb; S.c = bid;
    {
        LAS int* tab = (LAS int*)(smem + GEMM_LDS);
        constexpr int TNc = WHICH == 0 ? 2 : 4;
        if (tid < 64) {
            const unsigned cv = tid < 32 ? ((const unsigned*)(p.ws + WS_CTL) + CW_CNT + layer * 32)[tid] : 0u;
            int incl = (int)((cv + 255u) >> 8) * TNc;
#pragma unroll
            for (int d = 1; d < 32; d <<= 1) { const int o = __shfl_up(incl, d); if (tid >= d) incl += o; }
            if (tid < 32) { tab[1 + tid] = incl; tab[40 + tid] = (int)cv; }
            if (tid == 0) tab[0] = 0;
        }
        __syncthreads();
        S.tab = tab; S.nwg = __builtin_amdgcn_readfirstlane(tab[32]);
    }
    if (WHICH == 0) { S.W = (const bf16_t*)(p.ws + W_GU + (size_t)layer * 32 * 512 * 1024); S.K = 512; S.N = 512; S.TN = 2; S.lda = 512; S.shift = 1;
        S.place(); XEpiGlu8 e{{(bf16_t*)(p.ws + WS_Q), (const float*)(p.ws + WS_GATE)}}; pg8::gemm_phase((lds_ptr)smem, (const bf16_t*)(p.ws + WS_H), 512, S, e, tid); }
    else { S.W = (const bf16_t*)(p.ws + W_DN) + (size_t)layer * 32 * 1024 * 256; S.K = 256; S.N = 1024; S.TN = 4; S.lda = DEXP; S.shift = 0;
        S.place(); XEpiScatter e{(bf16_t*)(p.ws + WS_RAW)}; pg8::gemm_phase((lds_ptr)smem, (const bf16_t*)(p.ws + WS_Q), 256, S, e, tid); }
}
template <int WHICH>
DI void gemm_moe_x(const Params& p, unsigned char* smem, int layer, int bid, int nb, int tid) {
    const int wv = __builtin_amdgcn_readfirstlane(tid >> 6);
    gemm_moe_call<WHICH, false>(p, smem, layer, bid, nb, (wv << 6) | lane_now());
    gemm_moe_call<WHICH, true>(p, smem, layer, bid, nb, (wv << 6) | lane_now());
}

constexpr int NPHASES = 2 + (7 + 7 + 9 + 7) + 1;
constexpr int SMEM_BYTES = GEMM_LDS + 512;

template <int KIND>
DI void layer_phases(const Params& p, int& ph, const int lo, const int hi, const XcdBarrier& bar, unsigned char* smem, int bid, int nb, int wid_u) {
    constexpr int L = KIND;
    const float* mod = (const float*)(p.ws + WS_MOD) + (size_t)L * 9 * 6144;
    bf16_t* H = (bf16_t*)(p.ws + WS_H); bf16_t* O = (bf16_t*)(p.ws + WS_O); bf16_t* RAW = (bf16_t*)(p.ws + WS_RAW);
    bf16_t* Q = (bf16_t*)(p.ws + WS_Q); bf16_t* Kb = (bf16_t*)(p.ws + WS_K);
#ifndef AABL
#define AABL 0
#endif
#ifndef GPROBE
#define GPROBE 0
#endif
#ifndef DUP_MASK
#define DUP_MASK 0ull
#endif
#define PHASE2(BODY, DUPBODY) do { if (lo <= ph && ph < hi) { const int tid = (wid_u << 6) | lane_now(); if ((DUP_MASK >> ph) & 1ull) { DUPBODY; xcd_barrier(bar, tid == 0); } BODY; } if (lo <= ph && ph + 1 < hi) xcd_barrier(bar, ((wid_u << 6) | lane_now()) == 0); ++ph; } while (0)
#define PHASE(...) PHASE2((__VA_ARGS__), (__VA_ARGS__))
    if (L == 0) PHASE(phase_rows<2 | 8 | 32>(p, L, 0, bid, nb, tid), phase_router_prep(p, bid, nb, tid));
    else PHASE2((phase_rows<3 | 32>(p, L, 0, bid, nb, tid)), (phase_rows<2 | 32>(p, L, 0, bid, nb, tid)));
    AttnP a{};
    if (KIND == 0) {
        PHASE(gemm_qkv_x<0>(p, smem, (const bf16_t*)(p.ws + W_QKV0), 3072, p.in[15], p.in[16], bid, nb, tid));
        a = AttnP{Q, 1024, Kb, 1024, RAW + 2048, 3072, O, 1024, 16, 0, 0, 64, p.in[17], nullptr, 1, p.in[16]};
        PHASE(attn_na(a, smem, bid, nb, tid));
        PHASE2((gemm_dense_x<3>(p, smem, O, 512, (const bf16_t*)(p.ws + W_O0), 512, 1024, nullptr, 0, mod, bid, nb, tid)), (gemm_dense_x<0>(p, smem, O, 1024, (const bf16_t*)(p.ws + W_O0), 1024, 1024, RAW, 1024, nullptr, bid, nb, tid)));
    } else if (KIND == 1) {
        PHASE(gemm_qkv_x<1>(p, smem, (const bf16_t*)(p.ws + W_QKV1), 1536, p.in[20], p.in[21], bid, nb, tid));
        a = AttnP{Q, 1024, Kb, 256, RAW + 1280, 1536, O, 1024, 16, 2, 2, 64, nullptr, p.in[22], 1};
        PHASE(attn_mfma<64, 64, 1>(a, smem, bid, nb, tid));
        PHASE2((gemm_dense_x<3>(p, smem, O, 512, (const bf16_t*)(p.ws + W_O1), 512, 1024, nullptr, 0, mod, bid, nb, tid)), (gemm_dense_x<0>(p, smem, O, 1024, (const bf16_t*)(p.ws + W_O1), 1024, 1024, RAW, 1024, nullptr, bid, nb, tid)));
    } else if (KIND == 2) {
        bf16_t* cqn = O; bf16_t* ckvn = O + (size_t)MROWS * 384;
        PHASE(gemm_dense_x<2>(p, smem, H, 512, (const bf16_t*)(p.ws + W_DQKV), 512, 768, Q, 768, nullptr, bid, nb, tid));
        PHASE(phase_post_mla1(p, bid, nb, tid));
        PHASE(gemm_mla_x<true>(p, smem, bid, nb, tid), gemm_mla_x<false>(p, smem, bid, nb, (wid_u << 6) | lane_now()));
        a = AttnP{Q, 1536, Kb, 1536, RAW, 1024, O, 1024, 16, 0, 0, 64, nullptr, nullptr, 1};
        PHASE(attn_mfma<96, 64, 2>(a, smem, bid, nb, tid));
        PHASE2((gemm_dense_x<3>(p, smem, O, 512, (const bf16_t*)(p.ws + W_O2), 512, 1024, nullptr, 0, mod, bid, nb, tid)), (gemm_dense_x<0>(p, smem, O, 1024, (const bf16_t*)(p.ws + W_O2), 1024, 1024, RAW, 1024, nullptr, bid, nb, tid)));
    } else {
        PHASE(gemm_qkv_x<3>(p, smem, (const bf16_t*)(p.ws + W_QKV3), 3072, p.in[32], p.in[33], bid, nb, tid));
        a = AttnP{Q, 1024, Kb, 1024, RAW + 2048, 3072, H  , 2048, 16, 0, 1, 128, nullptr, nullptr, 0, nullptr, p.in[34], p.in[35], (unsigned char*)RAW  , 6144};
        PHASE(attn_mfma<64, 128, 2>(a, smem, bid, nb, tid));
        PHASE(gemm_dense_x<3>(p, smem, RAW, 3072, (const bf16_t*)(p.ws + W_O3), 512, 1024, nullptr, 0, mod, bid, nb, tid, true));
    }
    PHASE(phase_router(p, smem, L, L == 3, bid, nb, tid));
    PHASE(gemm_moe_x<0>(p, smem, L, bid, nb, tid));
    PHASE(gemm_moe_x<1>(p, smem, L, bid, nb, tid));
}

__global__ void __launch_bounds__(NTHREADS, 2) mega(Params p, int lo, int hi) {
    extern __shared__ __attribute__((aligned(16))) unsigned char smem[];
    const int bid = blockIdx.x, nb = gridDim.x, wid_u = __builtin_amdgcn_readfirstlane(threadIdx.x >> 6);
    float* lds = (float*)smem;
    volatile LAS unsigned* xbw = (volatile LAS unsigned*)(smem + SMEM_BYTES - 16);
    if (threadIdx.x == 0) { xbw[0] = 0u; xbw[1] = 0u; }
    __syncthreads();
    XcdBarrier bar = xcd_barrier_post((unsigned*)(p.ws + WS_CTL), xbw);
    int ph = 0;
    PHASE(phase_prologue(p, lds, bid, nb, tid));
    PHASE(phase_mod_reduce(p, bid, nb, tid));
    layer_phases<0>(p, ph, lo, hi, bar, smem, bid, nb, wid_u);
    layer_phases<1>(p, ph, lo, hi, bar, smem, bid, nb, wid_u);
    layer_phases<2>(p, ph, lo, hi, bar, smem, bid, nb, wid_u);
    layer_phases<3>(p, ph, lo, hi, bar, smem, bid, nb, wid_u);
    PHASE2((phase_rows<1 | 16>(p, 3, 0, bid, nb, tid)), (void)0);
}

extern "C" void kernel_launch(void* const* d_in, const int* in_sizes, int n_in, void* d_out, int out_size, void* d_ws, size_t ws_size, hipStream_t stream) {
    (void)in_sizes; (void)out_size;
    if (n_in < 37 || ws_size < WS_END) { fprintf(stderr, "kernel_launch: unexpected inputs (n_in %d, ws %zu)\n", n_in, ws_size); return; }
    static int grid = 0;
    if (!grid) {
        int dev = 0, cus = 0, per_cu = 0;
        hipGetDevice(&dev);
        hipDeviceGetAttribute(&cus, hipDeviceAttributeMultiprocessorCount, dev);
        hipFuncSetAttribute((const void*)mega, hipFuncAttributeMaxDynamicSharedMemorySize, SMEM_BYTES);
        hipOccupancyMaxActiveBlocksPerMultiprocessor(&per_cu, mega, NTHREADS, SMEM_BYTES);
        if (per_cu < 1) per_cu = 1;
        grid = cus * (per_cu < 1 ? per_cu : 1);
    }
    Params p{};
    for (int i = 0; i < 37; ++i) p.in[i] = (const float*)d_in[i];
    p.out = (float*)d_out; p.ws = (unsigned char*)d_ws;
    hipMemsetAsync(p.ws + WS_CTL, 0, 65536, stream);
#if ONE_LAUNCH
    hipLaunchKernelGGL(mega, dim3(grid), dim3(NTHREADS), SMEM_BYTES, stream, p, 0, NPHASES);
#else
    for (int k = 0; k < NPHASES; ++k) hipLaunchKernelGGL(mega, dim3(grid), dim3(NTHREADS), SMEM_BYTES, stream, p, k, k + 1);
#endif
}
```

```cpp
#include <hip/hip_runtime.h>
#include <stdint.h>
#include <stdio.h>

#ifndef ONE_LAUNCH
#define ONE_LAUNCH 1
#endif

#define DI __device__ __forceinline__
typedef unsigned short bf16_t;
typedef short bf16x8 __attribute__((ext_vector_type(8)));
typedef float f32x4 __attribute__((ext_vector_type(4)));
typedef float f32x16 __attribute__((ext_vector_type(16)));
typedef unsigned u32x4 __attribute__((ext_vector_type(4)));
typedef unsigned u32x2 __attribute__((ext_vector_type(2)));

constexpr int DM = 1024, NBATCH = 8, SEQ = 4096, CTXL = 256, PP = SEQ + CTXL, MROWS = NBATCH * PP;
constexpr int NEXP = 32, DEXP = 256;
constexpr float EPS = 1e-6f, LOG2E = 1.4426950408889634f;
constexpr int NTHREADS = 512, NW = NTHREADS / 64;

constexpr size_t MiB = 1ull << 20;
constexpr size_t WS_RAW_FWD = 380ull << 20;
constexpr size_t WS_CTL = 0, CTL_BYTES = 1 * MiB;
constexpr size_t WS_MOD = 1 * MiB;
constexpr size_t WS_MODP = WS_RAW_FWD;
constexpr size_t WS_XCTX = 9 * MiB;
constexpr size_t WS_LIST = 17 * MiB;
constexpr size_t WS_GATE = 22 * MiB;
constexpr size_t WS_W = 24 * MiB;
constexpr size_t W_QKV0 = WS_W + 0 * MiB, W_O0 = WS_W + 6 * MiB, W_QKV1 = WS_W + 8 * MiB, W_O1 = WS_W + 11 * MiB, W_DQKV = WS_W + 13 * MiB,
                 W_UQ = WS_W + 15 * MiB, W_UKV = WS_W + 17 * MiB, W_O2 = WS_W + 18 * MiB, W_QKV3 = WS_W + 20 * MiB, W_O3 = WS_W + 26 * MiB,
                 W_GU = WS_W + 28 * MiB, W_DN = WS_W + 156 * MiB;
constexpr size_t WS_H = 244 * MiB;
constexpr size_t WS_O = 312 * MiB;
constexpr size_t WS_RAW = 380 * MiB;
constexpr size_t WS_Q = 620 * MiB;
constexpr size_t WS_K = 722 * MiB;
constexpr size_t WS_XB = 824 * MiB;
constexpr size_t WS_END = 892 * MiB;
constexpr int CW_CNT = 4096;

constexpr size_t WS_RW = 2 * MiB;
struct Params { const float* in[37]; float* out; unsigned char* ws; };

DI unsigned f2bf(float f) { unsigned u = __float_as_uint(f); return (u + 0x7fffu + ((u >> 16) & 1u)) >> 16; }
DI float bf2f(unsigned h) { return __uint_as_float(h << 16); }
DI unsigned pk2(float lo, float hi) { return f2bf(lo) | (f2bf(hi) << 16); }
DI float bflo(unsigned w) { return __uint_as_float(w << 16); }
DI float bfhi(unsigned w) { return __uint_as_float(w & 0xffff0000u); }
DI int lane_now() { unsigned lane; asm volatile("v_mbcnt_lo_u32_b32 %0, -1, 0\n\tv_mbcnt_hi_u32_b32 %0, -1, %0" : "=v"(lane)); return (int)lane; }
DI float wave_sum(float v) {
#pragma unroll
    for (int o = 32; o > 0; o >>= 1) v += __shfl_xor(v, o);
    return v;
}
DI float silu_f(float x) { return x / (1.0f + __expf(-x)); }
DI void unpack8(const u32x4 w, float (&f)[8]) {
    f[0] = bflo(w.x); f[1] = bfhi(w.x); f[2] = bflo(w.y); f[3] = bfhi(w.y); f[4] = bflo(w.z); f[5] = bfhi(w.z); f[6] = bflo(w.w); f[7] = bfhi(w.w);
}
DI u32x4 pack8(const float (&f)[8]) { u32x4 w; w.x = pk2(f[0], f[1]); w.y = pk2(f[2], f[3]); w.z = pk2(f[4], f[5]); w.w = pk2(f[6], f[7]); return w; }
DI float* xrow_ptr(const Params& p, int r) {
    const int b = r / PP, pos = r - b * PP;
    return pos < SEQ ? p.out + ((size_t)b * SEQ + pos) * DM : (float*)(p.ws + WS_XCTX) + ((size_t)b * CTXL + (pos - SEQ)) * DM;
}
DI bf16_t* xb_row(const Params& p, int r) { return (bf16_t*)(p.ws + WS_XB) + (size_t)r * DM; }
DI int mod_row(int r) { const int b = r / PP, pos = r - b * PP; return pos < SEQ ? b : 8; }
__device__ const float ROPE64[2048] = {
  1.000000000e+00f, 0.000000000e+00f, 1.000000000e+00f, 0.000000000e+00f, 1.000000000e+00f, 0.000000000e+00f, 1.000000000e+00f, 0.000000000e+00f,
  1.000000000e+00f, 0.000000000e+00f, 1.000000000e+00f, 0.000000000e+00f, 1.000000000e+00f, 0.000000000e+00f, 1.000000000e+00f, 0.000000000e+00f,
  1.000000000e+00f, 0.000000000e+00f, 1.000000000e+00f, 0.000000000e+00f, 1.000000000e+00f, 0.000000000e+00f, 1.000000000e+00f, 0.000000000e+00f,
  1.000000000e+00f, 0.000000000e+00f, 1.000000000e+00f, 0.000000000e+00f, 1.000000000e+00f, 0.000000000e+00f, 1.000000000e+00f, 0.000000000e+00f,
  5.403022766e-01f, 8.414709568e-01f, 8.460091352e-01f, 5.331684351e-01f, 9.504152536e-01f, 3.109835982e-01f, 9.842302203e-01f, 1.768921912e-01f,
  9.950041771e-01f, 9.983342141e-02f, 9.984192848e-01f, 5.620449781e-02f, 9.995000362e-01f, 3.161750361e-02f, 9.998418689e-01f, 1.778185740e-02f,
  9.999499917e-01f, 9.999833070e-03f, 9.999842048e-01f, 5.623383448e-03f, 9.999949932e-01f, 3.162272274e-03f, 9.999983907e-01f, 1.778278500e-03f,
  9.999995232e-01f, 9.999999311e-04f, 9.999998212e-01f, 5.623412435e-04f, 9.999999404e-01f, 3.162277571e-04f, 1.000000000e+00f, 1.778279402e-04f,
  -4.161468446e-01f, 9.092974067e-01f, 4.314628243e-01f, 9.021307230e-01f, 8.065783978e-01f, 5.911270976e-01f, 9.374182820e-01f, 3.482052684e-01f,
  9.800665975e-01f, 1.986693293e-01f, 9.936820865e-01f, 1.122313142e-01f, 9.980006814e-01f, 6.320339441e-02f, 9.993675947e-01f, 3.555808961e-02f,
  9.998000264e-01f, 1.999866590e-02f, 9.999367595e-01f, 1.124658901e-02f, 9.999799728e-01f, 6.324512884e-03f, 9.999936819e-01f, 3.556551412e-03f,
  9.999979734e-01f, 1.999998698e-03f, 9.999993443e-01f, 1.124682371e-03f, 9.999998212e-01f, 6.324554561e-04f, 9.999999404e-01f, 3.556558804e-04f,
  -9.899924994e-01f, 1.411200017e-01f, -1.159661636e-01f, 9.932531714e-01f, 5.827536583e-01f, 8.126488924e-01f, 8.610406518e-01f, 5.085361004e-01f,
  9.553365111e-01f, 2.955202162e-01f, 9.858034849e-01f, 1.679033041e-01f, 9.955033660e-01f, 9.472608566e-02f, 9.985772967e-01f, 5.332308263e-02f,
  9.995500445e-01f, 2.999549918e-02f, 9.998577237e-01f, 1.686943881e-02f, 9.999549985e-01f, 9.486690164e-03f, 9.999857545e-01f, 5.334813148e-03f,
  9.999955297e-01f, 2.999995602e-03f, 9.999985695e-01f, 1.687023090e-03f, 9.999995232e-01f, 9.486831259e-04f, 9.999998808e-01f, 5.334838061e-04f,
  -6.536436081e-01f, -7.568024993e-01f, -6.276797056e-01f, 7.784717083e-01f, 3.011374772e-01f, 9.535807371e-01f, 7.575061917e-01f, 6.528279781e-01f,
  9.210609794e-01f, 3.894183338e-01f, 9.748082757e-01f, 2.230444849e-01f, 9.920106530e-01f, 1.261540651e-01f, 9.974712729e-01f, 7.107120752e-02f,
  9.992001057e-01f, 3.998933360e-02f, 9.997470379e-01f, 2.249175683e-02f, 9.999200106e-01f, 1.264877338e-02f, 9.999747276e-01f, 7.113057654e-03f,
  9.999920130e-01f, 3.999989480e-03f, 9.999974966e-01f, 2.249363344e-03f, 9.999992251e-01f, 1.264910679e-03f, 9.999997616e-01f, 7.113117026e-04f,
  2.836622000e-01f, -9.589242935e-01f, -9.460792542e-01f, 3.239352703e-01f, -1.034233812e-02f, 9.999465346e-01f, 6.300802827e-01f, 7.765299678e-01f,
  8.775825500e-01f, 4.794255495e-01f, 9.607312679e-01f, 2.774805427e-01f, 9.875259995e-01f, 1.574558765e-01f, 9.960497618e-01f, 8.879686147e-02f,
  9.987502694e-01f, 4.997916520e-02f, 9.996047616e-01f, 2.811336145e-02f, 9.998750091e-01f, 1.581072807e-02f, 9.999604821e-01f, 8.891279809e-03f,
  9.999874830e-01f, 4.999979399e-03f, 9.999960661e-01f, 2.811702900e-03f, 9.999987483e-01f, 1.581138116e-03f, 9.999995828e-01f, 8.891395992e-04f,
  9.601702690e-01f, -2.794154882e-01f, -9.731037021e-01f, -2.303675115e-01f, -3.207964003e-01f, 9.471482038e-01f, 4.827820361e-01f, 8.757405281e-01f,
  8.253356218e-01f, 5.646424890e-01f, 9.436169863e-01f, 3.310393095e-01f, 9.820539355e-01f, 1.886002719e-01f, 9.943132997e-01f, 1.064944416e-01f,
  9.982005358e-01f, 5.996400490e-02f, 9.994308352e-01f, 3.373407945e-02f, 9.998199940e-01f, 1.897252724e-02f, 9.999430776e-01f, 1.066947449e-02f,
  9.999819994e-01f, 5.999964196e-03f, 9.999943376e-01f, 3.374041524e-03f, 9.999982119e-01f, 1.897365320e-03f, 9.999994040e-01f, 1.066967379e-03f,
  7.539022565e-01f, 6.569865942e-01f, -7.004297972e-01f, -7.137212753e-01f, -5.994374752e-01f, 8.004215956e-01f, 3.202570081e-01f, 9.473307133e-01f,
  7.648422122e-01f, 6.442176700e-01f, 9.235194325e-01f, 3.835515678e-01f, 9.755998850e-01f, 2.195560932e-01f, 9.922624230e-01f, 1.241583377e-01f,
  9.975510240e-01f, 6.994284689e-02f, 9.992253184e-01f, 3.935372457e-02f, 9.997550249e-01f, 2.213413455e-02f, 9.999225140e-01f, 1.244763471e-02f,
  9.999755025e-01f, 6.999942940e-03f, 9.999922514e-01f, 3.936378751e-03f, 9.999975562e-01f, 2.213592408e-03f, 9.999992251e-01f, 1.244795276e-03f,
  -1.455000341e-01f, 9.893582463e-01f, -2.120364457e-01f, -9.772617817e-01f, -8.186324239e-01f, 5.743177533e-01f, 1.476312131e-01f, 9.890424609e-01f,
  6.967067122e-01f, 7.173560858e-01f, 9.005023241e-01f, 4.348512292e-01f, 9.681702852e-01f, 2.502923310e-01f, 9.898977876e-01f, 1.417829692e-01f,
  9.968017340e-01f, 7.991468906e-02f, 9.989882708e-01f, 4.497213289e-02f, 9.996800423e-01f, 2.529552206e-02f, 9.998987913e-01f, 1.422575582e-02f,
  9.999679923e-01f, 7.999914698e-03f, 9.999898672e-01f, 4.498715047e-03f, 9.999967813e-01f, 2.529819263e-03f, 9.999989867e-01f, 1.422623056e-03f,
  -9.111302495e-01f, 4.121184945e-01f, 3.416602612e-01f, -9.398235083e-01f, -9.566441774e-01f, 2.912592292e-01f, -2.965079620e-02f, 9.995602965e-01f,
  6.216099262e-01f, 7.833269238e-01f, 8.746382594e-01f, 4.847761393e-01f, 9.597726464e-01f, 2.807783186e-01f, 9.872201085e-01f, 1.593627781e-01f,
  9.959527254e-01f, 8.987854421e-02f, 9.987195730e-01f, 5.058911815e-02f, 9.995950460e-01f, 2.845665626e-02f, 9.998719096e-01f, 1.600383036e-02f,
  9.999595284e-01f, 8.999879472e-03f, 9.999871850e-01f, 5.061050411e-03f, 9.999959469e-01f, 2.846045885e-03f, 9.999987483e-01f, 1.600450720e-03f,
  -8.390715122e-01f, -5.440211296e-01f, 7.901318669e-01f, -6.129369140e-01f, -9.997860789e-01f, -2.068356983e-02f, -2.059976310e-01f, 9.785524607e-01f,
  5.403022766e-01f, 8.414709568e-01f, 8.460091352e-01f, 5.331684351e-01f, 9.504153132e-01f, 3.109835684e-01f, 9.842302203e-01f, 1.768921912e-01f,
  9.950041771e-01f, 9.983341396e-02f, 9.984192848e-01f, 5.620449781e-02f, 9.995000362e-01f, 3.161750361e-02f, 9.998418689e-01f, 1.778185740e-02f,
  9.999499917e-01f, 9.999834001e-03f, 9.999842048e-01f, 5.623383448e-03f, 9.999949932e-01f, 3.162272274e-03f, 9.999983907e-01f, 1.778278500e-03f,
  4.425697960e-03f, -9.999902248e-01f, 9.952573776e-01f, -9.727645665e-02f, -9.437797666e-01f, -3.305749595e-01f, -3.758473992e-01f, 9.266815782e-01f,
  4.535960853e-01f, 8.912073970e-01f, 8.147053123e-01f, 5.798751712e-01f, 9.401075840e-01f, 3.408778608e-01f, 9.809291363e-01f, 1.943656504e-01f,
  9.939560890e-01f, 1.097782999e-01f, 9.980874062e-01f, 6.181810424e-02f, 9.993950725e-01f, 3.477803990e-02f, 9.998086691e-01f, 1.955982670e-02f,
  9.999395013e-01f, 1.099977922e-02f, 9.999808669e-01f, 6.185714621e-03f, 9.999939203e-01f, 3.478498431e-03f, 9.999980927e-01f, 1.956106164e-03f,
  8.438539505e-01f, -5.365729332e-01f, 8.938615918e-01f, 4.483429790e-01f, -7.941793799e-01f, -6.076834202e-01f, -5.338430405e-01f, 8.455836177e-01f,
  3.623577058e-01f, 9.320390821e-01f, 7.808259130e-01f, 6.247486472e-01f, 9.288598895e-01f, 3.704313040e-01f, 9.773178697e-01f, 2.117776722e-01f,
  9.928086400e-01f, 1.197122037e-01f, 9.977239966e-01f, 6.742975861e-02f, 9.992800951e-01f, 3.793822229e-02f, 9.997723103e-01f, 2.133773454e-02f,
  9.999279976e-01f, 1.199971233e-02f, 9.999772310e-01f, 6.748044398e-03f, 9.999927878e-01f, 3.794723889e-03f, 9.999977350e-01f, 2.133933594e-03f,
  9.074468017e-01f, 4.201670289e-01f, 5.171728730e-01f, 8.558809757e-01f, -5.658205152e-01f, -8.245284557e-01f, -6.750016809e-01f, 7.378162146e-01f,
  2.674987614e-01f, 9.635581970e-01f, 7.444779873e-01f, 6.676470041e-01f, 9.166833758e-01f, 3.996143043e-01f, 9.733975530e-01f, 2.291227132e-01f,
  9.915618896e-01f, 1.296341419e-01f, 9.973290563e-01f, 7.303927839e-02f, 9.991551042e-01f, 4.109803215e-02f, 9.997327924e-01f, 2.311557345e-02f,
  9.999154806e-01f, 1.299963426e-02f, 9.999732971e-01f, 7.310371846e-03f, 9.999915361e-01f, 4.110949114e-03f, 9.999973178e-01f, 2.311761025e-03f,
  1.367372125e-01f, 9.906073809e-01f, -1.879615150e-02f, 9.998233318e-01f, -2.813494802e-01f, -9.596053958e-01f, -7.948709130e-01f, 6.067785621e-01f,
  1.699671596e-01f, 9.854497313e-01f, 7.057763934e-01f, 7.084347010e-01f, 9.035902619e-01f, 4.283977747e-01f, 9.691694379e-01f, 2.463953048e-01f,
  9.902160168e-01f, 1.395431161e-01f, 9.969025850e-01f, 7.864648104e-02f, 9.990201592e-01f, 4.425742477e-02f, 9.996901155e-01f, 2.489333972e-02f,
  9.999020100e-01f, 1.399954315e-02f, 9.999690056e-01f, 7.872696966e-03f, 9.999902248e-01f, 4.427174106e-03f, 9.999969006e-01f, 2.489588689e-03f,
  -7.596879005e-01f, 6.502878666e-01f, -5.489754677e-01f, 8.358384371e-01f, 3.102235124e-02f, -9.995186925e-01f, -8.896704316e-01f, 4.566032588e-01f,
  7.073719800e-02f, 9.974949956e-01f, 6.648434997e-01f, 7.469826341e-01f, 8.895936012e-01f, 4.567528665e-01f, 9.646348357e-01f, 2.635899782e-01f,
  9.887710810e-01f, 1.494381279e-01f, 9.964445233e-01f, 8.425120264e-02f, 9.988752007e-01f, 4.741638154e-02f, 9.996442795e-01f, 2.667102963e-02f,
  9.998875260e-01f, 1.499943808e-02f, 9.999644160e-01f, 8.435020223e-03f, 9.999887347e-01f, 4.743398633e-03f, 9.999964237e-01f, 2.667415887e-03f,
  -9.576594830e-01f, -2.879033089e-01f, -9.100810885e-01f, 4.144302309e-01f, 3.403181732e-01f, -9.403103590e-01f, -9.564100504e-01f, 2.920270860e-01f,
  -2.919954620e-02f, 9.995735884e-01f, 6.218088269e-01f, 7.831690907e-01f, 8.747074604e-01f, 4.846512377e-01f, 9.597951770e-01f, 2.807013094e-01f,
  9.872272611e-01f, 1.593182087e-01f, 9.959549904e-01f, 8.985326439e-02f, 9.987202883e-01f, 5.057485774e-02f, 9.995952845e-01f, 2.844863199e-02f,
  9.998720288e-01f, 1.599931903e-02f, 9.999595284e-01f, 8.997339755e-03f, 9.999871850e-01f, 5.059622694e-03f, 9.999959469e-01f, 2.845243318e-03f,
  -2.751633525e-01f, -9.613974690e-01f, -9.908979535e-01f, -1.346151382e-01f, 6.158648133e-01f, -7.878518701e-01f, -9.929850101e-01f, 1.182405204e-01f,
  -1.288445443e-01f, 9.916648269e-01f, 5.768082738e-01f, 8.168795705e-01f, 8.589466810e-01f, 5.120649934e-01f, 9.546520114e-01f, 2.977238595e-01f,
  9.855847955e-01f, 1.691823453e-01f, 9.954339862e-01f, 9.545248002e-02f, 9.985553622e-01f, 5.373282731e-02f, 9.995430708e-01f, 3.022614494e-02f,
  9.998555183e-01f, 1.699918136e-02f, 9.999542832e-01f, 9.559656493e-03f, 9.999855757e-01f, 5.375845823e-03f, 9.999954104e-01f, 3.023070283e-03f,
  6.603167057e-01f, -7.509872317e-01f, -7.665365338e-01f, -6.422007084e-01f, 8.303361535e-01f, -5.572628975e-01f, -9.982416630e-01f, -5.927551910e-02f,
  -2.272021621e-01f, 9.738476276e-01f, 5.299841762e-01f, 8.480075598e-01f, 8.423270583e-01f, 5.389667153e-01f, 9.492070079e-01f, 3.146522641e-01f,
  9.838436842e-01f, 1.790295690e-01f, 9.948815107e-01f, 1.010486856e-01f, 9.983804226e-01f, 5.689026415e-02f, 9.994877577e-01f, 3.200356290e-02f,
  9.998379946e-01f, 1.799902879e-02f, 9.999487996e-01f, 1.012197044e-02f, 9.999837875e-01f, 5.692068953e-03f, 9.999948740e-01f, 3.200897481e-03f,
  9.887046218e-01f, 1.498772055e-01f, -3.060953915e-01f, -9.520008564e-01f, 9.624637961e-01f, -2.714101076e-01f, -9.720142484e-01f, -2.349217981e-01f,
  -3.232895434e-01f, 9.463000894e-01f, 4.814845920e-01f, 8.764545321e-01f, 8.248651624e-01f, 5.653295517e-01f, 9.434618354e-01f, 3.314811885e-01f,
  9.820042253e-01f, 1.888588965e-01f, 9.942975044e-01f, 1.066416800e-01f, 9.981955290e-01f, 6.004713103e-02f, 9.994292855e-01f, 3.378088027e-02f,
  9.998195171e-01f, 1.899885759e-02f, 9.999428988e-01f, 1.068428159e-02f, 9.999819398e-01f, 6.008291151e-03f, 9.999942780e-01f, 3.378724447e-03f,
  4.080820680e-01f, 9.129452705e-01f, 2.486167252e-01f, -9.686019421e-01f, 9.991443753e-01f, 4.135828838e-02f, -9.151299596e-01f, -4.031589925e-01f,
  -4.161468446e-01f, 9.092974067e-01f, 4.314628243e-01f, 9.021307230e-01f, 8.065784574e-01f, 5.911270380e-01f, 9.374182820e-01f, 3.482052684e-01f,
  9.800665975e-01f, 1.986693144e-01f, 9.936820865e-01f, 1.122313142e-01f, 9.980006814e-01f, 6.320339441e-02f, 9.993675947e-01f, 3.555808961e-02f,
  9.998000264e-01f, 1.999866776e-02f, 9.999367595e-01f, 1.124658901e-02f, 9.999799728e-01f, 6.324512884e-03f, 9.999936819e-01f, 3.556551412e-03f,
  -5.477292538e-01f, 8.366556168e-01f, 7.267602682e-01f, -6.868911982e-01f, 9.367404580e-01f, 3.500247598e-01f, -8.293829560e-01f, -5.586805344e-01f,
  -5.048462152e-01f, 8.632093072e-01f, 3.800770044e-01f, 9.249548316e-01f, 7.874851823e-01f, 6.163335443e-01f, 9.310783744e-01f, 3.648192585e-01f,
  9.780309200e-01f, 2.084598988e-01f, 9.930352569e-01f, 1.178173944e-01f, 9.977958202e-01f, 6.635902822e-02f, 9.993028045e-01f, 3.733518720e-02f,
  9.997795224e-01f, 2.099845745e-02f, 9.999302626e-01f, 1.180889271e-02f, 9.999779463e-01f, 6.640734151e-03f, 9.999930263e-01f, 3.734378144e-03f,
  -9.999608397e-01f, -8.851309307e-03f, 9.810745716e-01f, -1.936302334e-01f, 7.814403772e-01f, 6.239799261e-01f, -7.174774408e-01f, -6.965817213e-01f,
  -5.885011554e-01f, 8.084963560e-01f, 3.274895847e-01f, 9.448547959e-01f, 7.676045895e-01f, 6.409237385e-01f, 9.244439602e-01f, 3.813178837e-01f,
  9.758974314e-01f, 2.182296216e-01f, 9.923570156e-01f, 1.233997419e-01f, 9.975810051e-01f, 6.951400638e-02f, 9.992348552e-01f, 3.911216930e-02f,
  9.997580051e-01f, 2.199822664e-02f, 9.999234676e-01f, 1.237119269e-02f, 9.999758005e-01f, 6.956954487e-03f, 9.999923706e-01f, 3.912204877e-03f,
  -5.328330398e-01f, -8.462204337e-01f, 9.332357645e-01f, 3.592645228e-01f, 5.486452579e-01f, 8.360552788e-01f, -5.829432607e-01f, -8.125128746e-01f,
  -6.662759781e-01f, 7.457052469e-01f, 2.738668323e-01f, 9.617676139e-01f, 7.469564080e-01f, 6.648730636e-01f, 9.175173044e-01f, 3.976959288e-01f,
  9.736663699e-01f, 2.279775143e-01f, 9.916474223e-01f, 1.289781928e-01f, 9.973561764e-01f, 7.266827673e-02f, 9.991636872e-01f, 4.088902473e-02f,
  9.997355342e-01f, 2.299797349e-02f, 9.999163747e-01f, 1.293348987e-02f, 9.999735355e-01f, 7.273174357e-03f, 9.999916553e-01f, 4.090031609e-03f,
  4.241790175e-01f, -9.055783749e-01f, 5.979771614e-01f, 8.015131354e-01f, 2.614416778e-01f, 9.652192593e-01f, -4.300232828e-01f, -9.028177857e-01f,
  -7.373937964e-01f, 6.754631400e-01f, 2.193782777e-01f, 9.756398797e-01f, 7.255613208e-01f, 6.881574988e-01f, 9.103004336e-01f, 4.139482081e-01f,
  9.713379741e-01f, 2.377026230e-01f, 9.909064770e-01f, 1.345525682e-01f, 9.971213937e-01f, 7.582182437e-02f, 9.990894198e-01f, 4.266574979e-02f,
  9.997119904e-01f, 2.399769612e-02f, 9.999089241e-01f, 1.349578146e-02f, 9.999712110e-01f, 7.589393295e-03f, 9.999908805e-01f, 4.267857410e-03f,
  9.912028313e-01f, -1.323517561e-01f, 7.855226099e-02f, 9.969099760e-01f, -5.168933049e-02f, 9.986631870e-01f, -2.635405958e-01f, -9.646483064e-01f,
  -8.011435866e-01f, 5.984721184e-01f, 1.641961634e-01f, 9.864277244e-01f, 7.034407258e-01f, 7.107539177e-01f, 9.027957320e-01f, 4.300695956e-01f,
  9.689124227e-01f, 2.474039644e-01f, 9.901341200e-01f, 1.401226968e-01f, 9.968766570e-01f, 7.897461206e-02f, 9.990119338e-01f, 4.444234073e-02f,
  9.996874928e-01f, 2.499739639e-02f, 9.999011755e-01f, 1.405806933e-02f, 9.999687672e-01f, 7.905611768e-03f, 9.999901056e-01f, 4.445684142e-03f,
  6.469193101e-01f, 7.625584602e-01f, -4.650644958e-01f, 8.852767944e-01f, -3.596943319e-01f, 9.330701828e-01f, -8.874550462e-02f, -9.960543513e-01f,
  -8.568888307e-01f, 5.155012608e-01f, 1.084949449e-01f, 9.940969944e-01f, 6.806167960e-01f, 7.326396108e-01f, 8.950055838e-01f, 4.460549951e-01f,
  9.663899541e-01f, 2.570805550e-01f, 9.893305302e-01f, 1.456883848e-01f, 9.966219068e-01f, 8.212661743e-02f, 9.989313483e-01f, 4.621879384e-02f,
  9.996620417e-01f, 2.599707060e-02f, 9.998931289e-01f, 1.462035347e-02f, 9.999662042e-01f, 8.221829310e-03f, 9.999893308e-01f, 4.623509943e-03f,
  -2.921388149e-01f, 9.563759565e-01f, -8.654506207e-01f, 5.009942055e-01f, -6.320286393e-01f, 7.749450207e-01f, 8.884811401e-02f, -9.960451722e-01f,
  -9.040721655e-01f, 4.273798466e-01f, 5.245061591e-02f, 9.986234903e-01f, 6.571123004e-01f, 7.537927032e-01f, 8.869323730e-01f, 4.618993104e-01f,
  9.637709260e-01f, 2.667314112e-01f, 9.884956479e-01f, 1.512494683e-01f, 9.963572025e-01f, 8.527779579e-02f, 9.988475442e-01f, 4.799510166e-02f,
  9.996355176e-01f, 2.699672058e-02f, 9.998847246e-01f, 1.518263202e-02f, 9.999635220e-01f, 8.538045920e-03f, 9.999884963e-01f, 4.801335745e-03f,
  -9.626058936e-01f, 2.709057927e-01f, -9.992933869e-01f, -3.758566082e-02f, -8.416849375e-01f, 5.399689674e-01f, 2.636395097e-01f, -9.646213055e-01f,
  -9.422222972e-01f, 3.349882066e-01f, -3.759419080e-03f, 9.999929070e-01f, 6.329506636e-01f, 7.741920948e-01f, 8.785787225e-01f, 4.775975943e-01f,
  9.610554576e-01f, 2.763556540e-01f, 9.876294732e-01f, 1.568057537e-01f, 9.960825443e-01f, 8.842811733e-02f, 9.987606406e-01f, 4.977125302e-02f,
  9.996080399e-01f, 2.799634263e-02f, 9.998760223e-01f, 1.574490592e-02f, 9.999607801e-01f, 8.854261599e-03f, 9.999876022e-01f, 4.979162011e-03f,
  -7.480575442e-01f, -6.636338830e-01f, -8.253716230e-01f, -5.645897985e-01f, -9.678714871e-01f, 2.514453232e-01f, 4.301158488e-01f, -9.027736783e-01f,
  -9.709581733e-01f, 2.392492294e-01f, -5.995756760e-02f, 9.982009530e-01f, 6.081562042e-01f, 7.938174009e-01f, 8.699471951e-01f, 4.931448400e-01f,
  9.582439065e-01f, 2.859522104e-01f, 9.867320657e-01f, 1.623570919e-01f, 9.957979321e-01f, 9.157756716e-02f, 9.986705780e-01f, 5.154724792e-02f,
  9.995795488e-01f, 2.899593674e-02f, 9.998670220e-01f, 1.630717516e-02f, 9.999579787e-01f, 9.170476347e-03f, 9.999867082e-01f, 5.156987347e-03f,
  1.542514563e-01f, -9.880316257e-01f, -3.972518742e-01f, -9.177096486e-01f, -9.980752468e-01f, -6.201484054e-02f, 5.830269456e-01f, -8.124528527e-01f,
  -9.899924994e-01f, 1.411200017e-01f, -1.159661636e-01f, 9.932531714e-01f, 5.827536583e-01f, 8.126488924e-01f, 8.610406518e-01f, 5.085361004e-01f,
  9.553365111e-01f, 2.955201864e-01f, 9.858034849e-01f, 1.679033041e-01f, 9.955033660e-01f, 9.472609311e-02f, 9.985772967e-01f, 5.332308263e-02f,
  9.995500445e-01f, 2.999550104e-02f, 9.998577237e-01f, 1.686943881e-02f, 9.999549985e-01f, 9.486690164e-03f, 9.999857545e-01f, 5.334813148e-03f,
  9.147423506e-01f, -4.040376544e-01f, 1.532154828e-01f, -9.881927967e-01f, -9.293003082e-01f, -3.693250120e-01f, 7.175492048e-01f, -6.965078115e-01f,
  -9.991351366e-01f, 4.158052057e-02f, -1.716081351e-01f, 9.851652980e-01f, 5.567683578e-01f, 8.306677938e-01f, 8.518617749e-01f, 5.237666368e-01f,
  9.523335695e-01f, 3.050586283e-01f, 9.848436713e-01f, 1.734442115e-01f, 9.951988459e-01f, 9.787366539e-02f, 9.984809160e-01f, 5.509874597e-02f,
  9.995195270e-01f, 3.099503554e-02f, 9.998480678e-01f, 1.743169688e-02f, 9.999519587e-01f, 9.802903049e-03f, 9.999848008e-01f, 5.512638018e-03f,
  8.342233896e-01f, 5.514267087e-01f, 6.564951539e-01f, -7.543302178e-01f, -7.683671117e-01f, -6.400094032e-01f, 8.294403553e-01f, -5.585952997e-01f,
  -9.982947707e-01f, -5.837419257e-02f, -2.267075777e-01f, 9.739628434e-01f, 5.302263498e-01f, 8.478561044e-01f, 8.424135447e-01f, 5.388315320e-01f,
  9.492354393e-01f, 3.145665526e-01f, 9.838528037e-01f, 1.789796203e-01f, 9.948843718e-01f, 1.010202691e-01f, 9.983813763e-01f, 5.687423423e-02f,
  9.994880557e-01f, 3.199454024e-02f, 9.998381138e-01f, 1.799395122e-02f, 9.999487996e-01f, 1.011911593e-02f, 9.999837875e-01f, 5.690463353e-03f,
  -1.327674743e-02f, 9.999118447e-01f, 9.575860500e-01f, -2.881473899e-01f, -5.312352777e-01f, -8.472243547e-01f, 9.151713848e-01f, -4.030649364e-01f,
  -9.874798059e-01f, -1.577456445e-01f, -2.810903192e-01f, 9.596813321e-01f, 5.031541586e-01f, 8.641966581e-01f, 8.326989412e-01f, 5.537260175e-01f,
  9.460423589e-01f, 3.240430057e-01f, 9.828307629e-01f, 1.845093668e-01f, 9.945599437e-01f, 1.041658595e-01f, 9.982786179e-01f, 5.864954367e-02f,
  9.994555712e-01f, 3.299400955e-02f, 9.998278022e-01f, 1.855619811e-02f, 9.999455214e-01f, 1.043532696e-02f, 9.999827743e-01f, 5.868288688e-03f,
  -8.485702872e-01f, 5.290827155e-01f, 9.637575150e-01f, 2.667797208e-01f, -2.414211184e-01f, -9.704204202e-01f, 9.720383286e-01f, -2.348221242e-01f,
  -9.667981863e-01f, -2.555412054e-01f, -3.345843852e-01f, 9.423658252e-01f, 4.755789042e-01f, 8.796730638e-01f, 8.227210045e-01f, 5.684453845e-01f,
  9.427546859e-01f, 3.334870934e-01f, 9.817776680e-01f, 1.900332868e-01f, 9.942255616e-01f, 1.073104069e-01f, 9.981727600e-01f, 6.042466685e-02f,
  9.994220734e-01f, 3.399345279e-02f, 9.998172522e-01f, 1.911843941e-02f, 9.999421835e-01f, 1.075153705e-02f, 9.999817014e-01f, 6.046113092e-03f,
  -9.036921859e-01f, -4.281826615e-01f, 6.731102467e-01f, 7.395421267e-01f, 7.233466953e-02f, -9.973804355e-01f, 9.982477427e-01f, -5.917267874e-02f,
  -9.364566803e-01f, -3.507832289e-01f, -3.870206773e-01f, 9.220710397e-01f, 4.475280643e-01f, 8.942698836e-01f, 8.124829531e-01f, 5.829849839e-01f,
  9.393727183e-01f, 3.428978026e-01f, 9.806935191e-01f, 1.955512017e-01f, 9.938812256e-01f, 1.104538813e-01f, 9.980637431e-01f, 6.219960377e-02f,
  9.993875623e-01f, 3.499285504e-02f, 9.998063445e-01f, 1.968067512e-02f, 9.999387264e-01f, 1.106774528e-02f, 9.999806285e-01f, 6.223937962e-03f,
  -1.279636919e-01f, -9.917788506e-01f, 1.751565337e-01f, 9.845405817e-01f, 3.789161742e-01f, -9.254310131e-01f, 9.929728508e-01f, 1.183425859e-01f,
  -8.967583776e-01f, -4.425205588e-01f, -4.382335544e-01f, 8.988611698e-01f, 4.190297425e-01f, 9.079725146e-01f, 8.019878864e-01f, 5.973402858e-01f,
  9.358968139e-01f, 3.522742093e-01f, 9.795783162e-01f, 2.010629177e-01f, 9.935269952e-01f, 1.135962531e-01f, 9.979515672e-01f, 6.397433579e-02f,
  9.993520975e-01f, 3.599222749e-02f, 9.997950792e-01f, 2.024290524e-02f, 9.999352098e-01f, 1.138395350e-02f, 9.999794960e-01f, 6.401761901e-03f,
  7.654140592e-01f, -6.435381174e-01f, -3.767423034e-01f, 9.263181090e-01f, 6.479216814e-01f, -7.617069483e-01f, 9.563800097e-01f, 2.921253741e-01f,
  -8.481000066e-01f, -5.298361778e-01f, -4.880608618e-01f, 8.728095889e-01f, 3.901124299e-01f, 9.207672477e-01f, 7.912392616e-01f, 6.115067005e-01f,
  9.323273301e-01f, 3.616154492e-01f, 9.784321785e-01f, 2.065682709e-01f, 9.931628108e-01f, 1.167374924e-01f, 9.978361726e-01f, 6.574887782e-02f,
  9.993155599e-01f, 3.699155897e-02f, 9.997835755e-01f, 2.080512606e-02f, 9.999315739e-01f, 1.170015987e-02f, 9.999783635e-01f, 6.579586305e-03f,
  9.550736547e-01f, 2.963685691e-01f, -8.126112223e-01f, 5.828061700e-01f, 8.526731133e-01f, -5.224447846e-01f, 8.896234632e-01f, 4.566946924e-01f,
  -7.909677625e-01f, -6.118578315e-01f, -5.363451838e-01f, 8.439987302e-01f, 3.608050346e-01f, 9.326412678e-01f, 7.802404165e-01f, 6.254796982e-01f,
  9.286646247e-01f, 3.709204793e-01f, 9.772551060e-01f, 2.120671123e-01f, 9.927886724e-01f, 1.198775545e-01f, 9.977176785e-01f, 6.752320379e-02f,
  9.992780685e-01f, 3.799085692e-02f, 9.997717142e-01f, 2.136734314e-02f, 9.999278188e-01f, 1.201636530e-02f, 9.999771714e-01f, 6.757410709e-03f,
  2.666429281e-01f, 9.637953639e-01f, -9.982103705e-01f, 5.980031565e-02f, 9.728653431e-01f, -2.313720137e-01f, 7.948083878e-01f, 6.068604589e-01f,
  -7.259322405e-01f, -6.877662539e-01f, -5.829339027e-01f, 8.125196099e-01f, 3.311368525e-01f, 9.435827136e-01f, 7.689949274e-01f, 6.392549276e-01f,
  9.249090552e-01f, 3.801884055e-01f, 9.760470986e-01f, 2.175592482e-01f, 9.924046397e-01f, 1.230164245e-01f, 9.975960255e-01f, 6.929731369e-02f,
  9.992396235e-01f, 3.899011388e-02f, 9.997594953e-01f, 2.192955278e-02f, 9.999239445e-01f, 1.233256981e-02f, 9.999759793e-01f, 6.935234182e-03f,
  -6.669380665e-01f, 7.451131344e-01f, -8.763794303e-01f, -4.816212952e-01f, 9.965789914e-01f, 8.264580369e-02f, 6.749256253e-01f, 7.378857136e-01f,
  -6.536436081e-01f, -7.568024993e-01f, -6.276797056e-01f, 7.784717083e-01f, 3.011375964e-01f, 9.535806775e-01f, 7.575061917e-01f, 6.528279781e-01f,
  9.210609794e-01f, 3.894183338e-01f, 9.748082757e-01f, 2.230444849e-01f, 9.920106530e-01f, 1.261540651e-01f, 9.974712729e-01f, 7.107120752e-02f,
  9.992001057e-01f, 3.998933733e-02f, 9.997470379e-01f, 2.249175683e-02f, 9.999200106e-01f, 1.264877338e-02f, 9.999747276e-01f, 7.113057654e-03f,
  -9.873392582e-01f, -1.586226672e-01f, -4.846394062e-01f, -8.747140169e-01f, 9.214623570e-01f, 3.884676993e-01f, 5.337560773e-01f, 8.456384540e-01f,
  -5.748240352e-01f, -8.182770610e-01f, -6.704410911e-01f, 7.419627905e-01f, 2.708370686e-01f, 9.626252055e-01f, 7.457779050e-01f, 6.661946774e-01f,
  9.171208143e-01f, 3.986093104e-01f, 9.735385776e-01f, 2.285226882e-01f, 9.916067719e-01f, 1.292904317e-01f, 9.973433018e-01f, 7.284487784e-02f,
  9.991596341e-01f, 4.098851606e-02f, 9.997342229e-01f, 2.305394970e-02f, 9.999159575e-01f, 1.296497509e-02f, 9.999734163e-01f, 7.290880661e-03f,
  -3.999853134e-01f, -9.165215492e-01f, 5.636094138e-02f, -9.984104633e-01f, 7.549653649e-01f, 6.557646990e-01f, 3.757521510e-01f, 9.267202020e-01f,
  -4.902605712e-01f, -8.715758920e-01f, -7.110829353e-01f, 7.031081319e-01f, 2.402658761e-01f, 9.707071185e-01f, 7.338138223e-01f, 6.793506742e-01f,
  9.130889177e-01f, 4.077604413e-01f, 9.722381234e-01f, 2.339936644e-01f, 9.911929369e-01f, 1.324255317e-01f, 9.972121716e-01f, 7.461831719e-02f,
  9.991181493e-01f, 4.198765755e-02f, 9.997211099e-01f, 2.361613885e-02f, 9.999117851e-01f, 1.328117587e-02f, 9.999721050e-01f, 7.468704134e-03f,
  5.551133156e-01f, -8.317747712e-01f, 5.800031424e-01f, -8.146142364e-01f, 5.135984421e-01f, 8.580306768e-01f, 2.058971673e-01f, 9.785736203e-01f,
  -4.007990062e-01f, -9.161660075e-01f, -7.494767308e-01f, 6.620306373e-01f, 2.094544172e-01f, 9.778184295e-01f, 7.216176391e-01f, 6.922917962e-01f,
  9.089657664e-01f, 4.168707728e-01f, 9.709069133e-01f, 2.394572198e-01f, 9.907692075e-01f, 1.355592906e-01f, 9.970778823e-01f, 7.639151812e-02f,
  9.990756512e-01f, 4.298675060e-02f, 9.997076392e-01f, 2.417832054e-02f, 9.999075532e-01f, 1.359737478e-02f, 9.999707937e-01f, 7.646527141e-03f,
  9.998432994e-01f, 1.770192571e-02f, 9.250146747e-01f, -3.799313903e-01f, 2.212981731e-01f, 9.752061963e-01f, 2.954781987e-02f, 9.995633960e-01f,
  -3.073327839e-01f, -9.516021013e-01f, -7.855011225e-01f, 6.188601851e-01f, 1.784335226e-01f, 9.839519858e-01f, 7.091933489e-01f, 7.050140500e-01f,
  9.047516584e-01f, 4.259394705e-01f, 9.695450068e-01f, 2.449132055e-01f, 9.903355837e-01f, 1.386916935e-01f, 9.969404936e-01f, 7.816448808e-02f,
  9.990321398e-01f, 4.398580641e-02f, 9.996939301e-01f, 2.474049293e-02f, 9.999032021e-01f, 1.391357277e-02f, 9.999693632e-01f, 7.824349217e-03f,
  5.253219604e-01f, 8.509035110e-01f, 9.851381779e-01f, 1.717635691e-01f, -9.294810891e-02f, 9.956709743e-01f, -1.477329880e-01f, 9.890272617e-01f,
  -2.107958049e-01f, -9.775301218e-01f, -8.190422058e-01f, 5.737332702e-01f, 1.472342163e-01f, 9.891016483e-01f, 6.965447664e-01f, 7.175133228e-01f,
  9.004471302e-01f, 4.349655211e-01f, 9.681524038e-01f, 2.503614724e-01f, 9.898920655e-01f, 1.418227106e-01f, 9.967998862e-01f, 7.993719727e-02f,
  9.989876747e-01f, 4.498481750e-02f, 9.996798635e-01f, 2.530265786e-02f, 9.998987317e-01f, 1.422976889e-02f, 9.999679923e-01f, 8.002171293e-03f,
  -4.321779311e-01f, 9.017883539e-01f, 7.418580055e-01f, 6.705570221e-01f, -3.979767561e-01f, 9.173954725e-01f, -3.203543723e-01f, 9.472977519e-01f,
  -1.121526212e-01f, -9.936909676e-01f, -8.499938846e-01f, 5.267925262e-01f, 1.158876941e-01f, 9.932623506e-01f, 6.836758852e-01f, 7.297857404e-01f,
  8.960524797e-01f, 4.439480901e-01f, 9.667292237e-01f, 2.558017969e-01f, 9.894386530e-01f, 1.449523121e-01f, 9.966561794e-01f, 8.170966059e-02f,
  9.989421964e-01f, 4.598378390e-02f, 9.996654391e-01f, 2.586481534e-02f, 9.998942018e-01f, 1.454596408e-02f, 9.999665618e-01f, 8.179994300e-03f,
  -9.923354983e-01f, 1.235731244e-01f, 2.700984478e-01f, 9.628326893e-01f, -6.635382771e-01f, 7.481423616e-01f, -4.828719497e-01f, 8.756909966e-01f,
  -1.238837745e-02f, -9.999232888e-01f, -8.782584071e-01f, 4.781863391e-01f, 8.442528546e-02f, 9.964298010e-01f, 6.705908775e-01f, 7.418274283e-01f,
  8.915683031e-01f, 4.528862834e-01f, 9.652754664e-01f, 2.612340748e-01f, 9.889753461e-01f, 1.480804533e-01f, 9.965093136e-01f, 8.348185569e-02f,
  9.988957047e-01f, 4.698270187e-02f, 9.996507764e-01f, 2.642696351e-02f, 9.998895526e-01f, 1.486215740e-02f, 9.999650717e-01f, 8.357816376e-03f,
  -6.401443481e-01f, -7.682546377e-01f, -2.848466039e-01f, 9.585731030e-01f, -8.632965088e-01f, 5.046970844e-01f, -6.301599741e-01f, 7.764653563e-01f,
  8.749917150e-02f, -9.961646199e-01f, -9.037463665e-01f, 4.280683994e-01f, 5.287845805e-02f, 9.986009598e-01f, 6.572937369e-01f, 7.536345124e-01f,
  8.869948983e-01f, 4.617791772e-01f, 9.637911916e-01f, 2.666580379e-01f, 9.885020852e-01f, 1.512071192e-01f, 9.963592887e-01f, 8.525379747e-02f,
  9.988481998e-01f, 4.798157141e-02f, 9.996357560e-01f, 2.698910423e-02f, 9.998847842e-01f, 1.517834887e-02f, 9.999635816e-01f, 8.535637520e-03f,
  3.005925417e-01f, -9.537526369e-01f, -7.520639896e-01f, 6.590901017e-01f, -9.774427414e-01f, 2.112006545e-01f, -7.575730681e-01f, 6.527503729e-01f,
  1.865124702e-01f, -9.824525714e-01f, -9.263771176e-01f, 3.765971363e-01f, 2.127875760e-02f, 9.997735620e-01f, 6.437888145e-01f, 7.652031779e-01f,
  8.823328614e-01f, 4.706258774e-01f, 9.622764587e-01f, 2.720735669e-01f, 9.880189896e-01f, 1.543322802e-01f, 9.962061048e-01f, 8.702547103e-02f,
  9.987997413e-01f, 4.898039624e-02f, 9.996203780e-01f, 2.755123749e-02f, 9.998799562e-01f, 1.549453940e-02f, 9.999620318e-01f, 8.713459596e-03f,
  9.649659991e-01f, -2.623748481e-01f, -9.876590967e-01f, 1.566190720e-01f, -9.946564436e-01f, -1.032404602e-01f, -8.610926867e-01f, 5.084479451e-01f,
  2.836622000e-01f, -9.589242935e-01f, -9.460792542e-01f, 3.239352703e-01f, -1.034221891e-02f, 9.999465346e-01f, 6.300802827e-01f, 7.765299678e-01f,
  8.775825500e-01f, 4.794255495e-01f, 9.607312679e-01f, 2.774805427e-01f, 9.875259995e-01f, 1.574558914e-01f, 9.960497618e-01f, 8.879686147e-02f,
  9.987502694e-01f, 4.997916892e-02f, 9.996047616e-01f, 2.811335959e-02f, 9.998750091e-01f, 1.581072807e-02f, 9.999604821e-01f, 8.891279809e-03f,
  7.421541810e-01f, 6.702291965e-01f, -9.190735221e-01f, -3.940860629e-01f, -9.132301211e-01f, -4.074441493e-01f, -9.374542236e-01f, 3.481085002e-01f,
  3.779776692e-01f, -9.258147478e-01f, -9.627903700e-01f, 2.702493370e-01f, -4.195285589e-02f, 9.991195798e-01f, 6.161724925e-01f, 7.876111865e-01f,
  8.727445006e-01f, 4.881772399e-01f, 9.591556787e-01f, 2.828786969e-01f, 9.870231748e-01f, 1.605779380e-01f, 9.958902597e-01f, 9.056797624e-02f,
  9.986997843e-01f, 5.097789690e-02f, 9.995887876e-01f, 2.867547423e-02f, 9.998699427e-01f, 1.612691768e-02f, 9.999588728e-01f, 9.069100954e-03f,
  -1.629907787e-01f, 9.866275787e-01f, -5.674300194e-01f, -8.234215975e-01f, -7.412399650e-01f, -6.712401509e-01f, -9.842484593e-01f, 1.767906845e-01f,
  4.685169160e-01f, -8.834545016e-01f, -9.764577150e-01f, 2.157090008e-01f, -7.352153957e-02f, 9.972936511e-01f, 6.020699143e-01f, 7.984433770e-01f,
  8.678191900e-01f, 4.968801141e-01f, 9.575498104e-01f, 2.882679403e-01f, 9.865104556e-01f, 1.636983752e-01f, 9.957276583e-01f, 9.233880043e-02f,
  9.986482859e-01f, 5.197656900e-02f, 9.995725155e-01f, 2.923758142e-02f, 9.998648167e-01f, 1.644310169e-02f, 9.999572635e-01f, 9.246920235e-03f,
  -9.182828069e-01f, 3.959251642e-01f, -4.102819040e-02f, -9.991579652e-01f, -4.957418144e-01f, -8.684699535e-01f, -1.000000000e+00f, -1.030206768e-04f,
  5.543745160e-01f, -8.322673440e-01f, -9.870380163e-01f, 1.604867280e-01f, -1.050167084e-01f, 9.944704771e-01f, 5.877769589e-01f, 8.090230227e-01f,
  8.628070951e-01f, 5.055333376e-01f, 9.559136033e-01f, 2.936480343e-01f, 9.859878421e-01f, 1.668171734e-01f, 9.955618382e-01f, 9.410934150e-02f,
  9.985958338e-01f, 5.297519267e-02f, 9.995558858e-01f, 2.979967557e-02f, 9.998595715e-01f, 1.675928757e-02f, 9.999555945e-01f, 9.424741380e-03f,
  -8.293098211e-01f, -5.587890744e-01f, 4.980095923e-01f, -8.671715260e-01f, -2.010796219e-01f, -9.795749187e-01f, -9.842120409e-01f, -1.769934744e-01f,
  6.346929669e-01f, -7.727644444e-01f, -9.944978952e-01f, 1.047568321e-01f, -1.364068687e-01f, 9.906529188e-01f, 5.732980371e-01f, 8.193469048e-01f,
  8.577086926e-01f, 5.141359568e-01f, 9.542471766e-01f, 2.990188897e-01f, 9.854553938e-01f, 1.699342877e-01f, 9.953929186e-01f, 9.587957710e-02f,
  9.985423684e-01f, 5.397376046e-02f, 9.995389581e-01f, 3.036176413e-02f, 9.998542070e-01f, 1.707546785e-02f, 9.999538660e-01f, 9.602561593e-03f,
  2.212675661e-02f, -9.997551441e-01f, 8.836693168e-01f, -4.681116641e-01f, 1.135217771e-01f, -9.935355186e-01f, -9.373825192e-01f, -3.483016491e-01f,
  7.086697817e-01f, -7.055402994e-01f, -9.988136292e-01f, 4.869600013e-02f, -1.676606387e-01f, 9.858447909e-01f, 5.586379170e-01f, 8.294116855e-01f,
  8.525245190e-01f, 5.226872563e-01f, 9.525505900e-01f, 3.043802381e-01f, 9.849131107e-01f, 1.730497181e-01f, 9.952208400e-01f, 9.764950722e-02f,
  9.984878898e-01f, 5.497227982e-02f, 9.995217323e-01f, 3.092384152e-02f, 9.998487830e-01f, 1.739165001e-02f, 9.999521971e-01f, 9.780380875e-03f,
  8.532201052e-01f, -5.215510130e-01f, 9.971746206e-01f, 7.511820644e-02f, 4.168670774e-01f, -9.089674354e-01f, -8.609884381e-01f, -5.086245537e-01f,
  7.755658031e-01f, -6.312667131e-01f, -9.999717474e-01f, -7.518785074e-03f, -1.987468749e-01f, 9.800508618e-01f, 5.438010693e-01f, 8.392141461e-01f,
  8.472551107e-01f, 5.311862230e-01f, 9.508239031e-01f, 3.097319603e-01f, 9.843609333e-01f, 1.761634201e-01f, 9.950456619e-01f, 9.941913933e-02f,
  9.984323978e-01f, 5.597073585e-02f, 9.995042086e-01f, 3.148590773e-02f, 9.998431802e-01f, 1.770782843e-02f, 9.999504089e-01f, 9.958200157e-03f,
  8.998668194e-01f, 4.361647666e-01f, 8.035690784e-01f, 5.952115059e-01f, 6.788702011e-01f, -7.342582941e-01f, -7.574391961e-01f, -6.529057026e-01f,
  8.347129226e-01f, -5.506852865e-01f, -9.979684949e-01f, -6.370979548e-02f, -2.296342701e-01f, 9.732769728e-01f, 5.287923217e-01f, 8.487512469e-01f,
  8.419010043e-01f, 5.396320224e-01f, 9.490671158e-01f, 3.150739372e-01f, 9.837989211e-01f, 1.792753637e-01f, 9.948672652e-01f, 1.011884511e-01f,
  9.983759522e-01f, 5.696914345e-02f, 9.994863272e-01f, 3.204796836e-02f, 9.998375773e-01f, 1.802400686e-02f, 9.999486208e-01f, 1.013601944e-02f,
  1.191801354e-01f, 9.928726554e-01f, 3.624766767e-01f, 9.319928288e-01f, 8.735505342e-01f, -4.867334962e-01f, -6.300007105e-01f, -7.765945792e-01f,
  8.855196238e-01f, -4.646020234e-01f, -9.928101897e-01f, -1.196993962e-01f, -2.602920532e-01f, 9.655299187e-01f, 5.136163235e-01f, 8.580200076e-01f,
  8.364626765e-01f, 5.480239391e-01f, 9.472803473e-01f, 3.204059005e-01f, 9.832270741e-01f, 1.823855042e-01f, 9.946857691e-01f, 1.029574350e-01f,
  9.983184934e-01f, 5.796748772e-02f, 9.994681478e-01f, 3.261001408e-02f, 9.998317957e-01f, 1.834018156e-02f, 9.999468327e-01f, 1.031383779e-02f,
  -7.710801959e-01f, 6.367380023e-01f, -1.902491003e-01f, 9.817358255e-01f, 9.816020727e-01f, -1.909380108e-01f, -4.826923311e-01f, -8.757900000e-01f,
  9.274784923e-01f, -3.738765717e-01f, -9.845131636e-01f, -1.753105819e-01f, -2.906895578e-01f, 9.568174481e-01f, 4.982779026e-01f, 8.670173883e-01f,
  8.309407234e-01f, 5.563610196e-01f, 9.454635978e-01f, 3.257277906e-01f, 9.826454520e-01f, 1.854938269e-01f, 9.945011139e-01f, 1.047261059e-01f,
  9.982600212e-01f, 5.896577984e-02f, 9.994496703e-01f, 3.317204863e-02f, 9.998259544e-01f, 1.865635626e-02f, 9.999449849e-01f, 1.049165614e-02f,
  -9.524129629e-01f, -3.048106134e-01f, -6.843819022e-01f, 7.291237116e-01f, 9.923083186e-01f, 1.237909496e-01f, -3.201591671e-01f, -9.473637342e-01f,
  9.601702690e-01f, -2.794154882e-01f, -9.731037021e-01f, -2.303675115e-01f, -3.207964003e-01f, 9.471482038e-01f, 4.827820361e-01f, 8.757405281e-01f,
  8.253356218e-01f, 5.646424294e-01f, 9.436169863e-01f, 3.310393095e-01f, 9.820539355e-01f, 1.886002868e-01f, 9.943132997e-01f, 1.064944416e-01f,
  9.982005358e-01f, 5.996400863e-02f, 9.994308352e-01f, 3.373407945e-02f, 9.998199940e-01f, 1.897252724e-02f, 9.999430776e-01f, 1.066947449e-02f,
  -2.581016421e-01f, -9.661177993e-01f, -9.677396417e-01f, 2.519522607e-01f, 9.046075940e-01f, 4.262454212e-01f, -1.475291997e-01f, -9.890577197e-01f,
  9.832684398e-01f, -1.821625978e-01f, -9.586178064e-01f, -2.846961617e-01f, -3.505824506e-01f, 9.365318418e-01f, 4.671334028e-01f, 8.841868639e-01f,
  8.196480274e-01f, 5.728674531e-01f, 9.417404532e-01f, 3.363404274e-01f, 9.814526439e-01f, 1.917048544e-01f, 9.941223264e-01f, 1.082624346e-01f,
  9.981400967e-01f, 6.096218154e-02f, 9.994117022e-01f, 3.429609165e-02f, 9.998139739e-01f, 1.928869821e-02f, 9.999411702e-01f, 1.084729191e-02f,
  6.735071540e-01f, -7.391806841e-01f, -9.530500174e-01f, -3.028128743e-01f, 7.271980643e-01f, 6.864276528e-01f, 2.975377068e-02f, -9.995572567e-01f,
  9.965420961e-01f, -8.308912069e-02f, -9.411013126e-01f, -3.381247520e-01f, -3.800179660e-01f, 9.249790907e-01f, 4.513370395e-01f, 8.923535347e-01f,
  8.138784766e-01f, 5.810351372e-01f, 9.398342371e-01f, 3.416308761e-01f, 9.808415174e-01f, 1.948075294e-01f, 9.939282537e-01f, 1.100300923e-01f,
  9.980786443e-01f, 6.196028739e-02f, 9.993922710e-01f, 3.485809639e-02f, 9.998078346e-01f, 1.960486546e-02f, 9.999392033e-01f, 1.102510840e-02f,
  9.858965874e-01f, 1.673557013e-01f, -6.448370218e-01f, -7.643200755e-01f, 4.776714444e-01f, 8.785385489e-01f, 2.060983330e-01f, -9.785313010e-01f,
  9.998586178e-01f, 1.681409031e-02f, -9.206095338e-01f, -3.904843926e-01f, -4.090735018e-01f, 9.125014544e-01f, 4.353979528e-01f, 9.002380967e-01f,
  8.080275059e-01f, 5.891447663e-01f, 9.378982186e-01f, 3.469105363e-01f, 9.802205563e-01f, 1.979082376e-01f, 9.937310219e-01f, 1.117973924e-01f,
  9.980161786e-01f, 6.295833737e-02f, 9.993724823e-01f, 3.542009369e-02f, 9.998015761e-01f, 1.992103085e-02f, 9.999372363e-01f, 1.120292582e-02f,
};
__device__ const float ROPE32[1024] = {
  1.000000000e+00f, 0.000000000e+00f, 1.000000000e+00f, 0.000000000e+00f, 1.000000000e+00f, 0.000000000e+00f, 1.000000000e+00f, 0.000000000e+00f,
  1.000000000e+00f, 0.000000000e+00f, 1.000000000e+00f, 0.000000000e+00f, 1.000000000e+00f, 0.000000000e+00f, 1.000000000e+00f, 0.000000000e+00f,
  5.403022766e-01f, 8.414709568e-01f, 9.504152536e-01f, 3.109835982e-01f, 9.950041771e-01f, 9.983342141e-02f, 9.995000362e-01f, 3.161750361e-02f,
  9.999499917e-01f, 9.999833070e-03f, 9.999949932e-01f, 3.162272274e-03f, 9.999995232e-01f, 9.999999311e-04f, 9.999999404e-01f, 3.162277571e-04f,
  -4.161468446e-01f, 9.092974067e-01f, 8.065783978e-01f, 5.911270976e-01f, 9.800665975e-01f, 1.986693293e-01f, 9.980006814e-01f, 6.320339441e-02f,
  9.998000264e-01f, 1.999866590e-02f, 9.999799728e-01f, 6.324512884e-03f, 9.999979734e-01f, 1.999998698e-03f, 9.999998212e-01f, 6.324554561e-04f,
  -9.899924994e-01f, 1.411200017e-01f, 5.827536583e-01f, 8.126488924e-01f, 9.553365111e-01f, 2.955202162e-01f, 9.955033660e-01f, 9.472608566e-02f,
  9.995500445e-01f, 2.999549918e-02f, 9.999549985e-01f, 9.486690164e-03f, 9.999955297e-01f, 2.999995602e-03f, 9.999995232e-01f, 9.486831259e-04f,
  -6.536436081e-01f, -7.568024993e-01f, 3.011374772e-01f, 9.535807371e-01f, 9.210609794e-01f, 3.894183338e-01f, 9.920106530e-01f, 1.261540651e-01f,
  9.992001057e-01f, 3.998933360e-02f, 9.999200106e-01f, 1.264877338e-02f, 9.999920130e-01f, 3.999989480e-03f, 9.999992251e-01f, 1.264910679e-03f,
  2.836622000e-01f, -9.589242935e-01f, -1.034233812e-02f, 9.999465346e-01f, 8.775825500e-01f, 4.794255495e-01f, 9.875259995e-01f, 1.574558765e-01f,
  9.987502694e-01f, 4.997916520e-02f, 9.998750091e-01f, 1.581072807e-02f, 9.999874830e-01f, 4.999979399e-03f, 9.999987483e-01f, 1.581138116e-03f,
  9.601702690e-01f, -2.794154882e-01f, -3.207964003e-01f, 9.471482038e-01f, 8.253356218e-01f, 5.646424890e-01f, 9.820539355e-01f, 1.886002719e-01f,
  9.982005358e-01f, 5.996400490e-02f, 9.998199940e-01f, 1.897252724e-02f, 9.999819994e-01f, 5.999964196e-03f, 9.999982119e-01f, 1.897365320e-03f,
  7.539022565e-01f, 6.569865942e-01f, -5.994374752e-01f, 8.004215956e-01f, 7.648422122e-01f, 6.442176700e-01f, 9.755998850e-01f, 2.195560932e-01f,
  9.975510240e-01f, 6.994284689e-02f, 9.997550249e-01f, 2.213413455e-02f, 9.999755025e-01f, 6.999942940e-03f, 9.999975562e-01f, 2.213592408e-03f,
  -1.455000341e-01f, 9.893582463e-01f, -8.186324239e-01f, 5.743177533e-01f, 6.967067122e-01f, 7.173560858e-01f, 9.681702852e-01f, 2.502923310e-01f,
  9.968017340e-01f, 7.991468906e-02f, 9.996800423e-01f, 2.529552206e-02f, 9.999679923e-01f, 7.999914698e-03f, 9.999967813e-01f, 2.529819263e-03f,
  -9.111302495e-01f, 4.121184945e-01f, -9.566441774e-01f, 2.912592292e-01f, 6.216099262e-01f, 7.833269238e-01f, 9.597726464e-01f, 2.807783186e-01f,
  9.959527254e-01f, 8.987854421e-02f, 9.995950460e-01f, 2.845665626e-02f, 9.999595284e-01f, 8.999879472e-03f, 9.999959469e-01f, 2.846045885e-03f,
  -8.390715122e-01f, -5.440211296e-01f, -9.997860789e-01f, -2.068356983e-02f, 5.403022766e-01f, 8.414709568e-01f, 9.504153132e-01f, 3.109835684e-01f,
  9.950041771e-01f, 9.983341396e-02f, 9.995000362e-01f, 3.161750361e-02f, 9.999499917e-01f, 9.999834001e-03f, 9.999949932e-01f, 3.162272274e-03f,
  4.425697960e-03f, -9.999902248e-01f, -9.437797666e-01f, -3.305749595e-01f, 4.535960853e-01f, 8.912073970e-01f, 9.401075840e-01f, 3.408778608e-01f,
  9.939560890e-01f, 1.097782999e-01f, 9.993950725e-01f, 3.477803990e-02f, 9.999395013e-01f, 1.099977922e-02f, 9.999939203e-01f, 3.478498431e-03f,
  8.438539505e-01f, -5.365729332e-01f, -7.941793799e-01f, -6.076834202e-01f, 3.623577058e-01f, 9.320390821e-01f, 9.288598895e-01f, 3.704313040e-01f,
  9.928086400e-01f, 1.197122037e-01f, 9.992800951e-01f, 3.793822229e-02f, 9.999279976e-01f, 1.199971233e-02f, 9.999927878e-01f, 3.794723889e-03f,
  9.074468017e-01f, 4.201670289e-01f, -5.658205152e-01f, -8.245284557e-01f, 2.674987614e-01f, 9.635581970e-01f, 9.166833758e-01f, 3.996143043e-01f,
  9.915618896e-01f, 1.296341419e-01f, 9.991551042e-01f, 4.109803215e-02f, 9.999154806e-01f, 1.299963426e-02f, 9.999915361e-01f, 4.110949114e-03f,
  1.367372125e-01f, 9.906073809e-01f, -2.813494802e-01f, -9.596053958e-01f, 1.699671596e-01f, 9.854497313e-01f, 9.035902619e-01f, 4.283977747e-01f,
  9.902160168e-01f, 1.395431161e-01f, 9.990201592e-01f, 4.425742477e-02f, 9.999020100e-01f, 1.399954315e-02f, 9.999902248e-01f, 4.427174106e-03f,
  -7.596879005e-01f, 6.502878666e-01f, 3.102235124e-02f, -9.995186925e-01f, 7.073719800e-02f, 9.974949956e-01f, 8.895936012e-01f, 4.567528665e-01f,
  9.887710810e-01f, 1.494381279e-01f, 9.988752007e-01f, 4.741638154e-02f, 9.998875260e-01f, 1.499943808e-02f, 9.999887347e-01f, 4.743398633e-03f,
  -9.576594830e-01f, -2.879033089e-01f, 3.403181732e-01f, -9.403103590e-01f, -2.919954620e-02f, 9.995735884e-01f, 8.747074604e-01f, 4.846512377e-01f,
  9.872272611e-01f, 1.593182087e-01f, 9.987202883e-01f, 5.057485774e-02f, 9.998720288e-01f, 1.599931903e-02f, 9.999871850e-01f, 5.059622694e-03f,
  -2.751633525e-01f, -9.613974690e-01f, 6.158648133e-01f, -7.878518701e-01f, -1.288445443e-01f, 9.916648269e-01f, 8.589466810e-01f, 5.120649934e-01f,
  9.855847955e-01f, 1.691823453e-01f, 9.985553622e-01f, 5.373282731e-02f, 9.998555183e-01f, 1.699918136e-02f, 9.999855757e-01f, 5.375845823e-03f,
  6.603167057e-01f, -7.509872317e-01f, 8.303361535e-01f, -5.572628975e-01f, -2.272021621e-01f, 9.738476276e-01f, 8.423270583e-01f, 5.389667153e-01f,
  9.838436842e-01f, 1.790295690e-01f, 9.983804226e-01f, 5.689026415e-02f, 9.998379946e-01f, 1.799902879e-02f, 9.999837875e-01f, 5.692068953e-03f,
  9.887046218e-01f, 1.498772055e-01f, 9.624637961e-01f, -2.714101076e-01f, -3.232895434e-01f, 9.463000894e-01f, 8.248651624e-01f, 5.653295517e-01f,
  9.820042253e-01f, 1.888588965e-01f, 9.981955290e-01f, 6.004713103e-02f, 9.998195171e-01f, 1.899885759e-02f, 9.999819398e-01f, 6.008291151e-03f,
  4.080820680e-01f, 9.129452705e-01f, 9.991443753e-01f, 4.135828838e-02f, -4.161468446e-01f, 9.092974067e-01f, 8.065784574e-01f, 5.911270380e-01f,
  9.800665975e-01f, 1.986693144e-01f, 9.980006814e-01f, 6.320339441e-02f, 9.998000264e-01f, 1.999866776e-02f, 9.999799728e-01f, 6.324512884e-03f,
  -5.477292538e-01f, 8.366556168e-01f, 9.367404580e-01f, 3.500247598e-01f, -5.048462152e-01f, 8.632093072e-01f, 7.874851823e-01f, 6.163335443e-01f,
  9.780309200e-01f, 2.084598988e-01f, 9.977958202e-01f, 6.635902822e-02f, 9.997795224e-01f, 2.099845745e-02f, 9.999779463e-01f, 6.640734151e-03f,
  -9.999608397e-01f, -8.851309307e-03f, 7.814403772e-01f, 6.239799261e-01f, -5.885011554e-01f, 8.084963560e-01f, 7.676045895e-01f, 6.409237385e-01f,
  9.758974314e-01f, 2.182296216e-01f, 9.975810051e-01f, 6.951400638e-02f, 9.997580051e-01f, 2.199822664e-02f, 9.999758005e-01f, 6.956954487e-03f,
  -5.328330398e-01f, -8.462204337e-01f, 5.486452579e-01f, 8.360552788e-01f, -6.662759781e-01f, 7.457052469e-01f, 7.469564080e-01f, 6.648730636e-01f,
  9.736663699e-01f, 2.279775143e-01f, 9.973561764e-01f, 7.266827673e-02f, 9.997355342e-01f, 2.299797349e-02f, 9.999735355e-01f, 7.273174357e-03f,
  4.241790175e-01f, -9.055783749e-01f, 2.614416778e-01f, 9.652192593e-01f, -7.373937964e-01f, 6.754631400e-01f, 7.255613208e-01f, 6.881574988e-01f,
  9.713379741e-01f, 2.377026230e-01f, 9.971213937e-01f, 7.582182437e-02f, 9.997119904e-01f, 2.399769612e-02f, 9.999712110e-01f, 7.589393295e-03f,
  9.912028313e-01f, -1.323517561e-01f, -5.168933049e-02f, 9.986631870e-01f, -8.011435866e-01f, 5.984721184e-01f, 7.034407258e-01f, 7.107539177e-01f,
  9.689124227e-01f, 2.474039644e-01f, 9.968766570e-01f, 7.897461206e-02f, 9.996874928e-01f, 2.499739639e-02f, 9.999687672e-01f, 7.905611768e-03f,
  6.469193101e-01f, 7.625584602e-01f, -3.596943319e-01f, 9.330701828e-01f, -8.568888307e-01f, 5.155012608e-01f, 6.806167960e-01f, 7.326396108e-01f,
  9.663899541e-01f, 2.570805550e-01f, 9.966219068e-01f, 8.212661743e-02f, 9.996620417e-01f, 2.599707060e-02f, 9.999662042e-01f, 8.221829310e-03f,
  -2.921388149e-01f, 9.563759565e-01f, -6.320286393e-01f, 7.749450207e-01f, -9.040721655e-01f, 4.273798466e-01f, 6.571123004e-01f, 7.537927032e-01f,
  9.637709260e-01f, 2.667314112e-01f, 9.963572025e-01f, 8.527779579e-02f, 9.996355176e-01f, 2.699672058e-02f, 9.999635220e-01f, 8.538045920e-03f,
  -9.626058936e-01f, 2.709057927e-01f, -8.416849375e-01f, 5.399689674e-01f, -9.422222972e-01f, 3.349882066e-01f, 6.329506636e-01f, 7.741920948e-01f,
  9.610554576e-01f, 2.763556540e-01f, 9.960825443e-01f, 8.842811733e-02f, 9.996080399e-01f, 2.799634263e-02f, 9.999607801e-01f, 8.854261599e-03f,
  -7.480575442e-01f, -6.636338830e-01f, -9.678714871e-01f, 2.514453232e-01f, -9.709581733e-01f, 2.392492294e-01f, 6.081562042e-01f, 7.938174009e-01f,
  9.582439065e-01f, 2.859522104e-01f, 9.957979321e-01f, 9.157756716e-02f, 9.995795488e-01f, 2.899593674e-02f, 9.999579787e-01f, 9.170476347e-03f,
  1.542514563e-01f, -9.880316257e-01f, -9.980752468e-01f, -6.201484054e-02f, -9.899924994e-01f, 1.411200017e-01f, 5.827536583e-01f, 8.126488924e-01f,
  9.553365111e-01f, 2.955201864e-01f, 9.955033660e-01f, 9.472609311e-02f, 9.995500445e-01f, 2.999550104e-02f, 9.999549985e-01f, 9.486690164e-03f,
  9.147423506e-01f, -4.040376544e-01f, -9.293003082e-01f, -3.693250120e-01f, -9.991351366e-01f, 4.158052057e-02f, 5.567683578e-01f, 8.306677938e-01f,
  9.523335695e-01f, 3.050586283e-01f, 9.951988459e-01f, 9.787366539e-02f, 9.995195270e-01f, 3.099503554e-02f, 9.999519587e-01f, 9.802903049e-03f,
  8.342233896e-01f, 5.514267087e-01f, -7.683671117e-01f, -6.400094032e-01f, -9.982947707e-01f, -5.837419257e-02f, 5.302263498e-01f, 8.478561044e-01f,
  9.492354393e-01f, 3.145665526e-01f, 9.948843718e-01f, 1.010202691e-01f, 9.994880557e-01f, 3.199454024e-02f, 9.999487996e-01f, 1.011911593e-02f,
  -1.327674743e-02f, 9.999118447e-01f, -5.312352777e-01f, -8.472243547e-01f, -9.874798059e-01f, -1.577456445e-01f, 5.031541586e-01f, 8.641966581e-01f,
  9.460423589e-01f, 3.240430057e-01f, 9.945599437e-01f, 1.041658595e-01f, 9.994555712e-01f, 3.299400955e-02f, 9.999455214e-01f, 1.043532696e-02f,
  -8.485702872e-01f, 5.290827155e-01f, -2.414211184e-01f, -9.704204202e-01f, -9.667981863e-01f, -2.555412054e-01f, 4.755789042e-01f, 8.796730638e-01f,
  9.427546859e-01f, 3.334870934e-01f, 9.942255616e-01f, 1.073104069e-01f, 9.994220734e-01f, 3.399345279e-02f, 9.999421835e-01f, 1.075153705e-02f,
  -9.036921859e-01f, -4.281826615e-01f, 7.233466953e-02f, -9.973804355e-01f, -9.364566803e-01f, -3.507832289e-01f, 4.475280643e-01f, 8.942698836e-01f,
  9.393727183e-01f, 3.428978026e-01f, 9.938812256e-01f, 1.104538813e-01f, 9.993875623e-01f, 3.499285504e-02f, 9.999387264e-01f, 1.106774528e-02f,
  -1.279636919e-01f, -9.917788506e-01f, 3.789161742e-01f, -9.254310131e-01f, -8.967583776e-01f, -4.425205588e-01f, 4.190297425e-01f, 9.079725146e-01f,
  9.358968139e-01f, 3.522742093e-01f, 9.935269952e-01f, 1.135962531e-01f, 9.993520975e-01f, 3.599222749e-02f, 9.999352098e-01f, 1.138395350e-02f,
  7.654140592e-01f, -6.435381174e-01f, 6.479216814e-01f, -7.617069483e-01f, -8.481000066e-01f, -5.298361778e-01f, 3.901124299e-01f, 9.207672477e-01f,
  9.323273301e-01f, 3.616154492e-01f, 9.931628108e-01f, 1.167374924e-01f, 9.993155599e-01f, 3.699155897e-02f, 9.999315739e-01f, 1.170015987e-02f,
  9.550736547e-01f, 2.963685691e-01f, 8.526731133e-01f, -5.224447846e-01f, -7.909677625e-01f, -6.118578315e-01f, 3.608050346e-01f, 9.326412678e-01f,
  9.286646247e-01f, 3.709204793e-01f, 9.927886724e-01f, 1.198775545e-01f, 9.992780685e-01f, 3.799085692e-02f, 9.999278188e-01f, 1.201636530e-02f,
  2.666429281e-01f, 9.637953639e-01f, 9.728653431e-01f, -2.313720137e-01f, -7.259322405e-01f, -6.877662539e-01f, 3.311368525e-01f, 9.435827136e-01f,
  9.249090552e-01f, 3.801884055e-01f, 9.924046397e-01f, 1.230164245e-01f, 9.992396235e-01f, 3.899011388e-02f, 9.999239445e-01f, 1.233256981e-02f,
  -6.669380665e-01f, 7.451131344e-01f, 9.965789914e-01f, 8.264580369e-02f, -6.536436081e-01f, -7.568024993e-01f, 3.011375964e-01f, 9.535806775e-01f,
  9.210609794e-01f, 3.894183338e-01f, 9.920106530e-01f, 1.261540651e-01f, 9.992001057e-01f, 3.998933733e-02f, 9.999200106e-01f, 1.264877338e-02f,
  -9.873392582e-01f, -1.586226672e-01f, 9.214623570e-01f, 3.884676993e-01f, -5.748240352e-01f, -8.182770610e-01f, 2.708370686e-01f, 9.626252055e-01f,
  9.171208143e-01f, 3.986093104e-01f, 9.916067719e-01f, 1.292904317e-01f, 9.991596341e-01f, 4.098851606e-02f, 9.999159575e-01f, 1.296497509e-02f,
  -3.999853134e-01f, -9.165215492e-01f, 7.549653649e-01f, 6.557646990e-01f, -4.902605712e-01f, -8.715758920e-01f, 2.402658761e-01f, 9.707071185e-01f,
  9.130889177e-01f, 4.077604413e-01f, 9.911929369e-01f, 1.324255317e-01f, 9.991181493e-01f, 4.198765755e-02f, 9.999117851e-01f, 1.328117587e-02f,
  5.551133156e-01f, -8.317747712e-01f, 5.135984421e-01f, 8.580306768e-01f, -4.007990062e-01f, -9.161660075e-01f, 2.094544172e-01f, 9.778184295e-01f,
  9.089657664e-01f, 4.168707728e-01f, 9.907692075e-01f, 1.355592906e-01f, 9.990756512e-01f, 4.298675060e-02f, 9.999075532e-01f, 1.359737478e-02f,
  9.998432994e-01f, 1.770192571e-02f, 2.212981731e-01f, 9.752061963e-01f, -3.073327839e-01f, -9.516021013e-01f, 1.784335226e-01f, 9.839519858e-01f,
  9.047516584e-01f, 4.259394705e-01f, 9.903355837e-01f, 1.386916935e-01f, 9.990321398e-01f, 4.398580641e-02f, 9.999032021e-01f, 1.391357277e-02f,
  5.253219604e-01f, 8.509035110e-01f, -9.294810891e-02f, 9.956709743e-01f, -2.107958049e-01f, -9.775301218e-01f, 1.472342163e-01f, 9.891016483e-01f,
  9.004471302e-01f, 4.349655211e-01f, 9.898920655e-01f, 1.418227106e-01f, 9.989876747e-01f, 4.498481750e-02f, 9.998987317e-01f, 1.422976889e-02f,
  -4.321779311e-01f, 9.017883539e-01f, -3.979767561e-01f, 9.173954725e-01f, -1.121526212e-01f, -9.936909676e-01f, 1.158876941e-01f, 9.932623506e-01f,
  8.960524797e-01f, 4.439480901e-01f, 9.894386530e-01f, 1.449523121e-01f, 9.989421964e-01f, 4.598378390e-02f, 9.998942018e-01f, 1.454596408e-02f,
  -9.923354983e-01f, 1.235731244e-01f, -6.635382771e-01f, 7.481423616e-01f, -1.238837745e-02f, -9.999232888e-01f, 8.442528546e-02f, 9.964298010e-01f,
  8.915683031e-01f, 4.528862834e-01f, 9.889753461e-01f, 1.480804533e-01f, 9.988957047e-01f, 4.698270187e-02f, 9.998895526e-01f, 1.486215740e-02f,
  -6.401443481e-01f, -7.682546377e-01f, -8.632965088e-01f, 5.046970844e-01f, 8.749917150e-02f, -9.961646199e-01f, 5.287845805e-02f, 9.986009598e-01f,
  8.869948983e-01f, 4.617791772e-01f, 9.885020852e-01f, 1.512071192e-01f, 9.988481998e-01f, 4.798157141e-02f, 9.998847842e-01f, 1.517834887e-02f,
  3.005925417e-01f, -9.537526369e-01f, -9.774427414e-01f, 2.112006545e-01f, 1.865124702e-01f, -9.824525714e-01f, 2.127875760e-02f, 9.997735620e-01f,
  8.823328614e-01f, 4.706258774e-01f, 9.880189896e-01f, 1.543322802e-01f, 9.987997413e-01f, 4.898039624e-02f, 9.998799562e-01f, 1.549453940e-02f,
  9.649659991e-01f, -2.623748481e-01f, -9.946564436e-01f, -1.032404602e-01f, 2.836622000e-01f, -9.589242935e-01f, -1.034221891e-02f, 9.999465346e-01f,
  8.775825500e-01f, 4.794255495e-01f, 9.875259995e-01f, 1.574558914e-01f, 9.987502694e-01f, 4.997916892e-02f, 9.998750091e-01f, 1.581072807e-02f,
  7.421541810e-01f, 6.702291965e-01f, -9.132301211e-01f, -4.074441493e-01f, 3.779776692e-01f, -9.258147478e-01f, -4.195285589e-02f, 9.991195798e-01f,
  8.727445006e-01f, 4.881772399e-01f, 9.870231748e-01f, 1.605779380e-01f, 9.986997843e-01f, 5.097789690e-02f, 9.998699427e-01f, 1.612691768e-02f,
  -1.629907787e-01f, 9.866275787e-01f, -7.412399650e-01f, -6.712401509e-01f, 4.685169160e-01f, -8.834545016e-01f, -7.352153957e-02f, 9.972936511e-01f,
  8.678191900e-01f, 4.968801141e-01f, 9.865104556e-01f, 1.636983752e-01f, 9.986482859e-01f, 5.197656900e-02f, 9.998648167e-01f, 1.644310169e-02f,
  -9.182828069e-01f, 3.959251642e-01f, -4.957418144e-01f, -8.684699535e-01f, 5.543745160e-01f, -8.322673440e-01f, -1.050167084e-01f, 9.944704771e-01f,
  8.628070951e-01f, 5.055333376e-01f, 9.859878421e-01f, 1.668171734e-01f, 9.985958338e-01f, 5.297519267e-02f, 9.998595715e-01f, 1.675928757e-02f,
  -8.293098211e-01f, -5.587890744e-01f, -2.010796219e-01f, -9.795749187e-01f, 6.346929669e-01f, -7.727644444e-01f, -1.364068687e-01f, 9.906529188e-01f,
  8.577086926e-01f, 5.141359568e-01f, 9.854553938e-01f, 1.699342877e-01f, 9.985423684e-01f, 5.397376046e-02f, 9.998542070e-01f, 1.707546785e-02f,
  2.212675661e-02f, -9.997551441e-01f, 1.135217771e-01f, -9.935355186e-01f, 7.086697817e-01f, -7.055402994e-01f, -1.676606387e-01f, 9.858447909e-01f,
  8.525245190e-01f, 5.226872563e-01f, 9.849131107e-01f, 1.730497181e-01f, 9.984878898e-01f, 5.497227982e-02f, 9.998487830e-01f, 1.739165001e-02f,
  8.532201052e-01f, -5.215510130e-01f, 4.168670774e-01f, -9.089674354e-01f, 7.755658031e-01f, -6.312667131e-01f, -1.987468749e-01f, 9.800508618e-01f,
  8.472551107e-01f, 5.311862230e-01f, 9.843609333e-01f, 1.761634201e-01f, 9.984323978e-01f, 5.597073585e-02f, 9.998431802e-01f, 1.770782843e-02f,
  8.998668194e-01f, 4.361647666e-01f, 6.788702011e-01f, -7.342582941e-01f, 8.347129226e-01f, -5.506852865e-01f, -2.296342701e-01f, 9.732769728e-01f,
  8.419010043e-01f, 5.396320224e-01f, 9.837989211e-01f, 1.792753637e-01f, 9.983759522e-01f, 5.696914345e-02f, 9.998375773e-01f, 1.802400686e-02f,
  1.191801354e-01f, 9.928726554e-01f, 8.735505342e-01f, -4.867334962e-01f, 8.855196238e-01f, -4.646020234e-01f, -2.602920532e-01f, 9.655299187e-01f,
  8.364626765e-01f, 5.480239391e-01f, 9.832270741e-01f, 1.823855042e-01f, 9.983184934e-01f, 5.796748772e-02f, 9.998317957e-01f, 1.834018156e-02f,
  -7.710801959e-01f, 6.367380023e-01f, 9.816020727e-01f, -1.909380108e-01f, 9.274784923e-01f, -3.738765717e-01f, -2.906895578e-01f, 9.568174481e-01f,
  8.309407234e-01f, 5.563610196e-01f, 9.826454520e-01f, 1.854938269e-01f, 9.982600212e-01f, 5.896577984e-02f, 9.998259544e-01f, 1.865635626e-02f,
  -9.524129629e-01f, -3.048106134e-01f, 9.923083186e-01f, 1.237909496e-01f, 9.601702690e-01f, -2.794154882e-01f, -3.207964003e-01f, 9.471482038e-01f,
  8.253356218e-01f, 5.646424294e-01f, 9.820539355e-01f, 1.886002868e-01f, 9.982005358e-01f, 5.996400863e-02f, 9.998199940e-01f, 1.897252724e-02f,
  -2.581016421e-01f, -9.661177993e-01f, 9.046075940e-01f, 4.262454212e-01f, 9.832684398e-01f, -1.821625978e-01f, -3.505824506e-01f, 9.365318418e-01f,
  8.196480274e-01f, 5.728674531e-01f, 9.814526439e-01f, 1.917048544e-01f, 9.981400967e-01f, 6.096218154e-02f, 9.998139739e-01f, 1.928869821e-02f,
  6.735071540e-01f, -7.391806841e-01f, 7.271980643e-01f, 6.864276528e-01f, 9.965420961e-01f, -8.308912069e-02f, -3.800179660e-01f, 9.249790907e-01f,
  8.138784766e-01f, 5.810351372e-01f, 9.808415174e-01f, 1.948075294e-01f, 9.980786443e-01f, 6.196028739e-02f, 9.998078346e-01f, 1.960486546e-02f,
  9.858965874e-01f, 1.673557013e-01f, 4.776714444e-01f, 8.785385489e-01f, 9.998586178e-01f, 1.681409031e-02f, -4.090735018e-01f, 9.125014544e-01f,
  8.080275059e-01f, 5.891447663e-01f, 9.802205563e-01f, 1.979082376e-01f, 9.980161786e-01f, 6.295833737e-02f, 9.998015761e-01f, 1.992103085e-02f,
};
#define XB_TMO      128
#define XB_XCNT(j)  (256  + 64 * (j))
#define XB_XSUB(j)  (1280 + 64 * (j))
#define XB_XGEN(j)  (2304 + 64 * (j))
#define XB_TOP      3328
#define XB_TOPGEN   3392
#define XCD_BAR_WORDS 3456
#define XB_SPIN_CAP (1u << 18)
#define LAS __attribute__((address_space(3)))

__device__ __forceinline__ unsigned xb_ld(unsigned* p)              { return __hip_atomic_load(p, __ATOMIC_RELAXED, __HIP_MEMORY_SCOPE_AGENT); }
__device__ __forceinline__ unsigned xb_add(unsigned* p, unsigned v) { return __hip_atomic_fetch_add(p, v, __ATOMIC_RELAXED, __HIP_MEMORY_SCOPE_AGENT); }
__device__ __forceinline__ unsigned xb_xcc_id() { return (unsigned)__builtin_amdgcn_s_getreg((3 << 11) | 20) & 0xFu; }
#define XB_SPIN(cond, bar) do { unsigned _sp = 0; while (cond) { __builtin_amdgcn_s_sleep(1); \
    if ((++_sp & 255u) == 0u) { if (xb_ld(&(bar)[XB_TMO])) break; if (_sp > XB_SPIN_CAP) { atomicAdd(&(bar)[XB_TMO], 1u); break; } } } } while (0)

struct XcdBarrier {
    unsigned* bar; unsigned x;
    volatile LAS unsigned* st;
};

__device__ __forceinline__ XcdBarrier xcd_barrier_post(unsigned* bar, volatile LAS unsigned* st) {
    XcdBarrier b; b.bar = bar; b.x = xb_xcc_id(); b.st = st;
    if (threadIdx.x == 0) (void)xb_add(&bar[XB_XCNT(b.x)], 1u);
    return b;
}
__device__ __forceinline__ void xcd_barrier_complete(unsigned* bar, unsigned x, unsigned& nloc, unsigned& nx) {
    const unsigned G = gridDim.x * gridDim.y * gridDim.z;
    unsigned sum, cnt, mine, sp = 0u;
    for (;;) {
        sum = 0u; cnt = 0u; mine = 0u;
#pragma unroll
        for (unsigned j = 0; j < 16; ++j) { const unsigned c = xb_ld(&bar[XB_XCNT(j)]); sum += c; cnt += (c > 0u) ? 1u : 0u; mine = (j == x) ? c : mine; }
        if (sum == G) break;
        __builtin_amdgcn_s_sleep(1);
        if ((++sp & 255u) == 0u) { if (xb_ld(&bar[XB_TMO])) break; if (sp > XB_SPIN_CAP) { atomicAdd(&bar[XB_TMO], 1u); break; } }
    }
    nloc = mine > 0u ? mine : 1u; nx = cnt > 0u ? cnt : 1u;
}

__device__ __forceinline__ void xcd_barrier(const XcdBarrier& b, const bool t0  ) {
    asm volatile("s_waitcnt vmcnt(0)" ::: "memory");
    __syncthreads();
    if (t0) {
        unsigned* bar = b.bar;
        __builtin_amdgcn_s_waitcnt(0);
        unsigned nloc = b.st[0], nx = b.st[1];
        if (nloc == 0u) { xcd_barrier_complete(bar, b.x, nloc, nx); b.st[0] = nloc; b.st[1] = nx; }
        const unsigned old = xb_add(&bar[XB_XSUB(b.x)], 1u);
        const unsigned gen = old / nloc;
        if (old + 1u == (gen + 1u) * nloc) {
            __builtin_amdgcn_fence(__ATOMIC_RELEASE, "agent");
            asm volatile("s_waitcnt vmcnt(0)" ::: "memory");
            const unsigned og = xb_add(&bar[XB_TOP], 1u);
            const unsigned tg = og / nx;
            if (og + 1u == (tg + 1u) * nx) xb_add(&bar[XB_TOPGEN], 1u);
            else XB_SPIN(xb_ld(&bar[XB_TOPGEN]) == tg, bar);
            __builtin_amdgcn_fence(__ATOMIC_ACQUIRE, "agent");
            xb_add(&bar[XB_XGEN(b.x)], 1u);
            asm volatile("s_waitcnt vmcnt(0)" ::: "memory");
        } else {
            XB_SPIN(xb_ld(&bar[XB_XGEN(b.x)]) == gen, bar);
            __builtin_amdgcn_fence(__ATOMIC_ACQUIRE, "agent");
            asm volatile("s_waitcnt vmcnt(0)" ::: "memory");
        }
    }
    __syncthreads();
}

DI void conv_fetch(const float* __restrict__ src, int K, int N, int k0, int n0, f32x4 (&v)[2], int tid) {
#pragma unroll
    for (int i = 0; i < 2; ++i) {
        const int idx = tid + NTHREADS * i, kr = idx >> 4, c4 = (idx & 15) * 4;
        v[i] = (f32x4){0.f, 0.f, 0.f, 0.f};
        if (n0 + c4 < N) v[i] = __builtin_nontemporal_load((const f32x4*)(src + (size_t)(k0 + kr) * N + n0 + c4));
    }
}
DI void conv_put(const f32x4 (&v)[2], float* lds, int tid) {
#pragma unroll
    for (int i = 0; i < 2; ++i) {
        const int idx = tid + NTHREADS * i, kr = idx >> 4, c4 = (idx & 15) * 4;
        float* d = lds + kr * 65 + c4;
        d[0] = v[i].x; d[1] = v[i].y; d[2] = v[i].z; d[3] = v[i].w;
    }
}
typedef float f32x2_8 __attribute__((ext_vector_type(2)));
DI unsigned cvt_fp8x4(float a, float b, float c, float d) { int w = __builtin_amdgcn_cvt_pk_fp8_f32(a, b, 0, false); w = __builtin_amdgcn_cvt_pk_fp8_f32(c, d, w, true); return (unsigned)w; }
template <bool NT, bool FP8>
DI void conv_store(int K, bf16_t* __restrict__ dst, int k0, int ndst0, int nstep, const float* lds, int tid) {
    const int idx = tid, n = idx >> 3, kc = idx & 7;
    float f[8];
#pragma unroll
    for (int j = 0; j < 8; ++j) f[j] = lds[(kc * 8 + j) * 65 + n];
    const size_t e = (size_t)(ndst0 + (n & 31) + (n >> 5) * nstep) * K + k0 + kc * 8;
    if (FP8) {
        u32x2 w; w.x = cvt_fp8x4(f[0] * 32.f, f[1] * 32.f, f[2] * 32.f, f[3] * 32.f); w.y = cvt_fp8x4(f[4] * 32.f, f[5] * 32.f, f[6] * 32.f, f[7] * 32.f);
        u32x2* d = (u32x2*)((unsigned char*)dst + e);
        if (NT) __builtin_nontemporal_store(w, d); else *d = w;
    } else {
        u32x4* d = (u32x4*)(dst + e);
        if (NT) __builtin_nontemporal_store(pack8(f), d); else *d = pack8(f);
    }
}
template <bool NT = true, bool FP8 = false>
DI void conv_job(const float* src, int count, int K, int N, int Npad, bf16_t* dst, int perm  , int& base, float* lds, int bid, int nb, int tid) {
    const int tk = K / 64, tn = Npad / 64, per = tk * tn, total = count * per;
    int t = (bid - (base % nb) + nb) % nb;
    f32x4 rg[4][2];
    auto fetch4 = [&](int tt) {
#pragma unroll
        for (int q = 0; q < 4; ++q) {
            const int tq = tt + q * nb;
            if (tq < total) { const int mi = tq / per, rem = tq - mi * per, nt = rem / tk, kt = rem - nt * tk;
                conv_fetch(src + (size_t)mi * K * N, K, N, kt * 64, nt * 64, rg[q], tid); }
        }
    };
    if (t < total) fetch4(t);
    for (; t < total; t += 4 * nb) {
#pragma unroll
        for (int q = 0; q < 4; ++q) if (t + q * nb < total) conv_put(rg[q], lds + q * 4160, tid);
        __syncthreads();
        if (t + 4 * nb < total) fetch4(t + 4 * nb);
#pragma unroll
        for (int q = 0; q < 4; ++q) {
            const int tq = t + q * nb;
            if (tq < total) { const int mi = tq / per, rem = tq - mi * per, nt = rem / tk, kt = rem - nt * tk, n0 = nt * 64;
                int nd0 = n0, nstep = 32;
                if (perm == 1) nd0 = ((n0 & 255) >> 7) * 256 + (n0 >> 8) * 128 + (n0 & 127);
                else if (n0 < perm) { const int hg = n0 >> 6; nd0 = (hg >> 2) * 256 + (hg & 3) * 32; nstep = 128; }
                conv_store<NT, FP8>(K, FP8 ? (bf16_t*)((unsigned char*)dst + (size_t)mi * Npad * K) : dst + (size_t)mi * Npad * K, kt * 64, nd0, nstep, lds + q * 4160, tid); }
        }
        __syncthreads();
    }
    base += total;
}

DI int mla_col(bool uq, int r) {
    const int hw = uq ? 96 : 128;
    if (r < 1024) { const int pn = r >> 8, bj = (r >> 7) & 1, wc = (r >> 5) & 3, d = r & 31; return (4 * pn + wc) * hw + 32 * bj + d; }
    const int rr = r - 1024;
    if (uq) { const int head = rr >> 5, c = rr & 31, dim = (c >> 3) * 4 + (c & 3) + 16 * ((c >> 2) & 1); return head * 96 + 64 + dim; }
    return (rr >> 6) * 128 + 64 + (rr & 63);
}
DI void phase_prologue(const Params& p, float* lds, int bid, int nb, int tid) {
    bf16_t* ws16 = (bf16_t*)p.ws;
    int base = 0;
    conv_job<true, true>(p.in[13], 1, 1024, 3072, 3072, (bf16_t*)(p.ws + W_QKV0), 2048, base, lds, bid, nb, tid);
    conv_job<true, true>(p.in[14], 1, 1024, 1024, 1024, (bf16_t*)(p.ws + W_O0), 0, base, lds, bid, nb, tid);
    conv_job<true, true>(p.in[18], 1, 1024, 1536, 1536, (bf16_t*)(p.ws + W_QKV1), 1280, base, lds, bid, nb, tid);
    conv_job<true, true>(p.in[19], 1, 1024, 1024, 1024, (bf16_t*)(p.ws + W_O1), 0, base, lds, bid, nb, tid);
    conv_job<true, true>(p.in[23], 1, 1024, 672, 768, (bf16_t*)(p.ws + W_DQKV), 0, base, lds, bid, nb, tid);
    for (int i = bid * NTHREADS + tid; i < 1536 * 48 + 2048 * 32; i += nb * NTHREADS) {
        const bool uq = i < 1536 * 48;
        const int K = uq ? 384 : 256, kc = K / 8, ii = uq ? i : i - 1536 * 48, r = ii / kc, k0 = (ii - r * kc) * 8, nsrc = uq ? 1536 : 2048;
        const int col = mla_col(uq, r);
        const float* src = p.in[uq ? 26 : 27] + (size_t)k0 * nsrc + col;
        float f[8];
#pragma unroll
        for (int j = 0; j < 8; ++j) f[j] = src[(size_t)j * nsrc];
        *(u32x4*)((bf16_t*)(p.ws + (uq ? W_UQ : W_UKV)) + (size_t)r * K + k0) = pack8(f);
    }
    conv_job<true, true>(p.in[30], 1, 1024, 1024, 1024, (bf16_t*)(p.ws + W_O2), 0, base, lds, bid, nb, tid);
    conv_job<true, true>(p.in[31], 1, 1024, 3072, 3072, (bf16_t*)(p.ws + W_QKV3), 2048, base, lds, bid, nb, tid);
    conv_job<true, true>(p.in[36], 1, 1024, 1024, 1024, (bf16_t*)(p.ws + W_O3), 0, base, lds, bid, nb, tid);
    conv_job<true, true>(p.in[11], 32, 1024, 512, 512, (bf16_t*)(p.ws + W_GU), 1, base, lds, bid, nb, tid);
    conv_job(p.in[12], 32, 256, 1024, 1024, (bf16_t*)(p.ws + W_DN), 0, base, lds, bid, nb, tid);
    (void)ws16;
    float* sc = lds;
    for (int i = tid; i < 9 * 1024; i += NTHREADS) {
        const int r = i >> 10, k = i & 1023;
        const float v = r < 8 ? p.in[1][r * 1024 + k] : p.in[3][k];
        sc[i] = silu_f(v);
    }
    __syncthreads();
    float* part = (float*)(p.ws + WS_MODP);
    for (int it = bid; it < 768; it += nb) {
        const int kc = it / 48, rem = it - kc * 48, l = rem / 12, nch = rem - l * 12;
        const int n = nch * 512 + tid;
        const float* w = p.in[4] + ((size_t)l * 1024 + kc * 64) * 6144 + n;
        float acc[9];
#pragma unroll
        for (int r = 0; r < 9; ++r) acc[r] = 0.f;
#pragma unroll 8
        for (int k = 0; k < 64; ++k) {
            const float wv = __builtin_nontemporal_load(w + (size_t)k * 6144);
#pragma unroll
            for (int r = 0; r < 9; ++r) acc[r] += sc[r * 1024 + kc * 64 + k] * wv;
        }
#pragma unroll
        for (int r = 0; r < 9; ++r) part[(((size_t)kc * 4 + l) * 9 + r) * 6144 + n] = acc[r];
    }
    __syncthreads();
}
DI void phase_mod_reduce(const Params& p, int bid, int nb, int tid) {
    const float* part = (const float*)(p.ws + WS_MODP);
    float* mod = (float*)(p.ws + WS_MOD);
    const int total = 4 * 9 * 6144;
    for (int i = bid * NTHREADS + tid; i < total; i += nb * NTHREADS) {
        const int l = i / (9 * 6144), n = i % 6144;
        float s = p.in[5][l * 6144 + n];
#pragma unroll
        for (int kc = 0; kc < 16; ++kc) s += part[(size_t)kc * total + i];
        mod[i] = s;
    }
}

template <int MODE>
DI void phase_rows(const Params& p, int layer  , int which  , int bid, int nb, int tid) {
    const int wid = __builtin_amdgcn_readfirstlane(tid >> 6), lane = tid & 63;
    const float* modall = (const float*)(p.ws + WS_MOD);
    const bf16_t* eo = (const bf16_t*)(p.ws + WS_RAW);
    bf16_t* H = (bf16_t*)(p.ws + WS_H);
    for (int r = bid * NW + wid; r < MROWS; r += nb * NW) {
        const int b = r / PP, pos = r - b * PP;
        if ((MODE & 16) && pos >= SEQ) continue;
        const int mr = pos < SEQ ? b : 8;
        bf16_t* xb = xb_row(p, r);
        float x[16];
        if (MODE & 8) {
            const float* xr = pos < SEQ ? p.in[0] + ((size_t)b * SEQ + pos) * DM : p.in[2] + ((size_t)b * CTXL + (pos - SEQ)) * DM;
#pragma unroll
            for (int j = 0; j < 4; ++j) { const f32x4 v = *(const f32x4*)(xr + lane * 4 + 256 * j); x[4 * j] = v.x; x[4 * j + 1] = v.y; x[4 * j + 2] = v.z; x[4 * j + 3] = v.w; }
        } else {
#pragma unroll
            for (int j = 0; j < 4; ++j) { const u32x2 v = *(const u32x2*)(xb + lane * 4 + 256 * j); x[4 * j] = bflo(v.x); x[4 * j + 1] = bfhi(v.x); x[4 * j + 2] = bflo(v.y); x[4 * j + 3] = bfhi(v.y); }
        }
        if (MODE & 1) {
            const float* g2 = modall + ((size_t)(layer - ((MODE & 2) ? 1 : 0)) * 9 + mr) * 6144 + 5120;
            const unsigned char* y0 = (const unsigned char*)eo + (size_t)(2 * r) * 1024, *y1 = y0 + 1024;
#pragma unroll
            for (int j = 0; j < 4; ++j) {
                const unsigned a = *(const unsigned*)(y0 + lane * 4 + 256 * j), bb = *(const unsigned*)(y1 + lane * 4 + 256 * j);
                const f32x4 g = *(const f32x4*)(g2 + lane * 4 + 256 * j) * (1.0f / 16.0f);
                const f32x2_8 a01 = __builtin_amdgcn_cvt_pk_f32_fp8((int)a, false), a23 = __builtin_amdgcn_cvt_pk_f32_fp8((int)a, true);
                const f32x2_8 b01 = __builtin_amdgcn_cvt_pk_f32_fp8((int)bb, false), b23 = __builtin_amdgcn_cvt_pk_f32_fp8((int)bb, true);
                x[4 * j] += g.x * (a01[0] + b01[0]); x[4 * j + 1] += g.y * (a01[1] + b01[1]);
                x[4 * j + 2] += g.z * (a23[0] + b23[0]); x[4 * j + 3] += g.w * (a23[1] + b23[1]);
            }
        }
        if (MODE & 16) {
            float* orow = p.out + ((size_t)b * SEQ + pos) * DM;
#pragma unroll
            for (int j = 0; j < 4; ++j) *(f32x4*)(orow + lane * 4 + 256 * j) = (f32x4){x[4 * j], x[4 * j + 1], x[4 * j + 2], x[4 * j + 3]};
        } else if (MODE & (1 | 8)) {
#pragma unroll
            for (int j = 0; j < 4; ++j) {
                u32x2 w; w.x = pk2(x[4 * j], x[4 * j + 1]); w.y = pk2(x[4 * j + 2], x[4 * j + 3]);
                *(u32x2*)(xb + lane * 4 + 256 * j) = w;
                x[4 * j] = bflo(w.x); x[4 * j + 1] = bfhi(w.x); x[4 * j + 2] = bflo(w.y); x[4 * j + 3] = bfhi(w.y);
            }
        }
        if (MODE & 2) {
            float ss = 0.f;
#pragma unroll
            for (int i = 0; i < 16; ++i) ss += x[i] * x[i];
            ss = wave_sum(ss);
            const float rs = rsqrtf(ss * (1.0f / 1024.0f) + EPS);
            const float* ng = p.in[6] + ((size_t)layer * 2 + which) * 1024;
            const float* md = modall + ((size_t)layer * 9 + mr) * 6144 + which * 3072;
#pragma unroll
            for (int j = 0; j < 4; ++j) {
                const f32x4 g = *(const f32x4*)(ng + lane * 4 + 256 * j), sh = *(const f32x4*)(md + lane * 4 + 256 * j), sc = *(const f32x4*)(md + 1024 + lane * 4 + 256 * j);
                const float h0 = x[4 * j] * rs * g.x * (1.0f + sc.x) + sh.x, h1 = x[4 * j + 1] * rs * g.y * (1.0f + sc.y) + sh.y;
                const float h2 = x[4 * j + 2] * rs * g.z * (1.0f + sc.z) + sh.z, h3 = x[4 * j + 3] * rs * g.w * (1.0f + sc.w) + sh.w;
                if (MODE & 32) *(unsigned*)((unsigned char*)H + (size_t)r * 1024 + lane * 4 + 256 * j) = cvt_fp8x4(h0, h1, h2, h3);
                else { u32x2 w; w.x = pk2(h0, h1); w.y = pk2(h2, h3); *(u32x2*)(H + (size_t)r * 1024 + lane * 4 + 256 * j) = w; }
            }
        }
    }
}

constexpr size_t WS_RC = WS_MOD + 917504;
DI void phase_router_prep(const Params& p, int bid, int nb, int tid) {
    const float* modall = (const float*)(p.ws + WS_MOD);
    bf16_t* wth = (bf16_t*)(p.ws + WS_RW); bf16_t* wtl = wth + 4 * 9 * 48 * 1024;
    const int total = 4 * 9 * 48 * 1024;
    for (int i = bid * NTHREADS + tid; i < total; i += nb * NTHREADS) {
        const int k = i & 1023, c = (i >> 10) % 48, lb = i / (48 * 1024), l = lb / 9, b = lb - l * 9;
        float v = 0.f;
        if (c < 36) {
            const float w = c < 32 ? p.in[9][((size_t)l * 1024 + k) * 32 + c] : p.in[7][((size_t)l * 1024 + k) * 4 + (c - 32)];
            v = p.in[6][((size_t)l * 2 + 1) * 1024 + k] * (1.0f + modall[((size_t)l * 9 + b) * 6144 + 4096 + k]) * w;
        }
        const unsigned hb = f2bf(v); wth[i] = (bf16_t)hb; wtl[i] = (bf16_t)f2bf(v - bf2f(hb));
    }
    float* cst = (float*)(p.ws + WS_RC);
    const int wid = __builtin_amdgcn_readfirstlane(tid >> 6), lane = tid & 63;
    for (int j = bid * NW + wid; j < 4 * 9 * 48; j += nb * NW) {
        const int c = j % 48, lb = j / 48, l = lb / 9, b = lb - l * 9;
        float acc = 0.f;
        if (c < 36) {
            for (int k = lane; k < 1024; k += 64) {
                const float w = c < 32 ? p.in[9][((size_t)l * 1024 + k) * 32 + c] : p.in[7][((size_t)l * 1024 + k) * 4 + (c - 32)];
                acc += modall[((size_t)l * 9 + b) * 6144 + 3072 + k] * w;
            }
            acc = wave_sum(acc) + (c < 32 ? p.in[10][l * 32 + c] : p.in[8][l * 4 + (c - 32)]);
        }
        if (lane == 0) cst[j] = acc;
    }
}
typedef float f32x2_3 __attribute__((ext_vector_type(2)));
typedef __bf16 bf16x2_3 __attribute__((ext_vector_type(2)));
DI unsigned cvtpk3(float lo, float hi) { f32x2_3 v = {lo, hi}; bf16x2_3 b = __builtin_convertvector(v, bf16x2_3); return __builtin_bit_cast(unsigned, b); }
DI void phase_router(const Params& p, unsigned char* smem, int layer, bool skip_ctx, int bid, int nb, int tid) {
    const int lane = tid & 63, wid = __builtin_amdgcn_readfirstlane(tid >> 6), li = lane & 15, kq = lane >> 4;
    LAS float* tile = (LAS float*)smem + wid * (32 * 49);
    const bf16_t* wth_all = (const bf16_t*)(p.ws + WS_RW) + (size_t)layer * 9 * 48 * 1024;
    const bf16_t* wtl_all = wth_all + 4 * 9 * 48 * 1024;
    const float* cst_all = (const float*)(p.ws + WS_RC) + layer * 9 * 48;
    unsigned* cnt = (unsigned*)(p.ws + WS_CTL) + CW_CNT + layer * 32;
    unsigned* list = (unsigned*)(p.ws + WS_LIST);
    float* gates = (float*)(p.ws + WS_GATE);
    if (layer > 0) {
        int base = 0;
        conv_job<false, true>(p.in[11] + (size_t)layer * 32 * 1024 * 512, 32, 1024, 512, 512, (bf16_t*)(p.ws + W_GU + (size_t)layer * 32 * 512 * 1024), 1, base, (float*)smem, bid, nb, tid);
        conv_job<false>(p.in[12] + (size_t)layer * 32 * 256 * 1024, 32, 256, 1024, 1024, (bf16_t*)(p.ws + W_DN) + (size_t)layer * 32 * 1024 * 256, 0, base, (float*)smem, bid, nb, tid);
    }
    for (int u = bid * NW + wid; u < MROWS / 32; u += nb * NW) {
        const int r0 = u * 32, b = r0 / PP, pos = r0 - b * PP;
        const bool isctx = pos >= SEQ;
        if (skip_ctx && isctx) continue;
        const int mr = isctx ? 8 : b;
        const bf16_t* xr = xb_row(p, r0 + li) + 8 * kq;
        const bf16_t* wh = wth_all + ((size_t)mr * 48 + li) * 1024 + 8 * kq;
        const bf16_t* wl = wtl_all + ((size_t)mr * 48 + li) * 1024 + 8 * kq;
        f32x4 acc[2][3];
#pragma unroll
        for (int m = 0; m < 2; ++m)
#pragma unroll
            for (int n = 0; n < 3; ++n) acc[m][n] = (f32x4){0.f, 0.f, 0.f, 0.f};
        float ss[2] = {0.f, 0.f};
#pragma unroll 2
        for (int s = 0; s < 32; ++s) {
            bf16x8 xa[2], bh[3], bl[3];
#pragma unroll
            for (int m = 0; m < 2; ++m) xa[m] = *(const bf16x8*)(xr + (size_t)m * 16 * DM + 32 * s);
#pragma unroll
            for (int n = 0; n < 3; ++n) { bh[n] = *(const bf16x8*)(wh + (size_t)n * 16 * 1024 + 32 * s); bl[n] = *(const bf16x8*)(wl + (size_t)n * 16 * 1024 + 32 * s); }
#pragma unroll
            for (int m = 0; m < 2; ++m) {
                const u32x4 w = __builtin_bit_cast(u32x4, xa[m]);
                ss[m] += bflo(w.x) * bflo(w.x) + bfhi(w.x) * bfhi(w.x) + bflo(w.y) * bflo(w.y) + bfhi(w.y) * bfhi(w.y) + bflo(w.z) * bflo(w.z) + bfhi(w.z) * bfhi(w.z) + bflo(w.w) * bflo(w.w) + bfhi(w.w) * bfhi(w.w);
#pragma unroll
                for (int n = 0; n < 3; ++n) {
                    acc[m][n] = __builtin_amdgcn_mfma_f32_16x16x32_bf16(xa[m], bl[n], acc[m][n], 0, 0, 0);
                    acc[m][n] = __builtin_amdgcn_mfma_f32_16x16x32_bf16(xa[m], bh[n], acc[m][n], 0, 0, 0);
                }
            }
        }
#pragma unroll
        for (int m = 0; m < 2; ++m) { ss[m] += __shfl_xor(ss[m], 16); ss[m] += __shfl_xor(ss[m], 32); }
#pragma unroll
        for (int m = 0; m < 2; ++m)
#pragma unroll
            for (int n = 0; n < 3; ++n)
#pragma unroll
                for (int i = 0; i < 4; ++i) tile[(16 * m + 4 * kq + i) * 49 + n * 16 + li] = acc[m][n][i];
        __builtin_amdgcn_s_waitcnt(0xc07f);
        const float ssr = (lane & 16) ? ss[1] : ss[0];
        const float rs = rsqrtf(ssr * (1.0f / 1024.0f) + EPS);
        if (lane < 32) {
            const float* cst = cst_all + mr * 48;
            const LAS float* tr = tile + lane * 49;
            float lg[4];
#pragma unroll
            for (int c = 0; c < 4; ++c) lg[c] = tr[32 + c] * rs + cst[32 + c];
            int gi = 0; float gm = lg[0];
#pragma unroll
            for (int c = 1; c < 4; ++c) if (lg[c] > gm) { gm = lg[c]; gi = c; }
            float gden = 0.f;
#pragma unroll
            for (int c = 0; c < 4; ++c) gden += __expf(lg[c] - gm);
            const float gw = 1.0f / gden;
            float le[8];
#pragma unroll
            for (int c = 0; c < 8; ++c) le[c] = tr[gi * 8 + c] * rs + cst[gi * 8 + c];
            int e0 = 0; float m0 = le[0];
#pragma unroll
            for (int c = 1; c < 8; ++c) if (le[c] > m0) { m0 = le[c]; e0 = c; }
            int e1 = -1; float m1 = -INFINITY;
#pragma unroll
            for (int c = 0; c < 8; ++c) if (c != e0 && le[c] > m1) { m1 = le[c]; e1 = c; }
            const float q1 = __expf(m1 - m0), inv = 1.0f / (1.0f + q1);
            const int r = r0 + lane, ex0 = gi * 8 + e0, ex1 = gi * 8 + e1;
            const unsigned s0 = atomicAdd(cnt + ex0, 1u), s1 = atomicAdd(cnt + ex1, 1u);
            list[(size_t)ex0 * MROWS + s0] = 2u * r; list[(size_t)ex1 * MROWS + s1] = 2u * r + 1u;
            gates[2 * r] = gw * inv; gates[2 * r + 1] = gw * q1 * inv;
        }
        {
            const float* ng = p.in[6] + ((size_t)layer * 2 + 1) * 1024;
            const float* md = (const float*)(p.ws + WS_MOD) + ((size_t)layer * 9 + mr) * 6144 + 3072;
            f32x4 gm[4], sh[4];
#pragma unroll
            for (int j = 0; j < 4; ++j) {
                const f32x4 g = *(const f32x4*)(ng + lane * 4 + 256 * j), sc = *(const f32x4*)(md + 1024 + lane * 4 + 256 * j);
                sh[j] = *(const f32x4*)(md + lane * 4 + 256 * j);
                gm[j] = (f32x4){g.x * (1.0f + sc.x), g.y * (1.0f + sc.y), g.z * (1.0f + sc.z), g.w * (1.0f + sc.w)};
            }
            unsigned char* H8 = p.ws + WS_H;
#pragma unroll 4
            for (int i = 0; i < 32; ++i) {
                const float rsi = __shfl(rs, i);
                const bf16_t* xb = xb_row(p, r0 + i);
#pragma unroll
                for (int j = 0; j < 4; ++j) {
                    const u32x2 v = *(const u32x2*)(xb + lane * 4 + 256 * j);
                    *(unsigned*)(H8 + (size_t)(r0 + i) * 1024 + lane * 4 + 256 * j) =
                        cvt_fp8x4(bflo(v.x) * rsi * gm[j].x + sh[j].x, bfhi(v.x) * rsi * gm[j].y + sh[j].y, bflo(v.y) * rsi * gm[j].z + sh[j].z, bfhi(v.y) * rsi * gm[j].w + sh[j].w);
                }
            }
        }
    }
}

#define MFMA32(a, b, c) __builtin_amdgcn_mfma_f32_32x32x16_bf16((a), (b), (c), 0, 0, 0)
typedef LAS unsigned char* lds_ptr;
constexpr int GEMM_TM = 256, GEMM_TN = 256;
constexpr int GEMM_STAGE = 65536;
constexpr int GEMM_LDS = 2 * GEMM_STAGE;
constexpr int GEMM_MT = 4;

struct RowDense { static constexpr bool DENSE = true; const bf16_t* A; int lda; int m0; DI unsigned row(int i) const { return (unsigned)(m0 + i) * (unsigned)lda; } };
struct RowGather { static constexpr bool DENSE = false; const bf16_t* A; int lda; const unsigned* ent; int valid; int shift;
    DI unsigned row(int i) const { const unsigned e = ent[i < valid ? i : valid - 1]; return (e >> shift) * (unsigned)lda; } };

struct EpiStore { bf16_t* C; int ldc; int m0;
    DI void wave_tile(const f32x16 (&acc)[2][GEMM_MT], int mloc, int ncol, int lane) const {
        const int r = lane & 31, h = lane >> 5;
#pragma unroll
        for (int mt = 0; mt < GEMM_MT; ++mt) {
            bf16_t* c = C + (size_t)(m0 + mloc + mt * 32 + r) * ldc + ncol + 4 * h;
#pragma unroll
            for (int nt = 0; nt < 2; ++nt)
#pragma unroll
                for (int g = 0; g < 4; ++g) {
                    u32x2 w; w.x = pk2(acc[nt][mt][4 * g], acc[nt][mt][4 * g + 1]); w.y = pk2(acc[nt][mt][4 * g + 2], acc[nt][mt][4 * g + 3]);
                    *(u32x2*)(c + nt * 32 + 8 * g) = w;
                }
        }
    } };
struct EpiResid { const Params* p; const float* mod; int m0;
    DI void wave_tile(const f32x16 (&acc)[2][GEMM_MT], int mloc, int ncol, int lane) const {
        const int r = lane & 31, h = lane >> 5;
#pragma unroll
        for (int mt = 0; mt < GEMM_MT; ++mt) {
            const int row = m0 + mloc + mt * 32 + r;
            float* xr = xrow_ptr(*p, row) + ncol + 4 * h;
            const float* gp = mod + (size_t)mod_row(row) * 6144 + 2048 + ncol + 4 * h;
#pragma unroll
            for (int nt = 0; nt < 2; ++nt)
#pragma unroll
                for (int g = 0; g < 4; ++g) {
                    f32x4 x = *(f32x4*)(xr + nt * 32 + 8 * g);
                    const f32x4 gg = *(const f32x4*)(gp + nt * 32 + 8 * g);
                    x.x += gg.x * acc[nt][mt][4 * g]; x.y += gg.y * acc[nt][mt][4 * g + 1]; x.z += gg.z * acc[nt][mt][4 * g + 2]; x.w += gg.w * acc[nt][mt][4 * g + 3];
                    *(f32x4*)(xr + nt * 32 + 8 * g) = x;
                }
        }
    } };
struct EpiGlu { bf16_t* act; const unsigned* ent; const float* gates; int valid;
    DI void wave_tile(const f32x16 (&acc)[2][GEMM_MT], int mloc, int ncol, int lane) const {
        const int r = lane & 31, h = lane >> 5;
#pragma unroll
        for (int mt = 0; mt < GEMM_MT; ++mt) {
            const int i = mloc + mt * 32 + r;
            if (i < valid) {
                const unsigned a = ent[i];
                const float gw = gates[a];
                bf16_t* o = act + (size_t)a * DEXP + (ncol >> 6) * 32 + 4 * h;
#pragma unroll
                for (int g = 0; g < 4; ++g) {
                    float v[4];
#pragma unroll
                    for (int j = 0; j < 4; ++j) v[j] = silu_f(acc[0][mt][4 * g + j]) * acc[1][mt][4 * g + j] * gw;
                    u32x2 w; w.x = pk2(v[0], v[1]); w.y = pk2(v[2], v[3]);
                    *(u32x2*)(o + 8 * g) = w;
                }
            }
        }
    } };
struct EpiScatter { bf16_t* outp; const unsigned* ent; int valid;
    DI void wave_tile(const f32x16 (&acc)[2][GEMM_MT], int mloc, int ncol, int lane) const {
        const int r = lane & 31, h = lane >> 5;
#pragma unroll
        for (int mt = 0; mt < GEMM_MT; ++mt) {
            const int i = mloc + mt * 32 + r;
            if (i < valid) {
                bf16_t* c = outp + (size_t)ent[i] * 1024 + ncol + 4 * h;
#pragma unroll
                for (int nt = 0; nt < 2; ++nt)
#pragma unroll
                    for (int g = 0; g < 4; ++g) {
                        u32x2 w; w.x = pk2(acc[nt][mt][4 * g], acc[nt][mt][4 * g + 1]); w.y = pk2(acc[nt][mt][4 * g + 2], acc[nt][mt][4 * g + 3]);
                        *(u32x2*)(c + nt * 32 + 8 * g) = w;
                    }
            }
        }
    } };

#define SCHED_FENCE() __builtin_amdgcn_sched_barrier(0)
DI void glds16(const bf16_t* g, lds_ptr l) { __builtin_amdgcn_global_load_lds((const unsigned*)g, (LAS unsigned*)l, 16, 0, 0); }
template <int PROBE, int NAG>
DI void gemm_kstep(f32x16 (&acc)[2][GEMM_MT], const lds_ptr st, const unsigned (&arow)[GEMM_MT], const unsigned (&wrow)[2], const unsigned (&aswz)[GEMM_MT], const unsigned (&wswz)[2], int h,
                   bool issue, const bf16_t* __restrict__ An, const bf16_t* __restrict__ Wn, const unsigned (&ag)[NAG], unsigned astep, const unsigned (&bg)[2], unsigned bstep, const lds_ptr sn) {
    if (PROBE != 2 && issue) {
#pragma unroll
        for (int j = 0; j < 8; ++j) { glds16(An + (NAG == 2 ? ag[j & 1] + (j >> 1) * astep : ag[j % NAG]), sn + j * 1024); glds16(Wn + bg[j & 1] + (j >> 1) * bstep, sn + 32768 + j * 1024); }
    }
    if (PROBE == 1) return;
    bf16x8 af[2][GEMM_MT], wf[2][2];
#pragma unroll
    for (int t = 0; t < 2; ++t) wf[0][t] = *(const LAS bf16x8*)(st + wrow[t] + ((((unsigned)h) ^ wswz[t]) << 4));
#pragma unroll
    for (int t = 0; t < GEMM_MT; ++t) af[0][t] = *(const LAS bf16x8*)(st + arow[t] + ((((unsigned)h) ^ aswz[t]) << 4));
#pragma unroll
    for (int kk = 0; kk < 4; ++kk) {
        if (kk < 3) {
#pragma unroll
            for (int t = 0; t < 2; ++t) wf[(kk + 1) & 1][t] = *(const LAS bf16x8*)(st + wrow[t] + ((((unsigned)((kk + 1) * 2 + h)) ^ wswz[t]) << 4));
#pragma unroll
            for (int t = 0; t < GEMM_MT; ++t) af[(kk + 1) & 1][t] = *(const LAS bf16x8*)(st + arow[t] + ((((unsigned)((kk + 1) * 2 + h)) ^ aswz[t]) << 4));
        }
        SCHED_FENCE();
        __builtin_amdgcn_s_setprio(1);
#pragma unroll
        for (int mt = 0; mt < GEMM_MT; ++mt)
#pragma unroll
            for (int nt = 0; nt < 2; ++nt) acc[nt][mt] = MFMA32(wf[kk & 1][nt], af[kk & 1][mt], acc[nt][mt]);
        __builtin_amdgcn_s_setprio(0);
        SCHED_FENCE();
    }
}
template <class RowSrc, class Epi, int PROBE = 0>
DI void gemm_tile_mfma(unsigned char* smem, const RowSrc& rs, const bf16_t* __restrict__ Wt, int K, int n0, const Epi& epi, int tid) {
    const lds_ptr lds = (lds_ptr)smem;
    const int lane = tid & 63, wid = __builtin_amdgcn_readfirstlane(tid >> 6), wm = wid & 1, wn = wid >> 1, r = lane & 31, h = lane >> 5;
    const bool loader = wid < 4;
    const int lw = wid & 3;
    constexpr int NAG = RowSrc::DENSE ? 2 : 8;
    unsigned ag[NAG], bg[2];
    const bf16_t* __restrict__ Ab = rs.A;
#pragma unroll
    for (int j = 0; j < NAG; ++j) {
        const int row = (lw * 8 + j) * 8 + (lane >> 3), c = (lane & 7) ^ ((row >> 1) & 7);
        ag[j] = rs.row(row) + c * 8;
    }
#pragma unroll
    for (int j = 0; j < 2; ++j) {
        const int row = (lw * 8 + j) * 8 + (lane >> 3), c = (lane & 7) ^ ((row >> 1) & 7);
        bg[j] = (unsigned)(n0 + row) * (unsigned)K + c * 8;
    }
    const unsigned astep = 16u * (unsigned)rs.lda, bstep = 16u * (unsigned)K;
    const unsigned dmaoff = (unsigned)lw * 8192u;
    unsigned arow[GEMM_MT], wrow[2], aswz[GEMM_MT], wswz[2];
#pragma unroll
    for (int t = 0; t < GEMM_MT; ++t) { const int ra = wm * 128 + t * 32 + r; arow[t] = ra * 128; aswz[t] = (ra >> 1) & 7; }
#pragma unroll
    for (int t = 0; t < 2; ++t) { const int rw = wn * 64 + t * 32 + r; wrow[t] = 32768 + rw * 128; wswz[t] = (rw >> 1) & 7; }
    f32x16 acc[2][GEMM_MT];
#pragma unroll
    for (int a = 0; a < 2; ++a)
#pragma unroll
        for (int b = 0; b < GEMM_MT; ++b)
#pragma unroll
            for (int i = 0; i < 16; ++i) acc[a][b][i] = 0.f;
    if (loader) {
#pragma unroll
        for (int j = 0; j < 8; ++j) { glds16(Ab + (NAG == 2 ? ag[j & 1] + (j >> 1) * astep : ag[j % NAG]), lds + dmaoff + j * 1024); glds16(Wt + bg[j & 1] + (j >> 1) * bstep, lds + 32768 + dmaoff + j * 1024); }
    }
    asm volatile("s_waitcnt vmcnt(0)" ::: "memory");
    __syncthreads();
    const int KT = K >> 6;
    for (int kt = 0; kt < KT; ++kt) {
        gemm_kstep<PROBE, NAG>(acc, lds + (kt & 1) * GEMM_STAGE, arow, wrow, aswz, wswz, h, loader && kt + 1 < KT, Ab + (kt + 1) * 64, Wt + (kt + 1) * 64, ag, astep, bg, bstep, lds + ((kt + 1) & 1) * GEMM_STAGE + dmaoff);
        asm volatile("s_waitcnt vmcnt(0)" ::: "memory");
        __syncthreads();
    }
    if (PROBE == 0 || acc[0][0][0] == 12345.678f) epi.wave_tile(acc, wm * 128, n0 + wn * 64, lane);
}

template <int EPIK, int PROBE = 0>
DI void gemm_dense(const Params& p, unsigned char* smem, const bf16_t* A, int lda, const bf16_t* Wt, int K, int N, bf16_t* C, int ldc, const float* mod, int bid, int nb, int tid) {
    const int tn = N / GEMM_TN, total = (MROWS / GEMM_TM) * tn;
    for (int t = bid; t < total; t += nb) {
        const int mt = t / tn, nt = t - mt * tn;
        RowDense rs{A, lda, mt * GEMM_TM};
        if (EPIK == 0) { EpiStore e{C, ldc, mt * GEMM_TM}; gemm_tile_mfma<RowDense, EpiStore, PROBE>(smem, rs, Wt, K, nt * GEMM_TN, e, tid); }
        else { EpiResid e{&p, mod, mt * GEMM_TM}; gemm_tile_mfma(smem, rs, Wt, K, nt * GEMM_TN, e, tid); }
    }
}
template <int WHICH>
DI void gemm_moe(const Params& p, unsigned char* smem, int layer, int bid, int nb, int tid) {
    const unsigned* cnt = (const unsigned*)(p.ws + WS_CTL) + CW_CNT + layer * 32;
    const unsigned* list = (const unsigned*)(p.ws + WS_LIST);
    const float* gates = (const float*)(p.ws + WS_GATE);
    const bf16_t* H = (const bf16_t*)(p.ws + WS_H);
    bf16_t* act = (bf16_t*)(p.ws + WS_Q);
    bf16_t* eo = (bf16_t*)(p.ws + WS_RAW);
    constexpr int TN = WHICH == 0 ? 2 : 4;
    int total = 0;
    for (int e = 0; e < NEXP; ++e) total += (int)((cnt[e] + 255u) >> 8) * TN;
    for (int t = bid; t < total; t += nb) {
        int e = 0, rem = t;
        for (; e < NEXP; ++e) { const int te = (int)((cnt[e] + 255u) >> 8) * TN; if (rem < te) break; rem -= te; }
        const int rt = rem / TN, ct = rem - rt * TN;
        const unsigned* ent = list + (size_t)e * MROWS + rt * GEMM_TM;
        const int valid = min(GEMM_TM, (int)cnt[e] - rt * GEMM_TM);
        if (WHICH == 0) {
            RowGather rs{H, 1024, ent, valid, 1};
            EpiGlu ep{act, ent, gates, valid};
            gemm_tile_mfma(smem, rs, (const bf16_t*)(p.ws + W_GU) + ((size_t)layer * 32 + e) * 512 * 1024, 1024, ct * GEMM_TN, ep, tid);
        } else {
            RowGather rs{act, DEXP, ent, valid, 0};
            EpiScatter ep{eo, ent, valid};
            gemm_tile_mfma(smem, rs, (const bf16_t*)(p.ws + W_DN) + ((size_t)layer * 32 + e) * 1024 * 256, 256, ct * GEMM_TN, ep, tid);
        }
    }
}

DI float quad_sum(float v) { v += __shfl_xor(v, 1); v += __shfl_xor(v, 2); return v; }
DI void head64_norm_rope(const bf16_t* src, bf16_t* dst, const float* gain, int sub, bool rope, int prow, int pcol, float scale) {
    float a[8], b[8];
    unpack8(*(const u32x4*)(src + sub * 8), a); unpack8(*(const u32x4*)(src + 32 + sub * 8), b);
    float ss = 0.f;
#pragma unroll
    for (int e = 0; e < 8; ++e) ss += a[e] * a[e] + b[e] * b[e];
    ss = quad_sum(ss);
    const float rs = rsqrtf(ss * (1.0f / 64.0f) + EPS);
#pragma unroll
    for (int e = 0; e < 8; ++e) { a[e] *= rs * gain[sub * 8 + e]; b[e] *= rs * gain[32 + sub * 8 + e]; }
    if (rope) {
#pragma unroll
        for (int e = 0; e < 8; ++e) {
            const int i = sub * 8 + e;
            const float* cs = ROPE64 + ((i < 16 ? prow : pcol) * 16 + (i & 15)) * 2;
            const float c = cs[0], s = cs[1], x1 = a[e], x2 = b[e];
            a[e] = x1 * c - x2 * s; b[e] = x2 * c + x1 * s;
        }
    }
#pragma unroll
    for (int e = 0; e < 8; ++e) { a[e] *= scale; b[e] *= scale; }
    *(u32x4*)(dst + sub * 8) = pack8(a); *(u32x4*)(dst + 32 + sub * 8) = pack8(b);
}
template <int KIND>
DI void phase_post_qk(const Params& p, int bid, int nb, int tid) {
    const int wid = __builtin_amdgcn_readfirstlane(tid >> 6), lane = tid & 63, hd = lane >> 2, sub = lane & 3;
    constexpr int NRAW = KIND == 1 ? 1536 : 3072, KH = KIND == 1 ? 4 : 16;
    const bf16_t* raw = (const bf16_t*)(p.ws + WS_RAW);
    bf16_t* Q = (bf16_t*)(p.ws + WS_Q); bf16_t* Kb = (bf16_t*)(p.ws + WS_K);
    const float* qn = p.in[KIND == 0 ? 15 : KIND == 1 ? 20 : 32];
    const float* kn = p.in[KIND == 0 ? 16 : KIND == 1 ? 21 : 33];
    const float qscale = 0.125f * LOG2E;
    for (int r = bid * NW + wid; r < MROWS; r += nb * NW) {
        const int b = r / PP, pos = r - b * PP;
        const bool rope = (KIND != 0) && pos < SEQ;
        const int prow = (pos >> 6) & 63, pcol = pos & 63;
        const bf16_t* rr = raw + (size_t)r * NRAW;
        head64_norm_rope(rr + hd * 64, Q + (size_t)r * 1024 + hd * 64, qn, sub, rope, prow, pcol, qscale);
        if (hd < KH) head64_norm_rope(rr + 1024 + hd * 64, Kb + (size_t)r * (KH * 64) + hd * 64, kn, sub, rope, prow, pcol, 1.0f);
    }
}
DI void phase_post_mla1(const Params& p, int bid, int nb, int tid) {
    const int wid = __builtin_amdgcn_readfirstlane(tid >> 6), lane = tid & 63;
    const bf16_t* raw = (const bf16_t*)(p.ws + WS_Q);
    bf16_t* cqn = (bf16_t*)(p.ws + WS_O);
    bf16_t* ckvn = cqn + (size_t)MROWS * 384;
    bf16_t* krope = ckvn + (size_t)MROWS * 256;
    const float* qa = p.in[24]; const float* kva = p.in[25]; const float* kn = p.in[29];
    for (int r = bid * NW + wid; r < MROWS; r += nb * NW) {
        const int b = r / PP, pos = r - b * PP;
        const bf16_t* rr = raw + (size_t)r * 768;
        {
            float v[6];
#pragma unroll
            for (int j = 0; j < 3; ++j) { const unsigned w = *(const unsigned*)(rr + lane * 6 + 2 * j); v[2 * j] = bflo(w); v[2 * j + 1] = bfhi(w); }
            float ss = 0.f;
#pragma unroll
            for (int j = 0; j < 6; ++j) ss += v[j] * v[j];
            ss = wave_sum(ss);
            const float rs = rsqrtf(ss * (1.0f / 384.0f) + EPS);
#pragma unroll
            for (int j = 0; j < 3; ++j) *(unsigned*)(cqn + (size_t)r * 384 + lane * 6 + 2 * j) = pk2(v[2 * j] * rs * qa[lane * 6 + 2 * j], v[2 * j + 1] * rs * qa[lane * 6 + 2 * j + 1]);
        }
        {
            const u32x2 w = *(const u32x2*)(rr + 384 + lane * 4);
            float v[4] = {bflo(w.x), bfhi(w.x), bflo(w.y), bfhi(w.y)};
            float ss = v[0] * v[0] + v[1] * v[1] + v[2] * v[2] + v[3] * v[3];
            ss = wave_sum(ss);
            const float rs = rsqrtf(ss * (1.0f / 256.0f) + EPS);
            u32x2 o; o.x = pk2(v[0] * rs * kva[lane * 4], v[1] * rs * kva[lane * 4 + 1]); o.y = pk2(v[2] * rs * kva[lane * 4 + 2], v[3] * rs * kva[lane * 4 + 3]);
            *(u32x2*)(ckvn + (size_t)r * 256 + lane * 4) = o;
        }
        {
            float x1 = 0.f, x2 = 0.f;
            if (lane < 16) { x1 = bf2f(rr[640 + lane]); x2 = bf2f(rr[640 + 16 + lane]); }
            float ss = wave_sum(x1 * x1 + x2 * x2);
            const float rs = rsqrtf(ss * (1.0f / 32.0f) + EPS);
            if (lane < 16) {
                x1 *= rs * kn[64 + lane]; x2 *= rs * kn[64 + 16 + lane];
                if (pos < SEQ) {
                    const int prow = (pos >> 6) & 63, pcol = pos & 63;
                    const float* cs = ROPE32 + ((lane < 8 ? prow : pcol) * 8 + (lane & 7)) * 2;
                    const float c = cs[0], s = cs[1], a = x1, bb = x2;
                    x1 = a * c - bb * s; x2 = bb * c + a * s;
                }
                bf16_t* kr = (bf16_t*)(p.ws + WS_K) + (size_t)r * 1536 + 64;
                const bf16_t b1 = (bf16_t)f2bf(x1), b2 = (bf16_t)f2bf(x2);
#pragma unroll
                for (int hh = 0; hh < 16; ++hh) { kr[hh * 96 + lane] = b1; kr[hh * 96 + 16 + lane] = b2; }
            }
        }
    }
}
DI void phase_post_mla2(const Params& p, int bid, int nb, int tid) {
    const int wid = __builtin_amdgcn_readfirstlane(tid >> 6), lane = tid & 63, hd = lane >> 2, sub = lane & 3;
    const bf16_t* qraw = (const bf16_t*)(p.ws + WS_RAW);
    const bf16_t* kvraw = qraw + (size_t)MROWS * 1536;
    const bf16_t* krope = (const bf16_t*)(p.ws + WS_O) + (size_t)MROWS * 640;
    bf16_t* Q = (bf16_t*)(p.ws + WS_Q); bf16_t* Kb = (bf16_t*)(p.ws + WS_K);
    const float* qn = p.in[28]; const float* kn = p.in[29];
    const float qscale = 0.10206207261596577f * LOG2E;
    for (int r = bid * NW + wid; r < MROWS; r += nb * NW) {
        const int b = r / PP, pos = r - b * PP;
        const bf16_t* qr = qraw + (size_t)r * 1536 + hd * 96;
        bf16_t* qo = Q + (size_t)r * 1536 + hd * 96;
        {
            float a[8], c[8];
            unpack8(*(const u32x4*)(qr + sub * 16), a); unpack8(*(const u32x4*)(qr + sub * 16 + 8), c);
            float ss = 0.f;
#pragma unroll
            for (int e = 0; e < 8; ++e) ss += a[e] * a[e] + c[e] * c[e];
            ss = quad_sum(ss);
            const float rs = rsqrtf(ss * (1.0f / 64.0f) + EPS) * qscale;
#pragma unroll
            for (int e = 0; e < 8; ++e) { a[e] *= rs * qn[sub * 16 + e]; c[e] *= rs * qn[sub * 16 + 8 + e]; }
            *(u32x4*)(qo + sub * 16) = pack8(a); *(u32x4*)(qo + sub * 16 + 8) = pack8(c);
        }
        {
            const u32x2 w1 = *(const u32x2*)(qr + 64 + sub * 4), w2 = *(const u32x2*)(qr + 64 + 16 + sub * 4);
            float x1[4] = {bflo(w1.x), bfhi(w1.x), bflo(w1.y), bfhi(w1.y)}, x2[4] = {bflo(w2.x), bfhi(w2.x), bflo(w2.y), bfhi(w2.y)};
            float ss = 0.f;
#pragma unroll
            for (int e = 0; e < 4; ++e) ss += x1[e] * x1[e] + x2[e] * x2[e];
            ss = quad_sum(ss);
            const float rs = rsqrtf(ss * (1.0f / 32.0f) + EPS);
#pragma unroll
            for (int e = 0; e < 4; ++e) {
                const int i = sub * 4 + e;
                float a = x1[e] * rs * qn[64 + i], bb = x2[e] * rs * qn[64 + 16 + i];
                if (pos < SEQ) {
                    const int prow = (pos >> 6) & 63, pcol = pos & 63;
                    const float* cs = ROPE32 + ((i < 8 ? prow : pcol) * 8 + (i & 7)) * 2;
                    const float c = cs[0], s = cs[1], t1 = a, t2 = bb;
                    a = t1 * c - t2 * s; bb = t2 * c + t1 * s;
                }
                x1[e] = a * qscale; x2[e] = bb * qscale;
            }
            u32x2 o1, o2; o1.x = pk2(x1[0], x1[1]); o1.y = pk2(x1[2], x1[3]); o2.x = pk2(x2[0], x2[1]); o2.y = pk2(x2[2], x2[3]);
            *(u32x2*)(qo + 64 + sub * 4) = o1; *(u32x2*)(qo + 64 + 16 + sub * 4) = o2;
        }
        {
            const bf16_t* kr = kvraw + (size_t)r * 2048 + hd * 128;
            bf16_t* ko = Kb + (size_t)r * 1536 + hd * 96;
            float a[8], c[8];
            unpack8(*(const u32x4*)(kr + sub * 16), a); unpack8(*(const u32x4*)(kr + sub * 16 + 8), c);
            float ss = 0.f;
#pragma unroll
            for (int e = 0; e < 8; ++e) ss += a[e] * a[e] + c[e] * c[e];
            ss = quad_sum(ss);
            const float rs = rsqrtf(ss * (1.0f / 64.0f) + EPS);
#pragma unroll
            for (int e = 0; e < 8; ++e) { a[e] *= rs * kn[sub * 16 + e]; c[e] *= rs * kn[sub * 16 + 8 + e]; }
            *(u32x4*)(ko + sub * 16) = pack8(a); *(u32x4*)(ko + sub * 16 + 8) = pack8(c);
            *(u32x4*)(ko + 64 + sub * 8) = *(const u32x4*)(krope + (size_t)r * 32 + sub * 8);
        }
    }
}
DI void phase_diff_combine(const Params& p, int bid, int nb, int tid) {
    const int wid = __builtin_amdgcn_readfirstlane(tid >> 6), lane = tid & 63, hd = lane >> 3, sub = lane & 7;
    const bf16_t* O12 = (const bf16_t*)(p.ws + WS_H);
    bf16_t* Oc = (bf16_t*)(p.ws + WS_Q);
    const float* lam = p.in[34]; const float* subln = p.in[35];
    const float lambda_init = 0.8f - 0.6f * 0.40656965974059917f;
    const float s1 = wave_sum(lam[lane] * lam[64 + lane]), s2 = wave_sum(lam[128 + lane] * lam[192 + lane]);
    const float lam_full = expf(s1) - expf(s2) + lambda_init;
    for (int r = bid * NW + wid; r < MROWS; r += nb * NW) {
        const bf16_t* o1 = O12 + (size_t)r * 2048 + (2 * hd) * 128 + sub * 16, *o2 = o1 + 128;
        float a[16], c[16];
        unpack8(*(const u32x4*)o1, *(float(*)[8])a); unpack8(*(const u32x4*)(o1 + 8), *(float(*)[8])(a + 8));
        unpack8(*(const u32x4*)o2, *(float(*)[8])c); unpack8(*(const u32x4*)(o2 + 8), *(float(*)[8])(c + 8));
        float ss = 0.f;
#pragma unroll
        for (int e = 0; e < 16; ++e) { a[e] -= lam_full * c[e]; ss += a[e] * a[e]; }
        ss += __shfl_xor(ss, 1); ss += __shfl_xor(ss, 2); ss += __shfl_xor(ss, 4);
        const float rs = rsqrtf(ss * (1.0f / 128.0f) + EPS) * (1.0f - lambda_init);
#pragma unroll
        for (int e = 0; e < 16; ++e) a[e] *= rs * subln[sub * 16 + e];
        bf16_t* o = Oc + (size_t)r * 1024 + hd * 128 + sub * 16;
        *(u32x4*)o = pack8(*(float(*)[8])a); *(u32x4*)(o + 8) = pack8(*(float(*)[8])(a + 8));
    }
}


typedef short s16x4 __attribute__((ext_vector_type(4)));
typedef float f32x2_t __attribute__((ext_vector_type(2)));
typedef __bf16 bf16x2_t __attribute__((ext_vector_type(2)));
DI unsigned cvtpk(float lo, float hi) { f32x2_t v = {lo, hi}; bf16x2_t b = __builtin_convertvector(v, bf16x2_t); return __builtin_bit_cast(unsigned, b); }
DI float xhalf_max(float v) { auto rr = __builtin_amdgcn_permlane32_swap(__float_as_uint(v), __float_as_uint(v), false, false); return fmaxf(__uint_as_float(rr[0]), __uint_as_float(rr[1])); }
DI float xhalf_sum(float v) { auto rr = __builtin_amdgcn_permlane32_swap(__float_as_uint(v), __float_as_uint(v), false, false); return __uint_as_float(rr[0]) + __uint_as_float(rr[1]); }
typedef short v4i16_t __attribute__((__vector_size__(4 * sizeof(short))));
DI s16x4 lds_tr(lds_ptr p) { return __builtin_bit_cast(s16x4, __builtin_amdgcn_ds_read_tr16_b64_v4i16((LAS v4i16_t*)p)); }
constexpr float ATT_BIG = 40.0f, ATT_BIGF = 1.0995116e12f;
DI int crow(int i, int hf) { return (i & 3) + 8 * (i >> 2) + 4 * hf; }

struct AttnP { const bf16_t* Q; int ldq; const bf16_t* K; int ldk; const bf16_t* V; int ldv; bf16_t* O; int ldo; int HQ; int gk; int gv; int vhs  ; const float* bias; const float* sink; int need_ctx; const float* kgain  ; const float* lam; const float* subln; unsigned char* Oc; int ldoc;   };

template <int DQ, int DV, int MODE, int ABL = 0>
DI void attn_mfma(const AttnP& a, unsigned char* smem, int bid, int nb, int tid) {
    constexpr int KSTR = DQ * 2 + 16, KTB = 64 * KSTR, VTB = 64 * DV * 2, NDB = DV / 32, NKK = DQ / 16;
    constexpr int KCH = DQ / 8, VCH = DV / 8, NKI = (64 * KCH + NTHREADS - 1) / NTHREADS, NVI = (64 * VCH + NTHREADS - 1) / NTHREADS;
    static_assert(2 * KTB + 2 * VTB + 2048 <= GEMM_LDS, "attention LDS");
    const lds_ptr lds = (lds_ptr)smem;
    LAS float* biasl = (LAS float*)(lds + 2 * KTB + 2 * VTB);
    const int lane = tid & 63, wid = __builtin_amdgcn_readfirstlane(tid >> 6), r = lane & 31, hf = lane >> 5;
    const int nq = a.need_ctx ? 17 : 16;
    const int xcd = bid & 7, slot = bid >> 3, nslots = nb >> 3, per_xcd = (NBATCH * a.HQ / 8) * nq;
    int koff[NKI], kdst[NKI], voff[NVI], vdst[NVI];
#pragma unroll
    for (int i = 0; i < NKI; ++i) { const int c = min(tid + NTHREADS * i, 64 * KCH - 1), row = c / KCH, kc = c - row * KCH; koff[i] = row * a.ldk + kc * 8; kdst[i] = row * KSTR + kc * 16; }
#pragma unroll
    for (int i = 0; i < NVI; ++i) { const int c = tid + NTHREADS * i, row = c / VCH, vc = c - row * VCH; voff[i] = row * a.ldv + vc * 8; vdst[i] = ((row >> 3) * NDB + (vc >> 2)) * 512 + (row & 7) * 64 + (vc & 3) * 16; }
    const int i16 = lane & 15, trq = i16 >> 2, trp = i16 & 3, grp = (lane >> 4) & 1;
    const int vtr0 = (4 * hf + trq) * 64 + 32 * grp + 8 * trp;
    constexpr bool PAIRED = (MODE == 2 && DV == 128);
    float lam_full = 0.f;
    if (PAIRED) { const float s1 = wave_sum(a.lam[lane] * a.lam[64 + lane]), s2 = wave_sum(a.lam[128 + lane] * a.lam[192 + lane]); lam_full = expf(s1) - expf(s2) + (0.8f - 0.6f * 0.40656965974059917f); }
    int it_i = 0;
    for (int j = slot; j < per_xcd; j += nslots, ++it_i) {
        const int nbh = NBATCH * a.HQ / 8;
        const int bhl = j < nbh * 16 ? j >> 4 : j - nbh * 16;
        int qt = j < nbh * 16 ? j & 15 : 16;
        int bh = bhl * 8 + xcd;
        if (MODE == 1) { const int P = (bhl >> 2) * 8 + xcd; bh = (P >> 2) * a.HQ + (P & 3) * 4 + (bhl & 3); }
        if (PAIRED) { const int pu = slot + nslots * (it_i >> 1); qt = pu & 15; bh = (pu >> 4) * a.HQ + 2 * xcd + (it_i & 1); }
        const int h = bh % a.HQ, b = bh / a.HQ;
        const bool is_ctx = qt >= 16;
        const int q0 = is_ctx ? SEQ : qt * 256;
        int t_lo = 0, n_lat = 0;
        if (!is_ctx) {
            if (MODE == 2) { t_lo = 0; n_lat = 64; }
            else if (MODE == 1) { t_lo = max(0, 4 * qt - 2); n_lat = min(63, 4 * qt + 5) - t_lo + 1; }
            else { const int r0 = 4 * qt; t_lo = min(max(r0 - 4, 0), 56); n_lat = min(max(r0 - 1, 0), 56) + 7 - t_lo + 1; }
        }
        const int ntiles = n_lat + 4;
        const int qw0 = q0 + wid * 32, qpos = qw0 + r;
        const size_t qrow = (size_t)b * PP + qpos;
        bf16x8 qf[NKK];
#pragma unroll
        for (int kk = 0; kk < NKK; ++kk) qf[kk] = *(const bf16x8*)(a.Q + qrow * a.ldq + h * DQ + kk * 16 + hf * 8);
        if (MODE == 0 && !is_ctx) { for (int i = tid; i < 465; i += NTHREADS) biasl[i] = a.bias[h * 465 + i] * LOG2E; }
        const bf16_t* Kg = a.K + (size_t)b * PP * a.ldk + (h >> a.gk) * DQ;
        const bf16_t* Vg = a.V + (size_t)b * PP * a.ldv + (h >> a.gv) * a.vhs;
        f32x16 o[NDB];
#pragma unroll
        for (int d = 0; d < NDB; ++d)
#pragma unroll
            for (int i = 0; i < 16; ++i) o[d][i] = 0.f;
        float mref = 0.f, l = 0.f;
        f32x16 negm;
#pragma unroll
        for (int i = 0; i < 16; ++i) negm[i] = 0.f;
        bool first = true;
        float lbig = 0.f;
        float one = 1.0f; asm volatile("" : "+v"(one));
#define ATT_TILE(IT) ((IT) < n_lat ? t_lo + (IT) : 64 + ((IT) - n_lat))
        auto tile_active = [&](int t) -> bool {
            if (t >= 64) return true;
            if (MODE == 1) return (t * 64 + 63 >= qw0 - 128) && (t * 64 <= qw0 + 31 + 128);
            if (MODE == 0) { const int rw = qw0 >> 6, row0 = min(max(rw - 4, 0), 56); return t >= row0 && t < row0 + 8; }
            return true;
        };
        auto qk = [&](f32x16 (&s)[2], const lds_ptr Kb) {
#pragma unroll
            for (int kk = 0; kk < NKK; ++kk)
#pragma unroll
                for (int kb = 0; kb < 2; ++kb) {
                    if (ABL & 4) { if (kk == 0) s[kb] = negm; }
                    else {
                    const bf16x8 kf = *(const LAS bf16x8*)(Kb + (kb * 32 + r) * KSTR + (kk * 2 + hf) * 16);
                    s[kb] = MFMA32(kf, qf[kk], kk == 0 ? negm : s[kb]);
                    }
                }
        };
        u32x4 kr[NKI], vr[NVI];
        {
            const int t0 = ATT_TILE(0), t1 = ATT_TILE(1);
            u32x4 k1[NKI];
#pragma unroll
            for (int i = 0; i < NKI; ++i) kr[i] = *(const u32x4*)(Kg + (size_t)t0 * 64 * a.ldk + koff[i]);
#pragma unroll
            for (int i = 0; i < NVI; ++i) vr[i] = *(const u32x4*)(Vg + (size_t)t0 * 64 * a.ldv + voff[i]);
#pragma unroll
            for (int i = 0; i < NKI; ++i) k1[i] = *(const u32x4*)(Kg + (size_t)t1 * 64 * a.ldk + koff[i]);
#pragma unroll
            for (int i = 0; i < NKI; ++i) { *(LAS u32x4*)(lds + kdst[i]) = kr[i]; *(LAS u32x4*)(lds + KTB + kdst[i]) = k1[i]; }
#pragma unroll
            for (int i = 0; i < NVI; ++i) *(LAS u32x4*)(lds + 2 * KTB + vdst[i]) = vr[i];
        }
        __syncthreads();
        f32x16 sc[2], sn[2];
        bool act_cur = tile_active(ATT_TILE(0)), act_nxt = false;
        if (act_cur) qk(sc, lds);
        __syncthreads();
        auto step = [&](const int it, const int e, const bool N2, const bool N1) {
            const int t = ATT_TILE(it);
            if (N2 && !(ABL & 8) && (!(ABL & 128) || e)) {
                const int tn = ATT_TILE(it + 2);
#pragma unroll
                for (int i = 0; i < NKI; ++i) kr[i] = *(const u32x4*)(Kg + (size_t)tn * 64 * a.ldk + koff[i]);
            }
            if (N1 && !(ABL & 8) && (!(ABL & 128) || e)) {
                const int tn = ATT_TILE(it + 1);
#pragma unroll
                for (int i = 0; i < NVI; ++i) vr[i] = *(const u32x4*)(Vg + (size_t)tn * 64 * a.ldv + voff[i]);
            }
            SCHED_FENCE();
            act_nxt = N1 && (MODE == 2 || tile_active(ATT_TILE(it + 1)));
            const lds_ptr Vb = lds + 2 * KTB + e * VTB;
            const bool do_cur = MODE == 2 || act_cur;
            if (do_cur) {
                if (t < 64 && MODE == 1 && !((t * 64 + 63 - qw0 <= 128) && (qw0 + 31 - t * 64 <= 128))) {
                    const int dbase = t * 64 + 4 * hf - qpos;
#pragma unroll
                    for (int kb = 0; kb < 2; ++kb)
#pragma unroll
                        for (int i = 0; i < 16; ++i) { const int c = kb * 32 + (i & 3) + 8 * (i >> 2); sc[kb][i] = (dbase > 128 - c || dbase < -128 - c) ? -INFINITY : sc[kb][i]; }
                }
                if (t < 64 && MODE == 0) {
                    const int qc = qpos & 63, rw = qpos >> 6, col0 = min(max(qc - 8, 0), 48);
                    const int brow = (t - rw + 7) * 31 + 15 - qc;
#pragma unroll
                    for (int kb = 0; kb < 2; ++kb)
#pragma unroll
                        for (int i = 0; i < 16; ++i) {
                            const int kc = kb * 32 + crow(i, hf);
                            const bool ok = kc >= col0 && kc < col0 + 16;
                            const float bv = biasl[ok ? brow + kc : 0];
                            sc[kb][i] = ok ? sc[kb][i] + bv : -INFINITY;
                        }
                }
                if (first || __builtin_amdgcn_ballot_w64(lbig > ATT_BIGF) != 0ull) {
                    float delta = lbig > ATT_BIGF ? ATT_BIG : 0.f;
                    if (first) {
                        float mx = sc[0][0];
#pragma unroll
                        for (int i = 1; i < 16; ++i) mx = fmaxf(mx, sc[0][i]);
#pragma unroll
                        for (int i = 0; i < 16; ++i) mx = fmaxf(mx, sc[1][i]);
                        mx = xhalf_max(mx);
                        delta = mx > -INFINITY ? mx : 0.f;
                    }
                    const float alpha = __builtin_amdgcn_exp2f(-delta);
                    l *= alpha; mref += delta;
#pragma unroll
                    for (int d = 0; d < NDB; ++d)
#pragma unroll
                        for (int i = 0; i < 16; ++i) o[d][i] *= alpha;
#pragma unroll
                    for (int kb = 0; kb < 2; ++kb)
#pragma unroll
                        for (int i = 0; i < 16; ++i) sc[kb][i] -= delta;
#pragma unroll
                    for (int i = 0; i < 16; ++i) negm[i] = -mref;
                    first = false;
                }
            }
            if (N1) qk(sn, lds + (e ^ 1) * KTB);
            if (do_cur) {
                float ls0 = 0.f, ls1 = 0.f;
#pragma unroll
                for (int kb = 0; kb < 2; ++kb)
#pragma unroll
                    for (int i = 0; i < 16; i += 2) {
                        const float p0 = (ABL & 1) ? sc[kb][i] : __builtin_amdgcn_exp2f(sc[kb][i]), p1 = (ABL & 1) ? sc[kb][i + 1] : __builtin_amdgcn_exp2f(sc[kb][i + 1]);
                        sc[kb][i] = p0; sc[kb][i + 1] = p1;
                        if (!(ABL & 16)) { ls0 += p0; ls1 = __builtin_fmaf(p1, one, ls1); }
                    }
                lbig = ls0 + ls1;
                l += lbig;
                bf16x8 pf[4];
#pragma unroll
                for (int kb = 0; kb < 2; ++kb)
#pragma unroll
                    for (int sp = 0; sp < 2; ++sp) {
                        u32x4 w;
                        w.x = cvtpk(sc[kb][8 * sp], sc[kb][8 * sp + 1]); w.y = cvtpk(sc[kb][8 * sp + 2], sc[kb][8 * sp + 3]);
                        w.z = cvtpk(sc[kb][8 * sp + 4], sc[kb][8 * sp + 5]); w.w = cvtpk(sc[kb][8 * sp + 6], sc[kb][8 * sp + 7]);
                        pf[kb * 2 + sp] = __builtin_bit_cast(bf16x8, w);
                    }
#pragma unroll
                for (int ks = 0; ks < 4; ++ks)
#pragma unroll
                    for (int d = 0; d < NDB; ++d) {
                        const lds_ptr vp = Vb + ((2 * ks) * NDB + d) * 512 + vtr0;
                        const s16x4 lo = lds_tr(vp), hi = lds_tr(vp + NDB * 512);
                        const bf16x8 vf = __builtin_shufflevector(lo, hi, 0, 1, 2, 3, 4, 5, 6, 7);
                        if (ABL & 2) { if (d == 0 && ks == 0) o[0][0] += __builtin_bit_cast(float, pf[0][0] | pf[1][0] | pf[2][0] | pf[3][0]) + __builtin_bit_cast(float, (int)vf[0]); } else
                        o[d] = MFMA32(vf, pf[ks], o[d]);
                    }
            }
            SCHED_FENCE();
            if (N2 && !(ABL & 8) && (!(ABL & 128) || e)) {
#pragma unroll
                for (int i = 0; i < NKI; ++i) *(LAS u32x4*)(lds + e * KTB + kdst[i]) = kr[i];
            }
            if (N1 && !(ABL & 8) && (!(ABL & 128) || e)) {
#pragma unroll
                for (int i = 0; i < NVI; ++i) *(LAS u32x4*)(lds + 2 * KTB + (e ^ 1) * VTB + vdst[i]) = vr[i];
            }
            if (!(ABL & 64) && (!(ABL & 128) || e)) __syncthreads();
#pragma unroll
            for (int kb = 0; kb < 2; ++kb) sc[kb] = sn[kb];
            act_cur = act_nxt;
        };
        int it = 0;
        for (; it + 3 < ntiles; it += 2) { step(it, 0, true, true); step(it + 1, 1, true, true); }
        if (ntiles - it == 3) { step(it, 0, true, true); step(it + 1, 1, false, true); step(it + 2, 0, false, false); }
        else { step(it, 0, false, true); step(it + 1, 1, false, false); }
#undef ATT_TILE
        l = xhalf_sum(l);
        if (a.sink) {
            l += __builtin_amdgcn_exp2f(a.sink[h] * LOG2E - mref);
        }
        const float inv = 1.0f / l;
        bf16_t* orow = a.O + qrow * a.ldo + h * DV + 4 * hf;
#pragma unroll
        for (int d = 0; d < NDB; ++d)
#pragma unroll
            for (int g = 0; g < 4; ++g) {
                if (DV == 64) {
                    *(unsigned*)((unsigned char*)a.O + qrow * a.ldo + h * DV + 4 * hf + d * 32 + 8 * g) = cvt_fp8x4(o[d][4 * g] * inv, o[d][4 * g + 1] * inv, o[d][4 * g + 2] * inv, o[d][4 * g + 3] * inv);
                } else {
                    u32x2 w; w.x = cvtpk(o[d][4 * g] * inv, o[d][4 * g + 1] * inv); w.y = cvtpk(o[d][4 * g + 2] * inv, o[d][4 * g + 3] * inv);
                    *(u32x2*)(orow + d * 32 + 8 * g) = w;
                }
            }
        if (PAIRED && (it_i & 1)) {
            asm volatile("s_waitcnt vmcnt(0)" ::: "memory");
            const float lambda_init = 0.8f - 0.6f * 0.40656965974059917f;
            const int sub = lane & 7, pair = h >> 1;
#pragma unroll
            for (int i4 = 0; i4 < 4; ++i4) {
                const size_t row = (size_t)b * PP + qw0 + i4 * 8 + (lane >> 3);
                const bf16_t* o1 = a.O + row * a.ldo + (2 * pair) * 128 + sub * 16, *o2 = o1 + 128;
                float av[16], cv[16];
                unpack8(*(const u32x4*)o1, *(float(*)[8])av); unpack8(*(const u32x4*)(o1 + 8), *(float(*)[8])(av + 8));
                unpack8(*(const u32x4*)o2, *(float(*)[8])cv); unpack8(*(const u32x4*)(o2 + 8), *(float(*)[8])(cv + 8));
                float ss = 0.f;
#pragma unroll
                for (int e = 0; e < 16; ++e) { av[e] -= lam_full * cv[e]; ss += av[e] * av[e]; }
                ss += __shfl_xor(ss, 1); ss += __shfl_xor(ss, 2); ss += __shfl_xor(ss, 4);
                const float rs = rsqrtf(ss * (1.0f / 128.0f) + EPS) * (1.0f - lambda_init);
#pragma unroll
                for (int e = 0; e < 16; ++e) av[e] *= rs * a.subln[sub * 16 + e];
                u32x4 w8; w8.x = cvt_fp8x4(av[0], av[1], av[2], av[3]); w8.y = cvt_fp8x4(av[4], av[5], av[6], av[7]); w8.z = cvt_fp8x4(av[8], av[9], av[10], av[11]); w8.w = cvt_fp8x4(av[12], av[13], av[14], av[15]);
                *(u32x4*)(a.Oc + row * (size_t)a.ldoc + pair * 128 + sub * 16) = w8;
            }
        }
    }
}

DI void attn_na(const AttnP& a, unsigned char* smem, int bid, int nb, int tid) {
    constexpr int DQ = 64, DV = 64, KSTR = DQ * 2 + 16, KTB = 64 * KSTR, VTB = 64 * DV * 2, NDB = 2, NKK = 4;
    const lds_ptr lds = (lds_ptr)smem;
    constexpr int BZ_TAB = 32, BZ_HEAD = 560, BZ_NINF = 16 * BZ_HEAD, BZ_N = BZ_NINF + 64;
    static_assert(4 * KTB + 4 * VTB + (BZ_N + 16) * 4 <= GEMM_LDS, "NA LDS");
    LAS float* biasl = (LAS float*)(lds + 4 * KTB + 4 * VTB);
    for (int i = tid; i < BZ_N; i += NTHREADS) {
        const int hh = i / BZ_HEAD, o = i - hh * BZ_HEAD;
        biasl[i] = i >= BZ_NINF ? -INFINITY : (o >= BZ_TAB && o < BZ_TAB + 465) ? a.bias[hh * 465 + o - BZ_TAB] * LOG2E : 0.f;
    }
    __syncthreads();
    {
        const int wv = __builtin_amdgcn_readfirstlane(tid >> 6), ln = tid & 63;
#pragma unroll
        for (int hh2 = 0; hh2 < 2; ++hh2) {
            const int hh = 2 * wv + hh2;
            float m = 0.f;
            for (int i = ln; i < 465; i += 64) m = fmaxf(m, biasl[hh * BZ_HEAD + BZ_TAB + i]);
#pragma unroll
            for (int d = 32; d >= 1; d >>= 1) m = fmaxf(m, __shfl_xor(m, d));
            if (ln == 0) biasl[BZ_N + hh] = m;
        }
    }
    float kmax = fabsf(a.kgain[tid & 63]);
#pragma unroll
    for (int d = 32; d >= 1; d >>= 1) kmax = fmaxf(kmax, __shfl_xor(kmax, d));
    kmax *= 8.0f * 1.01f;
    const int lane = tid & 63, wid = __builtin_amdgcn_readfirstlane(tid >> 6), r = lane & 31, hf = lane >> 5;
    const int nq = a.need_ctx ? 17 : 16;
    const int xcd = bid & 7, slot = bid >> 3, nslots = nb >> 3, per_xcd = (NBATCH * a.HQ / 8) * nq;
    const int krow_s = tid >> 3, kc_s = tid & 7;
    const int koff = krow_s * a.ldk + kc_s * 8, kdst = krow_s * KSTR + kc_s * 16, voff = krow_s * a.ldv + kc_s * 8;
    const int vdst = ((krow_s >> 3) * NDB + (kc_s >> 2)) * 512 + (krow_s & 7) * 64 + (kc_s & 3) * 16;
    const int i16 = lane & 15, trq = i16 >> 2, trp = i16 & 3, grp = (lane >> 4) & 1;
    const int vtr0 = (4 * hf + trq) * 64 + 32 * grp + 8 * trp;
    const int rp = wid >> 2, cq = wid & 3, k0 = cq == 0 ? 0 : cq == 1 ? 8 : cq == 2 ? 24 : 32;
    float one = 1.0f; asm volatile("" : "+v"(one));
    auto unit_of = [&](int j, int& b, int& h, int& qt, int& t_lo, int& n_lat) {
        const int nbh = NBATCH * a.HQ / 8;
        const int bhl = j < nbh * 16 ? j >> 4 : j - nbh * 16; qt = j < nbh * 16 ? j & 15 : 16;
        const int bh = bhl * 8 + xcd; h = bh % a.HQ; b = bh / a.HQ;
        t_lo = 0; n_lat = 0;
        if (qt < 16) { const int r0 = 4 * qt; t_lo = min(max(r0 - 4, 0), 56); n_lat = min(max(r0 - 1, 0), 56) + 7 - t_lo + 1; n_lat += n_lat & 1; }
    };
#define NA_TILE_OF(IT, TLO, NLAT) ((IT) < (NLAT) ? (TLO) + (IT) : 64 + ((IT) - (NLAT)))
    bf16x8 qf[NKK];
    u32x4 krA[2], vrA[2], krB[2], vrB[2];
    auto load_pair = [&](u32x4 (&kr)[2], u32x4 (&vr)[2], const bf16_t* Kg, const bf16_t* Vg, int t_lo, int n_lat, int pr) {
#pragma unroll
        for (int jj = 0; jj < 2; ++jj) {
            const int tn = NA_TILE_OF(2 * pr + jj, t_lo, n_lat);
            kr[jj] = *(const u32x4*)(Kg + (size_t)tn * 64 * a.ldk + koff); vr[jj] = *(const u32x4*)(Vg + (size_t)tn * 64 * a.ldv + voff);
        }
    };
    auto store_pair = [&](const u32x4 (&kr)[2], const u32x4 (&vr)[2], int e) {
#pragma unroll
        for (int jj = 0; jj < 2; ++jj) { *(LAS u32x4*)(lds + (2 * e + jj) * KTB + kdst) = kr[jj]; *(LAS u32x4*)(lds + 4 * KTB + (2 * e + jj) * VTB + vdst) = vr[jj]; }
    };
    auto qrow_of = [&](int b, int qt) -> size_t { const int qpos = qt >= 16 ? SEQ + wid * 32 + r : (4 * qt + 2 * rp + (r >> 4)) * 64 + 16 * cq + (r & 15); return (size_t)b * PP + qpos; };
    auto load_q = [&](int b, int h, int qt) {
        const size_t qrow = qrow_of(b, qt);
#pragma unroll
        for (int kk = 0; kk < NKK; ++kk) qf[kk] = *(const bf16x8*)(a.Q + qrow * a.ldq + h * DQ + kk * 16 + hf * 8);
    };
    if (slot >= per_xcd) return;
    int b, h, qt, t_lo, n_lat;
    unit_of(slot, b, h, qt, t_lo, n_lat);
    {
        load_q(b, h, qt);
        const bf16_t* Kg = a.K + (size_t)b * PP * a.ldk + h * DQ; const bf16_t* Vg = a.V + (size_t)b * PP * a.ldv + h * a.vhs;
        load_pair(krA, vrA, Kg, Vg, t_lo, n_lat, 0); store_pair(krA, vrA, 0); load_pair(krB, vrB, Kg, Vg, t_lo, n_lat, 1);
    }
    __syncthreads();
    for (int j = slot;;) {
        const int jn = j + nslots; const bool has_next = jn < per_xcd;
        int nb_, nh, nqt, nt_lo, nn_lat;
        unit_of(has_next ? jn : j, nb_, nh, nqt, nt_lo, nn_lat);
        const bf16_t* nKg = a.K + (size_t)nb_ * PP * a.ldk + nh * DQ; const bf16_t* nVg = a.V + (size_t)nb_ * PP * a.ldv + nh * a.vhs;
        const bool is_ctx = qt >= 16;
        const int r0 = 4 * qt;
        const int npair = (n_lat + 4) >> 1;
        const int qrw = r0 + 2 * rp + (r >> 4), qc = 16 * cq + (r & 15);
        const size_t qrow = qrow_of(b, qt);
        const bf16_t* Kg = a.K + (size_t)b * PP * a.ldk + h * DQ;
        const bf16_t* Vg = a.V + (size_t)b * PP * a.ldv + h * a.vhs;
        const int rwA = r0 + 2 * rp, wlo = min(max(rwA - 4, 0), 56), whi = min(max(rwA - 3, 0), 56) + 7;
        const int col0 = min(max(qc - 8, 0), 48), row0q = min(max(qrw - 4, 0), 56);
        const int lanebase = h * BZ_HEAD + BZ_TAB + (7 - qrw) * 31 + 15 - qc + k0 + 4 * hf;
        f32x16 o[NDB];
#pragma unroll
        for (int d = 0; d < NDB; ++d)
#pragma unroll
            for (int i = 0; i < 16; ++i) o[d][i] = 0.f;
        float l = 0.f;
        float qn2 = 0.f;
#pragma unroll
        for (int kk = 0; kk < NKK; ++kk)
#pragma unroll
            for (int jj = 0; jj < 8; ++jj) { const float qv = bf2f((bf16_t)qf[kk][jj]); qn2 = __builtin_fmaf(qv, qv, qn2); }
        qn2 = xhalf_sum(qn2);
        const float mref = __builtin_sqrtf(qn2) * kmax + biasl[BZ_N + h];
        f32x16 negmL;
#pragma unroll
        for (int i = 0; i < 16; ++i) { const int kc = k0 + crow(i, hf); negmL[i] = (kc >= col0 && kc < col0 + 16) ? -mref : -INFINITY; }
#define NA_TILE(IT) NA_TILE_OF(IT, t_lo, n_lat)
        auto ctx_tile = [&](const lds_ptr Kb, const lds_ptr Vb) {
            {
                f32x16 s[2], negm;
#pragma unroll
                for (int i = 0; i < 16; ++i) negm[i] = -mref;
#pragma unroll
                for (int kk = 0; kk < NKK; ++kk)
#pragma unroll
                    for (int kb = 0; kb < 2; ++kb) {
                        const bf16x8 kf = *(const LAS bf16x8*)(Kb + (kb * 32 + r) * KSTR + (kk * 2 + hf) * 16);
                        s[kb] = MFMA32(kf, qf[kk], kk == 0 ? negm : s[kb]);
                    }
                float ls0 = 0.f, ls1 = 0.f;
                bf16x8 pf[4];
#pragma unroll
                for (int kb = 0; kb < 2; ++kb) {
#pragma unroll
                    for (int i = 0; i < 16; i += 2) {
                        const float p0 = __builtin_amdgcn_exp2f(s[kb][i]), p1 = __builtin_amdgcn_exp2f(s[kb][i + 1]);
                        s[kb][i] = p0; s[kb][i + 1] = p1; ls0 += p0; ls1 = __builtin_fmaf(p1, one, ls1);
                    }
#pragma unroll
                    for (int sp = 0; sp < 2; ++sp) {
                        u32x4 w;
                        w.x = cvtpk(s[kb][8 * sp], s[kb][8 * sp + 1]); w.y = cvtpk(s[kb][8 * sp + 2], s[kb][8 * sp + 3]);
                        w.z = cvtpk(s[kb][8 * sp + 4], s[kb][8 * sp + 5]); w.w = cvtpk(s[kb][8 * sp + 6], s[kb][8 * sp + 7]);
                        pf[kb * 2 + sp] = __builtin_bit_cast(bf16x8, w);
                    }
                }
                l += ls0 + ls1;
#pragma unroll
                for (int ks = 0; ks < 4; ++ks)
#pragma unroll
                    for (int d = 0; d < NDB; ++d) {
                        const lds_ptr vp = Vb + ((2 * ks) * NDB + d) * 512 + vtr0;
                        const s16x4 lo = lds_tr(vp), hi = lds_tr(vp + NDB * 512);
                        o[d] = MFMA32(__builtin_shufflevector(lo, hi, 0, 1, 2, 3, 4, 5, 6, 7), pf[ks], o[d]);
                    }
            }
        };
        auto lat_tile = [&](const int t, const lds_ptr Kb, const lds_ptr Vb) {
            bf16x8 pf[2];
#pragma unroll
            for (int sp = 0; sp < 2; ++sp)
#pragma unroll
                for (int jj = 0; jj < 8; ++jj) pf[sp][jj] = 0;
            if (t >= wlo && t <= whi) {
                f32x16 s;
#pragma unroll
                for (int kk = 0; kk < NKK; ++kk) {
                    const bf16x8 kf = *(const LAS bf16x8*)(Kb + (k0 + r) * KSTR + (kk * 2 + hf) * 16);
                    s = MFMA32(kf, qf[kk], kk == 0 ? negmL : s);
                }
                const LAS float* bp = biasl + (((unsigned)(t - row0q) < 8u) ? lanebase + 31 * t : BZ_NINF);
#pragma unroll
                for (int i = 0; i < 16; ++i) s[i] += bp[crow(i, 0)];
                float ls0 = 0.f, ls1 = 0.f;
#pragma unroll
                for (int i = 0; i < 16; i += 2) {
                    const float p0 = __builtin_amdgcn_exp2f(s[i]), p1 = __builtin_amdgcn_exp2f(s[i + 1]);
                    s[i] = p0; s[i + 1] = p1; ls0 += p0; ls1 = __builtin_fmaf(p1, one, ls1);
                }
#pragma unroll
                for (int sp = 0; sp < 2; ++sp) {
                    u32x4 w;
                    w.x = cvtpk(s[8 * sp], s[8 * sp + 1]); w.y = cvtpk(s[8 * sp + 2], s[8 * sp + 3]);
                    w.z = cvtpk(s[8 * sp + 4], s[8 * sp + 5]); w.w = cvtpk(s[8 * sp + 6], s[8 * sp + 7]);
                    pf[sp] = __builtin_bit_cast(bf16x8, w);
                }
                l += ls0 + ls1;
            }
#pragma unroll
            for (int ks = 0; ks < 2; ++ks)
#pragma unroll
                for (int d = 0; d < NDB; ++d) {
                    const lds_ptr vp = Vb + (((k0 >> 3) + 2 * ks) * NDB + d) * 512 + vtr0;
                    const s16x4 lo = lds_tr(vp), hi = lds_tr(vp + NDB * 512);
                    o[d] = MFMA32(__builtin_shufflevector(lo, hi, 0, 1, 2, 3, 4, 5, 6, 7), pf[ks], o[d]);
                }
        };
#define NA_ITER(IP, E, KL, VL, KS, VS, LAT) do { \
            if ((IP) + 2 < npair) load_pair(KL, VL, Kg, Vg, t_lo, n_lat, (IP) + 2); \
            else if (has_next) load_pair(KL, VL, nKg, nVg, nt_lo, nn_lat, (IP) + 2 - npair); \
            SCHED_FENCE(); \
            if (LAT) { lat_tile(t_lo + 2 * (IP), lds + (2 * (E)) * KTB, lds + 4 * KTB + (2 * (E)) * VTB); lat_tile(t_lo + 2 * (IP) + 1, lds + (2 * (E) + 1) * KTB, lds + 4 * KTB + (2 * (E) + 1) * VTB); } \
            else { ctx_tile(lds + (2 * (E)) * KTB, lds + 4 * KTB + (2 * (E)) * VTB); ctx_tile(lds + (2 * (E) + 1) * KTB, lds + 4 * KTB + (2 * (E) + 1) * VTB); } \
            SCHED_FENCE(); \
            if ((IP) + 1 < npair || has_next) store_pair(KS, VS, (E) ^ 1); \
            __syncthreads(); } while (0)
        int ip = 0;
        for (; ip < (n_lat >> 1); ip += 2) { NA_ITER(ip, 0, krA, vrA, krB, vrB, true); NA_ITER(ip + 1, 1, krB, vrB, krA, vrA, true); }
        NA_ITER(ip, 0, krA, vrA, krB, vrB, false); NA_ITER(ip + 1, 1, krB, vrB, krA, vrA, false);
#undef NA_ITER
        if (has_next) load_q(nb_, nh, nqt);
#undef NA_TILE
        l = xhalf_sum(l);
        const float inv = 1.0f / l;
#pragma unroll
        for (int d = 0; d < NDB; ++d)
#pragma unroll
            for (int g = 0; g < 4; ++g)
                *(unsigned*)((unsigned char*)a.O + qrow * a.ldo + h * DV + 4 * hf + d * 32 + 8 * g) = cvt_fp8x4(o[d][4 * g] * inv, o[d][4 * g + 1] * inv, o[d][4 * g + 2] * inv, o[d][4 * g + 3] * inv);
        if (!has_next) break;
        j = jn; b = nb_; h = nh; qt = nqt; t_lo = nt_lo; n_lat = nn_lat;
    }
#undef NA_TILE_OF
}

template <class E> struct epi_fp8 { static constexpr int value = 0; };
typedef int v8i_t __attribute__((ext_vector_type(8)));
typedef int v4i_t __attribute__((ext_vector_type(4)));
namespace pg8 {
constexpr int BM = 256, BK = 64, HALF = 128, HTB = HALF * BK * 2  ;
DI int lds_byte(int r, int c) { const int st = (r >> 4) * 2 + (c >> 5), rr = r & 15, cc = c & 31, ob = rr * 64 + cc * 2; return st * 1024 + (ob ^ (((ob >> 9) & 1) << 5)); }
DI void stage_rc(int b, int& R, int& C) { const int st = b / 1024, sb = b % 1024, swz = sb ^ (((sb >> 9) & 1) << 5); R = (st >> 1) * 16 + swz / 64; C = (st & 1) * 32 + (swz % 64) / 2; }
DI int perm32(int rho) { const int n = rho >> 4, i = rho & 15; return 8 * (i >> 2) + 4 * n + (i & 3); }

template <class Epi, class Sched>
DI void gemm_phase(lds_ptr lds, const bf16_t* __restrict__ Aop, const int K, const Sched& S, const Epi& E, const int tid) {
    const int wid = __builtin_amdgcn_readfirstlane(tid >> 6), lane = tid & 63, wr = wid >> 2, wc = wid & 3, fr = lane & 15, fq = lane >> 4;
    const int nt = K / BK;
    int Ra[2], Ca[2]; unsigned voffB[2];
#pragma unroll
    for (int i = 0; i < 2; ++i) { int R, C; stage_rc(tid * 16 + i * 8192, R, C); const int Rb = Epi::PERM ? ((R & ~31) + perm32(R & 31)) : R;
        Ra[i] = R; Ca[i] = C; voffB[i] = (unsigned)(Rb * K + C) * 2u; }
    const size_t kstep = (size_t)(BK * 2);
    const size_t hstep = (size_t)HALF * K * 2;
    const unsigned ldsw = (unsigned)wid * 1024u;
    const int aoff = lds_byte(wr * 64 + fr, fq * 8), boff = lds_byte(wc * 32 + fr, fq * 8);
#define PG8_SA(b, h) (((b) * 2 + (h)) * HTB)
#define PG8_SB(b, h) ((4 + (b) * 2 + (h)) * HTB)
#define PG8_STAGE(bufoff, gbase, voff) do { const char* _gb = (const char*)(gbase); asm volatile("" : "+s"(_gb)); _Pragma("unroll") for (int _i = 0; _i < 2; ++_i) { \
        unsigned _o = (voff)[_i]; asm volatile("" : "+v"(_o)); \
        __builtin_amdgcn_global_load_lds((const unsigned*)(_gb + _o), (LAS unsigned*)(lds + (bufoff) + ldsw + _i * 8192), 16, 0, 0); } } while (0)
#define PG8_LDA(dst, b, h) do { _Pragma("unroll") for (int m = 0; m < 4; ++m) _Pragma("unroll") for (int k = 0; k < 2; ++k) dst[m][k] = *(const LAS bf16x8*)(lds + PG8_SA(b, h) + aoff + m * 2048 + k * 1024); } while (0)
#define PG8_LDB(dst, b, h) do { _Pragma("unroll") for (int n = 0; n < 2; ++n) _Pragma("unroll") for (int k = 0; k < 2; ++k) dst[n][k] = *(const LAS bf16x8*)(lds + PG8_SB(b, h) + boff + n * 2048 + k * 1024); } while (0)
typedef long i64x2_t __attribute__((ext_vector_type(2)));
#define PG8_MMA(ai, bj, At, Bt) do { __builtin_amdgcn_s_setprio(1); _Pragma("unroll") for (int m = 0; m < 4; ++m) _Pragma("unroll") for (int n = 0; n < 2; ++n) { \
        if (epi_fp8<Epi>::value == 2) { \
            const v8i_t _b = __builtin_shufflevector(__builtin_bit_cast(v4i_t, Bt[n][0]), __builtin_bit_cast(v4i_t, Bt[n][1]), 0, 1, 2, 3, 4, 5, 6, 7); \
            const v8i_t _a = __builtin_shufflevector(__builtin_bit_cast(v4i_t, At[m][0]), __builtin_bit_cast(v4i_t, At[m][1]), 0, 1, 2, 3, 4, 5, 6, 7); \
            acc[ai][bj][m][n] = __builtin_amdgcn_mfma_scale_f32_16x16x128_f8f6f4(_b, _a, acc[ai][bj][m][n], 0, 0, 0, 0, 0, 0); \
        } else { _Pragma("unroll") for (int k = 0; k < 2; ++k) { \
        if (epi_fp8<Epi>::value == 1) { const i64x2_t _b = __builtin_bit_cast(i64x2_t, Bt[n][k]), _a = __builtin_bit_cast(i64x2_t, At[m][k]); \
            acc[ai][bj][m][n] = __builtin_amdgcn_mfma_f32_16x16x32_fp8_fp8(_b[0], _a[0], acc[ai][bj][m][n], 0, 0, 0); \
            acc[ai][bj][m][n] = __builtin_amdgcn_mfma_f32_16x16x32_fp8_fp8(_b[1], _a[1], acc[ai][bj][m][n], 0, 0, 0); } \
        else acc[ai][bj][m][n] = __builtin_amdgcn_mfma_f32_16x16x32_bf16(Bt[n][k], At[m][k], acc[ai][bj][m][n], 0, 0, 0); } } } \
        __builtin_amdgcn_s_setprio(0); } while (0)
#define PG8_WAIT_V(n) asm volatile("s_waitcnt vmcnt(" #n ")" ::: "memory")
#define PG8_WAIT_L(n) asm volatile("s_waitcnt lgkmcnt(" #n ")" ::: "memory")
#define PG8_BAR __builtin_amdgcn_s_barrier()
#define PG8_SCHED __builtin_amdgcn_sched_barrier(0)
    typename Sched::Unit cur, nxt; int ui = 0;
    if (!S.next(0, cur)) return;
    f32x4 acc[2][2][4][2];
#pragma unroll
    for (int a = 0; a < 2; ++a)
#pragma unroll
        for (int b = 0; b < 2; ++b)
#pragma unroll
            for (int m = 0; m < 4; ++m)
#pragma unroll
                for (int n = 0; n < 2; ++n) acc[a][b][m][n] = (f32x4){0.f, 0.f, 0.f, 0.f};
    bf16x8 At[4][2], B0[2][2], B1[2][2];
    constexpr bool GATHER = Sched::GATHER;
    unsigned oc[2][2], on[2][2] = {{0u, 0u}, {0u, 0u}};
    size_t ubc[2] = {0, 0}, ubn[2] = {0, 0};
#pragma unroll
    for (int h = 0; h < 2; ++h) {
        if (!GATHER) ubc[h] = (size_t)S.a_off(cur, h * HALF) * 2u;
#pragma unroll
        for (int i = 0; i < 2; ++i) oc[h][i] = GATHER ? (S.a_off(cur, h * HALF + Ra[i]) + (unsigned)Ca[i]) * 2u : (unsigned)(Ra[i] * S.lda + Ca[i]) * 2u;
    }
    const char* gA = (const char*)Aop;
    const char* cB = (const char*)S.b_base(cur);
    PG8_STAGE(PG8_SB(0, 0), cB, voffB); PG8_STAGE(PG8_SB(0, 1), cB + hstep, voffB); PG8_STAGE(PG8_SA(0, 0), gA + ubc[0], oc[0]); PG8_STAGE(PG8_SA(0, 1), gA + ubc[1], oc[1]);
    if (wr == 1) PG8_BAR;
    PG8_WAIT_V(2); PG8_BAR;
    PG8_STAGE(PG8_SB(1, 0), cB + kstep, voffB); PG8_STAGE(PG8_SA(1, 0), gA + ubc[0] + kstep, oc[0]); PG8_STAGE(PG8_SB(1, 1), cB + hstep + kstep, voffB);
    PG8_WAIT_V(6); PG8_BAR;
    for (;;) {
        const bool has_next = S.next(ui + 1, nxt);
        const char* nB = has_next ? (const char*)S.b_base(nxt) : cB;
#pragma unroll
        for (int h = 0; h < 2; ++h) {
            if (!GATHER) ubn[h] = has_next ? (size_t)S.a_off(nxt, h * HALF) * 2u : ubc[h];
#pragma unroll
            for (int i = 0; i < 2; ++i) if (GATHER) { int R, C; stage_rc(((wid << 6) | lane_now()) * 16 + i * 8192, R, C);
                const unsigned* ip = S.a_ptr(nxt, h * HALF + R); if (epi_fp8<Epi>::value != 2) asm volatile("global_load_dword %0, %1, off" : "=v"(on[h][i]) : "v"(ip) : "memory"); }
        }
        const bool full = cur.half < 0;
        for (int t = 0; t < nt; t += 2) {
            const bool last = (t == nt - 2);
            const char* a1 = gA + (size_t)(t + 1) * kstep;
            const char* a2 = last ? gA : gA + (size_t)(t + 2) * kstep; const char* b2 = last ? nB : cB + (size_t)(t + 2) * kstep;
            const char* a3 = a2 + kstep; const char* b3 = b2 + kstep;
            size_t u2[2];
            if (GATHER && last) {
                if (epi_fp8<Epi>::value != 2) asm volatile("" : "+v"(on[0][0]), "+v"(on[0][1]), "+v"(on[1][0]), "+v"(on[1][1]));
#pragma unroll
                for (int i = 0; i < 2; ++i) { int R, C; stage_rc(((wid << 6) | lane_now()) * 16 + i * 8192, R, C);
                    if (epi_fp8<Epi>::value == 2) { on[0][i] = *S.a_ptr(nxt, R); on[1][i] = *S.a_ptr(nxt, HALF + R); }
                    oc[0][i] = (S.a_cvt(on[0][i]) + (unsigned)C) * 2u; on[1][i] = (S.a_cvt(on[1][i]) + (unsigned)C) * 2u; }
            }
#pragma unroll
            for (int h = 0; h < 2; ++h) u2[h] = last ? ubn[h] : ubc[h];
            PG8_LDB(B0, 0, 0); PG8_LDB(B1, 0, 1); PG8_SCHED; PG8_LDA(At, 0, 0); PG8_STAGE(PG8_SA(1, 1), a1 + ubc[1], oc[1]);
            if (GATHER && last) { oc[1][0] = on[1][0]; oc[1][1] = on[1][1]; }
            PG8_WAIT_V(8); PG8_WAIT_L(0); PG8_BAR; PG8_MMA(0, 0, At, B0); PG8_MMA(0, 1, At, B1); PG8_BAR; PG8_SCHED;
            PG8_LDA(At, 0, 1); PG8_STAGE(PG8_SB(0, 0), b2, voffB); PG8_STAGE(PG8_SB(0, 1), b2 + hstep, voffB); PG8_STAGE(PG8_SA(0, 0), a2 + u2[0], oc[0]);
            PG8_WAIT_V(8); PG8_WAIT_L(0); PG8_BAR; if (full) { PG8_MMA(1, 0, At, B0); PG8_MMA(1, 1, At, B1); } PG8_BAR; PG8_SCHED;
            PG8_LDB(B0, 1, 0); PG8_LDB(B1, 1, 1); PG8_SCHED; PG8_LDA(At, 1, 0); PG8_STAGE(PG8_SA(0, 1), a2 + u2[1], oc[1]);
            PG8_WAIT_V(8); PG8_WAIT_L(0); PG8_BAR; PG8_MMA(0, 0, At, B0); PG8_MMA(0, 1, At, B1); PG8_BAR; PG8_SCHED;
            PG8_LDA(At, 1, 1); PG8_STAGE(PG8_SB(1, 0), b3, voffB); PG8_STAGE(PG8_SB(1, 1), b3 + hstep, voffB); PG8_STAGE(PG8_SA(1, 0), a3 + u2[0], oc[0]);
            PG8_WAIT_V(8); PG8_WAIT_L(0); PG8_BAR; if (full) { PG8_MMA(1, 0, At, B0); PG8_MMA(1, 1, At, B1); } PG8_BAR; PG8_SCHED;
        }
        if (wr == 0) PG8_BAR;
        { const int ln = lane_now(); E(acc, cur, wr, wc, ln & 15, ln >> 4); }
        if (!has_next) break;
#pragma unroll
        for (int a = 0; a < 2; ++a)
#pragma unroll
            for (int b = 0; b < 2; ++b)
#pragma unroll
                for (int m = 0; m < 4; ++m)
#pragma unroll
                    for (int n = 0; n < 2; ++n) acc[a][b][m][n] = (f32x4){0.f, 0.f, 0.f, 0.f};
        cur = nxt; cB = nB; ++ui;
#pragma unroll
        for (int h = 0; h < 2; ++h) ubc[h] = ubn[h];
        if (wr == 1) PG8_BAR;
    }
    PG8_WAIT_V(0);
    PG8_BAR;
#undef PG8_SA
#undef PG8_SB
#undef PG8_STAGE
#undef PG8_LDA
#undef PG8_LDB
#undef PG8_MMA
#undef PG8_WAIT_V
#undef PG8_WAIT_L
#undef PG8_BAR
#undef PG8_SCHED
}
}

struct DenseSched {
    static constexpr bool GATHER = false;
    struct Unit { int pm, pn, half; };
    int nM, nN, nwg, G, c; const bf16_t* Bt; int K, lda; bool skip_ctx;
    DI void unit_of(int L, Unit& u) const {
        int wgid = L; { const int q = nwg / 8, r = nwg % 8, xcd = wgid % 8, off = wgid / 8; wgid = (xcd < r ? xcd * (q + 1) : r * (q + 1) + (xcd - r) * q) + off; }
        const int nig = 8 * nN, gid = wgid / nig, fm = gid * 8, gsz = (nM - fm) < 8 ? (nM - fm) : 8;
        u.pm = fm + ((wgid % nig) % gsz); u.pn = (wgid % nig) / gsz;
        if (skip_ctx) u.pm += u.pm >> 4;
    }
    DI bool next(int i, Unit& u) const {
        const int rounds = nwg / G, rem = nwg - rounds * G;
        if (i < rounds) { unit_of(i * G + c, u); u.half = -1; return true; }
        if (i > rounds || rem == 0) return false;
        if (2 * rem <= G) { if (c >= 2 * rem) return false; unit_of(rounds * G + (c >> 1), u); u.half = c & 1; return true; }
        if (c >= rem) return false;
        unit_of(rounds * G + c, u); u.half = -1; return true;
    }
    DI unsigned a_off(const Unit& u, int row) const { const int rr = u.half < 0 ? row : u.half * 128 + (row & 127); return (unsigned)(u.pm * 256 + rr) * (unsigned)lda; }
    DI const unsigned* a_ptr(const Unit&, int) const { return nullptr; }
    DI unsigned a_cvt(unsigned raw) const { return raw; }
    DI const bf16_t* b_base(const Unit& u) const { return Bt + (size_t)u.pn * 256 * K; }
};
struct MoeUnit { int e, pn, valid, half; const unsigned* ent; };
template <bool TAIL>
struct MoeSched {
    static constexpr bool GATHER = true;
    typedef MoeUnit Unit;
    const LAS int* tab; const unsigned* list; const unsigned* zero  ; const bf16_t* W; int K, N, TN, lda, shift, G, c, nwg;
    DI bool unit_of(int L, Unit& u) const {
        const int v = tab[1 + (lane_now() & 31)];
        const int e = __builtin_popcount((unsigned)__ballot(v <= L));
        if (e >= NEXP) return false;
        const int rem = L - __builtin_amdgcn_readfirstlane(tab[e]), cn = __builtin_amdgcn_readfirstlane(tab[40 + e]);
        const int rt = rem / TN; u.e = e; u.pn = rem - rt * TN; u.ent = list + (size_t)e * MROWS + rt * 256; u.valid = min(256, cn - rt * 256); return true;
    }
    int lo, n, GX, j;
    DI void place() { GX = G >> 3; j = c >> 3; const int per = ((((nwg + 7) >> 3) + TN - 1) / TN) * TN; lo = (c & 7) * per; n = max(0, min(per, nwg - lo)); }
    DI bool next(int i, Unit& u) const {
        u.ent = zero; u.valid = 1;
        const int rounds = n / GX, rem = n - rounds * GX;
        if (!TAIL) { u.half = -1; if (i >= rounds) return false; return unit_of(lo + i * GX + j, u); }
        if (i > 0 || rem == 0) return false;
        if (2 * rem <= GX) {
            if (j >= 2 * rem) return false;
            if (!unit_of(lo + rounds * GX + (j >> 1), u)) return false;
            u.half = j & 1; u.ent += u.half * 128; u.valid = min(128, u.valid - u.half * 128);
            return u.valid > 0;
        }
        u.half = -1; if (j >= rem) return false;
        return unit_of(lo + rounds * GX + j, u);
    }
    DI unsigned a_off(const Unit& u, int row) const { const int rr = (TAIL && u.half >= 0) ? (row & 127) : row; return (u.ent[rr < u.valid ? rr : u.valid - 1] >> shift) * (unsigned)lda; }
    DI const unsigned* a_ptr(const Unit& u, int row) const { const int rr = (TAIL && u.half >= 0) ? (row & 127) : row; return u.ent + (rr < u.valid ? rr : u.valid - 1); }
    DI unsigned a_cvt(unsigned raw) const { return (raw >> shift) * (unsigned)lda; }
    DI const bf16_t* b_base(const Unit& u) const { return W + ((size_t)u.e * N + (size_t)u.pn * 256) * K; }
};
typedef float f32x4_t __attribute__((ext_vector_type(4)));
struct XEpiStore {
    static constexpr bool PERM = true;
    bf16_t* C; int ldc;
    DI void operator()(const f32x4 (&acc)[2][2][4][2], const DenseSched::Unit& u, int wr, int wc, int fr, int fq) const {
        const int row0 = u.pm * 256 + (u.half > 0 ? 128 : 0) + wr * 64 + fr, col0 = u.pn * 256 + wc * 32 + 8 * fq;
#pragma unroll
        for (int ai = 0; ai < 2; ++ai) if (ai == 0 || u.half < 0)
#pragma unroll
            for (int m = 0; m < 4; ++m) { bf16_t* rowp = C + (size_t)(row0 + ai * 128 + m * 16) * ldc + col0;
#pragma unroll
                for (int bj = 0; bj < 2; ++bj) { const f32x4 v0 = acc[ai][bj][m][0], v1 = acc[ai][bj][m][1];
                    u32x4 w; w.x = cvtpk(v0[0], v0[1]); w.y = cvtpk(v0[2], v0[3]); w.z = cvtpk(v1[0], v1[1]); w.w = cvtpk(v1[2], v1[3]);
                    *(u32x4*)(rowp + bj * 128) = w; } }
    } };
struct XEpiStore8 {
    static constexpr bool PERM = true;
    bf16_t* C; int ldc;
    DI void operator()(const f32x4 (&acc)[2][2][4][2], const DenseSched::Unit& u, int wr, int wc, int fr, int fq) const {
        const int row0 = u.pm * 256 + (u.half > 0 ? 128 : 0) + wr * 64 + fr, col0 = u.pn * 256 + wc * 32 + 8 * fq;
#pragma unroll
        for (int ai = 0; ai < 2; ++ai) if (ai == 0 || u.half < 0)
#pragma unroll
            for (int m = 0; m < 4; ++m) { bf16_t* rowp = C + (size_t)(row0 + ai * 128 + m * 16) * ldc + col0;
#pragma unroll
                for (int bj = 0; bj < 2; ++bj) { const f32x4 v0 = acc[ai][bj][m][0] * (1.0f / 32.0f), v1 = acc[ai][bj][m][1] * (1.0f / 32.0f);
                    u32x4 w; w.x = cvtpk(v0[0], v0[1]); w.y = cvtpk(v0[2], v0[3]); w.z = cvtpk(v1[0], v1[1]); w.w = cvtpk(v1[2], v1[3]);
                    *(u32x4*)(rowp + bj * 128) = w; } }
    } };
template <> struct epi_fp8<XEpiStore8> { static constexpr int value = 2; };
struct XEpiResid {
    static constexpr bool PERM = true;
    const Params* p; const float* mod;
    DI void operator()(const f32x4 (&acc)[2][2][4][2], const DenseSched::Unit& u, int wr, int wc, int fr, int fq) const {
        const int row0 = u.pm * 256 + (u.half > 0 ? 128 : 0) + wr * 64 + fr, col0 = u.pn * 256 + wc * 32 + 8 * fq;
#pragma unroll
        for (int ai = 0; ai < 2; ++ai) if (ai == 0 || u.half < 0)
#pragma unroll
            for (int m = 0; m < 4; ++m) { const int row = row0 + ai * 128 + m * 16;
                bf16_t* xr = xb_row(*p, row) + col0; const float* gp = mod + (size_t)mod_row(row) * 6144 + 2048 + col0;
#pragma unroll
                for (int bj = 0; bj < 2; ++bj) {
                    const u32x4 xw = *(const u32x4*)(xr + bj * 128); const f32x4 g0 = *(const f32x4*)(gp + bj * 128), g1 = *(const f32x4*)(gp + bj * 128 + 4);
                    const f32x4 a0 = acc[ai][bj][m][0], a1 = acc[ai][bj][m][1];
                    u32x4 w;
                    w.x = cvtpk(bflo(xw.x) + g0[0] * a0[0], bfhi(xw.x) + g0[1] * a0[1]); w.y = cvtpk(bflo(xw.y) + g0[2] * a0[2], bfhi(xw.y) + g0[3] * a0[3]);
                    w.z = cvtpk(bflo(xw.z) + g1[0] * a1[0], bfhi(xw.z) + g1[1] * a1[1]); w.w = cvtpk(bflo(xw.w) + g1[2] * a1[2], bfhi(xw.w) + g1[3] * a1[3]);
                    *(u32x4*)(xr + bj * 128) = w; } }
    } };
struct XEpiResid8 {
    static constexpr bool PERM = true;
    const Params* p; const float* mod;
    DI void operator()(const f32x4 (&acc)[2][2][4][2], const DenseSched::Unit& u, int wr, int wc, int fr, int fq) const {
        const int row0 = u.pm * 256 + (u.half > 0 ? 128 : 0) + wr * 64 + fr, col0 = u.pn * 256 + wc * 32 + 8 * fq;
#pragma unroll
        for (int ai = 0; ai < 2; ++ai) if (ai == 0 || u.half < 0)
#pragma unroll
            for (int m = 0; m < 4; ++m) { const int row = row0 + ai * 128 + m * 16;
                bf16_t* xr = xb_row(*p, row) + col0; const float* gp = mod + (size_t)mod_row(row) * 6144 + 2048 + col0;
#pragma unroll
                for (int bj = 0; bj < 2; ++bj) {
                    const u32x4 xw = *(const u32x4*)(xr + bj * 128); const f32x4 g0 = *(const f32x4*)(gp + bj * 128) * (1.0f / 32.0f), g1 = *(const f32x4*)(gp + bj * 128 + 4) * (1.0f / 32.0f);
                    const f32x4 a0 = acc[ai][bj][m][0], a1 = acc[ai][bj][m][1];
                    u32x4 w;
                    w.x = cvtpk(bflo(xw.x) + g0[0] * a0[0], bfhi(xw.x) + g0[1] * a0[1]); w.y = cvtpk(bflo(xw.y) + g0[2] * a0[2], bfhi(xw.y) + g0[3] * a0[3]);
                    w.z = cvtpk(bflo(xw.z) + g1[0] * a1[0], bfhi(xw.z) + g1[1] * a1[1]); w.w = cvtpk(bflo(xw.w) + g1[2] * a1[2], bfhi(xw.w) + g1[3] * a1[3]);
                    *(u32x4*)(xr + bj * 128) = w; } }
    } };
template <> struct epi_fp8<XEpiResid8> { static constexpr int value = 2; };
struct XEpiGlu {
    static constexpr bool PERM = true;
    bf16_t* act; const float* gates;
    DI void operator()(const f32x4 (&acc)[2][2][4][2], const MoeUnit& u, int wr, int wc, int fr, int fq) const {
#pragma unroll
        for (int ai = 0; ai < 2; ++ai)
#pragma unroll
            for (int m = 0; m < 4; ++m) { const int i = ai * 128 + wr * 64 + m * 16 + fr;
                if (i < u.valid) { const unsigned a = u.ent[i]; const float gw = gates[a];
                    const f32x4 g0 = acc[ai][0][m][0], g1 = acc[ai][0][m][1], u0 = acc[ai][1][m][0], u1 = acc[ai][1][m][1];
                    float v[8];
#pragma unroll
                    for (int j = 0; j < 4; ++j) { v[j] = silu_f(g0[j]) * u0[j] * gw; v[4 + j] = silu_f(g1[j]) * u1[j] * gw; }
                    u32x4 w; w.x = cvtpk(v[0], v[1]); w.y = cvtpk(v[2], v[3]); w.z = cvtpk(v[4], v[5]); w.w = cvtpk(v[6], v[7]);
                    *(u32x4*)(act + (size_t)a * DEXP + u.pn * 128 + wc * 32 + 8 * fq) = w; } }
    } };
struct XEpiGlu8 : XEpiGlu {
    DI void operator()(const f32x4 (&acc)[2][2][4][2], const MoeUnit& u, int wr, int wc, int fr, int fq) const {
#pragma unroll
        for (int ai = 0; ai < 2; ++ai)
#pragma unroll
            for (int m = 0; m < 4; ++m) { const int i = ai * 128 + wr * 64 + m * 16 + fr;
                if (i < u.valid) { const unsigned a = u.ent[i]; const float gw = gates[a] * (1.0f / 32.0f);
                    const f32x4 g0 = acc[ai][0][m][0] * (1.0f / 32.0f), g1 = acc[ai][0][m][1] * (1.0f / 32.0f), u0 = acc[ai][1][m][0], u1 = acc[ai][1][m][1];
                    float v[8];
#pragma unroll
                    for (int j = 0; j < 4; ++j) { v[j] = silu_f(g0[j]) * u0[j] * gw; v[4 + j] = silu_f(g1[j]) * u1[j] * gw; }
                    u32x4 w; w.x = cvtpk(v[0], v[1]); w.y = cvtpk(v[2], v[3]); w.z = cvtpk(v[4], v[5]); w.w = cvtpk(v[6], v[7]);
                    *(u32x4*)(act + (size_t)a * DEXP + u.pn * 128 + wc * 32 + 8 * fq) = w; } }
    } };
template <> struct epi_fp8<XEpiGlu8> { static constexpr int value = 2; };
struct XEpiScatter {
    static constexpr bool PERM = true;
    bf16_t* outp;
    DI void operator()(const f32x4 (&acc)[2][2][4][2], const MoeUnit& u, int wr, int wc, int fr, int fq) const {
#pragma unroll
        for (int ai = 0; ai < 2; ++ai)
#pragma unroll
            for (int m = 0; m < 4; ++m) { const int i = ai * 128 + wr * 64 + m * 16 + fr;
                if (i < u.valid) { unsigned char* rowp = (unsigned char*)outp + (size_t)u.ent[i] * 1024 + u.pn * 256 + wc * 32 + 8 * fq;
#pragma unroll
                    for (int bj = 0; bj < 2; ++bj) { const f32x4 v0 = acc[ai][bj][m][0] * 16.f, v1 = acc[ai][bj][m][1] * 16.f;
                        u32x2 w; w.x = cvt_fp8x4(v0[0], v0[1], v0[2], v0[3]); w.y = cvt_fp8x4(v1[0], v1[1], v1[2], v1[3]);
                        *(u32x2*)(rowp + bj * 128) = w; } } }
    } };

template <int KIND>
struct XEpiQKV {
    static constexpr bool PERM = true;
    static constexpr int KW = KIND == 1 ? 256 : 1024, LDRAW = KIND == 1 ? 1536 : 3072;
    static constexpr float ASC = 1.0f / 32.0f;
    bf16_t* Q; bf16_t* Kb; bf16_t* RAW; const float* qn; const float* kn;
    DI void operator()(const f32x4 (&acc)[2][2][4][2], const DenseSched::Unit& u, int wr, int wc, int fr, int fq) const {
        const int col0 = u.pn * 256, row0 = u.pm * 256 + (u.half > 0 ? 128 : 0) + wr * 64 + fr;
        if (col0 >= 1024 + KW) {
#pragma unroll
            for (int ai = 0; ai < 2; ++ai) if (ai == 0 || u.half < 0)
#pragma unroll
                for (int m = 0; m < 4; ++m) { bf16_t* rowp = RAW + (size_t)(row0 + ai * 128 + m * 16) * LDRAW + col0 + wc * 32 + 8 * fq;
#pragma unroll
                    for (int bj = 0; bj < 2; ++bj) { const f32x4 v0 = acc[ai][bj][m][0] * ASC, v1 = acc[ai][bj][m][1] * ASC;
                        u32x4 w; w.x = cvtpk(v0[0], v0[1]); w.y = cvtpk(v0[2], v0[3]); w.z = cvtpk(v1[0], v1[1]); w.w = cvtpk(v1[2], v1[3]);
                        *(u32x4*)(rowp + bj * 128) = w; } }
            return;
        }
        const bool isq = col0 < 1024;
        const int head = isq ? 4 * u.pn + wc : ((col0 - 1024) >> 6) + wc;
        const float* gain = (isq ? qn : kn) + 8 * fq;
        const float scale = isq ? 0.125f * LOG2E : 1.0f;
        bf16_t* dstb = isq ? Q + head * 64 + 8 * fq : Kb + head * 64 + 8 * fq;
        const int ldd = isq ? 1024 : KW;
        f32x4 g[2][2];
#pragma unroll
        for (int bj = 0; bj < 2; ++bj)
#pragma unroll
            for (int n = 0; n < 2; ++n) g[bj][n] = *(const f32x4*)(gain + 32 * bj + 4 * n);
#pragma unroll
        for (int ai = 0; ai < 2; ++ai) if (ai == 0 || u.half < 0)
#pragma unroll
            for (int m = 0; m < 4; ++m) {
                const int row = row0 + ai * 128 + m * 16, b = row / PP, pos = row - b * PP;
                f32x4 v[2][2];
                float ss = 0.f;
#pragma unroll
                for (int bj = 0; bj < 2; ++bj)
#pragma unroll
                    for (int n = 0; n < 2; ++n) { v[bj][n] = acc[ai][bj][m][n] * ASC; ss += v[bj][n][0] * v[bj][n][0] + v[bj][n][1] * v[bj][n][1] + v[bj][n][2] * v[bj][n][2] + v[bj][n][3] * v[bj][n][3]; }
                ss += __shfl_xor(ss, 16); ss += __shfl_xor(ss, 32);
                const float rs = rsqrtf(ss * (1.0f / 64.0f) + EPS);
#pragma unroll
                for (int bj = 0; bj < 2; ++bj)
#pragma unroll
                    for (int n = 0; n < 2; ++n) v[bj][n] = v[bj][n] * rs * g[bj][n];
                if (KIND != 0 && pos < SEQ) {
                    const int prow = (pos >> 6) & 63, pcol = pos & 63;
                    const float* cs = ROPE64 + ((fq < 2 ? prow : pcol) * 16 + ((8 * fq) & 15)) * 2;
#pragma unroll
                    for (int n = 0; n < 2; ++n)
#pragma unroll
                        for (int j = 0; j < 4; ++j) {
                            const float c = cs[(4 * n + j) * 2], sn = cs[(4 * n + j) * 2 + 1], x1 = v[0][n][j], x2 = v[1][n][j];
                            v[0][n][j] = x1 * c - x2 * sn; v[1][n][j] = x2 * c + x1 * sn;
                        }
                }
                bf16_t* rowp = dstb + (size_t)row * ldd;
#pragma unroll
                for (int bj = 0; bj < 2; ++bj) { const f32x4 v0 = v[bj][0] * scale, v1 = v[bj][1] * scale;
                    u32x4 w; w.x = cvtpk(v0[0], v0[1]); w.y = cvtpk(v0[2], v0[3]); w.z = cvtpk(v1[0], v1[1]); w.w = cvtpk(v1[2], v1[3]);
                    *(u32x4*)(rowp + bj * 32) = w; }
            }
    } };
constexpr bool qkv_fp8(int kind) { return true; }
template <int KIND> struct epi_fp8<XEpiQKV<KIND>> { static constexpr int value = 2; };
template <int KIND>
DI void gemm_qkv_x(const Params& p, unsigned char* smem, const bf16_t* Wt, int N, const float* qn, const float* kn, int bid, int nb, int tid) {
    constexpr int KU = qkv_fp8(KIND) ? 512 : 1024;
    DenseSched S; S.nM = MROWS / 256; S.nN = N / 256; S.nwg = S.nM * S.nN; S.G = nb; S.c = bid; S.Bt = Wt; S.K = KU; S.lda = KU; S.skip_ctx = false;
    XEpiQKV<KIND> e{(bf16_t*)(p.ws + WS_Q), (bf16_t*)(p.ws + WS_K), (bf16_t*)(p.ws + WS_RAW), qn, kn};
    pg8::gemm_phase((lds_ptr)smem, (const bf16_t*)(p.ws + WS_H), KU, S, e, tid);
}
template <bool UQ>
struct XEpiMla {
    static constexpr bool PERM = true;
    bf16_t* Q; bf16_t* Kb; bf16_t* V; const float* qn; const float* kn;
    DI void operator()(const f32x4 (&acc)[2][2][4][2], const DenseSched::Unit& u, int wr, int wc, int fr, int fq) const {
        const int row0 = u.pm * 256 + (u.half > 0 ? 128 : 0) + wr * 64 + fr;
        if (u.pn < 4) {
            const int head = 4 * u.pn + wc;
            const float* gain = (UQ ? qn : kn) + 8 * fq;
            const float scale = UQ ? 0.10206207261596577f * LOG2E : 1.0f;
            bf16_t* dstb = (UQ ? Q : Kb) + head * 96 + 8 * fq;
            f32x4 g[2][2];
#pragma unroll
            for (int bj = 0; bj < 2; ++bj)
#pragma unroll
                for (int n = 0; n < 2; ++n) g[bj][n] = *(const f32x4*)(gain + 32 * bj + 4 * n);
#pragma unroll
            for (int ai = 0; ai < 2; ++ai) if (ai == 0 || u.half < 0)
#pragma unroll
                for (int m = 0; m < 4; ++m) {
                    const int row = row0 + ai * 128 + m * 16;
                    float ss = 0.f;
#pragma unroll
                    for (int bj = 0; bj < 2; ++bj)
#pragma unroll
                        for (int n = 0; n < 2; ++n) { const f32x4 v = acc[ai][bj][m][n]; ss += v[0] * v[0] + v[1] * v[1] + v[2] * v[2] + v[3] * v[3]; }
                    ss += __shfl_xor(ss, 16); ss += __shfl_xor(ss, 32);
                    const float rs = rsqrtf(ss * (1.0f / 64.0f) + EPS) * scale;
                    bf16_t* rowp = dstb + (size_t)row * 1536;
#pragma unroll
                    for (int bj = 0; bj < 2; ++bj) { const f32x4 v0 = acc[ai][bj][m][0] * rs * g[bj][0], v1 = acc[ai][bj][m][1] * rs * g[bj][1];
                        u32x4 w; w.x = cvtpk(v0[0], v0[1]); w.y = cvtpk(v0[2], v0[3]); w.z = cvtpk(v1[0], v1[1]); w.w = cvtpk(v1[2], v1[3]);
                        *(u32x4*)(rowp + bj * 32) = w; }
                }
        } else if (UQ) {
            const float scale = 0.10206207261596577f * LOG2E;
            const f32x4 g1 = *(const f32x4*)(qn + 64 + 4 * fq), g2 = *(const f32x4*)(qn + 64 + 16 + 4 * fq);
#pragma unroll
            for (int ai = 0; ai < 2; ++ai) if (ai == 0 || u.half < 0)
#pragma unroll
                for (int m = 0; m < 4; ++m) {
                    const int row = row0 + ai * 128 + m * 16, b = row / PP, pos = row - b * PP;
                    const int prow = (pos >> 6) & 63, pcol = pos & 63;
                    const float* cs = ROPE32 + ((fq < 2 ? prow : pcol) * 8 + ((4 * fq) & 7)) * 2;
#pragma unroll
                    for (int bj = 0; bj < 2; ++bj) {
                        f32x4 x1 = acc[ai][bj][m][0], x2 = acc[ai][bj][m][1];
                        float ss = x1[0] * x1[0] + x1[1] * x1[1] + x1[2] * x1[2] + x1[3] * x1[3] + x2[0] * x2[0] + x2[1] * x2[1] + x2[2] * x2[2] + x2[3] * x2[3];
                        ss += __shfl_xor(ss, 16); ss += __shfl_xor(ss, 32);
                        const float rs = rsqrtf(ss * (1.0f / 32.0f) + EPS);
                        x1 = x1 * rs * g1; x2 = x2 * rs * g2;
                        if (pos < SEQ) {
#pragma unroll
                            for (int j = 0; j < 4; ++j) { const float c = cs[2 * j], sn = cs[2 * j + 1], a1 = x1[j], a2 = x2[j]; x1[j] = a1 * c - a2 * sn; x2[j] = a2 * c + a1 * sn; }
                        }
                        x1 = x1 * scale; x2 = x2 * scale;
                        bf16_t* rowp = Q + (size_t)row * 1536 + (8 * (u.pn - 4) + 4 * bj + wc) * 96 + 64 + 4 * fq;
                        u32x2 w1, w2; w1.x = cvtpk(x1[0], x1[1]); w1.y = cvtpk(x1[2], x1[3]); w2.x = cvtpk(x2[0], x2[1]); w2.y = cvtpk(x2[2], x2[3]);
                        *(u32x2*)rowp = w1; *(u32x2*)(rowp + 16) = w2;
                    }
                }
        } else {
#pragma unroll
            for (int ai = 0; ai < 2; ++ai) if (ai == 0 || u.half < 0)
#pragma unroll
                for (int m = 0; m < 4; ++m) { bf16_t* rowp = V + (size_t)(row0 + ai * 128 + m * 16) * 1024 + (u.pn - 4) * 256 + wc * 32 + 8 * fq;
#pragma unroll
                    for (int bj = 0; bj < 2; ++bj) { const f32x4 v0 = acc[ai][bj][m][0], v1 = acc[ai][bj][m][1];
                        u32x4 w; w.x = cvtpk(v0[0], v0[1]); w.y = cvtpk(v0[2], v0[3]); w.z = cvtpk(v1[0], v1[1]); w.w = cvtpk(v1[2], v1[3]);
                        *(u32x4*)(rowp + bj * 128) = w; } }
        }
    } };
template <bool UQ>
DI void gemm_mla_x(const Params& p, unsigned char* smem, int bid, int nb, int tid) {
    bf16_t* O = (bf16_t*)(p.ws + WS_O);
    DenseSched S; S.nM = MROWS / 256; S.nN = (UQ ? 1536 : 2048) / 256; S.nwg = S.nM * S.nN; S.G = nb; S.c = bid; S.Bt = (const bf16_t*)(p.ws + (UQ ? W_UQ : W_UKV)); S.K = UQ ? 384 : 256; S.lda = S.K; S.skip_ctx = false;
    XEpiMla<UQ> e{(bf16_t*)(p.ws + WS_Q), (bf16_t*)(p.ws + WS_K), (bf16_t*)(p.ws + WS_RAW), p.in[28], p.in[29]};
    pg8::gemm_phase((lds_ptr)smem, UQ ? O : O + (size_t)MROWS * 384, S.K, S, e, tid);
}
template <int EPIK>
DI void gemm_dense_x(const Params& p, unsigned char* smem, const bf16_t* A, int lda, const bf16_t* Wt, int K, int N, bf16_t* C, int ldc, const float* mod, int bid, int nb, int tid, bool skip_ctx = false) {
    DenseSched S; S.nM = skip_ctx ? NBATCH * 16 : MROWS / 256; S.nN = N / 256; S.nwg = S.nM * S.nN; S.G = nb; S.c = bid; S.Bt = Wt; S.K = K; S.lda = lda; S.skip_ctx = skip_ctx;
    if (EPIK == 0) { XEpiStore e{C, ldc}; pg8::gemm_phase((lds_ptr)smem, A, K, S, e, tid); }
    else if (EPIK == 2) { XEpiStore8 e{C, ldc}; pg8::gemm_phase((lds_ptr)smem, A, K, S, e, tid); }
    else if (EPIK == 3) { XEpiResid8 e{&p, mod}; pg8::gemm_phase((lds_ptr)smem, A, K, S, e, tid); }
    else { XEpiResid e{&p, mod}; pg8::gemm_phase((lds_ptr)smem, A, K, S, e, tid); }
}
template <int WHICH, bool TAIL>
DI void gemm_moe_call(const Params& p, unsigned char* smem, int layer, int bid, int nb, int tid) {
    MoeSched<TAIL> S; S.list = (const unsigned*)(p.ws + WS_LIST); S.zero = (const unsigned*)(p.ws + WS_CTL) + 8192; S.G = nb; S.c = bid;
    {
        LAS int* tab = (LAS int*)(smem + GEMM_LDS);
        constexpr int TNc = WHICH == 0 ? 2 : 4;
        if (tid < 64) {
            const unsigned cv = tid < 32 ? ((const unsigned*)(p.ws + WS_CTL) + CW_CNT + layer * 32)[tid] : 0u;
            int incl = (int)((cv + 255u) >> 8) * TNc;
#pragma unroll
            for (int d = 1; d < 32; d <<= 1) { const int o = __shfl_up(incl, d); if (tid >= d) incl += o; }
            if (tid < 32) { tab[1 + tid] = incl; tab[40 + tid] = (int)cv; }
            if (tid == 0) tab[0] = 0;
        }
        __syncthreads();
        S.tab = tab; S.nwg = __builtin_amdgcn_readfirstlane(tab[32]);
    }
    if (WHICH == 0) { S.W = (const bf16_t*)(p.ws + W_GU + (size_t)layer * 32 * 512 * 1024); S.K = 512; S.N = 512; S.TN = 2; S.lda = 512; S.shift = 1;
        S.place(); XEpiGlu8 e{{(bf16_t*)(p.ws + WS_Q), (const float*)(p.ws + WS_GATE)}}; pg8::gemm_phase((lds_ptr)smem, (const bf16_t*)(p.ws + WS_H), 512, S, e, tid); }
    else { S.W = (const bf16_t*)(p.ws + W_DN) + (size_t)layer * 32 * 1024 * 256; S.K = 256; S.N = 1024; S.TN = 4; S.lda = DEXP; S.shift = 0;
        S.place(); XEpiScatter e{(bf16_t*)(p.ws + WS_RAW)}; pg8::gemm_phase((lds_ptr)smem, (const bf16_t*)(p.ws + WS_Q), 256, S, e, tid); }
}
template <int WHICH>
DI void gemm_moe_x(const Params& p, unsigned char* smem, int layer, int bid, int nb, int tid) {
    const int wv = __builtin_amdgcn_readfirstlane(tid >> 6);
    gemm_moe_call<WHICH, false>(p, smem, layer, bid, nb, (wv << 6) | lane_now());
    gemm_moe_call<WHICH, true>(p, smem, layer, bid, nb, (wv << 6) | lane_now());
}

constexpr int NPHASES = 2 + (7 + 7 + 9 + 7) + 1;
constexpr int SMEM_BYTES = GEMM_LDS + 512;

template <int KIND>
DI void layer_phases(const Params& p, int& ph, const int lo, const int hi, const XcdBarrier& bar, unsigned char* smem, int bid, int nb, int wid_u) {
    constexpr int L = KIND;
    const float* mod = (const float*)(p.ws + WS_MOD) + (size_t)L * 9 * 6144;
    bf16_t* H = (bf16_t*)(p.ws + WS_H); bf16_t* O = (bf16_t*)(p.ws + WS_O); bf16_t* RAW = (bf16_t*)(p.ws + WS_RAW);
    bf16_t* Q = (bf16_t*)(p.ws + WS_Q); bf16_t* Kb = (bf16_t*)(p.ws + WS_K);
#ifndef AABL
#define AABL 0
#endif
#ifndef GPROBE
#define GPROBE 0
#endif
#ifndef DUP_MASK
#define DUP_MASK 0ull
#endif
#define PHASE2(BODY, DUPBODY) do { if (lo <= ph && ph < hi) { const int tid = (wid_u << 6) | lane_now(); if ((DUP_MASK >> ph) & 1ull) { DUPBODY; xcd_barrier(bar, tid == 0); } BODY; } if (lo <= ph && ph + 1 < hi) xcd_barrier(bar, ((wid_u << 6) | lane_now()) == 0); ++ph; } while (0)
#define PHASE(...) PHASE2((__VA_ARGS__), (__VA_ARGS__))
    if (L == 0) PHASE(phase_rows<2 | 8 | 32>(p, L, 0, bid, nb, tid), phase_router_prep(p, bid, nb, tid));
    else PHASE2((phase_rows<3 | 32>(p, L, 0, bid, nb, tid)), (phase_rows<2 | 32>(p, L, 0, bid, nb, tid)));
    AttnP a{};
    if (KIND == 0) {
        PHASE(gemm_qkv_x<0>(p, smem, (const bf16_t*)(p.ws + W_QKV0), 3072, p.in[15], p.in[16], bid, nb, tid));
        a = AttnP{Q, 1024, Kb, 1024, RAW + 2048, 3072, O, 1024, 16, 0, 0, 64, p.in[17], nullptr, 1, p.in[16]};
        PHASE(attn_na(a, smem, bid, nb, tid));
        PHASE2((gemm_dense_x<3>(p, smem, O, 512, (const bf16_t*)(p.ws + W_O0), 512, 1024, nullptr, 0, mod, bid, nb, tid)), (gemm_dense_x<0>(p, smem, O, 1024, (const bf16_t*)(p.ws + W_O0), 1024, 1024, RAW, 1024, nullptr, bid, nb, tid)));
    } else if (KIND == 1) {
        PHASE(gemm_qkv_x<1>(p, smem, (const bf16_t*)(p.ws + W_QKV1), 1536, p.in[20], p.in[21], bid, nb, tid));
        a = AttnP{Q, 1024, Kb, 256, RAW + 1280, 1536, O, 1024, 16, 2, 2, 64, nullptr, p.in[22], 1};
        PHASE(attn_mfma<64, 64, 1>(a, smem, bid, nb, tid));
        PHASE2((gemm_dense_x<3>(p, smem, O, 512, (const bf16_t*)(p.ws + W_O1), 512, 1024, nullptr, 0, mod, bid, nb, tid)), (gemm_dense_x<0>(p, smem, O, 1024, (const bf16_t*)(p.ws + W_O1), 1024, 1024, RAW, 1024, nullptr, bid, nb, tid)));
    } else if (KIND == 2) {
        bf16_t* cqn = O; bf16_t* ckvn = O + (size_t)MROWS * 384;
        PHASE(gemm_dense_x<2>(p, smem, H, 512, (const bf16_t*)(p.ws + W_DQKV), 512, 768, Q, 768, nullptr, bid, nb, tid));
        PHASE(phase_post_mla1(p, bid, nb, tid));
        PHASE(gemm_mla_x<true>(p, smem, bid, nb, tid), gemm_mla_x<false>(p, smem, bid, nb, (wid_u << 6) | lane_now()));
        a = AttnP{Q, 1536, Kb, 1536, RAW, 1024, O, 1024, 16, 0, 0, 64, nullptr, nullptr, 1};
        PHASE(attn_mfma<96, 64, 2>(a, smem, bid, nb, tid));
        PHASE2((gemm_dense_x<3>(p, smem, O, 512, (const bf16_t*)(p.ws + W_O2), 512, 1024, nullptr, 0, mod, bid, nb, tid)), (gemm_dense_x<0>(p, smem, O, 1024, (const bf16_t*)(p.ws + W_O2), 1024, 1024, RAW, 1024, nullptr, bid, nb, tid)));
    } else {
        PHASE(gemm_qkv_x<3>(p, smem, (const bf16_t*)(p.ws + W_QKV3), 3072, p.in[32], p.in[33], bid, nb, tid));
        a = AttnP{Q, 1024, Kb, 1024, RAW + 2048, 3072, H  , 2048, 16, 0, 1, 128, nullptr, nullptr, 0, nullptr, p.in[34], p.in[35], (unsigned char*)RAW  , 6144};
        PHASE(attn_mfma<64, 128, 2>(a, smem, bid, nb, tid));
        PHASE(gemm_dense_x<3>(p, smem, RAW, 3072, (const bf16_t*)(p.ws + W_O3), 512, 1024, nullptr, 0, mod, bid, nb, tid, true));
    }
    PHASE(phase_router(p, smem, L, L == 3, bid, nb, tid));
    PHASE(gemm_moe_x<0>(p, smem, L, bid, nb, tid));
    PHASE(gemm_moe_x<1>(p, smem, L, bid, nb, tid));
}

__global__ void __launch_bounds__(NTHREADS, 2) mega(Params p, int lo, int hi) {
    extern __shared__ __attribute__((aligned(16))) unsigned char smem[];
    const int bid = blockIdx.x, nb = gridDim.x, wid_u = __builtin_amdgcn_readfirstlane(threadIdx.x >> 6);
    float* lds = (float*)smem;
    volatile LAS unsigned* xbw = (volatile LAS unsigned*)(smem + SMEM_BYTES - 16);
    if (threadIdx.x == 0) { xbw[0] = 0u; xbw[1] = 0u; }
    __syncthreads();
    XcdBarrier bar = xcd_barrier_post((unsigned*)(p.ws + WS_CTL), xbw);
    int ph = 0;
    PHASE(phase_prologue(p, lds, bid, nb, tid));
    PHASE(phase_mod_reduce(p, bid, nb, tid));
    layer_phases<0>(p, ph, lo, hi, bar, smem, bid, nb, wid_u);
    layer_phases<1>(p, ph, lo, hi, bar, smem, bid, nb, wid_u);
    layer_phases<2>(p, ph, lo, hi, bar, smem, bid, nb, wid_u);
    layer_phases<3>(p, ph, lo, hi, bar, smem, bid, nb, wid_u);
    PHASE2((phase_rows<1 | 16>(p, 3, 0, bid, nb, tid)), (void)0);
}

extern "C" void kernel_launch(void* const* d_in, const int* in_sizes, int n_in, void* d_out, int out_size, void* d_ws, size_t ws_size, hipStream_t stream) {
    (void)in_sizes; (void)out_size;
    if (n_in < 37 || ws_size < WS_END) { fprintf(stderr, "kernel_launch: unexpected inputs (n_in %d, ws %zu)\n", n_in, ws_size); return; }
    static int grid = 0;
    if (!grid) {
        int dev = 0, cus = 0, per_cu = 0;
        hipGetDevice(&dev);
        hipDeviceGetAttribute(&cus, hipDeviceAttributeMultiprocessorCount, dev);
        hipFuncSetAttribute((const void*)mega, hipFuncAttributeMaxDynamicSharedMemorySize, SMEM_BYTES);
        hipOccupancyMaxActiveBlocksPerMultiprocessor(&per_cu, mega, NTHREADS, SMEM_BYTES);
        if (per_cu < 1) per_cu = 1;
        grid = cus * (per_cu < 1 ? per_cu : 1);
    }
    Params p{};
    for (int i = 0; i < 37; ++i) p.in[i] = (const float*)d_in[i];
    p.out = (float*)d_out; p.ws = (unsigned char*)d_ws;
    hipMemsetAsync(p.ws + WS_CTL, 0, 65536, stream);
#if ONE_LAUNCH
    hipLaunchKernelGGL(mega, dim3(grid), dim3(NTHREADS), SMEM_BYTES, stream, p, 0, NPHASES);
#else
    for (int k = 0; k < NPHASES; ++k) hipLaunchKernelGGL(mega, dim3(grid), dim3(NTHREADS), SMEM_BYTES, stream, p, k, k + 1);
#endif
}
```

```cpp
#include <hip/hip_runtime.h>
#include <stdint.h>
#include <stdio.h>

#ifndef ONE_LAUNCH
#define ONE_LAUNCH 1
#endif

#define DI __device__ __forceinline__
typedef unsigned short bf16_t;
typedef short bf16x8 __attribute__((ext_vector_type(8)));
typedef float f32x4 __attribute__((ext_vector_type(4)));
typedef float f32x16 __attribute__((ext_vector_type(16)));
typedef unsigned u32x4 __attribute__((ext_vector_type(4)));
typedef unsigned u32x2 __attribute__((ext_vector_type(2)));

constexpr int DM = 1024, NBATCH = 8, SEQ = 4096, CTXL = 256, PP = SEQ + CTXL, MROWS = NBATCH * PP;
constexpr int NEXP = 32, DEXP = 256;
constexpr float EPS = 1e-6f, LOG2E = 1.4426950408889634f;
constexpr int NTHREADS = 512, NW = NTHREADS / 64;

constexpr size_t MiB = 1ull << 20;
constexpr size_t WS_RAW_FWD = 380ull << 20;
constexpr size_t WS_CTL = 0, CTL_BYTES = 1 * MiB;
constexpr size_t WS_MOD = 1 * MiB;
constexpr size_t WS_MODP = WS_RAW_FWD;
constexpr size_t WS_XCTX = 9 * MiB;
constexpr size_t WS_LIST = 17 * MiB;
constexpr size_t WS_GATE = 22 * MiB;
constexpr size_t WS_W = 24 * MiB;
constexpr size_t W_QKV0 = WS_W + 0 * MiB, W_O0 = WS_W + 6 * MiB, W_QKV1 = WS_W + 8 * MiB, W_O1 = WS_W + 11 * MiB, W_DQKV = WS_W + 13 * MiB,
                 W_UQ = WS_W + 15 * MiB, W_UKV = WS_W + 17 * MiB, W_O2 = WS_W + 18 * MiB, W_QKV3 = WS_W + 20 * MiB, W_O3 = WS_W + 26 * MiB,
                 W_GU = WS_W + 28 * MiB, W_DN = WS_W + 156 * MiB;
constexpr size_t WS_H = 244 * MiB;
constexpr size_t WS_O = 312 * MiB;
constexpr size_t WS_RAW = 380 * MiB;
constexpr size_t WS_Q = 620 * MiB;
constexpr size_t WS_K = 722 * MiB;
constexpr size_t WS_XB = 824 * MiB;
constexpr size_t WS_END = 892 * MiB;
constexpr int CW_CNT = 4096;

constexpr size_t WS_RW = 2 * MiB;
struct Params { const float* in[37]; float* out; unsigned char* ws; };

DI unsigned f2bf(float f) { unsigned u = __float_as_uint(f); return (u + 0x7fffu + ((u >> 16) & 1u)) >> 16; }
DI float bf2f(unsigned h) { return __uint_as_float(h << 16); }
DI unsigned pk2(float lo, float hi) { return f2bf(lo) | (f2bf(hi) << 16); }
DI float bflo(unsigned w) { return __uint_as_float(w << 16); }
DI float bfhi(unsigned w) { return __uint_as_float(w & 0xffff0000u); }
DI int lane_now() { unsigned lane; asm volatile("v_mbcnt_lo_u32_b32 %0, -1, 0\n\tv_mbcnt_hi_u32_b32 %0, -1, %0" : "=v"(lane)); return (int)lane; }
DI float wave_sum(float v) {
#pragma unroll
    for (int o = 32; o > 0; o >>= 1) v += __shfl_xor(v, o);
    return v;
}
DI float silu_f(float x) { return x / (1.0f + __expf(-x)); }
DI void unpack8(const u32x4 w, float (&f)[8]) {
    f[0] = bflo(w.x); f[1] = bfhi(w.x); f[2] = bflo(w.y); f[3] = bfhi(w.y); f[4] = bflo(w.z); f[5] = bfhi(w.z); f[6] = bflo(w.w); f[7] = bfhi(w.w);
}
DI u32x4 pack8(const float (&f)[8]) { u32x4 w; w.x = pk2(f[0], f[1]); w.y = pk2(f[2], f[3]); w.z = pk2(f[4], f[5]); w.w = pk2(f[6], f[7]); return w; }
DI float* xrow_ptr(const Params& p, int r) {
    const int b = r / PP, pos = r - b * PP;
    return pos < SEQ ? p.out + ((size_t)b * SEQ + pos) * DM : (float*)(p.ws + WS_XCTX) + ((size_t)b * CTXL + (pos - SEQ)) * DM;
}
DI bf16_t* xb_row(const Params& p, int r) { return (bf16_t*)(p.ws + WS_XB) + (size_t)r * DM; }
DI int mod_row(int r) { const int b = r / PP, pos = r - b * PP; return pos < SEQ ? b : 8; }
__device__ const float ROPE64[2048] = {
  1.000000000e+00f, 0.000000000e+00f, 1.000000000e+00f, 0.000000000e+00f, 1.000000000e+00f, 0.000000000e+00f, 1.000000000e+00f, 0.000000000e+00f,
  1.000000000e+00f, 0.000000000e+00f, 1.000000000e+00f, 0.000000000e+00f, 1.000000000e+00f, 0.000000000e+00f, 1.000000000e+00f, 0.000000000e+00f,
  1.000000000e+00f, 0.000000000e+00f, 1.000000000e+00f, 0.000000000e+00f, 1.000000000e+00f, 0.000000000e+00f, 1.000000000e+00f, 0.000000000e+00f,
  1.000000000e+00f, 0.000000000e+00f, 1.000000000e+00f, 0.000000000e+00f, 1.000000000e+00f, 0.000000000e+00f, 1.000000000e+00f, 0.000000000e+00f,
  5.403022766e-01f, 8.414709568e-01f, 8.460091352e-01f, 5.331684351e-01f, 9.504152536e-01f, 3.109835982e-01f, 9.842302203e-01f, 1.768921912e-01f,
  9.950041771e-01f, 9.983342141e-02f, 9.984192848e-01f, 5.620449781e-02f, 9.995000362e-01f, 3.161750361e-02f, 9.998418689e-01f, 1.778185740e-02f,
  9.999499917e-01f, 9.999833070e-03f, 9.999842048e-01f, 5.623383448e-03f, 9.999949932e-01f, 3.162272274e-03f, 9.999983907e-01f, 1.778278500e-03f,
  9.999995232e-01f, 9.999999311e-04f, 9.999998212e-01f, 5.623412435e-04f, 9.999999404e-01f, 3.162277571e-04f, 1.000000000e+00f, 1.778279402e-04f,
  -4.161468446e-01f, 9.092974067e-01f, 4.314628243e-01f, 9.021307230e-01f, 8.065783978e-01f, 5.911270976e-01f, 9.374182820e-01f, 3.482052684e-01f,
  9.800665975e-01f, 1.986693293e-01f, 9.936820865e-01f, 1.122313142e-01f, 9.980006814e-01f, 6.320339441e-02f, 9.993675947e-01f, 3.555808961e-02f,
  9.998000264e-01f, 1.999866590e-02f, 9.999367595e-01f, 1.124658901e-02f, 9.999799728e-01f, 6.324512884e-03f, 9.999936819e-01f, 3.556551412e-03f,
  9.999979734e-01f, 1.999998698e-03f, 9.999993443e-01f, 1.124682371e-03f, 9.999998212e-01f, 6.324554561e-04f, 9.999999404e-01f, 3.556558804e-04f,
  -9.899924994e-01f, 1.411200017e-01f, -1.159661636e-01f, 9.932531714e-01f, 5.827536583e-01f, 8.126488924e-01f, 8.610406518e-01f, 5.085361004e-01f,
  9.553365111e-01f, 2.955202162e-01f, 9.858034849e-01f, 1.679033041e-01f, 9.955033660e-01f, 9.472608566e-02f, 9.985772967e-01f, 5.332308263e-02f,
  9.995500445e-01f, 2.999549918e-02f, 9.998577237e-01f, 1.686943881e-02f, 9.999549985e-01f, 9.486690164e-03f, 9.999857545e-01f, 5.334813148e-03f,
  9.999955297e-01f, 2.999995602e-03f, 9.999985695e-01f, 1.687023090e-03f, 9.999995232e-01f, 9.486831259e-04f, 9.999998808e-01f, 5.334838061e-04f,
  -6.536436081e-01f, -7.568024993e-01f, -6.276797056e-01f, 7.784717083e-01f, 3.011374772e-01f, 9.535807371e-01f, 7.575061917e-01f, 6.528279781e-01f,
  9.210609794e-01f, 3.894183338e-01f, 9.748082757e-01f, 2.230444849e-01f, 9.920106530e-01f, 1.261540651e-01f, 9.974712729e-01f, 7.107120752e-02f,
  9.992001057e-01f, 3.998933360e-02f, 9.997470379e-01f, 2.249175683e-02f, 9.999200106e-01f, 1.264877338e-02f, 9.999747276e-01f, 7.113057654e-03f,
  9.999920130e-01f, 3.999989480e-03f, 9.999974966e-01f, 2.249363344e-03f, 9.999992251e-01f, 1.264910679e-03f, 9.999997616e-01f, 7.113117026e-04f,
  2.836622000e-01f, -9.589242935e-01f, -9.460792542e-01f, 3.239352703e-01f, -1.034233812e-02f, 9.999465346e-01f, 6.300802827e-01f, 7.765299678e-01f,
  8.775825500e-01f, 4.794255495e-01f, 9.607312679e-01f, 2.774805427e-01f, 9.875259995e-01f, 1.574558765e-01f, 9.960497618e-01f, 8.879686147e-02f,
  9.987502694e-01f, 4.997916520e-02f, 9.996047616e-01f, 2.811336145e-02f, 9.998750091e-01f, 1.581072807e-02f, 9.999604821e-01f, 8.891279809e-03f,
  9.999874830e-01f, 4.999979399e-03f, 9.999960661e-01f, 2.811702900e-03f, 9.999987483e-01f, 1.581138116e-03f, 9.999995828e-01f, 8.891395992e-04f,
  9.601702690e-01f, -2.794154882e-01f, -9.731037021e-01f, -2.303675115e-01f, -3.207964003e-01f, 9.471482038e-01f, 4.827820361e-01f, 8.757405281e-01f,
  8.253356218e-01f, 5.646424890e-01f, 9.436169863e-01f, 3.310393095e-01f, 9.820539355e-01f, 1.886002719e-01f, 9.943132997e-01f, 1.064944416e-01f,
  9.982005358e-01f, 5.996400490e-02f, 9.994308352e-01f, 3.373407945e-02f, 9.998199940e-01f, 1.897252724e-02f, 9.999430776e-01f, 1.066947449e-02f,
  9.999819994e-01f, 5.999964196e-03f, 9.999943376e-01f, 3.374041524e-03f, 9.999982119e-01f, 1.897365320e-03f, 9.999994040e-01f, 1.066967379e-03f,
  7.539022565e-01f, 6.569865942e-01f, -7.004297972e-01f, -7.137212753e-01f, -5.994374752e-01f, 8.004215956e-01f, 3.202570081e-01f, 9.473307133e-01f,
  7.648422122e-01f, 6.442176700e-01f, 9.235194325e-01f, 3.835515678e-01f, 9.755998850e-01f, 2.195560932e-01f, 9.922624230e-01f, 1.241583377e-01f,
  9.975510240e-01f, 6.994284689e-02f, 9.992253184e-01f, 3.935372457e-02f, 9.997550249e-01f, 2.213413455e-02f, 9.999225140e-01f, 1.244763471e-02f,
  9.999755025e-01f, 6.999942940e-03f, 9.999922514e-01f, 3.936378751e-03f, 9.999975562e-01f, 2.213592408e-03f, 9.999992251e-01f, 1.244795276e-03f,
  -1.455000341e-01f, 9.893582463e-01f, -2.120364457e-01f, -9.772617817e-01f, -8.186324239e-01f, 5.743177533e-01f, 1.476312131e-01f, 9.890424609e-01f,
  6.967067122e-01f, 7.173560858e-01f, 9.005023241e-01f, 4.348512292e-01f, 9.681702852e-01f, 2.502923310e-01f, 9.898977876e-01f, 1.417829692e-01f,
  9.968017340e-01f, 7.991468906e-02f, 9.989882708e-01f, 4.497213289e-02f, 9.996800423e-01f, 2.529552206e-02f, 9.998987913e-01f, 1.422575582e-02f,
  9.999679923e-01f, 7.999914698e-03f, 9.999898672e-01f, 4.498715047e-03f, 9.999967813e-01f, 2.529819263e-03f, 9.999989867e-01f, 1.422623056e-03f,
  -9.111302495e-01f, 4.121184945e-01f, 3.416602612e-01f, -9.398235083e-01f, -9.566441774e-01f, 2.912592292e-01f, -2.965079620e-02f, 9.995602965e-01f,
  6.216099262e-01f, 7.833269238e-01f, 8.746382594e-01f, 4.847761393e-01f, 9.597726464e-01f, 2.807783186e-01f, 9.872201085e-01f, 1.593627781e-01f,
  9.959527254e-01f, 8.987854421e-02f, 9.987195730e-01f, 5.058911815e-02f, 9.995950460e-01f, 2.845665626e-02f, 9.998719096e-01f, 1.600383036e-02f,
  9.999595284e-01f, 8.999879472e-03f, 9.999871850e-01f, 5.061050411e-03f, 9.999959469e-01f, 2.846045885e-03f, 9.999987483e-01f, 1.600450720e-03f,
  -8.390715122e-01f, -5.440211296e-01f, 7.901318669e-01f, -6.129369140e-01f, -9.997860789e-01f, -2.068356983e-02f, -2.059976310e-01f, 9.785524607e-01f,
  5.403022766e-01f, 8.414709568e-01f, 8.460091352e-01f, 5.331684351e-01f, 9.504153132e-01f, 3.109835684e-01f, 9.842302203e-01f, 1.768921912e-01f,
  9.950041771e-01f, 9.983341396e-02f, 9.984192848e-01f, 5.620449781e-02f, 9.995000362e-01f, 3.161750361e-02f, 9.998418689e-01f, 1.778185740e-02f,
  9.999499917e-01f, 9.999834001e-03f, 9.999842048e-01f, 5.623383448e-03f, 9.999949932e-01f, 3.162272274e-03f, 9.999983907e-01f, 1.778278500e-03f,
  4.425697960e-03f, -9.999902248e-01f, 9.952573776e-01f, -9.727645665e-02f, -9.437797666e-01f, -3.305749595e-01f, -3.758473992e-01f, 9.266815782e-01f,
  4.535960853e-01f, 8.912073970e-01f, 8.147053123e-01f, 5.798751712e-01f, 9.401075840e-01f, 3.408778608e-01f, 9.809291363e-01f, 1.943656504e-01f,
  9.939560890e-01f, 1.097782999e-01f, 9.980874062e-01f, 6.181810424e-02f, 9.993950725e-01f, 3.477803990e-02f, 9.998086691e-01f, 1.955982670e-02f,
  9.999395013e-01f, 1.099977922e-02f, 9.999808669e-01f, 6.185714621e-03f, 9.999939203e-01f, 3.478498431e-03f, 9.999980927e-01f, 1.956106164e-03f,
  8.438539505e-01f, -5.365729332e-01f, 8.938615918e-01f, 4.483429790e-01f, -7.941793799e-01f, -6.076834202e-01f, -5.338430405e-01f, 8.455836177e-01f,
  3.623577058e-01f, 9.320390821e-01f, 7.808259130e-01f, 6.247486472e-01f, 9.288598895e-01f, 3.704313040e-01f, 9.773178697e-01f, 2.117776722e-01f,
  9.928086400e-01f, 1.197122037e-01f, 9.977239966e-01f, 6.742975861e-02f, 9.992800951e-01f, 3.793822229e-02f, 9.997723103e-01f, 2.133773454e-02f,
  9.999279976e-01f, 1.199971233e-02f, 9.999772310e-01f, 6.748044398e-03f, 9.999927878e-01f, 3.794723889e-03f, 9.999977350e-01f, 2.133933594e-03f,
  9.074468017e-01f, 4.201670289e-01f, 5.171728730e-01f, 8.558809757e-01f, -5.658205152e-01f, -8.245284557e-01f, -6.750016809e-01f, 7.378162146e-01f,
  2.674987614e-01f, 9.635581970e-01f, 7.444779873e-01f, 6.676470041e-01f, 9.166833758e-01f, 3.996143043e-01f, 9.733975530e-01f, 2.291227132e-01f,
  9.915618896e-01f, 1.296341419e-01f, 9.973290563e-01f, 7.303927839e-02f, 9.991551042e-01f, 4.109803215e-02f, 9.997327924e-01f, 2.311557345e-02f,
  9.999154806e-01f, 1.299963426e-02f, 9.999732971e-01f, 7.310371846e-03f, 9.999915361e-01f, 4.110949114e-03f, 9.999973178e-01f, 2.311761025e-03f,
  1.367372125e-01f, 9.906073809e-01f, -1.879615150e-02f, 9.998233318e-01f, -2.813494802e-01f, -9.596053958e-01f, -7.948709130e-01f, 6.067785621e-01f,
  1.699671596e-01f, 9.854497313e-01f, 7.057763934e-01f, 7.084347010e-01f, 9.035902619e-01f, 4.283977747e-01f, 9.691694379e-01f, 2.463953048e-01f,
  9.902160168e-01f, 1.395431161e-01f, 9.969025850e-01f, 7.864648104e-02f, 9.990201592e-01f, 4.425742477e-02f, 9.996901155e-01f, 2.489333972e-02f,
  9.999020100e-01f, 1.399954315e-02f, 9.999690056e-01f, 7.872696966e-03f, 9.999902248e-01f, 4.427174106e-03f, 9.999969006e-01f, 2.489588689e-03f,
  -7.596879005e-01f, 6.502878666e-01f, -5.489754677e-01f, 8.358384371e-01f, 3.102235124e-02f, -9.995186925e-01f, -8.896704316e-01f, 4.566032588e-01f,
  7.073719800e-02f, 9.974949956e-01f, 6.648434997e-01f, 7.469826341e-01f, 8.895936012e-01f, 4.567528665e-01f, 9.646348357e-01f, 2.635899782e-01f,
  9.887710810e-01f, 1.494381279e-01f, 9.964445233e-01f, 8.425120264e-02f, 9.988752007e-01f, 4.741638154e-02f, 9.996442795e-01f, 2.667102963e-02f,
  9.998875260e-01f, 1.499943808e-02f, 9.999644160e-01f, 8.435020223e-03f, 9.999887347e-01f, 4.743398633e-03f, 9.999964237e-01f, 2.667415887e-03f,
  -9.576594830e-01f, -2.879033089e-01f, -9.100810885e-01f, 4.144302309e-01f, 3.403181732e-01f, -9.403103590e-01f, -9.564100504e-01f, 2.920270860e-01f,
  -2.919954620e-02f, 9.995735884e-01f, 6.218088269e-01f, 7.831690907e-01f, 8.747074604e-01f, 4.846512377e-01f, 9.597951770e-01f, 2.807013094e-01f,
  9.872272611e-01f, 1.593182087e-01f, 9.959549904e-01f, 8.985326439e-02f, 9.987202883e-01f, 5.057485774e-02f, 9.995952845e-01f, 2.844863199e-02f,
  9.998720288e-01f, 1.599931903e-02f, 9.999595284e-01f, 8.997339755e-03f, 9.999871850e-01f, 5.059622694e-03f, 9.999959469e-01f, 2.845243318e-03f,
  -2.751633525e-01f, -9.613974690e-01f, -9.908979535e-01f, -1.346151382e-01f, 6.158648133e-01f, -7.878518701e-01f, -9.929850101e-01f, 1.182405204e-01f,
  -1.288445443e-01f, 9.916648269e-01f, 5.768082738e-01f, 8.168795705e-01f, 8.589466810e-01f, 5.120649934e-01f, 9.546520114e-01f, 2.977238595e-01f,
  9.855847955e-01f, 1.691823453e-01f, 9.954339862e-01f, 9.545248002e-02f, 9.985553622e-01f, 5.373282731e-02f, 9.995430708e-01f, 3.022614494e-02f,
  9.998555183e-01f, 1.699918136e-02f, 9.999542832e-01f, 9.559656493e-03f, 9.999855757e-01f, 5.375845823e-03f, 9.999954104e-01f, 3.023070283e-03f,
  6.603167057e-01f, -7.509872317e-01f, -7.665365338e-01f, -6.422007084e-01f, 8.303361535e-01f, -5.572628975e-01f, -9.982416630e-01f, -5.927551910e-02f,
  -2.272021621e-01f, 9.738476276e-01f, 5.299841762e-01f, 8.480075598e-01f, 8.423270583e-01f, 5.389667153e-01f, 9.492070079e-01f, 3.146522641e-01f,
  9.838436842e-01f, 1.790295690e-01f, 9.948815107e-01f, 1.010486856e-01f, 9.983804226e-01f, 5.689026415e-02f, 9.994877577e-01f, 3.200356290e-02f,
  9.998379946e-01f, 1.799902879e-02f, 9.999487996e-01f, 1.012197044e-02f, 9.999837875e-01f, 5.692068953e-03f, 9.999948740e-01f, 3.200897481e-03f,
  9.887046218e-01f, 1.498772055e-01f, -3.060953915e-01f, -9.520008564e-01f, 9.624637961e-01f, -2.714101076e-01f, -9.720142484e-01f, -2.349217981e-01f,
  -3.232895434e-01f, 9.463000894e-01f, 4.814845920e-01f, 8.764545321e-01f, 8.248651624e-01f, 5.653295517e-01f, 9.434618354e-01f, 3.314811885e-01f,
  9.820042253e-01f, 1.888588965e-01f, 9.942975044e-01f, 1.066416800e-01f, 9.981955290e-01f, 6.004713103e-02f, 9.994292855e-01f, 3.378088027e-02f,
  9.998195171e-01f, 1.899885759e-02f, 9.999428988e-01f, 1.068428159e-02f, 9.999819398e-01f, 6.008291151e-03f, 9.999942780e-01f, 3.378724447e-03f,
  4.080820680e-01f, 9.129452705e-01f, 2.486167252e-01f, -9.686019421e-01f, 9.991443753e-01f, 4.135828838e-02f, -9.151299596e-01f, -4.031589925e-01f,
  -4.161468446e-01f, 9.092974067e-01f, 4.314628243e-01f, 9.021307230e-01f, 8.065784574e-01f, 5.911270380e-01f, 9.374182820e-01f, 3.482052684e-01f,
  9.800665975e-01f, 1.986693144e-01f, 9.936820865e-01f, 1.122313142e-01f, 9.980006814e-01f, 6.320339441e-02f, 9.993675947e-01f, 3.555808961e-02f,
  9.998000264e-01f, 1.999866776e-02f, 9.999367595e-01f, 1.124658901e-02f, 9.999799728e-01f, 6.324512884e-03f, 9.999936819e-01f, 3.556551412e-03f,
  -5.477292538e-01f, 8.366556168e-01f, 7.267602682e-01f, -6.868911982e-01f, 9.367404580e-01f, 3.500247598e-01f, -8.293829560e-01f, -5.586805344e-01f,
  -5.048462152e-01f, 8.632093072e-01f, 3.800770044e-01f, 9.249548316e-01f, 7.874851823e-01f, 6.163335443e-01f, 9.310783744e-01f, 3.648192585e-01f,
  9.780309200e-01f, 2.084598988e-01f, 9.930352569e-01f, 1.178173944e-01f, 9.977958202e-01f, 6.635902822e-02f, 9.993028045e-01f, 3.733518720e-02f,
  9.997795224e-01f, 2.099845745e-02f, 9.999302626e-01f, 1.180889271e-02f, 9.999779463e-01f, 6.640734151e-03f, 9.999930263e-01f, 3.734378144e-03f,
  -9.999608397e-01f, -8.851309307e-03f, 9.810745716e-01f, -1.936302334e-01f, 7.814403772e-01f, 6.239799261e-01f, -7.174774408e-01f, -6.965817213e-01f,
  -5.885011554e-01f, 8.084963560e-01f, 3.274895847e-01f, 9.448547959e-01f, 7.676045895e-01f, 6.409237385e-01f, 9.244439602e-01f, 3.813178837e-01f,
  9.758974314e-01f, 2.182296216e-01f, 9.923570156e-01f, 1.233997419e-01f, 9.975810051e-01f, 6.951400638e-02f, 9.992348552e-01f, 3.911216930e-02f,
  9.997580051e-01f, 2.199822664e-02f, 9.999234676e-01f, 1.237119269e-02f, 9.999758005e-01f, 6.956954487e-03f, 9.999923706e-01f, 3.912204877e-03f,
  -5.328330398e-01f, -8.462204337e-01f, 9.332357645e-01f, 3.592645228e-01f, 5.486452579e-01f, 8.360552788e-01f, -5.829432607e-01f, -8.125128746e-01f,
  -6.662759781e-01f, 7.457052469e-01f, 2.738668323e-01f, 9.617676139e-01f, 7.469564080e-01f, 6.648730636e-01f, 9.175173044e-01f, 3.976959288e-01f,
  9.736663699e-01f, 2.279775143e-01f, 9.916474223e-01f, 1.289781928e-01f, 9.973561764e-01f, 7.266827673e-02f, 9.991636872e-01f, 4.088902473e-02f,
  9.997355342e-01f, 2.299797349e-02f, 9.999163747e-01f, 1.293348987e-02f, 9.999735355e-01f, 7.273174357e-03f, 9.999916553e-01f, 4.090031609e-03f,
  4.241790175e-01f, -9.055783749e-01f, 5.979771614e-01f, 8.015131354e-01f, 2.614416778e-01f, 9.652192593e-01f, -4.300232828e-01f, -9.028177857e-01f,
  -7.373937964e-01f, 6.754631400e-01f, 2.193782777e-01f, 9.756398797e-01f, 7.255613208e-01f, 6.881574988e-01f, 9.103004336e-01f, 4.139482081e-01f,
  9.713379741e-01f, 2.377026230e-01f, 9.909064770e-01f, 1.345525682e-01f, 9.971213937e-01f, 7.582182437e-02f, 9.990894198e-01f, 4.266574979e-02f,
  9.997119904e-01f, 2.399769612e-02f, 9.999089241e-01f, 1.349578146e-02f, 9.999712110e-01f, 7.589393295e-03f, 9.999908805e-01f, 4.267857410e-03f,
  9.912028313e-01f, -1.323517561e-01f, 7.855226099e-02f, 9.969099760e-01f, -5.168933049e-02f, 9.986631870e-01f, -2.635405958e-01f, -9.646483064e-01f,
  -8.011435866e-01f, 5.984721184e-01f, 1.641961634e-01f, 9.864277244e-01f, 7.034407258e-01f, 7.107539177e-01f, 9.027957320e-01f, 4.300695956e-01f,
  9.689124227e-01f, 2.474039644e-01f, 9.901341200e-01f, 1.401226968e-01f, 9.968766570e-01f, 7.897461206e-02f, 9.990119338e-01f, 4.444234073e-02f,
  9.996874928e-01f, 2.499739639e-02f, 9.999011755e-01f, 1.405806933e-02f, 9.999687672e-01f, 7.905611768e-03f, 9.999901056e-01f, 4.445684142e-03f,
  6.469193101e-01f, 7.625584602e-01f, -4.650644958e-01f, 8.852767944e-01f, -3.596943319e-01f, 9.330701828e-01f, -8.874550462e-02f, -9.960543513e-01f,
  -8.568888307e-01f, 5.155012608e-01f, 1.084949449e-01f, 9.940969944e-01f, 6.806167960e-01f, 7.326396108e-01f, 8.950055838e-01f, 4.460549951e-01f,
  9.663899541e-01f, 2.570805550e-01f, 9.893305302e-01f, 1.456883848e-01f, 9.966219068e-01f, 8.212661743e-02f, 9.989313483e-01f, 4.621879384e-02f,
  9.996620417e-01f, 2.599707060e-02f, 9.998931289e-01f, 1.462035347e-02f, 9.999662042e-01f, 8.221829310e-03f, 9.999893308e-01f, 4.623509943e-03f,
  -2.921388149e-01f, 9.563759565e-01f, -8.654506207e-01f, 5.009942055e-01f, -6.320286393e-01f, 7.749450207e-01f, 8.884811401e-02f, -9.960451722e-01f,
  -9.040721655e-01f, 4.273798466e-01f, 5.245061591e-02f, 9.986234903e-01f, 6.571123004e-01f, 7.537927032e-01f, 8.869323730e-01f, 4.618993104e-01f,
  9.637709260e-01f, 2.667314112e-01f, 9.884956479e-01f, 1.512494683e-01f, 9.963572025e-01f, 8.527779579e-02f, 9.988475442e-01f, 4.799510166e-02f,
  9.996355176e-01f, 2.699672058e-02f, 9.998847246e-01f, 1.518263202e-02f, 9.999635220e-01f, 8.538045920e-03f, 9.999884963e-01f, 4.801335745e-03f,
  -9.626058936e-01f, 2.709057927e-01f, -9.992933869e-01f, -3.758566082e-02f, -8.416849375e-01f, 5.399689674e-01f, 2.636395097e-01f, -9.646213055e-01f,
  -9.422222972e-01f, 3.349882066e-01f, -3.759419080e-03f, 9.999929070e-01f, 6.329506636e-01f, 7.741920948e-01f, 8.785787225e-01f, 4.775975943e-01f,
  9.610554576e-01f, 2.763556540e-01f, 9.876294732e-01f, 1.568057537e-01f, 9.960825443e-01f, 8.842811733e-02f, 9.987606406e-01f, 4.977125302e-02f,
  9.996080399e-01f, 2.799634263e-02f, 9.998760223e-01f, 1.574490592e-02f, 9.999607801e-01f, 8.854261599e-03f, 9.999876022e-01f, 4.979162011e-03f,
  -7.480575442e-01f, -6.636338830e-01f, -8.253716230e-01f, -5.645897985e-01f, -9.678714871e-01f, 2.514453232e-01f, 4.301158488e-01f, -9.027736783e-01f,
  -9.709581733e-01f, 2.392492294e-01f, -5.995756760e-02f, 9.982009530e-01f, 6.081562042e-01f, 7.938174009e-01f, 8.699471951e-01f, 4.931448400e-01f,
  9.582439065e-01f, 2.859522104e-01f, 9.867320657e-01f, 1.623570919e-01f, 9.957979321e-01f, 9.157756716e-02f, 9.986705780e-01f, 5.154724792e-02f,
  9.995795488e-01f, 2.899593674e-02f, 9.998670220e-01f, 1.630717516e-02f, 9.999579787e-01f, 9.170476347e-03f, 9.999867082e-01f, 5.156987347e-03f,
  1.542514563e-01f, -9.880316257e-01f, -3.972518742e-01f, -9.177096486e-01f, -9.980752468e-01f, -6.201484054e-02f, 5.830269456e-01f, -8.124528527e-01f,
  -9.899924994e-01f, 1.411200017e-01f, -1.159661636e-01f, 9.932531714e-01f, 5.827536583e-01f, 8.126488924e-01f, 8.610406518e-01f, 5.085361004e-01f,
  9.553365111e-01f, 2.955201864e-01f, 9.858034849e-01f, 1.679033041e-01f, 9.955033660e-01f, 9.472609311e-02f, 9.985772967e-01f, 5.332308263e-02f,
  9.995500445e-01f, 2.999550104e-02f, 9.998577237e-01f, 1.686943881e-02f, 9.999549985e-01f, 9.486690164e-03f, 9.999857545e-01f, 5.334813148e-03f,
  9.147423506e-01f, -4.040376544e-01f, 1.532154828e-01f, -9.881927967e-01f, -9.293003082e-01f, -3.693250120e-01f, 7.175492048e-01f, -6.965078115e-01f,
  -9.991351366e-01f, 4.158052057e-02f, -1.716081351e-01f, 9.851652980e-01f, 5.567683578e-01f, 8.306677938e-01f, 8.518617749e-01f, 5.237666368e-01f,
  9.523335695e-01f, 3.050586283e-01f, 9.848436713e-01f, 1.734442115e-01f, 9.951988459e-01f, 9.787366539e-02f, 9.984809160e-01f, 5.509874597e-02f,
  9.995195270e-01f, 3.099503554e-02f, 9.998480678e-01f, 1.743169688e-02f, 9.999519587e-01f, 9.802903049e-03f, 9.999848008e-01f, 5.512638018e-03f,
  8.342233896e-01f, 5.514267087e-01f, 6.564951539e-01f, -7.543302178e-01f, -7.683671117e-01f, -6.400094032e-01f, 8.294403553e-01f, -5.585952997e-01f,
  -9.982947707e-01f, -5.837419257e-02f, -2.267075777e-01f, 9.739628434e-01f, 5.302263498e-01f, 8.478561044e-01f, 8.424135447e-01f, 5.388315320e-01f,
  9.492354393e-01f, 3.145665526e-01f, 9.838528037e-01f, 1.789796203e-01f, 9.948843718e-01f, 1.010202691e-01f, 9.983813763e-01f, 5.687423423e-02f,
  9.994880557e-01f, 3.199454024e-02f, 9.998381138e-01f, 1.799395122e-02f, 9.999487996e-01f, 1.011911593e-02f, 9.999837875e-01f, 5.690463353e-03f,
  -1.327674743e-02f, 9.999118447e-01f, 9.575860500e-01f, -2.881473899e-01f, -5.312352777e-01f, -8.472243547e-01f, 9.151713848e-01f, -4.030649364e-01f,
  -9.874798059e-01f, -1.577456445e-01f, -2.810903192e-01f, 9.596813321e-01f, 5.031541586e-01f, 8.641966581e-01f, 8.326989412e-01f, 5.537260175e-01f,
  9.460423589e-01f, 3.240430057e-01f, 9.828307629e-01f, 1.845093668e-01f, 9.945599437e-01f, 1.041658595e-01f, 9.982786179e-01f, 5.864954367e-02f,
  9.994555712e-01f, 3.299400955e-02f, 9.998278022e-01f, 1.855619811e-02f, 9.999455214e-01f, 1.043532696e-02f, 9.999827743e-01f, 5.868288688e-03f,
  -8.485702872e-01f, 5.290827155e-01f, 9.637575150e-01f, 2.667797208e-01f, -2.414211184e-01f, -9.704204202e-01f, 9.720383286e-01f, -2.348221242e-01f,
  -9.667981863e-01f, -2.555412054e-01f, -3.345843852e-01f, 9.423658252e-01f, 4.755789042e-01f, 8.796730638e-01f, 8.227210045e-01f, 5.684453845e-01f,
  9.427546859e-01f, 3.334870934e-01f, 9.817776680e-01f, 1.900332868e-01f, 9.942255616e-01f, 1.073104069e-01f, 9.981727600e-01f, 6.042466685e-02f,
  9.994220734e-01f, 3.399345279e-02f, 9.998172522e-01f, 1.911843941e-02f, 9.999421835e-01f, 1.075153705e-02f, 9.999817014e-01f, 6.046113092e-03f,
  -9.036921859e-01f, -4.281826615e-01f, 6.731102467e-01f, 7.395421267e-01f, 7.233466953e-02f, -9.973804355e-01f, 9.982477427e-01f, -5.917267874e-02f,
  -9.364566803e-01f, -3.507832289e-01f, -3.870206773e-01f, 9.220710397e-01f, 4.475280643e-01f, 8.942698836e-01f, 8.124829531e-01f, 5.829849839e-01f,
  9.393727183e-01f, 3.428978026e-01f, 9.806935191e-01f, 1.955512017e-01f, 9.938812256e-01f, 1.104538813e-01f, 9.980637431e-01f, 6.219960377e-02f,
  9.993875623e-01f, 3.499285504e-02f, 9.998063445e-01f, 1.968067512e-02f, 9.999387264e-01f, 1.106774528e-02f, 9.999806285e-01f, 6.223937962e-03f,
  -1.279636919e-01f, -9.917788506e-01f, 1.751565337e-01f, 9.845405817e-01f, 3.789161742e-01f, -9.254310131e-01f, 9.929728508e-01f, 1.183425859e-01f,
  -8.967583776e-01f, -4.425205588e-01f, -4.382335544e-01f, 8.988611698e-01f, 4.190297425e-01f, 9.079725146e-01f, 8.019878864e-01f, 5.973402858e-01f,
  9.358968139e-01f, 3.522742093e-01f, 9.795783162e-01f, 2.010629177e-01f, 9.935269952e-01f, 1.135962531e-01f, 9.979515672e-01f, 6.397433579e-02f,
  9.993520975e-01f, 3.599222749e-02f, 9.997950792e-01f, 2.024290524e-02f, 9.999352098e-01f, 1.138395350e-02f, 9.999794960e-01f, 6.401761901e-03f,
  7.654140592e-01f, -6.435381174e-01f, -3.767423034e-01f, 9.263181090e-01f, 6.479216814e-01f, -7.617069483e-01f, 9.563800097e-01f, 2.921253741e-01f,
  -8.481000066e-01f, -5.298361778e-01f, -4.880608618e-01f, 8.728095889e-01f, 3.901124299e-01f, 9.207672477e-01f, 7.912392616e-01f, 6.115067005e-01f,
  9.323273301e-01f, 3.616154492e-01f, 9.784321785e-01f, 2.065682709e-01f, 9.931628108e-01f, 1.167374924e-01f, 9.978361726e-01f, 6.574887782e-02f,
  9.993155599e-01f, 3.699155897e-02f, 9.997835755e-01f, 2.080512606e-02f, 9.999315739e-01f, 1.170015987e-02f, 9.999783635e-01f, 6.579586305e-03f,
  9.550736547e-01f, 2.963685691e-01f, -8.126112223e-01f, 5.828061700e-01f, 8.526731133e-01f, -5.224447846e-01f, 8.896234632e-01f, 4.566946924e-01f,
  -7.909677625e-01f, -6.118578315e-01f, -5.363451838e-01f, 8.439987302e-01f, 3.608050346e-01f, 9.326412678e-01f, 7.802404165e-01f, 6.254796982e-01f,
  9.286646247e-01f, 3.709204793e-01f, 9.772551060e-01f, 2.120671123e-01f, 9.927886724e-01f, 1.198775545e-01f, 9.977176785e-01f, 6.752320379e-02f,
  9.992780685e-01f, 3.799085692e-02f, 9.997717142e-01f, 2.136734314e-02f, 9.999278188e-01f, 1.201636530e-02f, 9.999771714e-01f, 6.757410709e-03f,
  2.666429281e-01f, 9.637953639e-01f, -9.982103705e-01f, 5.980031565e-02f, 9.728653431e-01f, -2.313720137e-01f, 7.948083878e-01f, 6.068604589e-01f,
  -7.259322405e-01f, -6.877662539e-01f, -5.829339027e-01f, 8.125196099e-01f, 3.311368525e-01f, 9.435827136e-01f, 7.689949274e-01f, 6.392549276e-01f,
  9.249090552e-01f, 3.801884055e-01f, 9.760470986e-01f, 2.175592482e-01f, 9.924046397e-01f, 1.230164245e-01f, 9.975960255e-01f, 6.929731369e-02f,
  9.992396235e-01f, 3.899011388e-02f, 9.997594953e-01f, 2.192955278e-02f, 9.999239445e-01f, 1.233256981e-02f, 9.999759793e-01f, 6.935234182e-03f,
  -6.669380665e-01f, 7.451131344e-01f, -8.763794303e-01f, -4.816212952e-01f, 9.965789914e-01f, 8.264580369e-02f, 6.749256253e-01f, 7.378857136e-01f,
  -6.536436081e-01f, -7.568024993e-01f, -6.276797056e-01f, 7.784717083e-01f, 3.011375964e-01f, 9.535806775e-01f, 7.575061917e-01f, 6.528279781e-01f,
  9.210609794e-01f, 3.894183338e-01f, 9.748082757e-01f, 2.230444849e-01f, 9.920106530e-01f, 1.261540651e-01f, 9.974712729e-01f, 7.107120752e-02f,
  9.992001057e-01f, 3.998933733e-02f, 9.997470379e-01f, 2.249175683e-02f, 9.999200106e-01f, 1.264877338e-02f, 9.999747276e-01f, 7.113057654e-03f,
  -9.873392582e-01f, -1.586226672e-01f, -4.846394062e-01f, -8.747140169e-01f, 9.214623570e-01f, 3.884676993e-01f, 5.337560773e-01f, 8.456384540e-01f,
  -5.748240352e-01f, -8.182770610e-01f, -6.704410911e-01f, 7.419627905e-01f, 2.708370686e-01f, 9.626252055e-01f, 7.457779050e-01f, 6.661946774e-01f,
  9.171208143e-01f, 3.986093104e-01f, 9.735385776e-01f, 2.285226882e-01f, 9.916067719e-01f, 1.292904317e-01f, 9.973433018e-01f, 7.284487784e-02f,
  9.991596341e-01f, 4.098851606e-02f, 9.997342229e-01f, 2.305394970e-02f, 9.999159575e-01f, 1.296497509e-02f, 9.999734163e-01f, 7.290880661e-03f,
  -3.999853134e-01f, -9.165215492e-01f, 5.636094138e-02f, -9.984104633e-01f, 7.549653649e-01f, 6.557646990e-01f, 3.757521510e-01f, 9.267202020e-01f,
  -4.902605712e-01f, -8.715758920e-01f, -7.110829353e-01f, 7.031081319e-01f, 2.402658761e-01f, 9.707071185e-01f, 7.338138223e-01f, 6.793506742e-01f,
  9.130889177e-01f, 4.077604413e-01f, 9.722381234e-01f, 2.339936644e-01f, 9.911929369e-01f, 1.324255317e-01f, 9.972121716e-01f, 7.461831719e-02f,
  9.991181493e-01f, 4.198765755e-02f, 9.997211099e-01f, 2.361613885e-02f, 9.999117851e-01f, 1.328117587e-02f, 9.999721050e-01f, 7.468704134e-03f,
  5.551133156e-01f, -8.317747712e-01f, 5.800031424e-01f, -8.146142364e-01f, 5.135984421e-01f, 8.580306768e-01f, 2.058971673e-01f, 9.785736203e-01f,
  -4.007990062e-01f, -9.161660075e-01f, -7.494767308e-01f, 6.620306373e-01f, 2.094544172e-01f, 9.778184295e-01f, 7.216176391e-01f, 6.922917962e-01f,
  9.089657664e-01f, 4.168707728e-01f, 9.709069133e-01f, 2.394572198e-01f, 9.907692075e-01f, 1.355592906e-01f, 9.970778823e-01f, 7.639151812e-02f,
  9.990756512e-01f, 4.298675060e-02f, 9.997076392e-01f, 2.417832054e-02f, 9.999075532e-01f, 1.359737478e-02f, 9.999707937e-01f, 7.646527141e-03f,
  9.998432994e-01f, 1.770192571e-02f, 9.250146747e-01f, -3.799313903e-01f, 2.212981731e-01f, 9.752061963e-01f, 2.954781987e-02f, 9.995633960e-01f,
  -3.073327839e-01f, -9.516021013e-01f, -7.855011225e-01f, 6.188601851e-01f, 1.784335226e-01f, 9.839519858e-01f, 7.091933489e-01f, 7.050140500e-01f,
  9.047516584e-01f, 4.259394705e-01f, 9.695450068e-01f, 2.449132055e-01f, 9.903355837e-01f, 1.386916935e-01f, 9.969404936e-01f, 7.816448808e-02f,
  9.990321398e-01f, 4.398580641e-02f, 9.996939301e-01f, 2.474049293e-02f, 9.999032021e-01f, 1.391357277e-02f, 9.999693632e-01f, 7.824349217e-03f,
  5.253219604e-01f, 8.509035110e-01f, 9.851381779e-01f, 1.717635691e-01f, -9.294810891e-02f, 9.956709743e-01f, -1.477329880e-01f, 9.890272617e-01f,
  -2.107958049e-01f, -9.775301218e-01f, -8.190422058e-01f, 5.737332702e-01f, 1.472342163e-01f, 9.891016483e-01f, 6.965447664e-01f, 7.175133228e-01f,
  9.004471302e-01f, 4.349655211e-01f, 9.681524038e-01f, 2.503614724e-01f, 9.898920655e-01f, 1.418227106e-01f, 9.967998862e-01f, 7.993719727e-02f,
  9.989876747e-01f, 4.498481750e-02f, 9.996798635e-01f, 2.530265786e-02f, 9.998987317e-01f, 1.422976889e-02f, 9.999679923e-01f, 8.002171293e-03f,
  -4.321779311e-01f, 9.017883539e-01f, 7.418580055e-01f, 6.705570221e-01f, -3.979767561e-01f, 9.173954725e-01f, -3.203543723e-01f, 9.472977519e-01f,
  -1.121526212e-01f, -9.936909676e-01f, -8.499938846e-01f, 5.267925262e-01f, 1.158876941e-01f, 9.932623506e-01f, 6.836758852e-01f, 7.297857404e-01f,
  8.960524797e-01f, 4.439480901e-01f, 9.667292237e-01f, 2.558017969e-01f, 9.894386530e-01f, 1.449523121e-01f, 9.966561794e-01f, 8.170966059e-02f,
  9.989421964e-01f, 4.598378390e-02f, 9.996654391e-01f, 2.586481534e-02f, 9.998942018e-01f, 1.454596408e-02f, 9.999665618e-01f, 8.179994300e-03f,
  -9.923354983e-01f, 1.235731244e-01f, 2.700984478e-01f, 9.628326893e-01f, -6.635382771e-01f, 7.481423616e-01f, -4.828719497e-01f, 8.756909966e-01f,
  -1.238837745e-02f, -9.999232888e-01f, -8.782584071e-01f, 4.781863391e-01f, 8.442528546e-02f, 9.964298010e-01f, 6.705908775e-01f, 7.418274283e-01f,
  8.915683031e-01f, 4.528862834e-01f, 9.652754664e-01f, 2.612340748e-01f, 9.889753461e-01f, 1.480804533e-01f, 9.965093136e-01f, 8.348185569e-02f,
  9.988957047e-01f, 4.698270187e-02f, 9.996507764e-01f, 2.642696351e-02f, 9.998895526e-01f, 1.486215740e-02f, 9.999650717e-01f, 8.357816376e-03f,
  -6.401443481e-01f, -7.682546377e-01f, -2.848466039e-01f, 9.585731030e-01f, -8.632965088e-01f, 5.046970844e-01f, -6.301599741e-01f, 7.764653563e-01f,
  8.749917150e-02f, -9.961646199e-01f, -9.037463665e-01f, 4.280683994e-01f, 5.287845805e-02f, 9.986009598e-01f, 6.572937369e-01f, 7.536345124e-01f,
  8.869948983e-01f, 4.617791772e-01f, 9.637911916e-01f, 2.666580379e-01f, 9.885020852e-01f, 1.512071192e-01f, 9.963592887e-01f, 8.525379747e-02f,
  9.988481998e-01f, 4.798157141e-02f, 9.996357560e-01f, 2.698910423e-02f, 9.998847842e-01f, 1.517834887e-02f, 9.999635816e-01f, 8.535637520e-03f,
  3.005925417e-01f, -9.537526369e-01f, -7.520639896e-01f, 6.590901017e-01f, -9.774427414e-01f, 2.112006545e-01f, -7.575730681e-01f, 6.527503729e-01f,
  1.865124702e-01f, -9.824525714e-01f, -9.263771176e-01f, 3.765971363e-01f, 2.127875760e-02f, 9.997735620e-01f, 6.437888145e-01f, 7.652031779e-01f,
  8.823328614e-01f, 4.706258774e-01f, 9.622764587e-01f, 2.720735669e-01f, 9.880189896e-01f, 1.543322802e-01f, 9.962061048e-01f, 8.702547103e-02f,
  9.987997413e-01f, 4.898039624e-02f, 9.996203780e-01f, 2.755123749e-02f, 9.998799562e-01f, 1.549453940e-02f, 9.999620318e-01f, 8.713459596e-03f,
  9.649659991e-01f, -2.623748481e-01f, -9.876590967e-01f, 1.566190720e-01f, -9.946564436e-01f, -1.032404602e-01f, -8.610926867e-01f, 5.084479451e-01f,
  2.836622000e-01f, -9.589242935e-01f, -9.460792542e-01f, 3.239352703e-01f, -1.034221891e-02f, 9.999465346e-01f, 6.300802827e-01f, 7.765299678e-01f,
  8.775825500e-01f, 4.794255495e-01f, 9.607312679e-01f, 2.774805427e-01f, 9.875259995e-01f, 1.574558914e-01f, 9.960497618e-01f, 8.879686147e-02f,
  9.987502694e-01f, 4.997916892e-02f, 9.996047616e-01f, 2.811335959e-02f, 9.998750091e-01f, 1.581072807e-02f, 9.999604821e-01f, 8.891279809e-03f,
  7.421541810e-01f, 6.702291965e-01f, -9.190735221e-01f, -3.940860629e-01f, -9.132301211e-01f, -4.074441493e-01f, -9.374542236e-01f, 3.481085002e-01f,
  3.779776692e-01f, -9.258147478e-01f, -9.627903700e-01f, 2.702493370e-01f, -4.195285589e-02f, 9.991195798e-01f, 6.161724925e-01f, 7.876111865e-01f,
  8.727445006e-01f, 4.881772399e-01f, 9.591556787e-01f, 2.828786969e-01f, 9.870231748e-01f, 1.605779380e-01f, 9.958902597e-01f, 9.056797624e-02f,
  9.986997843e-01f, 5.097789690e-02f, 9.995887876e-01f, 2.867547423e-02f, 9.998699427e-01f, 1.612691768e-02f, 9.999588728e-01f, 9.069100954e-03f,
  -1.629907787e-01f, 9.866275787e-01f, -5.674300194e-01f, -8.234215975e-01f, -7.412399650e-01f, -6.712401509e-01f, -9.842484593e-01f, 1.767906845e-01f,
  4.685169160e-01f, -8.834545016e-01f, -9.764577150e-01f, 2.157090008e-01f, -7.352153957e-02f, 9.972936511e-01f, 6.020699143e-01f, 7.984433770e-01f,
  8.678191900e-01f, 4.968801141e-01f, 9.575498104e-01f, 2.882679403e-01f, 9.865104556e-01f, 1.636983752e-01f, 9.957276583e-01f, 9.233880043e-02f,
  9.986482859e-01f, 5.197656900e-02f, 9.995725155e-01f, 2.923758142e-02f, 9.998648167e-01f, 1.644310169e-02f, 9.999572635e-01f, 9.246920235e-03f,
  -9.182828069e-01f, 3.959251642e-01f, -4.102819040e-02f, -9.991579652e-01f, -4.957418144e-01f, -8.684699535e-01f, -1.000000000e+00f, -1.030206768e-04f,
  5.543745160e-01f, -8.322673440e-01f, -9.870380163e-01f, 1.604867280e-01f, -1.050167084e-01f, 9.944704771e-01f, 5.877769589e-01f, 8.090230227e-01f,
  8.628070951e-01f, 5.055333376e-01f, 9.559136033e-01f, 2.936480343e-01f, 9.859878421e-01f, 1.668171734e-01f, 9.955618382e-01f, 9.410934150e-02f,
  9.985958338e-01f, 5.297519267e-02f, 9.995558858e-01f, 2.979967557e-02f, 9.998595715e-01f, 1.675928757e-02f, 9.999555945e-01f, 9.424741380e-03f,
  -8.293098211e-01f, -5.587890744e-01f, 4.980095923e-01f, -8.671715260e-01f, -2.010796219e-01f, -9.795749187e-01f, -9.842120409e-01f, -1.769934744e-01f,
  6.346929669e-01f, -7.727644444e-01f, -9.944978952e-01f, 1.047568321e-01f, -1.364068687e-01f, 9.906529188e-01f, 5.732980371e-01f, 8.193469048e-01f,
  8.577086926e-01f, 5.141359568e-01f, 9.542471766e-01f, 2.990188897e-01f, 9.854553938e-01f, 1.699342877e-01f, 9.953929186e-01f, 9.587957710e-02f,
  9.985423684e-01f, 5.397376046e-02f, 9.995389581e-01f, 3.036176413e-02f, 9.998542070e-01f, 1.707546785e-02f, 9.999538660e-01f, 9.602561593e-03f,
  2.212675661e-02f, -9.997551441e-01f, 8.836693168e-01f, -4.681116641e-01f, 1.135217771e-01f, -9.935355186e-01f, -9.373825192e-01f, -3.483016491e-01f,
  7.086697817e-01f, -7.055402994e-01f, -9.988136292e-01f, 4.869600013e-02f, -1.676606387e-01f, 9.858447909e-01f, 5.586379170e-01f, 8.294116855e-01f,
  8.525245190e-01f, 5.226872563e-01f, 9.525505900e-01f, 3.043802381e-01f, 9.849131107e-01f, 1.730497181e-01f, 9.952208400e-01f, 9.764950722e-02f,
  9.984878898e-01f, 5.497227982e-02f, 9.995217323e-01f, 3.092384152e-02f, 9.998487830e-01f, 1.739165001e-02f, 9.999521971e-01f, 9.780380875e-03f,
  8.532201052e-01f, -5.215510130e-01f, 9.971746206e-01f, 7.511820644e-02f, 4.168670774e-01f, -9.089674354e-01f, -8.609884381e-01f, -5.086245537e-01f,
  7.755658031e-01f, -6.312667131e-01f, -9.999717474e-01f, -7.518785074e-03f, -1.987468749e-01f, 9.800508618e-01f, 5.438010693e-01f, 8.392141461e-01f,
  8.472551107e-01f, 5.311862230e-01f, 9.508239031e-01f, 3.097319603e-01f, 9.843609333e-01f, 1.761634201e-01f, 9.950456619e-01f, 9.941913933e-02f,
  9.984323978e-01f, 5.597073585e-02f, 9.995042086e-01f, 3.148590773e-02f, 9.998431802e-01f, 1.770782843e-02f, 9.999504089e-01f, 9.958200157e-03f,
  8.998668194e-01f, 4.361647666e-01f, 8.035690784e-01f, 5.952115059e-01f, 6.788702011e-01f, -7.342582941e-01f, -7.574391961e-01f, -6.529057026e-01f,
  8.347129226e-01f, -5.506852865e-01f, -9.979684949e-01f, -6.370979548e-02f, -2.296342701e-01f, 9.732769728e-01f, 5.287923217e-01f, 8.487512469e-01f,
  8.419010043e-01f, 5.396320224e-01f, 9.490671158e-01f, 3.150739372e-01f, 9.837989211e-01f, 1.792753637e-01f, 9.948672652e-01f, 1.011884511e-01f,
  9.983759522e-01f, 5.696914345e-02f, 9.994863272e-01f, 3.204796836e-02f, 9.998375773e-01f, 1.802400686e-02f, 9.999486208e-01f, 1.013601944e-02f,
  1.191801354e-01f, 9.928726554e-01f, 3.624766767e-01f, 9.319928288e-01f, 8.735505342e-01f, -4.867334962e-01f, -6.300007105e-01f, -7.765945792e-01f,
  8.855196238e-01f, -4.646020234e-01f, -9.928101897e-01f, -1.196993962e-01f, -2.602920532e-01f, 9.655299187e-01f, 5.136163235e-01f, 8.580200076e-01f,
  8.364626765e-01f, 5.480239391e-01f, 9.472803473e-01f, 3.204059005e-01f, 9.832270741e-01f, 1.823855042e-01f, 9.946857691e-01f, 1.029574350e-01f,
  9.983184934e-01f, 5.796748772e-02f, 9.994681478e-01f, 3.261001408e-02f, 9.998317957e-01f, 1.834018156e-02f, 9.999468327e-01f, 1.031383779e-02f,
  -7.710801959e-01f, 6.367380023e-01f, -1.902491003e-01f, 9.817358255e-01f, 9.816020727e-01f, -1.909380108e-01f, -4.826923311e-01f, -8.757900000e-01f,
  9.274784923e-01f, -3.738765717e-01f, -9.845131636e-01f, -1.753105819e-01f, -2.906895578e-01f, 9.568174481e-01f, 4.982779026e-01f, 8.670173883e-01f,
  8.309407234e-01f, 5.563610196e-01f, 9.454635978e-01f, 3.257277906e-01f, 9.826454520e-01f, 1.854938269e-01f, 9.945011139e-01f, 1.047261059e-01f,
  9.982600212e-01f, 5.896577984e-02f, 9.994496703e-01f, 3.317204863e-02f, 9.998259544e-01f, 1.865635626e-02f, 9.999449849e-01f, 1.049165614e-02f,
  -9.524129629e-01f, -3.048106134e-01f, -6.843819022e-01f, 7.291237116e-01f, 9.923083186e-01f, 1.237909496e-01f, -3.201591671e-01f, -9.473637342e-01f,
  9.601702690e-01f, -2.794154882e-01f, -9.731037021e-01f, -2.303675115e-01f, -3.207964003e-01f, 9.471482038e-01f, 4.827820361e-01f, 8.757405281e-01f,
  8.253356218e-01f, 5.646424294e-01f, 9.436169863e-01f, 3.310393095e-01f, 9.820539355e-01f, 1.886002868e-01f, 9.943132997e-01f, 1.064944416e-01f,
  9.982005358e-01f, 5.996400863e-02f, 9.994308352e-01f, 3.373407945e-02f, 9.998199940e-01f, 1.897252724e-02f, 9.999430776e-01f, 1.066947449e-02f,
  -2.581016421e-01f, -9.661177993e-01f, -9.677396417e-01f, 2.519522607e-01f, 9.046075940e-01f, 4.262454212e-01f, -1.475291997e-01f, -9.890577197e-01f,
  9.832684398e-01f, -1.821625978e-01f, -9.586178064e-01f, -2.846961617e-01f, -3.505824506e-01f, 9.365318418e-01f, 4.671334028e-01f, 8.841868639e-01f,
  8.196480274e-01f, 5.728674531e-01f, 9.417404532e-01f, 3.363404274e-01f, 9.814526439e-01f, 1.917048544e-01f, 9.941223264e-01f, 1.082624346e-01f,
  9.981400967e-01f, 6.096218154e-02f, 9.994117022e-01f, 3.429609165e-02f, 9.998139739e-01f, 1.928869821e-02f, 9.999411702e-01f, 1.084729191e-02f,
  6.735071540e-01f, -7.391806841e-01f, -9.530500174e-01f, -3.028128743e-01f, 7.271980643e-01f, 6.864276528e-01f, 2.975377068e-02f, -9.995572567e-01f,
  9.965420961e-01f, -8.308912069e-02f, -9.411013126e-01f, -3.381247520e-01f, -3.800179660e-01f, 9.249790907e-01f, 4.513370395e-01f, 8.923535347e-01f,
  8.138784766e-01f, 5.810351372e-01f, 9.398342371e-01f, 3.416308761e-01f, 9.808415174e-01f, 1.948075294e-01f, 9.939282537e-01f, 1.100300923e-01f,
  9.980786443e-01f, 6.196028739e-02f, 9.993922710e-01f, 3.485809639e-02f, 9.998078346e-01f, 1.960486546e-02f, 9.999392033e-01f, 1.102510840e-02f,
  9.858965874e-01f, 1.673557013e-01f, -6.448370218e-01f, -7.643200755e-01f, 4.776714444e-01f, 8.785385489e-01f, 2.060983330e-01f, -9.785313010e-01f,
  9.998586178e-01f, 1.681409031e-02f, -9.206095338e-01f, -3.904843926e-01f, -4.090735018e-01f, 9.125014544e-01f, 4.353979528e-01f, 9.002380967e-01f,
  8.080275059e-01f, 5.891447663e-01f, 9.378982186e-01f, 3.469105363e-01f, 9.802205563e-01f, 1.979082376e-01f, 9.937310219e-01f, 1.117973924e-01f,
  9.980161786e-01f, 6.295833737e-02f, 9.993724823e-01f, 3.542009369e-02f, 9.998015761e-01f, 1.992103085e-02f, 9.999372363e-01f, 1.120292582e-02f,
};
__device__ const float ROPE32[1024] = {
  1.000000000e+00f, 0.000000000e+00f, 1.000000000e+00f, 0.000000000e+00f, 1.000000000e+00f, 0.000000000e+00f, 1.000000000e+00f, 0.000000000e+00f,
  1.000000000e+00f, 0.000000000e+00f, 1.000000000e+00f, 0.000000000e+00f, 1.000000000e+00f, 0.000000000e+00f, 1.000000000e+00f, 0.000000000e+00f,
  5.403022766e-01f, 8.414709568e-01f, 9.504152536e-01f, 3.109835982e-01f, 9.950041771e-01f, 9.983342141e-02f, 9.995000362e-01f, 3.161750361e-02f,
  9.999499917e-01f, 9.999833070e-03f, 9.999949932e-01f, 3.162272274e-03f, 9.999995232e-01f, 9.999999311e-04f, 9.999999404e-01f, 3.162277571e-04f,
  -4.161468446e-01f, 9.092974067e-01f, 8.065783978e-01f, 5.911270976e-01f, 9.800665975e-01f, 1.986693293e-01f, 9.980006814e-01f, 6.320339441e-02f,
  9.998000264e-01f, 1.999866590e-02f, 9.999799728e-01f, 6.324512884e-03f, 9.999979734e-01f, 1.999998698e-03f, 9.999998212e-01f, 6.324554561e-04f,
  -9.899924994e-01f, 1.411200017e-01f, 5.827536583e-01f, 8.126488924e-01f, 9.553365111e-01f, 2.955202162e-01f, 9.955033660e-01f, 9.472608566e-02f,
  9.995500445e-01f, 2.999549918e-02f, 9.999549985e-01f, 9.486690164e-03f, 9.999955297e-01f, 2.999995602e-03f, 9.999995232e-01f, 9.486831259e-04f,
  -6.536436081e-01f, -7.568024993e-01f, 3.011374772e-01f, 9.535807371e-01f, 9.210609794e-01f, 3.894183338e-01f, 9.920106530e-01f, 1.261540651e-01f,
  9.992001057e-01f, 3.998933360e-02f, 9.999200106e-01f, 1.264877338e-02f, 9.999920130e-01f, 3.999989480e-03f, 9.999992251e-01f, 1.264910679e-03f,
  2.836622000e-01f, -9.589242935e-01f, -1.034233812e-02f, 9.999465346e-01f, 8.775825500e-01f, 4.794255495e-01f, 9.875259995e-01f, 1.574558765e-01f,
  9.987502694e-01f, 4.997916520e-02f, 9.998750091e-01f, 1.581072807e-02f, 9.999874830e-01f, 4.999979399e-03f, 9.999987483e-01f, 1.581138116e-03f,
  9.601702690e-01f, -2.794154882e-01f, -3.207964003e-01f, 9.471482038e-01f, 8.253356218e-01f, 5.646424890e-01f, 9.820539355e-01f, 1.886002719e-01f,
  9.982005358e-01f, 5.996400490e-02f, 9.998199940e-01f, 1.897252724e-02f, 9.999819994e-01f, 5.999964196e-03f, 9.999982119e-01f, 1.897365320e-03f,
  7.539022565e-01f, 6.569865942e-01f, -5.994374752e-01f, 8.004215956e-01f, 7.648422122e-01f, 6.442176700e-01f, 9.755998850e-01f, 2.195560932e-01f,
  9.975510240e-01f, 6.994284689e-02f, 9.997550249e-01f, 2.213413455e-02f, 9.999755025e-01f, 6.999942940e-03f, 9.999975562e-01f, 2.213592408e-03f,
  -1.455000341e-01f, 9.893582463e-01f, -8.186324239e-01f, 5.743177533e-01f, 6.967067122e-01f, 7.173560858e-01f, 9.681702852e-01f, 2.502923310e-01f,
  9.968017340e-01f, 7.991468906e-02f, 9.996800423e-01f, 2.529552206e-02f, 9.999679923e-01f, 7.999914698e-03f, 9.999967813e-01f, 2.529819263e-03f,
  -9.111302495e-01f, 4.121184945e-01f, -9.566441774e-01f, 2.912592292e-01f, 6.216099262e-01f, 7.833269238e-01f, 9.597726464e-01f, 2.807783186e-01f,
  9.959527254e-01f, 8.987854421e-02f, 9.995950460e-01f, 2.845665626e-02f, 9.999595284e-01f, 8.999879472e-03f, 9.999959469e-01f, 2.846045885e-03f,
  -8.390715122e-01f, -5.440211296e-01f, -9.997860789e-01f, -2.068356983e-02f, 5.403022766e-01f, 8.414709568e-01f, 9.504153132e-01f, 3.109835684e-01f,
  9.950041771e-01f, 9.983341396e-02f, 9.995000362e-01f, 3.161750361e-02f, 9.999499917e-01f, 9.999834001e-03f, 9.999949932e-01f, 3.162272274e-03f,
  4.425697960e-03f, -9.999902248e-01f, -9.437797666e-01f, -3.305749595e-01f, 4.535960853e-01f, 8.912073970e-01f, 9.401075840e-01f, 3.408778608e-01f,
  9.939560890e-01f, 1.097782999e-01f, 9.993950725e-01f, 3.477803990e-02f, 9.999395013e-01f, 1.099977922e-02f, 9.999939203e-01f, 3.478498431e-03f,
  8.438539505e-01f, -5.365729332e-01f, -7.941793799e-01f, -6.076834202e-01f, 3.623577058e-01f, 9.320390821e-01f, 9.288598895e-01f, 3.704313040e-01f,
  9.928086400e-01f, 1.197122037e-01f, 9.992800951e-01f, 3.793822229e-02f, 9.999279976e-01f, 1.199971233e-02f, 9.999927878e-01f, 3.794723889e-03f,
  9.074468017e-01f, 4.201670289e-01f, -5.658205152e-01f, -8.245284557e-01f, 2.674987614e-01f, 9.635581970e-01f, 9.166833758e-01f, 3.996143043e-01f,
  9.915618896e-01f, 1.296341419e-01f, 9.991551042e-01f, 4.109803215e-02f, 9.999154806e-01f, 1.299963426e-02f, 9.999915361e-01f, 4.110949114e-03f,
  1.367372125e-01f, 9.906073809e-01f, -2.813494802e-01f, -9.596053958e-01f, 1.699671596e-01f, 9.854497313e-01f, 9.035902619e-01f, 4.283977747e-01f,
  9.902160168e-01f, 1.395431161e-01f, 9.990201592e-01f, 4.425742477e-02f, 9.999020100e-01f, 1.399954315e-02f, 9.999902248e-01f, 4.427174106e-03f,
  -7.596879005e-01f, 6.502878666e-01f, 3.102235124e-02f, -9.995186925e-01f, 7.073719800e-02f, 9.974949956e-01f, 8.895936012e-01f, 4.567528665e-01f,
  9.887710810e-01f, 1.494381279e-01f, 9.988752007e-01f, 4.741638154e-02f, 9.998875260e-01f, 1.499943808e-02f, 9.999887347e-01f, 4.743398633e-03f,
  -9.576594830e-01f, -2.879033089e-01f, 3.403181732e-01f, -9.403103590e-01f, -2.919954620e-02f, 9.995735884e-01f, 8.747074604e-01f, 4.846512377e-01f,
  9.872272611e-01f, 1.593182087e-01f, 9.987202883e-01f, 5.057485774e-02f, 9.998720288e-01f, 1.599931903e-02f, 9.999871850e-01f, 5.059622694e-03f,
  -2.751633525e-01f, -9.613974690e-01f, 6.158648133e-01f, -7.878518701e-01f, -1.288445443e-01f, 9.916648269e-01f, 8.589466810e-01f, 5.120649934e-01f,
  9.855847955e-01f, 1.691823453e-01f, 9.985553622e-01f, 5.373282731e-02f, 9.998555183e-01f, 1.699918136e-02f, 9.999855757e-01f, 5.375845823e-03f,
  6.603167057e-01f, -7.509872317e-01f, 8.303361535e-01f, -5.572628975e-01f, -2.272021621e-01f, 9.738476276e-01f, 8.423270583e-01f, 5.389667153e-01f,
  9.838436842e-01f, 1.790295690e-01f, 9.983804226e-01f, 5.689026415e-02f, 9.998379946e-01f, 1.799902879e-02f, 9.999837875e-01f, 5.692068953e-03f,
  9.887046218e-01f, 1.498772055e-01f, 9.624637961e-01f, -2.714101076e-01f, -3.232895434e-01f, 9.463000894e-01f, 8.248651624e-01f, 5.653295517e-01f,
  9.820042253e-01f, 1.888588965e-01f, 9.981955290e-01f, 6.004713103e-02f, 9.998195171e-01f, 1.899885759e-02f, 9.999819398e-01f, 6.008291151e-03f,
  4.080820680e-01f, 9.129452705e-01f, 9.991443753e-01f, 4.135828838e-02f, -4.161468446e-01f, 9.092974067e-01f, 8.065784574e-01f, 5.911270380e-01f,
  9.800665975e-01f, 1.986693144e-01f, 9.980006814e-01f, 6.320339441e-02f, 9.998000264e-01f, 1.999866776e-02f, 9.999799728e-01f, 6.324512884e-03f,
  -5.477292538e-01f, 8.366556168e-01f, 9.367404580e-01f, 3.500247598e-01f, -5.048462152e-01f, 8.632093072e-01f, 7.874851823e-01f, 6.163335443e-01f,
  9.780309200e-01f, 2.084598988e-01f, 9.977958202e-01f, 6.635902822e-02f, 9.997795224e-01f, 2.099845745e-02f, 9.999779463e-01f, 6.640734151e-03f,
  -9.999608397e-01f, -8.851309307e-03f, 7.814403772e-01f, 6.239799261e-01f, -5.885011554e-01f, 8.084963560e-01f, 7.676045895e-01f, 6.409237385e-01f,
  9.758974314e-01f, 2.182296216e-01f, 9.975810051e-01f, 6.951400638e-02f, 9.997580051e-01f, 2.199822664e-02f, 9.999758005e-01f, 6.956954487e-03f,
  -5.328330398e-01f, -8.462204337e-01f, 5.486452579e-01f, 8.360552788e-01f, -6.662759781e-01f, 7.457052469e-01f, 7.469564080e-01f, 6.648730636e-01f,
  9.736663699e-01f, 2.279775143e-01f, 9.973561764e-01f, 7.266827673e-02f, 9.997355342e-01f, 2.299797349e-02f, 9.999735355e-01f, 7.273174357e-03f,
  4.241790175e-01f, -9.055783749e-01f, 2.614416778e-01f, 9.652192593e-01f, -7.373937964e-01f, 6.754631400e-01f, 7.255613208e-01f, 6.881574988e-01f,
  9.713379741e-01f, 2.377026230e-01f, 9.971213937e-01f, 7.582182437e-02f, 9.997119904e-01f, 2.399769612e-02f, 9.999712110e-01f, 7.589393295e-03f,
  9.912028313e-01f, -1.323517561e-01f, -5.168933049e-02f, 9.986631870e-01f, -8.011435866e-01f, 5.984721184e-01f, 7.034407258e-01f, 7.107539177e-01f,
  9.689124227e-01f, 2.474039644e-01f, 9.968766570e-01f, 7.897461206e-02f, 9.996874928e-01f, 2.499739639e-02f, 9.999687672e-01f, 7.905611768e-03f,
  6.469193101e-01f, 7.625584602e-01f, -3.596943319e-01f, 9.330701828e-01f, -8.568888307e-01f, 5.155012608e-01f, 6.806167960e-01f, 7.326396108e-01f,
  9.663899541e-01f, 2.570805550e-01f, 9.966219068e-01f, 8.212661743e-02f, 9.996620417e-01f, 2.599707060e-02f, 9.999662042e-01f, 8.221829310e-03f,
  -2.921388149e-01f, 9.563759565e-01f, -6.320286393e-01f, 7.749450207e-01f, -9.040721655e-01f, 4.273798466e-01f, 6.571123004e-01f, 7.537927032e-01f,
  9.637709260e-01f, 2.667314112e-01f, 9.963572025e-01f, 8.527779579e-02f, 9.996355176e-01f, 2.699672058e-02f, 9.999635220e-01f, 8.538045920e-03f,
  -9.626058936e-01f, 2.709057927e-01f, -8.416849375e-01f, 5.399689674e-01f, -9.422222972e-01f, 3.349882066e-01f, 6.329506636e-01f, 7.741920948e-01f,
  9.610554576e-01f, 2.763556540e-01f, 9.960825443e-01f, 8.842811733e-02f, 9.996080399e-01f, 2.799634263e-02f, 9.999607801e-01f, 8.854261599e-03f,
  -7.480575442e-01f, -6.636338830e-01f, -9.678714871e-01f, 2.514453232e-01f, -9.709581733e-01f, 2.392492294e-01f, 6.081562042e-01f, 7.938174009e-01f,
  9.582439065e-01f, 2.859522104e-01f, 9.957979321e-01f, 9.157756716e-02f, 9.995795488e-01f, 2.899593674e-02f, 9.999579787e-01f, 9.170476347e-03f,
  1.542514563e-01f, -9.880316257e-01f, -9.980752468e-01f, -6.201484054e-02f, -9.899924994e-01f, 1.411200017e-01f, 5.827536583e-01f, 8.126488924e-01f,
  9.553365111e-01f, 2.955201864e-01f, 9.955033660e-01f, 9.472609311e-02f, 9.995500445e-01f, 2.999550104e-02f, 9.999549985e-01f, 9.486690164e-03f,
  9.147423506e-01f, -4.040376544e-01f, -9.293003082e-01f, -3.693250120e-01f, -9.991351366e-01f, 4.158052057e-02f, 5.567683578e-01f, 8.306677938e-01f,
  9.523335695e-01f, 3.050586283e-01f, 9.951988459e-01f, 9.787366539e-02f, 9.995195270e-01f, 3.099503554e-02f, 9.999519587e-01f, 9.802903049e-03f,
  8.342233896e-01f, 5.514267087e-01f, -7.683671117e-01f, -6.400094032e-01f, -9.982947707e-01f, -5.837419257e-02f, 5.302263498e-01f, 8.478561044e-01f,
  9.492354393e-01f, 3.145665526e-01f, 9.948843718e-01f, 1.010202691e-01f, 9.994880557e-01f, 3.199454024e-02f, 9.999487996e-01f, 1.011911593e-02f,
  -1.327674743e-02f, 9.999118447e-01f, -5.312352777e-01f, -8.472243547e-01f, -9.874798059e-01f, -1.577456445e-01f, 5.031541586e-01f, 8.641966581e-01f,
  9.460423589e-01f, 3.240430057e-01f, 9.945599437e-01f, 1.041658595e-01f, 9.994555712e-01f, 3.299400955e-02f, 9.999455214e-01f, 1.043532696e-02f,
  -8.485702872e-01f, 5.290827155e-01f, -2.414211184e-01f, -9.704204202e-01f, -9.667981863e-01f, -2.555412054e-01f, 4.755789042e-01f, 8.796730638e-01f,
  9.427546859e-01f, 3.334870934e-01f, 9.942255616e-01f, 1.073104069e-01f, 9.994220734e-01f, 3.399345279e-02f, 9.999421835e-01f, 1.075153705e-02f,
  -9.036921859e-01f, -4.281826615e-01f, 7.233466953e-02f, -9.973804355e-01f, -9.364566803e-01f, -3.507832289e-01f, 4.475280643e-01f, 8.942698836e-01f,
  9.393727183e-01f, 3.428978026e-01f, 9.938812256e-01f, 1.104538813e-01f, 9.993875623e-01f, 3.499285504e-02f, 9.999387264e-01f, 1.106774528e-02f,
  -1.279636919e-01f, -9.917788506e-01f, 3.789161742e-01f, -9.254310131e-01f, -8.967583776e-01f, -4.425205588e-01f, 4.190297425e-01f, 9.079725146e-01f,
  9.358968139e-01f, 3.522742093e-01f, 9.935269952e-01f, 1.135962531e-01f, 9.993520975e-01f, 3.599222749e-02f, 9.999352098e-01f, 1.138395350e-02f,
  7.654140592e-01f, -6.435381174e-01f, 6.479216814e-01f, -7.617069483e-01f, -8.481000066e-01f, -5.298361778e-01f, 3.901124299e-01f, 9.207672477e-01f,
  9.323273301e-01f, 3.616154492e-01f, 9.931628108e-01f, 1.167374924e-01f, 9.993155599e-01f, 3.699155897e-02f, 9.999315739e-01f, 1.170015987e-02f,
  9.550736547e-01f, 2.963685691e-01f, 8.526731133e-01f, -5.224447846e-01f, -7.909677625e-01f, -6.118578315e-01f, 3.608050346e-01f, 9.326412678e-01f,
  9.286646247e-01f, 3.709204793e-01f, 9.927886724e-01f, 1.198775545e-01f, 9.992780685e-01f, 3.799085692e-02f, 9.999278188e-01f, 1.201636530e-02f,
  2.666429281e-01f, 9.637953639e-01f, 9.728653431e-01f, -2.313720137e-01f, -7.259322405e-01f, -6.877662539e-01f, 3.311368525e-01f, 9.435827136e-01f,
  9.249090552e-01f, 3.801884055e-01f, 9.924046397e-01f, 1.230164245e-01f, 9.992396235e-01f, 3.899011388e-02f, 9.999239445e-01f, 1.233256981e-02f,
  -6.669380665e-01f, 7.451131344e-01f, 9.965789914e-01f, 8.264580369e-02f, -6.536436081e-01f, -7.568024993e-01f, 3.011375964e-01f, 9.535806775e-01f,
  9.210609794e-01f, 3.894183338e-01f, 9.920106530e-01f, 1.261540651e-01f, 9.992001057e-01f, 3.998933733e-02f, 9.999200106e-01f, 1.264877338e-02f,
  -9.873392582e-01f, -1.586226672e-01f, 9.214623570e-01f, 3.884676993e-01f, -5.748240352e-01f, -8.182770610e-01f, 2.708370686e-01f, 9.626252055e-01f,
  9.171208143e-01f, 3.986093104e-01f, 9.916067719e-01f, 1.292904317e-01f, 9.991596341e-01f, 4.098851606e-02f, 9.999159575e-01f, 1.296497509e-02f,
  -3.999853134e-01f, -9.165215492e-01f, 7.549653649e-01f, 6.557646990e-01f, -4.902605712e-01f, -8.715758920e-01f, 2.402658761e-01f, 9.707071185e-01f,
  9.130889177e-01f, 4.077604413e-01f, 9.911929369e-01f, 1.324255317e-01f, 9.991181493e-01f, 4.198765755e-02f, 9.999117851e-01f, 1.328117587e-02f,
  5.551133156e-01f, -8.317747712e-01f, 5.135984421e-01f, 8.580306768e-01f, -4.007990062e-01f, -9.161660075e-01f, 2.094544172e-01f, 9.778184295e-01f,
  9.089657664e-01f, 4.168707728e-01f, 9.907692075e-01f, 1.355592906e-01f, 9.990756512e-01f, 4.298675060e-02f, 9.999075532e-01f, 1.359737478e-02f,
  9.998432994e-01f, 1.770192571e-02f, 2.212981731e-01f, 9.752061963e-01f, -3.073327839e-01f, -9.516021013e-01f, 1.784335226e-01f, 9.839519858e-01f,
  9.047516584e-01f, 4.259394705e-01f, 9.903355837e-01f, 1.386916935e-01f, 9.990321398e-01f, 4.398580641e-02f, 9.999032021e-01f, 1.391357277e-02f,
  5.253219604e-01f, 8.509035110e-01f, -9.294810891e-02f, 9.956709743e-01f, -2.107958049e-01f, -9.775301218e-01f, 1.472342163e-01f, 9.891016483e-01f,
  9.004471302e-01f, 4.349655211e-01f, 9.898920655e-01f, 1.418227106e-01f, 9.989876747e-01f, 4.498481750e-02f, 9.998987317e-01f, 1.422976889e-02f,
  -4.321779311e-01f, 9.017883539e-01f, -3.979767561e-01f, 9.173954725e-01f, -1.121526212e-01f, -9.936909676e-01f, 1.158876941e-01f, 9.932623506e-01f,
  8.960524797e-01f, 4.439480901e-01f, 9.894386530e-01f, 1.449523121e-01f, 9.989421964e-01f, 4.598378390e-02f, 9.998942018e-01f, 1.454596408e-02f,
  -9.923354983e-01f, 1.235731244e-01f, -6.635382771e-01f, 7.481423616e-01f, -1.238837745e-02f, -9.999232888e-01f, 8.442528546e-02f, 9.964298010e-01f,
  8.915683031e-01f, 4.528862834e-01f, 9.889753461e-01f, 1.480804533e-01f, 9.988957047e-01f, 4.698270187e-02f, 9.998895526e-01f, 1.486215740e-02f,
  -6.401443481e-01f, -7.682546377e-01f, -8.632965088e-01f, 5.046970844e-01f, 8.749917150e-02f, -9.961646199e-01f, 5.287845805e-02f, 9.986009598e-01f,
  8.869948983e-01f, 4.617791772e-01f, 9.885020852e-01f, 1.512071192e-01f, 9.988481998e-01f, 4.798157141e-02f, 9.998847842e-01f, 1.517834887e-02f,
  3.005925417e-01f, -9.537526369e-01f, -9.774427414e-01f, 2.112006545e-01f, 1.865124702e-01f, -9.824525714e-01f, 2.127875760e-02f, 9.997735620e-01f,
  8.823328614e-01f, 4.706258774e-01f, 9.880189896e-01f, 1.543322802e-01f, 9.987997413e-01f, 4.898039624e-02f, 9.998799562e-01f, 1.549453940e-02f,
  9.649659991e-01f, -2.623748481e-01f, -9.946564436e-01f, -1.032404602e-01f, 2.836622000e-01f, -9.589242935e-01f, -1.034221891e-02f, 9.999465346e-01f,
  8.775825500e-01f, 4.794255495e-01f, 9.875259995e-01f, 1.574558914e-01f, 9.987502694e-01f, 4.997916892e-02f, 9.998750091e-01f, 1.581072807e-02f,
  7.421541810e-01f, 6.702291965e-01f, -9.132301211e-01f, -4.074441493e-01f, 3.779776692e-01f, -9.258147478e-01f, -4.195285589e-02f, 9.991195798e-01f,
  8.727445006e-01f, 4.881772399e-01f, 9.870231748e-01f, 1.605779380e-01f, 9.986997843e-01f, 5.097789690e-02f, 9.998699427e-01f, 1.612691768e-02f,
  -1.629907787e-01f, 9.866275787e-01f, -7.412399650e-01f, -6.712401509e-01f, 4.685169160e-01f, -8.834545016e-01f, -7.352153957e-02f, 9.972936511e-01f,
  8.678191900e-01f, 4.968801141e-01f, 9.865104556e-01f, 1.636983752e-01f, 9.986482859e-01f, 5.197656900e-02f, 9.998648167e-01f, 1.644310169e-02f,
  -9.182828069e-01f, 3.959251642e-01f, -4.957418144e-01f, -8.684699535e-01f, 5.543745160e-01f, -8.322673440e-01f, -1.050167084e-01f, 9.944704771e-01f,
  8.628070951e-01f, 5.055333376e-01f, 9.859878421e-01f, 1.668171734e-01f, 9.985958338e-01f, 5.297519267e-02f, 9.998595715e-01f, 1.675928757e-02f,
  -8.293098211e-01f, -5.587890744e-01f, -2.010796219e-01f, -9.795749187e-01f, 6.346929669e-01f, -7.727644444e-01f, -1.364068687e-01f, 9.906529188e-01f,
  8.577086926e-01f, 5.141359568e-01f, 9.854553938e-01f, 1.699342877e-01f, 9.985423684e-01f, 5.397376046e-02f, 9.998542070e-01f, 1.707546785e-02f,
  2.212675661e-02f, -9.997551441e-01f, 1.135217771e-01f, -9.935355186e-01f, 7.086697817e-01f, -7.055402994e-01f, -1.676606387e-01f, 9.858447909e-01f,
  8.525245190e-01f, 5.226872563e-01f, 9.849131107e-01f, 1.730497181e-01f, 9.984878898e-01f, 5.497227982e-02f, 9.998487830e-01f, 1.739165001e-02f,
  8.532201052e-01f, -5.215510130e-01f, 4.168670774e-01f, -9.089674354e-01f, 7.755658031e-01f, -6.312667131e-01f, -1.987468749e-01f, 9.800508618e-01f,
  8.472551107e-01f, 5.311862230e-01f, 9.843609333e-01f, 1.761634201e-01f, 9.984323978e-01f, 5.597073585e-02f, 9.998431802e-01f, 1.770782843e-02f,
  8.998668194e-01f, 4.361647666e-01f, 6.788702011e-01f, -7.342582941e-01f, 8.347129226e-01f, -5.506852865e-01f, -2.296342701e-01f, 9.732769728e-01f,
  8.419010043e-01f, 5.396320224e-01f, 9.837989211e-01f, 1.792753637e-01f, 9.983759522e-01f, 5.696914345e-02f, 9.998375773e-01f, 1.802400686e-02f,
  1.191801354e-01f, 9.928726554e-01f, 8.735505342e-01f, -4.867334962e-01f, 8.855196238e-01f, -4.646020234e-01f, -2.602920532e-01f, 9.655299187e-01f,
  8.364626765e-01f, 5.480239391e-01f, 9.832270741e-01f, 1.823855042e-01f, 9.983184934e-01f, 5.796748772e-02f, 9.998317957e-01f, 1.834018156e-02f,
  -7.710801959e-01f, 6.367380023e-01f, 9.816020727e-01f, -1.909380108e-01f, 9.274784923e-01f, -3.738765717e-01f, -2.906895578e-01f, 9.568174481e-01f,
  8.309407234e-01f, 5.563610196e-01f, 9.826454520e-01f, 1.854938269e-01f, 9.982600212e-01f, 5.896577984e-02f, 9.998259544e-01f, 1.865635626e-02f,
  -9.524129629e-01f, -3.048106134e-01f, 9.923083186e-01f, 1.237909496e-01f, 9.601702690e-01f, -2.794154882e-01f, -3.207964003e-01f, 9.471482038e-01f,
  8.253356218e-01f, 5.646424294e-01f, 9.820539355e-01f, 1.886002868e-01f, 9.982005358e-01f, 5.996400863e-02f, 9.998199940e-01f, 1.897252724e-02f,
  -2.581016421e-01f, -9.661177993e-01f, 9.046075940e-01f, 4.262454212e-01f, 9.832684398e-01f, -1.821625978e-01f, -3.505824506e-01f, 9.365318418e-01f,
  8.196480274e-01f, 5.728674531e-01f, 9.814526439e-01f, 1.917048544e-01f, 9.981400967e-01f, 6.096218154e-02f, 9.998139739e-01f, 1.928869821e-02f,
  6.735071540e-01f, -7.391806841e-01f, 7.271980643e-01f, 6.864276528e-01f, 9.965420961e-01f, -8.308912069e-02f, -3.800179660e-01f, 9.249790907e-01f,
  8.138784766e-01f, 5.810351372e-01f, 9.808415174e-01f, 1.948075294e-01f, 9.980786443e-01f, 6.196028739e-02f, 9.998078346e-01f, 1.960486546e-02f,
  9.858965874e-01f, 1.673557013e-01f, 4.776714444e-01f, 8.785385489e-01f, 9.998586178e-01f, 1.681409031e-02f, -4.090735018e-01f, 9.125014544e-01f,
  8.080275059e-01f, 5.891447663e-01f, 9.802205563e-01f, 1.979082376e-01f, 9.980161786e-01f, 6.295833737e-02f, 9.998015761e-01f, 1.992103085e-02f,
};
#define XB_TMO      128
#define XB_XCNT(j)  (256  + 64 * (j))
#define XB_XSUB(j)  (1280 + 64 * (j))
#define XB_XGEN(j)  (2304 + 64 * (j))
#define XB_TOP      3328
#define XB_TOPGEN   3392
#define XCD_BAR_WORDS 3456
#define XB_SPIN_CAP (1u << 18)
#define LAS __attribute__((address_space(3)))

__device__ __forceinline__ unsigned xb_ld(unsigned* p)              { return __hip_atomic_load(p, __ATOMIC_RELAXED, __HIP_MEMORY_SCOPE_AGENT); }
__device__ __forceinline__ unsigned xb_add(unsigned* p, unsigned v) { return __hip_atomic_fetch_add(p, v, __ATOMIC_RELAXED, __HIP_MEMORY_SCOPE_AGENT); }
__device__ __forceinline__ unsigned xb_xcc_id() { return (unsigned)__builtin_amdgcn_s_getreg((3 << 11) | 20) & 0xFu; }
#define XB_SPIN(cond, bar) do { unsigned _sp = 0; while (cond) { __builtin_amdgcn_s_sleep(1); \
    if ((++_sp & 255u) == 0u) { if (xb_ld(&(bar)[XB_TMO])) break; if (_sp > XB_SPIN_CAP) { atomicAdd(&(bar)[XB_TMO], 1u); break; } } } } while (0)

struct XcdBarrier {
    unsigned* bar; unsigned x;
    volatile LAS unsigned* st;
};

__device__ __forceinline__ XcdBarrier xcd_barrier_post(unsigned* bar, volatile LAS unsigned* st) {
    XcdBarrier b; b.bar = bar; b.x = xb_xcc_id(); b.st = st;
    if (threadIdx.x == 0) (void)xb_add(&bar[XB_XCNT(b.x)], 1u);
    return b;
}
__device__ __forceinline__ void xcd_barrier_complete(unsigned* bar, unsigned x, unsigned& nloc, unsigned& nx) {
    const unsigned G = gridDim.x * gridDim.y * gridDim.z;
    unsigned sum, cnt, mine, sp = 0u;
    for (;;) {
        sum = 0u; cnt = 0u; mine = 0u;
#pragma unroll
        for (unsigned j = 0; j < 16; ++j) { const unsigned c = xb_ld(&bar[XB_XCNT(j)]); sum += c; cnt += (c > 0u) ? 1u : 0u; mine = (j == x) ? c : mine; }
        if (sum == G) break;
        __builtin_amdgcn_s_sleep(1);
        if ((++sp & 255u) == 0u) { if (xb_ld(&bar[XB_TMO])) break; if (sp > XB_SPIN_CAP) { atomicAdd(&bar[XB_TMO], 1u); break; } }
    }
    nloc = mine > 0u ? mine : 1u; nx = cnt > 0u ? cnt : 1u;
}

__device__ __forceinline__ void xcd_barrier(const XcdBarrier& b, const bool t0  ) {
    asm volatile("s_waitcnt vmcnt(0)" ::: "memory");
    __syncthreads();
    if (t0) {
        unsigned* bar = b.bar;
        __builtin_amdgcn_s_waitcnt(0);
        unsigned nloc = b.st[0], nx = b.st[1];
        if (nloc == 0u) { xcd_barrier_complete(bar, b.x, nloc, nx); b.st[0] = nloc; b.st[1] = nx; }
        const unsigned old = xb_add(&bar[XB_XSUB(b.x)], 1u);
        const unsigned gen = old / nloc;
        if (old + 1u == (gen + 1u) * nloc) {
            __builtin_amdgcn_fence(__ATOMIC_RELEASE, "agent");
            asm volatile("s_waitcnt vmcnt(0)" ::: "memory");
            const unsigned og = xb_add(&bar[XB_TOP], 1u);
            const unsigned tg = og / nx;
            if (og + 1u == (tg + 1u) * nx) xb_add(&bar[XB_TOPGEN], 1u);
            else XB_SPIN(xb_ld(&bar[XB_TOPGEN]) == tg, bar);
            __builtin_amdgcn_fence(__ATOMIC_ACQUIRE, "agent");
            xb_add(&bar[XB_XGEN(b.x)], 1u);
            asm volatile("s_waitcnt vmcnt(0)" ::: "memory");
        } else {
            XB_SPIN(xb_ld(&bar[XB_XGEN(b.x)]) == gen, bar);
            __builtin_amdgcn_fence(__ATOMIC_ACQUIRE, "agent");
            asm volatile("s_waitcnt vmcnt(0)" ::: "memory");
        }
    }
    __syncthreads();
}

DI void conv_fetch(const float* __restrict__ src, int K, int N, int k0, int n0, f32x4 (&v)[2], int tid) {
#pragma unroll
    for (int i = 0; i < 2; ++i) {
        const int idx = tid + NTHREADS * i, kr = idx >> 4, c4 = (idx & 15) * 4;
        v[i] = (f32x4){0.f, 0.f, 0.f, 0.f};
        if (n0 + c4 < N) v[i] = __builtin_nontemporal_load((const f32x4*)(src + (size_t)(k0 + kr) * N + n0 + c4));
    }
}
DI void conv_put(const f32x4 (&v)[2], float* lds, int tid) {
#pragma unroll
    for (int i = 0; i < 2; ++i) {
        const int idx = tid + NTHREADS * i, kr = idx >> 4, c4 = (idx & 15) * 4;
        float* d = lds + kr * 65 + c4;
        d[0] = v[i].x; d[1] = v[i].y; d[2] = v[i].z; d[3] = v[i].w;
    }
}
typedef float f32x2_8 __attribute__((ext_vector_type(2)));
DI unsigned cvt_fp8x4(float a, float b, float c, float d) { int w = __builtin_amdgcn_cvt_pk_fp8_f32(a, b, 0, false); w = __builtin_amdgcn_cvt_pk_fp8_f32(c, d, w, true); return (unsigned)w; }
template <bool NT, bool FP8>
DI void conv_store(int K, bf16_t* __restrict__ dst, int k0, int ndst0, int nstep, const float* lds, int tid) {
    const int idx = tid, n = idx >> 3, kc = idx & 7;
    float f[8];
#pragma unroll
    for (int j = 0; j < 8; ++j) f[j] = lds[(kc * 8 + j) * 65 + n];
    const size_t e = (size_t)(ndst0 + (n & 31) + (n >> 5) * nstep) * K + k0 + kc * 8;
    if (FP8) {
        u32x2 w; w.x = cvt_fp8x4(f[0] * 32.f, f[1] * 32.f, f[2] * 32.f, f[3] * 32.f); w.y = cvt_fp8x4(f[4] * 32.f, f[5] * 32.f, f[6] * 32.f, f[7] * 32.f);
        u32x2* d = (u32x2*)((unsigned char*)dst + e);
        if (NT) __builtin_nontemporal_store(w, d); else *d = w;
    } else {
        u32x4* d = (u32x4*)(dst + e);
        if (NT) __builtin_nontemporal_store(pack8(f), d); else *d = pack8(f);
    }
}
template <bool NT = true, bool FP8 = false>
DI void conv_job(const float* src, int count, int K, int N, int Npad, bf16_t* dst, int perm  , int& base, float* lds, int bid, int nb, int tid) {
    const int tk = K / 64, tn = Npad / 64, per = tk * tn, total = count * per;
    int t = (bid - (base % nb) + nb) % nb;
    f32x4 rg[4][2];
    auto fetch4 = [&](int tt) {
#pragma unroll
        for (int q = 0; q < 4; ++q) {
            const int tq = tt + q * nb;
            if (tq < total) { const int mi = tq / per, rem = tq - mi * per, nt = rem / tk, kt = rem - nt * tk;
                conv_fetch(src + (size_t)mi * K * N, K, N, kt * 64, nt * 64, rg[q], tid); }
        }
    };
    if (t < total) fetch4(t);
    for (; t < total; t += 4 * nb) {
#pragma unroll
        for (int q = 0; q < 4; ++q) if (t + q * nb < total) conv_put(rg[q], lds + q * 4160, tid);
        __syncthreads();
        if (t + 4 * nb < total) fetch4(t + 4 * nb);
#pragma unroll
        for (int q = 0; q < 4; ++q) {
            const int tq = t + q * nb;
            if (tq < total) { const int mi = tq / per, rem = tq - mi * per, nt = rem / tk, kt = rem - nt * tk, n0 = nt * 64;
                int nd0 = n0, nstep = 32;
                if (perm == 1) nd0 = ((n0 & 255) >> 7) * 256 + (n0 >> 8) * 128 + (n0 & 127);
                else if (n0 < perm) { const int hg = n0 >> 6; nd0 = (hg >> 2) * 256 + (hg & 3) * 32; nstep = 128; }
                conv_store<NT, FP8>(K, FP8 ? (bf16_t*)((unsigned char*)dst + (size_t)mi * Npad * K) : dst + (size_t)mi * Npad * K, kt * 64, nd0, nstep, lds + q * 4160, tid); }
        }
        __syncthreads();
    }
    base += total;
}

DI int mla_col(bool uq, int r) {
    const int hw = uq ? 96 : 128;
    if (r < 1024) { const int pn = r >> 8, bj = (r >> 7) & 1, wc = (r >> 5) & 3, d = r & 31; return (4 * pn + wc) * hw + 32 * bj + d; }
    const int rr = r - 1024;
    if (uq) { const int head = rr >> 5, c = rr & 31, dim = (c >> 3) * 4 + (c & 3) + 16 * ((c >> 2) & 1); return head * 96 + 64 + dim; }
    return (rr >> 6) * 128 + 64 + (rr & 63);
}
DI void phase_prologue(const Params& p, float* lds, int bid, int nb, int tid) {
    bf16_t* ws16 = (bf16_t*)p.ws;
    int base = 0;
    conv_job<true, true>(p.in[13], 1, 1024, 3072, 3072, (bf16_t*)(p.ws + W_QKV0), 2048, base, lds, bid, nb, tid);
    conv_job<true, true>(p.in[14], 1, 1024, 1024, 1024, (bf16_t*)(p.ws + W_O0), 0, base, lds, bid, nb, tid);
    conv_job<true, true>(p.in[18], 1, 1024, 1536, 1536, (bf16_t*)(p.ws + W_QKV1), 1280, base, lds, bid, nb, tid);
    conv_job<true, true>(p.in[19], 1, 1024, 1024, 1024, (bf16_t*)(p.ws + W_O1), 0, base, lds, bid, nb, tid);
    conv_job<true, true>(p.in[23], 1, 1024, 672, 768, (bf16_t*)(p.ws + W_DQKV), 0, base, lds, bid, nb, tid);
    for (int i = bid * NTHREADS + tid; i < 1536 * 48 + 2048 * 32; i += nb * NTHREADS) {
        const bool uq = i < 1536 * 48;
        const int K = uq ? 384 : 256, kc = K / 8, ii = uq ? i : i - 1536 * 48, r = ii / kc, k0 = (ii - r * kc) * 8, nsrc = uq ? 1536 : 2048;
        const int col = mla_col(uq, r);
        const float* src = p.in[uq ? 26 : 27] + (size_t)k0 * nsrc + col;
        float f[8];
#pragma unroll
        for (int j = 0; j < 8; ++j) f[j] = src[(size_t)j * nsrc];
        *(u32x4*)((bf16_t*)(p.ws + (uq ? W_UQ : W_UKV)) + (size_t)r * K + k0) = pack8(f);
    }
    conv_job<true, true>(p.in[30], 1, 1024, 1024, 1024, (bf16_t*)(p.ws + W_O2), 0, base, lds, bid, nb, tid);
    conv_job<true, true>(p.in[31], 1, 1024, 3072, 3072, (bf16_t*)(p.ws + W_QKV3), 2048, base, lds, bid, nb, tid);
    conv_job<true, true>(p.in[36], 1, 1024, 1024, 1024, (bf16_t*)(p.ws + W_O3), 0, base, lds, bid, nb, tid);
    conv_job<true, true>(p.in[11], 32, 1024, 512, 512, (bf16_t*)(p.ws + W_GU), 1, base, lds, bid, nb, tid);
    conv_job(p.in[12], 32, 256, 1024, 1024, (bf16_t*)(p.ws + W_DN), 0, base, lds, bid, nb, tid);
    (void)ws16;
    float* sc = lds;
    for (int i = tid; i < 9 * 1024; i += NTHREADS) {
        const int r = i >> 10, k = i & 1023;
        const float v = r < 8 ? p.in[1][r * 1024 + k] : p.in[3][k];
        sc[i] = silu_f(v);
    }
    __syncthreads();
    float* part = (float*)(p.ws + WS_MODP);
    for (int it = bid; it < 768; it += nb) {
        const int kc = it / 48, rem = it - kc * 48, l = rem / 12, nch = rem - l * 12;
        const int n = nch * 512 + tid;
        const float* w = p.in[4] + ((size_t)l * 1024 + kc * 64) * 6144 + n;
        float acc[9];
#pragma unroll
        for (int r = 0; r < 9; ++r) acc[r] = 0.f;
#pragma unroll 8
        for (int k = 0; k < 64; ++k) {
            const float wv = __builtin_nontemporal_load(w + (size_t)k * 6144);
#pragma unroll
            for (int r = 0; r < 9; ++r) acc[r] += sc[r * 1024 + kc * 64 + k] * wv;
        }
#pragma unroll
        for (int r = 0; r < 9; ++r) part[(((size_t)kc * 4 + l) * 9 + r) * 6144 + n] = acc[r];
    }
    __syncthreads();
}
DI void phase_mod_reduce(const Params& p, int bid, int nb, int tid) {
    const float* part = (const float*)(p.ws + WS_MODP);
    float* mod = (float*)(p.ws + WS_MOD);
    const int total = 4 * 9 * 6144;
    for (int i = bid * NTHREADS + tid; i < total; i += nb * NTHREADS) {
        const int l = i / (9 * 6144), n = i % 6144;
        float s = p.in[5][l * 6144 + n];
#pragma unroll
        for (int kc = 0; kc < 16; ++kc) s += part[(size_t)kc * total + i];
        mod[i] = s;
    }
}

template <int MODE>
DI void phase_rows(const Params& p, int layer  , int which  , int bid, int nb, int tid) {
    const int wid = __builtin_amdgcn_readfirstlane(tid >> 6), lane = tid & 63;
    const float* modall = (const float*)(p.ws + WS_MOD);
    const bf16_t* eo = (const bf16_t*)(p.ws + WS_RAW);
    bf16_t* H = (bf16_t*)(p.ws + WS_H);
    for (int r = bid * NW + wid; r < MROWS; r += nb * NW) {
        const int b = r / PP, pos = r - b * PP;
        if ((MODE & 16) && pos >= SEQ) continue;
        const int mr = pos < SEQ ? b : 8;
        bf16_t* xb = xb_row(p, r);
        float x[16];
        if (MODE & 8) {
            const float* xr = pos < SEQ ? p.in[0] + ((size_t)b * SEQ + pos) * DM : p.in[2] + ((size_t)b * CTXL + (pos - SEQ)) * DM;
#pragma unroll
            for (int j = 0; j < 4; ++j) { const f32x4 v = *(const f32x4*)(xr + lane * 4 + 256 * j); x[4 * j] = v.x; x[4 * j + 1] = v.y; x[4 * j + 2] = v.z; x[4 * j + 3] = v.w; }
        } else {
#pragma unroll
            for (int j = 0; j < 4; ++j) { const u32x2 v = *(const u32x2*)(xb + lane * 4 + 256 * j); x[4 * j] = bflo(v.x); x[4 * j + 1] = bfhi(v.x); x[4 * j + 2] = bflo(v.y); x[4 * j + 3] = bfhi(v.y); }
        }
        if (MODE & 1) {
            const float* g2 = modall + ((size_t)(layer - ((MODE & 2) ? 1 : 0)) * 9 + mr) * 6144 + 5120;
            const unsigned char* y0 = (const unsigned char*)eo + (size_t)(2 * r) * 1024, *y1 = y0 + 1024;
#pragma unroll
            for (int j = 0; j < 4; ++j) {
                const unsigned a = *(const unsigned*)(y0 + lane * 4 + 256 * j), bb = *(const unsigned*)(y1 + lane * 4 + 256 * j);
                const f32x4 g = *(const f32x4*)(g2 + lane * 4 + 256 * j) * (1.0f / 16.0f);
                const f32x2_8 a01 = __builtin_amdgcn_cvt_pk_f32_fp8((int)a, false), a23 = __builtin_amdgcn_cvt_pk_f32_fp8((int)a, true);
                const f32x2_8 b01 = __builtin_amdgcn_cvt_pk_f32_fp8((int)bb, false), b23 = __builtin_amdgcn_cvt_pk_f32_fp8((int)bb, true);
                x[4 * j] += g.x * (a01[0] + b01[0]); x[4 * j + 1] += g.y * (a01[1] + b01[1]);
                x[4 * j + 2] += g.z * (a23[0] + b23[0]); x[4 * j + 3] += g.w * (a23[1] + b23[1]);
            }
        }
        if (MODE & 16) {
            float* orow = p.out + ((size_t)b * SEQ + pos) * DM;
#pragma unroll
            for (int j = 0; j < 4; ++j) *(f32x4*)(orow + lane * 4 + 256 * j) = (f32x4){x[4 * j], x[4 * j + 1], x[4 * j + 2], x[4 * j + 3]};
        } else if (MODE & (1 | 8)) {
#pragma unroll
            for (int j = 0; j < 4; ++j) {
                u32x2 w; w.x = pk2(x[4 * j], x[4 * j + 1]); w.y = pk2(x[4 * j + 2], x[4 * j + 3]);
                *(u32x2*)(xb + lane * 4 + 256 * j) = w;
                x[4 * j] = bflo(w.x); x[4 * j + 1] = bfhi(w.x); x[4 * j + 2] = bflo(w.y); x[4 * j + 3] = bfhi(w.y);
            }
        }
        if (MODE & 2) {
            float ss = 0.f;
#pragma unroll
            for (int i = 0; i < 16; ++i) ss += x[i] * x[i];
            ss = wave_sum(ss);
            const float rs = rsqrtf(ss * (1.0f / 1024.0f) + EPS);
            const float* ng = p.in[6] + ((size_t)layer * 2 + which) * 1024;
            const float* md = modall + ((size_t)layer * 9 + mr) * 6144 + which * 3072;
#pragma unroll
            for (int j = 0; j < 4; ++j) {
                const f32x4 g = *(const f32x4*)(ng + lane * 4 + 256 * j), sh = *(const f32x4*)(md + lane * 4 + 256 * j), sc = *(const f32x4*)(md + 1024 + lane * 4 + 256 * j);
                const float h0 = x[4 * j] * rs * g.x * (1.0f + sc.x) + sh.x, h1 = x[4 * j + 1] * rs * g.y * (1.0f + sc.y) + sh.y;
                const float h2 = x[4 * j + 2] * rs * g.z * (1.0f + sc.z) + sh.z, h3 = x[4 * j + 3] * rs * g.w * (1.0f + sc.w) + sh.w;
                if (MODE & 32) *(unsigned*)((unsigned char*)H + (size_t)r * 1024 + lane * 4 + 256 * j) = cvt_fp8x4(h0, h1, h2, h3);
                else { u32x2 w; w.x = pk2(h0, h1); w.y = pk2(h2, h3); *(u32x2*)(H + (size_t)r * 1024 + lane * 4 + 256 * j) = w; }
            }
        }
    }
}

constexpr size_t WS_RC = WS_MOD + 917504;
DI void phase_router_prep(const Params& p, int bid, int nb, int tid) {
    const float* modall = (const float*)(p.ws + WS_MOD);
    bf16_t* wth = (bf16_t*)(p.ws + WS_RW); bf16_t* wtl = wth + 4 * 9 * 48 * 1024;
    const int total = 4 * 9 * 48 * 1024;
    for (int i = bid * NTHREADS + tid; i < total; i += nb * NTHREADS) {
        const int k = i & 1023, c = (i >> 10) % 48, lb = i / (48 * 1024), l = lb / 9, b = lb - l * 9;
        float v = 0.f;
        if (c < 36) {
            const float w = c < 32 ? p.in[9][((size_t)l * 1024 + k) * 32 + c] : p.in[7][((size_t)l * 1024 + k) * 4 + (c - 32)];
            v = p.in[6][((size_t)l * 2 + 1) * 1024 + k] * (1.0f + modall[((size_t)l * 9 + b) * 6144 + 4096 + k]) * w;
        }
        const unsigned hb = f2bf(v); wth[i] = (bf16_t)hb; wtl[i] = (bf16_t)f2bf(v - bf2f(hb));
    }
    float* cst = (float*)(p.ws + WS_RC);
    const int wid = __builtin_amdgcn_readfirstlane(tid >> 6), lane = tid & 63;
    for (int j = bid * NW + wid; j < 4 * 9 * 48; j += nb * NW) {
        const int c = j % 48, lb = j / 48, l = lb / 9, b = lb - l * 9;
        float acc = 0.f;
        if (c < 36) {
            for (int k = lane; k < 1024; k += 64) {
                const float w = c < 32 ? p.in[9][((size_t)l * 1024 + k) * 32 + c] : p.in[7][((size_t)l * 1024 + k) * 4 + (c - 32)];
                acc += modall[((size_t)l * 9 + b) * 6144 + 3072 + k] * w;
            }
            acc = wave_sum(acc) + (c < 32 ? p.in[10][l * 32 + c] : p.in[8][l * 4 + (c - 32)]);
        }
        if (lane == 0) cst[j] = acc;
    }
}
typedef float f32x2_3 __attribute__((ext_vector_type(2)));
typedef __bf16 bf16x2_3 __attribute__((ext_vector_type(2)));
DI unsigned cvtpk3(float lo, float hi) { f32x2_3 v = {lo, hi}; bf16x2_3 b = __builtin_convertvector(v, bf16x2_3); return __builtin_bit_cast(unsigned, b); }
DI void phase_router(const Params& p, unsigned char* smem, int layer, bool skip_ctx, int bid, int nb, int tid) {
    const int lane = tid & 63, wid = __builtin_amdgcn_readfirstlane(tid >> 6), li = lane & 15, kq = lane >> 4;
    LAS float* tile = (LAS float*)smem + wid * (32 * 49);
    const bf16_t* wth_all = (const bf16_t*)(p.ws + WS_RW) + (size_t)layer * 9 * 48 * 1024;
    const bf16_t* wtl_all = wth_all + 4 * 9 * 48 * 1024;
    const float* cst_all = (const float*)(p.ws + WS_RC) + layer * 9 * 48;
    unsigned* cnt = (unsigned*)(p.ws + WS_CTL) + CW_CNT + layer * 32;
    unsigned* list = (unsigned*)(p.ws + WS_LIST);
    float* gates = (float*)(p.ws + WS_GATE);
    if (layer > 0) {
        int base = 0;
        conv_job<false, true>(p.in[11] + (size_t)layer * 32 * 1024 * 512, 32, 1024, 512, 512, (bf16_t*)(p.ws + W_GU + (size_t)layer * 32 * 512 * 1024), 1, base, (float*)smem, bid, nb, tid);
        conv_job<false>(p.in[12] + (size_t)layer * 32 * 256 * 1024, 32, 256, 1024, 1024, (bf16_t*)(p.ws + W_DN) + (size_t)layer * 32 * 1024 * 256, 0, base, (float*)smem, bid, nb, tid);
    }
    for (int u = bid * NW + wid; u < MROWS / 32; u += nb * NW) {
        const int r0 = u * 32, b = r0 / PP, pos = r0 - b * PP;
        const bool isctx = pos >= SEQ;
        if (skip_ctx && isctx) continue;
        const int mr = isctx ? 8 : b;
        const bf16_t* xr = xb_row(p, r0 + li) + 8 * kq;
        const bf16_t* wh = wth_all + ((size_t)mr * 48 + li) * 1024 + 8 * kq;
        const bf16_t* wl = wtl_all + ((size_t)mr * 48 + li) * 1024 + 8 * kq;
        f32x4 acc[2][3];
#pragma unroll
        for (int m = 0; m < 2; ++m)
#pragma unroll
            for (int n = 0; n < 3; ++n) acc[m][n] = (f32x4){0.f, 0.f, 0.f, 0.f};
        float ss[2] = {0.f, 0.f};
#pragma unroll 2
        for (int s = 0; s < 32; ++s) {
            bf16x8 xa[2], bh[3], bl[3];
#pragma unroll
            for (int m = 0; m < 2; ++m) xa[m] = *(const bf16x8*)(xr + (size_t)m * 16 * DM + 32 * s);
#pragma unroll
            for (int n = 0; n < 3; ++n) { bh[n] = *(const bf16x8*)(wh + (size_t)n * 16 * 1024 + 32 * s); bl[n] = *(const bf16x8*)(wl + (size_t)n * 16 * 1024 + 32 * s); }
#pragma unroll
            for (int m = 0; m < 2; ++m) {
                const u32x4 w = __builtin_bit_cast(u32x4, xa[m]);
                ss[m] += bflo(w.x) * bflo(w.x) + bfhi(w.x) * bfhi(w.x) + bflo(w.y) * bflo(w.y) + bfhi(w.y) * bfhi(w.y) + bflo(w.z) * bflo(w.z) + bfhi(w.z) * bfhi(w.z) + bflo(w.w) * bflo(w.w) + bfhi(w.w) * bfhi(w.w);
#pragma unroll
                for (int n = 0; n < 3; ++n) {
                    acc[m][n] = __builtin_amdgcn_mfma_f32_16x16x32_bf16(xa[m], bl[n], acc[m][n], 0, 0, 0);
                    acc[m][n] = __builtin_amdgcn_mfma_f32_16x16x32_bf16(xa[m], bh[n], acc[m][n], 0, 0, 0);
                }
            }
        }
#pragma unroll
        for (int m = 0; m < 2; ++m) { ss[m] += __shfl_xor(ss[m], 16); ss[m] += __shfl_xor(ss[m], 32); }
#pragma unroll
        for (int m = 0; m < 2; ++m)
#pragma unroll
            for (int n = 0; n < 3; ++n)
#pragma unroll
                for (int i = 0; i < 4; ++i) tile[(16 * m + 4 * kq + i) * 49 + n * 16 + li] = acc[m][n][i];
        __builtin_amdgcn_s_waitcnt(0xc07f);
        const float ssr = (lane & 16) ? ss[1] : ss[0];
        const float rs = rsqrtf(ssr * (1.0f / 1024.0f) + EPS);
        if (lane < 32) {
            const float* cst = cst_all + mr * 48;
            const LAS float* tr = tile + lane * 49;
            float lg[4];
#pragma unroll
            for (int c = 0; c < 4; ++c) lg[c] = tr[32 + c] * rs + cst[32 + c];
            int gi = 0; float gm = lg[0];
#pragma unroll
            for (int c = 1; c < 4; ++c) if (lg[c] > gm) { gm = lg[c]; gi = c; }
            float gden = 0.f;
#pragma unroll
            for (int c = 0; c < 4; ++c) gden += __expf(lg[c] - gm);
            const float gw = 1.0f / gden;
            float le[8];
#pragma unroll
            for (int c = 0; c < 8; ++c) le[c] = tr[gi * 8 + c] * rs + cst[gi * 8 + c];
            int e0 = 0; float m0 = le[0];
#pragma unroll
            for (int c = 1; c < 8; ++c) if (le[c] > m0) { m0 = le[c]; e0 = c; }
            int e1 = -1; float m1 = -INFINITY;
#pragma unroll
            for (int c = 0; c < 8; ++c) if (c != e0 && le[c] > m1) { m1 = le[c]; e1 = c; }
            const float q1 = __expf(m1 - m0), inv = 1.0f / (1.0f + q1);
            const int r = r0 + lane, ex0 = gi * 8 + e0, ex1 = gi * 8 + e1;
            const unsigned s0 = atomicAdd(cnt + ex0, 1u), s1 = atomicAdd(cnt + ex1, 1u);
            list[(size_t)ex0 * MROWS + s0] = 2u * r; list[(size_t)ex1 * MROWS + s1] = 2u * r + 1u;
            gates[2 * r] = gw * inv; gates[2 * r + 1] = gw * q1 * inv;
        }
        {
            const float* ng = p.in[6] + ((size_t)layer * 2 + 1) * 1024;
            const float* md = (const float*)(p.ws + WS_MOD) + ((size_t)layer * 9 + mr) * 6144 + 3072;
            f32x4 gm[4], sh[4];
#pragma unroll
            for (int j = 0; j < 4; ++j) {
                const f32x4 g = *(const f32x4*)(ng + lane * 4 + 256 * j), sc = *(const f32x4*)(md + 1024 + lane * 4 + 256 * j);
                sh[j] = *(const f32x4*)(md + lane * 4 + 256 * j);
                gm[j] = (f32x4){g.x * (1.0f + sc.x), g.y * (1.0f + sc.y), g.z * (1.0f + sc.z), g.w * (1.0f + sc.w)};
            }
            unsigned char* H8 = p.ws + WS_H;
#pragma unroll 4
            for (int i = 0; i < 32; ++i) {
                const float rsi = __shfl(rs, i);
                const bf16_t* xb = xb_row(p, r0 + i);
#pragma unroll
                for (int j = 0; j < 4; ++j) {
                    const u32x2 v = *(const u32x2*)(xb + lane * 4 + 256 * j);
                    *(unsigned*)(H8 + (size_t)(r0 + i) * 1024 + lane * 4 + 256 * j) =
                        cvt_fp8x4(bflo(v.x) * rsi * gm[j].x + sh[j].x, bfhi(v.x) * rsi * gm[j].y + sh[j].y, bflo(v.y) * rsi * gm[j].z + sh[j].z, bfhi(v.y) * rsi * gm[j].w + sh[j].w);
                }
            }
        }
    }
}

#define MFMA32(a, b, c) __builtin_amdgcn_mfma_f32_32x32x16_bf16((a), (b), (c), 0, 0, 0)
typedef LAS unsigned char* lds_ptr;
constexpr int GEMM_TM = 256, GEMM_TN = 256;
constexpr int GEMM_STAGE = 65536;
constexpr int GEMM_LDS = 2 * GEMM_STAGE;
constexpr int GEMM_MT = 4;

struct RowDense { static constexpr bool DENSE = true; const bf16_t* A; int lda; int m0; DI unsigned row(int i) const { return (unsigned)(m0 + i) * (unsigned)lda; } };
struct RowGather { static constexpr bool DENSE = false; const bf16_t* A; int lda; const unsigned* ent; int valid; int shift;
    DI unsigned row(int i) const { const unsigned e = ent[i < valid ? i : valid - 1]; return (e >> shift) * (unsigned)lda; } };

struct EpiStore { bf16_t* C; int ldc; int m0;
    DI void wave_tile(const f32x16 (&acc)[2][GEMM_MT], int mloc, int ncol, int lane) const {
        const int r = lane & 31, h = lane >> 5;
#pragma unroll
        for (int mt = 0; mt < GEMM_MT; ++mt) {
            bf16_t* c = C + (size_t)(m0 + mloc + mt * 32 + r) * ldc + ncol + 4 * h;
#pragma unroll
            for (int nt = 0; nt < 2; ++nt)
#pragma unroll
                for (int g = 0; g < 4; ++g) {
                    u32x2 w; w.x = pk2(acc[nt][mt][4 * g], acc[nt][mt][4 * g + 1]); w.y = pk2(acc[nt][mt][4 * g + 2], acc[nt][mt][4 * g + 3]);
                    *(u32x2*)(c + nt * 32 + 8 * g) = w;
                }
        }
    } };
struct EpiResid { const Params* p; const float* mod; int m0;
    DI void wave_tile(const f32x16 (&acc)[2][GEMM_MT], int mloc, int ncol, int lane) const {
        const int r = lane & 31, h = lane >> 5;
#pragma unroll
        for (int mt = 0; mt < GEMM_MT; ++mt) {
            const int row = m0 + mloc + mt * 32 + r;
            float* xr = xrow_ptr(*p, row) + ncol + 4 * h;
            const float* gp = mod + (size_t)mod_row(row) * 6144 + 2048 + ncol + 4 * h;
#pragma unroll
            for (int nt = 0; nt < 2; ++nt)
#pragma unroll
                for (int g = 0; g < 4; ++g) {
                    f32x4 x = *(f32x4*)(xr + nt * 32 + 8 * g);
                    const f32x4 gg = *(const f32x4*)(gp + nt * 32 + 8 * g);
                    x.x += gg.x * acc[nt][mt][4 * g]; x.y += gg.y * acc[nt][mt][4 * g + 1]; x.z += gg.z * acc[nt][mt][4 * g + 2]; x.w += gg.w * acc[nt][mt][4 * g + 3];
                    *(f32x4*)(xr + nt * 32 + 8 * g) = x;
                }
        }
    } };
struct EpiGlu { bf16_t* act; const unsigned* ent; const float* gates; int valid;
    DI void wave_tile(const f32x16 (&acc)[2][GEMM_MT], int mloc, int ncol, int lane) const {
        const int r = lane & 31, h = lane >> 5;
#pragma unroll
        for (int mt = 0; mt < GEMM_MT; ++mt) {
            const int i = mloc + mt * 32 + r;
            if (i < valid) {
                const unsigned a = ent[i];
                const float gw = gates[a];
                bf16_t* o = act + (size_t)a * DEXP + (ncol >> 6) * 32 + 4 * h;
#pragma unroll
                for (int g = 0; g < 4; ++g) {
                    float v[4];
#pragma unroll
                    for (int j = 0; j < 4; ++j) v[j] = silu_f(acc[0][mt][4 * g + j]) * acc[1][mt][4 * g + j] * gw;
                    u32x2 w; w.x = pk2(v[0], v[1]); w.y = pk2(v[2], v[3]);
                    *(u32x2*)(o + 8 * g) = w;
                }
            }
        }
    } };
struct EpiScatter { bf16_t* outp; const unsigned* ent; int valid;
    DI void wave_tile(const f32x16 (&acc)[2][GEMM_MT], int mloc, int ncol, int lane) const {
        const int r = lane & 31, h = lane >> 5;
#pragma unroll
        for (int mt = 0; mt < GEMM_MT; ++mt) {
            const int i = mloc + mt * 32 + r;
            if (i < valid) {
                bf16_t* c = outp + (size_t)ent[i] * 1024 + ncol + 4 * h;
#pragma unroll
                for (int nt = 0; nt < 2; ++nt)
#pragma unroll
                    for (int g = 0; g < 4; ++g) {
                        u32x2 w; w.x = pk2(acc[nt][mt][4 * g], acc[nt][mt][4 * g + 1]); w.y = pk2(acc[nt][mt][4 * g + 2], acc[nt][mt][4 * g + 3]);
                        *(u32x2*)(c + nt * 32 + 8 * g) = w;
                    }
            }
        }
    } };

#define SCHED_FENCE() __builtin_amdgcn_sched_barrier(0)
DI void glds16(const bf16_t* g, lds_ptr l) { __builtin_amdgcn_global_load_lds((const unsigned*)g, (LAS unsigned*)l, 16, 0, 0); }
template <int PROBE, int NAG>
DI void gemm_kstep(f32x16 (&acc)[2][GEMM_MT], const lds_ptr st, const unsigned (&arow)[GEMM_MT], const unsigned (&wrow)[2], const unsigned (&aswz)[GEMM_MT], const unsigned (&wswz)[2], int h,
                   bool issue, const bf16_t* __restrict__ An, const bf16_t* __restrict__ Wn, const unsigned (&ag)[NAG], unsigned astep, const unsigned (&bg)[2], unsigned bstep, const lds_ptr sn) {
    if (PROBE != 2 && issue) {
#pragma unroll
        for (int j = 0; j < 8; ++j) { glds16(An + (NAG == 2 ? ag[j & 1] + (j >> 1) * astep : ag[j % NAG]), sn + j * 1024); glds16(Wn + bg[j & 1] + (j >> 1) * bstep, sn + 32768 + j * 1024); }
    }
    if (PROBE == 1) return;
    bf16x8 af[2][GEMM_MT], wf[2][2];
#pragma unroll
    for (int t = 0; t < 2; ++t) wf[0][t] = *(const LAS bf16x8*)(st + wrow[t] + ((((unsigned)h) ^ wswz[t]) << 4));
#pragma unroll
    for (int t = 0; t < GEMM_MT; ++t) af[0][t] = *(const LAS bf16x8*)(st + arow[t] + ((((unsigned)h) ^ aswz[t]) << 4));
#pragma unroll
    for (int kk = 0; kk < 4; ++kk) {
        if (kk < 3) {
#pragma unroll
            for (int t = 0; t < 2; ++t) wf[(kk + 1) & 1][t] = *(const LAS bf16x8*)(st + wrow[t] + ((((unsigned)((kk + 1) * 2 + h)) ^ wswz[t]) << 4));
#pragma unroll
            for (int t = 0; t < GEMM_MT; ++t) af[(kk + 1) & 1][t] = *(const LAS bf16x8*)(st + arow[t] + ((((unsigned)((kk + 1) * 2 + h)) ^ aswz[t]) << 4));
        }
        SCHED_FENCE();
        __builtin_amdgcn_s_setprio(1);
#pragma unroll
        for (int mt = 0; mt < GEMM_MT; ++mt)
#pragma unroll
            for (int nt = 0; nt < 2; ++nt) acc[nt][mt] = MFMA32(wf[kk & 1][nt], af[kk & 1][mt], acc[nt][mt]);
        __builtin_amdgcn_s_setprio(0);
        SCHED_FENCE();
    }
}
template <class RowSrc, class Epi, int PROBE = 0>
DI void gemm_tile_mfma(unsigned char* smem, const RowSrc& rs, const bf16_t* __restrict__ Wt, int K, int n0, const Epi& epi, int tid) {
    const lds_ptr lds = (lds_ptr)smem;
    const int lane = tid & 63, wid = __builtin_amdgcn_readfirstlane(tid >> 6), wm = wid & 1, wn = wid >> 1, r = lane & 31, h = lane >> 5;
    const bool loader = wid < 4;
    const int lw = wid & 3;
    constexpr int NAG = RowSrc::DENSE ? 2 : 8;
    unsigned ag[NAG], bg[2];
    const bf16_t* __restrict__ Ab = rs.A;
#pragma unroll
    for (int j = 0; j < NAG; ++j) {
        const int row = (lw * 8 + j) * 8 + (lane >> 3), c = (lane & 7) ^ ((row >> 1) & 7);
        ag[j] = rs.row(row) + c * 8;
    }
#pragma unroll
    for (int j = 0; j < 2; ++j) {
        const int row = (lw * 8 + j) * 8 + (lane >> 3), c = (lane & 7) ^ ((row >> 1) & 7);
        bg[j] = (unsigned)(n0 + row) * (unsigned)K + c * 8;
    }
    const unsigned astep = 16u * (unsigned)rs.lda, bstep = 16u * (unsigned)K;
    const unsigned dmaoff = (unsigned)lw * 8192u;
    unsigned arow[GEMM_MT], wrow[2], aswz[GEMM_MT], wswz[2];
#pragma unroll
    for (int t = 0; t < GEMM_MT; ++t) { const int ra = wm * 128 + t * 32 + r; arow[t] = ra * 128; aswz[t] = (ra >> 1) & 7; }
#pragma unroll
    for (int t = 0; t < 2; ++t) { const int rw = wn * 64 + t * 32 + r; wrow[t] = 32768 + rw * 128; wswz[t] = (rw >> 1) & 7; }
    f32x16 acc[2][GEMM_MT];
#pragma unroll
    for (int a = 0; a < 2; ++a)
#pragma unroll
        for (int b = 0; b < GEMM_MT; ++b)
#pragma unroll
            for (int i = 0; i < 16; ++i) acc[a][b][i] = 0.f;
    if (loader) {
#pragma unroll
        for (int j = 0; j < 8; ++j) { glds16(Ab + (NAG == 2 ? ag[j & 1] + (j >> 1) * astep : ag[j % NAG]), lds + dmaoff + j * 1024); glds16(Wt + bg[j & 1] + (j >> 1) * bstep, lds + 32768 + dmaoff + j * 1024); }
    }
    asm volatile("s_waitcnt vmcnt(0)" ::: "memory");
    __syncthreads();
    const int KT = K >> 6;
    for (int kt = 0; kt < KT; ++kt) {
        gemm_kstep<PROBE, NAG>(acc, lds + (kt & 1) * GEMM_STAGE, arow, wrow, aswz, wswz, h, loader && kt + 1 < KT, Ab + (kt + 1) * 64, Wt + (kt + 1) * 64, ag, astep, bg, bstep, lds + ((kt + 1) & 1) * GEMM_STAGE + dmaoff);
        asm volatile("s_waitcnt vmcnt(0)" ::: "memory");
        __syncthreads();
    }
    if (PROBE == 0 || acc[0][0][0] == 12345.678f) epi.wave_tile(acc, wm * 128, n0 + wn * 64, lane);
}

template <int EPIK, int PROBE = 0>
DI void gemm_dense(const Params& p, unsigned char* smem, const bf16_t* A, int lda, const bf16_t* Wt, int K, int N, bf16_t* C, int ldc, const float* mod, int bid, int nb, int tid) {
    const int tn = N / GEMM_TN, total = (MROWS / GEMM_TM) * tn;
    for (int t = bid; t < total; t += nb) {
        const int mt = t / tn, nt = t - mt * tn;
        RowDense rs{A, lda, mt * GEMM_TM};
        if (EPIK == 0) { EpiStore e{C, ldc, mt * GEMM_TM}; gemm_tile_mfma<RowDense, EpiStore, PROBE>(smem, rs, Wt, K, nt * GEMM_TN, e, tid); }
        else { EpiResid e{&p, mod, mt * GEMM_TM}; gemm_tile_mfma(smem, rs, Wt, K, nt * GEMM_TN, e, tid); }
    }
}
template <int WHICH>
DI void gemm_moe(const Params& p, unsigned char* smem, int layer, int bid, int nb, int tid) {
    const unsigned* cnt = (const unsigned*)(p.ws + WS_CTL) + CW_CNT + layer * 32;
    const unsigned* list = (const unsigned*)(p.ws + WS_LIST);
    const float* gates = (const float*)(p.ws + WS_GATE);
    const bf16_t* H = (const bf16_t*)(p.ws + WS_H);
    bf16_t* act = (bf16_t*)(p.ws + WS_Q);
    bf16_t* eo = (bf16_t*)(p.ws + WS_RAW);
    constexpr int TN = WHICH == 0 ? 2 : 4;
    int total = 0;
    for (int e = 0; e < NEXP; ++e) total += (int)((cnt[e] + 255u) >> 8) * TN;
    for (int t = bid; t < total; t += nb) {
        int e = 0, rem = t;
        for (; e < NEXP; ++e) { const int te = (int)((cnt[e] + 255u) >> 8) * TN; if (rem < te) break; rem -= te; }
        const int rt = rem / TN, ct = rem - rt * TN;
        const unsigned* ent = list + (size_t)e * MROWS + rt * GEMM_TM;
        const int valid = min(GEMM_TM, (int)cnt[e] - rt * GEMM_TM);
        if (WHICH == 0) {
            RowGather rs{H, 1024, ent, valid, 1};
            EpiGlu ep{act, ent, gates, valid};
            gemm_tile_mfma(smem, rs, (const bf16_t*)(p.ws + W_GU) + ((size_t)layer * 32 + e) * 512 * 1024, 1024, ct * GEMM_TN, ep, tid);
        } else {
            RowGather rs{act, DEXP, ent, valid, 0};
            EpiScatter ep{eo, ent, valid};
            gemm_tile_mfma(smem, rs, (const bf16_t*)(p.ws + W_DN) + ((size_t)layer * 32 + e) * 1024 * 256, 256, ct * GEMM_TN, ep, tid);
        }
    }
}

DI float quad_sum(float v) { v += __shfl_xor(v, 1); v += __shfl_xor(v, 2); return v; }
DI void head64_norm_rope(const bf16_t* src, bf16_t* dst, const float* gain, int sub, bool rope, int prow, int pcol, float scale) {
    float a[8], b[8];
    unpack8(*(const u32x4*)(src + sub * 8), a); unpack8(*(const u32x4*)(src + 32 + sub * 8), b);
    float ss = 0.f;
#pragma unroll
    for (int e = 0; e < 8; ++e) ss += a[e] * a[e] + b[e] * b[e];
    ss = quad_sum(ss);
    const float rs = rsqrtf(ss * (1.0f / 64.0f) + EPS);
#pragma unroll
    for (int e = 0; e < 8; ++e) { a[e] *= rs * gain[sub * 8 + e]; b[e] *= rs * gain[32 + sub * 8 + e]; }
    if (rope) {
#pragma unroll
        for (int e = 0; e < 8; ++e) {
            const int i = sub * 8 + e;
            const float* cs = ROPE64 + ((i < 16 ? prow : pcol) * 16 + (i & 15)) * 2;
            const float c = cs[0], s = cs[1], x1 = a[e], x2 = b[e];
            a[e] = x1 * c - x2 * s; b[e] = x2 * c + x1 * s;
        }
    }
#pragma unroll
    for (int e = 0; e < 8; ++e) { a[e] *= scale; b[e] *= scale; }
    *(u32x4*)(dst + sub * 8) = pack8(a); *(u32x4*)(dst + 32 + sub * 8) = pack8(b);
}
template <int KIND>
DI void phase_post_qk(const Params& p, int bid, int nb, int tid) {
    const int wid = __builtin_amdgcn_readfirstlane(tid >> 6), lane = tid & 63, hd = lane >> 2, sub = lane & 3;
    constexpr int NRAW = KIND == 1 ? 1536 : 3072, KH = KIND == 1 ? 4 : 16;
    const bf16_t* raw = (const bf16_t*)(p.ws + WS_RAW);
    bf16_t* Q = (bf16_t*)(p.ws + WS_Q); bf16_t* Kb = (bf16_t*)(p.ws + WS_K);
    const float* qn = p.in[KIND == 0 ? 15 : KIND == 1 ? 20 : 32];
    const float* kn = p.in[KIND == 0 ? 16 : KIND == 1 ? 21 : 33];
    const float qscale = 0.125f * LOG2E;
    for (int r = bid * NW + wid; r < MROWS; r += nb * NW) {
        const int b = r / PP, pos = r - b * PP;
        const bool rope = (KIND != 0) && pos < SEQ;
        const int prow = (pos >> 6) & 63, pcol = pos & 63;
        const bf16_t* rr = raw + (size_t)r * NRAW;
        head64_norm_rope(rr + hd * 64, Q + (size_t)r * 1024 + hd * 64, qn, sub, rope, prow, pcol, qscale);
        if (hd < KH) head64_norm_rope(rr + 1024 + hd * 64, Kb + (size_t)r * (KH * 64) + hd * 64, kn, sub, rope, prow, pcol, 1.0f);
    }
}
DI void phase_post_mla1(const Params& p, int bid, int nb, int tid) {
    const int wid = __builtin_amdgcn_readfirstlane(tid >> 6), lane = tid & 63;
    const bf16_t* raw = (const bf16_t*)(p.ws + WS_Q);
    bf16_t* cqn = (bf16_t*)(p.ws + WS_O);
    bf16_t* ckvn = cqn + (size_t)MROWS * 384;
    bf16_t* krope = ckvn + (size_t)MROWS * 256;
    const float* qa = p.in[24]; const float* kva = p.in[25]; const float* kn = p.in[29];
    for (int r = bid * NW + wid; r < MROWS; r += nb * NW) {
        const int b = r / PP, pos = r - b * PP;
        const bf16_t* rr = raw + (size_t)r * 768;
        {
            float v[6];
#pragma unroll
            for (int j = 0; j < 3; ++j) { const unsigned w = *(const unsigned*)(rr + lane * 6 + 2 * j); v[2 * j] = bflo(w); v[2 * j + 1] = bfhi(w); }
            float ss = 0.f;
#pragma unroll
            for (int j = 0; j < 6; ++j) ss += v[j] * v[j];
            ss = wave_sum(ss);
            const float rs = rsqrtf(ss * (1.0f / 384.0f) + EPS);
#pragma unroll
            for (int j = 0; j < 3; ++j) *(unsigned*)(cqn + (size_t)r * 384 + lane * 6 + 2 * j) = pk2(v[2 * j] * rs * qa[lane * 6 + 2 * j], v[2 * j + 1] * rs * qa[lane * 6 + 2 * j + 1]);
        }
        {
            const u32x2 w = *(const u32x2*)(rr + 384 + lane * 4);
            float v[4] = {bflo(w.x), bfhi(w.x), bflo(w.y), bfhi(w.y)};
            float ss = v[0] * v[0] + v[1] * v[1] + v[2] * v[2] + v[3] * v[3];
            ss = wave_sum(ss);
            const float rs = rsqrtf(ss * (1.0f / 256.0f) + EPS);
            u32x2 o; o.x = pk2(v[0] * rs * kva[lane * 4], v[1] * rs * kva[lane * 4 + 1]); o.y = pk2(v[2] * rs * kva[lane * 4 + 2], v[3] * rs * kva[lane * 4 + 3]);
            *(u32x2*)(ckvn + (size_t)r * 256 + lane * 4) = o;
        }
        {
            float x1 = 0.f, x2 = 0.f;
            if (lane < 16) { x1 = bf2f(rr[640 + lane]); x2 = bf2f(rr[640 + 16 + lane]); }
            float ss = wave_sum(x1 * x1 + x2 * x2);
            const float rs = rsqrtf(ss * (1.0f / 32.0f) + EPS);
            if (lane < 16) {
                x1 *= rs * kn[64 + lane]; x2 *= rs * kn[64 + 16 + lane];
                if (pos < SEQ) {
                    const int prow = (pos >> 6) & 63, pcol = pos & 63;
                    const float* cs = ROPE32 + ((lane < 8 ? prow : pcol) * 8 + (lane & 7)) * 2;
                    const float c = cs[0], s = cs[1], a = x1, bb = x2;
                    x1 = a * c - bb * s; x2 = bb * c + a * s;
                }
            }
            {
                const int hh = lane >> 2, q = lane & 3;
                float vals[8];
#pragma unroll
                for (int j = 0; j < 8; ++j) { const int src = (8 * q + j) & 15; const float a = __shfl(x1, src), bb = __shfl(x2, src); vals[j] = q < 2 ? a : bb; }
                bf16_t* kr = (bf16_t*)(p.ws + WS_K) + (size_t)r * 1536 + 64;
                *(u32x4*)(kr + hh * 96 + 8 * q) = pack8(vals);
            }
        }
    }
}
DI void phase_post_mla2(const Params& p, int bid, int nb, int tid) {
    const int wid = __builtin_amdgcn_readfirstlane(tid >> 6), lane = tid & 63, hd = lane >> 2, sub = lane & 3;
    const bf16_t* qraw = (const bf16_t*)(p.ws + WS_RAW);
    const bf16_t* kvraw = qraw + (size_t)MROWS * 1536;
    const bf16_t* krope = (const bf16_t*)(p.ws + WS_O) + (size_t)MROWS * 640;
    bf16_t* Q = (bf16_t*)(p.ws + WS_Q); bf16_t* Kb = (bf16_t*)(p.ws + WS_K);
    const float* qn = p.in[28]; const float* kn = p.in[29];
    const float qscale = 0.10206207261596577f * LOG2E;
    for (int r = bid * NW + wid; r < MROWS; r += nb * NW) {
        const int b = r / PP, pos = r - b * PP;
        const bf16_t* qr = qraw + (size_t)r * 1536 + hd * 96;
        bf16_t* qo = Q + (size_t)r * 1536 + hd * 96;
        {
            float a[8], c[8];
            unpack8(*(const u32x4*)(qr + sub * 16), a); unpack8(*(const u32x4*)(qr + sub * 16 + 8), c);
            float ss = 0.f;
#pragma unroll
            for (int e = 0; e < 8; ++e) ss += a[e] * a[e] + c[e] * c[e];
            ss = quad_sum(ss);
            const float rs = rsqrtf(ss * (1.0f / 64.0f) + EPS) * qscale;
#pragma unroll
            for (int e = 0; e < 8; ++e) { a[e] *= rs * qn[sub * 16 + e]; c[e] *= rs * qn[sub * 16 + 8 + e]; }
            *(u32x4*)(qo + sub * 16) = pack8(a); *(u32x4*)(qo + sub * 16 + 8) = pack8(c);
        }
        {
            const u32x2 w1 = *(const u32x2*)(qr + 64 + sub * 4), w2 = *(const u32x2*)(qr + 64 + 16 + sub * 4);
            float x1[4] = {bflo(w1.x), bfhi(w1.x), bflo(w1.y), bfhi(w1.y)}, x2[4] = {bflo(w2.x), bfhi(w2.x), bflo(w2.y), bfhi(w2.y)};
            float ss = 0.f;
#pragma unroll
            for (int e = 0; e < 4; ++e) ss += x1[e] * x1[e] + x2[e] * x2[e];
            ss = quad_sum(ss);
            const float rs = rsqrtf(ss * (1.0f / 32.0f) + EPS);
#pragma unroll
            for (int e = 0; e < 4; ++e) {
                const int i = sub * 4 + e;
                float a = x1[e] * rs * qn[64 + i], bb = x2[e] * rs * qn[64 + 16 + i];
                if (pos < SEQ) {
                    const int prow = (pos >> 6) & 63, pcol = pos & 63;
                    const float* cs = ROPE32 + ((i < 8 ? prow : pcol) * 8 + (i & 7)) * 2;
                    const float c = cs[0], s = cs[1], t1 = a, t2 = bb;
                    a = t1 * c - t2 * s; bb = t2 * c + t1 * s;
                }
                x1[e] = a * qscale; x2[e] = bb * qscale;
            }
            u32x2 o1, o2; o1.x = pk2(x1[0], x1[1]); o1.y = pk2(x1[2], x1[3]); o2.x = pk2(x2[0], x2[1]); o2.y = pk2(x2[2], x2[3]);
            *(u32x2*)(qo + 64 + sub * 4) = o1; *(u32x2*)(qo + 64 + 16 + sub * 4) = o2;
        }
        {
            const bf16_t* kr = kvraw + (size_t)r * 2048 + hd * 128;
            bf16_t* ko = Kb + (size_t)r * 1536 + hd * 96;
            float a[8], c[8];
            unpack8(*(const u32x4*)(kr + sub * 16), a); unpack8(*(const u32x4*)(kr + sub * 16 + 8), c);
            float ss = 0.f;
#pragma unroll
            for (int e = 0; e < 8; ++e) ss += a[e] * a[e] + c[e] * c[e];
            ss = quad_sum(ss);
            const float rs = rsqrtf(ss * (1.0f / 64.0f) + EPS);
#pragma unroll
            for (int e = 0; e < 8; ++e) { a[e] *= rs * kn[sub * 16 + e]; c[e] *= rs * kn[sub * 16 + 8 + e]; }
            *(u32x4*)(ko + sub * 16) = pack8(a); *(u32x4*)(ko + sub * 16 + 8) = pack8(c);
            *(u32x4*)(ko + 64 + sub * 8) = *(const u32x4*)(krope + (size_t)r * 32 + sub * 8);
        }
    }
}
DI void phase_diff_combine(const Params& p, int bid, int nb, int tid) {
    const int wid = __builtin_amdgcn_readfirstlane(tid >> 6), lane = tid & 63, hd = lane >> 3, sub = lane & 7;
    const bf16_t* O12 = (const bf16_t*)(p.ws + WS_H);
    bf16_t* Oc = (bf16_t*)(p.ws + WS_Q);
    const float* lam = p.in[34]; const float* subln = p.in[35];
    const float lambda_init = 0.8f - 0.6f * 0.40656965974059917f;
    const float s1 = wave_sum(lam[lane] * lam[64 + lane]), s2 = wave_sum(lam[128 + lane] * lam[192 + lane]);
    const float lam_full = expf(s1) - expf(s2) + lambda_init;
    for (int r = bid * NW + wid; r < MROWS; r += nb * NW) {
        const bf16_t* o1 = O12 + (size_t)r * 2048 + (2 * hd) * 128 + sub * 16, *o2 = o1 + 128;
        float a[16], c[16];
        unpack8(*(const u32x4*)o1, *(float(*)[8])a); unpack8(*(const u32x4*)(o1 + 8), *(float(*)[8])(a + 8));
        unpack8(*(const u32x4*)o2, *(float(*)[8])c); unpack8(*(const u32x4*)(o2 + 8), *(float(*)[8])(c + 8));
        float ss = 0.f;
#pragma unroll
        for (int e = 0; e < 16; ++e) { a[e] -= lam_full * c[e]; ss += a[e] * a[e]; }
        ss += __shfl_xor(ss, 1); ss += __shfl_xor(ss, 2); ss += __shfl_xor(ss, 4);
        const float rs = rsqrtf(ss * (1.0f / 128.0f) + EPS) * (1.0f - lambda_init);
#pragma unroll
        for (int e = 0; e < 16; ++e) a[e] *= rs * subln[sub * 16 + e];
        bf16_t* o = Oc + (size_t)r * 1024 + hd * 128 + sub * 16;
        *(u32x4*)o = pack8(*(float(*)[8])a); *(u32x4*)(o + 8) = pack8(*(float(*)[8])(a + 8));
    }
}


typedef short s16x4 __attribute__((ext_vector_type(4)));
typedef float f32x2_t __attribute__((ext_vector_type(2)));
typedef __bf16 bf16x2_t __attribute__((ext_vector_type(2)));
DI unsigned cvtpk(float lo, float hi) { f32x2_t v = {lo, hi}; bf16x2_t b = __builtin_convertvector(v, bf16x2_t); return __builtin_bit_cast(unsigned, b); }
DI float xhalf_max(float v) { auto rr = __builtin_amdgcn_permlane32_swap(__float_as_uint(v), __float_as_uint(v), false, false); return fmaxf(__uint_as_float(rr[0]), __uint_as_float(rr[1])); }
DI float xhalf_sum(float v) { auto rr = __builtin_amdgcn_permlane32_swap(__float_as_uint(v), __float_as_uint(v), false, false); return __uint_as_float(rr[0]) + __uint_as_float(rr[1]); }
typedef short v4i16_t __attribute__((__vector_size__(4 * sizeof(short))));
DI s16x4 lds_tr(lds_ptr p) { return __builtin_bit_cast(s16x4, __builtin_amdgcn_ds_read_tr16_b64_v4i16((LAS v4i16_t*)p)); }
constexpr float ATT_BIG = 40.0f, ATT_BIGF = 1.0995116e12f;
DI int crow(int i, int hf) { return (i & 3) + 8 * (i >> 2) + 4 * hf; }

struct AttnP { const bf16_t* Q; int ldq; const bf16_t* K; int ldk; const bf16_t* V; int ldv; bf16_t* O; int ldo; int HQ; int gk; int gv; int vhs  ; const float* bias; const float* sink; int need_ctx; const float* kgain  ; const float* lam; const float* subln; unsigned char* Oc; int ldoc;   };

template <int DQ, int DV, int MODE, int ABL = 0>
DI void attn_mfma(const AttnP& a, unsigned char* smem, int bid, int nb, int tid) {
    constexpr int KSTR = DQ * 2 + 16, KTB = 64 * KSTR, VTB = 64 * DV * 2, NDB = DV / 32, NKK = DQ / 16;
    constexpr int KCH = DQ / 8, VCH = DV / 8, NKI = (64 * KCH + NTHREADS - 1) / NTHREADS, NVI = (64 * VCH + NTHREADS - 1) / NTHREADS;
    static_assert(2 * KTB + 2 * VTB + 2048 <= GEMM_LDS, "attention LDS");
    const lds_ptr lds = (lds_ptr)smem;
    LAS float* biasl = (LAS float*)(lds + 2 * KTB + 2 * VTB);
    const int lane = tid & 63, wid = __builtin_amdgcn_readfirstlane(tid >> 6), r = lane & 31, hf = lane >> 5;
    const int nq = a.need_ctx ? 17 : 16;
    const int xcd = bid & 7, slot = bid >> 3, nslots = nb >> 3, per_xcd = (NBATCH * a.HQ / 8) * nq;
    int koff[NKI], kdst[NKI], voff[NVI], vdst[NVI];
#pragma unroll
    for (int i = 0; i < NKI; ++i) { const int c = min(tid + NTHREADS * i, 64 * KCH - 1), row = c / KCH, kc = c - row * KCH; koff[i] = row * a.ldk + kc * 8; kdst[i] = row * KSTR + kc * 16; }
#pragma unroll
    for (int i = 0; i < NVI; ++i) { const int c = tid + NTHREADS * i, row = c / VCH, vc = c - row * VCH; voff[i] = row * a.ldv + vc * 8; vdst[i] = ((row >> 3) * NDB + (vc >> 2)) * 512 + (row & 7) * 64 + (vc & 3) * 16; }
    const int i16 = lane & 15, trq = i16 >> 2, trp = i16 & 3, grp = (lane >> 4) & 1;
    const int vtr0 = (4 * hf + trq) * 64 + 32 * grp + 8 * trp;
    constexpr bool PAIRED = (MODE == 2 && DV == 128);
    float lam_full = 0.f;
    if (PAIRED) { const float s1 = wave_sum(a.lam[lane] * a.lam[64 + lane]), s2 = wave_sum(a.lam[128 + lane] * a.lam[192 + lane]); lam_full = expf(s1) - expf(s2) + (0.8f - 0.6f * 0.40656965974059917f); }
    int it_i = 0;
    for (int j = slot; j < per_xcd; j += nslots, ++it_i) {
        const int nbh = NBATCH * a.HQ / 8;
        const int bhl = j < nbh * 16 ? j >> 4 : j - nbh * 16;
        int qt = j < nbh * 16 ? j & 15 : 16;
        int bh = bhl * 8 + xcd;
        if (MODE == 1) { const int P = (bhl >> 2) * 8 + xcd; bh = (P >> 2) * a.HQ + (P & 3) * 4 + (bhl & 3); }
        if (PAIRED) { const int pu = slot + nslots * (it_i >> 1); qt = pu & 15; bh = (pu >> 4) * a.HQ + 2 * xcd + (it_i & 1); }
        const int h = bh % a.HQ, b = bh / a.HQ;
        const bool is_ctx = qt >= 16;
        const int q0 = is_ctx ? SEQ : qt * 256;
        int t_lo = 0, n_lat = 0;
        if (!is_ctx) {
            if (MODE == 2) { t_lo = 0; n_lat = 64; }
            else if (MODE == 1) { t_lo = max(0, 4 * qt - 2); n_lat = min(63, 4 * qt + 5) - t_lo + 1; }
            else { const int r0 = 4 * qt; t_lo = min(max(r0 - 4, 0), 56); n_lat = min(max(r0 - 1, 0), 56) + 7 - t_lo + 1; }
        }
        const int ntiles = n_lat + 4;
        const int qw0 = q0 + wid * 32, qpos = qw0 + r;
        const size_t qrow = (size_t)b * PP + qpos;
        bf16x8 qf[NKK];
#pragma unroll
        for (int kk = 0; kk < NKK; ++kk) qf[kk] = *(const bf16x8*)(a.Q + qrow * a.ldq + h * DQ + kk * 16 + hf * 8);
        if (MODE == 0 && !is_ctx) { for (int i = tid; i < 465; i += NTHREADS) biasl[i] = a.bias[h * 465 + i] * LOG2E; }
        const bf16_t* Kg = a.K + (size_t)b * PP * a.ldk + (h >> a.gk) * DQ;
        const bf16_t* Vg = a.V + (size_t)b * PP * a.ldv + (h >> a.gv) * a.vhs;
        f32x16 o[NDB];
#pragma unroll
        for (int d = 0; d < NDB; ++d)
#pragma unroll
            for (int i = 0; i < 16; ++i) o[d][i] = 0.f;
        float mref = 0.f, l = 0.f;
        f32x16 negm;
#pragma unroll
        for (int i = 0; i < 16; ++i) negm[i] = 0.f;
        bool first = true;
        float lbig = 0.f;
        float one = 1.0f; asm volatile("" : "+v"(one));
#define ATT_TILE(IT) ((IT) < n_lat ? t_lo + (IT) : 64 + ((IT) - n_lat))
        auto tile_active = [&](int t) -> bool {
            if (t >= 64) return true;
            if (MODE == 1) return (t * 64 + 63 >= qw0 - 128) && (t * 64 <= qw0 + 31 + 128);
            if (MODE == 0) { const int rw = qw0 >> 6, row0 = min(max(rw - 4, 0), 56); return t >= row0 && t < row0 + 8; }
            return true;
        };
        auto qk = [&](f32x16 (&s)[2], const lds_ptr Kb) {
#pragma unroll
            for (int kk = 0; kk < NKK; ++kk)
#pragma unroll
                for (int kb = 0; kb < 2; ++kb) {
                    if (ABL & 4) { if (kk == 0) s[kb] = negm; }
                    else {
                    const bf16x8 kf = *(const LAS bf16x8*)(Kb + (kb * 32 + r) * KSTR + (kk * 2 + hf) * 16);
                    s[kb] = MFMA32(kf, qf[kk], kk == 0 ? negm : s[kb]);
                    }
                }
        };
        u32x4 kr[NKI], vr[NVI];
        {
            const int t0 = ATT_TILE(0), t1 = ATT_TILE(1);
            u32x4 k1[NKI];
#pragma unroll
            for (int i = 0; i < NKI; ++i) kr[i] = *(const u32x4*)(Kg + (size_t)t0 * 64 * a.ldk + koff[i]);
#pragma unroll
            for (int i = 0; i < NVI; ++i) vr[i] = *(const u32x4*)(Vg + (size_t)t0 * 64 * a.ldv + voff[i]);
#pragma unroll
            for (int i = 0; i < NKI; ++i) k1[i] = *(const u32x4*)(Kg + (size_t)t1 * 64 * a.ldk + koff[i]);
#pragma unroll
            for (int i = 0; i < NKI; ++i) { *(LAS u32x4*)(lds + kdst[i]) = kr[i]; *(LAS u32x4*)(lds + KTB + kdst[i]) = k1[i]; }
#pragma unroll
            for (int i = 0; i < NVI; ++i) *(LAS u32x4*)(lds + 2 * KTB + vdst[i]) = vr[i];
        }
        __syncthreads();
        f32x16 sc[2], sn[2];
        bool act_cur = tile_active(ATT_TILE(0)), act_nxt = false;
        if (act_cur) qk(sc, lds);
        __syncthreads();
        auto step = [&](const int it, const int e, const bool N2, const bool N1) {
            const int t = ATT_TILE(it);
            if (N2 && !(ABL & 8) && (!(ABL & 128) || e)) {
                const int tn = ATT_TILE(it + 2);
#pragma unroll
                for (int i = 0; i < NKI; ++i) kr[i] = *(const u32x4*)(Kg + (size_t)tn * 64 * a.ldk + koff[i]);
            }
            if (N1 && !(ABL & 8) && (!(ABL & 128) || e)) {
                const int tn = ATT_TILE(it + 1);
#pragma unroll
                for (int i = 0; i < NVI; ++i) vr[i] = *(const u32x4*)(Vg + (size_t)tn * 64 * a.ldv + voff[i]);
            }
            SCHED_FENCE();
            act_nxt = N1 && (MODE == 2 || tile_active(ATT_TILE(it + 1)));
            const lds_ptr Vb = lds + 2 * KTB + e * VTB;
            const bool do_cur = MODE == 2 || act_cur;
            if (do_cur) {
                if (t < 64 && MODE == 1 && !((t * 64 + 63 - qw0 <= 128) && (qw0 + 31 - t * 64 <= 128))) {
                    const int dbase = t * 64 + 4 * hf - qpos;
#pragma unroll
                    for (int kb = 0; kb < 2; ++kb)
#pragma unroll
                        for (int i = 0; i < 16; ++i) { const int c = kb * 32 + (i & 3) + 8 * (i >> 2); sc[kb][i] = (dbase > 128 - c || dbase < -128 - c) ? -INFINITY : sc[kb][i]; }
                }
                if (t < 64 && MODE == 0) {
                    const int qc = qpos & 63, rw = qpos >> 6, col0 = min(max(qc - 8, 0), 48);
                    const int brow = (t - rw + 7) * 31 + 15 - qc;
#pragma unroll
                    for (int kb = 0; kb < 2; ++kb)
#pragma unroll
                        for (int i = 0; i < 16; ++i) {
                            const int kc = kb * 32 + crow(i, hf);
                            const bool ok = kc >= col0 && kc < col0 + 16;
                            const float bv = biasl[ok ? brow + kc : 0];
                            sc[kb][i] = ok ? sc[kb][i] + bv : -INFINITY;
                        }
                }
                if (first || __builtin_amdgcn_ballot_w64(lbig > ATT_BIGF) != 0ull) {
                    float delta = lbig > ATT_BIGF ? ATT_BIG : 0.f;
                    if (first) {
                        float mx = sc[0][0];
#pragma unroll
                        for (int i = 1; i < 16; ++i) mx = fmaxf(mx, sc[0][i]);
#pragma unroll
                        for (int i = 0; i < 16; ++i) mx = fmaxf(mx, sc[1][i]);
                        mx = xhalf_max(mx);
                        delta = mx > -INFINITY ? mx : 0.f;
                    }
                    const float alpha = __builtin_amdgcn_exp2f(-delta);
                    l *= alpha; mref += delta;
#pragma unroll
                    for (int d = 0; d < NDB; ++d)
#pragma unroll
                        for (int i = 0; i < 16; ++i) o[d][i] *= alpha;
#pragma unroll
                    for (int kb = 0; kb < 2; ++kb)
#pragma unroll
                        for (int i = 0; i < 16; ++i) sc[kb][i] -= delta;
#pragma unroll
                    for (int i = 0; i < 16; ++i) negm[i] = -mref;
                    first = false;
                }
            }
            if (N1) qk(sn, lds + (e ^ 1) * KTB);
            if (do_cur) {
                float ls0 = 0.f, ls1 = 0.f;
#pragma unroll
                for (int kb = 0; kb < 2; ++kb)
#pragma unroll
                    for (int i = 0; i < 16; i += 2) {
                        const float p0 = (ABL & 1) ? sc[kb][i] : __builtin_amdgcn_exp2f(sc[kb][i]), p1 = (ABL & 1) ? sc[kb][i + 1] : __builtin_amdgcn_exp2f(sc[kb][i + 1]);
                        sc[kb][i] = p0; sc[kb][i + 1] = p1;
                        if (!(ABL & 16)) { ls0 += p0; ls1 = __builtin_fmaf(p1, one, ls1); }
                    }
                lbig = ls0 + ls1;
                l += lbig;
                bf16x8 pf[4];
#pragma unroll
                for (int kb = 0; kb < 2; ++kb)
#pragma unroll
                    for (int sp = 0; sp < 2; ++sp) {
                        u32x4 w;
                        w.x = cvtpk(sc[kb][8 * sp], sc[kb][8 * sp + 1]); w.y = cvtpk(sc[kb][8 * sp + 2], sc[kb][8 * sp + 3]);
                        w.z = cvtpk(sc[kb][8 * sp + 4], sc[kb][8 * sp + 5]); w.w = cvtpk(sc[kb][8 * sp + 6], sc[kb][8 * sp + 7]);
                        pf[kb * 2 + sp] = __builtin_bit_cast(bf16x8, w);
                    }
#pragma unroll
                for (int ks = 0; ks < 4; ++ks)
#pragma unroll
                    for (int d = 0; d < NDB; ++d) {
                        const lds_ptr vp = Vb + ((2 * ks) * NDB + d) * 512 + vtr0;
                        const s16x4 lo = lds_tr(vp), hi = lds_tr(vp + NDB * 512);
                        const bf16x8 vf = __builtin_shufflevector(lo, hi, 0, 1, 2, 3, 4, 5, 6, 7);
                        if (ABL & 2) { if (d == 0 && ks == 0) o[0][0] += __builtin_bit_cast(float, pf[0][0] | pf[1][0] | pf[2][0] | pf[3][0]) + __builtin_bit_cast(float, (int)vf[0]); } else
                        o[d] = MFMA32(vf, pf[ks], o[d]);
                    }
            }
            SCHED_FENCE();
            if (N2 && !(ABL & 8) && (!(ABL & 128) || e)) {
#pragma unroll
                for (int i = 0; i < NKI; ++i) *(LAS u32x4*)(lds + e * KTB + kdst[i]) = kr[i];
            }
            if (N1 && !(ABL & 8) && (!(ABL & 128) || e)) {
#pragma unroll
                for (int i = 0; i < NVI; ++i) *(LAS u32x4*)(lds + 2 * KTB + (e ^ 1) * VTB + vdst[i]) = vr[i];
            }
            if (!(ABL & 64) && (!(ABL & 128) || e)) __syncthreads();
#pragma unroll
            for (int kb = 0; kb < 2; ++kb) sc[kb] = sn[kb];
            act_cur = act_nxt;
        };
        int it = 0;
        for (; it + 3 < ntiles; it += 2) { step(it, 0, true, true); step(it + 1, 1, true, true); }
        if (ntiles - it == 3) { step(it, 0, true, true); step(it + 1, 1, false, true); step(it + 2, 0, false, false); }
        else { step(it, 0, false, true); step(it + 1, 1, false, false); }
#undef ATT_TILE
        l = xhalf_sum(l);
        if (a.sink) {
            l += __builtin_amdgcn_exp2f(a.sink[h] * LOG2E - mref);
        }
        const float inv = 1.0f / l;
        bf16_t* orow = a.O + qrow * a.ldo + h * DV + 4 * hf;
#pragma unroll
        for (int d = 0; d < NDB; ++d)
#pragma unroll
            for (int g = 0; g < 4; ++g) {
                if (DV == 64) {
                    *(unsigned*)((unsigned char*)a.O + qrow * a.ldo + h * DV + 4 * hf + d * 32 + 8 * g) = cvt_fp8x4(o[d][4 * g] * inv, o[d][4 * g + 1] * inv, o[d][4 * g + 2] * inv, o[d][4 * g + 3] * inv);
                } else {
                    u32x2 w; w.x = cvtpk(o[d][4 * g] * inv, o[d][4 * g + 1] * inv); w.y = cvtpk(o[d][4 * g + 2] * inv, o[d][4 * g + 3] * inv);
                    *(u32x2*)(orow + d * 32 + 8 * g) = w;
                }
            }
        if (PAIRED && (it_i & 1)) {
            asm volatile("s_waitcnt vmcnt(0)" ::: "memory");
            const float lambda_init = 0.8f - 0.6f * 0.40656965974059917f;
            const int sub = lane & 7, pair = h >> 1;
#pragma unroll
            for (int i4 = 0; i4 < 4; ++i4) {
                const size_t row = (size_t)b * PP + qw0 + i4 * 8 + (lane >> 3);
                const bf16_t* o1 = a.O + row * a.ldo + (2 * pair) * 128 + sub * 16, *o2 = o1 + 128;
                float av[16], cv[16];
                unpack8(*(const u32x4*)o1, *(float(*)[8])av); unpack8(*(const u32x4*)(o1 + 8), *(float(*)[8])(av + 8));
                unpack8(*(const u32x4*)o2, *(float(*)[8])cv); unpack8(*(const u32x4*)(o2 + 8), *(float(*)[8])(cv + 8));
                float ss = 0.f;
#pragma unroll
                for (int e = 0; e < 16; ++e) { av[e] -= lam_full * cv[e]; ss += av[e] * av[e]; }
                ss += __shfl_xor(ss, 1); ss += __shfl_xor(ss, 2); ss += __shfl_xor(ss, 4);
                const float rs = rsqrtf(ss * (1.0f / 128.0f) + EPS) * (1.0f - lambda_init);
#pragma unroll
                for (int e = 0; e < 16; ++e) av[e] *= rs * a.subln[sub * 16 + e];
                u32x4 w8; w8.x = cvt_fp8x4(av[0], av[1], av[2], av[3]); w8.y = cvt_fp8x4(av[4], av[5], av[6], av[7]); w8.z = cvt_fp8x4(av[8], av[9], av[10], av[11]); w8.w = cvt_fp8x4(av[12], av[13], av[14], av[15]);
                *(u32x4*)(a.Oc + row * (size_t)a.ldoc + pair * 128 + sub * 16) = w8;
            }
        }
    }
}

DI void attn_na(const AttnP& a, unsigned char* smem, int bid, int nb, int tid) {
    constexpr int DQ = 64, DV = 64, KSTR = DQ * 2 + 16, KTB = 64 * KSTR, VTB = 64 * DV * 2, NDB = 2, NKK = 4;
    const lds_ptr lds = (lds_ptr)smem;
    constexpr int BZ_TAB = 32, BZ_HEAD = 560, BZ_NINF = 16 * BZ_HEAD, BZ_N = BZ_NINF + 64;
    static_assert(4 * KTB + 4 * VTB + (BZ_N + 16) * 4 <= GEMM_LDS, "NA LDS");
    LAS float* biasl = (LAS float*)(lds + 4 * KTB + 4 * VTB);
    for (int i = tid; i < BZ_N; i += NTHREADS) {
        const int hh = i / BZ_HEAD, o = i - hh * BZ_HEAD;
        biasl[i] = i >= BZ_NINF ? -INFINITY : (o >= BZ_TAB && o < BZ_TAB + 465) ? a.bias[hh * 465 + o - BZ_TAB] * LOG2E : 0.f;
    }
    __syncthreads();
    {
        const int wv = __builtin_amdgcn_readfirstlane(tid >> 6), ln = tid & 63;
#pragma unroll
        for (int hh2 = 0; hh2 < 2; ++hh2) {
            const int hh = 2 * wv + hh2;
            float m = 0.f;
            for (int i = ln; i < 465; i += 64) m = fmaxf(m, biasl[hh * BZ_HEAD + BZ_TAB + i]);
#pragma unroll
            for (int d = 32; d >= 1; d >>= 1) m = fmaxf(m, __shfl_xor(m, d));
            if (ln == 0) biasl[BZ_N + hh] = m;
        }
    }
    float kmax = fabsf(a.kgain[tid & 63]);
#pragma unroll
    for (int d = 32; d >= 1; d >>= 1) kmax = fmaxf(kmax, __shfl_xor(kmax, d));
    kmax *= 8.0f * 1.01f;
    const int lane = tid & 63, wid = __builtin_amdgcn_readfirstlane(tid >> 6), r = lane & 31, hf = lane >> 5;
    const int nq = a.need_ctx ? 17 : 16;
    const int xcd = bid & 7, slot = bid >> 3, nslots = nb >> 3, per_xcd = (NBATCH * a.HQ / 8) * nq;
    const int krow_s = tid >> 3, kc_s = tid & 7;
    const int koff = krow_s * a.ldk + kc_s * 8, kdst = krow_s * KSTR + kc_s * 16, voff = krow_s * a.ldv + kc_s * 8;
    const int vdst = ((krow_s >> 3) * NDB + (kc_s >> 2)) * 512 + (krow_s & 7) * 64 + (kc_s & 3) * 16;
    const int i16 = lane & 15, trq = i16 >> 2, trp = i16 & 3, grp = (lane >> 4) & 1;
    const int vtr0 = (4 * hf + trq) * 64 + 32 * grp + 8 * trp;
    const int rp = wid >> 2, cq = wid & 3, k0 = cq == 0 ? 0 : cq == 1 ? 8 : cq == 2 ? 24 : 32;
    float one = 1.0f; asm volatile("" : "+v"(one));
    auto unit_of = [&](int j, int& b, int& h, int& qt, int& t_lo, int& n_lat) {
        const int nbh = NBATCH * a.HQ / 8;
        const int bhl = j < nbh * 16 ? j >> 4 : j - nbh * 16; qt = j < nbh * 16 ? j & 15 : 16;
        const int bh = bhl * 8 + xcd; h = bh % a.HQ; b = bh / a.HQ;
        t_lo = 0; n_lat = 0;
        if (qt < 16) { const int r0 = 4 * qt; t_lo = min(max(r0 - 4, 0), 56); n_lat = min(max(r0 - 1, 0), 56) + 7 - t_lo + 1; n_lat += n_lat & 1; }
    };
#define NA_TILE_OF(IT, TLO, NLAT) ((IT) < (NLAT) ? (TLO) + (IT) : 64 + ((IT) - (NLAT)))
    bf16x8 qf[NKK];
    u32x4 krA[2], vrA[2], krB[2], vrB[2];
    auto load_pair = [&](u32x4 (&kr)[2], u32x4 (&vr)[2], const bf16_t* Kg, const bf16_t* Vg, int t_lo, int n_lat, int pr) {
#pragma unroll
        for (int jj = 0; jj < 2; ++jj) {
            const int tn = NA_TILE_OF(2 * pr + jj, t_lo, n_lat);
            kr[jj] = *(const u32x4*)(Kg + (size_t)tn * 64 * a.ldk + koff); vr[jj] = *(const u32x4*)(Vg + (size_t)tn * 64 * a.ldv + voff);
        }
    };
    auto store_pair = [&](const u32x4 (&kr)[2], const u32x4 (&vr)[2], int e) {
#pragma unroll
        for (int jj = 0; jj < 2; ++jj) { *(LAS u32x4*)(lds + (2 * e + jj) * KTB + kdst) = kr[jj]; *(LAS u32x4*)(lds + 4 * KTB + (2 * e + jj) * VTB + vdst) = vr[jj]; }
    };
    auto qrow_of = [&](int b, int qt) -> size_t { const int qpos = qt >= 16 ? SEQ + wid * 32 + r : (4 * qt + 2 * rp + (r >> 4)) * 64 + 16 * cq + (r & 15); return (size_t)b * PP + qpos; };
    auto load_q = [&](int b, int h, int qt) {
        const size_t qrow = qrow_of(b, qt);
#pragma unroll
        for (int kk = 0; kk < NKK; ++kk) qf[kk] = *(const bf16x8*)(a.Q + qrow * a.ldq + h * DQ + kk * 16 + hf * 8);
    };
    if (slot >= per_xcd) return;
    int b, h, qt, t_lo, n_lat;
    unit_of(slot, b, h, qt, t_lo, n_lat);
    {
        load_q(b, h, qt);
        const bf16_t* Kg = a.K + (size_t)b * PP * a.ldk + h * DQ; const bf16_t* Vg = a.V + (size_t)b * PP * a.ldv + h * a.vhs;
        load_pair(krA, vrA, Kg, Vg, t_lo, n_lat, 0); store_pair(krA, vrA, 0); load_pair(krB, vrB, Kg, Vg, t_lo, n_lat, 1);
    }
    __syncthreads();
    for (int j = slot;;) {
        const int jn = j + nslots; const bool has_next = jn < per_xcd;
        int nb_, nh, nqt, nt_lo, nn_lat;
        unit_of(has_next ? jn : j, nb_, nh, nqt, nt_lo, nn_lat);
        const bf16_t* nKg = a.K + (size_t)nb_ * PP * a.ldk + nh * DQ; const bf16_t* nVg = a.V + (size_t)nb_ * PP * a.ldv + nh * a.vhs;
        const bool is_ctx = qt >= 16;
        const int r0 = 4 * qt;
        const int npair = (n_lat + 4) >> 1;
        const int qrw = r0 + 2 * rp + (r >> 4), qc = 16 * cq + (r & 15);
        const size_t qrow = qrow_of(b, qt);
        const bf16_t* Kg = a.K + (size_t)b * PP * a.ldk + h * DQ;
        const bf16_t* Vg = a.V + (size_t)b * PP * a.ldv + h * a.vhs;
        const int rwA = r0 + 2 * rp, wlo = min(max(rwA - 4, 0), 56), whi = min(max(rwA - 3, 0), 56) + 7;
        const int col0 = min(max(qc - 8, 0), 48), row0q = min(max(qrw - 4, 0), 56);
        const int lanebase = h * BZ_HEAD + BZ_TAB + (7 - qrw) * 31 + 15 - qc + k0 + 4 * hf;
        f32x16 o[NDB];
#pragma unroll
        for (int d = 0; d < NDB; ++d)
#pragma unroll
            for (int i = 0; i < 16; ++i) o[d][i] = 0.f;
        float l = 0.f;
        float qn2 = 0.f;
#pragma unroll
        for (int kk = 0; kk < NKK; ++kk)
#pragma unroll
            for (int jj = 0; jj < 8; ++jj) { const float qv = bf2f((bf16_t)qf[kk][jj]); qn2 = __builtin_fmaf(qv, qv, qn2); }
        qn2 = xhalf_sum(qn2);
        const float mref = __builtin_sqrtf(qn2) * kmax + biasl[BZ_N + h];
        f32x16 negmL;
#pragma unroll
        for (int i = 0; i < 16; ++i) { const int kc = k0 + crow(i, hf); negmL[i] = (kc >= col0 && kc < col0 + 16) ? -mref : -INFINITY; }
#define NA_TILE(IT) NA_TILE_OF(IT, t_lo, n_lat)
        auto ctx_tile = [&](const lds_ptr Kb, const lds_ptr Vb) {
            {
                f32x16 s[2], negm;
#pragma unroll
                for (int i = 0; i < 16; ++i) negm[i] = -mref;
#pragma unroll
                for (int kk = 0; kk < NKK; ++kk)
#pragma unroll
                    for (int kb = 0; kb < 2; ++kb) {
                        const bf16x8 kf = *(const LAS bf16x8*)(Kb + (kb * 32 + r) * KSTR + (kk * 2 + hf) * 16);
                        s[kb] = MFMA32(kf, qf[kk], kk == 0 ? negm : s[kb]);
                    }
                float ls0 = 0.f, ls1 = 0.f;
                bf16x8 pf[4];
#pragma unroll
                for (int kb = 0; kb < 2; ++kb) {
#pragma unroll
                    for (int i = 0; i < 16; i += 2) {
                        const float p0 = __builtin_amdgcn_exp2f(s[kb][i]), p1 = __builtin_amdgcn_exp2f(s[kb][i + 1]);
                        s[kb][i] = p0; s[kb][i + 1] = p1; ls0 += p0; ls1 = __builtin_fmaf(p1, one, ls1);
                    }
#pragma unroll
                    for (int sp = 0; sp < 2; ++sp) {
                        u32x4 w;
                        w.x = cvtpk(s[kb][8 * sp], s[kb][8 * sp + 1]); w.y = cvtpk(s[kb][8 * sp + 2], s[kb][8 * sp + 3]);
                        w.z = cvtpk(s[kb][8 * sp + 4], s[kb][8 * sp + 5]); w.w = cvtpk(s[kb][8 * sp + 6], s[kb][8 * sp + 7]);
                        pf[kb * 2 + sp] = __builtin_bit_cast(bf16x8, w);
                    }
                }
                l += ls0 + ls1;
#pragma unroll
                for (int ks = 0; ks < 4; ++ks)
#pragma unroll
                    for (int d = 0; d < NDB; ++d) {
                        const lds_ptr vp = Vb + ((2 * ks) * NDB + d) * 512 + vtr0;
                        const s16x4 lo = lds_tr(vp), hi = lds_tr(vp + NDB * 512);
                        o[d] = MFMA32(__builtin_shufflevector(lo, hi, 0, 1, 2, 3, 4, 5, 6, 7), pf[ks], o[d]);
                    }
            }
        };
        auto lat_tile = [&](const int t, const lds_ptr Kb, const lds_ptr Vb) {
            bf16x8 pf[2];
#pragma unroll
            for (int sp = 0; sp < 2; ++sp)
#pragma unroll
                for (int jj = 0; jj < 8; ++jj) pf[sp][jj] = 0;
            if (t >= wlo && t <= whi) {
                f32x16 s;
#pragma unroll
                for (int kk = 0; kk < NKK; ++kk) {
                    const bf16x8 kf = *(const LAS bf16x8*)(Kb + (k0 + r) * KSTR + (kk * 2 + hf) * 16);
                    s = MFMA32(kf, qf[kk], kk == 0 ? negmL : s);
                }
                const LAS float* bp = biasl + (((unsigned)(t - row0q) < 8u) ? lanebase + 31 * t : BZ_NINF);
#pragma unroll
                for (int i = 0; i < 16; ++i) s[i] += bp[crow(i, 0)];
                float ls0 = 0.f, ls1 = 0.f;
#pragma unroll
                for (int i = 0; i < 16; i += 2) {
                    const float p0 = __builtin_amdgcn_exp2f(s[i]), p1 = __builtin_amdgcn_exp2f(s[i + 1]);
                    s[i] = p0; s[i + 1] = p1; ls0 += p0; ls1 = __builtin_fmaf(p1, one, ls1);
                }
#pragma unroll
                for (int sp = 0; sp < 2; ++sp) {
                    u32x4 w;
                    w.x = cvtpk(s[8 * sp], s[8 * sp + 1]); w.y = cvtpk(s[8 * sp + 2], s[8 * sp + 3]);
                    w.z = cvtpk(s[8 * sp + 4], s[8 * sp + 5]); w.w = cvtpk(s[8 * sp + 6], s[8 * sp + 7]);
                    pf[sp] = __builtin_bit_cast(bf16x8, w);
                }
                l += ls0 + ls1;
            }
#pragma unroll
            for (int ks = 0; ks < 2; ++ks)
#pragma unroll
                for (int d = 0; d < NDB; ++d) {
                    const lds_ptr vp = Vb + (((k0 >> 3) + 2 * ks) * NDB + d) * 512 + vtr0;
                    const s16x4 lo = lds_tr(vp), hi = lds_tr(vp + NDB * 512);
                    o[d] = MFMA32(__builtin_shufflevector(lo, hi, 0, 1, 2, 3, 4, 5, 6, 7), pf[ks], o[d]);
                }
        };
#define NA_ITER(IP, E, KL, VL, KS, VS, LAT) do { \
            if ((IP) + 2 < npair) load_pair(KL, VL, Kg, Vg, t_lo, n_lat, (IP) + 2); \
            else if (has_next) load_pair(KL, VL, nKg, nVg, nt_lo, nn_lat, (IP) + 2 - npair); \
            SCHED_FENCE(); \
            if (LAT) { lat_tile(t_lo + 2 * (IP), lds + (2 * (E)) * KTB, lds + 4 * KTB + (2 * (E)) * VTB); lat_tile(t_lo + 2 * (IP) + 1, lds + (2 * (E) + 1) * KTB, lds + 4 * KTB + (2 * (E) + 1) * VTB); } \
            else { ctx_tile(lds + (2 * (E)) * KTB, lds + 4 * KTB + (2 * (E)) * VTB); ctx_tile(lds + (2 * (E) + 1) * KTB, lds + 4 * KTB + (2 * (E) + 1) * VTB); } \
            SCHED_FENCE(); \
            if ((IP) + 1 < npair || has_next) store_pair(KS, VS, (E) ^ 1); \
            __syncthreads(); } while (0)
        int ip = 0;
        for (; ip < (n_lat >> 1); ip += 2) { NA_ITER(ip, 0, krA, vrA, krB, vrB, true); NA_ITER(ip + 1, 1, krB, vrB, krA, vrA, true); }
        NA_ITER(ip, 0, krA, vrA, krB, vrB, false); NA_ITER(ip + 1, 1, krB, vrB, krA, vrA, false);
#undef NA_ITER
        if (has_next) load_q(nb_, nh, nqt);
#undef NA_TILE
        l = xhalf_sum(l);
        const float inv = 1.0f / l;
#pragma unroll
        for (int d = 0; d < NDB; ++d)
#pragma unroll
            for (int g = 0; g < 4; ++g)
                *(unsigned*)((unsigned char*)a.O + qrow * a.ldo + h * DV + 4 * hf + d * 32 + 8 * g) = cvt_fp8x4(o[d][4 * g] * inv, o[d][4 * g + 1] * inv, o[d][4 * g + 2] * inv, o[d][4 * g + 3] * inv);
        if (!has_next) break;
        j = jn; b = nb_; h = nh; qt = nqt; t_lo = nt_lo; n_lat = nn_lat;
    }
#undef NA_TILE_OF
}

template <class E> struct epi_fp8 { static constexpr int value = 0; };
typedef int v8i_t __attribute__((ext_vector_type(8)));
typedef int v4i_t __attribute__((ext_vector_type(4)));
namespace pg8 {
constexpr int BM = 256, BK = 64, HALF = 128, HTB = HALF * BK * 2  ;
DI int lds_byte(int r, int c) { const int st = (r >> 4) * 2 + (c >> 5), rr = r & 15, cc = c & 31, ob = rr * 64 + cc * 2; return st * 1024 + (ob ^ (((ob >> 9) & 1) << 5)); }
DI void stage_rc(int b, int& R, int& C) { const int st = b / 1024, sb = b % 1024, swz = sb ^ (((sb >> 9) & 1) << 5); R = (st >> 1) * 16 + swz / 64; C = (st & 1) * 32 + (swz % 64) / 2; }
DI int perm32(int rho) { const int n = rho >> 4, i = rho & 15; return 8 * (i >> 2) + 4 * n + (i & 3); }

template <class Epi, class Sched>
DI void gemm_phase(lds_ptr lds, const bf16_t* __restrict__ Aop, const int K, const Sched& S, const Epi& E, const int tid) {
    const int wid = __builtin_amdgcn_readfirstlane(tid >> 6), lane = tid & 63, wr = wid >> 2, wc = wid & 3, fr = lane & 15, fq = lane >> 4;
    const int nt = K / BK;
    int Ra[2], Ca[2]; unsigned voffB[2];
#pragma unroll
    for (int i = 0; i < 2; ++i) { int R, C; stage_rc(tid * 16 + i * 8192, R, C); const int Rb = Epi::PERM ? ((R & ~31) + perm32(R & 31)) : R;
        Ra[i] = R; Ca[i] = C; voffB[i] = (unsigned)(Rb * K + C) * 2u; }
    const size_t kstep = (size_t)(BK * 2);
    const size_t hstep = (size_t)HALF * K * 2;
    const unsigned ldsw = (unsigned)wid * 1024u;
    const int aoff = lds_byte(wr * 64 + fr, fq * 8), boff = lds_byte(wc * 32 + fr, fq * 8);
#define PG8_SA(b, h) (((b) * 2 + (h)) * HTB)
#define PG8_SB(b, h) ((4 + (b) * 2 + (h)) * HTB)
#define PG8_STAGE(bufoff, gbase, voff) do { const char* _gb = (const char*)(gbase); asm volatile("" : "+s"(_gb)); _Pragma("unroll") for (int _i = 0; _i < 2; ++_i) { \
        unsigned _o = (voff)[_i]; asm volatile("" : "+v"(_o)); \
        __builtin_amdgcn_global_load_lds((const unsigned*)(_gb + _o), (LAS unsigned*)(lds + (bufoff) + ldsw + _i * 8192), 16, 0, 0); } } while (0)
#define PG8_LDA(dst, b, h) do { _Pragma("unroll") for (int m = 0; m < 4; ++m) _Pragma("unroll") for (int k = 0; k < 2; ++k) dst[m][k] = *(const LAS bf16x8*)(lds + PG8_SA(b, h) + aoff + m * 2048 + k * 1024); } while (0)
#define PG8_LDB(dst, b, h) do { _Pragma("unroll") for (int n = 0; n < 2; ++n) _Pragma("unroll") for (int k = 0; k < 2; ++k) dst[n][k] = *(const LAS bf16x8*)(lds + PG8_SB(b, h) + boff + n * 2048 + k * 1024); } while (0)
typedef long i64x2_t __attribute__((ext_vector_type(2)));
#define PG8_MMA(ai, bj, At, Bt) do { __builtin_amdgcn_s_setprio(1); _Pragma("unroll") for (int m = 0; m < 4; ++m) _Pragma("unroll") for (int n = 0; n < 2; ++n) { \
        if (epi_fp8<Epi>::value == 2) { \
            const v8i_t _b = __builtin_shufflevector(__builtin_bit_cast(v4i_t, Bt[n][0]), __builtin_bit_cast(v4i_t, Bt[n][1]), 0, 1, 2, 3, 4, 5, 6, 7); \
            const v8i_t _a = __builtin_shufflevector(__builtin_bit_cast(v4i_t, At[m][0]), __builtin_bit_cast(v4i_t, At[m][1]), 0, 1, 2, 3, 4, 5, 6, 7); \
            acc[ai][bj][m][n] = __builtin_amdgcn_mfma_scale_f32_16x16x128_f8f6f4(_b, _a, acc[ai][bj][m][n], 0, 0, 0, 0, 0, 0); \
        } else { _Pragma("unroll") for (int k = 0; k < 2; ++k) { \
        if (epi_fp8<Epi>::value == 1) { const i64x2_t _b = __builtin_bit_cast(i64x2_t, Bt[n][k]), _a = __builtin_bit_cast(i64x2_t, At[m][k]); \
            acc[ai][bj][m][n] = __builtin_amdgcn_mfma_f32_16x16x32_fp8_fp8(_b[0], _a[0], acc[ai][bj][m][n], 0, 0, 0); \
            acc[ai][bj][m][n] = __builtin_amdgcn_mfma_f32_16x16x32_fp8_fp8(_b[1], _a[1], acc[ai][bj][m][n], 0, 0, 0); } \
        else acc[ai][bj][m][n] = __builtin_amdgcn_mfma_f32_16x16x32_bf16(Bt[n][k], At[m][k], acc[ai][bj][m][n], 0, 0, 0); } } } \
        __builtin_amdgcn_s_setprio(0); } while (0)
#define PG8_WAIT_V(n) asm volatile("s_waitcnt vmcnt(" #n ")" ::: "memory")
#define PG8_WAIT_L(n) asm volatile("s_waitcnt lgkmcnt(" #n ")" ::: "memory")
#define PG8_BAR __builtin_amdgcn_s_barrier()
#define PG8_SCHED __builtin_amdgcn_sched_barrier(0)
    typename Sched::Unit cur, nxt; int ui = 0;
    if (!S.next(0, cur)) return;
    f32x4 acc[2][2][4][2];
#pragma unroll
    for (int a = 0; a < 2; ++a)
#pragma unroll
        for (int b = 0; b < 2; ++b)
#pragma unroll
            for (int m = 0; m < 4; ++m)
#pragma unroll
                for (int n = 0; n < 2; ++n) acc[a][b][m][n] = (f32x4){0.f, 0.f, 0.f, 0.f};
    bf16x8 At[4][2], B0[2][2], B1[2][2];
    constexpr bool GATHER = Sched::GATHER;
    unsigned oc[2][2], on[2][2] = {{0u, 0u}, {0u, 0u}};
    size_t ubc[2] = {0, 0}, ubn[2] = {0, 0};
#pragma unroll
    for (int h = 0; h < 2; ++h) {
        if (!GATHER) ubc[h] = (size_t)S.a_off(cur, h * HALF) * 2u;
#pragma unroll
        for (int i = 0; i < 2; ++i) oc[h][i] = GATHER ? (S.a_off(cur, h * HALF + Ra[i]) + (unsigned)Ca[i]) * 2u : (unsigned)(Ra[i] * S.lda + Ca[i]) * 2u;
    }
    const char* gA = (const char*)Aop;
    const char* cB = (const char*)S.b_base(cur);
    PG8_STAGE(PG8_SB(0, 0), cB, voffB); PG8_STAGE(PG8_SB(0, 1), cB + hstep, voffB); PG8_STAGE(PG8_SA(0, 0), gA + ubc[0], oc[0]); PG8_STAGE(PG8_SA(0, 1), gA + ubc[1], oc[1]);
    if (wr == 1) PG8_BAR;
    PG8_WAIT_V(2); PG8_BAR;
    PG8_STAGE(PG8_SB(1, 0), cB + kstep, voffB); PG8_STAGE(PG8_SA(1, 0), gA + ubc[0] + kstep, oc[0]); PG8_STAGE(PG8_SB(1, 1), cB + hstep + kstep, voffB);
    PG8_WAIT_V(6); PG8_BAR;
    for (;;) {
        const bool has_next = S.next(ui + 1, nxt);
        const char* nB = has_next ? (const char*)S.b_base(nxt) : cB;
#pragma unroll
        for (int h = 0; h < 2; ++h) {
            if (!GATHER) ubn[h] = has_next ? (size_t)S.a_off(nxt, h * HALF) * 2u : ubc[h];
#pragma unroll
            for (int i = 0; i < 2; ++i) if (GATHER) { int R, C; stage_rc(((wid << 6) | lane_now()) * 16 + i * 8192, R, C);
                const unsigned* ip = S.a_ptr(nxt, h * HALF + R); if (epi_fp8<Epi>::value != 2) asm volatile("global_load_dword %0, %1, off" : "=v"(on[h][i]) : "v"(ip) : "memory"); }
        }
        const bool full = cur.half < 0;
        for (int t = 0; t < nt; t += 2) {
            const bool last = (t == nt - 2);
            const char* a1 = gA + (size_t)(t + 1) * kstep;
            const char* a2 = last ? gA : gA + (size_t)(t + 2) * kstep; const char* b2 = last ? nB : cB + (size_t)(t + 2) * kstep;
            const char* a3 = a2 + kstep; const char* b3 = b2 + kstep;
            size_t u2[2];
            if (GATHER && last) {
                if (epi_fp8<Epi>::value != 2) asm volatile("" : "+v"(on[0][0]), "+v"(on[0][1]), "+v"(on[1][0]), "+v"(on[1][1]));
#pragma unroll
                for (int i = 0; i < 2; ++i) { int R, C; stage_rc(((wid << 6) | lane_now()) * 16 + i * 8192, R, C);
                    if (epi_fp8<Epi>::value == 2) { on[0][i] = *S.a_ptr(nxt, R); on[1][i] = *S.a_ptr(nxt, HALF + R); }
                    oc[0][i] = (S.a_cvt(on[0][i]) + (unsigned)C) * 2u; on[1][i] = (S.a_cvt(on[1][i]) + (unsigned)C) * 2u; }
            }
#pragma unroll
            for (int h = 0; h < 2; ++h) u2[h] = last ? ubn[h] : ubc[h];
            PG8_LDB(B0, 0, 0); PG8_LDB(B1, 0, 1); PG8_SCHED; PG8_LDA(At, 0, 0); PG8_STAGE(PG8_SA(1, 1), a1 + ubc[1], oc[1]);
            if (GATHER && last) { oc[1][0] = on[1][0]; oc[1][1] = on[1][1]; }
            PG8_WAIT_V(8); PG8_WAIT_L(0); PG8_BAR; PG8_MMA(0, 0, At, B0); PG8_MMA(0, 1, At, B1); PG8_BAR; PG8_SCHED;
            PG8_LDA(At, 0, 1); PG8_STAGE(PG8_SB(0, 0), b2, voffB); PG8_STAGE(PG8_SB(0, 1), b2 + hstep, voffB); PG8_STAGE(PG8_SA(0, 0), a2 + u2[0], oc[0]);
            PG8_WAIT_V(8); PG8_WAIT_L(0); PG8_BAR; if (full) { PG8_MMA(1, 0, At, B0); PG8_MMA(1, 1, At, B1); } PG8_BAR; PG8_SCHED;
            PG8_LDB(B0, 1, 0); PG8_LDB(B1, 1, 1); PG8_SCHED; PG8_LDA(At, 1, 0); PG8_STAGE(PG8_SA(0, 1), a2 + u2[1], oc[1]);
            PG8_WAIT_V(8); PG8_WAIT_L(0); PG8_BAR; PG8_MMA(0, 0, At, B0); PG8_MMA(0, 1, At, B1); PG8_BAR; PG8_SCHED;
            PG8_LDA(At, 1, 1); PG8_STAGE(PG8_SB(1, 0), b3, voffB); PG8_STAGE(PG8_SB(1, 1), b3 + hstep, voffB); PG8_STAGE(PG8_SA(1, 0), a3 + u2[0], oc[0]);
            PG8_WAIT_V(8); PG8_WAIT_L(0); PG8_BAR; if (full) { PG8_MMA(1, 0, At, B0); PG8_MMA(1, 1, At, B1); } PG8_BAR; PG8_SCHED;
        }
        if (wr == 0) PG8_BAR;
        { const int ln = lane_now(); E(acc, cur, wr, wc, ln & 15, ln >> 4); }
        if (!has_next) break;
#pragma unroll
        for (int a = 0; a < 2; ++a)
#pragma unroll
            for (int b = 0; b < 2; ++b)
#pragma unroll
                for (int m = 0; m < 4; ++m)
#pragma unroll
                    for (int n = 0; n < 2; ++n) acc[a][b][m][n] = (f32x4){0.f, 0.f, 0.f, 0.f};
        cur = nxt; cB = nB; ++ui;
#pragma unroll
        for (int h = 0; h < 2; ++h) ubc[h] = ubn[h];
        if (wr == 1) PG8_BAR;
    }
    PG8_WAIT_V(0);
    PG8_BAR;
#undef PG8_SA
#undef PG8_SB
#undef PG8_STAGE
#undef PG8_LDA
#undef PG8_LDB
#undef PG8_MMA
#undef PG8_WAIT_V
#undef PG8_WAIT_L
#undef PG8_BAR
#undef PG8_SCHED
}
}

struct DenseSched {
    static constexpr bool GATHER = false;
    struct Unit { int pm, pn, half; };
    int nM, nN, nwg, G, c; const bf16_t* Bt; int K, lda; bool skip_ctx;
    DI void unit_of(int L, Unit& u) const {
        int wgid = L; { const int q = nwg / 8, r = nwg % 8, xcd = wgid % 8, off = wgid / 8; wgid = (xcd < r ? xcd * (q + 1) : r * (q + 1) + (xcd - r) * q) + off; }
        const int nig = 8 * nN, gid = wgid / nig, fm = gid * 8, gsz = (nM - fm) < 8 ? (nM - fm) : 8;
        u.pm = fm + ((wgid % nig) % gsz); u.pn = (wgid % nig) / gsz;
        if (skip_ctx) u.pm += u.pm >> 4;
    }
    DI bool next(int i, Unit& u) const {
        const int rounds = nwg / G, rem = nwg - rounds * G;
        if (i < rounds) { unit_of(i * G + c, u); u.half = -1; return true; }
        if (i > rounds || rem == 0) return false;
        if (2 * rem <= G) { if (c >= 2 * rem) return false; unit_of(rounds * G + (c >> 1), u); u.half = c & 1; return true; }
        if (c >= rem) return false;
        unit_of(rounds * G + c, u); u.half = -1; return true;
    }
    DI unsigned a_off(const Unit& u, int row) const { const int rr = u.half < 0 ? row : u.half * 128 + (row & 127); return (unsigned)(u.pm * 256 + rr) * (unsigned)lda; }
    DI const unsigned* a_ptr(const Unit&, int) const { return nullptr; }
    DI unsigned a_cvt(unsigned raw) const { return raw; }
    DI const bf16_t* b_base(const Unit& u) const { return Bt + (size_t)u.pn * 256 * K; }
};
struct MoeUnit { int e, pn, valid, half; const unsigned* ent; };
template <bool TAIL>
struct MoeSched {
    static constexpr bool GATHER = true;
    typedef MoeUnit Unit;
    const LAS int* tab; const unsigned* list; const unsigned* zero  ; const bf16_t* W; int K, N, TN, lda, shift, G, c, nwg;
    DI bool unit_of(int L, Unit& u) const {
        const int v = tab[1 + (lane_now() & 31)];
        const int e = __builtin_popcount((unsigned)__ballot(v <= L));
        if (e >= NEXP) return false;
        const int rem = L - __builtin_amdgcn_readfirstlane(tab[e]), cn = __builtin_amdgcn_readfirstlane(tab[40 + e]);
        const int rt = rem / TN; u.e = e; u.pn = rem - rt * TN; u.ent = list + (size_t)e * MROWS + rt * 256; u.valid = min(256, cn - rt * 256); return true;
    }
    int lo, n, GX, j;
    DI void place() { GX = G >> 3; j = c >> 3; const int per = ((((nwg + 7) >> 3) + TN - 1) / TN) * TN; lo = (c & 7) * per; n = max(0, min(per, nwg - lo)); }
    DI bool next(int i, Unit& u) const {
        u.ent = zero; u.valid = 1;
        const int rounds = n / GX, rem = n - rounds * GX;
        if (!TAIL) { u.half = -1; if (i >= rounds) return false; return unit_of(lo + i * GX + j, u); }
        if (i > 0 || rem == 0) return false;
        if (2 * rem <= GX) {
            if (j >= 2 * rem) return false;
            if (!unit_of(lo + rounds * GX + (j >> 1), u)) return false;
            u.half = j & 1; u.ent += u.half * 128; u.valid = min(128, u.valid - u.half * 128);
            return u.valid > 0;
        }
        u.half = -1; if (j >= rem) return false;
        return unit_of(lo + rounds * GX + j, u);
    }
    DI unsigned a_off(const Unit& u, int row) const { const int rr = (TAIL && u.half >= 0) ? (row & 127) : row; return (u.ent[rr < u.valid ? rr : u.valid - 1] >> shift) * (unsigned)lda; }
    DI const unsigned* a_ptr(const Unit& u, int row) const { const int rr = (TAIL && u.half >= 0) ? (row & 127) : row; return u.ent + (rr < u.valid ? rr : u.valid - 1); }
    DI unsigned a_cvt(unsigned raw) const { return (raw >> shift) * (unsigned)lda; }
    DI const bf16_t* b_base(const Unit& u) const { return W + ((size_t)u.e * N + (size_t)u.pn * 256) * K; }
};
typedef float f32x4_t __attribute__((ext_vector_type(4)));
struct XEpiStore {
    static constexpr bool PERM = true;
    bf16_t* C; int ldc;
    DI void operator()(const f32x4 (&acc)[2][2][4][2], const DenseSched::Unit& u, int wr, int wc, int fr, int fq) const {
        const int row0 = u.pm * 256 + (u.half > 0 ? 128 : 0) + wr * 64 + fr, col0 = u.pn * 256 + wc * 32 + 8 * fq;
#pragma unroll
        for (int ai = 0; ai < 2; ++ai) if (ai == 0 || u.half < 0)
#pragma unroll
            for (int m = 0; m < 4; ++m) { bf16_t* rowp = C + (size_t)(row0 + ai * 128 + m * 16) * ldc + col0;
#pragma unroll
                for (int bj = 0; bj < 2; ++bj) { const f32x4 v0 = acc[ai][bj][m][0], v1 = acc[ai][bj][m][1];
                    u32x4 w; w.x = cvtpk(v0[0], v0[1]); w.y = cvtpk(v0[2], v0[3]); w.z = cvtpk(v1[0], v1[1]); w.w = cvtpk(v1[2], v1[3]);
                    *(u32x4*)(rowp + bj * 128) = w; } }
    } };
struct XEpiStore8 {
    static constexpr bool PERM = true;
    bf16_t* C; int ldc;
    DI void operator()(const f32x4 (&acc)[2][2][4][2], const DenseSched::Unit& u, int wr, int wc, int fr, int fq) const {
        const int row0 = u.pm * 256 + (u.half > 0 ? 128 : 0) + wr * 64 + fr, col0 = u.pn * 256 + wc * 32 + 8 * fq;
#pragma unroll
        for (int ai = 0; ai < 2; ++ai) if (ai == 0 || u.half < 0)
#pragma unroll
            for (int m = 0; m < 4; ++m) { bf16_t* rowp = C + (size_t)(row0 + ai * 128 + m * 16) * ldc + col0;
#pragma unroll
                for (int bj = 0; bj < 2; ++bj) { const f32x4 v0 = acc[ai][bj][m][0] * (1.0f / 32.0f), v1 = acc[ai][bj][m][1] * (1.0f / 32.0f);
                    u32x4 w; w.x = cvtpk(v0[0], v0[1]); w.y = cvtpk(v0[2], v0[3]); w.z = cvtpk(v1[0], v1[1]); w.w = cvtpk(v1[2], v1[3]);
                    *(u32x4*)(rowp + bj * 128) = w; } }
    } };
template <> struct epi_fp8<XEpiStore8> { static constexpr int value = 2; };
struct XEpiResid {
    static constexpr bool PERM = true;
    const Params* p; const float* mod;
    DI void operator()(const f32x4 (&acc)[2][2][4][2], const DenseSched::Unit& u, int wr, int wc, int fr, int fq) const {
        const int row0 = u.pm * 256 + (u.half > 0 ? 128 : 0) + wr * 64 + fr, col0 = u.pn * 256 + wc * 32 + 8 * fq;
#pragma unroll
        for (int ai = 0; ai < 2; ++ai) if (ai == 0 || u.half < 0)
#pragma unroll
            for (int m = 0; m < 4; ++m) { const int row = row0 + ai * 128 + m * 16;
                bf16_t* xr = xb_row(*p, row) + col0; const float* gp = mod + (size_t)mod_row(row) * 6144 + 2048 + col0;
#pragma unroll
                for (int bj = 0; bj < 2; ++bj) {
                    const u32x4 xw = *(const u32x4*)(xr + bj * 128); const f32x4 g0 = *(const f32x4*)(gp + bj * 128), g1 = *(const f32x4*)(gp + bj * 128 + 4);
                    const f32x4 a0 = acc[ai][bj][m][0], a1 = acc[ai][bj][m][1];
                    u32x4 w;
                    w.x = cvtpk(bflo(xw.x) + g0[0] * a0[0], bfhi(xw.x) + g0[1] * a0[1]); w.y = cvtpk(bflo(xw.y) + g0[2] * a0[2], bfhi(xw.y) + g0[3] * a0[3]);
                    w.z = cvtpk(bflo(xw.z) + g1[0] * a1[0], bfhi(xw.z) + g1[1] * a1[1]); w.w = cvtpk(bflo(xw.w) + g1[2] * a1[2], bfhi(xw.w) + g1[3] * a1[3]);
                    *(u32x4*)(xr + bj * 128) = w; } }
    } };
struct XEpiResid8 {
    static constexpr bool PERM = true;
    const Params* p; const float* mod;
    DI void operator()(const f32x4 (&acc)[2][2][4][2], const DenseSched::Unit& u, int wr, int wc, int fr, int fq) const {
        const int row0 = u.pm * 256 + (u.half > 0 ? 128 : 0) + wr * 64 + fr, col0 = u.pn * 256 + wc * 32 + 8 * fq;
#pragma unroll
        for (int ai = 0; ai < 2; ++ai) if (ai == 0 || u.half < 0)
#pragma unroll
            for (int m = 0; m < 4; ++m) { const int row = row0 + ai * 128 + m * 16;
                bf16_t* xr = xb_row(*p, row) + col0; const float* gp = mod + (size_t)mod_row(row) * 6144 + 2048 + col0;
#pragma unroll
                for (int bj = 0; bj < 2; ++bj) {
                    const u32x4 xw = *(const u32x4*)(xr + bj * 128); const f32x4 g0 = *(const f32x4*)(gp + bj * 128) * (1.0f / 32.0f), g1 = *(const f32x4*)(gp + bj * 128 + 4) * (1.0f / 32.0f);
                    const f32x4 a0 = acc[ai][bj][m][0], a1 = acc[ai][bj][m][1];
                    u32x4 w;
                    w.x = cvtpk(bflo(xw.x) + g0[0] * a0[0], bfhi(xw.x) + g0[1] * a0[1]); w.y = cvtpk(bflo(xw.y) + g0[2] * a0[2], bfhi(xw.y) + g0[3] * a0[3]);
                    w.z = cvtpk(bflo(xw.z) + g1[0] * a1[0], bfhi(xw.z) + g1[1] * a1[1]); w.w = cvtpk(bflo(xw.w) + g1[2] * a1[2], bfhi(xw.w) + g1[3] * a1[3]);
                    *(u32x4*)(xr + bj * 128) = w; } }
    } };
template <> struct epi_fp8<XEpiResid8> { static constexpr int value = 2; };
struct XEpiGlu {
    static constexpr bool PERM = true;
    bf16_t* act; const float* gates;
    DI void operator()(const f32x4 (&acc)[2][2][4][2], const MoeUnit& u, int wr, int wc, int fr, int fq) const {
#pragma unroll
        for (int ai = 0; ai < 2; ++ai)
#pragma unroll
            for (int m = 0; m < 4; ++m) { const int i = ai * 128 + wr * 64 + m * 16 + fr;
                if (i < u.valid) { const unsigned a = u.ent[i]; const float gw = gates[a];
                    const f32x4 g0 = acc[ai][0][m][0], g1 = acc[ai][0][m][1], u0 = acc[ai][1][m][0], u1 = acc[ai][1][m][1];
                    float v[8];
#pragma unroll
                    for (int j = 0; j < 4; ++j) { v[j] = silu_f(g0[j]) * u0[j] * gw; v[4 + j] = silu_f(g1[j]) * u1[j] * gw; }
                    u32x4 w; w.x = cvtpk(v[0], v[1]); w.y = cvtpk(v[2], v[3]); w.z = cvtpk(v[4], v[5]); w.w = cvtpk(v[6], v[7]);
                    *(u32x4*)(act + (size_t)a * DEXP + u.pn * 128 + wc * 32 + 8 * fq) = w; } }
    } };
struct XEpiGlu8 : XEpiGlu {
    DI void operator()(const f32x4 (&acc)[2][2][4][2], const MoeUnit& u, int wr, int wc, int fr, int fq) const {
#pragma unroll
        for (int ai = 0; ai < 2; ++ai)
#pragma unroll
            for (int m = 0; m < 4; ++m) { const int i = ai * 128 + wr * 64 + m * 16 + fr;
                if (i < u.valid) { const unsigned a = u.ent[i]; const float gw = gates[a] * (1.0f / 32.0f);
                    const f32x4 g0 = acc[ai][0][m][0] * (1.0f / 32.0f), g1 = acc[ai][0][m][1] * (1.0f / 32.0f), u0 = acc[ai][1][m][0], u1 = acc[ai][1][m][1];
                    float v[8];
#pragma unroll
                    for (int j = 0; j < 4; ++j) { v[j] = silu_f(g0[j]) * u0[j] * gw; v[4 + j] = silu_f(g1[j]) * u1[j] * gw; }
                    u32x4 w; w.x = cvtpk(v[0], v[1]); w.y = cvtpk(v[2], v[3]); w.z = cvtpk(v[4], v[5]); w.w = cvtpk(v[6], v[7]);
                    *(u32x4*)(act + (size_t)a * DEXP + u.pn * 128 + wc * 32 + 8 * fq) = w; } }
    } };
template <> struct epi_fp8<XEpiGlu8> { static constexpr int value = 2; };
struct XEpiScatter {
    static constexpr bool PERM = true;
    bf16_t* outp;
    DI void operator()(const f32x4 (&acc)[2][2][4][2], const MoeUnit& u, int wr, int wc, int fr, int fq) const {
#pragma unroll
        for (int ai = 0; ai < 2; ++ai)
#pragma unroll
            for (int m = 0; m < 4; ++m) { const int i = ai * 128 + wr * 64 + m * 16 + fr;
                if (i < u.valid) { unsigned char* rowp = (unsigned char*)outp + (size_t)u.ent[i] * 1024 + u.pn * 256 + wc * 32 + 8 * fq;
#pragma unroll
                    for (int bj = 0; bj < 2; ++bj) { const f32x4 v0 = acc[ai][bj][m][0] * 16.f, v1 = acc[ai][bj][m][1] * 16.f;
                        u32x2 w; w.x = cvt_fp8x4(v0[0], v0[1], v0[2], v0[3]); w.y = cvt_fp8x4(v1[0], v1[1], v1[2], v1[3]);
                        *(u32x2*)(rowp + bj * 128) = w; } } }
    } };

template <int KIND>
struct XEpiQKV {
    static constexpr bool PERM = true;
    static constexpr int KW = KIND == 1 ? 256 : 1024, LDRAW = KIND == 1 ? 1536 : 3072;
    static constexpr float ASC = 1.0f / 32.0f;
    bf16_t* Q; bf16_t* Kb; bf16_t* RAW; const float* qn; const float* kn;
    DI void operator()(const f32x4 (&acc)[2][2][4][2], const DenseSched::Unit& u, int wr, int wc, int fr, int fq) const {
        const int col0 = u.pn * 256, row0 = u.pm * 256 + (u.half > 0 ? 128 : 0) + wr * 64 + fr;
        if (col0 >= 1024 + KW) {
#pragma unroll
            for (int ai = 0; ai < 2; ++ai) if (ai == 0 || u.half < 0)
#pragma unroll
                for (int m = 0; m < 4; ++m) { bf16_t* rowp = RAW + (size_t)(row0 + ai * 128 + m * 16) * LDRAW + col0 + wc * 32 + 8 * fq;
#pragma unroll
                    for (int bj = 0; bj < 2; ++bj) { const f32x4 v0 = acc[ai][bj][m][0] * ASC, v1 = acc[ai][bj][m][1] * ASC;
                        u32x4 w; w.x = cvtpk(v0[0], v0[1]); w.y = cvtpk(v0[2], v0[3]); w.z = cvtpk(v1[0], v1[1]); w.w = cvtpk(v1[2], v1[3]);
                        *(u32x4*)(rowp + bj * 128) = w; } }
            return;
        }
        const bool isq = col0 < 1024;
        const int head = isq ? 4 * u.pn + wc : ((col0 - 1024) >> 6) + wc;
        const float* gain = (isq ? qn : kn) + 8 * fq;
        const float scale = isq ? 0.125f * LOG2E : 1.0f;
        bf16_t* dstb = isq ? Q + head * 64 + 8 * fq : Kb + head * 64 + 8 * fq;
        const int ldd = isq ? 1024 : KW;
        f32x4 g[2][2];
#pragma unroll
        for (int bj = 0; bj < 2; ++bj)
#pragma unroll
            for (int n = 0; n < 2; ++n) g[bj][n] = *(const f32x4*)(gain + 32 * bj + 4 * n);
#pragma unroll
        for (int ai = 0; ai < 2; ++ai) if (ai == 0 || u.half < 0)
#pragma unroll
            for (int m = 0; m < 4; ++m) {
                const int row = row0 + ai * 128 + m * 16, b = row / PP, pos = row - b * PP;
                f32x4 v[2][2];
                float ss = 0.f;
#pragma unroll
                for (int bj = 0; bj < 2; ++bj)
#pragma unroll
                    for (int n = 0; n < 2; ++n) { v[bj][n] = acc[ai][bj][m][n] * ASC; ss += v[bj][n][0] * v[bj][n][0] + v[bj][n][1] * v[bj][n][1] + v[bj][n][2] * v[bj][n][2] + v[bj][n][3] * v[bj][n][3]; }
                ss += __shfl_xor(ss, 16); ss += __shfl_xor(ss, 32);
                const float rs = rsqrtf(ss * (1.0f / 64.0f) + EPS);
#pragma unroll
                for (int bj = 0; bj < 2; ++bj)
#pragma unroll
                    for (int n = 0; n < 2; ++n) v[bj][n] = v[bj][n] * rs * g[bj][n];
                if (KIND != 0 && pos < SEQ) {
                    const int prow = (pos >> 6) & 63, pcol = pos & 63;
                    const float* cs = ROPE64 + ((fq < 2 ? prow : pcol) * 16 + ((8 * fq) & 15)) * 2;
#pragma unroll
                    for (int n = 0; n < 2; ++n)
#pragma unroll
                        for (int j = 0; j < 4; ++j) {
                            const float c = cs[(4 * n + j) * 2], sn = cs[(4 * n + j) * 2 + 1], x1 = v[0][n][j], x2 = v[1][n][j];
                            v[0][n][j] = x1 * c - x2 * sn; v[1][n][j] = x2 * c + x1 * sn;
                        }
                }
                bf16_t* rowp = dstb + (size_t)row * ldd;
#pragma unroll
                for (int bj = 0; bj < 2; ++bj) { const f32x4 v0 = v[bj][0] * scale, v1 = v[bj][1] * scale;
                    u32x4 w; w.x = cvtpk(v0[0], v0[1]); w.y = cvtpk(v0[2], v0[3]); w.z = cvtpk(v1[0], v1[1]); w.w = cvtpk(v1[2], v1[3]);
                    *(u32x4*)(rowp + bj * 32) = w; }
            }
    } };
constexpr bool qkv_fp8(int kind) { return true; }
template <int KIND> struct epi_fp8<XEpiQKV<KIND>> { static constexpr int value = 2; };
template <int KIND>
DI void gemm_qkv_x(const Params& p, unsigned char* smem, const bf16_t* Wt, int N, const float* qn, const float* kn, int bid, int nb, int tid) {
    constexpr int KU = qkv_fp8(KIND) ? 512 : 1024;
    DenseSched S; S.nM = MROWS / 256; S.nN = N / 256; S.nwg = S.nM * S.nN; S.G = nb; S.c = bid; S.Bt = Wt; S.K = KU; S.lda = KU; S.skip_ctx = false;
    XEpiQKV<KIND> e{(bf16_t*)(p.ws + WS_Q), (bf16_t*)(p.ws + WS_K), (bf16_t*)(p.ws + WS_RAW), qn, kn};
    pg8::gemm_phase((lds_ptr)smem, (const bf16_t*)(p.ws + WS_H), KU, S, e, tid);
}
template <bool UQ>
struct XEpiMla {
    static constexpr bool PERM = true;
    bf16_t* Q; bf16_t* Kb; bf16_t* V; const float* qn; const float* kn;
    DI void operator()(const f32x4 (&acc)[2][2][4][2], const DenseSched::Unit& u, int wr, int wc, int fr, int fq) const {
        const int row0 = u.pm * 256 + (u.half > 0 ? 128 : 0) + wr * 64 + fr;
        if (u.pn < 4) {
            const int head = 4 * u.pn + wc;
            const float* gain = (UQ ? qn : kn) + 8 * fq;
            const float scale = UQ ? 0.10206207261596577f * LOG2E : 1.0f;
            bf16_t* dstb = (UQ ? Q : Kb) + head * 96 + 8 * fq;
            f32x4 g[2][2];
#pragma unroll
            for (int bj = 0; bj < 2; ++bj)
#pragma unroll
                for (int n = 0; n < 2; ++n) g[bj][n] = *(const f32x4*)(gain + 32 * bj + 4 * n);
#pragma unroll
            for (int ai = 0; ai < 2; ++ai) if (ai == 0 || u.half < 0)
#pragma unroll
                for (int m = 0; m < 4; ++m) {
                    const int row = row0 + ai * 128 + m * 16;
                    float ss = 0.f;
#pragma unroll
                    for (int bj = 0; bj < 2; ++bj)
#pragma unroll
                        for (int n = 0; n < 2; ++n) { const f32x4 v = acc[ai][bj][m][n]; ss += v[0] * v[0] + v[1] * v[1] + v[2] * v[2] + v[3] * v[3]; }
                    ss += __shfl_xor(ss, 16); ss += __shfl_xor(ss, 32);
                    const float rs = rsqrtf(ss * (1.0f / 64.0f) + EPS) * scale;
                    bf16_t* rowp = dstb + (size_t)row * 1536;
#pragma unroll
                    for (int bj = 0; bj < 2; ++bj) { const f32x4 v0 = acc[ai][bj][m][0] * rs * g[bj][0], v1 = acc[ai][bj][m][1] * rs * g[bj][1];
                        u32x4 w; w.x = cvtpk(v0[0], v0[1]); w.y = cvtpk(v0[2], v0[3]); w.z = cvtpk(v1[0], v1[1]); w.w = cvtpk(v1[2], v1[3]);
                        *(u32x4*)(rowp + bj * 32) = w; }
                }
        } else if (UQ) {
            const float scale = 0.10206207261596577f * LOG2E;
            const f32x4 g1 = *(const f32x4*)(qn + 64 + 4 * fq), g2 = *(const f32x4*)(qn + 64 + 16 + 4 * fq);
#pragma unroll
            for (int ai = 0; ai < 2; ++ai) if (ai == 0 || u.half < 0)
#pragma unroll
                for (int m = 0; m < 4; ++m) {
                    const int row = row0 + ai * 128 + m * 16, b = row / PP, pos = row - b * PP;
                    const int prow = (pos >> 6) & 63, pcol = pos & 63;
                    const float* cs = ROPE32 + ((fq < 2 ? prow : pcol) * 8 + ((4 * fq) & 7)) * 2;
#pragma unroll
                    for (int bj = 0; bj < 2; ++bj) {
                        f32x4 x1 = acc[ai][bj][m][0], x2 = acc[ai][bj][m][1];
                        float ss = x1[0] * x1[0] + x1[1] * x1[1] + x1[2] * x1[2] + x1[3] * x1[3] + x2[0] * x2[0] + x2[1] * x2[1] + x2[2] * x2[2] + x2[3] * x2[3];
                        ss += __shfl_xor(ss, 16); ss += __shfl_xor(ss, 32);
                        const float rs = rsqrtf(ss * (1.0f / 32.0f) + EPS);
                        x1 = x1 * rs * g1; x2 = x2 * rs * g2;
                        if (pos < SEQ) {
#pragma unroll
                            for (int j = 0; j < 4; ++j) { const float c = cs[2 * j], sn = cs[2 * j + 1], a1 = x1[j], a2 = x2[j]; x1[j] = a1 * c - a2 * sn; x2[j] = a2 * c + a1 * sn; }
                        }
                        x1 = x1 * scale; x2 = x2 * scale;
                        bf16_t* rowp = Q + (size_t)row * 1536 + (8 * (u.pn - 4) + 4 * bj + wc) * 96 + 64 + 4 * fq;
                        u32x2 w1, w2; w1.x = cvtpk(x1[0], x1[1]); w1.y = cvtpk(x1[2], x1[3]); w2.x = cvtpk(x2[0], x2[1]); w2.y = cvtpk(x2[2], x2[3]);
                        *(u32x2*)rowp = w1; *(u32x2*)(rowp + 16) = w2;
                    }
                }
        } else {
#pragma unroll
            for (int ai = 0; ai < 2; ++ai) if (ai == 0 || u.half < 0)
#pragma unroll
                for (int m = 0; m < 4; ++m) { bf16_t* rowp = V + (size_t)(row0 + ai * 128 + m * 16) * 1024 + (u.pn - 4) * 256 + wc * 32 + 8 * fq;
#pragma unroll
                    for (int bj = 0; bj < 2; ++bj) { const f32x4 v0 = acc[ai][bj][m][0], v1 = acc[ai][bj][m][1];
                        u32x4 w; w.x = cvtpk(v0[0], v0[1]); w.y = cvtpk(v0[2], v0[3]); w.z = cvtpk(v1[0], v1[1]); w.w = cvtpk(v1[2], v1[3]);
                        *(u32x4*)(rowp + bj * 128) = w; } }
        }
    } };
template <bool UQ>
DI void gemm_mla_x(const Params& p, unsigned char* smem, int bid, int nb, int tid) {
    bf16_t* O = (bf16_t*)(p.ws + WS_O);
    DenseSched S; S.nM = MROWS / 256; S.nN = (UQ ? 1536 : 2048) / 256; S.nwg = S.nM * S.nN; S.G = nb; S.c = bid; S.Bt = (const bf16_t*)(p.ws + (UQ ? W_UQ : W_UKV)); S.K = UQ ? 384 : 256; S.lda = S.K; S.skip_ctx = false;
    XEpiMla<UQ> e{(bf16_t*)(p.ws + WS_Q), (bf16_t*)(p.ws + WS_K), (bf16_t*)(p.ws + WS_RAW), p.in[28], p.in[29]};
    pg8::gemm_phase((lds_ptr)smem, UQ ? O : O + (size_t)MROWS * 384, S.K, S, e, tid);
}
template <int EPIK>
DI void gemm_dense_x(const Params& p, unsigned char* smem, const bf16_t* A, int lda, const bf16_t* Wt, int K, int N, bf16_t* C, int ldc, const float* mod, int bid, int nb, int tid, bool skip_ctx = false) {
    DenseSched S; S.nM = skip_ctx ? NBATCH * 16 : MROWS / 256; S.nN = N / 256; S.nwg = S.nM * S.nN; S.G = nb; S.c = bid; S.Bt = Wt; S.K = K; S.lda = lda; S.skip_ctx = skip_ctx;
    if (EPIK == 0) { XEpiStore e{C, ldc}; pg8::gemm_phase((lds_ptr)smem, A, K, S, e, tid); }
    else if (EPIK == 2) { XEpiStore8 e{C, ldc}; pg8::gemm_phase((lds_ptr)smem, A, K, S, e, tid); }
    else if (EPIK == 3) { XEpiResid8 e{&p, mod}; pg8::gemm_phase((lds_ptr)smem, A, K, S, e, tid); }
    else { XEpiResid e{&p, mod}; pg8::gemm_phase((lds_ptr)smem, A, K, S, e, tid); }
}
template <int WHICH, bool TAIL>
DI void gemm_moe_call(const Params& p, unsigned char* smem, int layer, int bid, int nb, int tid) {
    MoeSched<TAIL> S; S.list = (const unsigned*)(p.ws + WS_LIST); S.zero = (const unsigned*)(p.ws + WS_CTL) + 8192; S.G = nb; S.c = bid;
    {
        LAS int* tab = (LAS int*)(smem + GEMM_LDS);
        constexpr int TNc = WHICH == 0 ? 2 : 4;
        if (tid < 64) {
            const unsigned cv = tid < 32 ? ((const unsigned*)(p.ws + WS_CTL) + CW_CNT + layer * 32)[tid] : 0u;
            int incl = (int)((cv + 255u) >> 8) * TNc;
#pragma unroll
            for (int d = 1; d < 32; d <<= 1) { const int o = __shfl_up(incl, d); if (tid >= d) incl += o; }
            if (tid < 32) { tab[1 + tid] = incl; tab[40 + tid] = (int)cv; }
            if (tid == 0) tab[0] = 0;
        }
        __syncthreads();
        S.tab = tab; S.nwg = __builtin_amdgcn_readfirstlane(tab[32]);
    }
    if (WHICH == 0) { S.W = (const bf16_t*)(p.ws + W_GU + (size_t)layer * 32 * 512 * 1024); S.K = 512; S.N = 512; S.TN = 2; S.lda = 512; S.shift = 1;
        S.place(); XEpiGlu8 e{{(bf16_t*)(p.ws + WS_Q), (const float*)(p.ws + WS_GATE)}}; pg8::gemm_phase((lds_ptr)smem, (const bf16_t*)(p.ws + WS_H), 512, S, e, tid); }
    else { S.W = (const bf16_t*)(p.ws + W_DN) + (size_t)layer * 32 * 1024 * 256; S.K = 256; S.N = 1024; S.TN = 4; S.lda = DEXP; S.shift = 0;
        S.place(); XEpiScatter e{(bf16_t*)(p.ws + WS_RAW)}; pg8::gemm_phase((lds_ptr)smem, (const bf16_t*)(p.ws + WS_Q), 256, S, e, tid); }
}
template <int WHICH>
DI void gemm_moe_x(const Params& p, unsigned char* smem, int layer, int bid, int nb, int tid) {
    const int wv = __builtin_amdgcn_readfirstlane(tid >> 6);
    gemm_moe_call<WHICH, false>(p, smem, layer, bid, nb, (wv << 6) | lane_now());
    gemm_moe_call<WHICH, true>(p, smem, layer, bid, nb, (wv << 6) | lane_now());
}

constexpr int NPHASES = 2 + (7 + 7 + 9 + 7) + 1;
constexpr int SMEM_BYTES = GEMM_LDS + 512;

template <int KIND>
DI void layer_phases(const Params& p, int& ph, const int lo, const int hi, const XcdBarrier& bar, unsigned char* smem, int bid, int nb, int wid_u) {
    constexpr int L = KIND;
    const float* mod = (const float*)(p.ws + WS_MOD) + (size_t)L * 9 * 6144;
    bf16_t* H = (bf16_t*)(p.ws + WS_H); bf16_t* O = (bf16_t*)(p.ws + WS_O); bf16_t* RAW = (bf16_t*)(p.ws + WS_RAW);
    bf16_t* Q = (bf16_t*)(p.ws + WS_Q); bf16_t* Kb = (bf16_t*)(p.ws + WS_K);
#ifndef AABL
#define AABL 0
#endif
#ifndef GPROBE
#define GPROBE 0
#endif
#ifndef DUP_MASK
#define DUP_MASK 0ull
#endif
#define PHASE2(BODY, DUPBODY) do { if (lo <= ph && ph < hi) { const int tid = (wid_u << 6) | lane_now(); if ((DUP_MASK >> ph) & 1ull) { DUPBODY; xcd_barrier(bar, tid == 0); } BODY; } if (lo <= ph && ph + 1 < hi) xcd_barrier(bar, ((wid_u << 6) | lane_now()) == 0); ++ph; } while (0)
#define PHASE(...) PHASE2((__VA_ARGS__), (__VA_ARGS__))
    if (L == 0) PHASE(phase_rows<2 | 8 | 32>(p, L, 0, bid, nb, tid), phase_router_prep(p, bid, nb, tid));
    else PHASE2((phase_rows<3 | 32>(p, L, 0, bid, nb, tid)), (phase_rows<2 | 32>(p, L, 0, bid, nb, tid)));
    AttnP a{};
    if (KIND == 0) {
        PHASE(gemm_qkv_x<0>(p, smem, (const bf16_t*)(p.ws + W_QKV0), 3072, p.in[15], p.in[16], bid, nb, tid));
        a = AttnP{Q, 1024, Kb, 1024, RAW + 2048, 3072, O, 1024, 16, 0, 0, 64, p.in[17], nullptr, 1, p.in[16]};
        PHASE(attn_na(a, smem, bid, nb, tid));
        PHASE2((gemm_dense_x<3>(p, smem, O, 512, (const bf16_t*)(p.ws + W_O0), 512, 1024, nullptr, 0, mod, bid, nb, tid)), (gemm_dense_x<0>(p, smem, O, 1024, (const bf16_t*)(p.ws + W_O0), 1024, 1024, RAW, 1024, nullptr, bid, nb, tid)));
    } else if (KIND == 1) {
        PHASE(gemm_qkv_x<1>(p, smem, (const bf16_t*)(p.ws + W_QKV1), 1536, p.in[20], p.in[21], bid, nb, tid));
        a = AttnP{Q, 1024, Kb, 256, RAW + 1280, 1536, O, 1024, 16, 2, 2, 64, nullptr, p.in[22], 1};
        PHASE(attn_mfma<64, 64, 1>(a, smem, bid, nb, tid));
        PHASE2((gemm_dense_x<3>(p, smem, O, 512, (const bf16_t*)(p.ws + W_O1), 512, 1024, nullptr, 0, mod, bid, nb, tid)), (gemm_dense_x<0>(p, smem, O, 1024, (const bf16_t*)(p.ws + W_O1), 1024, 1024, RAW, 1024, nullptr, bid, nb, tid)));
    } else if (KIND == 2) {
        bf16_t* cqn = O; bf16_t* ckvn = O + (size_t)MROWS * 384;
        PHASE(gemm_dense_x<2>(p, smem, H, 512, (const bf16_t*)(p.ws + W_DQKV), 512, 768, Q, 768, nullptr, bid, nb, tid));
        PHASE(phase_post_mla1(p, bid, nb, tid));
        PHASE(gemm_mla_x<true>(p, smem, bid, nb, tid), gemm_mla_x<false>(p, smem, bid, nb, (wid_u << 6) | lane_now()));
        a = AttnP{Q, 1536, Kb, 1536, RAW, 1024, O, 1024, 16, 0, 0, 64, nullptr, nullptr, 1};
        PHASE(attn_mfma<96, 64, 2>(a, smem, bid, nb, tid));
        PHASE2((gemm_dense_x<3>(p, smem, O, 512, (const bf16_t*)(p.ws + W_O2), 512, 1024, nullptr, 0, mod, bid, nb, tid)), (gemm_dense_x<0>(p, smem, O, 1024, (const bf16_t*)(p.ws + W_O2), 1024, 1024, RAW, 1024, nullptr, bid, nb, tid)));
    } else {
        PHASE(gemm_qkv_x<3>(p, smem, (const bf16_t*)(p.ws + W_QKV3), 3072, p.in[32], p.in[33], bid, nb, tid));
        a = AttnP{Q, 1024, Kb, 1024, RAW + 2048, 3072, H  , 2048, 16, 0, 1, 128, nullptr, nullptr, 0, nullptr, p.in[34], p.in[35], (unsigned char*)RAW  , 6144};
        PHASE(attn_mfma<64, 128, 2>(a, smem, bid, nb, tid));
        PHASE(gemm_dense_x<3>(p, smem, RAW, 3072, (const bf16_t*)(p.ws + W_O3), 512, 1024, nullptr, 0, mod, bid, nb, tid, true));
    }
    PHASE(phase_router(p, smem, L, L == 3, bid, nb, tid));
    PHASE(gemm_moe_x<0>(p, smem, L, bid, nb, tid));
    PHASE(gemm_moe_x<1>(p, smem, L, bid, nb, tid));
}

__global__ void __launch_bounds__(NTHREADS, 2) mega(Params p, int lo, int hi) {
    extern __shared__ __attribute__((aligned(16))) unsigned char smem[];
    const int bid = blockIdx.x, nb = gridDim.x, wid_u = __builtin_amdgcn_readfirstlane(threadIdx.x >> 6);
    float* lds = (float*)smem;
    volatile LAS unsigned* xbw = (volatile LAS unsigned*)(smem + SMEM_BYTES - 16);
    if (threadIdx.x == 0) { xbw[0] = 0u; xbw[1] = 0u; }
    __syncthreads();
    XcdBarrier bar = xcd_barrier_post((unsigned*)(p.ws + WS_CTL), xbw);
    int ph = 0;
    PHASE(phase_prologue(p, lds, bid, nb, tid));
    PHASE(phase_mod_reduce(p, bid, nb, tid));
    layer_phases<0>(p, ph, lo, hi, bar, smem, bid, nb, wid_u);
    layer_phases<1>(p, ph, lo, hi, bar, smem, bid, nb, wid_u);
    layer_phases<2>(p, ph, lo, hi, bar, smem, bid, nb, wid_u);
    layer_phases<3>(p, ph, lo, hi, bar, smem, bid, nb, wid_u);
    PHASE2((phase_rows<1 | 16>(p, 3, 0, bid, nb, tid)), (void)0);
}

extern "C" void kernel_launch(void* const* d_in, const int* in_sizes, int n_in, void* d_out, int out_size, void* d_ws, size_t ws_size, hipStream_t stream) {
    (void)in_sizes; (void)out_size;
    if (n_in < 37 || ws_size < WS_END) { fprintf(stderr, "kernel_launch: unexpected inputs (n_in %d, ws %zu)\n", n_in, ws_size); return; }
    static int grid = 0;
    if (!grid) {
        int dev = 0, cus = 0, per_cu = 0;
        hipGetDevice(&dev);
        hipDeviceGetAttribute(&cus, hipDeviceAttributeMultiprocessorCount, dev);
        hipFuncSetAttribute((const void*)mega, hipFuncAttributeMaxDynamicSharedMemorySize, SMEM_BYTES);
        hipOccupancyMaxActiveBlocksPerMultiprocessor(&per_cu, mega, NTHREADS, SMEM_BYTES);
        if (per_cu < 1) per_cu = 1;
        grid = cus * (per_cu < 1 ? per_cu : 1);
    }
    Params p{};
    for (int i = 0; i < 37; ++i) p.in[i] = (const float*)d_in[i];
    p.out = (float*)d_out; p.ws = (unsigned char*)d_ws;
    hipMemsetAsync(p.ws + WS_CTL, 0, 65536, stream);
#if ONE_LAUNCH
    hipLaunchKernelGGL(mega, dim3(grid), dim3(NTHREADS), SMEM_BYTES, stream, p, 0, NPHASES);
#else
    for (int k = 0; k < NPHASES; ++k) hipLaunchKernelGGL(mega, dim3(grid), dim3(NTHREADS), SMEM_BYTES, stream, p, k, k + 1);
#endif
}
```

```cpp
#include <hip/hip_runtime.h>
#include <stdint.h>
#include <stdio.h>

#ifndef ONE_LAUNCH
#define ONE_LAUNCH 1
#endif

#define DI __device__ __forceinline__
typedef unsigned short bf16_t;
typedef short bf16x8 __attribute__((ext_vector_type(8)));
typedef float f32x4 __attribute__((ext_vector_type(4)));
typedef float f32x16 __attribute__((ext_vector_type(16)));
typedef unsigned u32x4 __attribute__((ext_vector_type(4)));
typedef unsigned u32x2 __attribute__((ext_vector_type(2)));

constexpr int DM = 1024, NBATCH = 8, SEQ = 4096, CTXL = 256, PP = SEQ + CTXL, MROWS = NBATCH * PP;
constexpr int NEXP = 32, DEXP = 256;
constexpr float EPS = 1e-6f, LOG2E = 1.4426950408889634f;
constexpr int NTHREADS = 512, NW = NTHREADS / 64;

constexpr size_t MiB = 1ull << 20;
constexpr size_t WS_RAW_FWD = 380ull << 20;
constexpr size_t WS_CTL = 0, CTL_BYTES = 1 * MiB;
constexpr size_t WS_MOD = 1 * MiB;
constexpr size_t WS_MODP = WS_RAW_FWD;
constexpr size_t WS_XCTX = 9 * MiB;
constexpr size_t WS_LIST = 17 * MiB;
constexpr size_t WS_GATE = 22 * MiB;
constexpr size_t WS_W = 24 * MiB;
constexpr size_t W_QKV0 = WS_W + 0 * MiB, W_O0 = WS_W + 6 * MiB, W_QKV1 = WS_W + 8 * MiB, W_O1 = WS_W + 11 * MiB, W_DQKV = WS_W + 13 * MiB,
                 W_UQ = WS_W + 15 * MiB, W_UKV = WS_W + 17 * MiB, W_O2 = WS_W + 18 * MiB, W_QKV3 = WS_W + 20 * MiB, W_O3 = WS_W + 26 * MiB,
                 W_GU = WS_W + 28 * MiB, W_DN = WS_W + 156 * MiB;
constexpr size_t WS_H = 244 * MiB;
constexpr size_t WS_O = 312 * MiB;
constexpr size_t WS_RAW = 380 * MiB;
constexpr size_t WS_Q = 620 * MiB;
constexpr size_t WS_K = 722 * MiB;
constexpr size_t WS_XB = 824 * MiB;
constexpr size_t WS_END = 892 * MiB;
constexpr int CW_CNT = 4096;

constexpr size_t WS_RW = 2 * MiB;
struct Params { const float* in[37]; float* out; unsigned char* ws; };

DI unsigned f2bf(float f) { unsigned u = __float_as_uint(f); return (u + 0x7fffu + ((u >> 16) & 1u)) >> 16; }
DI float bf2f(unsigned h) { return __uint_as_float(h << 16); }
DI unsigned pk2(float lo, float hi) { return f2bf(lo) | (f2bf(hi) << 16); }
DI float bflo(unsigned w) { return __uint_as_float(w << 16); }
DI float bfhi(unsigned w) { return __uint_as_float(w & 0xffff0000u); }
DI int lane_now() { unsigned lane; asm volatile("v_mbcnt_lo_u32_b32 %0, -1, 0\n\tv_mbcnt_hi_u32_b32 %0, -1, %0" : "=v"(lane)); return (int)lane; }
DI float wave_sum(float v) {
#pragma unroll
    for (int o = 32; o > 0; o >>= 1) v += __shfl_xor(v, o);
    return v;
}
DI float silu_f(float x) { return x / (1.0f + __expf(-x)); }
DI void unpack8(const u32x4 w, float (&f)[8]) {
    f[0] = bflo(w.x); f[1] = bfhi(w.x); f[2] = bflo(w.y); f[3] = bfhi(w.y); f[4] = bflo(w.z); f[5] = bfhi(w.z); f[6] = bflo(w.w); f[7] = bfhi(w.w);
}
DI u32x4 pack8(const float (&f)[8]) { u32x4 w; w.x = pk2(f[0], f[1]); w.y = pk2(f[2], f[3]); w.z = pk2(f[4], f[5]); w.w = pk2(f[6], f[7]); return w; }
DI float* xrow_ptr(const Params& p, int r) {
    const int b = r / PP, pos = r - b * PP;
    return pos < SEQ ? p.out + ((size_t)b * SEQ + pos) * DM : (float*)(p.ws + WS_XCTX) + ((size_t)b * CTXL + (pos - SEQ)) * DM;
}
DI bf16_t* xb_row(const Params& p, int r) { return (bf16_t*)(p.ws + WS_XB) + (size_t)r * DM; }
DI int mod_row(int r) { const int b = r / PP, pos = r - b * PP; return pos < SEQ ? b : 8; }
__device__ const float ROPE64[2048] = {
  1.000000000e+00f, 0.000000000e+00f, 1.000000000e+00f, 0.000000000e+00f, 1.000000000e+00f, 0.000000000e+00f, 1.000000000e+00f, 0.000000000e+00f,
  1.000000000e+00f, 0.000000000e+00f, 1.000000000e+00f, 0.000000000e+00f, 1.000000000e+00f, 0.000000000e+00f, 1.000000000e+00f, 0.000000000e+00f,
  1.000000000e+00f, 0.000000000e+00f, 1.000000000e+00f, 0.000000000e+00f, 1.000000000e+00f, 0.000000000e+00f, 1.000000000e+00f, 0.000000000e+00f,
  1.000000000e+00f, 0.000000000e+00f, 1.000000000e+00f, 0.000000000e+00f, 1.000000000e+00f, 0.000000000e+00f, 1.000000000e+00f, 0.000000000e+00f,
  5.403022766e-01f, 8.414709568e-01f, 8.460091352e-01f, 5.331684351e-01f, 9.504152536e-01f, 3.109835982e-01f, 9.842302203e-01f, 1.768921912e-01f,
  9.950041771e-01f, 9.983342141e-02f, 9.984192848e-01f, 5.620449781e-02f, 9.995000362e-01f, 3.161750361e-02f, 9.998418689e-01f, 1.778185740e-02f,
  9.999499917e-01f, 9.999833070e-03f, 9.999842048e-01f, 5.623383448e-03f, 9.999949932e-01f, 3.162272274e-03f, 9.999983907e-01f, 1.778278500e-03f,
  9.999995232e-01f, 9.999999311e-04f, 9.999998212e-01f, 5.623412435e-04f, 9.999999404e-01f, 3.162277571e-04f, 1.000000000e+00f, 1.778279402e-04f,
  -4.161468446e-01f, 9.092974067e-01f, 4.314628243e-01f, 9.021307230e-01f, 8.065783978e-01f, 5.911270976e-01f, 9.374182820e-01f, 3.482052684e-01f,
  9.800665975e-01f, 1.986693293e-01f, 9.936820865e-01f, 1.122313142e-01f, 9.980006814e-01f, 6.320339441e-02f, 9.993675947e-01f, 3.555808961e-02f,
  9.998000264e-01f, 1.999866590e-02f, 9.999367595e-01f, 1.124658901e-02f, 9.999799728e-01f, 6.324512884e-03f, 9.999936819e-01f, 3.556551412e-03f,
  9.999979734e-01f, 1.999998698e-03f, 9.999993443e-01f, 1.124682371e-03f, 9.999998212e-01f, 6.324554561e-04f, 9.999999404e-01f, 3.556558804e-04f,
  -9.899924994e-01f, 1.411200017e-01f, -1.159661636e-01f, 9.932531714e-01f, 5.827536583e-01f, 8.126488924e-01f, 8.610406518e-01f, 5.085361004e-01f,
  9.553365111e-01f, 2.955202162e-01f, 9.858034849e-01f, 1.679033041e-01f, 9.955033660e-01f, 9.472608566e-02f, 9.985772967e-01f, 5.332308263e-02f,
  9.995500445e-01f, 2.999549918e-02f, 9.998577237e-01f, 1.686943881e-02f, 9.999549985e-01f, 9.486690164e-03f, 9.999857545e-01f, 5.334813148e-03f,
  9.999955297e-01f, 2.999995602e-03f, 9.999985695e-01f, 1.687023090e-03f, 9.999995232e-01f, 9.486831259e-04f, 9.999998808e-01f, 5.334838061e-04f,
  -6.536436081e-01f, -7.568024993e-01f, -6.276797056e-01f, 7.784717083e-01f, 3.011374772e-01f, 9.535807371e-01f, 7.575061917e-01f, 6.528279781e-01f,
  9.210609794e-01f, 3.894183338e-01f, 9.748082757e-01f, 2.230444849e-01f, 9.920106530e-01f, 1.261540651e-01f, 9.974712729e-01f, 7.107120752e-02f,
  9.992001057e-01f, 3.998933360e-02f, 9.997470379e-01f, 2.249175683e-02f, 9.999200106e-01f, 1.264877338e-02f, 9.999747276e-01f, 7.113057654e-03f,
  9.999920130e-01f, 3.999989480e-03f, 9.999974966e-01f, 2.249363344e-03f, 9.999992251e-01f, 1.264910679e-03f, 9.999997616e-01f, 7.113117026e-04f,
  2.836622000e-01f, -9.589242935e-01f, -9.460792542e-01f, 3.239352703e-01f, -1.034233812e-02f, 9.999465346e-01f, 6.300802827e-01f, 7.765299678e-01f,
  8.775825500e-01f, 4.794255495e-01f, 9.607312679e-01f, 2.774805427e-01f, 9.875259995e-01f, 1.574558765e-01f, 9.960497618e-01f, 8.879686147e-02f,
  9.987502694e-01f, 4.997916520e-02f, 9.996047616e-01f, 2.811336145e-02f, 9.998750091e-01f, 1.581072807e-02f, 9.999604821e-01f, 8.891279809e-03f,
  9.999874830e-01f, 4.999979399e-03f, 9.999960661e-01f, 2.811702900e-03f, 9.999987483e-01f, 1.581138116e-03f, 9.999995828e-01f, 8.891395992e-04f,
  9.601702690e-01f, -2.794154882e-01f, -9.731037021e-01f, -2.303675115e-01f, -3.207964003e-01f, 9.471482038e-01f, 4.827820361e-01f, 8.757405281e-01f,
  8.253356218e-01f, 5.646424890e-01f, 9.436169863e-01f, 3.310393095e-01f, 9.820539355e-01f, 1.886002719e-01f, 9.943132997e-01f, 1.064944416e-01f,
  9.982005358e-01f, 5.996400490e-02f, 9.994308352e-01f, 3.373407945e-02f, 9.998199940e-01f, 1.897252724e-02f, 9.999430776e-01f, 1.066947449e-02f,
  9.999819994e-01f, 5.999964196e-03f, 9.999943376e-01f, 3.374041524e-03f, 9.999982119e-01f, 1.897365320e-03f, 9.999994040e-01f, 1.066967379e-03f,
  7.539022565e-01f, 6.569865942e-01f, -7.004297972e-01f, -7.137212753e-01f, -5.994374752e-01f, 8.004215956e-01f, 3.202570081e-01f, 9.473307133e-01f,
  7.648422122e-01f, 6.442176700e-01f, 9.235194325e-01f, 3.835515678e-01f, 9.755998850e-01f, 2.195560932e-01f, 9.922624230e-01f, 1.241583377e-01f,
  9.975510240e-01f, 6.994284689e-02f, 9.992253184e-01f, 3.935372457e-02f, 9.997550249e-01f, 2.213413455e-02f, 9.999225140e-01f, 1.244763471e-02f,
  9.999755025e-01f, 6.999942940e-03f, 9.999922514e-01f, 3.936378751e-03f, 9.999975562e-01f, 2.213592408e-03f, 9.999992251e-01f, 1.244795276e-03f,
  -1.455000341e-01f, 9.893582463e-01f, -2.120364457e-01f, -9.772617817e-01f, -8.186324239e-01f, 5.743177533e-01f, 1.476312131e-01f, 9.890424609e-01f,
  6.967067122e-01f, 7.173560858e-01f, 9.005023241e-01f, 4.348512292e-01f, 9.681702852e-01f, 2.502923310e-01f, 9.898977876e-01f, 1.417829692e-01f,
  9.968017340e-01f, 7.991468906e-02f, 9.989882708e-01f, 4.497213289e-02f, 9.996800423e-01f, 2.529552206e-02f, 9.998987913e-01f, 1.422575582e-02f,
  9.999679923e-01f, 7.999914698e-03f, 9.999898672e-01f, 4.498715047e-03f, 9.999967813e-01f, 2.529819263e-03f, 9.999989867e-01f, 1.422623056e-03f,
  -9.111302495e-01f, 4.121184945e-01f, 3.416602612e-01f, -9.398235083e-01f, -9.566441774e-01f, 2.912592292e-01f, -2.965079620e-02f, 9.995602965e-01f,
  6.216099262e-01f, 7.833269238e-01f, 8.746382594e-01f, 4.847761393e-01f, 9.597726464e-01f, 2.807783186e-01f, 9.872201085e-01f, 1.593627781e-01f,
  9.959527254e-01f, 8.987854421e-02f, 9.987195730e-01f, 5.058911815e-02f, 9.995950460e-01f, 2.845665626e-02f, 9.998719096e-01f, 1.600383036e-02f,
  9.999595284e-01f, 8.999879472e-03f, 9.999871850e-01f, 5.061050411e-03f, 9.999959469e-01f, 2.846045885e-03f, 9.999987483e-01f, 1.600450720e-03f,
  -8.390715122e-01f, -5.440211296e-01f, 7.901318669e-01f, -6.129369140e-01f, -9.997860789e-01f, -2.068356983e-02f, -2.059976310e-01f, 9.785524607e-01f,
  5.403022766e-01f, 8.414709568e-01f, 8.460091352e-01f, 5.331684351e-01f, 9.504153132e-01f, 3.109835684e-01f, 9.842302203e-01f, 1.768921912e-01f,
  9.950041771e-01f, 9.983341396e-02f, 9.984192848e-01f, 5.620449781e-02f, 9.995000362e-01f, 3.161750361e-02f, 9.998418689e-01f, 1.778185740e-02f,
  9.999499917e-01f, 9.999834001e-03f, 9.999842048e-01f, 5.623383448e-03f, 9.999949932e-01f, 3.162272274e-03f, 9.999983907e-01f, 1.778278500e-03f,
  4.425697960e-03f, -9.999902248e-01f, 9.952573776e-01f, -9.727645665e-02f, -9.437797666e-01f, -3.305749595e-01f, -3.758473992e-01f, 9.266815782e-01f,
  4.535960853e-01f, 8.912073970e-01f, 8.147053123e-01f, 5.798751712e-01f, 9.401075840e-01f, 3.408778608e-01f, 9.809291363e-01f, 1.943656504e-01f,
  9.939560890e-01f, 1.097782999e-01f, 9.980874062e-01f, 6.181810424e-02f, 9.993950725e-01f, 3.477803990e-02f, 9.998086691e-01f, 1.955982670e-02f,
  9.999395013e-01f, 1.099977922e-02f, 9.999808669e-01f, 6.185714621e-03f, 9.999939203e-01f, 3.478498431e-03f, 9.999980927e-01f, 1.956106164e-03f,
  8.438539505e-01f, -5.365729332e-01f, 8.938615918e-01f, 4.483429790e-01f, -7.941793799e-01f, -6.076834202e-01f, -5.338430405e-01f, 8.455836177e-01f,
  3.623577058e-01f, 9.320390821e-01f, 7.808259130e-01f, 6.247486472e-01f, 9.288598895e-01f, 3.704313040e-01f, 9.773178697e-01f, 2.117776722e-01f,
  9.928086400e-01f, 1.197122037e-01f, 9.977239966e-01f, 6.742975861e-02f, 9.992800951e-01f, 3.793822229e-02f, 9.997723103e-01f, 2.133773454e-02f,
  9.999279976e-01f, 1.199971233e-02f, 9.999772310e-01f, 6.748044398e-03f, 9.999927878e-01f, 3.794723889e-03f, 9.999977350e-01f, 2.133933594e-03f,
  9.074468017e-01f, 4.201670289e-01f, 5.171728730e-01f, 8.558809757e-01f, -5.658205152e-01f, -8.245284557e-01f, -6.750016809e-01f, 7.378162146e-01f,
  2.674987614e-01f, 9.635581970e-01f, 7.444779873e-01f, 6.676470041e-01f, 9.166833758e-01f, 3.996143043e-01f, 9.733975530e-01f, 2.291227132e-01f,
  9.915618896e-01f, 1.296341419e-01f, 9.973290563e-01f, 7.303927839e-02f, 9.991551042e-01f, 4.109803215e-02f, 9.997327924e-01f, 2.311557345e-02f,
  9.999154806e-01f, 1.299963426e-02f, 9.999732971e-01f, 7.310371846e-03f, 9.999915361e-01f, 4.110949114e-03f, 9.999973178e-01f, 2.311761025e-03f,
  1.367372125e-01f, 9.906073809e-01f, -1.879615150e-02f, 9.998233318e-01f, -2.813494802e-01f, -9.596053958e-01f, -7.948709130e-01f, 6.067785621e-01f,
  1.699671596e-01f, 9.854497313e-01f, 7.057763934e-01f, 7.084347010e-01f, 9.035902619e-01f, 4.283977747e-01f, 9.691694379e-01f, 2.463953048e-01f,
  9.902160168e-01f, 1.395431161e-01f, 9.969025850e-01f, 7.864648104e-02f, 9.990201592e-01f, 4.425742477e-02f, 9.996901155e-01f, 2.489333972e-02f,
  9.999020100e-01f, 1.399954315e-02f, 9.999690056e-01f, 7.872696966e-03f, 9.999902248e-01f, 4.427174106e-03f, 9.999969006e-01f, 2.489588689e-03f,
  -7.596879005e-01f, 6.502878666e-01f, -5.489754677e-01f, 8.358384371e-01f, 3.102235124e-02f, -9.995186925e-01f, -8.896704316e-01f, 4.566032588e-01f,
  7.073719800e-02f, 9.974949956e-01f, 6.648434997e-01f, 7.469826341e-01f, 8.895936012e-01f, 4.567528665e-01f, 9.646348357e-01f, 2.635899782e-01f,
  9.887710810e-01f, 1.494381279e-01f, 9.964445233e-01f, 8.425120264e-02f, 9.988752007e-01f, 4.741638154e-02f, 9.996442795e-01f, 2.667102963e-02f,
  9.998875260e-01f, 1.499943808e-02f, 9.999644160e-01f, 8.435020223e-03f, 9.999887347e-01f, 4.743398633e-03f, 9.999964237e-01f, 2.667415887e-03f,
  -9.576594830e-01f, -2.879033089e-01f, -9.100810885e-01f, 4.144302309e-01f, 3.403181732e-01f, -9.403103590e-01f, -9.564100504e-01f, 2.920270860e-01f,
  -2.919954620e-02f, 9.995735884e-01f, 6.218088269e-01f, 7.831690907e-01f, 8.747074604e-01f, 4.846512377e-01f, 9.597951770e-01f, 2.807013094e-01f,
  9.872272611e-01f, 1.593182087e-01f, 9.959549904e-01f, 8.985326439e-02f, 9.987202883e-01f, 5.057485774e-02f, 9.995952845e-01f, 2.844863199e-02f,
  9.998720288e-01f, 1.599931903e-02f, 9.999595284e-01f, 8.997339755e-03f, 9.999871850e-01f, 5.059622694e-03f, 9.999959469e-01f, 2.845243318e-03f,
  -2.751633525e-01f, -9.613974690e-01f, -9.908979535e-01f, -1.346151382e-01f, 6.158648133e-01f, -7.878518701e-01f, -9.929850101e-01f, 1.182405204e-01f,
  -1.288445443e-01f, 9.916648269e-01f, 5.768082738e-01f, 8.168795705e-01f, 8.589466810e-01f, 5.120649934e-01f, 9.546520114e-01f, 2.977238595e-01f,
  9.855847955e-01f, 1.691823453e-01f, 9.954339862e-01f, 9.545248002e-02f, 9.985553622e-01f, 5.373282731e-02f, 9.995430708e-01f, 3.022614494e-02f,
  9.998555183e-01f, 1.699918136e-02f, 9.999542832e-01f, 9.559656493e-03f, 9.999855757e-01f, 5.375845823e-03f, 9.999954104e-01f, 3.023070283e-03f,
  6.603167057e-01f, -7.509872317e-01f, -7.665365338e-01f, -6.422007084e-01f, 8.303361535e-01f, -5.572628975e-01f, -9.982416630e-01f, -5.927551910e-02f,
  -2.272021621e-01f, 9.738476276e-01f, 5.299841762e-01f, 8.480075598e-01f, 8.423270583e-01f, 5.389667153e-01f, 9.492070079e-01f, 3.146522641e-01f,
  9.838436842e-01f, 1.790295690e-01f, 9.948815107e-01f, 1.010486856e-01f, 9.983804226e-01f, 5.689026415e-02f, 9.994877577e-01f, 3.200356290e-02f,
  9.998379946e-01f, 1.799902879e-02f, 9.999487996e-01f, 1.012197044e-02f, 9.999837875e-01f, 5.692068953e-03f, 9.999948740e-01f, 3.200897481e-03f,
  9.887046218e-01f, 1.498772055e-01f, -3.060953915e-01f, -9.520008564e-01f, 9.624637961e-01f, -2.714101076e-01f, -9.720142484e-01f, -2.349217981e-01f,
  -3.232895434e-01f, 9.463000894e-01f, 4.814845920e-01f, 8.764545321e-01f, 8.248651624e-01f, 5.653295517e-01f, 9.434618354e-01f, 3.314811885e-01f,
  9.820042253e-01f, 1.888588965e-01f, 9.942975044e-01f, 1.066416800e-01f, 9.981955290e-01f, 6.004713103e-02f, 9.994292855e-01f, 3.378088027e-02f,
  9.998195171e-01f, 1.899885759e-02f, 9.999428988e-01f, 1.068428159e-02f, 9.999819398e-01f, 6.008291151e-03f, 9.999942780e-01f, 3.378724447e-03f,
  4.080820680e-01f, 9.129452705e-01f, 2.486167252e-01f, -9.686019421e-01f, 9.991443753e-01f, 4.135828838e-02f, -9.151299596e-01f, -4.031589925e-01f,
  -4.161468446e-01f, 9.092974067e-01f, 4.314628243e-01f, 9.021307230e-01f, 8.065784574e-01f, 5.911270380e-01f, 9.374182820e-01f, 3.482052684e-01f,
  9.800665975e-01f, 1.986693144e-01f, 9.936820865e-01f, 1.122313142e-01f, 9.980006814e-01f, 6.320339441e-02f, 9.993675947e-01f, 3.555808961e-02f,
  9.998000264e-01f, 1.999866776e-02f, 9.999367595e-01f, 1.124658901e-02f, 9.999799728e-01f, 6.324512884e-03f, 9.999936819e-01f, 3.556551412e-03f,
  -5.477292538e-01f, 8.366556168e-01f, 7.267602682e-01f, -6.868911982e-01f, 9.367404580e-01f, 3.500247598e-01f, -8.293829560e-01f, -5.586805344e-01f,
  -5.048462152e-01f, 8.632093072e-01f, 3.800770044e-01f, 9.249548316e-01f, 7.874851823e-01f, 6.163335443e-01f, 9.310783744e-01f, 3.648192585e-01f,
  9.780309200e-01f, 2.084598988e-01f, 9.930352569e-01f, 1.178173944e-01f, 9.977958202e-01f, 6.635902822e-02f, 9.993028045e-01f, 3.733518720e-02f,
  9.997795224e-01f, 2.099845745e-02f, 9.999302626e-01f, 1.180889271e-02f, 9.999779463e-01f, 6.640734151e-03f, 9.999930263e-01f, 3.734378144e-03f,
  -9.999608397e-01f, -8.851309307e-03f, 9.810745716e-01f, -1.936302334e-01f, 7.814403772e-01f, 6.239799261e-01f, -7.174774408e-01f, -6.965817213e-01f,
  -5.885011554e-01f, 8.084963560e-01f, 3.274895847e-01f, 9.448547959e-01f, 7.676045895e-01f, 6.409237385e-01f, 9.244439602e-01f, 3.813178837e-01f,
  9.758974314e-01f, 2.182296216e-01f, 9.923570156e-01f, 1.233997419e-01f, 9.975810051e-01f, 6.951400638e-02f, 9.992348552e-01f, 3.911216930e-02f,
  9.997580051e-01f, 2.199822664e-02f, 9.999234676e-01f, 1.237119269e-02f, 9.999758005e-01f, 6.956954487e-03f, 9.999923706e-01f, 3.912204877e-03f,
  -5.328330398e-01f, -8.462204337e-01f, 9.332357645e-01f, 3.592645228e-01f, 5.486452579e-01f, 8.360552788e-01f, -5.829432607e-01f, -8.125128746e-01f,
  -6.662759781e-01f, 7.457052469e-01f, 2.738668323e-01f, 9.617676139e-01f, 7.469564080e-01f, 6.648730636e-01f, 9.175173044e-01f, 3.976959288e-01f,
  9.736663699e-01f, 2.279775143e-01f, 9.916474223e-01f, 1.289781928e-01f, 9.973561764e-01f, 7.266827673e-02f, 9.991636872e-01f, 4.088902473e-02f,
  9.997355342e-01f, 2.299797349e-02f, 9.999163747e-01f, 1.293348987e-02f, 9.999735355e-01f, 7.273174357e-03f, 9.999916553e-01f, 4.090031609e-03f,
  4.241790175e-01f, -9.055783749e-01f, 5.979771614e-01f, 8.015131354e-01f, 2.614416778e-01f, 9.652192593e-01f, -4.300232828e-01f, -9.028177857e-01f,
  -7.373937964e-01f, 6.754631400e-01f, 2.193782777e-01f, 9.756398797e-01f, 7.255613208e-01f, 6.881574988e-01f, 9.103004336e-01f, 4.139482081e-01f,
  9.713379741e-01f, 2.377026230e-01f, 9.909064770e-01f, 1.345525682e-01f, 9.971213937e-01f, 7.582182437e-02f, 9.990894198e-01f, 4.266574979e-02f,
  9.997119904e-01f, 2.399769612e-02f, 9.999089241e-01f, 1.349578146e-02f, 9.999712110e-01f, 7.589393295e-03f, 9.999908805e-01f, 4.267857410e-03f,
  9.912028313e-01f, -1.323517561e-01f, 7.855226099e-02f, 9.969099760e-01f, -5.168933049e-02f, 9.986631870e-01f, -2.635405958e-01f, -9.646483064e-01f,
  -8.011435866e-01f, 5.984721184e-01f, 1.641961634e-01f, 9.864277244e-01f, 7.034407258e-01f, 7.107539177e-01f, 9.027957320e-01f, 4.300695956e-01f,
  9.689124227e-01f, 2.474039644e-01f, 9.901341200e-01f, 1.401226968e-01f, 9.968766570e-01f, 7.897461206e-02f, 9.990119338e-01f, 4.444234073e-02f,
  9.996874928e-01f, 2.499739639e-02f, 9.999011755e-01f, 1.405806933e-02f, 9.999687672e-01f, 7.905611768e-03f, 9.999901056e-01f, 4.445684142e-03f,
  6.469193101e-01f, 7.625584602e-01f, -4.650644958e-01f, 8.852767944e-01f, -3.596943319e-01f, 9.330701828e-01f, -8.874550462e-02f, -9.960543513e-01f,
  -8.568888307e-01f, 5.155012608e-01f, 1.084949449e-01f, 9.940969944e-01f, 6.806167960e-01f, 7.326396108e-01f, 8.950055838e-01f, 4.460549951e-01f,
  9.663899541e-01f, 2.570805550e-01f, 9.893305302e-01f, 1.456883848e-01f, 9.966219068e-01f, 8.212661743e-02f, 9.989313483e-01f, 4.621879384e-02f,
  9.996620417e-01f, 2.599707060e-02f, 9.998931289e-01f, 1.462035347e-02f, 9.999662042e-01f, 8.221829310e-03f, 9.999893308e-01f, 4.623509943e-03f,
  -2.921388149e-01f, 9.563759565e-01f, -8.654506207e-01f, 5.009942055e-01f, -6.320286393e-01f, 7.749450207e-01f, 8.884811401e-02f, -9.960451722e-01f,
  -9.040721655e-01f, 4.273798466e-01f, 5.245061591e-02f, 9.986234903e-01f, 6.571123004e-01f, 7.537927032e-01f, 8.869323730e-01f, 4.618993104e-01f,
  9.637709260e-01f, 2.667314112e-01f, 9.884956479e-01f, 1.512494683e-01f, 9.963572025e-01f, 8.527779579e-02f, 9.988475442e-01f, 4.799510166e-02f,
  9.996355176e-01f, 2.699672058e-02f, 9.998847246e-01f, 1.518263202e-02f, 9.999635220e-01f, 8.538045920e-03f, 9.999884963e-01f, 4.801335745e-03f,
  -9.626058936e-01f, 2.709057927e-01f, -9.992933869e-01f, -3.758566082e-02f, -8.416849375e-01f, 5.399689674e-01f, 2.636395097e-01f, -9.646213055e-01f,
  -9.422222972e-01f, 3.349882066e-01f, -3.759419080e-03f, 9.999929070e-01f, 6.329506636e-01f, 7.741920948e-01f, 8.785787225e-01f, 4.775975943e-01f,
  9.610554576e-01f, 2.763556540e-01f, 9.876294732e-01f, 1.568057537e-01f, 9.960825443e-01f, 8.842811733e-02f, 9.987606406e-01f, 4.977125302e-02f,
  9.996080399e-01f, 2.799634263e-02f, 9.998760223e-01f, 1.574490592e-02f, 9.999607801e-01f, 8.854261599e-03f, 9.999876022e-01f, 4.979162011e-03f,
  -7.480575442e-01f, -6.636338830e-01f, -8.253716230e-01f, -5.645897985e-01f, -9.678714871e-01f, 2.514453232e-01f, 4.301158488e-01f, -9.027736783e-01f,
  -9.709581733e-01f, 2.392492294e-01f, -5.995756760e-02f, 9.982009530e-01f, 6.081562042e-01f, 7.938174009e-01f, 8.699471951e-01f, 4.931448400e-01f,
  9.582439065e-01f, 2.859522104e-01f, 9.867320657e-01f, 1.623570919e-01f, 9.957979321e-01f, 9.157756716e-02f, 9.986705780e-01f, 5.154724792e-02f,
  9.995795488e-01f, 2.899593674e-02f, 9.998670220e-01f, 1.630717516e-02f, 9.999579787e-01f, 9.170476347e-03f, 9.999867082e-01f, 5.156987347e-03f,
  1.542514563e-01f, -9.880316257e-01f, -3.972518742e-01f, -9.177096486e-01f, -9.980752468e-01f, -6.201484054e-02f, 5.830269456e-01f, -8.124528527e-01f,
  -9.899924994e-01f, 1.411200017e-01f, -1.159661636e-01f, 9.932531714e-01f, 5.827536583e-01f, 8.126488924e-01f, 8.610406518e-01f, 5.085361004e-01f,
  9.553365111e-01f, 2.955201864e-01f, 9.858034849e-01f, 1.679033041e-01f, 9.955033660e-01f, 9.472609311e-02f, 9.985772967e-01f, 5.332308263e-02f,
  9.995500445e-01f, 2.999550104e-02f, 9.998577237e-01f, 1.686943881e-02f, 9.999549985e-01f, 9.486690164e-03f, 9.999857545e-01f, 5.334813148e-03f,
  9.147423506e-01f, -4.040376544e-01f, 1.532154828e-01f, -9.881927967e-01f, -9.293003082e-01f, -3.693250120e-01f, 7.175492048e-01f, -6.965078115e-01f,
  -9.991351366e-01f, 4.158052057e-02f, -1.716081351e-01f, 9.851652980e-01f, 5.567683578e-01f, 8.306677938e-01f, 8.518617749e-01f, 5.237666368e-01f,
  9.523335695e-01f, 3.050586283e-01f, 9.848436713e-01f, 1.734442115e-01f, 9.951988459e-01f, 9.787366539e-02f, 9.984809160e-01f, 5.509874597e-02f,
  9.995195270e-01f, 3.099503554e-02f, 9.998480678e-01f, 1.743169688e-02f, 9.999519587e-01f, 9.802903049e-03f, 9.999848008e-01f, 5.512638018e-03f,
  8.342233896e-01f, 5.514267087e-01f, 6.564951539e-01f, -7.543302178e-01f, -7.683671117e-01f, -6.400094032e-01f, 8.294403553e-01f, -5.585952997e-01f,
  -9.982947707e-01f, -5.837419257e-02f, -2.267075777e-01f, 9.739628434e-01f, 5.302263498e-01f, 8.478561044e-01f, 8.424135447e-01f, 5.388315320e-01f,
  9.492354393e-01f, 3.145665526e-01f, 9.838528037e-01f, 1.789796203e-01f, 9.948843718e-01f, 1.010202691e-01f, 9.983813763e-01f, 5.687423423e-02f,
  9.994880557e-01f, 3.199454024e-02f, 9.998381138e-01f, 1.799395122e-02f, 9.999487996e-01f, 1.011911593e-02f, 9.999837875e-01f, 5.690463353e-03f,
  -1.327674743e-02f, 9.999118447e-01f, 9.575860500e-01f, -2.881473899e-01f, -5.312352777e-01f, -8.472243547e-01f, 9.151713848e-01f, -4.030649364e-01f,
  -9.874798059e-01f, -1.577456445e-01f, -2.810903192e-01f, 9.596813321e-01f, 5.031541586e-01f, 8.641966581e-01f, 8.326989412e-01f, 5.537260175e-01f,
  9.460423589e-01f, 3.240430057e-01f, 9.828307629e-01f, 1.845093668e-01f, 9.945599437e-01f, 1.041658595e-01f, 9.982786179e-01f, 5.864954367e-02f,
  9.994555712e-01f, 3.299400955e-02f, 9.998278022e-01f, 1.855619811e-02f, 9.999455214e-01f, 1.043532696e-02f, 9.999827743e-01f, 5.868288688e-03f,
  -8.485702872e-01f, 5.290827155e-01f, 9.637575150e-01f, 2.667797208e-01f, -2.414211184e-01f, -9.704204202e-01f, 9.720383286e-01f, -2.348221242e-01f,
  -9.667981863e-01f, -2.555412054e-01f, -3.345843852e-01f, 9.423658252e-01f, 4.755789042e-01f, 8.796730638e-01f, 8.227210045e-01f, 5.684453845e-01f,
  9.427546859e-01f, 3.334870934e-01f, 9.817776680e-01f, 1.900332868e-01f, 9.942255616e-01f, 1.073104069e-01f, 9.981727600e-01f, 6.042466685e-02f,
  9.994220734e-01f, 3.399345279e-02f, 9.998172522e-01f, 1.911843941e-02f, 9.999421835e-01f, 1.075153705e-02f, 9.999817014e-01f, 6.046113092e-03f,
  -9.036921859e-01f, -4.281826615e-01f, 6.731102467e-01f, 7.395421267e-01f, 7.233466953e-02f, -9.973804355e-01f, 9.982477427e-01f, -5.917267874e-02f,
  -9.364566803e-01f, -3.507832289e-01f, -3.870206773e-01f, 9.220710397e-01f, 4.475280643e-01f, 8.942698836e-01f, 8.124829531e-01f, 5.829849839e-01f,
  9.393727183e-01f, 3.428978026e-01f, 9.806935191e-01f, 1.955512017e-01f, 9.938812256e-01f, 1.104538813e-01f, 9.980637431e-01f, 6.219960377e-02f,
  9.993875623e-01f, 3.499285504e-02f, 9.998063445e-01f, 1.968067512e-02f, 9.999387264e-01f, 1.106774528e-02f, 9.999806285e-01f, 6.223937962e-03f,
  -1.279636919e-01f, -9.917788506e-01f, 1.751565337e-01f, 9.845405817e-01f, 3.789161742e-01f, -9.254310131e-01f, 9.929728508e-01f, 1.183425859e-01f,
  -8.967583776e-01f, -4.425205588e-01f, -4.382335544e-01f, 8.988611698e-01f, 4.190297425e-01f, 9.079725146e-01f, 8.019878864e-01f, 5.973402858e-01f,
  9.358968139e-01f, 3.522742093e-01f, 9.795783162e-01f, 2.010629177e-01f, 9.935269952e-01f, 1.135962531e-01f, 9.979515672e-01f, 6.397433579e-02f,
  9.993520975e-01f, 3.599222749e-02f, 9.997950792e-01f, 2.024290524e-02f, 9.999352098e-01f, 1.138395350e-02f, 9.999794960e-01f, 6.401761901e-03f,
  7.654140592e-01f, -6.435381174e-01f, -3.767423034e-01f, 9.263181090e-01f, 6.479216814e-01f, -7.617069483e-01f, 9.563800097e-01f, 2.921253741e-01f,
  -8.481000066e-01f, -5.298361778e-01f, -4.880608618e-01f, 8.728095889e-01f, 3.901124299e-01f, 9.207672477e-01f, 7.912392616e-01f, 6.115067005e-01f,
  9.323273301e-01f, 3.616154492e-01f, 9.784321785e-01f, 2.065682709e-01f, 9.931628108e-01f, 1.167374924e-01f, 9.978361726e-01f, 6.574887782e-02f,
  9.993155599e-01f, 3.699155897e-02f, 9.997835755e-01f, 2.080512606e-02f, 9.999315739e-01f, 1.170015987e-02f, 9.999783635e-01f, 6.579586305e-03f,
  9.550736547e-01f, 2.963685691e-01f, -8.126112223e-01f, 5.828061700e-01f, 8.526731133e-01f, -5.224447846e-01f, 8.896234632e-01f, 4.566946924e-01f,
  -7.909677625e-01f, -6.118578315e-01f, -5.363451838e-01f, 8.439987302e-01f, 3.608050346e-01f, 9.326412678e-01f, 7.802404165e-01f, 6.254796982e-01f,
  9.286646247e-01f, 3.709204793e-01f, 9.772551060e-01f, 2.120671123e-01f, 9.927886724e-01f, 1.198775545e-01f, 9.977176785e-01f, 6.752320379e-02f,
  9.992780685e-01f, 3.799085692e-02f, 9.997717142e-01f, 2.136734314e-02f, 9.999278188e-01f, 1.201636530e-02f, 9.999771714e-01f, 6.757410709e-03f,
  2.666429281e-01f, 9.637953639e-01f, -9.982103705e-01f, 5.980031565e-02f, 9.728653431e-01f, -2.313720137e-01f, 7.948083878e-01f, 6.068604589e-01f,
  -7.259322405e-01f, -6.877662539e-01f, -5.829339027e-01f, 8.125196099e-01f, 3.311368525e-01f, 9.435827136e-01f, 7.689949274e-01f, 6.392549276e-01f,
  9.249090552e-01f, 3.801884055e-01f, 9.760470986e-01f, 2.175592482e-01f, 9.924046397e-01f, 1.230164245e-01f, 9.975960255e-01f, 6.929731369e-02f,
  9.992396235e-01f, 3.899011388e-02f, 9.997594953e-01f, 2.192955278e-02f, 9.999239445e-01f, 1.233256981e-02f, 9.999759793e-01f, 6.935234182e-03f,
  -6.669380665e-01f, 7.451131344e-01f, -8.763794303e-01f, -4.816212952e-01f, 9.965789914e-01f, 8.264580369e-02f, 6.749256253e-01f, 7.378857136e-01f,
  -6.536436081e-01f, -7.568024993e-01f, -6.276797056e-01f, 7.784717083e-01f, 3.011375964e-01f, 9.535806775e-01f, 7.575061917e-01f, 6.528279781e-01f,
  9.210609794e-01f, 3.894183338e-01f, 9.748082757e-01f, 2.230444849e-01f, 9.920106530e-01f, 1.261540651e-01f, 9.974712729e-01f, 7.107120752e-02f,
  9.992001057e-01f, 3.998933733e-02f, 9.997470379e-01f, 2.249175683e-02f, 9.999200106e-01f, 1.264877338e-02f, 9.999747276e-01f, 7.113057654e-03f,
  -9.873392582e-01f, -1.586226672e-01f, -4.846394062e-01f, -8.747140169e-01f, 9.214623570e-01f, 3.884676993e-01f, 5.337560773e-01f, 8.456384540e-01f,
  -5.748240352e-01f, -8.182770610e-01f, -6.704410911e-01f, 7.419627905e-01f, 2.708370686e-01f, 9.626252055e-01f, 7.457779050e-01f, 6.661946774e-01f,
  9.171208143e-01f, 3.986093104e-01f, 9.735385776e-01f, 2.285226882e-01f, 9.916067719e-01f, 1.292904317e-01f, 9.973433018e-01f, 7.284487784e-02f,
  9.991596341e-01f, 4.098851606e-02f, 9.997342229e-01f, 2.305394970e-02f, 9.999159575e-01f, 1.296497509e-02f, 9.999734163e-01f, 7.290880661e-03f,
  -3.999853134e-01f, -9.165215492e-01f, 5.636094138e-02f, -9.984104633e-01f, 7.549653649e-01f, 6.557646990e-01f, 3.757521510e-01f, 9.267202020e-01f,
  -4.902605712e-01f, -8.715758920e-01f, -7.110829353e-01f, 7.031081319e-01f, 2.402658761e-01f, 9.707071185e-01f, 7.338138223e-01f, 6.793506742e-01f,
  9.130889177e-01f, 4.077604413e-01f, 9.722381234e-01f, 2.339936644e-01f, 9.911929369e-01f, 1.324255317e-01f, 9.972121716e-01f, 7.461831719e-02f,
  9.991181493e-01f, 4.198765755e-02f, 9.997211099e-01f, 2.361613885e-02f, 9.999117851e-01f, 1.328117587e-02f, 9.999721050e-01f, 7.468704134e-03f,
  5.551133156e-01f, -8.317747712e-01f, 5.800031424e-01f, -8.146142364e-01f, 5.135984421e-01f, 8.580306768e-01f, 2.058971673e-01f, 9.785736203e-01f,
  -4.007990062e-01f, -9.161660075e-01f, -7.494767308e-01f, 6.620306373e-01f, 2.094544172e-01f, 9.778184295e-01f, 7.216176391e-01f, 6.922917962e-01f,
  9.089657664e-01f, 4.168707728e-01f, 9.709069133e-01f, 2.394572198e-01f, 9.907692075e-01f, 1.355592906e-01f, 9.970778823e-01f, 7.639151812e-02f,
  9.990756512e-01f, 4.298675060e-02f, 9.997076392e-01f, 2.417832054e-02f, 9.999075532e-01f, 1.359737478e-02f, 9.999707937e-01f, 7.646527141e-03f,
  9.998432994e-01f, 1.770192571e-02f, 9.250146747e-01f, -3.799313903e-01f, 2.212981731e-01f, 9.752061963e-01f, 2.954781987e-02f, 9.995633960e-01f,
  -3.073327839e-01f, -9.516021013e-01f, -7.855011225e-01f, 6.188601851e-01f, 1.784335226e-01f, 9.839519858e-01f, 7.091933489e-01f, 7.050140500e-01f,
  9.047516584e-01f, 4.259394705e-01f, 9.695450068e-01f, 2.449132055e-01f, 9.903355837e-01f, 1.386916935e-01f, 9.969404936e-01f, 7.816448808e-02f,
  9.990321398e-01f, 4.398580641e-02f, 9.996939301e-01f, 2.474049293e-02f, 9.999032021e-01f, 1.391357277e-02f, 9.999693632e-01f, 7.824349217e-03f,
  5.253219604e-01f, 8.509035110e-01f, 9.851381779e-01f, 1.717635691e-01f, -9.294810891e-02f, 9.956709743e-01f, -1.477329880e-01f, 9.890272617e-01f,
  -2.107958049e-01f, -9.775301218e-01f, -8.190422058e-01f, 5.737332702e-01f, 1.472342163e-01f, 9.891016483e-01f, 6.965447664e-01f, 7.175133228e-01f,
  9.004471302e-01f, 4.349655211e-01f, 9.681524038e-01f, 2.503614724e-01f, 9.898920655e-01f, 1.418227106e-01f, 9.967998862e-01f, 7.993719727e-02f,
  9.989876747e-01f, 4.498481750e-02f, 9.996798635e-01f, 2.530265786e-02f, 9.998987317e-01f, 1.422976889e-02f, 9.999679923e-01f, 8.002171293e-03f,
  -4.321779311e-01f, 9.017883539e-01f, 7.418580055e-01f, 6.705570221e-01f, -3.979767561e-01f, 9.173954725e-01f, -3.203543723e-01f, 9.472977519e-01f,
  -1.121526212e-01f, -9.936909676e-01f, -8.499938846e-01f, 5.267925262e-01f, 1.158876941e-01f, 9.932623506e-01f, 6.836758852e-01f, 7.297857404e-01f,
  8.960524797e-01f, 4.439480901e-01f, 9.667292237e-01f, 2.558017969e-01f, 9.894386530e-01f, 1.449523121e-01f, 9.966561794e-01f, 8.170966059e-02f,
  9.989421964e-01f, 4.598378390e-02f, 9.996654391e-01f, 2.586481534e-02f, 9.998942018e-01f, 1.454596408e-02f, 9.999665618e-01f, 8.179994300e-03f,
  -9.923354983e-01f, 1.235731244e-01f, 2.700984478e-01f, 9.628326893e-01f, -6.635382771e-01f, 7.481423616e-01f, -4.828719497e-01f, 8.756909966e-01f,
  -1.238837745e-02f, -9.999232888e-01f, -8.782584071e-01f, 4.781863391e-01f, 8.442528546e-02f, 9.964298010e-01f, 6.705908775e-01f, 7.418274283e-01f,
  8.915683031e-01f, 4.528862834e-01f, 9.652754664e-01f, 2.612340748e-01f, 9.889753461e-01f, 1.480804533e-01f, 9.965093136e-01f, 8.348185569e-02f,
  9.988957047e-01f, 4.698270187e-02f, 9.996507764e-01f, 2.642696351e-02f, 9.998895526e-01f, 1.486215740e-02f, 9.999650717e-01f, 8.357816376e-03f,
  -6.401443481e-01f, -7.682546377e-01f, -2.848466039e-01f, 9.585731030e-01f, -8.632965088e-01f, 5.046970844e-01f, -6.301599741e-01f, 7.764653563e-01f,
  8.749917150e-02f, -9.961646199e-01f, -9.037463665e-01f, 4.280683994e-01f, 5.287845805e-02f, 9.986009598e-01f, 6.572937369e-01f, 7.536345124e-01f,
  8.869948983e-01f, 4.617791772e-01f, 9.637911916e-01f, 2.666580379e-01f, 9.885020852e-01f, 1.512071192e-01f, 9.963592887e-01f, 8.525379747e-02f,
  9.988481998e-01f, 4.798157141e-02f, 9.996357560e-01f, 2.698910423e-02f, 9.998847842e-01f, 1.517834887e-02f, 9.999635816e-01f, 8.535637520e-03f,
  3.005925417e-01f, -9.537526369e-01f, -7.520639896e-01f, 6.590901017e-01f, -9.774427414e-01f, 2.112006545e-01f, -7.575730681e-01f, 6.527503729e-01f,
  1.865124702e-01f, -9.824525714e-01f, -9.263771176e-01f, 3.765971363e-01f, 2.127875760e-02f, 9.997735620e-01f, 6.437888145e-01f, 7.652031779e-01f,
  8.823328614e-01f, 4.706258774e-01f, 9.622764587e-01f, 2.720735669e-01f, 9.880189896e-01f, 1.543322802e-01f, 9.962061048e-01f, 8.702547103e-02f,
  9.987997413e-01f, 4.898039624e-02f, 9.996203780e-01f, 2.755123749e-02f, 9.998799562e-01f, 1.549453940e-02f, 9.999620318e-01f, 8.713459596e-03f,
  9.649659991e-01f, -2.623748481e-01f, -9.876590967e-01f, 1.566190720e-01f, -9.946564436e-01f, -1.032404602e-01f, -8.610926867e-01f, 5.084479451e-01f,
  2.836622000e-01f, -9.589242935e-01f, -9.460792542e-01f, 3.239352703e-01f, -1.034221891e-02f, 9.999465346e-01f, 6.300802827e-01f, 7.765299678e-01f,
  8.775825500e-01f, 4.794255495e-01f, 9.607312679e-01f, 2.774805427e-01f, 9.875259995e-01f, 1.574558914e-01f, 9.960497618e-01f, 8.879686147e-02f,
  9.987502694e-01f, 4.997916892e-02f, 9.996047616e-01f, 2.811335959e-02f, 9.998750091e-01f, 1.581072807e-02f, 9.999604821e-01f, 8.891279809e-03f,
  7.421541810e-01f, 6.702291965e-01f, -9.190735221e-01f, -3.940860629e-01f, -9.132301211e-01f, -4.074441493e-01f, -9.374542236e-01f, 3.481085002e-01f,
  3.779776692e-01f, -9.258147478e-01f, -9.627903700e-01f, 2.702493370e-01f, -4.195285589e-02f, 9.991195798e-01f, 6.161724925e-01f, 7.876111865e-01f,
  8.727445006e-01f, 4.881772399e-01f, 9.591556787e-01f, 2.828786969e-01f, 9.870231748e-01f, 1.605779380e-01f, 9.958902597e-01f, 9.056797624e-02f,
  9.986997843e-01f, 5.097789690e-02f, 9.995887876e-01f, 2.867547423e-02f, 9.998699427e-01f, 1.612691768e-02f, 9.999588728e-01f, 9.069100954e-03f,
  -1.629907787e-01f, 9.866275787e-01f, -5.674300194e-01f, -8.234215975e-01f, -7.412399650e-01f, -6.712401509e-01f, -9.842484593e-01f, 1.767906845e-01f,
  4.685169160e-01f, -8.834545016e-01f, -9.764577150e-01f, 2.157090008e-01f, -7.352153957e-02f, 9.972936511e-01f, 6.020699143e-01f, 7.984433770e-01f,
  8.678191900e-01f, 4.968801141e-01f, 9.575498104e-01f, 2.882679403e-01f, 9.865104556e-01f, 1.636983752e-01f, 9.957276583e-01f, 9.233880043e-02f,
  9.986482859e-01f, 5.197656900e-02f, 9.995725155e-01f, 2.923758142e-02f, 9.998648167e-01f, 1.644310169e-02f, 9.999572635e-01f, 9.246920235e-03f,
  -9.182828069e-01f, 3.959251642e-01f, -4.102819040e-02f, -9.991579652e-01f, -4.957418144e-01f, -8.684699535e-01f, -1.000000000e+00f, -1.030206768e-04f,
  5.543745160e-01f, -8.322673440e-01f, -9.870380163e-01f, 1.604867280e-01f, -1.050167084e-01f, 9.944704771e-01f, 5.877769589e-01f, 8.090230227e-01f,
  8.628070951e-01f, 5.055333376e-01f, 9.559136033e-01f, 2.936480343e-01f, 9.859878421e-01f, 1.668171734e-01f, 9.955618382e-01f, 9.410934150e-02f,
  9.985958338e-01f, 5.297519267e-02f, 9.995558858e-01f, 2.979967557e-02f, 9.998595715e-01f, 1.675928757e-02f, 9.999555945e-01f, 9.424741380e-03f,
  -8.293098211e-01f, -5.587890744e-01f, 4.980095923e-01f, -8.671715260e-01f, -2.010796219e-01f, -9.795749187e-01f, -9.842120409e-01f, -1.769934744e-01f,
  6.346929669e-01f, -7.727644444e-01f, -9.944978952e-01f, 1.047568321e-01f, -1.364068687e-01f, 9.906529188e-01f, 5.732980371e-01f, 8.193469048e-01f,
  8.577086926e-01f, 5.141359568e-01f, 9.542471766e-01f, 2.990188897e-01f, 9.854553938e-01f, 1.699342877e-01f, 9.953929186e-01f, 9.587957710e-02f,
  9.985423684e-01f, 5.397376046e-02f, 9.995389581e-01f, 3.036176413e-02f, 9.998542070e-01f, 1.707546785e-02f, 9.999538660e-01f, 9.602561593e-03f,
  2.212675661e-02f, -9.997551441e-01f, 8.836693168e-01f, -4.681116641e-01f, 1.135217771e-01f, -9.935355186e-01f, -9.373825192e-01f, -3.483016491e-01f,
  7.086697817e-01f, -7.055402994e-01f, -9.988136292e-01f, 4.869600013e-02f, -1.676606387e-01f, 9.858447909e-01f, 5.586379170e-01f, 8.294116855e-01f,
  8.525245190e-01f, 5.226872563e-01f, 9.525505900e-01f, 3.043802381e-01f, 9.849131107e-01f, 1.730497181e-01f, 9.952208400e-01f, 9.764950722e-02f,
  9.984878898e-01f, 5.497227982e-02f, 9.995217323e-01f, 3.092384152e-02f, 9.998487830e-01f, 1.739165001e-02f, 9.999521971e-01f, 9.780380875e-03f,
  8.532201052e-01f, -5.215510130e-01f, 9.971746206e-01f, 7.511820644e-02f, 4.168670774e-01f, -9.089674354e-01f, -8.609884381e-01f, -5.086245537e-01f,
  7.755658031e-01f, -6.312667131e-01f, -9.999717474e-01f, -7.518785074e-03f, -1.987468749e-01f, 9.800508618e-01f, 5.438010693e-01f, 8.392141461e-01f,
  8.472551107e-01f, 5.311862230e-01f, 9.508239031e-01f, 3.097319603e-01f, 9.843609333e-01f, 1.761634201e-01f, 9.950456619e-01f, 9.941913933e-02f,
  9.984323978e-01f, 5.597073585e-02f, 9.995042086e-01f, 3.148590773e-02f, 9.998431802e-01f, 1.770782843e-02f, 9.999504089e-01f, 9.958200157e-03f,
  8.998668194e-01f, 4.361647666e-01f, 8.035690784e-01f, 5.952115059e-01f, 6.788702011e-01f, -7.342582941e-01f, -7.574391961e-01f, -6.529057026e-01f,
  8.347129226e-01f, -5.506852865e-01f, -9.979684949e-01f, -6.370979548e-02f, -2.296342701e-01f, 9.732769728e-01f, 5.287923217e-01f, 8.487512469e-01f,
  8.419010043e-01f, 5.396320224e-01f, 9.490671158e-01f, 3.150739372e-01f, 9.837989211e-01f, 1.792753637e-01f, 9.948672652e-01f, 1.011884511e-01f,
  9.983759522e-01f, 5.696914345e-02f, 9.994863272e-01f, 3.204796836e-02f, 9.998375773e-01f, 1.802400686e-02f, 9.999486208e-01f, 1.013601944e-02f,
  1.191801354e-01f, 9.928726554e-01f, 3.624766767e-01f, 9.319928288e-01f, 8.735505342e-01f, -4.867334962e-01f, -6.300007105e-01f, -7.765945792e-01f,
  8.855196238e-01f, -4.646020234e-01f, -9.928101897e-01f, -1.196993962e-01f, -2.602920532e-01f, 9.655299187e-01f, 5.136163235e-01f, 8.580200076e-01f,
  8.364626765e-01f, 5.480239391e-01f, 9.472803473e-01f, 3.204059005e-01f, 9.832270741e-01f, 1.823855042e-01f, 9.946857691e-01f, 1.029574350e-01f,
  9.983184934e-01f, 5.796748772e-02f, 9.994681478e-01f, 3.261001408e-02f, 9.998317957e-01f, 1.834018156e-02f, 9.999468327e-01f, 1.031383779e-02f,
  -7.710801959e-01f, 6.367380023e-01f, -1.902491003e-01f, 9.817358255e-01f, 9.816020727e-01f, -1.909380108e-01f, -4.826923311e-01f, -8.757900000e-01f,
  9.274784923e-01f, -3.738765717e-01f, -9.845131636e-01f, -1.753105819e-01f, -2.906895578e-01f, 9.568174481e-01f, 4.982779026e-01f, 8.670173883e-01f,
  8.309407234e-01f, 5.563610196e-01f, 9.454635978e-01f, 3.257277906e-01f, 9.826454520e-01f, 1.854938269e-01f, 9.945011139e-01f, 1.047261059e-01f,
  9.982600212e-01f, 5.896577984e-02f, 9.994496703e-01f, 3.317204863e-02f, 9.998259544e-01f, 1.865635626e-02f, 9.999449849e-01f, 1.049165614e-02f,
  -9.524129629e-01f, -3.048106134e-01f, -6.843819022e-01f, 7.291237116e-01f, 9.923083186e-01f, 1.237909496e-01f, -3.201591671e-01f, -9.473637342e-01f,
  9.601702690e-01f, -2.794154882e-01f, -9.731037021e-01f, -2.303675115e-01f, -3.207964003e-01f, 9.471482038e-01f, 4.827820361e-01f, 8.757405281e-01f,
  8.253356218e-01f, 5.646424294e-01f, 9.436169863e-01f, 3.310393095e-01f, 9.820539355e-01f, 1.886002868e-01f, 9.943132997e-01f, 1.064944416e-01f,
  9.982005358e-01f, 5.996400863e-02f, 9.994308352e-01f, 3.373407945e-02f, 9.998199940e-01f, 1.897252724e-02f, 9.999430776e-01f, 1.066947449e-02f,
  -2.581016421e-01f, -9.661177993e-01f, -9.677396417e-01f, 2.519522607e-01f, 9.046075940e-01f, 4.262454212e-01f, -1.475291997e-01f, -9.890577197e-01f,
  9.832684398e-01f, -1.821625978e-01f, -9.586178064e-01f, -2.846961617e-01f, -3.505824506e-01f, 9.365318418e-01f, 4.671334028e-01f, 8.841868639e-01f,
  8.196480274e-01f, 5.728674531e-01f, 9.417404532e-01f, 3.363404274e-01f, 9.814526439e-01f, 1.917048544e-01f, 9.941223264e-01f, 1.082624346e-01f,
  9.981400967e-01f, 6.096218154e-02f, 9.994117022e-01f, 3.429609165e-02f, 9.998139739e-01f, 1.928869821e-02f, 9.999411702e-01f, 1.084729191e-02f,
  6.735071540e-01f, -7.391806841e-01f, -9.530500174e-01f, -3.028128743e-01f, 7.271980643e-01f, 6.864276528e-01f, 2.975377068e-02f, -9.995572567e-01f,
  9.965420961e-01f, -8.308912069e-02f, -9.411013126e-01f, -3.381247520e-01f, -3.800179660e-01f, 9.249790907e-01f, 4.513370395e-01f, 8.923535347e-01f,
  8.138784766e-01f, 5.810351372e-01f, 9.398342371e-01f, 3.416308761e-01f, 9.808415174e-01f, 1.948075294e-01f, 9.939282537e-01f, 1.100300923e-01f,
  9.980786443e-01f, 6.196028739e-02f, 9.993922710e-01f, 3.485809639e-02f, 9.998078346e-01f, 1.960486546e-02f, 9.999392033e-01f, 1.102510840e-02f,
  9.858965874e-01f, 1.673557013e-01f, -6.448370218e-01f, -7.643200755e-01f, 4.776714444e-01f, 8.785385489e-01f, 2.060983330e-01f, -9.785313010e-01f,
  9.998586178e-01f, 1.681409031e-02f, -9.206095338e-01f, -3.904843926e-01f, -4.090735018e-01f, 9.125014544e-01f, 4.353979528e-01f, 9.002380967e-01f,
  8.080275059e-01f, 5.891447663e-01f, 9.378982186e-01f, 3.469105363e-01f, 9.802205563e-01f, 1.979082376e-01f, 9.937310219e-01f, 1.117973924e-01f,
  9.980161786e-01f, 6.295833737e-02f, 9.993724823e-01f, 3.542009369e-02f, 9.998015761e-01f, 1.992103085e-02f, 9.999372363e-01f, 1.120292582e-02f,
};
__device__ const float ROPE32[1024] = {
  1.000000000e+00f, 0.000000000e+00f, 1.000000000e+00f, 0.000000000e+00f, 1.000000000e+00f, 0.000000000e+00f, 1.000000000e+00f, 0.000000000e+00f,
  1.000000000e+00f, 0.000000000e+00f, 1.000000000e+00f, 0.000000000e+00f, 1.000000000e+00f, 0.000000000e+00f, 1.000000000e+00f, 0.000000000e+00f,
  5.403022766e-01f, 8.414709568e-01f, 9.504152536e-01f, 3.109835982e-01f, 9.950041771e-01f, 9.983342141e-02f, 9.995000362e-01f, 3.161750361e-02f,
  9.999499917e-01f, 9.999833070e-03f, 9.999949932e-01f, 3.162272274e-03f, 9.999995232e-01f, 9.999999311e-04f, 9.999999404e-01f, 3.162277571e-04f,
  -4.161468446e-01f, 9.092974067e-01f, 8.065783978e-01f, 5.911270976e-01f, 9.800665975e-01f, 1.986693293e-01f, 9.980006814e-01f, 6.320339441e-02f,
  9.998000264e-01f, 1.999866590e-02f, 9.999799728e-01f, 6.324512884e-03f, 9.999979734e-01f, 1.999998698e-03f, 9.999998212e-01f, 6.324554561e-04f,
  -9.899924994e-01f, 1.411200017e-01f, 5.827536583e-01f, 8.126488924e-01f, 9.553365111e-01f, 2.955202162e-01f, 9.955033660e-01f, 9.472608566e-02f,
  9.995500445e-01f, 2.999549918e-02f, 9.999549985e-01f, 9.486690164e-03f, 9.999955297e-01f, 2.999995602e-03f, 9.999995232e-01f, 9.486831259e-04f,
  -6.536436081e-01f, -7.568024993e-01f, 3.011374772e-01f, 9.535807371e-01f, 9.210609794e-01f, 3.894183338e-01f, 9.920106530e-01f, 1.261540651e-01f,
  9.992001057e-01f, 3.998933360e-02f, 9.999200106e-01f, 1.264877338e-02f, 9.999920130e-01f, 3.999989480e-03f, 9.999992251e-01f, 1.264910679e-03f,
  2.836622000e-01f, -9.589242935e-01f, -1.034233812e-02f, 9.999465346e-01f, 8.775825500e-01f, 4.794255495e-01f, 9.875259995e-01f, 1.574558765e-01f,
  9.987502694e-01f, 4.997916520e-02f, 9.998750091e-01f, 1.581072807e-02f, 9.999874830e-01f, 4.999979399e-03f, 9.999987483e-01f, 1.581138116e-03f,
  9.601702690e-01f, -2.794154882e-01f, -3.207964003e-01f, 9.471482038e-01f, 8.253356218e-01f, 5.646424890e-01f, 9.820539355e-01f, 1.886002719e-01f,
  9.982005358e-01f, 5.996400490e-02f, 9.998199940e-01f, 1.897252724e-02f, 9.999819994e-01f, 5.999964196e-03f, 9.999982119e-01f, 1.897365320e-03f,
  7.539022565e-01f, 6.569865942e-01f, -5.994374752e-01f, 8.004215956e-01f, 7.648422122e-01f, 6.442176700e-01f, 9.755998850e-01f, 2.195560932e-01f,
  9.975510240e-01f, 6.994284689e-02f, 9.997550249e-01f, 2.213413455e-02f, 9.999755025e-01f, 6.999942940e-03f, 9.999975562e-01f, 2.213592408e-03f,
  -1.455000341e-01f, 9.893582463e-01f, -8.186324239e-01f, 5.743177533e-01f, 6.967067122e-01f, 7.173560858e-01f, 9.681702852e-01f, 2.502923310e-01f,
  9.968017340e-01f, 7.991468906e-02f, 9.996800423e-01f, 2.529552206e-02f, 9.999679923e-01f, 7.999914698e-03f, 9.999967813e-01f, 2.529819263e-03f,
  -9.111302495e-01f, 4.121184945e-01f, -9.566441774e-01f, 2.912592292e-01f, 6.216099262e-01f, 7.833269238e-01f, 9.597726464e-01f, 2.807783186e-01f,
  9.959527254e-01f, 8.987854421e-02f, 9.995950460e-01f, 2.845665626e-02f, 9.999595284e-01f, 8.999879472e-03f, 9.999959469e-01f, 2.846045885e-03f,
  -8.390715122e-01f, -5.440211296e-01f, -9.997860789e-01f, -2.068356983e-02f, 5.403022766e-01f, 8.414709568e-01f, 9.504153132e-01f, 3.109835684e-01f,
  9.950041771e-01f, 9.983341396e-02f, 9.995000362e-01f, 3.161750361e-02f, 9.999499917e-01f, 9.999834001e-03f, 9.999949932e-01f, 3.162272274e-03f,
  4.425697960e-03f, -9.999902248e-01f, -9.437797666e-01f, -3.305749595e-01f, 4.535960853e-01f, 8.912073970e-01f, 9.401075840e-01f, 3.408778608e-01f,
  9.939560890e-01f, 1.097782999e-01f, 9.993950725e-01f, 3.477803990e-02f, 9.999395013e-01f, 1.099977922e-02f, 9.999939203e-01f, 3.478498431e-03f,
  8.438539505e-01f, -5.365729332e-01f, -7.941793799e-01f, -6.076834202e-01f, 3.623577058e-01f, 9.320390821e-01f, 9.288598895e-01f, 3.704313040e-01f,
  9.928086400e-01f, 1.197122037e-01f, 9.992800951e-01f, 3.793822229e-02f, 9.999279976e-01f, 1.199971233e-02f, 9.999927878e-01f, 3.794723889e-03f,
  9.074468017e-01f, 4.201670289e-01f, -5.658205152e-01f, -8.245284557e-01f, 2.674987614e-01f, 9.635581970e-01f, 9.166833758e-01f, 3.996143043e-01f,
  9.915618896e-01f, 1.296341419e-01f, 9.991551042e-01f, 4.109803215e-02f, 9.999154806e-01f, 1.299963426e-02f, 9.999915361e-01f, 4.110949114e-03f,
  1.367372125e-01f, 9.906073809e-01f, -2.813494802e-01f, -9.596053958e-01f, 1.699671596e-01f, 9.854497313e-01f, 9.035902619e-01f, 4.283977747e-01f,
  9.902160168e-01f, 1.395431161e-01f, 9.990201592e-01f, 4.425742477e-02f, 9.999020100e-01f, 1.399954315e-02f, 9.999902248e-01f, 4.427174106e-03f,
  -7.596879005e-01f, 6.502878666e-01f, 3.102235124e-02f, -9.995186925e-01f, 7.073719800e-02f, 9.974949956e-01f, 8.895936012e-01f, 4.567528665e-01f,
  9.887710810e-01f, 1.494381279e-01f, 9.988752007e-01f, 4.741638154e-02f, 9.998875260e-01f, 1.499943808e-02f, 9.999887347e-01f, 4.743398633e-03f,
  -9.576594830e-01f, -2.879033089e-01f, 3.403181732e-01f, -9.403103590e-01f, -2.919954620e-02f, 9.995735884e-01f, 8.747074604e-01f, 4.846512377e-01f,
  9.872272611e-01f, 1.593182087e-01f, 9.987202883e-01f, 5.057485774e-02f, 9.998720288e-01f, 1.599931903e-02f, 9.999871850e-01f, 5.059622694e-03f,
  -2.751633525e-01f, -9.613974690e-01f, 6.158648133e-01f, -7.878518701e-01f, -1.288445443e-01f, 9.916648269e-01f, 8.589466810e-01f, 5.120649934e-01f,
  9.855847955e-01f, 1.691823453e-01f, 9.985553622e-01f, 5.373282731e-02f, 9.998555183e-01f, 1.699918136e-02f, 9.999855757e-01f, 5.375845823e-03f,
  6.603167057e-01f, -7.509872317e-01f, 8.303361535e-01f, -5.572628975e-01f, -2.272021621e-01f, 9.738476276e-01f, 8.423270583e-01f, 5.389667153e-01f,
  9.838436842e-01f, 1.790295690e-01f, 9.983804226e-01f, 5.689026415e-02f, 9.998379946e-01f, 1.799902879e-02f, 9.999837875e-01f, 5.692068953e-03f,
  9.887046218e-01f, 1.498772055e-01f, 9.624637961e-01f, -2.714101076e-01f, -3.232895434e-01f, 9.463000894e-01f, 8.248651624e-01f, 5.653295517e-01f,
  9.820042253e-01f, 1.888588965e-01f, 9.981955290e-01f, 6.004713103e-02f, 9.998195171e-01f, 1.899885759e-02f, 9.999819398e-01f, 6.008291151e-03f,
  4.080820680e-01f, 9.129452705e-01f, 9.991443753e-01f, 4.135828838e-02f, -4.161468446e-01f, 9.092974067e-01f, 8.065784574e-01f, 5.911270380e-01f,
  9.800665975e-01f, 1.986693144e-01f, 9.980006814e-01f, 6.320339441e-02f, 9.998000264e-01f, 1.999866776e-02f, 9.999799728e-01f, 6.324512884e-03f,
  -5.477292538e-01f, 8.366556168e-01f, 9.367404580e-01f, 3.500247598e-01f, -5.048462152e-01f, 8.632093072e-01f, 7.874851823e-01f, 6.163335443e-01f,
  9.780309200e-01f, 2.084598988e-01f, 9.977958202e-01f, 6.635902822e-02f, 9.997795224e-01f, 2.099845745e-02f, 9.999779463e-01f, 6.640734151e-03f,
  -9.999608397e-01f, -8.851309307e-03f, 7.814403772e-01f, 6.239799261e-01f, -5.885011554e-01f, 8.084963560e-01f, 7.676045895e-01f, 6.409237385e-01f,
  9.758974314e-01f, 2.182296216e-01f, 9.975810051e-01f, 6.951400638e-02f, 9.997580051e-01f, 2.199822664e-02f, 9.999758005e-01f, 6.956954487e-03f,
  -5.328330398e-01f, -8.462204337e-01f, 5.486452579e-01f, 8.360552788e-01f, -6.662759781e-01f, 7.457052469e-01f, 7.469564080e-01f, 6.648730636e-01f,
  9.736663699e-01f, 2.279775143e-01f, 9.973561764e-01f, 7.266827673e-02f, 9.997355342e-01f, 2.299797349e-02f, 9.999735355e-01f, 7.273174357e-03f,
  4.241790175e-01f, -9.055783749e-01f, 2.614416778e-01f, 9.652192593e-01f, -7.373937964e-01f, 6.754631400e-01f, 7.255613208e-01f, 6.881574988e-01f,
  9.713379741e-01f, 2.377026230e-01f, 9.971213937e-01f, 7.582182437e-02f, 9.997119904e-01f, 2.399769612e-02f, 9.999712110e-01f, 7.589393295e-03f,
  9.912028313e-01f, -1.323517561e-01f, -5.168933049e-02f, 9.986631870e-01f, -8.011435866e-01f, 5.984721184e-01f, 7.034407258e-01f, 7.107539177e-01f,
  9.689124227e-01f, 2.474039644e-01f, 9.968766570e-01f, 7.897461206e-02f, 9.996874928e-01f, 2.499739639e-02f, 9.999687672e-01f, 7.905611768e-03f,
  6.469193101e-01f, 7.625584602e-01f, -3.596943319e-01f, 9.330701828e-01f, -8.568888307e-01f, 5.155012608e-01f, 6.806167960e-01f, 7.326396108e-01f,
  9.663899541e-01f, 2.570805550e-01f, 9.966219068e-01f, 8.212661743e-02f, 9.996620417e-01f, 2.599707060e-02f, 9.999662042e-01f, 8.221829310e-03f,
  -2.921388149e-01f, 9.563759565e-01f, -6.320286393e-01f, 7.749450207e-01f, -9.040721655e-01f, 4.273798466e-01f, 6.571123004e-01f, 7.537927032e-01f,
  9.637709260e-01f, 2.667314112e-01f, 9.963572025e-01f, 8.527779579e-02f, 9.996355176e-01f, 2.699672058e-02f, 9.999635220e-01f, 8.538045920e-03f,
  -9.626058936e-01f, 2.709057927e-01f, -8.416849375e-01f, 5.399689674e-01f, -9.422222972e-01f, 3.349882066e-01f, 6.329506636e-01f, 7.741920948e-01f,
  9.610554576e-01f, 2.763556540e-01f, 9.960825443e-01f, 8.842811733e-02f, 9.996080399e-01f, 2.799634263e-02f, 9.999607801e-01f, 8.854261599e-03f,
  -7.480575442e-01f, -6.636338830e-01f, -9.678714871e-01f, 2.514453232e-01f, -9.709581733e-01f, 2.392492294e-01f, 6.081562042e-01f, 7.938174009e-01f,
  9.582439065e-01f, 2.859522104e-01f, 9.957979321e-01f, 9.157756716e-02f, 9.995795488e-01f, 2.899593674e-02f, 9.999579787e-01f, 9.170476347e-03f,
  1.542514563e-01f, -9.880316257e-01f, -9.980752468e-01f, -6.201484054e-02f, -9.899924994e-01f, 1.411200017e-01f, 5.827536583e-01f, 8.126488924e-01f,
  9.553365111e-01f, 2.955201864e-01f, 9.955033660e-01f, 9.472609311e-02f, 9.995500445e-01f, 2.999550104e-02f, 9.999549985e-01f, 9.486690164e-03f,
  9.147423506e-01f, -4.040376544e-01f, -9.293003082e-01f, -3.693250120e-01f, -9.991351366e-01f, 4.158052057e-02f, 5.567683578e-01f, 8.306677938e-01f,
  9.523335695e-01f, 3.050586283e-01f, 9.951988459e-01f, 9.787366539e-02f, 9.995195270e-01f, 3.099503554e-02f, 9.999519587e-01f, 9.802903049e-03f,
  8.342233896e-01f, 5.514267087e-01f, -7.683671117e-01f, -6.400094032e-01f, -9.982947707e-01f, -5.837419257e-02f, 5.302263498e-01f, 8.478561044e-01f,
  9.492354393e-01f, 3.145665526e-01f, 9.948843718e-01f, 1.010202691e-01f, 9.994880557e-01f, 3.199454024e-02f, 9.999487996e-01f, 1.011911593e-02f,
  -1.327674743e-02f, 9.999118447e-01f, -5.312352777e-01f, -8.472243547e-01f, -9.874798059e-01f, -1.577456445e-01f, 5.031541586e-01f, 8.641966581e-01f,
  9.460423589e-01f, 3.240430057e-01f, 9.945599437e-01f, 1.041658595e-01f, 9.994555712e-01f, 3.299400955e-02f, 9.999455214e-01f, 1.043532696e-02f,
  -8.485702872e-01f, 5.290827155e-01f, -2.414211184e-01f, -9.704204202e-01f, -9.667981863e-01f, -2.555412054e-01f, 4.755789042e-01f, 8.796730638e-01f,
  9.427546859e-01f, 3.334870934e-01f, 9.942255616e-01f, 1.073104069e-01f, 9.994220734e-01f, 3.399345279e-02f, 9.999421835e-01f, 1.075153705e-02f,
  -9.036921859e-01f, -4.281826615e-01f, 7.233466953e-02f, -9.973804355e-01f, -9.364566803e-01f, -3.507832289e-01f, 4.475280643e-01f, 8.942698836e-01f,
  9.393727183e-01f, 3.428978026e-01f, 9.938812256e-01f, 1.104538813e-01f, 9.993875623e-01f, 3.499285504e-02f, 9.999387264e-01f, 1.106774528e-02f,
  -1.279636919e-01f, -9.917788506e-01f, 3.789161742e-01f, -9.254310131e-01f, -8.967583776e-01f, -4.425205588e-01f, 4.190297425e-01f, 9.079725146e-01f,
  9.358968139e-01f, 3.522742093e-01f, 9.935269952e-01f, 1.135962531e-01f, 9.993520975e-01f, 3.599222749e-02f, 9.999352098e-01f, 1.138395350e-02f,
  7.654140592e-01f, -6.435381174e-01f, 6.479216814e-01f, -7.617069483e-01f, -8.481000066e-01f, -5.298361778e-01f, 3.901124299e-01f, 9.207672477e-01f,
  9.323273301e-01f, 3.616154492e-01f, 9.931628108e-01f, 1.167374924e-01f, 9.993155599e-01f, 3.699155897e-02f, 9.999315739e-01f, 1.170015987e-02f,
  9.550736547e-01f, 2.963685691e-01f, 8.526731133e-01f, -5.224447846e-01f, -7.909677625e-01f, -6.118578315e-01f, 3.608050346e-01f, 9.326412678e-01f,
  9.286646247e-01f, 3.709204793e-01f, 9.927886724e-01f, 1.198775545e-01f, 9.992780685e-01f, 3.799085692e-02f, 9.999278188e-01f, 1.201636530e-02f,
  2.666429281e-01f, 9.637953639e-01f, 9.728653431e-01f, -2.313720137e-01f, -7.259322405e-01f, -6.877662539e-01f, 3.311368525e-01f, 9.435827136e-01f,
  9.249090552e-01f, 3.801884055e-01f, 9.924046397e-01f, 1.230164245e-01f, 9.992396235e-01f, 3.899011388e-02f, 9.999239445e-01f, 1.233256981e-02f,
  -6.669380665e-01f, 7.451131344e-01f, 9.965789914e-01f, 8.264580369e-02f, -6.536436081e-01f, -7.568024993e-01f, 3.011375964e-01f, 9.535806775e-01f,
  9.210609794e-01f, 3.894183338e-01f, 9.920106530e-01f, 1.261540651e-01f, 9.992001057e-01f, 3.998933733e-02f, 9.999200106e-01f, 1.264877338e-02f,
  -9.873392582e-01f, -1.586226672e-01f, 9.214623570e-01f, 3.884676993e-01f, -5.748240352e-01f, -8.182770610e-01f, 2.708370686e-01f, 9.626252055e-01f,
  9.171208143e-01f, 3.986093104e-01f, 9.916067719e-01f, 1.292904317e-01f, 9.991596341e-01f, 4.098851606e-02f, 9.999159575e-01f, 1.296497509e-02f,
  -3.999853134e-01f, -9.165215492e-01f, 7.549653649e-01f, 6.557646990e-01f, -4.902605712e-01f, -8.715758920e-01f, 2.402658761e-01f, 9.707071185e-01f,
  9.130889177e-01f, 4.077604413e-01f, 9.911929369e-01f, 1.324255317e-01f, 9.991181493e-01f, 4.198765755e-02f, 9.999117851e-01f, 1.328117587e-02f,
  5.551133156e-01f, -8.317747712e-01f, 5.135984421e-01f, 8.580306768e-01f, -4.007990062e-01f, -9.161660075e-01f, 2.094544172e-01f, 9.778184295e-01f,
  9.089657664e-01f, 4.168707728e-01f, 9.907692075e-01f, 1.355592906e-01f, 9.990756512e-01f, 4.298675060e-02f, 9.999075532e-01f, 1.359737478e-02f,
  9.998432994e-01f, 1.770192571e-02f, 2.212981731e-01f, 9.752061963e-01f, -3.073327839e-01f, -9.516021013e-01f, 1.784335226e-01f, 9.839519858e-01f,
  9.047516584e-01f, 4.259394705e-01f, 9.903355837e-01f, 1.386916935e-01f, 9.990321398e-01f, 4.398580641e-02f, 9.999032021e-01f, 1.391357277e-02f,
  5.253219604e-01f, 8.509035110e-01f, -9.294810891e-02f, 9.956709743e-01f, -2.107958049e-01f, -9.775301218e-01f, 1.472342163e-01f, 9.891016483e-01f,
  9.004471302e-01f, 4.349655211e-01f, 9.898920655e-01f, 1.418227106e-01f, 9.989876747e-01f, 4.498481750e-02f, 9.998987317e-01f, 1.422976889e-02f,
  -4.321779311e-01f, 9.017883539e-01f, -3.979767561e-01f, 9.173954725e-01f, -1.121526212e-01f, -9.936909676e-01f, 1.158876941e-01f, 9.932623506e-01f,
  8.960524797e-01f, 4.439480901e-01f, 9.894386530e-01f, 1.449523121e-01f, 9.989421964e-01f, 4.598378390e-02f, 9.998942018e-01f, 1.454596408e-02f,
  -9.923354983e-01f, 1.235731244e-01f, -6.635382771e-01f, 7.481423616e-01f, -1.238837745e-02f, -9.999232888e-01f, 8.442528546e-02f, 9.964298010e-01f,
  8.915683031e-01f, 4.528862834e-01f, 9.889753461e-01f, 1.480804533e-01f, 9.988957047e-01f, 4.698270187e-02f, 9.998895526e-01f, 1.486215740e-02f,
  -6.401443481e-01f, -7.682546377e-01f, -8.632965088e-01f, 5.046970844e-01f, 8.749917150e-02f, -9.961646199e-01f, 5.287845805e-02f, 9.986009598e-01f,
  8.869948983e-01f, 4.617791772e-01f, 9.885020852e-01f, 1.512071192e-01f, 9.988481998e-01f, 4.798157141e-02f, 9.998847842e-01f, 1.517834887e-02f,
  3.005925417e-01f, -9.537526369e-01f, -9.774427414e-01f, 2.112006545e-01f, 1.865124702e-01f, -9.824525714e-01f, 2.127875760e-02f, 9.997735620e-01f,
  8.823328614e-01f, 4.706258774e-01f, 9.880189896e-01f, 1.543322802e-01f, 9.987997413e-01f, 4.898039624e-02f, 9.998799562e-01f, 1.549453940e-02f,
  9.649659991e-01f, -2.623748481e-01f, -9.946564436e-01f, -1.032404602e-01f, 2.836622000e-01f, -9.589242935e-01f, -1.034221891e-02f, 9.999465346e-01f,
  8.775825500e-01f, 4.794255495e-01f, 9.875259995e-01f, 1.574558914e-01f, 9.987502694e-01f, 4.997916892e-02f, 9.998750091e-01f, 1.581072807e-02f,
  7.421541810e-01f, 6.702291965e-01f, -9.132301211e-01f, -4.074441493e-01f, 3.779776692e-01f, -9.258147478e-01f, -4.195285589e-02f, 9.991195798e-01f,
  8.727445006e-01f, 4.881772399e-01f, 9.870231748e-01f, 1.605779380e-01f, 9.986997843e-01f, 5.097789690e-02f, 9.998699427e-01f, 1.612691768e-02f,
  -1.629907787e-01f, 9.866275787e-01f, -7.412399650e-01f, -6.712401509e-01f, 4.685169160e-01f, -8.834545016e-01f, -7.352153957e-02f, 9.972936511e-01f,
  8.678191900e-01f, 4.968801141e-01f, 9.865104556e-01f, 1.636983752e-01f, 9.986482859e-01f, 5.197656900e-02f, 9.998648167e-01f, 1.644310169e-02f,
  -9.182828069e-01f, 3.959251642e-01f, -4.957418144e-01f, -8.684699535e-01f, 5.543745160e-01f, -8.322673440e-01f, -1.050167084e-01f, 9.944704771e-01f,
  8.628070951e-01f, 5.055333376e-01f, 9.859878421e-01f, 1.668171734e-01f, 9.985958338e-01f, 5.297519267e-02f, 9.998595715e-01f, 1.675928757e-02f,
  -8.293098211e-01f, -5.587890744e-01f, -2.010796219e-01f, -9.795749187e-01f, 6.346929669e-01f, -7.727644444e-01f, -1.364068687e-01f, 9.906529188e-01f,
  8.577086926e-01f, 5.141359568e-01f, 9.854553938e-01f, 1.699342877e-01f, 9.985423684e-01f, 5.397376046e-02f, 9.998542070e-01f, 1.707546785e-02f,
  2.212675661e-02f, -9.997551441e-01f, 1.135217771e-01f, -9.935355186e-01f, 7.086697817e-01f, -7.055402994e-01f, -1.676606387e-01f, 9.858447909e-01f,
  8.525245190e-01f, 5.226872563e-01f, 9.849131107e-01f, 1.730497181e-01f, 9.984878898e-01f, 5.497227982e-02f, 9.998487830e-01f, 1.739165001e-02f,
  8.532201052e-01f, -5.215510130e-01f, 4.168670774e-01f, -9.089674354e-01f, 7.755658031e-01f, -6.312667131e-01f, -1.987468749e-01f, 9.800508618e-01f,
  8.472551107e-01f, 5.311862230e-01f, 9.843609333e-01f, 1.761634201e-01f, 9.984323978e-01f, 5.597073585e-02f, 9.998431802e-01f, 1.770782843e-02f,
  8.998668194e-01f, 4.361647666e-01f, 6.788702011e-01f, -7.342582941e-01f, 8.347129226e-01f, -5.506852865e-01f, -2.296342701e-01f, 9.732769728e-01f,
  8.419010043e-01f, 5.396320224e-01f, 9.837989211e-01f, 1.792753637e-01f, 9.983759522e-01f, 5.696914345e-02f, 9.998375773e-01f, 1.802400686e-02f,
  1.191801354e-01f, 9.928726554e-01f, 8.735505342e-01f, -4.867334962e-01f, 8.855196238e-01f, -4.646020234e-01f, -2.602920532e-01f, 9.655299187e-01f,
  8.364626765e-01f, 5.480239391e-01f, 9.832270741e-01f, 1.823855042e-01f, 9.983184934e-01f, 5.796748772e-02f, 9.998317957e-01f, 1.834018156e-02f,
  -7.710801959e-01f, 6.367380023e-01f, 9.816020727e-01f, -1.909380108e-01f, 9.274784923e-01f, -3.738765717e-01f, -2.906895578e-01f, 9.568174481e-01f,
  8.309407234e-01f, 5.563610196e-01f, 9.826454520e-01f, 1.854938269e-01f, 9.982600212e-01f, 5.896577984e-02f, 9.998259544e-01f, 1.865635626e-02f,
  -9.524129629e-01f, -3.048106134e-01f, 9.923083186e-01f, 1.237909496e-01f, 9.601702690e-01f, -2.794154882e-01f, -3.207964003e-01f, 9.471482038e-01f,
  8.253356218e-01f, 5.646424294e-01f, 9.820539355e-01f, 1.886002868e-01f, 9.982005358e-01f, 5.996400863e-02f, 9.998199940e-01f, 1.897252724e-02f,
  -2.581016421e-01f, -9.661177993e-01f, 9.046075940e-01f, 4.262454212e-01f, 9.832684398e-01f, -1.821625978e-01f, -3.505824506e-01f, 9.365318418e-01f,
  8.196480274e-01f, 5.728674531e-01f, 9.814526439e-01f, 1.917048544e-01f, 9.981400967e-01f, 6.096218154e-02f, 9.998139739e-01f, 1.928869821e-02f,
  6.735071540e-01f, -7.391806841e-01f, 7.271980643e-01f, 6.864276528e-01f, 9.965420961e-01f, -8.308912069e-02f, -3.800179660e-01f, 9.249790907e-01f,
  8.138784766e-01f, 5.810351372e-01f, 9.808415174e-01f, 1.948075294e-01f, 9.980786443e-01f, 6.196028739e-02f, 9.998078346e-01f, 1.960486546e-02f,
  9.858965874e-01f, 1.673557013e-01f, 4.776714444e-01f, 8.785385489e-01f, 9.998586178e-01f, 1.681409031e-02f, -4.090735018e-01f, 9.125014544e-01f,
  8.080275059e-01f, 5.891447663e-01f, 9.802205563e-01f, 1.979082376e-01f, 9.980161786e-01f, 6.295833737e-02f, 9.998015761e-01f, 1.992103085e-02f,
};
#define XB_TMO      128
#define XB_XCNT(j)  (256  + 64 * (j))
#define XB_XSUB(j)  (1280 + 64 * (j))
#define XB_XGEN(j)  (2304 + 64 * (j))
#define XB_TOP      3328
#define XB_TOPGEN   3392
#define XCD_BAR_WORDS 3456
#define XB_SPIN_CAP (1u << 18)
#define LAS __attribute__((address_space(3)))

__device__ __forceinline__ unsigned xb_ld(unsigned* p)              { return __hip_atomic_load(p, __ATOMIC_RELAXED, __HIP_MEMORY_SCOPE_AGENT); }
__device__ __forceinline__ unsigned xb_add(unsigned* p, unsigned v) { return __hip_atomic_fetch_add(p, v, __ATOMIC_RELAXED, __HIP_MEMORY_SCOPE_AGENT); }
__device__ __forceinline__ unsigned xb_xcc_id() { return (unsigned)__builtin_amdgcn_s_getreg((3 << 11) | 20) & 0xFu; }
#define XB_SPIN(cond, bar) do { unsigned _sp = 0; while (cond) { __builtin_amdgcn_s_sleep(1); \
    if ((++_sp & 255u) == 0u) { if (xb_ld(&(bar)[XB_TMO])) break; if (_sp > XB_SPIN_CAP) { atomicAdd(&(bar)[XB_TMO], 1u); break; } } } } while (0)

struct XcdBarrier {
    unsigned* bar; unsigned x;
    volatile LAS unsigned* st;
};

__device__ __forceinline__ XcdBarrier xcd_barrier_post(unsigned* bar, volatile LAS unsigned* st) {
    XcdBarrier b; b.bar = bar; b.x = xb_xcc_id(); b.st = st;
    if (threadIdx.x == 0) (void)xb_add(&bar[XB_XCNT(b.x)], 1u);
    return b;
}
__device__ __forceinline__ void xcd_barrier_complete(unsigned* bar, unsigned x, unsigned& nloc, unsigned& nx) {
    const unsigned G = gridDim.x * gridDim.y * gridDim.z;
    unsigned sum, cnt, mine, sp = 0u;
    for (;;) {
        sum = 0u; cnt = 0u; mine = 0u;
#pragma unroll
        for (unsigned j = 0; j < 16; ++j) { const unsigned c = xb_ld(&bar[XB_XCNT(j)]); sum += c; cnt += (c > 0u) ? 1u : 0u; mine = (j == x) ? c : mine; }
        if (sum == G) break;
        __builtin_amdgcn_s_sleep(1);
        if ((++sp & 255u) == 0u) { if (xb_ld(&bar[XB_TMO])) break; if (sp > XB_SPIN_CAP) { atomicAdd(&bar[XB_TMO], 1u); break; } }
    }
    nloc = mine > 0u ? mine : 1u; nx = cnt > 0u ? cnt : 1u;
}

__device__ __forceinline__ void xcd_barrier(const XcdBarrier& b, const bool t0  ) {
    asm volatile("s_waitcnt vmcnt(0)" ::: "memory");
    __syncthreads();
    if (t0) {
        unsigned* bar = b.bar;
        __builtin_amdgcn_s_waitcnt(0);
        unsigned nloc = b.st[0], nx = b.st[1];
        if (nloc == 0u) { xcd_barrier_complete(bar, b.x, nloc, nx); b.st[0] = nloc; b.st[1] = nx; }
        const unsigned old = xb_add(&bar[XB_XSUB(b.x)], 1u);
        const unsigned gen = old / nloc;
        if (old + 1u == (gen + 1u) * nloc) {
            __builtin_amdgcn_fence(__ATOMIC_RELEASE, "agent");
            asm volatile("s_waitcnt vmcnt(0)" ::: "memory");
            const unsigned og = xb_add(&bar[XB_TOP], 1u);
            const unsigned tg = og / nx;
            if (og + 1u == (tg + 1u) * nx) xb_add(&bar[XB_TOPGEN], 1u);
            else XB_SPIN(xb_ld(&bar[XB_TOPGEN]) == tg, bar);
            __builtin_amdgcn_fence(__ATOMIC_ACQUIRE, "agent");
            xb_add(&bar[XB_XGEN(b.x)], 1u);
            asm volatile("s_waitcnt vmcnt(0)" ::: "memory");
        } else {
            XB_SPIN(xb_ld(&bar[XB_XGEN(b.x)]) == gen, bar);
            __builtin_amdgcn_fence(__ATOMIC_ACQUIRE, "agent");
            asm volatile("s_waitcnt vmcnt(0)" ::: "memory");
        }
    }
    __syncthreads();
}

DI void conv_fetch(const float* __restrict__ src, int K, int N, int k0, int n0, f32x4 (&v)[2], int tid) {
#pragma unroll
    for (int i = 0; i < 2; ++i) {
        const int idx = tid + NTHREADS * i, kr = idx >> 4, c4 = (idx & 15) * 4;
        v[i] = (f32x4){0.f, 0.f, 0.f, 0.f};
        if (n0 + c4 < N) v[i] = __builtin_nontemporal_load((const f32x4*)(src + (size_t)(k0 + kr) * N + n0 + c4));
    }
}
DI void conv_put(const f32x4 (&v)[2], float* lds, int tid) {
#pragma unroll
    for (int i = 0; i < 2; ++i) {
        const int idx = tid + NTHREADS * i, kr = idx >> 4, c4 = (idx & 15) * 4;
        float* d = lds + kr * 65 + c4;
        d[0] = v[i].x; d[1] = v[i].y; d[2] = v[i].z; d[3] = v[i].w;
    }
}
typedef float f32x2_8 __attribute__((ext_vector_type(2)));
DI unsigned cvt_fp8x4(float a, float b, float c, float d) { int w = __builtin_amdgcn_cvt_pk_fp8_f32(a, b, 0, false); w = __builtin_amdgcn_cvt_pk_fp8_f32(c, d, w, true); return (unsigned)w; }
template <bool NT, bool FP8>
DI void conv_store(int K, bf16_t* __restrict__ dst, int k0, int ndst0, int nstep, const float* lds, int tid) {
    const int idx = tid, n = idx >> 3, kc = idx & 7;
    float f[8];
#pragma unroll
    for (int j = 0; j < 8; ++j) f[j] = lds[(kc * 8 + j) * 65 + n];
    const size_t e = (size_t)(ndst0 + (n & 31) + (n >> 5) * nstep) * K + k0 + kc * 8;
    if (FP8) {
        u32x2 w; w.x = cvt_fp8x4(f[0] * 32.f, f[1] * 32.f, f[2] * 32.f, f[3] * 32.f); w.y = cvt_fp8x4(f[4] * 32.f, f[5] * 32.f, f[6] * 32.f, f[7] * 32.f);
        u32x2* d = (u32x2*)((unsigned char*)dst + e);
        if (NT) __builtin_nontemporal_store(w, d); else *d = w;
    } else {
        u32x4* d = (u32x4*)(dst + e);
        if (NT) __builtin_nontemporal_store(pack8(f), d); else *d = pack8(f);
    }
}
template <bool NT = true, bool FP8 = false>
DI void conv_job(const float* src, int count, int K, int N, int Npad, bf16_t* dst, int perm  , int& base, float* lds, int bid, int nb, int tid) {
    const int tk = K / 64, tn = Npad / 64, per = tk * tn, total = count * per;
    int t = (bid - (base % nb) + nb) % nb;
    f32x4 rg[4][2];
    auto fetch4 = [&](int tt) {
#pragma unroll
        for (int q = 0; q < 4; ++q) {
            const int tq = tt + q * nb;
            if (tq < total) { const int mi = tq / per, rem = tq - mi * per, nt = rem / tk, kt = rem - nt * tk;
                conv_fetch(src + (size_t)mi * K * N, K, N, kt * 64, nt * 64, rg[q], tid); }
        }
    };
    if (t < total) fetch4(t);
    for (; t < total; t += 4 * nb) {
#pragma unroll
        for (int q = 0; q < 4; ++q) if (t + q * nb < total) conv_put(rg[q], lds + q * 4160, tid);
        __syncthreads();
        if (t + 4 * nb < total) fetch4(t + 4 * nb);
#pragma unroll
        for (int q = 0; q < 4; ++q) {
            const int tq = t + q * nb;
            if (tq < total) { const int mi = tq / per, rem = tq - mi * per, nt = rem / tk, kt = rem - nt * tk, n0 = nt * 64;
                int nd0 = n0, nstep = 32;
                if (perm == 1) nd0 = ((n0 & 255) >> 7) * 256 + (n0 >> 8) * 128 + (n0 & 127);
                else if (n0 < perm) { const int hg = n0 >> 6; nd0 = (hg >> 2) * 256 + (hg & 3) * 32; nstep = 128; }
                conv_store<NT, FP8>(K, FP8 ? (bf16_t*)((unsigned char*)dst + (size_t)mi * Npad * K) : dst + (size_t)mi * Npad * K, kt * 64, nd0, nstep, lds + q * 4160, tid); }
        }
        __syncthreads();
    }
    base += total;
}

DI int mla_col(bool uq, int r) {
    const int hw = uq ? 96 : 128;
    if (r < 1024) { const int pn = r >> 8, bj = (r >> 7) & 1, wc = (r >> 5) & 3, d = r & 31; return (4 * pn + wc) * hw + 32 * bj + d; }
    const int rr = r - 1024;
    if (uq) { const int head = rr >> 5, c = rr & 31, dim = (c >> 3) * 4 + (c & 3) + 16 * ((c >> 2) & 1); return head * 96 + 64 + dim; }
    return (rr >> 6) * 128 + 64 + (rr & 63);
}
DI void phase_prologue(const Params& p, float* lds, int bid, int nb, int tid) {
    bf16_t* ws16 = (bf16_t*)p.ws;
    int base = 0;
    conv_job<true, true>(p.in[13], 1, 1024, 3072, 3072, (bf16_t*)(p.ws + W_QKV0), 2048, base, lds, bid, nb, tid);
    conv_job<true, true>(p.in[14], 1, 1024, 1024, 1024, (bf16_t*)(p.ws + W_O0), 0, base, lds, bid, nb, tid);
    conv_job<true, true>(p.in[18], 1, 1024, 1536, 1536, (bf16_t*)(p.ws + W_QKV1), 1280, base, lds, bid, nb, tid);
    conv_job<true, true>(p.in[19], 1, 1024, 1024, 1024, (bf16_t*)(p.ws + W_O1), 0, base, lds, bid, nb, tid);
    conv_job<true, true>(p.in[23], 1, 1024, 672, 768, (bf16_t*)(p.ws + W_DQKV), 0, base, lds, bid, nb, tid);
    for (int i = bid * NTHREADS + tid; i < 1536 * 48 + 2048 * 32; i += nb * NTHREADS) {
        const bool uq = i < 1536 * 48;
        const int K = uq ? 384 : 256, kc = K / 8, ii = uq ? i : i - 1536 * 48, r = ii / kc, k0 = (ii - r * kc) * 8, nsrc = uq ? 1536 : 2048;
        const int col = mla_col(uq, r);
        const float* src = p.in[uq ? 26 : 27] + (size_t)k0 * nsrc + col;
        float f[8];
#pragma unroll
        for (int j = 0; j < 8; ++j) f[j] = src[(size_t)j * nsrc];
        *(u32x4*)((bf16_t*)(p.ws + (uq ? W_UQ : W_UKV)) + (size_t)r * K + k0) = pack8(f);
    }
    conv_job<true, true>(p.in[30], 1, 1024, 1024, 1024, (bf16_t*)(p.ws + W_O2), 0, base, lds, bid, nb, tid);
    conv_job<true, true>(p.in[31], 1, 1024, 3072, 3072, (bf16_t*)(p.ws + W_QKV3), 2048, base, lds, bid, nb, tid);
    conv_job<true, true>(p.in[36], 1, 1024, 1024, 1024, (bf16_t*)(p.ws + W_O3), 0, base, lds, bid, nb, tid);
    conv_job<true, true>(p.in[11], 32, 1024, 512, 512, (bf16_t*)(p.ws + W_GU), 1, base, lds, bid, nb, tid);
    conv_job(p.in[12], 32, 256, 1024, 1024, (bf16_t*)(p.ws + W_DN), 0, base, lds, bid, nb, tid);
    (void)ws16;
    float* sc = lds;
    for (int i = tid; i < 9 * 1024; i += NTHREADS) {
        const int r = i >> 10, k = i & 1023;
        const float v = r < 8 ? p.in[1][r * 1024 + k] : p.in[3][k];
        sc[i] = silu_f(v);
    }
    __syncthreads();
    float* part = (float*)(p.ws + WS_MODP);
    for (int it = bid; it < 768; it += nb) {
        const int kc = it / 48, rem = it - kc * 48, l = rem / 12, nch = rem - l * 12;
        const int n = nch * 512 + tid;
        const float* w = p.in[4] + ((size_t)l * 1024 + kc * 64) * 6144 + n;
        float acc[9];
#pragma unroll
        for (int r = 0; r < 9; ++r) acc[r] = 0.f;
#pragma unroll 8
        for (int k = 0; k < 64; ++k) {
            const float wv = __builtin_nontemporal_load(w + (size_t)k * 6144);
#pragma unroll
            for (int r = 0; r < 9; ++r) acc[r] += sc[r * 1024 + kc * 64 + k] * wv;
        }
#pragma unroll
        for (int r = 0; r < 9; ++r) part[(((size_t)kc * 4 + l) * 9 + r) * 6144 + n] = acc[r];
    }
    __syncthreads();
}
DI void phase_mod_reduce(const Params& p, int bid, int nb, int tid) {
    const float* part = (const float*)(p.ws + WS_MODP);
    float* mod = (float*)(p.ws + WS_MOD);
    const int total = 4 * 9 * 6144;
    for (int i = bid * NTHREADS + tid; i < total; i += nb * NTHREADS) {
        const int l = i / (9 * 6144), n = i % 6144;
        float s = p.in[5][l * 6144 + n];
#pragma unroll
        for (int kc = 0; kc < 16; ++kc) s += part[(size_t)kc * total + i];
        mod[i] = s;
    }
}

template <int MODE>
DI void phase_rows(const Params& p, int layer  , int which  , int bid, int nb, int tid) {
    const int wid = __builtin_amdgcn_readfirstlane(tid >> 6), lane = tid & 63;
    const float* modall = (const float*)(p.ws + WS_MOD);
    const bf16_t* eo = (const bf16_t*)(p.ws + WS_RAW);
    bf16_t* H = (bf16_t*)(p.ws + WS_H);
    const int rpw = (MROWS + nb * NW - 1) / (nb * NW), rbeg = (bid * NW + wid) * rpw, rend = min(MROWS, rbeg + rpw);
    int mr_have = -1;
    f32x4 g2v[4], gmv[4], shv[4];
    for (int r = rbeg; r < rend; ++r) {
        const int b = r / PP, pos = r - b * PP;
        if ((MODE & 16) && pos >= SEQ) continue;
        const int mr = pos < SEQ ? b : 8;
        if (mr != mr_have) {
            mr_have = mr;
            if (MODE & 1) { const float* g2 = modall + ((size_t)(layer - ((MODE & 2) ? 1 : 0)) * 9 + mr) * 6144 + 5120;
#pragma unroll
                for (int j = 0; j < 4; ++j) g2v[j] = *(const f32x4*)(g2 + lane * 4 + 256 * j) * (1.0f / 16.0f); }
            if (MODE & 2) { const float* ng = p.in[6] + ((size_t)layer * 2 + which) * 1024; const float* md = modall + ((size_t)layer * 9 + mr) * 6144 + which * 3072;
#pragma unroll
                for (int j = 0; j < 4; ++j) { const f32x4 g = *(const f32x4*)(ng + lane * 4 + 256 * j), sc = *(const f32x4*)(md + 1024 + lane * 4 + 256 * j);
                    shv[j] = *(const f32x4*)(md + lane * 4 + 256 * j); gmv[j] = (f32x4){g.x * (1.0f + sc.x), g.y * (1.0f + sc.y), g.z * (1.0f + sc.z), g.w * (1.0f + sc.w)}; } }
        }
        bf16_t* xb = xb_row(p, r);
        float x[16];
        if (MODE & 8) {
            const float* xr = pos < SEQ ? p.in[0] + ((size_t)b * SEQ + pos) * DM : p.in[2] + ((size_t)b * CTXL + (pos - SEQ)) * DM;
#pragma unroll
            for (int j = 0; j < 4; ++j) { const f32x4 v = *(const f32x4*)(xr + lane * 4 + 256 * j); x[4 * j] = v.x; x[4 * j + 1] = v.y; x[4 * j + 2] = v.z; x[4 * j + 3] = v.w; }
        } else {
#pragma unroll
            for (int j = 0; j < 4; ++j) { const u32x2 v = *(const u32x2*)(xb + lane * 4 + 256 * j); x[4 * j] = bflo(v.x); x[4 * j + 1] = bfhi(v.x); x[4 * j + 2] = bflo(v.y); x[4 * j + 3] = bfhi(v.y); }
        }
        if (MODE & 1) {
            const unsigned char* y0 = (const unsigned char*)eo + (size_t)(2 * r) * 1024, *y1 = y0 + 1024;
#pragma unroll
            for (int j = 0; j < 4; ++j) {
                const unsigned a = *(const unsigned*)(y0 + lane * 4 + 256 * j), bb = *(const unsigned*)(y1 + lane * 4 + 256 * j);
                const f32x4 g = g2v[j];
                const f32x2_8 a01 = __builtin_amdgcn_cvt_pk_f32_fp8((int)a, false), a23 = __builtin_amdgcn_cvt_pk_f32_fp8((int)a, true);
                const f32x2_8 b01 = __builtin_amdgcn_cvt_pk_f32_fp8((int)bb, false), b23 = __builtin_amdgcn_cvt_pk_f32_fp8((int)bb, true);
                x[4 * j] += g.x * (a01[0] + b01[0]); x[4 * j + 1] += g.y * (a01[1] + b01[1]);
                x[4 * j + 2] += g.z * (a23[0] + b23[0]); x[4 * j + 3] += g.w * (a23[1] + b23[1]);
            }
        }
        if (MODE & 16) {
            float* orow = p.out + ((size_t)b * SEQ + pos) * DM;
#pragma unroll
            for (int j = 0; j < 4; ++j) *(f32x4*)(orow + lane * 4 + 256 * j) = (f32x4){x[4 * j], x[4 * j + 1], x[4 * j + 2], x[4 * j + 3]};
        } else if (MODE & (1 | 8)) {
#pragma unroll
            for (int j = 0; j < 4; ++j) {
                u32x2 w; w.x = pk2(x[4 * j], x[4 * j + 1]); w.y = pk2(x[4 * j + 2], x[4 * j + 3]);
                *(u32x2*)(xb + lane * 4 + 256 * j) = w;
                x[4 * j] = bflo(w.x); x[4 * j + 1] = bfhi(w.x); x[4 * j + 2] = bflo(w.y); x[4 * j + 3] = bfhi(w.y);
            }
        }
        if (MODE & 2) {
            float ss = 0.f;
#pragma unroll
            for (int i = 0; i < 16; ++i) ss += x[i] * x[i];
            ss = wave_sum(ss);
            const float rs = rsqrtf(ss * (1.0f / 1024.0f) + EPS);
#pragma unroll
            for (int j = 0; j < 4; ++j) {
                const f32x4 g = gmv[j], sh = shv[j];
                const float h0 = x[4 * j] * rs * g.x + sh.x, h1 = x[4 * j + 1] * rs * g.y + sh.y;
                const float h2 = x[4 * j + 2] * rs * g.z + sh.z, h3 = x[4 * j + 3] * rs * g.w + sh.w;
                if (MODE & 32) *(unsigned*)((unsigned char*)H + (size_t)r * 1024 + lane * 4 + 256 * j) = cvt_fp8x4(h0, h1, h2, h3);
                else { u32x2 w; w.x = pk2(h0, h1); w.y = pk2(h2, h3); *(u32x2*)(H + (size_t)r * 1024 + lane * 4 + 256 * j) = w; }
            }
        }
    }
}

constexpr size_t WS_RC = WS_MOD + 917504;
DI void phase_router_prep(const Params& p, int bid, int nb, int tid) {
    const float* modall = (const float*)(p.ws + WS_MOD);
    bf16_t* wth = (bf16_t*)(p.ws + WS_RW); bf16_t* wtl = wth + 4 * 9 * 48 * 1024;
    const int total = 4 * 9 * 48 * 1024;
    for (int i = bid * NTHREADS + tid; i < total; i += nb * NTHREADS) {
        const int k = i & 1023, c = (i >> 10) % 48, lb = i / (48 * 1024), l = lb / 9, b = lb - l * 9;
        float v = 0.f;
        if (c < 36) {
            const float w = c < 32 ? p.in[9][((size_t)l * 1024 + k) * 32 + c] : p.in[7][((size_t)l * 1024 + k) * 4 + (c - 32)];
            v = p.in[6][((size_t)l * 2 + 1) * 1024 + k] * (1.0f + modall[((size_t)l * 9 + b) * 6144 + 4096 + k]) * w;
        }
        const unsigned hb = f2bf(v); wth[i] = (bf16_t)hb; wtl[i] = (bf16_t)f2bf(v - bf2f(hb));
    }
    float* cst = (float*)(p.ws + WS_RC);
    const int wid = __builtin_amdgcn_readfirstlane(tid >> 6), lane = tid & 63;
    for (int j = bid * NW + wid; j < 4 * 9 * 48; j += nb * NW) {
        const int c = j % 48, lb = j / 48, l = lb / 9, b = lb - l * 9;
        float acc = 0.f;
        if (c < 36) {
            for (int k = lane; k < 1024; k += 64) {
                const float w = c < 32 ? p.in[9][((size_t)l * 1024 + k) * 32 + c] : p.in[7][((size_t)l * 1024 + k) * 4 + (c - 32)];
                acc += modall[((size_t)l * 9 + b) * 6144 + 3072 + k] * w;
            }
            acc = wave_sum(acc) + (c < 32 ? p.in[10][l * 32 + c] : p.in[8][l * 4 + (c - 32)]);
        }
        if (lane == 0) cst[j] = acc;
    }
}
typedef float f32x2_3 __attribute__((ext_vector_type(2)));
typedef __bf16 bf16x2_3 __attribute__((ext_vector_type(2)));
DI unsigned cvtpk3(float lo, float hi) { f32x2_3 v = {lo, hi}; bf16x2_3 b = __builtin_convertvector(v, bf16x2_3); return __builtin_bit_cast(unsigned, b); }
DI void phase_router(const Params& p, unsigned char* smem, int layer, bool skip_ctx, int bid, int nb, int tid) {
    const int lane = tid & 63, wid = __builtin_amdgcn_readfirstlane(tid >> 6), li = lane & 15, kq = lane >> 4;
    LAS float* tile = (LAS float*)smem + wid * (32 * 49);
    const bf16_t* wth_all = (const bf16_t*)(p.ws + WS_RW) + (size_t)layer * 9 * 48 * 1024;
    const bf16_t* wtl_all = wth_all + 4 * 9 * 48 * 1024;
    const float* cst_all = (const float*)(p.ws + WS_RC) + layer * 9 * 48;
    unsigned* cnt = (unsigned*)(p.ws + WS_CTL) + CW_CNT + layer * 32;
    unsigned* list = (unsigned*)(p.ws + WS_LIST);
    float* gates = (float*)(p.ws + WS_GATE);
    if (layer > 0) {
        int base = 0;
        conv_job<false, true>(p.in[11] + (size_t)layer * 32 * 1024 * 512, 32, 1024, 512, 512, (bf16_t*)(p.ws + W_GU + (size_t)layer * 32 * 512 * 1024), 1, base, (float*)smem, bid, nb, tid);
        conv_job<false>(p.in[12] + (size_t)layer * 32 * 256 * 1024, 32, 256, 1024, 1024, (bf16_t*)(p.ws + W_DN) + (size_t)layer * 32 * 1024 * 256, 0, base, (float*)smem, bid, nb, tid);
    }
    for (int u = bid * NW + wid; u < MROWS / 32; u += nb * NW) {
        const int r0 = u * 32, b = r0 / PP, pos = r0 - b * PP;
        const bool isctx = pos >= SEQ;
        if (skip_ctx && isctx) continue;
        const int mr = isctx ? 8 : b;
        const bf16_t* xr = xb_row(p, r0 + li) + 8 * kq;
        const bf16_t* wh = wth_all + ((size_t)mr * 48 + li) * 1024 + 8 * kq;
        const bf16_t* wl = wtl_all + ((size_t)mr * 48 + li) * 1024 + 8 * kq;
        f32x4 acc[2][3];
#pragma unroll
        for (int m = 0; m < 2; ++m)
#pragma unroll
            for (int n = 0; n < 3; ++n) acc[m][n] = (f32x4){0.f, 0.f, 0.f, 0.f};
        float ss[2] = {0.f, 0.f};
#pragma unroll 2
        for (int s = 0; s < 32; ++s) {
            bf16x8 xa[2], bh[3], bl[3];
#pragma unroll
            for (int m = 0; m < 2; ++m) xa[m] = *(const bf16x8*)(xr + (size_t)m * 16 * DM + 32 * s);
#pragma unroll
            for (int n = 0; n < 3; ++n) { bh[n] = *(const bf16x8*)(wh + (size_t)n * 16 * 1024 + 32 * s); bl[n] = *(const bf16x8*)(wl + (size_t)n * 16 * 1024 + 32 * s); }
#pragma unroll
            for (int m = 0; m < 2; ++m) {
                const u32x4 w = __builtin_bit_cast(u32x4, xa[m]);
                ss[m] += bflo(w.x) * bflo(w.x) + bfhi(w.x) * bfhi(w.x) + bflo(w.y) * bflo(w.y) + bfhi(w.y) * bfhi(w.y) + bflo(w.z) * bflo(w.z) + bfhi(w.z) * bfhi(w.z) + bflo(w.w) * bflo(w.w) + bfhi(w.w) * bfhi(w.w);
#pragma unroll
                for (int n = 0; n < 3; ++n) {
                    acc[m][n] = __builtin_amdgcn_mfma_f32_16x16x32_bf16(xa[m], bl[n], acc[m][n], 0, 0, 0);
                    acc[m][n] = __builtin_amdgcn_mfma_f32_16x16x32_bf16(xa[m], bh[n], acc[m][n], 0, 0, 0);
                }
            }
        }
#pragma unroll
        for (int m = 0; m < 2; ++m) { ss[m] += __shfl_xor(ss[m], 16); ss[m] += __shfl_xor(ss[m], 32); }
#pragma unroll
        for (int m = 0; m < 2; ++m)
#pragma unroll
            for (int n = 0; n < 3; ++n)
#pragma unroll
                for (int i = 0; i < 4; ++i) tile[(16 * m + 4 * kq + i) * 49 + n * 16 + li] = acc[m][n][i];
        __builtin_amdgcn_s_waitcnt(0xc07f);
        const float ssr = (lane & 16) ? ss[1] : ss[0];
        const float rs = rsqrtf(ssr * (1.0f / 1024.0f) + EPS);
        if (lane < 32) {
            const float* cst = cst_all + mr * 48;
            const LAS float* tr = tile + lane * 49;
            float lg[4];
#pragma unroll
            for (int c = 0; c < 4; ++c) lg[c] = tr[32 + c] * rs + cst[32 + c];
            int gi = 0; float gm = lg[0];
#pragma unroll
            for (int c = 1; c < 4; ++c) if (lg[c] > gm) { gm = lg[c]; gi = c; }
            float gden = 0.f;
#pragma unroll
            for (int c = 0; c < 4; ++c) gden += __expf(lg[c] - gm);
            const float gw = 1.0f / gden;
            float le[8];
#pragma unroll
            for (int c = 0; c < 8; ++c) le[c] = tr[gi * 8 + c] * rs + cst[gi * 8 + c];
            int e0 = 0; float m0 = le[0];
#pragma unroll
            for (int c = 1; c < 8; ++c) if (le[c] > m0) { m0 = le[c]; e0 = c; }
            int e1 = -1; float m1 = -INFINITY;
#pragma unroll
            for (int c = 0; c < 8; ++c) if (c != e0 && le[c] > m1) { m1 = le[c]; e1 = c; }
            const float q1 = __expf(m1 - m0), inv = 1.0f / (1.0f + q1);
            const int r = r0 + lane, ex0 = gi * 8 + e0, ex1 = gi * 8 + e1;
            const unsigned s0 = atomicAdd(cnt + ex0, 1u), s1 = atomicAdd(cnt + ex1, 1u);
            list[(size_t)ex0 * MROWS + s0] = 2u * r; list[(size_t)ex1 * MROWS + s1] = 2u * r + 1u;
            gates[2 * r] = gw * inv; gates[2 * r + 1] = gw * q1 * inv;
        }
        {
            const float* ng = p.in[6] + ((size_t)layer * 2 + 1) * 1024;
            const float* md = (const float*)(p.ws + WS_MOD) + ((size_t)layer * 9 + mr) * 6144 + 3072;
            f32x4 gm[4], sh[4];
#pragma unroll
            for (int j = 0; j < 4; ++j) {
                const f32x4 g = *(const f32x4*)(ng + lane * 4 + 256 * j), sc = *(const f32x4*)(md + 1024 + lane * 4 + 256 * j);
                sh[j] = *(const f32x4*)(md + lane * 4 + 256 * j);
                gm[j] = (f32x4){g.x * (1.0f + sc.x), g.y * (1.0f + sc.y), g.z * (1.0f + sc.z), g.w * (1.0f + sc.w)};
            }
            unsigned char* H8 = p.ws + WS_H;
#pragma unroll 4
            for (int i = 0; i < 32; ++i) {
                const float rsi = __shfl(rs, i);
                const bf16_t* xb = xb_row(p, r0 + i);
#pragma unroll
                for (int j = 0; j < 4; ++j) {
                    const u32x2 v = *(const u32x2*)(xb + lane * 4 + 256 * j);
                    *(unsigned*)(H8 + (size_t)(r0 + i) * 1024 + lane * 4 + 256 * j) =
                        cvt_fp8x4(bflo(v.x) * rsi * gm[j].x + sh[j].x, bfhi(v.x) * rsi * gm[j].y + sh[j].y, bflo(v.y) * rsi * gm[j].z + sh[j].z, bfhi(v.y) * rsi * gm[j].w + sh[j].w);
                }
            }
        }
    }
}

#define MFMA32(a, b, c) __builtin_amdgcn_mfma_f32_32x32x16_bf16((a), (b), (c), 0, 0, 0)
typedef LAS unsigned char* lds_ptr;
constexpr int GEMM_TM = 256, GEMM_TN = 256;
constexpr int GEMM_STAGE = 65536;
constexpr int GEMM_LDS = 2 * GEMM_STAGE;
constexpr int GEMM_MT = 4;

struct RowDense { static constexpr bool DENSE = true; const bf16_t* A; int lda; int m0; DI unsigned row(int i) const { return (unsigned)(m0 + i) * (unsigned)lda; } };
struct RowGather { static constexpr bool DENSE = false; const bf16_t* A; int lda; const unsigned* ent; int valid; int shift;
    DI unsigned row(int i) const { const unsigned e = ent[i < valid ? i : valid - 1]; return (e >> shift) * (unsigned)lda; } };

struct EpiStore { bf16_t* C; int ldc; int m0;
    DI void wave_tile(const f32x16 (&acc)[2][GEMM_MT], int mloc, int ncol, int lane) const {
        const int r = lane & 31, h = lane >> 5;
#pragma unroll
        for (int mt = 0; mt < GEMM_MT; ++mt) {
            bf16_t* c = C + (size_t)(m0 + mloc + mt * 32 + r) * ldc + ncol + 4 * h;
#pragma unroll
            for (int nt = 0; nt < 2; ++nt)
#pragma unroll
                for (int g = 0; g < 4; ++g) {
                    u32x2 w; w.x = pk2(acc[nt][mt][4 * g], acc[nt][mt][4 * g + 1]); w.y = pk2(acc[nt][mt][4 * g + 2], acc[nt][mt][4 * g + 3]);
                    *(u32x2*)(c + nt * 32 + 8 * g) = w;
                }
        }
    } };
struct EpiResid { const Params* p; const float* mod; int m0;
    DI void wave_tile(const f32x16 (&acc)[2][GEMM_MT], int mloc, int ncol, int lane) const {
        const int r = lane & 31, h = lane >> 5;
#pragma unroll
        for (int mt = 0; mt < GEMM_MT; ++mt) {
            const int row = m0 + mloc + mt * 32 + r;
            float* xr = xrow_ptr(*p, row) + ncol + 4 * h;
            const float* gp = mod + (size_t)mod_row(row) * 6144 + 2048 + ncol + 4 * h;
#pragma unroll
            for (int nt = 0; nt < 2; ++nt)
#pragma unroll
                for (int g = 0; g < 4; ++g) {
                    f32x4 x = *(f32x4*)(xr + nt * 32 + 8 * g);
                    const f32x4 gg = *(const f32x4*)(gp + nt * 32 + 8 * g);
                    x.x += gg.x * acc[nt][mt][4 * g]; x.y += gg.y * acc[nt][mt][4 * g + 1]; x.z += gg.z * acc[nt][mt][4 * g + 2]; x.w += gg.w * acc[nt][mt][4 * g + 3];
                    *(f32x4*)(xr + nt * 32 + 8 * g) = x;
                }
        }
    } };
struct EpiGlu { bf16_t* act; const unsigned* ent; const float* gates; int valid;
    DI void wave_tile(const f32x16 (&acc)[2][GEMM_MT], int mloc, int ncol, int lane) const {
        const int r = lane & 31, h = lane >> 5;
#pragma unroll
        for (int mt = 0; mt < GEMM_MT; ++mt) {
            const int i = mloc + mt * 32 + r;
            if (i < valid) {
                const unsigned a = ent[i];
                const float gw = gates[a];
                bf16_t* o = act + (size_t)a * DEXP + (ncol >> 6) * 32 + 4 * h;
#pragma unroll
                for (int g = 0; g < 4; ++g) {
                    float v[4];
#pragma unroll
                    for (int j = 0; j < 4; ++j) v[j] = silu_f(acc[0][mt][4 * g + j]) * acc[1][mt][4 * g + j] * gw;
                    u32x2 w; w.x = pk2(v[0], v[1]); w.y = pk2(v[2], v[3]);
                    *(u32x2*)(o + 8 * g) = w;
                }
            }
        }
    } };
struct EpiScatter { bf16_t* outp; const unsigned* ent; int valid;
    DI void wave_tile(const f32x16 (&acc)[2][GEMM_MT], int mloc, int ncol, int lane) const {
        const int r = lane & 31, h = lane >> 5;
#pragma unroll
        for (int mt = 0; mt < GEMM_MT; ++mt) {
            const int i = mloc + mt * 32 + r;
            if (i < valid) {
                bf16_t* c = outp + (size_t)ent[i] * 1024 + ncol + 4 * h;
#pragma unroll
                for (int nt = 0; nt < 2; ++nt)
#pragma unroll
                    for (int g = 0; g < 4; ++g) {
                        u32x2 w; w.x = pk2(acc[nt][mt][4 * g], acc[nt][mt][4 * g + 1]); w.y = pk2(acc[nt][mt][4 * g + 2], acc[nt][mt][4 * g + 3]);
                        *(u32x2*)(c + nt * 32 + 8 * g) = w;
                    }
            }
        }
    } };

#define SCHED_FENCE() __builtin_amdgcn_sched_barrier(0)
DI void glds16(const bf16_t* g, lds_ptr l) { __builtin_amdgcn_global_load_lds((const unsigned*)g, (LAS unsigned*)l, 16, 0, 0); }
template <int PROBE, int NAG>
DI void gemm_kstep(f32x16 (&acc)[2][GEMM_MT], const lds_ptr st, const unsigned (&arow)[GEMM_MT], const unsigned (&wrow)[2], const unsigned (&aswz)[GEMM_MT], const unsigned (&wswz)[2], int h,
                   bool issue, const bf16_t* __restrict__ An, const bf16_t* __restrict__ Wn, const unsigned (&ag)[NAG], unsigned astep, const unsigned (&bg)[2], unsigned bstep, const lds_ptr sn) {
    if (PROBE != 2 && issue) {
#pragma unroll
        for (int j = 0; j < 8; ++j) { glds16(An + (NAG == 2 ? ag[j & 1] + (j >> 1) * astep : ag[j % NAG]), sn + j * 1024); glds16(Wn + bg[j & 1] + (j >> 1) * bstep, sn + 32768 + j * 1024); }
    }
    if (PROBE == 1) return;
    bf16x8 af[2][GEMM_MT], wf[2][2];
#pragma unroll
    for (int t = 0; t < 2; ++t) wf[0][t] = *(const LAS bf16x8*)(st + wrow[t] + ((((unsigned)h) ^ wswz[t]) << 4));
#pragma unroll
    for (int t = 0; t < GEMM_MT; ++t) af[0][t] = *(const LAS bf16x8*)(st + arow[t] + ((((unsigned)h) ^ aswz[t]) << 4));
#pragma unroll
    for (int kk = 0; kk < 4; ++kk) {
        if (kk < 3) {
#pragma unroll
            for (int t = 0; t < 2; ++t) wf[(kk + 1) & 1][t] = *(const LAS bf16x8*)(st + wrow[t] + ((((unsigned)((kk + 1) * 2 + h)) ^ wswz[t]) << 4));
#pragma unroll
            for (int t = 0; t < GEMM_MT; ++t) af[(kk + 1) & 1][t] = *(const LAS bf16x8*)(st + arow[t] + ((((unsigned)((kk + 1) * 2 + h)) ^ aswz[t]) << 4));
        }
        SCHED_FENCE();
        __builtin_amdgcn_s_setprio(1);
#pragma unroll
        for (int mt = 0; mt < GEMM_MT; ++mt)
#pragma unroll
            for (int nt = 0; nt < 2; ++nt) acc[nt][mt] = MFMA32(wf[kk & 1][nt], af[kk & 1][mt], acc[nt][mt]);
        __builtin_amdgcn_s_setprio(0);
        SCHED_FENCE();
    }
}
template <class RowSrc, class Epi, int PROBE = 0>
DI void gemm_tile_mfma(unsigned char* smem, const RowSrc& rs, const bf16_t* __restrict__ Wt, int K, int n0, const Epi& epi, int tid) {
    const lds_ptr lds = (lds_ptr)smem;
    const int lane = tid & 63, wid = __builtin_amdgcn_readfirstlane(tid >> 6), wm = wid & 1, wn = wid >> 1, r = lane & 31, h = lane >> 5;
    const bool loader = wid < 4;
    const int lw = wid & 3;
    constexpr int NAG = RowSrc::DENSE ? 2 : 8;
    unsigned ag[NAG], bg[2];
    const bf16_t* __restrict__ Ab = rs.A;
#pragma unroll
    for (int j = 0; j < NAG; ++j) {
        const int row = (lw * 8 + j) * 8 + (lane >> 3), c = (lane & 7) ^ ((row >> 1) & 7);
        ag[j] = rs.row(row) + c * 8;
    }
#pragma unroll
    for (int j = 0; j < 2; ++j) {
        const int row = (lw * 8 + j) * 8 + (lane >> 3), c = (lane & 7) ^ ((row >> 1) & 7);
        bg[j] = (unsigned)(n0 + row) * (unsigned)K + c * 8;
    }
    const unsigned astep = 16u * (unsigned)rs.lda, bstep = 16u * (unsigned)K;
    const unsigned dmaoff = (unsigned)lw * 8192u;
    unsigned arow[GEMM_MT], wrow[2], aswz[GEMM_MT], wswz[2];
#pragma unroll
    for (int t = 0; t < GEMM_MT; ++t) { const int ra = wm * 128 + t * 32 + r; arow[t] = ra * 128; aswz[t] = (ra >> 1) & 7; }
#pragma unroll
    for (int t = 0; t < 2; ++t) { const int rw = wn * 64 + t * 32 + r; wrow[t] = 32768 + rw * 128; wswz[t] = (rw >> 1) & 7; }
    f32x16 acc[2][GEMM_MT];
#pragma unroll
    for (int a = 0; a < 2; ++a)
#pragma unroll
        for (int b = 0; b < GEMM_MT; ++b)
#pragma unroll
            for (int i = 0; i < 16; ++i) acc[a][b][i] = 0.f;
    if (loader) {
#pragma unroll
        for (int j = 0; j < 8; ++j) { glds16(Ab + (NAG == 2 ? ag[j & 1] + (j >> 1) * astep : ag[j % NAG]), lds + dmaoff + j * 1024); glds16(Wt + bg[j & 1] + (j >> 1) * bstep, lds + 32768 + dmaoff + j * 1024); }
    }
    asm volatile("s_waitcnt vmcnt(0)" ::: "memory");
    __syncthreads();
    const int KT = K >> 6;
    for (int kt = 0; kt < KT; ++kt) {
        gemm_kstep<PROBE, NAG>(acc, lds + (kt & 1) * GEMM_STAGE, arow, wrow, aswz, wswz, h, loader && kt + 1 < KT, Ab + (kt + 1) * 64, Wt + (kt + 1) * 64, ag, astep, bg, bstep, lds + ((kt + 1) & 1) * GEMM_STAGE + dmaoff);
        asm volatile("s_waitcnt vmcnt(0)" ::: "memory");
        __syncthreads();
    }
    if (PROBE == 0 || acc[0][0][0] == 12345.678f) epi.wave_tile(acc, wm * 128, n0 + wn * 64, lane);
}

template <int EPIK, int PROBE = 0>
DI void gemm_dense(const Params& p, unsigned char* smem, const bf16_t* A, int lda, const bf16_t* Wt, int K, int N, bf16_t* C, int ldc, const float* mod, int bid, int nb, int tid) {
    const int tn = N / GEMM_TN, total = (MROWS / GEMM_TM) * tn;
    for (int t = bid; t < total; t += nb) {
        const int mt = t / tn, nt = t - mt * tn;
        RowDense rs{A, lda, mt * GEMM_TM};
        if (EPIK == 0) { EpiStore e{C, ldc, mt * GEMM_TM}; gemm_tile_mfma<RowDense, EpiStore, PROBE>(smem, rs, Wt, K, nt * GEMM_TN, e, tid); }
        else { EpiResid e{&p, mod, mt * GEMM_TM}; gemm_tile_mfma(smem, rs, Wt, K, nt * GEMM_TN, e, tid); }
    }
}
template <int WHICH>
DI void gemm_moe(const Params& p, unsigned char* smem, int layer, int bid, int nb, int tid) {
    const unsigned* cnt = (const unsigned*)(p.ws + WS_CTL) + CW_CNT + layer * 32;
    const unsigned* list = (const unsigned*)(p.ws + WS_LIST);
    const float* gates = (const float*)(p.ws + WS_GATE);
    const bf16_t* H = (const bf16_t*)(p.ws + WS_H);
    bf16_t* act = (bf16_t*)(p.ws + WS_Q);
    bf16_t* eo = (bf16_t*)(p.ws + WS_RAW);
    constexpr int TN = WHICH == 0 ? 2 : 4;
    int total = 0;
    for (int e = 0; e < NEXP; ++e) total += (int)((cnt[e] + 255u) >> 8) * TN;
    for (int t = bid; t < total; t += nb) {
        int e = 0, rem = t;
        for (; e < NEXP; ++e) { const int te = (int)((cnt[e] + 255u) >> 8) * TN; if (rem < te) break; rem -= te; }
        const int rt = rem / TN, ct = rem - rt * TN;
        const unsigned* ent = list + (size_t)e * MROWS + rt * GEMM_TM;
        const int valid = min(GEMM_TM, (int)cnt[e] - rt * GEMM_TM);
        if (WHICH == 0) {
            RowGather rs{H, 1024, ent, valid, 1};
            EpiGlu ep{act, ent, gates, valid};
            gemm_tile_mfma(smem, rs, (const bf16_t*)(p.ws + W_GU) + ((size_t)layer * 32 + e) * 512 * 1024, 1024, ct * GEMM_TN, ep, tid);
        } else {
            RowGather rs{act, DEXP, ent, valid, 0};
            EpiScatter ep{eo, ent, valid};
            gemm_tile_mfma(smem, rs, (const bf16_t*)(p.ws + W_DN) + ((size_t)layer * 32 + e) * 1024 * 256, 256, ct * GEMM_TN, ep, tid);
        }
    }
}

DI float quad_sum(float v) { v += __shfl_xor(v, 1); v += __shfl_xor(v, 2); return v; }
DI void head64_norm_rope(const bf16_t* src, bf16_t* dst, const float* gain, int sub, bool rope, int prow, int pcol, float scale) {
    float a[8], b[8];
    unpack8(*(const u32x4*)(src + sub * 8), a); unpack8(*(const u32x4*)(src + 32 + sub * 8), b);
    float ss = 0.f;
#pragma unroll
    for (int e = 0; e < 8; ++e) ss += a[e] * a[e] + b[e] * b[e];
    ss = quad_sum(ss);
    const float rs = rsqrtf(ss * (1.0f / 64.0f) + EPS);
#pragma unroll
    for (int e = 0; e < 8; ++e) { a[e] *= rs * gain[sub * 8 + e]; b[e] *= rs * gain[32 + sub * 8 + e]; }
    if (rope) {
#pragma unroll
        for (int e = 0; e < 8; ++e) {
            const int i = sub * 8 + e;
            const float* cs = ROPE64 + ((i < 16 ? prow : pcol) * 16 + (i & 15)) * 2;
            const float c = cs[0], s = cs[1], x1 = a[e], x2 = b[e];
            a[e] = x1 * c - x2 * s; b[e] = x2 * c + x1 * s;
        }
    }
#pragma unroll
    for (int e = 0; e < 8; ++e) { a[e] *= scale; b[e] *= scale; }
    *(u32x4*)(dst + sub * 8) = pack8(a); *(u32x4*)(dst + 32 + sub * 8) = pack8(b);
}
template <int KIND>
DI void phase_post_qk(const Params& p, int bid, int nb, int tid) {
    const int wid = __builtin_amdgcn_readfirstlane(tid >> 6), lane = tid & 63, hd = lane >> 2, sub = lane & 3;
    constexpr int NRAW = KIND == 1 ? 1536 : 3072, KH = KIND == 1 ? 4 : 16;
    const bf16_t* raw = (const bf16_t*)(p.ws + WS_RAW);
    bf16_t* Q = (bf16_t*)(p.ws + WS_Q); bf16_t* Kb = (bf16_t*)(p.ws + WS_K);
    const float* qn = p.in[KIND == 0 ? 15 : KIND == 1 ? 20 : 32];
    const float* kn = p.in[KIND == 0 ? 16 : KIND == 1 ? 21 : 33];
    const float qscale = 0.125f * LOG2E;
    for (int r = bid * NW + wid; r < MROWS; r += nb * NW) {
        const int b = r / PP, pos = r - b * PP;
        const bool rope = (KIND != 0) && pos < SEQ;
        const int prow = (pos >> 6) & 63, pcol = pos & 63;
        const bf16_t* rr = raw + (size_t)r * NRAW;
        head64_norm_rope(rr + hd * 64, Q + (size_t)r * 1024 + hd * 64, qn, sub, rope, prow, pcol, qscale);
        if (hd < KH) head64_norm_rope(rr + 1024 + hd * 64, Kb + (size_t)r * (KH * 64) + hd * 64, kn, sub, rope, prow, pcol, 1.0f);
    }
}
DI void phase_post_mla1(const Params& p, int bid, int nb, int tid) {
    const int wid = __builtin_amdgcn_readfirstlane(tid >> 6), lane = tid & 63;
    const bf16_t* raw = (const bf16_t*)(p.ws + WS_Q);
    bf16_t* cqn = (bf16_t*)(p.ws + WS_O);
    bf16_t* ckvn = cqn + (size_t)MROWS * 384;
    bf16_t* krope = ckvn + (size_t)MROWS * 256;
    const float* qa = p.in[24]; const float* kva = p.in[25]; const float* kn = p.in[29];
    for (int r = bid * NW + wid; r < MROWS; r += nb * NW) {
        const int b = r / PP, pos = r - b * PP;
        const bf16_t* rr = raw + (size_t)r * 768;
        {
            float v[6];
#pragma unroll
            for (int j = 0; j < 3; ++j) { const unsigned w = *(const unsigned*)(rr + lane * 6 + 2 * j); v[2 * j] = bflo(w); v[2 * j + 1] = bfhi(w); }
            float ss = 0.f;
#pragma unroll
            for (int j = 0; j < 6; ++j) ss += v[j] * v[j];
            ss = wave_sum(ss);
            const float rs = rsqrtf(ss * (1.0f / 384.0f) + EPS);
#pragma unroll
            for (int j = 0; j < 3; ++j) *(unsigned*)(cqn + (size_t)r * 384 + lane * 6 + 2 * j) = pk2(v[2 * j] * rs * qa[lane * 6 + 2 * j], v[2 * j + 1] * rs * qa[lane * 6 + 2 * j + 1]);
        }
        {
            const u32x2 w = *(const u32x2*)(rr + 384 + lane * 4);
            float v[4] = {bflo(w.x), bfhi(w.x), bflo(w.y), bfhi(w.y)};
            float ss = v[0] * v[0] + v[1] * v[1] + v[2] * v[2] + v[3] * v[3];
            ss = wave_sum(ss);
            const float rs = rsqrtf(ss * (1.0f / 256.0f) + EPS);
            u32x2 o; o.x = pk2(v[0] * rs * kva[lane * 4], v[1] * rs * kva[lane * 4 + 1]); o.y = pk2(v[2] * rs * kva[lane * 4 + 2], v[3] * rs * kva[lane * 4 + 3]);
            *(u32x2*)(ckvn + (size_t)r * 256 + lane * 4) = o;
        }
        {
            float x1 = 0.f, x2 = 0.f;
            if (lane < 16) { x1 = bf2f(rr[640 + lane]); x2 = bf2f(rr[640 + 16 + lane]); }
            float ss = wave_sum(x1 * x1 + x2 * x2);
            const float rs = rsqrtf(ss * (1.0f / 32.0f) + EPS);
            if (lane < 16) {
                x1 *= rs * kn[64 + lane]; x2 *= rs * kn[64 + 16 + lane];
                if (pos < SEQ) {
                    const int prow = (pos >> 6) & 63, pcol = pos & 63;
                    const float* cs = ROPE32 + ((lane < 8 ? prow : pcol) * 8 + (lane & 7)) * 2;
                    const float c = cs[0], s = cs[1], a = x1, bb = x2;
                    x1 = a * c - bb * s; x2 = bb * c + a * s;
                }
            }
            {
                const int hh = lane >> 2, q = lane & 3;
                float vals[8];
#pragma unroll
                for (int j = 0; j < 8; ++j) { const int src = (8 * q + j) & 15; const float a = __shfl(x1, src), bb = __shfl(x2, src); vals[j] = q < 2 ? a : bb; }
                bf16_t* kr = (bf16_t*)(p.ws + WS_K) + (size_t)r * 1536 + 64;
                *(u32x4*)(kr + hh * 96 + 8 * q) = pack8(vals);
            }
        }
    }
}
DI void phase_post_mla2(const Params& p, int bid, int nb, int tid) {
    const int wid = __builtin_amdgcn_readfirstlane(tid >> 6), lane = tid & 63, hd = lane >> 2, sub = lane & 3;
    const bf16_t* qraw = (const bf16_t*)(p.ws + WS_RAW);
    const bf16_t* kvraw = qraw + (size_t)MROWS * 1536;
    const bf16_t* krope = (const bf16_t*)(p.ws + WS_O) + (size_t)MROWS * 640;
    bf16_t* Q = (bf16_t*)(p.ws + WS_Q); bf16_t* Kb = (bf16_t*)(p.ws + WS_K);
    const float* qn = p.in[28]; const float* kn = p.in[29];
    const float qscale = 0.10206207261596577f * LOG2E;
    for (int r = bid * NW + wid; r < MROWS; r += nb * NW) {
        const int b = r / PP, pos = r - b * PP;
        const bf16_t* qr = qraw + (size_t)r * 1536 + hd * 96;
        bf16_t* qo = Q + (size_t)r * 1536 + hd * 96;
        {
            float a[8], c[8];
            unpack8(*(const u32x4*)(qr + sub * 16), a); unpack8(*(const u32x4*)(qr + sub * 16 + 8), c);
            float ss = 0.f;
#pragma unroll
            for (int e = 0; e < 8; ++e) ss += a[e] * a[e] + c[e] * c[e];
            ss = quad_sum(ss);
            const float rs = rsqrtf(ss * (1.0f / 64.0f) + EPS) * qscale;
#pragma unroll
            for (int e = 0; e < 8; ++e) { a[e] *= rs * qn[sub * 16 + e]; c[e] *= rs * qn[sub * 16 + 8 + e]; }
            *(u32x4*)(qo + sub * 16) = pack8(a); *(u32x4*)(qo + sub * 16 + 8) = pack8(c);
        }
        {
            const u32x2 w1 = *(const u32x2*)(qr + 64 + sub * 4), w2 = *(const u32x2*)(qr + 64 + 16 + sub * 4);
            float x1[4] = {bflo(w1.x), bfhi(w1.x), bflo(w1.y), bfhi(w1.y)}, x2[4] = {bflo(w2.x), bfhi(w2.x), bflo(w2.y), bfhi(w2.y)};
            float ss = 0.f;
#pragma unroll
            for (int e = 0; e < 4; ++e) ss += x1[e] * x1[e] + x2[e] * x2[e];
            ss = quad_sum(ss);
            const float rs = rsqrtf(ss * (1.0f / 32.0f) + EPS);
#pragma unroll
            for (int e = 0; e < 4; ++e) {
                const int i = sub * 4 + e;
                float a = x1[e] * rs * qn[64 + i], bb = x2[e] * rs * qn[64 + 16 + i];
                if (pos < SEQ) {
                    const int prow = (pos >> 6) & 63, pcol = pos & 63;
                    const float* cs = ROPE32 + ((i < 8 ? prow : pcol) * 8 + (i & 7)) * 2;
                    const float c = cs[0], s = cs[1], t1 = a, t2 = bb;
                    a = t1 * c - t2 * s; bb = t2 * c + t1 * s;
                }
                x1[e] = a * qscale; x2[e] = bb * qscale;
            }
            u32x2 o1, o2; o1.x = pk2(x1[0], x1[1]); o1.y = pk2(x1[2], x1[3]); o2.x = pk2(x2[0], x2[1]); o2.y = pk2(x2[2], x2[3]);
            *(u32x2*)(qo + 64 + sub * 4) = o1; *(u32x2*)(qo + 64 + 16 + sub * 4) = o2;
        }
        {
            const bf16_t* kr = kvraw + (size_t)r * 2048 + hd * 128;
            bf16_t* ko = Kb + (size_t)r * 1536 + hd * 96;
            float a[8], c[8];
            unpack8(*(const u32x4*)(kr + sub * 16), a); unpack8(*(const u32x4*)(kr + sub * 16 + 8), c);
            float ss = 0.f;
#pragma unroll
            for (int e = 0; e < 8; ++e) ss += a[e] * a[e] + c[e] * c[e];
            ss = quad_sum(ss);
            const float rs = rsqrtf(ss * (1.0f / 64.0f) + EPS);
#pragma unroll
            for (int e = 0; e < 8; ++e) { a[e] *= rs * kn[sub * 16 + e]; c[e] *= rs * kn[sub * 16 + 8 + e]; }
            *(u32x4*)(ko + sub * 16) = pack8(a); *(u32x4*)(ko + sub * 16 + 8) = pack8(c);
            *(u32x4*)(ko + 64 + sub * 8) = *(const u32x4*)(krope + (size_t)r * 32 + sub * 8);
        }
    }
}
DI void phase_diff_combine(const Params& p, int bid, int nb, int tid) {
    const int wid = __builtin_amdgcn_readfirstlane(tid >> 6), lane = tid & 63, hd = lane >> 3, sub = lane & 7;
    const bf16_t* O12 = (const bf16_t*)(p.ws + WS_H);
    bf16_t* Oc = (bf16_t*)(p.ws + WS_Q);
    const float* lam = p.in[34]; const float* subln = p.in[35];
    const float lambda_init = 0.8f - 0.6f * 0.40656965974059917f;
    const float s1 = wave_sum(lam[lane] * lam[64 + lane]), s2 = wave_sum(lam[128 + lane] * lam[192 + lane]);
    const float lam_full = expf(s1) - expf(s2) + lambda_init;
    for (int r = bid * NW + wid; r < MROWS; r += nb * NW) {
        const bf16_t* o1 = O12 + (size_t)r * 2048 + (2 * hd) * 128 + sub * 16, *o2 = o1 + 128;
        float a[16], c[16];
        unpack8(*(const u32x4*)o1, *(float(*)[8])a); unpack8(*(const u32x4*)(o1 + 8), *(float(*)[8])(a + 8));
        unpack8(*(const u32x4*)o2, *(float(*)[8])c); unpack8(*(const u32x4*)(o2 + 8), *(float(*)[8])(c + 8));
        float ss = 0.f;
#pragma unroll
        for (int e = 0; e < 16; ++e) { a[e] -= lam_full * c[e]; ss += a[e] * a[e]; }
        ss += __shfl_xor(ss, 1); ss += __shfl_xor(ss, 2); ss += __shfl_xor(ss, 4);
        const float rs = rsqrtf(ss * (1.0f / 128.0f) + EPS) * (1.0f - lambda_init);
#pragma unroll
        for (int e = 0; e < 16; ++e) a[e] *= rs * subln[sub * 16 + e];
        bf16_t* o = Oc + (size_t)r * 1024 + hd * 128 + sub * 16;
        *(u32x4*)o = pack8(*(float(*)[8])a); *(u32x4*)(o + 8) = pack8(*(float(*)[8])(a + 8));
    }
}


typedef short s16x4 __attribute__((ext_vector_type(4)));
typedef float f32x2_t __attribute__((ext_vector_type(2)));
typedef __bf16 bf16x2_t __attribute__((ext_vector_type(2)));
DI unsigned cvtpk(float lo, float hi) { f32x2_t v = {lo, hi}; bf16x2_t b = __builtin_convertvector(v, bf16x2_t); return __builtin_bit_cast(unsigned, b); }
DI float xhalf_max(float v) { auto rr = __builtin_amdgcn_permlane32_swap(__float_as_uint(v), __float_as_uint(v), false, false); return fmaxf(__uint_as_float(rr[0]), __uint_as_float(rr[1])); }
DI float xhalf_sum(float v) { auto rr = __builtin_amdgcn_permlane32_swap(__float_as_uint(v), __float_as_uint(v), false, false); return __uint_as_float(rr[0]) + __uint_as_float(rr[1]); }
typedef short v4i16_t __attribute__((__vector_size__(4 * sizeof(short))));
DI s16x4 lds_tr(lds_ptr p) { return __builtin_bit_cast(s16x4, __builtin_amdgcn_ds_read_tr16_b64_v4i16((LAS v4i16_t*)p)); }
constexpr float ATT_BIG = 40.0f, ATT_BIGF = 1.0995116e12f;
DI int crow(int i, int hf) { return (i & 3) + 8 * (i >> 2) + 4 * hf; }

struct AttnP { const bf16_t* Q; int ldq; const bf16_t* K; int ldk; const bf16_t* V; int ldv; bf16_t* O; int ldo; int HQ; int gk; int gv; int vhs  ; const float* bias; const float* sink; int need_ctx; const float* kgain  ; const float* lam; const float* subln; unsigned char* Oc; int ldoc;   };

template <int DQ, int DV, int MODE, int ABL = 0>
DI void attn_mfma(const AttnP& a, unsigned char* smem, int bid, int nb, int tid) {
    constexpr int KSTR = DQ * 2 + 16, KTB = 64 * KSTR, VTB = 64 * DV * 2, NDB = DV / 32, NKK = DQ / 16;
    constexpr int KCH = DQ / 8, VCH = DV / 8, NKI = (64 * KCH + NTHREADS - 1) / NTHREADS, NVI = (64 * VCH + NTHREADS - 1) / NTHREADS;
    static_assert(2 * KTB + 2 * VTB + 2048 <= GEMM_LDS, "attention LDS");
    const lds_ptr lds = (lds_ptr)smem;
    LAS float* biasl = (LAS float*)(lds + 2 * KTB + 2 * VTB);
    const int lane = tid & 63, wid = __builtin_amdgcn_readfirstlane(tid >> 6), r = lane & 31, hf = lane >> 5;
    const int nq = a.need_ctx ? 17 : 16;
    const int xcd = bid & 7, slot = bid >> 3, nslots = nb >> 3, per_xcd = (NBATCH * a.HQ / 8) * nq;
    int koff[NKI], kdst[NKI], voff[NVI], vdst[NVI];
#pragma unroll
    for (int i = 0; i < NKI; ++i) { const int c = min(tid + NTHREADS * i, 64 * KCH - 1), row = c / KCH, kc = c - row * KCH; koff[i] = row * a.ldk + kc * 8; kdst[i] = row * KSTR + kc * 16; }
#pragma unroll
    for (int i = 0; i < NVI; ++i) { const int c = tid + NTHREADS * i, row = c / VCH, vc = c - row * VCH; voff[i] = row * a.ldv + vc * 8; vdst[i] = ((row >> 3) * NDB + (vc >> 2)) * 512 + (row & 7) * 64 + (vc & 3) * 16; }
    const int i16 = lane & 15, trq = i16 >> 2, trp = i16 & 3, grp = (lane >> 4) & 1;
    const int vtr0 = (4 * hf + trq) * 64 + 32 * grp + 8 * trp;
    constexpr bool PAIRED = (MODE == 2 && DV == 128);
    float lam_full = 0.f;
    if (PAIRED) { const float s1 = wave_sum(a.lam[lane] * a.lam[64 + lane]), s2 = wave_sum(a.lam[128 + lane] * a.lam[192 + lane]); lam_full = expf(s1) - expf(s2) + (0.8f - 0.6f * 0.40656965974059917f); }
    int it_i = 0;
    for (int j = slot; j < per_xcd; j += nslots, ++it_i) {
        const int nbh = NBATCH * a.HQ / 8;
        const int bhl = j < nbh * 16 ? j >> 4 : j - nbh * 16;
        int qt = j < nbh * 16 ? j & 15 : 16;
        int bh = bhl * 8 + xcd;
        if (MODE == 1) { const int P = (bhl >> 2) * 8 + xcd; bh = (P >> 2) * a.HQ + (P & 3) * 4 + (bhl & 3); }
        if (PAIRED) { const int pu = slot + nslots * (it_i >> 1); qt = pu & 15; bh = (pu >> 4) * a.HQ + 2 * xcd + (it_i & 1); }
        const int h = bh % a.HQ, b = bh / a.HQ;
        const bool is_ctx = qt >= 16;
        const int q0 = is_ctx ? SEQ : qt * 256;
        int t_lo = 0, n_lat = 0;
        if (!is_ctx) {
            if (MODE == 2) { t_lo = 0; n_lat = 64; }
            else if (MODE == 1) { t_lo = max(0, 4 * qt - 2); n_lat = min(63, 4 * qt + 5) - t_lo + 1; }
            else { const int r0 = 4 * qt; t_lo = min(max(r0 - 4, 0), 56); n_lat = min(max(r0 - 1, 0), 56) + 7 - t_lo + 1; }
        }
        const int ntiles = n_lat + 4;
        const int qw0 = q0 + wid * 32, qpos = qw0 + r;
        const size_t qrow = (size_t)b * PP + qpos;
        bf16x8 qf[NKK];
#pragma unroll
        for (int kk = 0; kk < NKK; ++kk) qf[kk] = *(const bf16x8*)(a.Q + qrow * a.ldq + h * DQ + kk * 16 + hf * 8);
        if (MODE == 0 && !is_ctx) { for (int i = tid; i < 465; i += NTHREADS) biasl[i] = a.bias[h * 465 + i] * LOG2E; }
        const bf16_t* Kg = a.K + (size_t)b * PP * a.ldk + (h >> a.gk) * DQ;
        const bf16_t* Vg = a.V + (size_t)b * PP * a.ldv + (h >> a.gv) * a.vhs;
        f32x16 o[NDB];
#pragma unroll
        for (int d = 0; d < NDB; ++d)
#pragma unroll
            for (int i = 0; i < 16; ++i) o[d][i] = 0.f;
        float mref = 0.f, l = 0.f;
        f32x16 negm;
#pragma unroll
        for (int i = 0; i < 16; ++i) negm[i] = 0.f;
        bool first = true;
        float lbig = 0.f;
        float one = 1.0f; asm volatile("" : "+v"(one));
#define ATT_TILE(IT) ((IT) < n_lat ? t_lo + (IT) : 64 + ((IT) - n_lat))
        auto tile_active = [&](int t) -> bool {
            if (t >= 64) return true;
            if (MODE == 1) return (t * 64 + 63 >= qw0 - 128) && (t * 64 <= qw0 + 31 + 128);
            if (MODE == 0) { const int rw = qw0 >> 6, row0 = min(max(rw - 4, 0), 56); return t >= row0 && t < row0 + 8; }
            return true;
        };
        auto qk = [&](f32x16 (&s)[2], const lds_ptr Kb) {
#pragma unroll
            for (int kk = 0; kk < NKK; ++kk)
#pragma unroll
                for (int kb = 0; kb < 2; ++kb) {
                    if (ABL & 4) { if (kk == 0) s[kb] = negm; }
                    else {
                    const bf16x8 kf = *(const LAS bf16x8*)(Kb + (kb * 32 + r) * KSTR + (kk * 2 + hf) * 16);
                    s[kb] = MFMA32(kf, qf[kk], kk == 0 ? negm : s[kb]);
                    }
                }
        };
        u32x4 kr[NKI], vr[NVI];
        {
            const int t0 = ATT_TILE(0), t1 = ATT_TILE(1);
            u32x4 k1[NKI];
#pragma unroll
            for (int i = 0; i < NKI; ++i) kr[i] = *(const u32x4*)(Kg + (size_t)t0 * 64 * a.ldk + koff[i]);
#pragma unroll
            for (int i = 0; i < NVI; ++i) vr[i] = *(const u32x4*)(Vg + (size_t)t0 * 64 * a.ldv + voff[i]);
#pragma unroll
            for (int i = 0; i < NKI; ++i) k1[i] = *(const u32x4*)(Kg + (size_t)t1 * 64 * a.ldk + koff[i]);
#pragma unroll
            for (int i = 0; i < NKI; ++i) { *(LAS u32x4*)(lds + kdst[i]) = kr[i]; *(LAS u32x4*)(lds + KTB + kdst[i]) = k1[i]; }
#pragma unroll
            for (int i = 0; i < NVI; ++i) *(LAS u32x4*)(lds + 2 * KTB + vdst[i]) = vr[i];
        }
        __syncthreads();
        f32x16 sc[2], sn[2];
        bool act_cur = tile_active(ATT_TILE(0)), act_nxt = false;
        if (act_cur) qk(sc, lds);
        __syncthreads();
        auto step = [&](const int it, const int e, const bool N2, const bool N1) {
            const int t = ATT_TILE(it);
            if (N2 && !(ABL & 8) && (!(ABL & 128) || e)) {
                const int tn = ATT_TILE(it + 2);
#pragma unroll
                for (int i = 0; i < NKI; ++i) kr[i] = *(const u32x4*)(Kg + (size_t)tn * 64 * a.ldk + koff[i]);
            }
            if (N1 && !(ABL & 8) && (!(ABL & 128) || e)) {
                const int tn = ATT_TILE(it + 1);
#pragma unroll
                for (int i = 0; i < NVI; ++i) vr[i] = *(const u32x4*)(Vg + (size_t)tn * 64 * a.ldv + voff[i]);
            }
            SCHED_FENCE();
            act_nxt = N1 && (MODE == 2 || tile_active(ATT_TILE(it + 1)));
            const lds_ptr Vb = lds + 2 * KTB + e * VTB;
            const bool do_cur = MODE == 2 || act_cur;
            if (do_cur) {
                if (t < 64 && MODE == 1 && !((t * 64 + 63 - qw0 <= 128) && (qw0 + 31 - t * 64 <= 128))) {
                    const int dbase = t * 64 + 4 * hf - qpos;
#pragma unroll
                    for (int kb = 0; kb < 2; ++kb)
#pragma unroll
                        for (int i = 0; i < 16; ++i) { const int c = kb * 32 + (i & 3) + 8 * (i >> 2); sc[kb][i] = (dbase > 128 - c || dbase < -128 - c) ? -INFINITY : sc[kb][i]; }
                }
                if (t < 64 && MODE == 0) {
                    const int qc = qpos & 63, rw = qpos >> 6, col0 = min(max(qc - 8, 0), 48);
                    const int brow = (t - rw + 7) * 31 + 15 - qc;
#pragma unroll
                    for (int kb = 0; kb < 2; ++kb)
#pragma unroll
                        for (int i = 0; i < 16; ++i) {
                            const int kc = kb * 32 + crow(i, hf);
                            const bool ok = kc >= col0 && kc < col0 + 16;
                            const float bv = biasl[ok ? brow + kc : 0];
                            sc[kb][i] = ok ? sc[kb][i] + bv : -INFINITY;
                        }
                }
                if (first || __builtin_amdgcn_ballot_w64(lbig > ATT_BIGF) != 0ull) {
                    float delta = lbig > ATT_BIGF ? ATT_BIG : 0.f;
                    if (first) {
                        float mx = sc[0][0];
#pragma unroll
                        for (int i = 1; i < 16; ++i) mx = fmaxf(mx, sc[0][i]);
#pragma unroll
                        for (int i = 0; i < 16; ++i) mx = fmaxf(mx, sc[1][i]);
                        mx = xhalf_max(mx);
                        delta = mx > -INFINITY ? mx : 0.f;
                    }
                    const float alpha = __builtin_amdgcn_exp2f(-delta);
                    l *= alpha; mref += delta;
#pragma unroll
                    for (int d = 0; d < NDB; ++d)
#pragma unroll
                        for (int i = 0; i < 16; ++i) o[d][i] *= alpha;
#pragma unroll
                    for (int kb = 0; kb < 2; ++kb)
#pragma unroll
                        for (int i = 0; i < 16; ++i) sc[kb][i] -= delta;
#pragma unroll
                    for (int i = 0; i < 16; ++i) negm[i] = -mref;
                    first = false;
                }
            }
            if (N1) qk(sn, lds + (e ^ 1) * KTB);
            if (do_cur) {
                float ls0 = 0.f, ls1 = 0.f;
#pragma unroll
                for (int kb = 0; kb < 2; ++kb)
#pragma unroll
                    for (int i = 0; i < 16; i += 2) {
                        const float p0 = (ABL & 1) ? sc[kb][i] : __builtin_amdgcn_exp2f(sc[kb][i]), p1 = (ABL & 1) ? sc[kb][i + 1] : __builtin_amdgcn_exp2f(sc[kb][i + 1]);
                        sc[kb][i] = p0; sc[kb][i + 1] = p1;
                        if (!(ABL & 16)) { ls0 += p0; ls1 = __builtin_fmaf(p1, one, ls1); }
                    }
                lbig = ls0 + ls1;
                l += lbig;
                bf16x8 pf[4];
#pragma unroll
                for (int kb = 0; kb < 2; ++kb)
#pragma unroll
                    for (int sp = 0; sp < 2; ++sp) {
                        u32x4 w;
                        w.x = cvtpk(sc[kb][8 * sp], sc[kb][8 * sp + 1]); w.y = cvtpk(sc[kb][8 * sp + 2], sc[kb][8 * sp + 3]);
                        w.z = cvtpk(sc[kb][8 * sp + 4], sc[kb][8 * sp + 5]); w.w = cvtpk(sc[kb][8 * sp + 6], sc[kb][8 * sp + 7]);
                        pf[kb * 2 + sp] = __builtin_bit_cast(bf16x8, w);
                    }
#pragma unroll
                for (int ks = 0; ks < 4; ++ks)
#pragma unroll
                    for (int d = 0; d < NDB; ++d) {
                        const lds_ptr vp = Vb + ((2 * ks) * NDB + d) * 512 + vtr0;
                        const s16x4 lo = lds_tr(vp), hi = lds_tr(vp + NDB * 512);
                        const bf16x8 vf = __builtin_shufflevector(lo, hi, 0, 1, 2, 3, 4, 5, 6, 7);
                        if (ABL & 2) { if (d == 0 && ks == 0) o[0][0] += __builtin_bit_cast(float, pf[0][0] | pf[1][0] | pf[2][0] | pf[3][0]) + __builtin_bit_cast(float, (int)vf[0]); } else
                        o[d] = MFMA32(vf, pf[ks], o[d]);
                    }
            }
            SCHED_FENCE();
            if (N2 && !(ABL & 8) && (!(ABL & 128) || e)) {
#pragma unroll
                for (int i = 0; i < NKI; ++i) *(LAS u32x4*)(lds + e * KTB + kdst[i]) = kr[i];
            }
            if (N1 && !(ABL & 8) && (!(ABL & 128) || e)) {
#pragma unroll
                for (int i = 0; i < NVI; ++i) *(LAS u32x4*)(lds + 2 * KTB + (e ^ 1) * VTB + vdst[i]) = vr[i];
            }
            if (!(ABL & 64) && (!(ABL & 128) || e)) __syncthreads();
#pragma unroll
            for (int kb = 0; kb < 2; ++kb) sc[kb] = sn[kb];
            act_cur = act_nxt;
        };
        int it = 0;
        for (; it + 3 < ntiles; it += 2) { step(it, 0, true, true); step(it + 1, 1, true, true); }
        if (ntiles - it == 3) { step(it, 0, true, true); step(it + 1, 1, false, true); step(it + 2, 0, false, false); }
        else { step(it, 0, false, true); step(it + 1, 1, false, false); }
#undef ATT_TILE
        l = xhalf_sum(l);
        if (a.sink) {
            l += __builtin_amdgcn_exp2f(a.sink[h] * LOG2E - mref);
        }
        const float inv = 1.0f / l;
        bf16_t* orow = a.O + qrow * a.ldo + h * DV + 4 * hf;
#pragma unroll
        for (int d = 0; d < NDB; ++d)
#pragma unroll
            for (int g = 0; g < 4; ++g) {
                if (DV == 64) {
                    *(unsigned*)((unsigned char*)a.O + qrow * a.ldo + h * DV + 4 * hf + d * 32 + 8 * g) = cvt_fp8x4(o[d][4 * g] * inv, o[d][4 * g + 1] * inv, o[d][4 * g + 2] * inv, o[d][4 * g + 3] * inv);
                } else {
                    u32x2 w; w.x = cvtpk(o[d][4 * g] * inv, o[d][4 * g + 1] * inv); w.y = cvtpk(o[d][4 * g + 2] * inv, o[d][4 * g + 3] * inv);
                    *(u32x2*)(orow + d * 32 + 8 * g) = w;
                }
            }
        if (PAIRED && (it_i & 1)) {
            asm volatile("s_waitcnt vmcnt(0)" ::: "memory");
            const float lambda_init = 0.8f - 0.6f * 0.40656965974059917f;
            const int sub = lane & 7, pair = h >> 1;
#pragma unroll
            for (int i4 = 0; i4 < 4; ++i4) {
                const size_t row = (size_t)b * PP + qw0 + i4 * 8 + (lane >> 3);
                const bf16_t* o1 = a.O + row * a.ldo + (2 * pair) * 128 + sub * 16, *o2 = o1 + 128;
                float av[16], cv[16];
                unpack8(*(const u32x4*)o1, *(float(*)[8])av); unpack8(*(const u32x4*)(o1 + 8), *(float(*)[8])(av + 8));
                unpack8(*(const u32x4*)o2, *(float(*)[8])cv); unpack8(*(const u32x4*)(o2 + 8), *(float(*)[8])(cv + 8));
                float ss = 0.f;
#pragma unroll
                for (int e = 0; e < 16; ++e) { av[e] -= lam_full * cv[e]; ss += av[e] * av[e]; }
                ss += __shfl_xor(ss, 1); ss += __shfl_xor(ss, 2); ss += __shfl_xor(ss, 4);
                const float rs = rsqrtf(ss * (1.0f / 128.0f) + EPS) * (1.0f - lambda_init);
#pragma unroll
                for (int e = 0; e < 16; ++e) av[e] *= rs * a.subln[sub * 16 + e];
                u32x4 w8; w8.x = cvt_fp8x4(av[0], av[1], av[2], av[3]); w8.y = cvt_fp8x4(av[4], av[5], av[6], av[7]); w8.z = cvt_fp8x4(av[8], av[9], av[10], av[11]); w8.w = cvt_fp8x4(av[12], av[13], av[14], av[15]);
                *(u32x4*)(a.Oc + row * (size_t)a.ldoc + pair * 128 + sub * 16) = w8;
            }
        }
    }
}

DI void attn_na(const AttnP& a, unsigned char* smem, int bid, int nb, int tid) {
    constexpr int DQ = 64, DV = 64, KSTR = DQ * 2 + 16, KTB = 64 * KSTR, VTB = 64 * DV * 2, NDB = 2, NKK = 4;
    const lds_ptr lds = (lds_ptr)smem;
    constexpr int BZ_TAB = 32, BZ_HEAD = 560, BZ_NINF = 16 * BZ_HEAD, BZ_N = BZ_NINF + 64;
    static_assert(4 * KTB + 4 * VTB + (BZ_N + 16) * 4 <= GEMM_LDS, "NA LDS");
    LAS float* biasl = (LAS float*)(lds + 4 * KTB + 4 * VTB);
    for (int i = tid; i < BZ_N; i += NTHREADS) {
        const int hh = i / BZ_HEAD, o = i - hh * BZ_HEAD;
        biasl[i] = i >= BZ_NINF ? -INFINITY : (o >= BZ_TAB && o < BZ_TAB + 465) ? a.bias[hh * 465 + o - BZ_TAB] * LOG2E : 0.f;
    }
    __syncthreads();
    {
        const int wv = __builtin_amdgcn_readfirstlane(tid >> 6), ln = tid & 63;
#pragma unroll
        for (int hh2 = 0; hh2 < 2; ++hh2) {
            const int hh = 2 * wv + hh2;
            float m = 0.f;
            for (int i = ln; i < 465; i += 64) m = fmaxf(m, biasl[hh * BZ_HEAD + BZ_TAB + i]);
#pragma unroll
            for (int d = 32; d >= 1; d >>= 1) m = fmaxf(m, __shfl_xor(m, d));
            if (ln == 0) biasl[BZ_N + hh] = m;
        }
    }
    float kmax = fabsf(a.kgain[tid & 63]);
#pragma unroll
    for (int d = 32; d >= 1; d >>= 1) kmax = fmaxf(kmax, __shfl_xor(kmax, d));
    kmax *= 8.0f * 1.01f;
    const int lane = tid & 63, wid = __builtin_amdgcn_readfirstlane(tid >> 6), r = lane & 31, hf = lane >> 5;
    const int nq = a.need_ctx ? 17 : 16;
    const int xcd = bid & 7, slot = bid >> 3, nslots = nb >> 3, per_xcd = (NBATCH * a.HQ / 8) * nq;
    const int krow_s = tid >> 3, kc_s = tid & 7;
    const int koff = krow_s * a.ldk + kc_s * 8, kdst = krow_s * KSTR + kc_s * 16, voff = krow_s * a.ldv + kc_s * 8;
    const int vdst = ((krow_s >> 3) * NDB + (kc_s >> 2)) * 512 + (krow_s & 7) * 64 + (kc_s & 3) * 16;
    const int i16 = lane & 15, trq = i16 >> 2, trp = i16 & 3, grp = (lane >> 4) & 1;
    const int vtr0 = (4 * hf + trq) * 64 + 32 * grp + 8 * trp;
    const int rp = wid >> 2, cq = wid & 3, k0 = cq == 0 ? 0 : cq == 1 ? 8 : cq == 2 ? 24 : 32;
    float one = 1.0f; asm volatile("" : "+v"(one));
    auto unit_of = [&](int j, int& b, int& h, int& qt, int& t_lo, int& n_lat) {
        const int nbh = NBATCH * a.HQ / 8;
        const int bhl = j < nbh * 16 ? j >> 4 : j - nbh * 16; qt = j < nbh * 16 ? j & 15 : 16;
        const int bh = bhl * 8 + xcd; h = bh % a.HQ; b = bh / a.HQ;
        t_lo = 0; n_lat = 0;
        if (qt < 16) { const int r0 = 4 * qt; t_lo = min(max(r0 - 4, 0), 56); n_lat = min(max(r0 - 1, 0), 56) + 7 - t_lo + 1; n_lat += n_lat & 1; }
    };
#define NA_TILE_OF(IT, TLO, NLAT) ((IT) < (NLAT) ? (TLO) + (IT) : 64 + ((IT) - (NLAT)))
    bf16x8 qf[NKK];
    u32x4 krA[2], vrA[2], krB[2], vrB[2];
    auto load_pair = [&](u32x4 (&kr)[2], u32x4 (&vr)[2], const bf16_t* Kg, const bf16_t* Vg, int t_lo, int n_lat, int pr) {
#pragma unroll
        for (int jj = 0; jj < 2; ++jj) {
            const int tn = NA_TILE_OF(2 * pr + jj, t_lo, n_lat);
            kr[jj] = *(const u32x4*)(Kg + (size_t)tn * 64 * a.ldk + koff); vr[jj] = *(const u32x4*)(Vg + (size_t)tn * 64 * a.ldv + voff);
        }
    };
    auto store_pair = [&](const u32x4 (&kr)[2], const u32x4 (&vr)[2], int e) {
#pragma unroll
        for (int jj = 0; jj < 2; ++jj) { *(LAS u32x4*)(lds + (2 * e + jj) * KTB + kdst) = kr[jj]; *(LAS u32x4*)(lds + 4 * KTB + (2 * e + jj) * VTB + vdst) = vr[jj]; }
    };
    auto qrow_of = [&](int b, int qt) -> size_t { const int qpos = qt >= 16 ? SEQ + wid * 32 + r : (4 * qt + 2 * rp + (r >> 4)) * 64 + 16 * cq + (r & 15); return (size_t)b * PP + qpos; };
    auto load_q = [&](int b, int h, int qt) {
        const size_t qrow = qrow_of(b, qt);
#pragma unroll
        for (int kk = 0; kk < NKK; ++kk) qf[kk] = *(const bf16x8*)(a.Q + qrow * a.ldq + h * DQ + kk * 16 + hf * 8);
    };
    if (slot >= per_xcd) return;
    int b, h, qt, t_lo, n_lat;
    unit_of(slot, b, h, qt, t_lo, n_lat);
    {
        load_q(b, h, qt);
        const bf16_t* Kg = a.K + (size_t)b * PP * a.ldk + h * DQ; const bf16_t* Vg = a.V + (size_t)b * PP * a.ldv + h * a.vhs;
        load_pair(krA, vrA, Kg, Vg, t_lo, n_lat, 0); store_pair(krA, vrA, 0); load_pair(krB, vrB, Kg, Vg, t_lo, n_lat, 1);
    }
    __syncthreads();
    for (int j = slot;;) {
        const int jn = j + nslots; const bool has_next = jn < per_xcd;
        int nb_, nh, nqt, nt_lo, nn_lat;
        unit_of(has_next ? jn : j, nb_, nh, nqt, nt_lo, nn_lat);
        const bf16_t* nKg = a.K + (size_t)nb_ * PP * a.ldk + nh * DQ; const bf16_t* nVg = a.V + (size_t)nb_ * PP * a.ldv + nh * a.vhs;
        const bool is_ctx = qt >= 16;
        const int r0 = 4 * qt;
        const int npair = (n_lat + 4) >> 1;
        const int qrw = r0 + 2 * rp + (r >> 4), qc = 16 * cq + (r & 15);
        const size_t qrow = qrow_of(b, qt);
        const bf16_t* Kg = a.K + (size_t)b * PP * a.ldk + h * DQ;
        const bf16_t* Vg = a.V + (size_t)b * PP * a.ldv + h * a.vhs;
        const int rwA = r0 + 2 * rp, wlo = min(max(rwA - 4, 0), 56), whi = min(max(rwA - 3, 0), 56) + 7;
        const int col0 = min(max(qc - 8, 0), 48), row0q = min(max(qrw - 4, 0), 56);
        const int lanebase = h * BZ_HEAD + BZ_TAB + (7 - qrw) * 31 + 15 - qc + k0 + 4 * hf;
        f32x16 o[NDB];
#pragma unroll
        for (int d = 0; d < NDB; ++d)
#pragma unroll
            for (int i = 0; i < 16; ++i) o[d][i] = 0.f;
        float l = 0.f;
        float qn2 = 0.f;
#pragma unroll
        for (int kk = 0; kk < NKK; ++kk)
#pragma unroll
            for (int jj = 0; jj < 8; ++jj) { const float qv = bf2f((bf16_t)qf[kk][jj]); qn2 = __builtin_fmaf(qv, qv, qn2); }
        qn2 = xhalf_sum(qn2);
        const float mref = __builtin_sqrtf(qn2) * kmax + biasl[BZ_N + h];
        f32x16 negmL;
#pragma unroll
        for (int i = 0; i < 16; ++i) { const int kc = k0 + crow(i, hf); negmL[i] = (kc >= col0 && kc < col0 + 16) ? -mref : -INFINITY; }
#define NA_TILE(IT) NA_TILE_OF(IT, t_lo, n_lat)
        auto ctx_tile = [&](const lds_ptr Kb, const lds_ptr Vb) {
            {
                f32x16 s[2], negm;
#pragma unroll
                for (int i = 0; i < 16; ++i) negm[i] = -mref;
#pragma unroll
                for (int kk = 0; kk < NKK; ++kk)
#pragma unroll
                    for (int kb = 0; kb < 2; ++kb) {
                        const bf16x8 kf = *(const LAS bf16x8*)(Kb + (kb * 32 + r) * KSTR + (kk * 2 + hf) * 16);
                        s[kb] = MFMA32(kf, qf[kk], kk == 0 ? negm : s[kb]);
                    }
                float ls0 = 0.f, ls1 = 0.f;
                bf16x8 pf[4];
#pragma unroll
                for (int kb = 0; kb < 2; ++kb) {
#pragma unroll
                    for (int i = 0; i < 16; i += 2) {
                        const float p0 = __builtin_amdgcn_exp2f(s[kb][i]), p1 = __builtin_amdgcn_exp2f(s[kb][i + 1]);
                        s[kb][i] = p0; s[kb][i + 1] = p1; ls0 += p0; ls1 = __builtin_fmaf(p1, one, ls1);
                    }
#pragma unroll
                    for (int sp = 0; sp < 2; ++sp) {
                        u32x4 w;
                        w.x = cvtpk(s[kb][8 * sp], s[kb][8 * sp + 1]); w.y = cvtpk(s[kb][8 * sp + 2], s[kb][8 * sp + 3]);
                        w.z = cvtpk(s[kb][8 * sp + 4], s[kb][8 * sp + 5]); w.w = cvtpk(s[kb][8 * sp + 6], s[kb][8 * sp + 7]);
                        pf[kb * 2 + sp] = __builtin_bit_cast(bf16x8, w);
                    }
                }
                l += ls0 + ls1;
#pragma unroll
                for (int ks = 0; ks < 4; ++ks)
#pragma unroll
                    for (int d = 0; d < NDB; ++d) {
                        const lds_ptr vp = Vb + ((2 * ks) * NDB + d) * 512 + vtr0;
                        const s16x4 lo = lds_tr(vp), hi = lds_tr(vp + NDB * 512);
                        o[d] = MFMA32(__builtin_shufflevector(lo, hi, 0, 1, 2, 3, 4, 5, 6, 7), pf[ks], o[d]);
                    }
            }
        };
        auto lat_tile = [&](const int t, const lds_ptr Kb, const lds_ptr Vb) {
            bf16x8 pf[2];
#pragma unroll
            for (int sp = 0; sp < 2; ++sp)
#pragma unroll
                for (int jj = 0; jj < 8; ++jj) pf[sp][jj] = 0;
            if (t >= wlo && t <= whi) {
                f32x16 s;
#pragma unroll
                for (int kk = 0; kk < NKK; ++kk) {
                    const bf16x8 kf = *(const LAS bf16x8*)(Kb + (k0 + r) * KSTR + (kk * 2 + hf) * 16);
                    s = MFMA32(kf, qf[kk], kk == 0 ? negmL : s);
                }
                const LAS float* bp = biasl + (((unsigned)(t - row0q) < 8u) ? lanebase + 31 * t : BZ_NINF);
#pragma unroll
                for (int i = 0; i < 16; ++i) s[i] += bp[crow(i, 0)];
                float ls0 = 0.f, ls1 = 0.f;
#pragma unroll
                for (int i = 0; i < 16; i += 2) {
                    const float p0 = __builtin_amdgcn_exp2f(s[i]), p1 = __builtin_amdgcn_exp2f(s[i + 1]);
                    s[i] = p0; s[i + 1] = p1; ls0 += p0; ls1 = __builtin_fmaf(p1, one, ls1);
                }
#pragma unroll
                for (int sp = 0; sp < 2; ++sp) {
                    u32x4 w;
                    w.x = cvtpk(s[8 * sp], s[8 * sp + 1]); w.y = cvtpk(s[8 * sp + 2], s[8 * sp + 3]);
                    w.z = cvtpk(s[8 * sp + 4], s[8 * sp + 5]); w.w = cvtpk(s[8 * sp + 6], s[8 * sp + 7]);
                    pf[sp] = __builtin_bit_cast(bf16x8, w);
                }
                l += ls0 + ls1;
            }
#pragma unroll
            for (int ks = 0; ks < 2; ++ks)
#pragma unroll
                for (int d = 0; d < NDB; ++d) {
                    const lds_ptr vp = Vb + (((k0 >> 3) + 2 * ks) * NDB + d) * 512 + vtr0;
                    const s16x4 lo = lds_tr(vp), hi = lds_tr(vp + NDB * 512);
                    o[d] = MFMA32(__builtin_shufflevector(lo, hi, 0, 1, 2, 3, 4, 5, 6, 7), pf[ks], o[d]);
                }
        };
#define NA_ITER(IP, E, KL, VL, KS, VS, LAT) do { \
            if ((IP) + 2 < npair) load_pair(KL, VL, Kg, Vg, t_lo, n_lat, (IP) + 2); \
            else if (has_next) load_pair(KL, VL, nKg, nVg, nt_lo, nn_lat, (IP) + 2 - npair); \
            SCHED_FENCE(); \
            if (LAT) { lat_tile(t_lo + 2 * (IP), lds + (2 * (E)) * KTB, lds + 4 * KTB + (2 * (E)) * VTB); lat_tile(t_lo + 2 * (IP) + 1, lds + (2 * (E) + 1) * KTB, lds + 4 * KTB + (2 * (E) + 1) * VTB); } \
            else { ctx_tile(lds + (2 * (E)) * KTB, lds + 4 * KTB + (2 * (E)) * VTB); ctx_tile(lds + (2 * (E) + 1) * KTB, lds + 4 * KTB + (2 * (E) + 1) * VTB); } \
            SCHED_FENCE(); \
            if ((IP) + 1 < npair || has_next) store_pair(KS, VS, (E) ^ 1); \
            __syncthreads(); } while (0)
        int ip = 0;
        for (; ip < (n_lat >> 1); ip += 2) { NA_ITER(ip, 0, krA, vrA, krB, vrB, true); NA_ITER(ip + 1, 1, krB, vrB, krA, vrA, true); }
        NA_ITER(ip, 0, krA, vrA, krB, vrB, false); NA_ITER(ip + 1, 1, krB, vrB, krA, vrA, false);
#undef NA_ITER
        if (has_next) load_q(nb_, nh, nqt);
#undef NA_TILE
        l = xhalf_sum(l);
        const float inv = 1.0f / l;
#pragma unroll
        for (int d = 0; d < NDB; ++d)
#pragma unroll
            for (int g = 0; g < 4; ++g)
                *(unsigned*)((unsigned char*)a.O + qrow * a.ldo + h * DV + 4 * hf + d * 32 + 8 * g) = cvt_fp8x4(o[d][4 * g] * inv, o[d][4 * g + 1] * inv, o[d][4 * g + 2] * inv, o[d][4 * g + 3] * inv);
        if (!has_next) break;
        j = jn; b = nb_; h = nh; qt = nqt; t_lo = nt_lo; n_lat = nn_lat;
    }
#undef NA_TILE_OF
}

template <class E> struct epi_fp8 { static constexpr int value = 0; };
typedef int v8i_t __attribute__((ext_vector_type(8)));
typedef int v4i_t __attribute__((ext_vector_type(4)));
namespace pg8 {
constexpr int BM = 256, BK = 64, HALF = 128, HTB = HALF * BK * 2  ;
DI int lds_byte(int r, int c) { const int st = (r >> 4) * 2 + (c >> 5), rr = r & 15, cc = c & 31, ob = rr * 64 + cc * 2; return st * 1024 + (ob ^ (((ob >> 9) & 1) << 5)); }
DI void stage_rc(int b, int& R, int& C) { const int st = b / 1024, sb = b % 1024, swz = sb ^ (((sb >> 9) & 1) << 5); R = (st >> 1) * 16 + swz / 64; C = (st & 1) * 32 + (swz % 64) / 2; }
DI int perm32(int rho) { const int n = rho >> 4, i = rho & 15; return 8 * (i >> 2) + 4 * n + (i & 3); }

template <class Epi, class Sched>
DI void gemm_phase(lds_ptr lds, const bf16_t* __restrict__ Aop, const int K, const Sched& S, const Epi& E, const int tid) {
    const int wid = __builtin_amdgcn_readfirstlane(tid >> 6), lane = tid & 63, wr = wid >> 2, wc = wid & 3, fr = lane & 15, fq = lane >> 4;
    const int nt = K / BK;
    int Ra[2], Ca[2]; unsigned voffB[2];
#pragma unroll
    for (int i = 0; i < 2; ++i) { int R, C; stage_rc(tid * 16 + i * 8192, R, C); const int Rb = Epi::PERM ? ((R & ~31) + perm32(R & 31)) : R;
        Ra[i] = R; Ca[i] = C; voffB[i] = (unsigned)(Rb * K + C) * 2u; }
    const size_t kstep = (size_t)(BK * 2);
    const size_t hstep = (size_t)HALF * K * 2;
    const unsigned ldsw = (unsigned)wid * 1024u;
    const int aoff = lds_byte(wr * 64 + fr, fq * 8), boff = lds_byte(wc * 32 + fr, fq * 8);
#define PG8_SA(b, h) (((b) * 2 + (h)) * HTB)
#define PG8_SB(b, h) ((4 + (b) * 2 + (h)) * HTB)
#define PG8_STAGE(bufoff, gbase, voff) do { const char* _gb = (const char*)(gbase); asm volatile("" : "+s"(_gb)); _Pragma("unroll") for (int _i = 0; _i < 2; ++_i) { \
        unsigned _o = (voff)[_i]; asm volatile("" : "+v"(_o)); \
        __builtin_amdgcn_global_load_lds((const unsigned*)(_gb + _o), (LAS unsigned*)(lds + (bufoff) + ldsw + _i * 8192), 16, 0, 0); } } while (0)
#define PG8_LDA(dst, b, h) do { _Pragma("unroll") for (int m = 0; m < 4; ++m) _Pragma("unroll") for (int k = 0; k < 2; ++k) dst[m][k] = *(const LAS bf16x8*)(lds + PG8_SA(b, h) + aoff + m * 2048 + k * 1024); } while (0)
#define PG8_LDB(dst, b, h) do { _Pragma("unroll") for (int n = 0; n < 2; ++n) _Pragma("unroll") for (int k = 0; k < 2; ++k) dst[n][k] = *(const LAS bf16x8*)(lds + PG8_SB(b, h) + boff + n * 2048 + k * 1024); } while (0)
typedef long i64x2_t __attribute__((ext_vector_type(2)));
#define PG8_MMA(ai, bj, At, Bt) do { __builtin_amdgcn_s_setprio(1); _Pragma("unroll") for (int m = 0; m < 4; ++m) _Pragma("unroll") for (int n = 0; n < 2; ++n) { \
        if (epi_fp8<Epi>::value == 2) { \
            const v8i_t _b = __builtin_shufflevector(__builtin_bit_cast(v4i_t, Bt[n][0]), __builtin_bit_cast(v4i_t, Bt[n][1]), 0, 1, 2, 3, 4, 5, 6, 7); \
            const v8i_t _a = __builtin_shufflevector(__builtin_bit_cast(v4i_t, At[m][0]), __builtin_bit_cast(v4i_t, At[m][1]), 0, 1, 2, 3, 4, 5, 6, 7); \
            acc[ai][bj][m][n] = __builtin_amdgcn_mfma_scale_f32_16x16x128_f8f6f4(_b, _a, acc[ai][bj][m][n], 0, 0, 0, 0, 0, 0); \
        } else { _Pragma("unroll") for (int k = 0; k < 2; ++k) { \
        if (epi_fp8<Epi>::value == 1) { const i64x2_t _b = __builtin_bit_cast(i64x2_t, Bt[n][k]), _a = __builtin_bit_cast(i64x2_t, At[m][k]); \
            acc[ai][bj][m][n] = __builtin_amdgcn_mfma_f32_16x16x32_fp8_fp8(_b[0], _a[0], acc[ai][bj][m][n], 0, 0, 0); \
            acc[ai][bj][m][n] = __builtin_amdgcn_mfma_f32_16x16x32_fp8_fp8(_b[1], _a[1], acc[ai][bj][m][n], 0, 0, 0); } \
        else acc[ai][bj][m][n] = __builtin_amdgcn_mfma_f32_16x16x32_bf16(Bt[n][k], At[m][k], acc[ai][bj][m][n], 0, 0, 0); } } } \
        __builtin_amdgcn_s_setprio(0); } while (0)
#define PG8_WAIT_V(n) asm volatile("s_waitcnt vmcnt(" #n ")" ::: "memory")
#define PG8_WAIT_L(n) asm volatile("s_waitcnt lgkmcnt(" #n ")" ::: "memory")
#define PG8_BAR __builtin_amdgcn_s_barrier()
#define PG8_SCHED __builtin_amdgcn_sched_barrier(0)
    typename Sched::Unit cur, nxt; int ui = 0;
    if (!S.next(0, cur)) return;
    f32x4 acc[2][2][4][2];
#pragma unroll
    for (int a = 0; a < 2; ++a)
#pragma unroll
        for (int b = 0; b < 2; ++b)
#pragma unroll
            for (int m = 0; m < 4; ++m)
#pragma unroll
                for (int n = 0; n < 2; ++n) acc[a][b][m][n] = (f32x4){0.f, 0.f, 0.f, 0.f};
    bf16x8 At[4][2], B0[2][2], B1[2][2];
    constexpr bool GATHER = Sched::GATHER;
    unsigned oc[2][2], on[2][2] = {{0u, 0u}, {0u, 0u}};
    size_t ubc[2] = {0, 0}, ubn[2] = {0, 0};
#pragma unroll
    for (int h = 0; h < 2; ++h) {
        if (!GATHER) ubc[h] = (size_t)S.a_off(cur, h * HALF) * 2u;
#pragma unroll
        for (int i = 0; i < 2; ++i) oc[h][i] = GATHER ? (S.a_off(cur, h * HALF + Ra[i]) + (unsigned)Ca[i]) * 2u : (unsigned)(Ra[i] * S.lda + Ca[i]) * 2u;
    }
    const char* gA = (const char*)Aop;
    const char* cB = (const char*)S.b_base(cur);
    PG8_STAGE(PG8_SB(0, 0), cB, voffB); PG8_STAGE(PG8_SB(0, 1), cB + hstep, voffB); PG8_STAGE(PG8_SA(0, 0), gA + ubc[0], oc[0]); PG8_STAGE(PG8_SA(0, 1), gA + ubc[1], oc[1]);
    if (wr == 1) PG8_BAR;
    PG8_WAIT_V(2); PG8_BAR;
    PG8_STAGE(PG8_SB(1, 0), cB + kstep, voffB); PG8_STAGE(PG8_SA(1, 0), gA + ubc[0] + kstep, oc[0]); PG8_STAGE(PG8_SB(1, 1), cB + hstep + kstep, voffB);
    PG8_WAIT_V(6); PG8_BAR;
    for (;;) {
        const bool has_next = S.next(ui + 1, nxt);
        const char* nB = has_next ? (const char*)S.b_base(nxt) : cB;
#pragma unroll
        for (int h = 0; h < 2; ++h) {
            if (!GATHER) ubn[h] = has_next ? (size_t)S.a_off(nxt, h * HALF) * 2u : ubc[h];
#pragma unroll
            for (int i = 0; i < 2; ++i) if (GATHER) { int R, C; stage_rc(((wid << 6) | lane_now()) * 16 + i * 8192, R, C);
                const unsigned* ip = S.a_ptr(nxt, h * HALF + R); if (epi_fp8<Epi>::value != 2) asm volatile("global_load_dword %0, %1, off" : "=v"(on[h][i]) : "v"(ip) : "memory"); }
        }
        const bool full = cur.half < 0;
        for (int t = 0; t < nt; t += 2) {
            const bool last = (t == nt - 2);
            const char* a1 = gA + (size_t)(t + 1) * kstep;
            const char* a2 = last ? gA : gA + (size_t)(t + 2) * kstep; const char* b2 = last ? nB : cB + (size_t)(t + 2) * kstep;
            const char* a3 = a2 + kstep; const char* b3 = b2 + kstep;
            size_t u2[2];
            if (GATHER && last) {
                if (epi_fp8<Epi>::value != 2) asm volatile("" : "+v"(on[0][0]), "+v"(on[0][1]), "+v"(on[1][0]), "+v"(on[1][1]));
#pragma unroll
                for (int i = 0; i < 2; ++i) { int R, C; stage_rc(((wid << 6) | lane_now()) * 16 + i * 8192, R, C);
                    if (epi_fp8<Epi>::value == 2) { on[0][i] = *S.a_ptr(nxt, R); on[1][i] = *S.a_ptr(nxt, HALF + R); }
                    oc[0][i] = (S.a_cvt(on[0][i]) + (unsigned)C) * 2u; on[1][i] = (S.a_cvt(on[1][i]) + (unsigned)C) * 2u; }
            }
#pragma unroll
            for (int h = 0; h < 2; ++h) u2[h] = last ? ubn[h] : ubc[h];
            PG8_LDB(B0, 0, 0); PG8_LDB(B1, 0, 1); PG8_SCHED; PG8_LDA(At, 0, 0); PG8_STAGE(PG8_SA(1, 1), a1 + ubc[1], oc[1]);
            if (GATHER && last) { oc[1][0] = on[1][0]; oc[1][1] = on[1][1]; }
            PG8_WAIT_V(8); PG8_WAIT_L(0); PG8_BAR; PG8_MMA(0, 0, At, B0); PG8_MMA(0, 1, At, B1); PG8_BAR; PG8_SCHED;
            PG8_LDA(At, 0, 1); PG8_STAGE(PG8_SB(0, 0), b2, voffB); PG8_STAGE(PG8_SB(0, 1), b2 + hstep, voffB); PG8_STAGE(PG8_SA(0, 0), a2 + u2[0], oc[0]);
            PG8_WAIT_V(8); PG8_WAIT_L(0); PG8_BAR; if (full) { PG8_MMA(1, 0, At, B0); PG8_MMA(1, 1, At, B1); } PG8_BAR; PG8_SCHED;
            PG8_LDB(B0, 1, 0); PG8_LDB(B1, 1, 1); PG8_SCHED; PG8_LDA(At, 1, 0); PG8_STAGE(PG8_SA(0, 1), a2 + u2[1], oc[1]);
            PG8_WAIT_V(8); PG8_WAIT_L(0); PG8_BAR; PG8_MMA(0, 0, At, B0); PG8_MMA(0, 1, At, B1); PG8_BAR; PG8_SCHED;
            PG8_LDA(At, 1, 1); PG8_STAGE(PG8_SB(1, 0), b3, voffB); PG8_STAGE(PG8_SB(1, 1), b3 + hstep, voffB); PG8_STAGE(PG8_SA(1, 0), a3 + u2[0], oc[0]);
            PG8_WAIT_V(8); PG8_WAIT_L(0); PG8_BAR; if (full) { PG8_MMA(1, 0, At, B0); PG8_MMA(1, 1, At, B1); } PG8_BAR; PG8_SCHED;
        }
        if (wr == 0) PG8_BAR;
        { const int ln = lane_now(); E(acc, cur, wr, wc, ln & 15, ln >> 4); }
        if (!has_next) break;
#pragma unroll
        for (int a = 0; a < 2; ++a)
#pragma unroll
            for (int b = 0; b < 2; ++b)
#pragma unroll
                for (int m = 0; m < 4; ++m)
#pragma unroll
                    for (int n = 0; n < 2; ++n) acc[a][b][m][n] = (f32x4){0.f, 0.f, 0.f, 0.f};
        cur = nxt; cB = nB; ++ui;
#pragma unroll
        for (int h = 0; h < 2; ++h) ubc[h] = ubn[h];
        if (wr == 1) PG8_BAR;
    }
    PG8_WAIT_V(0);
    PG8_BAR;
#undef PG8_SA
#undef PG8_SB
#undef PG8_STAGE
#undef PG8_LDA
#undef PG8_LDB
#undef PG8_MMA
#undef PG8_WAIT_V
#undef PG8_WAIT_L
#undef PG8_BAR
#undef PG8_SCHED
}
}

struct DenseSched {
    static constexpr bool GATHER = false;
    struct Unit { int pm, pn, half; };
    int nM, nN, nwg, G, c; const bf16_t* Bt; int K, lda; bool skip_ctx;
    DI void unit_of(int L, Unit& u) const {
        int wgid = L; { const int q = nwg / 8, r = nwg % 8, xcd = wgid % 8, off = wgid / 8; wgid = (xcd < r ? xcd * (q + 1) : r * (q + 1) + (xcd - r) * q) + off; }
        const int nig = 8 * nN, gid = wgid / nig, fm = gid * 8, gsz = (nM - fm) < 8 ? (nM - fm) : 8;
        u.pm = fm + ((wgid % nig) % gsz); u.pn = (wgid % nig) / gsz;
        if (skip_ctx) u.pm += u.pm >> 4;
    }
    DI bool next(int i, Unit& u) const {
        const int rounds = nwg / G, rem = nwg - rounds * G;
        if (i < rounds) { unit_of(i * G + c, u); u.half = -1; return true; }
        if (i > rounds || rem == 0) return false;
        if (2 * rem <= G) { if (c >= 2 * rem) return false; unit_of(rounds * G + (c >> 1), u); u.half = c & 1; return true; }
        if (c >= rem) return false;
        unit_of(rounds * G + c, u); u.half = -1; return true;
    }
    DI unsigned a_off(const Unit& u, int row) const { const int rr = u.half < 0 ? row : u.half * 128 + (row & 127); return (unsigned)(u.pm * 256 + rr) * (unsigned)lda; }
    DI const unsigned* a_ptr(const Unit&, int) const { return nullptr; }
    DI unsigned a_cvt(unsigned raw) const { return raw; }
    DI const bf16_t* b_base(const Unit& u) const { return Bt + (size_t)u.pn * 256 * K; }
};
struct MoeUnit { int e, pn, valid, half; const unsigned* ent; };
template <bool TAIL>
struct MoeSched {
    static constexpr bool GATHER = true;
    typedef MoeUnit Unit;
    const LAS int* tab; const unsigned* list; const unsigned* zero  ; const bf16_t* W; int K, N, TN, lda, shift, G, c, nwg;
    DI bool unit_of(int L, Unit& u) const {
        const int v = tab[1 + (lane_now() & 31)];
        const int e = __builtin_popcount((unsigned)__ballot(v <= L));
        if (e >= NEXP) return false;
        const int rem = L - __builtin_amdgcn_readfirstlane(tab[e]), cn = __builtin_amdgcn_readfirstlane(tab[40 + e]);
        const int rt = rem / TN; u.e = e; u.pn = rem - rt * TN; u.ent = list + (size_t)e * MROWS + rt * 256; u.valid = min(256, cn - rt * 256); return true;
    }
    int lo, n, GX, j;
    DI void place() { GX = G >> 3; j = c >> 3; const int per = ((((nwg + 7) >> 3) + TN - 1) / TN) * TN; lo = (c & 7) * per; n = max(0, min(per, nwg - lo)); }
    DI bool next(int i, Unit& u) const {
        u.ent = zero; u.valid = 1;
        const int rounds = n / GX, rem = n - rounds * GX;
        if (!TAIL) { u.half = -1; if (i >= rounds) return false; return unit_of(lo + i * GX + j, u); }
        if (i > 0 || rem == 0) return false;
        if (2 * rem <= GX) {
            if (j >= 2 * rem) return false;
            if (!unit_of(lo + rounds * GX + (j >> 1), u)) return false;
            u.half = j & 1; u.ent += u.half * 128; u.valid = min(128, u.valid - u.half * 128);
            return u.valid > 0;
        }
        u.half = -1; if (j >= rem) return false;
        return unit_of(lo + rounds * GX + j, u);
    }
    DI unsigned a_off(const Unit& u, int row) const { const int rr = (TAIL && u.half >= 0) ? (row & 127) : row; return (u.ent[rr < u.valid ? rr : u.valid - 1] >> shift) * (unsigned)lda; }
    DI const unsigned* a_ptr(const Unit& u, int row) const { const int rr = (TAIL && u.half >= 0) ? (row & 127) : row; return u.ent + (rr < u.valid ? rr : u.valid - 1); }
    DI unsigned a_cvt(unsigned raw) const { return (raw >> shift) * (unsigned)lda; }
    DI const bf16_t* b_base(const Unit& u) const { return W + ((size_t)u.e * N + (size_t)u.pn * 256) * K; }
};
typedef float f32x4_t __attribute__((ext_vector_type(4)));
struct XEpiStore {
    static constexpr bool PERM = true;
    bf16_t* C; int ldc;
    DI void operator()(const f32x4 (&acc)[2][2][4][2], const DenseSched::Unit& u, int wr, int wc, int fr, int fq) const {
        const int row0 = u.pm * 256 + (u.half > 0 ? 128 : 0) + wr * 64 + fr, col0 = u.pn * 256 + wc * 32 + 8 * fq;
#pragma unroll
        for (int ai = 0; ai < 2; ++ai) if (ai == 0 || u.half < 0)
#pragma unroll
            for (int m = 0; m < 4; ++m) { bf16_t* rowp = C + (size_t)(row0 + ai * 128 + m * 16) * ldc + col0;
#pragma unroll
                for (int bj = 0; bj < 2; ++bj) { const f32x4 v0 = acc[ai][bj][m][0], v1 = acc[ai][bj][m][1];
                    u32x4 w; w.x = cvtpk(v0[0], v0[1]); w.y = cvtpk(v0[2], v0[3]); w.z = cvtpk(v1[0], v1[1]); w.w = cvtpk(v1[2], v1[3]);
                    *(u32x4*)(rowp + bj * 128) = w; } }
    } };
struct XEpiStore8 {
    static constexpr bool PERM = true;
    bf16_t* C; int ldc;
    DI void operator()(const f32x4 (&acc)[2][2][4][2], const DenseSched::Unit& u, int wr, int wc, int fr, int fq) const {
        const int row0 = u.pm * 256 + (u.half > 0 ? 128 : 0) + wr * 64 + fr, col0 = u.pn * 256 + wc * 32 + 8 * fq;
#pragma unroll
        for (int ai = 0; ai < 2; ++ai) if (ai == 0 || u.half < 0)
#pragma unroll
            for (int m = 0; m < 4; ++m) { bf16_t* rowp = C + (size_t)(row0 + ai * 128 + m * 16) * ldc + col0;
#pragma unroll
                for (int bj = 0; bj < 2; ++bj) { const f32x4 v0 = acc[ai][bj][m][0] * (1.0f / 32.0f), v1 = acc[ai][bj][m][1] * (1.0f / 32.0f);
                    u32x4 w; w.x = cvtpk(v0[0], v0[1]); w.y = cvtpk(v0[2], v0[3]); w.z = cvtpk(v1[0], v1[1]); w.w = cvtpk(v1[2], v1[3]);
                    *(u32x4*)(rowp + bj * 128) = w; } }
    } };
template <> struct epi_fp8<XEpiStore8> { static constexpr int value = 2; };
struct XEpiResid {
    static constexpr bool PERM = true;
    const Params* p; const float* mod;
    DI void operator()(const f32x4 (&acc)[2][2][4][2], const DenseSched::Unit& u, int wr, int wc, int fr, int fq) const {
        const int row0 = u.pm * 256 + (u.half > 0 ? 128 : 0) + wr * 64 + fr, col0 = u.pn * 256 + wc * 32 + 8 * fq;
#pragma unroll
        for (int ai = 0; ai < 2; ++ai) if (ai == 0 || u.half < 0)
#pragma unroll
            for (int m = 0; m < 4; ++m) { const int row = row0 + ai * 128 + m * 16;
                bf16_t* xr = xb_row(*p, row) + col0; const float* gp = mod + (size_t)mod_row(row) * 6144 + 2048 + col0;
#pragma unroll
                for (int bj = 0; bj < 2; ++bj) {
                    const u32x4 xw = *(const u32x4*)(xr + bj * 128); const f32x4 g0 = *(const f32x4*)(gp + bj * 128), g1 = *(const f32x4*)(gp + bj * 128 + 4);
                    const f32x4 a0 = acc[ai][bj][m][0], a1 = acc[ai][bj][m][1];
                    u32x4 w;
                    w.x = cvtpk(bflo(xw.x) + g0[0] * a0[0], bfhi(xw.x) + g0[1] * a0[1]); w.y = cvtpk(bflo(xw.y) + g0[2] * a0[2], bfhi(xw.y) + g0[3] * a0[3]);
                    w.z = cvtpk(bflo(xw.z) + g1[0] * a1[0], bfhi(xw.z) + g1[1] * a1[1]); w.w = cvtpk(bflo(xw.w) + g1[2] * a1[2], bfhi(xw.w) + g1[3] * a1[3]);
                    *(u32x4*)(xr + bj * 128) = w; } }
    } };
struct XEpiResid8 {
    static constexpr bool PERM = true;
    const Params* p; const float* mod;
    DI void operator()(const f32x4 (&acc)[2][2][4][2], const DenseSched::Unit& u, int wr, int wc, int fr, int fq) const {
        const int row0 = u.pm * 256 + (u.half > 0 ? 128 : 0) + wr * 64 + fr, col0 = u.pn * 256 + wc * 32 + 8 * fq;
#pragma unroll
        for (int ai = 0; ai < 2; ++ai) if (ai == 0 || u.half < 0)
#pragma unroll
            for (int m = 0; m < 4; ++m) { const int row = row0 + ai * 128 + m * 16;
                bf16_t* xr = xb_row(*p, row) + col0; const float* gp = mod + (size_t)mod_row(row) * 6144 + 2048 + col0;
#pragma unroll
                for (int bj = 0; bj < 2; ++bj) {
                    const u32x4 xw = *(const u32x4*)(xr + bj * 128); const f32x4 g0 = *(const f32x4*)(gp + bj * 128) * (1.0f / 32.0f), g1 = *(const f32x4*)(gp + bj * 128 + 4) * (1.0f / 32.0f);
                    const f32x4 a0 = acc[ai][bj][m][0], a1 = acc[ai][bj][m][1];
                    u32x4 w;
                    w.x = cvtpk(bflo(xw.x) + g0[0] * a0[0], bfhi(xw.x) + g0[1] * a0[1]); w.y = cvtpk(bflo(xw.y) + g0[2] * a0[2], bfhi(xw.y) + g0[3] * a0[3]);
                    w.z = cvtpk(bflo(xw.z) + g1[0] * a1[0], bfhi(xw.z) + g1[1] * a1[1]); w.w = cvtpk(bflo(xw.w) + g1[2] * a1[2], bfhi(xw.w) + g1[3] * a1[3]);
                    *(u32x4*)(xr + bj * 128) = w; } }
    } };
template <> struct epi_fp8<XEpiResid8> { static constexpr int value = 2; };
struct XEpiGlu {
    static constexpr bool PERM = true;
    bf16_t* act; const float* gates;
    DI void operator()(const f32x4 (&acc)[2][2][4][2], const MoeUnit& u, int wr, int wc, int fr, int fq) const {
#pragma unroll
        for (int ai = 0; ai < 2; ++ai)
#pragma unroll
            for (int m = 0; m < 4; ++m) { const int i = ai * 128 + wr * 64 + m * 16 + fr;
                if (i < u.valid) { const unsigned a = u.ent[i]; const float gw = gates[a];
                    const f32x4 g0 = acc[ai][0][m][0], g1 = acc[ai][0][m][1], u0 = acc[ai][1][m][0], u1 = acc[ai][1][m][1];
                    float v[8];
#pragma unroll
                    for (int j = 0; j < 4; ++j) { v[j] = silu_f(g0[j]) * u0[j] * gw; v[4 + j] = silu_f(g1[j]) * u1[j] * gw; }
                    u32x4 w; w.x = cvtpk(v[0], v[1]); w.y = cvtpk(v[2], v[3]); w.z = cvtpk(v[4], v[5]); w.w = cvtpk(v[6], v[7]);
                    *(u32x4*)(act + (size_t)a * DEXP + u.pn * 128 + wc * 32 + 8 * fq) = w; } }
    } };
struct XEpiGlu8 : XEpiGlu {
    DI void operator()(const f32x4 (&acc)[2][2][4][2], const MoeUnit& u, int wr, int wc, int fr, int fq) const {
#pragma unroll
        for (int ai = 0; ai < 2; ++ai)
#pragma unroll
            for (int m = 0; m < 4; ++m) { const int i = ai * 128 + wr * 64 + m * 16 + fr;
                if (i < u.valid) { const unsigned a = u.ent[i]; const float gw = gates[a] * (1.0f / 32.0f);
                    const f32x4 g0 = acc[ai][0][m][0] * (1.0f / 32.0f), g1 = acc[ai][0][m][1] * (1.0f / 32.0f), u0 = acc[ai][1][m][0], u1 = acc[ai][1][m][1];
                    float v[8];
#pragma unroll
                    for (int j = 0; j < 4; ++j) { v[j] = silu_f(g0[j]) * u0[j] * gw; v[4 + j] = silu_f(g1[j]) * u1[j] * gw; }
                    u32x4 w; w.x = cvtpk(v[0], v[1]); w.y = cvtpk(v[2], v[3]); w.z = cvtpk(v[4], v[5]); w.w = cvtpk(v[6], v[7]);
                    *(u32x4*)(act + (size_t)a * DEXP + u.pn * 128 + wc * 32 + 8 * fq) = w; } }
    } };
template <> struct epi_fp8<XEpiGlu8> { static constexpr int value = 2; };
struct XEpiScatter {
    static constexpr bool PERM = true;
    bf16_t* outp;
    DI void operator()(const f32x4 (&acc)[2][2][4][2], const MoeUnit& u, int wr, int wc, int fr, int fq) const {
#pragma unroll
        for (int ai = 0; ai < 2; ++ai)
#pragma unroll
            for (int m = 0; m < 4; ++m) { const int i = ai * 128 + wr * 64 + m * 16 + fr;
                if (i < u.valid) { unsigned char* rowp = (unsigned char*)outp + (size_t)u.ent[i] * 1024 + u.pn * 256 + wc * 32 + 8 * fq;
#pragma unroll
                    for (int bj = 0; bj < 2; ++bj) { const f32x4 v0 = acc[ai][bj][m][0] * 16.f, v1 = acc[ai][bj][m][1] * 16.f;
                        u32x2 w; w.x = cvt_fp8x4(v0[0], v0[1], v0[2], v0[3]); w.y = cvt_fp8x4(v1[0], v1[1], v1[2], v1[3]);
                        *(u32x2*)(rowp + bj * 128) = w; } } }
    } };

template <int KIND>
struct XEpiQKV {
    static constexpr bool PERM = true;
    static constexpr int KW = KIND == 1 ? 256 : 1024, LDRAW = KIND == 1 ? 1536 : 3072;
    static constexpr float ASC = 1.0f / 32.0f;
    bf16_t* Q; bf16_t* Kb; bf16_t* RAW; const float* qn; const float* kn;
    DI void operator()(const f32x4 (&acc)[2][2][4][2], const DenseSched::Unit& u, int wr, int wc, int fr, int fq) const {
        const int col0 = u.pn * 256, row0 = u.pm * 256 + (u.half > 0 ? 128 : 0) + wr * 64 + fr;
        if (col0 >= 1024 + KW) {
#pragma unroll
            for (int ai = 0; ai < 2; ++ai) if (ai == 0 || u.half < 0)
#pragma unroll
                for (int m = 0; m < 4; ++m) { bf16_t* rowp = RAW + (size_t)(row0 + ai * 128 + m * 16) * LDRAW + col0 + wc * 32 + 8 * fq;
#pragma unroll
                    for (int bj = 0; bj < 2; ++bj) { const f32x4 v0 = acc[ai][bj][m][0] * ASC, v1 = acc[ai][bj][m][1] * ASC;
                        u32x4 w; w.x = cvtpk(v0[0], v0[1]); w.y = cvtpk(v0[2], v0[3]); w.z = cvtpk(v1[0], v1[1]); w.w = cvtpk(v1[2], v1[3]);
                        *(u32x4*)(rowp + bj * 128) = w; } }
            return;
        }
        const bool isq = col0 < 1024;
        const int head = isq ? 4 * u.pn + wc : ((col0 - 1024) >> 6) + wc;
        const float* gain = (isq ? qn : kn) + 8 * fq;
        const float scale = isq ? 0.125f * LOG2E : 1.0f;
        bf16_t* dstb = isq ? Q + head * 64 + 8 * fq : Kb + head * 64 + 8 * fq;
        const int ldd = isq ? 1024 : KW;
        f32x4 g[2][2];
#pragma unroll
        for (int bj = 0; bj < 2; ++bj)
#pragma unroll
            for (int n = 0; n < 2; ++n) g[bj][n] = *(const f32x4*)(gain + 32 * bj + 4 * n);
#pragma unroll
        for (int ai = 0; ai < 2; ++ai) if (ai == 0 || u.half < 0)
#pragma unroll
            for (int m = 0; m < 4; ++m) {
                const int row = row0 + ai * 128 + m * 16, b = row / PP, pos = row - b * PP;
                f32x4 v[2][2];
                float ss = 0.f;
#pragma unroll
                for (int bj = 0; bj < 2; ++bj)
#pragma unroll
                    for (int n = 0; n < 2; ++n) { v[bj][n] = acc[ai][bj][m][n] * ASC; ss += v[bj][n][0] * v[bj][n][0] + v[bj][n][1] * v[bj][n][1] + v[bj][n][2] * v[bj][n][2] + v[bj][n][3] * v[bj][n][3]; }
                ss += __shfl_xor(ss, 16); ss += __shfl_xor(ss, 32);
                const float rs = rsqrtf(ss * (1.0f / 64.0f) + EPS);
#pragma unroll
                for (int bj = 0; bj < 2; ++bj)
#pragma unroll
                    for (int n = 0; n < 2; ++n) v[bj][n] = v[bj][n] * rs * g[bj][n];
                if (KIND != 0 && pos < SEQ) {
                    const int prow = (pos >> 6) & 63, pcol = pos & 63;
                    const float* cs = ROPE64 + ((fq < 2 ? prow : pcol) * 16 + ((8 * fq) & 15)) * 2;
#pragma unroll
                    for (int n = 0; n < 2; ++n)
#pragma unroll
                        for (int j = 0; j < 4; ++j) {
                            const float c = cs[(4 * n + j) * 2], sn = cs[(4 * n + j) * 2 + 1], x1 = v[0][n][j], x2 = v[1][n][j];
                            v[0][n][j] = x1 * c - x2 * sn; v[1][n][j] = x2 * c + x1 * sn;
                        }
                }
                bf16_t* rowp = dstb + (size_t)row * ldd;
#pragma unroll
                for (int bj = 0; bj < 2; ++bj) { const f32x4 v0 = v[bj][0] * scale, v1 = v[bj][1] * scale;
                    u32x4 w; w.x = cvtpk(v0[0], v0[1]); w.y = cvtpk(v0[2], v0[3]); w.z = cvtpk(v1[0], v1[1]); w.w = cvtpk(v1[2], v1[3]);
                    *(u32x4*)(rowp + bj * 32) = w; }
            }
    } };
constexpr bool qkv_fp8(int kind) { return true; }
template <int KIND> struct epi_fp8<XEpiQKV<KIND>> { static constexpr int value = 2; };
template <int KIND>
DI void gemm_qkv_x(const Params& p, unsigned char* smem, const bf16_t* Wt, int N, const float* qn, const float* kn, int bid, int nb, int tid) {
    constexpr int KU = qkv_fp8(KIND) ? 512 : 1024;
    DenseSched S; S.nM = MROWS / 256; S.nN = N / 256; S.nwg = S.nM * S.nN; S.G = nb; S.c = bid; S.Bt = Wt; S.K = KU; S.lda = KU; S.skip_ctx = false;
    XEpiQKV<KIND> e{(bf16_t*)(p.ws + WS_Q), (bf16_t*)(p.ws + WS_K), (bf16_t*)(p.ws + WS_RAW), qn, kn};
    pg8::gemm_phase((lds_ptr)smem, (const bf16_t*)(p.ws + WS_H), KU, S, e, tid);
}
template <bool UQ>
struct XEpiMla {
    static constexpr bool PERM = true;
    bf16_t* Q; bf16_t* Kb; bf16_t* V; const float* qn; const float* kn;
    DI void operator()(const f32x4 (&acc)[2][2][4][2], const DenseSched::Unit& u, int wr, int wc, int fr, int fq) const {
        const int row0 = u.pm * 256 + (u.half > 0 ? 128 : 0) + wr * 64 + fr;
        if (u.pn < 4) {
            const int head = 4 * u.pn + wc;
            const float* gain = (UQ ? qn : kn) + 8 * fq;
            const float scale = UQ ? 0.10206207261596577f * LOG2E : 1.0f;
            bf16_t* dstb = (UQ ? Q : Kb) + head * 96 + 8 * fq;
            f32x4 g[2][2];
#pragma unroll
            for (int bj = 0; bj < 2; ++bj)
#pragma unroll
                for (int n = 0; n < 2; ++n) g[bj][n] = *(const f32x4*)(gain + 32 * bj + 4 * n);
#pragma unroll
            for (int ai = 0; ai < 2; ++ai) if (ai == 0 || u.half < 0)
#pragma unroll
                for (int m = 0; m < 4; ++m) {
                    const int row = row0 + ai * 128 + m * 16;
                    float ss = 0.f;
#pragma unroll
                    for (int bj = 0; bj < 2; ++bj)
#pragma unroll
                        for (int n = 0; n < 2; ++n) { const f32x4 v = acc[ai][bj][m][n]; ss += v[0] * v[0] + v[1] * v[1] + v[2] * v[2] + v[3] * v[3]; }
                    ss += __shfl_xor(ss, 16); ss += __shfl_xor(ss, 32);
                    const float rs = rsqrtf(ss * (1.0f / 64.0f) + EPS) * scale;
                    bf16_t* rowp = dstb + (size_t)row * 1536;
#pragma unroll
                    for (int bj = 0; bj < 2; ++bj) { const f32x4 v0 = acc[ai][bj][m][0] * rs * g[bj][0], v1 = acc[ai][bj][m][1] * rs * g[bj][1];
                        u32x4 w; w.x = cvtpk(v0[0], v0[1]); w.y = cvtpk(v0[2], v0[3]); w.z = cvtpk(v1[0], v1[1]); w.w = cvtpk(v1[2], v1[3]);
                        *(u32x4*)(rowp + bj * 32) = w; }
                }
        } else if (UQ) {
            const float scale = 0.10206207261596577f * LOG2E;
            const f32x4 g1 = *(const f32x4*)(qn + 64 + 4 * fq), g2 = *(const f32x4*)(qn + 64 + 16 + 4 * fq);
#pragma unroll
            for (int ai = 0; ai < 2; ++ai) if (ai == 0 || u.half < 0)
#pragma unroll
                for (int m = 0; m < 4; ++m) {
                    const int row = row0 + ai * 128 + m * 16, b = row / PP, pos = row - b * PP;
                    const int prow = (pos >> 6) & 63, pcol = pos & 63;
                    const float* cs = ROPE32 + ((fq < 2 ? prow : pcol) * 8 + ((4 * fq) & 7)) * 2;
#pragma unroll
                    for (int bj = 0; bj < 2; ++bj) {
                        f32x4 x1 = acc[ai][bj][m][0], x2 = acc[ai][bj][m][1];
                        float ss = x1[0] * x1[0] + x1[1] * x1[1] + x1[2] * x1[2] + x1[3] * x1[3] + x2[0] * x2[0] + x2[1] * x2[1] + x2[2] * x2[2] + x2[3] * x2[3];
                        ss += __shfl_xor(ss, 16); ss += __shfl_xor(ss, 32);
                        const float rs = rsqrtf(ss * (1.0f / 32.0f) + EPS);
                        x1 = x1 * rs * g1; x2 = x2 * rs * g2;
                        if (pos < SEQ) {
#pragma unroll
                            for (int j = 0; j < 4; ++j) { const float c = cs[2 * j], sn = cs[2 * j + 1], a1 = x1[j], a2 = x2[j]; x1[j] = a1 * c - a2 * sn; x2[j] = a2 * c + a1 * sn; }
                        }
                        x1 = x1 * scale; x2 = x2 * scale;
                        bf16_t* rowp = Q + (size_t)row * 1536 + (8 * (u.pn - 4) + 4 * bj + wc) * 96 + 64 + 4 * fq;
                        u32x2 w1, w2; w1.x = cvtpk(x1[0], x1[1]); w1.y = cvtpk(x1[2], x1[3]); w2.x = cvtpk(x2[0], x2[1]); w2.y = cvtpk(x2[2], x2[3]);
                        *(u32x2*)rowp = w1; *(u32x2*)(rowp + 16) = w2;
                    }
                }
        } else {
#pragma unroll
            for (int ai = 0; ai < 2; ++ai) if (ai == 0 || u.half < 0)
#pragma unroll
                for (int m = 0; m < 4; ++m) { bf16_t* rowp = V + (size_t)(row0 + ai * 128 + m * 16) * 1024 + (u.pn - 4) * 256 + wc * 32 + 8 * fq;
#pragma unroll
                    for (int bj = 0; bj < 2; ++bj) { const f32x4 v0 = acc[ai][bj][m][0], v1 = acc[ai][bj][m][1];
                        u32x4 w; w.x = cvtpk(v0[0], v0[1]); w.y = cvtpk(v0[2], v0[3]); w.z = cvtpk(v1[0], v1[1]); w.w = cvtpk(v1[2], v1[3]);
                        *(u32x4*)(rowp + bj * 128) = w; } }
        }
    } };
template <bool UQ>
DI void gemm_mla_x(const Params& p, unsigned char* smem, int bid, int nb, int tid) {
    bf16_t* O = (bf16_t*)(p.ws + WS_O);
    DenseSched S; S.nM = MROWS / 256; S.nN = (UQ ? 1536 : 2048) / 256; S.nwg = S.nM * S.nN; S.G = nb; S.c = bid; S.Bt = (const bf16_t*)(p.ws + (UQ ? W_UQ : W_UKV)); S.K = UQ ? 384 : 256; S.lda = S.K; S.skip_ctx = false;
    XEpiMla<UQ> e{(bf16_t*)(p.ws + WS_Q), (bf16_t*)(p.ws + WS_K), (bf16_t*)(p.ws + WS_RAW), p.in[28], p.in[29]};
    pg8::gemm_phase((lds_ptr)smem, UQ ? O : O + (size_t)MROWS * 384, S.K, S, e, tid);
}
template <int EPIK>
DI void gemm_dense_x(const Params& p, unsigned char* smem, const bf16_t* A, int lda, const bf16_t* Wt, int K, int N, bf16_t* C, int ldc, const float* mod, int bid, int nb, int tid, bool skip_ctx = false) {
    DenseSched S; S.nM = skip_ctx ? NBATCH * 16 : MROWS / 256; S.nN = N / 256; S.nwg = S.nM * S.nN; S.G = nb; S.c = bid; S.Bt = Wt; S.K = K; S.lda = lda; S.skip_ctx = skip_ctx;
    if (EPIK == 0) { XEpiStore e{C, ldc}; pg8::gemm_phase((lds_ptr)smem, A, K, S, e, tid); }
    else if (EPIK == 2) { XEpiStore8 e{C, ldc}; pg8::gemm_phase((lds_ptr)smem, A, K, S, e, tid); }
    else if (EPIK == 3) { XEpiResid8 e{&p, mod}; pg8::gemm_phase((lds_ptr)smem, A, K, S, e, tid); }
    else { XEpiResid e{&p, mod}; pg8::gemm_phase((lds_ptr)smem, A, K, S, e, tid); }
}
template <int WHICH, bool TAIL>
DI void gemm_moe_call(const Params& p, unsigned char* smem, int layer, int bid, int nb, int tid) {
    MoeSched<TAIL> S; S.list = (const unsigned*)(p.ws + WS_LIST); S.zero = (const unsigned*)(p.ws + WS_CTL) + 8192; S.G = nb; S.c = bid;
    {
        LAS int* tab = (LAS int*)(smem + GEMM_LDS);
        constexpr int TNc = WHICH == 0 ? 2 : 4;
        if (tid < 64) {
            const unsigned cv = tid < 32 ? ((const unsigned*)(p.ws + WS_CTL) + CW_CNT + layer * 32)[tid] : 0u;
            int incl = (int)((cv + 255u) >> 8) * TNc;
#pragma unroll
            for (int d = 1; d < 32; d <<= 1) { const int o = __shfl_up(incl, d); if (tid >= d) incl += o; }
            if (tid < 32) { tab[1 + tid] = incl; tab[40 + tid] = (int)cv; }
            if (tid == 0) tab[0] = 0;
        }
        __syncthreads();
        S.tab = tab; S.nwg = __builtin_amdgcn_readfirstlane(tab[32]);
    }
    if (WHICH == 0) { S.W = (const bf16_t*)(p.ws + W_GU + (size_t)layer * 32 * 512 * 1024); S.K = 512; S.N = 512; S.TN = 2; S.lda = 512; S.shift = 1;
        S.place(); XEpiGlu8 e{{(bf16_t*)(p.ws + WS_Q), (const float*)(p.ws + WS_GATE)}}; pg8::gemm_phase((lds_ptr)smem, (const bf16_t*)(p.ws + WS_H), 512, S, e, tid); }
    else { S.W = (const bf16_t*)(p.ws + W_DN) + (size_t)layer * 32 * 1024 * 256; S.K = 256; S.N = 1024; S.TN = 4; S.lda = DEXP; S.shift = 0;
        S.place(); XEpiScatter e{(bf16_t*)(p.ws + WS_RAW)}; pg8::gemm_phase((lds_ptr)smem, (const bf16_t*)(p.ws + WS_Q), 256, S, e, tid); }
}
template <int WHICH>
DI void gemm_moe_x(const Params& p, unsigned char* smem, int layer, int bid, int nb, int tid) {
    const int wv = __builtin_amdgcn_readfirstlane(tid >> 6);
    gemm_moe_call<WHICH, false>(p, smem, layer, bid, nb, (wv << 6) | lane_now());
    gemm_moe_call<WHICH, true>(p, smem, layer, bid, nb, (wv << 6) | lane_now());
}

constexpr int NPHASES = 2 + (7 + 7 + 9 + 7) + 1;
constexpr int SMEM_BYTES = GEMM_LDS + 512;

template <int KIND>
DI void layer_phases(const Params& p, int& ph, const int lo, const int hi, const XcdBarrier& bar, unsigned char* smem, int bid, int nb, int wid_u) {
    constexpr int L = KIND;
    const float* mod = (const float*)(p.ws + WS_MOD) + (size_t)L * 9 * 6144;
    bf16_t* H = (bf16_t*)(p.ws + WS_H); bf16_t* O = (bf16_t*)(p.ws + WS_O); bf16_t* RAW = (bf16_t*)(p.ws + WS_RAW);
    bf16_t* Q = (bf16_t*)(p.ws + WS_Q); bf16_t* Kb = (bf16_t*)(p.ws + WS_K);
#ifndef AABL
#define AABL 0
#endif
#ifndef GPROBE
#define GPROBE 0
#endif
#ifndef DUP_MASK
#define DUP_MASK 0ull
#endif
#define PHASE2(BODY, DUPBODY) do { if (lo <= ph && ph < hi) { const int tid = (wid_u << 6) | lane_now(); if ((DUP_MASK >> ph) & 1ull) { DUPBODY; xcd_barrier(bar, tid == 0); } BODY; } if (lo <= ph && ph + 1 < hi) xcd_barrier(bar, ((wid_u << 6) | lane_now()) == 0); ++ph; } while (0)
#define PHASE(...) PHASE2((__VA_ARGS__), (__VA_ARGS__))
    if (L == 0) PHASE(phase_rows<2 | 8 | 32>(p, L, 0, bid, nb, tid), phase_router_prep(p, bid, nb, tid));
    else PHASE2((phase_rows<3 | 32>(p, L, 0, bid, nb, tid)), (phase_rows<2 | 32>(p, L, 0, bid, nb, tid)));
    AttnP a{};
    if (KIND == 0) {
        PHASE(gemm_qkv_x<0>(p, smem, (const bf16_t*)(p.ws + W_QKV0), 3072, p.in[15], p.in[16], bid, nb, tid));
        a = AttnP{Q, 1024, Kb, 1024, RAW + 2048, 3072, O, 1024, 16, 0, 0, 64, p.in[17], nullptr, 1, p.in[16]};
        PHASE(attn_na(a, smem, bid, nb, tid));
        PHASE2((gemm_dense_x<3>(p, smem, O, 512, (const bf16_t*)(p.ws + W_O0), 512, 1024, nullptr, 0, mod, bid, nb, tid)), (gemm_dense_x<0>(p, smem, O, 1024, (const bf16_t*)(p.ws + W_O0), 1024, 1024, RAW, 1024, nullptr, bid, nb, tid)));
    } else if (KIND == 1) {
        PHASE(gemm_qkv_x<1>(p, smem, (const bf16_t*)(p.ws + W_QKV1), 1536, p.in[20], p.in[21], bid, nb, tid));
        a = AttnP{Q, 1024, Kb, 256, RAW + 1280, 1536, O, 1024, 16, 2, 2, 64, nullptr, p.in[22], 1};
        PHASE(attn_mfma<64, 64, 1>(a, smem, bid, nb, tid));
        PHASE2((gemm_dense_x<3>(p, smem, O, 512, (const bf16_t*)(p.ws + W_O1), 512, 1024, nullptr, 0, mod, bid, nb, tid)), (gemm_dense_x<0>(p, smem, O, 1024, (const bf16_t*)(p.ws + W_O1), 1024, 1024, RAW, 1024, nullptr, bid, nb, tid)));
    } else if (KIND == 2) {
        bf16_t* cqn = O; bf16_t* ckvn = O + (size_t)MROWS * 384;
        PHASE(gemm_dense_x<2>(p, smem, H, 512, (const bf16_t*)(p.ws + W_DQKV), 512, 768, Q, 768, nullptr, bid, nb, tid));
        PHASE(phase_post_mla1(p, bid, nb, tid));
        PHASE(gemm_mla_x<true>(p, smem, bid, nb, tid), gemm_mla_x<false>(p, smem, bid, nb, (wid_u << 6) | lane_now()));
        a = AttnP{Q, 1536, Kb, 1536, RAW, 1024, O, 1024, 16, 0, 0, 64, nullptr, nullptr, 1};
        PHASE(attn_mfma<96, 64, 2>(a, smem, bid, nb, tid));
        PHASE2((gemm_dense_x<3>(p, smem, O, 512, (const bf16_t*)(p.ws + W_O2), 512, 1024, nullptr, 0, mod, bid, nb, tid)), (gemm_dense_x<0>(p, smem, O, 1024, (const bf16_t*)(p.ws + W_O2), 1024, 1024, RAW, 1024, nullptr, bid, nb, tid)));
    } else {
        PHASE(gemm_qkv_x<3>(p, smem, (const bf16_t*)(p.ws + W_QKV3), 3072, p.in[32], p.in[33], bid, nb, tid));
        a = AttnP{Q, 1024, Kb, 1024, RAW + 2048, 3072, H  , 2048, 16, 0, 1, 128, nullptr, nullptr, 0, nullptr, p.in[34], p.in[35], (unsigned char*)RAW  , 6144};
        PHASE(attn_mfma<64, 128, 2>(a, smem, bid, nb, tid));
        PHASE(gemm_dense_x<3>(p, smem, RAW, 3072, (const bf16_t*)(p.ws + W_O3), 512, 1024, nullptr, 0, mod, bid, nb, tid, true));
    }
    PHASE(phase_router(p, smem, L, L == 3, bid, nb, tid));
    PHASE(gemm_moe_x<0>(p, smem, L, bid, nb, tid));
    PHASE(gemm_moe_x<1>(p, smem, L, bid, nb, tid));
}

__global__ void __launch_bounds__(NTHREADS, 2) mega(Params p, int lo, int hi) {
    extern __shared__ __attribute__((aligned(16))) unsigned char smem[];
    const int bid = blockIdx.x, nb = gridDim.x, wid_u = __builtin_amdgcn_readfirstlane(threadIdx.x >> 6);
    float* lds = (float*)smem;
    volatile LAS unsigned* xbw = (volatile LAS unsigned*)(smem + SMEM_BYTES - 16);
    if (threadIdx.x == 0) { xbw[0] = 0u; xbw[1] = 0u; }
    __syncthreads();
    XcdBarrier bar = xcd_barrier_post((unsigned*)(p.ws + WS_CTL), xbw);
    int ph = 0;
    PHASE(phase_prologue(p, lds, bid, nb, tid));
    PHASE(phase_mod_reduce(p, bid, nb, tid));
    layer_phases<0>(p, ph, lo, hi, bar, smem, bid, nb, wid_u);
    layer_phases<1>(p, ph, lo, hi, bar, smem, bid, nb, wid_u);
    layer_phases<2>(p, ph, lo, hi, bar, smem, bid, nb, wid_u);
    layer_phases<3>(p, ph, lo, hi, bar, smem, bid, nb, wid_u);
    PHASE2((phase_rows<1 | 16>(p, 3, 0, bid, nb, tid)), (void)0);
}

extern "C" void kernel_launch(void* const* d_in, const int* in_sizes, int n_in, void* d_out, int out_size, void* d_ws, size_t ws_size, hipStream_t stream) {
    (void)in_sizes; (void)out_size;
    if (n_in < 37 || ws_size < WS_END) { fprintf(stderr, "kernel_launch: unexpected inputs (n_in %d, ws %zu)\n", n_in, ws_size); return; }
    static int grid = 0;
    if (!grid) {
        int dev = 0, cus = 0, per_cu = 0;
        hipGetDevice(&dev);
        hipDeviceGetAttribute(&cus, hipDeviceAttributeMultiprocessorCount, dev);
        hipFuncSetAttribute((const void*)mega, hipFuncAttributeMaxDynamicSharedMemorySize, SMEM_BYTES);
        hipOccupancyMaxActiveBlocksPerMultiprocessor(&per_cu, mega, NTHREADS, SMEM_BYTES);
        if (per_cu < 1) per_cu = 1;
        grid = cus * (per_cu < 1 ? per_cu : 1);
    }
    Params p{};
    for (int i = 0; i < 37; ++i) p.in[i] = (const float*)d_in[i];
    p.out = (float*)d_out; p.ws = (unsigned char*)d_ws;
    hipMemsetAsync(p.ws + WS_CTL, 0, 65536, stream);
#if ONE_LAUNCH
    hipLaunchKernelGGL(mega, dim3(grid), dim3(NTHREADS), SMEM_BYTES, stream, p, 0, NPHASES);
#else
    for (int k = 0; k < NPHASES; ++k) hipLaunchKernelGGL(mega, dim3(grid), dim3(NTHREADS), SMEM_BYTES, stream, p, k, k + 1);
#endif
}
```

```cpp
#include <hip/hip_runtime.h>
#include <stdint.h>
#include <stdio.h>

#ifndef ONE_LAUNCH
#define ONE_LAUNCH 1
#endif

#define DI __device__ __forceinline__
typedef unsigned short bf16_t;
typedef short bf16x8 __attribute__((ext_vector_type(8)));
typedef float f32x4 __attribute__((ext_vector_type(4)));
typedef float f32x16 __attribute__((ext_vector_type(16)));
typedef unsigned u32x4 __attribute__((ext_vector_type(4)));
typedef unsigned u32x2 __attribute__((ext_vector_type(2)));

constexpr int DM = 1024, NBATCH = 8, SEQ = 4096, CTXL = 256, PP = SEQ + CTXL, MROWS = NBATCH * PP;
constexpr int NEXP = 32, DEXP = 256;
constexpr float EPS = 1e-6f, LOG2E = 1.4426950408889634f;
constexpr int NTHREADS = 512, NW = NTHREADS / 64;

constexpr size_t MiB = 1ull << 20;
constexpr size_t WS_RAW_FWD = 380ull << 20;
constexpr size_t WS_CTL = 0, CTL_BYTES = 1 * MiB;
constexpr size_t WS_MOD = 1 * MiB;
constexpr size_t WS_MODP = WS_RAW_FWD;
constexpr size_t WS_XCTX = 9 * MiB;
constexpr size_t WS_LIST = 17 * MiB;
constexpr size_t WS_GATE = 22 * MiB;
constexpr size_t WS_W = 24 * MiB;
constexpr size_t W_QKV0 = WS_W + 0 * MiB, W_O0 = WS_W + 6 * MiB, W_QKV1 = WS_W + 8 * MiB, W_O1 = WS_W + 11 * MiB, W_DQKV = WS_W + 13 * MiB,
                 W_UQ = WS_W + 15 * MiB, W_UKV = WS_W + 17 * MiB, W_O2 = WS_W + 18 * MiB, W_QKV3 = WS_W + 20 * MiB, W_O3 = WS_W + 26 * MiB,
                 W_GU = WS_W + 28 * MiB, W_DN = WS_W + 156 * MiB;
constexpr size_t WS_H = 244 * MiB;
constexpr size_t WS_O = 312 * MiB;
constexpr size_t WS_RAW = 380 * MiB;
constexpr size_t WS_Q = 620 * MiB;
constexpr size_t WS_K = 722 * MiB;
constexpr size_t WS_XB = 824 * MiB;
constexpr size_t WS_END = 892 * MiB;
constexpr int CW_CNT = 4096;

constexpr size_t WS_RW = 2 * MiB;
struct Params { const float* in[37]; float* out; unsigned char* ws; };

DI unsigned f2bf(float f) { unsigned u = __float_as_uint(f); return (u + 0x7fffu + ((u >> 16) & 1u)) >> 16; }
DI float bf2f(unsigned h) { return __uint_as_float(h << 16); }
DI unsigned pk2(float lo, float hi) { return f2bf(lo) | (f2bf(hi) << 16); }
DI float bflo(unsigned w) { return __uint_as_float(w << 16); }
DI float bfhi(unsigned w) { return __uint_as_float(w & 0xffff0000u); }
DI int lane_now() { unsigned lane; asm volatile("v_mbcnt_lo_u32_b32 %0, -1, 0\n\tv_mbcnt_hi_u32_b32 %0, -1, %0" : "=v"(lane)); return (int)lane; }
DI float wave_sum(float v) {
#pragma unroll
    for (int o = 32; o > 0; o >>= 1) v += __shfl_xor(v, o);
    return v;
}
DI float silu_f(float x) { return x / (1.0f + __expf(-x)); }
DI void unpack8(const u32x4 w, float (&f)[8]) {
    f[0] = bflo(w.x); f[1] = bfhi(w.x); f[2] = bflo(w.y); f[3] = bfhi(w.y); f[4] = bflo(w.z); f[5] = bfhi(w.z); f[6] = bflo(w.w); f[7] = bfhi(w.w);
}
DI u32x4 pack8(const float (&f)[8]) { u32x4 w; w.x = pk2(f[0], f[1]); w.y = pk2(f[2], f[3]); w.z = pk2(f[4], f[5]); w.w = pk2(f[6], f[7]); return w; }
DI float* xrow_ptr(const Params& p, int r) {
    const int b = r / PP, pos = r - b * PP;
    return pos < SEQ ? p.out + ((size_t)b * SEQ + pos) * DM : (float*)(p.ws + WS_XCTX) + ((size_t)b * CTXL + (pos - SEQ)) * DM;
}
DI bf16_t* xb_row(const Params& p, int r) { return (bf16_t*)(p.ws + WS_XB) + (size_t)r * DM; }
DI int mod_row(int r) { const int b = r / PP, pos = r - b * PP; return pos < SEQ ? b : 8; }
__device__ const float ROPE64[2048] = {
  1.000000000e+00f, 0.000000000e+00f, 1.000000000e+00f, 0.000000000e+00f, 1.000000000e+00f, 0.000000000e+00f, 1.000000000e+00f, 0.000000000e+00f,
  1.000000000e+00f, 0.000000000e+00f, 1.000000000e+00f, 0.000000000e+00f, 1.000000000e+00f, 0.000000000e+00f, 1.000000000e+00f, 0.000000000e+00f,
  1.000000000e+00f, 0.000000000e+00f, 1.000000000e+00f, 0.000000000e+00f, 1.000000000e+00f, 0.000000000e+00f, 1.000000000e+00f, 0.000000000e+00f,
  1.000000000e+00f, 0.000000000e+00f, 1.000000000e+00f, 0.000000000e+00f, 1.000000000e+00f, 0.000000000e+00f, 1.000000000e+00f, 0.000000000e+00f,
  5.403022766e-01f, 8.414709568e-01f, 8.460091352e-01f, 5.331684351e-01f, 9.504152536e-01f, 3.109835982e-01f, 9.842302203e-01f, 1.768921912e-01f,
  9.950041771e-01f, 9.983342141e-02f, 9.984192848e-01f, 5.620449781e-02f, 9.995000362e-01f, 3.161750361e-02f, 9.998418689e-01f, 1.778185740e-02f,
  9.999499917e-01f, 9.999833070e-03f, 9.999842048e-01f, 5.623383448e-03f, 9.999949932e-01f, 3.162272274e-03f, 9.999983907e-01f, 1.778278500e-03f,
  9.999995232e-01f, 9.999999311e-04f, 9.999998212e-01f, 5.623412435e-04f, 9.999999404e-01f, 3.162277571e-04f, 1.000000000e+00f, 1.778279402e-04f,
  -4.161468446e-01f, 9.092974067e-01f, 4.314628243e-01f, 9.021307230e-01f, 8.065783978e-01f, 5.911270976e-01f, 9.374182820e-01f, 3.482052684e-01f,
  9.800665975e-01f, 1.986693293e-01f, 9.936820865e-01f, 1.122313142e-01f, 9.980006814e-01f, 6.320339441e-02f, 9.993675947e-01f, 3.555808961e-02f,
  9.998000264e-01f, 1.999866590e-02f, 9.999367595e-01f, 1.124658901e-02f, 9.999799728e-01f, 6.324512884e-03f, 9.999936819e-01f, 3.556551412e-03f,
  9.999979734e-01f, 1.999998698e-03f, 9.999993443e-01f, 1.124682371e-03f, 9.999998212e-01f, 6.324554561e-04f, 9.999999404e-01f, 3.556558804e-04f,
  -9.899924994e-01f, 1.411200017e-01f, -1.159661636e-01f, 9.932531714e-01f, 5.827536583e-01f, 8.126488924e-01f, 8.610406518e-01f, 5.085361004e-01f,
  9.553365111e-01f, 2.955202162e-01f, 9.858034849e-01f, 1.679033041e-01f, 9.955033660e-01f, 9.472608566e-02f, 9.985772967e-01f, 5.332308263e-02f,
  9.995500445e-01f, 2.999549918e-02f, 9.998577237e-01f, 1.686943881e-02f, 9.999549985e-01f, 9.486690164e-03f, 9.999857545e-01f, 5.334813148e-03f,
  9.999955297e-01f, 2.999995602e-03f, 9.999985695e-01f, 1.687023090e-03f, 9.999995232e-01f, 9.486831259e-04f, 9.999998808e-01f, 5.334838061e-04f,
  -6.536436081e-01f, -7.568024993e-01f, -6.276797056e-01f, 7.784717083e-01f, 3.011374772e-01f, 9.535807371e-01f, 7.575061917e-01f, 6.528279781e-01f,
  9.210609794e-01f, 3.894183338e-01f, 9.748082757e-01f, 2.230444849e-01f, 9.920106530e-01f, 1.261540651e-01f, 9.974712729e-01f, 7.107120752e-02f,
  9.992001057e-01f, 3.998933360e-02f, 9.997470379e-01f, 2.249175683e-02f, 9.999200106e-01f, 1.264877338e-02f, 9.999747276e-01f, 7.113057654e-03f,
  9.999920130e-01f, 3.999989480e-03f, 9.999974966e-01f, 2.249363344e-03f, 9.999992251e-01f, 1.264910679e-03f, 9.999997616e-01f, 7.113117026e-04f,
  2.836622000e-01f, -9.589242935e-01f, -9.460792542e-01f, 3.239352703e-01f, -1.034233812e-02f, 9.999465346e-01f, 6.300802827e-01f, 7.765299678e-01f,
  8.775825500e-01f, 4.794255495e-01f, 9.607312679e-01f, 2.774805427e-01f, 9.875259995e-01f, 1.574558765e-01f, 9.960497618e-01f, 8.879686147e-02f,
  9.987502694e-01f, 4.997916520e-02f, 9.996047616e-01f, 2.811336145e-02f, 9.998750091e-01f, 1.581072807e-02f, 9.999604821e-01f, 8.891279809e-03f,
  9.999874830e-01f, 4.999979399e-03f, 9.999960661e-01f, 2.811702900e-03f, 9.999987483e-01f, 1.581138116e-03f, 9.999995828e-01f, 8.891395992e-04f,
  9.601702690e-01f, -2.794154882e-01f, -9.731037021e-01f, -2.303675115e-01f, -3.207964003e-01f, 9.471482038e-01f, 4.827820361e-01f, 8.757405281e-01f,
  8.253356218e-01f, 5.646424890e-01f, 9.436169863e-01f, 3.310393095e-01f, 9.820539355e-01f, 1.886002719e-01f, 9.943132997e-01f, 1.064944416e-01f,
  9.982005358e-01f, 5.996400490e-02f, 9.994308352e-01f, 3.373407945e-02f, 9.998199940e-01f, 1.897252724e-02f, 9.999430776e-01f, 1.066947449e-02f,
  9.999819994e-01f, 5.999964196e-03f, 9.999943376e-01f, 3.374041524e-03f, 9.999982119e-01f, 1.897365320e-03f, 9.999994040e-01f, 1.066967379e-03f,
  7.539022565e-01f, 6.569865942e-01f, -7.004297972e-01f, -7.137212753e-01f, -5.994374752e-01f, 8.004215956e-01f, 3.202570081e-01f, 9.473307133e-01f,
  7.648422122e-01f, 6.442176700e-01f, 9.235194325e-01f, 3.835515678e-01f, 9.755998850e-01f, 2.195560932e-01f, 9.922624230e-01f, 1.241583377e-01f,
  9.975510240e-01f, 6.994284689e-02f, 9.992253184e-01f, 3.935372457e-02f, 9.997550249e-01f, 2.213413455e-02f, 9.999225140e-01f, 1.244763471e-02f,
  9.999755025e-01f, 6.999942940e-03f, 9.999922514e-01f, 3.936378751e-03f, 9.999975562e-01f, 2.213592408e-03f, 9.999992251e-01f, 1.244795276e-03f,
  -1.455000341e-01f, 9.893582463e-01f, -2.120364457e-01f, -9.772617817e-01f, -8.186324239e-01f, 5.743177533e-01f, 1.476312131e-01f, 9.890424609e-01f,
  6.967067122e-01f, 7.173560858e-01f, 9.005023241e-01f, 4.348512292e-01f, 9.681702852e-01f, 2.502923310e-01f, 9.898977876e-01f, 1.417829692e-01f,
  9.968017340e-01f, 7.991468906e-02f, 9.989882708e-01f, 4.497213289e-02f, 9.996800423e-01f, 2.529552206e-02f, 9.998987913e-01f, 1.422575582e-02f,
  9.999679923e-01f, 7.999914698e-03f, 9.999898672e-01f, 4.498715047e-03f, 9.999967813e-01f, 2.529819263e-03f, 9.999989867e-01f, 1.422623056e-03f,
  -9.111302495e-01f, 4.121184945e-01f, 3.416602612e-01f, -9.398235083e-01f, -9.566441774e-01f, 2.912592292e-01f, -2.965079620e-02f, 9.995602965e-01f,
  6.216099262e-01f, 7.833269238e-01f, 8.746382594e-01f, 4.847761393e-01f, 9.597726464e-01f, 2.807783186e-01f, 9.872201085e-01f, 1.593627781e-01f,
  9.959527254e-01f, 8.987854421e-02f, 9.987195730e-01f, 5.058911815e-02f, 9.995950460e-01f, 2.845665626e-02f, 9.998719096e-01f, 1.600383036e-02f,
  9.999595284e-01f, 8.999879472e-03f, 9.999871850e-01f, 5.061050411e-03f, 9.999959469e-01f, 2.846045885e-03f, 9.999987483e-01f, 1.600450720e-03f,
  -8.390715122e-01f, -5.440211296e-01f, 7.901318669e-01f, -6.129369140e-01f, -9.997860789e-01f, -2.068356983e-02f, -2.059976310e-01f, 9.785524607e-01f,
  5.403022766e-01f, 8.414709568e-01f, 8.460091352e-01f, 5.331684351e-01f, 9.504153132e-01f, 3.109835684e-01f, 9.842302203e-01f, 1.768921912e-01f,
  9.950041771e-01f, 9.983341396e-02f, 9.984192848e-01f, 5.620449781e-02f, 9.995000362e-01f, 3.161750361e-02f, 9.998418689e-01f, 1.778185740e-02f,
  9.999499917e-01f, 9.999834001e-03f, 9.999842048e-01f, 5.623383448e-03f, 9.999949932e-01f, 3.162272274e-03f, 9.999983907e-01f, 1.778278500e-03f,
  4.425697960e-03f, -9.999902248e-01f, 9.952573776e-01f, -9.727645665e-02f, -9.437797666e-01f, -3.305749595e-01f, -3.758473992e-01f, 9.266815782e-01f,
  4.535960853e-01f, 8.912073970e-01f, 8.147053123e-01f, 5.798751712e-01f, 9.401075840e-01f, 3.408778608e-01f, 9.809291363e-01f, 1.943656504e-01f,
  9.939560890e-01f, 1.097782999e-01f, 9.980874062e-01f, 6.181810424e-02f, 9.993950725e-01f, 3.477803990e-02f, 9.998086691e-01f, 1.955982670e-02f,
  9.999395013e-01f, 1.099977922e-02f, 9.999808669e-01f, 6.185714621e-03f, 9.999939203e-01f, 3.478498431e-03f, 9.999980927e-01f, 1.956106164e-03f,
  8.438539505e-01f, -5.365729332e-01f, 8.938615918e-01f, 4.483429790e-01f, -7.941793799e-01f, -6.076834202e-01f, -5.338430405e-01f, 8.455836177e-01f,
  3.623577058e-01f, 9.320390821e-01f, 7.808259130e-01f, 6.247486472e-01f, 9.288598895e-01f, 3.704313040e-01f, 9.773178697e-01f, 2.117776722e-01f,
  9.928086400e-01f, 1.197122037e-01f, 9.977239966e-01f, 6.742975861e-02f, 9.992800951e-01f, 3.793822229e-02f, 9.997723103e-01f, 2.133773454e-02f,
  9.999279976e-01f, 1.199971233e-02f, 9.999772310e-01f, 6.748044398e-03f, 9.999927878e-01f, 3.794723889e-03f, 9.999977350e-01f, 2.133933594e-03f,
  9.074468017e-01f, 4.201670289e-01f, 5.171728730e-01f, 8.558809757e-01f, -5.658205152e-01f, -8.245284557e-01f, -6.750016809e-01f, 7.378162146e-01f,
  2.674987614e-01f, 9.635581970e-01f, 7.444779873e-01f, 6.676470041e-01f, 9.166833758e-01f, 3.996143043e-01f, 9.733975530e-01f, 2.291227132e-01f,
  9.915618896e-01f, 1.296341419e-01f, 9.973290563e-01f, 7.303927839e-02f, 9.991551042e-01f, 4.109803215e-02f, 9.997327924e-01f, 2.311557345e-02f,
  9.999154806e-01f, 1.299963426e-02f, 9.999732971e-01f, 7.310371846e-03f, 9.999915361e-01f, 4.110949114e-03f, 9.999973178e-01f, 2.311761025e-03f,
  1.367372125e-01f, 9.906073809e-01f, -1.879615150e-02f, 9.998233318e-01f, -2.813494802e-01f, -9.596053958e-01f, -7.948709130e-01f, 6.067785621e-01f,
  1.699671596e-01f, 9.854497313e-01f, 7.057763934e-01f, 7.084347010e-01f, 9.035902619e-01f, 4.283977747e-01f, 9.691694379e-01f, 2.463953048e-01f,
  9.902160168e-01f, 1.395431161e-01f, 9.969025850e-01f, 7.864648104e-02f, 9.990201592e-01f, 4.425742477e-02f, 9.996901155e-01f, 2.489333972e-02f,
  9.999020100e-01f, 1.399954315e-02f, 9.999690056e-01f, 7.872696966e-03f, 9.999902248e-01f, 4.427174106e-03f, 9.999969006e-01f, 2.489588689e-03f,
  -7.596879005e-01f, 6.502878666e-01f, -5.489754677e-01f, 8.358384371e-01f, 3.102235124e-02f, -9.995186925e-01f, -8.896704316e-01f, 4.566032588e-01f,
  7.073719800e-02f, 9.974949956e-01f, 6.648434997e-01f, 7.469826341e-01f, 8.895936012e-01f, 4.567528665e-01f, 9.646348357e-01f, 2.635899782e-01f,
  9.887710810e-01f, 1.494381279e-01f, 9.964445233e-01f, 8.425120264e-02f, 9.988752007e-01f, 4.741638154e-02f, 9.996442795e-01f, 2.667102963e-02f,
  9.998875260e-01f, 1.499943808e-02f, 9.999644160e-01f, 8.435020223e-03f, 9.999887347e-01f, 4.743398633e-03f, 9.999964237e-01f, 2.667415887e-03f,
  -9.576594830e-01f, -2.879033089e-01f, -9.100810885e-01f, 4.144302309e-01f, 3.403181732e-01f, -9.403103590e-01f, -9.564100504e-01f, 2.920270860e-01f,
  -2.919954620e-02f, 9.995735884e-01f, 6.218088269e-01f, 7.831690907e-01f, 8.747074604e-01f, 4.846512377e-01f, 9.597951770e-01f, 2.807013094e-01f,
  9.872272611e-01f, 1.593182087e-01f, 9.959549904e-01f, 8.985326439e-02f, 9.987202883e-01f, 5.057485774e-02f, 9.995952845e-01f, 2.844863199e-02f,
  9.998720288e-01f, 1.599931903e-02f, 9.999595284e-01f, 8.997339755e-03f, 9.999871850e-01f, 5.059622694e-03f, 9.999959469e-01f, 2.845243318e-03f,
  -2.751633525e-01f, -9.613974690e-01f, -9.908979535e-01f, -1.346151382e-01f, 6.158648133e-01f, -7.878518701e-01f, -9.929850101e-01f, 1.182405204e-01f,
  -1.288445443e-01f, 9.916648269e-01f, 5.768082738e-01f, 8.168795705e-01f, 8.589466810e-01f, 5.120649934e-01f, 9.546520114e-01f, 2.977238595e-01f,
  9.855847955e-01f, 1.691823453e-01f, 9.954339862e-01f, 9.545248002e-02f, 9.985553622e-01f, 5.373282731e-02f, 9.995430708e-01f, 3.022614494e-02f,
  9.998555183e-01f, 1.699918136e-02f, 9.999542832e-01f, 9.559656493e-03f, 9.999855757e-01f, 5.375845823e-03f, 9.999954104e-01f, 3.023070283e-03f,
  6.603167057e-01f, -7.509872317e-01f, -7.665365338e-01f, -6.422007084e-01f, 8.303361535e-01f, -5.572628975e-01f, -9.982416630e-01f, -5.927551910e-02f,
  -2.272021621e-01f, 9.738476276e-01f, 5.299841762e-01f, 8.480075598e-01f, 8.423270583e-01f, 5.389667153e-01f, 9.492070079e-01f, 3.146522641e-01f,
  9.838436842e-01f, 1.790295690e-01f, 9.948815107e-01f, 1.010486856e-01f, 9.983804226e-01f, 5.689026415e-02f, 9.994877577e-01f, 3.200356290e-02f,
  9.998379946e-01f, 1.799902879e-02f, 9.999487996e-01f, 1.012197044e-02f, 9.999837875e-01f, 5.692068953e-03f, 9.999948740e-01f, 3.200897481e-03f,
  9.887046218e-01f, 1.498772055e-01f, -3.060953915e-01f, -9.520008564e-01f, 9.624637961e-01f, -2.714101076e-01f, -9.720142484e-01f, -2.349217981e-01f,
  -3.232895434e-01f, 9.463000894e-01f, 4.814845920e-01f, 8.764545321e-01f, 8.248651624e-01f, 5.653295517e-01f, 9.434618354e-01f, 3.314811885e-01f,
  9.820042253e-01f, 1.888588965e-01f, 9.942975044e-01f, 1.066416800e-01f, 9.981955290e-01f, 6.004713103e-02f, 9.994292855e-01f, 3.378088027e-02f,
  9.998195171e-01f, 1.899885759e-02f, 9.999428988e-01f, 1.068428159e-02f, 9.999819398e-01f, 6.008291151e-03f, 9.999942780e-01f, 3.378724447e-03f,
  4.080820680e-01f, 9.129452705e-01f, 2.486167252e-01f, -9.686019421e-01f, 9.991443753e-01f, 4.135828838e-02f, -9.151299596e-01f, -4.031589925e-01f,
  -4.161468446e-01f, 9.092974067e-01f, 4.314628243e-01f, 9.021307230e-01f, 8.065784574e-01f, 5.911270380e-01f, 9.374182820e-01f, 3.482052684e-01f,
  9.800665975e-01f, 1.986693144e-01f, 9.936820865e-01f, 1.122313142e-01f, 9.980006814e-01f, 6.320339441e-02f, 9.993675947e-01f, 3.555808961e-02f,
  9.998000264e-01f, 1.999866776e-02f, 9.999367595e-01f, 1.124658901e-02f, 9.999799728e-01f, 6.324512884e-03f, 9.999936819e-01f, 3.556551412e-03f,
  -5.477292538e-01f, 8.366556168e-01f, 7.267602682e-01f, -6.868911982e-01f, 9.367404580e-01f, 3.500247598e-01f, -8.293829560e-01f, -5.586805344e-01f,
  -5.048462152e-01f, 8.632093072e-01f, 3.800770044e-01f, 9.249548316e-01f, 7.874851823e-01f, 6.163335443e-01f, 9.310783744e-01f, 3.648192585e-01f,
  9.780309200e-01f, 2.084598988e-01f, 9.930352569e-01f, 1.178173944e-01f, 9.977958202e-01f, 6.635902822e-02f, 9.993028045e-01f, 3.733518720e-02f,
  9.997795224e-01f, 2.099845745e-02f, 9.999302626e-01f, 1.180889271e-02f, 9.999779463e-01f, 6.640734151e-03f, 9.999930263e-01f, 3.734378144e-03f,
  -9.999608397e-01f, -8.851309307e-03f, 9.810745716e-01f, -1.936302334e-01f, 7.814403772e-01f, 6.239799261e-01f, -7.174774408e-01f, -6.965817213e-01f,
  -5.885011554e-01f, 8.084963560e-01f, 3.274895847e-01f, 9.448547959e-01f, 7.676045895e-01f, 6.409237385e-01f, 9.244439602e-01f, 3.813178837e-01f,
  9.758974314e-01f, 2.182296216e-01f, 9.923570156e-01f, 1.233997419e-01f, 9.975810051e-01f, 6.951400638e-02f, 9.992348552e-01f, 3.911216930e-02f,
  9.997580051e-01f, 2.199822664e-02f, 9.999234676e-01f, 1.237119269e-02f, 9.999758005e-01f, 6.956954487e-03f, 9.999923706e-01f, 3.912204877e-03f,
  -5.328330398e-01f, -8.462204337e-01f, 9.332357645e-01f, 3.592645228e-01f, 5.486452579e-01f, 8.360552788e-01f, -5.829432607e-01f, -8.125128746e-01f,
  -6.662759781e-01f, 7.457052469e-01f, 2.738668323e-01f, 9.617676139e-01f, 7.469564080e-01f, 6.648730636e-01f, 9.175173044e-01f, 3.976959288e-01f,
  9.736663699e-01f, 2.279775143e-01f, 9.916474223e-01f, 1.289781928e-01f, 9.973561764e-01f, 7.266827673e-02f, 9.991636872e-01f, 4.088902473e-02f,
  9.997355342e-01f, 2.299797349e-02f, 9.999163747e-01f, 1.293348987e-02f, 9.999735355e-01f, 7.273174357e-03f, 9.999916553e-01f, 4.090031609e-03f,
  4.241790175e-01f, -9.055783749e-01f, 5.979771614e-01f, 8.015131354e-01f, 2.614416778e-01f, 9.652192593e-01f, -4.300232828e-01f, -9.028177857e-01f,
  -7.373937964e-01f, 6.754631400e-01f, 2.193782777e-01f, 9.756398797e-01f, 7.255613208e-01f, 6.881574988e-01f, 9.103004336e-01f, 4.139482081e-01f,
  9.713379741e-01f, 2.377026230e-01f, 9.909064770e-01f, 1.345525682e-01f, 9.971213937e-01f, 7.582182437e-02f, 9.990894198e-01f, 4.266574979e-02f,
  9.997119904e-01f, 2.399769612e-02f, 9.999089241e-01f, 1.349578146e-02f, 9.999712110e-01f, 7.589393295e-03f, 9.999908805e-01f, 4.267857410e-03f,
  9.912028313e-01f, -1.323517561e-01f, 7.855226099e-02f, 9.969099760e-01f, -5.168933049e-02f, 9.986631870e-01f, -2.635405958e-01f, -9.646483064e-01f,
  -8.011435866e-01f, 5.984721184e-01f, 1.641961634e-01f, 9.864277244e-01f, 7.034407258e-01f, 7.107539177e-01f, 9.027957320e-01f, 4.300695956e-01f,
  9.689124227e-01f, 2.474039644e-01f, 9.901341200e-01f, 1.401226968e-01f, 9.968766570e-01f, 7.897461206e-02f, 9.990119338e-01f, 4.444234073e-02f,
  9.996874928e-01f, 2.499739639e-02f, 9.999011755e-01f, 1.405806933e-02f, 9.999687672e-01f, 7.905611768e-03f, 9.999901056e-01f, 4.445684142e-03f,
  6.469193101e-01f, 7.625584602e-01f, -4.650644958e-01f, 8.852767944e-01f, -3.596943319e-01f, 9.330701828e-01f, -8.874550462e-02f, -9.960543513e-01f,
  -8.568888307e-01f, 5.155012608e-01f, 1.084949449e-01f, 9.940969944e-01f, 6.806167960e-01f, 7.326396108e-01f, 8.950055838e-01f, 4.460549951e-01f,
  9.663899541e-01f, 2.570805550e-01f, 9.893305302e-01f, 1.456883848e-01f, 9.966219068e-01f, 8.212661743e-02f, 9.989313483e-01f, 4.621879384e-02f,
  9.996620417e-01f, 2.599707060e-02f, 9.998931289e-01f, 1.462035347e-02f, 9.999662042e-01f, 8.221829310e-03f, 9.999893308e-01f, 4.623509943e-03f,
  -2.921388149e-01f, 9.563759565e-01f, -8.654506207e-01f, 5.009942055e-01f, -6.320286393e-01f, 7.749450207e-01f, 8.884811401e-02f, -9.960451722e-01f,
  -9.040721655e-01f, 4.273798466e-01f, 5.245061591e-02f, 9.986234903e-01f, 6.571123004e-01f, 7.537927032e-01f, 8.869323730e-01f, 4.618993104e-01f,
  9.637709260e-01f, 2.667314112e-01f, 9.884956479e-01f, 1.512494683e-01f, 9.963572025e-01f, 8.527779579e-02f, 9.988475442e-01f, 4.799510166e-02f,
  9.996355176e-01f, 2.699672058e-02f, 9.998847246e-01f, 1.518263202e-02f, 9.999635220e-01f, 8.538045920e-03f, 9.999884963e-01f, 4.801335745e-03f,
  -9.626058936e-01f, 2.709057927e-01f, -9.992933869e-01f, -3.758566082e-02f, -8.416849375e-01f, 5.399689674e-01f, 2.636395097e-01f, -9.646213055e-01f,
  -9.422222972e-01f, 3.349882066e-01f, -3.759419080e-03f, 9.999929070e-01f, 6.329506636e-01f, 7.741920948e-01f, 8.785787225e-01f, 4.775975943e-01f,
  9.610554576e-01f, 2.763556540e-01f, 9.876294732e-01f, 1.568057537e-01f, 9.960825443e-01f, 8.842811733e-02f, 9.987606406e-01f, 4.977125302e-02f,
  9.996080399e-01f, 2.799634263e-02f, 9.998760223e-01f, 1.574490592e-02f, 9.999607801e-01f, 8.854261599e-03f, 9.999876022e-01f, 4.979162011e-03f,
  -7.480575442e-01f, -6.636338830e-01f, -8.253716230e-01f, -5.645897985e-01f, -9.678714871e-01f, 2.514453232e-01f, 4.301158488e-01f, -9.027736783e-01f,
  -9.709581733e-01f, 2.392492294e-01f, -5.995756760e-02f, 9.982009530e-01f, 6.081562042e-01f, 7.938174009e-01f, 8.699471951e-01f, 4.931448400e-01f,
  9.582439065e-01f, 2.859522104e-01f, 9.867320657e-01f, 1.623570919e-01f, 9.957979321e-01f, 9.157756716e-02f, 9.986705780e-01f, 5.154724792e-02f,
  9.995795488e-01f, 2.899593674e-02f, 9.998670220e-01f, 1.630717516e-02f, 9.999579787e-01f, 9.170476347e-03f, 9.999867082e-01f, 5.156987347e-03f,
  1.542514563e-01f, -9.880316257e-01f, -3.972518742e-01f, -9.177096486e-01f, -9.980752468e-01f, -6.201484054e-02f, 5.830269456e-01f, -8.124528527e-01f,
  -9.899924994e-01f, 1.411200017e-01f, -1.159661636e-01f, 9.932531714e-01f, 5.827536583e-01f, 8.126488924e-01f, 8.610406518e-01f, 5.085361004e-01f,
  9.553365111e-01f, 2.955201864e-01f, 9.858034849e-01f, 1.679033041e-01f, 9.955033660e-01f, 9.472609311e-02f, 9.985772967e-01f, 5.332308263e-02f,
  9.995500445e-01f, 2.999550104e-02f, 9.998577237e-01f, 1.686943881e-02f, 9.999549985e-01f, 9.486690164e-03f, 9.999857545e-01f, 5.334813148e-03f,
  9.147423506e-01f, -4.040376544e-01f, 1.532154828e-01f, -9.881927967e-01f, -9.293003082e-01f, -3.693250120e-01f, 7.175492048e-01f, -6.965078115e-01f,
  -9.991351366e-01f, 4.158052057e-02f, -1.716081351e-01f, 9.851652980e-01f, 5.567683578e-01f, 8.306677938e-01f, 8.518617749e-01f, 5.237666368e-01f,
  9.523335695e-01f, 3.050586283e-01f, 9.848436713e-01f, 1.734442115e-01f, 9.951988459e-01f, 9.787366539e-02f, 9.984809160e-01f, 5.509874597e-02f,
  9.995195270e-01f, 3.099503554e-02f, 9.998480678e-01f, 1.743169688e-02f, 9.999519587e-01f, 9.802903049e-03f, 9.999848008e-01f, 5.512638018e-03f,
  8.342233896e-01f, 5.514267087e-01f, 6.564951539e-01f, -7.543302178e-01f, -7.683671117e-01f, -6.400094032e-01f, 8.294403553e-01f, -5.585952997e-01f,
  -9.982947707e-01f, -5.837419257e-02f, -2.267075777e-01f, 9.739628434e-01f, 5.302263498e-01f, 8.478561044e-01f, 8.424135447e-01f, 5.388315320e-01f,
  9.492354393e-01f, 3.145665526e-01f, 9.838528037e-01f, 1.789796203e-01f, 9.948843718e-01f, 1.010202691e-01f, 9.983813763e-01f, 5.687423423e-02f,
  9.994880557e-01f, 3.199454024e-02f, 9.998381138e-01f, 1.799395122e-02f, 9.999487996e-01f, 1.011911593e-02f, 9.999837875e-01f, 5.690463353e-03f,
  -1.327674743e-02f, 9.999118447e-01f, 9.575860500e-01f, -2.881473899e-01f, -5.312352777e-01f, -8.472243547e-01f, 9.151713848e-01f, -4.030649364e-01f,
  -9.874798059e-01f, -1.577456445e-01f, -2.810903192e-01f, 9.596813321e-01f, 5.031541586e-01f, 8.641966581e-01f, 8.326989412e-01f, 5.537260175e-01f,
  9.460423589e-01f, 3.240430057e-01f, 9.828307629e-01f, 1.845093668e-01f, 9.945599437e-01f, 1.041658595e-01f, 9.982786179e-01f, 5.864954367e-02f,
  9.994555712e-01f, 3.299400955e-02f, 9.998278022e-01f, 1.855619811e-02f, 9.999455214e-01f, 1.043532696e-02f, 9.999827743e-01f, 5.868288688e-03f,
  -8.485702872e-01f, 5.290827155e-01f, 9.637575150e-01f, 2.667797208e-01f, -2.414211184e-01f, -9.704204202e-01f, 9.720383286e-01f, -2.348221242e-01f,
  -9.667981863e-01f, -2.555412054e-01f, -3.345843852e-01f, 9.423658252e-01f, 4.755789042e-01f, 8.796730638e-01f, 8.227210045e-01f, 5.684453845e-01f,
  9.427546859e-01f, 3.334870934e-01f, 9.817776680e-01f, 1.900332868e-01f, 9.942255616e-01f, 1.073104069e-01f, 9.981727600e-01f, 6.042466685e-02f,
  9.994220734e-01f, 3.399345279e-02f, 9.998172522e-01f, 1.911843941e-02f, 9.999421835e-01f, 1.075153705e-02f, 9.999817014e-01f, 6.046113092e-03f,
  -9.036921859e-01f, -4.281826615e-01f, 6.731102467e-01f, 7.395421267e-01f, 7.233466953e-02f, -9.973804355e-01f, 9.982477427e-01f, -5.917267874e-02f,
  -9.364566803e-01f, -3.507832289e-01f, -3.870206773e-01f, 9.220710397e-01f, 4.475280643e-01f, 8.942698836e-01f, 8.124829531e-01f, 5.829849839e-01f,
  9.393727183e-01f, 3.428978026e-01f, 9.806935191e-01f, 1.955512017e-01f, 9.938812256e-01f, 1.104538813e-01f, 9.980637431e-01f, 6.219960377e-02f,
  9.993875623e-01f, 3.499285504e-02f, 9.998063445e-01f, 1.968067512e-02f, 9.999387264e-01f, 1.106774528e-02f, 9.999806285e-01f, 6.223937962e-03f,
  -1.279636919e-01f, -9.917788506e-01f, 1.751565337e-01f, 9.845405817e-01f, 3.789161742e-01f, -9.254310131e-01f, 9.929728508e-01f, 1.183425859e-01f,
  -8.967583776e-01f, -4.425205588e-01f, -4.382335544e-01f, 8.988611698e-01f, 4.190297425e-01f, 9.079725146e-01f, 8.019878864e-01f, 5.973402858e-01f,
  9.358968139e-01f, 3.522742093e-01f, 9.795783162e-01f, 2.010629177e-01f, 9.935269952e-01f, 1.135962531e-01f, 9.979515672e-01f, 6.397433579e-02f,
  9.993520975e-01f, 3.599222749e-02f, 9.997950792e-01f, 2.024290524e-02f, 9.999352098e-01f, 1.138395350e-02f, 9.999794960e-01f, 6.401761901e-03f,
  7.654140592e-01f, -6.435381174e-01f, -3.767423034e-01f, 9.263181090e-01f, 6.479216814e-01f, -7.617069483e-01f, 9.563800097e-01f, 2.921253741e-01f,
  -8.481000066e-01f, -5.298361778e-01f, -4.880608618e-01f, 8.728095889e-01f, 3.901124299e-01f, 9.207672477e-01f, 7.912392616e-01f, 6.115067005e-01f,
  9.323273301e-01f, 3.616154492e-01f, 9.784321785e-01f, 2.065682709e-01f, 9.931628108e-01f, 1.167374924e-01f, 9.978361726e-01f, 6.574887782e-02f,
  9.993155599e-01f, 3.699155897e-02f, 9.997835755e-01f, 2.080512606e-02f, 9.999315739e-01f, 1.170015987e-02f, 9.999783635e-01f, 6.579586305e-03f,
  9.550736547e-01f, 2.963685691e-01f, -8.126112223e-01f, 5.828061700e-01f, 8.526731133e-01f, -5.224447846e-01f, 8.896234632e-01f, 4.566946924e-01f,
  -7.909677625e-01f, -6.118578315e-01f, -5.363451838e-01f, 8.439987302e-01f, 3.608050346e-01f, 9.326412678e-01f, 7.802404165e-01f, 6.254796982e-01f,
  9.286646247e-01f, 3.709204793e-01f, 9.772551060e-01f, 2.120671123e-01f, 9.927886724e-01f, 1.198775545e-01f, 9.977176785e-01f, 6.752320379e-02f,
  9.992780685e-01f, 3.799085692e-02f, 9.997717142e-01f, 2.136734314e-02f, 9.999278188e-01f, 1.201636530e-02f, 9.999771714e-01f, 6.757410709e-03f,
  2.666429281e-01f, 9.637953639e-01f, -9.982103705e-01f, 5.980031565e-02f, 9.728653431e-01f, -2.313720137e-01f, 7.948083878e-01f, 6.068604589e-01f,
  -7.259322405e-01f, -6.877662539e-01f, -5.829339027e-01f, 8.125196099e-01f, 3.311368525e-01f, 9.435827136e-01f, 7.689949274e-01f, 6.392549276e-01f,
  9.249090552e-01f, 3.801884055e-01f, 9.760470986e-01f, 2.175592482e-01f, 9.924046397e-01f, 1.230164245e-01f, 9.975960255e-01f, 6.929731369e-02f,
  9.992396235e-01f, 3.899011388e-02f, 9.997594953e-01f, 2.192955278e-02f, 9.999239445e-01f, 1.233256981e-02f, 9.999759793e-01f, 6.935234182e-03f,
  -6.669380665e-01f, 7.451131344e-01f, -8.763794303e-01f, -4.816212952e-01f, 9.965789914e-01f, 8.264580369e-02f, 6.749256253e-01f, 7.378857136e-01f,
  -6.536436081e-01f, -7.568024993e-01f, -6.276797056e-01f, 7.784717083e-01f, 3.011375964e-01f, 9.535806775e-01f, 7.575061917e-01f, 6.528279781e-01f,
  9.210609794e-01f, 3.894183338e-01f, 9.748082757e-01f, 2.230444849e-01f, 9.920106530e-01f, 1.261540651e-01f, 9.974712729e-01f, 7.107120752e-02f,
  9.992001057e-01f, 3.998933733e-02f, 9.997470379e-01f, 2.249175683e-02f, 9.999200106e-01f, 1.264877338e-02f, 9.999747276e-01f, 7.113057654e-03f,
  -9.873392582e-01f, -1.586226672e-01f, -4.846394062e-01f, -8.747140169e-01f, 9.214623570e-01f, 3.884676993e-01f, 5.337560773e-01f, 8.456384540e-01f,
  -5.748240352e-01f, -8.182770610e-01f, -6.704410911e-01f, 7.419627905e-01f, 2.708370686e-01f, 9.626252055e-01f, 7.457779050e-01f, 6.661946774e-01f,
  9.171208143e-01f, 3.986093104e-01f, 9.735385776e-01f, 2.285226882e-01f, 9.916067719e-01f, 1.292904317e-01f, 9.973433018e-01f, 7.284487784e-02f,
  9.991596341e-01f, 4.098851606e-02f, 9.997342229e-01f, 2.305394970e-02f, 9.999159575e-01f, 1.296497509e-02f, 9.999734163e-01f, 7.290880661e-03f,
  -3.999853134e-01f, -9.165215492e-01f, 5.636094138e-02f, -9.984104633e-01f, 7.549653649e-01f, 6.557646990e-01f, 3.757521510e-01f, 9.267202020e-01f,
  -4.902605712e-01f, -8.715758920e-01f, -7.110829353e-01f, 7.031081319e-01f, 2.402658761e-01f, 9.707071185e-01f, 7.338138223e-01f, 6.793506742e-01f,
  9.130889177e-01f, 4.077604413e-01f, 9.722381234e-01f, 2.339936644e-01f, 9.911929369e-01f, 1.324255317e-01f, 9.972121716e-01f, 7.461831719e-02f,
  9.991181493e-01f, 4.198765755e-02f, 9.997211099e-01f, 2.361613885e-02f, 9.999117851e-01f, 1.328117587e-02f, 9.999721050e-01f, 7.468704134e-03f,
  5.551133156e-01f, -8.317747712e-01f, 5.800031424e-01f, -8.146142364e-01f, 5.135984421e-01f, 8.580306768e-01f, 2.058971673e-01f, 9.785736203e-01f,
  -4.007990062e-01f, -9.161660075e-01f, -7.494767308e-01f, 6.620306373e-01f, 2.094544172e-01f, 9.778184295e-01f, 7.216176391e-01f, 6.922917962e-01f,
  9.089657664e-01f, 4.168707728e-01f, 9.709069133e-01f, 2.394572198e-01f, 9.907692075e-01f, 1.355592906e-01f, 9.970778823e-01f, 7.639151812e-02f,
  9.990756512e-01f, 4.298675060e-02f, 9.997076392e-01f, 2.417832054e-02f, 9.999075532e-01f, 1.359737478e-02f, 9.999707937e-01f, 7.646527141e-03f,
  9.998432994e-01f, 1.770192571e-02f, 9.250146747e-01f, -3.799313903e-01f, 2.212981731e-01f, 9.752061963e-01f, 2.954781987e-02f, 9.995633960e-01f,
  -3.073327839e-01f, -9.516021013e-01f, -7.855011225e-01f, 6.188601851e-01f, 1.784335226e-01f, 9.839519858e-01f, 7.091933489e-01f, 7.050140500e-01f,
  9.047516584e-01f, 4.259394705e-01f, 9.695450068e-01f, 2.449132055e-01f, 9.903355837e-01f, 1.386916935e-01f, 9.969404936e-01f, 7.816448808e-02f,
  9.990321398e-01f, 4.398580641e-02f, 9.996939301e-01f, 2.474049293e-02f, 9.999032021e-01f, 1.391357277e-02f, 9.999693632e-01f, 7.824349217e-03f,
  5.253219604e-01f, 8.509035110e-01f, 9.851381779e-01f, 1.717635691e-01f, -9.294810891e-02f, 9.956709743e-01f, -1.477329880e-01f, 9.890272617e-01f,
  -2.107958049e-01f, -9.775301218e-01f, -8.190422058e-01f, 5.737332702e-01f, 1.472342163e-01f, 9.891016483e-01f, 6.965447664e-01f, 7.175133228e-01f,
  9.004471302e-01f, 4.349655211e-01f, 9.681524038e-01f, 2.503614724e-01f, 9.898920655e-01f, 1.418227106e-01f, 9.967998862e-01f, 7.993719727e-02f,
  9.989876747e-01f, 4.498481750e-02f, 9.996798635e-01f, 2.530265786e-02f, 9.998987317e-01f, 1.422976889e-02f, 9.999679923e-01f, 8.002171293e-03f,
  -4.321779311e-01f, 9.017883539e-01f, 7.418580055e-01f, 6.705570221e-01f, -3.979767561e-01f, 9.173954725e-01f, -3.203543723e-01f, 9.472977519e-01f,
  -1.121526212e-01f, -9.936909676e-01f, -8.499938846e-01f, 5.267925262e-01f, 1.158876941e-01f, 9.932623506e-01f, 6.836758852e-01f, 7.297857404e-01f,
  8.960524797e-01f, 4.439480901e-01f, 9.667292237e-01f, 2.558017969e-01f, 9.894386530e-01f, 1.449523121e-01f, 9.966561794e-01f, 8.170966059e-02f,
  9.989421964e-01f, 4.598378390e-02f, 9.996654391e-01f, 2.586481534e-02f, 9.998942018e-01f, 1.454596408e-02f, 9.999665618e-01f, 8.179994300e-03f,
  -9.923354983e-01f, 1.235731244e-01f, 2.700984478e-01f, 9.628326893e-01f, -6.635382771e-01f, 7.481423616e-01f, -4.828719497e-01f, 8.756909966e-01f,
  -1.238837745e-02f, -9.999232888e-01f, -8.782584071e-01f, 4.781863391e-01f, 8.442528546e-02f, 9.964298010e-01f, 6.705908775e-01f, 7.418274283e-01f,
  8.915683031e-01f, 4.528862834e-01f, 9.652754664e-01f, 2.612340748e-01f, 9.889753461e-01f, 1.480804533e-01f, 9.965093136e-01f, 8.348185569e-02f,
  9.988957047e-01f, 4.698270187e-02f, 9.996507764e-01f, 2.642696351e-02f, 9.998895526e-01f, 1.486215740e-02f, 9.999650717e-01f, 8.357816376e-03f,
  -6.401443481e-01f, -7.682546377e-01f, -2.848466039e-01f, 9.585731030e-01f, -8.632965088e-01f, 5.046970844e-01f, -6.301599741e-01f, 7.764653563e-01f,
  8.749917150e-02f, -9.961646199e-01f, -9.037463665e-01f, 4.280683994e-01f, 5.287845805e-02f, 9.986009598e-01f, 6.572937369e-01f, 7.536345124e-01f,
  8.869948983e-01f, 4.617791772e-01f, 9.637911916e-01f, 2.666580379e-01f, 9.885020852e-01f, 1.512071192e-01f, 9.963592887e-01f, 8.525379747e-02f,
  9.988481998e-01f, 4.798157141e-02f, 9.996357560e-01f, 2.698910423e-02f, 9.998847842e-01f, 1.517834887e-02f, 9.999635816e-01f, 8.535637520e-03f,
  3.005925417e-01f, -9.537526369e-01f, -7.520639896e-01f, 6.590901017e-01f, -9.774427414e-01f, 2.112006545e-01f, -7.575730681e-01f, 6.527503729e-01f,
  1.865124702e-01f, -9.824525714e-01f, -9.263771176e-01f, 3.765971363e-01f, 2.127875760e-02f, 9.997735620e-01f, 6.437888145e-01f, 7.652031779e-01f,
  8.823328614e-01f, 4.706258774e-01f, 9.622764587e-01f, 2.720735669e-01f, 9.880189896e-01f, 1.543322802e-01f, 9.962061048e-01f, 8.702547103e-02f,
  9.987997413e-01f, 4.898039624e-02f, 9.996203780e-01f, 2.755123749e-02f, 9.998799562e-01f, 1.549453940e-02f, 9.999620318e-01f, 8.713459596e-03f,
  9.649659991e-01f, -2.623748481e-01f, -9.876590967e-01f, 1.566190720e-01f, -9.946564436e-01f, -1.032404602e-01f, -8.610926867e-01f, 5.084479451e-01f,
  2.836622000e-01f, -9.589242935e-01f, -9.460792542e-01f, 3.239352703e-01f, -1.034221891e-02f, 9.999465346e-01f, 6.300802827e-01f, 7.765299678e-01f,
  8.775825500e-01f, 4.794255495e-01f, 9.607312679e-01f, 2.774805427e-01f, 9.875259995e-01f, 1.574558914e-01f, 9.960497618e-01f, 8.879686147e-02f,
  9.987502694e-01f, 4.997916892e-02f, 9.996047616e-01f, 2.811335959e-02f, 9.998750091e-01f, 1.581072807e-02f, 9.999604821e-01f, 8.891279809e-03f,
  7.421541810e-01f, 6.702291965e-01f, -9.190735221e-01f, -3.940860629e-01f, -9.132301211e-01f, -4.074441493e-01f, -9.374542236e-01f, 3.481085002e-01f,
  3.779776692e-01f, -9.258147478e-01f, -9.627903700e-01f, 2.702493370e-01f, -4.195285589e-02f, 9.991195798e-01f, 6.161724925e-01f, 7.876111865e-01f,
  8.727445006e-01f, 4.881772399e-01f, 9.591556787e-01f, 2.828786969e-01f, 9.870231748e-01f, 1.605779380e-01f, 9.958902597e-01f, 9.056797624e-02f,
  9.986997843e-01f, 5.097789690e-02f, 9.995887876e-01f, 2.867547423e-02f, 9.998699427e-01f, 1.612691768e-02f, 9.999588728e-01f, 9.069100954e-03f,
  -1.629907787e-01f, 9.866275787e-01f, -5.674300194e-01f, -8.234215975e-01f, -7.412399650e-01f, -6.712401509e-01f, -9.842484593e-01f, 1.767906845e-01f,
  4.685169160e-01f, -8.834545016e-01f, -9.764577150e-01f, 2.157090008e-01f, -7.352153957e-02f, 9.972936511e-01f, 6.020699143e-01f, 7.984433770e-01f,
  8.678191900e-01f, 4.968801141e-01f, 9.575498104e-01f, 2.882679403e-01f, 9.865104556e-01f, 1.636983752e-01f, 9.957276583e-01f, 9.233880043e-02f,
  9.986482859e-01f, 5.197656900e-02f, 9.995725155e-01f, 2.923758142e-02f, 9.998648167e-01f, 1.644310169e-02f, 9.999572635e-01f, 9.246920235e-03f,
  -9.182828069e-01f, 3.959251642e-01f, -4.102819040e-02f, -9.991579652e-01f, -4.957418144e-01f, -8.684699535e-01f, -1.000000000e+00f, -1.030206768e-04f,
  5.543745160e-01f, -8.322673440e-01f, -9.870380163e-01f, 1.604867280e-01f, -1.050167084e-01f, 9.944704771e-01f, 5.877769589e-01f, 8.090230227e-01f,
  8.628070951e-01f, 5.055333376e-01f, 9.559136033e-01f, 2.936480343e-01f, 9.859878421e-01f, 1.668171734e-01f, 9.955618382e-01f, 9.410934150e-02f,
  9.985958338e-01f, 5.297519267e-02f, 9.995558858e-01f, 2.979967557e-02f, 9.998595715e-01f, 1.675928757e-02f, 9.999555945e-01f, 9.424741380e-03f,
  -8.293098211e-01f, -5.587890744e-01f, 4.980095923e-01f, -8.671715260e-01f, -2.010796219e-01f, -9.795749187e-01f, -9.842120409e-01f, -1.769934744e-01f,
  6.346929669e-01f, -7.727644444e-01f, -9.944978952e-01f, 1.047568321e-01f, -1.364068687e-01f, 9.906529188e-01f, 5.732980371e-01f, 8.193469048e-01f,
  8.577086926e-01f, 5.141359568e-01f, 9.542471766e-01f, 2.990188897e-01f, 9.854553938e-01f, 1.699342877e-01f, 9.953929186e-01f, 9.587957710e-02f,
  9.985423684e-01f, 5.397376046e-02f, 9.995389581e-01f, 3.036176413e-02f, 9.998542070e-01f, 1.707546785e-02f, 9.999538660e-01f, 9.602561593e-03f,
  2.212675661e-02f, -9.997551441e-01f, 8.836693168e-01f, -4.681116641e-01f, 1.135217771e-01f, -9.935355186e-01f, -9.373825192e-01f, -3.483016491e-01f,
  7.086697817e-01f, -7.055402994e-01f, -9.988136292e-01f, 4.869600013e-02f, -1.676606387e-01f, 9.858447909e-01f, 5.586379170e-01f, 8.294116855e-01f,
  8.525245190e-01f, 5.226872563e-01f, 9.525505900e-01f, 3.043802381e-01f, 9.849131107e-01f, 1.730497181e-01f, 9.952208400e-01f, 9.764950722e-02f,
  9.984878898e-01f, 5.497227982e-02f, 9.995217323e-01f, 3.092384152e-02f, 9.998487830e-01f, 1.739165001e-02f, 9.999521971e-01f, 9.780380875e-03f,
  8.532201052e-01f, -5.215510130e-01f, 9.971746206e-01f, 7.511820644e-02f, 4.168670774e-01f, -9.089674354e-01f, -8.609884381e-01f, -5.086245537e-01f,
  7.755658031e-01f, -6.312667131e-01f, -9.999717474e-01f, -7.518785074e-03f, -1.987468749e-01f, 9.800508618e-01f, 5.438010693e-01f, 8.392141461e-01f,
  8.472551107e-01f, 5.311862230e-01f, 9.508239031e-01f, 3.097319603e-01f, 9.843609333e-01f, 1.761634201e-01f, 9.950456619e-01f, 9.941913933e-02f,
  9.984323978e-01f, 5.597073585e-02f, 9.995042086e-01f, 3.148590773e-02f, 9.998431802e-01f, 1.770782843e-02f, 9.999504089e-01f, 9.958200157e-03f,
  8.998668194e-01f, 4.361647666e-01f, 8.035690784e-01f, 5.952115059e-01f, 6.788702011e-01f, -7.342582941e-01f, -7.574391961e-01f, -6.529057026e-01f,
  8.347129226e-01f, -5.506852865e-01f, -9.979684949e-01f, -6.370979548e-02f, -2.296342701e-01f, 9.732769728e-01f, 5.287923217e-01f, 8.487512469e-01f,
  8.419010043e-01f, 5.396320224e-01f, 9.490671158e-01f, 3.150739372e-01f, 9.837989211e-01f, 1.792753637e-01f, 9.948672652e-01f, 1.011884511e-01f,
  9.983759522e-01f, 5.696914345e-02f, 9.994863272e-01f, 3.204796836e-02f, 9.998375773e-01f, 1.802400686e-02f, 9.999486208e-01f, 1.013601944e-02f,
  1.191801354e-01f, 9.928726554e-01f, 3.624766767e-01f, 9.319928288e-01f, 8.735505342e-01f, -4.867334962e-01f, -6.300007105e-01f, -7.765945792e-01f,
  8.855196238e-01f, -4.646020234e-01f, -9.928101897e-01f, -1.196993962e-01f, -2.602920532e-01f, 9.655299187e-01f, 5.136163235e-01f, 8.580200076e-01f,
  8.364626765e-01f, 5.480239391e-01f, 9.472803473e-01f, 3.204059005e-01f, 9.832270741e-01f, 1.823855042e-01f, 9.946857691e-01f, 1.029574350e-01f,
  9.983184934e-01f, 5.796748772e-02f, 9.994681478e-01f, 3.261001408e-02f, 9.998317957e-01f, 1.834018156e-02f, 9.999468327e-01f, 1.031383779e-02f,
  -7.710801959e-01f, 6.367380023e-01f, -1.902491003e-01f, 9.817358255e-01f, 9.816020727e-01f, -1.909380108e-01f, -4.826923311e-01f, -8.757900000e-01f,
  9.274784923e-01f, -3.738765717e-01f, -9.845131636e-01f, -1.753105819e-01f, -2.906895578e-01f, 9.568174481e-01f, 4.982779026e-01f, 8.670173883e-01f,
  8.309407234e-01f, 5.563610196e-01f, 9.454635978e-01f, 3.257277906e-01f, 9.826454520e-01f, 1.854938269e-01f, 9.945011139e-01f, 1.047261059e-01f,
  9.982600212e-01f, 5.896577984e-02f, 9.994496703e-01f, 3.317204863e-02f, 9.998259544e-01f, 1.865635626e-02f, 9.999449849e-01f, 1.049165614e-02f,
  -9.524129629e-01f, -3.048106134e-01f, -6.843819022e-01f, 7.291237116e-01f, 9.923083186e-01f, 1.237909496e-01f, -3.201591671e-01f, -9.473637342e-01f,
  9.601702690e-01f, -2.794154882e-01f, -9.731037021e-01f, -2.303675115e-01f, -3.207964003e-01f, 9.471482038e-01f, 4.827820361e-01f, 8.757405281e-01f,
  8.253356218e-01f, 5.646424294e-01f, 9.436169863e-01f, 3.310393095e-01f, 9.820539355e-01f, 1.886002868e-01f, 9.943132997e-01f, 1.064944416e-01f,
  9.982005358e-01f, 5.996400863e-02f, 9.994308352e-01f, 3.373407945e-02f, 9.998199940e-01f, 1.897252724e-02f, 9.999430776e-01f, 1.066947449e-02f,
  -2.581016421e-01f, -9.661177993e-01f, -9.677396417e-01f, 2.519522607e-01f, 9.046075940e-01f, 4.262454212e-01f, -1.475291997e-01f, -9.890577197e-01f,
  9.832684398e-01f, -1.821625978e-01f, -9.586178064e-01f, -2.846961617e-01f, -3.505824506e-01f, 9.365318418e-01f, 4.671334028e-01f, 8.841868639e-01f,
  8.196480274e-01f, 5.728674531e-01f, 9.417404532e-01f, 3.363404274e-01f, 9.814526439e-01f, 1.917048544e-01f, 9.941223264e-01f, 1.082624346e-01f,
  9.981400967e-01f, 6.096218154e-02f, 9.994117022e-01f, 3.429609165e-02f, 9.998139739e-01f, 1.928869821e-02f, 9.999411702e-01f, 1.084729191e-02f,
  6.735071540e-01f, -7.391806841e-01f, -9.530500174e-01f, -3.028128743e-01f, 7.271980643e-01f, 6.864276528e-01f, 2.975377068e-02f, -9.995572567e-01f,
  9.965420961e-01f, -8.308912069e-02f, -9.411013126e-01f, -3.381247520e-01f, -3.800179660e-01f, 9.249790907e-01f, 4.513370395e-01f, 8.923535347e-01f,
  8.138784766e-01f, 5.810351372e-01f, 9.398342371e-01f, 3.416308761e-01f, 9.808415174e-01f, 1.948075294e-01f, 9.939282537e-01f, 1.100300923e-01f,
  9.980786443e-01f, 6.196028739e-02f, 9.993922710e-01f, 3.485809639e-02f, 9.998078346e-01f, 1.960486546e-02f, 9.999392033e-01f, 1.102510840e-02f,
  9.858965874e-01f, 1.673557013e-01f, -6.448370218e-01f, -7.643200755e-01f, 4.776714444e-01f, 8.785385489e-01f, 2.060983330e-01f, -9.785313010e-01f,
  9.998586178e-01f, 1.681409031e-02f, -9.206095338e-01f, -3.904843926e-01f, -4.090735018e-01f, 9.125014544e-01f, 4.353979528e-01f, 9.002380967e-01f,
  8.080275059e-01f, 5.891447663e-01f, 9.378982186e-01f, 3.469105363e-01f, 9.802205563e-01f, 1.979082376e-01f, 9.937310219e-01f, 1.117973924e-01f,
  9.980161786e-01f, 6.295833737e-02f, 9.993724823e-01f, 3.542009369e-02f, 9.998015761e-01f, 1.992103085e-02f, 9.999372363e-01f, 1.120292582e-02f,
};
__device__ const float ROPE32[1024] = {
  1.000000000e+00f, 0.000000000e+00f, 1.000000000e+00f, 0.000000000e+00f, 1.000000000e+00f, 0.000000000e+00f, 1.000000000e+00f, 0.000000000e+00f,
  1.000000000e+00f, 0.000000000e+00f, 1.000000000e+00f, 0.000000000e+00f, 1.000000000e+00f, 0.000000000e+00f, 1.000000000e+00f, 0.000000000e+00f,
  5.403022766e-01f, 8.414709568e-01f, 9.504152536e-01f, 3.109835982e-01f, 9.950041771e-01f, 9.983342141e-02f, 9.995000362e-01f, 3.161750361e-02f,
  9.999499917e-01f, 9.999833070e-03f, 9.999949932e-01f, 3.162272274e-03f, 9.999995232e-01f, 9.999999311e-04f, 9.999999404e-01f, 3.162277571e-04f,
  -4.161468446e-01f, 9.092974067e-01f, 8.065783978e-01f, 5.911270976e-01f, 9.800665975e-01f, 1.986693293e-01f, 9.980006814e-01f, 6.320339441e-02f,
  9.998000264e-01f, 1.999866590e-02f, 9.999799728e-01f, 6.324512884e-03f, 9.999979734e-01f, 1.999998698e-03f, 9.999998212e-01f, 6.324554561e-04f,
  -9.899924994e-01f, 1.411200017e-01f, 5.827536583e-01f, 8.126488924e-01f, 9.553365111e-01f, 2.955202162e-01f, 9.955033660e-01f, 9.472608566e-02f,
  9.995500445e-01f, 2.999549918e-02f, 9.999549985e-01f, 9.486690164e-03f, 9.999955297e-01f, 2.999995602e-03f, 9.999995232e-01f, 9.486831259e-04f,
  -6.536436081e-01f, -7.568024993e-01f, 3.011374772e-01f, 9.535807371e-01f, 9.210609794e-01f, 3.894183338e-01f, 9.920106530e-01f, 1.261540651e-01f,
  9.992001057e-01f, 3.998933360e-02f, 9.999200106e-01f, 1.264877338e-02f, 9.999920130e-01f, 3.999989480e-03f, 9.999992251e-01f, 1.264910679e-03f,
  2.836622000e-01f, -9.589242935e-01f, -1.034233812e-02f, 9.999465346e-01f, 8.775825500e-01f, 4.794255495e-01f, 9.875259995e-01f, 1.574558765e-01f,
  9.987502694e-01f, 4.997916520e-02f, 9.998750091e-01f, 1.581072807e-02f, 9.999874830e-01f, 4.999979399e-03f, 9.999987483e-01f, 1.581138116e-03f,
  9.601702690e-01f, -2.794154882e-01f, -3.207964003e-01f, 9.471482038e-01f, 8.253356218e-01f, 5.646424890e-01f, 9.820539355e-01f, 1.886002719e-01f,
  9.982005358e-01f, 5.996400490e-02f, 9.998199940e-01f, 1.897252724e-02f, 9.999819994e-01f, 5.999964196e-03f, 9.999982119e-01f, 1.897365320e-03f,
  7.539022565e-01f, 6.569865942e-01f, -5.994374752e-01f, 8.004215956e-01f, 7.648422122e-01f, 6.442176700e-01f, 9.755998850e-01f, 2.195560932e-01f,
  9.975510240e-01f, 6.994284689e-02f, 9.997550249e-01f, 2.213413455e-02f, 9.999755025e-01f, 6.999942940e-03f, 9.999975562e-01f, 2.213592408e-03f,
  -1.455000341e-01f, 9.893582463e-01f, -8.186324239e-01f, 5.743177533e-01f, 6.967067122e-01f, 7.173560858e-01f, 9.681702852e-01f, 2.502923310e-01f,
  9.968017340e-01f, 7.991468906e-02f, 9.996800423e-01f, 2.529552206e-02f, 9.999679923e-01f, 7.999914698e-03f, 9.999967813e-01f, 2.529819263e-03f,
  -9.111302495e-01f, 4.121184945e-01f, -9.566441774e-01f, 2.912592292e-01f, 6.216099262e-01f, 7.833269238e-01f, 9.597726464e-01f, 2.807783186e-01f,
  9.959527254e-01f, 8.987854421e-02f, 9.995950460e-01f, 2.845665626e-02f, 9.999595284e-01f, 8.999879472e-03f, 9.999959469e-01f, 2.846045885e-03f,
  -8.390715122e-01f, -5.440211296e-01f, -9.997860789e-01f, -2.068356983e-02f, 5.403022766e-01f, 8.414709568e-01f, 9.504153132e-01f, 3.109835684e-01f,
  9.950041771e-01f, 9.983341396e-02f, 9.995000362e-01f, 3.161750361e-02f, 9.999499917e-01f, 9.999834001e-03f, 9.999949932e-01f, 3.162272274e-03f,
  4.425697960e-03f, -9.999902248e-01f, -9.437797666e-01f, -3.305749595e-01f, 4.535960853e-01f, 8.912073970e-01f, 9.401075840e-01f, 3.408778608e-01f,
  9.939560890e-01f, 1.097782999e-01f, 9.993950725e-01f, 3.477803990e-02f, 9.999395013e-01f, 1.099977922e-02f, 9.999939203e-01f, 3.478498431e-03f,
  8.438539505e-01f, -5.365729332e-01f, -7.941793799e-01f, -6.076834202e-01f, 3.623577058e-01f, 9.320390821e-01f, 9.288598895e-01f, 3.704313040e-01f,
  9.928086400e-01f, 1.197122037e-01f, 9.992800951e-01f, 3.793822229e-02f, 9.999279976e-01f, 1.199971233e-02f, 9.999927878e-01f, 3.794723889e-03f,
  9.074468017e-01f, 4.201670289e-01f, -5.658205152e-01f, -8.245284557e-01f, 2.674987614e-01f, 9.635581970e-01f, 9.166833758e-01f, 3.996143043e-01f,
  9.915618896e-01f, 1.296341419e-01f, 9.991551042e-01f, 4.109803215e-02f, 9.999154806e-01f, 1.299963426e-02f, 9.999915361e-01f, 4.110949114e-03f,
  1.367372125e-01f, 9.906073809e-01f, -2.813494802e-01f, -9.596053958e-01f, 1.699671596e-01f, 9.854497313e-01f, 9.035902619e-01f, 4.283977747e-01f,
  9.902160168e-01f, 1.395431161e-01f, 9.990201592e-01f, 4.425742477e-02f, 9.999020100e-01f, 1.399954315e-02f, 9.999902248e-01f, 4.427174106e-03f,
  -7.596879005e-01f, 6.502878666e-01f, 3.102235124e-02f, -9.995186925e-01f, 7.073719800e-02f, 9.974949956e-01f, 8.895936012e-01f, 4.567528665e-01f,
  9.887710810e-01f, 1.494381279e-01f, 9.988752007e-01f, 4.741638154e-02f, 9.998875260e-01f, 1.499943808e-02f, 9.999887347e-01f, 4.743398633e-03f,
  -9.576594830e-01f, -2.879033089e-01f, 3.403181732e-01f, -9.403103590e-01f, -2.919954620e-02f, 9.995735884e-01f, 8.747074604e-01f, 4.846512377e-01f,
  9.872272611e-01f, 1.593182087e-01f, 9.987202883e-01f, 5.057485774e-02f, 9.998720288e-01f, 1.599931903e-02f, 9.999871850e-01f, 5.059622694e-03f,
  -2.751633525e-01f, -9.613974690e-01f, 6.158648133e-01f, -7.878518701e-01f, -1.288445443e-01f, 9.916648269e-01f, 8.589466810e-01f, 5.120649934e-01f,
  9.855847955e-01f, 1.691823453e-01f, 9.985553622e-01f, 5.373282731e-02f, 9.998555183e-01f, 1.699918136e-02f, 9.999855757e-01f, 5.375845823e-03f,
  6.603167057e-01f, -7.509872317e-01f, 8.303361535e-01f, -5.572628975e-01f, -2.272021621e-01f, 9.738476276e-01f, 8.423270583e-01f, 5.389667153e-01f,
  9.838436842e-01f, 1.790295690e-01f, 9.983804226e-01f, 5.689026415e-02f, 9.998379946e-01f, 1.799902879e-02f, 9.999837875e-01f, 5.692068953e-03f,
  9.887046218e-01f, 1.498772055e-01f, 9.624637961e-01f, -2.714101076e-01f, -3.232895434e-01f, 9.463000894e-01f, 8.248651624e-01f, 5.653295517e-01f,
  9.820042253e-01f, 1.888588965e-01f, 9.981955290e-01f, 6.004713103e-02f, 9.998195171e-01f, 1.899885759e-02f, 9.999819398e-01f, 6.008291151e-03f,
  4.080820680e-01f, 9.129452705e-01f, 9.991443753e-01f, 4.135828838e-02f, -4.161468446e-01f, 9.092974067e-01f, 8.065784574e-01f, 5.911270380e-01f,
  9.800665975e-01f, 1.986693144e-01f, 9.980006814e-01f, 6.320339441e-02f, 9.998000264e-01f, 1.999866776e-02f, 9.999799728e-01f, 6.324512884e-03f,
  -5.477292538e-01f, 8.366556168e-01f, 9.367404580e-01f, 3.500247598e-01f, -5.048462152e-01f, 8.632093072e-01f, 7.874851823e-01f, 6.163335443e-01f,
  9.780309200e-01f, 2.084598988e-01f, 9.977958202e-01f, 6.635902822e-02f, 9.997795224e-01f, 2.099845745e-02f, 9.999779463e-01f, 6.640734151e-03f,
  -9.999608397e-01f, -8.851309307e-03f, 7.814403772e-01f, 6.239799261e-01f, -5.885011554e-01f, 8.084963560e-01f, 7.676045895e-01f, 6.409237385e-01f,
  9.758974314e-01f, 2.182296216e-01f, 9.975810051e-01f, 6.951400638e-02f, 9.997580051e-01f, 2.199822664e-02f, 9.999758005e-01f, 6.956954487e-03f,
  -5.328330398e-01f, -8.462204337e-01f, 5.486452579e-01f, 8.360552788e-01f, -6.662759781e-01f, 7.457052469e-01f, 7.469564080e-01f, 6.648730636e-01f,
  9.736663699e-01f, 2.279775143e-01f, 9.973561764e-01f, 7.266827673e-02f, 9.997355342e-01f, 2.299797349e-02f, 9.999735355e-01f, 7.273174357e-03f,
  4.241790175e-01f, -9.055783749e-01f, 2.614416778e-01f, 9.652192593e-01f, -7.373937964e-01f, 6.754631400e-01f, 7.255613208e-01f, 6.881574988e-01f,
  9.713379741e-01f, 2.377026230e-01f, 9.971213937e-01f, 7.582182437e-02f, 9.997119904e-01f, 2.399769612e-02f, 9.999712110e-01f, 7.589393295e-03f,
  9.912028313e-01f, -1.323517561e-01f, -5.168933049e-02f, 9.986631870e-01f, -8.011435866e-01f, 5.984721184e-01f, 7.034407258e-01f, 7.107539177e-01f,
  9.689124227e-01f, 2.474039644e-01f, 9.968766570e-01f, 7.897461206e-02f, 9.996874928e-01f, 2.499739639e-02f, 9.999687672e-01f, 7.905611768e-03f,
  6.469193101e-01f, 7.625584602e-01f, -3.596943319e-01f, 9.330701828e-01f, -8.568888307e-01f, 5.155012608e-01f, 6.806167960e-01f, 7.326396108e-01f,
  9.663899541e-01f, 2.570805550e-01f, 9.966219068e-01f, 8.212661743e-02f, 9.996620417e-01f, 2.599707060e-02f, 9.999662042e-01f, 8.221829310e-03f,
  -2.921388149e-01f, 9.563759565e-01f, -6.320286393e-01f, 7.749450207e-01f, -9.040721655e-01f, 4.273798466e-01f, 6.571123004e-01f, 7.537927032e-01f,
  9.637709260e-01f, 2.667314112e-01f, 9.963572025e-01f, 8.527779579e-02f, 9.996355176e-01f, 2.699672058e-02f, 9.999635220e-01f, 8.538045920e-03f,
  -9.626058936e-01f, 2.709057927e-01f, -8.416849375e-01f, 5.399689674e-01f, -9.422222972e-01f, 3.349882066e-01f, 6.329506636e-01f, 7.741920948e-01f,
  9.610554576e-01f, 2.763556540e-01f, 9.960825443e-01f, 8.842811733e-02f, 9.996080399e-01f, 2.799634263e-02f, 9.999607801e-01f, 8.854261599e-03f,
  -7.480575442e-01f, -6.636338830e-01f, -9.678714871e-01f, 2.514453232e-01f, -9.709581733e-01f, 2.392492294e-01f, 6.081562042e-01f, 7.938174009e-01f,
  9.582439065e-01f, 2.859522104e-01f, 9.957979321e-01f, 9.157756716e-02f, 9.995795488e-01f, 2.899593674e-02f, 9.999579787e-01f, 9.170476347e-03f,
  1.542514563e-01f, -9.880316257e-01f, -9.980752468e-01f, -6.201484054e-02f, -9.899924994e-01f, 1.411200017e-01f, 5.827536583e-01f, 8.126488924e-01f,
  9.553365111e-01f, 2.955201864e-01f, 9.955033660e-01f, 9.472609311e-02f, 9.995500445e-01f, 2.999550104e-02f, 9.999549985e-01f, 9.486690164e-03f,
  9.147423506e-01f, -4.040376544e-01f, -9.293003082e-01f, -3.693250120e-01f, -9.991351366e-01f, 4.158052057e-02f, 5.567683578e-01f, 8.306677938e-01f,
  9.523335695e-01f, 3.050586283e-01f, 9.951988459e-01f, 9.787366539e-02f, 9.995195270e-01f, 3.099503554e-02f, 9.999519587e-01f, 9.802903049e-03f,
  8.342233896e-01f, 5.514267087e-01f, -7.683671117e-01f, -6.400094032e-01f, -9.982947707e-01f, -5.837419257e-02f, 5.302263498e-01f, 8.478561044e-01f,
  9.492354393e-01f, 3.145665526e-01f, 9.948843718e-01f, 1.010202691e-01f, 9.994880557e-01f, 3.199454024e-02f, 9.999487996e-01f, 1.011911593e-02f,
  -1.327674743e-02f, 9.999118447e-01f, -5.312352777e-01f, -8.472243547e-01f, -9.874798059e-01f, -1.577456445e-01f, 5.031541586e-01f, 8.641966581e-01f,
  9.460423589e-01f, 3.240430057e-01f, 9.945599437e-01f, 1.041658595e-01f, 9.994555712e-01f, 3.299400955e-02f, 9.999455214e-01f, 1.043532696e-02f,
  -8.485702872e-01f, 5.290827155e-01f, -2.414211184e-01f, -9.704204202e-01f, -9.667981863e-01f, -2.555412054e-01f, 4.755789042e-01f, 8.796730638e-01f,
  9.427546859e-01f, 3.334870934e-01f, 9.942255616e-01f, 1.073104069e-01f, 9.994220734e-01f, 3.399345279e-02f, 9.999421835e-01f, 1.075153705e-02f,
  -9.036921859e-01f, -4.281826615e-01f, 7.233466953e-02f, -9.973804355e-01f, -9.364566803e-01f, -3.507832289e-01f, 4.475280643e-01f, 8.942698836e-01f,
  9.393727183e-01f, 3.428978026e-01f, 9.938812256e-01f, 1.104538813e-01f, 9.993875623e-01f, 3.499285504e-02f, 9.999387264e-01f, 1.106774528e-02f,
  -1.279636919e-01f, -9.917788506e-01f, 3.789161742e-01f, -9.254310131e-01f, -8.967583776e-01f, -4.425205588e-01f, 4.190297425e-01f, 9.079725146e-01f,
  9.358968139e-01f, 3.522742093e-01f, 9.935269952e-01f, 1.135962531e-01f, 9.993520975e-01f, 3.599222749e-02f, 9.999352098e-01f, 1.138395350e-02f,
  7.654140592e-01f, -6.435381174e-01f, 6.479216814e-01f, -7.617069483e-01f, -8.481000066e-01f, -5.298361778e-01f, 3.901124299e-01f, 9.207672477e-01f,
  9.323273301e-01f, 3.616154492e-01f, 9.931628108e-01f, 1.167374924e-01f, 9.993155599e-01f, 3.699155897e-02f, 9.999315739e-01f, 1.170015987e-02f,
  9.550736547e-01f, 2.963685691e-01f, 8.526731133e-01f, -5.224447846e-01f, -7.909677625e-01f, -6.118578315e-01f, 3.608050346e-01f, 9.326412678e-01f,
  9.286646247e-01f, 3.709204793e-01f, 9.927886724e-01f, 1.198775545e-01f, 9.992780685e-01f, 3.799085692e-02f, 9.999278188e-01f, 1.201636530e-02f,
  2.666429281e-01f, 9.637953639e-01f, 9.728653431e-01f, -2.313720137e-01f, -7.259322405e-01f, -6.877662539e-01f, 3.311368525e-01f, 9.435827136e-01f,
  9.249090552e-01f, 3.801884055e-01f, 9.924046397e-01f, 1.230164245e-01f, 9.992396235e-01f, 3.899011388e-02f, 9.999239445e-01f, 1.233256981e-02f,
  -6.669380665e-01f, 7.451131344e-01f, 9.965789914e-01f, 8.264580369e-02f, -6.536436081e-01f, -7.568024993e-01f, 3.011375964e-01f, 9.535806775e-01f,
  9.210609794e-01f, 3.894183338e-01f, 9.920106530e-01f, 1.261540651e-01f, 9.992001057e-01f, 3.998933733e-02f, 9.999200106e-01f, 1.264877338e-02f,
  -9.873392582e-01f, -1.586226672e-01f, 9.214623570e-01f, 3.884676993e-01f, -5.748240352e-01f, -8.182770610e-01f, 2.708370686e-01f, 9.626252055e-01f,
  9.171208143e-01f, 3.986093104e-01f, 9.916067719e-01f, 1.292904317e-01f, 9.991596341e-01f, 4.098851606e-02f, 9.999159575e-01f, 1.296497509e-02f,
  -3.999853134e-01f, -9.165215492e-01f, 7.549653649e-01f, 6.557646990e-01f, -4.902605712e-01f, -8.715758920e-01f, 2.402658761e-01f, 9.707071185e-01f,
  9.130889177e-01f, 4.077604413e-01f, 9.911929369e-01f, 1.324255317e-01f, 9.991181493e-01f, 4.198765755e-02f, 9.999117851e-01f, 1.328117587e-02f,
  5.551133156e-01f, -8.317747712e-01f, 5.135984421e-01f, 8.580306768e-01f, -4.007990062e-01f, -9.161660075e-01f, 2.094544172e-01f, 9.778184295e-01f,
  9.089657664e-01f, 4.168707728e-01f, 9.907692075e-01f, 1.355592906e-01f, 9.990756512e-01f, 4.298675060e-02f, 9.999075532e-01f, 1.359737478e-02f,
  9.998432994e-01f, 1.770192571e-02f, 2.212981731e-01f, 9.752061963e-01f, -3.073327839e-01f, -9.516021013e-01f, 1.784335226e-01f, 9.839519858e-01f,
  9.047516584e-01f, 4.259394705e-01f, 9.903355837e-01f, 1.386916935e-01f, 9.990321398e-01f, 4.398580641e-02f, 9.999032021e-01f, 1.391357277e-02f,
  5.253219604e-01f, 8.509035110e-01f, -9.294810891e-02f, 9.956709743e-01f, -2.107958049e-01f, -9.775301218e-01f, 1.472342163e-01f, 9.891016483e-01f,
  9.004471302e-01f, 4.349655211e-01f, 9.898920655e-01f, 1.418227106e-01f, 9.989876747e-01f, 4.498481750e-02f, 9.998987317e-01f, 1.422976889e-02f,
  -4.321779311e-01f, 9.017883539e-01f, -3.979767561e-01f, 9.173954725e-01f, -1.121526212e-01f, -9.936909676e-01f, 1.158876941e-01f, 9.932623506e-01f,
  8.960524797e-01f, 4.439480901e-01f, 9.894386530e-01f, 1.449523121e-01f, 9.989421964e-01f, 4.598378390e-02f, 9.998942018e-01f, 1.454596408e-02f,
  -9.923354983e-01f, 1.235731244e-01f, -6.635382771e-01f, 7.481423616e-01f, -1.238837745e-02f, -9.999232888e-01f, 8.442528546e-02f, 9.964298010e-01f,
  8.915683031e-01f, 4.528862834e-01f, 9.889753461e-01f, 1.480804533e-01f, 9.988957047e-01f, 4.698270187e-02f, 9.998895526e-01f, 1.486215740e-02f,
  -6.401443481e-01f, -7.682546377e-01f, -8.632965088e-01f, 5.046970844e-01f, 8.749917150e-02f, -9.961646199e-01f, 5.287845805e-02f, 9.986009598e-01f,
  8.869948983e-01f, 4.617791772e-01f, 9.885020852e-01f, 1.512071192e-01f, 9.988481998e-01f, 4.798157141e-02f, 9.998847842e-01f, 1.517834887e-02f,
  3.005925417e-01f, -9.537526369e-01f, -9.774427414e-01f, 2.112006545e-01f, 1.865124702e-01f, -9.824525714e-01f, 2.127875760e-02f, 9.997735620e-01f,
  8.823328614e-01f, 4.706258774e-01f, 9.880189896e-01f, 1.543322802e-01f, 9.987997413e-01f, 4.898039624e-02f, 9.998799562e-01f, 1.549453940e-02f,
  9.649659991e-01f, -2.623748481e-01f, -9.946564436e-01f, -1.032404602e-01f, 2.836622000e-01f, -9.589242935e-01f, -1.034221891e-02f, 9.999465346e-01f,
  8.775825500e-01f, 4.794255495e-01f, 9.875259995e-01f, 1.574558914e-01f, 9.987502694e-01f, 4.997916892e-02f, 9.998750091e-01f, 1.581072807e-02f,
  7.421541810e-01f, 6.702291965e-01f, -9.132301211e-01f, -4.074441493e-01f, 3.779776692e-01f, -9.258147478e-01f, -4.195285589e-02f, 9.991195798e-01f,
  8.727445006e-01f, 4.881772399e-01f, 9.870231748e-01f, 1.605779380e-01f, 9.986997843e-01f, 5.097789690e-02f, 9.998699427e-01f, 1.612691768e-02f,
  -1.629907787e-01f, 9.866275787e-01f, -7.412399650e-01f, -6.712401509e-01f, 4.685169160e-01f, -8.834545016e-01f, -7.352153957e-02f, 9.972936511e-01f,
  8.678191900e-01f, 4.968801141e-01f, 9.865104556e-01f, 1.636983752e-01f, 9.986482859e-01f, 5.197656900e-02f, 9.998648167e-01f, 1.644310169e-02f,
  -9.182828069e-01f, 3.959251642e-01f, -4.957418144e-01f, -8.684699535e-01f, 5.543745160e-01f, -8.322673440e-01f, -1.050167084e-01f, 9.944704771e-01f,
  8.628070951e-01f, 5.055333376e-01f, 9.859878421e-01f, 1.668171734e-01f, 9.985958338e-01f, 5.297519267e-02f, 9.998595715e-01f, 1.675928757e-02f,
  -8.293098211e-01f, -5.587890744e-01f, -2.010796219e-01f, -9.795749187e-01f, 6.346929669e-01f, -7.727644444e-01f, -1.364068687e-01f, 9.906529188e-01f,
  8.577086926e-01f, 5.141359568e-01f, 9.854553938e-01f, 1.699342877e-01f, 9.985423684e-01f, 5.397376046e-02f, 9.998542070e-01f, 1.707546785e-02f,
  2.212675661e-02f, -9.997551441e-01f, 1.135217771e-01f, -9.935355186e-01f, 7.086697817e-01f, -7.055402994e-01f, -1.676606387e-01f, 9.858447909e-01f,
  8.525245190e-01f, 5.226872563e-01f, 9.849131107e-01f, 1.730497181e-01f, 9.984878898e-01f, 5.497227982e-02f, 9.998487830e-01f, 1.739165001e-02f,
  8.532201052e-01f, -5.215510130e-01f, 4.168670774e-01f, -9.089674354e-01f, 7.755658031e-01f, -6.312667131e-01f, -1.987468749e-01f, 9.800508618e-01f,
  8.472551107e-01f, 5.311862230e-01f, 9.843609333e-01f, 1.761634201e-01f, 9.984323978e-01f, 5.597073585e-02f, 9.998431802e-01f, 1.770782843e-02f,
  8.998668194e-01f, 4.361647666e-01f, 6.788702011e-01f, -7.342582941e-01f, 8.347129226e-01f, -5.506852865e-01f, -2.296342701e-01f, 9.732769728e-01f,
  8.419010043e-01f, 5.396320224e-01f, 9.837989211e-01f, 1.792753637e-01f, 9.983759522e-01f, 5.696914345e-02f, 9.998375773e-01f, 1.802400686e-02f,
  1.191801354e-01f, 9.928726554e-01f, 8.735505342e-01f, -4.867334962e-01f, 8.855196238e-01f, -4.646020234e-01f, -2.602920532e-01f, 9.655299187e-01f,
  8.364626765e-01f, 5.480239391e-01f, 9.832270741e-01f, 1.823855042e-01f, 9.983184934e-01f, 5.796748772e-02f, 9.998317957e-01f, 1.834018156e-02f,
  -7.710801959e-01f, 6.367380023e-01f, 9.816020727e-01f, -1.909380108e-01f, 9.274784923e-01f, -3.738765717e-01f, -2.906895578e-01f, 9.568174481e-01f,
  8.309407234e-01f, 5.563610196e-01f, 9.826454520e-01f, 1.854938269e-01f, 9.982600212e-01f, 5.896577984e-02f, 9.998259544e-01f, 1.865635626e-02f,
  -9.524129629e-01f, -3.048106134e-01f, 9.923083186e-01f, 1.237909496e-01f, 9.601702690e-01f, -2.794154882e-01f, -3.207964003e-01f, 9.471482038e-01f,
  8.253356218e-01f, 5.646424294e-01f, 9.820539355e-01f, 1.886002868e-01f, 9.982005358e-01f, 5.996400863e-02f, 9.998199940e-01f, 1.897252724e-02f,
  -2.581016421e-01f, -9.661177993e-01f, 9.046075940e-01f, 4.262454212e-01f, 9.832684398e-01f, -1.821625978e-01f, -3.505824506e-01f, 9.365318418e-01f,
  8.196480274e-01f, 5.728674531e-01f, 9.814526439e-01f, 1.917048544e-01f, 9.981400967e-01f, 6.096218154e-02f, 9.998139739e-01f, 1.928869821e-02f,
  6.735071540e-01f, -7.391806841e-01f, 7.271980643e-01f, 6.864276528e-01f, 9.965420961e-01f, -8.308912069e-02f, -3.800179660e-01f, 9.249790907e-01f,
  8.138784766e-01f, 5.810351372e-01f, 9.808415174e-01f, 1.948075294e-01f, 9.980786443e-01f, 6.196028739e-02f, 9.998078346e-01f, 1.960486546e-02f,
  9.858965874e-01f, 1.673557013e-01f, 4.776714444e-01f, 8.785385489e-01f, 9.998586178e-01f, 1.681409031e-02f, -4.090735018e-01f, 9.125014544e-01f,
  8.080275059e-01f, 5.891447663e-01f, 9.802205563e-01f, 1.979082376e-01f, 9.980161786e-01f, 6.295833737e-02f, 9.998015761e-01f, 1.992103085e-02f,
};
#define XB_TMO      128
#define XB_XCNT(j)  (256  + 64 * (j))
#define XB_XSUB(j)  (1280 + 64 * (j))
#define XB_XGEN(j)  (2304 + 64 * (j))
#define XB_TOP      3328
#define XB_TOPGEN   3392
#define XCD_BAR_WORDS 3456
#define XB_SPIN_CAP (1u << 18)
#define LAS __attribute__((address_space(3)))

__device__ __forceinline__ unsigned xb_ld(unsigned* p)              { return __hip_atomic_load(p, __ATOMIC_RELAXED, __HIP_MEMORY_SCOPE_AGENT); }
__device__ __forceinline__ unsigned xb_add(unsigned* p, unsigned v) { return __hip_atomic_fetch_add(p, v, __ATOMIC_RELAXED, __HIP_MEMORY_SCOPE_AGENT); }
__device__ __forceinline__ unsigned xb_xcc_id() { return (unsigned)__builtin_amdgcn_s_getreg((3 << 11) | 20) & 0xFu; }
#define XB_SPIN(cond, bar) do { unsigned _sp = 0; while (cond) { __builtin_amdgcn_s_sleep(1); \
    if ((++_sp & 255u) == 0u) { if (xb_ld(&(bar)[XB_TMO])) break; if (_sp > XB_SPIN_CAP) { atomicAdd(&(bar)[XB_TMO], 1u); break; } } } } while (0)

struct XcdBarrier {
    unsigned* bar; unsigned x;
    volatile LAS unsigned* st;
};

__device__ __forceinline__ XcdBarrier xcd_barrier_post(unsigned* bar, volatile LAS unsigned* st) {
    XcdBarrier b; b.bar = bar; b.x = xb_xcc_id(); b.st = st;
    if (threadIdx.x == 0) (void)xb_add(&bar[XB_XCNT(b.x)], 1u);
    return b;
}
__device__ __forceinline__ void xcd_barrier_complete(unsigned* bar, unsigned x, unsigned& nloc, unsigned& nx) {
    const unsigned G = gridDim.x * gridDim.y * gridDim.z;
    unsigned sum, cnt, mine, sp = 0u;
    for (;;) {
        sum = 0u; cnt = 0u; mine = 0u;
#pragma unroll
        for (unsigned j = 0; j < 16; ++j) { const unsigned c = xb_ld(&bar[XB_XCNT(j)]); sum += c; cnt += (c > 0u) ? 1u : 0u; mine = (j == x) ? c : mine; }
        if (sum == G) break;
        __builtin_amdgcn_s_sleep(1);
        if ((++sp & 255u) == 0u) { if (xb_ld(&bar[XB_TMO])) break; if (sp > XB_SPIN_CAP) { atomicAdd(&bar[XB_TMO], 1u); break; } }
    }
    nloc = mine > 0u ? mine : 1u; nx = cnt > 0u ? cnt : 1u;
}

__device__ __forceinline__ void xcd_barrier(const XcdBarrier& b, const bool t0  ) {
    asm volatile("s_waitcnt vmcnt(0)" ::: "memory");
    __syncthreads();
    if (t0) {
        unsigned* bar = b.bar;
        __builtin_amdgcn_s_waitcnt(0);
        unsigned nloc = b.st[0], nx = b.st[1];
        if (nloc == 0u) { xcd_barrier_complete(bar, b.x, nloc, nx); b.st[0] = nloc; b.st[1] = nx; }
        const unsigned old = xb_add(&bar[XB_XSUB(b.x)], 1u);
        const unsigned gen = old / nloc;
        if (old + 1u == (gen + 1u) * nloc) {
            __builtin_amdgcn_fence(__ATOMIC_RELEASE, "agent");
            asm volatile("s_waitcnt vmcnt(0)" ::: "memory");
            const unsigned og = xb_add(&bar[XB_TOP], 1u);
            const unsigned tg = og / nx;
            if (og + 1u == (tg + 1u) * nx) xb_add(&bar[XB_TOPGEN], 1u);
            else XB_SPIN(xb_ld(&bar[XB_TOPGEN]) == tg, bar);
            __builtin_amdgcn_fence(__ATOMIC_ACQUIRE, "agent");
            xb_add(&bar[XB_XGEN(b.x)], 1u);
            asm volatile("s_waitcnt vmcnt(0)" ::: "memory");
        } else {
            XB_SPIN(xb_ld(&bar[XB_XGEN(b.x)]) == gen, bar);
            __builtin_amdgcn_fence(__ATOMIC_ACQUIRE, "agent");
            asm volatile("s_waitcnt vmcnt(0)" ::: "memory");
        }
    }
    __syncthreads();
}

DI void conv_fetch(const float* __restrict__ src, int K, int N, int k0, int n0, f32x4 (&v)[2], int tid) {
#pragma unroll
    for (int i = 0; i < 2; ++i) {
        const int idx = tid + NTHREADS * i, kr = idx >> 4, c4 = (idx & 15) * 4;
        v[i] = (f32x4){0.f, 0.f, 0.f, 0.f};
        if (n0 + c4 < N) v[i] = __builtin_nontemporal_load((const f32x4*)(src + (size_t)(k0 + kr) * N + n0 + c4));
    }
}
DI void conv_put(const f32x4 (&v)[2], float* lds, int tid) {
#pragma unroll
    for (int i = 0; i < 2; ++i) {
        const int idx = tid + NTHREADS * i, kr = idx >> 4, c4 = (idx & 15) * 4;
        float* d = lds + kr * 65 + c4;
        d[0] = v[i].x; d[1] = v[i].y; d[2] = v[i].z; d[3] = v[i].w;
    }
}
typedef float f32x2_8 __attribute__((ext_vector_type(2)));
DI unsigned cvt_fp8x4(float a, float b, float c, float d) { int w = __builtin_amdgcn_cvt_pk_fp8_f32(a, b, 0, false); w = __builtin_amdgcn_cvt_pk_fp8_f32(c, d, w, true); return (unsigned)w; }
template <bool NT, bool FP8>
DI void conv_store(int K, bf16_t* __restrict__ dst, int k0, int ndst0, int nstep, const float* lds, int tid) {
    const int idx = tid, n = idx >> 3, kc = idx & 7;
    float f[8];
#pragma unroll
    for (int j = 0; j < 8; ++j) f[j] = lds[(kc * 8 + j) * 65 + n];
    const size_t e = (size_t)(ndst0 + (n & 31) + (n >> 5) * nstep) * K + k0 + kc * 8;
    if (FP8) {
        u32x2 w; w.x = cvt_fp8x4(f[0] * 32.f, f[1] * 32.f, f[2] * 32.f, f[3] * 32.f); w.y = cvt_fp8x4(f[4] * 32.f, f[5] * 32.f, f[6] * 32.f, f[7] * 32.f);
        u32x2* d = (u32x2*)((unsigned char*)dst + e);
        if (NT) __builtin_nontemporal_store(w, d); else *d = w;
    } else {
        u32x4* d = (u32x4*)(dst + e);
        if (NT) __builtin_nontemporal_store(pack8(f), d); else *d = pack8(f);
    }
}
template <bool NT = true, bool FP8 = false>
DI void conv_job(const float* src, int count, int K, int N, int Npad, bf16_t* dst, int perm  , int& base, float* lds, int bid, int nb, int tid) {
    const int tk = K / 64, tn = Npad / 64, per = tk * tn, total = count * per;
    int t = (bid - (base % nb) + nb) % nb;
    f32x4 rg[4][2];
    auto fetch4 = [&](int tt) {
#pragma unroll
        for (int q = 0; q < 4; ++q) {
            const int tq = tt + q * nb;
            if (tq < total) { const int mi = tq / per, rem = tq - mi * per, nt = rem / tk, kt = rem - nt * tk;
                conv_fetch(src + (size_t)mi * K * N, K, N, kt * 64, nt * 64, rg[q], tid); }
        }
    };
    if (t < total) fetch4(t);
    for (; t < total; t += 4 * nb) {
#pragma unroll
        for (int q = 0; q < 4; ++q) if (t + q * nb < total) conv_put(rg[q], lds + q * 4160, tid);
        __syncthreads();
        if (t + 4 * nb < total) fetch4(t + 4 * nb);
#pragma unroll
        for (int q = 0; q < 4; ++q) {
            const int tq = t + q * nb;
            if (tq < total) { const int mi = tq / per, rem = tq - mi * per, nt = rem / tk, kt = rem - nt * tk, n0 = nt * 64;
                int nd0 = n0, nstep = 32;
                if (perm == 1) nd0 = ((n0 & 255) >> 7) * 256 + (n0 >> 8) * 128 + (n0 & 127);
                else if (n0 < perm) { const int hg = n0 >> 6; nd0 = (hg >> 2) * 256 + (hg & 3) * 32; nstep = 128; }
                conv_store<NT, FP8>(K, FP8 ? (bf16_t*)((unsigned char*)dst + (size_t)mi * Npad * K) : dst + (size_t)mi * Npad * K, kt * 64, nd0, nstep, lds + q * 4160, tid); }
        }
        __syncthreads();
    }
    base += total;
}

DI int mla_col(bool uq, int r) {
    const int hw = uq ? 96 : 128;
    if (r < 1024) { const int pn = r >> 8, bj = (r >> 7) & 1, wc = (r >> 5) & 3, d = r & 31; return (4 * pn + wc) * hw + 32 * bj + d; }
    const int rr = r - 1024;
    if (uq) { const int head = rr >> 5, c = rr & 31, dim = (c >> 3) * 4 + (c & 3) + 16 * ((c >> 2) & 1); return head * 96 + 64 + dim; }
    return (rr >> 6) * 128 + 64 + (rr & 63);
}
DI void phase_prologue(const Params& p, float* lds, int bid, int nb, int tid) {
    bf16_t* ws16 = (bf16_t*)p.ws;
    int base = 0;
    conv_job<true, true>(p.in[13], 1, 1024, 3072, 3072, (bf16_t*)(p.ws + W_QKV0), 2048, base, lds, bid, nb, tid);
    conv_job<true, true>(p.in[14], 1, 1024, 1024, 1024, (bf16_t*)(p.ws + W_O0), 0, base, lds, bid, nb, tid);
    conv_job<true, true>(p.in[18], 1, 1024, 1536, 1536, (bf16_t*)(p.ws + W_QKV1), 1280, base, lds, bid, nb, tid);
    conv_job<true, true>(p.in[19], 1, 1024, 1024, 1024, (bf16_t*)(p.ws + W_O1), 0, base, lds, bid, nb, tid);
    conv_job<true, true>(p.in[23], 1, 1024, 672, 768, (bf16_t*)(p.ws + W_DQKV), 0, base, lds, bid, nb, tid);
    for (int i = bid * NTHREADS + tid; i < 1536 * 64 + 2048 * 32; i += nb * NTHREADS) {
        const bool uq = i < 1536 * 64;
        const int K = uq ? 384 : 256, KB = uq ? 512 : 256, kc = KB / 8, ii = uq ? i : i - 1536 * 64, r = ii / kc, k0 = (ii - r * kc) * 8, nsrc = uq ? 1536 : 2048;
        u32x2 w8 = {0u, 0u};
        if (k0 < K) {
            const int col = mla_col(uq, r);
            const float* src = p.in[uq ? 26 : 27] + (size_t)k0 * nsrc + col;
            float f[8];
#pragma unroll
            for (int j = 0; j < 8; ++j) f[j] = src[(size_t)j * nsrc] * 32.f;
            w8.x = cvt_fp8x4(f[0], f[1], f[2], f[3]); w8.y = cvt_fp8x4(f[4], f[5], f[6], f[7]);
        }
        *(u32x2*)(p.ws + (uq ? W_UQ : W_UKV) + (size_t)r * KB + k0) = w8;
    }
    conv_job<true, true>(p.in[30], 1, 1024, 1024, 1024, (bf16_t*)(p.ws + W_O2), 0, base, lds, bid, nb, tid);
    conv_job<true, true>(p.in[31], 1, 1024, 3072, 3072, (bf16_t*)(p.ws + W_QKV3), 2048, base, lds, bid, nb, tid);
    conv_job<true, true>(p.in[36], 1, 1024, 1024, 1024, (bf16_t*)(p.ws + W_O3), 0, base, lds, bid, nb, tid);
    conv_job<true, true>(p.in[11], 32, 1024, 512, 512, (bf16_t*)(p.ws + W_GU), 1, base, lds, bid, nb, tid);
    conv_job(p.in[12], 32, 256, 1024, 1024, (bf16_t*)(p.ws + W_DN), 0, base, lds, bid, nb, tid);
    (void)ws16;
    float* sc = lds;
    for (int i = tid; i < 9 * 1024; i += NTHREADS) {
        const int r = i >> 10, k = i & 1023;
        const float v = r < 8 ? p.in[1][r * 1024 + k] : p.in[3][k];
        sc[i] = silu_f(v);
    }
    __syncthreads();
    float* part = (float*)(p.ws + WS_MODP);
    for (int it = bid; it < 768; it += nb) {
        const int kc = it / 48, rem = it - kc * 48, l = rem / 12, nch = rem - l * 12;
        const int n = nch * 512 + tid;
        const float* w = p.in[4] + ((size_t)l * 1024 + kc * 64) * 6144 + n;
        float acc[9];
#pragma unroll
        for (int r = 0; r < 9; ++r) acc[r] = 0.f;
#pragma unroll 8
        for (int k = 0; k < 64; ++k) {
            const float wv = __builtin_nontemporal_load(w + (size_t)k * 6144);
#pragma unroll
            for (int r = 0; r < 9; ++r) acc[r] += sc[r * 1024 + kc * 64 + k] * wv;
        }
#pragma unroll
        for (int r = 0; r < 9; ++r) part[(((size_t)kc * 4 + l) * 9 + r) * 6144 + n] = acc[r];
    }
    __syncthreads();
}
DI void phase_mod_reduce(const Params& p, int bid, int nb, int tid) {
    const float* part = (const float*)(p.ws + WS_MODP);
    float* mod = (float*)(p.ws + WS_MOD);
    const int total = 4 * 9 * 6144;
    for (int i = bid * NTHREADS + tid; i < total; i += nb * NTHREADS) {
        const int l = i / (9 * 6144), n = i % 6144;
        float s = p.in[5][l * 6144 + n];
#pragma unroll
        for (int kc = 0; kc < 16; ++kc) s += part[(size_t)kc * total + i];
        mod[i] = s;
    }
}

template <int MODE>
DI void phase_rows(const Params& p, int layer  , int which  , int bid, int nb, int tid) {
    const int wid = __builtin_amdgcn_readfirstlane(tid >> 6), lane = tid & 63;
    const float* modall = (const float*)(p.ws + WS_MOD);
    const bf16_t* eo = (const bf16_t*)(p.ws + WS_RAW);
    bf16_t* H = (bf16_t*)(p.ws + WS_H);
    const int rpw = (MROWS + nb * NW - 1) / (nb * NW), rbeg = (bid * NW + wid) * rpw, rend = min(MROWS, rbeg + rpw);
    int mr_have = -1;
    f32x4 g2v[4], gmv[4], shv[4];
    for (int r = rbeg; r < rend; ++r) {
        const int b = r / PP, pos = r - b * PP;
        if ((MODE & 16) && pos >= SEQ) continue;
        const int mr = pos < SEQ ? b : 8;
        if (mr != mr_have) {
            mr_have = mr;
            if (MODE & 1) { const float* g2 = modall + ((size_t)(layer - ((MODE & 2) ? 1 : 0)) * 9 + mr) * 6144 + 5120;
#pragma unroll
                for (int j = 0; j < 4; ++j) g2v[j] = *(const f32x4*)(g2 + lane * 4 + 256 * j) * (1.0f / 16.0f); }
            if (MODE & 2) { const float* ng = p.in[6] + ((size_t)layer * 2 + which) * 1024; const float* md = modall + ((size_t)layer * 9 + mr) * 6144 + which * 3072;
#pragma unroll
                for (int j = 0; j < 4; ++j) { const f32x4 g = *(const f32x4*)(ng + lane * 4 + 256 * j), sc = *(const f32x4*)(md + 1024 + lane * 4 + 256 * j);
                    shv[j] = *(const f32x4*)(md + lane * 4 + 256 * j); gmv[j] = (f32x4){g.x * (1.0f + sc.x), g.y * (1.0f + sc.y), g.z * (1.0f + sc.z), g.w * (1.0f + sc.w)}; } }
        }
        bf16_t* xb = xb_row(p, r);
        float x[16];
        if (MODE & 8) {
            const float* xr = pos < SEQ ? p.in[0] + ((size_t)b * SEQ + pos) * DM : p.in[2] + ((size_t)b * CTXL + (pos - SEQ)) * DM;
#pragma unroll
            for (int j = 0; j < 4; ++j) { const f32x4 v = *(const f32x4*)(xr + lane * 4 + 256 * j); x[4 * j] = v.x; x[4 * j + 1] = v.y; x[4 * j + 2] = v.z; x[4 * j + 3] = v.w; }
        } else {
#pragma unroll
            for (int j = 0; j < 4; ++j) { const u32x2 v = *(const u32x2*)(xb + lane * 4 + 256 * j); x[4 * j] = bflo(v.x); x[4 * j + 1] = bfhi(v.x); x[4 * j + 2] = bflo(v.y); x[4 * j + 3] = bfhi(v.y); }
        }
        if (MODE & 1) {
            const unsigned char* y0 = (const unsigned char*)eo + (size_t)(2 * r) * 1024, *y1 = y0 + 1024;
#pragma unroll
            for (int j = 0; j < 4; ++j) {
                const unsigned a = *(const unsigned*)(y0 + lane * 4 + 256 * j), bb = *(const unsigned*)(y1 + lane * 4 + 256 * j);
                const f32x4 g = g2v[j];
                const f32x2_8 a01 = __builtin_amdgcn_cvt_pk_f32_fp8((int)a, false), a23 = __builtin_amdgcn_cvt_pk_f32_fp8((int)a, true);
                const f32x2_8 b01 = __builtin_amdgcn_cvt_pk_f32_fp8((int)bb, false), b23 = __builtin_amdgcn_cvt_pk_f32_fp8((int)bb, true);
                x[4 * j] += g.x * (a01[0] + b01[0]); x[4 * j + 1] += g.y * (a01[1] + b01[1]);
                x[4 * j + 2] += g.z * (a23[0] + b23[0]); x[4 * j + 3] += g.w * (a23[1] + b23[1]);
            }
        }
        if (MODE & 16) {
            float* orow = p.out + ((size_t)b * SEQ + pos) * DM;
#pragma unroll
            for (int j = 0; j < 4; ++j) *(f32x4*)(orow + lane * 4 + 256 * j) = (f32x4){x[4 * j], x[4 * j + 1], x[4 * j + 2], x[4 * j + 3]};
        } else if (MODE & (1 | 8)) {
#pragma unroll
            for (int j = 0; j < 4; ++j) {
                u32x2 w; w.x = pk2(x[4 * j], x[4 * j + 1]); w.y = pk2(x[4 * j + 2], x[4 * j + 3]);
                *(u32x2*)(xb + lane * 4 + 256 * j) = w;
                x[4 * j] = bflo(w.x); x[4 * j + 1] = bfhi(w.x); x[4 * j + 2] = bflo(w.y); x[4 * j + 3] = bfhi(w.y);
            }
        }
        if (MODE & 2) {
            float ss = 0.f;
#pragma unroll
            for (int i = 0; i < 16; ++i) ss += x[i] * x[i];
            ss = wave_sum(ss);
            const float rs = rsqrtf(ss * (1.0f / 1024.0f) + EPS);
#pragma unroll
            for (int j = 0; j < 4; ++j) {
                const f32x4 g = gmv[j], sh = shv[j];
                const float h0 = x[4 * j] * rs * g.x + sh.x, h1 = x[4 * j + 1] * rs * g.y + sh.y;
                const float h2 = x[4 * j + 2] * rs * g.z + sh.z, h3 = x[4 * j + 3] * rs * g.w + sh.w;
                if (MODE & 32) *(unsigned*)((unsigned char*)H + (size_t)r * 1024 + lane * 4 + 256 * j) = cvt_fp8x4(h0, h1, h2, h3);
                else { u32x2 w; w.x = pk2(h0, h1); w.y = pk2(h2, h3); *(u32x2*)(H + (size_t)r * 1024 + lane * 4 + 256 * j) = w; }
            }
        }
    }
}

constexpr size_t WS_RC = WS_MOD + 917504;
DI void phase_router_prep(const Params& p, int bid, int nb, int tid) {
    const float* modall = (const float*)(p.ws + WS_MOD);
    bf16_t* wth = (bf16_t*)(p.ws + WS_RW); bf16_t* wtl = wth + 4 * 9 * 48 * 1024;
    const int total = 4 * 9 * 48 * 1024;
    for (int i = bid * NTHREADS + tid; i < total; i += nb * NTHREADS) {
        const int k = i & 1023, c = (i >> 10) % 48, lb = i / (48 * 1024), l = lb / 9, b = lb - l * 9;
        float v = 0.f;
        if (c < 36) {
            const float w = c < 32 ? p.in[9][((size_t)l * 1024 + k) * 32 + c] : p.in[7][((size_t)l * 1024 + k) * 4 + (c - 32)];
            v = p.in[6][((size_t)l * 2 + 1) * 1024 + k] * (1.0f + modall[((size_t)l * 9 + b) * 6144 + 4096 + k]) * w;
        }
        const unsigned hb = f2bf(v); wth[i] = (bf16_t)hb; wtl[i] = (bf16_t)f2bf(v - bf2f(hb));
    }
    float* cst = (float*)(p.ws + WS_RC);
    const int wid = __builtin_amdgcn_readfirstlane(tid >> 6), lane = tid & 63;
    for (int j = bid * NW + wid; j < 4 * 9 * 48; j += nb * NW) {
        const int c = j % 48, lb = j / 48, l = lb / 9, b = lb - l * 9;
        float acc = 0.f;
        if (c < 36) {
            for (int k = lane; k < 1024; k += 64) {
                const float w = c < 32 ? p.in[9][((size_t)l * 1024 + k) * 32 + c] : p.in[7][((size_t)l * 1024 + k) * 4 + (c - 32)];
                acc += modall[((size_t)l * 9 + b) * 6144 + 3072 + k] * w;
            }
            acc = wave_sum(acc) + (c < 32 ? p.in[10][l * 32 + c] : p.in[8][l * 4 + (c - 32)]);
        }
        if (lane == 0) cst[j] = acc;
    }
}
typedef float f32x2_3 __attribute__((ext_vector_type(2)));
typedef __bf16 bf16x2_3 __attribute__((ext_vector_type(2)));
DI unsigned cvtpk3(float lo, float hi) { f32x2_3 v = {lo, hi}; bf16x2_3 b = __builtin_convertvector(v, bf16x2_3); return __builtin_bit_cast(unsigned, b); }
DI void phase_router(const Params& p, unsigned char* smem, int layer, bool skip_ctx, int bid, int nb, int tid) {
    const int lane = tid & 63, wid = __builtin_amdgcn_readfirstlane(tid >> 6), li = lane & 15, kq = lane >> 4;
    LAS float* tile = (LAS float*)smem + wid * (32 * 49);
    const bf16_t* wth_all = (const bf16_t*)(p.ws + WS_RW) + (size_t)layer * 9 * 48 * 1024;
    const bf16_t* wtl_all = wth_all + 4 * 9 * 48 * 1024;
    const float* cst_all = (const float*)(p.ws + WS_RC) + layer * 9 * 48;
    unsigned* cnt = (unsigned*)(p.ws + WS_CTL) + CW_CNT + layer * 32;
    unsigned* list = (unsigned*)(p.ws + WS_LIST);
    float* gates = (float*)(p.ws + WS_GATE);
    if (layer > 0) {
        int base = 0;
        conv_job<false, true>(p.in[11] + (size_t)layer * 32 * 1024 * 512, 32, 1024, 512, 512, (bf16_t*)(p.ws + W_GU + (size_t)layer * 32 * 512 * 1024), 1, base, (float*)smem, bid, nb, tid);
        conv_job<false>(p.in[12] + (size_t)layer * 32 * 256 * 1024, 32, 256, 1024, 1024, (bf16_t*)(p.ws + W_DN) + (size_t)layer * 32 * 1024 * 256, 0, base, (float*)smem, bid, nb, tid);
    }
    for (int u = bid * NW + wid; u < MROWS / 32; u += nb * NW) {
        const int r0 = u * 32, b = r0 / PP, pos = r0 - b * PP;
        const bool isctx = pos >= SEQ;
        if (skip_ctx && isctx) continue;
        const int mr = isctx ? 8 : b;
        const bf16_t* xr = xb_row(p, r0 + li) + 8 * kq;
        const bf16_t* wh = wth_all + ((size_t)mr * 48 + li) * 1024 + 8 * kq;
        const bf16_t* wl = wtl_all + ((size_t)mr * 48 + li) * 1024 + 8 * kq;
        f32x4 acc[2][3];
#pragma unroll
        for (int m = 0; m < 2; ++m)
#pragma unroll
            for (int n = 0; n < 3; ++n) acc[m][n] = (f32x4){0.f, 0.f, 0.f, 0.f};
        float ss[2] = {0.f, 0.f};
#pragma unroll 2
        for (int s = 0; s < 32; ++s) {
            bf16x8 xa[2], bh[3], bl[3];
#pragma unroll
            for (int m = 0; m < 2; ++m) xa[m] = *(const bf16x8*)(xr + (size_t)m * 16 * DM + 32 * s);
#pragma unroll
            for (int n = 0; n < 3; ++n) { bh[n] = *(const bf16x8*)(wh + (size_t)n * 16 * 1024 + 32 * s); bl[n] = *(const bf16x8*)(wl + (size_t)n * 16 * 1024 + 32 * s); }
#pragma unroll
            for (int m = 0; m < 2; ++m) {
                const u32x4 w = __builtin_bit_cast(u32x4, xa[m]);
                ss[m] += bflo(w.x) * bflo(w.x) + bfhi(w.x) * bfhi(w.x) + bflo(w.y) * bflo(w.y) + bfhi(w.y) * bfhi(w.y) + bflo(w.z) * bflo(w.z) + bfhi(w.z) * bfhi(w.z) + bflo(w.w) * bflo(w.w) + bfhi(w.w) * bfhi(w.w);
#pragma unroll
                for (int n = 0; n < 3; ++n) {
                    acc[m][n] = __builtin_amdgcn_mfma_f32_16x16x32_bf16(xa[m], bl[n], acc[m][n], 0, 0, 0);
                    acc[m][n] = __builtin_amdgcn_mfma_f32_16x16x32_bf16(xa[m], bh[n], acc[m][n], 0, 0, 0);
                }
            }
        }
#pragma unroll
        for (int m = 0; m < 2; ++m) { ss[m] += __shfl_xor(ss[m], 16); ss[m] += __shfl_xor(ss[m], 32); }
#pragma unroll
        for (int m = 0; m < 2; ++m)
#pragma unroll
            for (int n = 0; n < 3; ++n)
#pragma unroll
                for (int i = 0; i < 4; ++i) tile[(16 * m + 4 * kq + i) * 49 + n * 16 + li] = acc[m][n][i];
        __builtin_amdgcn_s_waitcnt(0xc07f);
        const float ssr = (lane & 16) ? ss[1] : ss[0];
        const float rs = rsqrtf(ssr * (1.0f / 1024.0f) + EPS);
        if (lane < 32) {
            const float* cst = cst_all + mr * 48;
            const LAS float* tr = tile + lane * 49;
            float lg[4];
#pragma unroll
            for (int c = 0; c < 4; ++c) lg[c] = tr[32 + c] * rs + cst[32 + c];
            int gi = 0; float gm = lg[0];
#pragma unroll
            for (int c = 1; c < 4; ++c) if (lg[c] > gm) { gm = lg[c]; gi = c; }
            float gden = 0.f;
#pragma unroll
            for (int c = 0; c < 4; ++c) gden += __expf(lg[c] - gm);
            const float gw = 1.0f / gden;
            float le[8];
#pragma unroll
            for (int c = 0; c < 8; ++c) le[c] = tr[gi * 8 + c] * rs + cst[gi * 8 + c];
            int e0 = 0; float m0 = le[0];
#pragma unroll
            for (int c = 1; c < 8; ++c) if (le[c] > m0) { m0 = le[c]; e0 = c; }
            int e1 = -1; float m1 = -INFINITY;
#pragma unroll
            for (int c = 0; c < 8; ++c) if (c != e0 && le[c] > m1) { m1 = le[c]; e1 = c; }
            const float q1 = __expf(m1 - m0), inv = 1.0f / (1.0f + q1);
            const int r = r0 + lane, ex0 = gi * 8 + e0, ex1 = gi * 8 + e1;
            const unsigned s0 = atomicAdd(cnt + ex0, 1u), s1 = atomicAdd(cnt + ex1, 1u);
            list[(size_t)ex0 * MROWS + s0] = 2u * r; list[(size_t)ex1 * MROWS + s1] = 2u * r + 1u;
            gates[2 * r] = gw * inv; gates[2 * r + 1] = gw * q1 * inv;
        }
        {
            const float* ng = p.in[6] + ((size_t)layer * 2 + 1) * 1024;
            const float* md = (const float*)(p.ws + WS_MOD) + ((size_t)layer * 9 + mr) * 6144 + 3072;
            f32x4 gm[4], sh[4];
#pragma unroll
            for (int j = 0; j < 4; ++j) {
                const f32x4 g = *(const f32x4*)(ng + lane * 4 + 256 * j), sc = *(const f32x4*)(md + 1024 + lane * 4 + 256 * j);
                sh[j] = *(const f32x4*)(md + lane * 4 + 256 * j);
                gm[j] = (f32x4){g.x * (1.0f + sc.x), g.y * (1.0f + sc.y), g.z * (1.0f + sc.z), g.w * (1.0f + sc.w)};
            }
            unsigned char* H8 = p.ws + WS_H;
#pragma unroll 4
            for (int i = 0; i < 32; ++i) {
                const float rsi = __shfl(rs, i);
                const bf16_t* xb = xb_row(p, r0 + i);
#pragma unroll
                for (int j = 0; j < 4; ++j) {
                    const u32x2 v = *(const u32x2*)(xb + lane * 4 + 256 * j);
                    *(unsigned*)(H8 + (size_t)(r0 + i) * 1024 + lane * 4 + 256 * j) =
                        cvt_fp8x4(bflo(v.x) * rsi * gm[j].x + sh[j].x, bfhi(v.x) * rsi * gm[j].y + sh[j].y, bflo(v.y) * rsi * gm[j].z + sh[j].z, bfhi(v.y) * rsi * gm[j].w + sh[j].w);
                }
            }
        }
    }
}

#define MFMA32(a, b, c) __builtin_amdgcn_mfma_f32_32x32x16_bf16((a), (b), (c), 0, 0, 0)
typedef LAS unsigned char* lds_ptr;
constexpr int GEMM_TM = 256, GEMM_TN = 256;
constexpr int GEMM_STAGE = 65536;
constexpr int GEMM_LDS = 2 * GEMM_STAGE;
constexpr int GEMM_MT = 4;

struct RowDense { static constexpr bool DENSE = true; const bf16_t* A; int lda; int m0; DI unsigned row(int i) const { return (unsigned)(m0 + i) * (unsigned)lda; } };
struct RowGather { static constexpr bool DENSE = false; const bf16_t* A; int lda; const unsigned* ent; int valid; int shift;
    DI unsigned row(int i) const { const unsigned e = ent[i < valid ? i : valid - 1]; return (e >> shift) * (unsigned)lda; } };

struct EpiStore { bf16_t* C; int ldc; int m0;
    DI void wave_tile(const f32x16 (&acc)[2][GEMM_MT], int mloc, int ncol, int lane) const {
        const int r = lane & 31, h = lane >> 5;
#pragma unroll
        for (int mt = 0; mt < GEMM_MT; ++mt) {
            bf16_t* c = C + (size_t)(m0 + mloc + mt * 32 + r) * ldc + ncol + 4 * h;
#pragma unroll
            for (int nt = 0; nt < 2; ++nt)
#pragma unroll
                for (int g = 0; g < 4; ++g) {
                    u32x2 w; w.x = pk2(acc[nt][mt][4 * g], acc[nt][mt][4 * g + 1]); w.y = pk2(acc[nt][mt][4 * g + 2], acc[nt][mt][4 * g + 3]);
                    *(u32x2*)(c + nt * 32 + 8 * g) = w;
                }
        }
    } };
struct EpiResid { const Params* p; const float* mod; int m0;
    DI void wave_tile(const f32x16 (&acc)[2][GEMM_MT], int mloc, int ncol, int lane) const {
        const int r = lane & 31, h = lane >> 5;
#pragma unroll
        for (int mt = 0; mt < GEMM_MT; ++mt) {
            const int row = m0 + mloc + mt * 32 + r;
            float* xr = xrow_ptr(*p, row) + ncol + 4 * h;
            const float* gp = mod + (size_t)mod_row(row) * 6144 + 2048 + ncol + 4 * h;
#pragma unroll
            for (int nt = 0; nt < 2; ++nt)
#pragma unroll
                for (int g = 0; g < 4; ++g) {
                    f32x4 x = *(f32x4*)(xr + nt * 32 + 8 * g);
                    const f32x4 gg = *(const f32x4*)(gp + nt * 32 + 8 * g);
                    x.x += gg.x * acc[nt][mt][4 * g]; x.y += gg.y * acc[nt][mt][4 * g + 1]; x.z += gg.z * acc[nt][mt][4 * g + 2]; x.w += gg.w * acc[nt][mt][4 * g + 3];
                    *(f32x4*)(xr + nt * 32 + 8 * g) = x;
                }
        }
    } };
struct EpiGlu { bf16_t* act; const unsigned* ent; const float* gates; int valid;
    DI void wave_tile(const f32x16 (&acc)[2][GEMM_MT], int mloc, int ncol, int lane) const {
        const int r = lane & 31, h = lane >> 5;
#pragma unroll
        for (int mt = 0; mt < GEMM_MT; ++mt) {
            const int i = mloc + mt * 32 + r;
            if (i < valid) {
                const unsigned a = ent[i];
                const float gw = gates[a];
                bf16_t* o = act + (size_t)a * DEXP + (ncol >> 6) * 32 + 4 * h;
#pragma unroll
                for (int g = 0; g < 4; ++g) {
                    float v[4];
#pragma unroll
                    for (int j = 0; j < 4; ++j) v[j] = silu_f(acc[0][mt][4 * g + j]) * acc[1][mt][4 * g + j] * gw;
                    u32x2 w; w.x = pk2(v[0], v[1]); w.y = pk2(v[2], v[3]);
                    *(u32x2*)(o + 8 * g) = w;
                }
            }
        }
    } };
struct EpiScatter { bf16_t* outp; const unsigned* ent; int valid;
    DI void wave_tile(const f32x16 (&acc)[2][GEMM_MT], int mloc, int ncol, int lane) const {
        const int r = lane & 31, h = lane >> 5;
#pragma unroll
        for (int mt = 0; mt < GEMM_MT; ++mt) {
            const int i = mloc + mt * 32 + r;
            if (i < valid) {
                bf16_t* c = outp + (size_t)ent[i] * 1024 + ncol + 4 * h;
#pragma unroll
                for (int nt = 0; nt < 2; ++nt)
#pragma unroll
                    for (int g = 0; g < 4; ++g) {
                        u32x2 w; w.x = pk2(acc[nt][mt][4 * g], acc[nt][mt][4 * g + 1]); w.y = pk2(acc[nt][mt][4 * g + 2], acc[nt][mt][4 * g + 3]);
                        *(u32x2*)(c + nt * 32 + 8 * g) = w;
                    }
            }
        }
    } };

#define SCHED_FENCE() __builtin_amdgcn_sched_barrier(0)
DI void glds16(const bf16_t* g, lds_ptr l) { __builtin_amdgcn_global_load_lds((const unsigned*)g, (LAS unsigned*)l, 16, 0, 0); }
template <int PROBE, int NAG>
DI void gemm_kstep(f32x16 (&acc)[2][GEMM_MT], const lds_ptr st, const unsigned (&arow)[GEMM_MT], const unsigned (&wrow)[2], const unsigned (&aswz)[GEMM_MT], const unsigned (&wswz)[2], int h,
                   bool issue, const bf16_t* __restrict__ An, const bf16_t* __restrict__ Wn, const unsigned (&ag)[NAG], unsigned astep, const unsigned (&bg)[2], unsigned bstep, const lds_ptr sn) {
    if (PROBE != 2 && issue) {
#pragma unroll
        for (int j = 0; j < 8; ++j) { glds16(An + (NAG == 2 ? ag[j & 1] + (j >> 1) * astep : ag[j % NAG]), sn + j * 1024); glds16(Wn + bg[j & 1] + (j >> 1) * bstep, sn + 32768 + j * 1024); }
    }
    if (PROBE == 1) return;
    bf16x8 af[2][GEMM_MT], wf[2][2];
#pragma unroll
    for (int t = 0; t < 2; ++t) wf[0][t] = *(const LAS bf16x8*)(st + wrow[t] + ((((unsigned)h) ^ wswz[t]) << 4));
#pragma unroll
    for (int t = 0; t < GEMM_MT; ++t) af[0][t] = *(const LAS bf16x8*)(st + arow[t] + ((((unsigned)h) ^ aswz[t]) << 4));
#pragma unroll
    for (int kk = 0; kk < 4; ++kk) {
        if (kk < 3) {
#pragma unroll
            for (int t = 0; t < 2; ++t) wf[(kk + 1) & 1][t] = *(const LAS bf16x8*)(st + wrow[t] + ((((unsigned)((kk + 1) * 2 + h)) ^ wswz[t]) << 4));
#pragma unroll
            for (int t = 0; t < GEMM_MT; ++t) af[(kk + 1) & 1][t] = *(const LAS bf16x8*)(st + arow[t] + ((((unsigned)((kk + 1) * 2 + h)) ^ aswz[t]) << 4));
        }
        SCHED_FENCE();
        __builtin_amdgcn_s_setprio(1);
#pragma unroll
        for (int mt = 0; mt < GEMM_MT; ++mt)
#pragma unroll
            for (int nt = 0; nt < 2; ++nt) acc[nt][mt] = MFMA32(wf[kk & 1][nt], af[kk & 1][mt], acc[nt][mt]);
        __builtin_amdgcn_s_setprio(0);
        SCHED_FENCE();
    }
}
template <class RowSrc, class Epi, int PROBE = 0>
DI void gemm_tile_mfma(unsigned char* smem, const RowSrc& rs, const bf16_t* __restrict__ Wt, int K, int n0, const Epi& epi, int tid) {
    const lds_ptr lds = (lds_ptr)smem;
    const int lane = tid & 63, wid = __builtin_amdgcn_readfirstlane(tid >> 6), wm = wid & 1, wn = wid >> 1, r = lane & 31, h = lane >> 5;
    const bool loader = wid < 4;
    const int lw = wid & 3;
    constexpr int NAG = RowSrc::DENSE ? 2 : 8;
    unsigned ag[NAG], bg[2];
    const bf16_t* __restrict__ Ab = rs.A;
#pragma unroll
    for (int j = 0; j < NAG; ++j) {
        const int row = (lw * 8 + j) * 8 + (lane >> 3), c = (lane & 7) ^ ((row >> 1) & 7);
        ag[j] = rs.row(row) + c * 8;
    }
#pragma unroll
    for (int j = 0; j < 2; ++j) {
        const int row = (lw * 8 + j) * 8 + (lane >> 3), c = (lane & 7) ^ ((row >> 1) & 7);
        bg[j] = (unsigned)(n0 + row) * (unsigned)K + c * 8;
    }
    const unsigned astep = 16u * (unsigned)rs.lda, bstep = 16u * (unsigned)K;
    const unsigned dmaoff = (unsigned)lw * 8192u;
    unsigned arow[GEMM_MT], wrow[2], aswz[GEMM_MT], wswz[2];
#pragma unroll
    for (int t = 0; t < GEMM_MT; ++t) { const int ra = wm * 128 + t * 32 + r; arow[t] = ra * 128; aswz[t] = (ra >> 1) & 7; }
#pragma unroll
    for (int t = 0; t < 2; ++t) { const int rw = wn * 64 + t * 32 + r; wrow[t] = 32768 + rw * 128; wswz[t] = (rw >> 1) & 7; }
    f32x16 acc[2][GEMM_MT];
#pragma unroll
    for (int a = 0; a < 2; ++a)
#pragma unroll
        for (int b = 0; b < GEMM_MT; ++b)
#pragma unroll
            for (int i = 0; i < 16; ++i) acc[a][b][i] = 0.f;
    if (loader) {
#pragma unroll
        for (int j = 0; j < 8; ++j) { glds16(Ab + (NAG == 2 ? ag[j & 1] + (j >> 1) * astep : ag[j % NAG]), lds + dmaoff + j * 1024); glds16(Wt + bg[j & 1] + (j >> 1) * bstep, lds + 32768 + dmaoff + j * 1024); }
    }
    asm volatile("s_waitcnt vmcnt(0)" ::: "memory");
    __syncthreads();
    const int KT = K >> 6;
    for (int kt = 0; kt < KT; ++kt) {
        gemm_kstep<PROBE, NAG>(acc, lds + (kt & 1) * GEMM_STAGE, arow, wrow, aswz, wswz, h, loader && kt + 1 < KT, Ab + (kt + 1) * 64, Wt + (kt + 1) * 64, ag, astep, bg, bstep, lds + ((kt + 1) & 1) * GEMM_STAGE + dmaoff);
        asm volatile("s_waitcnt vmcnt(0)" ::: "memory");
        __syncthreads();
    }
    if (PROBE == 0 || acc[0][0][0] == 12345.678f) epi.wave_tile(acc, wm * 128, n0 + wn * 64, lane);
}

template <int EPIK, int PROBE = 0>
DI void gemm_dense(const Params& p, unsigned char* smem, const bf16_t* A, int lda, const bf16_t* Wt, int K, int N, bf16_t* C, int ldc, const float* mod, int bid, int nb, int tid) {
    const int tn = N / GEMM_TN, total = (MROWS / GEMM_TM) * tn;
    for (int t = bid; t < total; t += nb) {
        const int mt = t / tn, nt = t - mt * tn;
        RowDense rs{A, lda, mt * GEMM_TM};
        if (EPIK == 0) { EpiStore e{C, ldc, mt * GEMM_TM}; gemm_tile_mfma<RowDense, EpiStore, PROBE>(smem, rs, Wt, K, nt * GEMM_TN, e, tid); }
        else { EpiResid e{&p, mod, mt * GEMM_TM}; gemm_tile_mfma(smem, rs, Wt, K, nt * GEMM_TN, e, tid); }
    }
}
template <int WHICH>
DI void gemm_moe(const Params& p, unsigned char* smem, int layer, int bid, int nb, int tid) {
    const unsigned* cnt = (const unsigned*)(p.ws + WS_CTL) + CW_CNT + layer * 32;
    const unsigned* list = (const unsigned*)(p.ws + WS_LIST);
    const float* gates = (const float*)(p.ws + WS_GATE);
    const bf16_t* H = (const bf16_t*)(p.ws + WS_H);
    bf16_t* act = (bf16_t*)(p.ws + WS_Q);
    bf16_t* eo = (bf16_t*)(p.ws + WS_RAW);
    constexpr int TN = WHICH == 0 ? 2 : 4;
    int total = 0;
    for (int e = 0; e < NEXP; ++e) total += (int)((cnt[e] + 255u) >> 8) * TN;
    for (int t = bid; t < total; t += nb) {
        int e = 0, rem = t;
        for (; e < NEXP; ++e) { const int te = (int)((cnt[e] + 255u) >> 8) * TN; if (rem < te) break; rem -= te; }
        const int rt = rem / TN, ct = rem - rt * TN;
        const unsigned* ent = list + (size_t)e * MROWS + rt * GEMM_TM;
        const int valid = min(GEMM_TM, (int)cnt[e] - rt * GEMM_TM);
        if (WHICH == 0) {
            RowGather rs{H, 1024, ent, valid, 1};
            EpiGlu ep{act, ent, gates, valid};
            gemm_tile_mfma(smem, rs, (const bf16_t*)(p.ws + W_GU) + ((size_t)layer * 32 + e) * 512 * 1024, 1024, ct * GEMM_TN, ep, tid);
        } else {
            RowGather rs{act, DEXP, ent, valid, 0};
            EpiScatter ep{eo, ent, valid};
            gemm_tile_mfma(smem, rs, (const bf16_t*)(p.ws + W_DN) + ((size_t)layer * 32 + e) * 1024 * 256, 256, ct * GEMM_TN, ep, tid);
        }
    }
}

DI float quad_sum(float v) { v += __shfl_xor(v, 1); v += __shfl_xor(v, 2); return v; }
DI void head64_norm_rope(const bf16_t* src, bf16_t* dst, const float* gain, int sub, bool rope, int prow, int pcol, float scale) {
    float a[8], b[8];
    unpack8(*(const u32x4*)(src + sub * 8), a); unpack8(*(const u32x4*)(src + 32 + sub * 8), b);
    float ss = 0.f;
#pragma unroll
    for (int e = 0; e < 8; ++e) ss += a[e] * a[e] + b[e] * b[e];
    ss = quad_sum(ss);
    const float rs = rsqrtf(ss * (1.0f / 64.0f) + EPS);
#pragma unroll
    for (int e = 0; e < 8; ++e) { a[e] *= rs * gain[sub * 8 + e]; b[e] *= rs * gain[32 + sub * 8 + e]; }
    if (rope) {
#pragma unroll
        for (int e = 0; e < 8; ++e) {
            const int i = sub * 8 + e;
            const float* cs = ROPE64 + ((i < 16 ? prow : pcol) * 16 + (i & 15)) * 2;
            const float c = cs[0], s = cs[1], x1 = a[e], x2 = b[e];
            a[e] = x1 * c - x2 * s; b[e] = x2 * c + x1 * s;
        }
    }
#pragma unroll
    for (int e = 0; e < 8; ++e) { a[e] *= scale; b[e] *= scale; }
    *(u32x4*)(dst + sub * 8) = pack8(a); *(u32x4*)(dst + 32 + sub * 8) = pack8(b);
}
template <int KIND>
DI void phase_post_qk(const Params& p, int bid, int nb, int tid) {
    const int wid = __builtin_amdgcn_readfirstlane(tid >> 6), lane = tid & 63, hd = lane >> 2, sub = lane & 3;
    constexpr int NRAW = KIND == 1 ? 1536 : 3072, KH = KIND == 1 ? 4 : 16;
    const bf16_t* raw = (const bf16_t*)(p.ws + WS_RAW);
    bf16_t* Q = (bf16_t*)(p.ws + WS_Q); bf16_t* Kb = (bf16_t*)(p.ws + WS_K);
    const float* qn = p.in[KIND == 0 ? 15 : KIND == 1 ? 20 : 32];
    const float* kn = p.in[KIND == 0 ? 16 : KIND == 1 ? 21 : 33];
    const float qscale = 0.125f * LOG2E;
    for (int r = bid * NW + wid; r < MROWS; r += nb * NW) {
        const int b = r / PP, pos = r - b * PP;
        const bool rope = (KIND != 0) && pos < SEQ;
        const int prow = (pos >> 6) & 63, pcol = pos & 63;
        const bf16_t* rr = raw + (size_t)r * NRAW;
        head64_norm_rope(rr + hd * 64, Q + (size_t)r * 1024 + hd * 64, qn, sub, rope, prow, pcol, qscale);
        if (hd < KH) head64_norm_rope(rr + 1024 + hd * 64, Kb + (size_t)r * (KH * 64) + hd * 64, kn, sub, rope, prow, pcol, 1.0f);
    }
}
DI void phase_post_mla1(const Params& p, int bid, int nb, int tid) {
    const int wid = __builtin_amdgcn_readfirstlane(tid >> 6), lane = tid & 63;
    const bf16_t* raw = (const bf16_t*)(p.ws + WS_Q);
    bf16_t* cqn = (bf16_t*)(p.ws + WS_O);
    bf16_t* ckvn = cqn + (size_t)MROWS * 384;
    bf16_t* krope = ckvn + (size_t)MROWS * 256;
    const float* qa = p.in[24]; const float* kva = p.in[25]; const float* kn = p.in[29];
    for (int r = bid * NW + wid; r < MROWS; r += nb * NW) {
        const int b = r / PP, pos = r - b * PP;
        const bf16_t* rr = raw + (size_t)r * 768;
        {
            float v[8];
#pragma unroll
            for (int j = 0; j < 8; ++j) v[j] = 0.f;
            if (lane < 48) unpack8(*(const u32x4*)(rr + lane * 8), v);
            float ss = 0.f;
#pragma unroll
            for (int j = 0; j < 8; ++j) ss += v[j] * v[j];
            ss = wave_sum(ss);
            const float rs = rsqrtf(ss * (1.0f / 384.0f) + EPS);
            if (lane < 48) {
#pragma unroll
                for (int j = 0; j < 8; ++j) v[j] *= rs * qa[lane * 8 + j];
            }
            u32x2 o; o.x = cvt_fp8x4(v[0], v[1], v[2], v[3]); o.y = cvt_fp8x4(v[4], v[5], v[6], v[7]);
            *(u32x2*)((unsigned char*)cqn + (size_t)r * 512 + lane * 8) = o;
        }
        {
            const u32x2 w = *(const u32x2*)(rr + 384 + lane * 4);
            float v[4] = {bflo(w.x), bfhi(w.x), bflo(w.y), bfhi(w.y)};
            float ss = v[0] * v[0] + v[1] * v[1] + v[2] * v[2] + v[3] * v[3];
            ss = wave_sum(ss);
            const float rs = rsqrtf(ss * (1.0f / 256.0f) + EPS);
            *(unsigned*)((unsigned char*)cqn + (size_t)MROWS * 512 + (size_t)r * 256 + lane * 4) = cvt_fp8x4(v[0] * rs * kva[lane * 4], v[1] * rs * kva[lane * 4 + 1], v[2] * rs * kva[lane * 4 + 2], v[3] * rs * kva[lane * 4 + 3]);
        }
        {
            float x1 = 0.f, x2 = 0.f;
            if (lane < 16) { x1 = bf2f(rr[640 + lane]); x2 = bf2f(rr[640 + 16 + lane]); }
            float ss = wave_sum(x1 * x1 + x2 * x2);
            const float rs = rsqrtf(ss * (1.0f / 32.0f) + EPS);
            if (lane < 16) {
                x1 *= rs * kn[64 + lane]; x2 *= rs * kn[64 + 16 + lane];
                if (pos < SEQ) {
                    const int prow = (pos >> 6) & 63, pcol = pos & 63;
                    const float* cs = ROPE32 + ((lane < 8 ? prow : pcol) * 8 + (lane & 7)) * 2;
                    const float c = cs[0], s = cs[1], a = x1, bb = x2;
                    x1 = a * c - bb * s; x2 = bb * c + a * s;
                }
            }
            {
                const int hh = lane >> 2, q = lane & 3;
                float vals[8];
#pragma unroll
                for (int j = 0; j < 8; ++j) { const int src = (8 * q + j) & 15; const float a = __shfl(x1, src), bb = __shfl(x2, src); vals[j] = q < 2 ? a : bb; }
                bf16_t* kr = (bf16_t*)(p.ws + WS_K) + (size_t)r * 1536 + 64;
                *(u32x4*)(kr + hh * 96 + 8 * q) = pack8(vals);
            }
        }
    }
}
DI void phase_post_mla2(const Params& p, int bid, int nb, int tid) {
    const int wid = __builtin_amdgcn_readfirstlane(tid >> 6), lane = tid & 63, hd = lane >> 2, sub = lane & 3;
    const bf16_t* qraw = (const bf16_t*)(p.ws + WS_RAW);
    const bf16_t* kvraw = qraw + (size_t)MROWS * 1536;
    const bf16_t* krope = (const bf16_t*)(p.ws + WS_O) + (size_t)MROWS * 640;
    bf16_t* Q = (bf16_t*)(p.ws + WS_Q); bf16_t* Kb = (bf16_t*)(p.ws + WS_K);
    const float* qn = p.in[28]; const float* kn = p.in[29];
    const float qscale = 0.10206207261596577f * LOG2E;
    for (int r = bid * NW + wid; r < MROWS; r += nb * NW) {
        const int b = r / PP, pos = r - b * PP;
        const bf16_t* qr = qraw + (size_t)r * 1536 + hd * 96;
        bf16_t* qo = Q + (size_t)r * 1536 + hd * 96;
        {
            float a[8], c[8];
            unpack8(*(const u32x4*)(qr + sub * 16), a); unpack8(*(const u32x4*)(qr + sub * 16 + 8), c);
            float ss = 0.f;
#pragma unroll
            for (int e = 0; e < 8; ++e) ss += a[e] * a[e] + c[e] * c[e];
            ss = quad_sum(ss);
            const float rs = rsqrtf(ss * (1.0f / 64.0f) + EPS) * qscale;
#pragma unroll
            for (int e = 0; e < 8; ++e) { a[e] *= rs * qn[sub * 16 + e]; c[e] *= rs * qn[sub * 16 + 8 + e]; }
            *(u32x4*)(qo + sub * 16) = pack8(a); *(u32x4*)(qo + sub * 16 + 8) = pack8(c);
        }
        {
            const u32x2 w1 = *(const u32x2*)(qr + 64 + sub * 4), w2 = *(const u32x2*)(qr + 64 + 16 + sub * 4);
            float x1[4] = {bflo(w1.x), bfhi(w1.x), bflo(w1.y), bfhi(w1.y)}, x2[4] = {bflo(w2.x), bfhi(w2.x), bflo(w2.y), bfhi(w2.y)};
            float ss = 0.f;
#pragma unroll
            for (int e = 0; e < 4; ++e) ss += x1[e] * x1[e] + x2[e] * x2[e];
            ss = quad_sum(ss);
            const float rs = rsqrtf(ss * (1.0f / 32.0f) + EPS);
#pragma unroll
            for (int e = 0; e < 4; ++e) {
                const int i = sub * 4 + e;
                float a = x1[e] * rs * qn[64 + i], bb = x2[e] * rs * qn[64 + 16 + i];
                if (pos < SEQ) {
                    const int prow = (pos >> 6) & 63, pcol = pos & 63;
                    const float* cs = ROPE32 + ((i < 8 ? prow : pcol) * 8 + (i & 7)) * 2;
                    const float c = cs[0], s = cs[1], t1 = a, t2 = bb;
                    a = t1 * c - t2 * s; bb = t2 * c + t1 * s;
                }
                x1[e] = a * qscale; x2[e] = bb * qscale;
            }
            u32x2 o1, o2; o1.x = pk2(x1[0], x1[1]); o1.y = pk2(x1[2], x1[3]); o2.x = pk2(x2[0], x2[1]); o2.y = pk2(x2[2], x2[3]);
            *(u32x2*)(qo + 64 + sub * 4) = o1; *(u32x2*)(qo + 64 + 16 + sub * 4) = o2;
        }
        {
            const bf16_t* kr = kvraw + (size_t)r * 2048 + hd * 128;
            bf16_t* ko = Kb + (size_t)r * 1536 + hd * 96;
            float a[8], c[8];
            unpack8(*(const u32x4*)(kr + sub * 16), a); unpack8(*(const u32x4*)(kr + sub * 16 + 8), c);
            float ss = 0.f;
#pragma unroll
            for (int e = 0; e < 8; ++e) ss += a[e] * a[e] + c[e] * c[e];
            ss = quad_sum(ss);
            const float rs = rsqrtf(ss * (1.0f / 64.0f) + EPS);
#pragma unroll
            for (int e = 0; e < 8; ++e) { a[e] *= rs * kn[sub * 16 + e]; c[e] *= rs * kn[sub * 16 + 8 + e]; }
            *(u32x4*)(ko + sub * 16) = pack8(a); *(u32x4*)(ko + sub * 16 + 8) = pack8(c);
            *(u32x4*)(ko + 64 + sub * 8) = *(const u32x4*)(krope + (size_t)r * 32 + sub * 8);
        }
    }
}
DI void phase_diff_combine(const Params& p, int bid, int nb, int tid) {
    const int wid = __builtin_amdgcn_readfirstlane(tid >> 6), lane = tid & 63, hd = lane >> 3, sub = lane & 7;
    const bf16_t* O12 = (const bf16_t*)(p.ws + WS_H);
    bf16_t* Oc = (bf16_t*)(p.ws + WS_Q);
    const float* lam = p.in[34]; const float* subln = p.in[35];
    const float lambda_init = 0.8f - 0.6f * 0.40656965974059917f;
    const float s1 = wave_sum(lam[lane] * lam[64 + lane]), s2 = wave_sum(lam[128 + lane] * lam[192 + lane]);
    const float lam_full = expf(s1) - expf(s2) + lambda_init;
    for (int r = bid * NW + wid; r < MROWS; r += nb * NW) {
        const bf16_t* o1 = O12 + (size_t)r * 2048 + (2 * hd) * 128 + sub * 16, *o2 = o1 + 128;
        float a[16], c[16];
        unpack8(*(const u32x4*)o1, *(float(*)[8])a); unpack8(*(const u32x4*)(o1 + 8), *(float(*)[8])(a + 8));
        unpack8(*(const u32x4*)o2, *(float(*)[8])c); unpack8(*(const u32x4*)(o2 + 8), *(float(*)[8])(c + 8));
        float ss = 0.f;
#pragma unroll
        for (int e = 0; e < 16; ++e) { a[e] -= lam_full * c[e]; ss += a[e] * a[e]; }
        ss += __shfl_xor(ss, 1); ss += __shfl_xor(ss, 2); ss += __shfl_xor(ss, 4);
        const float rs = rsqrtf(ss * (1.0f / 128.0f) + EPS) * (1.0f - lambda_init);
#pragma unroll
        for (int e = 0; e < 16; ++e) a[e] *= rs * subln[sub * 16 + e];
        bf16_t* o = Oc + (size_t)r * 1024 + hd * 128 + sub * 16;
        *(u32x4*)o = pack8(*(float(*)[8])a); *(u32x4*)(o + 8) = pack8(*(float(*)[8])(a + 8));
    }
}


typedef short s16x4 __attribute__((ext_vector_type(4)));
typedef float f32x2_t __attribute__((ext_vector_type(2)));
typedef __bf16 bf16x2_t __attribute__((ext_vector_type(2)));
DI unsigned cvtpk(float lo, float hi) { f32x2_t v = {lo, hi}; bf16x2_t b = __builtin_convertvector(v, bf16x2_t); return __builtin_bit_cast(unsigned, b); }
DI float xhalf_max(float v) { auto rr = __builtin_amdgcn_permlane32_swap(__float_as_uint(v), __float_as_uint(v), false, false); return fmaxf(__uint_as_float(rr[0]), __uint_as_float(rr[1])); }
DI float xhalf_sum(float v) { auto rr = __builtin_amdgcn_permlane32_swap(__float_as_uint(v), __float_as_uint(v), false, false); return __uint_as_float(rr[0]) + __uint_as_float(rr[1]); }
typedef short v4i16_t __attribute__((__vector_size__(4 * sizeof(short))));
DI s16x4 lds_tr(lds_ptr p) { return __builtin_bit_cast(s16x4, __builtin_amdgcn_ds_read_tr16_b64_v4i16((LAS v4i16_t*)p)); }
constexpr float ATT_BIG = 40.0f, ATT_BIGF = 1.0995116e12f;
DI int crow(int i, int hf) { return (i & 3) + 8 * (i >> 2) + 4 * hf; }

struct AttnP { const bf16_t* Q; int ldq; const bf16_t* K; int ldk; const bf16_t* V; int ldv; bf16_t* O; int ldo; int HQ; int gk; int gv; int vhs  ; const float* bias; const float* sink; int need_ctx; const float* kgain  ; const float* lam; const float* subln; unsigned char* Oc; int ldoc;   };

template <int DQ, int DV, int MODE, int ABL = 0>
DI void attn_mfma(const AttnP& a, unsigned char* smem, int bid, int nb, int tid) {
    constexpr int KSTR = DQ * 2 + 16, KTB = 64 * KSTR, VTB = 64 * DV * 2, NDB = DV / 32, NKK = DQ / 16;
    constexpr int KCH = DQ / 8, VCH = DV / 8, NKI = (64 * KCH + NTHREADS - 1) / NTHREADS, NVI = (64 * VCH + NTHREADS - 1) / NTHREADS;
    static_assert(2 * KTB + 2 * VTB + 2048 <= GEMM_LDS, "attention LDS");
    const lds_ptr lds = (lds_ptr)smem;
    LAS float* biasl = (LAS float*)(lds + 2 * KTB + 2 * VTB);
    const int lane = tid & 63, wid = __builtin_amdgcn_readfirstlane(tid >> 6), r = lane & 31, hf = lane >> 5;
    const int nq = a.need_ctx ? 17 : 16;
    const int xcd = bid & 7, slot = bid >> 3, nslots = nb >> 3, per_xcd = (NBATCH * a.HQ / 8) * nq;
    int koff[NKI], kdst[NKI], voff[NVI], vdst[NVI];
#pragma unroll
    for (int i = 0; i < NKI; ++i) { const int c = min(tid + NTHREADS * i, 64 * KCH - 1), row = c / KCH, kc = c - row * KCH; koff[i] = row * a.ldk + kc * 8; kdst[i] = row * KSTR + kc * 16; }
#pragma unroll
    for (int i = 0; i < NVI; ++i) { const int c = tid + NTHREADS * i, row = c / VCH, vc = c - row * VCH; voff[i] = row * a.ldv + vc * 8; vdst[i] = ((row >> 3) * NDB + (vc >> 2)) * 512 + (row & 7) * 64 + (vc & 3) * 16; }
    const int i16 = lane & 15, trq = i16 >> 2, trp = i16 & 3, grp = (lane >> 4) & 1;
    const int vtr0 = (4 * hf + trq) * 64 + 32 * grp + 8 * trp;
    constexpr bool PAIRED = (MODE == 2 && DV == 128);
    float lam_full = 0.f;
    if (PAIRED) { const float s1 = wave_sum(a.lam[lane] * a.lam[64 + lane]), s2 = wave_sum(a.lam[128 + lane] * a.lam[192 + lane]); lam_full = expf(s1) - expf(s2) + (0.8f - 0.6f * 0.40656965974059917f); }
    int it_i = 0;
    for (int j = slot; j < per_xcd; j += nslots, ++it_i) {
        const int nbh = NBATCH * a.HQ / 8;
        const int bhl = j < nbh * 16 ? j >> 4 : j - nbh * 16;
        int qt = j < nbh * 16 ? j & 15 : 16;
        int bh = bhl * 8 + xcd;
        if (MODE == 1) { const int P = (bhl >> 2) * 8 + xcd; bh = (P >> 2) * a.HQ + (P & 3) * 4 + (bhl & 3); }
        if (PAIRED) { const int pu = slot + nslots * (it_i >> 1); qt = pu & 15; bh = (pu >> 4) * a.HQ + 2 * xcd + (it_i & 1); }
        const int h = bh % a.HQ, b = bh / a.HQ;
        const bool is_ctx = qt >= 16;
        const int q0 = is_ctx ? SEQ : qt * 256;
        int t_lo = 0, n_lat = 0;
        if (!is_ctx) {
            if (MODE == 2) { t_lo = 0; n_lat = 64; }
            else if (MODE == 1) { t_lo = max(0, 4 * qt - 2); n_lat = min(63, 4 * qt + 5) - t_lo + 1; }
            else { const int r0 = 4 * qt; t_lo = min(max(r0 - 4, 0), 56); n_lat = min(max(r0 - 1, 0), 56) + 7 - t_lo + 1; }
        }
        const int ntiles = n_lat + 4;
        const int qw0 = q0 + wid * 32, qpos = qw0 + r;
        const size_t qrow = (size_t)b * PP + qpos;
        bf16x8 qf[NKK];
#pragma unroll
        for (int kk = 0; kk < NKK; ++kk) qf[kk] = *(const bf16x8*)(a.Q + qrow * a.ldq + h * DQ + kk * 16 + hf * 8);
        if (MODE == 0 && !is_ctx) { for (int i = tid; i < 465; i += NTHREADS) biasl[i] = a.bias[h * 465 + i] * LOG2E; }
        const bf16_t* Kg = a.K + (size_t)b * PP * a.ldk + (h >> a.gk) * DQ;
        const bf16_t* Vg = a.V + (size_t)b * PP * a.ldv + (h >> a.gv) * a.vhs;
        f32x16 o[NDB];
#pragma unroll
        for (int d = 0; d < NDB; ++d)
#pragma unroll
            for (int i = 0; i < 16; ++i) o[d][i] = 0.f;
        float mref = 0.f, l = 0.f;
        f32x16 negm;
#pragma unroll
        for (int i = 0; i < 16; ++i) negm[i] = 0.f;
        bool first = true;
        float lbig = 0.f;
        float one = 1.0f; asm volatile("" : "+v"(one));
#define ATT_TILE(IT) ((IT) < n_lat ? t_lo + (IT) : 64 + ((IT) - n_lat))
        auto tile_active = [&](int t) -> bool {
            if (t >= 64) return true;
            if (MODE == 1) return (t * 64 + 63 >= qw0 - 128) && (t * 64 <= qw0 + 31 + 128);
            if (MODE == 0) { const int rw = qw0 >> 6, row0 = min(max(rw - 4, 0), 56); return t >= row0 && t < row0 + 8; }
            return true;
        };
        auto qk = [&](f32x16 (&s)[2], const lds_ptr Kb) {
#pragma unroll
            for (int kk = 0; kk < NKK; ++kk)
#pragma unroll
                for (int kb = 0; kb < 2; ++kb) {
                    if (ABL & 4) { if (kk == 0) s[kb] = negm; }
                    else {
                    const bf16x8 kf = *(const LAS bf16x8*)(Kb + (kb * 32 + r) * KSTR + (kk * 2 + hf) * 16);
                    s[kb] = MFMA32(kf, qf[kk], kk == 0 ? negm : s[kb]);
                    }
                }
        };
        u32x4 kr[NKI], vr[NVI];
        {
            const int t0 = ATT_TILE(0), t1 = ATT_TILE(1);
            u32x4 k1[NKI];
#pragma unroll
            for (int i = 0; i < NKI; ++i) kr[i] = *(const u32x4*)(Kg + (size_t)t0 * 64 * a.ldk + koff[i]);
#pragma unroll
            for (int i = 0; i < NVI; ++i) vr[i] = *(const u32x4*)(Vg + (size_t)t0 * 64 * a.ldv + voff[i]);
#pragma unroll
            for (int i = 0; i < NKI; ++i) k1[i] = *(const u32x4*)(Kg + (size_t)t1 * 64 * a.ldk + koff[i]);
#pragma unroll
            for (int i = 0; i < NKI; ++i) { *(LAS u32x4*)(lds + kdst[i]) = kr[i]; *(LAS u32x4*)(lds + KTB + kdst[i]) = k1[i]; }
#pragma unroll
            for (int i = 0; i < NVI; ++i) *(LAS u32x4*)(lds + 2 * KTB + vdst[i]) = vr[i];
        }
        __syncthreads();
        f32x16 sc[2], sn[2];
        bool act_cur = tile_active(ATT_TILE(0)), act_nxt = false;
        if (act_cur) qk(sc, lds);
        __syncthreads();
        auto step = [&](const int it, const int e, const bool N2, const bool N1) {
            const int t = ATT_TILE(it);
            if (N2 && !(ABL & 8) && (!(ABL & 128) || e)) {
                const int tn = ATT_TILE(it + 2);
#pragma unroll
                for (int i = 0; i < NKI; ++i) kr[i] = *(const u32x4*)(Kg + (size_t)tn * 64 * a.ldk + koff[i]);
            }
            if (N1 && !(ABL & 8) && (!(ABL & 128) || e)) {
                const int tn = ATT_TILE(it + 1);
#pragma unroll
                for (int i = 0; i < NVI; ++i) vr[i] = *(const u32x4*)(Vg + (size_t)tn * 64 * a.ldv + voff[i]);
            }
            SCHED_FENCE();
            act_nxt = N1 && (MODE == 2 || tile_active(ATT_TILE(it + 1)));
            const lds_ptr Vb = lds + 2 * KTB + e * VTB;
            const bool do_cur = MODE == 2 || act_cur;
            if (do_cur) {
                if (t < 64 && MODE == 1 && !((t * 64 + 63 - qw0 <= 128) && (qw0 + 31 - t * 64 <= 128))) {
                    const int dbase = t * 64 + 4 * hf - qpos;
#pragma unroll
                    for (int kb = 0; kb < 2; ++kb)
#pragma unroll
                        for (int i = 0; i < 16; ++i) { const int c = kb * 32 + (i & 3) + 8 * (i >> 2); sc[kb][i] = (dbase > 128 - c || dbase < -128 - c) ? -INFINITY : sc[kb][i]; }
                }
                if (t < 64 && MODE == 0) {
                    const int qc = qpos & 63, rw = qpos >> 6, col0 = min(max(qc - 8, 0), 48);
                    const int brow = (t - rw + 7) * 31 + 15 - qc;
#pragma unroll
                    for (int kb = 0; kb < 2; ++kb)
#pragma unroll
                        for (int i = 0; i < 16; ++i) {
                            const int kc = kb * 32 + crow(i, hf);
                            const bool ok = kc >= col0 && kc < col0 + 16;
                            const float bv = biasl[ok ? brow + kc : 0];
                            sc[kb][i] = ok ? sc[kb][i] + bv : -INFINITY;
                        }
                }
                if (first || __builtin_amdgcn_ballot_w64(lbig > ATT_BIGF) != 0ull) {
                    float delta = lbig > ATT_BIGF ? ATT_BIG : 0.f;
                    if (first) {
                        float mx = sc[0][0];
#pragma unroll
                        for (int i = 1; i < 16; ++i) mx = fmaxf(mx, sc[0][i]);
#pragma unroll
                        for (int i = 0; i < 16; ++i) mx = fmaxf(mx, sc[1][i]);
                        mx = xhalf_max(mx);
                        delta = mx > -INFINITY ? mx : 0.f;
                    }
                    const float alpha = __builtin_amdgcn_exp2f(-delta);
                    l *= alpha; mref += delta;
#pragma unroll
                    for (int d = 0; d < NDB; ++d)
#pragma unroll
                        for (int i = 0; i < 16; ++i) o[d][i] *= alpha;
#pragma unroll
                    for (int kb = 0; kb < 2; ++kb)
#pragma unroll
                        for (int i = 0; i < 16; ++i) sc[kb][i] -= delta;
#pragma unroll
                    for (int i = 0; i < 16; ++i) negm[i] = -mref;
                    first = false;
                }
            }
            if (N1) qk(sn, lds + (e ^ 1) * KTB);
            if (do_cur) {
                float ls0 = 0.f, ls1 = 0.f;
#pragma unroll
                for (int kb = 0; kb < 2; ++kb)
#pragma unroll
                    for (int i = 0; i < 16; i += 2) {
                        const float p0 = (ABL & 1) ? sc[kb][i] : __builtin_amdgcn_exp2f(sc[kb][i]), p1 = (ABL & 1) ? sc[kb][i + 1] : __builtin_amdgcn_exp2f(sc[kb][i + 1]);
                        sc[kb][i] = p0; sc[kb][i + 1] = p1;
                        if (!(ABL & 16)) { ls0 += p0; ls1 = __builtin_fmaf(p1, one, ls1); }
                    }
                lbig = ls0 + ls1;
                l += lbig;
                bf16x8 pf[4];
#pragma unroll
                for (int kb = 0; kb < 2; ++kb)
#pragma unroll
                    for (int sp = 0; sp < 2; ++sp) {
                        u32x4 w;
                        w.x = cvtpk(sc[kb][8 * sp], sc[kb][8 * sp + 1]); w.y = cvtpk(sc[kb][8 * sp + 2], sc[kb][8 * sp + 3]);
                        w.z = cvtpk(sc[kb][8 * sp + 4], sc[kb][8 * sp + 5]); w.w = cvtpk(sc[kb][8 * sp + 6], sc[kb][8 * sp + 7]);
                        pf[kb * 2 + sp] = __builtin_bit_cast(bf16x8, w);
                    }
#pragma unroll
                for (int ks = 0; ks < 4; ++ks)
#pragma unroll
                    for (int d = 0; d < NDB; ++d) {
                        const lds_ptr vp = Vb + ((2 * ks) * NDB + d) * 512 + vtr0;
                        const s16x4 lo = lds_tr(vp), hi = lds_tr(vp + NDB * 512);
                        const bf16x8 vf = __builtin_shufflevector(lo, hi, 0, 1, 2, 3, 4, 5, 6, 7);
                        if (ABL & 2) { if (d == 0 && ks == 0) o[0][0] += __builtin_bit_cast(float, pf[0][0] | pf[1][0] | pf[2][0] | pf[3][0]) + __builtin_bit_cast(float, (int)vf[0]); } else
                        o[d] = MFMA32(vf, pf[ks], o[d]);
                    }
            }
            SCHED_FENCE();
            if (N2 && !(ABL & 8) && (!(ABL & 128) || e)) {
#pragma unroll
                for (int i = 0; i < NKI; ++i) *(LAS u32x4*)(lds + e * KTB + kdst[i]) = kr[i];
            }
            if (N1 && !(ABL & 8) && (!(ABL & 128) || e)) {
#pragma unroll
                for (int i = 0; i < NVI; ++i) *(LAS u32x4*)(lds + 2 * KTB + (e ^ 1) * VTB + vdst[i]) = vr[i];
            }
            if (!(ABL & 64) && (!(ABL & 128) || e)) __syncthreads();
#pragma unroll
            for (int kb = 0; kb < 2; ++kb) sc[kb] = sn[kb];
            act_cur = act_nxt;
        };
        int it = 0;
        for (; it + 3 < ntiles; it += 2) { step(it, 0, true, true); step(it + 1, 1, true, true); }
        if (ntiles - it == 3) { step(it, 0, true, true); step(it + 1, 1, false, true); step(it + 2, 0, false, false); }
        else { step(it, 0, false, true); step(it + 1, 1, false, false); }
#undef ATT_TILE
        l = xhalf_sum(l);
        if (a.sink) {
            l += __builtin_amdgcn_exp2f(a.sink[h] * LOG2E - mref);
        }
        const float inv = 1.0f / l;
        bf16_t* orow = a.O + qrow * a.ldo + h * DV + 4 * hf;
#pragma unroll
        for (int d = 0; d < NDB; ++d)
#pragma unroll
            for (int g = 0; g < 4; ++g) {
                if (DV == 64) {
                    *(unsigned*)((unsigned char*)a.O + qrow * a.ldo + h * DV + 4 * hf + d * 32 + 8 * g) = cvt_fp8x4(o[d][4 * g] * inv, o[d][4 * g + 1] * inv, o[d][4 * g + 2] * inv, o[d][4 * g + 3] * inv);
                } else {
                    u32x2 w; w.x = cvtpk(o[d][4 * g] * inv, o[d][4 * g + 1] * inv); w.y = cvtpk(o[d][4 * g + 2] * inv, o[d][4 * g + 3] * inv);
                    *(u32x2*)(orow + d * 32 + 8 * g) = w;
                }
            }
        if (PAIRED && (it_i & 1)) {
            asm volatile("s_waitcnt vmcnt(0)" ::: "memory");
            const float lambda_init = 0.8f - 0.6f * 0.40656965974059917f;
            const int sub = lane & 7, pair = h >> 1;
#pragma unroll
            for (int i4 = 0; i4 < 4; ++i4) {
                const size_t row = (size_t)b * PP + qw0 + i4 * 8 + (lane >> 3);
                const bf16_t* o1 = a.O + row * a.ldo + (2 * pair) * 128 + sub * 16, *o2 = o1 + 128;
                float av[16], cv[16];
                unpack8(*(const u32x4*)o1, *(float(*)[8])av); unpack8(*(const u32x4*)(o1 + 8), *(float(*)[8])(av + 8));
                unpack8(*(const u32x4*)o2, *(float(*)[8])cv); unpack8(*(const u32x4*)(o2 + 8), *(float(*)[8])(cv + 8));
                float ss = 0.f;
#pragma unroll
                for (int e = 0; e < 16; ++e) { av[e] -= lam_full * cv[e]; ss += av[e] * av[e]; }
                ss += __shfl_xor(ss, 1); ss += __shfl_xor(ss, 2); ss += __shfl_xor(ss, 4);
                const float rs = rsqrtf(ss * (1.0f / 128.0f) + EPS) * (1.0f - lambda_init);
#pragma unroll
                for (int e = 0; e < 16; ++e) av[e] *= rs * a.subln[sub * 16 + e];
                u32x4 w8; w8.x = cvt_fp8x4(av[0], av[1], av[2], av[3]); w8.y = cvt_fp8x4(av[4], av[5], av[6], av[7]); w8.z = cvt_fp8x4(av[8], av[9], av[10], av[11]); w8.w = cvt_fp8x4(av[12], av[13], av[14], av[15]);
                *(u32x4*)(a.Oc + row * (size_t)a.ldoc + pair * 128 + sub * 16) = w8;
            }
        }
    }
}

DI void attn_na(const AttnP& a, unsigned char* smem, int bid, int nb, int tid) {
    constexpr int DQ = 64, DV = 64, KSTR = DQ * 2 + 16, KTB = 64 * KSTR, VTB = 64 * DV * 2, NDB = 2, NKK = 4;
    const lds_ptr lds = (lds_ptr)smem;
    constexpr int BZ_TAB = 32, BZ_HEAD = 560, BZ_NINF = 16 * BZ_HEAD, BZ_N = BZ_NINF + 64;
    static_assert(4 * KTB + 4 * VTB + (BZ_N + 16) * 4 <= GEMM_LDS, "NA LDS");
    LAS float* biasl = (LAS float*)(lds + 4 * KTB + 4 * VTB);
    for (int i = tid; i < BZ_N; i += NTHREADS) {
        const int hh = i / BZ_HEAD, o = i - hh * BZ_HEAD;
        biasl[i] = i >= BZ_NINF ? -INFINITY : (o >= BZ_TAB && o < BZ_TAB + 465) ? a.bias[hh * 465 + o - BZ_TAB] * LOG2E : 0.f;
    }
    __syncthreads();
    {
        const int wv = __builtin_amdgcn_readfirstlane(tid >> 6), ln = tid & 63;
#pragma unroll
        for (int hh2 = 0; hh2 < 2; ++hh2) {
            const int hh = 2 * wv + hh2;
            float m = 0.f;
            for (int i = ln; i < 465; i += 64) m = fmaxf(m, biasl[hh * BZ_HEAD + BZ_TAB + i]);
#pragma unroll
            for (int d = 32; d >= 1; d >>= 1) m = fmaxf(m, __shfl_xor(m, d));
            if (ln == 0) biasl[BZ_N + hh] = m;
        }
    }
    float kmax = fabsf(a.kgain[tid & 63]);
#pragma unroll
    for (int d = 32; d >= 1; d >>= 1) kmax = fmaxf(kmax, __shfl_xor(kmax, d));
    kmax *= 8.0f * 1.01f;
    const int lane = tid & 63, wid = __builtin_amdgcn_readfirstlane(tid >> 6), r = lane & 31, hf = lane >> 5;
    const int nq = a.need_ctx ? 17 : 16;
    const int xcd = bid & 7, slot = bid >> 3, nslots = nb >> 3, per_xcd = (NBATCH * a.HQ / 8) * nq;
    const int krow_s = tid >> 3, kc_s = tid & 7;
    const int koff = krow_s * a.ldk + kc_s * 8, kdst = krow_s * KSTR + kc_s * 16, voff = krow_s * a.ldv + kc_s * 8;
    const int vdst = ((krow_s >> 3) * NDB + (kc_s >> 2)) * 512 + (krow_s & 7) * 64 + (kc_s & 3) * 16;
    const int i16 = lane & 15, trq = i16 >> 2, trp = i16 & 3, grp = (lane >> 4) & 1;
    const int vtr0 = (4 * hf + trq) * 64 + 32 * grp + 8 * trp;
    const int rp = wid >> 2, cq = wid & 3, k0 = cq == 0 ? 0 : cq == 1 ? 8 : cq == 2 ? 24 : 32;
    float one = 1.0f; asm volatile("" : "+v"(one));
    auto unit_of = [&](int j, int& b, int& h, int& qt, int& t_lo, int& n_lat) {
        const int nbh = NBATCH * a.HQ / 8;
        const int bhl = j < nbh * 16 ? j >> 4 : j - nbh * 16; qt = j < nbh * 16 ? j & 15 : 16;
        const int bh = bhl * 8 + xcd; h = bh % a.HQ; b = bh / a.HQ;
        t_lo = 0; n_lat = 0;
        if (qt < 16) { const int r0 = 4 * qt; t_lo = min(max(r0 - 4, 0), 56); n_lat = min(max(r0 - 1, 0), 56) + 7 - t_lo + 1; n_lat += n_lat & 1; }
    };
#define NA_TILE_OF(IT, TLO, NLAT) ((IT) < (NLAT) ? (TLO) + (IT) : 64 + ((IT) - (NLAT)))
    bf16x8 qf[NKK];
    u32x4 krA[2], vrA[2], krB[2], vrB[2];
    auto load_pair = [&](u32x4 (&kr)[2], u32x4 (&vr)[2], const bf16_t* Kg, const bf16_t* Vg, int t_lo, int n_lat, int pr) {
#pragma unroll
        for (int jj = 0; jj < 2; ++jj) {
            const int tn = NA_TILE_OF(2 * pr + jj, t_lo, n_lat);
            kr[jj] = *(const u32x4*)(Kg + (size_t)tn * 64 * a.ldk + koff); vr[jj] = *(const u32x4*)(Vg + (size_t)tn * 64 * a.ldv + voff);
        }
    };
    auto store_pair = [&](const u32x4 (&kr)[2], const u32x4 (&vr)[2], int e) {
#pragma unroll
        for (int jj = 0; jj < 2; ++jj) { *(LAS u32x4*)(lds + (2 * e + jj) * KTB + kdst) = kr[jj]; *(LAS u32x4*)(lds + 4 * KTB + (2 * e + jj) * VTB + vdst) = vr[jj]; }
    };
    auto qrow_of = [&](int b, int qt) -> size_t { const int qpos = qt >= 16 ? SEQ + wid * 32 + r : (4 * qt + 2 * rp + (r >> 4)) * 64 + 16 * cq + (r & 15); return (size_t)b * PP + qpos; };
    auto load_q = [&](int b, int h, int qt) {
        const size_t qrow = qrow_of(b, qt);
#pragma unroll
        for (int kk = 0; kk < NKK; ++kk) qf[kk] = *(const bf16x8*)(a.Q + qrow * a.ldq + h * DQ + kk * 16 + hf * 8);
    };
    if (slot >= per_xcd) return;
    int b, h, qt, t_lo, n_lat;
    unit_of(slot, b, h, qt, t_lo, n_lat);
    {
        load_q(b, h, qt);
        const bf16_t* Kg = a.K + (size_t)b * PP * a.ldk + h * DQ; const bf16_t* Vg = a.V + (size_t)b * PP * a.ldv + h * a.vhs;
        load_pair(krA, vrA, Kg, Vg, t_lo, n_lat, 0); store_pair(krA, vrA, 0); load_pair(krB, vrB, Kg, Vg, t_lo, n_lat, 1);
    }
    __syncthreads();
    for (int j = slot;;) {
        const int jn = j + nslots; const bool has_next = jn < per_xcd;
        int nb_, nh, nqt, nt_lo, nn_lat;
        unit_of(has_next ? jn : j, nb_, nh, nqt, nt_lo, nn_lat);
        const bf16_t* nKg = a.K + (size_t)nb_ * PP * a.ldk + nh * DQ; const bf16_t* nVg = a.V + (size_t)nb_ * PP * a.ldv + nh * a.vhs;
        const bool is_ctx = qt >= 16;
        const int r0 = 4 * qt;
        const int npair = (n_lat + 4) >> 1;
        const int qrw = r0 + 2 * rp + (r >> 4), qc = 16 * cq + (r & 15);
        const size_t qrow = qrow_of(b, qt);
        const bf16_t* Kg = a.K + (size_t)b * PP * a.ldk + h * DQ;
        const bf16_t* Vg = a.V + (size_t)b * PP * a.ldv + h * a.vhs;
        const int rwA = r0 + 2 * rp, wlo = min(max(rwA - 4, 0), 56), whi = min(max(rwA - 3, 0), 56) + 7;
        const int col0 = min(max(qc - 8, 0), 48), row0q = min(max(qrw - 4, 0), 56);
        const int lanebase = h * BZ_HEAD + BZ_TAB + (7 - qrw) * 31 + 15 - qc + k0 + 4 * hf;
        f32x16 o[NDB];
#pragma unroll
        for (int d = 0; d < NDB; ++d)
#pragma unroll
            for (int i = 0; i < 16; ++i) o[d][i] = 0.f;
        float l = 0.f;
        float qn2 = 0.f;
#pragma unroll
        for (int kk = 0; kk < NKK; ++kk)
#pragma unroll
            for (int jj = 0; jj < 8; ++jj) { const float qv = bf2f((bf16_t)qf[kk][jj]); qn2 = __builtin_fmaf(qv, qv, qn2); }
        qn2 = xhalf_sum(qn2);
        const float mref = __builtin_sqrtf(qn2) * kmax + biasl[BZ_N + h];
        f32x16 negmL;
#pragma unroll
        for (int i = 0; i < 16; ++i) { const int kc = k0 + crow(i, hf); negmL[i] = (kc >= col0 && kc < col0 + 16) ? -mref : -INFINITY; }
#define NA_TILE(IT) NA_TILE_OF(IT, t_lo, n_lat)
        auto ctx_tile = [&](const lds_ptr Kb, const lds_ptr Vb) {
            {
                f32x16 s[2], negm;
#pragma unroll
                for (int i = 0; i < 16; ++i) negm[i] = -mref;
#pragma unroll
                for (int kk = 0; kk < NKK; ++kk)
#pragma unroll
                    for (int kb = 0; kb < 2; ++kb) {
                        const bf16x8 kf = *(const LAS bf16x8*)(Kb + (kb * 32 + r) * KSTR + (kk * 2 + hf) * 16);
                        s[kb] = MFMA32(kf, qf[kk], kk == 0 ? negm : s[kb]);
                    }
                float ls0 = 0.f, ls1 = 0.f;
                bf16x8 pf[4];
#pragma unroll
                for (int kb = 0; kb < 2; ++kb) {
#pragma unroll
                    for (int i = 0; i < 16; i += 2) {
                        const float p0 = __builtin_amdgcn_exp2f(s[kb][i]), p1 = __builtin_amdgcn_exp2f(s[kb][i + 1]);
                        s[kb][i] = p0; s[kb][i + 1] = p1; ls0 += p0; ls1 = __builtin_fmaf(p1, one, ls1);
                    }
#pragma unroll
                    for (int sp = 0; sp < 2; ++sp) {
                        u32x4 w;
                        w.x = cvtpk(s[kb][8 * sp], s[kb][8 * sp + 1]); w.y = cvtpk(s[kb][8 * sp + 2], s[kb][8 * sp + 3]);
                        w.z = cvtpk(s[kb][8 * sp + 4], s[kb][8 * sp + 5]); w.w = cvtpk(s[kb][8 * sp + 6], s[kb][8 * sp + 7]);
                        pf[kb * 2 + sp] = __builtin_bit_cast(bf16x8, w);
                    }
                }
                l += ls0 + ls1;
#pragma unroll
                for (int ks = 0; ks < 4; ++ks)
#pragma unroll
                    for (int d = 0; d < NDB; ++d) {
                        const lds_ptr vp = Vb + ((2 * ks) * NDB + d) * 512 + vtr0;
                        const s16x4 lo = lds_tr(vp), hi = lds_tr(vp + NDB * 512);
                        o[d] = MFMA32(__builtin_shufflevector(lo, hi, 0, 1, 2, 3, 4, 5, 6, 7), pf[ks], o[d]);
                    }
            }
        };
        auto lat_tile = [&](const int t, const lds_ptr Kb, const lds_ptr Vb) {
            bf16x8 pf[2];
#pragma unroll
            for (int sp = 0; sp < 2; ++sp)
#pragma unroll
                for (int jj = 0; jj < 8; ++jj) pf[sp][jj] = 0;
            if (t >= wlo && t <= whi) {
                f32x16 s;
#pragma unroll
                for (int kk = 0; kk < NKK; ++kk) {
                    const bf16x8 kf = *(const LAS bf16x8*)(Kb + (k0 + r) * KSTR + (kk * 2 + hf) * 16);
                    s = MFMA32(kf, qf[kk], kk == 0 ? negmL : s);
                }
                const LAS float* bp = biasl + (((unsigned)(t - row0q) < 8u) ? lanebase + 31 * t : BZ_NINF);
#pragma unroll
                for (int i = 0; i < 16; ++i) s[i] += bp[crow(i, 0)];
                float ls0 = 0.f, ls1 = 0.f;
#pragma unroll
                for (int i = 0; i < 16; i += 2) {
                    const float p0 = __builtin_amdgcn_exp2f(s[i]), p1 = __builtin_amdgcn_exp2f(s[i + 1]);
                    s[i] = p0; s[i + 1] = p1; ls0 += p0; ls1 = __builtin_fmaf(p1, one, ls1);
                }
#pragma unroll
                for (int sp = 0; sp < 2; ++sp) {
                    u32x4 w;
                    w.x = cvtpk(s[8 * sp], s[8 * sp + 1]); w.y = cvtpk(s[8 * sp + 2], s[8 * sp + 3]);
                    w.z = cvtpk(s[8 * sp + 4], s[8 * sp + 5]); w.w = cvtpk(s[8 * sp + 6], s[8 * sp + 7]);
                    pf[sp] = __builtin_bit_cast(bf16x8, w);
                }
                l += ls0 + ls1;
            }
#pragma unroll
            for (int ks = 0; ks < 2; ++ks)
#pragma unroll
                for (int d = 0; d < NDB; ++d) {
                    const lds_ptr vp = Vb + (((k0 >> 3) + 2 * ks) * NDB + d) * 512 + vtr0;
                    const s16x4 lo = lds_tr(vp), hi = lds_tr(vp + NDB * 512);
                    o[d] = MFMA32(__builtin_shufflevector(lo, hi, 0, 1, 2, 3, 4, 5, 6, 7), pf[ks], o[d]);
                }
        };
#define NA_ITER(IP, E, KL, VL, KS, VS, LAT) do { \
            if ((IP) + 2 < npair) load_pair(KL, VL, Kg, Vg, t_lo, n_lat, (IP) + 2); \
            else if (has_next) load_pair(KL, VL, nKg, nVg, nt_lo, nn_lat, (IP) + 2 - npair); \
            SCHED_FENCE(); \
            if (LAT) { lat_tile(t_lo + 2 * (IP), lds + (2 * (E)) * KTB, lds + 4 * KTB + (2 * (E)) * VTB); lat_tile(t_lo + 2 * (IP) + 1, lds + (2 * (E) + 1) * KTB, lds + 4 * KTB + (2 * (E) + 1) * VTB); } \
            else { ctx_tile(lds + (2 * (E)) * KTB, lds + 4 * KTB + (2 * (E)) * VTB); ctx_tile(lds + (2 * (E) + 1) * KTB, lds + 4 * KTB + (2 * (E) + 1) * VTB); } \
            SCHED_FENCE(); \
            if ((IP) + 1 < npair || has_next) store_pair(KS, VS, (E) ^ 1); \
            __syncthreads(); } while (0)
        int ip = 0;
        for (; ip < (n_lat >> 1); ip += 2) { NA_ITER(ip, 0, krA, vrA, krB, vrB, true); NA_ITER(ip + 1, 1, krB, vrB, krA, vrA, true); }
        NA_ITER(ip, 0, krA, vrA, krB, vrB, false); NA_ITER(ip + 1, 1, krB, vrB, krA, vrA, false);
#undef NA_ITER
        if (has_next) load_q(nb_, nh, nqt);
#undef NA_TILE
        l = xhalf_sum(l);
        const float inv = 1.0f / l;
#pragma unroll
        for (int d = 0; d < NDB; ++d)
#pragma unroll
            for (int g = 0; g < 4; ++g)
                *(unsigned*)((unsigned char*)a.O + qrow * a.ldo + h * DV + 4 * hf + d * 32 + 8 * g) = cvt_fp8x4(o[d][4 * g] * inv, o[d][4 * g + 1] * inv, o[d][4 * g + 2] * inv, o[d][4 * g + 3] * inv);
        if (!has_next) break;
        j = jn; b = nb_; h = nh; qt = nqt; t_lo = nt_lo; n_lat = nn_lat;
    }
#undef NA_TILE_OF
}

template <class E> struct epi_fp8 { static constexpr int value = 0; };
typedef int v8i_t __attribute__((ext_vector_type(8)));
typedef int v4i_t __attribute__((ext_vector_type(4)));
namespace pg8 {
constexpr int BM = 256, BK = 64, HALF = 128, HTB = HALF * BK * 2  ;
DI int lds_byte(int r, int c) { const int st = (r >> 4) * 2 + (c >> 5), rr = r & 15, cc = c & 31, ob = rr * 64 + cc * 2; return st * 1024 + (ob ^ (((ob >> 9) & 1) << 5)); }
DI void stage_rc(int b, int& R, int& C) { const int st = b / 1024, sb = b % 1024, swz = sb ^ (((sb >> 9) & 1) << 5); R = (st >> 1) * 16 + swz / 64; C = (st & 1) * 32 + (swz % 64) / 2; }
DI int perm32(int rho) { const int n = rho >> 4, i = rho & 15; return 8 * (i >> 2) + 4 * n + (i & 3); }

template <class Epi, class Sched>
DI void gemm_phase(lds_ptr lds, const bf16_t* __restrict__ Aop, const int K, const Sched& S, const Epi& E, const int tid) {
    const int wid = __builtin_amdgcn_readfirstlane(tid >> 6), lane = tid & 63, wr = wid >> 2, wc = wid & 3, fr = lane & 15, fq = lane >> 4;
    const int nt = K / BK;
    int Ra[2], Ca[2]; unsigned voffB[2];
#pragma unroll
    for (int i = 0; i < 2; ++i) { int R, C; stage_rc(tid * 16 + i * 8192, R, C); const int Rb = Epi::PERM ? ((R & ~31) + perm32(R & 31)) : R;
        Ra[i] = R; Ca[i] = C; voffB[i] = (unsigned)(Rb * K + C) * 2u; }
    const size_t kstep = (size_t)(BK * 2);
    const size_t hstep = (size_t)HALF * K * 2;
    const unsigned ldsw = (unsigned)wid * 1024u;
    const int aoff = lds_byte(wr * 64 + fr, fq * 8), boff = lds_byte(wc * 32 + fr, fq * 8);
#define PG8_SA(b, h) (((b) * 2 + (h)) * HTB)
#define PG8_SB(b, h) ((4 + (b) * 2 + (h)) * HTB)
#define PG8_STAGE(bufoff, gbase, voff) do { const char* _gb = (const char*)(gbase); asm volatile("" : "+s"(_gb)); _Pragma("unroll") for (int _i = 0; _i < 2; ++_i) { \
        unsigned _o = (voff)[_i]; asm volatile("" : "+v"(_o)); \
        __builtin_amdgcn_global_load_lds((const unsigned*)(_gb + _o), (LAS unsigned*)(lds + (bufoff) + ldsw + _i * 8192), 16, 0, 0); } } while (0)
#define PG8_LDA(dst, b, h) do { _Pragma("unroll") for (int m = 0; m < 4; ++m) _Pragma("unroll") for (int k = 0; k < 2; ++k) dst[m][k] = *(const LAS bf16x8*)(lds + PG8_SA(b, h) + aoff + m * 2048 + k * 1024); } while (0)
#define PG8_LDB(dst, b, h) do { _Pragma("unroll") for (int n = 0; n < 2; ++n) _Pragma("unroll") for (int k = 0; k < 2; ++k) dst[n][k] = *(const LAS bf16x8*)(lds + PG8_SB(b, h) + boff + n * 2048 + k * 1024); } while (0)
typedef long i64x2_t __attribute__((ext_vector_type(2)));
#define PG8_MMA(ai, bj, At, Bt) do { __builtin_amdgcn_s_setprio(1); _Pragma("unroll") for (int m = 0; m < 4; ++m) _Pragma("unroll") for (int n = 0; n < 2; ++n) { \
        if (epi_fp8<Epi>::value == 2) { \
            const v8i_t _b = __builtin_shufflevector(__builtin_bit_cast(v4i_t, Bt[n][0]), __builtin_bit_cast(v4i_t, Bt[n][1]), 0, 1, 2, 3, 4, 5, 6, 7); \
            const v8i_t _a = __builtin_shufflevector(__builtin_bit_cast(v4i_t, At[m][0]), __builtin_bit_cast(v4i_t, At[m][1]), 0, 1, 2, 3, 4, 5, 6, 7); \
            acc[ai][bj][m][n] = __builtin_amdgcn_mfma_scale_f32_16x16x128_f8f6f4(_b, _a, acc[ai][bj][m][n], 0, 0, 0, 0, 0, 0); \
        } else { _Pragma("unroll") for (int k = 0; k < 2; ++k) { \
        if (epi_fp8<Epi>::value == 1) { const i64x2_t _b = __builtin_bit_cast(i64x2_t, Bt[n][k]), _a = __builtin_bit_cast(i64x2_t, At[m][k]); \
            acc[ai][bj][m][n] = __builtin_amdgcn_mfma_f32_16x16x32_fp8_fp8(_b[0], _a[0], acc[ai][bj][m][n], 0, 0, 0); \
            acc[ai][bj][m][n] = __builtin_amdgcn_mfma_f32_16x16x32_fp8_fp8(_b[1], _a[1], acc[ai][bj][m][n], 0, 0, 0); } \
        else acc[ai][bj][m][n] = __builtin_amdgcn_mfma_f32_16x16x32_bf16(Bt[n][k], At[m][k], acc[ai][bj][m][n], 0, 0, 0); } } } \
        __builtin_amdgcn_s_setprio(0); } while (0)
#define PG8_WAIT_V(n) asm volatile("s_waitcnt vmcnt(" #n ")" ::: "memory")
#define PG8_WAIT_L(n) asm volatile("s_waitcnt lgkmcnt(" #n ")" ::: "memory")
#define PG8_BAR __builtin_amdgcn_s_barrier()
#define PG8_SCHED __builtin_amdgcn_sched_barrier(0)
    typename Sched::Unit cur, nxt; int ui = 0;
    if (!S.next(0, cur)) return;
    f32x4 acc[2][2][4][2];
#pragma unroll
    for (int a = 0; a < 2; ++a)
#pragma unroll
        for (int b = 0; b < 2; ++b)
#pragma unroll
            for (int m = 0; m < 4; ++m)
#pragma unroll
                for (int n = 0; n < 2; ++n) acc[a][b][m][n] = (f32x4){0.f, 0.f, 0.f, 0.f};
    bf16x8 At[4][2], B0[2][2], B1[2][2];
    constexpr bool GATHER = Sched::GATHER;
    unsigned oc[2][2], on[2][2] = {{0u, 0u}, {0u, 0u}};
    size_t ubc[2] = {0, 0}, ubn[2] = {0, 0};
#pragma unroll
    for (int h = 0; h < 2; ++h) {
        if (!GATHER) ubc[h] = (size_t)S.a_off(cur, h * HALF) * 2u;
#pragma unroll
        for (int i = 0; i < 2; ++i) oc[h][i] = GATHER ? (S.a_off(cur, h * HALF + Ra[i]) + (unsigned)Ca[i]) * 2u : (unsigned)(Ra[i] * S.lda + Ca[i]) * 2u;
    }
    const char* gA = (const char*)Aop;
    const char* cB = (const char*)S.b_base(cur);
    PG8_STAGE(PG8_SB(0, 0), cB, voffB); PG8_STAGE(PG8_SB(0, 1), cB + hstep, voffB); PG8_STAGE(PG8_SA(0, 0), gA + ubc[0], oc[0]); PG8_STAGE(PG8_SA(0, 1), gA + ubc[1], oc[1]);
    if (wr == 1) PG8_BAR;
    PG8_WAIT_V(2); PG8_BAR;
    PG8_STAGE(PG8_SB(1, 0), cB + kstep, voffB); PG8_STAGE(PG8_SA(1, 0), gA + ubc[0] + kstep, oc[0]); PG8_STAGE(PG8_SB(1, 1), cB + hstep + kstep, voffB);
    PG8_WAIT_V(6); PG8_BAR;
    for (;;) {
        const bool has_next = S.next(ui + 1, nxt);
        const char* nB = has_next ? (const char*)S.b_base(nxt) : cB;
#pragma unroll
        for (int h = 0; h < 2; ++h) {
            if (!GATHER) ubn[h] = has_next ? (size_t)S.a_off(nxt, h * HALF) * 2u : ubc[h];
#pragma unroll
            for (int i = 0; i < 2; ++i) if (GATHER) { int R, C; stage_rc(((wid << 6) | lane_now()) * 16 + i * 8192, R, C);
                const unsigned* ip = S.a_ptr(nxt, h * HALF + R); if (epi_fp8<Epi>::value != 2) asm volatile("global_load_dword %0, %1, off" : "=v"(on[h][i]) : "v"(ip) : "memory"); }
        }
        const bool full = cur.half < 0;
        for (int t = 0; t < nt; t += 2) {
            const bool last = (t == nt - 2);
            const char* a1 = gA + (size_t)(t + 1) * kstep;
            const char* a2 = last ? gA : gA + (size_t)(t + 2) * kstep; const char* b2 = last ? nB : cB + (size_t)(t + 2) * kstep;
            const char* a3 = a2 + kstep; const char* b3 = b2 + kstep;
            size_t u2[2];
            if (GATHER && last) {
                if (epi_fp8<Epi>::value != 2) asm volatile("" : "+v"(on[0][0]), "+v"(on[0][1]), "+v"(on[1][0]), "+v"(on[1][1]));
#pragma unroll
                for (int i = 0; i < 2; ++i) { int R, C; stage_rc(((wid << 6) | lane_now()) * 16 + i * 8192, R, C);
                    if (epi_fp8<Epi>::value == 2) { on[0][i] = *S.a_ptr(nxt, R); on[1][i] = *S.a_ptr(nxt, HALF + R); }
                    oc[0][i] = (S.a_cvt(on[0][i]) + (unsigned)C) * 2u; on[1][i] = (S.a_cvt(on[1][i]) + (unsigned)C) * 2u; }
            }
#pragma unroll
            for (int h = 0; h < 2; ++h) u2[h] = last ? ubn[h] : ubc[h];
            PG8_LDB(B0, 0, 0); PG8_LDB(B1, 0, 1); PG8_SCHED; PG8_LDA(At, 0, 0); PG8_STAGE(PG8_SA(1, 1), a1 + ubc[1], oc[1]);
            if (GATHER && last) { oc[1][0] = on[1][0]; oc[1][1] = on[1][1]; }
            PG8_WAIT_V(8); PG8_WAIT_L(0); PG8_BAR; PG8_MMA(0, 0, At, B0); PG8_MMA(0, 1, At, B1); PG8_BAR; PG8_SCHED;
            PG8_LDA(At, 0, 1); PG8_STAGE(PG8_SB(0, 0), b2, voffB); PG8_STAGE(PG8_SB(0, 1), b2 + hstep, voffB); PG8_STAGE(PG8_SA(0, 0), a2 + u2[0], oc[0]);
            PG8_WAIT_V(8); PG8_WAIT_L(0); PG8_BAR; if (full) { PG8_MMA(1, 0, At, B0); PG8_MMA(1, 1, At, B1); } PG8_BAR; PG8_SCHED;
            PG8_LDB(B0, 1, 0); PG8_LDB(B1, 1, 1); PG8_SCHED; PG8_LDA(At, 1, 0); PG8_STAGE(PG8_SA(0, 1), a2 + u2[1], oc[1]);
            PG8_WAIT_V(8); PG8_WAIT_L(0); PG8_BAR; PG8_MMA(0, 0, At, B0); PG8_MMA(0, 1, At, B1); PG8_BAR; PG8_SCHED;
            PG8_LDA(At, 1, 1); PG8_STAGE(PG8_SB(1, 0), b3, voffB); PG8_STAGE(PG8_SB(1, 1), b3 + hstep, voffB); PG8_STAGE(PG8_SA(1, 0), a3 + u2[0], oc[0]);
            PG8_WAIT_V(8); PG8_WAIT_L(0); PG8_BAR; if (full) { PG8_MMA(1, 0, At, B0); PG8_MMA(1, 1, At, B1); } PG8_BAR; PG8_SCHED;
        }
        if (wr == 0) PG8_BAR;
        { const int ln = lane_now(); E(acc, cur, wr, wc, ln & 15, ln >> 4); }
        if (!has_next) break;
#pragma unroll
        for (int a = 0; a < 2; ++a)
#pragma unroll
            for (int b = 0; b < 2; ++b)
#pragma unroll
                for (int m = 0; m < 4; ++m)
#pragma unroll
                    for (int n = 0; n < 2; ++n) acc[a][b][m][n] = (f32x4){0.f, 0.f, 0.f, 0.f};
        cur = nxt; cB = nB; ++ui;
#pragma unroll
        for (int h = 0; h < 2; ++h) ubc[h] = ubn[h];
        if (wr == 1) PG8_BAR;
    }
    PG8_WAIT_V(0);
    PG8_BAR;
#undef PG8_SA
#undef PG8_SB
#undef PG8_STAGE
#undef PG8_LDA
#undef PG8_LDB
#undef PG8_MMA
#undef PG8_WAIT_V
#undef PG8_WAIT_L
#undef PG8_BAR
#undef PG8_SCHED
}
}

struct DenseSched {
    static constexpr bool GATHER = false;
    struct Unit { int pm, pn, half; };
    int nM, nN, nwg, G, c; const bf16_t* Bt; int K, lda; bool skip_ctx;
    DI void unit_of(int L, Unit& u) const {
        int wgid = L; { const int q = nwg / 8, r = nwg % 8, xcd = wgid % 8, off = wgid / 8; wgid = (xcd < r ? xcd * (q + 1) : r * (q + 1) + (xcd - r) * q) + off; }
        const int nig = 8 * nN, gid = wgid / nig, fm = gid * 8, gsz = (nM - fm) < 8 ? (nM - fm) : 8;
        u.pm = fm + ((wgid % nig) % gsz); u.pn = (wgid % nig) / gsz;
        if (skip_ctx) u.pm += u.pm >> 4;
    }
    DI bool next(int i, Unit& u) const {
        const int rounds = nwg / G, rem = nwg - rounds * G;
        if (i < rounds) { unit_of(i * G + c, u); u.half = -1; return true; }
        if (i > rounds || rem == 0) return false;
        if (2 * rem <= G) { if (c >= 2 * rem) return false; unit_of(rounds * G + (c >> 1), u); u.half = c & 1; return true; }
        if (c >= rem) return false;
        unit_of(rounds * G + c, u); u.half = -1; return true;
    }
    DI unsigned a_off(const Unit& u, int row) const { const int rr = u.half < 0 ? row : u.half * 128 + (row & 127); return (unsigned)(u.pm * 256 + rr) * (unsigned)lda; }
    DI const unsigned* a_ptr(const Unit&, int) const { return nullptr; }
    DI unsigned a_cvt(unsigned raw) const { return raw; }
    DI const bf16_t* b_base(const Unit& u) const { return Bt + (size_t)u.pn * 256 * K; }
};
struct MoeUnit { int e, pn, valid, half; const unsigned* ent; };
template <bool TAIL>
struct MoeSched {
    static constexpr bool GATHER = true;
    typedef MoeUnit Unit;
    const LAS int* tab; const unsigned* list; const unsigned* zero  ; const bf16_t* W; int K, N, TN, lda, shift, G, c, nwg;
    DI bool unit_of(int L, Unit& u) const {
        const int v = tab[1 + (lane_now() & 31)];
        const int e = __builtin_popcount((unsigned)__ballot(v <= L));
        if (e >= NEXP) return false;
        const int rem = L - __builtin_amdgcn_readfirstlane(tab[e]), cn = __builtin_amdgcn_readfirstlane(tab[40 + e]);
        const int rt = rem / TN; u.e = e; u.pn = rem - rt * TN; u.ent = list + (size_t)e * MROWS + rt * 256; u.valid = min(256, cn - rt * 256); return true;
    }
    int lo, n, GX, j;
    DI void place() { GX = G >> 3; j = c >> 3; const int per = ((((nwg + 7) >> 3) + TN - 1) / TN) * TN; lo = (c & 7) * per; n = max(0, min(per, nwg - lo)); }
    DI bool next(int i, Unit& u) const {
        u.ent = zero; u.valid = 1;
        const int rounds = n / GX, rem = n - rounds * GX;
        if (!TAIL) { u.half = -1; if (i >= rounds) return false; return unit_of(lo + i * GX + j, u); }
        if (i > 0 || rem == 0) return false;
        if (2 * rem <= GX) {
            if (j >= 2 * rem) return false;
            if (!unit_of(lo + rounds * GX + (j >> 1), u)) return false;
            u.half = j & 1; u.ent += u.half * 128; u.valid = min(128, u.valid - u.half * 128);
            return u.valid > 0;
        }
        u.half = -1; if (j >= rem) return false;
        return unit_of(lo + rounds * GX + j, u);
    }
    DI unsigned a_off(const Unit& u, int row) const { const int rr = (TAIL && u.half >= 0) ? (row & 127) : row; return (u.ent[rr < u.valid ? rr : u.valid - 1] >> shift) * (unsigned)lda; }
    DI const unsigned* a_ptr(const Unit& u, int row) const { const int rr = (TAIL && u.half >= 0) ? (row & 127) : row; return u.ent + (rr < u.valid ? rr : u.valid - 1); }
    DI unsigned a_cvt(unsigned raw) const { return (raw >> shift) * (unsigned)lda; }
    DI const bf16_t* b_base(const Unit& u) const { return W + ((size_t)u.e * N + (size_t)u.pn * 256) * K; }
};
typedef float f32x4_t __attribute__((ext_vector_type(4)));
struct XEpiStore {
    static constexpr bool PERM = true;
    bf16_t* C; int ldc;
    DI void operator()(const f32x4 (&acc)[2][2][4][2], const DenseSched::Unit& u, int wr, int wc, int fr, int fq) const {
        const int row0 = u.pm * 256 + (u.half > 0 ? 128 : 0) + wr * 64 + fr, col0 = u.pn * 256 + wc * 32 + 8 * fq;
#pragma unroll
        for (int ai = 0; ai < 2; ++ai) if (ai == 0 || u.half < 0)
#pragma unroll
            for (int m = 0; m < 4; ++m) { bf16_t* rowp = C + (size_t)(row0 + ai * 128 + m * 16) * ldc + col0;
#pragma unroll
                for (int bj = 0; bj < 2; ++bj) { const f32x4 v0 = acc[ai][bj][m][0], v1 = acc[ai][bj][m][1];
                    u32x4 w; w.x = cvtpk(v0[0], v0[1]); w.y = cvtpk(v0[2], v0[3]); w.z = cvtpk(v1[0], v1[1]); w.w = cvtpk(v1[2], v1[3]);
                    *(u32x4*)(rowp + bj * 128) = w; } }
    } };
struct XEpiStore8 {
    static constexpr bool PERM = true;
    bf16_t* C; int ldc;
    DI void operator()(const f32x4 (&acc)[2][2][4][2], const DenseSched::Unit& u, int wr, int wc, int fr, int fq) const {
        const int row0 = u.pm * 256 + (u.half > 0 ? 128 : 0) + wr * 64 + fr, col0 = u.pn * 256 + wc * 32 + 8 * fq;
#pragma unroll
        for (int ai = 0; ai < 2; ++ai) if (ai == 0 || u.half < 0)
#pragma unroll
            for (int m = 0; m < 4; ++m) { bf16_t* rowp = C + (size_t)(row0 + ai * 128 + m * 16) * ldc + col0;
#pragma unroll
                for (int bj = 0; bj < 2; ++bj) { const f32x4 v0 = acc[ai][bj][m][0] * (1.0f / 32.0f), v1 = acc[ai][bj][m][1] * (1.0f / 32.0f);
                    u32x4 w; w.x = cvtpk(v0[0], v0[1]); w.y = cvtpk(v0[2], v0[3]); w.z = cvtpk(v1[0], v1[1]); w.w = cvtpk(v1[2], v1[3]);
                    *(u32x4*)(rowp + bj * 128) = w; } }
    } };
template <> struct epi_fp8<XEpiStore8> { static constexpr int value = 2; };
struct XEpiResid {
    static constexpr bool PERM = true;
    const Params* p; const float* mod;
    DI void operator()(const f32x4 (&acc)[2][2][4][2], const DenseSched::Unit& u, int wr, int wc, int fr, int fq) const {
        const int row0 = u.pm * 256 + (u.half > 0 ? 128 : 0) + wr * 64 + fr, col0 = u.pn * 256 + wc * 32 + 8 * fq;
#pragma unroll
        for (int ai = 0; ai < 2; ++ai) if (ai == 0 || u.half < 0)
#pragma unroll
            for (int m = 0; m < 4; ++m) { const int row = row0 + ai * 128 + m * 16;
                bf16_t* xr = xb_row(*p, row) + col0; const float* gp = mod + (size_t)mod_row(row) * 6144 + 2048 + col0;
#pragma unroll
                for (int bj = 0; bj < 2; ++bj) {
                    const u32x4 xw = *(const u32x4*)(xr + bj * 128); const f32x4 g0 = *(const f32x4*)(gp + bj * 128), g1 = *(const f32x4*)(gp + bj * 128 + 4);
                    const f32x4 a0 = acc[ai][bj][m][0], a1 = acc[ai][bj][m][1];
                    u32x4 w;
                    w.x = cvtpk(bflo(xw.x) + g0[0] * a0[0], bfhi(xw.x) + g0[1] * a0[1]); w.y = cvtpk(bflo(xw.y) + g0[2] * a0[2], bfhi(xw.y) + g0[3] * a0[3]);
                    w.z = cvtpk(bflo(xw.z) + g1[0] * a1[0], bfhi(xw.z) + g1[1] * a1[1]); w.w = cvtpk(bflo(xw.w) + g1[2] * a1[2], bfhi(xw.w) + g1[3] * a1[3]);
                    *(u32x4*)(xr + bj * 128) = w; } }
    } };
struct XEpiResid8 {
    static constexpr bool PERM = true;
    const Params* p; const float* mod;
    DI void operator()(const f32x4 (&acc)[2][2][4][2], const DenseSched::Unit& u, int wr, int wc, int fr, int fq) const {
        const int row0 = u.pm * 256 + (u.half > 0 ? 128 : 0) + wr * 64 + fr, col0 = u.pn * 256 + wc * 32 + 8 * fq;
#pragma unroll
        for (int ai = 0; ai < 2; ++ai) if (ai == 0 || u.half < 0)
#pragma unroll
            for (int m = 0; m < 4; ++m) { const int row = row0 + ai * 128 + m * 16;
                bf16_t* xr = xb_row(*p, row) + col0; const float* gp = mod + (size_t)mod_row(row) * 6144 + 2048 + col0;
#pragma unroll
                for (int bj = 0; bj < 2; ++bj) {
                    const u32x4 xw = *(const u32x4*)(xr + bj * 128); const f32x4 g0 = *(const f32x4*)(gp + bj * 128) * (1.0f / 32.0f), g1 = *(const f32x4*)(gp + bj * 128 + 4) * (1.0f / 32.0f);
                    const f32x4 a0 = acc[ai][bj][m][0], a1 = acc[ai][bj][m][1];
                    u32x4 w;
                    w.x = cvtpk(bflo(xw.x) + g0[0] * a0[0], bfhi(xw.x) + g0[1] * a0[1]); w.y = cvtpk(bflo(xw.y) + g0[2] * a0[2], bfhi(xw.y) + g0[3] * a0[3]);
                    w.z = cvtpk(bflo(xw.z) + g1[0] * a1[0], bfhi(xw.z) + g1[1] * a1[1]); w.w = cvtpk(bflo(xw.w) + g1[2] * a1[2], bfhi(xw.w) + g1[3] * a1[3]);
                    *(u32x4*)(xr + bj * 128) = w; } }
    } };
template <> struct epi_fp8<XEpiResid8> { static constexpr int value = 2; };
struct XEpiGlu {
    static constexpr bool PERM = true;
    bf16_t* act; const float* gates;
    DI void operator()(const f32x4 (&acc)[2][2][4][2], const MoeUnit& u, int wr, int wc, int fr, int fq) const {
#pragma unroll
        for (int ai = 0; ai < 2; ++ai)
#pragma unroll
            for (int m = 0; m < 4; ++m) { const int i = ai * 128 + wr * 64 + m * 16 + fr;
                if (i < u.valid) { const unsigned a = u.ent[i]; const float gw = gates[a];
                    const f32x4 g0 = acc[ai][0][m][0], g1 = acc[ai][0][m][1], u0 = acc[ai][1][m][0], u1 = acc[ai][1][m][1];
                    float v[8];
#pragma unroll
                    for (int j = 0; j < 4; ++j) { v[j] = silu_f(g0[j]) * u0[j] * gw; v[4 + j] = silu_f(g1[j]) * u1[j] * gw; }
                    u32x4 w; w.x = cvtpk(v[0], v[1]); w.y = cvtpk(v[2], v[3]); w.z = cvtpk(v[4], v[5]); w.w = cvtpk(v[6], v[7]);
                    *(u32x4*)(act + (size_t)a * DEXP + u.pn * 128 + wc * 32 + 8 * fq) = w; } }
    } };
struct XEpiGlu8 : XEpiGlu {
    DI void operator()(const f32x4 (&acc)[2][2][4][2], const MoeUnit& u, int wr, int wc, int fr, int fq) const {
#pragma unroll
        for (int ai = 0; ai < 2; ++ai)
#pragma unroll
            for (int m = 0; m < 4; ++m) { const int i = ai * 128 + wr * 64 + m * 16 + fr;
                if (i < u.valid) { const unsigned a = u.ent[i]; const float gw = gates[a] * (1.0f / 32.0f);
                    const f32x4 g0 = acc[ai][0][m][0] * (1.0f / 32.0f), g1 = acc[ai][0][m][1] * (1.0f / 32.0f), u0 = acc[ai][1][m][0], u1 = acc[ai][1][m][1];
                    float v[8];
#pragma unroll
                    for (int j = 0; j < 4; ++j) { v[j] = silu_f(g0[j]) * u0[j] * gw; v[4 + j] = silu_f(g1[j]) * u1[j] * gw; }
                    u32x4 w; w.x = cvtpk(v[0], v[1]); w.y = cvtpk(v[2], v[3]); w.z = cvtpk(v[4], v[5]); w.w = cvtpk(v[6], v[7]);
                    *(u32x4*)(act + (size_t)a * DEXP + u.pn * 128 + wc * 32 + 8 * fq) = w; } }
    } };
template <> struct epi_fp8<XEpiGlu8> { static constexpr int value = 2; };
struct XEpiScatter {
    static constexpr bool PERM = true;
    bf16_t* outp;
    DI void operator()(const f32x4 (&acc)[2][2][4][2], const MoeUnit& u, int wr, int wc, int fr, int fq) const {
#pragma unroll
        for (int ai = 0; ai < 2; ++ai)
#pragma unroll
            for (int m = 0; m < 4; ++m) { const int i = ai * 128 + wr * 64 + m * 16 + fr;
                if (i < u.valid) { unsigned char* rowp = (unsigned char*)outp + (size_t)u.ent[i] * 1024 + u.pn * 256 + wc * 32 + 8 * fq;
#pragma unroll
                    for (int bj = 0; bj < 2; ++bj) { const f32x4 v0 = acc[ai][bj][m][0] * 16.f, v1 = acc[ai][bj][m][1] * 16.f;
                        u32x2 w; w.x = cvt_fp8x4(v0[0], v0[1], v0[2], v0[3]); w.y = cvt_fp8x4(v1[0], v1[1], v1[2], v1[3]);
                        *(u32x2*)(rowp + bj * 128) = w; } } }
    } };

template <int KIND>
struct XEpiQKV {
    static constexpr bool PERM = true;
    static constexpr int KW = KIND == 1 ? 256 : 1024, LDRAW = KIND == 1 ? 1536 : 3072;
    static constexpr float ASC = 1.0f / 32.0f;
    bf16_t* Q; bf16_t* Kb; bf16_t* RAW; const float* qn; const float* kn;
    DI void operator()(const f32x4 (&acc)[2][2][4][2], const DenseSched::Unit& u, int wr, int wc, int fr, int fq) const {
        const int col0 = u.pn * 256, row0 = u.pm * 256 + (u.half > 0 ? 128 : 0) + wr * 64 + fr;
        if (col0 >= 1024 + KW) {
#pragma unroll
            for (int ai = 0; ai < 2; ++ai) if (ai == 0 || u.half < 0)
#pragma unroll
                for (int m = 0; m < 4; ++m) { bf16_t* rowp = RAW + (size_t)(row0 + ai * 128 + m * 16) * LDRAW + col0 + wc * 32 + 8 * fq;
#pragma unroll
                    for (int bj = 0; bj < 2; ++bj) { const f32x4 v0 = acc[ai][bj][m][0] * ASC, v1 = acc[ai][bj][m][1] * ASC;
                        u32x4 w; w.x = cvtpk(v0[0], v0[1]); w.y = cvtpk(v0[2], v0[3]); w.z = cvtpk(v1[0], v1[1]); w.w = cvtpk(v1[2], v1[3]);
                        *(u32x4*)(rowp + bj * 128) = w; } }
            return;
        }
        const bool isq = col0 < 1024;
        const int head = isq ? 4 * u.pn + wc : ((col0 - 1024) >> 6) + wc;
        const float* gain = (isq ? qn : kn) + 8 * fq;
        const float scale = isq ? 0.125f * LOG2E : 1.0f;
        bf16_t* dstb = isq ? Q + head * 64 + 8 * fq : Kb + head * 64 + 8 * fq;
        const int ldd = isq ? 1024 : KW;
        f32x4 g[2][2];
#pragma unroll
        for (int bj = 0; bj < 2; ++bj)
#pragma unroll
            for (int n = 0; n < 2; ++n) g[bj][n] = *(const f32x4*)(gain + 32 * bj + 4 * n);
#pragma unroll
        for (int ai = 0; ai < 2; ++ai) if (ai == 0 || u.half < 0)
#pragma unroll
            for (int m = 0; m < 4; ++m) {
                const int row = row0 + ai * 128 + m * 16, b = row / PP, pos = row - b * PP;
                f32x4 v[2][2];
                float ss = 0.f;
#pragma unroll
                for (int bj = 0; bj < 2; ++bj)
#pragma unroll
                    for (int n = 0; n < 2; ++n) { v[bj][n] = acc[ai][bj][m][n] * ASC; ss += v[bj][n][0] * v[bj][n][0] + v[bj][n][1] * v[bj][n][1] + v[bj][n][2] * v[bj][n][2] + v[bj][n][3] * v[bj][n][3]; }
                ss += __shfl_xor(ss, 16); ss += __shfl_xor(ss, 32);
                const float rs = rsqrtf(ss * (1.0f / 64.0f) + EPS);
#pragma unroll
                for (int bj = 0; bj < 2; ++bj)
#pragma unroll
                    for (int n = 0; n < 2; ++n) v[bj][n] = v[bj][n] * rs * g[bj][n];
                if (KIND != 0 && pos < SEQ) {
                    const int prow = (pos >> 6) & 63, pcol = pos & 63;
                    const float* cs = ROPE64 + ((fq < 2 ? prow : pcol) * 16 + ((8 * fq) & 15)) * 2;
#pragma unroll
                    for (int n = 0; n < 2; ++n)
#pragma unroll
                        for (int j = 0; j < 4; ++j) {
                            const float c = cs[(4 * n + j) * 2], sn = cs[(4 * n + j) * 2 + 1], x1 = v[0][n][j], x2 = v[1][n][j];
                            v[0][n][j] = x1 * c - x2 * sn; v[1][n][j] = x2 * c + x1 * sn;
                        }
                }
                bf16_t* rowp = dstb + (size_t)row * ldd;
#pragma unroll
                for (int bj = 0; bj < 2; ++bj) { const f32x4 v0 = v[bj][0] * scale, v1 = v[bj][1] * scale;
                    u32x4 w; w.x = cvtpk(v0[0], v0[1]); w.y = cvtpk(v0[2], v0[3]); w.z = cvtpk(v1[0], v1[1]); w.w = cvtpk(v1[2], v1[3]);
                    *(u32x4*)(rowp + bj * 32) = w; }
            }
    } };
constexpr bool qkv_fp8(int kind) { return true; }
template <int KIND> struct epi_fp8<XEpiQKV<KIND>> { static constexpr int value = 2; };
template <int KIND>
DI void gemm_qkv_x(const Params& p, unsigned char* smem, const bf16_t* Wt, int N, const float* qn, const float* kn, int bid, int nb, int tid) {
    constexpr int KU = qkv_fp8(KIND) ? 512 : 1024;
    DenseSched S; S.nM = MROWS / 256; S.nN = N / 256; S.nwg = S.nM * S.nN; S.G = nb; S.c = bid; S.Bt = Wt; S.K = KU; S.lda = KU; S.skip_ctx = false;
    XEpiQKV<KIND> e{(bf16_t*)(p.ws + WS_Q), (bf16_t*)(p.ws + WS_K), (bf16_t*)(p.ws + WS_RAW), qn, kn};
    pg8::gemm_phase((lds_ptr)smem, (const bf16_t*)(p.ws + WS_H), KU, S, e, tid);
}
template <bool UQ>
struct XEpiMla {
    static constexpr bool PERM = true;
    static constexpr float ASC = 1.0f / 32.0f;
    bf16_t* Q; bf16_t* Kb; bf16_t* V; const float* qn; const float* kn;
    DI void operator()(const f32x4 (&acc)[2][2][4][2], const DenseSched::Unit& u, int wr, int wc, int fr, int fq) const {
        const int row0 = u.pm * 256 + (u.half > 0 ? 128 : 0) + wr * 64 + fr;
        if (u.pn < 4) {
            const int head = 4 * u.pn + wc;
            const float* gain = (UQ ? qn : kn) + 8 * fq;
            const float scale = UQ ? 0.10206207261596577f * LOG2E : 1.0f;
            bf16_t* dstb = (UQ ? Q : Kb) + head * 96 + 8 * fq;
            f32x4 g[2][2];
#pragma unroll
            for (int bj = 0; bj < 2; ++bj)
#pragma unroll
                for (int n = 0; n < 2; ++n) g[bj][n] = *(const f32x4*)(gain + 32 * bj + 4 * n);
#pragma unroll
            for (int ai = 0; ai < 2; ++ai) if (ai == 0 || u.half < 0)
#pragma unroll
                for (int m = 0; m < 4; ++m) {
                    const int row = row0 + ai * 128 + m * 16;
                    float ss = 0.f;
#pragma unroll
                    for (int bj = 0; bj < 2; ++bj)
#pragma unroll
                        for (int n = 0; n < 2; ++n) { const f32x4 v = acc[ai][bj][m][n] * ASC; ss += v[0] * v[0] + v[1] * v[1] + v[2] * v[2] + v[3] * v[3]; }
                    ss += __shfl_xor(ss, 16); ss += __shfl_xor(ss, 32);
                    const float rs = rsqrtf(ss * (1.0f / 64.0f) + EPS) * scale;
                    bf16_t* rowp = dstb + (size_t)row * 1536;
#pragma unroll
                    for (int bj = 0; bj < 2; ++bj) { const f32x4 v0 = acc[ai][bj][m][0] * (ASC * rs) * g[bj][0], v1 = acc[ai][bj][m][1] * (ASC * rs) * g[bj][1];
                        u32x4 w; w.x = cvtpk(v0[0], v0[1]); w.y = cvtpk(v0[2], v0[3]); w.z = cvtpk(v1[0], v1[1]); w.w = cvtpk(v1[2], v1[3]);
                        *(u32x4*)(rowp + bj * 32) = w; }
                }
        } else if (UQ) {
            const float scale = 0.10206207261596577f * LOG2E;
            const f32x4 g1 = *(const f32x4*)(qn + 64 + 4 * fq), g2 = *(const f32x4*)(qn + 64 + 16 + 4 * fq);
#pragma unroll
            for (int ai = 0; ai < 2; ++ai) if (ai == 0 || u.half < 0)
#pragma unroll
                for (int m = 0; m < 4; ++m) {
                    const int row = row0 + ai * 128 + m * 16, b = row / PP, pos = row - b * PP;
                    const int prow = (pos >> 6) & 63, pcol = pos & 63;
                    const float* cs = ROPE32 + ((fq < 2 ? prow : pcol) * 8 + ((4 * fq) & 7)) * 2;
#pragma unroll
                    for (int bj = 0; bj < 2; ++bj) {
                        f32x4 x1 = acc[ai][bj][m][0] * ASC, x2 = acc[ai][bj][m][1] * ASC;
                        float ss = x1[0] * x1[0] + x1[1] * x1[1] + x1[2] * x1[2] + x1[3] * x1[3] + x2[0] * x2[0] + x2[1] * x2[1] + x2[2] * x2[2] + x2[3] * x2[3];
                        ss += __shfl_xor(ss, 16); ss += __shfl_xor(ss, 32);
                        const float rs = rsqrtf(ss * (1.0f / 32.0f) + EPS);
                        x1 = x1 * rs * g1; x2 = x2 * rs * g2;
                        if (pos < SEQ) {
#pragma unroll
                            for (int j = 0; j < 4; ++j) { const float c = cs[2 * j], sn = cs[2 * j + 1], a1 = x1[j], a2 = x2[j]; x1[j] = a1 * c - a2 * sn; x2[j] = a2 * c + a1 * sn; }
                        }
                        x1 = x1 * scale; x2 = x2 * scale;
                        bf16_t* rowp = Q + (size_t)row * 1536 + (8 * (u.pn - 4) + 4 * bj + wc) * 96 + 64 + 4 * fq;
                        u32x2 w1, w2; w1.x = cvtpk(x1[0], x1[1]); w1.y = cvtpk(x1[2], x1[3]); w2.x = cvtpk(x2[0], x2[1]); w2.y = cvtpk(x2[2], x2[3]);
                        *(u32x2*)rowp = w1; *(u32x2*)(rowp + 16) = w2;
                    }
                }
        } else {
#pragma unroll
            for (int ai = 0; ai < 2; ++ai) if (ai == 0 || u.half < 0)
#pragma unroll
                for (int m = 0; m < 4; ++m) { bf16_t* rowp = V + (size_t)(row0 + ai * 128 + m * 16) * 1024 + (u.pn - 4) * 256 + wc * 32 + 8 * fq;
#pragma unroll
                    for (int bj = 0; bj < 2; ++bj) { const f32x4 v0 = acc[ai][bj][m][0] * ASC, v1 = acc[ai][bj][m][1] * ASC;
                        u32x4 w; w.x = cvtpk(v0[0], v0[1]); w.y = cvtpk(v0[2], v0[3]); w.z = cvtpk(v1[0], v1[1]); w.w = cvtpk(v1[2], v1[3]);
                        *(u32x4*)(rowp + bj * 128) = w; } }
        }
    } };
template <bool UQ> struct epi_fp8<XEpiMla<UQ>> { static constexpr int value = 2; };
template <bool UQ>
DI void gemm_mla_x(const Params& p, unsigned char* smem, int bid, int nb, int tid) {
    bf16_t* O = (bf16_t*)(p.ws + WS_O);
    DenseSched S; S.nM = MROWS / 256; S.nN = (UQ ? 1536 : 2048) / 256; S.nwg = S.nM * S.nN; S.G = nb; S.c = bid; S.Bt = (const bf16_t*)(p.ws + (UQ ? W_UQ : W_UKV)); S.K = UQ ? 256 : 128; S.lda = S.K; S.skip_ctx = false;
    XEpiMla<UQ> e{(bf16_t*)(p.ws + WS_Q), (bf16_t*)(p.ws + WS_K), (bf16_t*)(p.ws + WS_RAW), p.in[28], p.in[29]};
    pg8::gemm_phase((lds_ptr)smem, UQ ? O : (const bf16_t*)((const unsigned char*)O + (size_t)MROWS * 512), S.K, S, e, tid);
}
template <int EPIK>
DI void gemm_dense_x(const Params& p, unsigned char* smem, const bf16_t* A, int lda, const bf16_t* Wt, int K, int N, bf16_t* C, int ldc, const float* mod, int bid, int nb, int tid, bool skip_ctx = false) {
    DenseSched S; S.nM = skip_ctx ? NBATCH * 16 : MROWS / 256; S.nN = N / 256; S.nwg = S.nM * S.nN; S.G = nb; S.c = bid; S.Bt = Wt; S.K = K; S.lda = lda; S.skip_ctx = skip_ctx;
    if (EPIK == 0) { XEpiStore e{C, ldc}; pg8::gemm_phase((lds_ptr)smem, A, K, S, e, tid); }
    else if (EPIK == 2) { XEpiStore8 e{C, ldc}; pg8::gemm_phase((lds_ptr)smem, A, K, S, e, tid); }
    else if (EPIK == 3) { XEpiResid8 e{&p, mod}; pg8::gemm_phase((lds_ptr)smem, A, K, S, e, tid); }
    else { XEpiResid e{&p, mod}; pg8::gemm_phase((lds_ptr)smem, A, K, S, e, tid); }
}
template <int WHICH, bool TAIL>
DI void gemm_moe_call(const Params& p, unsigned char* smem, int layer, int bid, int nb, int tid) {
    MoeSched<TAIL> S; S.list = (const unsigned*)(p.ws + WS_LIST); S.zero = (const unsigned*)(p.ws + WS_CTL) + 8192; S.G = nb; S.c = bid;
    {
        LAS int* tab = (LAS int*)(smem + GEMM_LDS);
        constexpr int TNc = WHICH == 0 ? 2 : 4;
        if (tid < 64) {
            const unsigned cv = tid < 32 ? ((const unsigned*)(p.ws + WS_CTL) + CW_CNT + layer * 32)[tid] : 0u;
            int incl = (int)((cv + 255u) >> 8) * TNc;
#pragma unroll
            for (int d = 1; d < 32; d <<= 1) { const int o = __shfl_up(incl, d); if (tid >= d) incl += o; }
            if (tid < 32) { tab[1 + tid] = incl; tab[40 + tid] = (int)cv; }
            if (tid == 0) tab[0] = 0;
        }
        __syncthreads();
        S.tab = tab; S.nwg = __builtin_amdgcn_readfirstlane(tab[32]);
    }
    if (WHICH == 0) { S.W = (const bf16_t*)(p.ws + W_GU + (size_t)layer * 32 * 512 * 1024); S.K = 512; S.N = 512; S.TN = 2; S.lda = 512; S.shift = 1;
        S.place(); XEpiGlu8 e{{(bf16_t*)(p.ws + WS_Q), (const float*)(p.ws + WS_GATE)}}; pg8::gemm_phase((lds_ptr)smem, (const bf16_t*)(p.ws + WS_H), 512, S, e, tid); }
    else { S.W = (const bf16_t*)(p.ws + W_DN) + (size_t)layer * 32 * 1024 * 256; S.K = 256; S.N = 1024; S.TN = 4; S.lda = DEXP; S.shift = 0;
        S.place(); XEpiScatter e{(bf16_t*)(p.ws + WS_RAW)}; pg8::gemm_phase((lds_ptr)smem, (const bf16_t*)(p.ws + WS_Q), 256, S, e, tid); }
}
template <int WHICH>
DI void gemm_moe_x(const Params& p, unsigned char* smem, int layer, int bid, int nb, int tid) {
    const int wv = __builtin_amdgcn_readfirstlane(tid >> 6);
    gemm_moe_call<WHICH, false>(p, smem, layer, bid, nb, (wv << 6) | lane_now());
    gemm_moe_call<WHICH, true>(p, smem, layer, bid, nb, (wv << 6) | lane_now());
}

constexpr int NPHASES = 2 + (7 + 7 + 9 + 7) + 1;
constexpr int SMEM_BYTES = GEMM_LDS + 512;

template <int KIND>
DI void layer_phases(const Params& p, int& ph, const int lo, const int hi, const XcdBarrier& bar, unsigned char* smem, int bid, int nb, int wid_u) {
    constexpr int L = KIND;
    const float* mod = (const float*)(p.ws + WS_MOD) + (size_t)L * 9 * 6144;
    bf16_t* H = (bf16_t*)(p.ws + WS_H); bf16_t* O = (bf16_t*)(p.ws + WS_O); bf16_t* RAW = (bf16_t*)(p.ws + WS_RAW);
    bf16_t* Q = (bf16_t*)(p.ws + WS_Q); bf16_t* Kb = (bf16_t*)(p.ws + WS_K);
#ifndef AABL
#define AABL 0
#endif
#ifndef GPROBE
#define GPROBE 0
#endif
#ifndef DUP_MASK
#define DUP_MASK 0ull
#endif
#define PHASE2(BODY, DUPBODY) do { if (lo <= ph && ph < hi) { const int tid = (wid_u << 6) | lane_now(); if ((DUP_MASK >> ph) & 1ull) { DUPBODY; xcd_barrier(bar, tid == 0); } BODY; } if (lo <= ph && ph + 1 < hi) xcd_barrier(bar, ((wid_u << 6) | lane_now()) == 0); ++ph; } while (0)
#define PHASE(...) PHASE2((__VA_ARGS__), (__VA_ARGS__))
    if (L == 0) PHASE(phase_rows<2 | 8 | 32>(p, L, 0, bid, nb, tid), phase_router_prep(p, bid, nb, tid));
    else PHASE2((phase_rows<3 | 32>(p, L, 0, bid, nb, tid)), (phase_rows<2 | 32>(p, L, 0, bid, nb, tid)));
    AttnP a{};
    if (KIND == 0) {
        PHASE(gemm_qkv_x<0>(p, smem, (const bf16_t*)(p.ws + W_QKV0), 3072, p.in[15], p.in[16], bid, nb, tid));
        a = AttnP{Q, 1024, Kb, 1024, RAW + 2048, 3072, O, 1024, 16, 0, 0, 64, p.in[17], nullptr, 1, p.in[16]};
        PHASE(attn_na(a, smem, bid, nb, tid));
        PHASE2((gemm_dense_x<3>(p, smem, O, 512, (const bf16_t*)(p.ws + W_O0), 512, 1024, nullptr, 0, mod, bid, nb, tid)), (gemm_dense_x<0>(p, smem, O, 1024, (const bf16_t*)(p.ws + W_O0), 1024, 1024, RAW, 1024, nullptr, bid, nb, tid)));
    } else if (KIND == 1) {
        PHASE(gemm_qkv_x<1>(p, smem, (const bf16_t*)(p.ws + W_QKV1), 1536, p.in[20], p.in[21], bid, nb, tid));
        a = AttnP{Q, 1024, Kb, 256, RAW + 1280, 1536, O, 1024, 16, 2, 2, 64, nullptr, p.in[22], 1};
        PHASE(attn_mfma<64, 64, 1>(a, smem, bid, nb, tid));
        PHASE2((gemm_dense_x<3>(p, smem, O, 512, (const bf16_t*)(p.ws + W_O1), 512, 1024, nullptr, 0, mod, bid, nb, tid)), (gemm_dense_x<0>(p, smem, O, 1024, (const bf16_t*)(p.ws + W_O1), 1024, 1024, RAW, 1024, nullptr, bid, nb, tid)));
    } else if (KIND == 2) {
        bf16_t* cqn = O; bf16_t* ckvn = O + (size_t)MROWS * 384;
        PHASE(gemm_dense_x<2>(p, smem, H, 512, (const bf16_t*)(p.ws + W_DQKV), 512, 768, Q, 768, nullptr, bid, nb, tid));
        PHASE(phase_post_mla1(p, bid, nb, tid));
        PHASE(gemm_mla_x<true>(p, smem, bid, nb, tid), gemm_mla_x<false>(p, smem, bid, nb, (wid_u << 6) | lane_now()));
        a = AttnP{Q, 1536, Kb, 1536, RAW, 1024, O, 1024, 16, 0, 0, 64, nullptr, nullptr, 1};
        PHASE(attn_mfma<96, 64, 2>(a, smem, bid, nb, tid));
        PHASE2((gemm_dense_x<3>(p, smem, O, 512, (const bf16_t*)(p.ws + W_O2), 512, 1024, nullptr, 0, mod, bid, nb, tid)), (gemm_dense_x<0>(p, smem, O, 1024, (const bf16_t*)(p.ws + W_O2), 1024, 1024, RAW, 1024, nullptr, bid, nb, tid)));
    } else {
        PHASE(gemm_qkv_x<3>(p, smem, (const bf16_t*)(p.ws + W_QKV3), 3072, p.in[32], p.in[33], bid, nb, tid));
        a = AttnP{Q, 1024, Kb, 1024, RAW + 2048, 3072, H  , 2048, 16, 0, 1, 128, nullptr, nullptr, 0, nullptr, p.in[34], p.in[35], (unsigned char*)RAW  , 6144};
        PHASE(attn_mfma<64, 128, 2>(a, smem, bid, nb, tid));
        PHASE(gemm_dense_x<3>(p, smem, RAW, 3072, (const bf16_t*)(p.ws + W_O3), 512, 1024, nullptr, 0, mod, bid, nb, tid, true));
    }
    PHASE(phase_router(p, smem, L, L == 3, bid, nb, tid));
    PHASE(gemm_moe_x<0>(p, smem, L, bid, nb, tid));
    PHASE(gemm_moe_x<1>(p, smem, L, bid, nb, tid));
}

__global__ void __launch_bounds__(NTHREADS, 2) mega(Params p, int lo, int hi) {
    extern __shared__ __attribute__((aligned(16))) unsigned char smem[];
    const int bid = blockIdx.x, nb = gridDim.x, wid_u = __builtin_amdgcn_readfirstlane(threadIdx.x >> 6);
    float* lds = (float*)smem;
    volatile LAS unsigned* xbw = (volatile LAS unsigned*)(smem + SMEM_BYTES - 16);
    if (threadIdx.x == 0) { xbw[0] = 0u; xbw[1] = 0u; }
    __syncthreads();
    XcdBarrier bar = xcd_barrier_post((unsigned*)(p.ws + WS_CTL), xbw);
    int ph = 0;
    PHASE(phase_prologue(p, lds, bid, nb, tid));
    PHASE(phase_mod_reduce(p, bid, nb, tid));
    layer_phases<0>(p, ph, lo, hi, bar, smem, bid, nb, wid_u);
    layer_phases<1>(p, ph, lo, hi, bar, smem, bid, nb, wid_u);
    layer_phases<2>(p, ph, lo, hi, bar, smem, bid, nb, wid_u);
    layer_phases<3>(p, ph, lo, hi, bar, smem, bid, nb, wid_u);
    PHASE2((phase_rows<1 | 16>(p, 3, 0, bid, nb, tid)), (void)0);
}

extern "C" void kernel_launch(void* const* d_in, const int* in_sizes, int n_in, void* d_out, int out_size, void* d_ws, size_t ws_size, hipStream_t stream) {
    (void)in_sizes; (void)out_size;
    if (n_in < 37 || ws_size < WS_END) { fprintf(stderr, "kernel_launch: unexpected inputs (n_in %d, ws %zu)\n", n_in, ws_size); return; }
    static int grid = 0;
    if (!grid) {
        int dev = 0, cus = 0, per_cu = 0;
        hipGetDevice(&dev);
        hipDeviceGetAttribute(&cus, hipDeviceAttributeMultiprocessorCount, dev);
        hipFuncSetAttribute((const void*)mega, hipFuncAttributeMaxDynamicSharedMemorySize, SMEM_BYTES);
        hipOccupancyMaxActiveBlocksPerMultiprocessor(&per_cu, mega, NTHREADS, SMEM_BYTES);
        if (per_cu < 1) per_cu = 1;
        grid = cus * (per_cu < 1 ? per_cu : 1);
    }
    Params p{};
    for (int i = 0; i < 37; ++i) p.in[i] = (const float*)d_in[i];
    p.out = (float*)d_out; p.ws = (unsigned char*)d_ws;
    hipMemsetAsync(p.ws + WS_CTL, 0, 65536, stream);
#if ONE_LAUNCH
    hipLaunchKernelGGL(mega, dim3(grid), dim3(NTHREADS), SMEM_BYTES, stream, p, 0, NPHASES);
#else
    for (int k = 0; k < NPHASES; ++k) hipLaunchKernelGGL(mega, dim3(grid), dim3(NTHREADS), SMEM_BYTES, stream, p, k, k + 1);
#endif
}
```

```cpp
#include <hip/hip_runtime.h>
#include <stdint.h>
#include <stdio.h>

#ifndef ONE_LAUNCH
#define ONE_LAUNCH 1
#endif

#define DI __device__ __forceinline__
typedef unsigned short bf16_t;
typedef short bf16x8 __attribute__((ext_vector_type(8)));
typedef float f32x4 __attribute__((ext_vector_type(4)));
typedef float f32x16 __attribute__((ext_vector_type(16)));
typedef unsigned u32x4 __attribute__((ext_vector_type(4)));
typedef unsigned u32x2 __attribute__((ext_vector_type(2)));

constexpr int DM = 1024, NBATCH = 8, SEQ = 4096, CTXL = 256, PP = SEQ + CTXL, MROWS = NBATCH * PP;
constexpr int NEXP = 32, DEXP = 256;
constexpr float EPS = 1e-6f, LOG2E = 1.4426950408889634f;
constexpr int NTHREADS = 512, NW = NTHREADS / 64;

constexpr size_t MiB = 1ull << 20;
constexpr size_t WS_RAW_FWD = 380ull << 20;
constexpr size_t WS_CTL = 0, CTL_BYTES = 1 * MiB;
constexpr size_t WS_MOD = 1 * MiB;
constexpr size_t WS_MODP = WS_RAW_FWD;
constexpr size_t WS_XCTX = 9 * MiB;
constexpr size_t WS_LIST = 17 * MiB;
constexpr size_t WS_GATE = 22 * MiB;
constexpr size_t WS_W = 24 * MiB;
constexpr size_t W_QKV0 = WS_W + 0 * MiB, W_O0 = WS_W + 6 * MiB, W_QKV1 = WS_W + 8 * MiB, W_O1 = WS_W + 11 * MiB, W_DQKV = WS_W + 13 * MiB,
                 W_UQ = WS_W + 15 * MiB, W_UKV = WS_W + 17 * MiB, W_O2 = WS_W + 18 * MiB, W_QKV3 = WS_W + 20 * MiB, W_O3 = WS_W + 26 * MiB,
                 W_GU = WS_W + 28 * MiB, W_DN = WS_W + 156 * MiB;
constexpr size_t WS_H = 244 * MiB;
constexpr size_t WS_O = 312 * MiB;
constexpr size_t WS_RAW = 380 * MiB;
constexpr size_t WS_Q = 620 * MiB;
constexpr size_t WS_K = 722 * MiB;
constexpr size_t WS_XB = 824 * MiB;
constexpr size_t WS_END = 892 * MiB;
constexpr int CW_CNT = 4096;

constexpr size_t WS_RW = 2 * MiB;
struct Params { const float* in[37]; float* out; unsigned char* ws; };

DI unsigned f2bf(float f) { unsigned u = __float_as_uint(f); return (u + 0x7fffu + ((u >> 16) & 1u)) >> 16; }
DI float bf2f(unsigned h) { return __uint_as_float(h << 16); }
DI unsigned pk2(float lo, float hi) { return f2bf(lo) | (f2bf(hi) << 16); }
DI float bflo(unsigned w) { return __uint_as_float(w << 16); }
DI float bfhi(unsigned w) { return __uint_as_float(w & 0xffff0000u); }
DI int lane_now() { unsigned lane; asm volatile("v_mbcnt_lo_u32_b32 %0, -1, 0\n\tv_mbcnt_hi_u32_b32 %0, -1, %0" : "=v"(lane)); return (int)lane; }
DI float wave_sum(float v) {
#pragma unroll
    for (int o = 32; o > 0; o >>= 1) v += __shfl_xor(v, o);
    return v;
}
DI float silu_f(float x) { return x / (1.0f + __expf(-x)); }
DI void unpack8(const u32x4 w, float (&f)[8]) {
    f[0] = bflo(w.x); f[1] = bfhi(w.x); f[2] = bflo(w.y); f[3] = bfhi(w.y); f[4] = bflo(w.z); f[5] = bfhi(w.z); f[6] = bflo(w.w); f[7] = bfhi(w.w);
}
DI u32x4 pack8(const float (&f)[8]) { u32x4 w; w.x = pk2(f[0], f[1]); w.y = pk2(f[2], f[3]); w.z = pk2(f[4], f[5]); w.w = pk2(f[6], f[7]); return w; }
DI float* xrow_ptr(const Params& p, int r) {
    const int b = r / PP, pos = r - b * PP;
    return pos < SEQ ? p.out + ((size_t)b * SEQ + pos) * DM : (float*)(p.ws + WS_XCTX) + ((size_t)b * CTXL + (pos - SEQ)) * DM;
}
DI bf16_t* xb_row(const Params& p, int r) { return (bf16_t*)(p.ws + WS_XB) + (size_t)r * DM; }
DI int mod_row(int r) { const int b = r / PP, pos = r - b * PP; return pos < SEQ ? b : 8; }
__device__ const float ROPE64[2048] = {
  1.000000000e+00f, 0.000000000e+00f, 1.000000000e+00f, 0.000000000e+00f, 1.000000000e+00f, 0.000000000e+00f, 1.000000000e+00f, 0.000000000e+00f,
  1.000000000e+00f, 0.000000000e+00f, 1.000000000e+00f, 0.000000000e+00f, 1.000000000e+00f, 0.000000000e+00f, 1.000000000e+00f, 0.000000000e+00f,
  1.000000000e+00f, 0.000000000e+00f, 1.000000000e+00f, 0.000000000e+00f, 1.000000000e+00f, 0.000000000e+00f, 1.000000000e+00f, 0.000000000e+00f,
  1.000000000e+00f, 0.000000000e+00f, 1.000000000e+00f, 0.000000000e+00f, 1.000000000e+00f, 0.000000000e+00f, 1.000000000e+00f, 0.000000000e+00f,
  5.403022766e-01f, 8.414709568e-01f, 8.460091352e-01f, 5.331684351e-01f, 9.504152536e-01f, 3.109835982e-01f, 9.842302203e-01f, 1.768921912e-01f,
  9.950041771e-01f, 9.983342141e-02f, 9.984192848e-01f, 5.620449781e-02f, 9.995000362e-01f, 3.161750361e-02f, 9.998418689e-01f, 1.778185740e-02f,
  9.999499917e-01f, 9.999833070e-03f, 9.999842048e-01f, 5.623383448e-03f, 9.999949932e-01f, 3.162272274e-03f, 9.999983907e-01f, 1.778278500e-03f,
  9.999995232e-01f, 9.999999311e-04f, 9.999998212e-01f, 5.623412435e-04f, 9.999999404e-01f, 3.162277571e-04f, 1.000000000e+00f, 1.778279402e-04f,
  -4.161468446e-01f, 9.092974067e-01f, 4.314628243e-01f, 9.021307230e-01f, 8.065783978e-01f, 5.911270976e-01f, 9.374182820e-01f, 3.482052684e-01f,
  9.800665975e-01f, 1.986693293e-01f, 9.936820865e-01f, 1.122313142e-01f, 9.980006814e-01f, 6.320339441e-02f, 9.993675947e-01f, 3.555808961e-02f,
  9.998000264e-01f, 1.999866590e-02f, 9.999367595e-01f, 1.124658901e-02f, 9.999799728e-01f, 6.324512884e-03f, 9.999936819e-01f, 3.556551412e-03f,
  9.999979734e-01f, 1.999998698e-03f, 9.999993443e-01f, 1.124682371e-03f, 9.999998212e-01f, 6.324554561e-04f, 9.999999404e-01f, 3.556558804e-04f,
  -9.899924994e-01f, 1.411200017e-01f, -1.159661636e-01f, 9.932531714e-01f, 5.827536583e-01f, 8.126488924e-01f, 8.610406518e-01f, 5.085361004e-01f,
  9.553365111e-01f, 2.955202162e-01f, 9.858034849e-01f, 1.679033041e-01f, 9.955033660e-01f, 9.472608566e-02f, 9.985772967e-01f, 5.332308263e-02f,
  9.995500445e-01f, 2.999549918e-02f, 9.998577237e-01f, 1.686943881e-02f, 9.999549985e-01f, 9.486690164e-03f, 9.999857545e-01f, 5.334813148e-03f,
  9.999955297e-01f, 2.999995602e-03f, 9.999985695e-01f, 1.687023090e-03f, 9.999995232e-01f, 9.486831259e-04f, 9.999998808e-01f, 5.334838061e-04f,
  -6.536436081e-01f, -7.568024993e-01f, -6.276797056e-01f, 7.784717083e-01f, 3.011374772e-01f, 9.535807371e-01f, 7.575061917e-01f, 6.528279781e-01f,
  9.210609794e-01f, 3.894183338e-01f, 9.748082757e-01f, 2.230444849e-01f, 9.920106530e-01f, 1.261540651e-01f, 9.974712729e-01f, 7.107120752e-02f,
  9.992001057e-01f, 3.998933360e-02f, 9.997470379e-01f, 2.249175683e-02f, 9.999200106e-01f, 1.264877338e-02f, 9.999747276e-01f, 7.113057654e-03f,
  9.999920130e-01f, 3.999989480e-03f, 9.999974966e-01f, 2.249363344e-03f, 9.999992251e-01f, 1.264910679e-03f, 9.999997616e-01f, 7.113117026e-04f,
  2.836622000e-01f, -9.589242935e-01f, -9.460792542e-01f, 3.239352703e-01f, -1.034233812e-02f, 9.999465346e-01f, 6.300802827e-01f, 7.765299678e-01f,
  8.775825500e-01f, 4.794255495e-01f, 9.607312679e-01f, 2.774805427e-01f, 9.875259995e-01f, 1.574558765e-01f, 9.960497618e-01f, 8.879686147e-02f,
  9.987502694e-01f, 4.997916520e-02f, 9.996047616e-01f, 2.811336145e-02f, 9.998750091e-01f, 1.581072807e-02f, 9.999604821e-01f, 8.891279809e-03f,
  9.999874830e-01f, 4.999979399e-03f, 9.999960661e-01f, 2.811702900e-03f, 9.999987483e-01f, 1.581138116e-03f, 9.999995828e-01f, 8.891395992e-04f,
  9.601702690e-01f, -2.794154882e-01f, -9.731037021e-01f, -2.303675115e-01f, -3.207964003e-01f, 9.471482038e-01f, 4.827820361e-01f, 8.757405281e-01f,
  8.253356218e-01f, 5.646424890e-01f, 9.436169863e-01f, 3.310393095e-01f, 9.820539355e-01f, 1.886002719e-01f, 9.943132997e-01f, 1.064944416e-01f,
  9.982005358e-01f, 5.996400490e-02f, 9.994308352e-01f, 3.373407945e-02f, 9.998199940e-01f, 1.897252724e-02f, 9.999430776e-01f, 1.066947449e-02f,
  9.999819994e-01f, 5.999964196e-03f, 9.999943376e-01f, 3.374041524e-03f, 9.999982119e-01f, 1.897365320e-03f, 9.999994040e-01f, 1.066967379e-03f,
  7.539022565e-01f, 6.569865942e-01f, -7.004297972e-01f, -7.137212753e-01f, -5.994374752e-01f, 8.004215956e-01f, 3.202570081e-01f, 9.473307133e-01f,
  7.648422122e-01f, 6.442176700e-01f, 9.235194325e-01f, 3.835515678e-01f, 9.755998850e-01f, 2.195560932e-01f, 9.922624230e-01f, 1.241583377e-01f,
  9.975510240e-01f, 6.994284689e-02f, 9.992253184e-01f, 3.935372457e-02f, 9.997550249e-01f, 2.213413455e-02f, 9.999225140e-01f, 1.244763471e-02f,
  9.999755025e-01f, 6.999942940e-03f, 9.999922514e-01f, 3.936378751e-03f, 9.999975562e-01f, 2.213592408e-03f, 9.999992251e-01f, 1.244795276e-03f,
  -1.455000341e-01f, 9.893582463e-01f, -2.120364457e-01f, -9.772617817e-01f, -8.186324239e-01f, 5.743177533e-01f, 1.476312131e-01f, 9.890424609e-01f,
  6.967067122e-01f, 7.173560858e-01f, 9.005023241e-01f, 4.348512292e-01f, 9.681702852e-01f, 2.502923310e-01f, 9.898977876e-01f, 1.417829692e-01f,
  9.968017340e-01f, 7.991468906e-02f, 9.989882708e-01f, 4.497213289e-02f, 9.996800423e-01f, 2.529552206e-02f, 9.998987913e-01f, 1.422575582e-02f,
  9.999679923e-01f, 7.999914698e-03f, 9.999898672e-01f, 4.498715047e-03f, 9.999967813e-01f, 2.529819263e-03f, 9.999989867e-01f, 1.422623056e-03f,
  -9.111302495e-01f, 4.121184945e-01f, 3.416602612e-01f, -9.398235083e-01f, -9.566441774e-01f, 2.912592292e-01f, -2.965079620e-02f, 9.995602965e-01f,
  6.216099262e-01f, 7.833269238e-01f, 8.746382594e-01f, 4.847761393e-01f, 9.597726464e-01f, 2.807783186e-01f, 9.872201085e-01f, 1.593627781e-01f,
  9.959527254e-01f, 8.987854421e-02f, 9.987195730e-01f, 5.058911815e-02f, 9.995950460e-01f, 2.845665626e-02f, 9.998719096e-01f, 1.600383036e-02f,
  9.999595284e-01f, 8.999879472e-03f, 9.999871850e-01f, 5.061050411e-03f, 9.999959469e-01f, 2.846045885e-03f, 9.999987483e-01f, 1.600450720e-03f,
  -8.390715122e-01f, -5.440211296e-01f, 7.901318669e-01f, -6.129369140e-01f, -9.997860789e-01f, -2.068356983e-02f, -2.059976310e-01f, 9.785524607e-01f,
  5.403022766e-01f, 8.414709568e-01f, 8.460091352e-01f, 5.331684351e-01f, 9.504153132e-01f, 3.109835684e-01f, 9.842302203e-01f, 1.768921912e-01f,
  9.950041771e-01f, 9.983341396e-02f, 9.984192848e-01f, 5.620449781e-02f, 9.995000362e-01f, 3.161750361e-02f, 9.998418689e-01f, 1.778185740e-02f,
  9.999499917e-01f, 9.999834001e-03f, 9.999842048e-01f, 5.623383448e-03f, 9.999949932e-01f, 3.162272274e-03f, 9.999983907e-01f, 1.778278500e-03f,
  4.425697960e-03f, -9.999902248e-01f, 9.952573776e-01f, -9.727645665e-02f, -9.437797666e-01f, -3.305749595e-01f, -3.758473992e-01f, 9.266815782e-01f,
  4.535960853e-01f, 8.912073970e-01f, 8.147053123e-01f, 5.798751712e-01f, 9.401075840e-01f, 3.408778608e-01f, 9.809291363e-01f, 1.943656504e-01f,
  9.939560890e-01f, 1.097782999e-01f, 9.980874062e-01f, 6.181810424e-02f, 9.993950725e-01f, 3.477803990e-02f, 9.998086691e-01f, 1.955982670e-02f,
  9.999395013e-01f, 1.099977922e-02f, 9.999808669e-01f, 6.185714621e-03f, 9.999939203e-01f, 3.478498431e-03f, 9.999980927e-01f, 1.956106164e-03f,
  8.438539505e-01f, -5.365729332e-01f, 8.938615918e-01f, 4.483429790e-01f, -7.941793799e-01f, -6.076834202e-01f, -5.338430405e-01f, 8.455836177e-01f,
  3.623577058e-01f, 9.320390821e-01f, 7.808259130e-01f, 6.247486472e-01f, 9.288598895e-01f, 3.704313040e-01f, 9.773178697e-01f, 2.117776722e-01f,
  9.928086400e-01f, 1.197122037e-01f, 9.977239966e-01f, 6.742975861e-02f, 9.992800951e-01f, 3.793822229e-02f, 9.997723103e-01f, 2.133773454e-02f,
  9.999279976e-01f, 1.199971233e-02f, 9.999772310e-01f, 6.748044398e-03f, 9.999927878e-01f, 3.794723889e-03f, 9.999977350e-01f, 2.133933594e-03f,
  9.074468017e-01f, 4.201670289e-01f, 5.171728730e-01f, 8.558809757e-01f, -5.658205152e-01f, -8.245284557e-01f, -6.750016809e-01f, 7.378162146e-01f,
  2.674987614e-01f, 9.635581970e-01f, 7.444779873e-01f, 6.676470041e-01f, 9.166833758e-01f, 3.996143043e-01f, 9.733975530e-01f, 2.291227132e-01f,
  9.915618896e-01f, 1.296341419e-01f, 9.973290563e-01f, 7.303927839e-02f, 9.991551042e-01f, 4.109803215e-02f, 9.997327924e-01f, 2.311557345e-02f,
  9.999154806e-01f, 1.299963426e-02f, 9.999732971e-01f, 7.310371846e-03f, 9.999915361e-01f, 4.110949114e-03f, 9.999973178e-01f, 2.311761025e-03f,
  1.367372125e-01f, 9.906073809e-01f, -1.879615150e-02f, 9.998233318e-01f, -2.813494802e-01f, -9.596053958e-01f, -7.948709130e-01f, 6.067785621e-01f,
  1.699671596e-01f, 9.854497313e-01f, 7.057763934e-01f, 7.084347010e-01f, 9.035902619e-01f, 4.283977747e-01f, 9.691694379e-01f, 2.463953048e-01f,
  9.902160168e-01f, 1.395431161e-01f, 9.969025850e-01f, 7.864648104e-02f, 9.990201592e-01f, 4.425742477e-02f, 9.996901155e-01f, 2.489333972e-02f,
  9.999020100e-01f, 1.399954315e-02f, 9.999690056e-01f, 7.872696966e-03f, 9.999902248e-01f, 4.427174106e-03f, 9.999969006e-01f, 2.489588689e-03f,
  -7.596879005e-01f, 6.502878666e-01f, -5.489754677e-01f, 8.358384371e-01f, 3.102235124e-02f, -9.995186925e-01f, -8.896704316e-01f, 4.566032588e-01f,
  7.073719800e-02f, 9.974949956e-01f, 6.648434997e-01f, 7.469826341e-01f, 8.895936012e-01f, 4.567528665e-01f, 9.646348357e-01f, 2.635899782e-01f,
  9.887710810e-01f, 1.494381279e-01f, 9.964445233e-01f, 8.425120264e-02f, 9.988752007e-01f, 4.741638154e-02f, 9.996442795e-01f, 2.667102963e-02f,
  9.998875260e-01f, 1.499943808e-02f, 9.999644160e-01f, 8.435020223e-03f, 9.999887347e-01f, 4.743398633e-03f, 9.999964237e-01f, 2.667415887e-03f,
  -9.576594830e-01f, -2.879033089e-01f, -9.100810885e-01f, 4.144302309e-01f, 3.403181732e-01f, -9.403103590e-01f, -9.564100504e-01f, 2.920270860e-01f,
  -2.919954620e-02f, 9.995735884e-01f, 6.218088269e-01f, 7.831690907e-01f, 8.747074604e-01f, 4.846512377e-01f, 9.597951770e-01f, 2.807013094e-01f,
  9.872272611e-01f, 1.593182087e-01f, 9.959549904e-01f, 8.985326439e-02f, 9.987202883e-01f, 5.057485774e-02f, 9.995952845e-01f, 2.844863199e-02f,
  9.998720288e-01f, 1.599931903e-02f, 9.999595284e-01f, 8.997339755e-03f, 9.999871850e-01f, 5.059622694e-03f, 9.999959469e-01f, 2.845243318e-03f,
  -2.751633525e-01f, -9.613974690e-01f, -9.908979535e-01f, -1.346151382e-01f, 6.158648133e-01f, -7.878518701e-01f, -9.929850101e-01f, 1.182405204e-01f,
  -1.288445443e-01f, 9.916648269e-01f, 5.768082738e-01f, 8.168795705e-01f, 8.589466810e-01f, 5.120649934e-01f, 9.546520114e-01f, 2.977238595e-01f,
  9.855847955e-01f, 1.691823453e-01f, 9.954339862e-01f, 9.545248002e-02f, 9.985553622e-01f, 5.373282731e-02f, 9.995430708e-01f, 3.022614494e-02f,
  9.998555183e-01f, 1.699918136e-02f, 9.999542832e-01f, 9.559656493e-03f, 9.999855757e-01f, 5.375845823e-03f, 9.999954104e-01f, 3.023070283e-03f,
  6.603167057e-01f, -7.509872317e-01f, -7.665365338e-01f, -6.422007084e-01f, 8.303361535e-01f, -5.572628975e-01f, -9.982416630e-01f, -5.927551910e-02f,
  -2.272021621e-01f, 9.738476276e-01f, 5.299841762e-01f, 8.480075598e-01f, 8.423270583e-01f, 5.389667153e-01f, 9.492070079e-01f, 3.146522641e-01f,
  9.838436842e-01f, 1.790295690e-01f, 9.948815107e-01f, 1.010486856e-01f, 9.983804226e-01f, 5.689026415e-02f, 9.994877577e-01f, 3.200356290e-02f,
  9.998379946e-01f, 1.799902879e-02f, 9.999487996e-01f, 1.012197044e-02f, 9.999837875e-01f, 5.692068953e-03f, 9.999948740e-01f, 3.200897481e-03f,
  9.887046218e-01f, 1.498772055e-01f, -3.060953915e-01f, -9.520008564e-01f, 9.624637961e-01f, -2.714101076e-01f, -9.720142484e-01f, -2.349217981e-01f,
  -3.232895434e-01f, 9.463000894e-01f, 4.814845920e-01f, 8.764545321e-01f, 8.248651624e-01f, 5.653295517e-01f, 9.434618354e-01f, 3.314811885e-01f,
  9.820042253e-01f, 1.888588965e-01f, 9.942975044e-01f, 1.066416800e-01f, 9.981955290e-01f, 6.004713103e-02f, 9.994292855e-01f, 3.378088027e-02f,
  9.998195171e-01f, 1.899885759e-02f, 9.999428988e-01f, 1.068428159e-02f, 9.999819398e-01f, 6.008291151e-03f, 9.999942780e-01f, 3.378724447e-03f,
  4.080820680e-01f, 9.129452705e-01f, 2.486167252e-01f, -9.686019421e-01f, 9.991443753e-01f, 4.135828838e-02f, -9.151299596e-01f, -4.031589925e-01f,
  -4.161468446e-01f, 9.092974067e-01f, 4.314628243e-01f, 9.021307230e-01f, 8.065784574e-01f, 5.911270380e-01f, 9.374182820e-01f, 3.482052684e-01f,
  9.800665975e-01f, 1.986693144e-01f, 9.936820865e-01f, 1.122313142e-01f, 9.980006814e-01f, 6.320339441e-02f, 9.993675947e-01f, 3.555808961e-02f,
  9.998000264e-01f, 1.999866776e-02f, 9.999367595e-01f, 1.124658901e-02f, 9.999799728e-01f, 6.324512884e-03f, 9.999936819e-01f, 3.556551412e-03f,
  -5.477292538e-01f, 8.366556168e-01f, 7.267602682e-01f, -6.868911982e-01f, 9.367404580e-01f, 3.500247598e-01f, -8.293829560e-01f, -5.586805344e-01f,
  -5.048462152e-01f, 8.632093072e-01f, 3.800770044e-01f, 9.249548316e-01f, 7.874851823e-01f, 6.163335443e-01f, 9.310783744e-01f, 3.648192585e-01f,
  9.780309200e-01f, 2.084598988e-01f, 9.930352569e-01f, 1.178173944e-01f, 9.977958202e-01f, 6.635902822e-02f, 9.993028045e-01f, 3.733518720e-02f,
  9.997795224e-01f, 2.099845745e-02f, 9.999302626e-01f, 1.180889271e-02f, 9.999779463e-01f, 6.640734151e-03f, 9.999930263e-01f, 3.734378144e-03f,
  -9.999608397e-01f, -8.851309307e-03f, 9.810745716e-01f, -1.936302334e-01f, 7.814403772e-01f, 6.239799261e-01f, -7.174774408e-01f, -6.965817213e-01f,
  -5.885011554e-01f, 8.084963560e-01f, 3.274895847e-01f, 9.448547959e-01f, 7.676045895e-01f, 6.409237385e-01f, 9.244439602e-01f, 3.813178837e-01f,
  9.758974314e-01f, 2.182296216e-01f, 9.923570156e-01f, 1.233997419e-01f, 9.975810051e-01f, 6.951400638e-02f, 9.992348552e-01f, 3.911216930e-02f,
  9.997580051e-01f, 2.199822664e-02f, 9.999234676e-01f, 1.237119269e-02f, 9.999758005e-01f, 6.956954487e-03f, 9.999923706e-01f, 3.912204877e-03f,
  -5.328330398e-01f, -8.462204337e-01f, 9.332357645e-01f, 3.592645228e-01f, 5.486452579e-01f, 8.360552788e-01f, -5.829432607e-01f, -8.125128746e-01f,
  -6.662759781e-01f, 7.457052469e-01f, 2.738668323e-01f, 9.617676139e-01f, 7.469564080e-01f, 6.648730636e-01f, 9.175173044e-01f, 3.976959288e-01f,
  9.736663699e-01f, 2.279775143e-01f, 9.916474223e-01f, 1.289781928e-01f, 9.973561764e-01f, 7.266827673e-02f, 9.991636872e-01f, 4.088902473e-02f,
  9.997355342e-01f, 2.299797349e-02f, 9.999163747e-01f, 1.293348987e-02f, 9.999735355e-01f, 7.273174357e-03f, 9.999916553e-01f, 4.090031609e-03f,
  4.241790175e-01f, -9.055783749e-01f, 5.979771614e-01f, 8.015131354e-01f, 2.614416778e-01f, 9.652192593e-01f, -4.300232828e-01f, -9.028177857e-01f,
  -7.373937964e-01f, 6.754631400e-01f, 2.193782777e-01f, 9.756398797e-01f, 7.255613208e-01f, 6.881574988e-01f, 9.103004336e-01f, 4.139482081e-01f,
  9.713379741e-01f, 2.377026230e-01f, 9.909064770e-01f, 1.345525682e-01f, 9.971213937e-01f, 7.582182437e-02f, 9.990894198e-01f, 4.266574979e-02f,
  9.997119904e-01f, 2.399769612e-02f, 9.999089241e-01f, 1.349578146e-02f, 9.999712110e-01f, 7.589393295e-03f, 9.999908805e-01f, 4.267857410e-03f,
  9.912028313e-01f, -1.323517561e-01f, 7.855226099e-02f, 9.969099760e-01f, -5.168933049e-02f, 9.986631870e-01f, -2.635405958e-01f, -9.646483064e-01f,
  -8.011435866e-01f, 5.984721184e-01f, 1.641961634e-01f, 9.864277244e-01f, 7.034407258e-01f, 7.107539177e-01f, 9.027957320e-01f, 4.300695956e-01f,
  9.689124227e-01f, 2.474039644e-01f, 9.901341200e-01f, 1.401226968e-01f, 9.968766570e-01f, 7.897461206e-02f, 9.990119338e-01f, 4.444234073e-02f,
  9.996874928e-01f, 2.499739639e-02f, 9.999011755e-01f, 1.405806933e-02f, 9.999687672e-01f, 7.905611768e-03f, 9.999901056e-01f, 4.445684142e-03f,
  6.469193101e-01f, 7.625584602e-01f, -4.650644958e-01f, 8.852767944e-01f, -3.596943319e-01f, 9.330701828e-01f, -8.874550462e-02f, -9.960543513e-01f,
  -8.568888307e-01f, 5.155012608e-01f, 1.084949449e-01f, 9.940969944e-01f, 6.806167960e-01f, 7.326396108e-01f, 8.950055838e-01f, 4.460549951e-01f,
  9.663899541e-01f, 2.570805550e-01f, 9.893305302e-01f, 1.456883848e-01f, 9.966219068e-01f, 8.212661743e-02f, 9.989313483e-01f, 4.621879384e-02f,
  9.996620417e-01f, 2.599707060e-02f, 9.998931289e-01f, 1.462035347e-02f, 9.999662042e-01f, 8.221829310e-03f, 9.999893308e-01f, 4.623509943e-03f,
  -2.921388149e-01f, 9.563759565e-01f, -8.654506207e-01f, 5.009942055e-01f, -6.320286393e-01f, 7.749450207e-01f, 8.884811401e-02f, -9.960451722e-01f,
  -9.040721655e-01f, 4.273798466e-01f, 5.245061591e-02f, 9.986234903e-01f, 6.571123004e-01f, 7.537927032e-01f, 8.869323730e-01f, 4.618993104e-01f,
  9.637709260e-01f, 2.667314112e-01f, 9.884956479e-01f, 1.512494683e-01f, 9.963572025e-01f, 8.527779579e-02f, 9.988475442e-01f, 4.799510166e-02f,
  9.996355176e-01f, 2.699672058e-02f, 9.998847246e-01f, 1.518263202e-02f, 9.999635220e-01f, 8.538045920e-03f, 9.999884963e-01f, 4.801335745e-03f,
  -9.626058936e-01f, 2.709057927e-01f, -9.992933869e-01f, -3.758566082e-02f, -8.416849375e-01f, 5.399689674e-01f, 2.636395097e-01f, -9.646213055e-01f,
  -9.422222972e-01f, 3.349882066e-01f, -3.759419080e-03f, 9.999929070e-01f, 6.329506636e-01f, 7.741920948e-01f, 8.785787225e-01f, 4.775975943e-01f,
  9.610554576e-01f, 2.763556540e-01f, 9.876294732e-01f, 1.568057537e-01f, 9.960825443e-01f, 8.842811733e-02f, 9.987606406e-01f, 4.977125302e-02f,
  9.996080399e-01f, 2.799634263e-02f, 9.998760223e-01f, 1.574490592e-02f, 9.999607801e-01f, 8.854261599e-03f, 9.999876022e-01f, 4.979162011e-03f,
  -7.480575442e-01f, -6.636338830e-01f, -8.253716230e-01f, -5.645897985e-01f, -9.678714871e-01f, 2.514453232e-01f, 4.301158488e-01f, -9.027736783e-01f,
  -9.709581733e-01f, 2.392492294e-01f, -5.995756760e-02f, 9.982009530e-01f, 6.081562042e-01f, 7.938174009e-01f, 8.699471951e-01f, 4.931448400e-01f,
  9.582439065e-01f, 2.859522104e-01f, 9.867320657e-01f, 1.623570919e-01f, 9.957979321e-01f, 9.157756716e-02f, 9.986705780e-01f, 5.154724792e-02f,
  9.995795488e-01f, 2.899593674e-02f, 9.998670220e-01f, 1.630717516e-02f, 9.999579787e-01f, 9.170476347e-03f, 9.999867082e-01f, 5.156987347e-03f,
  1.542514563e-01f, -9.880316257e-01f, -3.972518742e-01f, -9.177096486e-01f, -9.980752468e-01f, -6.201484054e-02f, 5.830269456e-01f, -8.124528527e-01f,
  -9.899924994e-01f, 1.411200017e-01f, -1.159661636e-01f, 9.932531714e-01f, 5.827536583e-01f, 8.126488924e-01f, 8.610406518e-01f, 5.085361004e-01f,
  9.553365111e-01f, 2.955201864e-01f, 9.858034849e-01f, 1.679033041e-01f, 9.955033660e-01f, 9.472609311e-02f, 9.985772967e-01f, 5.332308263e-02f,
  9.995500445e-01f, 2.999550104e-02f, 9.998577237e-01f, 1.686943881e-02f, 9.999549985e-01f, 9.486690164e-03f, 9.999857545e-01f, 5.334813148e-03f,
  9.147423506e-01f, -4.040376544e-01f, 1.532154828e-01f, -9.881927967e-01f, -9.293003082e-01f, -3.693250120e-01f, 7.175492048e-01f, -6.965078115e-01f,
  -9.991351366e-01f, 4.158052057e-02f, -1.716081351e-01f, 9.851652980e-01f, 5.567683578e-01f, 8.306677938e-01f, 8.518617749e-01f, 5.237666368e-01f,
  9.523335695e-01f, 3.050586283e-01f, 9.848436713e-01f, 1.734442115e-01f, 9.951988459e-01f, 9.787366539e-02f, 9.984809160e-01f, 5.509874597e-02f,
  9.995195270e-01f, 3.099503554e-02f, 9.998480678e-01f, 1.743169688e-02f, 9.999519587e-01f, 9.802903049e-03f, 9.999848008e-01f, 5.512638018e-03f,
  8.342233896e-01f, 5.514267087e-01f, 6.564951539e-01f, -7.543302178e-01f, -7.683671117e-01f, -6.400094032e-01f, 8.294403553e-01f, -5.585952997e-01f,
  -9.982947707e-01f, -5.837419257e-02f, -2.267075777e-01f, 9.739628434e-01f, 5.302263498e-01f, 8.478561044e-01f, 8.424135447e-01f, 5.388315320e-01f,
  9.492354393e-01f, 3.145665526e-01f, 9.838528037e-01f, 1.789796203e-01f, 9.948843718e-01f, 1.010202691e-01f, 9.983813763e-01f, 5.687423423e-02f,
  9.994880557e-01f, 3.199454024e-02f, 9.998381138e-01f, 1.799395122e-02f, 9.999487996e-01f, 1.011911593e-02f, 9.999837875e-01f, 5.690463353e-03f,
  -1.327674743e-02f, 9.999118447e-01f, 9.575860500e-01f, -2.881473899e-01f, -5.312352777e-01f, -8.472243547e-01f, 9.151713848e-01f, -4.030649364e-01f,
  -9.874798059e-01f, -1.577456445e-01f, -2.810903192e-01f, 9.596813321e-01f, 5.031541586e-01f, 8.641966581e-01f, 8.326989412e-01f, 5.537260175e-01f,
  9.460423589e-01f, 3.240430057e-01f, 9.828307629e-01f, 1.845093668e-01f, 9.945599437e-01f, 1.041658595e-01f, 9.982786179e-01f, 5.864954367e-02f,
  9.994555712e-01f, 3.299400955e-02f, 9.998278022e-01f, 1.855619811e-02f, 9.999455214e-01f, 1.043532696e-02f, 9.999827743e-01f, 5.868288688e-03f,
  -8.485702872e-01f, 5.290827155e-01f, 9.637575150e-01f, 2.667797208e-01f, -2.414211184e-01f, -9.704204202e-01f, 9.720383286e-01f, -2.348221242e-01f,
  -9.667981863e-01f, -2.555412054e-01f, -3.345843852e-01f, 9.423658252e-01f, 4.755789042e-01f, 8.796730638e-01f, 8.227210045e-01f, 5.684453845e-01f,
  9.427546859e-01f, 3.334870934e-01f, 9.817776680e-01f, 1.900332868e-01f, 9.942255616e-01f, 1.073104069e-01f, 9.981727600e-01f, 6.042466685e-02f,
  9.994220734e-01f, 3.399345279e-02f, 9.998172522e-01f, 1.911843941e-02f, 9.999421835e-01f, 1.075153705e-02f, 9.999817014e-01f, 6.046113092e-03f,
  -9.036921859e-01f, -4.281826615e-01f, 6.731102467e-01f, 7.395421267e-01f, 7.233466953e-02f, -9.973804355e-01f, 9.982477427e-01f, -5.917267874e-02f,
  -9.364566803e-01f, -3.507832289e-01f, -3.870206773e-01f, 9.220710397e-01f, 4.475280643e-01f, 8.942698836e-01f, 8.124829531e-01f, 5.829849839e-01f,
  9.393727183e-01f, 3.428978026e-01f, 9.806935191e-01f, 1.955512017e-01f, 9.938812256e-01f, 1.104538813e-01f, 9.980637431e-01f, 6.219960377e-02f,
  9.993875623e-01f, 3.499285504e-02f, 9.998063445e-01f, 1.968067512e-02f, 9.999387264e-01f, 1.106774528e-02f, 9.999806285e-01f, 6.223937962e-03f,
  -1.279636919e-01f, -9.917788506e-01f, 1.751565337e-01f, 9.845405817e-01f, 3.789161742e-01f, -9.254310131e-01f, 9.929728508e-01f, 1.183425859e-01f,
  -8.967583776e-01f, -4.425205588e-01f, -4.382335544e-01f, 8.988611698e-01f, 4.190297425e-01f, 9.079725146e-01f, 8.019878864e-01f, 5.973402858e-01f,
  9.358968139e-01f, 3.522742093e-01f, 9.795783162e-01f, 2.010629177e-01f, 9.935269952e-01f, 1.135962531e-01f, 9.979515672e-01f, 6.397433579e-02f,
  9.993520975e-01f, 3.599222749e-02f, 9.997950792e-01f, 2.024290524e-02f, 9.999352098e-01f, 1.138395350e-02f, 9.999794960e-01f, 6.401761901e-03f,
  7.654140592e-01f, -6.435381174e-01f, -3.767423034e-01f, 9.263181090e-01f, 6.479216814e-01f, -7.617069483e-01f, 9.563800097e-01f, 2.921253741e-01f,
  -8.481000066e-01f, -5.298361778e-01f, -4.880608618e-01f, 8.728095889e-01f, 3.901124299e-01f, 9.207672477e-01f, 7.912392616e-01f, 6.115067005e-01f,
  9.323273301e-01f, 3.616154492e-01f, 9.784321785e-01f, 2.065682709e-01f, 9.931628108e-01f, 1.167374924e-01f, 9.978361726e-01f, 6.574887782e-02f,
  9.993155599e-01f, 3.699155897e-02f, 9.997835755e-01f, 2.080512606e-02f, 9.999315739e-01f, 1.170015987e-02f, 9.999783635e-01f, 6.579586305e-03f,
  9.550736547e-01f, 2.963685691e-01f, -8.126112223e-01f, 5.828061700e-01f, 8.526731133e-01f, -5.224447846e-01f, 8.896234632e-01f, 4.566946924e-01f,
  -7.909677625e-01f, -6.118578315e-01f, -5.363451838e-01f, 8.439987302e-01f, 3.608050346e-01f, 9.326412678e-01f, 7.802404165e-01f, 6.254796982e-01f,
  9.286646247e-01f, 3.709204793e-01f, 9.772551060e-01f, 2.120671123e-01f, 9.927886724e-01f, 1.198775545e-01f, 9.977176785e-01f, 6.752320379e-02f,
  9.992780685e-01f, 3.799085692e-02f, 9.997717142e-01f, 2.136734314e-02f, 9.999278188e-01f, 1.201636530e-02f, 9.999771714e-01f, 6.757410709e-03f,
  2.666429281e-01f, 9.637953639e-01f, -9.982103705e-01f, 5.980031565e-02f, 9.728653431e-01f, -2.313720137e-01f, 7.948083878e-01f, 6.068604589e-01f,
  -7.259322405e-01f, -6.877662539e-01f, -5.829339027e-01f, 8.125196099e-01f, 3.311368525e-01f, 9.435827136e-01f, 7.689949274e-01f, 6.392549276e-01f,
  9.249090552e-01f, 3.801884055e-01f, 9.760470986e-01f, 2.175592482e-01f, 9.924046397e-01f, 1.230164245e-01f, 9.975960255e-01f, 6.929731369e-02f,
  9.992396235e-01f, 3.899011388e-02f, 9.997594953e-01f, 2.192955278e-02f, 9.999239445e-01f, 1.233256981e-02f, 9.999759793e-01f, 6.935234182e-03f,
  -6.669380665e-01f, 7.451131344e-01f, -8.763794303e-01f, -4.816212952e-01f, 9.965789914e-01f, 8.264580369e-02f, 6.749256253e-01f, 7.378857136e-01f,
  -6.536436081e-01f, -7.568024993e-01f, -6.276797056e-01f, 7.784717083e-01f, 3.011375964e-01f, 9.535806775e-01f, 7.575061917e-01f, 6.528279781e-01f,
  9.210609794e-01f, 3.894183338e-01f, 9.748082757e-01f, 2.230444849e-01f, 9.920106530e-01f, 1.261540651e-01f, 9.974712729e-01f, 7.107120752e-02f,
  9.992001057e-01f, 3.998933733e-02f, 9.997470379e-01f, 2.249175683e-02f, 9.999200106e-01f, 1.264877338e-02f, 9.999747276e-01f, 7.113057654e-03f,
  -9.873392582e-01f, -1.586226672e-01f, -4.846394062e-01f, -8.747140169e-01f, 9.214623570e-01f, 3.884676993e-01f, 5.337560773e-01f, 8.456384540e-01f,
  -5.748240352e-01f, -8.182770610e-01f, -6.704410911e-01f, 7.419627905e-01f, 2.708370686e-01f, 9.626252055e-01f, 7.457779050e-01f, 6.661946774e-01f,
  9.171208143e-01f, 3.986093104e-01f, 9.735385776e-01f, 2.285226882e-01f, 9.916067719e-01f, 1.292904317e-01f, 9.973433018e-01f, 7.284487784e-02f,
  9.991596341e-01f, 4.098851606e-02f, 9.997342229e-01f, 2.305394970e-02f, 9.999159575e-01f, 1.296497509e-02f, 9.999734163e-01f, 7.290880661e-03f,
  -3.999853134e-01f, -9.165215492e-01f, 5.636094138e-02f, -9.984104633e-01f, 7.549653649e-01f, 6.557646990e-01f, 3.757521510e-01f, 9.267202020e-01f,
  -4.902605712e-01f, -8.715758920e-01f, -7.110829353e-01f, 7.031081319e-01f, 2.402658761e-01f, 9.707071185e-01f, 7.338138223e-01f, 6.793506742e-01f,
  9.130889177e-01f, 4.077604413e-01f, 9.722381234e-01f, 2.339936644e-01f, 9.911929369e-01f, 1.324255317e-01f, 9.972121716e-01f, 7.461831719e-02f,
  9.991181493e-01f, 4.198765755e-02f, 9.997211099e-01f, 2.361613885e-02f, 9.999117851e-01f, 1.328117587e-02f, 9.999721050e-01f, 7.468704134e-03f,
  5.551133156e-01f, -8.317747712e-01f, 5.800031424e-01f, -8.146142364e-01f, 5.135984421e-01f, 8.580306768e-01f, 2.058971673e-01f, 9.785736203e-01f,
  -4.007990062e-01f, -9.161660075e-01f, -7.494767308e-01f, 6.620306373e-01f, 2.094544172e-01f, 9.778184295e-01f, 7.216176391e-01f, 6.922917962e-01f,
  9.089657664e-01f, 4.168707728e-01f, 9.709069133e-01f, 2.394572198e-01f, 9.907692075e-01f, 1.355592906e-01f, 9.970778823e-01f, 7.639151812e-02f,
  9.990756512e-01f, 4.298675060e-02f, 9.997076392e-01f, 2.417832054e-02f, 9.999075532e-01f, 1.359737478e-02f, 9.999707937e-01f, 7.646527141e-03f,
  9.998432994e-01f, 1.770192571e-02f, 9.250146747e-01f, -3.799313903e-01f, 2.212981731e-01f, 9.752061963e-01f, 2.954781987e-02f, 9.995633960e-01f,
  -3.073327839e-01f, -9.516021013e-01f, -7.855011225e-01f, 6.188601851e-01f, 1.784335226e-01f, 9.839519858e-01f, 7.091933489e-01f, 7.050140500e-01f,
  9.047516584e-01f, 4.259394705e-01f, 9.695450068e-01f, 2.449132055e-01f, 9.903355837e-01f, 1.386916935e-01f, 9.969404936e-01f, 7.816448808e-02f,
  9.990321398e-01f, 4.398580641e-02f, 9.996939301e-01f, 2.474049293e-02f, 9.999032021e-01f, 1.391357277e-02f, 9.999693632e-01f, 7.824349217e-03f,
  5.253219604e-01f, 8.509035110e-01f, 9.851381779e-01f, 1.717635691e-01f, -9.294810891e-02f, 9.956709743e-01f, -1.477329880e-01f, 9.890272617e-01f,
  -2.107958049e-01f, -9.775301218e-01f, -8.190422058e-01f, 5.737332702e-01f, 1.472342163e-01f, 9.891016483e-01f, 6.965447664e-01f, 7.175133228e-01f,
  9.004471302e-01f, 4.349655211e-01f, 9.681524038e-01f, 2.503614724e-01f, 9.898920655e-01f, 1.418227106e-01f, 9.967998862e-01f, 7.993719727e-02f,
  9.989876747e-01f, 4.498481750e-02f, 9.996798635e-01f, 2.530265786e-02f, 9.998987317e-01f, 1.422976889e-02f, 9.999679923e-01f, 8.002171293e-03f,
  -4.321779311e-01f, 9.017883539e-01f, 7.418580055e-01f, 6.705570221e-01f, -3.979767561e-01f, 9.173954725e-01f, -3.203543723e-01f, 9.472977519e-01f,
  -1.121526212e-01f, -9.936909676e-01f, -8.499938846e-01f, 5.267925262e-01f, 1.158876941e-01f, 9.932623506e-01f, 6.836758852e-01f, 7.297857404e-01f,
  8.960524797e-01f, 4.439480901e-01f, 9.667292237e-01f, 2.558017969e-01f, 9.894386530e-01f, 1.449523121e-01f, 9.966561794e-01f, 8.170966059e-02f,
  9.989421964e-01f, 4.598378390e-02f, 9.996654391e-01f, 2.586481534e-02f, 9.998942018e-01f, 1.454596408e-02f, 9.999665618e-01f, 8.179994300e-03f,
  -9.923354983e-01f, 1.235731244e-01f, 2.700984478e-01f, 9.628326893e-01f, -6.635382771e-01f, 7.481423616e-01f, -4.828719497e-01f, 8.756909966e-01f,
  -1.238837745e-02f, -9.999232888e-01f, -8.782584071e-01f, 4.781863391e-01f, 8.442528546e-02f, 9.964298010e-01f, 6.705908775e-01f, 7.418274283e-01f,
  8.915683031e-01f, 4.528862834e-01f, 9.652754664e-01f, 2.612340748e-01f, 9.889753461e-01f, 1.480804533e-01f, 9.965093136e-01f, 8.348185569e-02f,
  9.988957047e-01f, 4.698270187e-02f, 9.996507764e-01f, 2.642696351e-02f, 9.998895526e-01f, 1.486215740e-02f, 9.999650717e-01f, 8.357816376e-03f,
  -6.401443481e-01f, -7.682546377e-01f, -2.848466039e-01f, 9.585731030e-01f, -8.632965088e-01f, 5.046970844e-01f, -6.301599741e-01f, 7.764653563e-01f,
  8.749917150e-02f, -9.961646199e-01f, -9.037463665e-01f, 4.280683994e-01f, 5.287845805e-02f, 9.986009598e-01f, 6.572937369e-01f, 7.536345124e-01f,
  8.869948983e-01f, 4.617791772e-01f, 9.637911916e-01f, 2.666580379e-01f, 9.885020852e-01f, 1.512071192e-01f, 9.963592887e-01f, 8.525379747e-02f,
  9.988481998e-01f, 4.798157141e-02f, 9.996357560e-01f, 2.698910423e-02f, 9.998847842e-01f, 1.517834887e-02f, 9.999635816e-01f, 8.535637520e-03f,
  3.005925417e-01f, -9.537526369e-01f, -7.520639896e-01f, 6.590901017e-01f, -9.774427414e-01f, 2.112006545e-01f, -7.575730681e-01f, 6.527503729e-01f,
  1.865124702e-01f, -9.824525714e-01f, -9.263771176e-01f, 3.765971363e-01f, 2.127875760e-02f, 9.997735620e-01f, 6.437888145e-01f, 7.652031779e-01f,
  8.823328614e-01f, 4.706258774e-01f, 9.622764587e-01f, 2.720735669e-01f, 9.880189896e-01f, 1.543322802e-01f, 9.962061048e-01f, 8.702547103e-02f,
  9.987997413e-01f, 4.898039624e-02f, 9.996203780e-01f, 2.755123749e-02f, 9.998799562e-01f, 1.549453940e-02f, 9.999620318e-01f, 8.713459596e-03f,
  9.649659991e-01f, -2.623748481e-01f, -9.876590967e-01f, 1.566190720e-01f, -9.946564436e-01f, -1.032404602e-01f, -8.610926867e-01f, 5.084479451e-01f,
  2.836622000e-01f, -9.589242935e-01f, -9.460792542e-01f, 3.239352703e-01f, -1.034221891e-02f, 9.999465346e-01f, 6.300802827e-01f, 7.765299678e-01f,
  8.775825500e-01f, 4.794255495e-01f, 9.607312679e-01f, 2.774805427e-01f, 9.875259995e-01f, 1.574558914e-01f, 9.960497618e-01f, 8.879686147e-02f,
  9.987502694e-01f, 4.997916892e-02f, 9.996047616e-01f, 2.811335959e-02f, 9.998750091e-01f, 1.581072807e-02f, 9.999604821e-01f, 8.891279809e-03f,
  7.421541810e-01f, 6.702291965e-01f, -9.190735221e-01f, -3.940860629e-01f, -9.132301211e-01f, -4.074441493e-01f, -9.374542236e-01f, 3.481085002e-01f,
  3.779776692e-01f, -9.258147478e-01f, -9.627903700e-01f, 2.702493370e-01f, -4.195285589e-02f, 9.991195798e-01f, 6.161724925e-01f, 7.876111865e-01f,
  8.727445006e-01f, 4.881772399e-01f, 9.591556787e-01f, 2.828786969e-01f, 9.870231748e-01f, 1.605779380e-01f, 9.958902597e-01f, 9.056797624e-02f,
  9.986997843e-01f, 5.097789690e-02f, 9.995887876e-01f, 2.867547423e-02f, 9.998699427e-01f, 1.612691768e-02f, 9.999588728e-01f, 9.069100954e-03f,
  -1.629907787e-01f, 9.866275787e-01f, -5.674300194e-01f, -8.234215975e-01f, -7.412399650e-01f, -6.712401509e-01f, -9.842484593e-01f, 1.767906845e-01f,
  4.685169160e-01f, -8.834545016e-01f, -9.764577150e-01f, 2.157090008e-01f, -7.352153957e-02f, 9.972936511e-01f, 6.020699143e-01f, 7.984433770e-01f,
  8.678191900e-01f, 4.968801141e-01f, 9.575498104e-01f, 2.882679403e-01f, 9.865104556e-01f, 1.636983752e-01f, 9.957276583e-01f, 9.233880043e-02f,
  9.986482859e-01f, 5.197656900e-02f, 9.995725155e-01f, 2.923758142e-02f, 9.998648167e-01f, 1.644310169e-02f, 9.999572635e-01f, 9.246920235e-03f,
  -9.182828069e-01f, 3.959251642e-01f, -4.102819040e-02f, -9.991579652e-01f, -4.957418144e-01f, -8.684699535e-01f, -1.000000000e+00f, -1.030206768e-04f,
  5.543745160e-01f, -8.322673440e-01f, -9.870380163e-01f, 1.604867280e-01f, -1.050167084e-01f, 9.944704771e-01f, 5.877769589e-01f, 8.090230227e-01f,
  8.628070951e-01f, 5.055333376e-01f, 9.559136033e-01f, 2.936480343e-01f, 9.859878421e-01f, 1.668171734e-01f, 9.955618382e-01f, 9.410934150e-02f,
  9.985958338e-01f, 5.297519267e-02f, 9.995558858e-01f, 2.979967557e-02f, 9.998595715e-01f, 1.675928757e-02f, 9.999555945e-01f, 9.424741380e-03f,
  -8.293098211e-01f, -5.587890744e-01f, 4.980095923e-01f, -8.671715260e-01f, -2.010796219e-01f, -9.795749187e-01f, -9.842120409e-01f, -1.769934744e-01f,
  6.346929669e-01f, -7.727644444e-01f, -9.944978952e-01f, 1.047568321e-01f, -1.364068687e-01f, 9.906529188e-01f, 5.732980371e-01f, 8.193469048e-01f,
  8.577086926e-01f, 5.141359568e-01f, 9.542471766e-01f, 2.990188897e-01f, 9.854553938e-01f, 1.699342877e-01f, 9.953929186e-01f, 9.587957710e-02f,
  9.985423684e-01f, 5.397376046e-02f, 9.995389581e-01f, 3.036176413e-02f, 9.998542070e-01f, 1.707546785e-02f, 9.999538660e-01f, 9.602561593e-03f,
  2.212675661e-02f, -9.997551441e-01f, 8.836693168e-01f, -4.681116641e-01f, 1.135217771e-01f, -9.935355186e-01f, -9.373825192e-01f, -3.483016491e-01f,
  7.086697817e-01f, -7.055402994e-01f, -9.988136292e-01f, 4.869600013e-02f, -1.676606387e-01f, 9.858447909e-01f, 5.586379170e-01f, 8.294116855e-01f,
  8.525245190e-01f, 5.226872563e-01f, 9.525505900e-01f, 3.043802381e-01f, 9.849131107e-01f, 1.730497181e-01f, 9.952208400e-01f, 9.764950722e-02f,
  9.984878898e-01f, 5.497227982e-02f, 9.995217323e-01f, 3.092384152e-02f, 9.998487830e-01f, 1.739165001e-02f, 9.999521971e-01f, 9.780380875e-03f,
  8.532201052e-01f, -5.215510130e-01f, 9.971746206e-01f, 7.511820644e-02f, 4.168670774e-01f, -9.089674354e-01f, -8.609884381e-01f, -5.086245537e-01f,
  7.755658031e-01f, -6.312667131e-01f, -9.999717474e-01f, -7.518785074e-03f, -1.987468749e-01f, 9.800508618e-01f, 5.438010693e-01f, 8.392141461e-01f,
  8.472551107e-01f, 5.311862230e-01f, 9.508239031e-01f, 3.097319603e-01f, 9.843609333e-01f, 1.761634201e-01f, 9.950456619e-01f, 9.941913933e-02f,
  9.984323978e-01f, 5.597073585e-02f, 9.995042086e-01f, 3.148590773e-02f, 9.998431802e-01f, 1.770782843e-02f, 9.999504089e-01f, 9.958200157e-03f,
  8.998668194e-01f, 4.361647666e-01f, 8.035690784e-01f, 5.952115059e-01f, 6.788702011e-01f, -7.342582941e-01f, -7.574391961e-01f, -6.529057026e-01f,
  8.347129226e-01f, -5.506852865e-01f, -9.979684949e-01f, -6.370979548e-02f, -2.296342701e-01f, 9.732769728e-01f, 5.287923217e-01f, 8.487512469e-01f,
  8.419010043e-01f, 5.396320224e-01f, 9.490671158e-01f, 3.150739372e-01f, 9.837989211e-01f, 1.792753637e-01f, 9.948672652e-01f, 1.011884511e-01f,
  9.983759522e-01f, 5.696914345e-02f, 9.994863272e-01f, 3.204796836e-02f, 9.998375773e-01f, 1.802400686e-02f, 9.999486208e-01f, 1.013601944e-02f,
  1.191801354e-01f, 9.928726554e-01f, 3.624766767e-01f, 9.319928288e-01f, 8.735505342e-01f, -4.867334962e-01f, -6.300007105e-01f, -7.765945792e-01f,
  8.855196238e-01f, -4.646020234e-01f, -9.928101897e-01f, -1.196993962e-01f, -2.602920532e-01f, 9.655299187e-01f, 5.136163235e-01f, 8.580200076e-01f,
  8.364626765e-01f, 5.480239391e-01f, 9.472803473e-01f, 3.204059005e-01f, 9.832270741e-01f, 1.823855042e-01f, 9.946857691e-01f, 1.029574350e-01f,
  9.983184934e-01f, 5.796748772e-02f, 9.994681478e-01f, 3.261001408e-02f, 9.998317957e-01f, 1.834018156e-02f, 9.999468327e-01f, 1.031383779e-02f,
  -7.710801959e-01f, 6.367380023e-01f, -1.902491003e-01f, 9.817358255e-01f, 9.816020727e-01f, -1.909380108e-01f, -4.826923311e-01f, -8.757900000e-01f,
  9.274784923e-01f, -3.738765717e-01f, -9.845131636e-01f, -1.753105819e-01f, -2.906895578e-01f, 9.568174481e-01f, 4.982779026e-01f, 8.670173883e-01f,
  8.309407234e-01f, 5.563610196e-01f, 9.454635978e-01f, 3.257277906e-01f, 9.826454520e-01f, 1.854938269e-01f, 9.945011139e-01f, 1.047261059e-01f,
  9.982600212e-01f, 5.896577984e-02f, 9.994496703e-01f, 3.317204863e-02f, 9.998259544e-01f, 1.865635626e-02f, 9.999449849e-01f, 1.049165614e-02f,
  -9.524129629e-01f, -3.048106134e-01f, -6.843819022e-01f, 7.291237116e-01f, 9.923083186e-01f, 1.237909496e-01f, -3.201591671e-01f, -9.473637342e-01f,
  9.601702690e-01f, -2.794154882e-01f, -9.731037021e-01f, -2.303675115e-01f, -3.207964003e-01f, 9.471482038e-01f, 4.827820361e-01f, 8.757405281e-01f,
  8.253356218e-01f, 5.646424294e-01f, 9.436169863e-01f, 3.310393095e-01f, 9.820539355e-01f, 1.886002868e-01f, 9.943132997e-01f, 1.064944416e-01f,
  9.982005358e-01f, 5.996400863e-02f, 9.994308352e-01f, 3.373407945e-02f, 9.998199940e-01f, 1.897252724e-02f, 9.999430776e-01f, 1.066947449e-02f,
  -2.581016421e-01f, -9.661177993e-01f, -9.677396417e-01f, 2.519522607e-01f, 9.046075940e-01f, 4.262454212e-01f, -1.475291997e-01f, -9.890577197e-01f,
  9.832684398e-01f, -1.821625978e-01f, -9.586178064e-01f, -2.846961617e-01f, -3.505824506e-01f, 9.365318418e-01f, 4.671334028e-01f, 8.841868639e-01f,
  8.196480274e-01f, 5.728674531e-01f, 9.417404532e-01f, 3.363404274e-01f, 9.814526439e-01f, 1.917048544e-01f, 9.941223264e-01f, 1.082624346e-01f,
  9.981400967e-01f, 6.096218154e-02f, 9.994117022e-01f, 3.429609165e-02f, 9.998139739e-01f, 1.928869821e-02f, 9.999411702e-01f, 1.084729191e-02f,
  6.735071540e-01f, -7.391806841e-01f, -9.530500174e-01f, -3.028128743e-01f, 7.271980643e-01f, 6.864276528e-01f, 2.975377068e-02f, -9.995572567e-01f,
  9.965420961e-01f, -8.308912069e-02f, -9.411013126e-01f, -3.381247520e-01f, -3.800179660e-01f, 9.249790907e-01f, 4.513370395e-01f, 8.923535347e-01f,
  8.138784766e-01f, 5.810351372e-01f, 9.398342371e-01f, 3.416308761e-01f, 9.808415174e-01f, 1.948075294e-01f, 9.939282537e-01f, 1.100300923e-01f,
  9.980786443e-01f, 6.196028739e-02f, 9.993922710e-01f, 3.485809639e-02f, 9.998078346e-01f, 1.960486546e-02f, 9.999392033e-01f, 1.102510840e-02f,
  9.858965874e-01f, 1.673557013e-01f, -6.448370218e-01f, -7.643200755e-01f, 4.776714444e-01f, 8.785385489e-01f, 2.060983330e-01f, -9.785313010e-01f,
  9.998586178e-01f, 1.681409031e-02f, -9.206095338e-01f, -3.904843926e-01f, -4.090735018e-01f, 9.125014544e-01f, 4.353979528e-01f, 9.002380967e-01f,
  8.080275059e-01f, 5.891447663e-01f, 9.378982186e-01f, 3.469105363e-01f, 9.802205563e-01f, 1.979082376e-01f, 9.937310219e-01f, 1.117973924e-01f,
  9.980161786e-01f, 6.295833737e-02f, 9.993724823e-01f, 3.542009369e-02f, 9.998015761e-01f, 1.992103085e-02f, 9.999372363e-01f, 1.120292582e-02f,
};
__device__ const float ROPE32[1024] = {
  1.000000000e+00f, 0.000000000e+00f, 1.000000000e+00f, 0.000000000e+00f, 1.000000000e+00f, 0.000000000e+00f, 1.000000000e+00f, 0.000000000e+00f,
  1.000000000e+00f, 0.000000000e+00f, 1.000000000e+00f, 0.000000000e+00f, 1.000000000e+00f, 0.000000000e+00f, 1.000000000e+00f, 0.000000000e+00f,
  5.403022766e-01f, 8.414709568e-01f, 9.504152536e-01f, 3.109835982e-01f, 9.950041771e-01f, 9.983342141e-02f, 9.995000362e-01f, 3.161750361e-02f,
  9.999499917e-01f, 9.999833070e-03f, 9.999949932e-01f, 3.162272274e-03f, 9.999995232e-01f, 9.999999311e-04f, 9.999999404e-01f, 3.162277571e-04f,
  -4.161468446e-01f, 9.092974067e-01f, 8.065783978e-01f, 5.911270976e-01f, 9.800665975e-01f, 1.986693293e-01f, 9.980006814e-01f, 6.320339441e-02f,
  9.998000264e-01f, 1.999866590e-02f, 9.999799728e-01f, 6.324512884e-03f, 9.999979734e-01f, 1.999998698e-03f, 9.999998212e-01f, 6.324554561e-04f,
  -9.899924994e-01f, 1.411200017e-01f, 5.827536583e-01f, 8.126488924e-01f, 9.553365111e-01f, 2.955202162e-01f, 9.955033660e-01f, 9.472608566e-02f,
  9.995500445e-01f, 2.999549918e-02f, 9.999549985e-01f, 9.486690164e-03f, 9.999955297e-01f, 2.999995602e-03f, 9.999995232e-01f, 9.486831259e-04f,
  -6.536436081e-01f, -7.568024993e-01f, 3.011374772e-01f, 9.535807371e-01f, 9.210609794e-01f, 3.894183338e-01f, 9.920106530e-01f, 1.261540651e-01f,
  9.992001057e-01f, 3.998933360e-02f, 9.999200106e-01f, 1.264877338e-02f, 9.999920130e-01f, 3.999989480e-03f, 9.999992251e-01f, 1.264910679e-03f,
  2.836622000e-01f, -9.589242935e-01f, -1.034233812e-02f, 9.999465346e-01f, 8.775825500e-01f, 4.794255495e-01f, 9.875259995e-01f, 1.574558765e-01f,
  9.987502694e-01f, 4.997916520e-02f, 9.998750091e-01f, 1.581072807e-02f, 9.999874830e-01f, 4.999979399e-03f, 9.999987483e-01f, 1.581138116e-03f,
  9.601702690e-01f, -2.794154882e-01f, -3.207964003e-01f, 9.471482038e-01f, 8.253356218e-01f, 5.646424890e-01f, 9.820539355e-01f, 1.886002719e-01f,
  9.982005358e-01f, 5.996400490e-02f, 9.998199940e-01f, 1.897252724e-02f, 9.999819994e-01f, 5.999964196e-03f, 9.999982119e-01f, 1.897365320e-03f,
  7.539022565e-01f, 6.569865942e-01f, -5.994374752e-01f, 8.004215956e-01f, 7.648422122e-01f, 6.442176700e-01f, 9.755998850e-01f, 2.195560932e-01f,
  9.975510240e-01f, 6.994284689e-02f, 9.997550249e-01f, 2.213413455e-02f, 9.999755025e-01f, 6.999942940e-03f, 9.999975562e-01f, 2.213592408e-03f,
  -1.455000341e-01f, 9.893582463e-01f, -8.186324239e-01f, 5.743177533e-01f, 6.967067122e-01f, 7.173560858e-01f, 9.681702852e-01f, 2.502923310e-01f,
  9.968017340e-01f, 7.991468906e-02f, 9.996800423e-01f, 2.529552206e-02f, 9.999679923e-01f, 7.999914698e-03f, 9.999967813e-01f, 2.529819263e-03f,
  -9.111302495e-01f, 4.121184945e-01f, -9.566441774e-01f, 2.912592292e-01f, 6.216099262e-01f, 7.833269238e-01f, 9.597726464e-01f, 2.807783186e-01f,
  9.959527254e-01f, 8.987854421e-02f, 9.995950460e-01f, 2.845665626e-02f, 9.999595284e-01f, 8.999879472e-03f, 9.999959469e-01f, 2.846045885e-03f,
  -8.390715122e-01f, -5.440211296e-01f, -9.997860789e-01f, -2.068356983e-02f, 5.403022766e-01f, 8.414709568e-01f, 9.504153132e-01f, 3.109835684e-01f,
  9.950041771e-01f, 9.983341396e-02f, 9.995000362e-01f, 3.161750361e-02f, 9.999499917e-01f, 9.999834001e-03f, 9.999949932e-01f, 3.162272274e-03f,
  4.425697960e-03f, -9.999902248e-01f, -9.437797666e-01f, -3.305749595e-01f, 4.535960853e-01f, 8.912073970e-01f, 9.401075840e-01f, 3.408778608e-01f,
  9.939560890e-01f, 1.097782999e-01f, 9.993950725e-01f, 3.477803990e-02f, 9.999395013e-01f, 1.099977922e-02f, 9.999939203e-01f, 3.478498431e-03f,
  8.438539505e-01f, -5.365729332e-01f, -7.941793799e-01f, -6.076834202e-01f, 3.623577058e-01f, 9.320390821e-01f, 9.288598895e-01f, 3.704313040e-01f,
  9.928086400e-01f, 1.197122037e-01f, 9.992800951e-01f, 3.793822229e-02f, 9.999279976e-01f, 1.199971233e-02f, 9.999927878e-01f, 3.794723889e-03f,
  9.074468017e-01f, 4.201670289e-01f, -5.658205152e-01f, -8.245284557e-01f, 2.674987614e-01f, 9.635581970e-01f, 9.166833758e-01f, 3.996143043e-01f,
  9.915618896e-01f, 1.296341419e-01f, 9.991551042e-01f, 4.109803215e-02f, 9.999154806e-01f, 1.299963426e-02f, 9.999915361e-01f, 4.110949114e-03f,
  1.367372125e-01f, 9.906073809e-01f, -2.813494802e-01f, -9.596053958e-01f, 1.699671596e-01f, 9.854497313e-01f, 9.035902619e-01f, 4.283977747e-01f,
  9.902160168e-01f, 1.395431161e-01f, 9.990201592e-01f, 4.425742477e-02f, 9.999020100e-01f, 1.399954315e-02f, 9.999902248e-01f, 4.427174106e-03f,
  -7.596879005e-01f, 6.502878666e-01f, 3.102235124e-02f, -9.995186925e-01f, 7.073719800e-02f, 9.974949956e-01f, 8.895936012e-01f, 4.567528665e-01f,
  9.887710810e-01f, 1.494381279e-01f, 9.988752007e-01f, 4.741638154e-02f, 9.998875260e-01f, 1.499943808e-02f, 9.999887347e-01f, 4.743398633e-03f,
  -9.576594830e-01f, -2.879033089e-01f, 3.403181732e-01f, -9.403103590e-01f, -2.919954620e-02f, 9.995735884e-01f, 8.747074604e-01f, 4.846512377e-01f,
  9.872272611e-01f, 1.593182087e-01f, 9.987202883e-01f, 5.057485774e-02f, 9.998720288e-01f, 1.599931903e-02f, 9.999871850e-01f, 5.059622694e-03f,
  -2.751633525e-01f, -9.613974690e-01f, 6.158648133e-01f, -7.878518701e-01f, -1.288445443e-01f, 9.916648269e-01f, 8.589466810e-01f, 5.120649934e-01f,
  9.855847955e-01f, 1.691823453e-01f, 9.985553622e-01f, 5.373282731e-02f, 9.998555183e-01f, 1.699918136e-02f, 9.999855757e-01f, 5.375845823e-03f,
  6.603167057e-01f, -7.509872317e-01f, 8.303361535e-01f, -5.572628975e-01f, -2.272021621e-01f, 9.738476276e-01f, 8.423270583e-01f, 5.389667153e-01f,
  9.838436842e-01f, 1.790295690e-01f, 9.983804226e-01f, 5.689026415e-02f, 9.998379946e-01f, 1.799902879e-02f, 9.999837875e-01f, 5.692068953e-03f,
  9.887046218e-01f, 1.498772055e-01f, 9.624637961e-01f, -2.714101076e-01f, -3.232895434e-01f, 9.463000894e-01f, 8.248651624e-01f, 5.653295517e-01f,
  9.820042253e-01f, 1.888588965e-01f, 9.981955290e-01f, 6.004713103e-02f, 9.998195171e-01f, 1.899885759e-02f, 9.999819398e-01f, 6.008291151e-03f,
  4.080820680e-01f, 9.129452705e-01f, 9.991443753e-01f, 4.135828838e-02f, -4.161468446e-01f, 9.092974067e-01f, 8.065784574e-01f, 5.911270380e-01f,
  9.800665975e-01f, 1.986693144e-01f, 9.980006814e-01f, 6.320339441e-02f, 9.998000264e-01f, 1.999866776e-02f, 9.999799728e-01f, 6.324512884e-03f,
  -5.477292538e-01f, 8.366556168e-01f, 9.367404580e-01f, 3.500247598e-01f, -5.048462152e-01f, 8.632093072e-01f, 7.874851823e-01f, 6.163335443e-01f,
  9.780309200e-01f, 2.084598988e-01f, 9.977958202e-01f, 6.635902822e-02f, 9.997795224e-01f, 2.099845745e-02f, 9.999779463e-01f, 6.640734151e-03f,
  -9.999608397e-01f, -8.851309307e-03f, 7.814403772e-01f, 6.239799261e-01f, -5.885011554e-01f, 8.084963560e-01f, 7.676045895e-01f, 6.409237385e-01f,
  9.758974314e-01f, 2.182296216e-01f, 9.975810051e-01f, 6.951400638e-02f, 9.997580051e-01f, 2.199822664e-02f, 9.999758005e-01f, 6.956954487e-03f,
  -5.328330398e-01f, -8.462204337e-01f, 5.486452579e-01f, 8.360552788e-01f, -6.662759781e-01f, 7.457052469e-01f, 7.469564080e-01f, 6.648730636e-01f,
  9.736663699e-01f, 2.279775143e-01f, 9.973561764e-01f, 7.266827673e-02f, 9.997355342e-01f, 2.299797349e-02f, 9.999735355e-01f, 7.273174357e-03f,
  4.241790175e-01f, -9.055783749e-01f, 2.614416778e-01f, 9.652192593e-01f, -7.373937964e-01f, 6.754631400e-01f, 7.255613208e-01f, 6.881574988e-01f,
  9.713379741e-01f, 2.377026230e-01f, 9.971213937e-01f, 7.582182437e-02f, 9.997119904e-01f, 2.399769612e-02f, 9.999712110e-01f, 7.589393295e-03f,
  9.912028313e-01f, -1.323517561e-01f, -5.168933049e-02f, 9.986631870e-01f, -8.011435866e-01f, 5.984721184e-01f, 7.034407258e-01f, 7.107539177e-01f,
  9.689124227e-01f, 2.474039644e-01f, 9.968766570e-01f, 7.897461206e-02f, 9.996874928e-01f, 2.499739639e-02f, 9.999687672e-01f, 7.905611768e-03f,
  6.469193101e-01f, 7.625584602e-01f, -3.596943319e-01f, 9.330701828e-01f, -8.568888307e-01f, 5.155012608e-01f, 6.806167960e-01f, 7.326396108e-01f,
  9.663899541e-01f, 2.570805550e-01f, 9.966219068e-01f, 8.212661743e-02f, 9.996620417e-01f, 2.599707060e-02f, 9.999662042e-01f, 8.221829310e-03f,
  -2.921388149e-01f, 9.563759565e-01f, -6.320286393e-01f, 7.749450207e-01f, -9.040721655e-01f, 4.273798466e-01f, 6.571123004e-01f, 7.537927032e-01f,
  9.637709260e-01f, 2.667314112e-01f, 9.963572025e-01f, 8.527779579e-02f, 9.996355176e-01f, 2.699672058e-02f, 9.999635220e-01f, 8.538045920e-03f,
  -9.626058936e-01f, 2.709057927e-01f, -8.416849375e-01f, 5.399689674e-01f, -9.422222972e-01f, 3.349882066e-01f, 6.329506636e-01f, 7.741920948e-01f,
  9.610554576e-01f, 2.763556540e-01f, 9.960825443e-01f, 8.842811733e-02f, 9.996080399e-01f, 2.799634263e-02f, 9.999607801e-01f, 8.854261599e-03f,
  -7.480575442e-01f, -6.636338830e-01f, -9.678714871e-01f, 2.514453232e-01f, -9.709581733e-01f, 2.392492294e-01f, 6.081562042e-01f, 7.938174009e-01f,
  9.582439065e-01f, 2.859522104e-01f, 9.957979321e-01f, 9.157756716e-02f, 9.995795488e-01f, 2.899593674e-02f, 9.999579787e-01f, 9.170476347e-03f,
  1.542514563e-01f, -9.880316257e-01f, -9.980752468e-01f, -6.201484054e-02f, -9.899924994e-01f, 1.411200017e-01f, 5.827536583e-01f, 8.126488924e-01f,
  9.553365111e-01f, 2.955201864e-01f, 9.955033660e-01f, 9.472609311e-02f, 9.995500445e-01f, 2.999550104e-02f, 9.999549985e-01f, 9.486690164e-03f,
  9.147423506e-01f, -4.040376544e-01f, -9.293003082e-01f, -3.693250120e-01f, -9.991351366e-01f, 4.158052057e-02f, 5.567683578e-01f, 8.306677938e-01f,
  9.523335695e-01f, 3.050586283e-01f, 9.951988459e-01f, 9.787366539e-02f, 9.995195270e-01f, 3.099503554e-02f, 9.999519587e-01f, 9.802903049e-03f,
  8.342233896e-01f, 5.514267087e-01f, -7.683671117e-01f, -6.400094032e-01f, -9.982947707e-01f, -5.837419257e-02f, 5.302263498e-01f, 8.478561044e-01f,
  9.492354393e-01f, 3.145665526e-01f, 9.948843718e-01f, 1.010202691e-01f, 9.994880557e-01f, 3.199454024e-02f, 9.999487996e-01f, 1.011911593e-02f,
  -1.327674743e-02f, 9.999118447e-01f, -5.312352777e-01f, -8.472243547e-01f, -9.874798059e-01f, -1.577456445e-01f, 5.031541586e-01f, 8.641966581e-01f,
  9.460423589e-01f, 3.240430057e-01f, 9.945599437e-01f, 1.041658595e-01f, 9.994555712e-01f, 3.299400955e-02f, 9.999455214e-01f, 1.043532696e-02f,
  -8.485702872e-01f, 5.290827155e-01f, -2.414211184e-01f, -9.704204202e-01f, -9.667981863e-01f, -2.555412054e-01f, 4.755789042e-01f, 8.796730638e-01f,
  9.427546859e-01f, 3.334870934e-01f, 9.942255616e-01f, 1.073104069e-01f, 9.994220734e-01f, 3.399345279e-02f, 9.999421835e-01f, 1.075153705e-02f,
  -9.036921859e-01f, -4.281826615e-01f, 7.233466953e-02f, -9.973804355e-01f, -9.364566803e-01f, -3.507832289e-01f, 4.475280643e-01f, 8.942698836e-01f,
  9.393727183e-01f, 3.428978026e-01f, 9.938812256e-01f, 1.104538813e-01f, 9.993875623e-01f, 3.499285504e-02f, 9.999387264e-01f, 1.106774528e-02f,
  -1.279636919e-01f, -9.917788506e-01f, 3.789161742e-01f, -9.254310131e-01f, -8.967583776e-01f, -4.425205588e-01f, 4.190297425e-01f, 9.079725146e-01f,
  9.358968139e-01f, 3.522742093e-01f, 9.935269952e-01f, 1.135962531e-01f, 9.993520975e-01f, 3.599222749e-02f, 9.999352098e-01f, 1.138395350e-02f,
  7.654140592e-01f, -6.435381174e-01f, 6.479216814e-01f, -7.617069483e-01f, -8.481000066e-01f, -5.298361778e-01f, 3.901124299e-01f, 9.207672477e-01f,
  9.323273301e-01f, 3.616154492e-01f, 9.931628108e-01f, 1.167374924e-01f, 9.993155599e-01f, 3.699155897e-02f, 9.999315739e-01f, 1.170015987e-02f,
  9.550736547e-01f, 2.963685691e-01f, 8.526731133e-01f, -5.224447846e-01f, -7.909677625e-01f, -6.118578315e-01f, 3.608050346e-01f, 9.326412678e-01f,
  9.286646247e-01f, 3.709204793e-01f, 9.927886724e-01f, 1.198775545e-01f, 9.992780685e-01f, 3.799085692e-02f, 9.999278188e-01f, 1.201636530e-02f,
  2.666429281e-01f, 9.637953639e-01f, 9.728653431e-01f, -2.313720137e-01f, -7.259322405e-01f, -6.877662539e-01f, 3.311368525e-01f, 9.435827136e-01f,
  9.249090552e-01f, 3.801884055e-01f, 9.924046397e-01f, 1.230164245e-01f, 9.992396235e-01f, 3.899011388e-02f, 9.999239445e-01f, 1.233256981e-02f,
  -6.669380665e-01f, 7.451131344e-01f, 9.965789914e-01f, 8.264580369e-02f, -6.536436081e-01f, -7.568024993e-01f, 3.011375964e-01f, 9.535806775e-01f,
  9.210609794e-01f, 3.894183338e-01f, 9.920106530e-01f, 1.261540651e-01f, 9.992001057e-01f, 3.998933733e-02f, 9.999200106e-01f, 1.264877338e-02f,
  -9.873392582e-01f, -1.586226672e-01f, 9.214623570e-01f, 3.884676993e-01f, -5.748240352e-01f, -8.182770610e-01f, 2.708370686e-01f, 9.626252055e-01f,
  9.171208143e-01f, 3.986093104e-01f, 9.916067719e-01f, 1.292904317e-01f, 9.991596341e-01f, 4.098851606e-02f, 9.999159575e-01f, 1.296497509e-02f,
  -3.999853134e-01f, -9.165215492e-01f, 7.549653649e-01f, 6.557646990e-01f, -4.902605712e-01f, -8.715758920e-01f, 2.402658761e-01f, 9.707071185e-01f,
  9.130889177e-01f, 4.077604413e-01f, 9.911929369e-01f, 1.324255317e-01f, 9.991181493e-01f, 4.198765755e-02f, 9.999117851e-01f, 1.328117587e-02f,
  5.551133156e-01f, -8.317747712e-01f, 5.135984421e-01f, 8.580306768e-01f, -4.007990062e-01f, -9.161660075e-01f, 2.094544172e-01f, 9.778184295e-01f,
  9.089657664e-01f, 4.168707728e-01f, 9.907692075e-01f, 1.355592906e-01f, 9.990756512e-01f, 4.298675060e-02f, 9.999075532e-01f, 1.359737478e-02f,
  9.998432994e-01f, 1.770192571e-02f, 2.212981731e-01f, 9.752061963e-01f, -3.073327839e-01f, -9.516021013e-01f, 1.784335226e-01f, 9.839519858e-01f,
  9.047516584e-01f, 4.259394705e-01f, 9.903355837e-01f, 1.386916935e-01f, 9.990321398e-01f, 4.398580641e-02f, 9.999032021e-01f, 1.391357277e-02f,
  5.253219604e-01f, 8.509035110e-01f, -9.294810891e-02f, 9.956709743e-01f, -2.107958049e-01f, -9.775301218e-01f, 1.472342163e-01f, 9.891016483e-01f,
  9.004471302e-01f, 4.349655211e-01f, 9.898920655e-01f, 1.418227106e-01f, 9.989876747e-01f, 4.498481750e-02f, 9.998987317e-01f, 1.422976889e-02f,
  -4.321779311e-01f, 9.017883539e-01f, -3.979767561e-01f, 9.173954725e-01f, -1.121526212e-01f, -9.936909676e-01f, 1.158876941e-01f, 9.932623506e-01f,
  8.960524797e-01f, 4.439480901e-01f, 9.894386530e-01f, 1.449523121e-01f, 9.989421964e-01f, 4.598378390e-02f, 9.998942018e-01f, 1.454596408e-02f,
  -9.923354983e-01f, 1.235731244e-01f, -6.635382771e-01f, 7.481423616e-01f, -1.238837745e-02f, -9.999232888e-01f, 8.442528546e-02f, 9.964298010e-01f,
  8.915683031e-01f, 4.528862834e-01f, 9.889753461e-01f, 1.480804533e-01f, 9.988957047e-01f, 4.698270187e-02f, 9.998895526e-01f, 1.486215740e-02f,
  -6.401443481e-01f, -7.682546377e-01f, -8.632965088e-01f, 5.046970844e-01f, 8.749917150e-02f, -9.961646199e-01f, 5.287845805e-02f, 9.986009598e-01f,
  8.869948983e-01f, 4.617791772e-01f, 9.885020852e-01f, 1.512071192e-01f, 9.988481998e-01f, 4.798157141e-02f, 9.998847842e-01f, 1.517834887e-02f,
  3.005925417e-01f, -9.537526369e-01f, -9.774427414e-01f, 2.112006545e-01f, 1.865124702e-01f, -9.824525714e-01f, 2.127875760e-02f, 9.997735620e-01f,
  8.823328614e-01f, 4.706258774e-01f, 9.880189896e-01f, 1.543322802e-01f, 9.987997413e-01f, 4.898039624e-02f, 9.998799562e-01f, 1.549453940e-02f,
  9.649659991e-01f, -2.623748481e-01f, -9.946564436e-01f, -1.032404602e-01f, 2.836622000e-01f, -9.589242935e-01f, -1.034221891e-02f, 9.999465346e-01f,
  8.775825500e-01f, 4.794255495e-01f, 9.875259995e-01f, 1.574558914e-01f, 9.987502694e-01f, 4.997916892e-02f, 9.998750091e-01f, 1.581072807e-02f,
  7.421541810e-01f, 6.702291965e-01f, -9.132301211e-01f, -4.074441493e-01f, 3.779776692e-01f, -9.258147478e-01f, -4.195285589e-02f, 9.991195798e-01f,
  8.727445006e-01f, 4.881772399e-01f, 9.870231748e-01f, 1.605779380e-01f, 9.986997843e-01f, 5.097789690e-02f, 9.998699427e-01f, 1.612691768e-02f,
  -1.629907787e-01f, 9.866275787e-01f, -7.412399650e-01f, -6.712401509e-01f, 4.685169160e-01f, -8.834545016e-01f, -7.352153957e-02f, 9.972936511e-01f,
  8.678191900e-01f, 4.968801141e-01f, 9.865104556e-01f, 1.636983752e-01f, 9.986482859e-01f, 5.197656900e-02f, 9.998648167e-01f, 1.644310169e-02f,
  -9.182828069e-01f, 3.959251642e-01f, -4.957418144e-01f, -8.684699535e-01f, 5.543745160e-01f, -8.322673440e-01f, -1.050167084e-01f, 9.944704771e-01f,
  8.628070951e-01f, 5.055333376e-01f, 9.859878421e-01f, 1.668171734e-01f, 9.985958338e-01f, 5.297519267e-02f, 9.998595715e-01f, 1.675928757e-02f,
  -8.293098211e-01f, -5.587890744e-01f, -2.010796219e-01f, -9.795749187e-01f, 6.346929669e-01f, -7.727644444e-01f, -1.364068687e-01f, 9.906529188e-01f,
  8.577086926e-01f, 5.141359568e-01f, 9.854553938e-01f, 1.699342877e-01f, 9.985423684e-01f, 5.397376046e-02f, 9.998542070e-01f, 1.707546785e-02f,
  2.212675661e-02f, -9.997551441e-01f, 1.135217771e-01f, -9.935355186e-01f, 7.086697817e-01f, -7.055402994e-01f, -1.676606387e-01f, 9.858447909e-01f,
  8.525245190e-01f, 5.226872563e-01f, 9.849131107e-01f, 1.730497181e-01f, 9.984878898e-01f, 5.497227982e-02f, 9.998487830e-01f, 1.739165001e-02f,
  8.532201052e-01f, -5.215510130e-01f, 4.168670774e-01f, -9.089674354e-01f, 7.755658031e-01f, -6.312667131e-01f, -1.987468749e-01f, 9.800508618e-01f,
  8.472551107e-01f, 5.311862230e-01f, 9.843609333e-01f, 1.761634201e-01f, 9.984323978e-01f, 5.597073585e-02f, 9.998431802e-01f, 1.770782843e-02f,
  8.998668194e-01f, 4.361647666e-01f, 6.788702011e-01f, -7.342582941e-01f, 8.347129226e-01f, -5.506852865e-01f, -2.296342701e-01f, 9.732769728e-01f,
  8.419010043e-01f, 5.396320224e-01f, 9.837989211e-01f, 1.792753637e-01f, 9.983759522e-01f, 5.696914345e-02f, 9.998375773e-01f, 1.802400686e-02f,
  1.191801354e-01f, 9.928726554e-01f, 8.735505342e-01f, -4.867334962e-01f, 8.855196238e-01f, -4.646020234e-01f, -2.602920532e-01f, 9.655299187e-01f,
  8.364626765e-01f, 5.480239391e-01f, 9.832270741e-01f, 1.823855042e-01f, 9.983184934e-01f, 5.796748772e-02f, 9.998317957e-01f, 1.834018156e-02f,
  -7.710801959e-01f, 6.367380023e-01f, 9.816020727e-01f, -1.909380108e-01f, 9.274784923e-01f, -3.738765717e-01f, -2.906895578e-01f, 9.568174481e-01f,
  8.309407234e-01f, 5.563610196e-01f, 9.826454520e-01f, 1.854938269e-01f, 9.982600212e-01f, 5.896577984e-02f, 9.998259544e-01f, 1.865635626e-02f,
  -9.524129629e-01f, -3.048106134e-01f, 9.923083186e-01f, 1.237909496e-01f, 9.601702690e-01f, -2.794154882e-01f, -3.207964003e-01f, 9.471482038e-01f,
  8.253356218e-01f, 5.646424294e-01f, 9.820539355e-01f, 1.886002868e-01f, 9.982005358e-01f, 5.996400863e-02f, 9.998199940e-01f, 1.897252724e-02f,
  -2.581016421e-01f, -9.661177993e-01f, 9.046075940e-01f, 4.262454212e-01f, 9.832684398e-01f, -1.821625978e-01f, -3.505824506e-01f, 9.365318418e-01f,
  8.196480274e-01f, 5.728674531e-01f, 9.814526439e-01f, 1.917048544e-01f, 9.981400967e-01f, 6.096218154e-02f, 9.998139739e-01f, 1.928869821e-02f,
  6.735071540e-01f, -7.391806841e-01f, 7.271980643e-01f, 6.864276528e-01f, 9.965420961e-01f, -8.308912069e-02f, -3.800179660e-01f, 9.249790907e-01f,
  8.138784766e-01f, 5.810351372e-01f, 9.808415174e-01f, 1.948075294e-01f, 9.980786443e-01f, 6.196028739e-02f, 9.998078346e-01f, 1.960486546e-02f,
  9.858965874e-01f, 1.673557013e-01f, 4.776714444e-01f, 8.785385489e-01f, 9.998586178e-01f, 1.681409031e-02f, -4.090735018e-01f, 9.125014544e-01f,
  8.080275059e-01f, 5.891447663e-01f, 9.802205563e-01f, 1.979082376e-01f, 9.980161786e-01f, 6.295833737e-02f, 9.998015761e-01f, 1.992103085e-02f,
};
#define XB_TMO      128
#define XB_XCNT(j)  (256  + 64 * (j))
#define XB_XSUB(j)  (1280 + 64 * (j))
#define XB_XGEN(j)  (2304 + 64 * (j))
#define XB_TOP      3328
#define XB_TOPGEN   3392
#define XCD_BAR_WORDS 3456
#define XB_SPIN_CAP (1u << 18)
#define LAS __attribute__((address_space(3)))

__device__ __forceinline__ unsigned xb_ld(unsigned* p)              { return __hip_atomic_load(p, __ATOMIC_RELAXED, __HIP_MEMORY_SCOPE_AGENT); }
__device__ __forceinline__ unsigned xb_add(unsigned* p, unsigned v) { return __hip_atomic_fetch_add(p, v, __ATOMIC_RELAXED, __HIP_MEMORY_SCOPE_AGENT); }
__device__ __forceinline__ unsigned xb_xcc_id() { return (unsigned)__builtin_amdgcn_s_getreg((3 << 11) | 20) & 0xFu; }
#define XB_SPIN(cond, bar) do { unsigned _sp = 0; while (cond) { __builtin_amdgcn_s_sleep(1); \
    if ((++_sp & 255u) == 0u) { if (xb_ld(&(bar)[XB_TMO])) break; if (_sp > XB_SPIN_CAP) { atomicAdd(&(bar)[XB_TMO], 1u); break; } } } } while (0)

struct XcdBarrier {
    unsigned* bar; unsigned x;
    volatile LAS unsigned* st;
};

__device__ __forceinline__ XcdBarrier xcd_barrier_post(unsigned* bar, volatile LAS unsigned* st) {
    XcdBarrier b; b.bar = bar; b.x = xb_xcc_id(); b.st = st;
    if (threadIdx.x == 0) (void)xb_add(&bar[XB_XCNT(b.x)], 1u);
    return b;
}
__device__ __forceinline__ void xcd_barrier_complete(unsigned* bar, unsigned x, unsigned& nloc, unsigned& nx) {
    const unsigned G = gridDim.x * gridDim.y * gridDim.z;
    unsigned sum, cnt, mine, sp = 0u;
    for (;;) {
        sum = 0u; cnt = 0u; mine = 0u;
#pragma unroll
        for (unsigned j = 0; j < 16; ++j) { const unsigned c = xb_ld(&bar[XB_XCNT(j)]); sum += c; cnt += (c > 0u) ? 1u : 0u; mine = (j == x) ? c : mine; }
        if (sum == G) break;
        __builtin_amdgcn_s_sleep(1);
        if ((++sp & 255u) == 0u) { if (xb_ld(&bar[XB_TMO])) break; if (sp > XB_SPIN_CAP) { atomicAdd(&bar[XB_TMO], 1u); break; } }
    }
    nloc = mine > 0u ? mine : 1u; nx = cnt > 0u ? cnt : 1u;
}

__device__ __forceinline__ void xcd_barrier(const XcdBarrier& b, const bool t0  ) {
    asm volatile("s_waitcnt vmcnt(0)" ::: "memory");
    __syncthreads();
    if (t0) {
        unsigned* bar = b.bar;
        __builtin_amdgcn_s_waitcnt(0);
        unsigned nloc = b.st[0], nx = b.st[1];
        if (nloc == 0u) { xcd_barrier_complete(bar, b.x, nloc, nx); b.st[0] = nloc; b.st[1] = nx; }
        const unsigned old = xb_add(&bar[XB_XSUB(b.x)], 1u);
        const unsigned gen = old / nloc;
        if (old + 1u == (gen + 1u) * nloc) {
            __builtin_amdgcn_fence(__ATOMIC_RELEASE, "agent");
            asm volatile("s_waitcnt vmcnt(0)" ::: "memory");
            const unsigned og = xb_add(&bar[XB_TOP], 1u);
            const unsigned tg = og / nx;
            if (og + 1u == (tg + 1u) * nx) xb_add(&bar[XB_TOPGEN], 1u);
            else XB_SPIN(xb_ld(&bar[XB_TOPGEN]) == tg, bar);
            __builtin_amdgcn_fence(__ATOMIC_ACQUIRE, "agent");
            xb_add(&bar[XB_XGEN(b.x)], 1u);
            asm volatile("s_waitcnt vmcnt(0)" ::: "memory");
        } else {
            XB_SPIN(xb_ld(&bar[XB_XGEN(b.x)]) == gen, bar);
            __builtin_amdgcn_fence(__ATOMIC_ACQUIRE, "agent");
            asm volatile("s_waitcnt vmcnt(0)" ::: "memory");
        }
    }
    __syncthreads();
}

DI void conv_fetch(const float* __restrict__ src, int K, int N, int k0, int n0, f32x4 (&v)[2], int tid) {
#pragma unroll
    for (int i = 0; i < 2; ++i) {
        const int idx = tid + NTHREADS * i, kr = idx >> 4, c4 = (idx & 15) * 4;
        v[i] = (f32x4){0.f, 0.f, 0.f, 0.f};
        if (n0 + c4 < N) v[i] = __builtin_nontemporal_load((const f32x4*)(src + (size_t)(k0 + kr) * N + n0 + c4));
    }
}
DI void conv_put(const f32x4 (&v)[2], float* lds, int tid) {
#pragma unroll
    for (int i = 0; i < 2; ++i) {
        const int idx = tid + NTHREADS * i, kr = idx >> 4, c4 = (idx & 15) * 4;
        float* d = lds + kr * 65 + c4;
        d[0] = v[i].x; d[1] = v[i].y; d[2] = v[i].z; d[3] = v[i].w;
    }
}
typedef float f32x2_8 __attribute__((ext_vector_type(2)));
DI unsigned cvt_fp8x4(float a, float b, float c, float d) { int w = __builtin_amdgcn_cvt_pk_fp8_f32(a, b, 0, false); w = __builtin_amdgcn_cvt_pk_fp8_f32(c, d, w, true); return (unsigned)w; }
template <bool NT, bool FP8>
DI void conv_store(int K, bf16_t* __restrict__ dst, int k0, int ndst0, int nstep, const float* lds, int tid) {
    const int idx = tid, n = idx >> 3, kc = idx & 7;
    float f[8];
#pragma unroll
    for (int j = 0; j < 8; ++j) f[j] = lds[(kc * 8 + j) * 65 + n];
    const size_t e = (size_t)(ndst0 + (n & 31) + (n >> 5) * nstep) * K + k0 + kc * 8;
    if (FP8) {
        u32x2 w; w.x = cvt_fp8x4(f[0] * 32.f, f[1] * 32.f, f[2] * 32.f, f[3] * 32.f); w.y = cvt_fp8x4(f[4] * 32.f, f[5] * 32.f, f[6] * 32.f, f[7] * 32.f);
        u32x2* d = (u32x2*)((unsigned char*)dst + e);
        if (NT) __builtin_nontemporal_store(w, d); else *d = w;
    } else {
        u32x4* d = (u32x4*)(dst + e);
        if (NT) __builtin_nontemporal_store(pack8(f), d); else *d = pack8(f);
    }
}
template <bool NT = true, bool FP8 = false>
DI void conv_job(const float* src, int count, int K, int N, int Npad, bf16_t* dst, int perm  , int& base, float* lds, int bid, int nb, int tid) {
    const int tk = K / 64, tn = Npad / 64, per = tk * tn, total = count * per;
    int t = (bid - (base % nb) + nb) % nb;
    f32x4 rg[4][2];
    auto fetch4 = [&](int tt) {
#pragma unroll
        for (int q = 0; q < 4; ++q) {
            const int tq = tt + q * nb;
            if (tq < total) { const int mi = tq / per, rem = tq - mi * per, nt = rem / tk, kt = rem - nt * tk;
                conv_fetch(src + (size_t)mi * K * N, K, N, kt * 64, nt * 64, rg[q], tid); }
        }
    };
    if (t < total) fetch4(t);
    for (; t < total; t += 4 * nb) {
#pragma unroll
        for (int q = 0; q < 4; ++q) if (t + q * nb < total) conv_put(rg[q], lds + q * 4160, tid);
        __syncthreads();
        if (t + 4 * nb < total) fetch4(t + 4 * nb);
#pragma unroll
        for (int q = 0; q < 4; ++q) {
            const int tq = t + q * nb;
            if (tq < total) { const int mi = tq / per, rem = tq - mi * per, nt = rem / tk, kt = rem - nt * tk, n0 = nt * 64;
                int nd0 = n0, nstep = 32;
                if (perm == 1) nd0 = ((n0 & 255) >> 7) * 256 + (n0 >> 8) * 128 + (n0 & 127);
                else if (n0 < perm) { const int hg = n0 >> 6; nd0 = (hg >> 2) * 256 + (hg & 3) * 32; nstep = 128; }
                conv_store<NT, FP8>(K, FP8 ? (bf16_t*)((unsigned char*)dst + (size_t)mi * Npad * K) : dst + (size_t)mi * Npad * K, kt * 64, nd0, nstep, lds + q * 4160, tid); }
        }
        __syncthreads();
    }
    base += total;
}

DI int mla_col(bool uq, int r) {
    const int hw = uq ? 96 : 128;
    if (r < 1024) { const int pn = r >> 8, bj = (r >> 7) & 1, wc = (r >> 5) & 3, d = r & 31; return (4 * pn + wc) * hw + 32 * bj + d; }
    const int rr = r - 1024;
    if (uq) { const int head = rr >> 5, c = rr & 31, dim = (c >> 3) * 4 + (c & 3) + 16 * ((c >> 2) & 1); return head * 96 + 64 + dim; }
    return (rr >> 6) * 128 + 64 + (rr & 63);
}
DI void phase_prologue(const Params& p, float* lds, int bid, int nb, int tid) {
    bf16_t* ws16 = (bf16_t*)p.ws;
    int base = 0;
    conv_job<true, true>(p.in[13], 1, 1024, 3072, 3072, (bf16_t*)(p.ws + W_QKV0), 2048, base, lds, bid, nb, tid);
    conv_job<true, true>(p.in[14], 1, 1024, 1024, 1024, (bf16_t*)(p.ws + W_O0), 0, base, lds, bid, nb, tid);
    conv_job<true, true>(p.in[18], 1, 1024, 1536, 1536, (bf16_t*)(p.ws + W_QKV1), 1280, base, lds, bid, nb, tid);
    conv_job<true, true>(p.in[19], 1, 1024, 1024, 1024, (bf16_t*)(p.ws + W_O1), 0, base, lds, bid, nb, tid);
    conv_job<true, true>(p.in[23], 1, 1024, 672, 768, (bf16_t*)(p.ws + W_DQKV), 0, base, lds, bid, nb, tid);
    for (int i = bid * NTHREADS + tid; i < 1536 * 64 + 2048 * 32; i += nb * NTHREADS) {
        const bool uq = i < 1536 * 64;
        const int K = uq ? 384 : 256, KB = uq ? 512 : 256, kc = KB / 8, ii = uq ? i : i - 1536 * 64, r = ii / kc, k0 = (ii - r * kc) * 8, nsrc = uq ? 1536 : 2048;
        u32x2 w8 = {0u, 0u};
        if (k0 < K) {
            const int col = mla_col(uq, r);
            const float* src = p.in[uq ? 26 : 27] + (size_t)k0 * nsrc + col;
            float f[8];
#pragma unroll
            for (int j = 0; j < 8; ++j) f[j] = src[(size_t)j * nsrc] * 32.f;
            w8.x = cvt_fp8x4(f[0], f[1], f[2], f[3]); w8.y = cvt_fp8x4(f[4], f[5], f[6], f[7]);
        }
        *(u32x2*)(p.ws + (uq ? W_UQ : W_UKV) + (size_t)r * KB + k0) = w8;
    }
    conv_job<true, true>(p.in[30], 1, 1024, 1024, 1024, (bf16_t*)(p.ws + W_O2), 0, base, lds, bid, nb, tid);
    conv_job<true, true>(p.in[31], 1, 1024, 3072, 3072, (bf16_t*)(p.ws + W_QKV3), 2048, base, lds, bid, nb, tid);
    conv_job<true, true>(p.in[36], 1, 1024, 1024, 1024, (bf16_t*)(p.ws + W_O3), 0, base, lds, bid, nb, tid);
    conv_job<true, true>(p.in[11], 32, 1024, 512, 512, (bf16_t*)(p.ws + W_GU), 1, base, lds, bid, nb, tid);
    conv_job(p.in[12], 32, 256, 1024, 1024, (bf16_t*)(p.ws + W_DN), 0, base, lds, bid, nb, tid);
    (void)ws16;
    float* sc = lds;
    for (int i = tid; i < 9 * 1024; i += NTHREADS) {
        const int r = i >> 10, k = i & 1023;
        const float v = r < 8 ? p.in[1][r * 1024 + k] : p.in[3][k];
        sc[i] = silu_f(v);
    }
    __syncthreads();
    float* part = (float*)(p.ws + WS_MODP);
    for (int it = bid; it < 768; it += nb) {
        const int kc = it / 48, rem = it - kc * 48, l = rem / 12, nch = rem - l * 12;
        const int n = nch * 512 + tid;
        const float* w = p.in[4] + ((size_t)l * 1024 + kc * 64) * 6144 + n;
        float acc[9];
#pragma unroll
        for (int r = 0; r < 9; ++r) acc[r] = 0.f;
#pragma unroll 8
        for (int k = 0; k < 64; ++k) {
            const float wv = __builtin_nontemporal_load(w + (size_t)k * 6144);
#pragma unroll
            for (int r = 0; r < 9; ++r) acc[r] += sc[r * 1024 + kc * 64 + k] * wv;
        }
#pragma unroll
        for (int r = 0; r < 9; ++r) part[(((size_t)kc * 4 + l) * 9 + r) * 6144 + n] = acc[r];
    }
    __syncthreads();
}
DI void phase_mod_reduce(const Params& p, int bid, int nb, int tid) {
    const float* part = (const float*)(p.ws + WS_MODP);
    float* mod = (float*)(p.ws + WS_MOD);
    const int total = 4 * 9 * 6144;
    for (int i = bid * NTHREADS + tid; i < total; i += nb * NTHREADS) {
        const int l = i / (9 * 6144), n = i % 6144;
        float s = p.in[5][l * 6144 + n];
#pragma unroll
        for (int kc = 0; kc < 16; ++kc) s += part[(size_t)kc * total + i];
        mod[i] = s;
    }
}

template <int MODE>
DI void phase_rows(const Params& p, int layer  , int which  , int bid, int nb, int tid) {
    const int wid = __builtin_amdgcn_readfirstlane(tid >> 6), lane = tid & 63;
    const float* modall = (const float*)(p.ws + WS_MOD);
    const bf16_t* eo = (const bf16_t*)(p.ws + WS_RAW);
    bf16_t* H = (bf16_t*)(p.ws + WS_H);
    const int rpw = (MROWS + nb * NW - 1) / (nb * NW), rbeg = (bid * NW + wid) * rpw, rend = min(MROWS, rbeg + rpw);
    int mr_have = -1;
    f32x4 g2v[4], gmv[4], shv[4];
    for (int r = rbeg; r < rend; ++r) {
        const int b = r / PP, pos = r - b * PP;
        if ((MODE & 16) && pos >= SEQ) continue;
        const int mr = pos < SEQ ? b : 8;
        if (mr != mr_have) {
            mr_have = mr;
            if (MODE & 1) { const float* g2 = modall + ((size_t)(layer - ((MODE & 2) ? 1 : 0)) * 9 + mr) * 6144 + 5120;
#pragma unroll
                for (int j = 0; j < 4; ++j) g2v[j] = *(const f32x4*)(g2 + lane * 4 + 256 * j) * (1.0f / 16.0f); }
            if (MODE & 2) { const float* ng = p.in[6] + ((size_t)layer * 2 + which) * 1024; const float* md = modall + ((size_t)layer * 9 + mr) * 6144 + which * 3072;
#pragma unroll
                for (int j = 0; j < 4; ++j) { const f32x4 g = *(const f32x4*)(ng + lane * 4 + 256 * j), sc = *(const f32x4*)(md + 1024 + lane * 4 + 256 * j);
                    shv[j] = *(const f32x4*)(md + lane * 4 + 256 * j); gmv[j] = (f32x4){g.x * (1.0f + sc.x), g.y * (1.0f + sc.y), g.z * (1.0f + sc.z), g.w * (1.0f + sc.w)}; } }
        }
        bf16_t* xb = xb_row(p, r);
        float x[16];
        if (MODE & 8) {
            const float* xr = pos < SEQ ? p.in[0] + ((size_t)b * SEQ + pos) * DM : p.in[2] + ((size_t)b * CTXL + (pos - SEQ)) * DM;
#pragma unroll
            for (int j = 0; j < 4; ++j) { const f32x4 v = *(const f32x4*)(xr + lane * 4 + 256 * j); x[4 * j] = v.x; x[4 * j + 1] = v.y; x[4 * j + 2] = v.z; x[4 * j + 3] = v.w; }
        } else {
#pragma unroll
            for (int j = 0; j < 4; ++j) { const u32x2 v = *(const u32x2*)(xb + lane * 4 + 256 * j); x[4 * j] = bflo(v.x); x[4 * j + 1] = bfhi(v.x); x[4 * j + 2] = bflo(v.y); x[4 * j + 3] = bfhi(v.y); }
        }
        if (MODE & 1) {
            const unsigned char* y0 = (const unsigned char*)eo + (size_t)(2 * r) * 1024, *y1 = y0 + 1024;
#pragma unroll
            for (int j = 0; j < 4; ++j) {
                const unsigned a = *(const unsigned*)(y0 + lane * 4 + 256 * j), bb = *(const unsigned*)(y1 + lane * 4 + 256 * j);
                const f32x4 g = g2v[j];
                const f32x2_8 a01 = __builtin_amdgcn_cvt_pk_f32_fp8((int)a, false), a23 = __builtin_amdgcn_cvt_pk_f32_fp8((int)a, true);
                const f32x2_8 b01 = __builtin_amdgcn_cvt_pk_f32_fp8((int)bb, false), b23 = __builtin_amdgcn_cvt_pk_f32_fp8((int)bb, true);
                x[4 * j] += g.x * (a01[0] + b01[0]); x[4 * j + 1] += g.y * (a01[1] + b01[1]);
                x[4 * j + 2] += g.z * (a23[0] + b23[0]); x[4 * j + 3] += g.w * (a23[1] + b23[1]);
            }
        }
        if (MODE & 16) {
            float* orow = p.out + ((size_t)b * SEQ + pos) * DM;
#pragma unroll
            for (int j = 0; j < 4; ++j) *(f32x4*)(orow + lane * 4 + 256 * j) = (f32x4){x[4 * j], x[4 * j + 1], x[4 * j + 2], x[4 * j + 3]};
        } else if (MODE & (1 | 8)) {
#pragma unroll
            for (int j = 0; j < 4; ++j) {
                u32x2 w; w.x = pk2(x[4 * j], x[4 * j + 1]); w.y = pk2(x[4 * j + 2], x[4 * j + 3]);
                *(u32x2*)(xb + lane * 4 + 256 * j) = w;
                x[4 * j] = bflo(w.x); x[4 * j + 1] = bfhi(w.x); x[4 * j + 2] = bflo(w.y); x[4 * j + 3] = bfhi(w.y);
            }
        }
        if (MODE & 2) {
            float ss = 0.f;
#pragma unroll
            for (int i = 0; i < 16; ++i) ss += x[i] * x[i];
            ss = wave_sum(ss);
            const float rs = rsqrtf(ss * (1.0f / 1024.0f) + EPS);
#pragma unroll
            for (int j = 0; j < 4; ++j) {
                const f32x4 g = gmv[j], sh = shv[j];
                const float h0 = x[4 * j] * rs * g.x + sh.x, h1 = x[4 * j + 1] * rs * g.y + sh.y;
                const float h2 = x[4 * j + 2] * rs * g.z + sh.z, h3 = x[4 * j + 3] * rs * g.w + sh.w;
                if (MODE & 32) *(unsigned*)((unsigned char*)H + (size_t)r * 1024 + lane * 4 + 256 * j) = cvt_fp8x4(h0, h1, h2, h3);
                else { u32x2 w; w.x = pk2(h0, h1); w.y = pk2(h2, h3); *(u32x2*)(H + (size_t)r * 1024 + lane * 4 + 256 * j) = w; }
            }
        }
    }
}

constexpr size_t WS_RC = WS_MOD + 917504;
DI void phase_router_prep(const Params& p, int bid, int nb, int tid) {
    const float* modall = (const float*)(p.ws + WS_MOD);
    bf16_t* wth = (bf16_t*)(p.ws + WS_RW); bf16_t* wtl = wth + 4 * 9 * 48 * 1024;
    const int total = 4 * 9 * 48 * 1024;
    for (int i = bid * NTHREADS + tid; i < total; i += nb * NTHREADS) {
        const int k = i & 1023, c = (i >> 10) % 48, lb = i / (48 * 1024), l = lb / 9, b = lb - l * 9;
        float v = 0.f;
        if (c < 36) {
            const float w = c < 32 ? p.in[9][((size_t)l * 1024 + k) * 32 + c] : p.in[7][((size_t)l * 1024 + k) * 4 + (c - 32)];
            v = p.in[6][((size_t)l * 2 + 1) * 1024 + k] * (1.0f + modall[((size_t)l * 9 + b) * 6144 + 4096 + k]) * w;
        }
        const unsigned hb = f2bf(v); wth[i] = (bf16_t)hb; wtl[i] = (bf16_t)f2bf(v - bf2f(hb));
    }
    float* cst = (float*)(p.ws + WS_RC);
    const int wid = __builtin_amdgcn_readfirstlane(tid >> 6), lane = tid & 63;
    for (int j = bid * NW + wid; j < 4 * 9 * 48; j += nb * NW) {
        const int c = j % 48, lb = j / 48, l = lb / 9, b = lb - l * 9;
        float acc = 0.f;
        if (c < 36) {
            for (int k = lane; k < 1024; k += 64) {
                const float w = c < 32 ? p.in[9][((size_t)l * 1024 + k) * 32 + c] : p.in[7][((size_t)l * 1024 + k) * 4 + (c - 32)];
                acc += modall[((size_t)l * 9 + b) * 6144 + 3072 + k] * w;
            }
            acc = wave_sum(acc) + (c < 32 ? p.in[10][l * 32 + c] : p.in[8][l * 4 + (c - 32)]);
        }
        if (lane == 0) cst[j] = acc;
    }
}
typedef float f32x2_3 __attribute__((ext_vector_type(2)));
typedef __bf16 bf16x2_3 __attribute__((ext_vector_type(2)));
DI unsigned cvtpk3(float lo, float hi) { f32x2_3 v = {lo, hi}; bf16x2_3 b = __builtin_convertvector(v, bf16x2_3); return __builtin_bit_cast(unsigned, b); }
DI void phase_router(const Params& p, unsigned char* smem, int layer, bool skip_ctx, int bid, int nb, int tid) {
    const int lane = tid & 63, wid = __builtin_amdgcn_readfirstlane(tid >> 6), li = lane & 15, kq = lane >> 4;
    LAS float* tile = (LAS float*)smem + wid * (32 * 49);
    const bf16_t* wth_all = (const bf16_t*)(p.ws + WS_RW) + (size_t)layer * 9 * 48 * 1024;
    const bf16_t* wtl_all = wth_all + 4 * 9 * 48 * 1024;
    const float* cst_all = (const float*)(p.ws + WS_RC) + layer * 9 * 48;
    unsigned* cnt = (unsigned*)(p.ws + WS_CTL) + CW_CNT + layer * 32;
    unsigned* list = (unsigned*)(p.ws + WS_LIST);
    float* gates = (float*)(p.ws + WS_GATE);
    if (layer > 0) {
        int base = 0;
        conv_job<false, true>(p.in[11] + (size_t)layer * 32 * 1024 * 512, 32, 1024, 512, 512, (bf16_t*)(p.ws + W_GU + (size_t)layer * 32 * 512 * 1024), 1, base, (float*)smem, bid, nb, tid);
        conv_job<false>(p.in[12] + (size_t)layer * 32 * 256 * 1024, 32, 256, 1024, 1024, (bf16_t*)(p.ws + W_DN) + (size_t)layer * 32 * 1024 * 256, 0, base, (float*)smem, bid, nb, tid);
    }
    for (int u = bid * NW + wid; u < MROWS / 32; u += nb * NW) {
        const int r0 = u * 32, b = r0 / PP, pos = r0 - b * PP;
        const bool isctx = pos >= SEQ;
        if (skip_ctx && isctx) continue;
        const int mr = isctx ? 8 : b;
        const bf16_t* xr = xb_row(p, r0 + li) + 8 * kq;
        const bf16_t* wh = wth_all + ((size_t)mr * 48 + li) * 1024 + 8 * kq;
        const bf16_t* wl = wtl_all + ((size_t)mr * 48 + li) * 1024 + 8 * kq;
        f32x4 acc[2][3];
#pragma unroll
        for (int m = 0; m < 2; ++m)
#pragma unroll
            for (int n = 0; n < 3; ++n) acc[m][n] = (f32x4){0.f, 0.f, 0.f, 0.f};
        float ss[2] = {0.f, 0.f};
#pragma unroll 2
        for (int s = 0; s < 32; ++s) {
            bf16x8 xa[2], bh[3], bl[3];
#pragma unroll
            for (int m = 0; m < 2; ++m) xa[m] = *(const bf16x8*)(xr + (size_t)m * 16 * DM + 32 * s);
#pragma unroll
            for (int n = 0; n < 3; ++n) { bh[n] = *(const bf16x8*)(wh + (size_t)n * 16 * 1024 + 32 * s); bl[n] = *(const bf16x8*)(wl + (size_t)n * 16 * 1024 + 32 * s); }
#pragma unroll
            for (int m = 0; m < 2; ++m) {
                const u32x4 w = __builtin_bit_cast(u32x4, xa[m]);
                ss[m] += bflo(w.x) * bflo(w.x) + bfhi(w.x) * bfhi(w.x) + bflo(w.y) * bflo(w.y) + bfhi(w.y) * bfhi(w.y) + bflo(w.z) * bflo(w.z) + bfhi(w.z) * bfhi(w.z) + bflo(w.w) * bflo(w.w) + bfhi(w.w) * bfhi(w.w);
#pragma unroll
                for (int n = 0; n < 3; ++n) {
                    acc[m][n] = __builtin_amdgcn_mfma_f32_16x16x32_bf16(xa[m], bl[n], acc[m][n], 0, 0, 0);
                    acc[m][n] = __builtin_amdgcn_mfma_f32_16x16x32_bf16(xa[m], bh[n], acc[m][n], 0, 0, 0);
                }
            }
        }
#pragma unroll
        for (int m = 0; m < 2; ++m) { ss[m] += __shfl_xor(ss[m], 16); ss[m] += __shfl_xor(ss[m], 32); }
#pragma unroll
        for (int m = 0; m < 2; ++m)
#pragma unroll
            for (int n = 0; n < 3; ++n)
#pragma unroll
                for (int i = 0; i < 4; ++i) tile[(16 * m + 4 * kq + i) * 49 + n * 16 + li] = acc[m][n][i];
        __builtin_amdgcn_s_waitcnt(0xc07f);
        const float ssr = (lane & 16) ? ss[1] : ss[0];
        const float rs = rsqrtf(ssr * (1.0f / 1024.0f) + EPS);
        if (lane < 32) {
            const float* cst = cst_all + mr * 48;
            const LAS float* tr = tile + lane * 49;
            float lg[4];
#pragma unroll
            for (int c = 0; c < 4; ++c) lg[c] = tr[32 + c] * rs + cst[32 + c];
            int gi = 0; float gm = lg[0];
#pragma unroll
            for (int c = 1; c < 4; ++c) if (lg[c] > gm) { gm = lg[c]; gi = c; }
            float gden = 0.f;
#pragma unroll
            for (int c = 0; c < 4; ++c) gden += __expf(lg[c] - gm);
            const float gw = 1.0f / gden;
            float le[8];
#pragma unroll
            for (int c = 0; c < 8; ++c) le[c] = tr[gi * 8 + c] * rs + cst[gi * 8 + c];
            int e0 = 0; float m0 = le[0];
#pragma unroll
            for (int c = 1; c < 8; ++c) if (le[c] > m0) { m0 = le[c]; e0 = c; }
            int e1 = -1; float m1 = -INFINITY;
#pragma unroll
            for (int c = 0; c < 8; ++c) if (c != e0 && le[c] > m1) { m1 = le[c]; e1 = c; }
            const float q1 = __expf(m1 - m0), inv = 1.0f / (1.0f + q1);
            const int r = r0 + lane, ex0 = gi * 8 + e0, ex1 = gi * 8 + e1;
            const unsigned s0 = atomicAdd(cnt + ex0, 1u), s1 = atomicAdd(cnt + ex1, 1u);
            list[(size_t)ex0 * MROWS + s0] = 2u * r; list[(size_t)ex1 * MROWS + s1] = 2u * r + 1u;
            gates[2 * r] = gw * inv; gates[2 * r + 1] = gw * q1 * inv;
        }
        {
            const float* ng = p.in[6] + ((size_t)layer * 2 + 1) * 1024;
            const float* md = (const float*)(p.ws + WS_MOD) + ((size_t)layer * 9 + mr) * 6144 + 3072;
            f32x4 gm[4], sh[4];
#pragma unroll
            for (int j = 0; j < 4; ++j) {
                const f32x4 g = *(const f32x4*)(ng + lane * 4 + 256 * j), sc = *(const f32x4*)(md + 1024 + lane * 4 + 256 * j);
                sh[j] = *(const f32x4*)(md + lane * 4 + 256 * j);
                gm[j] = (f32x4){g.x * (1.0f + sc.x), g.y * (1.0f + sc.y), g.z * (1.0f + sc.z), g.w * (1.0f + sc.w)};
            }
            unsigned char* H8 = p.ws + WS_H;
#pragma unroll 4
            for (int i = 0; i < 32; ++i) {
                const float rsi = __shfl(rs, i);
                const bf16_t* xb = xb_row(p, r0 + i);
#pragma unroll
                for (int j = 0; j < 4; ++j) {
                    const u32x2 v = *(const u32x2*)(xb + lane * 4 + 256 * j);
                    *(unsigned*)(H8 + (size_t)(r0 + i) * 1024 + lane * 4 + 256 * j) =
                        cvt_fp8x4(bflo(v.x) * rsi * gm[j].x + sh[j].x, bfhi(v.x) * rsi * gm[j].y + sh[j].y, bflo(v.y) * rsi * gm[j].z + sh[j].z, bfhi(v.y) * rsi * gm[j].w + sh[j].w);
                }
            }
        }
    }
}

#define MFMA32(a, b, c) __builtin_amdgcn_mfma_f32_32x32x16_bf16((a), (b), (c), 0, 0, 0)
typedef LAS unsigned char* lds_ptr;
constexpr int GEMM_TM = 256, GEMM_TN = 256;
constexpr int GEMM_STAGE = 65536;
constexpr int GEMM_LDS = 2 * GEMM_STAGE;
constexpr int GEMM_MT = 4;

struct RowDense { static constexpr bool DENSE = true; const bf16_t* A; int lda; int m0; DI unsigned row(int i) const { return (unsigned)(m0 + i) * (unsigned)lda; } };
struct RowGather { static constexpr bool DENSE = false; const bf16_t* A; int lda; const unsigned* ent; int valid; int shift;
    DI unsigned row(int i) const { const unsigned e = ent[i < valid ? i : valid - 1]; return (e >> shift) * (unsigned)lda; } };

struct EpiStore { bf16_t* C; int ldc; int m0;
    DI void wave_tile(const f32x16 (&acc)[2][GEMM_MT], int mloc, int ncol, int lane) const {
        const int r = lane & 31, h = lane >> 5;
#pragma unroll
        for (int mt = 0; mt < GEMM_MT; ++mt) {
            bf16_t* c = C + (size_t)(m0 + mloc + mt * 32 + r) * ldc + ncol + 4 * h;
#pragma unroll
            for (int nt = 0; nt < 2; ++nt)
#pragma unroll
                for (int g = 0; g < 4; ++g) {
                    u32x2 w; w.x = pk2(acc[nt][mt][4 * g], acc[nt][mt][4 * g + 1]); w.y = pk2(acc[nt][mt][4 * g + 2], acc[nt][mt][4 * g + 3]);
                    *(u32x2*)(c + nt * 32 + 8 * g) = w;
                }
        }
    } };
struct EpiResid { const Params* p; const float* mod; int m0;
    DI void wave_tile(const f32x16 (&acc)[2][GEMM_MT], int mloc, int ncol, int lane) const {
        const int r = lane & 31, h = lane >> 5;
#pragma unroll
        for (int mt = 0; mt < GEMM_MT; ++mt) {
            const int row = m0 + mloc + mt * 32 + r;
            float* xr = xrow_ptr(*p, row) + ncol + 4 * h;
            const float* gp = mod + (size_t)mod_row(row) * 6144 + 2048 + ncol + 4 * h;
#pragma unroll
            for (int nt = 0; nt < 2; ++nt)
#pragma unroll
                for (int g = 0; g < 4; ++g) {
                    f32x4 x = *(f32x4*)(xr + nt * 32 + 8 * g);
                    const f32x4 gg = *(const f32x4*)(gp + nt * 32 + 8 * g);
                    x.x += gg.x * acc[nt][mt][4 * g]; x.y += gg.y * acc[nt][mt][4 * g + 1]; x.z += gg.z * acc[nt][mt][4 * g + 2]; x.w += gg.w * acc[nt][mt][4 * g + 3];
                    *(f32x4*)(xr + nt * 32 + 8 * g) = x;
                }
        }
    } };
struct EpiGlu { bf16_t* act; const unsigned* ent; const float* gates; int valid;
    DI void wave_tile(const f32x16 (&acc)[2][GEMM_MT], int mloc, int ncol, int lane) const {
        const int r = lane & 31, h = lane >> 5;
#pragma unroll
        for (int mt = 0; mt < GEMM_MT; ++mt) {
            const int i = mloc + mt * 32 + r;
            if (i < valid) {
                const unsigned a = ent[i];
                const float gw = gates[a];
                bf16_t* o = act + (size_t)a * DEXP + (ncol >> 6) * 32 + 4 * h;
#pragma unroll
                for (int g = 0; g < 4; ++g) {
                    float v[4];
#pragma unroll
                    for (int j = 0; j < 4; ++j) v[j] = silu_f(acc[0][mt][4 * g + j]) * acc[1][mt][4 * g + j] * gw;
                    u32x2 w; w.x = pk2(v[0], v[1]); w.y = pk2(v[2], v[3]);
                    *(u32x2*)(o + 8 * g) = w;
                }
            }
        }
    } };
struct EpiScatter { bf16_t* outp; const unsigned* ent; int valid;
    DI void wave_tile(const f32x16 (&acc)[2][GEMM_MT], int mloc, int ncol, int lane) const {
        const int r = lane & 31, h = lane >> 5;
#pragma unroll
        for (int mt = 0; mt < GEMM_MT; ++mt) {
            const int i = mloc + mt * 32 + r;
            if (i < valid) {
                bf16_t* c = outp + (size_t)ent[i] * 1024 + ncol + 4 * h;
#pragma unroll
                for (int nt = 0; nt < 2; ++nt)
#pragma unroll
                    for (int g = 0; g < 4; ++g) {
                        u32x2 w; w.x = pk2(acc[nt][mt][4 * g], acc[nt][mt][4 * g + 1]); w.y = pk2(acc[nt][mt][4 * g + 2], acc[nt][mt][4 * g + 3]);
                        *(u32x2*)(c + nt * 32 + 8 * g) = w;
                    }
            }
        }
    } };

#define SCHED_FENCE() __builtin_amdgcn_sched_barrier(0)
DI void glds16(const bf16_t* g, lds_ptr l) { __builtin_amdgcn_global_load_lds((const unsigned*)g, (LAS unsigned*)l, 16, 0, 0); }
template <int PROBE, int NAG>
DI void gemm_kstep(f32x16 (&acc)[2][GEMM_MT], const lds_ptr st, const unsigned (&arow)[GEMM_MT], const unsigned (&wrow)[2], const unsigned (&aswz)[GEMM_MT], const unsigned (&wswz)[2], int h,
                   bool issue, const bf16_t* __restrict__ An, const bf16_t* __restrict__ Wn, const unsigned (&ag)[NAG], unsigned astep, const unsigned (&bg)[2], unsigned bstep, const lds_ptr sn) {
    if (PROBE != 2 && issue) {
#pragma unroll
        for (int j = 0; j < 8; ++j) { glds16(An + (NAG == 2 ? ag[j & 1] + (j >> 1) * astep : ag[j % NAG]), sn + j * 1024); glds16(Wn + bg[j & 1] + (j >> 1) * bstep, sn + 32768 + j * 1024); }
    }
    if (PROBE == 1) return;
    bf16x8 af[2][GEMM_MT], wf[2][2];
#pragma unroll
    for (int t = 0; t < 2; ++t) wf[0][t] = *(const LAS bf16x8*)(st + wrow[t] + ((((unsigned)h) ^ wswz[t]) << 4));
#pragma unroll
    for (int t = 0; t < GEMM_MT; ++t) af[0][t] = *(const LAS bf16x8*)(st + arow[t] + ((((unsigned)h) ^ aswz[t]) << 4));
#pragma unroll
    for (int kk = 0; kk < 4; ++kk) {
        if (kk < 3) {
#pragma unroll
            for (int t = 0; t < 2; ++t) wf[(kk + 1) & 1][t] = *(const LAS bf16x8*)(st + wrow[t] + ((((unsigned)((kk + 1) * 2 + h)) ^ wswz[t]) << 4));
#pragma unroll
            for (int t = 0; t < GEMM_MT; ++t) af[(kk + 1) & 1][t] = *(const LAS bf16x8*)(st + arow[t] + ((((unsigned)((kk + 1) * 2 + h)) ^ aswz[t]) << 4));
        }
        SCHED_FENCE();
        __builtin_amdgcn_s_setprio(1);
#pragma unroll
        for (int mt = 0; mt < GEMM_MT; ++mt)
#pragma unroll
            for (int nt = 0; nt < 2; ++nt) acc[nt][mt] = MFMA32(wf[kk & 1][nt], af[kk & 1][mt], acc[nt][mt]);
        __builtin_amdgcn_s_setprio(0);
        SCHED_FENCE();
    }
}
template <class RowSrc, class Epi, int PROBE = 0>
DI void gemm_tile_mfma(unsigned char* smem, const RowSrc& rs, const bf16_t* __restrict__ Wt, int K, int n0, const Epi& epi, int tid) {
    const lds_ptr lds = (lds_ptr)smem;
    const int lane = tid & 63, wid = __builtin_amdgcn_readfirstlane(tid >> 6), wm = wid & 1, wn = wid >> 1, r = lane & 31, h = lane >> 5;
    const bool loader = wid < 4;
    const int lw = wid & 3;
    constexpr int NAG = RowSrc::DENSE ? 2 : 8;
    unsigned ag[NAG], bg[2];
    const bf16_t* __restrict__ Ab = rs.A;
#pragma unroll
    for (int j = 0; j < NAG; ++j) {
        const int row = (lw * 8 + j) * 8 + (lane >> 3), c = (lane & 7) ^ ((row >> 1) & 7);
        ag[j] = rs.row(row) + c * 8;
    }
#pragma unroll
    for (int j = 0; j < 2; ++j) {
        const int row = (lw * 8 + j) * 8 + (lane >> 3), c = (lane & 7) ^ ((row >> 1) & 7);
        bg[j] = (unsigned)(n0 + row) * (unsigned)K + c * 8;
    }
    const unsigned astep = 16u * (unsigned)rs.lda, bstep = 16u * (unsigned)K;
    const unsigned dmaoff = (unsigned)lw * 8192u;
    unsigned arow[GEMM_MT], wrow[2], aswz[GEMM_MT], wswz[2];
#pragma unroll
    for (int t = 0; t < GEMM_MT; ++t) { const int ra = wm * 128 + t * 32 + r; arow[t] = ra * 128; aswz[t] = (ra >> 1) & 7; }
#pragma unroll
    for (int t = 0; t < 2; ++t) { const int rw = wn * 64 + t * 32 + r; wrow[t] = 32768 + rw * 128; wswz[t] = (rw >> 1) & 7; }
    f32x16 acc[2][GEMM_MT];
#pragma unroll
    for (int a = 0; a < 2; ++a)
#pragma unroll
        for (int b = 0; b < GEMM_MT; ++b)
#pragma unroll
            for (int i = 0; i < 16; ++i) acc[a][b][i] = 0.f;
    if (loader) {
#pragma unroll
        for (int j = 0; j < 8; ++j) { glds16(Ab + (NAG == 2 ? ag[j & 1] + (j >> 1) * astep : ag[j % NAG]), lds + dmaoff + j * 1024); glds16(Wt + bg[j & 1] + (j >> 1) * bstep, lds + 32768 + dmaoff + j * 1024); }
    }
    asm volatile("s_waitcnt vmcnt(0)" ::: "memory");
    __syncthreads();
    const int KT = K >> 6;
    for (int kt = 0; kt < KT; ++kt) {
        gemm_kstep<PROBE, NAG>(acc, lds + (kt & 1) * GEMM_STAGE, arow, wrow, aswz, wswz, h, loader && kt + 1 < KT, Ab + (kt + 1) * 64, Wt + (kt + 1) * 64, ag, astep, bg, bstep, lds + ((kt + 1) & 1) * GEMM_STAGE + dmaoff);
        asm volatile("s_waitcnt vmcnt(0)" ::: "memory");
        __syncthreads();
    }
    if (PROBE == 0 || acc[0][0][0] == 12345.678f) epi.wave_tile(acc, wm * 128, n0 + wn * 64, lane);
}

template <int EPIK, int PROBE = 0>
DI void gemm_dense(const Params& p, unsigned char* smem, const bf16_t* A, int lda, const bf16_t* Wt, int K, int N, bf16_t* C, int ldc, const float* mod, int bid, int nb, int tid) {
    const int tn = N / GEMM_TN, total = (MROWS / GEMM_TM) * tn;
    for (int t = bid; t < total; t += nb) {
        const int mt = t / tn, nt = t - mt * tn;
        RowDense rs{A, lda, mt * GEMM_TM};
        if (EPIK == 0) { EpiStore e{C, ldc, mt * GEMM_TM}; gemm_tile_mfma<RowDense, EpiStore, PROBE>(smem, rs, Wt, K, nt * GEMM_TN, e, tid); }
        else { EpiResid e{&p, mod, mt * GEMM_TM}; gemm_tile_mfma(smem, rs, Wt, K, nt * GEMM_TN, e, tid); }
    }
}
template <int WHICH>
DI void gemm_moe(const Params& p, unsigned char* smem, int layer, int bid, int nb, int tid) {
    const unsigned* cnt = (const unsigned*)(p.ws + WS_CTL) + CW_CNT + layer * 32;
    const unsigned* list = (const unsigned*)(p.ws + WS_LIST);
    const float* gates = (const float*)(p.ws + WS_GATE);
    const bf16_t* H = (const bf16_t*)(p.ws + WS_H);
    bf16_t* act = (bf16_t*)(p.ws + WS_Q);
    bf16_t* eo = (bf16_t*)(p.ws + WS_RAW);
    constexpr int TN = WHICH == 0 ? 2 : 4;
    int total = 0;
    for (int e = 0; e < NEXP; ++e) total += (int)((cnt[e] + 255u) >> 8) * TN;
    for (int t = bid; t < total; t += nb) {
        int e = 0, rem = t;
        for (; e < NEXP; ++e) { const int te = (int)((cnt[e] + 255u) >> 8) * TN; if (rem < te) break; rem -= te; }
        const int rt = rem / TN, ct = rem - rt * TN;
        const unsigned* ent = list + (size_t)e * MROWS + rt * GEMM_TM;
        const int valid = min(GEMM_TM, (int)cnt[e] - rt * GEMM_TM);
        if (WHICH == 0) {
            RowGather rs{H, 1024, ent, valid, 1};
            EpiGlu ep{act, ent, gates, valid};
            gemm_tile_mfma(smem, rs, (const bf16_t*)(p.ws + W_GU) + ((size_t)layer * 32 + e) * 512 * 1024, 1024, ct * GEMM_TN, ep, tid);
        } else {
            RowGather rs{act, DEXP, ent, valid, 0};
            EpiScatter ep{eo, ent, valid};
            gemm_tile_mfma(smem, rs, (const bf16_t*)(p.ws + W_DN) + ((size_t)layer * 32 + e) * 1024 * 256, 256, ct * GEMM_TN, ep, tid);
        }
    }
}

DI float quad_sum(float v) { v += __shfl_xor(v, 1); v += __shfl_xor(v, 2); return v; }
DI void head64_norm_rope(const bf16_t* src, bf16_t* dst, const float* gain, int sub, bool rope, int prow, int pcol, float scale) {
    float a[8], b[8];
    unpack8(*(const u32x4*)(src + sub * 8), a); unpack8(*(const u32x4*)(src + 32 + sub * 8), b);
    float ss = 0.f;
#pragma unroll
    for (int e = 0; e < 8; ++e) ss += a[e] * a[e] + b[e] * b[e];
    ss = quad_sum(ss);
    const float rs = rsqrtf(ss * (1.0f / 64.0f) + EPS);
#pragma unroll
    for (int e = 0; e < 8; ++e) { a[e] *= rs * gain[sub * 8 + e]; b[e] *= rs * gain[32 + sub * 8 + e]; }
    if (rope) {
#pragma unroll
        for (int e = 0; e < 8; ++e) {
            const int i = sub * 8 + e;
            const float* cs = ROPE64 + ((i < 16 ? prow : pcol) * 16 + (i & 15)) * 2;
            const float c = cs[0], s = cs[1], x1 = a[e], x2 = b[e];
            a[e] = x1 * c - x2 * s; b[e] = x2 * c + x1 * s;
        }
    }
#pragma unroll
    for (int e = 0; e < 8; ++e) { a[e] *= scale; b[e] *= scale; }
    *(u32x4*)(dst + sub * 8) = pack8(a); *(u32x4*)(dst + 32 + sub * 8) = pack8(b);
}
template <int KIND>
DI void phase_post_qk(const Params& p, int bid, int nb, int tid) {
    const int wid = __builtin_amdgcn_readfirstlane(tid >> 6), lane = tid & 63, hd = lane >> 2, sub = lane & 3;
    constexpr int NRAW = KIND == 1 ? 1536 : 3072, KH = KIND == 1 ? 4 : 16;
    const bf16_t* raw = (const bf16_t*)(p.ws + WS_RAW);
    bf16_t* Q = (bf16_t*)(p.ws + WS_Q); bf16_t* Kb = (bf16_t*)(p.ws + WS_K);
    const float* qn = p.in[KIND == 0 ? 15 : KIND == 1 ? 20 : 32];
    const float* kn = p.in[KIND == 0 ? 16 : KIND == 1 ? 21 : 33];
    const float qscale = 0.125f * LOG2E;
    for (int r = bid * NW + wid; r < MROWS; r += nb * NW) {
        const int b = r / PP, pos = r - b * PP;
        const bool rope = (KIND != 0) && pos < SEQ;
        const int prow = (pos >> 6) & 63, pcol = pos & 63;
        const bf16_t* rr = raw + (size_t)r * NRAW;
        head64_norm_rope(rr + hd * 64, Q + (size_t)r * 1024 + hd * 64, qn, sub, rope, prow, pcol, qscale);
        if (hd < KH) head64_norm_rope(rr + 1024 + hd * 64, Kb + (size_t)r * (KH * 64) + hd * 64, kn, sub, rope, prow, pcol, 1.0f);
    }
}
DI void phase_post_mla1(const Params& p, int bid, int nb, int tid) {
    const int wid = __builtin_amdgcn_readfirstlane(tid >> 6), lane = tid & 63;
    const bf16_t* raw = (const bf16_t*)(p.ws + WS_Q);
    bf16_t* cqn = (bf16_t*)(p.ws + WS_O);
    bf16_t* ckvn = cqn + (size_t)MROWS * 384;
    bf16_t* krope = ckvn + (size_t)MROWS * 256;
    const float* qa = p.in[24]; const float* kva = p.in[25]; const float* kn = p.in[29];
    for (int r = bid * NW + wid; r < MROWS; r += nb * NW) {
        const int b = r / PP, pos = r - b * PP;
        const bf16_t* rr = raw + (size_t)r * 768;
        {
            float v[8];
#pragma unroll
            for (int j = 0; j < 8; ++j) v[j] = 0.f;
            if (lane < 48) unpack8(*(const u32x4*)(rr + lane * 8), v);
            float ss = 0.f;
#pragma unroll
            for (int j = 0; j < 8; ++j) ss += v[j] * v[j];
            ss = wave_sum(ss);
            const float rs = rsqrtf(ss * (1.0f / 384.0f) + EPS);
            if (lane < 48) {
#pragma unroll
                for (int j = 0; j < 8; ++j) v[j] *= rs * qa[lane * 8 + j];
            }
            u32x2 o; o.x = cvt_fp8x4(v[0], v[1], v[2], v[3]); o.y = cvt_fp8x4(v[4], v[5], v[6], v[7]);
            *(u32x2*)((unsigned char*)cqn + (size_t)r * 512 + lane * 8) = o;
        }
        {
            const u32x2 w = *(const u32x2*)(rr + 384 + lane * 4);
            float v[4] = {bflo(w.x), bfhi(w.x), bflo(w.y), bfhi(w.y)};
            float ss = v[0] * v[0] + v[1] * v[1] + v[2] * v[2] + v[3] * v[3];
            ss = wave_sum(ss);
            const float rs = rsqrtf(ss * (1.0f / 256.0f) + EPS);
            *(unsigned*)((unsigned char*)cqn + (size_t)MROWS * 512 + (size_t)r * 256 + lane * 4) = cvt_fp8x4(v[0] * rs * kva[lane * 4], v[1] * rs * kva[lane * 4 + 1], v[2] * rs * kva[lane * 4 + 2], v[3] * rs * kva[lane * 4 + 3]);
        }
        {
            float x1 = 0.f, x2 = 0.f;
            if (lane < 16) { x1 = bf2f(rr[640 + lane]); x2 = bf2f(rr[640 + 16 + lane]); }
            float ss = wave_sum(x1 * x1 + x2 * x2);
            const float rs = rsqrtf(ss * (1.0f / 32.0f) + EPS);
            if (lane < 16) {
                x1 *= rs * kn[64 + lane]; x2 *= rs * kn[64 + 16 + lane];
                if (pos < SEQ) {
                    const int prow = (pos >> 6) & 63, pcol = pos & 63;
                    const float* cs = ROPE32 + ((lane < 8 ? prow : pcol) * 8 + (lane & 7)) * 2;
                    const float c = cs[0], s = cs[1], a = x1, bb = x2;
                    x1 = a * c - bb * s; x2 = bb * c + a * s;
                }
            }
            {
                const int hh = lane >> 2, q = lane & 3;
                float vals[8];
#pragma unroll
                for (int j = 0; j < 8; ++j) { const int src = (8 * q + j) & 15; const float a = __shfl(x1, src), bb = __shfl(x2, src); vals[j] = q < 2 ? a : bb; }
                bf16_t* kr = (bf16_t*)(p.ws + WS_K) + (size_t)r * 1536 + 64;
                *(u32x4*)(kr + hh * 96 + 8 * q) = pack8(vals);
            }
        }
    }
}
DI void phase_post_mla2(const Params& p, int bid, int nb, int tid) {
    const int wid = __builtin_amdgcn_readfirstlane(tid >> 6), lane = tid & 63, hd = lane >> 2, sub = lane & 3;
    const bf16_t* qraw = (const bf16_t*)(p.ws + WS_RAW);
    const bf16_t* kvraw = qraw + (size_t)MROWS * 1536;
    const bf16_t* krope = (const bf16_t*)(p.ws + WS_O) + (size_t)MROWS * 640;
    bf16_t* Q = (bf16_t*)(p.ws + WS_Q); bf16_t* Kb = (bf16_t*)(p.ws + WS_K);
    const float* qn = p.in[28]; const float* kn = p.in[29];
    const float qscale = 0.10206207261596577f * LOG2E;
    for (int r = bid * NW + wid; r < MROWS; r += nb * NW) {
        const int b = r / PP, pos = r - b * PP;
        const bf16_t* qr = qraw + (size_t)r * 1536 + hd * 96;
        bf16_t* qo = Q + (size_t)r * 1536 + hd * 96;
        {
            float a[8], c[8];
            unpack8(*(const u32x4*)(qr + sub * 16), a); unpack8(*(const u32x4*)(qr + sub * 16 + 8), c);
            float ss = 0.f;
#pragma unroll
            for (int e = 0; e < 8; ++e) ss += a[e] * a[e] + c[e] * c[e];
            ss = quad_sum(ss);
            const float rs = rsqrtf(ss * (1.0f / 64.0f) + EPS) * qscale;
#pragma unroll
            for (int e = 0; e < 8; ++e) { a[e] *= rs * qn[sub * 16 + e]; c[e] *= rs * qn[sub * 16 + 8 + e]; }
            *(u32x4*)(qo + sub * 16) = pack8(a); *(u32x4*)(qo + sub * 16 + 8) = pack8(c);
        }
        {
            const u32x2 w1 = *(const u32x2*)(qr + 64 + sub * 4), w2 = *(const u32x2*)(qr + 64 + 16 + sub * 4);
            float x1[4] = {bflo(w1.x), bfhi(w1.x), bflo(w1.y), bfhi(w1.y)}, x2[4] = {bflo(w2.x), bfhi(w2.x), bflo(w2.y), bfhi(w2.y)};
            float ss = 0.f;
#pragma unroll
            for (int e = 0; e < 4; ++e) ss += x1[e] * x1[e] + x2[e] * x2[e];
            ss = quad_sum(ss);
            const float rs = rsqrtf(ss * (1.0f / 32.0f) + EPS);
#pragma unroll
            for (int e = 0; e < 4; ++e) {
                const int i = sub * 4 + e;
                float a = x1[e] * rs * qn[64 + i], bb = x2[e] * rs * qn[64 + 16 + i];
                if (pos < SEQ) {
                    const int prow = (pos >> 6) & 63, pcol = pos & 63;
                    const float* cs = ROPE32 + ((i < 8 ? prow : pcol) * 8 + (i & 7)) * 2;
                    const float c = cs[0], s = cs[1], t1 = a, t2 = bb;
                    a = t1 * c - t2 * s; bb = t2 * c + t1 * s;
                }
                x1[e] = a * qscale; x2[e] = bb * qscale;
            }
            u32x2 o1, o2; o1.x = pk2(x1[0], x1[1]); o1.y = pk2(x1[2], x1[3]); o2.x = pk2(x2[0], x2[1]); o2.y = pk2(x2[2], x2[3]);
            *(u32x2*)(qo + 64 + sub * 4) = o1; *(u32x2*)(qo + 64 + 16 + sub * 4) = o2;
        }
        {
            const bf16_t* kr = kvraw + (size_t)r * 2048 + hd * 128;
            bf16_t* ko = Kb + (size_t)r * 1536 + hd * 96;
            float a[8], c[8];
            unpack8(*(const u32x4*)(kr + sub * 16), a); unpack8(*(const u32x4*)(kr + sub * 16 + 8), c);
            float ss = 0.f;
#pragma unroll
            for (int e = 0; e < 8; ++e) ss += a[e] * a[e] + c[e] * c[e];
            ss = quad_sum(ss);
            const float rs = rsqrtf(ss * (1.0f / 64.0f) + EPS);
#pragma unroll
            for (int e = 0; e < 8; ++e) { a[e] *= rs * kn[sub * 16 + e]; c[e] *= rs * kn[sub * 16 + 8 + e]; }
            *(u32x4*)(ko + sub * 16) = pack8(a); *(u32x4*)(ko + sub * 16 + 8) = pack8(c);
            *(u32x4*)(ko + 64 + sub * 8) = *(const u32x4*)(krope + (size_t)r * 32 + sub * 8);
        }
    }
}
DI void phase_diff_combine(const Params& p, int bid, int nb, int tid) {
    const int wid = __builtin_amdgcn_readfirstlane(tid >> 6), lane = tid & 63, hd = lane >> 3, sub = lane & 7;
    const bf16_t* O12 = (const bf16_t*)(p.ws + WS_H);
    bf16_t* Oc = (bf16_t*)(p.ws + WS_Q);
    const float* lam = p.in[34]; const float* subln = p.in[35];
    const float lambda_init = 0.8f - 0.6f * 0.40656965974059917f;
    const float s1 = wave_sum(lam[lane] * lam[64 + lane]), s2 = wave_sum(lam[128 + lane] * lam[192 + lane]);
    const float lam_full = expf(s1) - expf(s2) + lambda_init;
    for (int r = bid * NW + wid; r < MROWS; r += nb * NW) {
        const bf16_t* o1 = O12 + (size_t)r * 2048 + (2 * hd) * 128 + sub * 16, *o2 = o1 + 128;
        float a[16], c[16];
        unpack8(*(const u32x4*)o1, *(float(*)[8])a); unpack8(*(const u32x4*)(o1 + 8), *(float(*)[8])(a + 8));
        unpack8(*(const u32x4*)o2, *(float(*)[8])c); unpack8(*(const u32x4*)(o2 + 8), *(float(*)[8])(c + 8));
        float ss = 0.f;
#pragma unroll
        for (int e = 0; e < 16; ++e) { a[e] -= lam_full * c[e]; ss += a[e] * a[e]; }
        ss += __shfl_xor(ss, 1); ss += __shfl_xor(ss, 2); ss += __shfl_xor(ss, 4);
        const float rs = rsqrtf(ss * (1.0f / 128.0f) + EPS) * (1.0f - lambda_init);
#pragma unroll
        for (int e = 0; e < 16; ++e) a[e] *= rs * subln[sub * 16 + e];
        bf16_t* o = Oc + (size_t)r * 1024 + hd * 128 + sub * 16;
        *(u32x4*)o = pack8(*(float(*)[8])a); *(u32x4*)(o + 8) = pack8(*(float(*)[8])(a + 8));
    }
}


typedef short s16x4 __attribute__((ext_vector_type(4)));
typedef float f32x2_t __attribute__((ext_vector_type(2)));
typedef __bf16 bf16x2_t __attribute__((ext_vector_type(2)));
DI unsigned cvtpk(float lo, float hi) { f32x2_t v = {lo, hi}; bf16x2_t b = __builtin_convertvector(v, bf16x2_t); return __builtin_bit_cast(unsigned, b); }
DI float xhalf_max(float v) { auto rr = __builtin_amdgcn_permlane32_swap(__float_as_uint(v), __float_as_uint(v), false, false); return fmaxf(__uint_as_float(rr[0]), __uint_as_float(rr[1])); }
DI float xhalf_sum(float v) { auto rr = __builtin_amdgcn_permlane32_swap(__float_as_uint(v), __float_as_uint(v), false, false); return __uint_as_float(rr[0]) + __uint_as_float(rr[1]); }
typedef short v4i16_t __attribute__((__vector_size__(4 * sizeof(short))));
DI s16x4 lds_tr(lds_ptr p) { return __builtin_bit_cast(s16x4, __builtin_amdgcn_ds_read_tr16_b64_v4i16((LAS v4i16_t*)p)); }
constexpr float ATT_BIG = 40.0f, ATT_BIGF = 1.0995116e12f;
DI int crow(int i, int hf) { return (i & 3) + 8 * (i >> 2) + 4 * hf; }

struct AttnP { const bf16_t* Q; int ldq; const bf16_t* K; int ldk; const bf16_t* V; int ldv; bf16_t* O; int ldo; int HQ; int gk; int gv; int vhs  ; const float* bias; const float* sink; int need_ctx; const float* kgain  ; const float* lam; const float* subln; unsigned char* Oc; int ldoc;   };

template <int DQ, int DV, int MODE, int ABL = 0>
DI void attn_mfma(const AttnP& a, unsigned char* smem, int bid, int nb, int tid) {
    constexpr int KSTR = DQ * 2 + 16, KTB = 64 * KSTR, VTB = 64 * DV * 2, NDB = DV / 32, NKK = DQ / 16;
    constexpr int KCH = DQ / 8, VCH = DV / 8, NKI = (64 * KCH + NTHREADS - 1) / NTHREADS, NVI = (64 * VCH + NTHREADS - 1) / NTHREADS;
    static_assert(2 * KTB + 2 * VTB + 2048 <= GEMM_LDS, "attention LDS");
    const lds_ptr lds = (lds_ptr)smem;
    LAS float* biasl = (LAS float*)(lds + 2 * KTB + 2 * VTB);
    const int lane = tid & 63, wid = __builtin_amdgcn_readfirstlane(tid >> 6), r = lane & 31, hf = lane >> 5;
    const int nq = a.need_ctx ? 17 : 16;
    const int xcd = bid & 7, slot = bid >> 3, nslots = nb >> 3, per_xcd = (NBATCH * a.HQ / 8) * nq;
    int koff[NKI], kdst[NKI], voff[NVI], vdst[NVI];
#pragma unroll
    for (int i = 0; i < NKI; ++i) { const int c = min(tid + NTHREADS * i, 64 * KCH - 1), row = c / KCH, kc = c - row * KCH; koff[i] = row * a.ldk + kc * 8; kdst[i] = row * KSTR + kc * 16; }
#pragma unroll
    for (int i = 0; i < NVI; ++i) { const int c = tid + NTHREADS * i, row = c / VCH, vc = c - row * VCH; voff[i] = row * a.ldv + vc * 8; vdst[i] = ((row >> 3) * NDB + (vc >> 2)) * 512 + (row & 7) * 64 + (vc & 3) * 16; }
    const int i16 = lane & 15, trq = i16 >> 2, trp = i16 & 3, grp = (lane >> 4) & 1;
    const int vtr0 = (4 * hf + trq) * 64 + 32 * grp + 8 * trp;
    constexpr bool PAIRED = (MODE == 2 && DV == 128);
    float lam_full = 0.f;
    if (PAIRED) { const float s1 = wave_sum(a.lam[lane] * a.lam[64 + lane]), s2 = wave_sum(a.lam[128 + lane] * a.lam[192 + lane]); lam_full = expf(s1) - expf(s2) + (0.8f - 0.6f * 0.40656965974059917f); }
    int it_i = 0;
    for (int j = slot; j < per_xcd; j += nslots, ++it_i) {
        const int nbh = NBATCH * a.HQ / 8;
        const int bhl = j < nbh * 16 ? j >> 4 : j - nbh * 16;
        int qt = j < nbh * 16 ? j & 15 : 16;
        int bh = bhl * 8 + xcd;
        if (MODE == 1) { const int P = (bhl >> 2) * 8 + xcd; bh = (P >> 2) * a.HQ + (P & 3) * 4 + (bhl & 3); }
        if (PAIRED) { const int pu = slot + nslots * (it_i >> 1); qt = pu & 15; bh = (pu >> 4) * a.HQ + 2 * xcd + (it_i & 1); }
        const int h = bh % a.HQ, b = bh / a.HQ;
        const bool is_ctx = qt >= 16;
        const int q0 = is_ctx ? SEQ : qt * 256;
        int t_lo = 0, n_lat = 0;
        if (!is_ctx) {
            if (MODE == 2) { t_lo = 0; n_lat = 64; }
            else if (MODE == 1) { t_lo = max(0, 4 * qt - 2); n_lat = min(63, 4 * qt + 5) - t_lo + 1; }
            else { const int r0 = 4 * qt; t_lo = min(max(r0 - 4, 0), 56); n_lat = min(max(r0 - 1, 0), 56) + 7 - t_lo + 1; }
        }
        const int ntiles = n_lat + 4;
        const int qw0 = q0 + wid * 32, qpos = qw0 + r;
        const size_t qrow = (size_t)b * PP + qpos;
        bf16x8 qf[NKK];
#pragma unroll
        for (int kk = 0; kk < NKK; ++kk) qf[kk] = *(const bf16x8*)(a.Q + qrow * a.ldq + h * DQ + kk * 16 + hf * 8);
        if (MODE == 0 && !is_ctx) { for (int i = tid; i < 465; i += NTHREADS) biasl[i] = a.bias[h * 465 + i] * LOG2E; }
        const bf16_t* Kg = a.K + (size_t)b * PP * a.ldk + (h >> a.gk) * DQ;
        const bf16_t* Vg = a.V + (size_t)b * PP * a.ldv + (h >> a.gv) * a.vhs;
        f32x16 o[NDB];
#pragma unroll
        for (int d = 0; d < NDB; ++d)
#pragma unroll
            for (int i = 0; i < 16; ++i) o[d][i] = 0.f;
        float mref = 0.f, l = 0.f;
        f32x16 negm;
#pragma unroll
        for (int i = 0; i < 16; ++i) negm[i] = 0.f;
        bool first = true;
        float lbig = 0.f;
        float one = 1.0f; asm volatile("" : "+v"(one));
#define ATT_TILE(IT) ((IT) < n_lat ? t_lo + (IT) : 64 + ((IT) - n_lat))
        auto tile_active = [&](int t) -> bool {
            if (t >= 64) return true;
            if (MODE == 1) return (t * 64 + 63 >= qw0 - 128) && (t * 64 <= qw0 + 31 + 128);
            if (MODE == 0) { const int rw = qw0 >> 6, row0 = min(max(rw - 4, 0), 56); return t >= row0 && t < row0 + 8; }
            return true;
        };
        auto qk = [&](f32x16 (&s)[2], const lds_ptr Kb) {
#pragma unroll
            for (int kk = 0; kk < NKK; ++kk)
#pragma unroll
                for (int kb = 0; kb < 2; ++kb) {
                    if (ABL & 4) { if (kk == 0) s[kb] = negm; }
                    else {
                    const bf16x8 kf = *(const LAS bf16x8*)(Kb + (kb * 32 + r) * KSTR + (kk * 2 + hf) * 16);
                    s[kb] = MFMA32(kf, qf[kk], kk == 0 ? negm : s[kb]);
                    }
                }
        };
        u32x4 kr[NKI], vr[NVI];
        {
            const int t0 = ATT_TILE(0), t1 = ATT_TILE(1);
            u32x4 k1[NKI];
#pragma unroll
            for (int i = 0; i < NKI; ++i) kr[i] = *(const u32x4*)(Kg + (size_t)t0 * 64 * a.ldk + koff[i]);
#pragma unroll
            for (int i = 0; i < NVI; ++i) vr[i] = *(const u32x4*)(Vg + (size_t)t0 * 64 * a.ldv + voff[i]);
#pragma unroll
            for (int i = 0; i < NKI; ++i) k1[i] = *(const u32x4*)(Kg + (size_t)t1 * 64 * a.ldk + koff[i]);
#pragma unroll
            for (int i = 0; i < NKI; ++i) { *(LAS u32x4*)(lds + kdst[i]) = kr[i]; *(LAS u32x4*)(lds + KTB + kdst[i]) = k1[i]; }
#pragma unroll
            for (int i = 0; i < NVI; ++i) *(LAS u32x4*)(lds + 2 * KTB + vdst[i]) = vr[i];
        }
        __syncthreads();
        f32x16 sc[2], sn[2];
        bool act_cur = tile_active(ATT_TILE(0)), act_nxt = false;
        if (act_cur) qk(sc, lds);
        __syncthreads();
        auto step = [&](const int it, const int e, const bool N2, const bool N1) {
            const int t = ATT_TILE(it);
            if (N2 && !(ABL & 8) && (!(ABL & 128) || e)) {
                const int tn = ATT_TILE(it + 2);
#pragma unroll
                for (int i = 0; i < NKI; ++i) kr[i] = *(const u32x4*)(Kg + (size_t)tn * 64 * a.ldk + koff[i]);
            }
            if (N1 && !(ABL & 8) && (!(ABL & 128) || e)) {
                const int tn = ATT_TILE(it + 1);
#pragma unroll
                for (int i = 0; i < NVI; ++i) vr[i] = *(const u32x4*)(Vg + (size_t)tn * 64 * a.ldv + voff[i]);
            }
            SCHED_FENCE();
            act_nxt = N1 && (MODE == 2 || tile_active(ATT_TILE(it + 1)));
            const lds_ptr Vb = lds + 2 * KTB + e * VTB;
            const bool do_cur = MODE == 2 || act_cur;
            if (do_cur) {
                if (t < 64 && MODE == 1 && !((t * 64 + 63 - qw0 <= 128) && (qw0 + 31 - t * 64 <= 128))) {
                    const int dbase = t * 64 + 4 * hf - qpos;
#pragma unroll
                    for (int kb = 0; kb < 2; ++kb)
#pragma unroll
                        for (int i = 0; i < 16; ++i) { const int c = kb * 32 + (i & 3) + 8 * (i >> 2); sc[kb][i] = (dbase > 128 - c || dbase < -128 - c) ? -INFINITY : sc[kb][i]; }
                }
                if (t < 64 && MODE == 0) {
                    const int qc = qpos & 63, rw = qpos >> 6, col0 = min(max(qc - 8, 0), 48);
                    const int brow = (t - rw + 7) * 31 + 15 - qc;
#pragma unroll
                    for (int kb = 0; kb < 2; ++kb)
#pragma unroll
                        for (int i = 0; i < 16; ++i) {
                            const int kc = kb * 32 + crow(i, hf);
                            const bool ok = kc >= col0 && kc < col0 + 16;
                            const float bv = biasl[ok ? brow + kc : 0];
                            sc[kb][i] = ok ? sc[kb][i] + bv : -INFINITY;
                        }
                }
                if (first || __builtin_amdgcn_ballot_w64(lbig > ATT_BIGF) != 0ull) {
                    float delta = lbig > ATT_BIGF ? ATT_BIG : 0.f;
                    if (first) {
                        float mx = sc[0][0];
#pragma unroll
                        for (int i = 1; i < 16; ++i) mx = fmaxf(mx, sc[0][i]);
#pragma unroll
                        for (int i = 0; i < 16; ++i) mx = fmaxf(mx, sc[1][i]);
                        mx = xhalf_max(mx);
                        delta = mx > -INFINITY ? mx : 0.f;
                    }
                    const float alpha = __builtin_amdgcn_exp2f(-delta);
                    l *= alpha; mref += delta;
#pragma unroll
                    for (int d = 0; d < NDB; ++d)
#pragma unroll
                        for (int i = 0; i < 16; ++i) o[d][i] *= alpha;
#pragma unroll
                    for (int kb = 0; kb < 2; ++kb)
#pragma unroll
                        for (int i = 0; i < 16; ++i) sc[kb][i] -= delta;
#pragma unroll
                    for (int i = 0; i < 16; ++i) negm[i] = -mref;
                    first = false;
                }
            }
            if (N1) qk(sn, lds + (e ^ 1) * KTB);
            if (do_cur) {
                float ls0 = 0.f, ls1 = 0.f;
#pragma unroll
                for (int kb = 0; kb < 2; ++kb)
#pragma unroll
                    for (int i = 0; i < 16; i += 2) {
                        const float p0 = (ABL & 1) ? sc[kb][i] : __builtin_amdgcn_exp2f(sc[kb][i]), p1 = (ABL & 1) ? sc[kb][i + 1] : __builtin_amdgcn_exp2f(sc[kb][i + 1]);
                        sc[kb][i] = p0; sc[kb][i + 1] = p1;
                        if (!(ABL & 16)) { ls0 += p0; ls1 = __builtin_fmaf(p1, one, ls1); }
                    }
                lbig = ls0 + ls1;
                l += lbig;
                bf16x8 pf[4];
#pragma unroll
                for (int kb = 0; kb < 2; ++kb)
#pragma unroll
                    for (int sp = 0; sp < 2; ++sp) {
                        u32x4 w;
                        w.x = cvtpk(sc[kb][8 * sp], sc[kb][8 * sp + 1]); w.y = cvtpk(sc[kb][8 * sp + 2], sc[kb][8 * sp + 3]);
                        w.z = cvtpk(sc[kb][8 * sp + 4], sc[kb][8 * sp + 5]); w.w = cvtpk(sc[kb][8 * sp + 6], sc[kb][8 * sp + 7]);
                        pf[kb * 2 + sp] = __builtin_bit_cast(bf16x8, w);
                    }
#pragma unroll
                for (int ks = 0; ks < 4; ++ks)
#pragma unroll
                    for (int d = 0; d < NDB; ++d) {
                        const lds_ptr vp = Vb + ((2 * ks) * NDB + d) * 512 + vtr0;
                        const s16x4 lo = lds_tr(vp), hi = lds_tr(vp + NDB * 512);
                        const bf16x8 vf = __builtin_shufflevector(lo, hi, 0, 1, 2, 3, 4, 5, 6, 7);
                        if (ABL & 2) { if (d == 0 && ks == 0) o[0][0] += __builtin_bit_cast(float, pf[0][0] | pf[1][0] | pf[2][0] | pf[3][0]) + __builtin_bit_cast(float, (int)vf[0]); } else
                        o[d] = MFMA32(vf, pf[ks], o[d]);
                    }
            }
            SCHED_FENCE();
            if (N2 && !(ABL & 8) && (!(ABL & 128) || e)) {
#pragma unroll
                for (int i = 0; i < NKI; ++i) *(LAS u32x4*)(lds + e * KTB + kdst[i]) = kr[i];
            }
            if (N1 && !(ABL & 8) && (!(ABL & 128) || e)) {
#pragma unroll
                for (int i = 0; i < NVI; ++i) *(LAS u32x4*)(lds + 2 * KTB + (e ^ 1) * VTB + vdst[i]) = vr[i];
            }
            if (!(ABL & 64) && (!(ABL & 128) || e)) __syncthreads();
#pragma unroll
            for (int kb = 0; kb < 2; ++kb) sc[kb] = sn[kb];
            act_cur = act_nxt;
        };
        int it = 0;
        for (; it + 3 < ntiles; it += 2) { step(it, 0, true, true); step(it + 1, 1, true, true); }
        if (ntiles - it == 3) { step(it, 0, true, true); step(it + 1, 1, false, true); step(it + 2, 0, false, false); }
        else { step(it, 0, false, true); step(it + 1, 1, false, false); }
#undef ATT_TILE
        l = xhalf_sum(l);
        if (a.sink) {
            l += __builtin_amdgcn_exp2f(a.sink[h] * LOG2E - mref);
        }
        const float inv = 1.0f / l;
        bf16_t* orow = a.O + qrow * a.ldo + h * DV + 4 * hf;
#pragma unroll
        for (int d = 0; d < NDB; ++d)
#pragma unroll
            for (int g = 0; g < 4; ++g) {
                if (DV == 64) {
                    *(unsigned*)((unsigned char*)a.O + qrow * a.ldo + h * DV + 4 * hf + d * 32 + 8 * g) = cvt_fp8x4(o[d][4 * g] * inv, o[d][4 * g + 1] * inv, o[d][4 * g + 2] * inv, o[d][4 * g + 3] * inv);
                } else {
                    u32x2 w; w.x = cvtpk(o[d][4 * g] * inv, o[d][4 * g + 1] * inv); w.y = cvtpk(o[d][4 * g + 2] * inv, o[d][4 * g + 3] * inv);
                    *(u32x2*)(orow + d * 32 + 8 * g) = w;
                }
            }
        if (PAIRED && (it_i & 1)) {
            asm volatile("s_waitcnt vmcnt(0)" ::: "memory");
            const float lambda_init = 0.8f - 0.6f * 0.40656965974059917f;
            const int sub = lane & 7, pair = h >> 1;
#pragma unroll
            for (int i4 = 0; i4 < 4; ++i4) {
                const size_t row = (size_t)b * PP + qw0 + i4 * 8 + (lane >> 3);
                const bf16_t* o1 = a.O + row * a.ldo + (2 * pair) * 128 + sub * 16, *o2 = o1 + 128;
                float av[16], cv[16];
                unpack8(*(const u32x4*)o1, *(float(*)[8])av); unpack8(*(const u32x4*)(o1 + 8), *(float(*)[8])(av + 8));
                unpack8(*(const u32x4*)o2, *(float(*)[8])cv); unpack8(*(const u32x4*)(o2 + 8), *(float(*)[8])(cv + 8));
                float ss = 0.f;
#pragma unroll
                for (int e = 0; e < 16; ++e) { av[e] -= lam_full * cv[e]; ss += av[e] * av[e]; }
                ss += __shfl_xor(ss, 1); ss += __shfl_xor(ss, 2); ss += __shfl_xor(ss, 4);
                const float rs = rsqrtf(ss * (1.0f / 128.0f) + EPS) * (1.0f - lambda_init);
#pragma unroll
                for (int e = 0; e < 16; ++e) av[e] *= rs * a.subln[sub * 16 + e];
                u32x4 w8; w8.x = cvt_fp8x4(av[0], av[1], av[2], av[3]); w8.y = cvt_fp8x4(av[4], av[5], av[6], av[7]); w8.z = cvt_fp8x4(av[8], av[9], av[10], av[11]); w8.w = cvt_fp8x4(av[12], av[13], av[14], av[15]);
                *(u32x4*)(a.Oc + row * (size_t)a.ldoc + pair * 128 + sub * 16) = w8;
            }
        }
    }
}

DI void attn_na(const AttnP& a, unsigned char* smem, int bid, int nb, int tid) {
    constexpr int DQ = 64, DV = 64, KSTR = DQ * 2 + 16, KTB = 64 * KSTR, VTB = 64 * DV * 2, NDB = 2, NKK = 4;
    const lds_ptr lds = (lds_ptr)smem;
    constexpr int BZ_TAB = 32, BZ_HEAD = 560, BZ_NINF = 16 * BZ_HEAD, BZ_N = BZ_NINF + 64;
    static_assert(4 * KTB + 4 * VTB + (BZ_N + 16) * 4 <= GEMM_LDS, "NA LDS");
    LAS float* biasl = (LAS float*)(lds + 4 * KTB + 4 * VTB);
    for (int i = tid; i < BZ_N; i += NTHREADS) {
        const int hh = i / BZ_HEAD, o = i - hh * BZ_HEAD;
        biasl[i] = i >= BZ_NINF ? -INFINITY : (o >= BZ_TAB && o < BZ_TAB + 465) ? a.bias[hh * 465 + o - BZ_TAB] * LOG2E : 0.f;
    }
    __syncthreads();
    {
        const int wv = __builtin_amdgcn_readfirstlane(tid >> 6), ln = tid & 63;
#pragma unroll
        for (int hh2 = 0; hh2 < 2; ++hh2) {
            const int hh = 2 * wv + hh2;
            float m = 0.f;
            for (int i = ln; i < 465; i += 64) m = fmaxf(m, biasl[hh * BZ_HEAD + BZ_TAB + i]);
#pragma unroll
            for (int d = 32; d >= 1; d >>= 1) m = fmaxf(m, __shfl_xor(m, d));
            if (ln == 0) biasl[BZ_N + hh] = m;
        }
    }
    float kmax = fabsf(a.kgain[tid & 63]);
#pragma unroll
    for (int d = 32; d >= 1; d >>= 1) kmax = fmaxf(kmax, __shfl_xor(kmax, d));
    kmax *= 8.0f * 1.01f;
    const int lane = tid & 63, wid = __builtin_amdgcn_readfirstlane(tid >> 6), r = lane & 31, hf = lane >> 5;
    const int nq = a.need_ctx ? 17 : 16;
    const int xcd = bid & 7, slot = bid >> 3, nslots = nb >> 3, per_xcd = (NBATCH * a.HQ / 8) * nq;
    const int krow_s = tid >> 3, kc_s = tid & 7;
    const int koff = krow_s * a.ldk + kc_s * 8, kdst = krow_s * KSTR + kc_s * 16, voff = krow_s * a.ldv + kc_s * 8;
    const int vdst = ((krow_s >> 3) * NDB + (kc_s >> 2)) * 512 + (krow_s & 7) * 64 + (kc_s & 3) * 16;
    const int i16 = lane & 15, trq = i16 >> 2, trp = i16 & 3, grp = (lane >> 4) & 1;
    const int vtr0 = (4 * hf + trq) * 64 + 32 * grp + 8 * trp;
    const int rp = wid >> 2, cq = wid & 3, k0 = cq == 0 ? 0 : cq == 1 ? 8 : cq == 2 ? 24 : 32;
    float one = 1.0f; asm volatile("" : "+v"(one));
    auto unit_of = [&](int j, int& b, int& h, int& qt, int& t_lo, int& n_lat) {
        const int nbh = NBATCH * a.HQ / 8;
        const int bhl = j < nbh * 16 ? j >> 4 : j - nbh * 16; qt = j < nbh * 16 ? j & 15 : 16;
        const int bh = bhl * 8 + xcd; h = bh % a.HQ; b = bh / a.HQ;
        t_lo = 0; n_lat = 0;
        if (qt < 16) { const int r0 = 4 * qt; t_lo = min(max(r0 - 4, 0), 56); n_lat = min(max(r0 - 1, 0), 56) + 7 - t_lo + 1; n_lat += n_lat & 1; }
    };
#define NA_TILE_OF(IT, TLO, NLAT) ((IT) < (NLAT) ? (TLO) + (IT) : 64 + ((IT) - (NLAT)))
    bf16x8 qf[NKK];
    u32x4 krA[2], vrA[2], krB[2], vrB[2];
    auto load_pair = [&](u32x4 (&kr)[2], u32x4 (&vr)[2], const bf16_t* Kg, const bf16_t* Vg, int t_lo, int n_lat, int pr) {
#pragma unroll
        for (int jj = 0; jj < 2; ++jj) {
            const int tn = NA_TILE_OF(2 * pr + jj, t_lo, n_lat);
            kr[jj] = *(const u32x4*)(Kg + (size_t)tn * 64 * a.ldk + koff); vr[jj] = *(const u32x4*)(Vg + (size_t)tn * 64 * a.ldv + voff);
        }
    };
    auto store_pair = [&](const u32x4 (&kr)[2], const u32x4 (&vr)[2], int e) {
#pragma unroll
        for (int jj = 0; jj < 2; ++jj) { *(LAS u32x4*)(lds + (2 * e + jj) * KTB + kdst) = kr[jj]; *(LAS u32x4*)(lds + 4 * KTB + (2 * e + jj) * VTB + vdst) = vr[jj]; }
    };
    auto qrow_of = [&](int b, int qt) -> size_t { const int qpos = qt >= 16 ? SEQ + wid * 32 + r : (4 * qt + 2 * rp + (r >> 4)) * 64 + 16 * cq + (r & 15); return (size_t)b * PP + qpos; };
    auto load_q = [&](int b, int h, int qt) {
        const size_t qrow = qrow_of(b, qt);
#pragma unroll
        for (int kk = 0; kk < NKK; ++kk) qf[kk] = *(const bf16x8*)(a.Q + qrow * a.ldq + h * DQ + kk * 16 + hf * 8);
    };
    if (slot >= per_xcd) return;
    int b, h, qt, t_lo, n_lat;
    unit_of(slot, b, h, qt, t_lo, n_lat);
    {
        load_q(b, h, qt);
        const bf16_t* Kg = a.K + (size_t)b * PP * a.ldk + h * DQ; const bf16_t* Vg = a.V + (size_t)b * PP * a.ldv + h * a.vhs;
        load_pair(krA, vrA, Kg, Vg, t_lo, n_lat, 0); store_pair(krA, vrA, 0); load_pair(krB, vrB, Kg, Vg, t_lo, n_lat, 1);
    }
    __syncthreads();
    for (int j = slot;;) {
        const int jn = j + nslots; const bool has_next = jn < per_xcd;
        int nb_, nh, nqt, nt_lo, nn_lat;
        unit_of(has_next ? jn : j, nb_, nh, nqt, nt_lo, nn_lat);
        const bf16_t* nKg = a.K + (size_t)nb_ * PP * a.ldk + nh * DQ; const bf16_t* nVg = a.V + (size_t)nb_ * PP * a.ldv + nh * a.vhs;
        const bool is_ctx = qt >= 16;
        const int r0 = 4 * qt;
        const int npair = (n_lat + 4) >> 1;
        const int qrw = r0 + 2 * rp + (r >> 4), qc = 16 * cq + (r & 15);
        const size_t qrow = qrow_of(b, qt);
        const bf16_t* Kg = a.K + (size_t)b * PP * a.ldk + h * DQ;
        const bf16_t* Vg = a.V + (size_t)b * PP * a.ldv + h * a.vhs;
        const int rwA = r0 + 2 * rp, wlo = min(max(rwA - 4, 0), 56), whi = min(max(rwA - 3, 0), 56) + 7;
        const int col0 = min(max(qc - 8, 0), 48), row0q = min(max(qrw - 4, 0), 56);
        const int lanebase = h * BZ_HEAD + BZ_TAB + (7 - qrw) * 31 + 15 - qc + k0 + 4 * hf;
        f32x16 o[NDB];
#pragma unroll
        for (int d = 0; d < NDB; ++d)
#pragma unroll
            for (int i = 0; i < 16; ++i) o[d][i] = 0.f;
        float l = 0.f;
        float qn2 = 0.f;
#pragma unroll
        for (int kk = 0; kk < NKK; ++kk)
#pragma unroll
            for (int jj = 0; jj < 8; ++jj) { const float qv = bf2f((bf16_t)qf[kk][jj]); qn2 = __builtin_fmaf(qv, qv, qn2); }
        qn2 = xhalf_sum(qn2);
        const float mref = __builtin_sqrtf(qn2) * kmax + biasl[BZ_N + h];
        f32x16 negmL;
#pragma unroll
        for (int i = 0; i < 16; ++i) { const int kc = k0 + crow(i, hf); negmL[i] = (kc >= col0 && kc < col0 + 16) ? -mref : -INFINITY; }
#define NA_TILE(IT) NA_TILE_OF(IT, t_lo, n_lat)
        auto ctx_tile = [&](const lds_ptr Kb, const lds_ptr Vb) {
            {
                f32x16 s[2], negm;
#pragma unroll
                for (int i = 0; i < 16; ++i) negm[i] = -mref;
#pragma unroll
                for (int kk = 0; kk < NKK; ++kk)
#pragma unroll
                    for (int kb = 0; kb < 2; ++kb) {
                        const bf16x8 kf = *(const LAS bf16x8*)(Kb + (kb * 32 + r) * KSTR + (kk * 2 + hf) * 16);
                        s[kb] = MFMA32(kf, qf[kk], kk == 0 ? negm : s[kb]);
                    }
                float ls0 = 0.f, ls1 = 0.f;
                bf16x8 pf[4];
#pragma unroll
                for (int kb = 0; kb < 2; ++kb) {
#pragma unroll
                    for (int i = 0; i < 16; i += 2) {
                        const float p0 = __builtin_amdgcn_exp2f(s[kb][i]), p1 = __builtin_amdgcn_exp2f(s[kb][i + 1]);
                        s[kb][i] = p0; s[kb][i + 1] = p1; ls0 += p0; ls1 = __builtin_fmaf(p1, one, ls1);
                    }
#pragma unroll
                    for (int sp = 0; sp < 2; ++sp) {
                        u32x4 w;
                        w.x = cvtpk(s[kb][8 * sp], s[kb][8 * sp + 1]); w.y = cvtpk(s[kb][8 * sp + 2], s[kb][8 * sp + 3]);
                        w.z = cvtpk(s[kb][8 * sp + 4], s[kb][8 * sp + 5]); w.w = cvtpk(s[kb][8 * sp + 6], s[kb][8 * sp + 7]);
                        pf[kb * 2 + sp] = __builtin_bit_cast(bf16x8, w);
                    }
                }
                l += ls0 + ls1;
#pragma unroll
                for (int ks = 0; ks < 4; ++ks)
#pragma unroll
                    for (int d = 0; d < NDB; ++d) {
                        const lds_ptr vp = Vb + ((2 * ks) * NDB + d) * 512 + vtr0;
                        const s16x4 lo = lds_tr(vp), hi = lds_tr(vp + NDB * 512);
                        o[d] = MFMA32(__builtin_shufflevector(lo, hi, 0, 1, 2, 3, 4, 5, 6, 7), pf[ks], o[d]);
                    }
            }
        };
        auto lat_tile = [&](const int t, const lds_ptr Kb, const lds_ptr Vb) {
            bf16x8 pf[2];
#pragma unroll
            for (int sp = 0; sp < 2; ++sp)
#pragma unroll
                for (int jj = 0; jj < 8; ++jj) pf[sp][jj] = 0;
            if (t >= wlo && t <= whi) {
                f32x16 s;
#pragma unroll
                for (int kk = 0; kk < NKK; ++kk) {
                    const bf16x8 kf = *(const LAS bf16x8*)(Kb + (k0 + r) * KSTR + (kk * 2 + hf) * 16);
                    s = MFMA32(kf, qf[kk], kk == 0 ? negmL : s);
                }
                const LAS float* bp = biasl + (((unsigned)(t - row0q) < 8u) ? lanebase + 31 * t : BZ_NINF);
#pragma unroll
                for (int i = 0; i < 16; ++i) s[i] += bp[crow(i, 0)];
                float ls0 = 0.f, ls1 = 0.f;
#pragma unroll
                for (int i = 0; i < 16; i += 2) {
                    const float p0 = __builtin_amdgcn_exp2f(s[i]), p1 = __builtin_amdgcn_exp2f(s[i + 1]);
                    s[i] = p0; s[i + 1] = p1; ls0 += p0; ls1 = __builtin_fmaf(p1, one, ls1);
                }
#pragma unroll
                for (int sp = 0; sp < 2; ++sp) {
                    u32x4 w;
                    w.x = cvtpk(s[8 * sp], s[8 * sp + 1]); w.y = cvtpk(s[8 * sp + 2], s[8 * sp + 3]);
                    w.z = cvtpk(s[8 * sp + 4], s[8 * sp + 5]); w.w = cvtpk(s[8 * sp + 6], s[8 * sp + 7]);
                    pf[sp] = __builtin_bit_cast(bf16x8, w);
                }
                l += ls0 + ls1;
            }
#pragma unroll
            for (int ks = 0; ks < 2; ++ks)
#pragma unroll
                for (int d = 0; d < NDB; ++d) {
                    const lds_ptr vp = Vb + (((k0 >> 3) + 2 * ks) * NDB + d) * 512 + vtr0;
                    const s16x4 lo = lds_tr(vp), hi = lds_tr(vp + NDB * 512);
                    o[d] = MFMA32(__builtin_shufflevector(lo, hi, 0, 1, 2, 3, 4, 5, 6, 7), pf[ks], o[d]);
                }
        };
#define NA_ITER(IP, E, KL, VL, KS, VS, LAT) do { \
            if ((IP) + 2 < npair) load_pair(KL, VL, Kg, Vg, t_lo, n_lat, (IP) + 2); \
            else if (has_next) load_pair(KL, VL, nKg, nVg, nt_lo, nn_lat, (IP) + 2 - npair); \
            SCHED_FENCE(); \
            if (LAT) { lat_tile(t_lo + 2 * (IP), lds + (2 * (E)) * KTB, lds + 4 * KTB + (2 * (E)) * VTB); lat_tile(t_lo + 2 * (IP) + 1, lds + (2 * (E) + 1) * KTB, lds + 4 * KTB + (2 * (E) + 1) * VTB); } \
            else { ctx_tile(lds + (2 * (E)) * KTB, lds + 4 * KTB + (2 * (E)) * VTB); ctx_tile(lds + (2 * (E) + 1) * KTB, lds + 4 * KTB + (2 * (E) + 1) * VTB); } \
            SCHED_FENCE(); \
            if ((IP) + 1 < npair || has_next) store_pair(KS, VS, (E) ^ 1); \
            __syncthreads(); } while (0)
        int ip = 0;
        for (; ip < (n_lat >> 1); ip += 2) { NA_ITER(ip, 0, krA, vrA, krB, vrB, true); NA_ITER(ip + 1, 1, krB, vrB, krA, vrA, true); }
        NA_ITER(ip, 0, krA, vrA, krB, vrB, false); NA_ITER(ip + 1, 1, krB, vrB, krA, vrA, false);
#undef NA_ITER
        if (has_next) load_q(nb_, nh, nqt);
#undef NA_TILE
        l = xhalf_sum(l);
        const float inv = 1.0f / l;
#pragma unroll
        for (int d = 0; d < NDB; ++d)
#pragma unroll
            for (int g = 0; g < 4; ++g)
                *(unsigned*)((unsigned char*)a.O + qrow * a.ldo + h * DV + 4 * hf + d * 32 + 8 * g) = cvt_fp8x4(o[d][4 * g] * inv, o[d][4 * g + 1] * inv, o[d][4 * g + 2] * inv, o[d][4 * g + 3] * inv);
        if (!has_next) break;
        j = jn; b = nb_; h = nh; qt = nqt; t_lo = nt_lo; n_lat = nn_lat;
    }
#undef NA_TILE_OF
}

template <class E> struct epi_perm16 { static constexpr bool value = false; };
template <class E> struct epi_fp8 { static constexpr int value = 0; };
typedef int v8i_t __attribute__((ext_vector_type(8)));
typedef int v4i_t __attribute__((ext_vector_type(4)));
namespace pg8 {
constexpr int BM = 256, BK = 64, HALF = 128, HTB = HALF * BK * 2  ;
DI int lds_byte(int r, int c) { const int st = (r >> 4) * 2 + (c >> 5), rr = r & 15, cc = c & 31, ob = rr * 64 + cc * 2; return st * 1024 + (ob ^ (((ob >> 9) & 1) << 5)); }
DI void stage_rc(int b, int& R, int& C) { const int st = b / 1024, sb = b % 1024, swz = sb ^ (((sb >> 9) & 1) << 5); R = (st >> 1) * 16 + swz / 64; C = (st & 1) * 32 + (swz % 64) / 2; }
DI int perm32(int rho) { const int n = rho >> 4, i = rho & 15; return 8 * (i >> 2) + 4 * n + (i & 3); }

template <class Epi, class Sched>
DI void gemm_phase(lds_ptr lds, const bf16_t* __restrict__ Aop, const int K, const Sched& S, const Epi& E, const int tid) {
    const int wid = __builtin_amdgcn_readfirstlane(tid >> 6), lane = tid & 63, wr = wid >> 2, wc = wid & 3, fr = lane & 15, fq = lane >> 4;
    const int nt = K / BK;
    int Ra[2], Ca[2]; unsigned voffB[2];
#pragma unroll
    for (int i = 0; i < 2; ++i) { int R, C; stage_rc(tid * 16 + i * 8192, R, C); const int p32 = perm32(R & 31); const int Rb = epi_perm16<Epi>::value ? 64 * (R >> 5) + 16 * (p32 >> 3) + (p32 & 7) : Epi::PERM ? ((R & ~31) + p32) : R;
        Ra[i] = R; Ca[i] = C; voffB[i] = (unsigned)(Rb * K + C) * 2u; }
    const size_t kstep = (size_t)(BK * 2);
    const size_t hstep = (size_t)(epi_perm16<Epi>::value ? 8 : HALF) * K * 2;
    const unsigned ldsw = (unsigned)wid * 1024u;
    const int aoff = lds_byte(wr * 64 + fr, fq * 8), boff = lds_byte(wc * 32 + fr, fq * 8);
#define PG8_SA(b, h) (((b) * 2 + (h)) * HTB)
#define PG8_SB(b, h) ((4 + (b) * 2 + (h)) * HTB)
#define PG8_STAGE(bufoff, gbase, voff) do { const char* _gb = (const char*)(gbase); asm volatile("" : "+s"(_gb)); _Pragma("unroll") for (int _i = 0; _i < 2; ++_i) { \
        unsigned _o = (voff)[_i]; asm volatile("" : "+v"(_o)); \
        __builtin_amdgcn_global_load_lds((const unsigned*)(_gb + _o), (LAS unsigned*)(lds + (bufoff) + ldsw + _i * 8192), 16, 0, 0); } } while (0)
#define PG8_LDA(dst, b, h) do { _Pragma("unroll") for (int m = 0; m < 4; ++m) _Pragma("unroll") for (int k = 0; k < 2; ++k) dst[m][k] = *(const LAS bf16x8*)(lds + PG8_SA(b, h) + aoff + m * 2048 + k * 1024); } while (0)
#define PG8_LDB(dst, b, h) do { _Pragma("unroll") for (int n = 0; n < 2; ++n) _Pragma("unroll") for (int k = 0; k < 2; ++k) dst[n][k] = *(const LAS bf16x8*)(lds + PG8_SB(b, h) + boff + n * 2048 + k * 1024); } while (0)
typedef long i64x2_t __attribute__((ext_vector_type(2)));
#define PG8_MMA(ai, bj, At, Bt) do { __builtin_amdgcn_s_setprio(1); _Pragma("unroll") for (int m = 0; m < 4; ++m) _Pragma("unroll") for (int n = 0; n < 2; ++n) { \
        if (epi_fp8<Epi>::value == 2) { \
            const v8i_t _b = __builtin_shufflevector(__builtin_bit_cast(v4i_t, Bt[n][0]), __builtin_bit_cast(v4i_t, Bt[n][1]), 0, 1, 2, 3, 4, 5, 6, 7); \
            const v8i_t _a = __builtin_shufflevector(__builtin_bit_cast(v4i_t, At[m][0]), __builtin_bit_cast(v4i_t, At[m][1]), 0, 1, 2, 3, 4, 5, 6, 7); \
            acc[ai][bj][m][n] = __builtin_amdgcn_mfma_scale_f32_16x16x128_f8f6f4(_b, _a, acc[ai][bj][m][n], 0, 0, 0, 0, 0, 0); \
        } else { _Pragma("unroll") for (int k = 0; k < 2; ++k) { \
        if (epi_fp8<Epi>::value == 1) { const i64x2_t _b = __builtin_bit_cast(i64x2_t, Bt[n][k]), _a = __builtin_bit_cast(i64x2_t, At[m][k]); \
            acc[ai][bj][m][n] = __builtin_amdgcn_mfma_f32_16x16x32_fp8_fp8(_b[0], _a[0], acc[ai][bj][m][n], 0, 0, 0); \
            acc[ai][bj][m][n] = __builtin_amdgcn_mfma_f32_16x16x32_fp8_fp8(_b[1], _a[1], acc[ai][bj][m][n], 0, 0, 0); } \
        else acc[ai][bj][m][n] = __builtin_amdgcn_mfma_f32_16x16x32_bf16(Bt[n][k], At[m][k], acc[ai][bj][m][n], 0, 0, 0); } } } \
        __builtin_amdgcn_s_setprio(0); } while (0)
#define PG8_WAIT_V(n) asm volatile("s_waitcnt vmcnt(" #n ")" ::: "memory")
#define PG8_WAIT_L(n) asm volatile("s_waitcnt lgkmcnt(" #n ")" ::: "memory")
#define PG8_BAR __builtin_amdgcn_s_barrier()
#define PG8_SCHED __builtin_amdgcn_sched_barrier(0)
    typename Sched::Unit cur, nxt; int ui = 0;
    if (!S.next(0, cur)) return;
    f32x4 acc[2][2][4][2];
#pragma unroll
    for (int a = 0; a < 2; ++a)
#pragma unroll
        for (int b = 0; b < 2; ++b)
#pragma unroll
            for (int m = 0; m < 4; ++m)
#pragma unroll
                for (int n = 0; n < 2; ++n) acc[a][b][m][n] = (f32x4){0.f, 0.f, 0.f, 0.f};
    bf16x8 At[4][2], B0[2][2], B1[2][2];
    constexpr bool GATHER = Sched::GATHER;
    unsigned oc[2][2], on[2][2] = {{0u, 0u}, {0u, 0u}};
    size_t ubc[2] = {0, 0}, ubn[2] = {0, 0};
#pragma unroll
    for (int h = 0; h < 2; ++h) {
        if (!GATHER) ubc[h] = (size_t)S.a_off(cur, h * HALF) * 2u;
#pragma unroll
        for (int i = 0; i < 2; ++i) oc[h][i] = GATHER ? (S.a_off(cur, h * HALF + Ra[i]) + (unsigned)Ca[i]) * 2u : (unsigned)(Ra[i] * S.lda + Ca[i]) * 2u;
    }
    const char* gA = (const char*)Aop;
    const char* cB = (const char*)S.b_base(cur);
    PG8_STAGE(PG8_SB(0, 0), cB, voffB); PG8_STAGE(PG8_SB(0, 1), cB + hstep, voffB); PG8_STAGE(PG8_SA(0, 0), gA + ubc[0], oc[0]); PG8_STAGE(PG8_SA(0, 1), gA + ubc[1], oc[1]);
    if (wr == 1) PG8_BAR;
    PG8_WAIT_V(2); PG8_BAR;
    PG8_STAGE(PG8_SB(1, 0), cB + kstep, voffB); PG8_STAGE(PG8_SA(1, 0), gA + ubc[0] + kstep, oc[0]); PG8_STAGE(PG8_SB(1, 1), cB + hstep + kstep, voffB);
    PG8_WAIT_V(6); PG8_BAR;
    for (;;) {
        const bool has_next = S.next(ui + 1, nxt);
        const char* nB = has_next ? (const char*)S.b_base(nxt) : cB;
#pragma unroll
        for (int h = 0; h < 2; ++h) {
            if (!GATHER) ubn[h] = has_next ? (size_t)S.a_off(nxt, h * HALF) * 2u : ubc[h];
#pragma unroll
            for (int i = 0; i < 2; ++i) if (GATHER) { int R, C; stage_rc(((wid << 6) | lane_now()) * 16 + i * 8192, R, C);
                const unsigned* ip = S.a_ptr(nxt, h * HALF + R); if (epi_fp8<Epi>::value != 2) asm volatile("global_load_dword %0, %1, off" : "=v"(on[h][i]) : "v"(ip) : "memory"); }
        }
        const bool full = cur.half < 0;
        for (int t = 0; t < nt; t += 2) {
            const bool last = (t == nt - 2);
            const char* a1 = gA + (size_t)(t + 1) * kstep;
            const char* a2 = last ? gA : gA + (size_t)(t + 2) * kstep; const char* b2 = last ? nB : cB + (size_t)(t + 2) * kstep;
            const char* a3 = a2 + kstep; const char* b3 = b2 + kstep;
            size_t u2[2];
            if (GATHER && last) {
                if (epi_fp8<Epi>::value != 2) asm volatile("" : "+v"(on[0][0]), "+v"(on[0][1]), "+v"(on[1][0]), "+v"(on[1][1]));
#pragma unroll
                for (int i = 0; i < 2; ++i) { int R, C; stage_rc(((wid << 6) | lane_now()) * 16 + i * 8192, R, C);
                    if (epi_fp8<Epi>::value == 2) { on[0][i] = *S.a_ptr(nxt, R); on[1][i] = *S.a_ptr(nxt, HALF + R); }
                    oc[0][i] = (S.a_cvt(on[0][i]) + (unsigned)C) * 2u; on[1][i] = (S.a_cvt(on[1][i]) + (unsigned)C) * 2u; }
            }
#pragma unroll
            for (int h = 0; h < 2; ++h) u2[h] = last ? ubn[h] : ubc[h];
            PG8_LDB(B0, 0, 0); PG8_LDB(B1, 0, 1); PG8_SCHED; PG8_LDA(At, 0, 0); PG8_STAGE(PG8_SA(1, 1), a1 + ubc[1], oc[1]);
            if (GATHER && last) { oc[1][0] = on[1][0]; oc[1][1] = on[1][1]; }
            PG8_WAIT_V(8); PG8_WAIT_L(0); PG8_BAR; PG8_MMA(0, 0, At, B0); PG8_MMA(0, 1, At, B1); PG8_BAR; PG8_SCHED;
            PG8_LDA(At, 0, 1); PG8_STAGE(PG8_SB(0, 0), b2, voffB); PG8_STAGE(PG8_SB(0, 1), b2 + hstep, voffB); PG8_STAGE(PG8_SA(0, 0), a2 + u2[0], oc[0]);
            PG8_WAIT_V(8); PG8_WAIT_L(0); PG8_BAR; if (full) { PG8_MMA(1, 0, At, B0); PG8_MMA(1, 1, At, B1); } PG8_BAR; PG8_SCHED;
            PG8_LDB(B0, 1, 0); PG8_LDB(B1, 1, 1); PG8_SCHED; PG8_LDA(At, 1, 0); PG8_STAGE(PG8_SA(0, 1), a2 + u2[1], oc[1]);
            PG8_WAIT_V(8); PG8_WAIT_L(0); PG8_BAR; PG8_MMA(0, 0, At, B0); PG8_MMA(0, 1, At, B1); PG8_BAR; PG8_SCHED;
            PG8_LDA(At, 1, 1); PG8_STAGE(PG8_SB(1, 0), b3, voffB); PG8_STAGE(PG8_SB(1, 1), b3 + hstep, voffB); PG8_STAGE(PG8_SA(1, 0), a3 + u2[0], oc[0]);
            PG8_WAIT_V(8); PG8_WAIT_L(0); PG8_BAR; if (full) { PG8_MMA(1, 0, At, B0); PG8_MMA(1, 1, At, B1); } PG8_BAR; PG8_SCHED;
        }
        if (wr == 0) PG8_BAR;
        { const int ln = lane_now(); E(acc, cur, wr, wc, ln & 15, ln >> 4); }
        if (!has_next) break;
#pragma unroll
        for (int a = 0; a < 2; ++a)
#pragma unroll
            for (int b = 0; b < 2; ++b)
#pragma unroll
                for (int m = 0; m < 4; ++m)
#pragma unroll
                    for (int n = 0; n < 2; ++n) acc[a][b][m][n] = (f32x4){0.f, 0.f, 0.f, 0.f};
        cur = nxt; cB = nB; ++ui;
#pragma unroll
        for (int h = 0; h < 2; ++h) ubc[h] = ubn[h];
        if (wr == 1) PG8_BAR;
    }
    PG8_WAIT_V(0);
    PG8_BAR;
#undef PG8_SA
#undef PG8_SB
#undef PG8_STAGE
#undef PG8_LDA
#undef PG8_LDB
#undef PG8_MMA
#undef PG8_WAIT_V
#undef PG8_WAIT_L
#undef PG8_BAR
#undef PG8_SCHED
}
}

struct DenseSched {
    static constexpr bool GATHER = false;
    struct Unit { int pm, pn, half; };
    int nM, nN, nwg, G, c; const bf16_t* Bt; int K, lda; bool skip_ctx;
    DI void unit_of(int L, Unit& u) const {
        int wgid = L; { const int q = nwg / 8, r = nwg % 8, xcd = wgid % 8, off = wgid / 8; wgid = (xcd < r ? xcd * (q + 1) : r * (q + 1) + (xcd - r) * q) + off; }
        const int nig = 8 * nN, gid = wgid / nig, fm = gid * 8, gsz = (nM - fm) < 8 ? (nM - fm) : 8;
        u.pm = fm + ((wgid % nig) % gsz); u.pn = (wgid % nig) / gsz;
        if (skip_ctx) u.pm += u.pm >> 4;
    }
    DI bool next(int i, Unit& u) const {
        const int rounds = nwg / G, rem = nwg - rounds * G;
        if (i < rounds) { unit_of(i * G + c, u); u.half = -1; return true; }
        if (i > rounds || rem == 0) return false;
        if (2 * rem <= G) { if (c >= 2 * rem) return false; unit_of(rounds * G + (c >> 1), u); u.half = c & 1; return true; }
        if (c >= rem) return false;
        unit_of(rounds * G + c, u); u.half = -1; return true;
    }
    DI unsigned a_off(const Unit& u, int row) const { const int rr = u.half < 0 ? row : u.half * 128 + (row & 127); return (unsigned)(u.pm * 256 + rr) * (unsigned)lda; }
    DI const unsigned* a_ptr(const Unit&, int) const { return nullptr; }
    DI unsigned a_cvt(unsigned raw) const { return raw; }
    DI const bf16_t* b_base(const Unit& u) const { return Bt + (size_t)u.pn * 256 * K; }
};
struct MoeUnit { int e, pn, valid, half; const unsigned* ent; };
template <bool TAIL>
struct MoeSched {
    static constexpr bool GATHER = true;
    typedef MoeUnit Unit;
    const LAS int* tab; const unsigned* list; const unsigned* zero  ; const bf16_t* W; int K, N, TN, lda, shift, G, c, nwg;
    DI bool unit_of(int L, Unit& u) const {
        const int v = tab[1 + (lane_now() & 31)];
        const int e = __builtin_popcount((unsigned)__ballot(v <= L));
        if (e >= NEXP) return false;
        const int rem = L - __builtin_amdgcn_readfirstlane(tab[e]), cn = __builtin_amdgcn_readfirstlane(tab[40 + e]);
        const int rt = rem / TN; u.e = e; u.pn = rem - rt * TN; u.ent = list + (size_t)e * MROWS + rt * 256; u.valid = min(256, cn - rt * 256); return true;
    }
    int lo, n, GX, j;
    DI void place() { GX = G >> 3; j = c >> 3; const int per = ((((nwg + 7) >> 3) + TN - 1) / TN) * TN; lo = (c & 7) * per; n = max(0, min(per, nwg - lo)); }
    DI bool next(int i, Unit& u) const {
        u.ent = zero; u.valid = 1;
        const int rounds = n / GX, rem = n - rounds * GX;
        if (!TAIL) { u.half = -1; if (i >= rounds) return false; return unit_of(lo + i * GX + j, u); }
        if (i > 0 || rem == 0) return false;
        if (2 * rem <= GX) {
            if (j >= 2 * rem) return false;
            if (!unit_of(lo + rounds * GX + (j >> 1), u)) return false;
            u.half = j & 1; u.ent += u.half * 128; u.valid = min(128, u.valid - u.half * 128);
            return u.valid > 0;
        }
        u.half = -1; if (j >= rem) return false;
        return unit_of(lo + rounds * GX + j, u);
    }
    DI unsigned a_off(const Unit& u, int row) const { const int rr = (TAIL && u.half >= 0) ? (row & 127) : row; return (u.ent[rr < u.valid ? rr : u.valid - 1] >> shift) * (unsigned)lda; }
    DI const unsigned* a_ptr(const Unit& u, int row) const { const int rr = (TAIL && u.half >= 0) ? (row & 127) : row; return u.ent + (rr < u.valid ? rr : u.valid - 1); }
    DI unsigned a_cvt(unsigned raw) const { return (raw >> shift) * (unsigned)lda; }
    DI const bf16_t* b_base(const Unit& u) const { return W + ((size_t)u.e * N + (size_t)u.pn * 256) * K; }
};
typedef float f32x4_t __attribute__((ext_vector_type(4)));
struct XEpiStore {
    static constexpr bool PERM = true;
    bf16_t* C; int ldc;
    DI void operator()(const f32x4 (&acc)[2][2][4][2], const DenseSched::Unit& u, int wr, int wc, int fr, int fq) const {
        const int row0 = u.pm * 256 + (u.half > 0 ? 128 : 0) + wr * 64 + fr, col0 = u.pn * 256 + wc * 32 + 8 * fq;
#pragma unroll
        for (int ai = 0; ai < 2; ++ai) if (ai == 0 || u.half < 0)
#pragma unroll
            for (int m = 0; m < 4; ++m) { bf16_t* rowp = C + (size_t)(row0 + ai * 128 + m * 16) * ldc + col0;
#pragma unroll
                for (int bj = 0; bj < 2; ++bj) { const f32x4 v0 = acc[ai][bj][m][0], v1 = acc[ai][bj][m][1];
                    u32x4 w; w.x = cvtpk(v0[0], v0[1]); w.y = cvtpk(v0[2], v0[3]); w.z = cvtpk(v1[0], v1[1]); w.w = cvtpk(v1[2], v1[3]);
                    *(u32x4*)(rowp + bj * 128) = w; } }
    } };
struct XEpiStore8 {
    static constexpr bool PERM = true;
    bf16_t* C; int ldc;
    DI void operator()(const f32x4 (&acc)[2][2][4][2], const DenseSched::Unit& u, int wr, int wc, int fr, int fq) const {
        const int row0 = u.pm * 256 + (u.half > 0 ? 128 : 0) + wr * 64 + fr, col0 = u.pn * 256 + wc * 32 + 8 * fq;
#pragma unroll
        for (int ai = 0; ai < 2; ++ai) if (ai == 0 || u.half < 0)
#pragma unroll
            for (int m = 0; m < 4; ++m) { bf16_t* rowp = C + (size_t)(row0 + ai * 128 + m * 16) * ldc + col0;
#pragma unroll
                for (int bj = 0; bj < 2; ++bj) { const f32x4 v0 = acc[ai][bj][m][0] * (1.0f / 32.0f), v1 = acc[ai][bj][m][1] * (1.0f / 32.0f);
                    u32x4 w; w.x = cvtpk(v0[0], v0[1]); w.y = cvtpk(v0[2], v0[3]); w.z = cvtpk(v1[0], v1[1]); w.w = cvtpk(v1[2], v1[3]);
                    *(u32x4*)(rowp + bj * 128) = w; } }
    } };
template <> struct epi_fp8<XEpiStore8> { static constexpr int value = 2; };
struct XEpiResid {
    static constexpr bool PERM = true;
    const Params* p; const float* mod;
    DI void operator()(const f32x4 (&acc)[2][2][4][2], const DenseSched::Unit& u, int wr, int wc, int fr, int fq) const {
        const int row0 = u.pm * 256 + (u.half > 0 ? 128 : 0) + wr * 64 + fr, col0 = u.pn * 256 + wc * 32 + 8 * fq;
#pragma unroll
        for (int ai = 0; ai < 2; ++ai) if (ai == 0 || u.half < 0)
#pragma unroll
            for (int m = 0; m < 4; ++m) { const int row = row0 + ai * 128 + m * 16;
                bf16_t* xr = xb_row(*p, row) + col0; const float* gp = mod + (size_t)mod_row(row) * 6144 + 2048 + col0;
#pragma unroll
                for (int bj = 0; bj < 2; ++bj) {
                    const u32x4 xw = *(const u32x4*)(xr + bj * 128); const f32x4 g0 = *(const f32x4*)(gp + bj * 128), g1 = *(const f32x4*)(gp + bj * 128 + 4);
                    const f32x4 a0 = acc[ai][bj][m][0], a1 = acc[ai][bj][m][1];
                    u32x4 w;
                    w.x = cvtpk(bflo(xw.x) + g0[0] * a0[0], bfhi(xw.x) + g0[1] * a0[1]); w.y = cvtpk(bflo(xw.y) + g0[2] * a0[2], bfhi(xw.y) + g0[3] * a0[3]);
                    w.z = cvtpk(bflo(xw.z) + g1[0] * a1[0], bfhi(xw.z) + g1[1] * a1[1]); w.w = cvtpk(bflo(xw.w) + g1[2] * a1[2], bfhi(xw.w) + g1[3] * a1[3]);
                    *(u32x4*)(xr + bj * 128) = w; } }
    } };
struct XEpiResid8 {
    static constexpr bool PERM = true;
    const Params* p; const float* mod;
    DI void operator()(const f32x4 (&acc)[2][2][4][2], const DenseSched::Unit& u, int wr, int wc, int fr, int fq) const {
        const int row0 = u.pm * 256 + (u.half > 0 ? 128 : 0) + wr * 64 + fr, col0 = u.pn * 256 + wc * 32 + 8 * fq;
#pragma unroll
        for (int ai = 0; ai < 2; ++ai) if (ai == 0 || u.half < 0)
#pragma unroll
            for (int m = 0; m < 4; ++m) { const int row = row0 + ai * 128 + m * 16;
                bf16_t* xr = xb_row(*p, row) + col0; const float* gp = mod + (size_t)mod_row(row) * 6144 + 2048 + col0;
#pragma unroll
                for (int bj = 0; bj < 2; ++bj) {
                    const u32x4 xw = *(const u32x4*)(xr + bj * 128); const f32x4 g0 = *(const f32x4*)(gp + bj * 128) * (1.0f / 32.0f), g1 = *(const f32x4*)(gp + bj * 128 + 4) * (1.0f / 32.0f);
                    const f32x4 a0 = acc[ai][bj][m][0], a1 = acc[ai][bj][m][1];
                    u32x4 w;
                    w.x = cvtpk(bflo(xw.x) + g0[0] * a0[0], bfhi(xw.x) + g0[1] * a0[1]); w.y = cvtpk(bflo(xw.y) + g0[2] * a0[2], bfhi(xw.y) + g0[3] * a0[3]);
                    w.z = cvtpk(bflo(xw.z) + g1[0] * a1[0], bfhi(xw.z) + g1[1] * a1[1]); w.w = cvtpk(bflo(xw.w) + g1[2] * a1[2], bfhi(xw.w) + g1[3] * a1[3]);
                    *(u32x4*)(xr + bj * 128) = w; } }
    } };
template <> struct epi_fp8<XEpiResid8> { static constexpr int value = 2; };
struct XEpiGlu {
    static constexpr bool PERM = true;
    bf16_t* act; const float* gates;
    DI void operator()(const f32x4 (&acc)[2][2][4][2], const MoeUnit& u, int wr, int wc, int fr, int fq) const {
#pragma unroll
        for (int ai = 0; ai < 2; ++ai)
#pragma unroll
            for (int m = 0; m < 4; ++m) { const int i = ai * 128 + wr * 64 + m * 16 + fr;
                if (i < u.valid) { const unsigned a = u.ent[i]; const float gw = gates[a];
                    const f32x4 g0 = acc[ai][0][m][0], g1 = acc[ai][0][m][1], u0 = acc[ai][1][m][0], u1 = acc[ai][1][m][1];
                    float v[8];
#pragma unroll
                    for (int j = 0; j < 4; ++j) { v[j] = silu_f(g0[j]) * u0[j] * gw; v[4 + j] = silu_f(g1[j]) * u1[j] * gw; }
                    u32x4 w; w.x = cvtpk(v[0], v[1]); w.y = cvtpk(v[2], v[3]); w.z = cvtpk(v[4], v[5]); w.w = cvtpk(v[6], v[7]);
                    *(u32x4*)(act + (size_t)a * DEXP + u.pn * 128 + wc * 32 + 8 * fq) = w; } }
    } };
struct XEpiGlu8 : XEpiGlu {
    DI void operator()(const f32x4 (&acc)[2][2][4][2], const MoeUnit& u, int wr, int wc, int fr, int fq) const {
#pragma unroll
        for (int ai = 0; ai < 2; ++ai)
#pragma unroll
            for (int m = 0; m < 4; ++m) { const int i = ai * 128 + wr * 64 + m * 16 + fr;
                if (i < u.valid) { const unsigned a = u.ent[i]; const float gw = gates[a] * (1.0f / 32.0f);
                    const f32x4 g0 = acc[ai][0][m][0] * (1.0f / 32.0f), g1 = acc[ai][0][m][1] * (1.0f / 32.0f), u0 = acc[ai][1][m][0], u1 = acc[ai][1][m][1];
                    float v[8];
#pragma unroll
                    for (int j = 0; j < 4; ++j) { v[j] = silu_f(g0[j]) * u0[j] * gw; v[4 + j] = silu_f(g1[j]) * u1[j] * gw; }
                    u32x4 w; w.x = cvtpk(v[0], v[1]); w.y = cvtpk(v[2], v[3]); w.z = cvtpk(v[4], v[5]); w.w = cvtpk(v[6], v[7]);
                    *(u32x4*)(act + (size_t)a * DEXP + u.pn * 128 + wc * 32 + 8 * fq) = w; } }
    } };
template <> struct epi_fp8<XEpiGlu8> { static constexpr int value = 2; };
struct XEpiScatter {
    static constexpr bool PERM = true;
    bf16_t* outp;
    DI void operator()(const f32x4 (&acc)[2][2][4][2], const MoeUnit& u, int wr, int wc, int fr, int fq) const {
#pragma unroll
        for (int ai = 0; ai < 2; ++ai)
#pragma unroll
            for (int m = 0; m < 4; ++m) { const int i = ai * 128 + wr * 64 + m * 16 + fr;
                if (i < u.valid) { unsigned char* rowp = (unsigned char*)outp + (size_t)u.ent[i] * 1024 + u.pn * 256 + wc * 64 + 16 * fq;
                    const f32x4 a0 = acc[ai][0][m][0] * 16.f, a1 = acc[ai][0][m][1] * 16.f, b0 = acc[ai][1][m][0] * 16.f, b1 = acc[ai][1][m][1] * 16.f;
                    u32x4 w; w.x = cvt_fp8x4(a0[0], a0[1], a0[2], a0[3]); w.y = cvt_fp8x4(a1[0], a1[1], a1[2], a1[3]); w.z = cvt_fp8x4(b0[0], b0[1], b0[2], b0[3]); w.w = cvt_fp8x4(b1[0], b1[1], b1[2], b1[3]);
                    *(u32x4*)rowp = w; } }
    } };
template <> struct epi_perm16<XEpiScatter> { static constexpr bool value = true; };

template <int KIND>
struct XEpiQKV {
    static constexpr bool PERM = true;
    static constexpr int KW = KIND == 1 ? 256 : 1024, LDRAW = KIND == 1 ? 1536 : 3072;
    static constexpr float ASC = 1.0f / 32.0f;
    bf16_t* Q; bf16_t* Kb; bf16_t* RAW; const float* qn; const float* kn;
    DI void operator()(const f32x4 (&acc)[2][2][4][2], const DenseSched::Unit& u, int wr, int wc, int fr, int fq) const {
        const int col0 = u.pn * 256, row0 = u.pm * 256 + (u.half > 0 ? 128 : 0) + wr * 64 + fr;
        if (col0 >= 1024 + KW) {
#pragma unroll
            for (int ai = 0; ai < 2; ++ai) if (ai == 0 || u.half < 0)
#pragma unroll
                for (int m = 0; m < 4; ++m) { bf16_t* rowp = RAW + (size_t)(row0 + ai * 128 + m * 16) * LDRAW + col0 + wc * 32 + 8 * fq;
#pragma unroll
                    for (int bj = 0; bj < 2; ++bj) { const f32x4 v0 = acc[ai][bj][m][0] * ASC, v1 = acc[ai][bj][m][1] * ASC;
                        u32x4 w; w.x = cvtpk(v0[0], v0[1]); w.y = cvtpk(v0[2], v0[3]); w.z = cvtpk(v1[0], v1[1]); w.w = cvtpk(v1[2], v1[3]);
                        *(u32x4*)(rowp + bj * 128) = w; } }
            return;
        }
        const bool isq = col0 < 1024;
        const int head = isq ? 4 * u.pn + wc : ((col0 - 1024) >> 6) + wc;
        const float* gain = (isq ? qn : kn) + 8 * fq;
        const float scale = isq ? 0.125f * LOG2E : 1.0f;
        bf16_t* dstb = isq ? Q + head * 64 + 8 * fq : Kb + head * 64 + 8 * fq;
        const int ldd = isq ? 1024 : KW;
        f32x4 g[2][2];
#pragma unroll
        for (int bj = 0; bj < 2; ++bj)
#pragma unroll
            for (int n = 0; n < 2; ++n) g[bj][n] = *(const f32x4*)(gain + 32 * bj + 4 * n);
#pragma unroll
        for (int ai = 0; ai < 2; ++ai) if (ai == 0 || u.half < 0)
#pragma unroll
            for (int m = 0; m < 4; ++m) {
                const int row = row0 + ai * 128 + m * 16, b = row / PP, pos = row - b * PP;
                f32x4 v[2][2];
                float ss = 0.f;
#pragma unroll
                for (int bj = 0; bj < 2; ++bj)
#pragma unroll
                    for (int n = 0; n < 2; ++n) { v[bj][n] = acc[ai][bj][m][n] * ASC; ss += v[bj][n][0] * v[bj][n][0] + v[bj][n][1] * v[bj][n][1] + v[bj][n][2] * v[bj][n][2] + v[bj][n][3] * v[bj][n][3]; }
                ss += __shfl_xor(ss, 16); ss += __shfl_xor(ss, 32);
                const float rs = rsqrtf(ss * (1.0f / 64.0f) + EPS);
#pragma unroll
                for (int bj = 0; bj < 2; ++bj)
#pragma unroll
                    for (int n = 0; n < 2; ++n) v[bj][n] = v[bj][n] * rs * g[bj][n];
                if (KIND != 0 && pos < SEQ) {
                    const int prow = (pos >> 6) & 63, pcol = pos & 63;
                    const float* cs = ROPE64 + ((fq < 2 ? prow : pcol) * 16 + ((8 * fq) & 15)) * 2;
#pragma unroll
                    for (int n = 0; n < 2; ++n)
#pragma unroll
                        for (int j = 0; j < 4; ++j) {
                            const float c = cs[(4 * n + j) * 2], sn = cs[(4 * n + j) * 2 + 1], x1 = v[0][n][j], x2 = v[1][n][j];
                            v[0][n][j] = x1 * c - x2 * sn; v[1][n][j] = x2 * c + x1 * sn;
                        }
                }
                bf16_t* rowp = dstb + (size_t)row * ldd;
#pragma unroll
                for (int bj = 0; bj < 2; ++bj) { const f32x4 v0 = v[bj][0] * scale, v1 = v[bj][1] * scale;
                    u32x4 w; w.x = cvtpk(v0[0], v0[1]); w.y = cvtpk(v0[2], v0[3]); w.z = cvtpk(v1[0], v1[1]); w.w = cvtpk(v1[2], v1[3]);
                    *(u32x4*)(rowp + bj * 32) = w; }
            }
    } };
constexpr bool qkv_fp8(int kind) { return true; }
template <int KIND> struct epi_fp8<XEpiQKV<KIND>> { static constexpr int value = 2; };
template <int KIND>
DI void gemm_qkv_x(const Params& p, unsigned char* smem, const bf16_t* Wt, int N, const float* qn, const float* kn, int bid, int nb, int tid) {
    constexpr int KU = qkv_fp8(KIND) ? 512 : 1024;
    DenseSched S; S.nM = MROWS / 256; S.nN = N / 256; S.nwg = S.nM * S.nN; S.G = nb; S.c = bid; S.Bt = Wt; S.K = KU; S.lda = KU; S.skip_ctx = false;
    XEpiQKV<KIND> e{(bf16_t*)(p.ws + WS_Q), (bf16_t*)(p.ws + WS_K), (bf16_t*)(p.ws + WS_RAW), qn, kn};
    pg8::gemm_phase((lds_ptr)smem, (const bf16_t*)(p.ws + WS_H), KU, S, e, tid);
}
template <bool UQ>
struct XEpiMla {
    static constexpr bool PERM = true;
    static constexpr float ASC = 1.0f / 32.0f;
    bf16_t* Q; bf16_t* Kb; bf16_t* V; const float* qn; const float* kn;
    DI void operator()(const f32x4 (&acc)[2][2][4][2], const DenseSched::Unit& u, int wr, int wc, int fr, int fq) const {
        const int row0 = u.pm * 256 + (u.half > 0 ? 128 : 0) + wr * 64 + fr;
        if (u.pn < 4) {
            const int head = 4 * u.pn + wc;
            const float* gain = (UQ ? qn : kn) + 8 * fq;
            const float scale = UQ ? 0.10206207261596577f * LOG2E : 1.0f;
            bf16_t* dstb = (UQ ? Q : Kb) + head * 96 + 8 * fq;
            f32x4 g[2][2];
#pragma unroll
            for (int bj = 0; bj < 2; ++bj)
#pragma unroll
                for (int n = 0; n < 2; ++n) g[bj][n] = *(const f32x4*)(gain + 32 * bj + 4 * n);
#pragma unroll
            for (int ai = 0; ai < 2; ++ai) if (ai == 0 || u.half < 0)
#pragma unroll
                for (int m = 0; m < 4; ++m) {
                    const int row = row0 + ai * 128 + m * 16;
                    float ss = 0.f;
#pragma unroll
                    for (int bj = 0; bj < 2; ++bj)
#pragma unroll
                        for (int n = 0; n < 2; ++n) { const f32x4 v = acc[ai][bj][m][n] * ASC; ss += v[0] * v[0] + v[1] * v[1] + v[2] * v[2] + v[3] * v[3]; }
                    ss += __shfl_xor(ss, 16); ss += __shfl_xor(ss, 32);
                    const float rs = rsqrtf(ss * (1.0f / 64.0f) + EPS) * scale;
                    bf16_t* rowp = dstb + (size_t)row * 1536;
#pragma unroll
                    for (int bj = 0; bj < 2; ++bj) { const f32x4 v0 = acc[ai][bj][m][0] * (ASC * rs) * g[bj][0], v1 = acc[ai][bj][m][1] * (ASC * rs) * g[bj][1];
                        u32x4 w; w.x = cvtpk(v0[0], v0[1]); w.y = cvtpk(v0[2], v0[3]); w.z = cvtpk(v1[0], v1[1]); w.w = cvtpk(v1[2], v1[3]);
                        *(u32x4*)(rowp + bj * 32) = w; }
                }
        } else if (UQ) {
            const float scale = 0.10206207261596577f * LOG2E;
            const f32x4 g1 = *(const f32x4*)(qn + 64 + 4 * fq), g2 = *(const f32x4*)(qn + 64 + 16 + 4 * fq);
#pragma unroll
            for (int ai = 0; ai < 2; ++ai) if (ai == 0 || u.half < 0)
#pragma unroll
                for (int m = 0; m < 4; ++m) {
                    const int row = row0 + ai * 128 + m * 16, b = row / PP, pos = row - b * PP;
                    const int prow = (pos >> 6) & 63, pcol = pos & 63;
                    const float* cs = ROPE32 + ((fq < 2 ? prow : pcol) * 8 + ((4 * fq) & 7)) * 2;
#pragma unroll
                    for (int bj = 0; bj < 2; ++bj) {
                        f32x4 x1 = acc[ai][bj][m][0] * ASC, x2 = acc[ai][bj][m][1] * ASC;
                        float ss = x1[0] * x1[0] + x1[1] * x1[1] + x1[2] * x1[2] + x1[3] * x1[3] + x2[0] * x2[0] + x2[1] * x2[1] + x2[2] * x2[2] + x2[3] * x2[3];
                        ss += __shfl_xor(ss, 16); ss += __shfl_xor(ss, 32);
                        const float rs = rsqrtf(ss * (1.0f / 32.0f) + EPS);
                        x1 = x1 * rs * g1; x2 = x2 * rs * g2;
                        if (pos < SEQ) {
#pragma unroll
                            for (int j = 0; j < 4; ++j) { const float c = cs[2 * j], sn = cs[2 * j + 1], a1 = x1[j], a2 = x2[j]; x1[j] = a1 * c - a2 * sn; x2[j] = a2 * c + a1 * sn; }
                        }
                        x1 = x1 * scale; x2 = x2 * scale;
                        bf16_t* rowp = Q + (size_t)row * 1536 + (8 * (u.pn - 4) + 4 * bj + wc) * 96 + 64 + 4 * fq;
                        u32x2 w1, w2; w1.x = cvtpk(x1[0], x1[1]); w1.y = cvtpk(x1[2], x1[3]); w2.x = cvtpk(x2[0], x2[1]); w2.y = cvtpk(x2[2], x2[3]);
                        *(u32x2*)rowp = w1; *(u32x2*)(rowp + 16) = w2;
                    }
                }
        } else {
#pragma unroll
            for (int ai = 0; ai < 2; ++ai) if (ai == 0 || u.half < 0)
#pragma unroll
                for (int m = 0; m < 4; ++m) { bf16_t* rowp = V + (size_t)(row0 + ai * 128 + m * 16) * 1024 + (u.pn - 4) * 256 + wc * 32 + 8 * fq;
#pragma unroll
                    for (int bj = 0; bj < 2; ++bj) { const f32x4 v0 = acc[ai][bj][m][0] * ASC, v1 = acc[ai][bj][m][1] * ASC;
                        u32x4 w; w.x = cvtpk(v0[0], v0[1]); w.y = cvtpk(v0[2], v0[3]); w.z = cvtpk(v1[0], v1[1]); w.w = cvtpk(v1[2], v1[3]);
                        *(u32x4*)(rowp + bj * 128) = w; } }
        }
    } };
template <bool UQ> struct epi_fp8<XEpiMla<UQ>> { static constexpr int value = 2; };
template <bool UQ>
DI void gemm_mla_x(const Params& p, unsigned char* smem, int bid, int nb, int tid) {
    bf16_t* O = (bf16_t*)(p.ws + WS_O);
    DenseSched S; S.nM = MROWS / 256; S.nN = (UQ ? 1536 : 2048) / 256; S.nwg = S.nM * S.nN; S.G = nb; S.c = bid; S.Bt = (const bf16_t*)(p.ws + (UQ ? W_UQ : W_UKV)); S.K = UQ ? 256 : 128; S.lda = S.K; S.skip_ctx = false;
    XEpiMla<UQ> e{(bf16_t*)(p.ws + WS_Q), (bf16_t*)(p.ws + WS_K), (bf16_t*)(p.ws + WS_RAW), p.in[28], p.in[29]};
    pg8::gemm_phase((lds_ptr)smem, UQ ? O : (const bf16_t*)((const unsigned char*)O + (size_t)MROWS * 512), S.K, S, e, tid);
}
template <int EPIK>
DI void gemm_dense_x(const Params& p, unsigned char* smem, const bf16_t* A, int lda, const bf16_t* Wt, int K, int N, bf16_t* C, int ldc, const float* mod, int bid, int nb, int tid, bool skip_ctx = false) {
    DenseSched S; S.nM = skip_ctx ? NBATCH * 16 : MROWS / 256; S.nN = N / 256; S.nwg = S.nM * S.nN; S.G = nb; S.c = bid; S.Bt = Wt; S.K = K; S.lda = lda; S.skip_ctx = skip_ctx;
    if (EPIK == 0) { XEpiStore e{C, ldc}; pg8::gemm_phase((lds_ptr)smem, A, K, S, e, tid); }
    else if (EPIK == 2) { XEpiStore8 e{C, ldc}; pg8::gemm_phase((lds_ptr)smem, A, K, S, e, tid); }
    else if (EPIK == 3) { XEpiResid8 e{&p, mod}; pg8::gemm_phase((lds_ptr)smem, A, K, S, e, tid); }
    else { XEpiResid e{&p, mod}; pg8::gemm_phase((lds_ptr)smem, A, K, S, e, tid); }
}
template <int WHICH, bool TAIL>
DI void gemm_moe_call(const Params& p, unsigned char* smem, int layer, int bid, int nb, int tid) {
    MoeSched<TAIL> S; S.list = (const unsigned*)(p.ws + WS_LIST); S.zero = (const unsigned*)(p.ws + WS_CTL) + 8192; S.G = nb; S.c = bid;
    {
        LAS int* tab = (LAS int*)(smem + GEMM_LDS);
        constexpr int TNc = WHICH == 0 ? 2 : 4;
        if (tid < 64) {
            const unsigned cv = tid < 32 ? ((const unsigned*)(p.ws + WS_CTL) + CW_CNT + layer * 32)[tid] : 0u;
            int incl = (int)((cv + 255u) >> 8) * TNc;
#pragma unroll
            for (int d = 1; d < 32; d <<= 1) { const int o = __shfl_up(incl, d); if (tid >= d) incl += o; }
            if (tid < 32) { tab[1 + tid] = incl; tab[40 + tid] = (int)cv; }
            if (tid == 0) tab[0] = 0;
        }
        __syncthreads();
        S.tab = tab; S.nwg = __builtin_amdgcn_readfirstlane(tab[32]);
    }
    if (WHICH == 0) { S.W = (const bf16_t*)(p.ws + W_GU + (size_t)layer * 32 * 512 * 1024); S.K = 512; S.N = 512; S.TN = 2; S.lda = 512; S.shift = 1;
        S.place(); XEpiGlu8 e{{(bf16_t*)(p.ws + WS_Q), (const float*)(p.ws + WS_GATE)}}; pg8::gemm_phase((lds_ptr)smem, (const bf16_t*)(p.ws + WS_H), 512, S, e, tid); }
    else { S.W = (const bf16_t*)(p.ws + W_DN) + (size_t)layer * 32 * 1024 * 256; S.K = 256; S.N = 1024; S.TN = 4; S.lda = DEXP; S.shift = 0;
        S.place(); XEpiScatter e{(bf16_t*)(p.ws + WS_RAW)}; pg8::gemm_phase((lds_ptr)smem, (const bf16_t*)(p.ws + WS_Q), 256, S, e, tid); }
}
template <int WHICH>
DI void gemm_moe_x(const Params& p, unsigned char* smem, int layer, int bid, int nb, int tid) {
    const int wv = __builtin_amdgcn_readfirstlane(tid >> 6);
    gemm_moe_call<WHICH, false>(p, smem, layer, bid, nb, (wv << 6) | lane_now());
    gemm_moe_call<WHICH, true>(p, smem, layer, bid, nb, (wv << 6) | lane_now());
}

constexpr int NPHASES = 2 + (7 + 7 + 9 + 7) + 1;
constexpr int SMEM_BYTES = GEMM_LDS + 512;

template <int KIND>
DI void layer_phases(const Params& p, int& ph, const int lo, const int hi, const XcdBarrier& bar, unsigned char* smem, int bid, int nb, int wid_u) {
    constexpr int L = KIND;
    const float* mod = (const float*)(p.ws + WS_MOD) + (size_t)L * 9 * 6144;
    bf16_t* H = (bf16_t*)(p.ws + WS_H); bf16_t* O = (bf16_t*)(p.ws + WS_O); bf16_t* RAW = (bf16_t*)(p.ws + WS_RAW);
    bf16_t* Q = (bf16_t*)(p.ws + WS_Q); bf16_t* Kb = (bf16_t*)(p.ws + WS_K);
#ifndef AABL
#define AABL 0
#endif
#ifndef GPROBE
#define GPROBE 0
#endif
#ifndef DUP_MASK
#define DUP_MASK 0ull
#endif
#define PHASE2(BODY, DUPBODY) do { if (lo <= ph && ph < hi) { const int tid = (wid_u << 6) | lane_now(); if ((DUP_MASK >> ph) & 1ull) { DUPBODY; xcd_barrier(bar, tid == 0); } BODY; } if (lo <= ph && ph + 1 < hi) xcd_barrier(bar, ((wid_u << 6) | lane_now()) == 0); ++ph; } while (0)
#define PHASE(...) PHASE2((__VA_ARGS__), (__VA_ARGS__))
    if (L == 0) PHASE(phase_rows<2 | 8 | 32>(p, L, 0, bid, nb, tid), phase_router_prep(p, bid, nb, tid));
    else PHASE2((phase_rows<3 | 32>(p, L, 0, bid, nb, tid)), (phase_rows<2 | 32>(p, L, 0, bid, nb, tid)));
    AttnP a{};
    if (KIND == 0) {
        PHASE(gemm_qkv_x<0>(p, smem, (const bf16_t*)(p.ws + W_QKV0), 3072, p.in[15], p.in[16], bid, nb, tid));
        a = AttnP{Q, 1024, Kb, 1024, RAW + 2048, 3072, O, 1024, 16, 0, 0, 64, p.in[17], nullptr, 1, p.in[16]};
        PHASE(attn_na(a, smem, bid, nb, tid));
        PHASE2((gemm_dense_x<3>(p, smem, O, 512, (const bf16_t*)(p.ws + W_O0), 512, 1024, nullptr, 0, mod, bid, nb, tid)), (gemm_dense_x<0>(p, smem, O, 1024, (const bf16_t*)(p.ws + W_O0), 1024, 1024, RAW, 1024, nullptr, bid, nb, tid)));
    } else if (KIND == 1) {
        PHASE(gemm_qkv_x<1>(p, smem, (const bf16_t*)(p.ws + W_QKV1), 1536, p.in[20], p.in[21], bid, nb, tid));
        a = AttnP{Q, 1024, Kb, 256, RAW + 1280, 1536, O, 1024, 16, 2, 2, 64, nullptr, p.in[22], 1};
        PHASE(attn_mfma<64, 64, 1>(a, smem, bid, nb, tid));
        PHASE2((gemm_dense_x<3>(p, smem, O, 512, (const bf16_t*)(p.ws + W_O1), 512, 1024, nullptr, 0, mod, bid, nb, tid)), (gemm_dense_x<0>(p, smem, O, 1024, (const bf16_t*)(p.ws + W_O1), 1024, 1024, RAW, 1024, nullptr, bid, nb, tid)));
    } else if (KIND == 2) {
        bf16_t* cqn = O; bf16_t* ckvn = O + (size_t)MROWS * 384;
        PHASE(gemm_dense_x<2>(p, smem, H, 512, (const bf16_t*)(p.ws + W_DQKV), 512, 768, Q, 768, nullptr, bid, nb, tid));
        PHASE(phase_post_mla1(p, bid, nb, tid));
        PHASE(gemm_mla_x<true>(p, smem, bid, nb, tid), gemm_mla_x<false>(p, smem, bid, nb, (wid_u << 6) | lane_now()));
        a = AttnP{Q, 1536, Kb, 1536, RAW, 1024, O, 1024, 16, 0, 0, 64, nullptr, nullptr, 1};
        PHASE(attn_mfma<96, 64, 2>(a, smem, bid, nb, tid));
        PHASE2((gemm_dense_x<3>(p, smem, O, 512, (const bf16_t*)(p.ws + W_O2), 512, 1024, nullptr, 0, mod, bid, nb, tid)), (gemm_dense_x<0>(p, smem, O, 1024, (const bf16_t*)(p.ws + W_O2), 1024, 1024, RAW, 1024, nullptr, bid, nb, tid)));
    } else {
        PHASE(gemm_qkv_x<3>(p, smem, (const bf16_t*)(p.ws + W_QKV3), 3072, p.in[32], p.in[33], bid, nb, tid));
        a = AttnP{Q, 1024, Kb, 1024, RAW + 2048, 3072, H  , 2048, 16, 0, 1, 128, nullptr, nullptr, 0, nullptr, p.in[34], p.in[35], (unsigned char*)RAW  , 6144};
        PHASE(attn_mfma<64, 128, 2>(a, smem, bid, nb, tid));
        PHASE(gemm_dense_x<3>(p, smem, RAW, 3072, (const bf16_t*)(p.ws + W_O3), 512, 1024, nullptr, 0, mod, bid, nb, tid, true));
    }
    PHASE(phase_router(p, smem, L, L == 3, bid, nb, tid));
    PHASE(gemm_moe_x<0>(p, smem, L, bid, nb, tid));
    PHASE(gemm_moe_x<1>(p, smem, L, bid, nb, tid));
}

__global__ void __launch_bounds__(NTHREADS, 2) mega(Params p, int lo, int hi) {
    extern __shared__ __attribute__((aligned(16))) unsigned char smem[];
    const int bid = blockIdx.x, nb = gridDim.x, wid_u = __builtin_amdgcn_readfirstlane(threadIdx.x >> 6);
    float* lds = (float*)smem;
    volatile LAS unsigned* xbw = (volatile LAS unsigned*)(smem + SMEM_BYTES - 16);
    if (threadIdx.x == 0) { xbw[0] = 0u; xbw[1] = 0u; }
    __syncthreads();
    XcdBarrier bar = xcd_barrier_post((unsigned*)(p.ws + WS_CTL), xbw);
    int ph = 0;
    PHASE(phase_prologue(p, lds, bid, nb, tid));
    PHASE(phase_mod_reduce(p, bid, nb, tid));
    layer_phases<0>(p, ph, lo, hi, bar, smem, bid, nb, wid_u);
    layer_phases<1>(p, ph, lo, hi, bar, smem, bid, nb, wid_u);
    layer_phases<2>(p, ph, lo, hi, bar, smem, bid, nb, wid_u);
    layer_phases<3>(p, ph, lo, hi, bar, smem, bid, nb, wid_u);
    PHASE2((phase_rows<1 | 16>(p, 3, 0, bid, nb, tid)), (void)0);
}

extern "C" void kernel_launch(void* const* d_in, const int* in_sizes, int n_in, void* d_out, int out_size, void* d_ws, size_t ws_size, hipStream_t stream) {
    (void)in_sizes; (void)out_size;
    if (n_in < 37 || ws_size < WS_END) { fprintf(stderr, "kernel_launch: unexpected inputs (n_in %d, ws %zu)\n", n_in, ws_size); return; }
    static int grid = 0;
    if (!grid) {
        int dev = 0, cus = 0, per_cu = 0;
        hipGetDevice(&dev);
        hipDeviceGetAttribute(&cus, hipDeviceAttributeMultiprocessorCount, dev);
        hipFuncSetAttribute((const void*)mega, hipFuncAttributeMaxDynamicSharedMemorySize, SMEM_BYTES);
        hipOccupancyMaxActiveBlocksPerMultiprocessor(&per_cu, mega, NTHREADS, SMEM_BYTES);
        if (per_cu < 1) per_cu = 1;
        grid = cus * (per_cu < 1 ? per_cu : 1);
    }
    Params p{};
    for (int i = 0; i < 37; ++i) p.in[i] = (const float*)d_in[i];
    p.out = (float*)d_out; p.ws = (unsigned char*)d_ws;
    hipMemsetAsync(p.ws + WS_CTL, 0, 65536, stream);
#if ONE_LAUNCH
    hipLaunchKernelGGL(mega, dim3(grid), dim3(NTHREADS), SMEM_BYTES, stream, p, 0, NPHASES);
#else
    for (int k = 0; k < NPHASES; ++k) hipLaunchKernelGGL(mega, dim3(grid), dim3(NTHREADS), SMEM_BYTES, stream, p, k, k + 1);
#endif
}
```

```cpp
#include <hip/hip_runtime.h>
#include <stdint.h>
#include <stdio.h>

#ifndef ONE_LAUNCH
#define ONE_LAUNCH 1
#endif

#define DI __device__ __forceinline__
typedef unsigned short bf16_t;
typedef short bf16x8 __attribute__((ext_vector_type(8)));
typedef float f32x4 __attribute__((ext_vector_type(4)));
typedef float f32x16 __attribute__((ext_vector_type(16)));
typedef unsigned u32x4 __attribute__((ext_vector_type(4)));
typedef unsigned u32x2 __attribute__((ext_vector_type(2)));

constexpr int DM = 1024, NBATCH = 8, SEQ = 4096, CTXL = 256, PP = SEQ + CTXL, MROWS = NBATCH * PP;
constexpr int NEXP = 32, DEXP = 256;
constexpr float EPS = 1e-6f, LOG2E = 1.4426950408889634f;
constexpr int NTHREADS = 512, NW = NTHREADS / 64;

constexpr size_t MiB = 1ull << 20;
constexpr size_t WS_RAW_FWD = 380ull << 20;
constexpr size_t WS_CTL = 0, CTL_BYTES = 1 * MiB;
constexpr size_t WS_MOD = 1 * MiB;
constexpr size_t WS_MODP = WS_RAW_FWD;
constexpr size_t WS_XCTX = 9 * MiB;
constexpr size_t WS_LIST = 17 * MiB;
constexpr size_t WS_GATE = 22 * MiB;
constexpr size_t WS_W = 24 * MiB;
constexpr size_t W_QKV0 = WS_W + 0 * MiB, W_O0 = WS_W + 6 * MiB, W_QKV1 = WS_W + 8 * MiB, W_O1 = WS_W + 11 * MiB, W_DQKV = WS_W + 13 * MiB,
                 W_UQ = WS_W + 15 * MiB, W_UKV = WS_W + 17 * MiB, W_O2 = WS_W + 18 * MiB, W_QKV3 = WS_W + 20 * MiB, W_O3 = WS_W + 26 * MiB,
                 W_GU = WS_W + 28 * MiB, W_DN = WS_W + 156 * MiB;
constexpr size_t WS_H = 244 * MiB;
constexpr size_t WS_O = 312 * MiB;
constexpr size_t WS_RAW = 380 * MiB;
constexpr size_t WS_Q = 620 * MiB;
constexpr size_t WS_K = 722 * MiB;
constexpr size_t WS_XB = 824 * MiB;
constexpr size_t WS_END = 892 * MiB;
constexpr int CW_CNT = 4096;

constexpr size_t WS_RW = 2 * MiB;
struct Params { const float* in[37]; float* out; unsigned char* ws; };

DI unsigned f2bf(float f) { unsigned u = __float_as_uint(f); return (u + 0x7fffu + ((u >> 16) & 1u)) >> 16; }
DI float bf2f(unsigned h) { return __uint_as_float(h << 16); }
DI unsigned pk2(float lo, float hi) { return f2bf(lo) | (f2bf(hi) << 16); }
DI float bflo(unsigned w) { return __uint_as_float(w << 16); }
DI float bfhi(unsigned w) { return __uint_as_float(w & 0xffff0000u); }
DI int lane_now() { unsigned lane; asm volatile("v_mbcnt_lo_u32_b32 %0, -1, 0\n\tv_mbcnt_hi_u32_b32 %0, -1, %0" : "=v"(lane)); return (int)lane; }
DI float wave_sum(float v) {
#pragma unroll
    for (int o = 32; o > 0; o >>= 1) v += __shfl_xor(v, o);
    return v;
}
DI float silu_f(float x) { return x / (1.0f + __expf(-x)); }
DI void unpack8(const u32x4 w, float (&f)[8]) {
    f[0] = bflo(w.x); f[1] = bfhi(w.x); f[2] = bflo(w.y); f[3] = bfhi(w.y); f[4] = bflo(w.z); f[5] = bfhi(w.z); f[6] = bflo(w.w); f[7] = bfhi(w.w);
}
DI u32x4 pack8(const float (&f)[8]) { u32x4 w; w.x = pk2(f[0], f[1]); w.y = pk2(f[2], f[3]); w.z = pk2(f[4], f[5]); w.w = pk2(f[6], f[7]); return w; }
DI float* xrow_ptr(const Params& p, int r) {
    const int b = r / PP, pos = r - b * PP;
    return pos < SEQ ? p.out + ((size_t)b * SEQ + pos) * DM : (float*)(p.ws + WS_XCTX) + ((size_t)b * CTXL + (pos - SEQ)) * DM;
}
DI bf16_t* xb_row(const Params& p, int r) { return (bf16_t*)(p.ws + WS_XB) + (size_t)r * DM; }
DI int mod_row(int r) { const int b = r / PP, pos = r - b * PP; return pos < SEQ ? b : 8; }
__device__ const float ROPE64[2048] = {
  1.000000000e+00f, 0.000000000e+00f, 1.000000000e+00f, 0.000000000e+00f, 1.000000000e+00f, 0.000000000e+00f, 1.000000000e+00f, 0.000000000e+00f,
  1.000000000e+00f, 0.000000000e+00f, 1.000000000e+00f, 0.000000000e+00f, 1.000000000e+00f, 0.000000000e+00f, 1.000000000e+00f, 0.000000000e+00f,
  1.000000000e+00f, 0.000000000e+00f, 1.000000000e+00f, 0.000000000e+00f, 1.000000000e+00f, 0.000000000e+00f, 1.000000000e+00f, 0.000000000e+00f,
  1.000000000e+00f, 0.000000000e+00f, 1.000000000e+00f, 0.000000000e+00f, 1.000000000e+00f, 0.000000000e+00f, 1.000000000e+00f, 0.000000000e+00f,
  5.403022766e-01f, 8.414709568e-01f, 8.460091352e-01f, 5.331684351e-01f, 9.504152536e-01f, 3.109835982e-01f, 9.842302203e-01f, 1.768921912e-01f,
  9.950041771e-01f, 9.983342141e-02f, 9.984192848e-01f, 5.620449781e-02f, 9.995000362e-01f, 3.161750361e-02f, 9.998418689e-01f, 1.778185740e-02f,
  9.999499917e-01f, 9.999833070e-03f, 9.999842048e-01f, 5.623383448e-03f, 9.999949932e-01f, 3.162272274e-03f, 9.999983907e-01f, 1.778278500e-03f,
  9.999995232e-01f, 9.999999311e-04f, 9.999998212e-01f, 5.623412435e-04f, 9.999999404e-01f, 3.162277571e-04f, 1.000000000e+00f, 1.778279402e-04f,
  -4.161468446e-01f, 9.092974067e-01f, 4.314628243e-01f, 9.021307230e-01f, 8.065783978e-01f, 5.911270976e-01f, 9.374182820e-01f, 3.482052684e-01f,
  9.800665975e-01f, 1.986693293e-01f, 9.936820865e-01f, 1.122313142e-01f, 9.980006814e-01f, 6.320339441e-02f, 9.993675947e-01f, 3.555808961e-02f,
  9.998000264e-01f, 1.999866590e-02f, 9.999367595e-01f, 1.124658901e-02f, 9.999799728e-01f, 6.324512884e-03f, 9.999936819e-01f, 3.556551412e-03f,
  9.999979734e-01f, 1.999998698e-03f, 9.999993443e-01f, 1.124682371e-03f, 9.999998212e-01f, 6.324554561e-04f, 9.999999404e-01f, 3.556558804e-04f,
  -9.899924994e-01f, 1.411200017e-01f, -1.159661636e-01f, 9.932531714e-01f, 5.827536583e-01f, 8.126488924e-01f, 8.610406518e-01f, 5.085361004e-01f,
  9.553365111e-01f, 2.955202162e-01f, 9.858034849e-01f, 1.679033041e-01f, 9.955033660e-01f, 9.472608566e-02f, 9.985772967e-01f, 5.332308263e-02f,
  9.995500445e-01f, 2.999549918e-02f, 9.998577237e-01f, 1.686943881e-02f, 9.999549985e-01f, 9.486690164e-03f, 9.999857545e-01f, 5.334813148e-03f,
  9.999955297e-01f, 2.999995602e-03f, 9.999985695e-01f, 1.687023090e-03f, 9.999995232e-01f, 9.486831259e-04f, 9.999998808e-01f, 5.334838061e-04f,
  -6.536436081e-01f, -7.568024993e-01f, -6.276797056e-01f, 7.784717083e-01f, 3.011374772e-01f, 9.535807371e-01f, 7.575061917e-01f, 6.528279781e-01f,
  9.210609794e-01f, 3.894183338e-01f, 9.748082757e-01f, 2.230444849e-01f, 9.920106530e-01f, 1.261540651e-01f, 9.974712729e-01f, 7.107120752e-02f,
  9.992001057e-01f, 3.998933360e-02f, 9.997470379e-01f, 2.249175683e-02f, 9.999200106e-01f, 1.264877338e-02f, 9.999747276e-01f, 7.113057654e-03f,
  9.999920130e-01f, 3.999989480e-03f, 9.999974966e-01f, 2.249363344e-03f, 9.999992251e-01f, 1.264910679e-03f, 9.999997616e-01f, 7.113117026e-04f,
  2.836622000e-01f, -9.589242935e-01f, -9.460792542e-01f, 3.239352703e-01f, -1.034233812e-02f, 9.999465346e-01f, 6.300802827e-01f, 7.765299678e-01f,
  8.775825500e-01f, 4.794255495e-01f, 9.607312679e-01f, 2.774805427e-01f, 9.875259995e-01f, 1.574558765e-01f, 9.960497618e-01f, 8.879686147e-02f,
  9.987502694e-01f, 4.997916520e-02f, 9.996047616e-01f, 2.811336145e-02f, 9.998750091e-01f, 1.581072807e-02f, 9.999604821e-01f, 8.891279809e-03f,
  9.999874830e-01f, 4.999979399e-03f, 9.999960661e-01f, 2.811702900e-03f, 9.999987483e-01f, 1.581138116e-03f, 9.999995828e-01f, 8.891395992e-04f,
  9.601702690e-01f, -2.794154882e-01f, -9.731037021e-01f, -2.303675115e-01f, -3.207964003e-01f, 9.471482038e-01f, 4.827820361e-01f, 8.757405281e-01f,
  8.253356218e-01f, 5.646424890e-01f, 9.436169863e-01f, 3.310393095e-01f, 9.820539355e-01f, 1.886002719e-01f, 9.943132997e-01f, 1.064944416e-01f,
  9.982005358e-01f, 5.996400490e-02f, 9.994308352e-01f, 3.373407945e-02f, 9.998199940e-01f, 1.897252724e-02f, 9.999430776e-01f, 1.066947449e-02f,
  9.999819994e-01f, 5.999964196e-03f, 9.999943376e-01f, 3.374041524e-03f, 9.999982119e-01f, 1.897365320e-03f, 9.999994040e-01f, 1.066967379e-03f,
  7.539022565e-01f, 6.569865942e-01f, -7.004297972e-01f, -7.137212753e-01f, -5.994374752e-01f, 8.004215956e-01f, 3.202570081e-01f, 9.473307133e-01f,
  7.648422122e-01f, 6.442176700e-01f, 9.235194325e-01f, 3.835515678e-01f, 9.755998850e-01f, 2.195560932e-01f, 9.922624230e-01f, 1.241583377e-01f,
  9.975510240e-01f, 6.994284689e-02f, 9.992253184e-01f, 3.935372457e-02f, 9.997550249e-01f, 2.213413455e-02f, 9.999225140e-01f, 1.244763471e-02f,
  9.999755025e-01f, 6.999942940e-03f, 9.999922514e-01f, 3.936378751e-03f, 9.999975562e-01f, 2.213592408e-03f, 9.999992251e-01f, 1.244795276e-03f,
  -1.455000341e-01f, 9.893582463e-01f, -2.120364457e-01f, -9.772617817e-01f, -8.186324239e-01f, 5.743177533e-01f, 1.476312131e-01f, 9.890424609e-01f,
  6.967067122e-01f, 7.173560858e-01f, 9.005023241e-01f, 4.348512292e-01f, 9.681702852e-01f, 2.502923310e-01f, 9.898977876e-01f, 1.417829692e-01f,
  9.968017340e-01f, 7.991468906e-02f, 9.989882708e-01f, 4.497213289e-02f, 9.996800423e-01f, 2.529552206e-02f, 9.998987913e-01f, 1.422575582e-02f,
  9.999679923e-01f, 7.999914698e-03f, 9.999898672e-01f, 4.498715047e-03f, 9.999967813e-01f, 2.529819263e-03f, 9.999989867e-01f, 1.422623056e-03f,
  -9.111302495e-01f, 4.121184945e-01f, 3.416602612e-01f, -9.398235083e-01f, -9.566441774e-01f, 2.912592292e-01f, -2.965079620e-02f, 9.995602965e-01f,
  6.216099262e-01f, 7.833269238e-01f, 8.746382594e-01f, 4.847761393e-01f, 9.597726464e-01f, 2.807783186e-01f, 9.872201085e-01f, 1.593627781e-01f,
  9.959527254e-01f, 8.987854421e-02f, 9.987195730e-01f, 5.058911815e-02f, 9.995950460e-01f, 2.845665626e-02f, 9.998719096e-01f, 1.600383036e-02f,
  9.999595284e-01f, 8.999879472e-03f, 9.999871850e-01f, 5.061050411e-03f, 9.999959469e-01f, 2.846045885e-03f, 9.999987483e-01f, 1.600450720e-03f,
  -8.390715122e-01f, -5.440211296e-01f, 7.901318669e-01f, -6.129369140e-01f, -9.997860789e-01f, -2.068356983e-02f, -2.059976310e-01f, 9.785524607e-01f,
  5.403022766e-01f, 8.414709568e-01f, 8.460091352e-01f, 5.331684351e-01f, 9.504153132e-01f, 3.109835684e-01f, 9.842302203e-01f, 1.768921912e-01f,
  9.950041771e-01f, 9.983341396e-02f, 9.984192848e-01f, 5.620449781e-02f, 9.995000362e-01f, 3.161750361e-02f, 9.998418689e-01f, 1.778185740e-02f,
  9.999499917e-01f, 9.999834001e-03f, 9.999842048e-01f, 5.623383448e-03f, 9.999949932e-01f, 3.162272274e-03f, 9.999983907e-01f, 1.778278500e-03f,
  4.425697960e-03f, -9.999902248e-01f, 9.952573776e-01f, -9.727645665e-02f, -9.437797666e-01f, -3.305749595e-01f, -3.758473992e-01f, 9.266815782e-01f,
  4.535960853e-01f, 8.912073970e-01f, 8.147053123e-01f, 5.798751712e-01f, 9.401075840e-01f, 3.408778608e-01f, 9.809291363e-01f, 1.943656504e-01f,
  9.939560890e-01f, 1.097782999e-01f, 9.980874062e-01f, 6.181810424e-02f, 9.993950725e-01f, 3.477803990e-02f, 9.998086691e-01f, 1.955982670e-02f,
  9.999395013e-01f, 1.099977922e-02f, 9.999808669e-01f, 6.185714621e-03f, 9.999939203e-01f, 3.478498431e-03f, 9.999980927e-01f, 1.956106164e-03f,
  8.438539505e-01f, -5.365729332e-01f, 8.938615918e-01f, 4.483429790e-01f, -7.941793799e-01f, -6.076834202e-01f, -5.338430405e-01f, 8.455836177e-01f,
  3.623577058e-01f, 9.320390821e-01f, 7.808259130e-01f, 6.247486472e-01f, 9.288598895e-01f, 3.704313040e-01f, 9.773178697e-01f, 2.117776722e-01f,
  9.928086400e-01f, 1.197122037e-01f, 9.977239966e-01f, 6.742975861e-02f, 9.992800951e-01f, 3.793822229e-02f, 9.997723103e-01f, 2.133773454e-02f,
  9.999279976e-01f, 1.199971233e-02f, 9.999772310e-01f, 6.748044398e-03f, 9.999927878e-01f, 3.794723889e-03f, 9.999977350e-01f, 2.133933594e-03f,
  9.074468017e-01f, 4.201670289e-01f, 5.171728730e-01f, 8.558809757e-01f, -5.658205152e-01f, -8.245284557e-01f, -6.750016809e-01f, 7.378162146e-01f,
  2.674987614e-01f, 9.635581970e-01f, 7.444779873e-01f, 6.676470041e-01f, 9.166833758e-01f, 3.996143043e-01f, 9.733975530e-01f, 2.291227132e-01f,
  9.915618896e-01f, 1.296341419e-01f, 9.973290563e-01f, 7.303927839e-02f, 9.991551042e-01f, 4.109803215e-02f, 9.997327924e-01f, 2.311557345e-02f,
  9.999154806e-01f, 1.299963426e-02f, 9.999732971e-01f, 7.310371846e-03f, 9.999915361e-01f, 4.110949114e-03f, 9.999973178e-01f, 2.311761025e-03f,
  1.367372125e-01f, 9.906073809e-01f, -1.879615150e-02f, 9.998233318e-01f, -2.813494802e-01f, -9.596053958e-01f, -7.948709130e-01f, 6.067785621e-01f,
  1.699671596e-01f, 9.854497313e-01f, 7.057763934e-01f, 7.084347010e-01f, 9.035902619e-01f, 4.283977747e-01f, 9.691694379e-01f, 2.463953048e-01f,
  9.902160168e-01f, 1.395431161e-01f, 9.969025850e-01f, 7.864648104e-02f, 9.990201592e-01f, 4.425742477e-02f, 9.996901155e-01f, 2.489333972e-02f,
  9.999020100e-01f, 1.399954315e-02f, 9.999690056e-01f, 7.872696966e-03f, 9.999902248e-01f, 4.427174106e-03f, 9.999969006e-01f, 2.489588689e-03f,
  -7.596879005e-01f, 6.502878666e-01f, -5.489754677e-01f, 8.358384371e-01f, 3.102235124e-02f, -9.995186925e-01f, -8.896704316e-01f, 4.566032588e-01f,
  7.073719800e-02f, 9.974949956e-01f, 6.648434997e-01f, 7.469826341e-01f, 8.895936012e-01f, 4.567528665e-01f, 9.646348357e-01f, 2.635899782e-01f,
  9.887710810e-01f, 1.494381279e-01f, 9.964445233e-01f, 8.425120264e-02f, 9.988752007e-01f, 4.741638154e-02f, 9.996442795e-01f, 2.667102963e-02f,
  9.998875260e-01f, 1.499943808e-02f, 9.999644160e-01f, 8.435020223e-03f, 9.999887347e-01f, 4.743398633e-03f, 9.999964237e-01f, 2.667415887e-03f,
  -9.576594830e-01f, -2.879033089e-01f, -9.100810885e-01f, 4.144302309e-01f, 3.403181732e-01f, -9.403103590e-01f, -9.564100504e-01f, 2.920270860e-01f,
  -2.919954620e-02f, 9.995735884e-01f, 6.218088269e-01f, 7.831690907e-01f, 8.747074604e-01f, 4.846512377e-01f, 9.597951770e-01f, 2.807013094e-01f,
  9.872272611e-01f, 1.593182087e-01f, 9.959549904e-01f, 8.985326439e-02f, 9.987202883e-01f, 5.057485774e-02f, 9.995952845e-01f, 2.844863199e-02f,
  9.998720288e-01f, 1.599931903e-02f, 9.999595284e-01f, 8.997339755e-03f, 9.999871850e-01f, 5.059622694e-03f, 9.999959469e-01f, 2.845243318e-03f,
  -2.751633525e-01f, -9.613974690e-01f, -9.908979535e-01f, -1.346151382e-01f, 6.158648133e-01f, -7.878518701e-01f, -9.929850101e-01f, 1.182405204e-01f,
  -1.288445443e-01f, 9.916648269e-01f, 5.768082738e-01f, 8.168795705e-01f, 8.589466810e-01f, 5.120649934e-01f, 9.546520114e-01f, 2.977238595e-01f,
  9.855847955e-01f, 1.691823453e-01f, 9.954339862e-01f, 9.545248002e-02f, 9.985553622e-01f, 5.373282731e-02f, 9.995430708e-01f, 3.022614494e-02f,
  9.998555183e-01f, 1.699918136e-02f, 9.999542832e-01f, 9.559656493e-03f, 9.999855757e-01f, 5.375845823e-03f, 9.999954104e-01f, 3.023070283e-03f,
  6.603167057e-01f, -7.509872317e-01f, -7.665365338e-01f, -6.422007084e-01f, 8.303361535e-01f, -5.572628975e-01f, -9.982416630e-01f, -5.927551910e-02f,
  -2.272021621e-01f, 9.738476276e-01f, 5.299841762e-01f, 8.480075598e-01f, 8.423270583e-01f, 5.389667153e-01f, 9.492070079e-01f, 3.146522641e-01f,
  9.838436842e-01f, 1.790295690e-01f, 9.948815107e-01f, 1.010486856e-01f, 9.983804226e-01f, 5.689026415e-02f, 9.994877577e-01f, 3.200356290e-02f,
  9.998379946e-01f, 1.799902879e-02f, 9.999487996e-01f, 1.012197044e-02f, 9.999837875e-01f, 5.692068953e-03f, 9.999948740e-01f, 3.200897481e-03f,
  9.887046218e-01f, 1.498772055e-01f, -3.060953915e-01f, -9.520008564e-01f, 9.624637961e-01f, -2.714101076e-01f, -9.720142484e-01f, -2.349217981e-01f,
  -3.232895434e-01f, 9.463000894e-01f, 4.814845920e-01f, 8.764545321e-01f, 8.248651624e-01f, 5.653295517e-01f, 9.434618354e-01f, 3.314811885e-01f,
  9.820042253e-01f, 1.888588965e-01f, 9.942975044e-01f, 1.066416800e-01f, 9.981955290e-01f, 6.004713103e-02f, 9.994292855e-01f, 3.378088027e-02f,
  9.998195171e-01f, 1.899885759e-02f, 9.999428988e-01f, 1.068428159e-02f, 9.999819398e-01f, 6.008291151e-03f, 9.999942780e-01f, 3.378724447e-03f,
  4.080820680e-01f, 9.129452705e-01f, 2.486167252e-01f, -9.686019421e-01f, 9.991443753e-01f, 4.135828838e-02f, -9.151299596e-01f, -4.031589925e-01f,
  -4.161468446e-01f, 9.092974067e-01f, 4.314628243e-01f, 9.021307230e-01f, 8.065784574e-01f, 5.911270380e-01f, 9.374182820e-01f, 3.482052684e-01f,
  9.800665975e-01f, 1.986693144e-01f, 9.936820865e-01f, 1.122313142e-01f, 9.980006814e-01f, 6.320339441e-02f, 9.993675947e-01f, 3.555808961e-02f,
  9.998000264e-01f, 1.999866776e-02f, 9.999367595e-01f, 1.124658901e-02f, 9.999799728e-01f, 6.324512884e-03f, 9.999936819e-01f, 3.556551412e-03f,
  -5.477292538e-01f, 8.366556168e-01f, 7.267602682e-01f, -6.868911982e-01f, 9.367404580e-01f, 3.500247598e-01f, -8.293829560e-01f, -5.586805344e-01f,
  -5.048462152e-01f, 8.632093072e-01f, 3.800770044e-01f, 9.249548316e-01f, 7.874851823e-01f, 6.163335443e-01f, 9.310783744e-01f, 3.648192585e-01f,
  9.780309200e-01f, 2.084598988e-01f, 9.930352569e-01f, 1.178173944e-01f, 9.977958202e-01f, 6.635902822e-02f, 9.993028045e-01f, 3.733518720e-02f,
  9.997795224e-01f, 2.099845745e-02f, 9.999302626e-01f, 1.180889271e-02f, 9.999779463e-01f, 6.640734151e-03f, 9.999930263e-01f, 3.734378144e-03f,
  -9.999608397e-01f, -8.851309307e-03f, 9.810745716e-01f, -1.936302334e-01f, 7.814403772e-01f, 6.239799261e-01f, -7.174774408e-01f, -6.965817213e-01f,
  -5.885011554e-01f, 8.084963560e-01f, 3.274895847e-01f, 9.448547959e-01f, 7.676045895e-01f, 6.409237385e-01f, 9.244439602e-01f, 3.813178837e-01f,
  9.758974314e-01f, 2.182296216e-01f, 9.923570156e-01f, 1.233997419e-01f, 9.975810051e-01f, 6.951400638e-02f, 9.992348552e-01f, 3.911216930e-02f,
  9.997580051e-01f, 2.199822664e-02f, 9.999234676e-01f, 1.237119269e-02f, 9.999758005e-01f, 6.956954487e-03f, 9.999923706e-01f, 3.912204877e-03f,
  -5.328330398e-01f, -8.462204337e-01f, 9.332357645e-01f, 3.592645228e-01f, 5.486452579e-01f, 8.360552788e-01f, -5.829432607e-01f, -8.125128746e-01f,
  -6.662759781e-01f, 7.457052469e-01f, 2.738668323e-01f, 9.617676139e-01f, 7.469564080e-01f, 6.648730636e-01f, 9.175173044e-01f, 3.976959288e-01f,
  9.736663699e-01f, 2.279775143e-01f, 9.916474223e-01f, 1.289781928e-01f, 9.973561764e-01f, 7.266827673e-02f, 9.991636872e-01f, 4.088902473e-02f,
  9.997355342e-01f, 2.299797349e-02f, 9.999163747e-01f, 1.293348987e-02f, 9.999735355e-01f, 7.273174357e-03f, 9.999916553e-01f, 4.090031609e-03f,
  4.241790175e-01f, -9.055783749e-01f, 5.979771614e-01f, 8.015131354e-01f, 2.614416778e-01f, 9.652192593e-01f, -4.300232828e-01f, -9.028177857e-01f,
  -7.373937964e-01f, 6.754631400e-01f, 2.193782777e-01f, 9.756398797e-01f, 7.255613208e-01f, 6.881574988e-01f, 9.103004336e-01f, 4.139482081e-01f,
  9.713379741e-01f, 2.377026230e-01f, 9.909064770e-01f, 1.345525682e-01f, 9.971213937e-01f, 7.582182437e-02f, 9.990894198e-01f, 4.266574979e-02f,
  9.997119904e-01f, 2.399769612e-02f, 9.999089241e-01f, 1.349578146e-02f, 9.999712110e-01f, 7.589393295e-03f, 9.999908805e-01f, 4.267857410e-03f,
  9.912028313e-01f, -1.323517561e-01f, 7.855226099e-02f, 9.969099760e-01f, -5.168933049e-02f, 9.986631870e-01f, -2.635405958e-01f, -9.646483064e-01f,
  -8.011435866e-01f, 5.984721184e-01f, 1.641961634e-01f, 9.864277244e-01f, 7.034407258e-01f, 7.107539177e-01f, 9.027957320e-01f, 4.300695956e-01f,
  9.689124227e-01f, 2.474039644e-01f, 9.901341200e-01f, 1.401226968e-01f, 9.968766570e-01f, 7.897461206e-02f, 9.990119338e-01f, 4.444234073e-02f,
  9.996874928e-01f, 2.499739639e-02f, 9.999011755e-01f, 1.405806933e-02f, 9.999687672e-01f, 7.905611768e-03f, 9.999901056e-01f, 4.445684142e-03f,
  6.469193101e-01f, 7.625584602e-01f, -4.650644958e-01f, 8.852767944e-01f, -3.596943319e-01f, 9.330701828e-01f, -8.874550462e-02f, -9.960543513e-01f,
  -8.568888307e-01f, 5.155012608e-01f, 1.084949449e-01f, 9.940969944e-01f, 6.806167960e-01f, 7.326396108e-01f, 8.950055838e-01f, 4.460549951e-01f,
  9.663899541e-01f, 2.570805550e-01f, 9.893305302e-01f, 1.456883848e-01f, 9.966219068e-01f, 8.212661743e-02f, 9.989313483e-01f, 4.621879384e-02f,
  9.996620417e-01f, 2.599707060e-02f, 9.998931289e-01f, 1.462035347e-02f, 9.999662042e-01f, 8.221829310e-03f, 9.999893308e-01f, 4.623509943e-03f,
  -2.921388149e-01f, 9.563759565e-01f, -8.654506207e-01f, 5.009942055e-01f, -6.320286393e-01f, 7.749450207e-01f, 8.884811401e-02f, -9.960451722e-01f,
  -9.040721655e-01f, 4.273798466e-01f, 5.245061591e-02f, 9.986234903e-01f, 6.571123004e-01f, 7.537927032e-01f, 8.869323730e-01f, 4.618993104e-01f,
  9.637709260e-01f, 2.667314112e-01f, 9.884956479e-01f, 1.512494683e-01f, 9.963572025e-01f, 8.527779579e-02f, 9.988475442e-01f, 4.799510166e-02f,
  9.996355176e-01f, 2.699672058e-02f, 9.998847246e-01f, 1.518263202e-02f, 9.999635220e-01f, 8.538045920e-03f, 9.999884963e-01f, 4.801335745e-03f,
  -9.626058936e-01f, 2.709057927e-01f, -9.992933869e-01f, -3.758566082e-02f, -8.416849375e-01f, 5.399689674e-01f, 2.636395097e-01f, -9.646213055e-01f,
  -9.422222972e-01f, 3.349882066e-01f, -3.759419080e-03f, 9.999929070e-01f, 6.329506636e-01f, 7.741920948e-01f, 8.785787225e-01f, 4.775975943e-01f,
  9.610554576e-01f, 2.763556540e-01f, 9.876294732e-01f, 1.568057537e-01f, 9.960825443e-01f, 8.842811733e-02f, 9.987606406e-01f, 4.977125302e-02f,
  9.996080399e-01f, 2.799634263e-02f, 9.998760223e-01f, 1.574490592e-02f, 9.999607801e-01f, 8.854261599e-03f, 9.999876022e-01f, 4.979162011e-03f,
  -7.480575442e-01f, -6.636338830e-01f, -8.253716230e-01f, -5.645897985e-01f, -9.678714871e-01f, 2.514453232e-01f, 4.301158488e-01f, -9.027736783e-01f,
  -9.709581733e-01f, 2.392492294e-01f, -5.995756760e-02f, 9.982009530e-01f, 6.081562042e-01f, 7.938174009e-01f, 8.699471951e-01f, 4.931448400e-01f,
  9.582439065e-01f, 2.859522104e-01f, 9.867320657e-01f, 1.623570919e-01f, 9.957979321e-01f, 9.157756716e-02f, 9.986705780e-01f, 5.154724792e-02f,
  9.995795488e-01f, 2.899593674e-02f, 9.998670220e-01f, 1.630717516e-02f, 9.999579787e-01f, 9.170476347e-03f, 9.999867082e-01f, 5.156987347e-03f,
  1.542514563e-01f, -9.880316257e-01f, -3.972518742e-01f, -9.177096486e-01f, -9.980752468e-01f, -6.201484054e-02f, 5.830269456e-01f, -8.124528527e-01f,
  -9.899924994e-01f, 1.411200017e-01f, -1.159661636e-01f, 9.932531714e-01f, 5.827536583e-01f, 8.126488924e-01f, 8.610406518e-01f, 5.085361004e-01f,
  9.553365111e-01f, 2.955201864e-01f, 9.858034849e-01f, 1.679033041e-01f, 9.955033660e-01f, 9.472609311e-02f, 9.985772967e-01f, 5.332308263e-02f,
  9.995500445e-01f, 2.999550104e-02f, 9.998577237e-01f, 1.686943881e-02f, 9.999549985e-01f, 9.486690164e-03f, 9.999857545e-01f, 5.334813148e-03f,
  9.147423506e-01f, -4.040376544e-01f, 1.532154828e-01f, -9.881927967e-01f, -9.293003082e-01f, -3.693250120e-01f, 7.175492048e-01f, -6.965078115e-01f,
  -9.991351366e-01f, 4.158052057e-02f, -1.716081351e-01f, 9.851652980e-01f, 5.567683578e-01f, 8.306677938e-01f, 8.518617749e-01f, 5.237666368e-01f,
  9.523335695e-01f, 3.050586283e-01f, 9.848436713e-01f, 1.734442115e-01f, 9.951988459e-01f, 9.787366539e-02f, 9.984809160e-01f, 5.509874597e-02f,
  9.995195270e-01f, 3.099503554e-02f, 9.998480678e-01f, 1.743169688e-02f, 9.999519587e-01f, 9.802903049e-03f, 9.999848008e-01f, 5.512638018e-03f,
  8.342233896e-01f, 5.514267087e-01f, 6.564951539e-01f, -7.543302178e-01f, -7.683671117e-01f, -6.400094032e-01f, 8.294403553e-01f, -5.585952997e-01f,
  -9.982947707e-01f, -5.837419257e-02f, -2.267075777e-01f, 9.739628434e-01f, 5.302263498e-01f, 8.478561044e-01f, 8.424135447e-01f, 5.388315320e-01f,
  9.492354393e-01f, 3.145665526e-01f, 9.838528037e-01f, 1.789796203e-01f, 9.948843718e-01f, 1.010202691e-01f, 9.983813763e-01f, 5.687423423e-02f,
  9.994880557e-01f, 3.199454024e-02f, 9.998381138e-01f, 1.799395122e-02f, 9.999487996e-01f, 1.011911593e-02f, 9.999837875e-01f, 5.690463353e-03f,
  -1.327674743e-02f, 9.999118447e-01f, 9.575860500e-01f, -2.881473899e-01f, -5.312352777e-01f, -8.472243547e-01f, 9.151713848e-01f, -4.030649364e-01f,
  -9.874798059e-01f, -1.577456445e-01f, -2.810903192e-01f, 9.596813321e-01f, 5.031541586e-01f, 8.641966581e-01f, 8.326989412e-01f, 5.537260175e-01f,
  9.460423589e-01f, 3.240430057e-01f, 9.828307629e-01f, 1.845093668e-01f, 9.945599437e-01f, 1.041658595e-01f, 9.982786179e-01f, 5.864954367e-02f,
  9.994555712e-01f, 3.299400955e-02f, 9.998278022e-01f, 1.855619811e-02f, 9.999455214e-01f, 1.043532696e-02f, 9.999827743e-01f, 5.868288688e-03f,
  -8.485702872e-01f, 5.290827155e-01f, 9.637575150e-01f, 2.667797208e-01f, -2.414211184e-01f, -9.704204202e-01f, 9.720383286e-01f, -2.348221242e-01f,
  -9.667981863e-01f, -2.555412054e-01f, -3.345843852e-01f, 9.423658252e-01f, 4.755789042e-01f, 8.796730638e-01f, 8.227210045e-01f, 5.684453845e-01f,
  9.427546859e-01f, 3.334870934e-01f, 9.817776680e-01f, 1.900332868e-01f, 9.942255616e-01f, 1.073104069e-01f, 9.981727600e-01f, 6.042466685e-02f,
  9.994220734e-01f, 3.399345279e-02f, 9.998172522e-01f, 1.911843941e-02f, 9.999421835e-01f, 1.075153705e-02f, 9.999817014e-01f, 6.046113092e-03f,
  -9.036921859e-01f, -4.281826615e-01f, 6.731102467e-01f, 7.395421267e-01f, 7.233466953e-02f, -9.973804355e-01f, 9.982477427e-01f, -5.917267874e-02f,
  -9.364566803e-01f, -3.507832289e-01f, -3.870206773e-01f, 9.220710397e-01f, 4.475280643e-01f, 8.942698836e-01f, 8.124829531e-01f, 5.829849839e-01f,
  9.393727183e-01f, 3.428978026e-01f, 9.806935191e-01f, 1.955512017e-01f, 9.938812256e-01f, 1.104538813e-01f, 9.980637431e-01f, 6.219960377e-02f,
  9.993875623e-01f, 3.499285504e-02f, 9.998063445e-01f, 1.968067512e-02f, 9.999387264e-01f, 1.106774528e-02f, 9.999806285e-01f, 6.223937962e-03f,
  -1.279636919e-01f, -9.917788506e-01f, 1.751565337e-01f, 9.845405817e-01f, 3.789161742e-01f, -9.254310131e-01f, 9.929728508e-01f, 1.183425859e-01f,
  -8.967583776e-01f, -4.425205588e-01f, -4.382335544e-01f, 8.988611698e-01f, 4.190297425e-01f, 9.079725146e-01f, 8.019878864e-01f, 5.973402858e-01f,
  9.358968139e-01f, 3.522742093e-01f, 9.795783162e-01f, 2.010629177e-01f, 9.935269952e-01f, 1.135962531e-01f, 9.979515672e-01f, 6.397433579e-02f,
  9.993520975e-01f, 3.599222749e-02f, 9.997950792e-01f, 2.024290524e-02f, 9.999352098e-01f, 1.138395350e-02f, 9.999794960e-01f, 6.401761901e-03f,
  7.654140592e-01f, -6.435381174e-01f, -3.767423034e-01f, 9.263181090e-01f, 6.479216814e-01f, -7.617069483e-01f, 9.563800097e-01f, 2.921253741e-01f,
  -8.481000066e-01f, -5.298361778e-01f, -4.880608618e-01f, 8.728095889e-01f, 3.901124299e-01f, 9.207672477e-01f, 7.912392616e-01f, 6.115067005e-01f,
  9.323273301e-01f, 3.616154492e-01f, 9.784321785e-01f, 2.065682709e-01f, 9.931628108e-01f, 1.167374924e-01f, 9.978361726e-01f, 6.574887782e-02f,
  9.993155599e-01f, 3.699155897e-02f, 9.997835755e-01f, 2.080512606e-02f, 9.999315739e-01f, 1.170015987e-02f, 9.999783635e-01f, 6.579586305e-03f,
  9.550736547e-01f, 2.963685691e-01f, -8.126112223e-01f, 5.828061700e-01f, 8.526731133e-01f, -5.224447846e-01f, 8.896234632e-01f, 4.566946924e-01f,
  -7.909677625e-01f, -6.118578315e-01f, -5.363451838e-01f, 8.439987302e-01f, 3.608050346e-01f, 9.326412678e-01f, 7.802404165e-01f, 6.254796982e-01f,
  9.286646247e-01f, 3.709204793e-01f, 9.772551060e-01f, 2.120671123e-01f, 9.927886724e-01f, 1.198775545e-01f, 9.977176785e-01f, 6.752320379e-02f,
  9.992780685e-01f, 3.799085692e-02f, 9.997717142e-01f, 2.136734314e-02f, 9.999278188e-01f, 1.201636530e-02f, 9.999771714e-01f, 6.757410709e-03f,
  2.666429281e-01f, 9.637953639e-01f, -9.982103705e-01f, 5.980031565e-02f, 9.728653431e-01f, -2.313720137e-01f, 7.948083878e-01f, 6.068604589e-01f,
  -7.259322405e-01f, -6.877662539e-01f, -5.829339027e-01f, 8.125196099e-01f, 3.311368525e-01f, 9.435827136e-01f, 7.689949274e-01f, 6.392549276e-01f,
  9.249090552e-01f, 3.801884055e-01f, 9.760470986e-01f, 2.175592482e-01f, 9.924046397e-01f, 1.230164245e-01f, 9.975960255e-01f, 6.929731369e-02f,
  9.992396235e-01f, 3.899011388e-02f, 9.997594953e-01f, 2.192955278e-02f, 9.999239445e-01f, 1.233256981e-02f, 9.999759793e-01f, 6.935234182e-03f,
  -6.669380665e-01f, 7.451131344e-01f, -8.763794303e-01f, -4.816212952e-01f, 9.965789914e-01f, 8.264580369e-02f, 6.749256253e-01f, 7.378857136e-01f,
  -6.536436081e-01f, -7.568024993e-01f, -6.276797056e-01f, 7.784717083e-01f, 3.011375964e-01f, 9.535806775e-01f, 7.575061917e-01f, 6.528279781e-01f,
  9.210609794e-01f, 3.894183338e-01f, 9.748082757e-01f, 2.230444849e-01f, 9.920106530e-01f, 1.261540651e-01f, 9.974712729e-01f, 7.107120752e-02f,
  9.992001057e-01f, 3.998933733e-02f, 9.997470379e-01f, 2.249175683e-02f, 9.999200106e-01f, 1.264877338e-02f, 9.999747276e-01f, 7.113057654e-03f,
  -9.873392582e-01f, -1.586226672e-01f, -4.846394062e-01f, -8.747140169e-01f, 9.214623570e-01f, 3.884676993e-01f, 5.337560773e-01f, 8.456384540e-01f,
  -5.748240352e-01f, -8.182770610e-01f, -6.704410911e-01f, 7.419627905e-01f, 2.708370686e-01f, 9.626252055e-01f, 7.457779050e-01f, 6.661946774e-01f,
  9.171208143e-01f, 3.986093104e-01f, 9.735385776e-01f, 2.285226882e-01f, 9.916067719e-01f, 1.292904317e-01f, 9.973433018e-01f, 7.284487784e-02f,
  9.991596341e-01f, 4.098851606e-02f, 9.997342229e-01f, 2.305394970e-02f, 9.999159575e-01f, 1.296497509e-02f, 9.999734163e-01f, 7.290880661e-03f,
  -3.999853134e-01f, -9.165215492e-01f, 5.636094138e-02f, -9.984104633e-01f, 7.549653649e-01f, 6.557646990e-01f, 3.757521510e-01f, 9.267202020e-01f,
  -4.902605712e-01f, -8.715758920e-01f, -7.110829353e-01f, 7.031081319e-01f, 2.402658761e-01f, 9.707071185e-01f, 7.338138223e-01f, 6.793506742e-01f,
  9.130889177e-01f, 4.077604413e-01f, 9.722381234e-01f, 2.339936644e-01f, 9.911929369e-01f, 1.324255317e-01f, 9.972121716e-01f, 7.461831719e-02f,
  9.991181493e-01f, 4.198765755e-02f, 9.997211099e-01f, 2.361613885e-02f, 9.999117851e-01f, 1.328117587e-02f, 9.999721050e-01f, 7.468704134e-03f,
  5.551133156e-01f, -8.317747712e-01f, 5.800031424e-01f, -8.146142364e-01f, 5.135984421e-01f, 8.580306768e-01f, 2.058971673e-01f, 9.785736203e-01f,
  -4.007990062e-01f, -9.161660075e-01f, -7.494767308e-01f, 6.620306373e-01f, 2.094544172e-01f, 9.778184295e-01f, 7.216176391e-01f, 6.922917962e-01f,
  9.089657664e-01f, 4.168707728e-01f, 9.709069133e-01f, 2.394572198e-01f, 9.907692075e-01f, 1.355592906e-01f, 9.970778823e-01f, 7.639151812e-02f,
  9.990756512e-01f, 4.298675060e-02f, 9.997076392e-01f, 2.417832054e-02f, 9.999075532e-01f, 1.359737478e-02f, 9.999707937e-01f, 7.646527141e-03f,
  9.998432994e-01f, 1.770192571e-02f, 9.250146747e-01f, -3.799313903e-01f, 2.212981731e-01f, 9.752061963e-01f, 2.954781987e-02f, 9.995633960e-01f,
  -3.073327839e-01f, -9.516021013e-01f, -7.855011225e-01f, 6.188601851e-01f, 1.784335226e-01f, 9.839519858e-01f, 7.091933489e-01f, 7.050140500e-01f,
  9.047516584e-01f, 4.259394705e-01f, 9.695450068e-01f, 2.449132055e-01f, 9.903355837e-01f, 1.386916935e-01f, 9.969404936e-01f, 7.816448808e-02f,
  9.990321398e-01f, 4.398580641e-02f, 9.996939301e-01f, 2.474049293e-02f, 9.999032021e-01f, 1.391357277e-02f, 9.999693632e-01f, 7.824349217e-03f,
  5.253219604e-01f, 8.509035110e-01f, 9.851381779e-01f, 1.717635691e-01f, -9.294810891e-02f, 9.956709743e-01f, -1.477329880e-01f, 9.890272617e-01f,
  -2.107958049e-01f, -9.775301218e-01f, -8.190422058e-01f, 5.737332702e-01f, 1.472342163e-01f, 9.891016483e-01f, 6.965447664e-01f, 7.175133228e-01f,
  9.004471302e-01f, 4.349655211e-01f, 9.681524038e-01f, 2.503614724e-01f, 9.898920655e-01f, 1.418227106e-01f, 9.967998862e-01f, 7.993719727e-02f,
  9.989876747e-01f, 4.498481750e-02f, 9.996798635e-01f, 2.530265786e-02f, 9.998987317e-01f, 1.422976889e-02f, 9.999679923e-01f, 8.002171293e-03f,
  -4.321779311e-01f, 9.017883539e-01f, 7.418580055e-01f, 6.705570221e-01f, -3.979767561e-01f, 9.173954725e-01f, -3.203543723e-01f, 9.472977519e-01f,
  -1.121526212e-01f, -9.936909676e-01f, -8.499938846e-01f, 5.267925262e-01f, 1.158876941e-01f, 9.932623506e-01f, 6.836758852e-01f, 7.297857404e-01f,
  8.960524797e-01f, 4.439480901e-01f, 9.667292237e-01f, 2.558017969e-01f, 9.894386530e-01f, 1.449523121e-01f, 9.966561794e-01f, 8.170966059e-02f,
  9.989421964e-01f, 4.598378390e-02f, 9.996654391e-01f, 2.586481534e-02f, 9.998942018e-01f, 1.454596408e-02f, 9.999665618e-01f, 8.179994300e-03f,
  -9.923354983e-01f, 1.235731244e-01f, 2.700984478e-01f, 9.628326893e-01f, -6.635382771e-01f, 7.481423616e-01f, -4.828719497e-01f, 8.756909966e-01f,
  -1.238837745e-02f, -9.999232888e-01f, -8.782584071e-01f, 4.781863391e-01f, 8.442528546e-02f, 9.964298010e-01f, 6.705908775e-01f, 7.418274283e-01f,
  8.915683031e-01f, 4.528862834e-01f, 9.652754664e-01f, 2.612340748e-01f, 9.889753461e-01f, 1.480804533e-01f, 9.965093136e-01f, 8.348185569e-02f,
  9.988957047e-01f, 4.698270187e-02f, 9.996507764e-01f, 2.642696351e-02f, 9.998895526e-01f, 1.486215740e-02f, 9.999650717e-01f, 8.357816376e-03f,
  -6.401443481e-01f, -7.682546377e-01f, -2.848466039e-01f, 9.585731030e-01f, -8.632965088e-01f, 5.046970844e-01f, -6.301599741e-01f, 7.764653563e-01f,
  8.749917150e-02f, -9.961646199e-01f, -9.037463665e-01f, 4.280683994e-01f, 5.287845805e-02f, 9.986009598e-01f, 6.572937369e-01f, 7.536345124e-01f,
  8.869948983e-01f, 4.617791772e-01f, 9.637911916e-01f, 2.666580379e-01f, 9.885020852e-01f, 1.512071192e-01f, 9.963592887e-01f, 8.525379747e-02f,
  9.988481998e-01f, 4.798157141e-02f, 9.996357560e-01f, 2.698910423e-02f, 9.998847842e-01f, 1.517834887e-02f, 9.999635816e-01f, 8.535637520e-03f,
  3.005925417e-01f, -9.537526369e-01f, -7.520639896e-01f, 6.590901017e-01f, -9.774427414e-01f, 2.112006545e-01f, -7.575730681e-01f, 6.527503729e-01f,
  1.865124702e-01f, -9.824525714e-01f, -9.263771176e-01f, 3.765971363e-01f, 2.127875760e-02f, 9.997735620e-01f, 6.437888145e-01f, 7.652031779e-01f,
  8.823328614e-01f, 4.706258774e-01f, 9.622764587e-01f, 2.720735669e-01f, 9.880189896e-01f, 1.543322802e-01f, 9.962061048e-01f, 8.702547103e-02f,
  9.987997413e-01f, 4.898039624e-02f, 9.996203780e-01f, 2.755123749e-02f, 9.998799562e-01f, 1.549453940e-02f, 9.999620318e-01f, 8.713459596e-03f,
  9.649659991e-01f, -2.623748481e-01f, -9.876590967e-01f, 1.566190720e-01f, -9.946564436e-01f, -1.032404602e-01f, -8.610926867e-01f, 5.084479451e-01f,
  2.836622000e-01f, -9.589242935e-01f, -9.460792542e-01f, 3.239352703e-01f, -1.034221891e-02f, 9.999465346e-01f, 6.300802827e-01f, 7.765299678e-01f,
  8.775825500e-01f, 4.794255495e-01f, 9.607312679e-01f, 2.774805427e-01f, 9.875259995e-01f, 1.574558914e-01f, 9.960497618e-01f, 8.879686147e-02f,
  9.987502694e-01f, 4.997916892e-02f, 9.996047616e-01f, 2.811335959e-02f, 9.998750091e-01f, 1.581072807e-02f, 9.999604821e-01f, 8.891279809e-03f,
  7.421541810e-01f, 6.702291965e-01f, -9.190735221e-01f, -3.940860629e-01f, -9.132301211e-01f, -4.074441493e-01f, -9.374542236e-01f, 3.481085002e-01f,
  3.779776692e-01f, -9.258147478e-01f, -9.627903700e-01f, 2.702493370e-01f, -4.195285589e-02f, 9.991195798e-01f, 6.161724925e-01f, 7.876111865e-01f,
  8.727445006e-01f, 4.881772399e-01f, 9.591556787e-01f, 2.828786969e-01f, 9.870231748e-01f, 1.605779380e-01f, 9.958902597e-01f, 9.056797624e-02f,
  9.986997843e-01f, 5.097789690e-02f, 9.995887876e-01f, 2.867547423e-02f, 9.998699427e-01f, 1.612691768e-02f, 9.999588728e-01f, 9.069100954e-03f,
  -1.629907787e-01f, 9.866275787e-01f, -5.674300194e-01f, -8.234215975e-01f, -7.412399650e-01f, -6.712401509e-01f, -9.842484593e-01f, 1.767906845e-01f,
  4.685169160e-01f, -8.834545016e-01f, -9.764577150e-01f, 2.157090008e-01f, -7.352153957e-02f, 9.972936511e-01f, 6.020699143e-01f, 7.984433770e-01f,
  8.678191900e-01f, 4.968801141e-01f, 9.575498104e-01f, 2.882679403e-01f, 9.865104556e-01f, 1.636983752e-01f, 9.957276583e-01f, 9.233880043e-02f,
  9.986482859e-01f, 5.197656900e-02f, 9.995725155e-01f, 2.923758142e-02f, 9.998648167e-01f, 1.644310169e-02f, 9.999572635e-01f, 9.246920235e-03f,
  -9.182828069e-01f, 3.959251642e-01f, -4.102819040e-02f, -9.991579652e-01f, -4.957418144e-01f, -8.684699535e-01f, -1.000000000e+00f, -1.030206768e-04f,
  5.543745160e-01f, -8.322673440e-01f, -9.870380163e-01f, 1.604867280e-01f, -1.050167084e-01f, 9.944704771e-01f, 5.877769589e-01f, 8.090230227e-01f,
  8.628070951e-01f, 5.055333376e-01f, 9.559136033e-01f, 2.936480343e-01f, 9.859878421e-01f, 1.668171734e-01f, 9.955618382e-01f, 9.410934150e-02f,
  9.985958338e-01f, 5.297519267e-02f, 9.995558858e-01f, 2.979967557e-02f, 9.998595715e-01f, 1.675928757e-02f, 9.999555945e-01f, 9.424741380e-03f,
  -8.293098211e-01f, -5.587890744e-01f, 4.980095923e-01f, -8.671715260e-01f, -2.010796219e-01f, -9.795749187e-01f, -9.842120409e-01f, -1.769934744e-01f,
  6.346929669e-01f, -7.727644444e-01f, -9.944978952e-01f, 1.047568321e-01f, -1.364068687e-01f, 9.906529188e-01f, 5.732980371e-01f, 8.193469048e-01f,
  8.577086926e-01f, 5.141359568e-01f, 9.542471766e-01f, 2.990188897e-01f, 9.854553938e-01f, 1.699342877e-01f, 9.953929186e-01f, 9.587957710e-02f,
  9.985423684e-01f, 5.397376046e-02f, 9.995389581e-01f, 3.036176413e-02f, 9.998542070e-01f, 1.707546785e-02f, 9.999538660e-01f, 9.602561593e-03f,
  2.212675661e-02f, -9.997551441e-01f, 8.836693168e-01f, -4.681116641e-01f, 1.135217771e-01f, -9.935355186e-01f, -9.373825192e-01f, -3.483016491e-01f,
  7.086697817e-01f, -7.055402994e-01f, -9.988136292e-01f, 4.869600013e-02f, -1.676606387e-01f, 9.858447909e-01f, 5.586379170e-01f, 8.294116855e-01f,
  8.525245190e-01f, 5.226872563e-01f, 9.525505900e-01f, 3.043802381e-01f, 9.849131107e-01f, 1.730497181e-01f, 9.952208400e-01f, 9.764950722e-02f,
  9.984878898e-01f, 5.497227982e-02f, 9.995217323e-01f, 3.092384152e-02f, 9.998487830e-01f, 1.739165001e-02f, 9.999521971e-01f, 9.780380875e-03f,
  8.532201052e-01f, -5.215510130e-01f, 9.971746206e-01f, 7.511820644e-02f, 4.168670774e-01f, -9.089674354e-01f, -8.609884381e-01f, -5.086245537e-01f,
  7.755658031e-01f, -6.312667131e-01f, -9.999717474e-01f, -7.518785074e-03f, -1.987468749e-01f, 9.800508618e-01f, 5.438010693e-01f, 8.392141461e-01f,
  8.472551107e-01f, 5.311862230e-01f, 9.508239031e-01f, 3.097319603e-01f, 9.843609333e-01f, 1.761634201e-01f, 9.950456619e-01f, 9.941913933e-02f,
  9.984323978e-01f, 5.597073585e-02f, 9.995042086e-01f, 3.148590773e-02f, 9.998431802e-01f, 1.770782843e-02f, 9.999504089e-01f, 9.958200157e-03f,
  8.998668194e-01f, 4.361647666e-01f, 8.035690784e-01f, 5.952115059e-01f, 6.788702011e-01f, -7.342582941e-01f, -7.574391961e-01f, -6.529057026e-01f,
  8.347129226e-01f, -5.506852865e-01f, -9.979684949e-01f, -6.370979548e-02f, -2.296342701e-01f, 9.732769728e-01f, 5.287923217e-01f, 8.487512469e-01f,
  8.419010043e-01f, 5.396320224e-01f, 9.490671158e-01f, 3.150739372e-01f, 9.837989211e-01f, 1.792753637e-01f, 9.948672652e-01f, 1.011884511e-01f,
  9.983759522e-01f, 5.696914345e-02f, 9.994863272e-01f, 3.204796836e-02f, 9.998375773e-01f, 1.802400686e-02f, 9.999486208e-01f, 1.013601944e-02f,
  1.191801354e-01f, 9.928726554e-01f, 3.624766767e-01f, 9.319928288e-01f, 8.735505342e-01f, -4.867334962e-01f, -6.300007105e-01f, -7.765945792e-01f,
  8.855196238e-01f, -4.646020234e-01f, -9.928101897e-01f, -1.196993962e-01f, -2.602920532e-01f, 9.655299187e-01f, 5.136163235e-01f, 8.580200076e-01f,
  8.364626765e-01f, 5.480239391e-01f, 9.472803473e-01f, 3.204059005e-01f, 9.832270741e-01f, 1.823855042e-01f, 9.946857691e-01f, 1.029574350e-01f,
  9.983184934e-01f, 5.796748772e-02f, 9.994681478e-01f, 3.261001408e-02f, 9.998317957e-01f, 1.834018156e-02f, 9.999468327e-01f, 1.031383779e-02f,
  -7.710801959e-01f, 6.367380023e-01f, -1.902491003e-01f, 9.817358255e-01f, 9.816020727e-01f, -1.909380108e-01f, -4.826923311e-01f, -8.757900000e-01f,
  9.274784923e-01f, -3.738765717e-01f, -9.845131636e-01f, -1.753105819e-01f, -2.906895578e-01f, 9.568174481e-01f, 4.982779026e-01f, 8.670173883e-01f,
  8.309407234e-01f, 5.563610196e-01f, 9.454635978e-01f, 3.257277906e-01f, 9.826454520e-01f, 1.854938269e-01f, 9.945011139e-01f, 1.047261059e-01f,
  9.982600212e-01f, 5.896577984e-02f, 9.994496703e-01f, 3.317204863e-02f, 9.998259544e-01f, 1.865635626e-02f, 9.999449849e-01f, 1.049165614e-02f,
  -9.524129629e-01f, -3.048106134e-01f, -6.843819022e-01f, 7.291237116e-01f, 9.923083186e-01f, 1.237909496e-01f, -3.201591671e-01f, -9.473637342e-01f,
  9.601702690e-01f, -2.794154882e-01f, -9.731037021e-01f, -2.303675115e-01f, -3.207964003e-01f, 9.471482038e-01f, 4.827820361e-01f, 8.757405281e-01f,
  8.253356218e-01f, 5.646424294e-01f, 9.436169863e-01f, 3.310393095e-01f, 9.820539355e-01f, 1.886002868e-01f, 9.943132997e-01f, 1.064944416e-01f,
  9.982005358e-01f, 5.996400863e-02f, 9.994308352e-01f, 3.373407945e-02f, 9.998199940e-01f, 1.897252724e-02f, 9.999430776e-01f, 1.066947449e-02f,
  -2.581016421e-01f, -9.661177993e-01f, -9.677396417e-01f, 2.519522607e-01f, 9.046075940e-01f, 4.262454212e-01f, -1.475291997e-01f, -9.890577197e-01f,
  9.832684398e-01f, -1.821625978e-01f, -9.586178064e-01f, -2.846961617e-01f, -3.505824506e-01f, 9.365318418e-01f, 4.671334028e-01f, 8.841868639e-01f,
  8.196480274e-01f, 5.728674531e-01f, 9.417404532e-01f, 3.363404274e-01f, 9.814526439e-01f, 1.917048544e-01f, 9.941223264e-01f, 1.082624346e-01f,
  9.981400967e-01f, 6.096218154e-02f, 9.994117022e-01f, 3.429609165e-02f, 9.998139739e-01f, 1.928869821e-02f, 9.999411702e-01f, 1.084729191e-02f,
  6.735071540e-01f, -7.391806841e-01f, -9.530500174e-01f, -3.028128743e-01f, 7.271980643e-01f, 6.864276528e-01f, 2.975377068e-02f, -9.995572567e-01f,
  9.965420961e-01f, -8.308912069e-02f, -9.411013126e-01f, -3.381247520e-01f, -3.800179660e-01f, 9.249790907e-01f, 4.513370395e-01f, 8.923535347e-01f,
  8.138784766e-01f, 5.810351372e-01f, 9.398342371e-01f, 3.416308761e-01f, 9.808415174e-01f, 1.948075294e-01f, 9.939282537e-01f, 1.100300923e-01f,
  9.980786443e-01f, 6.196028739e-02f, 9.993922710e-01f, 3.485809639e-02f, 9.998078346e-01f, 1.960486546e-02f, 9.999392033e-01f, 1.102510840e-02f,
  9.858965874e-01f, 1.673557013e-01f, -6.448370218e-01f, -7.643200755e-01f, 4.776714444e-01f, 8.785385489e-01f, 2.060983330e-01f, -9.785313010e-01f,
  9.998586178e-01f, 1.681409031e-02f, -9.206095338e-01f, -3.904843926e-01f, -4.090735018e-01f, 9.125014544e-01f, 4.353979528e-01f, 9.002380967e-01f,
  8.080275059e-01f, 5.891447663e-01f, 9.378982186e-01f, 3.469105363e-01f, 9.802205563e-01f, 1.979082376e-01f, 9.937310219e-01f, 1.117973924e-01f,
  9.980161786e-01f, 6.295833737e-02f, 9.993724823e-01f, 3.542009369e-02f, 9.998015761e-01f, 1.992103085e-02f, 9.999372363e-01f, 1.120292582e-02f,
};
__device__ const float ROPE32[1024] = {
  1.000000000e+00f, 0.000000000e+00f, 1.000000000e+00f, 0.000000000e+00f, 1.000000000e+00f, 0.000000000e+00f, 1.000000000e+00f, 0.000000000e+00f,
  1.000000000e+00f, 0.000000000e+00f, 1.000000000e+00f, 0.000000000e+00f, 1.000000000e+00f, 0.000000000e+00f, 1.000000000e+00f, 0.000000000e+00f,
  5.403022766e-01f, 8.414709568e-01f, 9.504152536e-01f, 3.109835982e-01f, 9.950041771e-01f, 9.983342141e-02f, 9.995000362e-01f, 3.161750361e-02f,
  9.999499917e-01f, 9.999833070e-03f, 9.999949932e-01f, 3.162272274e-03f, 9.999995232e-01f, 9.999999311e-04f, 9.999999404e-01f, 3.162277571e-04f,
  -4.161468446e-01f, 9.092974067e-01f, 8.065783978e-01f, 5.911270976e-01f, 9.800665975e-01f, 1.986693293e-01f, 9.980006814e-01f, 6.320339441e-02f,
  9.998000264e-01f, 1.999866590e-02f, 9.999799728e-01f, 6.324512884e-03f, 9.999979734e-01f, 1.999998698e-03f, 9.999998212e-01f, 6.324554561e-04f,
  -9.899924994e-01f, 1.411200017e-01f, 5.827536583e-01f, 8.126488924e-01f, 9.553365111e-01f, 2.955202162e-01f, 9.955033660e-01f, 9.472608566e-02f,
  9.995500445e-01f, 2.999549918e-02f, 9.999549985e-01f, 9.486690164e-03f, 9.999955297e-01f, 2.999995602e-03f, 9.999995232e-01f, 9.486831259e-04f,
  -6.536436081e-01f, -7.568024993e-01f, 3.011374772e-01f, 9.535807371e-01f, 9.210609794e-01f, 3.894183338e-01f, 9.920106530e-01f, 1.261540651e-01f,
  9.992001057e-01f, 3.998933360e-02f, 9.999200106e-01f, 1.264877338e-02f, 9.999920130e-01f, 3.999989480e-03f, 9.999992251e-01f, 1.264910679e-03f,
  2.836622000e-01f, -9.589242935e-01f, -1.034233812e-02f, 9.999465346e-01f, 8.775825500e-01f, 4.794255495e-01f, 9.875259995e-01f, 1.574558765e-01f,
  9.987502694e-01f, 4.997916520e-02f, 9.998750091e-01f, 1.581072807e-02f, 9.999874830e-01f, 4.999979399e-03f, 9.999987483e-01f, 1.581138116e-03f,
  9.601702690e-01f, -2.794154882e-01f, -3.207964003e-01f, 9.471482038e-01f, 8.253356218e-01f, 5.646424890e-01f, 9.820539355e-01f, 1.886002719e-01f,
  9.982005358e-01f, 5.996400490e-02f, 9.998199940e-01f, 1.897252724e-02f, 9.999819994e-01f, 5.999964196e-03f, 9.999982119e-01f, 1.897365320e-03f,
  7.539022565e-01f, 6.569865942e-01f, -5.994374752e-01f, 8.004215956e-01f, 7.648422122e-01f, 6.442176700e-01f, 9.755998850e-01f, 2.195560932e-01f,
  9.975510240e-01f, 6.994284689e-02f, 9.997550249e-01f, 2.213413455e-02f, 9.999755025e-01f, 6.999942940e-03f, 9.999975562e-01f, 2.213592408e-03f,
  -1.455000341e-01f, 9.893582463e-01f, -8.186324239e-01f, 5.743177533e-01f, 6.967067122e-01f, 7.173560858e-01f, 9.681702852e-01f, 2.502923310e-01f,
  9.968017340e-01f, 7.991468906e-02f, 9.996800423e-01f, 2.529552206e-02f, 9.999679923e-01f, 7.999914698e-03f, 9.999967813e-01f, 2.529819263e-03f,
  -9.111302495e-01f, 4.121184945e-01f, -9.566441774e-01f, 2.912592292e-01f, 6.216099262e-01f, 7.833269238e-01f, 9.597726464e-01f, 2.807783186e-01f,
  9.959527254e-01f, 8.987854421e-02f, 9.995950460e-01f, 2.845665626e-02f, 9.999595284e-01f, 8.999879472e-03f, 9.999959469e-01f, 2.846045885e-03f,
  -8.390715122e-01f, -5.440211296e-01f, -9.997860789e-01f, -2.068356983e-02f, 5.403022766e-01f, 8.414709568e-01f, 9.504153132e-01f, 3.109835684e-01f,
  9.950041771e-01f, 9.983341396e-02f, 9.995000362e-01f, 3.161750361e-02f, 9.999499917e-01f, 9.999834001e-03f, 9.999949932e-01f, 3.162272274e-03f,
  4.425697960e-03f, -9.999902248e-01f, -9.437797666e-01f, -3.305749595e-01f, 4.535960853e-01f, 8.912073970e-01f, 9.401075840e-01f, 3.408778608e-01f,
  9.939560890e-01f, 1.097782999e-01f, 9.993950725e-01f, 3.477803990e-02f, 9.999395013e-01f, 1.099977922e-02f, 9.999939203e-01f, 3.478498431e-03f,
  8.438539505e-01f, -5.365729332e-01f, -7.941793799e-01f, -6.076834202e-01f, 3.623577058e-01f, 9.320390821e-01f, 9.288598895e-01f, 3.704313040e-01f,
  9.928086400e-01f, 1.197122037e-01f, 9.992800951e-01f, 3.793822229e-02f, 9.999279976e-01f, 1.199971233e-02f, 9.999927878e-01f, 3.794723889e-03f,
  9.074468017e-01f, 4.201670289e-01f, -5.658205152e-01f, -8.245284557e-01f, 2.674987614e-01f, 9.635581970e-01f, 9.166833758e-01f, 3.996143043e-01f,
  9.915618896e-01f, 1.296341419e-01f, 9.991551042e-01f, 4.109803215e-02f, 9.999154806e-01f, 1.299963426e-02f, 9.999915361e-01f, 4.110949114e-03f,
  1.367372125e-01f, 9.906073809e-01f, -2.813494802e-01f, -9.596053958e-01f, 1.699671596e-01f, 9.854497313e-01f, 9.035902619e-01f, 4.283977747e-01f,
  9.902160168e-01f, 1.395431161e-01f, 9.990201592e-01f, 4.425742477e-02f, 9.999020100e-01f, 1.399954315e-02f, 9.999902248e-01f, 4.427174106e-03f,
  -7.596879005e-01f, 6.502878666e-01f, 3.102235124e-02f, -9.995186925e-01f, 7.073719800e-02f, 9.974949956e-01f, 8.895936012e-01f, 4.567528665e-01f,
  9.887710810e-01f, 1.494381279e-01f, 9.988752007e-01f, 4.741638154e-02f, 9.998875260e-01f, 1.499943808e-02f, 9.999887347e-01f, 4.743398633e-03f,
  -9.576594830e-01f, -2.879033089e-01f, 3.403181732e-01f, -9.403103590e-01f, -2.919954620e-02f, 9.995735884e-01f, 8.747074604e-01f, 4.846512377e-01f,
  9.872272611e-01f, 1.593182087e-01f, 9.987202883e-01f, 5.057485774e-02f, 9.998720288e-01f, 1.599931903e-02f, 9.999871850e-01f, 5.059622694e-03f,
  -2.751633525e-01f, -9.613974690e-01f, 6.158648133e-01f, -7.878518701e-01f, -1.288445443e-01f, 9.916648269e-01f, 8.589466810e-01f, 5.120649934e-01f,
  9.855847955e-01f, 1.691823453e-01f, 9.985553622e-01f, 5.373282731e-02f, 9.998555183e-01f, 1.699918136e-02f, 9.999855757e-01f, 5.375845823e-03f,
  6.603167057e-01f, -7.509872317e-01f, 8.303361535e-01f, -5.572628975e-01f, -2.272021621e-01f, 9.738476276e-01f, 8.423270583e-01f, 5.389667153e-01f,
  9.838436842e-01f, 1.790295690e-01f, 9.983804226e-01f, 5.689026415e-02f, 9.998379946e-01f, 1.799902879e-02f, 9.999837875e-01f, 5.692068953e-03f,
  9.887046218e-01f, 1.498772055e-01f, 9.624637961e-01f, -2.714101076e-01f, -3.232895434e-01f, 9.463000894e-01f, 8.248651624e-01f, 5.653295517e-01f,
  9.820042253e-01f, 1.888588965e-01f, 9.981955290e-01f, 6.004713103e-02f, 9.998195171e-01f, 1.899885759e-02f, 9.999819398e-01f, 6.008291151e-03f,
  4.080820680e-01f, 9.129452705e-01f, 9.991443753e-01f, 4.135828838e-02f, -4.161468446e-01f, 9.092974067e-01f, 8.065784574e-01f, 5.911270380e-01f,
  9.800665975e-01f, 1.986693144e-01f, 9.980006814e-01f, 6.320339441e-02f, 9.998000264e-01f, 1.999866776e-02f, 9.999799728e-01f, 6.324512884e-03f,
  -5.477292538e-01f, 8.366556168e-01f, 9.367404580e-01f, 3.500247598e-01f, -5.048462152e-01f, 8.632093072e-01f, 7.874851823e-01f, 6.163335443e-01f,
  9.780309200e-01f, 2.084598988e-01f, 9.977958202e-01f, 6.635902822e-02f, 9.997795224e-01f, 2.099845745e-02f, 9.999779463e-01f, 6.640734151e-03f,
  -9.999608397e-01f, -8.851309307e-03f, 7.814403772e-01f, 6.239799261e-01f, -5.885011554e-01f, 8.084963560e-01f, 7.676045895e-01f, 6.409237385e-01f,
  9.758974314e-01f, 2.182296216e-01f, 9.975810051e-01f, 6.951400638e-02f, 9.997580051e-01f, 2.199822664e-02f, 9.999758005e-01f, 6.956954487e-03f,
  -5.328330398e-01f, -8.462204337e-01f, 5.486452579e-01f, 8.360552788e-01f, -6.662759781e-01f, 7.457052469e-01f, 7.469564080e-01f, 6.648730636e-01f,
  9.736663699e-01f, 2.279775143e-01f, 9.973561764e-01f, 7.266827673e-02f, 9.997355342e-01f, 2.299797349e-02f, 9.999735355e-01f, 7.273174357e-03f,
  4.241790175e-01f, -9.055783749e-01f, 2.614416778e-01f, 9.652192593e-01f, -7.373937964e-01f, 6.754631400e-01f, 7.255613208e-01f, 6.881574988e-01f,
  9.713379741e-01f, 2.377026230e-01f, 9.971213937e-01f, 7.582182437e-02f, 9.997119904e-01f, 2.399769612e-02f, 9.999712110e-01f, 7.589393295e-03f,
  9.912028313e-01f, -1.323517561e-01f, -5.168933049e-02f, 9.986631870e-01f, -8.011435866e-01f, 5.984721184e-01f, 7.034407258e-01f, 7.107539177e-01f,
  9.689124227e-01f, 2.474039644e-01f, 9.968766570e-01f, 7.897461206e-02f, 9.996874928e-01f, 2.499739639e-02f, 9.999687672e-01f, 7.905611768e-03f,
  6.469193101e-01f, 7.625584602e-01f, -3.596943319e-01f, 9.330701828e-01f, -8.568888307e-01f, 5.155012608e-01f, 6.806167960e-01f, 7.326396108e-01f,
  9.663899541e-01f, 2.570805550e-01f, 9.966219068e-01f, 8.212661743e-02f, 9.996620417e-01f, 2.599707060e-02f, 9.999662042e-01f, 8.221829310e-03f,
  -2.921388149e-01f, 9.563759565e-01f, -6.320286393e-01f, 7.749450207e-01f, -9.040721655e-01f, 4.273798466e-01f, 6.571123004e-01f, 7.537927032e-01f,
  9.637709260e-01f, 2.667314112e-01f, 9.963572025e-01f, 8.527779579e-02f, 9.996355176e-01f, 2.699672058e-02f, 9.999635220e-01f, 8.538045920e-03f,
  -9.626058936e-01f, 2.709057927e-01f, -8.416849375e-01f, 5.399689674e-01f, -9.422222972e-01f, 3.349882066e-01f, 6.329506636e-01f, 7.741920948e-01f,
  9.610554576e-01f, 2.763556540e-01f, 9.960825443e-01f, 8.842811733e-02f, 9.996080399e-01f, 2.799634263e-02f, 9.999607801e-01f, 8.854261599e-03f,
  -7.480575442e-01f, -6.636338830e-01f, -9.678714871e-01f, 2.514453232e-01f, -9.709581733e-01f, 2.392492294e-01f, 6.081562042e-01f, 7.938174009e-01f,
  9.582439065e-01f, 2.859522104e-01f, 9.957979321e-01f, 9.157756716e-02f, 9.995795488e-01f, 2.899593674e-02f, 9.999579787e-01f, 9.170476347e-03f,
  1.542514563e-01f, -9.880316257e-01f, -9.980752468e-01f, -6.201484054e-02f, -9.899924994e-01f, 1.411200017e-01f, 5.827536583e-01f, 8.126488924e-01f,
  9.553365111e-01f, 2.955201864e-01f, 9.955033660e-01f, 9.472609311e-02f, 9.995500445e-01f, 2.999550104e-02f, 9.999549985e-01f, 9.486690164e-03f,
  9.147423506e-01f, -4.040376544e-01f, -9.293003082e-01f, -3.693250120e-01f, -9.991351366e-01f, 4.158052057e-02f, 5.567683578e-01f, 8.306677938e-01f,
  9.523335695e-01f, 3.050586283e-01f, 9.951988459e-01f, 9.787366539e-02f, 9.995195270e-01f, 3.099503554e-02f, 9.999519587e-01f, 9.802903049e-03f,
  8.342233896e-01f, 5.514267087e-01f, -7.683671117e-01f, -6.400094032e-01f, -9.982947707e-01f, -5.837419257e-02f, 5.302263498e-01f, 8.478561044e-01f,
  9.492354393e-01f, 3.145665526e-01f, 9.948843718e-01f, 1.010202691e-01f, 9.994880557e-01f, 3.199454024e-02f, 9.999487996e-01f, 1.011911593e-02f,
  -1.327674743e-02f, 9.999118447e-01f, -5.312352777e-01f, -8.472243547e-01f, -9.874798059e-01f, -1.577456445e-01f, 5.031541586e-01f, 8.641966581e-01f,
  9.460423589e-01f, 3.240430057e-01f, 9.945599437e-01f, 1.041658595e-01f, 9.994555712e-01f, 3.299400955e-02f, 9.999455214e-01f, 1.043532696e-02f,
  -8.485702872e-01f, 5.290827155e-01f, -2.414211184e-01f, -9.704204202e-01f, -9.667981863e-01f, -2.555412054e-01f, 4.755789042e-01f, 8.796730638e-01f,
  9.427546859e-01f, 3.334870934e-01f, 9.942255616e-01f, 1.073104069e-01f, 9.994220734e-01f, 3.399345279e-02f, 9.999421835e-01f, 1.075153705e-02f,
  -9.036921859e-01f, -4.281826615e-01f, 7.233466953e-02f, -9.973804355e-01f, -9.364566803e-01f, -3.507832289e-01f, 4.475280643e-01f, 8.942698836e-01f,
  9.393727183e-01f, 3.428978026e-01f, 9.938812256e-01f, 1.104538813e-01f, 9.993875623e-01f, 3.499285504e-02f, 9.999387264e-01f, 1.106774528e-02f,
  -1.279636919e-01f, -9.917788506e-01f, 3.789161742e-01f, -9.254310131e-01f, -8.967583776e-01f, -4.425205588e-01f, 4.190297425e-01f, 9.079725146e-01f,
  9.358968139e-01f, 3.522742093e-01f, 9.935269952e-01f, 1.135962531e-01f, 9.993520975e-01f, 3.599222749e-02f, 9.999352098e-01f, 1.138395350e-02f,
  7.654140592e-01f, -6.435381174e-01f, 6.479216814e-01f, -7.617069483e-01f, -8.481000066e-01f, -5.298361778e-01f, 3.901124299e-01f, 9.207672477e-01f,
  9.323273301e-01f, 3.616154492e-01f, 9.931628108e-01f, 1.167374924e-01f, 9.993155599e-01f, 3.699155897e-02f, 9.999315739e-01f, 1.170015987e-02f,
  9.550736547e-01f, 2.963685691e-01f, 8.526731133e-01f, -5.224447846e-01f, -7.909677625e-01f, -6.118578315e-01f, 3.608050346e-01f, 9.326412678e-01f,
  9.286646247e-01f, 3.709204793e-01f, 9.927886724e-01f, 1.198775545e-01f, 9.992780685e-01f, 3.799085692e-02f, 9.999278188e-01f, 1.201636530e-02f,
  2.666429281e-01f, 9.637953639e-01f, 9.728653431e-01f, -2.313720137e-01f, -7.259322405e-01f, -6.877662539e-01f, 3.311368525e-01f, 9.435827136e-01f,
  9.249090552e-01f, 3.801884055e-01f, 9.924046397e-01f, 1.230164245e-01f, 9.992396235e-01f, 3.899011388e-02f, 9.999239445e-01f, 1.233256981e-02f,
  -6.669380665e-01f, 7.451131344e-01f, 9.965789914e-01f, 8.264580369e-02f, -6.536436081e-01f, -7.568024993e-01f, 3.011375964e-01f, 9.535806775e-01f,
  9.210609794e-01f, 3.894183338e-01f, 9.920106530e-01f, 1.261540651e-01f, 9.992001057e-01f, 3.998933733e-02f, 9.999200106e-01f, 1.264877338e-02f,
  -9.873392582e-01f, -1.586226672e-01f, 9.214623570e-01f, 3.884676993e-01f, -5.748240352e-01f, -8.182770610e-01f, 2.708370686e-01f, 9.626252055e-01f,
  9.171208143e-01f, 3.986093104e-01f, 9.916067719e-01f, 1.292904317e-01f, 9.991596341e-01f, 4.098851606e-02f, 9.999159575e-01f, 1.296497509e-02f,
  -3.999853134e-01f, -9.165215492e-01f, 7.549653649e-01f, 6.557646990e-01f, -4.902605712e-01f, -8.715758920e-01f, 2.402658761e-01f, 9.707071185e-01f,
  9.130889177e-01f, 4.077604413e-01f, 9.911929369e-01f, 1.324255317e-01f, 9.991181493e-01f, 4.198765755e-02f, 9.999117851e-01f, 1.328117587e-02f,
  5.551133156e-01f, -8.317747712e-01f, 5.135984421e-01f, 8.580306768e-01f, -4.007990062e-01f, -9.161660075e-01f, 2.094544172e-01f, 9.778184295e-01f,
  9.089657664e-01f, 4.168707728e-01f, 9.907692075e-01f, 1.355592906e-01f, 9.990756512e-01f, 4.298675060e-02f, 9.999075532e-01f, 1.359737478e-02f,
  9.998432994e-01f, 1.770192571e-02f, 2.212981731e-01f, 9.752061963e-01f, -3.073327839e-01f, -9.516021013e-01f, 1.784335226e-01f, 9.839519858e-01f,
  9.047516584e-01f, 4.259394705e-01f, 9.903355837e-01f, 1.386916935e-01f, 9.990321398e-01f, 4.398580641e-02f, 9.999032021e-01f, 1.391357277e-02f,
  5.253219604e-01f, 8.509035110e-01f, -9.294810891e-02f, 9.956709743e-01f, -2.107958049e-01f, -9.775301218e-01f, 1.472342163e-01f, 9.891016483e-01f,
  9.004471302e-01f, 4.349655211e-01f, 9.898920655e-01f, 1.418227106e-01f, 9.989876747e-01f, 4.498481750e-02f, 9.998987317e-01f, 1.422976889e-02f,
  -4.321779311e-01f, 9.017883539e-01f, -3.979767561e-01f, 9.173954725e-01f, -1.121526212e-01f, -9.936909676e-01f, 1.158876941e-01f, 9.932623506e-01f,
  8.960524797e-01f, 4.439480901e-01f, 9.894386530e-01f, 1.449523121e-01f, 9.989421964e-01f, 4.598378390e-02f, 9.998942018e-01f, 1.454596408e-02f,
  -9.923354983e-01f, 1.235731244e-01f, -6.635382771e-01f, 7.481423616e-01f, -1.238837745e-02f, -9.999232888e-01f, 8.442528546e-02f, 9.964298010e-01f,
  8.915683031e-01f, 4.528862834e-01f, 9.889753461e-01f, 1.480804533e-01f, 9.988957047e-01f, 4.698270187e-02f, 9.998895526e-01f, 1.486215740e-02f,
  -6.401443481e-01f, -7.682546377e-01f, -8.632965088e-01f, 5.046970844e-01f, 8.749917150e-02f, -9.961646199e-01f, 5.287845805e-02f, 9.986009598e-01f,
  8.869948983e-01f, 4.617791772e-01f, 9.885020852e-01f, 1.512071192e-01f, 9.988481998e-01f, 4.798157141e-02f, 9.998847842e-01f, 1.517834887e-02f,
  3.005925417e-01f, -9.537526369e-01f, -9.774427414e-01f, 2.112006545e-01f, 1.865124702e-01f, -9.824525714e-01f, 2.127875760e-02f, 9.997735620e-01f,
  8.823328614e-01f, 4.706258774e-01f, 9.880189896e-01f, 1.543322802e-01f, 9.987997413e-01f, 4.898039624e-02f, 9.998799562e-01f, 1.549453940e-02f,
  9.649659991e-01f, -2.623748481e-01f, -9.946564436e-01f, -1.032404602e-01f, 2.836622000e-01f, -9.589242935e-01f, -1.034221891e-02f, 9.999465346e-01f,
  8.775825500e-01f, 4.794255495e-01f, 9.875259995e-01f, 1.574558914e-01f, 9.987502694e-01f, 4.997916892e-02f, 9.998750091e-01f, 1.581072807e-02f,
  7.421541810e-01f, 6.702291965e-01f, -9.132301211e-01f, -4.074441493e-01f, 3.779776692e-01f, -9.258147478e-01f, -4.195285589e-02f, 9.991195798e-01f,
  8.727445006e-01f, 4.881772399e-01f, 9.870231748e-01f, 1.605779380e-01f, 9.986997843e-01f, 5.097789690e-02f, 9.998699427e-01f, 1.612691768e-02f,
  -1.629907787e-01f, 9.866275787e-01f, -7.412399650e-01f, -6.712401509e-01f, 4.685169160e-01f, -8.834545016e-01f, -7.352153957e-02f, 9.972936511e-01f,
  8.678191900e-01f, 4.968801141e-01f, 9.865104556e-01f, 1.636983752e-01f, 9.986482859e-01f, 5.197656900e-02f, 9.998648167e-01f, 1.644310169e-02f,
  -9.182828069e-01f, 3.959251642e-01f, -4.957418144e-01f, -8.684699535e-01f, 5.543745160e-01f, -8.322673440e-01f, -1.050167084e-01f, 9.944704771e-01f,
  8.628070951e-01f, 5.055333376e-01f, 9.859878421e-01f, 1.668171734e-01f, 9.985958338e-01f, 5.297519267e-02f, 9.998595715e-01f, 1.675928757e-02f,
  -8.293098211e-01f, -5.587890744e-01f, -2.010796219e-01f, -9.795749187e-01f, 6.346929669e-01f, -7.727644444e-01f, -1.364068687e-01f, 9.906529188e-01f,
  8.577086926e-01f, 5.141359568e-01f, 9.854553938e-01f, 1.699342877e-01f, 9.985423684e-01f, 5.397376046e-02f, 9.998542070e-01f, 1.707546785e-02f,
  2.212675661e-02f, -9.997551441e-01f, 1.135217771e-01f, -9.935355186e-01f, 7.086697817e-01f, -7.055402994e-01f, -1.676606387e-01f, 9.858447909e-01f,
  8.525245190e-01f, 5.226872563e-01f, 9.849131107e-01f, 1.730497181e-01f, 9.984878898e-01f, 5.497227982e-02f, 9.998487830e-01f, 1.739165001e-02f,
  8.532201052e-01f, -5.215510130e-01f, 4.168670774e-01f, -9.089674354e-01f, 7.755658031e-01f, -6.312667131e-01f, -1.987468749e-01f, 9.800508618e-01f,
  8.472551107e-01f, 5.311862230e-01f, 9.843609333e-01f, 1.761634201e-01f, 9.984323978e-01f, 5.597073585e-02f, 9.998431802e-01f, 1.770782843e-02f,
  8.998668194e-01f, 4.361647666e-01f, 6.788702011e-01f, -7.342582941e-01f, 8.347129226e-01f, -5.506852865e-01f, -2.296342701e-01f, 9.732769728e-01f,
  8.419010043e-01f, 5.396320224e-01f, 9.837989211e-01f, 1.792753637e-01f, 9.983759522e-01f, 5.696914345e-02f, 9.998375773e-01f, 1.802400686e-02f,
  1.191801354e-01f, 9.928726554e-01f, 8.735505342e-01f, -4.867334962e-01f, 8.855196238e-01f, -4.646020234e-01f, -2.602920532e-01f, 9.655299187e-01f,
  8.364626765e-01f, 5.480239391e-01f, 9.832270741e-01f, 1.823855042e-01f, 9.983184934e-01f, 5.796748772e-02f, 9.998317957e-01f, 1.834018156e-02f,
  -7.710801959e-01f, 6.367380023e-01f, 9.816020727e-01f, -1.909380108e-01f, 9.274784923e-01f, -3.738765717e-01f, -2.906895578e-01f, 9.568174481e-01f,
  8.309407234e-01f, 5.563610196e-01f, 9.826454520e-01f, 1.854938269e-01f, 9.982600212e-01f, 5.896577984e-02f, 9.998259544e-01f, 1.865635626e-02f,
  -9.524129629e-01f, -3.048106134e-01f, 9.923083186e-01f, 1.237909496e-01f, 9.601702690e-01f, -2.794154882e-01f, -3.207964003e-01f, 9.471482038e-01f,
  8.253356218e-01f, 5.646424294e-01f, 9.820539355e-01f, 1.886002868e-01f, 9.982005358e-01f, 5.996400863e-02f, 9.998199940e-01f, 1.897252724e-02f,
  -2.581016421e-01f, -9.661177993e-01f, 9.046075940e-01f, 4.262454212e-01f, 9.832684398e-01f, -1.821625978e-01f, -3.505824506e-01f, 9.365318418e-01f,
  8.196480274e-01f, 5.728674531e-01f, 9.814526439e-01f, 1.917048544e-01f, 9.981400967e-01f, 6.096218154e-02f, 9.998139739e-01f, 1.928869821e-02f,
  6.735071540e-01f, -7.391806841e-01f, 7.271980643e-01f, 6.864276528e-01f, 9.965420961e-01f, -8.308912069e-02f, -3.800179660e-01f, 9.249790907e-01f,
  8.138784766e-01f, 5.810351372e-01f, 9.808415174e-01f, 1.948075294e-01f, 9.980786443e-01f, 6.196028739e-02f, 9.998078346e-01f, 1.960486546e-02f,
  9.858965874e-01f, 1.673557013e-01f, 4.776714444e-01f, 8.785385489e-01f, 9.998586178e-01f, 1.681409031e-02f, -4.090735018e-01f, 9.125014544e-01f,
  8.080275059e-01f, 5.891447663e-01f, 9.802205563e-01f, 1.979082376e-01f, 9.980161786e-01f, 6.295833737e-02f, 9.998015761e-01f, 1.992103085e-02f,
};
#define XB_TMO      128
#define XB_XCNT(j)  (256  + 64 * (j))
#define XB_XSUB(j)  (1280 + 64 * (j))
#define XB_XGEN(j)  (2304 + 64 * (j))
#define XB_TOP      3328
#define XB_TOPGEN   3392
#define XCD_BAR_WORDS 3456
#define XB_SPIN_CAP (1u << 18)
#define LAS __attribute__((address_space(3)))

__device__ __forceinline__ unsigned xb_ld(unsigned* p)              { return __hip_atomic_load(p, __ATOMIC_RELAXED, __HIP_MEMORY_SCOPE_AGENT); }
__device__ __forceinline__ unsigned xb_add(unsigned* p, unsigned v) { return __hip_atomic_fetch_add(p, v, __ATOMIC_RELAXED, __HIP_MEMORY_SCOPE_AGENT); }
__device__ __forceinline__ unsigned xb_xcc_id() { return (unsigned)__builtin_amdgcn_s_getreg((3 << 11) | 20) & 0xFu; }
#define XB_SPIN(cond, bar) do { unsigned _sp = 0; while (cond) { __builtin_amdgcn_s_sleep(1); \
    if ((++_sp & 255u) == 0u) { if (xb_ld(&(bar)[XB_TMO])) break; if (_sp > XB_SPIN_CAP) { atomicAdd(&(bar)[XB_TMO], 1u); break; } } } } while (0)

struct XcdBarrier {
    unsigned* bar; unsigned x;
    volatile LAS unsigned* st;
};

__device__ __forceinline__ XcdBarrier xcd_barrier_post(unsigned* bar, volatile LAS unsigned* st) {
    XcdBarrier b; b.bar = bar; b.x = xb_xcc_id(); b.st = st;
    if (threadIdx.x == 0) (void)xb_add(&bar[XB_XCNT(b.x)], 1u);
    return b;
}
__device__ __forceinline__ void xcd_barrier_complete(unsigned* bar, unsigned x, unsigned& nloc, unsigned& nx) {
    const unsigned G = gridDim.x * gridDim.y * gridDim.z;
    unsigned sum, cnt, mine, sp = 0u;
    for (;;) {
        sum = 0u; cnt = 0u; mine = 0u;
#pragma unroll
        for (unsigned j = 0; j < 16; ++j) { const unsigned c = xb_ld(&bar[XB_XCNT(j)]); sum += c; cnt += (c > 0u) ? 1u : 0u; mine = (j == x) ? c : mine; }
        if (sum == G) break;
        __builtin_amdgcn_s_sleep(1);
        if ((++sp & 255u) == 0u) { if (xb_ld(&bar[XB_TMO])) break; if (sp > XB_SPIN_CAP) { atomicAdd(&bar[XB_TMO], 1u); break; } }
    }
    nloc = mine > 0u ? mine : 1u; nx = cnt > 0u ? cnt : 1u;
}

__device__ __forceinline__ void xcd_barrier(const XcdBarrier& b, const bool t0  ) {
    asm volatile("s_waitcnt vmcnt(0)" ::: "memory");
    __syncthreads();
    if (t0) {
        unsigned* bar = b.bar;
        __builtin_amdgcn_s_waitcnt(0);
        unsigned nloc = b.st[0], nx = b.st[1];
        if (nloc == 0u) { xcd_barrier_complete(bar, b.x, nloc, nx); b.st[0] = nloc; b.st[1] = nx; }
        const unsigned old = xb_add(&bar[XB_XSUB(b.x)], 1u);
        const unsigned gen = old / nloc;
        if (old + 1u == (gen + 1u) * nloc) {
            __builtin_amdgcn_fence(__ATOMIC_RELEASE, "agent");
            asm volatile("s_waitcnt vmcnt(0)" ::: "memory");
            const unsigned og = xb_add(&bar[XB_TOP], 1u);
            const unsigned tg = og / nx;
            if (og + 1u == (tg + 1u) * nx) xb_add(&bar[XB_TOPGEN], 1u);
            else XB_SPIN(xb_ld(&bar[XB_TOPGEN]) == tg, bar);
            __builtin_amdgcn_fence(__ATOMIC_ACQUIRE, "agent");
            xb_add(&bar[XB_XGEN(b.x)], 1u);
            asm volatile("s_waitcnt vmcnt(0)" ::: "memory");
        } else {
            XB_SPIN(xb_ld(&bar[XB_XGEN(b.x)]) == gen, bar);
            __builtin_amdgcn_fence(__ATOMIC_ACQUIRE, "agent");
            asm volatile("s_waitcnt vmcnt(0)" ::: "memory");
        }
    }
    __syncthreads();
}

DI void conv_fetch(const float* __restrict__ src, int K, int N, int k0, int n0, f32x4 (&v)[2], int tid) {
#pragma unroll
    for (int i = 0; i < 2; ++i) {
        const int idx = tid + NTHREADS * i, kr = idx >> 4, c4 = (idx & 15) * 4;
        v[i] = (f32x4){0.f, 0.f, 0.f, 0.f};
        if (n0 + c4 < N) v[i] = __builtin_nontemporal_load((const f32x4*)(src + (size_t)(k0 + kr) * N + n0 + c4));
    }
}
DI void conv_put(const f32x4 (&v)[2], float* lds, int tid) {
#pragma unroll
    for (int i = 0; i < 2; ++i) {
        const int idx = tid + NTHREADS * i, kr = idx >> 4, c4 = (idx & 15) * 4;
        float* d = lds + kr * 65 + c4;
        d[0] = v[i].x; d[1] = v[i].y; d[2] = v[i].z; d[3] = v[i].w;
    }
}
typedef float f32x2_8 __attribute__((ext_vector_type(2)));
DI unsigned cvt_fp8x4(float a, float b, float c, float d) { int w = __builtin_amdgcn_cvt_pk_fp8_f32(a, b, 0, false); w = __builtin_amdgcn_cvt_pk_fp8_f32(c, d, w, true); return (unsigned)w; }
template <bool NT, bool FP8>
DI void conv_store(int K, bf16_t* __restrict__ dst, int k0, int ndst0, int nstep, const float* lds, int tid) {
    const int idx = tid, n = idx >> 3, kc = idx & 7;
    float f[8];
#pragma unroll
    for (int j = 0; j < 8; ++j) f[j] = lds[(kc * 8 + j) * 65 + n];
    const size_t e = (size_t)(ndst0 + (n & 31) + (n >> 5) * nstep) * K + k0 + kc * 8;
    if (FP8) {
        u32x2 w; w.x = cvt_fp8x4(f[0] * 32.f, f[1] * 32.f, f[2] * 32.f, f[3] * 32.f); w.y = cvt_fp8x4(f[4] * 32.f, f[5] * 32.f, f[6] * 32.f, f[7] * 32.f);
        u32x2* d = (u32x2*)((unsigned char*)dst + e);
        if (NT) __builtin_nontemporal_store(w, d); else *d = w;
    } else {
        u32x4* d = (u32x4*)(dst + e);
        if (NT) __builtin_nontemporal_store(pack8(f), d); else *d = pack8(f);
    }
}
template <bool NT = true, bool FP8 = false>
DI void conv_job(const float* src, int count, int K, int N, int Npad, bf16_t* dst, int perm  , int& base, float* lds, int bid, int nb, int tid) {
    const int tk = K / 64, tn = Npad / 64, per = tk * tn, total = count * per;
    int t = (bid - (base % nb) + nb) % nb;
    f32x4 rg[4][2];
    auto fetch4 = [&](int tt) {
#pragma unroll
        for (int q = 0; q < 4; ++q) {
            const int tq = tt + q * nb;
            if (tq < total) { const int mi = tq / per, rem = tq - mi * per, nt = rem / tk, kt = rem - nt * tk;
                conv_fetch(src + (size_t)mi * K * N, K, N, kt * 64, nt * 64, rg[q], tid); }
        }
    };
    if (t < total) fetch4(t);
    for (; t < total; t += 4 * nb) {
#pragma unroll
        for (int q = 0; q < 4; ++q) if (t + q * nb < total) conv_put(rg[q], lds + q * 4160, tid);
        __syncthreads();
        if (t + 4 * nb < total) fetch4(t + 4 * nb);
#pragma unroll
        for (int q = 0; q < 4; ++q) {
            const int tq = t + q * nb;
            if (tq < total) { const int mi = tq / per, rem = tq - mi * per, nt = rem / tk, kt = rem - nt * tk, n0 = nt * 64;
                int nd0 = n0, nstep = 32;
                if (perm == 1) nd0 = ((n0 & 255) >> 7) * 256 + (n0 >> 8) * 128 + (n0 & 127);
                else if (n0 < perm) { const int hg = n0 >> 6; nd0 = (hg >> 2) * 256 + (hg & 3) * 32; nstep = 128; }
                conv_store<NT, FP8>(K, FP8 ? (bf16_t*)((unsigned char*)dst + (size_t)mi * Npad * K) : dst + (size_t)mi * Npad * K, kt * 64, nd0, nstep, lds + q * 4160, tid); }
        }
        __syncthreads();
    }
    base += total;
}

DI int mla_col(bool uq, int r) {
    const int hw = uq ? 96 : 128;
    if (r < 1024) { const int pn = r >> 8, bj = (r >> 7) & 1, wc = (r >> 5) & 3, d = r & 31; return (4 * pn + wc) * hw + 32 * bj + d; }
    const int rr = r - 1024;
    if (uq) { const int head = rr >> 5, c = rr & 31, dim = (c >> 3) * 4 + (c & 3) + 16 * ((c >> 2) & 1); return head * 96 + 64 + dim; }
    return (rr >> 6) * 128 + 64 + (rr & 63);
}
DI void phase_prologue(const Params& p, float* lds, int bid, int nb, int tid) {
    bf16_t* ws16 = (bf16_t*)p.ws;
    int base = 0;
    conv_job<true, true>(p.in[13], 1, 1024, 3072, 3072, (bf16_t*)(p.ws + W_QKV0), 2048, base, lds, bid, nb, tid);
    conv_job<true, true>(p.in[14], 1, 1024, 1024, 1024, (bf16_t*)(p.ws + W_O0), 0, base, lds, bid, nb, tid);
    conv_job<true, true>(p.in[18], 1, 1024, 1536, 1536, (bf16_t*)(p.ws + W_QKV1), 1280, base, lds, bid, nb, tid);
    conv_job<true, true>(p.in[19], 1, 1024, 1024, 1024, (bf16_t*)(p.ws + W_O1), 0, base, lds, bid, nb, tid);
    conv_job<true, true>(p.in[23], 1, 1024, 672, 768, (bf16_t*)(p.ws + W_DQKV), 0, base, lds, bid, nb, tid);
    for (int i = bid * NTHREADS + tid; i < 1536 * 64 + 2048 * 32; i += nb * NTHREADS) {
        const bool uq = i < 1536 * 64;
        const int K = uq ? 384 : 256, KB = uq ? 512 : 256, kc = KB / 8, ii = uq ? i : i - 1536 * 64, r = ii / kc, k0 = (ii - r * kc) * 8, nsrc = uq ? 1536 : 2048;
        u32x2 w8 = {0u, 0u};
        if (k0 < K) {
            const int col = mla_col(uq, r);
            const float* src = p.in[uq ? 26 : 27] + (size_t)k0 * nsrc + col;
            float f[8];
#pragma unroll
            for (int j = 0; j < 8; ++j) f[j] = src[(size_t)j * nsrc] * 32.f;
            w8.x = cvt_fp8x4(f[0], f[1], f[2], f[3]); w8.y = cvt_fp8x4(f[4], f[5], f[6], f[7]);
        }
        *(u32x2*)(p.ws + (uq ? W_UQ : W_UKV) + (size_t)r * KB + k0) = w8;
    }
    conv_job<true, true>(p.in[30], 1, 1024, 1024, 1024, (bf16_t*)(p.ws + W_O2), 0, base, lds, bid, nb, tid);
    conv_job<true, true>(p.in[31], 1, 1024, 3072, 3072, (bf16_t*)(p.ws + W_QKV3), 2048, base, lds, bid, nb, tid);
    conv_job<true, true>(p.in[36], 1, 1024, 1024, 1024, (bf16_t*)(p.ws + W_O3), 0, base, lds, bid, nb, tid);
    conv_job<true, true>(p.in[11], 32, 1024, 512, 512, (bf16_t*)(p.ws + W_GU), 1, base, lds, bid, nb, tid);
    conv_job(p.in[12], 32, 256, 1024, 1024, (bf16_t*)(p.ws + W_DN), 0, base, lds, bid, nb, tid);
    (void)ws16;
    float* sc = lds;
    for (int i = tid; i < 9 * 1024; i += NTHREADS) {
        const int r = i >> 10, k = i & 1023;
        const float v = r < 8 ? p.in[1][r * 1024 + k] : p.in[3][k];
        sc[i] = silu_f(v);
    }
    __syncthreads();
    float* part = (float*)(p.ws + WS_MODP);
    for (int it = bid; it < 768; it += nb) {
        const int kc = it / 48, rem = it - kc * 48, l = rem / 12, nch = rem - l * 12;
        const int n = nch * 512 + tid;
        const float* w = p.in[4] + ((size_t)l * 1024 + kc * 64) * 6144 + n;
        float acc[9];
#pragma unroll
        for (int r = 0; r < 9; ++r) acc[r] = 0.f;
#pragma unroll 8
        for (int k = 0; k < 64; ++k) {
            const float wv = __builtin_nontemporal_load(w + (size_t)k * 6144);
#pragma unroll
            for (int r = 0; r < 9; ++r) acc[r] += sc[r * 1024 + kc * 64 + k] * wv;
        }
#pragma unroll
        for (int r = 0; r < 9; ++r) part[(((size_t)kc * 4 + l) * 9 + r) * 6144 + n] = acc[r];
    }
    __syncthreads();
}
DI void phase_mod_reduce(const Params& p, int bid, int nb, int tid) {
    const float* part = (const float*)(p.ws + WS_MODP);
    float* mod = (float*)(p.ws + WS_MOD);
    const int total = 4 * 9 * 6144;
    for (int i = bid * NTHREADS + tid; i < total; i += nb * NTHREADS) {
        const int l = i / (9 * 6144), n = i % 6144;
        float s = p.in[5][l * 6144 + n];
#pragma unroll
        for (int kc = 0; kc < 16; ++kc) s += part[(size_t)kc * total + i];
        mod[i] = s;
    }
}

template <int MODE>
DI void phase_rows(const Params& p, int layer  , int which  , int bid, int nb, int tid) {
    const int wid = __builtin_amdgcn_readfirstlane(tid >> 6), lane = tid & 63;
    const float* modall = (const float*)(p.ws + WS_MOD);
    const bf16_t* eo = (const bf16_t*)(p.ws + WS_RAW);
    bf16_t* H = (bf16_t*)(p.ws + WS_H);
    const int rpw = (MROWS + nb * NW - 1) / (nb * NW), rbeg = (bid * NW + wid) * rpw, rend = min(MROWS, rbeg + rpw);
    int mr_have = -1;
    f32x4 g2v[4], gmv[4], shv[4];
    for (int r = rbeg; r < rend; ++r) {
        const int b = r / PP, pos = r - b * PP;
        if ((MODE & 16) && pos >= SEQ) continue;
        const int mr = pos < SEQ ? b : 8;
        if (mr != mr_have) {
            mr_have = mr;
            if (MODE & 1) { const float* g2 = modall + ((size_t)(layer - ((MODE & 2) ? 1 : 0)) * 9 + mr) * 6144 + 5120;
#pragma unroll
                for (int j = 0; j < 4; ++j) g2v[j] = *(const f32x4*)(g2 + lane * 4 + 256 * j) * (1.0f / 16.0f); }
            if (MODE & 2) { const float* ng = p.in[6] + ((size_t)layer * 2 + which) * 1024; const float* md = modall + ((size_t)layer * 9 + mr) * 6144 + which * 3072;
#pragma unroll
                for (int j = 0; j < 4; ++j) { const f32x4 g = *(const f32x4*)(ng + lane * 4 + 256 * j), sc = *(const f32x4*)(md + 1024 + lane * 4 + 256 * j);
                    shv[j] = *(const f32x4*)(md + lane * 4 + 256 * j); gmv[j] = (f32x4){g.x * (1.0f + sc.x), g.y * (1.0f + sc.y), g.z * (1.0f + sc.z), g.w * (1.0f + sc.w)}; } }
        }
        bf16_t* xb = xb_row(p, r);
        float x[16];
        if (MODE & 8) {
            const float* xr = pos < SEQ ? p.in[0] + ((size_t)b * SEQ + pos) * DM : p.in[2] + ((size_t)b * CTXL + (pos - SEQ)) * DM;
#pragma unroll
            for (int j = 0; j < 4; ++j) { const f32x4 v = *(const f32x4*)(xr + lane * 4 + 256 * j); x[4 * j] = v.x; x[4 * j + 1] = v.y; x[4 * j + 2] = v.z; x[4 * j + 3] = v.w; }
        } else {
#pragma unroll
            for (int j = 0; j < 4; ++j) { const u32x2 v = *(const u32x2*)(xb + lane * 4 + 256 * j); x[4 * j] = bflo(v.x); x[4 * j + 1] = bfhi(v.x); x[4 * j + 2] = bflo(v.y); x[4 * j + 3] = bfhi(v.y); }
        }
        if (MODE & 1) {
            const unsigned char* y0 = (const unsigned char*)eo + (size_t)(2 * r) * 1024, *y1 = y0 + 1024;
#pragma unroll
            for (int j = 0; j < 4; ++j) {
                const unsigned a = *(const unsigned*)(y0 + lane * 4 + 256 * j), bb = *(const unsigned*)(y1 + lane * 4 + 256 * j);
                const f32x4 g = g2v[j];
                const f32x2_8 a01 = __builtin_amdgcn_cvt_pk_f32_fp8((int)a, false), a23 = __builtin_amdgcn_cvt_pk_f32_fp8((int)a, true);
                const f32x2_8 b01 = __builtin_amdgcn_cvt_pk_f32_fp8((int)bb, false), b23 = __builtin_amdgcn_cvt_pk_f32_fp8((int)bb, true);
                x[4 * j] += g.x * (a01[0] + b01[0]); x[4 * j + 1] += g.y * (a01[1] + b01[1]);
                x[4 * j + 2] += g.z * (a23[0] + b23[0]); x[4 * j + 3] += g.w * (a23[1] + b23[1]);
            }
        }
        if (MODE & 16) {
            float* orow = p.out + ((size_t)b * SEQ + pos) * DM;
#pragma unroll
            for (int j = 0; j < 4; ++j) *(f32x4*)(orow + lane * 4 + 256 * j) = (f32x4){x[4 * j], x[4 * j + 1], x[4 * j + 2], x[4 * j + 3]};
        } else if (MODE & (1 | 8)) {
#pragma unroll
            for (int j = 0; j < 4; ++j) {
                u32x2 w; w.x = pk2(x[4 * j], x[4 * j + 1]); w.y = pk2(x[4 * j + 2], x[4 * j + 3]);
                *(u32x2*)(xb + lane * 4 + 256 * j) = w;
                x[4 * j] = bflo(w.x); x[4 * j + 1] = bfhi(w.x); x[4 * j + 2] = bflo(w.y); x[4 * j + 3] = bfhi(w.y);
            }
        }
        if (MODE & 2) {
            float ss = 0.f;
#pragma unroll
            for (int i = 0; i < 16; ++i) ss += x[i] * x[i];
            ss = wave_sum(ss);
            const float rs = rsqrtf(ss * (1.0f / 1024.0f) + EPS);
#pragma unroll
            for (int j = 0; j < 4; ++j) {
                const f32x4 g = gmv[j], sh = shv[j];
                const float h0 = x[4 * j] * rs * g.x + sh.x, h1 = x[4 * j + 1] * rs * g.y + sh.y;
                const float h2 = x[4 * j + 2] * rs * g.z + sh.z, h3 = x[4 * j + 3] * rs * g.w + sh.w;
                if (MODE & 32) *(unsigned*)((unsigned char*)H + (size_t)r * 1024 + lane * 4 + 256 * j) = cvt_fp8x4(h0, h1, h2, h3);
                else { u32x2 w; w.x = pk2(h0, h1); w.y = pk2(h2, h3); *(u32x2*)(H + (size_t)r * 1024 + lane * 4 + 256 * j) = w; }
            }
        }
    }
}

constexpr size_t WS_RC = WS_MOD + 917504;
DI void phase_router_prep(const Params& p, int bid, int nb, int tid) {
    const float* modall = (const float*)(p.ws + WS_MOD);
    bf16_t* wth = (bf16_t*)(p.ws + WS_RW); bf16_t* wtl = wth + 4 * 9 * 48 * 1024;
    const int total = 4 * 9 * 48 * 1024;
    for (int i = bid * NTHREADS + tid; i < total; i += nb * NTHREADS) {
        const int k = i & 1023, c = (i >> 10) % 48, lb = i / (48 * 1024), l = lb / 9, b = lb - l * 9;
        float v = 0.f;
        if (c < 36) {
            const float w = c < 32 ? p.in[9][((size_t)l * 1024 + k) * 32 + c] : p.in[7][((size_t)l * 1024 + k) * 4 + (c - 32)];
            v = p.in[6][((size_t)l * 2 + 1) * 1024 + k] * (1.0f + modall[((size_t)l * 9 + b) * 6144 + 4096 + k]) * w;
        }
        const unsigned hb = f2bf(v); wth[i] = (bf16_t)hb; wtl[i] = (bf16_t)f2bf(v - bf2f(hb));
    }
    float* cst = (float*)(p.ws + WS_RC);
    const int wid = __builtin_amdgcn_readfirstlane(tid >> 6), lane = tid & 63;
    for (int j = bid * NW + wid; j < 4 * 9 * 48; j += nb * NW) {
        const int c = j % 48, lb = j / 48, l = lb / 9, b = lb - l * 9;
        float acc = 0.f;
        if (c < 36) {
            for (int k = lane; k < 1024; k += 64) {
                const float w = c < 32 ? p.in[9][((size_t)l * 1024 + k) * 32 + c] : p.in[7][((size_t)l * 1024 + k) * 4 + (c - 32)];
                acc += modall[((size_t)l * 9 + b) * 6144 + 3072 + k] * w;
            }
            acc = wave_sum(acc) + (c < 32 ? p.in[10][l * 32 + c] : p.in[8][l * 4 + (c - 32)]);
        }
        if (lane == 0) cst[j] = acc;
    }
}
typedef float f32x2_3 __attribute__((ext_vector_type(2)));
typedef __bf16 bf16x2_3 __attribute__((ext_vector_type(2)));
DI unsigned cvtpk3(float lo, float hi) { f32x2_3 v = {lo, hi}; bf16x2_3 b = __builtin_convertvector(v, bf16x2_3); return __builtin_bit_cast(unsigned, b); }
DI void phase_router(const Params& p, unsigned char* smem, int layer, bool skip_ctx, int bid, int nb, int tid) {
    const int lane = tid & 63, wid = __builtin_amdgcn_readfirstlane(tid >> 6), li = lane & 15, kq = lane >> 4;
    LAS float* tile = (LAS float*)smem + wid * (32 * 49);
    const bf16_t* wth_all = (const bf16_t*)(p.ws + WS_RW) + (size_t)layer * 9 * 48 * 1024;
    const bf16_t* wtl_all = wth_all + 4 * 9 * 48 * 1024;
    const float* cst_all = (const float*)(p.ws + WS_RC) + layer * 9 * 48;
    unsigned* cnt = (unsigned*)(p.ws + WS_CTL) + CW_CNT + layer * 32;
    unsigned* list = (unsigned*)(p.ws + WS_LIST);
    float* gates = (float*)(p.ws + WS_GATE);
    if (layer > 0) {
        int base = 0;
        conv_job<false, true>(p.in[11] + (size_t)layer * 32 * 1024 * 512, 32, 1024, 512, 512, (bf16_t*)(p.ws + W_GU + (size_t)layer * 32 * 512 * 1024), 1, base, (float*)smem, bid, nb, tid);
        conv_job<false>(p.in[12] + (size_t)layer * 32 * 256 * 1024, 32, 256, 1024, 1024, (bf16_t*)(p.ws + W_DN) + (size_t)layer * 32 * 1024 * 256, 0, base, (float*)smem, bid, nb, tid);
    }
    for (int u = bid * NW + wid; u < MROWS / 32; u += nb * NW) {
        const int r0 = u * 32, b = r0 / PP, pos = r0 - b * PP;
        const bool isctx = pos >= SEQ;
        if (skip_ctx && isctx) continue;
        const int mr = isctx ? 8 : b;
        const bf16_t* xr = xb_row(p, r0 + li) + 8 * kq;
        const bf16_t* wh = wth_all + ((size_t)mr * 48 + li) * 1024 + 8 * kq;
        const bf16_t* wl = wtl_all + ((size_t)mr * 48 + li) * 1024 + 8 * kq;
        f32x4 acc[2][3];
#pragma unroll
        for (int m = 0; m < 2; ++m)
#pragma unroll
            for (int n = 0; n < 3; ++n) acc[m][n] = (f32x4){0.f, 0.f, 0.f, 0.f};
        float ss[2] = {0.f, 0.f};
#pragma unroll 2
        for (int s = 0; s < 32; ++s) {
            bf16x8 xa[2], bh[3], bl[3];
#pragma unroll
            for (int m = 0; m < 2; ++m) xa[m] = *(const bf16x8*)(xr + (size_t)m * 16 * DM + 32 * s);
#pragma unroll
            for (int n = 0; n < 3; ++n) { bh[n] = *(const bf16x8*)(wh + (size_t)n * 16 * 1024 + 32 * s); bl[n] = *(const bf16x8*)(wl + (size_t)n * 16 * 1024 + 32 * s); }
#pragma unroll
            for (int m = 0; m < 2; ++m) {
                const u32x4 w = __builtin_bit_cast(u32x4, xa[m]);
                ss[m] += bflo(w.x) * bflo(w.x) + bfhi(w.x) * bfhi(w.x) + bflo(w.y) * bflo(w.y) + bfhi(w.y) * bfhi(w.y) + bflo(w.z) * bflo(w.z) + bfhi(w.z) * bfhi(w.z) + bflo(w.w) * bflo(w.w) + bfhi(w.w) * bfhi(w.w);
#pragma unroll
                for (int n = 0; n < 3; ++n) {
                    acc[m][n] = __builtin_amdgcn_mfma_f32_16x16x32_bf16(xa[m], bl[n], acc[m][n], 0, 0, 0);
                    acc[m][n] = __builtin_amdgcn_mfma_f32_16x16x32_bf16(xa[m], bh[n], acc[m][n], 0, 0, 0);
                }
            }
        }
#pragma unroll
        for (int m = 0; m < 2; ++m) { ss[m] += __shfl_xor(ss[m], 16); ss[m] += __shfl_xor(ss[m], 32); }
#pragma unroll
        for (int m = 0; m < 2; ++m)
#pragma unroll
            for (int n = 0; n < 3; ++n)
#pragma unroll
                for (int i = 0; i < 4; ++i) tile[(16 * m + 4 * kq + i) * 49 + n * 16 + li] = acc[m][n][i];
        __builtin_amdgcn_s_waitcnt(0xc07f);
        const float ssr = (lane & 16) ? ss[1] : ss[0];
        const float rs = rsqrtf(ssr * (1.0f / 1024.0f) + EPS);
        if (lane < 32) {
            const float* cst = cst_all + mr * 48;
            const LAS float* tr = tile + lane * 49;
            float lg[4];
#pragma unroll
            for (int c = 0; c < 4; ++c) lg[c] = tr[32 + c] * rs + cst[32 + c];
            int gi = 0; float gm = lg[0];
#pragma unroll
            for (int c = 1; c < 4; ++c) if (lg[c] > gm) { gm = lg[c]; gi = c; }
            float gden = 0.f;
#pragma unroll
            for (int c = 0; c < 4; ++c) gden += __expf(lg[c] - gm);
            const float gw = 1.0f / gden;
            float le[8];
#pragma unroll
            for (int c = 0; c < 8; ++c) le[c] = tr[gi * 8 + c] * rs + cst[gi * 8 + c];
            int e0 = 0; float m0 = le[0];
#pragma unroll
            for (int c = 1; c < 8; ++c) if (le[c] > m0) { m0 = le[c]; e0 = c; }
            int e1 = -1; float m1 = -INFINITY;
#pragma unroll
            for (int c = 0; c < 8; ++c) if (c != e0 && le[c] > m1) { m1 = le[c]; e1 = c; }
            const float q1 = __expf(m1 - m0), inv = 1.0f / (1.0f + q1);
            const int r = r0 + lane, ex0 = gi * 8 + e0, ex1 = gi * 8 + e1;
            const unsigned s0 = atomicAdd(cnt + ex0, 1u), s1 = atomicAdd(cnt + ex1, 1u);
            list[(size_t)ex0 * MROWS + s0] = 2u * r; list[(size_t)ex1 * MROWS + s1] = 2u * r + 1u;
            gates[2 * r] = gw * inv; gates[2 * r + 1] = gw * q1 * inv;
        }
        {
            const float* ng = p.in[6] + ((size_t)layer * 2 + 1) * 1024;
            const float* md = (const float*)(p.ws + WS_MOD) + ((size_t)layer * 9 + mr) * 6144 + 3072;
            f32x4 gm[4], sh[4];
#pragma unroll
            for (int j = 0; j < 4; ++j) {
                const f32x4 g = *(const f32x4*)(ng + lane * 4 + 256 * j), sc = *(const f32x4*)(md + 1024 + lane * 4 + 256 * j);
                sh[j] = *(const f32x4*)(md + lane * 4 + 256 * j);
                gm[j] = (f32x4){g.x * (1.0f + sc.x), g.y * (1.0f + sc.y), g.z * (1.0f + sc.z), g.w * (1.0f + sc.w)};
            }
            unsigned char* H8 = p.ws + WS_H;
#pragma unroll 4
            for (int i = 0; i < 32; ++i) {
                const float rsi = __shfl(rs, i);
                const bf16_t* xb = xb_row(p, r0 + i);
#pragma unroll
                for (int j = 0; j < 4; ++j) {
                    const u32x2 v = *(const u32x2*)(xb + lane * 4 + 256 * j);
                    *(unsigned*)(H8 + (size_t)(r0 + i) * 1024 + lane * 4 + 256 * j) =
                        cvt_fp8x4(bflo(v.x) * rsi * gm[j].x + sh[j].x, bfhi(v.x) * rsi * gm[j].y + sh[j].y, bflo(v.y) * rsi * gm[j].z + sh[j].z, bfhi(v.y) * rsi * gm[j].w + sh[j].w);
                }
            }
        }
    }
}

#define MFMA32(a, b, c) __builtin_amdgcn_mfma_f32_32x32x16_bf16((a), (b), (c), 0, 0, 0)
typedef LAS unsigned char* lds_ptr;
constexpr int GEMM_TM = 256, GEMM_TN = 256;
constexpr int GEMM_STAGE = 65536;
constexpr int GEMM_LDS = 2 * GEMM_STAGE;
constexpr int GEMM_MT = 4;

struct RowDense { static constexpr bool DENSE = true; const bf16_t* A; int lda; int m0; DI unsigned row(int i) const { return (unsigned)(m0 + i) * (unsigned)lda; } };
struct RowGather { static constexpr bool DENSE = false; const bf16_t* A; int lda; const unsigned* ent; int valid; int shift;
    DI unsigned row(int i) const { const unsigned e = ent[i < valid ? i : valid - 1]; return (e >> shift) * (unsigned)lda; } };

struct EpiStore { bf16_t* C; int ldc; int m0;
    DI void wave_tile(const f32x16 (&acc)[2][GEMM_MT], int mloc, int ncol, int lane) const {
        const int r = lane & 31, h = lane >> 5;
#pragma unroll
        for (int mt = 0; mt < GEMM_MT; ++mt) {
            bf16_t* c = C + (size_t)(m0 + mloc + mt * 32 + r) * ldc + ncol + 4 * h;
#pragma unroll
            for (int nt = 0; nt < 2; ++nt)
#pragma unroll
                for (int g = 0; g < 4; ++g) {
                    u32x2 w; w.x = pk2(acc[nt][mt][4 * g], acc[nt][mt][4 * g + 1]); w.y = pk2(acc[nt][mt][4 * g + 2], acc[nt][mt][4 * g + 3]);
                    *(u32x2*)(c + nt * 32 + 8 * g) = w;
                }
        }
    } };
struct EpiResid { const Params* p; const float* mod; int m0;
    DI void wave_tile(const f32x16 (&acc)[2][GEMM_MT], int mloc, int ncol, int lane) const {
        const int r = lane & 31, h = lane >> 5;
#pragma unroll
        for (int mt = 0; mt < GEMM_MT; ++mt) {
            const int row = m0 + mloc + mt * 32 + r;
            float* xr = xrow_ptr(*p, row) + ncol + 4 * h;
            const float* gp = mod + (size_t)mod_row(row) * 6144 + 2048 + ncol + 4 * h;
#pragma unroll
            for (int nt = 0; nt < 2; ++nt)
#pragma unroll
                for (int g = 0; g < 4; ++g) {
                    f32x4 x = *(f32x4*)(xr + nt * 32 + 8 * g);
                    const f32x4 gg = *(const f32x4*)(gp + nt * 32 + 8 * g);
                    x.x += gg.x * acc[nt][mt][4 * g]; x.y += gg.y * acc[nt][mt][4 * g + 1]; x.z += gg.z * acc[nt][mt][4 * g + 2]; x.w += gg.w * acc[nt][mt][4 * g + 3];
                    *(f32x4*)(xr + nt * 32 + 8 * g) = x;
                }
        }
    } };
struct EpiGlu { bf16_t* act; const unsigned* ent; const float* gates; int valid;
    DI void wave_tile(const f32x16 (&acc)[2][GEMM_MT], int mloc, int ncol, int lane) const {
        const int r = lane & 31, h = lane >> 5;
#pragma unroll
        for (int mt = 0; mt < GEMM_MT; ++mt) {
            const int i = mloc + mt * 32 + r;
            if (i < valid) {
                const unsigned a = ent[i];
                const float gw = gates[a];
                bf16_t* o = act + (size_t)a * DEXP + (ncol >> 6) * 32 + 4 * h;
#pragma unroll
                for (int g = 0; g < 4; ++g) {
                    float v[4];
#pragma unroll
                    for (int j = 0; j < 4; ++j) v[j] = silu_f(acc[0][mt][4 * g + j]) * acc[1][mt][4 * g + j] * gw;
                    u32x2 w; w.x = pk2(v[0], v[1]); w.y = pk2(v[2], v[3]);
                    *(u32x2*)(o + 8 * g) = w;
                }
            }
        }
    } };
struct EpiScatter { bf16_t* outp; const unsigned* ent; int valid;
    DI void wave_tile(const f32x16 (&acc)[2][GEMM_MT], int mloc, int ncol, int lane) const {
        const int r = lane & 31, h = lane >> 5;
#pragma unroll
        for (int mt = 0; mt < GEMM_MT; ++mt) {
            const int i = mloc + mt * 32 + r;
            if (i < valid) {
                bf16_t* c = outp + (size_t)ent[i] * 1024 + ncol + 4 * h;
#pragma unroll
                for (int nt = 0; nt < 2; ++nt)
#pragma unroll
                    for (int g = 0; g < 4; ++g) {
                        u32x2 w; w.x = pk2(acc[nt][mt][4 * g], acc[nt][mt][4 * g + 1]); w.y = pk2(acc[nt][mt][4 * g + 2], acc[nt][mt][4 * g + 3]);
                        *(u32x2*)(c + nt * 32 + 8 * g) = w;
                    }
            }
        }
    } };

#define SCHED_FENCE() __builtin_amdgcn_sched_barrier(0)
DI void glds16(const bf16_t* g, lds_ptr l) { __builtin_amdgcn_global_load_lds((const unsigned*)g, (LAS unsigned*)l, 16, 0, 0); }
template <int PROBE, int NAG>
DI void gemm_kstep(f32x16 (&acc)[2][GEMM_MT], const lds_ptr st, const unsigned (&arow)[GEMM_MT], const unsigned (&wrow)[2], const unsigned (&aswz)[GEMM_MT], const unsigned (&wswz)[2], int h,
                   bool issue, const bf16_t* __restrict__ An, const bf16_t* __restrict__ Wn, const unsigned (&ag)[NAG], unsigned astep, const unsigned (&bg)[2], unsigned bstep, const lds_ptr sn) {
    if (PROBE != 2 && issue) {
#pragma unroll
        for (int j = 0; j < 8; ++j) { glds16(An + (NAG == 2 ? ag[j & 1] + (j >> 1) * astep : ag[j % NAG]), sn + j * 1024); glds16(Wn + bg[j & 1] + (j >> 1) * bstep, sn + 32768 + j * 1024); }
    }
    if (PROBE == 1) return;
    bf16x8 af[2][GEMM_MT], wf[2][2];
#pragma unroll
    for (int t = 0; t < 2; ++t) wf[0][t] = *(const LAS bf16x8*)(st + wrow[t] + ((((unsigned)h) ^ wswz[t]) << 4));
#pragma unroll
    for (int t = 0; t < GEMM_MT; ++t) af[0][t] = *(const LAS bf16x8*)(st + arow[t] + ((((unsigned)h) ^ aswz[t]) << 4));
#pragma unroll
    for (int kk = 0; kk < 4; ++kk) {
        if (kk < 3) {
#pragma unroll
            for (int t = 0; t < 2; ++t) wf[(kk + 1) & 1][t] = *(const LAS bf16x8*)(st + wrow[t] + ((((unsigned)((kk + 1) * 2 + h)) ^ wswz[t]) << 4));
#pragma unroll
            for (int t = 0; t < GEMM_MT; ++t) af[(kk + 1) & 1][t] = *(const LAS bf16x8*)(st + arow[t] + ((((unsigned)((kk + 1) * 2 + h)) ^ aswz[t]) << 4));
        }
        SCHED_FENCE();
        __builtin_amdgcn_s_setprio(1);
#pragma unroll
        for (int mt = 0; mt < GEMM_MT; ++mt)
#pragma unroll
            for (int nt = 0; nt < 2; ++nt) acc[nt][mt] = MFMA32(wf[kk & 1][nt], af[kk & 1][mt], acc[nt][mt]);
        __builtin_amdgcn_s_setprio(0);
        SCHED_FENCE();
    }
}
template <class RowSrc, class Epi, int PROBE = 0>
DI void gemm_tile_mfma(unsigned char* smem, const RowSrc& rs, const bf16_t* __restrict__ Wt, int K, int n0, const Epi& epi, int tid) {
    const lds_ptr lds = (lds_ptr)smem;
    const int lane = tid & 63, wid = __builtin_amdgcn_readfirstlane(tid >> 6), wm = wid & 1, wn = wid >> 1, r = lane & 31, h = lane >> 5;
    const bool loader = wid < 4;
    const int lw = wid & 3;
    constexpr int NAG = RowSrc::DENSE ? 2 : 8;
    unsigned ag[NAG], bg[2];
    const bf16_t* __restrict__ Ab = rs.A;
#pragma unroll
    for (int j = 0; j < NAG; ++j) {
        const int row = (lw * 8 + j) * 8 + (lane >> 3), c = (lane & 7) ^ ((row >> 1) & 7);
        ag[j] = rs.row(row) + c * 8;
    }
#pragma unroll
    for (int j = 0; j < 2; ++j) {
        const int row = (lw * 8 + j) * 8 + (lane >> 3), c = (lane & 7) ^ ((row >> 1) & 7);
        bg[j] = (unsigned)(n0 + row) * (unsigned)K + c * 8;
    }
    const unsigned astep = 16u * (unsigned)rs.lda, bstep = 16u * (unsigned)K;
    const unsigned dmaoff = (unsigned)lw * 8192u;
    unsigned arow[GEMM_MT], wrow[2], aswz[GEMM_MT], wswz[2];
#pragma unroll
    for (int t = 0; t < GEMM_MT; ++t) { const int ra = wm * 128 + t * 32 + r; arow[t] = ra * 128; aswz[t] = (ra >> 1) & 7; }
#pragma unroll
    for (int t = 0; t < 2; ++t) { const int rw = wn * 64 + t * 32 + r; wrow[t] = 32768 + rw * 128; wswz[t] = (rw >> 1) & 7; }
    f32x16 acc[2][GEMM_MT];
#pragma unroll
    for (int a = 0; a < 2; ++a)
#pragma unroll
        for (int b = 0; b < GEMM_MT; ++b)
#pragma unroll
            for (int i = 0; i < 16; ++i) acc[a][b][i] = 0.f;
    if (loader) {
#pragma unroll
        for (int j = 0; j < 8; ++j) { glds16(Ab + (NAG == 2 ? ag[j & 1] + (j >> 1) * astep : ag[j % NAG]), lds + dmaoff + j * 1024); glds16(Wt + bg[j & 1] + (j >> 1) * bstep, lds + 32768 + dmaoff + j * 1024); }
    }
    asm volatile("s_waitcnt vmcnt(0)" ::: "memory");
    __syncthreads();
    const int KT = K >> 6;
    for (int kt = 0; kt < KT; ++kt) {
        gemm_kstep<PROBE, NAG>(acc, lds + (kt & 1) * GEMM_STAGE, arow, wrow, aswz, wswz, h, loader && kt + 1 < KT, Ab + (kt + 1) * 64, Wt + (kt + 1) * 64, ag, astep, bg, bstep, lds + ((kt + 1) & 1) * GEMM_STAGE + dmaoff);
        asm volatile("s_waitcnt vmcnt(0)" ::: "memory");
        __syncthreads();
    }
    if (PROBE == 0 || acc[0][0][0] == 12345.678f) epi.wave_tile(acc, wm * 128, n0 + wn * 64, lane);
}

template <int EPIK, int PROBE = 0>
DI void gemm_dense(const Params& p, unsigned char* smem, const bf16_t* A, int lda, const bf16_t* Wt, int K, int N, bf16_t* C, int ldc, const float* mod, int bid, int nb, int tid) {
    const int tn = N / GEMM_TN, total = (MROWS / GEMM_TM) * tn;
    for (int t = bid; t < total; t += nb) {
        const int mt = t / tn, nt = t - mt * tn;
        RowDense rs{A, lda, mt * GEMM_TM};
        if (EPIK == 0) { EpiStore e{C, ldc, mt * GEMM_TM}; gemm_tile_mfma<RowDense, EpiStore, PROBE>(smem, rs, Wt, K, nt * GEMM_TN, e, tid); }
        else { EpiResid e{&p, mod, mt * GEMM_TM}; gemm_tile_mfma(smem, rs, Wt, K, nt * GEMM_TN, e, tid); }
    }
}
template <int WHICH>
DI void gemm_moe(const Params& p, unsigned char* smem, int layer, int bid, int nb, int tid) {
    const unsigned* cnt = (const unsigned*)(p.ws + WS_CTL) + CW_CNT + layer * 32;
    const unsigned* list = (const unsigned*)(p.ws + WS_LIST);
    const float* gates = (const float*)(p.ws + WS_GATE);
    const bf16_t* H = (const bf16_t*)(p.ws + WS_H);
    bf16_t* act = (bf16_t*)(p.ws + WS_Q);
    bf16_t* eo = (bf16_t*)(p.ws + WS_RAW);
    constexpr int TN = WHICH == 0 ? 2 : 4;
    int total = 0;
    for (int e = 0; e < NEXP; ++e) total += (int)((cnt[e] + 255u) >> 8) * TN;
    for (int t = bid; t < total; t += nb) {
        int e = 0, rem = t;
        for (; e < NEXP; ++e) { const int te = (int)((cnt[e] + 255u) >> 8) * TN; if (rem < te) break; rem -= te; }
        const int rt = rem / TN, ct = rem - rt * TN;
        const unsigned* ent = list + (size_t)e * MROWS + rt * GEMM_TM;
        const int valid = min(GEMM_TM, (int)cnt[e] - rt * GEMM_TM);
        if (WHICH == 0) {
            RowGather rs{H, 1024, ent, valid, 1};
            EpiGlu ep{act, ent, gates, valid};
            gemm_tile_mfma(smem, rs, (const bf16_t*)(p.ws + W_GU) + ((size_t)layer * 32 + e) * 512 * 1024, 1024, ct * GEMM_TN, ep, tid);
        } else {
            RowGather rs{act, DEXP, ent, valid, 0};
            EpiScatter ep{eo, ent, valid};
            gemm_tile_mfma(smem, rs, (const bf16_t*)(p.ws + W_DN) + ((size_t)layer * 32 + e) * 1024 * 256, 256, ct * GEMM_TN, ep, tid);
        }
    }
}

DI float quad_sum(float v) { v += __shfl_xor(v, 1); v += __shfl_xor(v, 2); return v; }
DI void head64_norm_rope(const bf16_t* src, bf16_t* dst, const float* gain, int sub, bool rope, int prow, int pcol, float scale) {
    float a[8], b[8];
    unpack8(*(const u32x4*)(src + sub * 8), a); unpack8(*(const u32x4*)(src + 32 + sub * 8), b);
    float ss = 0.f;
#pragma unroll
    for (int e = 0; e < 8; ++e) ss += a[e] * a[e] + b[e] * b[e];
    ss = quad_sum(ss);
    const float rs = rsqrtf(ss * (1.0f / 64.0f) + EPS);
#pragma unroll
    for (int e = 0; e < 8; ++e) { a[e] *= rs * gain[sub * 8 + e]; b[e] *= rs * gain[32 + sub * 8 + e]; }
    if (rope) {
#pragma unroll
        for (int e = 0; e < 8; ++e) {
            const int i = sub * 8 + e;
            const float* cs = ROPE64 + ((i < 16 ? prow : pcol) * 16 + (i & 15)) * 2;
            const float c = cs[0], s = cs[1], x1 = a[e], x2 = b[e];
            a[e] = x1 * c - x2 * s; b[e] = x2 * c + x1 * s;
        }
    }
#pragma unroll
    for (int e = 0; e < 8; ++e) { a[e] *= scale; b[e] *= scale; }
    *(u32x4*)(dst + sub * 8) = pack8(a); *(u32x4*)(dst + 32 + sub * 8) = pack8(b);
}
template <int KIND>
DI void phase_post_qk(const Params& p, int bid, int nb, int tid) {
    const int wid = __builtin_amdgcn_readfirstlane(tid >> 6), lane = tid & 63, hd = lane >> 2, sub = lane & 3;
    constexpr int NRAW = KIND == 1 ? 1536 : 3072, KH = KIND == 1 ? 4 : 16;
    const bf16_t* raw = (const bf16_t*)(p.ws + WS_RAW);
    bf16_t* Q = (bf16_t*)(p.ws + WS_Q); bf16_t* Kb = (bf16_t*)(p.ws + WS_K);
    const float* qn = p.in[KIND == 0 ? 15 : KIND == 1 ? 20 : 32];
    const float* kn = p.in[KIND == 0 ? 16 : KIND == 1 ? 21 : 33];
    const float qscale = 0.125f * LOG2E;
    for (int r = bid * NW + wid; r < MROWS; r += nb * NW) {
        const int b = r / PP, pos = r - b * PP;
        const bool rope = (KIND != 0) && pos < SEQ;
        const int prow = (pos >> 6) & 63, pcol = pos & 63;
        const bf16_t* rr = raw + (size_t)r * NRAW;
        head64_norm_rope(rr + hd * 64, Q + (size_t)r * 1024 + hd * 64, qn, sub, rope, prow, pcol, qscale);
        if (hd < KH) head64_norm_rope(rr + 1024 + hd * 64, Kb + (size_t)r * (KH * 64) + hd * 64, kn, sub, rope, prow, pcol, 1.0f);
    }
}
DI void phase_post_mla1(const Params& p, int bid, int nb, int tid) {
    const int wid = __builtin_amdgcn_readfirstlane(tid >> 6), lane = tid & 63;
    const bf16_t* raw = (const bf16_t*)(p.ws + WS_Q);
    bf16_t* cqn = (bf16_t*)(p.ws + WS_O);
    bf16_t* ckvn = cqn + (size_t)MROWS * 384;
    bf16_t* krope = ckvn + (size_t)MROWS * 256;
    const float* qa = p.in[24]; const float* kva = p.in[25]; const float* kn = p.in[29];
    for (int r = bid * NW + wid; r < MROWS; r += nb * NW) {
        const int b = r / PP, pos = r - b * PP;
        const bf16_t* rr = raw + (size_t)r * 768;
        {
            float v[8];
#pragma unroll
            for (int j = 0; j < 8; ++j) v[j] = 0.f;
            if (lane < 48) unpack8(*(const u32x4*)(rr + lane * 8), v);
            float ss = 0.f;
#pragma unroll
            for (int j = 0; j < 8; ++j) ss += v[j] * v[j];
            ss = wave_sum(ss);
            const float rs = rsqrtf(ss * (1.0f / 384.0f) + EPS);
            if (lane < 48) {
#pragma unroll
                for (int j = 0; j < 8; ++j) v[j] *= rs * qa[lane * 8 + j];
            }
            u32x2 o; o.x = cvt_fp8x4(v[0], v[1], v[2], v[3]); o.y = cvt_fp8x4(v[4], v[5], v[6], v[7]);
            *(u32x2*)((unsigned char*)cqn + (size_t)r * 512 + lane * 8) = o;
        }
        {
            const u32x2 w = *(const u32x2*)(rr + 384 + lane * 4);
            float v[4] = {bflo(w.x), bfhi(w.x), bflo(w.y), bfhi(w.y)};
            float ss = v[0] * v[0] + v[1] * v[1] + v[2] * v[2] + v[3] * v[3];
            ss = wave_sum(ss);
            const float rs = rsqrtf(ss * (1.0f / 256.0f) + EPS);
            *(unsigned*)((unsigned char*)cqn + (size_t)MROWS * 512 + (size_t)r * 256 + lane * 4) = cvt_fp8x4(v[0] * rs * kva[lane * 4], v[1] * rs * kva[lane * 4 + 1], v[2] * rs * kva[lane * 4 + 2], v[3] * rs * kva[lane * 4 + 3]);
        }
        {
            float x1 = 0.f, x2 = 0.f;
            if (lane < 16) { x1 = bf2f(rr[640 + lane]); x2 = bf2f(rr[640 + 16 + lane]); }
            float ss = wave_sum(x1 * x1 + x2 * x2);
            const float rs = rsqrtf(ss * (1.0f / 32.0f) + EPS);
            if (lane < 16) {
                x1 *= rs * kn[64 + lane]; x2 *= rs * kn[64 + 16 + lane];
                if (pos < SEQ) {
                    const int prow = (pos >> 6) & 63, pcol = pos & 63;
                    const float* cs = ROPE32 + ((lane < 8 ? prow : pcol) * 8 + (lane & 7)) * 2;
                    const float c = cs[0], s = cs[1], a = x1, bb = x2;
                    x1 = a * c - bb * s; x2 = bb * c + a * s;
                }
            }
            {
                const int hh = lane >> 2, q = lane & 3;
                float vals[8];
#pragma unroll
                for (int j = 0; j < 8; ++j) { const int src = (8 * q + j) & 15; const float a = __shfl(x1, src), bb = __shfl(x2, src); vals[j] = q < 2 ? a : bb; }
                bf16_t* kr = (bf16_t*)(p.ws + WS_K) + (size_t)r * 1536 + 64;
                *(u32x4*)(kr + hh * 96 + 8 * q) = pack8(vals);
            }
        }
    }
}
DI void phase_post_mla2(const Params& p, int bid, int nb, int tid) {
    const int wid = __builtin_amdgcn_readfirstlane(tid >> 6), lane = tid & 63, hd = lane >> 2, sub = lane & 3;
    const bf16_t* qraw = (const bf16_t*)(p.ws + WS_RAW);
    const bf16_t* kvraw = qraw + (size_t)MROWS * 1536;
    const bf16_t* krope = (const bf16_t*)(p.ws + WS_O) + (size_t)MROWS * 640;
    bf16_t* Q = (bf16_t*)(p.ws + WS_Q); bf16_t* Kb = (bf16_t*)(p.ws + WS_K);
    const float* qn = p.in[28]; const float* kn = p.in[29];
    const float qscale = 0.10206207261596577f * LOG2E;
    for (int r = bid * NW + wid; r < MROWS; r += nb * NW) {
        const int b = r / PP, pos = r - b * PP;
        const bf16_t* qr = qraw + (size_t)r * 1536 + hd * 96;
        bf16_t* qo = Q + (size_t)r * 1536 + hd * 96;
        {
            float a[8], c[8];
            unpack8(*(const u32x4*)(qr + sub * 16), a); unpack8(*(const u32x4*)(qr + sub * 16 + 8), c);
            float ss = 0.f;
#pragma unroll
            for (int e = 0; e < 8; ++e) ss += a[e] * a[e] + c[e] * c[e];
            ss = quad_sum(ss);
            const float rs = rsqrtf(ss * (1.0f / 64.0f) + EPS) * qscale;
#pragma unroll
            for (int e = 0; e < 8; ++e) { a[e] *= rs * qn[sub * 16 + e]; c[e] *= rs * qn[sub * 16 + 8 + e]; }
            *(u32x4*)(qo + sub * 16) = pack8(a); *(u32x4*)(qo + sub * 16 + 8) = pack8(c);
        }
        {
            const u32x2 w1 = *(const u32x2*)(qr + 64 + sub * 4), w2 = *(const u32x2*)(qr + 64 + 16 + sub * 4);
            float x1[4] = {bflo(w1.x), bfhi(w1.x), bflo(w1.y), bfhi(w1.y)}, x2[4] = {bflo(w2.x), bfhi(w2.x), bflo(w2.y), bfhi(w2.y)};
            float ss = 0.f;
#pragma unroll
            for (int e = 0; e < 4; ++e) ss += x1[e] * x1[e] + x2[e] * x2[e];
            ss = quad_sum(ss);
            const float rs = rsqrtf(ss * (1.0f / 32.0f) + EPS);
#pragma unroll
            for (int e = 0; e < 4; ++e) {
                const int i = sub * 4 + e;
                float a = x1[e] * rs * qn[64 + i], bb = x2[e] * rs * qn[64 + 16 + i];
                if (pos < SEQ) {
                    const int prow = (pos >> 6) & 63, pcol = pos & 63;
                    const float* cs = ROPE32 + ((i < 8 ? prow : pcol) * 8 + (i & 7)) * 2;
                    const float c = cs[0], s = cs[1], t1 = a, t2 = bb;
                    a = t1 * c - t2 * s; bb = t2 * c + t1 * s;
                }
                x1[e] = a * qscale; x2[e] = bb * qscale;
            }
            u32x2 o1, o2; o1.x = pk2(x1[0], x1[1]); o1.y = pk2(x1[2], x1[3]); o2.x = pk2(x2[0], x2[1]); o2.y = pk2(x2[2], x2[3]);
            *(u32x2*)(qo + 64 + sub * 4) = o1; *(u32x2*)(qo + 64 + 16 + sub * 4) = o2;
        }
        {
            const bf16_t* kr = kvraw + (size_t)r * 2048 + hd * 128;
            bf16_t* ko = Kb + (size_t)r * 1536 + hd * 96;
            float a[8], c[8];
            unpack8(*(const u32x4*)(kr + sub * 16), a); unpack8(*(const u32x4*)(kr + sub * 16 + 8), c);
            float ss = 0.f;
#pragma unroll
            for (int e = 0; e < 8; ++e) ss += a[e] * a[e] + c[e] * c[e];
            ss = quad_sum(ss);
            const float rs = rsqrtf(ss * (1.0f / 64.0f) + EPS);
#pragma unroll
            for (int e = 0; e < 8; ++e) { a[e] *= rs * kn[sub * 16 + e]; c[e] *= rs * kn[sub * 16 + 8 + e]; }
            *(u32x4*)(ko + sub * 16) = pack8(a); *(u32x4*)(ko + sub * 16 + 8) = pack8(c);
            *(u32x4*)(ko + 64 + sub * 8) = *(const u32x4*)(krope + (size_t)r * 32 + sub * 8);
        }
    }
}
DI void phase_diff_combine(const Params& p, int bid, int nb, int tid) {
    const int wid = __builtin_amdgcn_readfirstlane(tid >> 6), lane = tid & 63, hd = lane >> 3, sub = lane & 7;
    const bf16_t* O12 = (const bf16_t*)(p.ws + WS_H);
    bf16_t* Oc = (bf16_t*)(p.ws + WS_Q);
    const float* lam = p.in[34]; const float* subln = p.in[35];
    const float lambda_init = 0.8f - 0.6f * 0.40656965974059917f;
    const float s1 = wave_sum(lam[lane] * lam[64 + lane]), s2 = wave_sum(lam[128 + lane] * lam[192 + lane]);
    const float lam_full = expf(s1) - expf(s2) + lambda_init;
    for (int r = bid * NW + wid; r < MROWS; r += nb * NW) {
        const bf16_t* o1 = O12 + (size_t)r * 2048 + (2 * hd) * 128 + sub * 16, *o2 = o1 + 128;
        float a[16], c[16];
        unpack8(*(const u32x4*)o1, *(float(*)[8])a); unpack8(*(const u32x4*)(o1 + 8), *(float(*)[8])(a + 8));
        unpack8(*(const u32x4*)o2, *(float(*)[8])c); unpack8(*(const u32x4*)(o2 + 8), *(float(*)[8])(c + 8));
        float ss = 0.f;
#pragma unroll
        for (int e = 0; e < 16; ++e) { a[e] -= lam_full * c[e]; ss += a[e] * a[e]; }
        ss += __shfl_xor(ss, 1); ss += __shfl_xor(ss, 2); ss += __shfl_xor(ss, 4);
        const float rs = rsqrtf(ss * (1.0f / 128.0f) + EPS) * (1.0f - lambda_init);
#pragma unroll
        for (int e = 0; e < 16; ++e) a[e] *= rs * subln[sub * 16 + e];
        bf16_t* o = Oc + (size_t)r * 1024 + hd * 128 + sub * 16;
        *(u32x4*)o = pack8(*(float(*)[8])a); *(u32x4*)(o + 8) = pack8(*(float(*)[8])(a + 8));
    }
}


typedef short s16x4 __attribute__((ext_vector_type(4)));
typedef float f32x2_t __attribute__((ext_vector_type(2)));
typedef __bf16 bf16x2_t __attribute__((ext_vector_type(2)));
DI unsigned cvtpk(float lo, float hi) { f32x2_t v = {lo, hi}; bf16x2_t b = __builtin_convertvector(v, bf16x2_t); return __builtin_bit_cast(unsigned, b); }
DI float xhalf_max(float v) { auto rr = __builtin_amdgcn_permlane32_swap(__float_as_uint(v), __float_as_uint(v), false, false); return fmaxf(__uint_as_float(rr[0]), __uint_as_float(rr[1])); }
DI float xhalf_sum(float v) { auto rr = __builtin_amdgcn_permlane32_swap(__float_as_uint(v), __float_as_uint(v), false, false); return __uint_as_float(rr[0]) + __uint_as_float(rr[1]); }
typedef short v4i16_t __attribute__((__vector_size__(4 * sizeof(short))));
DI s16x4 lds_tr(lds_ptr p) { return __builtin_bit_cast(s16x4, __builtin_amdgcn_ds_read_tr16_b64_v4i16((LAS v4i16_t*)p)); }
constexpr float ATT_BIG = 40.0f, ATT_BIGF = 1.0995116e12f;
DI int crow(int i, int hf) { return (i & 3) + 8 * (i >> 2) + 4 * hf; }

struct AttnP { const bf16_t* Q; int ldq; const bf16_t* K; int ldk; const bf16_t* V; int ldv; bf16_t* O; int ldo; int HQ; int gk; int gv; int vhs  ; const float* bias; const float* sink; int need_ctx; const float* kgain  ; const float* lam; const float* subln; unsigned char* Oc; int ldoc;   };

template <int DQ, int DV, int MODE, int ABL = 0>
DI void attn_mfma(const AttnP& a, unsigned char* smem, int bid, int nb, int tid) {
    constexpr int KSTR = DQ * 2 + 16, KTB = 64 * KSTR, VTB = 64 * DV * 2, NDB = DV / 32, NKK = DQ / 16;
    constexpr int KCH = DQ / 8, VCH = DV / 8, NKI = (64 * KCH + NTHREADS - 1) / NTHREADS, NVI = (64 * VCH + NTHREADS - 1) / NTHREADS;
    static_assert(2 * KTB + 2 * VTB + 2048 <= GEMM_LDS, "attention LDS");
    const lds_ptr lds = (lds_ptr)smem;
    LAS float* biasl = (LAS float*)(lds + 2 * KTB + 2 * VTB);
    const int lane = tid & 63, wid = __builtin_amdgcn_readfirstlane(tid >> 6), r = lane & 31, hf = lane >> 5;
    const int nq = a.need_ctx ? 17 : 16;
    const int xcd = bid & 7, slot = bid >> 3, nslots = nb >> 3, per_xcd = (NBATCH * a.HQ / 8) * nq;
    int koff[NKI], kdst[NKI], voff[NVI], vdst[NVI];
#pragma unroll
    for (int i = 0; i < NKI; ++i) { const int c = min(tid + NTHREADS * i, 64 * KCH - 1), row = c / KCH, kc = c - row * KCH; koff[i] = row * a.ldk + kc * 8; kdst[i] = row * KSTR + kc * 16; }
#pragma unroll
    for (int i = 0; i < NVI; ++i) { const int c = tid + NTHREADS * i, row = c / VCH, vc = c - row * VCH; voff[i] = row * a.ldv + vc * 8; vdst[i] = ((row >> 3) * NDB + (vc >> 2)) * 512 + (row & 7) * 64 + (vc & 3) * 16; }
    const int i16 = lane & 15, trq = i16 >> 2, trp = i16 & 3, grp = (lane >> 4) & 1;
    const int vtr0 = (4 * hf + trq) * 64 + 32 * grp + 8 * trp;
    constexpr bool PAIRED = (MODE == 2 && DV == 128);
    float lam_full = 0.f;
    if (PAIRED) { const float s1 = wave_sum(a.lam[lane] * a.lam[64 + lane]), s2 = wave_sum(a.lam[128 + lane] * a.lam[192 + lane]); lam_full = expf(s1) - expf(s2) + (0.8f - 0.6f * 0.40656965974059917f); }
    int it_i = 0;
    for (int j = slot; j < per_xcd; j += nslots, ++it_i) {
        const int nbh = NBATCH * a.HQ / 8;
        const int bhl = j < nbh * 16 ? j >> 4 : j - nbh * 16;
        int qt = j < nbh * 16 ? j & 15 : 16;
        int bh = bhl * 8 + xcd;
        if (MODE == 1) { const int P = (bhl >> 2) * 8 + xcd; bh = (P >> 2) * a.HQ + (P & 3) * 4 + (bhl & 3); }
        if (PAIRED) { const int pu = slot + nslots * (it_i >> 1); qt = pu & 15; bh = (pu >> 4) * a.HQ + 2 * xcd + (it_i & 1); }
        const int h = bh % a.HQ, b = bh / a.HQ;
        const bool is_ctx = qt >= 16;
        const int q0 = is_ctx ? SEQ : qt * 256;
        int t_lo = 0, n_lat = 0;
        if (!is_ctx) {
            if (MODE == 2) { t_lo = 0; n_lat = 64; }
            else if (MODE == 1) { t_lo = max(0, 4 * qt - 2); n_lat = min(63, 4 * qt + 5) - t_lo + 1; }
            else { const int r0 = 4 * qt; t_lo = min(max(r0 - 4, 0), 56); n_lat = min(max(r0 - 1, 0), 56) + 7 - t_lo + 1; }
        }
        const int ntiles = n_lat + 4;
        const int qw0 = q0 + wid * 32, qpos = qw0 + r;
        const size_t qrow = (size_t)b * PP + qpos;
        bf16x8 qf[NKK];
#pragma unroll
        for (int kk = 0; kk < NKK; ++kk) qf[kk] = *(const bf16x8*)(a.Q + qrow * a.ldq + h * DQ + kk * 16 + hf * 8);
        if (MODE == 0 && !is_ctx) { for (int i = tid; i < 465; i += NTHREADS) biasl[i] = a.bias[h * 465 + i] * LOG2E; }
        const bf16_t* Kg = a.K + (size_t)b * PP * a.ldk + (h >> a.gk) * DQ;
        const bf16_t* Vg = a.V + (size_t)b * PP * a.ldv + (h >> a.gv) * a.vhs;
        f32x16 o[NDB];
#pragma unroll
        for (int d = 0; d < NDB; ++d)
#pragma unroll
            for (int i = 0; i < 16; ++i) o[d][i] = 0.f;
        float mref = 0.f, l = 0.f;
        f32x16 negm;
#pragma unroll
        for (int i = 0; i < 16; ++i) negm[i] = 0.f;
        bool first = true;
        float lbig = 0.f;
        float one = 1.0f; asm volatile("" : "+v"(one));
#define ATT_TILE(IT) ((IT) < n_lat ? t_lo + (IT) : 64 + ((IT) - n_lat))
        auto tile_active = [&](int t) -> bool {
            if (t >= 64) return true;
            if (MODE == 1) return (t * 64 + 63 >= qw0 - 128) && (t * 64 <= qw0 + 31 + 128);
            if (MODE == 0) { const int rw = qw0 >> 6, row0 = min(max(rw - 4, 0), 56); return t >= row0 && t < row0 + 8; }
            return true;
        };
        auto qk = [&](f32x16 (&s)[2], const lds_ptr Kb) {
#pragma unroll
            for (int kk = 0; kk < NKK; ++kk)
#pragma unroll
                for (int kb = 0; kb < 2; ++kb) {
                    if (ABL & 4) { if (kk == 0) s[kb] = negm; }
                    else {
                    const bf16x8 kf = *(const LAS bf16x8*)(Kb + (kb * 32 + r) * KSTR + (kk * 2 + hf) * 16);
                    s[kb] = MFMA32(kf, qf[kk], kk == 0 ? negm : s[kb]);
                    }
                }
        };
        u32x4 kr[NKI], vr[NVI];
        {
            const int t0 = ATT_TILE(0), t1 = ATT_TILE(1);
            u32x4 k1[NKI];
#pragma unroll
            for (int i = 0; i < NKI; ++i) kr[i] = *(const u32x4*)(Kg + (size_t)t0 * 64 * a.ldk + koff[i]);
#pragma unroll
            for (int i = 0; i < NVI; ++i) vr[i] = *(const u32x4*)(Vg + (size_t)t0 * 64 * a.ldv + voff[i]);
#pragma unroll
            for (int i = 0; i < NKI; ++i) k1[i] = *(const u32x4*)(Kg + (size_t)t1 * 64 * a.ldk + koff[i]);
#pragma unroll
            for (int i = 0; i < NKI; ++i) { *(LAS u32x4*)(lds + kdst[i]) = kr[i]; *(LAS u32x4*)(lds + KTB + kdst[i]) = k1[i]; }
#pragma unroll
            for (int i = 0; i < NVI; ++i) *(LAS u32x4*)(lds + 2 * KTB + vdst[i]) = vr[i];
        }
        __syncthreads();
        f32x16 sc[2], sn[2];
        bool act_cur = tile_active(ATT_TILE(0)), act_nxt = false;
        if (act_cur) qk(sc, lds);
        __syncthreads();
        auto step = [&](const int it, const int e, const bool N2, const bool N1) {
            const int t = ATT_TILE(it);
            if (N2 && !(ABL & 8) && (!(ABL & 128) || e)) {
                const int tn = ATT_TILE(it + 2);
#pragma unroll
                for (int i = 0; i < NKI; ++i) kr[i] = *(const u32x4*)(Kg + (size_t)tn * 64 * a.ldk + koff[i]);
            }
            if (N1 && !(ABL & 8) && (!(ABL & 128) || e)) {
                const int tn = ATT_TILE(it + 1);
#pragma unroll
                for (int i = 0; i < NVI; ++i) vr[i] = *(const u32x4*)(Vg + (size_t)tn * 64 * a.ldv + voff[i]);
            }
            SCHED_FENCE();
            act_nxt = N1 && (MODE == 2 || tile_active(ATT_TILE(it + 1)));
            const lds_ptr Vb = lds + 2 * KTB + e * VTB;
            const bool do_cur = MODE == 2 || act_cur;
            if (do_cur) {
                if (t < 64 && MODE == 1 && !((t * 64 + 63 - qw0 <= 128) && (qw0 + 31 - t * 64 <= 128))) {
                    const int dbase = t * 64 + 4 * hf - qpos;
#pragma unroll
                    for (int kb = 0; kb < 2; ++kb)
#pragma unroll
                        for (int i = 0; i < 16; ++i) { const int c = kb * 32 + (i & 3) + 8 * (i >> 2); sc[kb][i] = (dbase > 128 - c || dbase < -128 - c) ? -INFINITY : sc[kb][i]; }
                }
                if (t < 64 && MODE == 0) {
                    const int qc = qpos & 63, rw = qpos >> 6, col0 = min(max(qc - 8, 0), 48);
                    const int brow = (t - rw + 7) * 31 + 15 - qc;
#pragma unroll
                    for (int kb = 0; kb < 2; ++kb)
#pragma unroll
                        for (int i = 0; i < 16; ++i) {
                            const int kc = kb * 32 + crow(i, hf);
                            const bool ok = kc >= col0 && kc < col0 + 16;
                            const float bv = biasl[ok ? brow + kc : 0];
                            sc[kb][i] = ok ? sc[kb][i] + bv : -INFINITY;
                        }
                }
                if (first || __builtin_amdgcn_ballot_w64(lbig > ATT_BIGF) != 0ull) {
                    float delta = lbig > ATT_BIGF ? ATT_BIG : 0.f;
                    if (first) {
                        float mx = sc[0][0];
#pragma unroll
                        for (int i = 1; i < 16; ++i) mx = fmaxf(mx, sc[0][i]);
#pragma unroll
                        for (int i = 0; i < 16; ++i) mx = fmaxf(mx, sc[1][i]);
                        mx = xhalf_max(mx);
                        delta = mx > -INFINITY ? mx : 0.f;
                    }
                    const float alpha = __builtin_amdgcn_exp2f(-delta);
                    l *= alpha; mref += delta;
#pragma unroll
                    for (int d = 0; d < NDB; ++d)
#pragma unroll
                        for (int i = 0; i < 16; ++i) o[d][i] *= alpha;
#pragma unroll
                    for (int kb = 0; kb < 2; ++kb)
#pragma unroll
                        for (int i = 0; i < 16; ++i) sc[kb][i] -= delta;
#pragma unroll
                    for (int i = 0; i < 16; ++i) negm[i] = -mref;
                    first = false;
                }
            }
            if (N1) qk(sn, lds + (e ^ 1) * KTB);
            if (do_cur) {
                float ls0 = 0.f, ls1 = 0.f;
#pragma unroll
                for (int kb = 0; kb < 2; ++kb)
#pragma unroll
                    for (int i = 0; i < 16; i += 2) {
                        const float p0 = (ABL & 1) ? sc[kb][i] : __builtin_amdgcn_exp2f(sc[kb][i]), p1 = (ABL & 1) ? sc[kb][i + 1] : __builtin_amdgcn_exp2f(sc[kb][i + 1]);
                        sc[kb][i] = p0; sc[kb][i + 1] = p1;
                        if (!(ABL & 16)) { ls0 += p0; ls1 = __builtin_fmaf(p1, one, ls1); }
                    }
                lbig = ls0 + ls1;
                l += lbig;
                bf16x8 pf[4];
#pragma unroll
                for (int kb = 0; kb < 2; ++kb)
#pragma unroll
                    for (int sp = 0; sp < 2; ++sp) {
                        u32x4 w;
                        w.x = cvtpk(sc[kb][8 * sp], sc[kb][8 * sp + 1]); w.y = cvtpk(sc[kb][8 * sp + 2], sc[kb][8 * sp + 3]);
                        w.z = cvtpk(sc[kb][8 * sp + 4], sc[kb][8 * sp + 5]); w.w = cvtpk(sc[kb][8 * sp + 6], sc[kb][8 * sp + 7]);
                        pf[kb * 2 + sp] = __builtin_bit_cast(bf16x8, w);
                    }
#pragma unroll
                for (int ks = 0; ks < 4; ++ks)
#pragma unroll
                    for (int d = 0; d < NDB; ++d) {
                        const lds_ptr vp = Vb + ((2 * ks) * NDB + d) * 512 + vtr0;
                        const s16x4 lo = lds_tr(vp), hi = lds_tr(vp + NDB * 512);
                        const bf16x8 vf = __builtin_shufflevector(lo, hi, 0, 1, 2, 3, 4, 5, 6, 7);
                        if (ABL & 2) { if (d == 0 && ks == 0) o[0][0] += __builtin_bit_cast(float, pf[0][0] | pf[1][0] | pf[2][0] | pf[3][0]) + __builtin_bit_cast(float, (int)vf[0]); } else
                        o[d] = MFMA32(vf, pf[ks], o[d]);
                    }
            }
            SCHED_FENCE();
            if (N2 && !(ABL & 8) && (!(ABL & 128) || e)) {
#pragma unroll
                for (int i = 0; i < NKI; ++i) *(LAS u32x4*)(lds + e * KTB + kdst[i]) = kr[i];
            }
            if (N1 && !(ABL & 8) && (!(ABL & 128) || e)) {
#pragma unroll
                for (int i = 0; i < NVI; ++i) *(LAS u32x4*)(lds + 2 * KTB + (e ^ 1) * VTB + vdst[i]) = vr[i];
            }
            if (!(ABL & 64) && (!(ABL & 128) || e)) __syncthreads();
#pragma unroll
            for (int kb = 0; kb < 2; ++kb) sc[kb] = sn[kb];
            act_cur = act_nxt;
        };
        int it = 0;
        for (; it + 3 < ntiles; it += 2) { step(it, 0, true, true); step(it + 1, 1, true, true); }
        if (ntiles - it == 3) { step(it, 0, true, true); step(it + 1, 1, false, true); step(it + 2, 0, false, false); }
        else { step(it, 0, false, true); step(it + 1, 1, false, false); }
#undef ATT_TILE
        l = xhalf_sum(l);
        if (a.sink) {
            l += __builtin_amdgcn_exp2f(a.sink[h] * LOG2E - mref);
        }
        const float inv = 1.0f / l;
        bf16_t* orow = a.O + qrow * a.ldo + h * DV + 4 * hf;
#pragma unroll
        for (int d = 0; d < NDB; ++d)
#pragma unroll
            for (int g = 0; g < 4; ++g) {
                if (DV == 64) {
                    *(unsigned*)((unsigned char*)a.O + qrow * a.ldo + h * DV + 4 * hf + d * 32 + 8 * g) = cvt_fp8x4(o[d][4 * g] * inv, o[d][4 * g + 1] * inv, o[d][4 * g + 2] * inv, o[d][4 * g + 3] * inv);
                } else {
                    u32x2 w; w.x = cvtpk(o[d][4 * g] * inv, o[d][4 * g + 1] * inv); w.y = cvtpk(o[d][4 * g + 2] * inv, o[d][4 * g + 3] * inv);
                    *(u32x2*)(orow + d * 32 + 8 * g) = w;
                }
            }
        if (PAIRED && (it_i & 1)) {
            asm volatile("s_waitcnt vmcnt(0)" ::: "memory");
            const float lambda_init = 0.8f - 0.6f * 0.40656965974059917f;
            const int sub = lane & 7, pair = h >> 1;
#pragma unroll
            for (int i4 = 0; i4 < 4; ++i4) {
                const size_t row = (size_t)b * PP + qw0 + i4 * 8 + (lane >> 3);
                const bf16_t* o1 = a.O + row * a.ldo + (2 * pair) * 128 + sub * 16, *o2 = o1 + 128;
                float av[16], cv[16];
                unpack8(*(const u32x4*)o1, *(float(*)[8])av); unpack8(*(const u32x4*)(o1 + 8), *(float(*)[8])(av + 8));
                unpack8(*(const u32x4*)o2, *(float(*)[8])cv); unpack8(*(const u32x4*)(o2 + 8), *(float(*)[8])(cv + 8));
                float ss = 0.f;
#pragma unroll
                for (int e = 0; e < 16; ++e) { av[e] -= lam_full * cv[e]; ss += av[e] * av[e]; }
                ss += __shfl_xor(ss, 1); ss += __shfl_xor(ss, 2); ss += __shfl_xor(ss, 4);
                const float rs = rsqrtf(ss * (1.0f / 128.0f) + EPS) * (1.0f - lambda_init);
#pragma unroll
                for (int e = 0; e < 16; ++e) av[e] *= rs * a.subln[sub * 16 + e];
                u32x4 w8; w8.x = cvt_fp8x4(av[0], av[1], av[2], av[3]); w8.y = cvt_fp8x4(av[4], av[5], av[6], av[7]); w8.z = cvt_fp8x4(av[8], av[9], av[10], av[11]); w8.w = cvt_fp8x4(av[12], av[13], av[14], av[15]);
                *(u32x4*)(a.Oc + row * (size_t)a.ldoc + pair * 128 + sub * 16) = w8;
            }
        }
    }
}

DI void attn_na(const AttnP& a, unsigned char* smem, int bid, int nb, int tid) {
    constexpr int DQ = 64, DV = 64, KSTR = DQ * 2 + 16, KTB = 64 * KSTR, VTB = 64 * DV * 2, NDB = 2, NKK = 4;
    const lds_ptr lds = (lds_ptr)smem;
    constexpr int BZ_TAB = 32, BZ_HEAD = 560, BZ_NINF = 16 * BZ_HEAD, BZ_N = BZ_NINF + 64;
    static_assert(4 * KTB + 4 * VTB + (BZ_N + 16) * 4 <= GEMM_LDS, "NA LDS");
    LAS float* biasl = (LAS float*)(lds + 4 * KTB + 4 * VTB);
    for (int i = tid; i < BZ_N; i += NTHREADS) {
        const int hh = i / BZ_HEAD, o = i - hh * BZ_HEAD;
        biasl[i] = i >= BZ_NINF ? -INFINITY : (o >= BZ_TAB && o < BZ_TAB + 465) ? a.bias[hh * 465 + o - BZ_TAB] * LOG2E : 0.f;
    }
    __syncthreads();
    {
        const int wv = __builtin_amdgcn_readfirstlane(tid >> 6), ln = tid & 63;
#pragma unroll
        for (int hh2 = 0; hh2 < 2; ++hh2) {
            const int hh = 2 * wv + hh2;
            float m = 0.f;
            for (int i = ln; i < 465; i += 64) m = fmaxf(m, biasl[hh * BZ_HEAD + BZ_TAB + i]);
#pragma unroll
            for (int d = 32; d >= 1; d >>= 1) m = fmaxf(m, __shfl_xor(m, d));
            if (ln == 0) biasl[BZ_N + hh] = m;
        }
    }
    float kmax = fabsf(a.kgain[tid & 63]);
#pragma unroll
    for (int d = 32; d >= 1; d >>= 1) kmax = fmaxf(kmax, __shfl_xor(kmax, d));
    kmax *= 8.0f * 1.01f;
    const int lane = tid & 63, wid = __builtin_amdgcn_readfirstlane(tid >> 6), r = lane & 31, hf = lane >> 5;
    const int nq = a.need_ctx ? 17 : 16;
    const int xcd = bid & 7, slot = bid >> 3, nslots = nb >> 3, per_xcd = (NBATCH * a.HQ / 8) * nq;
    const int krow_s = tid >> 3, kc_s = tid & 7;
    const int koff = krow_s * a.ldk + kc_s * 8, kdst = krow_s * KSTR + kc_s * 16, voff = krow_s * a.ldv + kc_s * 8;
    const int vdst = ((krow_s >> 3) * NDB + (kc_s >> 2)) * 512 + (krow_s & 7) * 64 + (kc_s & 3) * 16;
    const int i16 = lane & 15, trq = i16 >> 2, trp = i16 & 3, grp = (lane >> 4) & 1;
    const int vtr0 = (4 * hf + trq) * 64 + 32 * grp + 8 * trp;
    const int rp = wid >> 2, cq = wid & 3, k0 = cq == 0 ? 0 : cq == 1 ? 8 : cq == 2 ? 24 : 32;
    float one = 1.0f; asm volatile("" : "+v"(one));
    auto unit_of = [&](int j, int& b, int& h, int& qt, int& t_lo, int& n_lat) {
        const int nbh = NBATCH * a.HQ / 8;
        const int bhl = j < nbh * 16 ? j >> 4 : j - nbh * 16; qt = j < nbh * 16 ? j & 15 : 16;
        const int bh = bhl * 8 + xcd; h = bh % a.HQ; b = bh / a.HQ;
        t_lo = 0; n_lat = 0;
        if (qt < 16) { const int r0 = 4 * qt; t_lo = min(max(r0 - 4, 0), 56); n_lat = min(max(r0 - 1, 0), 56) + 7 - t_lo + 1; n_lat += n_lat & 1; }
    };
#define NA_TILE_OF(IT, TLO, NLAT) ((IT) < (NLAT) ? (TLO) + (IT) : 64 + ((IT) - (NLAT)))
    bf16x8 qf[NKK];
    u32x4 krA[2], vrA[2], krB[2], vrB[2];
    auto load_pair = [&](u32x4 (&kr)[2], u32x4 (&vr)[2], const bf16_t* Kg, const bf16_t* Vg, int t_lo, int n_lat, int pr) {
#pragma unroll
        for (int jj = 0; jj < 2; ++jj) {
            const int tn = NA_TILE_OF(2 * pr + jj, t_lo, n_lat);
            kr[jj] = *(const u32x4*)(Kg + (size_t)tn * 64 * a.ldk + koff); vr[jj] = *(const u32x4*)(Vg + (size_t)tn * 64 * a.ldv + voff);
        }
    };
    auto store_pair = [&](const u32x4 (&kr)[2], const u32x4 (&vr)[2], int e) {
#pragma unroll
        for (int jj = 0; jj < 2; ++jj) { *(LAS u32x4*)(lds + (2 * e + jj) * KTB + kdst) = kr[jj]; *(LAS u32x4*)(lds + 4 * KTB + (2 * e + jj) * VTB + vdst) = vr[jj]; }
    };
    auto qrow_of = [&](int b, int qt) -> size_t { const int qpos = qt >= 16 ? SEQ + wid * 32 + r : (4 * qt + 2 * rp + (r >> 4)) * 64 + 16 * cq + (r & 15); return (size_t)b * PP + qpos; };
    auto load_q = [&](int b, int h, int qt) {
        const size_t qrow = qrow_of(b, qt);
#pragma unroll
        for (int kk = 0; kk < NKK; ++kk) qf[kk] = *(const bf16x8*)(a.Q + qrow * a.ldq + h * DQ + kk * 16 + hf * 8);
    };
    if (slot >= per_xcd) return;
    int b, h, qt, t_lo, n_lat;
    unit_of(slot, b, h, qt, t_lo, n_lat);
    {
        load_q(b, h, qt);
        const bf16_t* Kg = a.K + (size_t)b * PP * a.ldk + h * DQ; const bf16_t* Vg = a.V + (size_t)b * PP * a.ldv + h * a.vhs;
        load_pair(krA, vrA, Kg, Vg, t_lo, n_lat, 0); store_pair(krA, vrA, 0); load_pair(krB, vrB, Kg, Vg, t_lo, n_lat, 1);
    }
    __syncthreads();
    for (int j = slot;;) {
        const int jn = j + nslots; const bool has_next = jn < per_xcd;
        int nb_, nh, nqt, nt_lo, nn_lat;
        unit_of(has_next ? jn : j, nb_, nh, nqt, nt_lo, nn_lat);
        const bf16_t* nKg = a.K + (size_t)nb_ * PP * a.ldk + nh * DQ; const bf16_t* nVg = a.V + (size_t)nb_ * PP * a.ldv + nh * a.vhs;
        const bool is_ctx = qt >= 16;
        const int r0 = 4 * qt;
        const int npair = (n_lat + 4) >> 1;
        const int qrw = r0 + 2 * rp + (r >> 4), qc = 16 * cq + (r & 15);
        const size_t qrow = qrow_of(b, qt);
        const bf16_t* Kg = a.K + (size_t)b * PP * a.ldk + h * DQ;
        const bf16_t* Vg = a.V + (size_t)b * PP * a.ldv + h * a.vhs;
        const int rwA = r0 + 2 * rp, wlo = min(max(rwA - 4, 0), 56), whi = min(max(rwA - 3, 0), 56) + 7;
        const int col0 = min(max(qc - 8, 0), 48), row0q = min(max(qrw - 4, 0), 56);
        const int lanebase = h * BZ_HEAD + BZ_TAB + (7 - qrw) * 31 + 15 - qc + k0 + 4 * hf;
        f32x16 o[NDB];
#pragma unroll
        for (int d = 0; d < NDB; ++d)
#pragma unroll
            for (int i = 0; i < 16; ++i) o[d][i] = 0.f;
        float l = 0.f;
        float qn2 = 0.f;
#pragma unroll
        for (int kk = 0; kk < NKK; ++kk)
#pragma unroll
            for (int jj = 0; jj < 8; ++jj) { const float qv = bf2f((bf16_t)qf[kk][jj]); qn2 = __builtin_fmaf(qv, qv, qn2); }
        qn2 = xhalf_sum(qn2);
        const float mref = __builtin_sqrtf(qn2) * kmax + biasl[BZ_N + h];
        f32x16 negmL;
#pragma unroll
        for (int i = 0; i < 16; ++i) { const int kc = k0 + crow(i, hf); negmL[i] = (kc >= col0 && kc < col0 + 16) ? -mref : -INFINITY; }
#define NA_TILE(IT) NA_TILE_OF(IT, t_lo, n_lat)
        auto ctx_tile = [&](const lds_ptr Kb, const lds_ptr Vb) {
            {
                f32x16 s[2], negm;
#pragma unroll
                for (int i = 0; i < 16; ++i) negm[i] = -mref;
#pragma unroll
                for (int kk = 0; kk < NKK; ++kk)
#pragma unroll
                    for (int kb = 0; kb < 2; ++kb) {
                        const bf16x8 kf = *(const LAS bf16x8*)(Kb + (kb * 32 + r) * KSTR + (kk * 2 + hf) * 16);
                        s[kb] = MFMA32(kf, qf[kk], kk == 0 ? negm : s[kb]);
                    }
                float ls0 = 0.f, ls1 = 0.f;
                bf16x8 pf[4];
#pragma unroll
                for (int kb = 0; kb < 2; ++kb) {
#pragma unroll
                    for (int i = 0; i < 16; i += 2) {
                        const float p0 = __builtin_amdgcn_exp2f(s[kb][i]), p1 = __builtin_amdgcn_exp2f(s[kb][i + 1]);
                        s[kb][i] = p0; s[kb][i + 1] = p1; ls0 += p0; ls1 = __builtin_fmaf(p1, one, ls1);
                    }
#pragma unroll
                    for (int sp = 0; sp < 2; ++sp) {
                        u32x4 w;
                        w.x = cvtpk(s[kb][8 * sp], s[kb][8 * sp + 1]); w.y = cvtpk(s[kb][8 * sp + 2], s[kb][8 * sp + 3]);
                        w.z = cvtpk(s[kb][8 * sp + 4], s[kb][8 * sp + 5]); w.w = cvtpk(s[kb][8 * sp + 6], s[kb][8 * sp + 7]);
                        pf[kb * 2 + sp] = __builtin_bit_cast(bf16x8, w);
                    }
                }
                l += ls0 + ls1;
#pragma unroll
                for (int ks = 0; ks < 4; ++ks)
#pragma unroll
                    for (int d = 0; d < NDB; ++d) {
                        const lds_ptr vp = Vb + ((2 * ks) * NDB + d) * 512 + vtr0;
                        const s16x4 lo = lds_tr(vp), hi = lds_tr(vp + NDB * 512);
                        o[d] = MFMA32(__builtin_shufflevector(lo, hi, 0, 1, 2, 3, 4, 5, 6, 7), pf[ks], o[d]);
                    }
            }
        };
        auto lat_tile = [&](const int t, const lds_ptr Kb, const lds_ptr Vb) {
            bf16x8 pf[2];
#pragma unroll
            for (int sp = 0; sp < 2; ++sp)
#pragma unroll
                for (int jj = 0; jj < 8; ++jj) pf[sp][jj] = 0;
            if (t >= wlo && t <= whi) {
                f32x16 s;
#pragma unroll
                for (int kk = 0; kk < NKK; ++kk) {
                    const bf16x8 kf = *(const LAS bf16x8*)(Kb + (k0 + r) * KSTR + (kk * 2 + hf) * 16);
                    s = MFMA32(kf, qf[kk], kk == 0 ? negmL : s);
                }
                const LAS float* bp = biasl + (((unsigned)(t - row0q) < 8u) ? lanebase + 31 * t : BZ_NINF);
#pragma unroll
                for (int i = 0; i < 16; ++i) s[i] += bp[crow(i, 0)];
                float ls0 = 0.f, ls1 = 0.f;
#pragma unroll
                for (int i = 0; i < 16; i += 2) {
                    const float p0 = __builtin_amdgcn_exp2f(s[i]), p1 = __builtin_amdgcn_exp2f(s[i + 1]);
                    s[i] = p0; s[i + 1] = p1; ls0 += p0; ls1 = __builtin_fmaf(p1, one, ls1);
                }
#pragma unroll
                for (int sp = 0; sp < 2; ++sp) {
                    u32x4 w;
                    w.x = cvtpk(s[8 * sp], s[8 * sp + 1]); w.y = cvtpk(s[8 * sp + 2], s[8 * sp + 3]);
                    w.z = cvtpk(s[8 * sp + 4], s[8 * sp + 5]); w.w = cvtpk(s[8 * sp + 6], s[8 * sp + 7]);
                    pf[sp] = __builtin_bit_cast(bf16x8, w);
                }
                l += ls0 + ls1;
            }
#pragma unroll
            for (int ks = 0; ks < 2; ++ks)
#pragma unroll
                for (int d = 0; d < NDB; ++d) {
                    const lds_ptr vp = Vb + (((k0 >> 3) + 2 * ks) * NDB + d) * 512 + vtr0;
                    const s16x4 lo = lds_tr(vp), hi = lds_tr(vp + NDB * 512);
                    o[d] = MFMA32(__builtin_shufflevector(lo, hi, 0, 1, 2, 3, 4, 5, 6, 7), pf[ks], o[d]);
                }
        };
#define NA_ITER(IP, E, KL, VL, KS, VS, LAT) do { \
            if ((IP) + 2 < npair) load_pair(KL, VL, Kg, Vg, t_lo, n_lat, (IP) + 2); \
            else if (has_next) load_pair(KL, VL, nKg, nVg, nt_lo, nn_lat, (IP) + 2 - npair); \
            SCHED_FENCE(); \
            if (LAT) { lat_tile(t_lo + 2 * (IP), lds + (2 * (E)) * KTB, lds + 4 * KTB + (2 * (E)) * VTB); lat_tile(t_lo + 2 * (IP) + 1, lds + (2 * (E) + 1) * KTB, lds + 4 * KTB + (2 * (E) + 1) * VTB); } \
            else { ctx_tile(lds + (2 * (E)) * KTB, lds + 4 * KTB + (2 * (E)) * VTB); ctx_tile(lds + (2 * (E) + 1) * KTB, lds + 4 * KTB + (2 * (E) + 1) * VTB); } \
            SCHED_FENCE(); \
            if ((IP) + 1 < npair || has_next) store_pair(KS, VS, (E) ^ 1); \
            __syncthreads(); } while (0)
        int ip = 0;
        for (; ip < (n_lat >> 1); ip += 2) { NA_ITER(ip, 0, krA, vrA, krB, vrB, true); NA_ITER(ip + 1, 1, krB, vrB, krA, vrA, true); }
        NA_ITER(ip, 0, krA, vrA, krB, vrB, false); NA_ITER(ip + 1, 1, krB, vrB, krA, vrA, false);
#undef NA_ITER
        if (has_next) load_q(nb_, nh, nqt);
#undef NA_TILE
        l = xhalf_sum(l);
        const float inv = 1.0f / l;
#pragma unroll
        for (int d = 0; d < NDB; ++d)
#pragma unroll
            for (int g = 0; g < 4; ++g)
                *(unsigned*)((unsigned char*)a.O + qrow * a.ldo + h * DV + 4 * hf + d * 32 + 8 * g) = cvt_fp8x4(o[d][4 * g] * inv, o[d][4 * g + 1] * inv, o[d][4 * g + 2] * inv, o[d][4 * g + 3] * inv);
        if (!has_next) break;
        j = jn; b = nb_; h = nh; qt = nqt; t_lo = nt_lo; n_lat = nn_lat;
    }
#undef NA_TILE_OF
}

template <class E> struct epi_perm16 { static constexpr bool value = false; };
template <class E> struct epi_fp8 { static constexpr int value = 0; };
typedef int v8i_t __attribute__((ext_vector_type(8)));
typedef int v4i_t __attribute__((ext_vector_type(4)));
namespace pg8 {
constexpr int BM = 256, BK = 64, HALF = 128, HTB = HALF * BK * 2  ;
DI int lds_byte(int r, int c) { const int st = (r >> 4) * 2 + (c >> 5), rr = r & 15, cc = c & 31, ob = rr * 64 + cc * 2; return st * 1024 + (ob ^ (((ob >> 9) & 1) << 5)); }
DI void stage_rc(int b, int& R, int& C) { const int st = b / 1024, sb = b % 1024, swz = sb ^ (((sb >> 9) & 1) << 5); R = (st >> 1) * 16 + swz / 64; C = (st & 1) * 32 + (swz % 64) / 2; }
DI int perm32(int rho) { const int n = rho >> 4, i = rho & 15; return 8 * (i >> 2) + 4 * n + (i & 3); }

template <class Epi, class Sched>
DI void gemm_phase(lds_ptr lds, const bf16_t* __restrict__ Aop, const int K, const Sched& S, const Epi& E, const int tid) {
    const int wid = __builtin_amdgcn_readfirstlane(tid >> 6), lane = tid & 63, wr = wid >> 2, wc = wid & 3, fr = lane & 15, fq = lane >> 4;
    const int nt = K / BK;
    int Ra[2], Ca[2]; unsigned voffB[2];
#pragma unroll
    for (int i = 0; i < 2; ++i) { int R, C; stage_rc(tid * 16 + i * 8192, R, C); const int p32 = perm32(R & 31); const int Rb = epi_perm16<Epi>::value ? 64 * (R >> 5) + 16 * (p32 >> 3) + (p32 & 7) : Epi::PERM ? ((R & ~31) + p32) : R;
        Ra[i] = R; Ca[i] = C; voffB[i] = (unsigned)(Rb * K + C) * 2u; }
    const size_t kstep = (size_t)(BK * 2);
    const size_t hstep = (size_t)(epi_perm16<Epi>::value ? 8 : HALF) * K * 2;
    const unsigned ldsw = (unsigned)wid * 1024u;
    const int aoff = lds_byte(wr * 64 + fr, fq * 8), boff = lds_byte(wc * 32 + fr, fq * 8);
#define PG8_SA(b, h) (((b) * 2 + (h)) * HTB)
#define PG8_SB(b, h) ((4 + (b) * 2 + (h)) * HTB)
#define PG8_STAGE(bufoff, gbase, voff) do { const char* _gb = (const char*)(gbase); asm volatile("" : "+s"(_gb)); _Pragma("unroll") for (int _i = 0; _i < 2; ++_i) { \
        unsigned _o = (voff)[_i]; asm volatile("" : "+v"(_o)); \
        __builtin_amdgcn_global_load_lds((const unsigned*)(_gb + _o), (LAS unsigned*)(lds + (bufoff) + ldsw + _i * 8192), 16, 0, 0); } } while (0)
#define PG8_LDA(dst, b, h) do { _Pragma("unroll") for (int m = 0; m < 4; ++m) _Pragma("unroll") for (int k = 0; k < 2; ++k) dst[m][k] = *(const LAS bf16x8*)(lds + PG8_SA(b, h) + aoff + m * 2048 + k * 1024); } while (0)
#define PG8_LDB(dst, b, h) do { _Pragma("unroll") for (int n = 0; n < 2; ++n) _Pragma("unroll") for (int k = 0; k < 2; ++k) dst[n][k] = *(const LAS bf16x8*)(lds + PG8_SB(b, h) + boff + n * 2048 + k * 1024); } while (0)
typedef long i64x2_t __attribute__((ext_vector_type(2)));
#define PG8_MMA(ai, bj, At, Bt) do { __builtin_amdgcn_s_setprio(1); _Pragma("unroll") for (int m = 0; m < 4; ++m) _Pragma("unroll") for (int n = 0; n < 2; ++n) { \
        if (epi_fp8<Epi>::value == 2) { \
            const v8i_t _b = __builtin_shufflevector(__builtin_bit_cast(v4i_t, Bt[n][0]), __builtin_bit_cast(v4i_t, Bt[n][1]), 0, 1, 2, 3, 4, 5, 6, 7); \
            const v8i_t _a = __builtin_shufflevector(__builtin_bit_cast(v4i_t, At[m][0]), __builtin_bit_cast(v4i_t, At[m][1]), 0, 1, 2, 3, 4, 5, 6, 7); \
            acc[ai][bj][m][n] = __builtin_amdgcn_mfma_scale_f32_16x16x128_f8f6f4(_b, _a, acc[ai][bj][m][n], 0, 0, 0, 0, 0, 0); \
        } else { _Pragma("unroll") for (int k = 0; k < 2; ++k) { \
        if (epi_fp8<Epi>::value == 1) { const i64x2_t _b = __builtin_bit_cast(i64x2_t, Bt[n][k]), _a = __builtin_bit_cast(i64x2_t, At[m][k]); \
            acc[ai][bj][m][n] = __builtin_amdgcn_mfma_f32_16x16x32_fp8_fp8(_b[0], _a[0], acc[ai][bj][m][n], 0, 0, 0); \
            acc[ai][bj][m][n] = __builtin_amdgcn_mfma_f32_16x16x32_fp8_fp8(_b[1], _a[1], acc[ai][bj][m][n], 0, 0, 0); } \
        else acc[ai][bj][m][n] = __builtin_amdgcn_mfma_f32_16x16x32_bf16(Bt[n][k], At[m][k], acc[ai][bj][m][n], 0, 0, 0); } } } \
        __builtin_amdgcn_s_setprio(0); } while (0)
#define PG8_WAIT_V(n) asm volatile("s_waitcnt vmcnt(" #n ")" ::: "memory")
#define PG8_WAIT_L(n) asm volatile("s_waitcnt lgkmcnt(" #n ")" ::: "memory")
#define PG8_BAR __builtin_amdgcn_s_barrier()
#define PG8_SCHED __builtin_amdgcn_sched_barrier(0)
    typename Sched::Unit cur, nxt; int ui = 0;
    if (!S.next(0, cur)) return;
    f32x4 acc[2][2][4][2];
#pragma unroll
    for (int a = 0; a < 2; ++a)
#pragma unroll
        for (int b = 0; b < 2; ++b)
#pragma unroll
            for (int m = 0; m < 4; ++m)
#pragma unroll
                for (int n = 0; n < 2; ++n) acc[a][b][m][n] = (f32x4){0.f, 0.f, 0.f, 0.f};
    bf16x8 At[4][2], B0[2][2], B1[2][2];
    constexpr bool GATHER = Sched::GATHER;
    unsigned oc[2][2], on[2][2] = {{0u, 0u}, {0u, 0u}};
    size_t ubc[2] = {0, 0}, ubn[2] = {0, 0};
#pragma unroll
    for (int h = 0; h < 2; ++h) {
        if (!GATHER) ubc[h] = (size_t)S.a_off(cur, h * HALF) * 2u;
#pragma unroll
        for (int i = 0; i < 2; ++i) oc[h][i] = GATHER ? (S.a_off(cur, h * HALF + Ra[i]) + (unsigned)Ca[i]) * 2u : (unsigned)(Ra[i] * S.lda + Ca[i]) * 2u;
    }
    const char* gA = (const char*)Aop;
    const char* cB = (const char*)S.b_base(cur);
    PG8_STAGE(PG8_SB(0, 0), cB, voffB); PG8_STAGE(PG8_SB(0, 1), cB + hstep, voffB); PG8_STAGE(PG8_SA(0, 0), gA + ubc[0], oc[0]); PG8_STAGE(PG8_SA(0, 1), gA + ubc[1], oc[1]);
    if (wr == 1) PG8_BAR;
    PG8_WAIT_V(2); PG8_BAR;
    PG8_STAGE(PG8_SB(1, 0), cB + kstep, voffB); PG8_STAGE(PG8_SA(1, 0), gA + ubc[0] + kstep, oc[0]); PG8_STAGE(PG8_SB(1, 1), cB + hstep + kstep, voffB);
    PG8_WAIT_V(6); PG8_BAR;
    for (;;) {
        const bool has_next = S.next(ui + 1, nxt);
        const char* nB = has_next ? (const char*)S.b_base(nxt) : cB;
#pragma unroll
        for (int h = 0; h < 2; ++h) {
            if (!GATHER) ubn[h] = has_next ? (size_t)S.a_off(nxt, h * HALF) * 2u : ubc[h];
#pragma unroll
            for (int i = 0; i < 2; ++i) if (GATHER) { int R, C; stage_rc(((wid << 6) | lane_now()) * 16 + i * 8192, R, C);
                const unsigned* ip = S.a_ptr(nxt, h * HALF + R); if (epi_fp8<Epi>::value != 2) asm volatile("global_load_dword %0, %1, off" : "=v"(on[h][i]) : "v"(ip) : "memory"); }
        }
        const bool full = cur.half < 0;
        for (int t = 0; t < nt; t += 2) {
            const bool last = (t == nt - 2);
            const char* a1 = gA + (size_t)(t + 1) * kstep;
            const char* a2 = last ? gA : gA + (size_t)(t + 2) * kstep; const char* b2 = last ? nB : cB + (size_t)(t + 2) * kstep;
            const char* a3 = a2 + kstep; const char* b3 = b2 + kstep;
            size_t u2[2];
            if (GATHER && last) {
                if (epi_fp8<Epi>::value != 2) asm volatile("" : "+v"(on[0][0]), "+v"(on[0][1]), "+v"(on[1][0]), "+v"(on[1][1]));
#pragma unroll
                for (int i = 0; i < 2; ++i) { int R, C; stage_rc(((wid << 6) | lane_now()) * 16 + i * 8192, R, C);
                    if (epi_fp8<Epi>::value == 2) { on[0][i] = *S.a_ptr(nxt, R); on[1][i] = *S.a_ptr(nxt, HALF + R); }
                    oc[0][i] = (S.a_cvt(on[0][i]) + (unsigned)C) * 2u; on[1][i] = (S.a_cvt(on[1][i]) + (unsigned)C) * 2u; }
            }
#pragma unroll
            for (int h = 0; h < 2; ++h) u2[h] = last ? ubn[h] : ubc[h];
            PG8_LDB(B0, 0, 0); PG8_LDB(B1, 0, 1); PG8_SCHED; PG8_LDA(At, 0, 0); PG8_STAGE(PG8_SA(1, 1), a1 + ubc[1], oc[1]);
            if (GATHER && last) { oc[1][0] = on[1][0]; oc[1][1] = on[1][1]; }
            PG8_WAIT_V(8); PG8_WAIT_L(0); PG8_BAR; PG8_MMA(0, 0, At, B0); PG8_MMA(0, 1, At, B1); PG8_BAR; PG8_SCHED;
            PG8_LDA(At, 0, 1); PG8_STAGE(PG8_SB(0, 0), b2, voffB); PG8_STAGE(PG8_SB(0, 1), b2 + hstep, voffB); PG8_STAGE(PG8_SA(0, 0), a2 + u2[0], oc[0]);
            PG8_WAIT_V(8); PG8_WAIT_L(0); PG8_BAR; if (full) { PG8_MMA(1, 0, At, B0); PG8_MMA(1, 1, At, B1); } PG8_BAR; PG8_SCHED;
            PG8_LDB(B0, 1, 0); PG8_LDB(B1, 1, 1); PG8_SCHED; PG8_LDA(At, 1, 0); PG8_STAGE(PG8_SA(0, 1), a2 + u2[1], oc[1]);
            PG8_WAIT_V(8); PG8_WAIT_L(0); PG8_BAR; PG8_MMA(0, 0, At, B0); PG8_MMA(0, 1, At, B1); PG8_BAR; PG8_SCHED;
            PG8_LDA(At, 1, 1); PG8_STAGE(PG8_SB(1, 0), b3, voffB); PG8_STAGE(PG8_SB(1, 1), b3 + hstep, voffB); PG8_STAGE(PG8_SA(1, 0), a3 + u2[0], oc[0]);
            PG8_WAIT_V(8); PG8_WAIT_L(0); PG8_BAR; if (full) { PG8_MMA(1, 0, At, B0); PG8_MMA(1, 1, At, B1); } PG8_BAR; PG8_SCHED;
        }
        if (wr == 0) PG8_BAR;
        { const int ln = lane_now(); E(acc, cur, wr, wc, ln & 15, ln >> 4); }
        if (!has_next) break;
#pragma unroll
        for (int a = 0; a < 2; ++a)
#pragma unroll
            for (int b = 0; b < 2; ++b)
#pragma unroll
                for (int m = 0; m < 4; ++m)
#pragma unroll
                    for (int n = 0; n < 2; ++n) acc[a][b][m][n] = (f32x4){0.f, 0.f, 0.f, 0.f};
        cur = nxt; cB = nB; ++ui;
#pragma unroll
        for (int h = 0; h < 2; ++h) ubc[h] = ubn[h];
        if (wr == 1) PG8_BAR;
    }
    PG8_WAIT_V(0);
    PG8_BAR;
#undef PG8_SA
#undef PG8_SB
#undef PG8_STAGE
#undef PG8_LDA
#undef PG8_LDB
#undef PG8_MMA
#undef PG8_WAIT_V
#undef PG8_WAIT_L
#undef PG8_BAR
#undef PG8_SCHED
}
}

struct DenseSched {
    static constexpr bool GATHER = false;
    struct Unit { int pm, pn, half; };
    int nM, nN, nwg, G, c; const bf16_t* Bt; int K, lda; bool skip_ctx;
    DI void unit_of(int L, Unit& u) const {
        int wgid = L; { const int q = nwg / 8, r = nwg % 8, xcd = wgid % 8, off = wgid / 8; wgid = (xcd < r ? xcd * (q + 1) : r * (q + 1) + (xcd - r) * q) + off; }
        const int nig = 8 * nN, gid = wgid / nig, fm = gid * 8, gsz = (nM - fm) < 8 ? (nM - fm) : 8;
        u.pm = fm + ((wgid % nig) % gsz); u.pn = (wgid % nig) / gsz;
        if (skip_ctx) u.pm += u.pm >> 4;
    }
    DI bool next(int i, Unit& u) const {
        const int rounds = nwg / G, rem = nwg - rounds * G;
        if (i < rounds) { unit_of(i * G + c, u); u.half = -1; return true; }
        if (i > rounds || rem == 0) return false;
        if (2 * rem <= G) { if (c >= 2 * rem) return false; unit_of(rounds * G + (c >> 1), u); u.half = c & 1; return true; }
        if (c >= rem) return false;
        unit_of(rounds * G + c, u); u.half = -1; return true;
    }
    DI unsigned a_off(const Unit& u, int row) const { const int rr = u.half < 0 ? row : u.half * 128 + (row & 127); return (unsigned)(u.pm * 256 + rr) * (unsigned)lda; }
    DI const unsigned* a_ptr(const Unit&, int) const { return nullptr; }
    DI unsigned a_cvt(unsigned raw) const { return raw; }
    DI const bf16_t* b_base(const Unit& u) const { return Bt + (size_t)u.pn * 256 * K; }
};
struct MoeUnit { int e, pn, valid, half; const unsigned* ent; };
template <bool TAIL>
struct MoeSched {
    static constexpr bool GATHER = true;
    typedef MoeUnit Unit;
    const LAS int* tab; const unsigned* list; const unsigned* zero  ; const bf16_t* W; int K, N, TN, lda, shift, G, c, nwg;
    DI bool unit_of(int L, Unit& u) const {
        const int v = tab[1 + (lane_now() & 31)];
        const int e = __builtin_popcount((unsigned)__ballot(v <= L));
        if (e >= NEXP) return false;
        const int rem = L - __builtin_amdgcn_readfirstlane(tab[e]), cn = __builtin_amdgcn_readfirstlane(tab[40 + e]);
        const int rt = rem / TN; u.e = e; u.pn = rem - rt * TN; u.ent = list + (size_t)e * MROWS + rt * 256; u.valid = min(256, cn - rt * 256); return true;
    }
    int lo, n, GX, j;
    DI void place() { GX = G >> 3; j = c >> 3; const int per = ((((nwg + 7) >> 3) + TN - 1) / TN) * TN; lo = (c & 7) * per; n = max(0, min(per, nwg - lo)); }
    DI bool next(int i, Unit& u) const {
        u.ent = zero; u.valid = 1;
        const int rounds = n / GX, rem = n - rounds * GX;
        if (!TAIL) { u.half = -1; if (i >= rounds) return false; return unit_of(lo + i * GX + j, u); }
        if (i > 0 || rem == 0) return false;
        if (2 * rem <= GX) {
            if (j >= 2 * rem) return false;
            if (!unit_of(lo + rounds * GX + (j >> 1), u)) return false;
            u.half = j & 1; u.ent += u.half * 128; u.valid = min(128, u.valid - u.half * 128);
            return u.valid > 0;
        }
        u.half = -1; if (j >= rem) return false;
        return unit_of(lo + rounds * GX + j, u);
    }
    DI unsigned a_off(const Unit& u, int row) const { const int rr = (TAIL && u.half >= 0) ? (row & 127) : row; return (u.ent[rr < u.valid ? rr : u.valid - 1] >> shift) * (unsigned)lda; }
    DI const unsigned* a_ptr(const Unit& u, int row) const { const int rr = (TAIL && u.half >= 0) ? (row & 127) : row; return u.ent + (rr < u.valid ? rr : u.valid - 1); }
    DI unsigned a_cvt(unsigned raw) const { return (raw >> shift) * (unsigned)lda; }
    DI const bf16_t* b_base(const Unit& u) const { return W + ((size_t)u.e * N + (size_t)u.pn * 256) * K; }
};
typedef float f32x4_t __attribute__((ext_vector_type(4)));
struct XEpiStore {
    static constexpr bool PERM = true;
    bf16_t* C; int ldc;
    DI void operator()(const f32x4 (&acc)[2][2][4][2], const DenseSched::Unit& u, int wr, int wc, int fr, int fq) const {
        const int row0 = u.pm * 256 + (u.half > 0 ? 128 : 0) + wr * 64 + fr, col0 = u.pn * 256 + wc * 32 + 8 * fq;
#pragma unroll
        for (int ai = 0; ai < 2; ++ai) if (ai == 0 || u.half < 0)
#pragma unroll
            for (int m = 0; m < 4; ++m) { bf16_t* rowp = C + (size_t)(row0 + ai * 128 + m * 16) * ldc + col0;
#pragma unroll
                for (int bj = 0; bj < 2; ++bj) { const f32x4 v0 = acc[ai][bj][m][0], v1 = acc[ai][bj][m][1];
                    u32x4 w; w.x = cvtpk(v0[0], v0[1]); w.y = cvtpk(v0[2], v0[3]); w.z = cvtpk(v1[0], v1[1]); w.w = cvtpk(v1[2], v1[3]);
                    *(u32x4*)(rowp + bj * 128) = w; } }
    } };
struct XEpiStore8 {
    static constexpr bool PERM = true;
    bf16_t* C; int ldc;
    DI void operator()(const f32x4 (&acc)[2][2][4][2], const DenseSched::Unit& u, int wr, int wc, int fr, int fq) const {
        const int row0 = u.pm * 256 + (u.half > 0 ? 128 : 0) + wr * 64 + fr, col0 = u.pn * 256 + wc * 32 + 8 * fq;
#pragma unroll
        for (int ai = 0; ai < 2; ++ai) if (ai == 0 || u.half < 0)
#pragma unroll
            for (int m = 0; m < 4; ++m) { bf16_t* rowp = C + (size_t)(row0 + ai * 128 + m * 16) * ldc + col0;
#pragma unroll
                for (int bj = 0; bj < 2; ++bj) { const f32x4 v0 = acc[ai][bj][m][0] * (1.0f / 32.0f), v1 = acc[ai][bj][m][1] * (1.0f / 32.0f);
                    u32x4 w; w.x = cvtpk(v0[0], v0[1]); w.y = cvtpk(v0[2], v0[3]); w.z = cvtpk(v1[0], v1[1]); w.w = cvtpk(v1[2], v1[3]);
                    *(u32x4*)(rowp + bj * 128) = w; } }
    } };
template <> struct epi_fp8<XEpiStore8> { static constexpr int value = 2; };
struct XEpiResid {
    static constexpr bool PERM = true;
    const Params* p; const float* mod;
    DI void operator()(const f32x4 (&acc)[2][2][4][2], const DenseSched::Unit& u, int wr, int wc, int fr, int fq) const {
        const int row0 = u.pm * 256 + (u.half > 0 ? 128 : 0) + wr * 64 + fr, col0 = u.pn * 256 + wc * 32 + 8 * fq;
#pragma unroll
        for (int ai = 0; ai < 2; ++ai) if (ai == 0 || u.half < 0)
#pragma unroll
            for (int m = 0; m < 4; ++m) { const int row = row0 + ai * 128 + m * 16;
                bf16_t* xr = xb_row(*p, row) + col0; const float* gp = mod + (size_t)mod_row(row) * 6144 + 2048 + col0;
#pragma unroll
                for (int bj = 0; bj < 2; ++bj) {
                    const u32x4 xw = *(const u32x4*)(xr + bj * 128); const f32x4 g0 = *(const f32x4*)(gp + bj * 128), g1 = *(const f32x4*)(gp + bj * 128 + 4);
                    const f32x4 a0 = acc[ai][bj][m][0], a1 = acc[ai][bj][m][1];
                    u32x4 w;
                    w.x = cvtpk(bflo(xw.x) + g0[0] * a0[0], bfhi(xw.x) + g0[1] * a0[1]); w.y = cvtpk(bflo(xw.y) + g0[2] * a0[2], bfhi(xw.y) + g0[3] * a0[3]);
                    w.z = cvtpk(bflo(xw.z) + g1[0] * a1[0], bfhi(xw.z) + g1[1] * a1[1]); w.w = cvtpk(bflo(xw.w) + g1[2] * a1[2], bfhi(xw.w) + g1[3] * a1[3]);
                    *(u32x4*)(xr + bj * 128) = w; } }
    } };
struct XEpiResid8 {
    static constexpr bool PERM = true;
    const Params* p; const float* mod;
    DI void operator()(const f32x4 (&acc)[2][2][4][2], const DenseSched::Unit& u, int wr, int wc, int fr, int fq) const {
        const int row0 = u.pm * 256 + (u.half > 0 ? 128 : 0) + wr * 64 + fr, col0 = u.pn * 256 + wc * 32 + 8 * fq;
        const float* gp = mod + (size_t)mod_row(u.pm * 256) * 6144 + 2048 + col0;
        f32x4 gv[2][2];
#pragma unroll
        for (int bj = 0; bj < 2; ++bj) { gv[bj][0] = *(const f32x4*)(gp + bj * 128) * (1.0f / 32.0f); gv[bj][1] = *(const f32x4*)(gp + bj * 128 + 4) * (1.0f / 32.0f); }
#pragma unroll
        for (int ai = 0; ai < 2; ++ai) if (ai == 0 || u.half < 0)
#pragma unroll
            for (int m = 0; m < 4; ++m) { const int row = row0 + ai * 128 + m * 16;
                bf16_t* xr = xb_row(*p, row) + col0;
#pragma unroll
                for (int bj = 0; bj < 2; ++bj) {
                    const u32x4 xw = *(const u32x4*)(xr + bj * 128); const f32x4 g0 = gv[bj][0], g1 = gv[bj][1];
                    const f32x4 a0 = acc[ai][bj][m][0], a1 = acc[ai][bj][m][1];
                    u32x4 w;
                    w.x = cvtpk(bflo(xw.x) + g0[0] * a0[0], bfhi(xw.x) + g0[1] * a0[1]); w.y = cvtpk(bflo(xw.y) + g0[2] * a0[2], bfhi(xw.y) + g0[3] * a0[3]);
                    w.z = cvtpk(bflo(xw.z) + g1[0] * a1[0], bfhi(xw.z) + g1[1] * a1[1]); w.w = cvtpk(bflo(xw.w) + g1[2] * a1[2], bfhi(xw.w) + g1[3] * a1[3]);
                    *(u32x4*)(xr + bj * 128) = w; } }
    } };
template <> struct epi_fp8<XEpiResid8> { static constexpr int value = 2; };
struct XEpiGlu {
    static constexpr bool PERM = true;
    bf16_t* act; const float* gates;
    DI void operator()(const f32x4 (&acc)[2][2][4][2], const MoeUnit& u, int wr, int wc, int fr, int fq) const {
#pragma unroll
        for (int ai = 0; ai < 2; ++ai)
#pragma unroll
            for (int m = 0; m < 4; ++m) { const int i = ai * 128 + wr * 64 + m * 16 + fr;
                if (i < u.valid) { const unsigned a = u.ent[i]; const float gw = gates[a];
                    const f32x4 g0 = acc[ai][0][m][0], g1 = acc[ai][0][m][1], u0 = acc[ai][1][m][0], u1 = acc[ai][1][m][1];
                    float v[8];
#pragma unroll
                    for (int j = 0; j < 4; ++j) { v[j] = silu_f(g0[j]) * u0[j] * gw; v[4 + j] = silu_f(g1[j]) * u1[j] * gw; }
                    u32x4 w; w.x = cvtpk(v[0], v[1]); w.y = cvtpk(v[2], v[3]); w.z = cvtpk(v[4], v[5]); w.w = cvtpk(v[6], v[7]);
                    *(u32x4*)(act + (size_t)a * DEXP + u.pn * 128 + wc * 32 + 8 * fq) = w; } }
    } };
struct XEpiGlu8 : XEpiGlu {
    DI void operator()(const f32x4 (&acc)[2][2][4][2], const MoeUnit& u, int wr, int wc, int fr, int fq) const {
#pragma unroll
        for (int ai = 0; ai < 2; ++ai)
#pragma unroll
            for (int m = 0; m < 4; ++m) { const int i = ai * 128 + wr * 64 + m * 16 + fr;
                if (i < u.valid) { const unsigned a = u.ent[i]; const float gw = gates[a] * (1.0f / 32.0f);
                    const f32x4 g0 = acc[ai][0][m][0] * (1.0f / 32.0f), g1 = acc[ai][0][m][1] * (1.0f / 32.0f), u0 = acc[ai][1][m][0], u1 = acc[ai][1][m][1];
                    float v[8];
#pragma unroll
                    for (int j = 0; j < 4; ++j) { v[j] = silu_f(g0[j]) * u0[j] * gw; v[4 + j] = silu_f(g1[j]) * u1[j] * gw; }
                    u32x4 w; w.x = cvtpk(v[0], v[1]); w.y = cvtpk(v[2], v[3]); w.z = cvtpk(v[4], v[5]); w.w = cvtpk(v[6], v[7]);
                    *(u32x4*)(act + (size_t)a * DEXP + u.pn * 128 + wc * 32 + 8 * fq) = w; } }
    } };
template <> struct epi_fp8<XEpiGlu8> { static constexpr int value = 2; };
struct XEpiScatter {
    static constexpr bool PERM = true;
    bf16_t* outp;
    DI void operator()(const f32x4 (&acc)[2][2][4][2], const MoeUnit& u, int wr, int wc, int fr, int fq) const {
#pragma unroll
        for (int ai = 0; ai < 2; ++ai)
#pragma unroll
            for (int m = 0; m < 4; ++m) { const int i = ai * 128 + wr * 64 + m * 16 + fr;
                if (i < u.valid) { unsigned char* rowp = (unsigned char*)outp + (size_t)u.ent[i] * 1024 + u.pn * 256 + wc * 64 + 16 * fq;
                    const f32x4 a0 = acc[ai][0][m][0] * 16.f, a1 = acc[ai][0][m][1] * 16.f, b0 = acc[ai][1][m][0] * 16.f, b1 = acc[ai][1][m][1] * 16.f;
                    u32x4 w; w.x = cvt_fp8x4(a0[0], a0[1], a0[2], a0[3]); w.y = cvt_fp8x4(a1[0], a1[1], a1[2], a1[3]); w.z = cvt_fp8x4(b0[0], b0[1], b0[2], b0[3]); w.w = cvt_fp8x4(b1[0], b1[1], b1[2], b1[3]);
                    *(u32x4*)rowp = w; } }
    } };
template <> struct epi_perm16<XEpiScatter> { static constexpr bool value = true; };

template <int KIND>
struct XEpiQKV {
    static constexpr bool PERM = true;
    static constexpr int KW = KIND == 1 ? 256 : 1024, LDRAW = KIND == 1 ? 1536 : 3072;
    static constexpr float ASC = 1.0f / 32.0f;
    bf16_t* Q; bf16_t* Kb; bf16_t* RAW; const float* qn; const float* kn;
    DI void operator()(const f32x4 (&acc)[2][2][4][2], const DenseSched::Unit& u, int wr, int wc, int fr, int fq) const {
        const int col0 = u.pn * 256, row0 = u.pm * 256 + (u.half > 0 ? 128 : 0) + wr * 64 + fr;
        if (col0 >= 1024 + KW) {
#pragma unroll
            for (int ai = 0; ai < 2; ++ai) if (ai == 0 || u.half < 0)
#pragma unroll
                for (int m = 0; m < 4; ++m) { bf16_t* rowp = RAW + (size_t)(row0 + ai * 128 + m * 16) * LDRAW + col0 + wc * 32 + 8 * fq;
#pragma unroll
                    for (int bj = 0; bj < 2; ++bj) { const f32x4 v0 = acc[ai][bj][m][0] * ASC, v1 = acc[ai][bj][m][1] * ASC;
                        u32x4 w; w.x = cvtpk(v0[0], v0[1]); w.y = cvtpk(v0[2], v0[3]); w.z = cvtpk(v1[0], v1[1]); w.w = cvtpk(v1[2], v1[3]);
                        *(u32x4*)(rowp + bj * 128) = w; } }
            return;
        }
        const bool isq = col0 < 1024;
        const int head = isq ? 4 * u.pn + wc : ((col0 - 1024) >> 6) + wc;
        const float* gain = (isq ? qn : kn) + 8 * fq;
        const float scale = isq ? 0.125f * LOG2E : 1.0f;
        bf16_t* dstb = isq ? Q + head * 64 + 8 * fq : Kb + head * 64 + 8 * fq;
        const int ldd = isq ? 1024 : KW;
        f32x4 g[2][2];
#pragma unroll
        for (int bj = 0; bj < 2; ++bj)
#pragma unroll
            for (int n = 0; n < 2; ++n) g[bj][n] = *(const f32x4*)(gain + 32 * bj + 4 * n);
#pragma unroll
        for (int ai = 0; ai < 2; ++ai) if (ai == 0 || u.half < 0)
#pragma unroll
            for (int m = 0; m < 4; ++m) {
                const int row = row0 + ai * 128 + m * 16, b = row / PP, pos = row - b * PP;
                f32x4 v[2][2];
                float ss = 0.f;
#pragma unroll
                for (int bj = 0; bj < 2; ++bj)
#pragma unroll
                    for (int n = 0; n < 2; ++n) { v[bj][n] = acc[ai][bj][m][n] * ASC; ss += v[bj][n][0] * v[bj][n][0] + v[bj][n][1] * v[bj][n][1] + v[bj][n][2] * v[bj][n][2] + v[bj][n][3] * v[bj][n][3]; }
                ss += __shfl_xor(ss, 16); ss += __shfl_xor(ss, 32);
                const float rs = rsqrtf(ss * (1.0f / 64.0f) + EPS);
#pragma unroll
                for (int bj = 0; bj < 2; ++bj)
#pragma unroll
                    for (int n = 0; n < 2; ++n) v[bj][n] = v[bj][n] * rs * g[bj][n];
                if (KIND != 0 && pos < SEQ) {
                    const int prow = (pos >> 6) & 63, pcol = pos & 63;
                    const float* cs = ROPE64 + ((fq < 2 ? prow : pcol) * 16 + ((8 * fq) & 15)) * 2;
#pragma unroll
                    for (int n = 0; n < 2; ++n)
#pragma unroll
                        for (int j = 0; j < 4; ++j) {
                            const float c = cs[(4 * n + j) * 2], sn = cs[(4 * n + j) * 2 + 1], x1 = v[0][n][j], x2 = v[1][n][j];
                            v[0][n][j] = x1 * c - x2 * sn; v[1][n][j] = x2 * c + x1 * sn;
                        }
                }
                bf16_t* rowp = dstb + (size_t)row * ldd;
#pragma unroll
                for (int bj = 0; bj < 2; ++bj) { const f32x4 v0 = v[bj][0] * scale, v1 = v[bj][1] * scale;
                    u32x4 w; w.x = cvtpk(v0[0], v0[1]); w.y = cvtpk(v0[2], v0[3]); w.z = cvtpk(v1[0], v1[1]); w.w = cvtpk(v1[2], v1[3]);
                    *(u32x4*)(rowp + bj * 32) = w; }
            }
    } };
constexpr bool qkv_fp8(int kind) { return true; }
template <int KIND> struct epi_fp8<XEpiQKV<KIND>> { static constexpr int value = 2; };
template <int KIND>
DI void gemm_qkv_x(const Params& p, unsigned char* smem, const bf16_t* Wt, int N, const float* qn, const float* kn, int bid, int nb, int tid) {
    constexpr int KU = qkv_fp8(KIND) ? 512 : 1024;
    DenseSched S; S.nM = MROWS / 256; S.nN = N / 256; S.nwg = S.nM * S.nN; S.G = nb; S.c = bid; S.Bt = Wt; S.K = KU; S.lda = KU; S.skip_ctx = false;
    XEpiQKV<KIND> e{(bf16_t*)(p.ws + WS_Q), (bf16_t*)(p.ws + WS_K), (bf16_t*)(p.ws + WS_RAW), qn, kn};
    pg8::gemm_phase((lds_ptr)smem, (const bf16_t*)(p.ws + WS_H), KU, S, e, tid);
}
template <bool UQ>
struct XEpiMla {
    static constexpr bool PERM = true;
    static constexpr float ASC = 1.0f / 32.0f;
    bf16_t* Q; bf16_t* Kb; bf16_t* V; const float* qn; const float* kn;
    DI void operator()(const f32x4 (&acc)[2][2][4][2], const DenseSched::Unit& u, int wr, int wc, int fr, int fq) const {
        const int row0 = u.pm * 256 + (u.half > 0 ? 128 : 0) + wr * 64 + fr;
        if (u.pn < 4) {
            const int head = 4 * u.pn + wc;
            const float* gain = (UQ ? qn : kn) + 8 * fq;
            const float scale = UQ ? 0.10206207261596577f * LOG2E : 1.0f;
            bf16_t* dstb = (UQ ? Q : Kb) + head * 96 + 8 * fq;
            f32x4 g[2][2];
#pragma unroll
            for (int bj = 0; bj < 2; ++bj)
#pragma unroll
                for (int n = 0; n < 2; ++n) g[bj][n] = *(const f32x4*)(gain + 32 * bj + 4 * n);
#pragma unroll
            for (int ai = 0; ai < 2; ++ai) if (ai == 0 || u.half < 0)
#pragma unroll
                for (int m = 0; m < 4; ++m) {
                    const int row = row0 + ai * 128 + m * 16;
                    float ss = 0.f;
#pragma unroll
                    for (int bj = 0; bj < 2; ++bj)
#pragma unroll
                        for (int n = 0; n < 2; ++n) { const f32x4 v = acc[ai][bj][m][n] * ASC; ss += v[0] * v[0] + v[1] * v[1] + v[2] * v[2] + v[3] * v[3]; }
                    ss += __shfl_xor(ss, 16); ss += __shfl_xor(ss, 32);
                    const float rs = rsqrtf(ss * (1.0f / 64.0f) + EPS) * scale;
                    bf16_t* rowp = dstb + (size_t)row * 1536;
#pragma unroll
                    for (int bj = 0; bj < 2; ++bj) { const f32x4 v0 = acc[ai][bj][m][0] * (ASC * rs) * g[bj][0], v1 = acc[ai][bj][m][1] * (ASC * rs) * g[bj][1];
                        u32x4 w; w.x = cvtpk(v0[0], v0[1]); w.y = cvtpk(v0[2], v0[3]); w.z = cvtpk(v1[0], v1[1]); w.w = cvtpk(v1[2], v1[3]);
                        *(u32x4*)(rowp + bj * 32) = w; }
                }
        } else if (UQ) {
            const float scale = 0.10206207261596577f * LOG2E;
            const f32x4 g1 = *(const f32x4*)(qn + 64 + 4 * fq), g2 = *(const f32x4*)(qn + 64 + 16 + 4 * fq);
#pragma unroll
            for (int ai = 0; ai < 2; ++ai) if (ai == 0 || u.half < 0)
#pragma unroll
                for (int m = 0; m < 4; ++m) {
                    const int row = row0 + ai * 128 + m * 16, b = row / PP, pos = row - b * PP;
                    const int prow = (pos >> 6) & 63, pcol = pos & 63;
                    const float* cs = ROPE32 + ((fq < 2 ? prow : pcol) * 8 + ((4 * fq) & 7)) * 2;
#pragma unroll
                    for (int bj = 0; bj < 2; ++bj) {
                        f32x4 x1 = acc[ai][bj][m][0] * ASC, x2 = acc[ai][bj][m][1] * ASC;
                        float ss = x1[0] * x1[0] + x1[1] * x1[1] + x1[2] * x1[2] + x1[3] * x1[3] + x2[0] * x2[0] + x2[1] * x2[1] + x2[2] * x2[2] + x2[3] * x2[3];
                        ss += __shfl_xor(ss, 16); ss += __shfl_xor(ss, 32);
                        const float rs = rsqrtf(ss * (1.0f / 32.0f) + EPS);
                        x1 = x1 * rs * g1; x2 = x2 * rs * g2;
                        if (pos < SEQ) {
#pragma unroll
                            for (int j = 0; j < 4; ++j) { const float c = cs[2 * j], sn = cs[2 * j + 1], a1 = x1[j], a2 = x2[j]; x1[j] = a1 * c - a2 * sn; x2[j] = a2 * c + a1 * sn; }
                        }
                        x1 = x1 * scale; x2 = x2 * scale;
                        bf16_t* rowp = Q + (size_t)row * 1536 + (8 * (u.pn - 4) + 4 * bj + wc) * 96 + 64 + 4 * fq;
                        u32x2 w1, w2; w1.x = cvtpk(x1[0], x1[1]); w1.y = cvtpk(x1[2], x1[3]); w2.x = cvtpk(x2[0], x2[1]); w2.y = cvtpk(x2[2], x2[3]);
                        *(u32x2*)rowp = w1; *(u32x2*)(rowp + 16) = w2;
                    }
                }
        } else {
#pragma unroll
            for (int ai = 0; ai < 2; ++ai) if (ai == 0 || u.half < 0)
#pragma unroll
                for (int m = 0; m < 4; ++m) { bf16_t* rowp = V + (size_t)(row0 + ai * 128 + m * 16) * 1024 + (u.pn - 4) * 256 + wc * 32 + 8 * fq;
#pragma unroll
                    for (int bj = 0; bj < 2; ++bj) { const f32x4 v0 = acc[ai][bj][m][0] * ASC, v1 = acc[ai][bj][m][1] * ASC;
                        u32x4 w; w.x = cvtpk(v0[0], v0[1]); w.y = cvtpk(v0[2], v0[3]); w.z = cvtpk(v1[0], v1[1]); w.w = cvtpk(v1[2], v1[3]);
                        *(u32x4*)(rowp + bj * 128) = w; } }
        }
    } };
template <bool UQ> struct epi_fp8<XEpiMla<UQ>> { static constexpr int value = 2; };
template <bool UQ>
DI void gemm_mla_x(const Params& p, unsigned char* smem, int bid, int nb, int tid) {
    bf16_t* O = (bf16_t*)(p.ws + WS_O);
    DenseSched S; S.nM = MROWS / 256; S.nN = (UQ ? 1536 : 2048) / 256; S.nwg = S.nM * S.nN; S.G = nb; S.c = bid; S.Bt = (const bf16_t*)(p.ws + (UQ ? W_UQ : W_UKV)); S.K = UQ ? 256 : 128; S.lda = S.K; S.skip_ctx = false;
    XEpiMla<UQ> e{(bf16_t*)(p.ws + WS_Q), (bf16_t*)(p.ws + WS_K), (bf16_t*)(p.ws + WS_RAW), p.in[28], p.in[29]};
    pg8::gemm_phase((lds_ptr)smem, UQ ? O : (const bf16_t*)((const unsigned char*)O + (size_t)MROWS * 512), S.K, S, e, tid);
}
template <int EPIK>
DI void gemm_dense_x(const Params& p, unsigned char* smem, const bf16_t* A, int lda, const bf16_t* Wt, int K, int N, bf16_t* C, int ldc, const float* mod, int bid, int nb, int tid, bool skip_ctx = false) {
    DenseSched S; S.nM = skip_ctx ? NBATCH * 16 : MROWS / 256; S.nN = N / 256; S.nwg = S.nM * S.nN; S.G = nb; S.c = bid; S.Bt = Wt; S.K = K; S.lda = lda; S.skip_ctx = skip_ctx;
    if (EPIK == 0) { XEpiStore e{C, ldc}; pg8::gemm_phase((lds_ptr)smem, A, K, S, e, tid); }
    else if (EPIK == 2) { XEpiStore8 e{C, ldc}; pg8::gemm_phase((lds_ptr)smem, A, K, S, e, tid); }
    else if (EPIK == 3) { XEpiResid8 e{&p, mod}; pg8::gemm_phase((lds_ptr)smem, A, K, S, e, tid); }
    else { XEpiResid e{&p, mod}; pg8::gemm_phase((lds_ptr)smem, A, K, S, e, tid); }
}
template <int WHICH, bool TAIL>
DI void gemm_moe_call(const Params& p, unsigned char* smem, int layer, int bid, int nb, int tid) {
    MoeSched<TAIL> S; S.list = (const unsigned*)(p.ws + WS_LIST); S.zero = (const unsigned*)(p.ws + WS_CTL) + 8192; S.G = nb; S.c = bid;
    {
        LAS int* tab = (LAS int*)(smem + GEMM_LDS);
        constexpr int TNc = WHICH == 0 ? 2 : 4;
        if (tid < 64) {
            const unsigned cv = tid < 32 ? ((const unsigned*)(p.ws + WS_CTL) + CW_CNT + layer * 32)[tid] : 0u;
            int incl = (int)((cv + 255u) >> 8) * TNc;
#pragma unroll
            for (int d = 1; d < 32; d <<= 1) { const int o = __shfl_up(incl, d); if (tid >= d) incl += o; }
            if (tid < 32) { tab[1 + tid] = incl; tab[40 + tid] = (int)cv; }
            if (tid == 0) tab[0] = 0;
        }
        __syncthreads();
        S.tab = tab; S.nwg = __builtin_amdgcn_readfirstlane(tab[32]);
    }
    if (WHICH == 0) { S.W = (const bf16_t*)(p.ws + W_GU + (size_t)layer * 32 * 512 * 1024); S.K = 512; S.N = 512; S.TN = 2; S.lda = 512; S.shift = 1;
        S.place(); XEpiGlu8 e{{(bf16_t*)(p.ws + WS_Q), (const float*)(p.ws + WS_GATE)}}; pg8::gemm_phase((lds_ptr)smem, (const bf16_t*)(p.ws + WS_H), 512, S, e, tid); }
    else { S.W = (const bf16_t*)(p.ws + W_DN) + (size_t)layer * 32 * 1024 * 256; S.K = 256; S.N = 1024; S.TN = 4; S.lda = DEXP; S.shift = 0;
        S.place(); XEpiScatter e{(bf16_t*)(p.ws + WS_RAW)}; pg8::gemm_phase((lds_ptr)smem, (const bf16_t*)(p.ws + WS_Q), 256, S, e, tid); }
}
template <int WHICH>
DI void gemm_moe_x(const Params& p, unsigned char* smem, int layer, int bid, int nb, int tid) {
    const int wv = __builtin_amdgcn_readfirstlane(tid >> 6);
    gemm_moe_call<WHICH, false>(p, smem, layer, bid, nb, (wv << 6) | lane_now());
    gemm_moe_call<WHICH, true>(p, smem, layer, bid, nb, (wv << 6) | lane_now());
}

constexpr int NPHASES = 2 + (7 + 7 + 9 + 7) + 1;
constexpr int SMEM_BYTES = GEMM_LDS + 512;

template <int KIND>
DI void layer_phases(const Params& p, int& ph, const int lo, const int hi, const XcdBarrier& bar, unsigned char* smem, int bid, int nb, int wid_u) {
    constexpr int L = KIND;
    const float* mod = (const float*)(p.ws + WS_MOD) + (size_t)L * 9 * 6144;
    bf16_t* H = (bf16_t*)(p.ws + WS_H); bf16_t* O = (bf16_t*)(p.ws + WS_O); bf16_t* RAW = (bf16_t*)(p.ws + WS_RAW);
    bf16_t* Q = (bf16_t*)(p.ws + WS_Q); bf16_t* Kb = (bf16_t*)(p.ws + WS_K);
#ifndef AABL
#define AABL 0
#endif
#ifndef GPROBE
#define GPROBE 0
#endif
#ifndef DUP_MASK
#define DUP_MASK 0ull
#endif
#define PHASE2(BODY, DUPBODY) do { if (lo <= ph && ph < hi) { const int tid = (wid_u << 6) | lane_now(); if ((DUP_MASK >> ph) & 1ull) { DUPBODY; xcd_barrier(bar, tid == 0); } BODY; } if (lo <= ph && ph + 1 < hi) xcd_barrier(bar, ((wid_u << 6) | lane_now()) == 0); ++ph; } while (0)
#define PHASE(...) PHASE2((__VA_ARGS__), (__VA_ARGS__))
    if (L == 0) PHASE(phase_rows<2 | 8 | 32>(p, L, 0, bid, nb, tid), phase_router_prep(p, bid, nb, tid));
    else PHASE2((phase_rows<3 | 32>(p, L, 0, bid, nb, tid)), (phase_rows<2 | 32>(p, L, 0, bid, nb, tid)));
    AttnP a{};
    if (KIND == 0) {
        PHASE(gemm_qkv_x<0>(p, smem, (const bf16_t*)(p.ws + W_QKV0), 3072, p.in[15], p.in[16], bid, nb, tid));
        a = AttnP{Q, 1024, Kb, 1024, RAW + 2048, 3072, O, 1024, 16, 0, 0, 64, p.in[17], nullptr, 1, p.in[16]};
        PHASE(attn_na(a, smem, bid, nb, tid));
        PHASE2((gemm_dense_x<3>(p, smem, O, 512, (const bf16_t*)(p.ws + W_O0), 512, 1024, nullptr, 0, mod, bid, nb, tid)), (gemm_dense_x<0>(p, smem, O, 1024, (const bf16_t*)(p.ws + W_O0), 1024, 1024, RAW, 1024, nullptr, bid, nb, tid)));
    } else if (KIND == 1) {
        PHASE(gemm_qkv_x<1>(p, smem, (const bf16_t*)(p.ws + W_QKV1), 1536, p.in[20], p.in[21], bid, nb, tid));
        a = AttnP{Q, 1024, Kb, 256, RAW + 1280, 1536, O, 1024, 16, 2, 2, 64, nullptr, p.in[22], 1};
        PHASE(attn_mfma<64, 64, 1>(a, smem, bid, nb, tid));
        PHASE2((gemm_dense_x<3>(p, smem, O, 512, (const bf16_t*)(p.ws + W_O1), 512, 1024, nullptr, 0, mod, bid, nb, tid)), (gemm_dense_x<0>(p, smem, O, 1024, (const bf16_t*)(p.ws + W_O1), 1024, 1024, RAW, 1024, nullptr, bid, nb, tid)));
    } else if (KIND == 2) {
        bf16_t* cqn = O; bf16_t* ckvn = O + (size_t)MROWS * 384;
        PHASE(gemm_dense_x<2>(p, smem, H, 512, (const bf16_t*)(p.ws + W_DQKV), 512, 768, Q, 768, nullptr, bid, nb, tid));
        PHASE(phase_post_mla1(p, bid, nb, tid));
        PHASE(gemm_mla_x<true>(p, smem, bid, nb, tid), gemm_mla_x<false>(p, smem, bid, nb, (wid_u << 6) | lane_now()));
        a = AttnP{Q, 1536, Kb, 1536, RAW, 1024, O, 1024, 16, 0, 0, 64, nullptr, nullptr, 1};
        PHASE(attn_mfma<96, 64, 2>(a, smem, bid, nb, tid));
        PHASE2((gemm_dense_x<3>(p, smem, O, 512, (const bf16_t*)(p.ws + W_O2), 512, 1024, nullptr, 0, mod, bid, nb, tid)), (gemm_dense_x<0>(p, smem, O, 1024, (const bf16_t*)(p.ws + W_O2), 1024, 1024, RAW, 1024, nullptr, bid, nb, tid)));
    } else {
        PHASE(gemm_qkv_x<3>(p, smem, (const bf16_t*)(p.ws + W_QKV3), 3072, p.in[32], p.in[33], bid, nb, tid));
        a = AttnP{Q, 1024, Kb, 1024, RAW + 2048, 3072, H  , 2048, 16, 0, 1, 128, nullptr, nullptr, 0, nullptr, p.in[34], p.in[35], (unsigned char*)RAW  , 6144};
        PHASE(attn_mfma<64, 128, 2>(a, smem, bid, nb, tid));
        PHASE(gemm_dense_x<3>(p, smem, RAW, 3072, (const bf16_t*)(p.ws + W_O3), 512, 1024, nullptr, 0, mod, bid, nb, tid, true));
    }
    PHASE(phase_router(p, smem, L, L == 3, bid, nb, tid));
    PHASE(gemm_moe_x<0>(p, smem, L, bid, nb, tid));
    PHASE(gemm_moe_x<1>(p, smem, L, bid, nb, tid));
}

__global__ void __launch_bounds__(NTHREADS, 2) mega(Params p, int lo, int hi) {
    extern __shared__ __attribute__((aligned(16))) unsigned char smem[];
    const int bid = blockIdx.x, nb = gridDim.x, wid_u = __builtin_amdgcn_readfirstlane(threadIdx.x >> 6);
    float* lds = (float*)smem;
    volatile LAS unsigned* xbw = (volatile LAS unsigned*)(smem + SMEM_BYTES - 16);
    if (threadIdx.x == 0) { xbw[0] = 0u; xbw[1] = 0u; }
    __syncthreads();
    XcdBarrier bar = xcd_barrier_post((unsigned*)(p.ws + WS_CTL), xbw);
    int ph = 0;
    PHASE(phase_prologue(p, lds, bid, nb, tid));
    PHASE(phase_mod_reduce(p, bid, nb, tid));
    layer_phases<0>(p, ph, lo, hi, bar, smem, bid, nb, wid_u);
    layer_phases<1>(p, ph, lo, hi, bar, smem, bid, nb, wid_u);
    layer_phases<2>(p, ph, lo, hi, bar, smem, bid, nb, wid_u);
    layer_phases<3>(p, ph, lo, hi, bar, smem, bid, nb, wid_u);
    PHASE2((phase_rows<1 | 16>(p, 3, 0, bid, nb, tid)), (void)0);
}

extern "C" void kernel_launch(void* const* d_in, const int* in_sizes, int n_in, void* d_out, int out_size, void* d_ws, size_t ws_size, hipStream_t stream) {
    (void)in_sizes; (void)out_size;
    if (n_in < 37 || ws_size < WS_END) { fprintf(stderr, "kernel_launch: unexpected inputs (n_in %d, ws %zu)\n", n_in, ws_size); return; }
    static int grid = 0;
    if (!grid) {
        int dev = 0, cus = 0, per_cu = 0;
        hipGetDevice(&dev);
        hipDeviceGetAttribute(&cus, hipDeviceAttributeMultiprocessorCount, dev);
        hipFuncSetAttribute((const void*)mega, hipFuncAttributeMaxDynamicSharedMemorySize, SMEM_BYTES);
        hipOccupancyMaxActiveBlocksPerMultiprocessor(&per_cu, mega, NTHREADS, SMEM_BYTES);
        if (per_cu < 1) per_cu = 1;
        grid = cus * (per_cu < 1 ? per_cu : 1);
    }
    Params p{};
    for (int i = 0; i < 37; ++i) p.in[i] = (const float*)d_in[i];
    p.out = (float*)d_out; p.ws = (unsigned char*)d_ws;
    hipMemsetAsync(p.ws + WS_CTL, 0, 65536, stream);
#if ONE_LAUNCH
    hipLaunchKernelGGL(mega, dim3(grid), dim3(NTHREADS), SMEM_BYTES, stream, p, 0, NPHASES);
#else
    for (int k = 0; k < NPHASES; ++k) hipLaunchKernelGGL(mega, dim3(grid), dim3(NTHREADS), SMEM_BYTES, stream, p, k, k + 1);
#endif
}
```

```cpp
#include <hip/hip_runtime.h>
#include <stdint.h>
#include <stdio.h>

#ifndef ONE_LAUNCH
#define ONE_LAUNCH 1
#endif

#define DI __device__ __forceinline__
typedef unsigned short bf16_t;
typedef short bf16x8 __attribute__((ext_vector_type(8)));
typedef float f32x4 __attribute__((ext_vector_type(4)));
typedef float f32x16 __attribute__((ext_vector_type(16)));
typedef unsigned u32x4 __attribute__((ext_vector_type(4)));
typedef unsigned u32x2 __attribute__((ext_vector_type(2)));

constexpr int DM = 1024, NBATCH = 8, SEQ = 4096, CTXL = 256, PP = SEQ + CTXL, MROWS = NBATCH * PP;
constexpr int NEXP = 32, DEXP = 256;
constexpr float EPS = 1e-6f, LOG2E = 1.4426950408889634f;
constexpr int NTHREADS = 512, NW = NTHREADS / 64;

constexpr size_t MiB = 1ull << 20;
constexpr size_t WS_RAW_FWD = 380ull << 20;
constexpr size_t WS_CTL = 0, CTL_BYTES = 1 * MiB;
constexpr size_t WS_MOD = 1 * MiB;
constexpr size_t WS_MODP = WS_RAW_FWD;
constexpr size_t WS_XCTX = 9 * MiB;
constexpr size_t WS_LIST = 17 * MiB;
constexpr size_t WS_GATE = 22 * MiB;
constexpr size_t WS_W = 24 * MiB;
constexpr size_t W_QKV0 = WS_W + 0 * MiB, W_O0 = WS_W + 6 * MiB, W_QKV1 = WS_W + 8 * MiB, W_O1 = WS_W + 11 * MiB, W_DQKV = WS_W + 13 * MiB,
                 W_UQ = WS_W + 15 * MiB, W_UKV = WS_W + 17 * MiB, W_O2 = WS_W + 18 * MiB, W_QKV3 = WS_W + 20 * MiB, W_O3 = WS_W + 26 * MiB,
                 W_GU = WS_W + 28 * MiB, W_DN = WS_W + 156 * MiB;
constexpr size_t WS_H = 244 * MiB;
constexpr size_t WS_O = 312 * MiB;
constexpr size_t WS_RAW = 380 * MiB;
constexpr size_t WS_Q = 620 * MiB;
constexpr size_t WS_K = 722 * MiB;
constexpr size_t WS_XB = 824 * MiB;
constexpr size_t WS_END = 892 * MiB;
constexpr int CW_CNT = 4096;

constexpr size_t WS_RW = 2 * MiB;
struct Params { const float* in[37]; float* out; unsigned char* ws; };

DI unsigned f2bf(float f) { unsigned u = __float_as_uint(f); return (u + 0x7fffu + ((u >> 16) & 1u)) >> 16; }
DI float bf2f(unsigned h) { return __uint_as_float(h << 16); }
DI unsigned pk2(float lo, float hi) { return f2bf(lo) | (f2bf(hi) << 16); }
DI float bflo(unsigned w) { return __uint_as_float(w << 16); }
DI float bfhi(unsigned w) { return __uint_as_float(w & 0xffff0000u); }
DI int lane_now() { unsigned lane; asm volatile("v_mbcnt_lo_u32_b32 %0, -1, 0\n\tv_mbcnt_hi_u32_b32 %0, -1, %0" : "=v"(lane)); return (int)lane; }
DI float wave_sum(float v) {
#pragma unroll
    for (int o = 32; o > 0; o >>= 1) v += __shfl_xor(v, o);
    return v;
}
DI float silu_f(float x) { return x / (1.0f + __expf(-x)); }
DI void unpack8(const u32x4 w, float (&f)[8]) {
    f[0] = bflo(w.x); f[1] = bfhi(w.x); f[2] = bflo(w.y); f[3] = bfhi(w.y); f[4] = bflo(w.z); f[5] = bfhi(w.z); f[6] = bflo(w.w); f[7] = bfhi(w.w);
}
DI u32x4 pack8(const float (&f)[8]) { u32x4 w; w.x = pk2(f[0], f[1]); w.y = pk2(f[2], f[3]); w.z = pk2(f[4], f[5]); w.w = pk2(f[6], f[7]); return w; }
DI float* xrow_ptr(const Params& p, int r) {
    const int b = r / PP, pos = r - b * PP;
    return pos < SEQ ? p.out + ((size_t)b * SEQ + pos) * DM : (float*)(p.ws + WS_XCTX) + ((size_t)b * CTXL + (pos - SEQ)) * DM;
}
DI bf16_t* xb_row(const Params& p, int r) { return (bf16_t*)(p.ws + WS_XB) + (size_t)r * DM; }
DI int mod_row(int r) { const int b = r / PP, pos = r - b * PP; return pos < SEQ ? b : 8; }
__device__ const float ROPE64[2048] = {
  1.000000000e+00f, 0.000000000e+00f, 1.000000000e+00f, 0.000000000e+00f, 1.000000000e+00f, 0.000000000e+00f, 1.000000000e+00f, 0.000000000e+00f,
  1.000000000e+00f, 0.000000000e+00f, 1.000000000e+00f, 0.000000000e+00f, 1.000000000e+00f, 0.000000000e+00f, 1.000000000e+00f, 0.000000000e+00f,
  1.000000000e+00f, 0.000000000e+00f, 1.000000000e+00f, 0.000000000e+00f, 1.000000000e+00f, 0.000000000e+00f, 1.000000000e+00f, 0.000000000e+00f,
  1.000000000e+00f, 0.000000000e+00f, 1.000000000e+00f, 0.000000000e+00f, 1.000000000e+00f, 0.000000000e+00f, 1.000000000e+00f, 0.000000000e+00f,
  5.403022766e-01f, 8.414709568e-01f, 8.460091352e-01f, 5.331684351e-01f, 9.504152536e-01f, 3.109835982e-01f, 9.842302203e-01f, 1.768921912e-01f,
  9.950041771e-01f, 9.983342141e-02f, 9.984192848e-01f, 5.620449781e-02f, 9.995000362e-01f, 3.161750361e-02f, 9.998418689e-01f, 1.778185740e-02f,
  9.999499917e-01f, 9.999833070e-03f, 9.999842048e-01f, 5.623383448e-03f, 9.999949932e-01f, 3.162272274e-03f, 9.999983907e-01f, 1.778278500e-03f,
  9.999995232e-01f, 9.999999311e-04f, 9.999998212e-01f, 5.623412435e-04f, 9.999999404e-01f, 3.162277571e-04f, 1.000000000e+00f, 1.778279402e-04f,
  -4.161468446e-01f, 9.092974067e-01f, 4.314628243e-01f, 9.021307230e-01f, 8.065783978e-01f, 5.911270976e-01f, 9.374182820e-01f, 3.482052684e-01f,
  9.800665975e-01f, 1.986693293e-01f, 9.936820865e-01f, 1.122313142e-01f, 9.980006814e-01f, 6.320339441e-02f, 9.993675947e-01f, 3.555808961e-02f,
  9.998000264e-01f, 1.999866590e-02f, 9.999367595e-01f, 1.124658901e-02f, 9.999799728e-01f, 6.324512884e-03f, 9.999936819e-01f, 3.556551412e-03f,
  9.999979734e-01f, 1.999998698e-03f, 9.999993443e-01f, 1.124682371e-03f, 9.999998212e-01f, 6.324554561e-04f, 9.999999404e-01f, 3.556558804e-04f,
  -9.899924994e-01f, 1.411200017e-01f, -1.159661636e-01f, 9.932531714e-01f, 5.827536583e-01f, 8.126488924e-01f, 8.610406518e-01f, 5.085361004e-01f,
  9.553365111e-01f, 2.955202162e-01f, 9.858034849e-01f, 1.679033041e-01f, 9.955033660e-01f, 9.472608566e-02f, 9.985772967e-01f, 5.332308263e-02f,
  9.995500445e-01f, 2.999549918e-02f, 9.998577237e-01f, 1.686943881e-02f, 9.999549985e-01f, 9.486690164e-03f, 9.999857545e-01f, 5.334813148e-03f,
  9.999955297e-01f, 2.999995602e-03f, 9.999985695e-01f, 1.687023090e-03f, 9.999995232e-01f, 9.486831259e-04f, 9.999998808e-01f, 5.334838061e-04f,
  -6.536436081e-01f, -7.568024993e-01f, -6.276797056e-01f, 7.784717083e-01f, 3.011374772e-01f, 9.535807371e-01f, 7.575061917e-01f, 6.528279781e-01f,
  9.210609794e-01f, 3.894183338e-01f, 9.748082757e-01f, 2.230444849e-01f, 9.920106530e-01f, 1.261540651e-01f, 9.974712729e-01f, 7.107120752e-02f,
  9.992001057e-01f, 3.998933360e-02f, 9.997470379e-01f, 2.249175683e-02f, 9.999200106e-01f, 1.264877338e-02f, 9.999747276e-01f, 7.113057654e-03f,
  9.999920130e-01f, 3.999989480e-03f, 9.999974966e-01f, 2.249363344e-03f, 9.999992251e-01f, 1.264910679e-03f, 9.999997616e-01f, 7.113117026e-04f,
  2.836622000e-01f, -9.589242935e-01f, -9.460792542e-01f, 3.239352703e-01f, -1.034233812e-02f, 9.999465346e-01f, 6.300802827e-01f, 7.765299678e-01f,
  8.775825500e-01f, 4.794255495e-01f, 9.607312679e-01f, 2.774805427e-01f, 9.875259995e-01f, 1.574558765e-01f, 9.960497618e-01f, 8.879686147e-02f,
  9.987502694e-01f, 4.997916520e-02f, 9.996047616e-01f, 2.811336145e-02f, 9.998750091e-01f, 1.581072807e-02f, 9.999604821e-01f, 8.891279809e-03f,
  9.999874830e-01f, 4.999979399e-03f, 9.999960661e-01f, 2.811702900e-03f, 9.999987483e-01f, 1.581138116e-03f, 9.999995828e-01f, 8.891395992e-04f,
  9.601702690e-01f, -2.794154882e-01f, -9.731037021e-01f, -2.303675115e-01f, -3.207964003e-01f, 9.471482038e-01f, 4.827820361e-01f, 8.757405281e-01f,
  8.253356218e-01f, 5.646424890e-01f, 9.436169863e-01f, 3.310393095e-01f, 9.820539355e-01f, 1.886002719e-01f, 9.943132997e-01f, 1.064944416e-01f,
  9.982005358e-01f, 5.996400490e-02f, 9.994308352e-01f, 3.373407945e-02f, 9.998199940e-01f, 1.897252724e-02f, 9.999430776e-01f, 1.066947449e-02f,
  9.999819994e-01f, 5.999964196e-03f, 9.999943376e-01f, 3.374041524e-03f, 9.999982119e-01f, 1.897365320e-03f, 9.999994040e-01f, 1.066967379e-03f,
  7.539022565e-01f, 6.569865942e-01f, -7.004297972e-01f, -7.137212753e-01f, -5.994374752e-01f, 8.004215956e-01f, 3.202570081e-01f, 9.473307133e-01f,
  7.648422122e-01f, 6.442176700e-01f, 9.235194325e-01f, 3.835515678e-01f, 9.755998850e-01f, 2.195560932e-01f, 9.922624230e-01f, 1.241583377e-01f,
  9.975510240e-01f, 6.994284689e-02f, 9.992253184e-01f, 3.935372457e-02f, 9.997550249e-01f, 2.213413455e-02f, 9.999225140e-01f, 1.244763471e-02f,
  9.999755025e-01f, 6.999942940e-03f, 9.999922514e-01f, 3.936378751e-03f, 9.999975562e-01f, 2.213592408e-03f, 9.999992251e-01f, 1.244795276e-03f,
  -1.455000341e-01f, 9.893582463e-01f, -2.120364457e-01f, -9.772617817e-01f, -8.186324239e-01f, 5.743177533e-01f, 1.476312131e-01f, 9.890424609e-01f,
  6.967067122e-01f, 7.173560858e-01f, 9.005023241e-01f, 4.348512292e-01f, 9.681702852e-01f, 2.502923310e-01f, 9.898977876e-01f, 1.417829692e-01f,
  9.968017340e-01f, 7.991468906e-02f, 9.989882708e-01f, 4.497213289e-02f, 9.996800423e-01f, 2.529552206e-02f, 9.998987913e-01f, 1.422575582e-02f,
  9.999679923e-01f, 7.999914698e-03f, 9.999898672e-01f, 4.498715047e-03f, 9.999967813e-01f, 2.529819263e-03f, 9.999989867e-01f, 1.422623056e-03f,
  -9.111302495e-01f, 4.121184945e-01f, 3.416602612e-01f, -9.398235083e-01f, -9.566441774e-01f, 2.912592292e-01f, -2.965079620e-02f, 9.995602965e-01f,
  6.216099262e-01f, 7.833269238e-01f, 8.746382594e-01f, 4.847761393e-01f, 9.597726464e-01f, 2.807783186e-01f, 9.872201085e-01f, 1.593627781e-01f,
  9.959527254e-01f, 8.987854421e-02f, 9.987195730e-01f, 5.058911815e-02f, 9.995950460e-01f, 2.845665626e-02f, 9.998719096e-01f, 1.600383036e-02f,
  9.999595284e-01f, 8.999879472e-03f, 9.999871850e-01f, 5.061050411e-03f, 9.999959469e-01f, 2.846045885e-03f, 9.999987483e-01f, 1.600450720e-03f,
  -8.390715122e-01f, -5.440211296e-01f, 7.901318669e-01f, -6.129369140e-01f, -9.997860789e-01f, -2.068356983e-02f, -2.059976310e-01f, 9.785524607e-01f,
  5.403022766e-01f, 8.414709568e-01f, 8.460091352e-01f, 5.331684351e-01f, 9.504153132e-01f, 3.109835684e-01f, 9.842302203e-01f, 1.768921912e-01f,
  9.950041771e-01f, 9.983341396e-02f, 9.984192848e-01f, 5.620449781e-02f, 9.995000362e-01f, 3.161750361e-02f, 9.998418689e-01f, 1.778185740e-02f,
  9.999499917e-01f, 9.999834001e-03f, 9.999842048e-01f, 5.623383448e-03f, 9.999949932e-01f, 3.162272274e-03f, 9.999983907e-01f, 1.778278500e-03f,
  4.425697960e-03f, -9.999902248e-01f, 9.952573776e-01f, -9.727645665e-02f, -9.437797666e-01f, -3.305749595e-01f, -3.758473992e-01f, 9.266815782e-01f,
  4.535960853e-01f, 8.912073970e-01f, 8.147053123e-01f, 5.798751712e-01f, 9.401075840e-01f, 3.408778608e-01f, 9.809291363e-01f, 1.943656504e-01f,
  9.939560890e-01f, 1.097782999e-01f, 9.980874062e-01f, 6.181810424e-02f, 9.993950725e-01f, 3.477803990e-02f, 9.998086691e-01f, 1.955982670e-02f,
  9.999395013e-01f, 1.099977922e-02f, 9.999808669e-01f, 6.185714621e-03f, 9.999939203e-01f, 3.478498431e-03f, 9.999980927e-01f, 1.956106164e-03f,
  8.438539505e-01f, -5.365729332e-01f, 8.938615918e-01f, 4.483429790e-01f, -7.941793799e-01f, -6.076834202e-01f, -5.338430405e-01f, 8.455836177e-01f,
  3.623577058e-01f, 9.320390821e-01f, 7.808259130e-01f, 6.247486472e-01f, 9.288598895e-01f, 3.704313040e-01f, 9.773178697e-01f, 2.117776722e-01f,
  9.928086400e-01f, 1.197122037e-01f, 9.977239966e-01f, 6.742975861e-02f, 9.992800951e-01f, 3.793822229e-02f, 9.997723103e-01f, 2.133773454e-02f,
  9.999279976e-01f, 1.199971233e-02f, 9.999772310e-01f, 6.748044398e-03f, 9.999927878e-01f, 3.794723889e-03f, 9.999977350e-01f, 2.133933594e-03f,
  9.074468017e-01f, 4.201670289e-01f, 5.171728730e-01f, 8.558809757e-01f, -5.658205152e-01f, -8.245284557e-01f, -6.750016809e-01f, 7.378162146e-01f,
  2.674987614e-01f, 9.635581970e-01f, 7.444779873e-01f, 6.676470041e-01f, 9.166833758e-01f, 3.996143043e-01f, 9.733975530e-01f, 2.291227132e-01f,
  9.915618896e-01f, 1.296341419e-01f, 9.973290563e-01f, 7.303927839e-02f, 9.991551042e-01f, 4.109803215e-02f, 9.997327924e-01f, 2.311557345e-02f,
  9.999154806e-01f, 1.299963426e-02f, 9.999732971e-01f, 7.310371846e-03f, 9.999915361e-01f, 4.110949114e-03f, 9.999973178e-01f, 2.311761025e-03f,
  1.367372125e-01f, 9.906073809e-01f, -1.879615150e-02f, 9.998233318e-01f, -2.813494802e-01f, -9.596053958e-01f, -7.948709130e-01f, 6.067785621e-01f,
  1.699671596e-01f, 9.854497313e-01f, 7.057763934e-01f, 7.084347010e-01f, 9.035902619e-01f, 4.283977747e-01f, 9.691694379e-01f, 2.463953048e-01f,
  9.902160168e-01f, 1.395431161e-01f, 9.969025850e-01f, 7.864648104e-02f, 9.990201592e-01f, 4.425742477e-02f, 9.996901155e-01f, 2.489333972e-02f,
  9.999020100e-01f, 1.399954315e-02f, 9.999690056e-01f, 7.872696966e-03f, 9.999902248e-01f, 4.427174106e-03f, 9.999969006e-01f, 2.489588689e-03f,
  -7.596879005e-01f, 6.502878666e-01f, -5.489754677e-01f, 8.358384371e-01f, 3.102235124e-02f, -9.995186925e-01f, -8.896704316e-01f, 4.566032588e-01f,
  7.073719800e-02f, 9.974949956e-01f, 6.648434997e-01f, 7.469826341e-01f, 8.895936012e-01f, 4.567528665e-01f, 9.646348357e-01f, 2.635899782e-01f,
  9.887710810e-01f, 1.494381279e-01f, 9.964445233e-01f, 8.425120264e-02f, 9.988752007e-01f, 4.741638154e-02f, 9.996442795e-01f, 2.667102963e-02f,
  9.998875260e-01f, 1.499943808e-02f, 9.999644160e-01f, 8.435020223e-03f, 9.999887347e-01f, 4.743398633e-03f, 9.999964237e-01f, 2.667415887e-03f,
  -9.576594830e-01f, -2.879033089e-01f, -9.100810885e-01f, 4.144302309e-01f, 3.403181732e-01f, -9.403103590e-01f, -9.564100504e-01f, 2.920270860e-01f,
  -2.919954620e-02f, 9.995735884e-01f, 6.218088269e-01f, 7.831690907e-01f, 8.747074604e-01f, 4.846512377e-01f, 9.597951770e-01f, 2.807013094e-01f,
  9.872272611e-01f, 1.593182087e-01f, 9.959549904e-01f, 8.985326439e-02f, 9.987202883e-01f, 5.057485774e-02f, 9.995952845e-01f, 2.844863199e-02f,
  9.998720288e-01f, 1.599931903e-02f, 9.999595284e-01f, 8.997339755e-03f, 9.999871850e-01f, 5.059622694e-03f, 9.999959469e-01f, 2.845243318e-03f,
  -2.751633525e-01f, -9.613974690e-01f, -9.908979535e-01f, -1.346151382e-01f, 6.158648133e-01f, -7.878518701e-01f, -9.929850101e-01f, 1.182405204e-01f,
  -1.288445443e-01f, 9.916648269e-01f, 5.768082738e-01f, 8.168795705e-01f, 8.589466810e-01f, 5.120649934e-01f, 9.546520114e-01f, 2.977238595e-01f,
  9.855847955e-01f, 1.691823453e-01f, 9.954339862e-01f, 9.545248002e-02f, 9.985553622e-01f, 5.373282731e-02f, 9.995430708e-01f, 3.022614494e-02f,
  9.998555183e-01f, 1.699918136e-02f, 9.999542832e-01f, 9.559656493e-03f, 9.999855757e-01f, 5.375845823e-03f, 9.999954104e-01f, 3.023070283e-03f,
  6.603167057e-01f, -7.509872317e-01f, -7.665365338e-01f, -6.422007084e-01f, 8.303361535e-01f, -5.572628975e-01f, -9.982416630e-01f, -5.927551910e-02f,
  -2.272021621e-01f, 9.738476276e-01f, 5.299841762e-01f, 8.480075598e-01f, 8.423270583e-01f, 5.389667153e-01f, 9.492070079e-01f, 3.146522641e-01f,
  9.838436842e-01f, 1.790295690e-01f, 9.948815107e-01f, 1.010486856e-01f, 9.983804226e-01f, 5.689026415e-02f, 9.994877577e-01f, 3.200356290e-02f,
  9.998379946e-01f, 1.799902879e-02f, 9.999487996e-01f, 1.012197044e-02f, 9.999837875e-01f, 5.692068953e-03f, 9.999948740e-01f, 3.200897481e-03f,
  9.887046218e-01f, 1.498772055e-01f, -3.060953915e-01f, -9.520008564e-01f, 9.624637961e-01f, -2.714101076e-01f, -9.720142484e-01f, -2.349217981e-01f,
  -3.232895434e-01f, 9.463000894e-01f, 4.814845920e-01f, 8.764545321e-01f, 8.248651624e-01f, 5.653295517e-01f, 9.434618354e-01f, 3.314811885e-01f,
  9.820042253e-01f, 1.888588965e-01f, 9.942975044e-01f, 1.066416800e-01f, 9.981955290e-01f, 6.004713103e-02f, 9.994292855e-01f, 3.378088027e-02f,
  9.998195171e-01f, 1.899885759e-02f, 9.999428988e-01f, 1.068428159e-02f, 9.999819398e-01f, 6.008291151e-03f, 9.999942780e-01f, 3.378724447e-03f,
  4.080820680e-01f, 9.129452705e-01f, 2.486167252e-01f, -9.686019421e-01f, 9.991443753e-01f, 4.135828838e-02f, -9.151299596e-01f, -4.031589925e-01f,
  -4.161468446e-01f, 9.092974067e-01f, 4.314628243e-01f, 9.021307230e-01f, 8.065784574e-01f, 5.911270380e-01f, 9.374182820e-01f, 3.482052684e-01f,
  9.800665975e-01f, 1.986693144e-01f, 9.936820865e-01f, 1.122313142e-01f, 9.980006814e-01f, 6.320339441e-02f, 9.993675947e-01f, 3.555808961e-02f,
  9.998000264e-01f, 1.999866776e-02f, 9.999367595e-01f, 1.124658901e-02f, 9.999799728e-01f, 6.324512884e-03f, 9.999936819e-01f, 3.556551412e-03f,
  -5.477292538e-01f, 8.366556168e-01f, 7.267602682e-01f, -6.868911982e-01f, 9.367404580e-01f, 3.500247598e-01f, -8.293829560e-01f, -5.586805344e-01f,
  -5.048462152e-01f, 8.632093072e-01f, 3.800770044e-01f, 9.249548316e-01f, 7.874851823e-01f, 6.163335443e-01f, 9.310783744e-01f, 3.648192585e-01f,
  9.780309200e-01f, 2.084598988e-01f, 9.930352569e-01f, 1.178173944e-01f, 9.977958202e-01f, 6.635902822e-02f, 9.993028045e-01f, 3.733518720e-02f,
  9.997795224e-01f, 2.099845745e-02f, 9.999302626e-01f, 1.180889271e-02f, 9.999779463e-01f, 6.640734151e-03f, 9.999930263e-01f, 3.734378144e-03f,
  -9.999608397e-01f, -8.851309307e-03f, 9.810745716e-01f, -1.936302334e-01f, 7.814403772e-01f, 6.239799261e-01f, -7.174774408e-01f, -6.965817213e-01f,
  -5.885011554e-01f, 8.084963560e-01f, 3.274895847e-01f, 9.448547959e-01f, 7.676045895e-01f, 6.409237385e-01f, 9.244439602e-01f, 3.813178837e-01f,
  9.758974314e-01f, 2.182296216e-01f, 9.923570156e-01f, 1.233997419e-01f, 9.975810051e-01f, 6.951400638e-02f, 9.992348552e-01f, 3.911216930e-02f,
  9.997580051e-01f, 2.199822664e-02f, 9.999234676e-01f, 1.237119269e-02f, 9.999758005e-01f, 6.956954487e-03f, 9.999923706e-01f, 3.912204877e-03f,
  -5.328330398e-01f, -8.462204337e-01f, 9.332357645e-01f, 3.592645228e-01f, 5.486452579e-01f, 8.360552788e-01f, -5.829432607e-01f, -8.125128746e-01f,
  -6.662759781e-01f, 7.457052469e-01f, 2.738668323e-01f, 9.617676139e-01f, 7.469564080e-01f, 6.648730636e-01f, 9.175173044e-01f, 3.976959288e-01f,
  9.736663699e-01f, 2.279775143e-01f, 9.916474223e-01f, 1.289781928e-01f, 9.973561764e-01f, 7.266827673e-02f, 9.991636872e-01f, 4.088902473e-02f,
  9.997355342e-01f, 2.299797349e-02f, 9.999163747e-01f, 1.293348987e-02f, 9.999735355e-01f, 7.273174357e-03f, 9.999916553e-01f, 4.090031609e-03f,
  4.241790175e-01f, -9.055783749e-01f, 5.979771614e-01f, 8.015131354e-01f, 2.614416778e-01f, 9.652192593e-01f, -4.300232828e-01f, -9.028177857e-01f,
  -7.373937964e-01f, 6.754631400e-01f, 2.193782777e-01f, 9.756398797e-01f, 7.255613208e-01f, 6.881574988e-01f, 9.103004336e-01f, 4.139482081e-01f,
  9.713379741e-01f, 2.377026230e-01f, 9.909064770e-01f, 1.345525682e-01f, 9.971213937e-01f, 7.582182437e-02f, 9.990894198e-01f, 4.266574979e-02f,
  9.997119904e-01f, 2.399769612e-02f, 9.999089241e-01f, 1.349578146e-02f, 9.999712110e-01f, 7.589393295e-03f, 9.999908805e-01f, 4.267857410e-03f,
  9.912028313e-01f, -1.323517561e-01f, 7.855226099e-02f, 9.969099760e-01f, -5.168933049e-02f, 9.986631870e-01f, -2.635405958e-01f, -9.646483064e-01f,
  -8.011435866e-01f, 5.984721184e-01f, 1.641961634e-01f, 9.864277244e-01f, 7.034407258e-01f, 7.107539177e-01f, 9.027957320e-01f, 4.300695956e-01f,
  9.689124227e-01f, 2.474039644e-01f, 9.901341200e-01f, 1.401226968e-01f, 9.968766570e-01f, 7.897461206e-02f, 9.990119338e-01f, 4.444234073e-02f,
  9.996874928e-01f, 2.499739639e-02f, 9.999011755e-01f, 1.405806933e-02f, 9.999687672e-01f, 7.905611768e-03f, 9.999901056e-01f, 4.445684142e-03f,
  6.469193101e-01f, 7.625584602e-01f, -4.650644958e-01f, 8.852767944e-01f, -3.596943319e-01f, 9.330701828e-01f, -8.874550462e-02f, -9.960543513e-01f,
  -8.568888307e-01f, 5.155012608e-01f, 1.084949449e-01f, 9.940969944e-01f, 6.806167960e-01f, 7.326396108e-01f, 8.950055838e-01f, 4.460549951e-01f,
  9.663899541e-01f, 2.570805550e-01f, 9.893305302e-01f, 1.456883848e-01f, 9.966219068e-01f, 8.212661743e-02f, 9.989313483e-01f, 4.621879384e-02f,
  9.996620417e-01f, 2.599707060e-02f, 9.998931289e-01f, 1.462035347e-02f, 9.999662042e-01f, 8.221829310e-03f, 9.999893308e-01f, 4.623509943e-03f,
  -2.921388149e-01f, 9.563759565e-01f, -8.654506207e-01f, 5.009942055e-01f, -6.320286393e-01f, 7.749450207e-01f, 8.884811401e-02f, -9.960451722e-01f,
  -9.040721655e-01f, 4.273798466e-01f, 5.245061591e-02f, 9.986234903e-01f, 6.571123004e-01f, 7.537927032e-01f, 8.869323730e-01f, 4.618993104e-01f,
  9.637709260e-01f, 2.667314112e-01f, 9.884956479e-01f, 1.512494683e-01f, 9.963572025e-01f, 8.527779579e-02f, 9.988475442e-01f, 4.799510166e-02f,
  9.996355176e-01f, 2.699672058e-02f, 9.998847246e-01f, 1.518263202e-02f, 9.999635220e-01f, 8.538045920e-03f, 9.999884963e-01f, 4.801335745e-03f,
  -9.626058936e-01f, 2.709057927e-01f, -9.992933869e-01f, -3.758566082e-02f, -8.416849375e-01f, 5.399689674e-01f, 2.636395097e-01f, -9.646213055e-01f,
  -9.422222972e-01f, 3.349882066e-01f, -3.759419080e-03f, 9.999929070e-01f, 6.329506636e-01f, 7.741920948e-01f, 8.785787225e-01f, 4.775975943e-01f,
  9.610554576e-01f, 2.763556540e-01f, 9.876294732e-01f, 1.568057537e-01f, 9.960825443e-01f, 8.842811733e-02f, 9.987606406e-01f, 4.977125302e-02f,
  9.996080399e-01f, 2.799634263e-02f, 9.998760223e-01f, 1.574490592e-02f, 9.999607801e-01f, 8.854261599e-03f, 9.999876022e-01f, 4.979162011e-03f,
  -7.480575442e-01f, -6.636338830e-01f, -8.253716230e-01f, -5.645897985e-01f, -9.678714871e-01f, 2.514453232e-01f, 4.301158488e-01f, -9.027736783e-01f,
  -9.709581733e-01f, 2.392492294e-01f, -5.995756760e-02f, 9.982009530e-01f, 6.081562042e-01f, 7.938174009e-01f, 8.699471951e-01f, 4.931448400e-01f,
  9.582439065e-01f, 2.859522104e-01f, 9.867320657e-01f, 1.623570919e-01f, 9.957979321e-01f, 9.157756716e-02f, 9.986705780e-01f, 5.154724792e-02f,
  9.995795488e-01f, 2.899593674e-02f, 9.998670220e-01f, 1.630717516e-02f, 9.999579787e-01f, 9.170476347e-03f, 9.999867082e-01f, 5.156987347e-03f,
  1.542514563e-01f, -9.880316257e-01f, -3.972518742e-01f, -9.177096486e-01f, -9.980752468e-01f, -6.201484054e-02f, 5.830269456e-01f, -8.124528527e-01f,
  -9.899924994e-01f, 1.411200017e-01f, -1.159661636e-01f, 9.932531714e-01f, 5.827536583e-01f, 8.126488924e-01f, 8.610406518e-01f, 5.085361004e-01f,
  9.553365111e-01f, 2.955201864e-01f, 9.858034849e-01f, 1.679033041e-01f, 9.955033660e-01f, 9.472609311e-02f, 9.985772967e-01f, 5.332308263e-02f,
  9.995500445e-01f, 2.999550104e-02f, 9.998577237e-01f, 1.686943881e-02f, 9.999549985e-01f, 9.486690164e-03f, 9.999857545e-01f, 5.334813148e-03f,
  9.147423506e-01f, -4.040376544e-01f, 1.532154828e-01f, -9.881927967e-01f, -9.293003082e-01f, -3.693250120e-01f, 7.175492048e-01f, -6.965078115e-01f,
  -9.991351366e-01f, 4.158052057e-02f, -1.716081351e-01f, 9.851652980e-01f, 5.567683578e-01f, 8.306677938e-01f, 8.518617749e-01f, 5.237666368e-01f,
  9.523335695e-01f, 3.050586283e-01f, 9.848436713e-01f, 1.734442115e-01f, 9.951988459e-01f, 9.787366539e-02f, 9.984809160e-01f, 5.509874597e-02f,
  9.995195270e-01f, 3.099503554e-02f, 9.998480678e-01f, 1.743169688e-02f, 9.999519587e-01f, 9.802903049e-03f, 9.999848008e-01f, 5.512638018e-03f,
  8.342233896e-01f, 5.514267087e-01f, 6.564951539e-01f, -7.543302178e-01f, -7.683671117e-01f, -6.400094032e-01f, 8.294403553e-01f, -5.585952997e-01f,
  -9.982947707e-01f, -5.837419257e-02f, -2.267075777e-01f, 9.739628434e-01f, 5.302263498e-01f, 8.478561044e-01f, 8.424135447e-01f, 5.388315320e-01f,
  9.492354393e-01f, 3.145665526e-01f, 9.838528037e-01f, 1.789796203e-01f, 9.948843718e-01f, 1.010202691e-01f, 9.983813763e-01f, 5.687423423e-02f,
  9.994880557e-01f, 3.199454024e-02f, 9.998381138e-01f, 1.799395122e-02f, 9.999487996e-01f, 1.011911593e-02f, 9.999837875e-01f, 5.690463353e-03f,
  -1.327674743e-02f, 9.999118447e-01f, 9.575860500e-01f, -2.881473899e-01f, -5.312352777e-01f, -8.472243547e-01f, 9.151713848e-01f, -4.030649364e-01f,
  -9.874798059e-01f, -1.577456445e-01f, -2.810903192e-01f, 9.596813321e-01f, 5.031541586e-01f, 8.641966581e-01f, 8.326989412e-01f, 5.537260175e-01f,
  9.460423589e-01f, 3.240430057e-01f, 9.828307629e-01f, 1.845093668e-01f, 9.945599437e-01f, 1.041658595e-01f, 9.982786179e-01f, 5.864954367e-02f,
  9.994555712e-01f, 3.299400955e-02f, 9.998278022e-01f, 1.855619811e-02f, 9.999455214e-01f, 1.043532696e-02f, 9.999827743e-01f, 5.868288688e-03f,
  -8.485702872e-01f, 5.290827155e-01f, 9.637575150e-01f, 2.667797208e-01f, -2.414211184e-01f, -9.704204202e-01f, 9.720383286e-01f, -2.348221242e-01f,
  -9.667981863e-01f, -2.555412054e-01f, -3.345843852e-01f, 9.423658252e-01f, 4.755789042e-01f, 8.796730638e-01f, 8.227210045e-01f, 5.684453845e-01f,
  9.427546859e-01f, 3.334870934e-01f, 9.817776680e-01f, 1.900332868e-01f, 9.942255616e-01f, 1.073104069e-01f, 9.981727600e-01f, 6.042466685e-02f,
  9.994220734e-01f, 3.399345279e-02f, 9.998172522e-01f, 1.911843941e-02f, 9.999421835e-01f, 1.075153705e-02f, 9.999817014e-01f, 6.046113092e-03f,
  -9.036921859e-01f, -4.281826615e-01f, 6.731102467e-01f, 7.395421267e-01f, 7.233466953e-02f, -9.973804355e-01f, 9.982477427e-01f, -5.917267874e-02f,
  -9.364566803e-01f, -3.507832289e-01f, -3.870206773e-01f, 9.220710397e-01f, 4.475280643e-01f, 8.942698836e-01f, 8.124829531e-01f, 5.829849839e-01f,
  9.393727183e-01f, 3.428978026e-01f, 9.806935191e-01f, 1.955512017e-01f, 9.938812256e-01f, 1.104538813e-01f, 9.980637431e-01f, 6.219960377e-02f,
  9.993875623e-01f, 3.499285504e-02f, 9.998063445e-01f, 1.968067512e-02f, 9.999387264e-01f, 1.106774528e-02f, 9.999806285e-01f, 6.223937962e-03f,
  -1.279636919e-01f, -9.917788506e-01f, 1.751565337e-01f, 9.845405817e-01f, 3.789161742e-01f, -9.254310131e-01f, 9.929728508e-01f, 1.183425859e-01f,
  -8.967583776e-01f, -4.425205588e-01f, -4.382335544e-01f, 8.988611698e-01f, 4.190297425e-01f, 9.079725146e-01f, 8.019878864e-01f, 5.973402858e-01f,
  9.358968139e-01f, 3.522742093e-01f, 9.795783162e-01f, 2.010629177e-01f, 9.935269952e-01f, 1.135962531e-01f, 9.979515672e-01f, 6.397433579e-02f,
  9.993520975e-01f, 3.599222749e-02f, 9.997950792e-01f, 2.024290524e-02f, 9.999352098e-01f, 1.138395350e-02f, 9.999794960e-01f, 6.401761901e-03f,
  7.654140592e-01f, -6.435381174e-01f, -3.767423034e-01f, 9.263181090e-01f, 6.479216814e-01f, -7.617069483e-01f, 9.563800097e-01f, 2.921253741e-01f,
  -8.481000066e-01f, -5.298361778e-01f, -4.880608618e-01f, 8.728095889e-01f, 3.901124299e-01f, 9.207672477e-01f, 7.912392616e-01f, 6.115067005e-01f,
  9.323273301e-01f, 3.616154492e-01f, 9.784321785e-01f, 2.065682709e-01f, 9.931628108e-01f, 1.167374924e-01f, 9.978361726e-01f, 6.574887782e-02f,
  9.993155599e-01f, 3.699155897e-02f, 9.997835755e-01f, 2.080512606e-02f, 9.999315739e-01f, 1.170015987e-02f, 9.999783635e-01f, 6.579586305e-03f,
  9.550736547e-01f, 2.963685691e-01f, -8.126112223e-01f, 5.828061700e-01f, 8.526731133e-01f, -5.224447846e-01f, 8.896234632e-01f, 4.566946924e-01f,
  -7.909677625e-01f, -6.118578315e-01f, -5.363451838e-01f, 8.439987302e-01f, 3.608050346e-01f, 9.326412678e-01f, 7.802404165e-01f, 6.254796982e-01f,
  9.286646247e-01f, 3.709204793e-01f, 9.772551060e-01f, 2.120671123e-01f, 9.927886724e-01f, 1.198775545e-01f, 9.977176785e-01f, 6.752320379e-02f,
  9.992780685e-01f, 3.799085692e-02f, 9.997717142e-01f, 2.136734314e-02f, 9.999278188e-01f, 1.201636530e-02f, 9.999771714e-01f, 6.757410709e-03f,
  2.666429281e-01f, 9.637953639e-01f, -9.982103705e-01f, 5.980031565e-02f, 9.728653431e-01f, -2.313720137e-01f, 7.948083878e-01f, 6.068604589e-01f,
  -7.259322405e-01f, -6.877662539e-01f, -5.829339027e-01f, 8.125196099e-01f, 3.311368525e-01f, 9.435827136e-01f, 7.689949274e-01f, 6.392549276e-01f,
  9.249090552e-01f, 3.801884055e-01f, 9.760470986e-01f, 2.175592482e-01f, 9.924046397e-01f, 1.230164245e-01f, 9.975960255e-01f, 6.929731369e-02f,
  9.992396235e-01f, 3.899011388e-02f, 9.997594953e-01f, 2.192955278e-02f, 9.999239445e-01f, 1.233256981e-02f, 9.999759793e-01f, 6.935234182e-03f,
  -6.669380665e-01f, 7.451131344e-01f, -8.763794303e-01f, -4.816212952e-01f, 9.965789914e-01f, 8.264580369e-02f, 6.749256253e-01f, 7.378857136e-01f,
  -6.536436081e-01f, -7.568024993e-01f, -6.276797056e-01f, 7.784717083e-01f, 3.011375964e-01f, 9.535806775e-01f, 7.575061917e-01f, 6.528279781e-01f,
  9.210609794e-01f, 3.894183338e-01f, 9.748082757e-01f, 2.230444849e-01f, 9.920106530e-01f, 1.261540651e-01f, 9.974712729e-01f, 7.107120752e-02f,
  9.992001057e-01f, 3.998933733e-02f, 9.997470379e-01f, 2.249175683e-02f, 9.999200106e-01f, 1.264877338e-02f, 9.999747276e-01f, 7.113057654e-03f,
  -9.873392582e-01f, -1.586226672e-01f, -4.846394062e-01f, -8.747140169e-01f, 9.214623570e-01f, 3.884676993e-01f, 5.337560773e-01f, 8.456384540e-01f,
  -5.748240352e-01f, -8.182770610e-01f, -6.704410911e-01f, 7.419627905e-01f, 2.708370686e-01f, 9.626252055e-01f, 7.457779050e-01f, 6.661946774e-01f,
  9.171208143e-01f, 3.986093104e-01f, 9.735385776e-01f, 2.285226882e-01f, 9.916067719e-01f, 1.292904317e-01f, 9.973433018e-01f, 7.284487784e-02f,
  9.991596341e-01f, 4.098851606e-02f, 9.997342229e-01f, 2.305394970e-02f, 9.999159575e-01f, 1.296497509e-02f, 9.999734163e-01f, 7.290880661e-03f,
  -3.999853134e-01f, -9.165215492e-01f, 5.636094138e-02f, -9.984104633e-01f, 7.549653649e-01f, 6.557646990e-01f, 3.757521510e-01f, 9.267202020e-01f,
  -4.902605712e-01f, -8.715758920e-01f, -7.110829353e-01f, 7.031081319e-01f, 2.402658761e-01f, 9.707071185e-01f, 7.338138223e-01f, 6.793506742e-01f,
  9.130889177e-01f, 4.077604413e-01f, 9.722381234e-01f, 2.339936644e-01f, 9.911929369e-01f, 1.324255317e-01f, 9.972121716e-01f, 7.461831719e-02f,
  9.991181493e-01f, 4.198765755e-02f, 9.997211099e-01f, 2.361613885e-02f, 9.999117851e-01f, 1.328117587e-02f, 9.999721050e-01f, 7.468704134e-03f,
  5.551133156e-01f, -8.317747712e-01f, 5.800031424e-01f, -8.146142364e-01f, 5.135984421e-01f, 8.580306768e-01f, 2.058971673e-01f, 9.785736203e-01f,
  -4.007990062e-01f, -9.161660075e-01f, -7.494767308e-01f, 6.620306373e-01f, 2.094544172e-01f, 9.778184295e-01f, 7.216176391e-01f, 6.922917962e-01f,
  9.089657664e-01f, 4.168707728e-01f, 9.709069133e-01f, 2.394572198e-01f, 9.907692075e-01f, 1.355592906e-01f, 9.970778823e-01f, 7.639151812e-02f,
  9.990756512e-01f, 4.298675060e-02f, 9.997076392e-01f, 2.417832054e-02f, 9.999075532e-01f, 1.359737478e-02f, 9.999707937e-01f, 7.646527141e-03f,
  9.998432994e-01f, 1.770192571e-02f, 9.250146747e-01f, -3.799313903e-01f, 2.212981731e-01f, 9.752061963e-01f, 2.954781987e-02f, 9.995633960e-01f,
  -3.073327839e-01f, -9.516021013e-01f, -7.855011225e-01f, 6.188601851e-01f, 1.784335226e-01f, 9.839519858e-01f, 7.091933489e-01f, 7.050140500e-01f,
  9.047516584e-01f, 4.259394705e-01f, 9.695450068e-01f, 2.449132055e-01f, 9.903355837e-01f, 1.386916935e-01f, 9.969404936e-01f, 7.816448808e-02f,
  9.990321398e-01f, 4.398580641e-02f, 9.996939301e-01f, 2.474049293e-02f, 9.999032021e-01f, 1.391357277e-02f, 9.999693632e-01f, 7.824349217e-03f,
  5.253219604e-01f, 8.509035110e-01f, 9.851381779e-01f, 1.717635691e-01f, -9.294810891e-02f, 9.956709743e-01f, -1.477329880e-01f, 9.890272617e-01f,
  -2.107958049e-01f, -9.775301218e-01f, -8.190422058e-01f, 5.737332702e-01f, 1.472342163e-01f, 9.891016483e-01f, 6.965447664e-01f, 7.175133228e-01f,
  9.004471302e-01f, 4.349655211e-01f, 9.681524038e-01f, 2.503614724e-01f, 9.898920655e-01f, 1.418227106e-01f, 9.967998862e-01f, 7.993719727e-02f,
  9.989876747e-01f, 4.498481750e-02f, 9.996798635e-01f, 2.530265786e-02f, 9.998987317e-01f, 1.422976889e-02f, 9.999679923e-01f, 8.002171293e-03f,
  -4.321779311e-01f, 9.017883539e-01f, 7.418580055e-01f, 6.705570221e-01f, -3.979767561e-01f, 9.173954725e-01f, -3.203543723e-01f, 9.472977519e-01f,
  -1.121526212e-01f, -9.936909676e-01f, -8.499938846e-01f, 5.267925262e-01f, 1.158876941e-01f, 9.932623506e-01f, 6.836758852e-01f, 7.297857404e-01f,
  8.960524797e-01f, 4.439480901e-01f, 9.667292237e-01f, 2.558017969e-01f, 9.894386530e-01f, 1.449523121e-01f, 9.966561794e-01f, 8.170966059e-02f,
  9.989421964e-01f, 4.598378390e-02f, 9.996654391e-01f, 2.586481534e-02f, 9.998942018e-01f, 1.454596408e-02f, 9.999665618e-01f, 8.179994300e-03f,
  -9.923354983e-01f, 1.235731244e-01f, 2.700984478e-01f, 9.628326893e-01f, -6.635382771e-01f, 7.481423616e-01f, -4.828719497e-01f, 8.756909966e-01f,
  -1.238837745e-02f, -9.999232888e-01f, -8.782584071e-01f, 4.781863391e-01f, 8.442528546e-02f, 9.964298010e-01f, 6.705908775e-01f, 7.418274283e-01f,
  8.915683031e-01f, 4.528862834e-01f, 9.652754664e-01f, 2.612340748e-01f, 9.889753461e-01f, 1.480804533e-01f, 9.965093136e-01f, 8.348185569e-02f,
  9.988957047e-01f, 4.698270187e-02f, 9.996507764e-01f, 2.642696351e-02f, 9.998895526e-01f, 1.486215740e-02f, 9.999650717e-01f, 8.357816376e-03f,
  -6.401443481e-01f, -7.682546377e-01f, -2.848466039e-01f, 9.585731030e-01f, -8.632965088e-01f, 5.046970844e-01f, -6.301599741e-01f, 7.764653563e-01f,
  8.749917150e-02f, -9.961646199e-01f, -9.037463665e-01f, 4.280683994e-01f, 5.287845805e-02f, 9.986009598e-01f, 6.572937369e-01f, 7.536345124e-01f,
  8.869948983e-01f, 4.617791772e-01f, 9.637911916e-01f, 2.666580379e-01f, 9.885020852e-01f, 1.512071192e-01f, 9.963592887e-01f, 8.525379747e-02f,
  9.988481998e-01f, 4.798157141e-02f, 9.996357560e-01f, 2.698910423e-02f, 9.998847842e-01f, 1.517834887e-02f, 9.999635816e-01f, 8.535637520e-03f,
  3.005925417e-01f, -9.537526369e-01f, -7.520639896e-01f, 6.590901017e-01f, -9.774427414e-01f, 2.112006545e-01f, -7.575730681e-01f, 6.527503729e-01f,
  1.865124702e-01f, -9.824525714e-01f, -9.263771176e-01f, 3.765971363e-01f, 2.127875760e-02f, 9.997735620e-01f, 6.437888145e-01f, 7.652031779e-01f,
  8.823328614e-01f, 4.706258774e-01f, 9.622764587e-01f, 2.720735669e-01f, 9.880189896e-01f, 1.543322802e-01f, 9.962061048e-01f, 8.702547103e-02f,
  9.987997413e-01f, 4.898039624e-02f, 9.996203780e-01f, 2.755123749e-02f, 9.998799562e-01f, 1.549453940e-02f, 9.999620318e-01f, 8.713459596e-03f,
  9.649659991e-01f, -2.623748481e-01f, -9.876590967e-01f, 1.566190720e-01f, -9.946564436e-01f, -1.032404602e-01f, -8.610926867e-01f, 5.084479451e-01f,
  2.836622000e-01f, -9.589242935e-01f, -9.460792542e-01f, 3.239352703e-01f, -1.034221891e-02f, 9.999465346e-01f, 6.300802827e-01f, 7.765299678e-01f,
  8.775825500e-01f, 4.794255495e-01f, 9.607312679e-01f, 2.774805427e-01f, 9.875259995e-01f, 1.574558914e-01f, 9.960497618e-01f, 8.879686147e-02f,
  9.987502694e-01f, 4.997916892e-02f, 9.996047616e-01f, 2.811335959e-02f, 9.998750091e-01f, 1.581072807e-02f, 9.999604821e-01f, 8.891279809e-03f,
  7.421541810e-01f, 6.702291965e-01f, -9.190735221e-01f, -3.940860629e-01f, -9.132301211e-01f, -4.074441493e-01f, -9.374542236e-01f, 3.481085002e-01f,
  3.779776692e-01f, -9.258147478e-01f, -9.627903700e-01f, 2.702493370e-01f, -4.195285589e-02f, 9.991195798e-01f, 6.161724925e-01f, 7.876111865e-01f,
  8.727445006e-01f, 4.881772399e-01f, 9.591556787e-01f, 2.828786969e-01f, 9.870231748e-01f, 1.605779380e-01f, 9.958902597e-01f, 9.056797624e-02f,
  9.986997843e-01f, 5.097789690e-02f, 9.995887876e-01f, 2.867547423e-02f, 9.998699427e-01f, 1.612691768e-02f, 9.999588728e-01f, 9.069100954e-03f,
  -1.629907787e-01f, 9.866275787e-01f, -5.674300194e-01f, -8.234215975e-01f, -7.412399650e-01f, -6.712401509e-01f, -9.842484593e-01f, 1.767906845e-01f,
  4.685169160e-01f, -8.834545016e-01f, -9.764577150e-01f, 2.157090008e-01f, -7.352153957e-02f, 9.972936511e-01f, 6.020699143e-01f, 7.984433770e-01f,
  8.678191900e-01f, 4.968801141e-01f, 9.575498104e-01f, 2.882679403e-01f, 9.865104556e-01f, 1.636983752e-01f, 9.957276583e-01f, 9.233880043e-02f,
  9.986482859e-01f, 5.197656900e-02f, 9.995725155e-01f, 2.923758142e-02f, 9.998648167e-01f, 1.644310169e-02f, 9.999572635e-01f, 9.246920235e-03f,
  -9.182828069e-01f, 3.959251642e-01f, -4.102819040e-02f, -9.991579652e-01f, -4.957418144e-01f, -8.684699535e-01f, -1.000000000e+00f, -1.030206768e-04f,
  5.543745160e-01f, -8.322673440e-01f, -9.870380163e-01f, 1.604867280e-01f, -1.050167084e-01f, 9.944704771e-01f, 5.877769589e-01f, 8.090230227e-01f,
  8.628070951e-01f, 5.055333376e-01f, 9.559136033e-01f, 2.936480343e-01f, 9.859878421e-01f, 1.668171734e-01f, 9.955618382e-01f, 9.410934150e-02f,
  9.985958338e-01f, 5.297519267e-02f, 9.995558858e-01f, 2.979967557e-02f, 9.998595715e-01f, 1.675928757e-02f, 9.999555945e-01f, 9.424741380e-03f,
  -8.293098211e-01f, -5.587890744e-01f, 4.980095923e-01f, -8.671715260e-01f, -2.010796219e-01f, -9.795749187e-01f, -9.842120409e-01f, -1.769934744e-01f,
  6.346929669e-01f, -7.727644444e-01f, -9.944978952e-01f, 1.047568321e-01f, -1.364068687e-01f, 9.906529188e-01f, 5.732980371e-01f, 8.193469048e-01f,
  8.577086926e-01f, 5.141359568e-01f, 9.542471766e-01f, 2.990188897e-01f, 9.854553938e-01f, 1.699342877e-01f, 9.953929186e-01f, 9.587957710e-02f,
  9.985423684e-01f, 5.397376046e-02f, 9.995389581e-01f, 3.036176413e-02f, 9.998542070e-01f, 1.707546785e-02f, 9.999538660e-01f, 9.602561593e-03f,
  2.212675661e-02f, -9.997551441e-01f, 8.836693168e-01f, -4.681116641e-01f, 1.135217771e-01f, -9.935355186e-01f, -9.373825192e-01f, -3.483016491e-01f,
  7.086697817e-01f, -7.055402994e-01f, -9.988136292e-01f, 4.869600013e-02f, -1.676606387e-01f, 9.858447909e-01f, 5.586379170e-01f, 8.294116855e-01f,
  8.525245190e-01f, 5.226872563e-01f, 9.525505900e-01f, 3.043802381e-01f, 9.849131107e-01f, 1.730497181e-01f, 9.952208400e-01f, 9.764950722e-02f,
  9.984878898e-01f, 5.497227982e-02f, 9.995217323e-01f, 3.092384152e-02f, 9.998487830e-01f, 1.739165001e-02f, 9.999521971e-01f, 9.780380875e-03f,
  8.532201052e-01f, -5.215510130e-01f, 9.971746206e-01f, 7.511820644e-02f, 4.168670774e-01f, -9.089674354e-01f, -8.609884381e-01f, -5.086245537e-01f,
  7.755658031e-01f, -6.312667131e-01f, -9.999717474e-01f, -7.518785074e-03f, -1.987468749e-01f, 9.800508618e-01f, 5.438010693e-01f, 8.392141461e-01f,
  8.472551107e-01f, 5.311862230e-01f, 9.508239031e-01f, 3.097319603e-01f, 9.843609333e-01f, 1.761634201e-01f, 9.950456619e-01f, 9.941913933e-02f,
  9.984323978e-01f, 5.597073585e-02f, 9.995042086e-01f, 3.148590773e-02f, 9.998431802e-01f, 1.770782843e-02f, 9.999504089e-01f, 9.958200157e-03f,
  8.998668194e-01f, 4.361647666e-01f, 8.035690784e-01f, 5.952115059e-01f, 6.788702011e-01f, -7.342582941e-01f, -7.574391961e-01f, -6.529057026e-01f,
  8.347129226e-01f, -5.506852865e-01f, -9.979684949e-01f, -6.370979548e-02f, -2.296342701e-01f, 9.732769728e-01f, 5.287923217e-01f, 8.487512469e-01f,
  8.419010043e-01f, 5.396320224e-01f, 9.490671158e-01f, 3.150739372e-01f, 9.837989211e-01f, 1.792753637e-01f, 9.948672652e-01f, 1.011884511e-01f,
  9.983759522e-01f, 5.696914345e-02f, 9.994863272e-01f, 3.204796836e-02f, 9.998375773e-01f, 1.802400686e-02f, 9.999486208e-01f, 1.013601944e-02f,
  1.191801354e-01f, 9.928726554e-01f, 3.624766767e-01f, 9.319928288e-01f, 8.735505342e-01f, -4.867334962e-01f, -6.300007105e-01f, -7.765945792e-01f,
  8.855196238e-01f, -4.646020234e-01f, -9.928101897e-01f, -1.196993962e-01f, -2.602920532e-01f, 9.655299187e-01f, 5.136163235e-01f, 8.580200076e-01f,
  8.364626765e-01f, 5.480239391e-01f, 9.472803473e-01f, 3.204059005e-01f, 9.832270741e-01f, 1.823855042e-01f, 9.946857691e-01f, 1.029574350e-01f,
  9.983184934e-01f, 5.796748772e-02f, 9.994681478e-01f, 3.261001408e-02f, 9.998317957e-01f, 1.834018156e-02f, 9.999468327e-01f, 1.031383779e-02f,
  -7.710801959e-01f, 6.367380023e-01f, -1.902491003e-01f, 9.817358255e-01f, 9.816020727e-01f, -1.909380108e-01f, -4.826923311e-01f, -8.757900000e-01f,
  9.274784923e-01f, -3.738765717e-01f, -9.845131636e-01f, -1.753105819e-01f, -2.906895578e-01f, 9.568174481e-01f, 4.982779026e-01f, 8.670173883e-01f,
  8.309407234e-01f, 5.563610196e-01f, 9.454635978e-01f, 3.257277906e-01f, 9.826454520e-01f, 1.854938269e-01f, 9.945011139e-01f, 1.047261059e-01f,
  9.982600212e-01f, 5.896577984e-02f, 9.994496703e-01f, 3.317204863e-02f, 9.998259544e-01f, 1.865635626e-02f, 9.999449849e-01f, 1.049165614e-02f,
  -9.524129629e-01f, -3.048106134e-01f, -6.843819022e-01f, 7.291237116e-01f, 9.923083186e-01f, 1.237909496e-01f, -3.201591671e-01f, -9.473637342e-01f,
  9.601702690e-01f, -2.794154882e-01f, -9.731037021e-01f, -2.303675115e-01f, -3.207964003e-01f, 9.471482038e-01f, 4.827820361e-01f, 8.757405281e-01f,
  8.253356218e-01f, 5.646424294e-01f, 9.436169863e-01f, 3.310393095e-01f, 9.820539355e-01f, 1.886002868e-01f, 9.943132997e-01f, 1.064944416e-01f,
  9.982005358e-01f, 5.996400863e-02f, 9.994308352e-01f, 3.373407945e-02f, 9.998199940e-01f, 1.897252724e-02f, 9.999430776e-01f, 1.066947449e-02f,
  -2.581016421e-01f, -9.661177993e-01f, -9.677396417e-01f, 2.519522607e-01f, 9.046075940e-01f, 4.262454212e-01f, -1.475291997e-01f, -9.890577197e-01f,
  9.832684398e-01f, -1.821625978e-01f, -9.586178064e-01f, -2.846961617e-01f, -3.505824506e-01f, 9.365318418e-01f, 4.671334028e-01f, 8.841868639e-01f,
  8.196480274e-01f, 5.728674531e-01f, 9.417404532e-01f, 3.363404274e-01f, 9.814526439e-01f, 1.917048544e-01f, 9.941223264e-01f, 1.082624346e-01f,
  9.981400967e-01f, 6.096218154e-02f, 9.994117022e-01f, 3.429609165e-02f, 9.998139739e-01f, 1.928869821e-02f, 9.999411702e-01f, 1.084729191e-02f,
  6.735071540e-01f, -7.391806841e-01f, -9.530500174e-01f, -3.028128743e-01f, 7.271980643e-01f, 6.864276528e-01f, 2.975377068e-02f, -9.995572567e-01f,
  9.965420961e-01f, -8.308912069e-02f, -9.411013126e-01f, -3.381247520e-01f, -3.800179660e-01f, 9.249790907e-01f, 4.513370395e-01f, 8.923535347e-01f,
  8.138784766e-01f, 5.810351372e-01f, 9.398342371e-01f, 3.416308761e-01f, 9.808415174e-01f, 1.948075294e-01f, 9.939282537e-01f, 1.100300923e-01f,
  9.980786443e-01f, 6.196028739e-02f, 9.993922710e-01f, 3.485809639e-02f, 9.998078346e-01f, 1.960486546e-02f, 9.999392033e-01f, 1.102510840e-02f,
  9.858965874e-01f, 1.673557013e-01f, -6.448370218e-01f, -7.643200755e-01f, 4.776714444e-01f, 8.785385489e-01f, 2.060983330e-01f, -9.785313010e-01f,
  9.998586178e-01f, 1.681409031e-02f, -9.206095338e-01f, -3.904843926e-01f, -4.090735018e-01f, 9.125014544e-01f, 4.353979528e-01f, 9.002380967e-01f,
  8.080275059e-01f, 5.891447663e-01f, 9.378982186e-01f, 3.469105363e-01f, 9.802205563e-01f, 1.979082376e-01f, 9.937310219e-01f, 1.117973924e-01f,
  9.980161786e-01f, 6.295833737e-02f, 9.993724823e-01f, 3.542009369e-02f, 9.998015761e-01f, 1.992103085e-02f, 9.999372363e-01f, 1.120292582e-02f,
};
__device__ const float ROPE32[1024] = {
  1.000000000e+00f, 0.000000000e+00f, 1.000000000e+00f, 0.000000000e+00f, 1.000000000e+00f, 0.000000000e+00f, 1.000000000e+00f, 0.000000000e+00f,
  1.000000000e+00f, 0.000000000e+00f, 1.000000000e+00f, 0.000000000e+00f, 1.000000000e+00f, 0.000000000e+00f, 1.000000000e+00f, 0.000000000e+00f,
  5.403022766e-01f, 8.414709568e-01f, 9.504152536e-01f, 3.109835982e-01f, 9.950041771e-01f, 9.983342141e-02f, 9.995000362e-01f, 3.161750361e-02f,
  9.999499917e-01f, 9.999833070e-03f, 9.999949932e-01f, 3.162272274e-03f, 9.999995232e-01f, 9.999999311e-04f, 9.999999404e-01f, 3.162277571e-04f,
  -4.161468446e-01f, 9.092974067e-01f, 8.065783978e-01f, 5.911270976e-01f, 9.800665975e-01f, 1.986693293e-01f, 9.980006814e-01f, 6.320339441e-02f,
  9.998000264e-01f, 1.999866590e-02f, 9.999799728e-01f, 6.324512884e-03f, 9.999979734e-01f, 1.999998698e-03f, 9.999998212e-01f, 6.324554561e-04f,
  -9.899924994e-01f, 1.411200017e-01f, 5.827536583e-01f, 8.126488924e-01f, 9.553365111e-01f, 2.955202162e-01f, 9.955033660e-01f, 9.472608566e-02f,
  9.995500445e-01f, 2.999549918e-02f, 9.999549985e-01f, 9.486690164e-03f, 9.999955297e-01f, 2.999995602e-03f, 9.999995232e-01f, 9.486831259e-04f,
  -6.536436081e-01f, -7.568024993e-01f, 3.011374772e-01f, 9.535807371e-01f, 9.210609794e-01f, 3.894183338e-01f, 9.920106530e-01f, 1.261540651e-01f,
  9.992001057e-01f, 3.998933360e-02f, 9.999200106e-01f, 1.264877338e-02f, 9.999920130e-01f, 3.999989480e-03f, 9.999992251e-01f, 1.264910679e-03f,
  2.836622000e-01f, -9.589242935e-01f, -1.034233812e-02f, 9.999465346e-01f, 8.775825500e-01f, 4.794255495e-01f, 9.875259995e-01f, 1.574558765e-01f,
  9.987502694e-01f, 4.997916520e-02f, 9.998750091e-01f, 1.581072807e-02f, 9.999874830e-01f, 4.999979399e-03f, 9.999987483e-01f, 1.581138116e-03f,
  9.601702690e-01f, -2.794154882e-01f, -3.207964003e-01f, 9.471482038e-01f, 8.253356218e-01f, 5.646424890e-01f, 9.820539355e-01f, 1.886002719e-01f,
  9.982005358e-01f, 5.996400490e-02f, 9.998199940e-01f, 1.897252724e-02f, 9.999819994e-01f, 5.999964196e-03f, 9.999982119e-01f, 1.897365320e-03f,
  7.539022565e-01f, 6.569865942e-01f, -5.994374752e-01f, 8.004215956e-01f, 7.648422122e-01f, 6.442176700e-01f, 9.755998850e-01f, 2.195560932e-01f,
  9.975510240e-01f, 6.994284689e-02f, 9.997550249e-01f, 2.213413455e-02f, 9.999755025e-01f, 6.999942940e-03f, 9.999975562e-01f, 2.213592408e-03f,
  -1.455000341e-01f, 9.893582463e-01f, -8.186324239e-01f, 5.743177533e-01f, 6.967067122e-01f, 7.173560858e-01f, 9.681702852e-01f, 2.502923310e-01f,
  9.968017340e-01f, 7.991468906e-02f, 9.996800423e-01f, 2.529552206e-02f, 9.999679923e-01f, 7.999914698e-03f, 9.999967813e-01f, 2.529819263e-03f,
  -9.111302495e-01f, 4.121184945e-01f, -9.566441774e-01f, 2.912592292e-01f, 6.216099262e-01f, 7.833269238e-01f, 9.597726464e-01f, 2.807783186e-01f,
  9.959527254e-01f, 8.987854421e-02f, 9.995950460e-01f, 2.845665626e-02f, 9.999595284e-01f, 8.999879472e-03f, 9.999959469e-01f, 2.846045885e-03f,
  -8.390715122e-01f, -5.440211296e-01f, -9.997860789e-01f, -2.068356983e-02f, 5.403022766e-01f, 8.414709568e-01f, 9.504153132e-01f, 3.109835684e-01f,
  9.950041771e-01f, 9.983341396e-02f, 9.995000362e-01f, 3.161750361e-02f, 9.999499917e-01f, 9.999834001e-03f, 9.999949932e-01f, 3.162272274e-03f,
  4.425697960e-03f, -9.999902248e-01f, -9.437797666e-01f, -3.305749595e-01f, 4.535960853e-01f, 8.912073970e-01f, 9.401075840e-01f, 3.408778608e-01f,
  9.939560890e-01f, 1.097782999e-01f, 9.993950725e-01f, 3.477803990e-02f, 9.999395013e-01f, 1.099977922e-02f, 9.999939203e-01f, 3.478498431e-03f,
  8.438539505e-01f, -5.365729332e-01f, -7.941793799e-01f, -6.076834202e-01f, 3.623577058e-01f, 9.320390821e-01f, 9.288598895e-01f, 3.704313040e-01f,
  9.928086400e-01f, 1.197122037e-01f, 9.992800951e-01f, 3.793822229e-02f, 9.999279976e-01f, 1.199971233e-02f, 9.999927878e-01f, 3.794723889e-03f,
  9.074468017e-01f, 4.201670289e-01f, -5.658205152e-01f, -8.245284557e-01f, 2.674987614e-01f, 9.635581970e-01f, 9.166833758e-01f, 3.996143043e-01f,
  9.915618896e-01f, 1.296341419e-01f, 9.991551042e-01f, 4.109803215e-02f, 9.999154806e-01f, 1.299963426e-02f, 9.999915361e-01f, 4.110949114e-03f,
  1.367372125e-01f, 9.906073809e-01f, -2.813494802e-01f, -9.596053958e-01f, 1.699671596e-01f, 9.854497313e-01f, 9.035902619e-01f, 4.283977747e-01f,
  9.902160168e-01f, 1.395431161e-01f, 9.990201592e-01f, 4.425742477e-02f, 9.999020100e-01f, 1.399954315e-02f, 9.999902248e-01f, 4.427174106e-03f,
  -7.596879005e-01f, 6.502878666e-01f, 3.102235124e-02f, -9.995186925e-01f, 7.073719800e-02f, 9.974949956e-01f, 8.895936012e-01f, 4.567528665e-01f,
  9.887710810e-01f, 1.494381279e-01f, 9.988752007e-01f, 4.741638154e-02f, 9.998875260e-01f, 1.499943808e-02f, 9.999887347e-01f, 4.743398633e-03f,
  -9.576594830e-01f, -2.879033089e-01f, 3.403181732e-01f, -9.403103590e-01f, -2.919954620e-02f, 9.995735884e-01f, 8.747074604e-01f, 4.846512377e-01f,
  9.872272611e-01f, 1.593182087e-01f, 9.987202883e-01f, 5.057485774e-02f, 9.998720288e-01f, 1.599931903e-02f, 9.999871850e-01f, 5.059622694e-03f,
  -2.751633525e-01f, -9.613974690e-01f, 6.158648133e-01f, -7.878518701e-01f, -1.288445443e-01f, 9.916648269e-01f, 8.589466810e-01f, 5.120649934e-01f,
  9.855847955e-01f, 1.691823453e-01f, 9.985553622e-01f, 5.373282731e-02f, 9.998555183e-01f, 1.699918136e-02f, 9.999855757e-01f, 5.375845823e-03f,
  6.603167057e-01f, -7.509872317e-01f, 8.303361535e-01f, -5.572628975e-01f, -2.272021621e-01f, 9.738476276e-01f, 8.423270583e-01f, 5.389667153e-01f,
  9.838436842e-01f, 1.790295690e-01f, 9.983804226e-01f, 5.689026415e-02f, 9.998379946e-01f, 1.799902879e-02f, 9.999837875e-01f, 5.692068953e-03f,
  9.887046218e-01f, 1.498772055e-01f, 9.624637961e-01f, -2.714101076e-01f, -3.232895434e-01f, 9.463000894e-01f, 8.248651624e-01f, 5.653295517e-01f,
  9.820042253e-01f, 1.888588965e-01f, 9.981955290e-01f, 6.004713103e-02f, 9.998195171e-01f, 1.899885759e-02f, 9.999819398e-01f, 6.008291151e-03f,
  4.080820680e-01f, 9.129452705e-01f, 9.991443753e-01f, 4.135828838e-02f, -4.161468446e-01f, 9.092974067e-01f, 8.065784574e-01f, 5.911270380e-01f,
  9.800665975e-01f, 1.986693144e-01f, 9.980006814e-01f, 6.320339441e-02f, 9.998000264e-01f, 1.999866776e-02f, 9.999799728e-01f, 6.324512884e-03f,
  -5.477292538e-01f, 8.366556168e-01f, 9.367404580e-01f, 3.500247598e-01f, -5.048462152e-01f, 8.632093072e-01f, 7.874851823e-01f, 6.163335443e-01f,
  9.780309200e-01f, 2.084598988e-01f, 9.977958202e-01f, 6.635902822e-02f, 9.997795224e-01f, 2.099845745e-02f, 9.999779463e-01f, 6.640734151e-03f,
  -9.999608397e-01f, -8.851309307e-03f, 7.814403772e-01f, 6.239799261e-01f, -5.885011554e-01f, 8.084963560e-01f, 7.676045895e-01f, 6.409237385e-01f,
  9.758974314e-01f, 2.182296216e-01f, 9.975810051e-01f, 6.951400638e-02f, 9.997580051e-01f, 2.199822664e-02f, 9.999758005e-01f, 6.956954487e-03f,
  -5.328330398e-01f, -8.462204337e-01f, 5.486452579e-01f, 8.360552788e-01f, -6.662759781e-01f, 7.457052469e-01f, 7.469564080e-01f, 6.648730636e-01f,
  9.736663699e-01f, 2.279775143e-01f, 9.973561764e-01f, 7.266827673e-02f, 9.997355342e-01f, 2.299797349e-02f, 9.999735355e-01f, 7.273174357e-03f,
  4.241790175e-01f, -9.055783749e-01f, 2.614416778e-01f, 9.652192593e-01f, -7.373937964e-01f, 6.754631400e-01f, 7.255613208e-01f, 6.881574988e-01f,
  9.713379741e-01f, 2.377026230e-01f, 9.971213937e-01f, 7.582182437e-02f, 9.997119904e-01f, 2.399769612e-02f, 9.999712110e-01f, 7.589393295e-03f,
  9.912028313e-01f, -1.323517561e-01f, -5.168933049e-02f, 9.986631870e-01f, -8.011435866e-01f, 5.984721184e-01f, 7.034407258e-01f, 7.107539177e-01f,
  9.689124227e-01f, 2.474039644e-01f, 9.968766570e-01f, 7.897461206e-02f, 9.996874928e-01f, 2.499739639e-02f, 9.999687672e-01f, 7.905611768e-03f,
  6.469193101e-01f, 7.625584602e-01f, -3.596943319e-01f, 9.330701828e-01f, -8.568888307e-01f, 5.155012608e-01f, 6.806167960e-01f, 7.326396108e-01f,
  9.663899541e-01f, 2.570805550e-01f, 9.966219068e-01f, 8.212661743e-02f, 9.996620417e-01f, 2.599707060e-02f, 9.999662042e-01f, 8.221829310e-03f,
  -2.921388149e-01f, 9.563759565e-01f, -6.320286393e-01f, 7.749450207e-01f, -9.040721655e-01f, 4.273798466e-01f, 6.571123004e-01f, 7.537927032e-01f,
  9.637709260e-01f, 2.667314112e-01f, 9.963572025e-01f, 8.527779579e-02f, 9.996355176e-01f, 2.699672058e-02f, 9.999635220e-01f, 8.538045920e-03f,
  -9.626058936e-01f, 2.709057927e-01f, -8.416849375e-01f, 5.399689674e-01f, -9.422222972e-01f, 3.349882066e-01f, 6.329506636e-01f, 7.741920948e-01f,
  9.610554576e-01f, 2.763556540e-01f, 9.960825443e-01f, 8.842811733e-02f, 9.996080399e-01f, 2.799634263e-02f, 9.999607801e-01f, 8.854261599e-03f,
  -7.480575442e-01f, -6.636338830e-01f, -9.678714871e-01f, 2.514453232e-01f, -9.709581733e-01f, 2.392492294e-01f, 6.081562042e-01f, 7.938174009e-01f,
  9.582439065e-01f, 2.859522104e-01f, 9.957979321e-01f, 9.157756716e-02f, 9.995795488e-01f, 2.899593674e-02f, 9.999579787e-01f, 9.170476347e-03f,
  1.542514563e-01f, -9.880316257e-01f, -9.980752468e-01f, -6.201484054e-02f, -9.899924994e-01f, 1.411200017e-01f, 5.827536583e-01f, 8.126488924e-01f,
  9.553365111e-01f, 2.955201864e-01f, 9.955033660e-01f, 9.472609311e-02f, 9.995500445e-01f, 2.999550104e-02f, 9.999549985e-01f, 9.486690164e-03f,
  9.147423506e-01f, -4.040376544e-01f, -9.293003082e-01f, -3.693250120e-01f, -9.991351366e-01f, 4.158052057e-02f, 5.567683578e-01f, 8.306677938e-01f,
  9.523335695e-01f, 3.050586283e-01f, 9.951988459e-01f, 9.787366539e-02f, 9.995195270e-01f, 3.099503554e-02f, 9.999519587e-01f, 9.802903049e-03f,
  8.342233896e-01f, 5.514267087e-01f, -7.683671117e-01f, -6.400094032e-01f, -9.982947707e-01f, -5.837419257e-02f, 5.302263498e-01f, 8.478561044e-01f,
  9.492354393e-01f, 3.145665526e-01f, 9.948843718e-01f, 1.010202691e-01f, 9.994880557e-01f, 3.199454024e-02f, 9.999487996e-01f, 1.011911593e-02f,
  -1.327674743e-02f, 9.999118447e-01f, -5.312352777e-01f, -8.472243547e-01f, -9.874798059e-01f, -1.577456445e-01f, 5.031541586e-01f, 8.641966581e-01f,
  9.460423589e-01f, 3.240430057e-01f, 9.945599437e-01f, 1.041658595e-01f, 9.994555712e-01f, 3.299400955e-02f, 9.999455214e-01f, 1.043532696e-02f,
  -8.485702872e-01f, 5.290827155e-01f, -2.414211184e-01f, -9.704204202e-01f, -9.667981863e-01f, -2.555412054e-01f, 4.755789042e-01f, 8.796730638e-01f,
  9.427546859e-01f, 3.334870934e-01f, 9.942255616e-01f, 1.073104069e-01f, 9.994220734e-01f, 3.399345279e-02f, 9.999421835e-01f, 1.075153705e-02f,
  -9.036921859e-01f, -4.281826615e-01f, 7.233466953e-02f, -9.973804355e-01f, -9.364566803e-01f, -3.507832289e-01f, 4.475280643e-01f, 8.942698836e-01f,
  9.393727183e-01f, 3.428978026e-01f, 9.938812256e-01f, 1.104538813e-01f, 9.993875623e-01f, 3.499285504e-02f, 9.999387264e-01f, 1.106774528e-02f,
  -1.279636919e-01f, -9.917788506e-01f, 3.789161742e-01f, -9.254310131e-01f, -8.967583776e-01f, -4.425205588e-01f, 4.190297425e-01f, 9.079725146e-01f,
  9.358968139e-01f, 3.522742093e-01f, 9.935269952e-01f, 1.135962531e-01f, 9.993520975e-01f, 3.599222749e-02f, 9.999352098e-01f, 1.138395350e-02f,
  7.654140592e-01f, -6.435381174e-01f, 6.479216814e-01f, -7.617069483e-01f, -8.481000066e-01f, -5.298361778e-01f, 3.901124299e-01f, 9.207672477e-01f,
  9.323273301e-01f, 3.616154492e-01f, 9.931628108e-01f, 1.167374924e-01f, 9.993155599e-01f, 3.699155897e-02f, 9.999315739e-01f, 1.170015987e-02f,
  9.550736547e-01f, 2.963685691e-01f, 8.526731133e-01f, -5.224447846e-01f, -7.909677625e-01f, -6.118578315e-01f, 3.608050346e-01f, 9.326412678e-01f,
  9.286646247e-01f, 3.709204793e-01f, 9.927886724e-01f, 1.198775545e-01f, 9.992780685e-01f, 3.799085692e-02f, 9.999278188e-01f, 1.201636530e-02f,
  2.666429281e-01f, 9.637953639e-01f, 9.728653431e-01f, -2.313720137e-01f, -7.259322405e-01f, -6.877662539e-01f, 3.311368525e-01f, 9.435827136e-01f,
  9.249090552e-01f, 3.801884055e-01f, 9.924046397e-01f, 1.230164245e-01f, 9.992396235e-01f, 3.899011388e-02f, 9.999239445e-01f, 1.233256981e-02f,
  -6.669380665e-01f, 7.451131344e-01f, 9.965789914e-01f, 8.264580369e-02f, -6.536436081e-01f, -7.568024993e-01f, 3.011375964e-01f, 9.535806775e-01f,
  9.210609794e-01f, 3.894183338e-01f, 9.920106530e-01f, 1.261540651e-01f, 9.992001057e-01f, 3.998933733e-02f, 9.999200106e-01f, 1.264877338e-02f,
  -9.873392582e-01f, -1.586226672e-01f, 9.214623570e-01f, 3.884676993e-01f, -5.748240352e-01f, -8.182770610e-01f, 2.708370686e-01f, 9.626252055e-01f,
  9.171208143e-01f, 3.986093104e-01f, 9.916067719e-01f, 1.292904317e-01f, 9.991596341e-01f, 4.098851606e-02f, 9.999159575e-01f, 1.296497509e-02f,
  -3.999853134e-01f, -9.165215492e-01f, 7.549653649e-01f, 6.557646990e-01f, -4.902605712e-01f, -8.715758920e-01f, 2.402658761e-01f, 9.707071185e-01f,
  9.130889177e-01f, 4.077604413e-01f, 9.911929369e-01f, 1.324255317e-01f, 9.991181493e-01f, 4.198765755e-02f, 9.999117851e-01f, 1.328117587e-02f,
  5.551133156e-01f, -8.317747712e-01f, 5.135984421e-01f, 8.580306768e-01f, -4.007990062e-01f, -9.161660075e-01f, 2.094544172e-01f, 9.778184295e-01f,
  9.089657664e-01f, 4.168707728e-01f, 9.907692075e-01f, 1.355592906e-01f, 9.990756512e-01f, 4.298675060e-02f, 9.999075532e-01f, 1.359737478e-02f,
  9.998432994e-01f, 1.770192571e-02f, 2.212981731e-01f, 9.752061963e-01f, -3.073327839e-01f, -9.516021013e-01f, 1.784335226e-01f, 9.839519858e-01f,
  9.047516584e-01f, 4.259394705e-01f, 9.903355837e-01f, 1.386916935e-01f, 9.990321398e-01f, 4.398580641e-02f, 9.999032021e-01f, 1.391357277e-02f,
  5.253219604e-01f, 8.509035110e-01f, -9.294810891e-02f, 9.956709743e-01f, -2.107958049e-01f, -9.775301218e-01f, 1.472342163e-01f, 9.891016483e-01f,
  9.004471302e-01f, 4.349655211e-01f, 9.898920655e-01f, 1.418227106e-01f, 9.989876747e-01f, 4.498481750e-02f, 9.998987317e-01f, 1.422976889e-02f,
  -4.321779311e-01f, 9.017883539e-01f, -3.979767561e-01f, 9.173954725e-01f, -1.121526212e-01f, -9.936909676e-01f, 1.158876941e-01f, 9.932623506e-01f,
  8.960524797e-01f, 4.439480901e-01f, 9.894386530e-01f, 1.449523121e-01f, 9.989421964e-01f, 4.598378390e-02f, 9.998942018e-01f, 1.454596408e-02f,
  -9.923354983e-01f, 1.235731244e-01f, -6.635382771e-01f, 7.481423616e-01f, -1.238837745e-02f, -9.999232888e-01f, 8.442528546e-02f, 9.964298010e-01f,
  8.915683031e-01f, 4.528862834e-01f, 9.889753461e-01f, 1.480804533e-01f, 9.988957047e-01f, 4.698270187e-02f, 9.998895526e-01f, 1.486215740e-02f,
  -6.401443481e-01f, -7.682546377e-01f, -8.632965088e-01f, 5.046970844e-01f, 8.749917150e-02f, -9.961646199e-01f, 5.287845805e-02f, 9.986009598e-01f,
  8.869948983e-01f, 4.617791772e-01f, 9.885020852e-01f, 1.512071192e-01f, 9.988481998e-01f, 4.798157141e-02f, 9.998847842e-01f, 1.517834887e-02f,
  3.005925417e-01f, -9.537526369e-01f, -9.774427414e-01f, 2.112006545e-01f, 1.865124702e-01f, -9.824525714e-01f, 2.127875760e-02f, 9.997735620e-01f,
  8.823328614e-01f, 4.706258774e-01f, 9.880189896e-01f, 1.543322802e-01f, 9.987997413e-01f, 4.898039624e-02f, 9.998799562e-01f, 1.549453940e-02f,
  9.649659991e-01f, -2.623748481e-01f, -9.946564436e-01f, -1.032404602e-01f, 2.836622000e-01f, -9.589242935e-01f, -1.034221891e-02f, 9.999465346e-01f,
  8.775825500e-01f, 4.794255495e-01f, 9.875259995e-01f, 1.574558914e-01f, 9.987502694e-01f, 4.997916892e-02f, 9.998750091e-01f, 1.581072807e-02f,
  7.421541810e-01f, 6.702291965e-01f, -9.132301211e-01f, -4.074441493e-01f, 3.779776692e-01f, -9.258147478e-01f, -4.195285589e-02f, 9.991195798e-01f,
  8.727445006e-01f, 4.881772399e-01f, 9.870231748e-01f, 1.605779380e-01f, 9.986997843e-01f, 5.097789690e-02f, 9.998699427e-01f, 1.612691768e-02f,
  -1.629907787e-01f, 9.866275787e-01f, -7.412399650e-01f, -6.712401509e-01f, 4.685169160e-01f, -8.834545016e-01f, -7.352153957e-02f, 9.972936511e-01f,
  8.678191900e-01f, 4.968801141e-01f, 9.865104556e-01f, 1.636983752e-01f, 9.986482859e-01f, 5.197656900e-02f, 9.998648167e-01f, 1.644310169e-02f,
  -9.182828069e-01f, 3.959251642e-01f, -4.957418144e-01f, -8.684699535e-01f, 5.543745160e-01f, -8.322673440e-01f, -1.050167084e-01f, 9.944704771e-01f,
  8.628070951e-01f, 5.055333376e-01f, 9.859878421e-01f, 1.668171734e-01f, 9.985958338e-01f, 5.297519267e-02f, 9.998595715e-01f, 1.675928757e-02f,
  -8.293098211e-01f, -5.587890744e-01f, -2.010796219e-01f, -9.795749187e-01f, 6.346929669e-01f, -7.727644444e-01f, -1.364068687e-01f, 9.906529188e-01f,
  8.577086926e-01f, 5.141359568e-01f, 9.854553938e-01f, 1.699342877e-01f, 9.985423684e-01f, 5.397376046e-02f, 9.998542070e-01f, 1.707546785e-02f,
  2.212675661e-02f, -9.997551441e-01f, 1.135217771e-01f, -9.935355186e-01f, 7.086697817e-01f, -7.055402994e-01f, -1.676606387e-01f, 9.858447909e-01f,
  8.525245190e-01f, 5.226872563e-01f, 9.849131107e-01f, 1.730497181e-01f, 9.984878898e-01f, 5.497227982e-02f, 9.998487830e-01f, 1.739165001e-02f,
  8.532201052e-01f, -5.215510130e-01f, 4.168670774e-01f, -9.089674354e-01f, 7.755658031e-01f, -6.312667131e-01f, -1.987468749e-01f, 9.800508618e-01f,
  8.472551107e-01f, 5.311862230e-01f, 9.843609333e-01f, 1.761634201e-01f, 9.984323978e-01f, 5.597073585e-02f, 9.998431802e-01f, 1.770782843e-02f,
  8.998668194e-01f, 4.361647666e-01f, 6.788702011e-01f, -7.342582941e-01f, 8.347129226e-01f, -5.506852865e-01f, -2.296342701e-01f, 9.732769728e-01f,
  8.419010043e-01f, 5.396320224e-01f, 9.837989211e-01f, 1.792753637e-01f, 9.983759522e-01f, 5.696914345e-02f, 9.998375773e-01f, 1.802400686e-02f,
  1.191801354e-01f, 9.928726554e-01f, 8.735505342e-01f, -4.867334962e-01f, 8.855196238e-01f, -4.646020234e-01f, -2.602920532e-01f, 9.655299187e-01f,
  8.364626765e-01f, 5.480239391e-01f, 9.832270741e-01f, 1.823855042e-01f, 9.983184934e-01f, 5.796748772e-02f, 9.998317957e-01f, 1.834018156e-02f,
  -7.710801959e-01f, 6.367380023e-01f, 9.816020727e-01f, -1.909380108e-01f, 9.274784923e-01f, -3.738765717e-01f, -2.906895578e-01f, 9.568174481e-01f,
  8.309407234e-01f, 5.563610196e-01f, 9.826454520e-01f, 1.854938269e-01f, 9.982600212e-01f, 5.896577984e-02f, 9.998259544e-01f, 1.865635626e-02f,
  -9.524129629e-01f, -3.048106134e-01f, 9.923083186e-01f, 1.237909496e-01f, 9.601702690e-01f, -2.794154882e-01f, -3.207964003e-01f, 9.471482038e-01f,
  8.253356218e-01f, 5.646424294e-01f, 9.820539355e-01f, 1.886002868e-01f, 9.982005358e-01f, 5.996400863e-02f, 9.998199940e-01f, 1.897252724e-02f,
  -2.581016421e-01f, -9.661177993e-01f, 9.046075940e-01f, 4.262454212e-01f, 9.832684398e-01f, -1.821625978e-01f, -3.505824506e-01f, 9.365318418e-01f,
  8.196480274e-01f, 5.728674531e-01f, 9.814526439e-01f, 1.917048544e-01f, 9.981400967e-01f, 6.096218154e-02f, 9.998139739e-01f, 1.928869821e-02f,
  6.735071540e-01f, -7.391806841e-01f, 7.271980643e-01f, 6.864276528e-01f, 9.965420961e-01f, -8.308912069e-02f, -3.800179660e-01f, 9.249790907e-01f,
  8.138784766e-01f, 5.810351372e-01f, 9.808415174e-01f, 1.948075294e-01f, 9.980786443e-01f, 6.196028739e-02f, 9.998078346e-01f, 1.960486546e-02f,
  9.858965874e-01f, 1.673557013e-01f, 4.776714444e-01f, 8.785385489e-01f, 9.998586178e-01f, 1.681409031e-02f, -4.090735018e-01f, 9.125014544e-01f,
  8.080275059e-01f, 5.891447663e-01f, 9.802205563e-01f, 1.979082376e-01f, 9.980161786e-01f, 6.295833737e-02f, 9.998015761e-01f, 1.992103085e-02f,
};
#define XB_TMO      128
#define XB_XCNT(j)  (256  + 64 * (j))
#define XB_XSUB(j)  (1280 + 64 * (j))
#define XB_XGEN(j)  (2304 + 64 * (j))
#define XB_TOP      3328
#define XB_TOPGEN   3392
#define XCD_BAR_WORDS 3456
#define XB_SPIN_CAP (1u << 18)
#define LAS __attribute__((address_space(3)))

__device__ __forceinline__ unsigned xb_ld(unsigned* p)              { return __hip_atomic_load(p, __ATOMIC_RELAXED, __HIP_MEMORY_SCOPE_AGENT); }
__device__ __forceinline__ unsigned xb_add(unsigned* p, unsigned v) { return __hip_atomic_fetch_add(p, v, __ATOMIC_RELAXED, __HIP_MEMORY_SCOPE_AGENT); }
__device__ __forceinline__ unsigned xb_xcc_id() { return (unsigned)__builtin_amdgcn_s_getreg((3 << 11) | 20) & 0xFu; }
#define XB_SPIN(cond, bar) do { unsigned _sp = 0; while (cond) { __builtin_amdgcn_s_sleep(1); \
    if ((++_sp & 255u) == 0u) { if (xb_ld(&(bar)[XB_TMO])) break; if (_sp > XB_SPIN_CAP) { atomicAdd(&(bar)[XB_TMO], 1u); break; } } } } while (0)

struct XcdBarrier {
    unsigned* bar; unsigned x;
    volatile LAS unsigned* st;
};

__device__ __forceinline__ XcdBarrier xcd_barrier_post(unsigned* bar, volatile LAS unsigned* st) {
    XcdBarrier b; b.bar = bar; b.x = xb_xcc_id(); b.st = st;
    if (threadIdx.x == 0) (void)xb_add(&bar[XB_XCNT(b.x)], 1u);
    return b;
}
__device__ __forceinline__ void xcd_barrier_complete(unsigned* bar, unsigned x, unsigned& nloc, unsigned& nx) {
    const unsigned G = gridDim.x * gridDim.y * gridDim.z;
    unsigned sum, cnt, mine, sp = 0u;
    for (;;) {
        sum = 0u; cnt = 0u; mine = 0u;
#pragma unroll
        for (unsigned j = 0; j < 16; ++j) { const unsigned c = xb_ld(&bar[XB_XCNT(j)]); sum += c; cnt += (c > 0u) ? 1u : 0u; mine = (j == x) ? c : mine; }
        if (sum == G) break;
        __builtin_amdgcn_s_sleep(1);
        if ((++sp & 255u) == 0u) { if (xb_ld(&bar[XB_TMO])) break; if (sp > XB_SPIN_CAP) { atomicAdd(&bar[XB_TMO], 1u); break; } }
    }
    nloc = mine > 0u ? mine : 1u; nx = cnt > 0u ? cnt : 1u;
}

__device__ __forceinline__ void xcd_barrier(const XcdBarrier& b, const bool t0  ) {
    asm volatile("s_waitcnt vmcnt(0)" ::: "memory");
    __syncthreads();
    if (t0) {
        unsigned* bar = b.bar;
        __builtin_amdgcn_s_waitcnt(0);
        unsigned nloc = b.st[0], nx = b.st[1];
        if (nloc == 0u) { xcd_barrier_complete(bar, b.x, nloc, nx); b.st[0] = nloc; b.st[1] = nx; }
        const unsigned old = xb_add(&bar[XB_XSUB(b.x)], 1u);
        const unsigned gen = old / nloc;
        if (old + 1u == (gen + 1u) * nloc) {
            __builtin_amdgcn_fence(__ATOMIC_RELEASE, "agent");
            asm volatile("s_waitcnt vmcnt(0)" ::: "memory");
            const unsigned og = xb_add(&bar[XB_TOP], 1u);
            const unsigned tg = og / nx;
            if (og + 1u == (tg + 1u) * nx) xb_add(&bar[XB_TOPGEN], 1u);
            else XB_SPIN(xb_ld(&bar[XB_TOPGEN]) == tg, bar);
            __builtin_amdgcn_fence(__ATOMIC_ACQUIRE, "agent");
            xb_add(&bar[XB_XGEN(b.x)], 1u);
            asm volatile("s_waitcnt vmcnt(0)" ::: "memory");
        } else {
            XB_SPIN(xb_ld(&bar[XB_XGEN(b.x)]) == gen, bar);
            __builtin_amdgcn_fence(__ATOMIC_ACQUIRE, "agent");
            asm volatile("s_waitcnt vmcnt(0)" ::: "memory");
        }
    }
    __syncthreads();
}

DI void conv_fetch(const float* __restrict__ src, int K, int N, int k0, int n0, f32x4 (&v)[2], int tid) {
#pragma unroll
    for (int i = 0; i < 2; ++i) {
        const int idx = tid + NTHREADS * i, kr = idx >> 4, c4 = (idx & 15) * 4;
        v[i] = (f32x4){0.f, 0.f, 0.f, 0.f};
        if (n0 + c4 < N) v[i] = __builtin_nontemporal_load((const f32x4*)(src + (size_t)(k0 + kr) * N + n0 + c4));
    }
}
DI void conv_put(const f32x4 (&v)[2], float* lds, int tid) {
#pragma unroll
    for (int i = 0; i < 2; ++i) {
        const int idx = tid + NTHREADS * i, kr = idx >> 4, c4 = (idx & 15) * 4;
        float* d = lds + kr * 65 + c4;
        d[0] = v[i].x; d[1] = v[i].y; d[2] = v[i].z; d[3] = v[i].w;
    }
}
typedef float f32x2_8 __attribute__((ext_vector_type(2)));
DI unsigned cvt_fp8x4(float a, float b, float c, float d) { int w = __builtin_amdgcn_cvt_pk_fp8_f32(a, b, 0, false); w = __builtin_amdgcn_cvt_pk_fp8_f32(c, d, w, true); return (unsigned)w; }
template <bool NT, bool FP8>
DI void conv_store(int K, bf16_t* __restrict__ dst, int k0, int ndst0, int nstep, const float* lds, int tid) {
    const int idx = tid, n = idx >> 3, kc = idx & 7;
    float f[8];
#pragma unroll
    for (int j = 0; j < 8; ++j) f[j] = lds[(kc * 8 + j) * 65 + n];
    const size_t e = (size_t)(ndst0 + (n & 31) + (n >> 5) * nstep) * K + k0 + kc * 8;
    if (FP8) {
        u32x2 w; w.x = cvt_fp8x4(f[0] * 32.f, f[1] * 32.f, f[2] * 32.f, f[3] * 32.f); w.y = cvt_fp8x4(f[4] * 32.f, f[5] * 32.f, f[6] * 32.f, f[7] * 32.f);
        u32x2* d = (u32x2*)((unsigned char*)dst + e);
        if (NT) __builtin_nontemporal_store(w, d); else *d = w;
    } else {
        u32x4* d = (u32x4*)(dst + e);
        if (NT) __builtin_nontemporal_store(pack8(f), d); else *d = pack8(f);
    }
}
template <bool NT = true, bool FP8 = false>
DI void conv_job(const float* src, int count, int K, int N, int Npad, bf16_t* dst, int perm  , int& base, float* lds, int bid, int nb, int tid) {
    const int tk = K / 64, tn = Npad / 64, per = tk * tn, total = count * per;
    int t = (bid - (base % nb) + nb) % nb;
    f32x4 rg[4][2];
    auto fetch4 = [&](int tt) {
#pragma unroll
        for (int q = 0; q < 4; ++q) {
            const int tq = tt + q * nb;
            if (tq < total) { const int mi = tq / per, rem = tq - mi * per, nt = rem / tk, kt = rem - nt * tk;
                conv_fetch(src + (size_t)mi * K * N, K, N, kt * 64, nt * 64, rg[q], tid); }
        }
    };
    if (t < total) fetch4(t);
    for (; t < total; t += 4 * nb) {
#pragma unroll
        for (int q = 0; q < 4; ++q) if (t + q * nb < total) conv_put(rg[q], lds + q * 4160, tid);
        __syncthreads();
        if (t + 4 * nb < total) fetch4(t + 4 * nb);
#pragma unroll
        for (int q = 0; q < 4; ++q) {
            const int tq = t + q * nb;
            if (tq < total) { const int mi = tq / per, rem = tq - mi * per, nt = rem / tk, kt = rem - nt * tk, n0 = nt * 64;
                int nd0 = n0, nstep = 32;
                if (perm == 1) nd0 = ((n0 & 255) >> 7) * 256 + (n0 >> 8) * 128 + (n0 & 127);
                else if (n0 < perm) { const int hg = n0 >> 6; nd0 = (hg >> 2) * 256 + (hg & 3) * 32; nstep = 128; }
                conv_store<NT, FP8>(K, FP8 ? (bf16_t*)((unsigned char*)dst + (size_t)mi * Npad * K) : dst + (size_t)mi * Npad * K, kt * 64, nd0, nstep, lds + q * 4160, tid); }
        }
        __syncthreads();
    }
    base += total;
}

DI int mla_col(bool uq, int r) {
    const int hw = uq ? 96 : 128;
    if (r < 1024) { const int pn = r >> 8, bj = (r >> 7) & 1, wc = (r >> 5) & 3, d = r & 31; return (4 * pn + wc) * hw + 32 * bj + d; }
    const int rr = r - 1024;
    if (uq) { const int head = rr >> 5, c = rr & 31, dim = (c >> 3) * 4 + (c & 3) + 16 * ((c >> 2) & 1); return head * 96 + 64 + dim; }
    return (rr >> 6) * 128 + 64 + (rr & 63);
}
DI void phase_prologue(const Params& p, float* lds, int bid, int nb, int tid) {
    bf16_t* ws16 = (bf16_t*)p.ws;
    int base = 0;
    conv_job<true, true>(p.in[13], 1, 1024, 3072, 3072, (bf16_t*)(p.ws + W_QKV0), 2048, base, lds, bid, nb, tid);
    conv_job<true, true>(p.in[14], 1, 1024, 1024, 1024, (bf16_t*)(p.ws + W_O0), 0, base, lds, bid, nb, tid);
    conv_job<true, true>(p.in[18], 1, 1024, 1536, 1536, (bf16_t*)(p.ws + W_QKV1), 1280, base, lds, bid, nb, tid);
    conv_job<true, true>(p.in[19], 1, 1024, 1024, 1024, (bf16_t*)(p.ws + W_O1), 0, base, lds, bid, nb, tid);
    conv_job<true, true>(p.in[23], 1, 1024, 672, 768, (bf16_t*)(p.ws + W_DQKV), 0, base, lds, bid, nb, tid);
    for (int i = bid * NTHREADS + tid; i < 1536 * 64 + 2048 * 32; i += nb * NTHREADS) {
        const bool uq = i < 1536 * 64;
        const int K = uq ? 384 : 256, KB = uq ? 512 : 256, kc = KB / 8, ii = uq ? i : i - 1536 * 64, r = ii / kc, k0 = (ii - r * kc) * 8, nsrc = uq ? 1536 : 2048;
        u32x2 w8 = {0u, 0u};
        if (k0 < K) {
            const int col = mla_col(uq, r);
            const float* src = p.in[uq ? 26 : 27] + (size_t)k0 * nsrc + col;
            float f[8];
#pragma unroll
            for (int j = 0; j < 8; ++j) f[j] = src[(size_t)j * nsrc] * 32.f;
            w8.x = cvt_fp8x4(f[0], f[1], f[2], f[3]); w8.y = cvt_fp8x4(f[4], f[5], f[6], f[7]);
        }
        *(u32x2*)(p.ws + (uq ? W_UQ : W_UKV) + (size_t)r * KB + k0) = w8;
    }
    conv_job<true, true>(p.in[30], 1, 1024, 1024, 1024, (bf16_t*)(p.ws + W_O2), 0, base, lds, bid, nb, tid);
    conv_job<true, true>(p.in[31], 1, 1024, 3072, 3072, (bf16_t*)(p.ws + W_QKV3), 2048, base, lds, bid, nb, tid);
    conv_job<true, true>(p.in[36], 1, 1024, 1024, 1024, (bf16_t*)(p.ws + W_O3), 0, base, lds, bid, nb, tid);
    conv_job<true, true>(p.in[11], 32, 1024, 512, 512, (bf16_t*)(p.ws + W_GU), 1, base, lds, bid, nb, tid);
    conv_job(p.in[12], 32, 256, 1024, 1024, (bf16_t*)(p.ws + W_DN), 0, base, lds, bid, nb, tid);
    (void)ws16;
    float* sc = lds;
    for (int i = tid; i < 9 * 1024; i += NTHREADS) {
        const int r = i >> 10, k = i & 1023;
        const float v = r < 8 ? p.in[1][r * 1024 + k] : p.in[3][k];
        sc[i] = silu_f(v);
    }
    __syncthreads();
    float* part = (float*)(p.ws + WS_MODP);
    for (int it = bid; it < 768; it += nb) {
        const int kc = it / 48, rem = it - kc * 48, l = rem / 12, nch = rem - l * 12;
        const int n = nch * 512 + tid;
        const float* w = p.in[4] + ((size_t)l * 1024 + kc * 64) * 6144 + n;
        float acc[9];
#pragma unroll
        for (int r = 0; r < 9; ++r) acc[r] = 0.f;
#pragma unroll 32
        for (int k = 0; k < 64; ++k) {
            const float wv = __builtin_nontemporal_load(w + (size_t)k * 6144);
#pragma unroll
            for (int r = 0; r < 9; ++r) acc[r] += sc[r * 1024 + kc * 64 + k] * wv;
        }
#pragma unroll
        for (int r = 0; r < 9; ++r) part[(((size_t)kc * 4 + l) * 9 + r) * 6144 + n] = acc[r];
    }
    __syncthreads();
}
DI void phase_mod_reduce(const Params& p, int bid, int nb, int tid) {
    const float* part = (const float*)(p.ws + WS_MODP);
    float* mod = (float*)(p.ws + WS_MOD);
    const int total = 4 * 9 * 6144;
    for (int i = bid * NTHREADS + tid; i < total; i += nb * NTHREADS) {
        const int l = i / (9 * 6144), n = i % 6144;
        float s = p.in[5][l * 6144 + n];
#pragma unroll
        for (int kc = 0; kc < 16; ++kc) s += part[(size_t)kc * total + i];
        mod[i] = s;
    }
}

template <int MODE>
DI void phase_rows(const Params& p, int layer  , int which  , int bid, int nb, int tid) {
    const int wid = __builtin_amdgcn_readfirstlane(tid >> 6), lane = tid & 63;
    const float* modall = (const float*)(p.ws + WS_MOD);
    const bf16_t* eo = (const bf16_t*)(p.ws + WS_RAW);
    bf16_t* H = (bf16_t*)(p.ws + WS_H);
    const int rpw = (MROWS + nb * NW - 1) / (nb * NW), rbeg = (bid * NW + wid) * rpw, rend = min(MROWS, rbeg + rpw);
    int mr_have = -1;
    f32x4 g2v[4], gmv[4], shv[4];
    for (int r = rbeg; r < rend; ++r) {
        const int b = r / PP, pos = r - b * PP;
        if ((MODE & 16) && pos >= SEQ) continue;
        const int mr = pos < SEQ ? b : 8;
        if (mr != mr_have) {
            mr_have = mr;
            if (MODE & 1) { const float* g2 = modall + ((size_t)(layer - ((MODE & 2) ? 1 : 0)) * 9 + mr) * 6144 + 5120;
#pragma unroll
                for (int j = 0; j < 4; ++j) g2v[j] = *(const f32x4*)(g2 + lane * 4 + 256 * j) * (1.0f / 16.0f); }
            if (MODE & 2) { const float* ng = p.in[6] + ((size_t)layer * 2 + which) * 1024; const float* md = modall + ((size_t)layer * 9 + mr) * 6144 + which * 3072;
#pragma unroll
                for (int j = 0; j < 4; ++j) { const f32x4 g = *(const f32x4*)(ng + lane * 4 + 256 * j), sc = *(const f32x4*)(md + 1024 + lane * 4 + 256 * j);
                    shv[j] = *(const f32x4*)(md + lane * 4 + 256 * j); gmv[j] = (f32x4){g.x * (1.0f + sc.x), g.y * (1.0f + sc.y), g.z * (1.0f + sc.z), g.w * (1.0f + sc.w)}; } }
        }
        bf16_t* xb = xb_row(p, r);
        float x[16];
        if (MODE & 8) {
            const float* xr = pos < SEQ ? p.in[0] + ((size_t)b * SEQ + pos) * DM : p.in[2] + ((size_t)b * CTXL + (pos - SEQ)) * DM;
#pragma unroll
            for (int j = 0; j < 4; ++j) { const f32x4 v = *(const f32x4*)(xr + lane * 4 + 256 * j); x[4 * j] = v.x; x[4 * j + 1] = v.y; x[4 * j + 2] = v.z; x[4 * j + 3] = v.w; }
        } else {
#pragma unroll
            for (int j = 0; j < 4; ++j) { const u32x2 v = *(const u32x2*)(xb + lane * 4 + 256 * j); x[4 * j] = bflo(v.x); x[4 * j + 1] = bfhi(v.x); x[4 * j + 2] = bflo(v.y); x[4 * j + 3] = bfhi(v.y); }
        }
        if (MODE & 1) {
            const unsigned char* y0 = (const unsigned char*)eo + (size_t)(2 * r) * 1024, *y1 = y0 + 1024;
#pragma unroll
            for (int j = 0; j < 4; ++j) {
                const unsigned a = *(const unsigned*)(y0 + lane * 4 + 256 * j), bb = *(const unsigned*)(y1 + lane * 4 + 256 * j);
                const f32x4 g = g2v[j];
                const f32x2_8 a01 = __builtin_amdgcn_cvt_pk_f32_fp8((int)a, false), a23 = __builtin_amdgcn_cvt_pk_f32_fp8((int)a, true);
                const f32x2_8 b01 = __builtin_amdgcn_cvt_pk_f32_fp8((int)bb, false), b23 = __builtin_amdgcn_cvt_pk_f32_fp8((int)bb, true);
                x[4 * j] += g.x * (a01[0] + b01[0]); x[4 * j + 1] += g.y * (a01[1] + b01[1]);
                x[4 * j + 2] += g.z * (a23[0] + b23[0]); x[4 * j + 3] += g.w * (a23[1] + b23[1]);
            }
        }
        if (MODE & 16) {
            float* orow = p.out + ((size_t)b * SEQ + pos) * DM;
#pragma unroll
            for (int j = 0; j < 4; ++j) *(f32x4*)(orow + lane * 4 + 256 * j) = (f32x4){x[4 * j], x[4 * j + 1], x[4 * j + 2], x[4 * j + 3]};
        } else if (MODE & (1 | 8)) {
#pragma unroll
            for (int j = 0; j < 4; ++j) {
                u32x2 w; w.x = pk2(x[4 * j], x[4 * j + 1]); w.y = pk2(x[4 * j + 2], x[4 * j + 3]);
                *(u32x2*)(xb + lane * 4 + 256 * j) = w;
                x[4 * j] = bflo(w.x); x[4 * j + 1] = bfhi(w.x); x[4 * j + 2] = bflo(w.y); x[4 * j + 3] = bfhi(w.y);
            }
        }
        if (MODE & 2) {
            float ss = 0.f;
#pragma unroll
            for (int i = 0; i < 16; ++i) ss += x[i] * x[i];
            ss = wave_sum(ss);
            const float rs = rsqrtf(ss * (1.0f / 1024.0f) + EPS);
#pragma unroll
            for (int j = 0; j < 4; ++j) {
                const f32x4 g = gmv[j], sh = shv[j];
                const float h0 = x[4 * j] * rs * g.x + sh.x, h1 = x[4 * j + 1] * rs * g.y + sh.y;
                const float h2 = x[4 * j + 2] * rs * g.z + sh.z, h3 = x[4 * j + 3] * rs * g.w + sh.w;
                if (MODE & 32) *(unsigned*)((unsigned char*)H + (size_t)r * 1024 + lane * 4 + 256 * j) = cvt_fp8x4(h0, h1, h2, h3);
                else { u32x2 w; w.x = pk2(h0, h1); w.y = pk2(h2, h3); *(u32x2*)(H + (size_t)r * 1024 + lane * 4 + 256 * j) = w; }
            }
        }
    }
}

constexpr size_t WS_RC = WS_MOD + 917504;
DI void phase_router_prep(const Params& p, int bid, int nb, int tid) {
    const float* modall = (const float*)(p.ws + WS_MOD);
    bf16_t* wth = (bf16_t*)(p.ws + WS_RW); bf16_t* wtl = wth + 4 * 9 * 48 * 1024;
    const int total = 4 * 9 * 48 * 1024;
    for (int i = bid * NTHREADS + tid; i < total; i += nb * NTHREADS) {
        const int k = i & 1023, c = (i >> 10) % 48, lb = i / (48 * 1024), l = lb / 9, b = lb - l * 9;
        float v = 0.f;
        if (c < 36) {
            const float w = c < 32 ? p.in[9][((size_t)l * 1024 + k) * 32 + c] : p.in[7][((size_t)l * 1024 + k) * 4 + (c - 32)];
            v = p.in[6][((size_t)l * 2 + 1) * 1024 + k] * (1.0f + modall[((size_t)l * 9 + b) * 6144 + 4096 + k]) * w;
        }
        const unsigned hb = f2bf(v); wth[i] = (bf16_t)hb; wtl[i] = (bf16_t)f2bf(v - bf2f(hb));
    }
    float* cst = (float*)(p.ws + WS_RC);
    const int wid = __builtin_amdgcn_readfirstlane(tid >> 6), lane = tid & 63;
    for (int j = bid * NW + wid; j < 4 * 9 * 48; j += nb * NW) {
        const int c = j % 48, lb = j / 48, l = lb / 9, b = lb - l * 9;
        float acc = 0.f;
        if (c < 36) {
            for (int k = lane; k < 1024; k += 64) {
                const float w = c < 32 ? p.in[9][((size_t)l * 1024 + k) * 32 + c] : p.in[7][((size_t)l * 1024 + k) * 4 + (c - 32)];
                acc += modall[((size_t)l * 9 + b) * 6144 + 3072 + k] * w;
            }
            acc = wave_sum(acc) + (c < 32 ? p.in[10][l * 32 + c] : p.in[8][l * 4 + (c - 32)]);
        }
        if (lane == 0) cst[j] = acc;
    }
}
typedef float f32x2_3 __attribute__((ext_vector_type(2)));
typedef __bf16 bf16x2_3 __attribute__((ext_vector_type(2)));
DI unsigned cvtpk3(float lo, float hi) { f32x2_3 v = {lo, hi}; bf16x2_3 b = __builtin_convertvector(v, bf16x2_3); return __builtin_bit_cast(unsigned, b); }
DI void phase_router(const Params& p, unsigned char* smem, int layer, bool skip_ctx, int bid, int nb, int tid) {
    const int lane = tid & 63, wid = __builtin_amdgcn_readfirstlane(tid >> 6), li = lane & 15, kq = lane >> 4;
    LAS float* tile = (LAS float*)smem + wid * (32 * 49);
    const bf16_t* wth_all = (const bf16_t*)(p.ws + WS_RW) + (size_t)layer * 9 * 48 * 1024;
    const bf16_t* wtl_all = wth_all + 4 * 9 * 48 * 1024;
    const float* cst_all = (const float*)(p.ws + WS_RC) + layer * 9 * 48;
    unsigned* cnt = (unsigned*)(p.ws + WS_CTL) + CW_CNT + layer * 32;
    unsigned* list = (unsigned*)(p.ws + WS_LIST);
    float* gates = (float*)(p.ws + WS_GATE);
    if (layer > 0) {
        int base = 0;
        conv_job<false, true>(p.in[11] + (size_t)layer * 32 * 1024 * 512, 32, 1024, 512, 512, (bf16_t*)(p.ws + W_GU + (size_t)layer * 32 * 512 * 1024), 1, base, (float*)smem, bid, nb, tid);
        conv_job<false>(p.in[12] + (size_t)layer * 32 * 256 * 1024, 32, 256, 1024, 1024, (bf16_t*)(p.ws + W_DN) + (size_t)layer * 32 * 1024 * 256, 0, base, (float*)smem, bid, nb, tid);
    }
    for (int u = wid * nb + bid; u < MROWS / 32; u += nb * NW) {
        const int r0 = u * 32, b = r0 / PP, pos = r0 - b * PP;
        const bool isctx = pos >= SEQ;
        if (skip_ctx && isctx) continue;
        const int mr = isctx ? 8 : b;
        const bf16_t* xr = xb_row(p, r0 + li) + 8 * kq;
        const bf16_t* wh = wth_all + ((size_t)mr * 48 + li) * 1024 + 8 * kq;
        const bf16_t* wl = wtl_all + ((size_t)mr * 48 + li) * 1024 + 8 * kq;
        f32x4 acc[2][3];
#pragma unroll
        for (int m = 0; m < 2; ++m)
#pragma unroll
            for (int n = 0; n < 3; ++n) acc[m][n] = (f32x4){0.f, 0.f, 0.f, 0.f};
        float ss[2] = {0.f, 0.f};
#pragma unroll 2
        for (int s = 0; s < 32; ++s) {
            bf16x8 xa[2], bh[3], bl[3];
#pragma unroll
            for (int m = 0; m < 2; ++m) xa[m] = *(const bf16x8*)(xr + (size_t)m * 16 * DM + 32 * s);
#pragma unroll
            for (int n = 0; n < 3; ++n) { bh[n] = *(const bf16x8*)(wh + (size_t)n * 16 * 1024 + 32 * s); bl[n] = *(const bf16x8*)(wl + (size_t)n * 16 * 1024 + 32 * s); }
#pragma unroll
            for (int m = 0; m < 2; ++m) {
                const u32x4 w = __builtin_bit_cast(u32x4, xa[m]);
                ss[m] += bflo(w.x) * bflo(w.x) + bfhi(w.x) * bfhi(w.x) + bflo(w.y) * bflo(w.y) + bfhi(w.y) * bfhi(w.y) + bflo(w.z) * bflo(w.z) + bfhi(w.z) * bfhi(w.z) + bflo(w.w) * bflo(w.w) + bfhi(w.w) * bfhi(w.w);
#pragma unroll
                for (int n = 0; n < 3; ++n) {
                    acc[m][n] = __builtin_amdgcn_mfma_f32_16x16x32_bf16(xa[m], bl[n], acc[m][n], 0, 0, 0);
                    acc[m][n] = __builtin_amdgcn_mfma_f32_16x16x32_bf16(xa[m], bh[n], acc[m][n], 0, 0, 0);
                }
            }
        }
#pragma unroll
        for (int m = 0; m < 2; ++m) { ss[m] += __shfl_xor(ss[m], 16); ss[m] += __shfl_xor(ss[m], 32); }
#pragma unroll
        for (int m = 0; m < 2; ++m)
#pragma unroll
            for (int n = 0; n < 3; ++n)
#pragma unroll
                for (int i = 0; i < 4; ++i) tile[(16 * m + 4 * kq + i) * 49 + n * 16 + li] = acc[m][n][i];
        __builtin_amdgcn_s_waitcnt(0xc07f);
        const float ssr = (lane & 16) ? ss[1] : ss[0];
        const float rs = rsqrtf(ssr * (1.0f / 1024.0f) + EPS);
        if (lane < 32) {
            const float* cst = cst_all + mr * 48;
            const LAS float* tr = tile + lane * 49;
            float lg[4];
#pragma unroll
            for (int c = 0; c < 4; ++c) lg[c] = tr[32 + c] * rs + cst[32 + c];
            int gi = 0; float gm = lg[0];
#pragma unroll
            for (int c = 1; c < 4; ++c) if (lg[c] > gm) { gm = lg[c]; gi = c; }
            float gden = 0.f;
#pragma unroll
            for (int c = 0; c < 4; ++c) gden += __expf(lg[c] - gm);
            const float gw = 1.0f / gden;
            float le[8];
#pragma unroll
            for (int c = 0; c < 8; ++c) le[c] = tr[gi * 8 + c] * rs + cst[gi * 8 + c];
            int e0 = 0; float m0 = le[0];
#pragma unroll
            for (int c = 1; c < 8; ++c) if (le[c] > m0) { m0 = le[c]; e0 = c; }
            int e1 = -1; float m1 = -INFINITY;
#pragma unroll
            for (int c = 0; c < 8; ++c) if (c != e0 && le[c] > m1) { m1 = le[c]; e1 = c; }
            const float q1 = __expf(m1 - m0), inv = 1.0f / (1.0f + q1);
            const int r = r0 + lane, ex0 = gi * 8 + e0, ex1 = gi * 8 + e1;
            const unsigned s0 = atomicAdd(cnt + ex0, 1u), s1 = atomicAdd(cnt + ex1, 1u);
            list[(size_t)ex0 * MROWS + s0] = 2u * r; list[(size_t)ex1 * MROWS + s1] = 2u * r + 1u;
            gates[2 * r] = gw * inv; gates[2 * r + 1] = gw * q1 * inv;
        }
        {
            const float* ng = p.in[6] + ((size_t)layer * 2 + 1) * 1024;
            const float* md = (const float*)(p.ws + WS_MOD) + ((size_t)layer * 9 + mr) * 6144 + 3072;
            f32x4 gm[4], sh[4];
#pragma unroll
            for (int j = 0; j < 4; ++j) {
                const f32x4 g = *(const f32x4*)(ng + lane * 4 + 256 * j), sc = *(const f32x4*)(md + 1024 + lane * 4 + 256 * j);
                sh[j] = *(const f32x4*)(md + lane * 4 + 256 * j);
                gm[j] = (f32x4){g.x * (1.0f + sc.x), g.y * (1.0f + sc.y), g.z * (1.0f + sc.z), g.w * (1.0f + sc.w)};
            }
            unsigned char* H8 = p.ws + WS_H;
#pragma unroll 4
            for (int i = 0; i < 32; ++i) {
                const float rsi = __shfl(rs, i);
                const bf16_t* xb = xb_row(p, r0 + i);
#pragma unroll
                for (int j = 0; j < 4; ++j) {
                    const u32x2 v = *(const u32x2*)(xb + lane * 4 + 256 * j);
                    *(unsigned*)(H8 + (size_t)(r0 + i) * 1024 + lane * 4 + 256 * j) =
                        cvt_fp8x4(bflo(v.x) * rsi * gm[j].x + sh[j].x, bfhi(v.x) * rsi * gm[j].y + sh[j].y, bflo(v.y) * rsi * gm[j].z + sh[j].z, bfhi(v.y) * rsi * gm[j].w + sh[j].w);
                }
            }
        }
    }
}

#define MFMA32(a, b, c) __builtin_amdgcn_mfma_f32_32x32x16_bf16((a), (b), (c), 0, 0, 0)
typedef LAS unsigned char* lds_ptr;
constexpr int GEMM_TM = 256, GEMM_TN = 256;
constexpr int GEMM_STAGE = 65536;
constexpr int GEMM_LDS = 2 * GEMM_STAGE;
constexpr int GEMM_MT = 4;

struct RowDense { static constexpr bool DENSE = true; const bf16_t* A; int lda; int m0; DI unsigned row(int i) const { return (unsigned)(m0 + i) * (unsigned)lda; } };
struct RowGather { static constexpr bool DENSE = false; const bf16_t* A; int lda; const unsigned* ent; int valid; int shift;
    DI unsigned row(int i) const { const unsigned e = ent[i < valid ? i : valid - 1]; return (e >> shift) * (unsigned)lda; } };

struct EpiStore { bf16_t* C; int ldc; int m0;
    DI void wave_tile(const f32x16 (&acc)[2][GEMM_MT], int mloc, int ncol, int lane) const {
        const int r = lane & 31, h = lane >> 5;
#pragma unroll
        for (int mt = 0; mt < GEMM_MT; ++mt) {
            bf16_t* c = C + (size_t)(m0 + mloc + mt * 32 + r) * ldc + ncol + 4 * h;
#pragma unroll
            for (int nt = 0; nt < 2; ++nt)
#pragma unroll
                for (int g = 0; g < 4; ++g) {
                    u32x2 w; w.x = pk2(acc[nt][mt][4 * g], acc[nt][mt][4 * g + 1]); w.y = pk2(acc[nt][mt][4 * g + 2], acc[nt][mt][4 * g + 3]);
                    *(u32x2*)(c + nt * 32 + 8 * g) = w;
                }
        }
    } };
struct EpiResid { const Params* p; const float* mod; int m0;
    DI void wave_tile(const f32x16 (&acc)[2][GEMM_MT], int mloc, int ncol, int lane) const {
        const int r = lane & 31, h = lane >> 5;
#pragma unroll
        for (int mt = 0; mt < GEMM_MT; ++mt) {
            const int row = m0 + mloc + mt * 32 + r;
            float* xr = xrow_ptr(*p, row) + ncol + 4 * h;
            const float* gp = mod + (size_t)mod_row(row) * 6144 + 2048 + ncol + 4 * h;
#pragma unroll
            for (int nt = 0; nt < 2; ++nt)
#pragma unroll
                for (int g = 0; g < 4; ++g) {
                    f32x4 x = *(f32x4*)(xr + nt * 32 + 8 * g);
                    const f32x4 gg = *(const f32x4*)(gp + nt * 32 + 8 * g);
                    x.x += gg.x * acc[nt][mt][4 * g]; x.y += gg.y * acc[nt][mt][4 * g + 1]; x.z += gg.z * acc[nt][mt][4 * g + 2]; x.w += gg.w * acc[nt][mt][4 * g + 3];
                    *(f32x4*)(xr + nt * 32 + 8 * g) = x;
                }
        }
    } };
struct EpiGlu { bf16_t* act; const unsigned* ent; const float* gates; int valid;
    DI void wave_tile(const f32x16 (&acc)[2][GEMM_MT], int mloc, int ncol, int lane) const {
        const int r = lane & 31, h = lane >> 5;
#pragma unroll
        for (int mt = 0; mt < GEMM_MT; ++mt) {
            const int i = mloc + mt * 32 + r;
            if (i < valid) {
                const unsigned a = ent[i];
                const float gw = gates[a];
                bf16_t* o = act + (size_t)a * DEXP + (ncol >> 6) * 32 + 4 * h;
#pragma unroll
                for (int g = 0; g < 4; ++g) {
                    float v[4];
#pragma unroll
                    for (int j = 0; j < 4; ++j) v[j] = silu_f(acc[0][mt][4 * g + j]) * acc[1][mt][4 * g + j] * gw;
                    u32x2 w; w.x = pk2(v[0], v[1]); w.y = pk2(v[2], v[3]);
                    *(u32x2*)(o + 8 * g) = w;
                }
            }
        }
    } };
struct EpiScatter { bf16_t* outp; const unsigned* ent; int valid;
    DI void wave_tile(const f32x16 (&acc)[2][GEMM_MT], int mloc, int ncol, int lane) const {
        const int r = lane & 31, h = lane >> 5;
#pragma unroll
        for (int mt = 0; mt < GEMM_MT; ++mt) {
            const int i = mloc + mt * 32 + r;
            if (i < valid) {
                bf16_t* c = outp + (size_t)ent[i] * 1024 + ncol + 4 * h;
#pragma unroll
                for (int nt = 0; nt < 2; ++nt)
#pragma unroll
                    for (int g = 0; g < 4; ++g) {
                        u32x2 w; w.x = pk2(acc[nt][mt][4 * g], acc[nt][mt][4 * g + 1]); w.y = pk2(acc[nt][mt][4 * g + 2], acc[nt][mt][4 * g + 3]);
                        *(u32x2*)(c + nt * 32 + 8 * g) = w;
                    }
            }
        }
    } };

#define SCHED_FENCE() __builtin_amdgcn_sched_barrier(0)
DI void glds16(const bf16_t* g, lds_ptr l) { __builtin_amdgcn_global_load_lds((const unsigned*)g, (LAS unsigned*)l, 16, 0, 0); }
template <int PROBE, int NAG>
DI void gemm_kstep(f32x16 (&acc)[2][GEMM_MT], const lds_ptr st, const unsigned (&arow)[GEMM_MT], const unsigned (&wrow)[2], const unsigned (&aswz)[GEMM_MT], const unsigned (&wswz)[2], int h,
                   bool issue, const bf16_t* __restrict__ An, const bf16_t* __restrict__ Wn, const unsigned (&ag)[NAG], unsigned astep, const unsigned (&bg)[2], unsigned bstep, const lds_ptr sn) {
    if (PROBE != 2 && issue) {
#pragma unroll
        for (int j = 0; j < 8; ++j) { glds16(An + (NAG == 2 ? ag[j & 1] + (j >> 1) * astep : ag[j % NAG]), sn + j * 1024); glds16(Wn + bg[j & 1] + (j >> 1) * bstep, sn + 32768 + j * 1024); }
    }
    if (PROBE == 1) return;
    bf16x8 af[2][GEMM_MT], wf[2][2];
#pragma unroll
    for (int t = 0; t < 2; ++t) wf[0][t] = *(const LAS bf16x8*)(st + wrow[t] + ((((unsigned)h) ^ wswz[t]) << 4));
#pragma unroll
    for (int t = 0; t < GEMM_MT; ++t) af[0][t] = *(const LAS bf16x8*)(st + arow[t] + ((((unsigned)h) ^ aswz[t]) << 4));
#pragma unroll
    for (int kk = 0; kk < 4; ++kk) {
        if (kk < 3) {
#pragma unroll
            for (int t = 0; t < 2; ++t) wf[(kk + 1) & 1][t] = *(const LAS bf16x8*)(st + wrow[t] + ((((unsigned)((kk + 1) * 2 + h)) ^ wswz[t]) << 4));
#pragma unroll
            for (int t = 0; t < GEMM_MT; ++t) af[(kk + 1) & 1][t] = *(const LAS bf16x8*)(st + arow[t] + ((((unsigned)((kk + 1) * 2 + h)) ^ aswz[t]) << 4));
        }
        SCHED_FENCE();
        __builtin_amdgcn_s_setprio(1);
#pragma unroll
        for (int mt = 0; mt < GEMM_MT; ++mt)
#pragma unroll
            for (int nt = 0; nt < 2; ++nt) acc[nt][mt] = MFMA32(wf[kk & 1][nt], af[kk & 1][mt], acc[nt][mt]);
        __builtin_amdgcn_s_setprio(0);
        SCHED_FENCE();
    }
}
template <class RowSrc, class Epi, int PROBE = 0>
DI void gemm_tile_mfma(unsigned char* smem, const RowSrc& rs, const bf16_t* __restrict__ Wt, int K, int n0, const Epi& epi, int tid) {
    const lds_ptr lds = (lds_ptr)smem;
    const int lane = tid & 63, wid = __builtin_amdgcn_readfirstlane(tid >> 6), wm = wid & 1, wn = wid >> 1, r = lane & 31, h = lane >> 5;
    const bool loader = wid < 4;
    const int lw = wid & 3;
    constexpr int NAG = RowSrc::DENSE ? 2 : 8;
    unsigned ag[NAG], bg[2];
    const bf16_t* __restrict__ Ab = rs.A;
#pragma unroll
    for (int j = 0; j < NAG; ++j) {
        const int row = (lw * 8 + j) * 8 + (lane >> 3), c = (lane & 7) ^ ((row >> 1) & 7);
        ag[j] = rs.row(row) + c * 8;
    }
#pragma unroll
    for (int j = 0; j < 2; ++j) {
        const int row = (lw * 8 + j) * 8 + (lane >> 3), c = (lane & 7) ^ ((row >> 1) & 7);
        bg[j] = (unsigned)(n0 + row) * (unsigned)K + c * 8;
    }
    const unsigned astep = 16u * (unsigned)rs.lda, bstep = 16u * (unsigned)K;
    const unsigned dmaoff = (unsigned)lw * 8192u;
    unsigned arow[GEMM_MT], wrow[2], aswz[GEMM_MT], wswz[2];
#pragma unroll
    for (int t = 0; t < GEMM_MT; ++t) { const int ra = wm * 128 + t * 32 + r; arow[t] = ra * 128; aswz[t] = (ra >> 1) & 7; }
#pragma unroll
    for (int t = 0; t < 2; ++t) { const int rw = wn * 64 + t * 32 + r; wrow[t] = 32768 + rw * 128; wswz[t] = (rw >> 1) & 7; }
    f32x16 acc[2][GEMM_MT];
#pragma unroll
    for (int a = 0; a < 2; ++a)
#pragma unroll
        for (int b = 0; b < GEMM_MT; ++b)
#pragma unroll
            for (int i = 0; i < 16; ++i) acc[a][b][i] = 0.f;
    if (loader) {
#pragma unroll
        for (int j = 0; j < 8; ++j) { glds16(Ab + (NAG == 2 ? ag[j & 1] + (j >> 1) * astep : ag[j % NAG]), lds + dmaoff + j * 1024); glds16(Wt + bg[j & 1] + (j >> 1) * bstep, lds + 32768 + dmaoff + j * 1024); }
    }
    asm volatile("s_waitcnt vmcnt(0)" ::: "memory");
    __syncthreads();
    const int KT = K >> 6;
    for (int kt = 0; kt < KT; ++kt) {
        gemm_kstep<PROBE, NAG>(acc, lds + (kt & 1) * GEMM_STAGE, arow, wrow, aswz, wswz, h, loader && kt + 1 < KT, Ab + (kt + 1) * 64, Wt + (kt + 1) * 64, ag, astep, bg, bstep, lds + ((kt + 1) & 1) * GEMM_STAGE + dmaoff);
        asm volatile("s_waitcnt vmcnt(0)" ::: "memory");
        __syncthreads();
    }
    if (PROBE == 0 || acc[0][0][0] == 12345.678f) epi.wave_tile(acc, wm * 128, n0 + wn * 64, lane);
}

template <int EPIK, int PROBE = 0>
DI void gemm_dense(const Params& p, unsigned char* smem, const bf16_t* A, int lda, const bf16_t* Wt, int K, int N, bf16_t* C, int ldc, const float* mod, int bid, int nb, int tid) {
    const int tn = N / GEMM_TN, total = (MROWS / GEMM_TM) * tn;
    for (int t = bid; t < total; t += nb) {
        const int mt = t / tn, nt = t - mt * tn;
        RowDense rs{A, lda, mt * GEMM_TM};
        if (EPIK == 0) { EpiStore e{C, ldc, mt * GEMM_TM}; gemm_tile_mfma<RowDense, EpiStore, PROBE>(smem, rs, Wt, K, nt * GEMM_TN, e, tid); }
        else { EpiResid e{&p, mod, mt * GEMM_TM}; gemm_tile_mfma(smem, rs, Wt, K, nt * GEMM_TN, e, tid); }
    }
}
template <int WHICH>
DI void gemm_moe(const Params& p, unsigned char* smem, int layer, int bid, int nb, int tid) {
    const unsigned* cnt = (const unsigned*)(p.ws + WS_CTL) + CW_CNT + layer * 32;
    const unsigned* list = (const unsigned*)(p.ws + WS_LIST);
    const float* gates = (const float*)(p.ws + WS_GATE);
    const bf16_t* H = (const bf16_t*)(p.ws + WS_H);
    bf16_t* act = (bf16_t*)(p.ws + WS_Q);
    bf16_t* eo = (bf16_t*)(p.ws + WS_RAW);
    constexpr int TN = WHICH == 0 ? 2 : 4;
    int total = 0;
    for (int e = 0; e < NEXP; ++e) total += (int)((cnt[e] + 255u) >> 8) * TN;
    for (int t = bid; t < total; t += nb) {
        int e = 0, rem = t;
        for (; e < NEXP; ++e) { const int te = (int)((cnt[e] + 255u) >> 8) * TN; if (rem < te) break; rem -= te; }
        const int rt = rem / TN, ct = rem - rt * TN;
        const unsigned* ent = list + (size_t)e * MROWS + rt * GEMM_TM;
        const int valid = min(GEMM_TM, (int)cnt[e] - rt * GEMM_TM);
        if (WHICH == 0) {
            RowGather rs{H, 1024, ent, valid, 1};
            EpiGlu ep{act, ent, gates, valid};
            gemm_tile_mfma(smem, rs, (const bf16_t*)(p.ws + W_GU) + ((size_t)layer * 32 + e) * 512 * 1024, 1024, ct * GEMM_TN, ep, tid);
        } else {
            RowGather rs{act, DEXP, ent, valid, 0};
            EpiScatter ep{eo, ent, valid};
            gemm_tile_mfma(smem, rs, (const bf16_t*)(p.ws + W_DN) + ((size_t)layer * 32 + e) * 1024 * 256, 256, ct * GEMM_TN, ep, tid);
        }
    }
}

DI float quad_sum(float v) { v += __shfl_xor(v, 1); v += __shfl_xor(v, 2); return v; }
DI void head64_norm_rope(const bf16_t* src, bf16_t* dst, const float* gain, int sub, bool rope, int prow, int pcol, float scale) {
    float a[8], b[8];
    unpack8(*(const u32x4*)(src + sub * 8), a); unpack8(*(const u32x4*)(src + 32 + sub * 8), b);
    float ss = 0.f;
#pragma unroll
    for (int e = 0; e < 8; ++e) ss += a[e] * a[e] + b[e] * b[e];
    ss = quad_sum(ss);
    const float rs = rsqrtf(ss * (1.0f / 64.0f) + EPS);
#pragma unroll
    for (int e = 0; e < 8; ++e) { a[e] *= rs * gain[sub * 8 + e]; b[e] *= rs * gain[32 + sub * 8 + e]; }
    if (rope) {
#pragma unroll
        for (int e = 0; e < 8; ++e) {
            const int i = sub * 8 + e;
            const float* cs = ROPE64 + ((i < 16 ? prow : pcol) * 16 + (i & 15)) * 2;
            const float c = cs[0], s = cs[1], x1 = a[e], x2 = b[e];
            a[e] = x1 * c - x2 * s; b[e] = x2 * c + x1 * s;
        }
    }
#pragma unroll
    for (int e = 0; e < 8; ++e) { a[e] *= scale; b[e] *= scale; }
    *(u32x4*)(dst + sub * 8) = pack8(a); *(u32x4*)(dst + 32 + sub * 8) = pack8(b);
}
template <int KIND>
DI void phase_post_qk(const Params& p, int bid, int nb, int tid) {
    const int wid = __builtin_amdgcn_readfirstlane(tid >> 6), lane = tid & 63, hd = lane >> 2, sub = lane & 3;
    constexpr int NRAW = KIND == 1 ? 1536 : 3072, KH = KIND == 1 ? 4 : 16;
    const bf16_t* raw = (const bf16_t*)(p.ws + WS_RAW);
    bf16_t* Q = (bf16_t*)(p.ws + WS_Q); bf16_t* Kb = (bf16_t*)(p.ws + WS_K);
    const float* qn = p.in[KIND == 0 ? 15 : KIND == 1 ? 20 : 32];
    const float* kn = p.in[KIND == 0 ? 16 : KIND == 1 ? 21 : 33];
    const float qscale = 0.125f * LOG2E;
    for (int r = bid * NW + wid; r < MROWS; r += nb * NW) {
        const int b = r / PP, pos = r - b * PP;
        const bool rope = (KIND != 0) && pos < SEQ;
        const int prow = (pos >> 6) & 63, pcol = pos & 63;
        const bf16_t* rr = raw + (size_t)r * NRAW;
        head64_norm_rope(rr + hd * 64, Q + (size_t)r * 1024 + hd * 64, qn, sub, rope, prow, pcol, qscale);
        if (hd < KH) head64_norm_rope(rr + 1024 + hd * 64, Kb + (size_t)r * (KH * 64) + hd * 64, kn, sub, rope, prow, pcol, 1.0f);
    }
}
DI void phase_post_mla1(const Params& p, int bid, int nb, int tid) {
    const int wid = __builtin_amdgcn_readfirstlane(tid >> 6), lane = tid & 63;
    const bf16_t* raw = (const bf16_t*)(p.ws + WS_Q);
    bf16_t* cqn = (bf16_t*)(p.ws + WS_O);
    bf16_t* ckvn = cqn + (size_t)MROWS * 384;
    bf16_t* krope = ckvn + (size_t)MROWS * 256;
    const float* qa = p.in[24]; const float* kva = p.in[25]; const float* kn = p.in[29];
    for (int r = bid * NW + wid; r < MROWS; r += nb * NW) {
        const int b = r / PP, pos = r - b * PP;
        const bf16_t* rr = raw + (size_t)r * 768;
        {
            float v[8];
#pragma unroll
            for (int j = 0; j < 8; ++j) v[j] = 0.f;
            if (lane < 48) unpack8(*(const u32x4*)(rr + lane * 8), v);
            float ss = 0.f;
#pragma unroll
            for (int j = 0; j < 8; ++j) ss += v[j] * v[j];
            ss = wave_sum(ss);
            const float rs = rsqrtf(ss * (1.0f / 384.0f) + EPS);
            if (lane < 48) {
#pragma unroll
                for (int j = 0; j < 8; ++j) v[j] *= rs * qa[lane * 8 + j];
            }
            u32x2 o; o.x = cvt_fp8x4(v[0], v[1], v[2], v[3]); o.y = cvt_fp8x4(v[4], v[5], v[6], v[7]);
            *(u32x2*)((unsigned char*)cqn + (size_t)r * 512 + lane * 8) = o;
        }
        {
            const u32x2 w = *(const u32x2*)(rr + 384 + lane * 4);
            float v[4] = {bflo(w.x), bfhi(w.x), bflo(w.y), bfhi(w.y)};
            float ss = v[0] * v[0] + v[1] * v[1] + v[2] * v[2] + v[3] * v[3];
            ss = wave_sum(ss);
            const float rs = rsqrtf(ss * (1.0f / 256.0f) + EPS);
            *(unsigned*)((unsigned char*)cqn + (size_t)MROWS * 512 + (size_t)r * 256 + lane * 4) = cvt_fp8x4(v[0] * rs * kva[lane * 4], v[1] * rs * kva[lane * 4 + 1], v[2] * rs * kva[lane * 4 + 2], v[3] * rs * kva[lane * 4 + 3]);
        }
        {
            float x1 = 0.f, x2 = 0.f;
            if (lane < 16) { x1 = bf2f(rr[640 + lane]); x2 = bf2f(rr[640 + 16 + lane]); }
            float ss = wave_sum(x1 * x1 + x2 * x2);
            const float rs = rsqrtf(ss * (1.0f / 32.0f) + EPS);
            if (lane < 16) {
                x1 *= rs * kn[64 + lane]; x2 *= rs * kn[64 + 16 + lane];
                if (pos < SEQ) {
                    const int prow = (pos >> 6) & 63, pcol = pos & 63;
                    const float* cs = ROPE32 + ((lane < 8 ? prow : pcol) * 8 + (lane & 7)) * 2;
                    const float c = cs[0], s = cs[1], a = x1, bb = x2;
                    x1 = a * c - bb * s; x2 = bb * c + a * s;
                }
            }
            {
                const int hh = lane >> 2, q = lane & 3;
                float vals[8];
#pragma unroll
                for (int j = 0; j < 8; ++j) { const int src = (8 * q + j) & 15; const float a = __shfl(x1, src), bb = __shfl(x2, src); vals[j] = q < 2 ? a : bb; }
                bf16_t* kr = (bf16_t*)(p.ws + WS_K) + (size_t)r * 1536 + 64;
                *(u32x4*)(kr + hh * 96 + 8 * q) = pack8(vals);
            }
        }
    }
}
DI void phase_post_mla2(const Params& p, int bid, int nb, int tid) {
    const int wid = __builtin_amdgcn_readfirstlane(tid >> 6), lane = tid & 63, hd = lane >> 2, sub = lane & 3;
    const bf16_t* qraw = (const bf16_t*)(p.ws + WS_RAW);
    const bf16_t* kvraw = qraw + (size_t)MROWS * 1536;
    const bf16_t* krope = (const bf16_t*)(p.ws + WS_O) + (size_t)MROWS * 640;
    bf16_t* Q = (bf16_t*)(p.ws + WS_Q); bf16_t* Kb = (bf16_t*)(p.ws + WS_K);
    const float* qn = p.in[28]; const float* kn = p.in[29];
    const float qscale = 0.10206207261596577f * LOG2E;
    for (int r = bid * NW + wid; r < MROWS; r += nb * NW) {
        const int b = r / PP, pos = r - b * PP;
        const bf16_t* qr = qraw + (size_t)r * 1536 + hd * 96;
        bf16_t* qo = Q + (size_t)r * 1536 + hd * 96;
        {
            float a[8], c[8];
            unpack8(*(const u32x4*)(qr + sub * 16), a); unpack8(*(const u32x4*)(qr + sub * 16 + 8), c);
            float ss = 0.f;
#pragma unroll
            for (int e = 0; e < 8; ++e) ss += a[e] * a[e] + c[e] * c[e];
            ss = quad_sum(ss);
            const float rs = rsqrtf(ss * (1.0f / 64.0f) + EPS) * qscale;
#pragma unroll
            for (int e = 0; e < 8; ++e) { a[e] *= rs * qn[sub * 16 + e]; c[e] *= rs * qn[sub * 16 + 8 + e]; }
            *(u32x4*)(qo + sub * 16) = pack8(a); *(u32x4*)(qo + sub * 16 + 8) = pack8(c);
        }
        {
            const u32x2 w1 = *(const u32x2*)(qr + 64 + sub * 4), w2 = *(const u32x2*)(qr + 64 + 16 + sub * 4);
            float x1[4] = {bflo(w1.x), bfhi(w1.x), bflo(w1.y), bfhi(w1.y)}, x2[4] = {bflo(w2.x), bfhi(w2.x), bflo(w2.y), bfhi(w2.y)};
            float ss = 0.f;
#pragma unroll
            for (int e = 0; e < 4; ++e) ss += x1[e] * x1[e] + x2[e] * x2[e];
            ss = quad_sum(ss);
            const float rs = rsqrtf(ss * (1.0f / 32.0f) + EPS);
#pragma unroll
            for (int e = 0; e < 4; ++e) {
                const int i = sub * 4 + e;
                float a = x1[e] * rs * qn[64 + i], bb = x2[e] * rs * qn[64 + 16 + i];
                if (pos < SEQ) {
                    const int prow = (pos >> 6) & 63, pcol = pos & 63;
                    const float* cs = ROPE32 + ((i < 8 ? prow : pcol) * 8 + (i & 7)) * 2;
                    const float c = cs[0], s = cs[1], t1 = a, t2 = bb;
                    a = t1 * c - t2 * s; bb = t2 * c + t1 * s;
                }
                x1[e] = a * qscale; x2[e] = bb * qscale;
            }
            u32x2 o1, o2; o1.x = pk2(x1[0], x1[1]); o1.y = pk2(x1[2], x1[3]); o2.x = pk2(x2[0], x2[1]); o2.y = pk2(x2[2], x2[3]);
            *(u32x2*)(qo + 64 + sub * 4) = o1; *(u32x2*)(qo + 64 + 16 + sub * 4) = o2;
        }
        {
            const bf16_t* kr = kvraw + (size_t)r * 2048 + hd * 128;
            bf16_t* ko = Kb + (size_t)r * 1536 + hd * 96;
            float a[8], c[8];
            unpack8(*(const u32x4*)(kr + sub * 16), a); unpack8(*(const u32x4*)(kr + sub * 16 + 8), c);
            float ss = 0.f;
#pragma unroll
            for (int e = 0; e < 8; ++e) ss += a[e] * a[e] + c[e] * c[e];
            ss = quad_sum(ss);
            const float rs = rsqrtf(ss * (1.0f / 64.0f) + EPS);
#pragma unroll
            for (int e = 0; e < 8; ++e) { a[e] *= rs * kn[sub * 16 + e]; c[e] *= rs * kn[sub * 16 + 8 + e]; }
            *(u32x4*)(ko + sub * 16) = pack8(a); *(u32x4*)(ko + sub * 16 + 8) = pack8(c);
            *(u32x4*)(ko + 64 + sub * 8) = *(const u32x4*)(krope + (size_t)r * 32 + sub * 8);
        }
    }
}
DI void phase_diff_combine(const Params& p, int bid, int nb, int tid) {
    const int wid = __builtin_amdgcn_readfirstlane(tid >> 6), lane = tid & 63, hd = lane >> 3, sub = lane & 7;
    const bf16_t* O12 = (const bf16_t*)(p.ws + WS_H);
    bf16_t* Oc = (bf16_t*)(p.ws + WS_Q);
    const float* lam = p.in[34]; const float* subln = p.in[35];
    const float lambda_init = 0.8f - 0.6f * 0.40656965974059917f;
    const float s1 = wave_sum(lam[lane] * lam[64 + lane]), s2 = wave_sum(lam[128 + lane] * lam[192 + lane]);
    const float lam_full = expf(s1) - expf(s2) + lambda_init;
    for (int r = bid * NW + wid; r < MROWS; r += nb * NW) {
        const bf16_t* o1 = O12 + (size_t)r * 2048 + (2 * hd) * 128 + sub * 16, *o2 = o1 + 128;
        float a[16], c[16];
        unpack8(*(const u32x4*)o1, *(float(*)[8])a); unpack8(*(const u32x4*)(o1 + 8), *(float(*)[8])(a + 8));
        unpack8(*(const u32x4*)o2, *(float(*)[8])c); unpack8(*(const u32x4*)(o2 + 8), *(float(*)[8])(c + 8));
        float ss = 0.f;
#pragma unroll
        for (int e = 0; e < 16; ++e) { a[e] -= lam_full * c[e]; ss += a[e] * a[e]; }
        ss += __shfl_xor(ss, 1); ss += __shfl_xor(ss, 2); ss += __shfl_xor(ss, 4);
        const float rs = rsqrtf(ss * (1.0f / 128.0f) + EPS) * (1.0f - lambda_init);
#pragma unroll
        for (int e = 0; e < 16; ++e) a[e] *= rs * subln[sub * 16 + e];
        bf16_t* o = Oc + (size_t)r * 1024 + hd * 128 + sub * 16;
        *(u32x4*)o = pack8(*(float(*)[8])a); *(u32x4*)(o + 8) = pack8(*(float(*)[8])(a + 8));
    }
}


typedef short s16x4 __attribute__((ext_vector_type(4)));
typedef float f32x2_t __attribute__((ext_vector_type(2)));
typedef __bf16 bf16x2_t __attribute__((ext_vector_type(2)));
DI unsigned cvtpk(float lo, float hi) { f32x2_t v = {lo, hi}; bf16x2_t b = __builtin_convertvector(v, bf16x2_t); return __builtin_bit_cast(unsigned, b); }
DI float xhalf_max(float v) { auto rr = __builtin_amdgcn_permlane32_swap(__float_as_uint(v), __float_as_uint(v), false, false); return fmaxf(__uint_as_float(rr[0]), __uint_as_float(rr[1])); }
DI float xhalf_sum(float v) { auto rr = __builtin_amdgcn_permlane32_swap(__float_as_uint(v), __float_as_uint(v), false, false); return __uint_as_float(rr[0]) + __uint_as_float(rr[1]); }
typedef short v4i16_t __attribute__((__vector_size__(4 * sizeof(short))));
DI s16x4 lds_tr(lds_ptr p) { return __builtin_bit_cast(s16x4, __builtin_amdgcn_ds_read_tr16_b64_v4i16((LAS v4i16_t*)p)); }
constexpr float ATT_BIG = 40.0f, ATT_BIGF = 1.0995116e12f;
DI int crow(int i, int hf) { return (i & 3) + 8 * (i >> 2) + 4 * hf; }

struct AttnP { const bf16_t* Q; int ldq; const bf16_t* K; int ldk; const bf16_t* V; int ldv; bf16_t* O; int ldo; int HQ; int gk; int gv; int vhs  ; const float* bias; const float* sink; int need_ctx; const float* kgain  ; const float* lam; const float* subln; unsigned char* Oc; int ldoc;   };

template <int DQ, int DV, int MODE, int ABL = 0>
DI void attn_mfma(const AttnP& a, unsigned char* smem, int bid, int nb, int tid) {
    constexpr int KSTR = DQ * 2 + 16, KTB = 64 * KSTR, VTB = 64 * DV * 2, NDB = DV / 32, NKK = DQ / 16;
    constexpr int KCH = DQ / 8, VCH = DV / 8, NKI = (64 * KCH + NTHREADS - 1) / NTHREADS, NVI = (64 * VCH + NTHREADS - 1) / NTHREADS;
    static_assert(2 * KTB + 2 * VTB + 2048 <= GEMM_LDS, "attention LDS");
    const lds_ptr lds = (lds_ptr)smem;
    LAS float* biasl = (LAS float*)(lds + 2 * KTB + 2 * VTB);
    const int lane = tid & 63, wid = __builtin_amdgcn_readfirstlane(tid >> 6), r = lane & 31, hf = lane >> 5;
    const int nq = a.need_ctx ? 17 : 16;
    const int xcd = bid & 7, slot = bid >> 3, nslots = nb >> 3, per_xcd = (NBATCH * a.HQ / 8) * nq;
    int koff[NKI], kdst[NKI], voff[NVI], vdst[NVI];
#pragma unroll
    for (int i = 0; i < NKI; ++i) { const int c = min(tid + NTHREADS * i, 64 * KCH - 1), row = c / KCH, kc = c - row * KCH; koff[i] = row * a.ldk + kc * 8; kdst[i] = row * KSTR + kc * 16; }
#pragma unroll
    for (int i = 0; i < NVI; ++i) { const int c = tid + NTHREADS * i, row = c / VCH, vc = c - row * VCH; voff[i] = row * a.ldv + vc * 8; vdst[i] = ((row >> 3) * NDB + (vc >> 2)) * 512 + (row & 7) * 64 + (vc & 3) * 16; }
    const int i16 = lane & 15, trq = i16 >> 2, trp = i16 & 3, grp = (lane >> 4) & 1;
    const int vtr0 = (4 * hf + trq) * 64 + 32 * grp + 8 * trp;
    constexpr bool PAIRED = (MODE == 2 && DV == 128);
    float lam_full = 0.f;
    if (PAIRED) { const float s1 = wave_sum(a.lam[lane] * a.lam[64 + lane]), s2 = wave_sum(a.lam[128 + lane] * a.lam[192 + lane]); lam_full = expf(s1) - expf(s2) + (0.8f - 0.6f * 0.40656965974059917f); }
    int it_i = 0;
    for (int j = slot; j < per_xcd; j += nslots, ++it_i) {
        const int nbh = NBATCH * a.HQ / 8;
        const int bhl = j < nbh * 16 ? j >> 4 : j - nbh * 16;
        int qt = j < nbh * 16 ? j & 15 : 16;
        int bh = bhl * 8 + xcd;
        if (MODE == 1) { const int P = (bhl >> 2) * 8 + xcd; bh = (P >> 2) * a.HQ + (P & 3) * 4 + (bhl & 3); }
        if (PAIRED) { const int pu = slot + nslots * (it_i >> 1); qt = pu & 15; bh = (pu >> 4) * a.HQ + 2 * xcd + (it_i & 1); }
        const int h = bh % a.HQ, b = bh / a.HQ;
        const bool is_ctx = qt >= 16;
        const int q0 = is_ctx ? SEQ : qt * 256;
        int t_lo = 0, n_lat = 0;
        if (!is_ctx) {
            if (MODE == 2) { t_lo = 0; n_lat = 64; }
            else if (MODE == 1) { t_lo = max(0, 4 * qt - 2); n_lat = min(63, 4 * qt + 5) - t_lo + 1; }
            else { const int r0 = 4 * qt; t_lo = min(max(r0 - 4, 0), 56); n_lat = min(max(r0 - 1, 0), 56) + 7 - t_lo + 1; }
        }
        const int ntiles = n_lat + 4;
        const int qw0 = q0 + wid * 32, qpos = qw0 + r;
        const size_t qrow = (size_t)b * PP + qpos;
        bf16x8 qf[NKK];
#pragma unroll
        for (int kk = 0; kk < NKK; ++kk) qf[kk] = *(const bf16x8*)(a.Q + qrow * a.ldq + h * DQ + kk * 16 + hf * 8);
        if (MODE == 0 && !is_ctx) { for (int i = tid; i < 465; i += NTHREADS) biasl[i] = a.bias[h * 465 + i] * LOG2E; }
        const bf16_t* Kg = a.K + (size_t)b * PP * a.ldk + (h >> a.gk) * DQ;
        const bf16_t* Vg = a.V + (size_t)b * PP * a.ldv + (h >> a.gv) * a.vhs;
        f32x16 o[NDB];
#pragma unroll
        for (int d = 0; d < NDB; ++d)
#pragma unroll
            for (int i = 0; i < 16; ++i) o[d][i] = 0.f;
        float mref = 0.f, l = 0.f;
        f32x16 negm;
#pragma unroll
        for (int i = 0; i < 16; ++i) negm[i] = 0.f;
        bool first = true;
        float lbig = 0.f;
        float one = 1.0f; asm volatile("" : "+v"(one));
#define ATT_TILE(IT) ((IT) < n_lat ? t_lo + (IT) : 64 + ((IT) - n_lat))
        auto tile_active = [&](int t) -> bool {
            if (t >= 64) return true;
            if (MODE == 1) return (t * 64 + 63 >= qw0 - 128) && (t * 64 <= qw0 + 31 + 128);
            if (MODE == 0) { const int rw = qw0 >> 6, row0 = min(max(rw - 4, 0), 56); return t >= row0 && t < row0 + 8; }
            return true;
        };
        auto qk = [&](f32x16 (&s)[2], const lds_ptr Kb) {
#pragma unroll
            for (int kk = 0; kk < NKK; ++kk)
#pragma unroll
                for (int kb = 0; kb < 2; ++kb) {
                    if (ABL & 4) { if (kk == 0) s[kb] = negm; }
                    else {
                    const bf16x8 kf = *(const LAS bf16x8*)(Kb + (kb * 32 + r) * KSTR + (kk * 2 + hf) * 16);
                    s[kb] = MFMA32(kf, qf[kk], kk == 0 ? negm : s[kb]);
                    }
                }
        };
        u32x4 kr[NKI], vr[NVI];
        {
            const int t0 = ATT_TILE(0), t1 = ATT_TILE(1);
            u32x4 k1[NKI];
#pragma unroll
            for (int i = 0; i < NKI; ++i) kr[i] = *(const u32x4*)(Kg + (size_t)t0 * 64 * a.ldk + koff[i]);
#pragma unroll
            for (int i = 0; i < NVI; ++i) vr[i] = *(const u32x4*)(Vg + (size_t)t0 * 64 * a.ldv + voff[i]);
#pragma unroll
            for (int i = 0; i < NKI; ++i) k1[i] = *(const u32x4*)(Kg + (size_t)t1 * 64 * a.ldk + koff[i]);
#pragma unroll
            for (int i = 0; i < NKI; ++i) { *(LAS u32x4*)(lds + kdst[i]) = kr[i]; *(LAS u32x4*)(lds + KTB + kdst[i]) = k1[i]; }
#pragma unroll
            for (int i = 0; i < NVI; ++i) *(LAS u32x4*)(lds + 2 * KTB + vdst[i]) = vr[i];
        }
        __syncthreads();
        f32x16 sc[2], sn[2];
        bool act_cur = tile_active(ATT_TILE(0)), act_nxt = false;
        if (act_cur) qk(sc, lds);
        __syncthreads();
        auto step = [&](const int it, const int e, const bool N2, const bool N1) {
            const int t = ATT_TILE(it);
            if (N2 && !(ABL & 8) && (!(ABL & 128) || e)) {
                const int tn = ATT_TILE(it + 2);
#pragma unroll
                for (int i = 0; i < NKI; ++i) kr[i] = *(const u32x4*)(Kg + (size_t)tn * 64 * a.ldk + koff[i]);
            }
            if (N1 && !(ABL & 8) && (!(ABL & 128) || e)) {
                const int tn = ATT_TILE(it + 1);
#pragma unroll
                for (int i = 0; i < NVI; ++i) vr[i] = *(const u32x4*)(Vg + (size_t)tn * 64 * a.ldv + voff[i]);
            }
            SCHED_FENCE();
            act_nxt = N1 && (MODE == 2 || tile_active(ATT_TILE(it + 1)));
            const lds_ptr Vb = lds + 2 * KTB + e * VTB;
            const bool do_cur = MODE == 2 || act_cur;
            if (do_cur) {
                if (t < 64 && MODE == 1 && !((t * 64 + 63 - qw0 <= 128) && (qw0 + 31 - t * 64 <= 128))) {
                    const int dbase = t * 64 + 4 * hf - qpos;
#pragma unroll
                    for (int kb = 0; kb < 2; ++kb)
#pragma unroll
                        for (int i = 0; i < 16; ++i) { const int c = kb * 32 + (i & 3) + 8 * (i >> 2); sc[kb][i] = (dbase > 128 - c || dbase < -128 - c) ? -INFINITY : sc[kb][i]; }
                }
                if (t < 64 && MODE == 0) {
                    const int qc = qpos & 63, rw = qpos >> 6, col0 = min(max(qc - 8, 0), 48);
                    const int brow = (t - rw + 7) * 31 + 15 - qc;
#pragma unroll
                    for (int kb = 0; kb < 2; ++kb)
#pragma unroll
                        for (int i = 0; i < 16; ++i) {
                            const int kc = kb * 32 + crow(i, hf);
                            const bool ok = kc >= col0 && kc < col0 + 16;
                            const float bv = biasl[ok ? brow + kc : 0];
                            sc[kb][i] = ok ? sc[kb][i] + bv : -INFINITY;
                        }
                }
                if (first || __builtin_amdgcn_ballot_w64(lbig > ATT_BIGF) != 0ull) {
                    float delta = lbig > ATT_BIGF ? ATT_BIG : 0.f;
                    if (first) {
                        float mx = sc[0][0];
#pragma unroll
                        for (int i = 1; i < 16; ++i) mx = fmaxf(mx, sc[0][i]);
#pragma unroll
                        for (int i = 0; i < 16; ++i) mx = fmaxf(mx, sc[1][i]);
                        mx = xhalf_max(mx);
                        delta = mx > -INFINITY ? mx : 0.f;
                    }
                    const float alpha = __builtin_amdgcn_exp2f(-delta);
                    l *= alpha; mref += delta;
#pragma unroll
                    for (int d = 0; d < NDB; ++d)
#pragma unroll
                        for (int i = 0; i < 16; ++i) o[d][i] *= alpha;
#pragma unroll
                    for (int kb = 0; kb < 2; ++kb)
#pragma unroll
                        for (int i = 0; i < 16; ++i) sc[kb][i] -= delta;
#pragma unroll
                    for (int i = 0; i < 16; ++i) negm[i] = -mref;
                    first = false;
                }
            }
            if (N1) qk(sn, lds + (e ^ 1) * KTB);
            if (do_cur) {
                float ls0 = 0.f, ls1 = 0.f;
#pragma unroll
                for (int kb = 0; kb < 2; ++kb)
#pragma unroll
                    for (int i = 0; i < 16; i += 2) {
                        const float p0 = (ABL & 1) ? sc[kb][i] : __builtin_amdgcn_exp2f(sc[kb][i]), p1 = (ABL & 1) ? sc[kb][i + 1] : __builtin_amdgcn_exp2f(sc[kb][i + 1]);
                        sc[kb][i] = p0; sc[kb][i + 1] = p1;
                        if (!(ABL & 16)) { ls0 += p0; ls1 = __builtin_fmaf(p1, one, ls1); }
                    }
                lbig = ls0 + ls1;
                l += lbig;
                bf16x8 pf[4];
#pragma unroll
                for (int kb = 0; kb < 2; ++kb)
#pragma unroll
                    for (int sp = 0; sp < 2; ++sp) {
                        u32x4 w;
                        w.x = cvtpk(sc[kb][8 * sp], sc[kb][8 * sp + 1]); w.y = cvtpk(sc[kb][8 * sp + 2], sc[kb][8 * sp + 3]);
                        w.z = cvtpk(sc[kb][8 * sp + 4], sc[kb][8 * sp + 5]); w.w = cvtpk(sc[kb][8 * sp + 6], sc[kb][8 * sp + 7]);
                        pf[kb * 2 + sp] = __builtin_bit_cast(bf16x8, w);
                    }
#pragma unroll
                for (int ks = 0; ks < 4; ++ks)
#pragma unroll
                    for (int d = 0; d < NDB; ++d) {
                        const lds_ptr vp = Vb + ((2 * ks) * NDB + d) * 512 + vtr0;
                        const s16x4 lo = lds_tr(vp), hi = lds_tr(vp + NDB * 512);
                        const bf16x8 vf = __builtin_shufflevector(lo, hi, 0, 1, 2, 3, 4, 5, 6, 7);
                        if (ABL & 2) { if (d == 0 && ks == 0) o[0][0] += __builtin_bit_cast(float, pf[0][0] | pf[1][0] | pf[2][0] | pf[3][0]) + __builtin_bit_cast(float, (int)vf[0]); } else
                        o[d] = MFMA32(vf, pf[ks], o[d]);
                    }
            }
            SCHED_FENCE();
            if (N2 && !(ABL & 8) && (!(ABL & 128) || e)) {
#pragma unroll
                for (int i = 0; i < NKI; ++i) *(LAS u32x4*)(lds + e * KTB + kdst[i]) = kr[i];
            }
            if (N1 && !(ABL & 8) && (!(ABL & 128) || e)) {
#pragma unroll
                for (int i = 0; i < NVI; ++i) *(LAS u32x4*)(lds + 2 * KTB + (e ^ 1) * VTB + vdst[i]) = vr[i];
            }
            if (!(ABL & 64) && (!(ABL & 128) || e)) __syncthreads();
#pragma unroll
            for (int kb = 0; kb < 2; ++kb) sc[kb] = sn[kb];
            act_cur = act_nxt;
        };
        int it = 0;
        for (; it + 3 < ntiles; it += 2) { step(it, 0, true, true); step(it + 1, 1, true, true); }
        if (ntiles - it == 3) { step(it, 0, true, true); step(it + 1, 1, false, true); step(it + 2, 0, false, false); }
        else { step(it, 0, false, true); step(it + 1, 1, false, false); }
#undef ATT_TILE
        l = xhalf_sum(l);
        if (a.sink) {
            l += __builtin_amdgcn_exp2f(a.sink[h] * LOG2E - mref);
        }
        const float inv = 1.0f / l;
        bf16_t* orow = a.O + qrow * a.ldo + h * DV + 4 * hf;
#pragma unroll
        for (int d = 0; d < NDB; ++d)
#pragma unroll
            for (int g = 0; g < 4; ++g) {
                if (DV == 64) {
                    *(unsigned*)((unsigned char*)a.O + qrow * a.ldo + h * DV + 4 * hf + d * 32 + 8 * g) = cvt_fp8x4(o[d][4 * g] * inv, o[d][4 * g + 1] * inv, o[d][4 * g + 2] * inv, o[d][4 * g + 3] * inv);
                } else {
                    u32x2 w; w.x = cvtpk(o[d][4 * g] * inv, o[d][4 * g + 1] * inv); w.y = cvtpk(o[d][4 * g + 2] * inv, o[d][4 * g + 3] * inv);
                    *(u32x2*)(orow + d * 32 + 8 * g) = w;
                }
            }
        if (PAIRED && (it_i & 1)) {
            asm volatile("s_waitcnt vmcnt(0)" ::: "memory");
            const float lambda_init = 0.8f - 0.6f * 0.40656965974059917f;
            const int sub = lane & 7, pair = h >> 1;
#pragma unroll
            for (int i4 = 0; i4 < 4; ++i4) {
                const size_t row = (size_t)b * PP + qw0 + i4 * 8 + (lane >> 3);
                const bf16_t* o1 = a.O + row * a.ldo + (2 * pair) * 128 + sub * 16, *o2 = o1 + 128;
                float av[16], cv[16];
                unpack8(*(const u32x4*)o1, *(float(*)[8])av); unpack8(*(const u32x4*)(o1 + 8), *(float(*)[8])(av + 8));
                unpack8(*(const u32x4*)o2, *(float(*)[8])cv); unpack8(*(const u32x4*)(o2 + 8), *(float(*)[8])(cv + 8));
                float ss = 0.f;
#pragma unroll
                for (int e = 0; e < 16; ++e) { av[e] -= lam_full * cv[e]; ss += av[e] * av[e]; }
                ss += __shfl_xor(ss, 1); ss += __shfl_xor(ss, 2); ss += __shfl_xor(ss, 4);
                const float rs = rsqrtf(ss * (1.0f / 128.0f) + EPS) * (1.0f - lambda_init);
#pragma unroll
                for (int e = 0; e < 16; ++e) av[e] *= rs * a.subln[sub * 16 + e];
                u32x4 w8; w8.x = cvt_fp8x4(av[0], av[1], av[2], av[3]); w8.y = cvt_fp8x4(av[4], av[5], av[6], av[7]); w8.z = cvt_fp8x4(av[8], av[9], av[10], av[11]); w8.w = cvt_fp8x4(av[12], av[13], av[14], av[15]);
                *(u32x4*)(a.Oc + row * (size_t)a.ldoc + pair * 128 + sub * 16) = w8;
            }
        }
    }
}

DI void attn_na(const AttnP& a, unsigned char* smem, int bid, int nb, int tid) {
    constexpr int DQ = 64, DV = 64, KSTR = DQ * 2 + 16, KTB = 64 * KSTR, VTB = 64 * DV * 2, NDB = 2, NKK = 4;
    const lds_ptr lds = (lds_ptr)smem;
    constexpr int BZ_TAB = 32, BZ_HEAD = 560, BZ_NINF = 16 * BZ_HEAD, BZ_N = BZ_NINF + 64;
    static_assert(4 * KTB + 4 * VTB + (BZ_N + 16) * 4 <= GEMM_LDS, "NA LDS");
    LAS float* biasl = (LAS float*)(lds + 4 * KTB + 4 * VTB);
    for (int i = tid; i < BZ_N; i += NTHREADS) {
        const int hh = i / BZ_HEAD, o = i - hh * BZ_HEAD;
        biasl[i] = i >= BZ_NINF ? -INFINITY : (o >= BZ_TAB && o < BZ_TAB + 465) ? a.bias[hh * 465 + o - BZ_TAB] * LOG2E : 0.f;
    }
    __syncthreads();
    {
        const int wv = __builtin_amdgcn_readfirstlane(tid >> 6), ln = tid & 63;
#pragma unroll
        for (int hh2 = 0; hh2 < 2; ++hh2) {
            const int hh = 2 * wv + hh2;
            float m = 0.f;
            for (int i = ln; i < 465; i += 64) m = fmaxf(m, biasl[hh * BZ_HEAD + BZ_TAB + i]);
#pragma unroll
            for (int d = 32; d >= 1; d >>= 1) m = fmaxf(m, __shfl_xor(m, d));
            if (ln == 0) biasl[BZ_N + hh] = m;
        }
    }
    float kmax = fabsf(a.kgain[tid & 63]);
#pragma unroll
    for (int d = 32; d >= 1; d >>= 1) kmax = fmaxf(kmax, __shfl_xor(kmax, d));
    kmax *= 8.0f * 1.01f;
    const int lane = tid & 63, wid = __builtin_amdgcn_readfirstlane(tid >> 6), r = lane & 31, hf = lane >> 5;
    const int nq = a.need_ctx ? 17 : 16;
    const int xcd = bid & 7, slot = bid >> 3, nslots = nb >> 3, per_xcd = (NBATCH * a.HQ / 8) * nq;
    const int krow_s = tid >> 3, kc_s = tid & 7;
    const int koff = krow_s * a.ldk + kc_s * 8, kdst = krow_s * KSTR + kc_s * 16, voff = krow_s * a.ldv + kc_s * 8;
    const int vdst = ((krow_s >> 3) * NDB + (kc_s >> 2)) * 512 + (krow_s & 7) * 64 + (kc_s & 3) * 16;
    const int i16 = lane & 15, trq = i16 >> 2, trp = i16 & 3, grp = (lane >> 4) & 1;
    const int vtr0 = (4 * hf + trq) * 64 + 32 * grp + 8 * trp;
    const int rp = wid >> 2, cq = wid & 3, k0 = cq == 0 ? 0 : cq == 1 ? 8 : cq == 2 ? 24 : 32;
    float one = 1.0f; asm volatile("" : "+v"(one));
    auto unit_of = [&](int j, int& b, int& h, int& qt, int& t_lo, int& n_lat) {
        const int nbh = NBATCH * a.HQ / 8;
        const int bhl = j < nbh * 16 ? j >> 4 : j - nbh * 16; qt = j < nbh * 16 ? j & 15 : 16;
        const int bh = bhl * 8 + xcd; h = bh % a.HQ; b = bh / a.HQ;
        t_lo = 0; n_lat = 0;
        if (qt < 16) { const int r0 = 4 * qt; t_lo = min(max(r0 - 4, 0), 56); n_lat = min(max(r0 - 1, 0), 56) + 7 - t_lo + 1; n_lat += n_lat & 1; }
    };
#define NA_TILE_OF(IT, TLO, NLAT) ((IT) < (NLAT) ? (TLO) + (IT) : 64 + ((IT) - (NLAT)))
    bf16x8 qf[NKK];
    u32x4 krA[2], vrA[2], krB[2], vrB[2];
    auto load_pair = [&](u32x4 (&kr)[2], u32x4 (&vr)[2], const bf16_t* Kg, const bf16_t* Vg, int t_lo, int n_lat, int pr) {
#pragma unroll
        for (int jj = 0; jj < 2; ++jj) {
            const int tn = NA_TILE_OF(2 * pr + jj, t_lo, n_lat);
            kr[jj] = *(const u32x4*)(Kg + (size_t)tn * 64 * a.ldk + koff); vr[jj] = *(const u32x4*)(Vg + (size_t)tn * 64 * a.ldv + voff);
        }
    };
    auto store_pair = [&](const u32x4 (&kr)[2], const u32x4 (&vr)[2], int e) {
#pragma unroll
        for (int jj = 0; jj < 2; ++jj) { *(LAS u32x4*)(lds + (2 * e + jj) * KTB + kdst) = kr[jj]; *(LAS u32x4*)(lds + 4 * KTB + (2 * e + jj) * VTB + vdst) = vr[jj]; }
    };
    auto qrow_of = [&](int b, int qt) -> size_t { const int qpos = qt >= 16 ? SEQ + wid * 32 + r : (4 * qt + 2 * rp + (r >> 4)) * 64 + 16 * cq + (r & 15); return (size_t)b * PP + qpos; };
    auto load_q = [&](int b, int h, int qt) {
        const size_t qrow = qrow_of(b, qt);
#pragma unroll
        for (int kk = 0; kk < NKK; ++kk) qf[kk] = *(const bf16x8*)(a.Q + qrow * a.ldq + h * DQ + kk * 16 + hf * 8);
    };
    if (slot >= per_xcd) return;
    int b, h, qt, t_lo, n_lat;
    unit_of(slot, b, h, qt, t_lo, n_lat);
    {
        load_q(b, h, qt);
        const bf16_t* Kg = a.K + (size_t)b * PP * a.ldk + h * DQ; const bf16_t* Vg = a.V + (size_t)b * PP * a.ldv + h * a.vhs;
        load_pair(krA, vrA, Kg, Vg, t_lo, n_lat, 0); store_pair(krA, vrA, 0); load_pair(krB, vrB, Kg, Vg, t_lo, n_lat, 1);
    }
    __syncthreads();
    for (int j = slot;;) {
        const int jn = j + nslots; const bool has_next = jn < per_xcd;
        int nb_, nh, nqt, nt_lo, nn_lat;
        unit_of(has_next ? jn : j, nb_, nh, nqt, nt_lo, nn_lat);
        const bf16_t* nKg = a.K + (size_t)nb_ * PP * a.ldk + nh * DQ; const bf16_t* nVg = a.V + (size_t)nb_ * PP * a.ldv + nh * a.vhs;
        const bool is_ctx = qt >= 16;
        const int r0 = 4 * qt;
        const int npair = (n_lat + 4) >> 1;
        const int qrw = r0 + 2 * rp + (r >> 4), qc = 16 * cq + (r & 15);
        const size_t qrow = qrow_of(b, qt);
        const bf16_t* Kg = a.K + (size_t)b * PP * a.ldk + h * DQ;
        const bf16_t* Vg = a.V + (size_t)b * PP * a.ldv + h * a.vhs;
        const int rwA = r0 + 2 * rp, wlo = min(max(rwA - 4, 0), 56), whi = min(max(rwA - 3, 0), 56) + 7;
        const int col0 = min(max(qc - 8, 0), 48), row0q = min(max(qrw - 4, 0), 56);
        const int lanebase = h * BZ_HEAD + BZ_TAB + (7 - qrw) * 31 + 15 - qc + k0 + 4 * hf;
        f32x16 o[NDB];
#pragma unroll
        for (int d = 0; d < NDB; ++d)
#pragma unroll
            for (int i = 0; i < 16; ++i) o[d][i] = 0.f;
        float l = 0.f;
        float qn2 = 0.f;
#pragma unroll
        for (int kk = 0; kk < NKK; ++kk)
#pragma unroll
            for (int jj = 0; jj < 8; ++jj) { const float qv = bf2f((bf16_t)qf[kk][jj]); qn2 = __builtin_fmaf(qv, qv, qn2); }
        qn2 = xhalf_sum(qn2);
        const float mref = __builtin_sqrtf(qn2) * kmax + biasl[BZ_N + h];
        f32x16 negmL;
#pragma unroll
        for (int i = 0; i < 16; ++i) { const int kc = k0 + crow(i, hf); negmL[i] = (kc >= col0 && kc < col0 + 16) ? -mref : -INFINITY; }
#define NA_TILE(IT) NA_TILE_OF(IT, t_lo, n_lat)
        auto ctx_tile = [&](const lds_ptr Kb, const lds_ptr Vb) {
            {
                f32x16 s[2], negm;
#pragma unroll
                for (int i = 0; i < 16; ++i) negm[i] = -mref;
#pragma unroll
                for (int kk = 0; kk < NKK; ++kk)
#pragma unroll
                    for (int kb = 0; kb < 2; ++kb) {
                        const bf16x8 kf = *(const LAS bf16x8*)(Kb + (kb * 32 + r) * KSTR + (kk * 2 + hf) * 16);
                        s[kb] = MFMA32(kf, qf[kk], kk == 0 ? negm : s[kb]);
                    }
                float ls0 = 0.f, ls1 = 0.f;
                bf16x8 pf[4];
#pragma unroll
                for (int kb = 0; kb < 2; ++kb) {
#pragma unroll
                    for (int i = 0; i < 16; i += 2) {
                        const float p0 = __builtin_amdgcn_exp2f(s[kb][i]), p1 = __builtin_amdgcn_exp2f(s[kb][i + 1]);
                        s[kb][i] = p0; s[kb][i + 1] = p1; ls0 += p0; ls1 = __builtin_fmaf(p1, one, ls1);
                    }
#pragma unroll
                    for (int sp = 0; sp < 2; ++sp) {
                        u32x4 w;
                        w.x = cvtpk(s[kb][8 * sp], s[kb][8 * sp + 1]); w.y = cvtpk(s[kb][8 * sp + 2], s[kb][8 * sp + 3]);
                        w.z = cvtpk(s[kb][8 * sp + 4], s[kb][8 * sp + 5]); w.w = cvtpk(s[kb][8 * sp + 6], s[kb][8 * sp + 7]);
                        pf[kb * 2 + sp] = __builtin_bit_cast(bf16x8, w);
                    }
                }
                l += ls0 + ls1;
#pragma unroll
                for (int ks = 0; ks < 4; ++ks)
#pragma unroll
                    for (int d = 0; d < NDB; ++d) {
                        const lds_ptr vp = Vb + ((2 * ks) * NDB + d) * 512 + vtr0;
                        const s16x4 lo = lds_tr(vp), hi = lds_tr(vp + NDB * 512);
                        o[d] = MFMA32(__builtin_shufflevector(lo, hi, 0, 1, 2, 3, 4, 5, 6, 7), pf[ks], o[d]);
                    }
            }
        };
        auto lat_tile = [&](const int t, const lds_ptr Kb, const lds_ptr Vb) {
            bf16x8 pf[2];
#pragma unroll
            for (int sp = 0; sp < 2; ++sp)
#pragma unroll
                for (int jj = 0; jj < 8; ++jj) pf[sp][jj] = 0;
            if (t >= wlo && t <= whi) {
                f32x16 s;
#pragma unroll
                for (int kk = 0; kk < NKK; ++kk) {
                    const bf16x8 kf = *(const LAS bf16x8*)(Kb + (k0 + r) * KSTR + (kk * 2 + hf) * 16);
                    s = MFMA32(kf, qf[kk], kk == 0 ? negmL : s);
                }
                const LAS float* bp = biasl + (((unsigned)(t - row0q) < 8u) ? lanebase + 31 * t : BZ_NINF);
#pragma unroll
                for (int i = 0; i < 16; ++i) s[i] += bp[crow(i, 0)];
                float ls0 = 0.f, ls1 = 0.f;
#pragma unroll
                for (int i = 0; i < 16; i += 2) {
                    const float p0 = __builtin_amdgcn_exp2f(s[i]), p1 = __builtin_amdgcn_exp2f(s[i + 1]);
                    s[i] = p0; s[i + 1] = p1; ls0 += p0; ls1 = __builtin_fmaf(p1, one, ls1);
                }
#pragma unroll
                for (int sp = 0; sp < 2; ++sp) {
                    u32x4 w;
                    w.x = cvtpk(s[8 * sp], s[8 * sp + 1]); w.y = cvtpk(s[8 * sp + 2], s[8 * sp + 3]);
                    w.z = cvtpk(s[8 * sp + 4], s[8 * sp + 5]); w.w = cvtpk(s[8 * sp + 6], s[8 * sp + 7]);
                    pf[sp] = __builtin_bit_cast(bf16x8, w);
                }
                l += ls0 + ls1;
            }
#pragma unroll
            for (int ks = 0; ks < 2; ++ks)
#pragma unroll
                for (int d = 0; d < NDB; ++d) {
                    const lds_ptr vp = Vb + (((k0 >> 3) + 2 * ks) * NDB + d) * 512 + vtr0;
                    const s16x4 lo = lds_tr(vp), hi = lds_tr(vp + NDB * 512);
                    o[d] = MFMA32(__builtin_shufflevector(lo, hi, 0, 1, 2, 3, 4, 5, 6, 7), pf[ks], o[d]);
                }
        };
#define NA_ITER(IP, E, KL, VL, KS, VS, LAT) do { \
            if ((IP) + 2 < npair) load_pair(KL, VL, Kg, Vg, t_lo, n_lat, (IP) + 2); \
            else if (has_next) load_pair(KL, VL, nKg, nVg, nt_lo, nn_lat, (IP) + 2 - npair); \
            SCHED_FENCE(); \
            if (LAT) { lat_tile(t_lo + 2 * (IP), lds + (2 * (E)) * KTB, lds + 4 * KTB + (2 * (E)) * VTB); lat_tile(t_lo + 2 * (IP) + 1, lds + (2 * (E) + 1) * KTB, lds + 4 * KTB + (2 * (E) + 1) * VTB); } \
            else { ctx_tile(lds + (2 * (E)) * KTB, lds + 4 * KTB + (2 * (E)) * VTB); ctx_tile(lds + (2 * (E) + 1) * KTB, lds + 4 * KTB + (2 * (E) + 1) * VTB); } \
            SCHED_FENCE(); \
            if ((IP) + 1 < npair || has_next) store_pair(KS, VS, (E) ^ 1); \
            __syncthreads(); } while (0)
        int ip = 0;
        for (; ip < (n_lat >> 1); ip += 2) { NA_ITER(ip, 0, krA, vrA, krB, vrB, true); NA_ITER(ip + 1, 1, krB, vrB, krA, vrA, true); }
        NA_ITER(ip, 0, krA, vrA, krB, vrB, false); NA_ITER(ip + 1, 1, krB, vrB, krA, vrA, false);
#undef NA_ITER
        if (has_next) load_q(nb_, nh, nqt);
#undef NA_TILE
        l = xhalf_sum(l);
        const float inv = 1.0f / l;
#pragma unroll
        for (int d = 0; d < NDB; ++d)
#pragma unroll
            for (int g = 0; g < 4; ++g)
                *(unsigned*)((unsigned char*)a.O + qrow * a.ldo + h * DV + 4 * hf + d * 32 + 8 * g) = cvt_fp8x4(o[d][4 * g] * inv, o[d][4 * g + 1] * inv, o[d][4 * g + 2] * inv, o[d][4 * g + 3] * inv);
        if (!has_next) break;
        j = jn; b = nb_; h = nh; qt = nqt; t_lo = nt_lo; n_lat = nn_lat;
    }
#undef NA_TILE_OF
}

template <class E> struct epi_perm16 { static constexpr bool value = false; };
template <class E> struct epi_fp8 { static constexpr int value = 0; };
typedef int v8i_t __attribute__((ext_vector_type(8)));
typedef int v4i_t __attribute__((ext_vector_type(4)));
namespace pg8 {
constexpr int BM = 256, BK = 64, HALF = 128, HTB = HALF * BK * 2  ;
DI int lds_byte(int r, int c) { const int st = (r >> 4) * 2 + (c >> 5), rr = r & 15, cc = c & 31, ob = rr * 64 + cc * 2; return st * 1024 + (ob ^ (((ob >> 9) & 1) << 5)); }
DI void stage_rc(int b, int& R, int& C) { const int st = b / 1024, sb = b % 1024, swz = sb ^ (((sb >> 9) & 1) << 5); R = (st >> 1) * 16 + swz / 64; C = (st & 1) * 32 + (swz % 64) / 2; }
DI int perm32(int rho) { const int n = rho >> 4, i = rho & 15; return 8 * (i >> 2) + 4 * n + (i & 3); }

template <class Epi, class Sched>
DI void gemm_phase(lds_ptr lds, const bf16_t* __restrict__ Aop, const int K, const Sched& S, const Epi& E, const int tid) {
    const int wid = __builtin_amdgcn_readfirstlane(tid >> 6), lane = tid & 63, wr = wid >> 2, wc = wid & 3, fr = lane & 15, fq = lane >> 4;
    const int nt = K / BK;
    int Ra[2], Ca[2]; unsigned voffB[2];
#pragma unroll
    for (int i = 0; i < 2; ++i) { int R, C; stage_rc(tid * 16 + i * 8192, R, C); const int p32 = perm32(R & 31); const int Rb = epi_perm16<Epi>::value ? 64 * (R >> 5) + 16 * (p32 >> 3) + (p32 & 7) : Epi::PERM ? ((R & ~31) + p32) : R;
        Ra[i] = R; Ca[i] = C; voffB[i] = (unsigned)(Rb * K + C) * 2u; }
    const size_t kstep = (size_t)(BK * 2);
    const size_t hstep = (size_t)(epi_perm16<Epi>::value ? 8 : HALF) * K * 2;
    const unsigned ldsw = (unsigned)wid * 1024u;
    const int aoff = lds_byte(wr * 64 + fr, fq * 8), boff = lds_byte(wc * 32 + fr, fq * 8);
#define PG8_SA(b, h) (((b) * 2 + (h)) * HTB)
#define PG8_SB(b, h) ((4 + (b) * 2 + (h)) * HTB)
#define PG8_STAGE(bufoff, gbase, voff) do { const char* _gb = (const char*)(gbase); asm volatile("" : "+s"(_gb)); _Pragma("unroll") for (int _i = 0; _i < 2; ++_i) { \
        unsigned _o = (voff)[_i]; asm volatile("" : "+v"(_o)); \
        __builtin_amdgcn_global_load_lds((const unsigned*)(_gb + _o), (LAS unsigned*)(lds + (bufoff) + ldsw + _i * 8192), 16, 0, 0); } } while (0)
#define PG8_LDA(dst, b, h) do { _Pragma("unroll") for (int m = 0; m < 4; ++m) _Pragma("unroll") for (int k = 0; k < 2; ++k) dst[m][k] = *(const LAS bf16x8*)(lds + PG8_SA(b, h) + aoff + m * 2048 + k * 1024); } while (0)
#define PG8_LDB(dst, b, h) do { _Pragma("unroll") for (int n = 0; n < 2; ++n) _Pragma("unroll") for (int k = 0; k < 2; ++k) dst[n][k] = *(const LAS bf16x8*)(lds + PG8_SB(b, h) + boff + n * 2048 + k * 1024); } while (0)
typedef long i64x2_t __attribute__((ext_vector_type(2)));
#define PG8_MMA(ai, bj, At, Bt) do { __builtin_amdgcn_s_setprio(1); _Pragma("unroll") for (int m = 0; m < 4; ++m) _Pragma("unroll") for (int n = 0; n < 2; ++n) { \
        if (epi_fp8<Epi>::value == 2) { \
            const v8i_t _b = __builtin_shufflevector(__builtin_bit_cast(v4i_t, Bt[n][0]), __builtin_bit_cast(v4i_t, Bt[n][1]), 0, 1, 2, 3, 4, 5, 6, 7); \
            const v8i_t _a = __builtin_shufflevector(__builtin_bit_cast(v4i_t, At[m][0]), __builtin_bit_cast(v4i_t, At[m][1]), 0, 1, 2, 3, 4, 5, 6, 7); \
            acc[ai][bj][m][n] = __builtin_amdgcn_mfma_scale_f32_16x16x128_f8f6f4(_b, _a, acc[ai][bj][m][n], 0, 0, 0, 0, 0, 0); \
        } else { _Pragma("unroll") for (int k = 0; k < 2; ++k) { \
        if (epi_fp8<Epi>::value == 1) { const i64x2_t _b = __builtin_bit_cast(i64x2_t, Bt[n][k]), _a = __builtin_bit_cast(i64x2_t, At[m][k]); \
            acc[ai][bj][m][n] = __builtin_amdgcn_mfma_f32_16x16x32_fp8_fp8(_b[0], _a[0], acc[ai][bj][m][n], 0, 0, 0); \
            acc[ai][bj][m][n] = __builtin_amdgcn_mfma_f32_16x16x32_fp8_fp8(_b[1], _a[1], acc[ai][bj][m][n], 0, 0, 0); } \
        else acc[ai][bj][m][n] = __builtin_amdgcn_mfma_f32_16x16x32_bf16(Bt[n][k], At[m][k], acc[ai][bj][m][n], 0, 0, 0); } } } \
        __builtin_amdgcn_s_setprio(0); } while (0)
#define PG8_WAIT_V(n) asm volatile("s_waitcnt vmcnt(" #n ")" ::: "memory")
#define PG8_WAIT_L(n) asm volatile("s_waitcnt lgkmcnt(" #n ")" ::: "memory")
#define PG8_BAR __builtin_amdgcn_s_barrier()
#define PG8_SCHED __builtin_amdgcn_sched_barrier(0)
    typename Sched::Unit cur, nxt; int ui = 0;
    if (!S.next(0, cur)) return;
    f32x4 acc[2][2][4][2];
#pragma unroll
    for (int a = 0; a < 2; ++a)
#pragma unroll
        for (int b = 0; b < 2; ++b)
#pragma unroll
            for (int m = 0; m < 4; ++m)
#pragma unroll
                for (int n = 0; n < 2; ++n) acc[a][b][m][n] = (f32x4){0.f, 0.f, 0.f, 0.f};
    bf16x8 At[4][2], B0[2][2], B1[2][2];
    constexpr bool GATHER = Sched::GATHER;
    unsigned oc[2][2], on[2][2] = {{0u, 0u}, {0u, 0u}};
    size_t ubc[2] = {0, 0}, ubn[2] = {0, 0};
#pragma unroll
    for (int h = 0; h < 2; ++h) {
        if (!GATHER) ubc[h] = (size_t)S.a_off(cur, h * HALF) * 2u;
#pragma unroll
        for (int i = 0; i < 2; ++i) oc[h][i] = GATHER ? (S.a_off(cur, h * HALF + Ra[i]) + (unsigned)Ca[i]) * 2u : (unsigned)(Ra[i] * S.lda + Ca[i]) * 2u;
    }
    const char* gA = (const char*)Aop;
    const char* cB = (const char*)S.b_base(cur);
    PG8_STAGE(PG8_SB(0, 0), cB, voffB); PG8_STAGE(PG8_SB(0, 1), cB + hstep, voffB); PG8_STAGE(PG8_SA(0, 0), gA + ubc[0], oc[0]); PG8_STAGE(PG8_SA(0, 1), gA + ubc[1], oc[1]);
    if (wr == 1) PG8_BAR;
    PG8_WAIT_V(2); PG8_BAR;
    PG8_STAGE(PG8_SB(1, 0), cB + kstep, voffB); PG8_STAGE(PG8_SA(1, 0), gA + ubc[0] + kstep, oc[0]); PG8_STAGE(PG8_SB(1, 1), cB + hstep + kstep, voffB);
    PG8_WAIT_V(6); PG8_BAR;
    for (;;) {
        const bool has_next = S.next(ui + 1, nxt);
        const char* nB = has_next ? (const char*)S.b_base(nxt) : cB;
#pragma unroll
        for (int h = 0; h < 2; ++h) {
            if (!GATHER) ubn[h] = has_next ? (size_t)S.a_off(nxt, h * HALF) * 2u : ubc[h];
#pragma unroll
            for (int i = 0; i < 2; ++i) if (GATHER) { int R, C; stage_rc(((wid << 6) | lane_now()) * 16 + i * 8192, R, C);
                const unsigned* ip = S.a_ptr(nxt, h * HALF + R); if (epi_fp8<Epi>::value != 2) asm volatile("global_load_dword %0, %1, off" : "=v"(on[h][i]) : "v"(ip) : "memory"); }
        }
        const bool full = cur.half < 0;
        for (int t = 0; t < nt; t += 2) {
            const bool last = (t == nt - 2);
            const char* a1 = gA + (size_t)(t + 1) * kstep;
            const char* a2 = last ? gA : gA + (size_t)(t + 2) * kstep; const char* b2 = last ? nB : cB + (size_t)(t + 2) * kstep;
            const char* a3 = a2 + kstep; const char* b3 = b2 + kstep;
            size_t u2[2];
            if (GATHER && last) {
                if (epi_fp8<Epi>::value != 2) asm volatile("" : "+v"(on[0][0]), "+v"(on[0][1]), "+v"(on[1][0]), "+v"(on[1][1]));
#pragma unroll
                for (int i = 0; i < 2; ++i) { int R, C; stage_rc(((wid << 6) | lane_now()) * 16 + i * 8192, R, C);
                    if (epi_fp8<Epi>::value == 2) { on[0][i] = *S.a_ptr(nxt, R); on[1][i] = *S.a_ptr(nxt, HALF + R); }
                    oc[0][i] = (S.a_cvt(on[0][i]) + (unsigned)C) * 2u; on[1][i] = (S.a_cvt(on[1][i]) + (unsigned)C) * 2u; }
            }
#pragma unroll
            for (int h = 0; h < 2; ++h) u2[h] = last ? ubn[h] : ubc[h];
            PG8_LDB(B0, 0, 0); PG8_LDB(B1, 0, 1); PG8_SCHED; PG8_LDA(At, 0, 0); PG8_STAGE(PG8_SA(1, 1), a1 + ubc[1], oc[1]);
            if (GATHER && last) { oc[1][0] = on[1][0]; oc[1][1] = on[1][1]; }
            PG8_WAIT_V(8); PG8_WAIT_L(0); PG8_BAR; PG8_MMA(0, 0, At, B0); PG8_MMA(0, 1, At, B1); PG8_BAR; PG8_SCHED;
            PG8_LDA(At, 0, 1); PG8_STAGE(PG8_SB(0, 0), b2, voffB); PG8_STAGE(PG8_SB(0, 1), b2 + hstep, voffB); PG8_STAGE(PG8_SA(0, 0), a2 + u2[0], oc[0]);
            PG8_WAIT_V(8); PG8_WAIT_L(0); PG8_BAR; if (full) { PG8_MMA(1, 0, At, B0); PG8_MMA(1, 1, At, B1); } PG8_BAR; PG8_SCHED;
            PG8_LDB(B0, 1, 0); PG8_LDB(B1, 1, 1); PG8_SCHED; PG8_LDA(At, 1, 0); PG8_STAGE(PG8_SA(0, 1), a2 + u2[1], oc[1]);
            PG8_WAIT_V(8); PG8_WAIT_L(0); PG8_BAR; PG8_MMA(0, 0, At, B0); PG8_MMA(0, 1, At, B1); PG8_BAR; PG8_SCHED;
            PG8_LDA(At, 1, 1); PG8_STAGE(PG8_SB(1, 0), b3, voffB); PG8_STAGE(PG8_SB(1, 1), b3 + hstep, voffB); PG8_STAGE(PG8_SA(1, 0), a3 + u2[0], oc[0]);
            PG8_WAIT_V(8); PG8_WAIT_L(0); PG8_BAR; if (full) { PG8_MMA(1, 0, At, B0); PG8_MMA(1, 1, At, B1); } PG8_BAR; PG8_SCHED;
        }
        if (wr == 0) PG8_BAR;
        { const int ln = lane_now(); E(acc, cur, wr, wc, ln & 15, ln >> 4); }
        if (!has_next) break;
#pragma unroll
        for (int a = 0; a < 2; ++a)
#pragma unroll
            for (int b = 0; b < 2; ++b)
#pragma unroll
                for (int m = 0; m < 4; ++m)
#pragma unroll
                    for (int n = 0; n < 2; ++n) acc[a][b][m][n] = (f32x4){0.f, 0.f, 0.f, 0.f};
        cur = nxt; cB = nB; ++ui;
#pragma unroll
        for (int h = 0; h < 2; ++h) ubc[h] = ubn[h];
        if (wr == 1) PG8_BAR;
    }
    PG8_WAIT_V(0);
    PG8_BAR;
#undef PG8_SA
#undef PG8_SB
#undef PG8_STAGE
#undef PG8_LDA
#undef PG8_LDB
#undef PG8_MMA
#undef PG8_WAIT_V
#undef PG8_WAIT_L
#undef PG8_BAR
#undef PG8_SCHED
}
}

struct DenseSched {
    static constexpr bool GATHER = false;
    struct Unit { int pm, pn, half; };
    int nM, nN, nwg, G, c; const bf16_t* Bt; int K, lda; bool skip_ctx;
    DI void unit_of(int L, Unit& u) const {
        int wgid = L; { const int q = nwg / 8, r = nwg % 8, xcd = wgid % 8, off = wgid / 8; wgid = (xcd < r ? xcd * (q + 1) : r * (q + 1) + (xcd - r) * q) + off; }
        const int nig = 8 * nN, gid = wgid / nig, fm = gid * 8, gsz = (nM - fm) < 8 ? (nM - fm) : 8;
        u.pm = fm + ((wgid % nig) % gsz); u.pn = (wgid % nig) / gsz;
        if (skip_ctx) u.pm += u.pm >> 4;
    }
    DI bool next(int i, Unit& u) const {
        const int rounds = nwg / G, rem = nwg - rounds * G;
        if (i < rounds) { unit_of(i * G + c, u); u.half = -1; return true; }
        if (i > rounds || rem == 0) return false;
        if (2 * rem <= G) { if (c >= 2 * rem) return false; unit_of(rounds * G + (c >> 1), u); u.half = c & 1; return true; }
        if (c >= rem) return false;
        unit_of(rounds * G + c, u); u.half = -1; return true;
    }
    DI unsigned a_off(const Unit& u, int row) const { const int rr = u.half < 0 ? row : u.half * 128 + (row & 127); return (unsigned)(u.pm * 256 + rr) * (unsigned)lda; }
    DI const unsigned* a_ptr(const Unit&, int) const { return nullptr; }
    DI unsigned a_cvt(unsigned raw) const { return raw; }
    DI const bf16_t* b_base(const Unit& u) const { return Bt + (size_t)u.pn * 256 * K; }
};
struct MoeUnit { int e, pn, valid, half; const unsigned* ent; };
template <bool TAIL>
struct MoeSched {
    static constexpr bool GATHER = true;
    typedef MoeUnit Unit;
    const LAS int* tab; const unsigned* list; const unsigned* zero  ; const bf16_t* W; int K, N, TN, lda, shift, G, c, nwg;
    DI bool unit_of(int L, Unit& u) const {
        const int v = tab[1 + (lane_now() & 31)];
        const int e = __builtin_popcount((unsigned)__ballot(v <= L));
        if (e >= NEXP) return false;
        const int rem = L - __builtin_amdgcn_readfirstlane(tab[e]), cn = __builtin_amdgcn_readfirstlane(tab[40 + e]);
        const int rt = rem / TN; u.e = e; u.pn = rem - rt * TN; u.ent = list + (size_t)e * MROWS + rt * 256; u.valid = min(256, cn - rt * 256); return true;
    }
    int lo, n, GX, j;
    DI void place() { GX = G >> 3; j = c >> 3; const int per = ((((nwg + 7) >> 3) + TN - 1) / TN) * TN; lo = (c & 7) * per; n = max(0, min(per, nwg - lo)); }
    DI bool next(int i, Unit& u) const {
        u.ent = zero; u.valid = 1;
        const int rounds = n / GX, rem = n - rounds * GX;
        if (!TAIL) { u.half = -1; if (i >= rounds) return false; return unit_of(lo + i * GX + j, u); }
        if (i > 0 || rem == 0) return false;
        if (2 * rem <= GX) {
            if (j >= 2 * rem) return false;
            if (!unit_of(lo + rounds * GX + (j >> 1), u)) return false;
            u.half = j & 1; u.ent += u.half * 128; u.valid = min(128, u.valid - u.half * 128);
            return u.valid > 0;
        }
        u.half = -1; if (j >= rem) return false;
        return unit_of(lo + rounds * GX + j, u);
    }
    DI unsigned a_off(const Unit& u, int row) const { const int rr = (TAIL && u.half >= 0) ? (row & 127) : row; return (u.ent[rr < u.valid ? rr : u.valid - 1] >> shift) * (unsigned)lda; }
    DI const unsigned* a_ptr(const Unit& u, int row) const { const int rr = (TAIL && u.half >= 0) ? (row & 127) : row; return u.ent + (rr < u.valid ? rr : u.valid - 1); }
    DI unsigned a_cvt(unsigned raw) const { return (raw >> shift) * (unsigned)lda; }
    DI const bf16_t* b_base(const Unit& u) const { return W + ((size_t)u.e * N + (size_t)u.pn * 256) * K; }
};
typedef float f32x4_t __attribute__((ext_vector_type(4)));
struct XEpiStore {
    static constexpr bool PERM = true;
    bf16_t* C; int ldc;
    DI void operator()(const f32x4 (&acc)[2][2][4][2], const DenseSched::Unit& u, int wr, int wc, int fr, int fq) const {
        const int row0 = u.pm * 256 + (u.half > 0 ? 128 : 0) + wr * 64 + fr, col0 = u.pn * 256 + wc * 32 + 8 * fq;
#pragma unroll
        for (int ai = 0; ai < 2; ++ai) if (ai == 0 || u.half < 0)
#pragma unroll
            for (int m = 0; m < 4; ++m) { bf16_t* rowp = C + (size_t)(row0 + ai * 128 + m * 16) * ldc + col0;
#pragma unroll
                for (int bj = 0; bj < 2; ++bj) { const f32x4 v0 = acc[ai][bj][m][0], v1 = acc[ai][bj][m][1];
                    u32x4 w; w.x = cvtpk(v0[0], v0[1]); w.y = cvtpk(v0[2], v0[3]); w.z = cvtpk(v1[0], v1[1]); w.w = cvtpk(v1[2], v1[3]);
                    *(u32x4*)(rowp + bj * 128) = w; } }
    } };
struct XEpiStore8 {
    static constexpr bool PERM = true;
    bf16_t* C; int ldc;
    DI void operator()(const f32x4 (&acc)[2][2][4][2], const DenseSched::Unit& u, int wr, int wc, int fr, int fq) const {
        const int row0 = u.pm * 256 + (u.half > 0 ? 128 : 0) + wr * 64 + fr, col0 = u.pn * 256 + wc * 32 + 8 * fq;
#pragma unroll
        for (int ai = 0; ai < 2; ++ai) if (ai == 0 || u.half < 0)
#pragma unroll
            for (int m = 0; m < 4; ++m) { bf16_t* rowp = C + (size_t)(row0 + ai * 128 + m * 16) * ldc + col0;
#pragma unroll
                for (int bj = 0; bj < 2; ++bj) { const f32x4 v0 = acc[ai][bj][m][0] * (1.0f / 32.0f), v1 = acc[ai][bj][m][1] * (1.0f / 32.0f);
                    u32x4 w; w.x = cvtpk(v0[0], v0[1]); w.y = cvtpk(v0[2], v0[3]); w.z = cvtpk(v1[0], v1[1]); w.w = cvtpk(v1[2], v1[3]);
                    *(u32x4*)(rowp + bj * 128) = w; } }
    } };
template <> struct epi_fp8<XEpiStore8> { static constexpr int value = 2; };
struct XEpiResid {
    static constexpr bool PERM = true;
    const Params* p; const float* mod;
    DI void operator()(const f32x4 (&acc)[2][2][4][2], const DenseSched::Unit& u, int wr, int wc, int fr, int fq) const {
        const int row0 = u.pm * 256 + (u.half > 0 ? 128 : 0) + wr * 64 + fr, col0 = u.pn * 256 + wc * 32 + 8 * fq;
#pragma unroll
        for (int ai = 0; ai < 2; ++ai) if (ai == 0 || u.half < 0)
#pragma unroll
            for (int m = 0; m < 4; ++m) { const int row = row0 + ai * 128 + m * 16;
                bf16_t* xr = xb_row(*p, row) + col0; const float* gp = mod + (size_t)mod_row(row) * 6144 + 2048 + col0;
#pragma unroll
                for (int bj = 0; bj < 2; ++bj) {
                    const u32x4 xw = *(const u32x4*)(xr + bj * 128); const f32x4 g0 = *(const f32x4*)(gp + bj * 128), g1 = *(const f32x4*)(gp + bj * 128 + 4);
                    const f32x4 a0 = acc[ai][bj][m][0], a1 = acc[ai][bj][m][1];
                    u32x4 w;
                    w.x = cvtpk(bflo(xw.x) + g0[0] * a0[0], bfhi(xw.x) + g0[1] * a0[1]); w.y = cvtpk(bflo(xw.y) + g0[2] * a0[2], bfhi(xw.y) + g0[3] * a0[3]);
                    w.z = cvtpk(bflo(xw.z) + g1[0] * a1[0], bfhi(xw.z) + g1[1] * a1[1]); w.w = cvtpk(bflo(xw.w) + g1[2] * a1[2], bfhi(xw.w) + g1[3] * a1[3]);
                    *(u32x4*)(xr + bj * 128) = w; } }
    } };
struct XEpiResid8 {
    static constexpr bool PERM = true;
    const Params* p; const float* mod;
    DI void operator()(const f32x4 (&acc)[2][2][4][2], const DenseSched::Unit& u, int wr, int wc, int fr, int fq) const {
        const int row0 = u.pm * 256 + (u.half > 0 ? 128 : 0) + wr * 64 + fr, col0 = u.pn * 256 + wc * 32 + 8 * fq;
        const float* gp = mod + (size_t)mod_row(u.pm * 256) * 6144 + 2048 + col0;
        f32x4 gv[2][2];
#pragma unroll
        for (int bj = 0; bj < 2; ++bj) { gv[bj][0] = *(const f32x4*)(gp + bj * 128) * (1.0f / 32.0f); gv[bj][1] = *(const f32x4*)(gp + bj * 128 + 4) * (1.0f / 32.0f); }
#pragma unroll
        for (int ai = 0; ai < 2; ++ai) if (ai == 0 || u.half < 0)
#pragma unroll
            for (int m = 0; m < 4; ++m) { const int row = row0 + ai * 128 + m * 16;
                bf16_t* xr = xb_row(*p, row) + col0;
#pragma unroll
                for (int bj = 0; bj < 2; ++bj) {
                    const u32x4 xw = *(const u32x4*)(xr + bj * 128); const f32x4 g0 = gv[bj][0], g1 = gv[bj][1];
                    const f32x4 a0 = acc[ai][bj][m][0], a1 = acc[ai][bj][m][1];
                    u32x4 w;
                    w.x = cvtpk(bflo(xw.x) + g0[0] * a0[0], bfhi(xw.x) + g0[1] * a0[1]); w.y = cvtpk(bflo(xw.y) + g0[2] * a0[2], bfhi(xw.y) + g0[3] * a0[3]);
                    w.z = cvtpk(bflo(xw.z) + g1[0] * a1[0], bfhi(xw.z) + g1[1] * a1[1]); w.w = cvtpk(bflo(xw.w) + g1[2] * a1[2], bfhi(xw.w) + g1[3] * a1[3]);
                    *(u32x4*)(xr + bj * 128) = w; } }
    } };
template <> struct epi_fp8<XEpiResid8> { static constexpr int value = 2; };
struct XEpiGlu {
    static constexpr bool PERM = true;
    bf16_t* act; const float* gates;
    DI void operator()(const f32x4 (&acc)[2][2][4][2], const MoeUnit& u, int wr, int wc, int fr, int fq) const {
#pragma unroll
        for (int ai = 0; ai < 2; ++ai)
#pragma unroll
            for (int m = 0; m < 4; ++m) { const int i = ai * 128 + wr * 64 + m * 16 + fr;
                if (i < u.valid) { const unsigned a = u.ent[i]; const float gw = gates[a];
                    const f32x4 g0 = acc[ai][0][m][0], g1 = acc[ai][0][m][1], u0 = acc[ai][1][m][0], u1 = acc[ai][1][m][1];
                    float v[8];
#pragma unroll
                    for (int j = 0; j < 4; ++j) { v[j] = silu_f(g0[j]) * u0[j] * gw; v[4 + j] = silu_f(g1[j]) * u1[j] * gw; }
                    u32x4 w; w.x = cvtpk(v[0], v[1]); w.y = cvtpk(v[2], v[3]); w.z = cvtpk(v[4], v[5]); w.w = cvtpk(v[6], v[7]);
                    *(u32x4*)(act + (size_t)a * DEXP + u.pn * 128 + wc * 32 + 8 * fq) = w; } }
    } };
struct XEpiGlu8 : XEpiGlu {
    DI void operator()(const f32x4 (&acc)[2][2][4][2], const MoeUnit& u, int wr, int wc, int fr, int fq) const {
#pragma unroll
        for (int ai = 0; ai < 2; ++ai)
#pragma unroll
            for (int m = 0; m < 4; ++m) { const int i = ai * 128 + wr * 64 + m * 16 + fr;
                if (i < u.valid) { const unsigned a = u.ent[i]; const float gw = gates[a] * (1.0f / 32.0f);
                    const f32x4 g0 = acc[ai][0][m][0] * (1.0f / 32.0f), g1 = acc[ai][0][m][1] * (1.0f / 32.0f), u0 = acc[ai][1][m][0], u1 = acc[ai][1][m][1];
                    float v[8];
#pragma unroll
                    for (int j = 0; j < 4; ++j) { v[j] = silu_f(g0[j]) * u0[j] * gw; v[4 + j] = silu_f(g1[j]) * u1[j] * gw; }
                    u32x4 w; w.x = cvtpk(v[0], v[1]); w.y = cvtpk(v[2], v[3]); w.z = cvtpk(v[4], v[5]); w.w = cvtpk(v[6], v[7]);
                    *(u32x4*)(act + (size_t)a * DEXP + u.pn * 128 + wc * 32 + 8 * fq) = w; } }
    } };
template <> struct epi_fp8<XEpiGlu8> { static constexpr int value = 2; };
struct XEpiScatter {
    static constexpr bool PERM = true;
    bf16_t* outp;
    DI void operator()(const f32x4 (&acc)[2][2][4][2], const MoeUnit& u, int wr, int wc, int fr, int fq) const {
#pragma unroll
        for (int ai = 0; ai < 2; ++ai)
#pragma unroll
            for (int m = 0; m < 4; ++m) { const int i = ai * 128 + wr * 64 + m * 16 + fr;
                if (i < u.valid) { unsigned char* rowp = (unsigned char*)outp + (size_t)u.ent[i] * 1024 + u.pn * 256 + wc * 64 + 16 * fq;
                    const f32x4 a0 = acc[ai][0][m][0] * 16.f, a1 = acc[ai][0][m][1] * 16.f, b0 = acc[ai][1][m][0] * 16.f, b1 = acc[ai][1][m][1] * 16.f;
                    u32x4 w; w.x = cvt_fp8x4(a0[0], a0[1], a0[2], a0[3]); w.y = cvt_fp8x4(a1[0], a1[1], a1[2], a1[3]); w.z = cvt_fp8x4(b0[0], b0[1], b0[2], b0[3]); w.w = cvt_fp8x4(b1[0], b1[1], b1[2], b1[3]);
                    *(u32x4*)rowp = w; } }
    } };
template <> struct epi_perm16<XEpiScatter> { static constexpr bool value = true; };

template <int KIND>
struct XEpiQKV {
    static constexpr bool PERM = true;
    static constexpr int KW = KIND == 1 ? 256 : 1024, LDRAW = KIND == 1 ? 1536 : 3072;
    static constexpr float ASC = 1.0f / 32.0f;
    bf16_t* Q; bf16_t* Kb; bf16_t* RAW; const float* qn; const float* kn;
    DI void operator()(const f32x4 (&acc)[2][2][4][2], const DenseSched::Unit& u, int wr, int wc, int fr, int fq) const {
        const int col0 = u.pn * 256, row0 = u.pm * 256 + (u.half > 0 ? 128 : 0) + wr * 64 + fr;
        if (col0 >= 1024 + KW) {
#pragma unroll
            for (int ai = 0; ai < 2; ++ai) if (ai == 0 || u.half < 0)
#pragma unroll
                for (int m = 0; m < 4; ++m) { bf16_t* rowp = RAW + (size_t)(row0 + ai * 128 + m * 16) * LDRAW + col0 + wc * 32 + 8 * fq;
#pragma unroll
                    for (int bj = 0; bj < 2; ++bj) { const f32x4 v0 = acc[ai][bj][m][0] * ASC, v1 = acc[ai][bj][m][1] * ASC;
                        u32x4 w; w.x = cvtpk(v0[0], v0[1]); w.y = cvtpk(v0[2], v0[3]); w.z = cvtpk(v1[0], v1[1]); w.w = cvtpk(v1[2], v1[3]);
                        *(u32x4*)(rowp + bj * 128) = w; } }
            return;
        }
        const bool isq = col0 < 1024;
        const int head = isq ? 4 * u.pn + wc : ((col0 - 1024) >> 6) + wc;
        const float* gain = (isq ? qn : kn) + 8 * fq;
        const float scale = isq ? 0.125f * LOG2E : 1.0f;
        bf16_t* dstb = isq ? Q + head * 64 + 8 * fq : Kb + head * 64 + 8 * fq;
        const int ldd = isq ? 1024 : KW;
        f32x4 g[2][2];
#pragma unroll
        for (int bj = 0; bj < 2; ++bj)
#pragma unroll
            for (int n = 0; n < 2; ++n) g[bj][n] = *(const f32x4*)(gain + 32 * bj + 4 * n);
#pragma unroll
        for (int ai = 0; ai < 2; ++ai) if (ai == 0 || u.half < 0)
#pragma unroll
            for (int m = 0; m < 4; ++m) {
                const int row = row0 + ai * 128 + m * 16, b = row / PP, pos = row - b * PP;
                f32x4 v[2][2];
                float ss = 0.f;
#pragma unroll
                for (int bj = 0; bj < 2; ++bj)
#pragma unroll
                    for (int n = 0; n < 2; ++n) { v[bj][n] = acc[ai][bj][m][n] * ASC; ss += v[bj][n][0] * v[bj][n][0] + v[bj][n][1] * v[bj][n][1] + v[bj][n][2] * v[bj][n][2] + v[bj][n][3] * v[bj][n][3]; }
                ss += __shfl_xor(ss, 16); ss += __shfl_xor(ss, 32);
                const float rs = rsqrtf(ss * (1.0f / 64.0f) + EPS);
#pragma unroll
                for (int bj = 0; bj < 2; ++bj)
#pragma unroll
                    for (int n = 0; n < 2; ++n) v[bj][n] = v[bj][n] * rs * g[bj][n];
                if (KIND != 0 && pos < SEQ) {
                    const int prow = (pos >> 6) & 63, pcol = pos & 63;
                    const float* cs = ROPE64 + ((fq < 2 ? prow : pcol) * 16 + ((8 * fq) & 15)) * 2;
#pragma unroll
                    for (int n = 0; n < 2; ++n)
#pragma unroll
                        for (int j = 0; j < 4; ++j) {
                            const float c = cs[(4 * n + j) * 2], sn = cs[(4 * n + j) * 2 + 1], x1 = v[0][n][j], x2 = v[1][n][j];
                            v[0][n][j] = x1 * c - x2 * sn; v[1][n][j] = x2 * c + x1 * sn;
                        }
                }
                bf16_t* rowp = dstb + (size_t)row * ldd;
#pragma unroll
                for (int bj = 0; bj < 2; ++bj) { const f32x4 v0 = v[bj][0] * scale, v1 = v[bj][1] * scale;
                    u32x4 w; w.x = cvtpk(v0[0], v0[1]); w.y = cvtpk(v0[2], v0[3]); w.z = cvtpk(v1[0], v1[1]); w.w = cvtpk(v1[2], v1[3]);
                    *(u32x4*)(rowp + bj * 32) = w; }
            }
    } };
constexpr bool qkv_fp8(int kind) { return true; }
template <int KIND> struct epi_fp8<XEpiQKV<KIND>> { static constexpr int value = 2; };
template <int KIND>
DI void gemm_qkv_x(const Params& p, unsigned char* smem, const bf16_t* Wt, int N, const float* qn, const float* kn, int bid, int nb, int tid) {
    constexpr int KU = qkv_fp8(KIND) ? 512 : 1024;
    DenseSched S; S.nM = MROWS / 256; S.nN = N / 256; S.nwg = S.nM * S.nN; S.G = nb; S.c = bid; S.Bt = Wt; S.K = KU; S.lda = KU; S.skip_ctx = false;
    XEpiQKV<KIND> e{(bf16_t*)(p.ws + WS_Q), (bf16_t*)(p.ws + WS_K), (bf16_t*)(p.ws + WS_RAW), qn, kn};
    pg8::gemm_phase((lds_ptr)smem, (const bf16_t*)(p.ws + WS_H), KU, S, e, tid);
}
template <bool UQ>
struct XEpiMla {
    static constexpr bool PERM = true;
    static constexpr float ASC = 1.0f / 32.0f;
    bf16_t* Q; bf16_t* Kb; bf16_t* V; const float* qn; const float* kn;
    DI void operator()(const f32x4 (&acc)[2][2][4][2], const DenseSched::Unit& u, int wr, int wc, int fr, int fq) const {
        const int row0 = u.pm * 256 + (u.half > 0 ? 128 : 0) + wr * 64 + fr;
        if (u.pn < 4) {
            const int head = 4 * u.pn + wc;
            const float* gain = (UQ ? qn : kn) + 8 * fq;
            const float scale = UQ ? 0.10206207261596577f * LOG2E : 1.0f;
            bf16_t* dstb = (UQ ? Q : Kb) + head * 96 + 8 * fq;
            f32x4 g[2][2];
#pragma unroll
            for (int bj = 0; bj < 2; ++bj)
#pragma unroll
                for (int n = 0; n < 2; ++n) g[bj][n] = *(const f32x4*)(gain + 32 * bj + 4 * n);
#pragma unroll
            for (int ai = 0; ai < 2; ++ai) if (ai == 0 || u.half < 0)
#pragma unroll
                for (int m = 0; m < 4; ++m) {
                    const int row = row0 + ai * 128 + m * 16;
                    float ss = 0.f;
#pragma unroll
                    for (int bj = 0; bj < 2; ++bj)
#pragma unroll
                        for (int n = 0; n < 2; ++n) { const f32x4 v = acc[ai][bj][m][n] * ASC; ss += v[0] * v[0] + v[1] * v[1] + v[2] * v[2] + v[3] * v[3]; }
                    ss += __shfl_xor(ss, 16); ss += __shfl_xor(ss, 32);
                    const float rs = rsqrtf(ss * (1.0f / 64.0f) + EPS) * scale;
                    bf16_t* rowp = dstb + (size_t)row * 1536;
#pragma unroll
                    for (int bj = 0; bj < 2; ++bj) { const f32x4 v0 = acc[ai][bj][m][0] * (ASC * rs) * g[bj][0], v1 = acc[ai][bj][m][1] * (ASC * rs) * g[bj][1];
                        u32x4 w; w.x = cvtpk(v0[0], v0[1]); w.y = cvtpk(v0[2], v0[3]); w.z = cvtpk(v1[0], v1[1]); w.w = cvtpk(v1[2], v1[3]);
                        *(u32x4*)(rowp + bj * 32) = w; }
                }
        } else if (UQ) {
            const float scale = 0.10206207261596577f * LOG2E;
            const f32x4 g1 = *(const f32x4*)(qn + 64 + 4 * fq), g2 = *(const f32x4*)(qn + 64 + 16 + 4 * fq);
#pragma unroll
            for (int ai = 0; ai < 2; ++ai) if (ai == 0 || u.half < 0)
#pragma unroll
                for (int m = 0; m < 4; ++m) {
                    const int row = row0 + ai * 128 + m * 16, b = row / PP, pos = row - b * PP;
                    const int prow = (pos >> 6) & 63, pcol = pos & 63;
                    const float* cs = ROPE32 + ((fq < 2 ? prow : pcol) * 8 + ((4 * fq) & 7)) * 2;
#pragma unroll
                    for (int bj = 0; bj < 2; ++bj) {
                        f32x4 x1 = acc[ai][bj][m][0] * ASC, x2 = acc[ai][bj][m][1] * ASC;
                        float ss = x1[0] * x1[0] + x1[1] * x1[1] + x1[2] * x1[2] + x1[3] * x1[3] + x2[0] * x2[0] + x2[1] * x2[1] + x2[2] * x2[2] + x2[3] * x2[3];
                        ss += __shfl_xor(ss, 16); ss += __shfl_xor(ss, 32);
                        const float rs = rsqrtf(ss * (1.0f / 32.0f) + EPS);
                        x1 = x1 * rs * g1; x2 = x2 * rs * g2;
                        if (pos < SEQ) {
#pragma unroll
                            for (int j = 0; j < 4; ++j) { const float c = cs[2 * j], sn = cs[2 * j + 1], a1 = x1[j], a2 = x2[j]; x1[j] = a1 * c - a2 * sn; x2[j] = a2 * c + a1 * sn; }
                        }
                        x1 = x1 * scale; x2 = x2 * scale;
                        bf16_t* rowp = Q + (size_t)row * 1536 + (8 * (u.pn - 4) + 4 * bj + wc) * 96 + 64 + 4 * fq;
                        u32x2 w1, w2; w1.x = cvtpk(x1[0], x1[1]); w1.y = cvtpk(x1[2], x1[3]); w2.x = cvtpk(x2[0], x2[1]); w2.y = cvtpk(x2[2], x2[3]);
                        *(u32x2*)rowp = w1; *(u32x2*)(rowp + 16) = w2;
                    }
                }
        } else {
#pragma unroll
            for (int ai = 0; ai < 2; ++ai) if (ai == 0 || u.half < 0)
#pragma unroll
                for (int m = 0; m < 4; ++m) { bf16_t* rowp = V + (size_t)(row0 + ai * 128 + m * 16) * 1024 + (u.pn - 4) * 256 + wc * 32 + 8 * fq;
#pragma unroll
                    for (int bj = 0; bj < 2; ++bj) { const f32x4 v0 = acc[ai][bj][m][0] * ASC, v1 = acc[ai][bj][m][1] * ASC;
                        u32x4 w; w.x = cvtpk(v0[0], v0[1]); w.y = cvtpk(v0[2], v0[3]); w.z = cvtpk(v1[0], v1[1]); w.w = cvtpk(v1[2], v1[3]);
                        *(u32x4*)(rowp + bj * 128) = w; } }
        }
    } };
template <bool UQ> struct epi_fp8<XEpiMla<UQ>> { static constexpr int value = 2; };
template <bool UQ>
DI void gemm_mla_x(const Params& p, unsigned char* smem, int bid, int nb, int tid) {
    bf16_t* O = (bf16_t*)(p.ws + WS_O);
    DenseSched S; S.nM = MROWS / 256; S.nN = (UQ ? 1536 : 2048) / 256; S.nwg = S.nM * S.nN; S.G = nb; S.c = bid; S.Bt = (const bf16_t*)(p.ws + (UQ ? W_UQ : W_UKV)); S.K = UQ ? 256 : 128; S.lda = S.K; S.skip_ctx = false;
    XEpiMla<UQ> e{(bf16_t*)(p.ws + WS_Q), (bf16_t*)(p.ws + WS_K), (bf16_t*)(p.ws + WS_RAW), p.in[28], p.in[29]};
    pg8::gemm_phase((lds_ptr)smem, UQ ? O : (const bf16_t*)((const unsigned char*)O + (size_t)MROWS * 512), S.K, S, e, tid);
}
template <int EPIK>
DI void gemm_dense_x(const Params& p, unsigned char* smem, const bf16_t* A, int lda, const bf16_t* Wt, int K, int N, bf16_t* C, int ldc, const float* mod, int bid, int nb, int tid, bool skip_ctx = false) {
    DenseSched S; S.nM = skip_ctx ? NBATCH * 16 : MROWS / 256; S.nN = N / 256; S.nwg = S.nM * S.nN; S.G = nb; S.c = bid; S.Bt = Wt; S.K = K; S.lda = lda; S.skip_ctx = skip_ctx;
    if (EPIK == 0) { XEpiStore e{C, ldc}; pg8::gemm_phase((lds_ptr)smem, A, K, S, e, tid); }
    else if (EPIK == 2) { XEpiStore8 e{C, ldc}; pg8::gemm_phase((lds_ptr)smem, A, K, S, e, tid); }
    else if (EPIK == 3) { XEpiResid8 e{&p, mod}; pg8::gemm_phase((lds_ptr)smem, A, K, S, e, tid); }
    else { XEpiResid e{&p, mod}; pg8::gemm_phase((lds_ptr)smem, A, K, S, e, tid); }
}
template <int WHICH, bool TAIL>
DI void gemm_moe_call(const Params& p, unsigned char* smem, int layer, int bid, int nb, int tid) {
    MoeSched<TAIL> S; S.list = (const unsigned*)(p.ws + WS_LIST); S.zero = (const unsigned*)(p.ws + WS_CTL) + 8192; S.G = nb; S.c = bid;
    {
        LAS int* tab = (LAS int*)(smem + GEMM_LDS);
        constexpr int TNc = WHICH == 0 ? 2 : 4;
        if (tid < 64) {
            const unsigned cv = tid < 32 ? ((const unsigned*)(p.ws + WS_CTL) + CW_CNT + layer * 32)[tid] : 0u;
            int incl = (int)((cv + 255u) >> 8) * TNc;
#pragma unroll
            for (int d = 1; d < 32; d <<= 1) { const int o = __shfl_up(incl, d); if (tid >= d) incl += o; }
            if (tid < 32) { tab[1 + tid] = incl; tab[40 + tid] = (int)cv; }
            if (tid == 0) tab[0] = 0;
        }
        __syncthreads();
        S.tab = tab; S.nwg = __builtin_amdgcn_readfirstlane(tab[32]);
    }
    if (WHICH == 0) { S.W = (const bf16_t*)(p.ws + W_GU + (size_t)layer * 32 * 512 * 1024); S.K = 512; S.N = 512; S.TN = 2; S.lda = 512; S.shift = 1;
        S.place(); XEpiGlu8 e{{(bf16_t*)(p.ws + WS_Q), (const float*)(p.ws + WS_GATE)}}; pg8::gemm_phase((lds_ptr)smem, (const bf16_t*)(p.ws + WS_H), 512, S, e, tid); }
    else { S.W = (const bf16_t*)(p.ws + W_DN) + (size_t)layer * 32 * 1024 * 256; S.K = 256; S.N = 1024; S.TN = 4; S.lda = DEXP; S.shift = 0;
        S.place(); XEpiScatter e{(bf16_t*)(p.ws + WS_RAW)}; pg8::gemm_phase((lds_ptr)smem, (const bf16_t*)(p.ws + WS_Q), 256, S, e, tid); }
}
template <int WHICH>
DI void gemm_moe_x(const Params& p, unsigned char* smem, int layer, int bid, int nb, int tid) {
    const int wv = __builtin_amdgcn_readfirstlane(tid >> 6);
    gemm_moe_call<WHICH, false>(p, smem, layer, bid, nb, (wv << 6) | lane_now());
    gemm_moe_call<WHICH, true>(p, smem, layer, bid, nb, (wv << 6) | lane_now());
}

constexpr int NPHASES = 2 + (7 + 7 + 9 + 7) + 1;
constexpr int SMEM_BYTES = GEMM_LDS + 512;

template <int KIND>
DI void layer_phases(const Params& p, int& ph, const int lo, const int hi, const XcdBarrier& bar, unsigned char* smem, int bid, int nb, int wid_u) {
    constexpr int L = KIND;
    const float* mod = (const float*)(p.ws + WS_MOD) + (size_t)L * 9 * 6144;
    bf16_t* H = (bf16_t*)(p.ws + WS_H); bf16_t* O = (bf16_t*)(p.ws + WS_O); bf16_t* RAW = (bf16_t*)(p.ws + WS_RAW);
    bf16_t* Q = (bf16_t*)(p.ws + WS_Q); bf16_t* Kb = (bf16_t*)(p.ws + WS_K);
#ifndef AABL
#define AABL 0
#endif
#ifndef GPROBE
#define GPROBE 0
#endif
#ifndef DUP_MASK
#define DUP_MASK 0ull
#endif
#define PHASE2(BODY, DUPBODY) do { if (lo <= ph && ph < hi) { const int tid = (wid_u << 6) | lane_now(); if ((DUP_MASK >> ph) & 1ull) { DUPBODY; xcd_barrier(bar, tid == 0); } BODY; } if (lo <= ph && ph + 1 < hi) xcd_barrier(bar, ((wid_u << 6) | lane_now()) == 0); ++ph; } while (0)
#define PHASE(...) PHASE2((__VA_ARGS__), (__VA_ARGS__))
    if (L == 0) PHASE(phase_rows<2 | 8 | 32>(p, L, 0, bid, nb, tid), phase_router_prep(p, bid, nb, tid));
    else PHASE2((phase_rows<3 | 32>(p, L, 0, bid, nb, tid)), (phase_rows<2 | 32>(p, L, 0, bid, nb, tid)));
    AttnP a{};
    if (KIND == 0) {
        PHASE(gemm_qkv_x<0>(p, smem, (const bf16_t*)(p.ws + W_QKV0), 3072, p.in[15], p.in[16], bid, nb, tid));
        a = AttnP{Q, 1024, Kb, 1024, RAW + 2048, 3072, O, 1024, 16, 0, 0, 64, p.in[17], nullptr, 1, p.in[16]};
        PHASE(attn_na(a, smem, bid, nb, tid));
        PHASE2((gemm_dense_x<3>(p, smem, O, 512, (const bf16_t*)(p.ws + W_O0), 512, 1024, nullptr, 0, mod, bid, nb, tid)), (gemm_dense_x<0>(p, smem, O, 1024, (const bf16_t*)(p.ws + W_O0), 1024, 1024, RAW, 1024, nullptr, bid, nb, tid)));
    } else if (KIND == 1) {
        PHASE(gemm_qkv_x<1>(p, smem, (const bf16_t*)(p.ws + W_QKV1), 1536, p.in[20], p.in[21], bid, nb, tid));
        a = AttnP{Q, 1024, Kb, 256, RAW + 1280, 1536, O, 1024, 16, 2, 2, 64, nullptr, p.in[22], 1};
        PHASE(attn_mfma<64, 64, 1>(a, smem, bid, nb, tid));
        PHASE2((gemm_dense_x<3>(p, smem, O, 512, (const bf16_t*)(p.ws + W_O1), 512, 1024, nullptr, 0, mod, bid, nb, tid)), (gemm_dense_x<0>(p, smem, O, 1024, (const bf16_t*)(p.ws + W_O1), 1024, 1024, RAW, 1024, nullptr, bid, nb, tid)));
    } else if (KIND == 2) {
        bf16_t* cqn = O; bf16_t* ckvn = O + (size_t)MROWS * 384;
        PHASE(gemm_dense_x<2>(p, smem, H, 512, (const bf16_t*)(p.ws + W_DQKV), 512, 768, Q, 768, nullptr, bid, nb, tid));
        PHASE(phase_post_mla1(p, bid, nb, tid));
        PHASE(gemm_mla_x<true>(p, smem, bid, nb, tid), gemm_mla_x<false>(p, smem, bid, nb, (wid_u << 6) | lane_now()));
        a = AttnP{Q, 1536, Kb, 1536, RAW, 1024, O, 1024, 16, 0, 0, 64, nullptr, nullptr, 1};
        PHASE(attn_mfma<96, 64, 2>(a, smem, bid, nb, tid));
        PHASE2((gemm_dense_x<3>(p, smem, O, 512, (const bf16_t*)(p.ws + W_O2), 512, 1024, nullptr, 0, mod, bid, nb, tid)), (gemm_dense_x<0>(p, smem, O, 1024, (const bf16_t*)(p.ws + W_O2), 1024, 1024, RAW, 1024, nullptr, bid, nb, tid)));
    } else {
        PHASE(gemm_qkv_x<3>(p, smem, (const bf16_t*)(p.ws + W_QKV3), 3072, p.in[32], p.in[33], bid, nb, tid));
        a = AttnP{Q, 1024, Kb, 1024, RAW + 2048, 3072, H  , 2048, 16, 0, 1, 128, nullptr, nullptr, 0, nullptr, p.in[34], p.in[35], (unsigned char*)RAW  , 6144};
        PHASE(attn_mfma<64, 128, 2>(a, smem, bid, nb, tid));
        PHASE(gemm_dense_x<3>(p, smem, RAW, 3072, (const bf16_t*)(p.ws + W_O3), 512, 1024, nullptr, 0, mod, bid, nb, tid, true));
    }
    PHASE(phase_router(p, smem, L, L == 3, bid, nb, tid));
    PHASE(gemm_moe_x<0>(p, smem, L, bid, nb, tid));
    PHASE(gemm_moe_x<1>(p, smem, L, bid, nb, tid));
}

__global__ void __launch_bounds__(NTHREADS, 2) mega(Params p, int lo, int hi) {
    extern __shared__ __attribute__((aligned(16))) unsigned char smem[];
    const int bid = blockIdx.x, nb = gridDim.x, wid_u = __builtin_amdgcn_readfirstlane(threadIdx.x >> 6);
    float* lds = (float*)smem;
    volatile LAS unsigned* xbw = (volatile LAS unsigned*)(smem + SMEM_BYTES - 16);
    if (threadIdx.x == 0) { xbw[0] = 0u; xbw[1] = 0u; }
    __syncthreads();
    XcdBarrier bar = xcd_barrier_post((unsigned*)(p.ws + WS_CTL), xbw);
    int ph = 0;
    PHASE(phase_prologue(p, lds, bid, nb, tid));
    PHASE(phase_mod_reduce(p, bid, nb, tid));
    layer_phases<0>(p, ph, lo, hi, bar, smem, bid, nb, wid_u);
    layer_phases<1>(p, ph, lo, hi, bar, smem, bid, nb, wid_u);
    layer_phases<2>(p, ph, lo, hi, bar, smem, bid, nb, wid_u);
    layer_phases<3>(p, ph, lo, hi, bar, smem, bid, nb, wid_u);
    PHASE2((phase_rows<1 | 16>(p, 3, 0, bid, nb, tid)), (void)0);
}

extern "C" void kernel_launch(void* const* d_in, const int* in_sizes, int n_in, void* d_out, int out_size, void* d_ws, size_t ws_size, hipStream_t stream) {
    (void)in_sizes; (void)out_size;
    if (n_in < 37 || ws_size < WS_END) { fprintf(stderr, "kernel_launch: unexpected inputs (n_in %d, ws %zu)\n", n_in, ws_size); return; }
    static int grid = 0;
    if (!grid) {
        int dev = 0, cus = 0, per_cu = 0;
        hipGetDevice(&dev);
        hipDeviceGetAttribute(&cus, hipDeviceAttributeMultiprocessorCount, dev);
        hipFuncSetAttribute((const void*)mega, hipFuncAttributeMaxDynamicSharedMemorySize, SMEM_BYTES);
        hipOccupancyMaxActiveBlocksPerMultiprocessor(&per_cu, mega, NTHREADS, SMEM_BYTES);
        if (per_cu < 1) per_cu = 1;
        grid = cus * (per_cu < 1 ? per_cu : 1);
    }
    Params p{};
    for (int i = 0; i < 37; ++i) p.in[i] = (const float*)d_in[i];
    p.out = (float*)d_out; p.ws = (unsigned char*)d_ws;
    hipMemsetAsync(p.ws + WS_CTL, 0, 65536, stream);
#if ONE_LAUNCH
    hipLaunchKernelGGL(mega, dim3(grid), dim3(NTHREADS), SMEM_BYTES, stream, p, 0, NPHASES);
#else
    for (int k = 0; k < NPHASES; ++k) hipLaunchKernelGGL(mega, dim3(grid), dim3(NTHREADS), SMEM_BYTES, stream, p, k, k + 1);
#endif
}
```
